# Optimizing an MI355X kernel written in HIP

```python
import math
import jax, jax.numpy as jnp
from jax import lax
import numpy as np

D_MODEL = 1024
BATCH = 8
SEQ = 2048
DEPTH = 2

HEAD_DIM = 64
FOX_HEADS = 4
DIL_HEADS = 4
FOX_W = FOX_HEADS * HEAD_DIM
DIL_W = DIL_HEADS * HEAD_DIM
SSD_HEADS = 8
SSD_HEAD_DIM = 64
SSD_INNER = SSD_HEADS * SSD_HEAD_DIM
SSD_GROUPS = 2
SSD_HPG = SSD_HEADS // SSD_GROUPS
SSD_STATE = 128
SSD_CONV = 4
SSD_CHUNK = 128
SSD_CONV_CH = SSD_INNER + 2 * SSD_GROUPS * SSD_STATE
MIX_WIDTH = FOX_W + DIL_W + SSD_INNER
PROJ_SIZES = (FOX_W, FOX_W, FOX_W, FOX_HEADS, DIL_W, DIL_W, DIL_W, SSD_INNER, SSD_CONV_CH, SSD_HEADS)
IN_PROJ = sum(PROJ_SIZES)
Q_BLOCK = 128
DIL_CONFIGS = ((128, 1), (512, 4), (2048, 16))
ROPE_THETA = 500000.0
ROPE_DIM = HEAD_DIM // 4
MEM_LEN = 256
XA_HEADS = 4
XA_HEAD_DIM = D_MODEL // XA_HEADS
N_GROUPS = 4
EXPERTS_PER_GROUP = 8
N_EXPERTS = N_GROUPS * EXPERTS_PER_GROUP
TOP_K = 2
EXPERT_FF = 512
MOE_BLOCK = 128
EPS = 1e-6

kernel_name = "hybrid_fox_dilated_ssd_hmoe"


def rmsnorm(x, g):
    xf = x.astype(jnp.float32)
    y = xf * lax.rsqrt(jnp.mean(xf * xf, axis=-1, keepdims=True) + EPS)
    return (y * g.astype(jnp.float32)).astype(x.dtype)


def rotary_partial(t, pos):
    half = ROPE_DIM // 2
    inv = jnp.power(ROPE_THETA, -2.0 * jnp.arange(half, dtype=jnp.float32) / ROPE_DIM)
    ang = pos.astype(jnp.float32)[:, None] * inv[None, :]
    cos = jnp.cos(ang).astype(t.dtype)
    sin = jnp.sin(ang).astype(t.dtype)
    t1, t2, rest = t[..., :half], t[..., half:ROPE_DIM], t[..., ROPE_DIM:]
    return jnp.concatenate([t1 * cos - t2 * sin, t2 * cos + t1 * sin, rest], axis=-1)


def fox_attention(q, k, v, log_f):
    B, H, S, hd = q.shape
    nb = S // Q_BLOCK
    c = jnp.cumsum(log_f, axis=-1)
    scale = hd ** -0.5
    qb = q.reshape(B, H, nb, Q_BLOCK, hd).transpose(2, 0, 1, 3, 4)
    cb = c.reshape(B, H, nb, Q_BLOCK).transpose(2, 0, 1, 3)
    kpos = jnp.arange(S)

    def block(args):
        qi, ci, bi = args
        s = jnp.einsum("bhqd,bhkd->bhqk", qi, k).astype(jnp.float32) * scale
        s = s + ci[..., :, None] - c[..., None, :]
        qpos = bi * Q_BLOCK + jnp.arange(Q_BLOCK)
        s = jnp.where(kpos[None, :] <= qpos[:, None], s, -jnp.inf)
        p = jax.nn.softmax(s, axis=-1)
        return jnp.einsum("bhqk,bhkd->bhqd", p.astype(v.dtype), v)

    o = lax.map(block, (qb, cb, jnp.arange(nb)))
    return o.transpose(1, 2, 0, 3, 4).reshape(B, H, S, hd)


def dilated_attention(q, k, v):
    B, H, S, hd = q.shape
    scale = hd ** -0.5
    outs, maxes, dens = [], [], []
    for window, dil in DIL_CONFIGS:
        steps = window // dil
        L = S // dil
        nb = -(-L // steps)
        Lp = nb * steps

        def to_res(t):
            t = t.reshape(B, H, L, dil, hd).transpose(0, 1, 3, 2, 4)
            t = jnp.pad(t, ((0, 0), (0, 0), (0, 0), (0, Lp - L), (0, 0)))
            return t.reshape(B, H, dil, nb, steps, hd)

        def band(t):
            prev = jnp.pad(t, ((0, 0), (0, 0), (0, 0), (1, 0), (0, 0), (0, 0)))[:, :, :, :-1]
            return jnp.concatenate([prev, t], axis=4)

        def from_res(t):
            X = t.shape[-1]
            t = t.reshape(B, H, dil, Lp, X)[:, :, :, :L]
            return t.transpose(0, 1, 3, 2, 4).reshape(B, H, S, X)

        qr = to_res(q)
        kb = band(to_res(k))
        vb = band(to_res(v))
        s = jnp.einsum("bhrnqd,bhrnkd->bhrnqk", qr, kb).astype(jnp.float32) * scale
        qi = jnp.arange(steps)[:, None] + steps
        kj = jnp.arange(2 * steps)[None, :]
        dist = qi - kj
        blk = jnp.arange(nb)[:, None, None]
        valid = (dist >= 0) & (dist <= steps) & (blk * steps + kj[None] - steps >= 0)
        s = jnp.where(valid, s, -jnp.inf)
        m = jnp.max(s, axis=-1, keepdims=True)
        e = jnp.exp(s - m)
        den = jnp.sum(e, axis=-1, keepdims=True)
        o = jnp.einsum("bhrnqk,bhrnkd->bhrnqd", (e / den).astype(v.dtype), vb)
        outs.append(from_res(o).astype(jnp.float32))
        maxes.append(from_res(m))
        dens.append(from_res(den))
    ms = jnp.stack(maxes)
    ds = jnp.stack(dens)
    os_ = jnp.stack(outs)
    w = jnp.exp(ms - jnp.max(ms, axis=0, keepdims=True)) * ds
    o = jnp.sum(w * os_, axis=0) / jnp.sum(w, axis=0)
    return o.astype(q.dtype)


def ssd_mixer(z, xbc, dt_raw, conv_w, conv_b, dt_bias, A_log, D_skip, norm_g):
    B, S, _ = z.shape
    G, R, P, N, Q = SSD_GROUPS, SSD_HPG, SSD_HEAD_DIM, SSD_STATE, SSD_CHUNK
    nc = S // Q
    conv = lax.conv_general_dilated(
        xbc, conv_w.reshape(SSD_CONV, 1, SSD_CONV_CH).astype(xbc.dtype),
        window_strides=(1,), padding=((SSD_CONV - 1, 0),),
        dimension_numbers=("NWC", "WIO", "NWC"), feature_group_count=SSD_CONV_CH)
    xbc = jax.nn.silu(conv + conv_b)
    xs = xbc[..., :SSD_INNER].reshape(B, S, G, R, P)
    Bm = xbc[..., SSD_INNER:SSD_INNER + G * N].reshape(B, nc, Q, G, N)
    Cm = xbc[..., SSD_INNER + G * N:].reshape(B, nc, Q, G, N)
    dt = jax.nn.softplus(dt_raw.astype(jnp.float32) + dt_bias.astype(jnp.float32))
    A = -jnp.exp(A_log.astype(jnp.float32))
    dA = (dt * A).reshape(B, nc, Q, G, R).transpose(0, 3, 4, 1, 2)
    Xc = (xs * dt.reshape(B, S, G, R)[..., None]).reshape(B, nc, Q, G, R, P)
    A_cs = jnp.cumsum(dA, axis=-1)
    tri = jnp.tril(jnp.ones((Q, Q), dtype=bool))
    Lmat = jnp.exp(jnp.where(tri, A_cs[..., :, None] - A_cs[..., None, :], -jnp.inf))
    CB = jnp.einsum("bclgn,bcsgn->bcgls", Cm, Bm)
    y_diag = jnp.einsum("bcgls,bgrcls,bcsgrp->bclgrp", CB, Lmat, Xc)
    decay_states = jnp.exp(A_cs[..., -1:] - A_cs)
    states = jnp.einsum("bclgn,bgrcl,bclgrp->bcgrpn", Bm, decay_states, Xc)
    chunk_decay = jnp.exp(A_cs[..., -1])

    def step(h, inp):
        st, dec = inp
        return dec[..., None, None] * h + st, h

    h0 = jnp.zeros((B, G, R, P, N), states.dtype)
    _, h_in = lax.scan(step, h0, (jnp.moveaxis(states, 1, 0), jnp.moveaxis(chunk_decay, -1, 0)))
    h_in = jnp.moveaxis(h_in, 0, 1)
    y_off = jnp.einsum("bclgn,bcgrpn,bgrcl->bclgrp", Cm, h_in, jnp.exp(A_cs))
    y = (y_diag + y_off).reshape(B, S, G, R, P) + xs * D_skip.reshape(G, R, 1)
    y = y.reshape(B, S, SSD_INNER).astype(z.dtype)
    return rmsnorm(y * jax.nn.silu(z), norm_g)


def memory_cross_attention(h, mem_n, wq, wkv, qn_g, kn_g, wo):
    B, S, _ = h.shape
    q = rmsnorm((h @ wq).reshape(B, S, XA_HEADS, XA_HEAD_DIM), qn_g)
    k, v = jnp.split(mem_n @ wkv, 2, axis=-1)
    k = rmsnorm(k.reshape(B, MEM_LEN, XA_HEADS, XA_HEAD_DIM), kn_g)
    v = v.reshape(B, MEM_LEN, XA_HEADS, XA_HEAD_DIM)
    s = jnp.einsum("bshd,bmhd->bhsm", q, k).astype(jnp.float32) * (XA_HEAD_DIM ** -0.5)
    p = jax.nn.softmax(s, axis=-1)
    o = jnp.einsum("bhsm,bmhd->bshd", p.astype(v.dtype), v).reshape(B, S, D_MODEL)
    return o @ wo


def hierarchical_moe(h, wg, bg, we, be, w1, w3, w2):
    B, S, D = h.shape
    T = B * S
    xt = h.reshape(T, D)
    g_logits = (xt @ wg).astype(jnp.float32) + bg
    g_prob = jax.nn.softmax(g_logits, axis=-1)
    g_sel = jnp.argmax(g_logits, axis=-1)
    g_gate = jnp.take_along_axis(g_prob, g_sel[:, None], axis=1)
    e_logits = ((xt @ we).astype(jnp.float32) + be).reshape(T, N_GROUPS, EXPERTS_PER_GROUP)
    e_in = jnp.take_along_axis(e_logits, g_sel[:, None, None], axis=1)[:, 0]
    top_v, top_i = lax.top_k(e_in, TOP_K)
    gates = (jax.nn.softmax(top_v, axis=-1) * g_gate).reshape(T * TOP_K)
    eid = (g_sel[:, None] * EXPERTS_PER_GROUP + top_i).reshape(T * TOP_K)
    tok = jnp.repeat(jnp.arange(T), TOP_K)
    n_assign = T * TOP_K
    order = jnp.argsort(eid)
    s_eid, s_tok, s_gate = eid[order], tok[order], gates[order]
    counts = jnp.bincount(eid, length=N_EXPERTS)
    padded = (counts + MOE_BLOCK - 1) // MOE_BLOCK * MOE_BLOCK
    starts = jnp.cumsum(counts) - counts
    ends_p = jnp.cumsum(padded)
    pstarts = ends_p - padded
    dest = pstarts[s_eid] + jnp.arange(n_assign) - starts[s_eid]
    nblk = (n_assign + MOE_BLOCK - 1) // MOE_BLOCK + N_EXPERTS
    buf = jnp.zeros((nblk * MOE_BLOCK, D), xt.dtype).at[dest].set(xt[s_tok])
    blk_expert = jnp.minimum(jnp.searchsorted(ends_p, jnp.arange(nblk) * MOE_BLOCK, side="right"), N_EXPERTS - 1)

    def run(args):
        xb, e = args
        return (jax.nn.silu(xb @ w1[e]) * (xb @ w3[e])) @ w2[e]

    ybuf = lax.map(run, (buf.reshape(nblk, MOE_BLOCK, D), blk_expert)).reshape(nblk * MOE_BLOCK, D)
    y = jnp.zeros((T, D), xt.dtype).at[s_tok].add(ybuf[dest] * s_gate[:, None].astype(xt.dtype))
    return y.reshape(B, S, D)


def setup_inputs(seed: int = 0) -> dict:
    key = jax.random.key(seed)
    ks = iter(jax.random.split(key, 48))
    L = DEPTH

    def nrm(shape, s):
        return jax.random.normal(next(ks), shape, jnp.float32) * s

    def gain(n):
        return 1.0 + nrm((L, n), 0.02)

    x = nrm((BATCH, SEQ, D_MODEL), 1.0)
    mem = nrm((BATCH, MEM_LEN, D_MODEL), 1.0)
    norm1_g = gain(D_MODEL)
    w_in = nrm((L, D_MODEL, IN_PROJ), D_MODEL ** -0.5)
    fox_fgate_b = jax.random.uniform(next(ks), (L, FOX_HEADS), jnp.float32, 1.0, 4.0)
    fox_qn_g = gain(HEAD_DIM)
    fox_kn_g = gain(HEAD_DIM)
    dil_qn_g = gain(HEAD_DIM)
    dil_kn_g = gain(HEAD_DIM)
    ssd_conv_w = nrm((L, SSD_CONV, SSD_CONV_CH), SSD_CONV ** -0.5)
    ssd_conv_b = nrm((L, SSD_CONV_CH), 0.01)
    dt0 = jnp.exp(jax.random.uniform(next(ks), (L, SSD_HEADS), jnp.float32)
                  * (math.log(0.1) - math.log(0.001)) + math.log(0.001))
    ssd_dt_bias = dt0 + jnp.log(-jnp.expm1(-dt0))
    ssd_A_log = jnp.log(jax.random.uniform(next(ks), (L, SSD_HEADS), jnp.float32, 1.0, 16.0))
    ssd_D = 1.0 + nrm((L, SSD_HEADS), 0.1)
    ssd_norm_g = gain(SSD_INNER)
    w_out = nrm((L, MIX_WIDTH, D_MODEL), MIX_WIDTH ** -0.5)
    norm2_g = gain(D_MODEL)
    mem_norm_g = gain(D_MODEL)
    xa_wq = nrm((L, D_MODEL, D_MODEL), D_MODEL ** -0.5)
    xa_wkv = nrm((L, D_MODEL, 2 * D_MODEL), D_MODEL ** -0.5)
    xa_qn_g = gain(XA_HEAD_DIM)
    xa_kn_g = gain(XA_HEAD_DIM)
    xa_wo = nrm((L, D_MODEL, D_MODEL), D_MODEL ** -0.5)
    norm3_g = gain(D_MODEL)
    router_wg = nrm((L, D_MODEL, N_GROUPS), D_MODEL ** -0.5)
    router_bg = nrm((L, N_GROUPS), 0.01)
    router_we = nrm((L, D_MODEL, N_EXPERTS), D_MODEL ** -0.5)
    router_be = nrm((L, N_EXPERTS), 0.01)
    exp_w1 = nrm((L, N_EXPERTS, D_MODEL, EXPERT_FF), D_MODEL ** -0.5)
    exp_w3 = nrm((L, N_EXPERTS, D_MODEL, EXPERT_FF), D_MODEL ** -0.5)
    exp_w2 = nrm((L, N_EXPERTS, EXPERT_FF, D_MODEL), EXPERT_FF ** -0.5)
    return {"x": x, "mem": mem, "norm1_g": norm1_g, "w_in": w_in, "fox_fgate_b": fox_fgate_b,
            "fox_qn_g": fox_qn_g, "fox_kn_g": fox_kn_g, "dil_qn_g": dil_qn_g, "dil_kn_g": dil_kn_g,
            "ssd_conv_w": ssd_conv_w, "ssd_conv_b": ssd_conv_b, "ssd_dt_bias": ssd_dt_bias,
            "ssd_A_log": ssd_A_log, "ssd_D": ssd_D, "ssd_norm_g": ssd_norm_g, "w_out": w_out,
            "norm2_g": norm2_g, "mem_norm_g": mem_norm_g, "xa_wq": xa_wq, "xa_wkv": xa_wkv,
            "xa_qn_g": xa_qn_g, "xa_kn_g": xa_kn_g, "xa_wo": xa_wo, "norm3_g": norm3_g,
            "router_wg": router_wg, "router_bg": router_bg, "router_we": router_we,
            "router_be": router_be, "exp_w1": exp_w1, "exp_w3": exp_w3, "exp_w2": exp_w2}


def reference(x, mem, norm1_g, w_in, fox_fgate_b, fox_qn_g, fox_kn_g, dil_qn_g, dil_kn_g,
              ssd_conv_w, ssd_conv_b, ssd_dt_bias, ssd_A_log, ssd_D, ssd_norm_g, w_out,
              norm2_g, mem_norm_g, xa_wq, xa_wkv, xa_qn_g, xa_kn_g, xa_wo, norm3_g,
              router_wg, router_bg, router_we, router_be, exp_w1, exp_w3, exp_w2):
    B, S, _ = x.shape
    pos = jnp.arange(S)
    split_idx = np.cumsum(PROJ_SIZES)[:-1].tolist()

    def heads(t, n):
        return t.reshape(B, S, n, -1).transpose(0, 2, 1, 3)

    for l in range(DEPTH):
        h = rmsnorm(x, norm1_g[l])
        (fq, fk, fv, ff, dq, dk, dv, z, xbc, dt_raw) = jnp.split(h @ w_in[l], split_idx, axis=-1)
        fq = rmsnorm(heads(fq, FOX_HEADS), fox_qn_g[l])
        fk = rmsnorm(heads(fk, FOX_HEADS), fox_kn_g[l])
        log_f = jax.nn.log_sigmoid(ff.astype(jnp.float32) + fox_fgate_b[l].astype(jnp.float32)).transpose(0, 2, 1)
        o_fox = fox_attention(fq, fk, heads(fv, FOX_HEADS), log_f)
        dq = rotary_partial(rmsnorm(heads(dq, DIL_HEADS), dil_qn_g[l]), pos)
        dk = rotary_partial(rmsnorm(heads(dk, DIL_HEADS), dil_kn_g[l]), pos)
        o_dil = dilated_attention(dq, dk, heads(dv, DIL_HEADS))
        o_ssd = ssd_mixer(z, xbc, dt_raw, ssd_conv_w[l], ssd_conv_b[l], ssd_dt_bias[l],
                          ssd_A_log[l], ssd_D[l], ssd_norm_g[l])
        mix = jnp.concatenate([o_fox.transpose(0, 2, 1, 3).reshape(B, S, FOX_W),
                               o_dil.transpose(0, 2, 1, 3).reshape(B, S, DIL_W),
                               o_ssd.astype(x.dtype)], axis=-1)
        x = x + mix @ w_out[l]
        h = rmsnorm(x, norm2_g[l])
        m = rmsnorm(mem, mem_norm_g[l])
        x = x + memory_cross_attention(h, m, xa_wq[l], xa_wkv[l], xa_qn_g[l], xa_kn_g[l], xa_wo[l])
        h = rmsnorm(x, norm3_g[l])
        x = x + hierarchical_moe(h, router_wg[l], router_bg[l], router_we[l], router_be[l],
                                 exp_w1[l], exp_w3[l], exp_w2[l])
    return x
```

```cpp
#include <hip/hip_runtime.h>
#include <hip/hip_cooperative_groups.h>
#include <cstdio>
#include <cstdint>
namespace cg = cooperative_groups;

typedef unsigned short bf16_t;
typedef short bf16x8 __attribute__((ext_vector_type(8)));
typedef short s16x4 __attribute__((ext_vector_type(4)));
typedef float f32x4 __attribute__((ext_vector_type(4)));
typedef unsigned u32x4 __attribute__((ext_vector_type(4)));
typedef unsigned u32x2 __attribute__((ext_vector_type(2)));
#define DEVI __device__ __forceinline__
#define LAS __attribute__((address_space(3)))

constexpr int NB = 8, S = 2048, DM = 1024, T = NB * S, DEPTH = 2;
constexpr int INP = 3084, NPROJ = 3072;
constexpr int C_FQ = 0, C_FK = 256, C_FV = 512, C_DQ = 768, C_DK = 1024, C_DV = 1280, C_Z = 1536, C_XBC = 2048;
constexpr int MEMLEN = 256, MROWS = NB * MEMLEN;
constexpr int NEXP = 32, EFF = 512;
constexpr float EPS = 1e-6f;
constexpr int NTHR = 512;
constexpr int LDS_BYTES = 151552;

constexpr size_t al256(size_t x) { return (x + 255) & ~(size_t)255; }
constexpr size_t WS_W_IN = 0;
constexpr size_t WS_W_OUT = WS_W_IN + (size_t)NPROJ * DM * 2;
constexpr size_t WS_W_Q = WS_W_OUT + (size_t)DM * DM * 2;
constexpr size_t WS_W_KV = WS_W_Q + (size_t)DM * DM * 2;
constexpr size_t WS_W_O = WS_W_KV + (size_t)2 * DM * DM * 2;
constexpr size_t WS_W_13 = WS_W_O + (size_t)DM * DM * 2;
constexpr size_t WS_W_2 = WS_W_13 + (size_t)NEXP * 1024 * DM * 2;
constexpr size_t WS_WSMALL = WS_W_2 + (size_t)NEXP * DM * EFF * 2;
constexpr size_t WS_WROUT = WS_WSMALL + (size_t)DEPTH * 12 * DM * 4;
constexpr size_t WS_XB = WS_WROUT + (size_t)DEPTH * 36 * DM * 4;
constexpr size_t WS_HBUF = WS_XB + (size_t)T * DM * 4;
constexpr size_t WS_PROJ = WS_HBUF + (size_t)T * DM * 2;
constexpr size_t WS_QBUF = WS_PROJ;
constexpr size_t WS_OBUF = WS_PROJ + (size_t)T * DM * 2;
constexpr size_t WS_ACT = WS_PROJ;
constexpr size_t WS_MIX = WS_PROJ + (size_t)T * NPROJ * 2;
constexpr size_t WS_U = WS_MIX + (size_t)T * DM * 2;
constexpr size_t WS_YBUF = WS_U;
constexpr size_t WS_DILO = WS_U;
constexpr size_t WS_DILM = WS_DILO + (size_t)3 * T * 256 * 4;
constexpr size_t WS_DILL = WS_DILM + (size_t)3 * T * 4 * 4;
constexpr size_t WS_SSTATE = WS_DILL + (size_t)3 * T * 4 * 4;
constexpr size_t WS_HIN = WS_SSTATE + (size_t)NB * 16 * 8 * 8192 * 4;
constexpr size_t WS_GBUF = WS_HIN + (size_t)NB * 16 * 8 * 8192 * 2;
constexpr size_t WS_U_END = WS_GBUF + (size_t)T * 512 * 4;
constexpr size_t WS_MEMN = WS_U_END;
constexpr size_t WS_KV = WS_MEMN + (size_t)MROWS * DM * 2;
constexpr size_t WS_LOGF = WS_KV + (size_t)MROWS * 2 * DM * 2;
constexpr size_t WS_CUMF = WS_LOGF + (size_t)T * 4 * 4;
constexpr size_t WS_DTV = WS_CUMF + (size_t)T * 4 * 4;
constexpr size_t WS_DECAY = WS_DTV + (size_t)T * 8 * 4;
constexpr size_t WS_CNT = WS_DECAY + (size_t)NB * 16 * 8 * 4;
constexpr size_t WS_LIST = WS_CNT + 1024;
constexpr size_t WS_GATE = WS_LIST + (size_t)NEXP * 2 * T * 4;
constexpr size_t WS_BAR = WS_GATE + (size_t)2 * T * 4;
constexpr size_t WS_END = WS_BAR + 65536;
static_assert(WS_YBUF + (size_t)2 * T * DM * 2 <= WS_U_END, "ybuf alias");
static_assert(WS_OBUF + (size_t)T * DM * 2 <= WS_MIX, "obuf alias");

struct Params {
    const float* in[31];
    float* out;
    unsigned char* ws;
    int ph_lo, ph_hi;
    int use_grid_sync, pad;
};

DEVI int TIDX() { int t = threadIdx.x; asm volatile("" : "+v"(t)); return t; }
DEVI int BIDX() { int b = blockIdx.x; asm volatile("" : "+s"(b)); return b; }
DEVI float bf2f(bf16_t v) { return __uint_as_float(((unsigned)v) << 16); }
typedef float f32x2 __attribute__((ext_vector_type(2)));
typedef __bf16 bf16x2_t __attribute__((ext_vector_type(2)));
DEVI unsigned cvt_pk(float lo, float hi) { f32x2 v = {lo, hi}; bf16x2_t b = __builtin_convertvector(v, bf16x2_t); return __builtin_bit_cast(unsigned, b); }
DEVI bf16_t f2bf(float f) { return (bf16_t)(cvt_pk(f, 0.f) & 0xffffu); }
DEVI float bflo(unsigned w) { return __uint_as_float(w << 16); }
DEVI float bfhi(unsigned w) { return __uint_as_float(w & 0xffff0000u); }
DEVI float wave_sum(float v) {
#pragma unroll
    for (int m = 32; m >= 1; m >>= 1) v += __shfl_xor(v, m);
    return v;
}
DEVI float silu_f(float x) { return x / (1.f + __expf(-x)); }
DEVI float softplus_f(float x) { return x > 20.f ? x : log1pf(__expf(x)); }
DEVI float logsigmoid_f(float x) { return x >= 0.f ? -log1pf(__expf(-x)) : x - log1pf(__expf(x)); }
#define MFMA16(a, b, c) __builtin_amdgcn_mfma_f32_16x16x32_bf16(a, b, c, 0, 0, 0)
DEVI s16x4 tr_read(const bf16_t* p) {
    return __builtin_bit_cast(s16x4, __builtin_amdgcn_ds_read_tr16_b64_v4i16((LAS s16x4*)p));
}

DEVI int maprow(int mode, int n) { return mode == 0 ? n : ((n >> 4) * 32 + (n & 15) + (mode == 2 ? 16 : 0)); }
DEVI void prep_tile(const float* __restrict__ src, int ld, int k0, int c0, bf16_t* __restrict__ dst, int dstld, int mode, int n0,
                    const float* __restrict__ kscale, int ks_from, float* tl) {
    const int tid = TIDX();
#pragma unroll
    for (int i = 0; i < 2; ++i) {
        const int k = (tid >> 4) + 32 * i, n4 = (tid & 15) * 4;
        const float4 v = *(const float4*)(src + (size_t)(k0 + k) * ld + c0 + n4);
        float sc = 1.f;
        if (kscale != nullptr && (k0 + k) >= ks_from) sc = kscale[k0 + k - ks_from];
        tl[k * 65 + n4 + 0] = v.x * sc; tl[k * 65 + n4 + 1] = v.y * sc; tl[k * 65 + n4 + 2] = v.z * sc; tl[k * 65 + n4 + 3] = v.w * sc;
    }
    __syncthreads();
    {
        const int n = tid >> 3, kc = (tid & 7) * 8;
        u32x4 w;
        w.x = cvt_pk(tl[(kc + 0) * 65 + n], tl[(kc + 1) * 65 + n]);
        w.y = cvt_pk(tl[(kc + 2) * 65 + n], tl[(kc + 3) * 65 + n]);
        w.z = cvt_pk(tl[(kc + 4) * 65 + n], tl[(kc + 5) * 65 + n]);
        w.w = cvt_pk(tl[(kc + 6) * 65 + n], tl[(kc + 7) * 65 + n]);
        const int drow = maprow(mode, n0 + n);
        *(u32x4*)(dst + (size_t)drow * dstld + k0 + kc) = w;
    }
    __syncthreads();
}

constexpr int PREP_UNITS = 2048 + 3 * 4096;
DEVI void prep_unit(const Params& p, int l, int u, float* tl) {
    unsigned char* ws = p.ws;
    if (u < 768) {
        const int kt = u / 48, nt = u % 48, n0 = nt * 64, c0 = n0 < 768 ? n0 : n0 + 4;
        prep_tile(p.in[3] + (size_t)l * DM * INP, INP, kt * 64, c0, (bf16_t*)(ws + WS_W_IN), DM, 0, n0, nullptr, 0, tl);
    } else if (u < 1024) {
        const int v = u - 768, kt = v / 16, nt = v % 16;
        prep_tile(p.in[15] + (size_t)l * DM * DM, DM, kt * 64, nt * 64, (bf16_t*)(ws + WS_W_OUT), DM, 0, nt * 64, p.in[14] + l * 512, 512, tl);
    } else if (u < 1280) {
        const int v = u - 1024, kt = v / 16, nt = v % 16;
        prep_tile(p.in[18] + (size_t)l * DM * DM, DM, kt * 64, nt * 64, (bf16_t*)(ws + WS_W_Q), DM, 0, nt * 64, nullptr, 0, tl);
    } else if (u < 1792) {
        const int v = u - 1280, kt = v / 32, nt = v % 32;
        prep_tile(p.in[19] + (size_t)l * DM * 2 * DM, 2 * DM, kt * 64, nt * 64, (bf16_t*)(ws + WS_W_KV), DM, 0, nt * 64, nullptr, 0, tl);
    } else if (u < 2048) {
        const int v = u - 1792, kt = v / 16, nt = v % 16;
        prep_tile(p.in[22] + (size_t)l * DM * DM, DM, kt * 64, nt * 64, (bf16_t*)(ws + WS_W_O), DM, 0, nt * 64, nullptr, 0, tl);
    } else if (u < 2048 + 8192) {
        const int v = u - 2048, which = v / 4096, w = v % 4096, e = w / 128, tI = w % 128, kt = tI / 8, nt = tI % 8;
        const float* src = (which == 0 ? p.in[28] : p.in[29]) + ((size_t)l * NEXP + e) * DM * EFF;
        prep_tile(src, EFF, kt * 64, nt * 64, (bf16_t*)(ws + WS_W_13) + (size_t)e * 1024 * DM, DM, which == 0 ? 1 : 2, nt * 64, nullptr, 0, tl);
    } else {
        const int w = u - 2048 - 8192, e = w / 128, tI = w % 128, kt = tI / 16, nt = tI % 16;
        const float* src = p.in[30] + ((size_t)l * NEXP + e) * EFF * DM;
        prep_tile(src, DM, kt * 64, nt * 64, (bf16_t*)(ws + WS_W_2) + (size_t)e * DM * EFF, EFF, 0, nt * 64, nullptr, 0, tl);
    }
}
DEVI void prep_small(const Params& p) {
    float* wsm = (float*)(p.ws + WS_WSMALL);
    float* wro = (float*)(p.ws + WS_WROUT);
    const int gtid = BIDX() * NTHR + TIDX(), gn = gridDim.x * NTHR;
    for (int i = gtid; i < DEPTH * 12 * DM; i += gn) {
        const int l = i / (12 * DM), r = i % (12 * DM), c = r / DM, k = r % DM;
        const int col = c < 4 ? 768 + c : 3076 + (c - 4);
        wsm[i] = p.in[3][((size_t)l * DM + k) * INP + col];
    }
    for (int i = gtid; i < DEPTH * 36 * DM; i += gn) {
        const int l = i / (36 * DM), r = i % (36 * DM), c = r / DM, k = r % DM;
        wro[i] = c < 4 ? p.in[24][((size_t)l * DM + k) * 4 + c] : p.in[26][((size_t)l * DM + k) * 32 + (c - 4)];
    }
    if (BIDX() == 0 && TIDX() < 128) ((int*)(p.ws + WS_CNT))[TIDX()] = 0;
}

DEVI void store_h_bf16(bf16_t* hrow, const float (&h)[16], int lane) {
#pragma unroll
    for (int j = 0; j < 4; ++j) {
        u32x2 w; w.x = cvt_pk(h[4 * j], h[4 * j + 1]); w.y = cvt_pk(h[4 * j + 2], h[4 * j + 3]);
        *(u32x2*)(hrow + j * 256 + lane * 4) = w;
    }
}
DEVI void load_row_f32(const float* xr, float (&x)[16], int lane) {
#pragma unroll
    for (int j = 0; j < 4; ++j) { const float4 v = *(const float4*)(xr + j * 256 + lane * 4); x[4 * j] = v.x; x[4 * j + 1] = v.y; x[4 * j + 2] = v.z; x[4 * j + 3] = v.w; }
}
DEVI void add_row_bf16(const bf16_t* yr, float (&x)[16], int lane) {
#pragma unroll
    for (int j = 0; j < 4; ++j) { const u32x2 w = *(const u32x2*)(yr + j * 256 + lane * 4); x[4 * j] += bflo(w.x); x[4 * j + 1] += bfhi(w.x); x[4 * j + 2] += bflo(w.y); x[4 * j + 3] += bfhi(w.y); }
}
DEVI void store_row_f32(float* xr, const float (&x)[16], int lane) {
#pragma unroll
    for (int j = 0; j < 4; ++j) *(float4*)(xr + j * 256 + lane * 4) = make_float4(x[4 * j], x[4 * j + 1], x[4 * j + 2], x[4 * j + 3]);
}
DEVI void norm_row(const float (&x)[16], const float* g, float (&h)[16], int lane) {
    float ss = 0.f;
#pragma unroll
    for (int i = 0; i < 16; ++i) ss += x[i] * x[i];
    ss = wave_sum(ss);
    const float rstd = rsqrtf(ss * (1.0f / DM) + EPS);
#pragma unroll
    for (int j = 0; j < 4; ++j) { const float4 gv = *(const float4*)(g + j * 256 + lane * 4);
        h[4 * j] = x[4 * j] * rstd * gv.x; h[4 * j + 1] = x[4 * j + 1] * rstd * gv.y; h[4 * j + 2] = x[4 * j + 2] * rstd * gv.z; h[4 * j + 3] = x[4 * j + 3] * rstd * gv.w; }
}
DEVI float dot_lds(const float (&h)[16], const float* wrow, int lane) {
    float a = 0.f;
#pragma unroll
    for (int j = 0; j < 4; ++j) { const float4 w = *(const float4*)(wrow + j * 256 + lane * 4); a += h[4 * j] * w.x + h[4 * j + 1] * w.y + h[4 * j + 2] * w.z + h[4 * j + 3] * w.w; }
    return a;
}

DEVI void phase_norm1(const Params& p, int l, char* lds) {
    const int tid = TIDX(), wid = tid >> 6, lane = tid & 63;
    unsigned char* ws = p.ws;
    float* wsl = (float*)lds;
    { const float4* src = (const float4*)((const float*)(ws + WS_WSMALL) + (size_t)l * 12 * DM);
      for (int i = tid; i < 12 * DM / 4; i += NTHR) ((float4*)wsl)[i] = src[i]; }
    __syncthreads();
    const float* xin = l == 0 ? p.in[0] : (const float*)(ws + WS_XB);
    float* xout = p.out;
    const bf16_t* ybuf = (const bf16_t*)(ws + WS_YBUF);
    bf16_t* hbuf = (bf16_t*)(ws + WS_HBUF);
    const float* g1 = p.in[2] + l * DM;
    float* logf = (float*)(ws + WS_LOGF);
    float* dtv = (float*)(ws + WS_DTV);
    for (int row = BIDX() * 8 + wid; row < T; row += gridDim.x * 8) {
        float x[16], h[16];
        load_row_f32(xin + (size_t)row * DM, x, lane);
        if (l > 0) {
            add_row_bf16(ybuf + (size_t)(2 * row) * DM, x, lane);
            add_row_bf16(ybuf + (size_t)(2 * row + 1) * DM, x, lane);
            store_row_f32(xout + (size_t)row * DM, x, lane);
        }
        norm_row(x, g1, h, lane);
        store_h_bf16(hbuf + (size_t)row * DM, h, lane);
        float acc[12];
#pragma unroll
        for (int c = 0; c < 12; ++c) acc[c] = wave_sum(dot_lds(h, wsl + c * DM, lane));
        if (lane == 0) {
#pragma unroll
            for (int c = 0; c < 4; ++c) logf[(size_t)row * 4 + c] = logsigmoid_f(acc[c] + p.in[4][l * 4 + c]);
#pragma unroll
            for (int c = 0; c < 8; ++c) dtv[(size_t)row * 8 + c] = softplus_f(acc[4 + c] + p.in[11][l * 8 + c]);
        }
    }
    const float* gm = p.in[17] + l * DM;
    bf16_t* memn = (bf16_t*)(ws + WS_MEMN);
    for (int row = BIDX() * 8 + wid; row < MROWS; row += gridDim.x * 8) {
        float x[16], h[16];
        load_row_f32(p.in[1] + (size_t)row * DM, x, lane);
        norm_row(x, gm, h, lane);
        store_h_bf16(memn + (size_t)row * DM, h, lane);
    }
}
DEVI void phase_norm2(const Params& p, int l, const float* xin) {
    const int tid = TIDX(), wid = tid >> 6, lane = tid & 63;
    bf16_t* hbuf = (bf16_t*)(p.ws + WS_HBUF);
    const float* g = p.in[16] + l * DM;
    for (int row = BIDX() * 8 + wid; row < T; row += gridDim.x * 8) {
        float x[16], h[16];
        load_row_f32(xin + (size_t)row * DM, x, lane);
        norm_row(x, g, h, lane);
        store_h_bf16(hbuf + (size_t)row * DM, h, lane);
    }
}
DEVI void phase_norm3(const Params& p, int l, const float* xin, char* lds) {
    const int tid = TIDX(), wid = tid >> 6, lane = tid & 63;
    unsigned char* ws = p.ws;
    float* wr = (float*)lds;
    { const float4* src = (const float4*)((const float*)(ws + WS_WROUT) + (size_t)l * 36 * DM);
      for (int i = tid; i < 36 * DM / 4; i += NTHR) ((float4*)wr)[i] = src[i]; }
    __syncthreads();
    bf16_t* hbuf = (bf16_t*)(ws + WS_HBUF);
    const float* g = p.in[23] + l * DM;
    int* cnt = (int*)(ws + WS_CNT) + l * 64;
    int* list = (int*)(ws + WS_LIST);
    float* gate = (float*)(ws + WS_GATE);
    const float* bg = p.in[25] + l * 4;
    const float* be = p.in[27] + l * 32;
    for (int row = BIDX() * 8 + wid; row < T; row += gridDim.x * 8) {
        float x[16], h[16];
        load_row_f32(xin + (size_t)row * DM, x, lane);
        norm_row(x, g, h, lane);
        store_h_bf16(hbuf + (size_t)row * DM, h, lane);
        float gl[4];
#pragma unroll
        for (int c = 0; c < 4; ++c) gl[c] = wave_sum(dot_lds(h, wr + c * DM, lane)) + bg[c];
        int gsel = 0; float gmax = gl[0];
#pragma unroll
        for (int c = 1; c < 4; ++c) if (gl[c] > gmax) { gmax = gl[c]; gsel = c; }
        float gden = 0.f;
#pragma unroll
        for (int c = 0; c < 4; ++c) gden += __expf(gl[c] - gmax);
        const float ggate = 1.0f / gden;
        gsel = __builtin_amdgcn_readfirstlane(gsel);
        float el[8];
#pragma unroll
        for (int c = 0; c < 8; ++c) el[c] = wave_sum(dot_lds(h, wr + (4 + gsel * 8 + c) * DM, lane)) + be[gsel * 8 + c];
        int i1 = 0; float v1 = el[0];
#pragma unroll
        for (int c = 1; c < 8; ++c) if (el[c] > v1) { v1 = el[c]; i1 = c; }
        int i2 = (i1 == 0) ? 1 : 0; float v2 = -3.0e38f;
#pragma unroll
        for (int c = 0; c < 8; ++c) if (c != i1 && el[c] > v2) { v2 = el[c]; i2 = c; }
        const float e2 = __expf(v2 - v1), inv = 1.0f / (1.0f + e2);
        const float ga = inv * ggate, gb = e2 * inv * ggate;
        if (lane == 0) {
            const int ea = gsel * 8 + i1, eb = gsel * 8 + i2;
            const int sa = atomicAdd(&cnt[ea], 1);
            list[(size_t)ea * (2 * T) + sa] = 2 * row;
            const int sb = atomicAdd(&cnt[eb], 1);
            list[(size_t)eb * (2 * T) + sb] = 2 * row + 1;
            gate[2 * row] = ga; gate[2 * row + 1] = gb;
        }
    }
}

constexpr int G_BM = 256, G_BN = 128, G_BK = 64, G_ST = 72;
constexpr int G_ABUF = G_BM * G_ST, G_BBUF = G_BN * G_ST;
template <class AMap, class Epi>
DEVI void gemm_tile(const AMap& amap, const bf16_t* __restrict__ Bt, int K, const Epi& epi, char* lds) {
    const int tid = TIDX(), wid = tid >> 6, lane = tid & 63, r16 = lane & 15, g4 = lane >> 4;
    const int wr = wid >> 1, wc = wid & 1;
    bf16_t* As = (bf16_t*)lds;
    bf16_t* Bs = As + 2 * G_ABUF;
    const int srow = tid >> 3, skc = (tid & 7) * 8;
    const bf16_t* ap[4];
#pragma unroll
    for (int i = 0; i < 4; ++i) ap[i] = amap(srow + 64 * i) + skc;
    const bf16_t* bp[2];
#pragma unroll
    for (int i = 0; i < 2; ++i) bp[i] = Bt + (size_t)(srow + 64 * i) * K + skc;
    u32x4 ra[4], rb[2];
#pragma unroll
    for (int i = 0; i < 4; ++i) ra[i] = *(const u32x4*)(ap[i]);
#pragma unroll
    for (int i = 0; i < 2; ++i) rb[i] = *(const u32x4*)(bp[i]);
    f32x4 acc[4][4];
#pragma unroll
    for (int m = 0; m < 4; ++m)
#pragma unroll
        for (int n = 0; n < 4; ++n) acc[m][n] = (f32x4){0.f, 0.f, 0.f, 0.f};
    const int nt = K / G_BK;
    for (int t = 0; t < nt; ++t) {
        bf16_t* Ab = As + (t & 1) * G_ABUF;
        bf16_t* Bb = Bs + (t & 1) * G_BBUF;
#pragma unroll
        for (int i = 0; i < 4; ++i) *(u32x4*)(Ab + (srow + 64 * i) * G_ST + skc) = ra[i];
#pragma unroll
        for (int i = 0; i < 2; ++i) *(u32x4*)(Bb + (srow + 64 * i) * G_ST + skc) = rb[i];
        __syncthreads();
        if (t + 1 < nt) {
#pragma unroll
            for (int i = 0; i < 4; ++i) ra[i] = *(const u32x4*)(ap[i] + (size_t)(t + 1) * G_BK);
#pragma unroll
            for (int i = 0; i < 2; ++i) rb[i] = *(const u32x4*)(bp[i] + (size_t)(t + 1) * G_BK);
        }
#pragma unroll
        for (int kk = 0; kk < 2; ++kk) {
            bf16x8 af[4], bfr[4];
#pragma unroll
            for (int m = 0; m < 4; ++m) af[m] = *(const bf16x8*)(Ab + (wr * 64 + m * 16 + r16) * G_ST + kk * 32 + g4 * 8);
#pragma unroll
            for (int n = 0; n < 4; ++n) bfr[n] = *(const bf16x8*)(Bb + (wc * 64 + n * 16 + r16) * G_ST + kk * 32 + g4 * 8);
#pragma unroll
            for (int m = 0; m < 4; ++m)
#pragma unroll
                for (int n = 0; n < 4; ++n) acc[m][n] = MFMA16(bfr[n], af[m], acc[m][n]);
        }
    }
    epi(acc, wr * 64 + r16, wc * 64 + g4 * 4);
    __syncthreads();
}

struct AMapDense { const bf16_t* A; int K; DEVI const bf16_t* operator()(int r) const { return A + (size_t)r * K; } };
struct EpiBf16Out { bf16_t* O; int ldo;
    DEVI void operator()(const f32x4 (&acc)[4][4], int rb, int cb) const {
#pragma unroll
        for (int m = 0; m < 4; ++m)
#pragma unroll
            for (int n = 0; n < 4; ++n) { u32x2 w; w.x = cvt_pk(acc[m][n][0], acc[m][n][1]); w.y = cvt_pk(acc[m][n][2], acc[m][n][3]);
                *(u32x2*)(O + (size_t)(rb + m * 16) * ldo + cb + n * 16) = w; }
    } };
struct EpiResF32 { const float* R; float* O; int ld;
    DEVI void operator()(const f32x4 (&acc)[4][4], int rb, int cb) const {
#pragma unroll
        for (int m = 0; m < 4; ++m)
#pragma unroll
            for (int n = 0; n < 4; ++n) { const size_t off = (size_t)(rb + m * 16) * ld + cb + n * 16;
                const f32x4 r = *(const f32x4*)(R + off); *(f32x4*)(O + off) = r + acc[m][n]; }
    } };

template <class MakeEpi>
DEVI void gemm_dense_units(const bf16_t* A, const bf16_t* Bt, int M, int N, int K, const MakeEpi& mk, char* lds, int u0, int ustride) {
    const int nN = N / G_BN, nU = (M / G_BM) * nN;
    for (int u = u0; u < nU; u += ustride) {
        const int pm = u / nN, pn = u % nN;
        AMapDense am{A + (size_t)pm * G_BM * K, K};
        gemm_tile(am, Bt + (size_t)pn * G_BN * K, K, mk(pm * G_BM, pn * G_BN), lds);
    }
}

DEVI void cumsum_task(const Params& p, int bh, char* lds) {
    const int tid = TIDX(), wid = tid >> 6, lane = tid & 63;
    const int b = bh >> 2, h = bh & 3;
    const float* logf = (const float*)(p.ws + WS_LOGF);
    float* cumf = (float*)(p.ws + WS_CUMF);
    float* wtot = (float*)lds;
    float v[4];
#pragma unroll
    for (int j = 0; j < 4; ++j) v[j] = logf[((size_t)b * S + tid * 4 + j) * 4 + h];
    v[1] += v[0]; v[2] += v[1]; v[3] += v[2];
    float incl = v[3];
#pragma unroll
    for (int d = 1; d < 64; d <<= 1) { const float t = __shfl_up(incl, d); if (lane >= d) incl += t; }
    if (lane == 63) wtot[wid] = incl;
    __syncthreads();
    float woff = 0.f;
    for (int w = 0; w < wid; ++w) woff += wtot[w];
    const float base = woff + incl - v[3];
    *(float4*)(cumf + (size_t)bh * S + tid * 4) = make_float4(base + v[0], base + v[1], base + v[2], base + v[3]);
    __syncthreads();
}
DEVI void phase_inproj(const Params& p, int l, char* lds) {
    unsigned char* ws = p.ws;
    for (int t = BIDX(); t < 32; t += gridDim.x) cumsum_task(p, t, lds);
    bf16_t* proj = (bf16_t*)(ws + WS_PROJ);
    auto mk1 = [&](int r0, int c0) { return EpiBf16Out{proj + (size_t)r0 * NPROJ + c0, NPROJ}; };
    gemm_dense_units((const bf16_t*)(ws + WS_HBUF), (const bf16_t*)(ws + WS_W_IN), T, NPROJ, DM, mk1, lds, BIDX(), gridDim.x);
    bf16_t* kv = (bf16_t*)(ws + WS_KV);
    auto mk2 = [&](int r0, int c0) { return EpiBf16Out{kv + (size_t)r0 * 2 * DM + c0, 2 * DM}; };
    gemm_dense_units((const bf16_t*)(ws + WS_MEMN), (const bf16_t*)(ws + WS_W_KV), MROWS, 2 * DM, DM, mk2, lds, gridDim.x - 1 - BIDX(), gridDim.x);
}

DEVI void phase_post(const Params& p, int l) {
    const int tid = TIDX(), wid = tid >> 6, lane = tid & 63;
    unsigned char* ws = p.ws;
    bf16_t* proj = (bf16_t*)(ws + WS_PROJ);
    const int sl = lane >> 2, qt = lane & 3, type = sl >> 2, head = sl & 3;
    const int col0 = (type < 2 ? type * 256 : 768 + (type - 2) * 256) + head * 64 + qt * 16;
    const float *gq0 = p.in[5], *gq1 = p.in[6], *gq2 = p.in[7], *gq3 = p.in[8];
    asm volatile("" : "+s"(gq0), "+s"(gq1), "+s"(gq2), "+s"(gq3));
    const float* gain = (type == 0 ? gq0 : type == 1 ? gq1 : type == 2 ? gq2 : gq3) + l * 64 + qt * 16;
    float gv[16];
#pragma unroll
    for (int i = 0; i < 16; ++i) gv[i] = gain[i];
    float inv[8];
#pragma unroll
    for (int i = 0; i < 8; ++i) inv[i] = powf(500000.0f, -(float)i / 8.0f);
    for (int row = BIDX() * 8 + wid; row < T; row += gridDim.x * 8) {
        bf16_t* ptr = proj + (size_t)row * NPROJ + col0;
        const u32x4 w0 = *(const u32x4*)ptr, w1 = *(const u32x4*)(ptr + 8);
        float v[16];
        v[0] = bflo(w0.x); v[1] = bfhi(w0.x); v[2] = bflo(w0.y); v[3] = bfhi(w0.y); v[4] = bflo(w0.z); v[5] = bfhi(w0.z); v[6] = bflo(w0.w); v[7] = bfhi(w0.w);
        v[8] = bflo(w1.x); v[9] = bfhi(w1.x); v[10] = bflo(w1.y); v[11] = bfhi(w1.y); v[12] = bflo(w1.z); v[13] = bfhi(w1.z); v[14] = bflo(w1.w); v[15] = bfhi(w1.w);
        float ss = 0.f;
#pragma unroll
        for (int i = 0; i < 16; ++i) ss += v[i] * v[i];
        ss += __shfl_xor(ss, 1); ss += __shfl_xor(ss, 2);
        const float rstd = rsqrtf(ss * (1.0f / 64.0f) + EPS);
#pragma unroll
        for (int i = 0; i < 16; ++i) v[i] = v[i] * rstd * gv[i];
        if (type >= 2 && qt == 0) {
            const float pos = (float)(row & (S - 1));
#pragma unroll
            for (int i = 0; i < 8; ++i) { float sn, cs; sincosf(pos * inv[i], &sn, &cs);
                const float a = v[i], b = v[i + 8]; v[i] = a * cs - b * sn; v[i + 8] = b * cs + a * sn; }
        }
        u32x4 o0, o1;
        o0.x = cvt_pk(v[0], v[1]); o0.y = cvt_pk(v[2], v[3]); o0.z = cvt_pk(v[4], v[5]); o0.w = cvt_pk(v[6], v[7]);
        o1.x = cvt_pk(v[8], v[9]); o1.y = cvt_pk(v[10], v[11]); o1.z = cvt_pk(v[12], v[13]); o1.w = cvt_pk(v[14], v[15]);
        *(u32x4*)ptr = o0; *(u32x4*)(ptr + 8) = o1;
    }
    bf16_t* kv = (bf16_t*)(ws + WS_KV);
    const float* kg = p.in[21] + l * 256 + (lane & 15) * 16;
    float kgv[16];
#pragma unroll
    for (int i = 0; i < 16; ++i) kgv[i] = kg[i];
    for (int row = BIDX() * 8 + wid; row < MROWS; row += gridDim.x * 8) {
        bf16_t* ptr = kv + (size_t)row * 2 * DM + lane * 16;
        const u32x4 w0 = *(const u32x4*)ptr, w1 = *(const u32x4*)(ptr + 8);
        float v[16];
        v[0] = bflo(w0.x); v[1] = bfhi(w0.x); v[2] = bflo(w0.y); v[3] = bfhi(w0.y); v[4] = bflo(w0.z); v[5] = bfhi(w0.z); v[6] = bflo(w0.w); v[7] = bfhi(w0.w);
        v[8] = bflo(w1.x); v[9] = bfhi(w1.x); v[10] = bflo(w1.y); v[11] = bfhi(w1.y); v[12] = bflo(w1.z); v[13] = bfhi(w1.z); v[14] = bflo(w1.w); v[15] = bfhi(w1.w);
        float ss = 0.f;
#pragma unroll
        for (int i = 0; i < 16; ++i) ss += v[i] * v[i];
        ss += __shfl_xor(ss, 1); ss += __shfl_xor(ss, 2); ss += __shfl_xor(ss, 4); ss += __shfl_xor(ss, 8);
        const float rstd = rsqrtf(ss * (1.0f / 256.0f) + EPS);
#pragma unroll
        for (int i = 0; i < 16; ++i) v[i] = v[i] * rstd * kgv[i];
        u32x4 o0, o1;
        o0.x = cvt_pk(v[0], v[1]); o0.y = cvt_pk(v[2], v[3]); o0.z = cvt_pk(v[4], v[5]); o0.w = cvt_pk(v[6], v[7]);
        o1.x = cvt_pk(v[8], v[9]); o1.y = cvt_pk(v[10], v[11]); o1.z = cvt_pk(v[12], v[13]); o1.w = cvt_pk(v[14], v[15]);
        *(u32x4*)ptr = o0; *(u32x4*)(ptr + 8) = o1;
    }
}

template <int DH> struct AttnLds { static constexpr int KST = DH + 8, PST = 72; static constexpr int BYTES = (2 * 64 * KST + 8 * 16 * PST) * 2; };
template <int DH, int MODE>
DEVI void attn_task(const bf16_t* __restrict__ Qb, int ldq, int qtok0, int qstep,
                    const bf16_t* __restrict__ Kb, const bf16_t* __restrict__ Vb, int ldk, int ktok0, int kstep,
                    int p0, int kt_lo, int kt_hi, float scale,
                    const float* __restrict__ cum, const float* __restrict__ qgain,
                    bf16_t* Ob, int ldo, float* Of, float* Om, float* Ol, char* lds) {
    constexpr int KST = AttnLds<DH>::KST, PST = AttnLds<DH>::PST, NKK = DH / 32, ND = DH / 16;
    const int tid = TIDX(), wid = tid >> 6, lane = tid & 63, r16 = lane & 15, g4 = lane >> 4;
    bf16_t* Ks = (bf16_t*)lds;
    bf16_t* Vs = Ks + 64 * KST;
    bf16_t* Ps = Vs + 64 * KST + wid * 16 * PST;
    bf16x8 qf[NKK];
    {
        const bf16_t* qp = Qb + (size_t)(qtok0 + (p0 + wid * 16 + r16) * qstep) * ldq + g4 * 8;
#pragma unroll
        for (int kk = 0; kk < NKK; ++kk) qf[kk] = *(const bf16x8*)(qp + kk * 32);
    }
    if (MODE == 2) {
        float ss = 0.f;
#pragma unroll
        for (int kk = 0; kk < NKK; ++kk)
#pragma unroll
            for (int j = 0; j < 8; ++j) { const float v = bf2f((bf16_t)qf[kk][j]); ss += v * v; }
        ss += __shfl_xor(ss, 16); ss += __shfl_xor(ss, 32);
        const float rstd = rsqrtf(ss * (1.0f / DH) + EPS);
#pragma unroll
        for (int kk = 0; kk < NKK; ++kk)
#pragma unroll
            for (int j = 0; j < 8; ++j) { const float v = bf2f((bf16_t)qf[kk][j]) * rstd * qgain[kk * 32 + g4 * 8 + j]; qf[kk][j] = (short)f2bf(v); }
    }
    float m_[4], l_[4], cq[4];
    f32x4 o[ND];
#pragma unroll
    for (int j = 0; j < 4; ++j) { m_[j] = -1.0e30f; l_[j] = 0.f; cq[j] = 0.f; }
#pragma unroll
    for (int n = 0; n < ND; ++n) o[n] = (f32x4){0.f, 0.f, 0.f, 0.f};
    if (MODE == 0) {
#pragma unroll
        for (int j = 0; j < 4; ++j) cq[j] = cum[p0 + wid * 16 + g4 * 4 + j];
    }
    for (int kt = kt_lo; kt < kt_hi; ++kt) {
        __syncthreads();
        for (int c = tid; c < 64 * DH / 8; c += NTHR) {
            const int key = c / (DH / 8), dc = c % (DH / 8);
            const size_t tok = (size_t)(ktok0 + (kt * 64 + key) * kstep);
            *(u32x4*)(Ks + key * KST + dc * 8) = *(const u32x4*)(Kb + tok * ldk + dc * 8);
            *(u32x4*)(Vs + key * KST + dc * 8) = *(const u32x4*)(Vb + tok * ldk + dc * 8);
        }
        __syncthreads();
        f32x4 s[4];
#pragma unroll
        for (int n = 0; n < 4; ++n) {
            s[n] = (f32x4){0.f, 0.f, 0.f, 0.f};
#pragma unroll
            for (int kk = 0; kk < NKK; ++kk) {
                const bf16x8 kf = *(const bf16x8*)(Ks + (n * 16 + r16) * KST + kk * 32 + g4 * 8);
                s[n] = MFMA16(qf[kk], kf, s[n]);
            }
        }
        float ck[4];
#pragma unroll
        for (int n = 0; n < 4; ++n) ck[n] = (MODE == 0) ? cum[kt * 64 + n * 16 + r16] : 0.f;
#pragma unroll
        for (int j = 0; j < 4; ++j) {
            const int qpos = p0 + wid * 16 + g4 * 4 + j;
            float v[4];
            float mx = -INFINITY;
#pragma unroll
            for (int n = 0; n < 4; ++n) {
                const int kpos = kt * 64 + n * 16 + r16;
                float t = s[n][j] * scale;
                if (MODE == 0) { t += cq[j] - ck[n]; if (kpos > qpos) t = -INFINITY; }
                if (MODE == 1) { const int dd = qpos - kpos; if (dd < 0 || dd > 128) t = -INFINITY; }
                v[n] = t; mx = fmaxf(mx, t);
            }
            mx = fmaxf(mx, __shfl_xor(mx, 1)); mx = fmaxf(mx, __shfl_xor(mx, 2)); mx = fmaxf(mx, __shfl_xor(mx, 4)); mx = fmaxf(mx, __shfl_xor(mx, 8));
            const float mn = fmaxf(m_[j], mx);
            const float alpha = __expf(m_[j] - mn);
            float rs = 0.f;
#pragma unroll
            for (int n = 0; n < 4; ++n) { const float pv = __expf(v[n] - mn); rs += pv; Ps[(g4 * 4 + j) * PST + n * 16 + r16] = f2bf(pv); }
            rs += __shfl_xor(rs, 1); rs += __shfl_xor(rs, 2); rs += __shfl_xor(rs, 4); rs += __shfl_xor(rs, 8);
            l_[j] = l_[j] * alpha + rs; m_[j] = mn;
#pragma unroll
            for (int n = 0; n < ND; ++n) o[n][j] *= alpha;
        }
        __builtin_amdgcn_wave_barrier();
        asm volatile("s_waitcnt lgkmcnt(0)" ::: "memory");
#pragma unroll
        for (int kk = 0; kk < 2; ++kk) {
            const bf16x8 pf = *(const bf16x8*)(Ps + r16 * PST + kk * 32 + g4 * 8);
            const bf16_t* vb = Vs + (kk * 32 + 8 * g4 + (r16 >> 2)) * KST + 4 * (r16 & 3);
#pragma unroll
            for (int n = 0; n < ND; ++n) {
                const s16x4 lo = tr_read(vb + n * 16), hi = tr_read(vb + 4 * KST + n * 16);
                bf16x8 vf; vf[0] = lo[0]; vf[1] = lo[1]; vf[2] = lo[2]; vf[3] = lo[3]; vf[4] = hi[0]; vf[5] = hi[1]; vf[6] = hi[2]; vf[7] = hi[3];
                o[n] = MFMA16(pf, vf, o[n]);
            }
        }
        __builtin_amdgcn_wave_barrier();
    }
#pragma unroll
    for (int j = 0; j < 4; ++j) {
        const int prow = p0 + wid * 16 + g4 * 4 + j;
        const size_t tok = (size_t)(qtok0 + prow * qstep);
        if (MODE == 1) {
#pragma unroll
            for (int n = 0; n < ND; ++n) Of[tok * 256 + n * 16 + r16] = o[n][j];
            if (r16 == 0) { Om[tok * 4] = m_[j]; Ol[tok * 4] = l_[j]; }
        } else {
            const float inv = 1.0f / l_[j];
#pragma unroll
            for (int n = 0; n < ND; ++n) Ob[tok * ldo + n * 16 + r16] = f2bf(o[n][j] * inv);
        }
    }
}

DEVI void ssd_acs(const Params& p, int l, int b, int c, int g, float* acs, float* dts) {
    const int tid = TIDX(), wid = tid >> 6, lane = tid & 63;
    if (wid < 4) {
        const int head = g * 4 + wid;
        const float* dtv = (const float*)(p.ws + WS_DTV);
        const float A = -__expf(p.in[12][l * 8 + head]);
        const size_t t0 = (size_t)b * S + c * 128 + 2 * lane;
        const float d0 = dtv[t0 * 8 + head], d1 = dtv[(t0 + 1) * 8 + head];
        const float a0 = d0 * A, a1 = d1 * A;
        float incl = a0 + a1;
#pragma unroll
        for (int d = 1; d < 64; d <<= 1) { const float t = __shfl_up(incl, d); if (lane >= d) incl += t; }
        const float ex = incl - (a0 + a1);
        acs[wid * 128 + 2 * lane] = ex + a0; acs[wid * 128 + 2 * lane + 1] = ex + a0 + a1;
        dts[wid * 128 + 2 * lane] = d0; dts[wid * 128 + 2 * lane + 1] = d1;
    }
}
DEVI void conv8_chan(const Params& p, int l, const bf16_t* proj, int b, int c, int chan, int l0, float (&out)[8]) {
    const float* cw = p.in[9] + (size_t)l * 4 * 1024 + chan;
    const float w0 = cw[0], w1 = cw[1024], w2 = cw[2048], w3 = cw[3072], cb = p.in[10][l * 1024 + chan];
    float v[11];
    const int sbase = c * 128 + l0 - 3;
#pragma unroll
    for (int i = 0; i < 11; ++i) { const int sp = sbase + i; v[i] = sp >= 0 ? bf2f(proj[((size_t)b * S + sp) * NPROJ + C_XBC + chan]) : 0.f; }
#pragma unroll
    for (int i = 0; i < 8; ++i) out[i] = silu_f(cb + w0 * v[i] + w1 * v[i + 1] + w2 * v[i + 2] + w3 * v[i + 3]);
}
DEVI void conv8_pos(const Params& p, int l, const bf16_t* proj, int b, int sp, int chan0, float (&out)[8]) {
    float a[8];
    const float* cb = p.in[10] + l * 1024 + chan0;
#pragma unroll
    for (int i = 0; i < 8; ++i) a[i] = cb[i];
#pragma unroll
    for (int j = 0; j < 4; ++j) {
        const int s2 = sp - 3 + j;
        if (s2 >= 0) {
            const u32x4 w = *(const u32x4*)(proj + ((size_t)b * S + s2) * NPROJ + C_XBC + chan0);
            const float* cw = p.in[9] + ((size_t)l * 4 + j) * 1024 + chan0;
            a[0] += cw[0] * bflo(w.x); a[1] += cw[1] * bfhi(w.x); a[2] += cw[2] * bflo(w.y); a[3] += cw[3] * bfhi(w.y);
            a[4] += cw[4] * bflo(w.z); a[5] += cw[5] * bfhi(w.z); a[6] += cw[6] * bflo(w.w); a[7] += cw[7] * bfhi(w.w);
        }
    }
#pragma unroll
    for (int i = 0; i < 8; ++i) out[i] = silu_f(a[i]);
}
DEVI u32x4 pack8(const float (&v)[8]) { u32x4 w; w.x = cvt_pk(v[0], v[1]); w.y = cvt_pk(v[2], v[3]); w.z = cvt_pk(v[4], v[5]); w.w = cvt_pk(v[6], v[7]); return w; }

constexpr int SST = 136;
DEVI void ssd_states_task(const Params& p, int l, int b, int c, int g, char* lds) {
    const int tid = TIDX(), wid = tid >> 6, lane = tid & 63, r16 = lane & 15, g4 = lane >> 4;
    const bf16_t* proj = (const bf16_t*)(p.ws + WS_PROJ);
    bf16_t* BT = (bf16_t*)lds;
    bf16_t* XT = BT + 128 * SST;
    float* acs = (float*)(XT + 256 * SST);
    float* dts = acs + 512;
    __syncthreads();
    ssd_acs(p, l, b, c, g, acs, dts);
    __syncthreads();
    if (tid < 4) ((float*)(p.ws + WS_DECAY))[((size_t)b * 16 + c) * 8 + g * 4 + tid] = __expf(acs[tid * 128 + 127]);
    for (int it = tid; it < 2048; it += NTHR) {
        const int n = it & 127, lc = it >> 7;
        float v[8]; conv8_chan(p, l, proj, b, c, 512 + g * 128 + n, lc * 8, v);
        *(u32x4*)(BT + n * SST + lc * 8) = pack8(v);
    }
    for (int it = tid; it < 4096; it += NTHR) {
        const int ch = it & 255, lc = it >> 8, hl = ch >> 6;
        float v[8]; conv8_chan(p, l, proj, b, c, g * 256 + ch, lc * 8, v);
        const float alast = acs[hl * 128 + 127];
#pragma unroll
        for (int i = 0; i < 8; ++i) { const int ll = lc * 8 + i; v[i] *= dts[hl * 128 + ll] * __expf(alast - acs[hl * 128 + ll]); }
        *(u32x4*)(XT + ch * SST + lc * 8) = pack8(v);
    }
    __syncthreads();
    const int hl = wid >> 1, nh = wid & 1;
    f32x4 acc[4][4];
#pragma unroll
    for (int m = 0; m < 4; ++m)
#pragma unroll
        for (int n = 0; n < 4; ++n) acc[m][n] = (f32x4){0.f, 0.f, 0.f, 0.f};
#pragma unroll
    for (int kk = 0; kk < 4; ++kk) {
        bf16x8 af[4], bfr[4];
#pragma unroll
        for (int m = 0; m < 4; ++m) af[m] = *(const bf16x8*)(XT + (hl * 64 + m * 16 + r16) * SST + kk * 32 + g4 * 8);
#pragma unroll
        for (int n = 0; n < 4; ++n) bfr[n] = *(const bf16x8*)(BT + (nh * 64 + n * 16 + r16) * SST + kk * 32 + g4 * 8);
#pragma unroll
        for (int m = 0; m < 4; ++m)
#pragma unroll
            for (int n = 0; n < 4; ++n) acc[m][n] = MFMA16(bfr[n], af[m], acc[m][n]);
    }
    float* st = (float*)(p.ws + WS_SSTATE) + (((size_t)b * 16 + c) * 8 + g * 4 + hl) * 8192;
#pragma unroll
    for (int m = 0; m < 4; ++m)
#pragma unroll
        for (int n = 0; n < 4; ++n) *(f32x4*)(st + (m * 16 + r16) * 128 + nh * 64 + n * 16 + g4 * 4) = acc[m][n];
}
DEVI void phase_ssd_scan(const Params& p) {
    const float* st = (const float*)(p.ws + WS_SSTATE);
    bf16_t* hin = (bf16_t*)(p.ws + WS_HIN);
    const float* decay = (const float*)(p.ws + WS_DECAY);
    const int total = NB * 8 * 2048;
    for (int i = BIDX() * NTHR + TIDX(); i < total; i += gridDim.x * NTHR) {
        const int e4 = i & 2047, head = (i >> 11) & 7, b = i >> 14;
        f32x4 h = (f32x4){0.f, 0.f, 0.f, 0.f};
        for (int c = 0; c < 16; ++c) {
            const size_t off = (((size_t)b * 16 + c) * 8 + head) * 8192 + e4 * 4;
            u32x2 w; w.x = cvt_pk(h[0], h[1]); w.y = cvt_pk(h[2], h[3]);
            *(u32x2*)(hin + off) = w;
            const f32x4 s = *(const f32x4*)(st + off);
            const float d = decay[((size_t)b * 16 + c) * 8 + head];
            h = h * d + s;
        }
    }
}
DEVI void ssd_out_task(const Params& p, int l, int b, int c, char* lds) {
    const int tid = TIDX(), wid = tid >> 6, lane = tid & 63, r16 = lane & 15, g4 = lane >> 4;
    const bf16_t* proj = (const bf16_t*)(p.ws + WS_PROJ);
    bf16_t* Cs = (bf16_t*)lds;
    bf16_t* Bs = Cs + 128 * SST;
    bf16_t* XT = Bs + 128 * SST;
    bf16_t* Hs = XT + 64 * SST;
    bf16_t* Mw = Hs + 64 * SST + wid * 16 * SST;
    float* acs = (float*)(Hs + 64 * SST + 8 * 16 * SST);
    float* dts = acs + 512;
    const int lrow = wid * 16 + r16;
    const size_t tok = (size_t)b * S + c * 128 + lrow;
    float* gbuf = (float*)(p.ws + WS_GBUF);
    float ssq = 0.f;
    for (int g = 0; g < 2; ++g) {
        __syncthreads();
        ssd_acs(p, l, b, c, g, acs, dts);
        for (int it = tid; it < 2048; it += NTHR) {
            const int ll = it >> 4, nc = (it & 15) * 8;
            float v[8];
            conv8_pos(p, l, proj, b, c * 128 + ll, 768 + g * 128 + nc, v);
            *(u32x4*)(Cs + ll * SST + nc) = pack8(v);
            conv8_pos(p, l, proj, b, c * 128 + ll, 512 + g * 128 + nc, v);
            *(u32x4*)(Bs + ll * SST + nc) = pack8(v);
        }
        __syncthreads();
        bf16x8 cfr[4];
#pragma unroll
        for (int kk = 0; kk < 4; ++kk) cfr[kk] = *(const bf16x8*)(Cs + lrow * SST + kk * 32 + g4 * 8);
        f32x4 cb[8];
#pragma unroll
        for (int st = 0; st < 8; ++st) {
            cb[st] = (f32x4){0.f, 0.f, 0.f, 0.f};
#pragma unroll
            for (int kk = 0; kk < 4; ++kk) {
                const bf16x8 bfr = *(const bf16x8*)(Bs + (st * 16 + r16) * SST + kk * 32 + g4 * 8);
                cb[st] = MFMA16(bfr, cfr[kk], cb[st]);
            }
        }
        for (int hl = 0; hl < 4; ++hl) {
            const int head = g * 4 + hl;
            __syncthreads();
            for (int it = tid; it < 1024; it += NTHR) {
                const int pp = it & 63, sc = it >> 6;
                float v[8]; conv8_chan(p, l, proj, b, c, g * 256 + hl * 64 + pp, sc * 8, v);
                *(u32x4*)(XT + pp * SST + sc * 8) = pack8(v);
                const bf16_t* hsrc = (const bf16_t*)(p.ws + WS_HIN) + (((size_t)b * 16 + c) * 8 + head) * 8192 + (size_t)it * 8;
                *(u32x4*)(Hs + (it >> 4) * SST + (it & 15) * 8) = *(const u32x4*)hsrc;
            }
            __syncthreads();
            const float al = acs[hl * 128 + lrow];
#pragma unroll
            for (int st = 0; st < 8; ++st) {
                float mv[4];
#pragma unroll
                for (int j = 0; j < 4; ++j) { const int sidx = st * 16 + g4 * 4 + j;
                    mv[j] = (sidx <= lrow) ? cb[st][j] * __expf(al - acs[hl * 128 + sidx]) * dts[hl * 128 + sidx] : 0.f; }
                u32x2 w; w.x = cvt_pk(mv[0], mv[1]); w.y = cvt_pk(mv[2], mv[3]);
                *(u32x2*)(Mw + r16 * SST + st * 16 + g4 * 4) = w;
            }
            __builtin_amdgcn_wave_barrier();
            asm volatile("s_waitcnt lgkmcnt(0)" ::: "memory");
            f32x4 yd[4], yo[4];
#pragma unroll
            for (int pt = 0; pt < 4; ++pt) { yd[pt] = (f32x4){0.f, 0.f, 0.f, 0.f}; yo[pt] = (f32x4){0.f, 0.f, 0.f, 0.f}; }
#pragma unroll
            for (int kk = 0; kk < 4; ++kk) {
                const bf16x8 mf = *(const bf16x8*)(Mw + r16 * SST + kk * 32 + g4 * 8);
#pragma unroll
                for (int pt = 0; pt < 4; ++pt) {
                    const bf16x8 xf = *(const bf16x8*)(XT + (pt * 16 + r16) * SST + kk * 32 + g4 * 8);
                    yd[pt] = MFMA16(xf, mf, yd[pt]);
                    const bf16x8 hf = *(const bf16x8*)(Hs + (pt * 16 + r16) * SST + kk * 32 + g4 * 8);
                    yo[pt] = MFMA16(hf, cfr[kk], yo[pt]);
                }
            }
            __builtin_amdgcn_wave_barrier();
            const float el = __expf(al), Dh = p.in[13][l * 8 + head];
#pragma unroll
            for (int pt = 0; pt < 4; ++pt) {
                const int pc = pt * 16 + g4 * 4;
                const u32x2 zw = *(const u32x2*)(proj + tok * NPROJ + C_Z + head * 64 + pc);
                const float zz[4] = {bflo(zw.x), bfhi(zw.x), bflo(zw.y), bfhi(zw.y)};
                f32x4 gv;
#pragma unroll
                for (int j = 0; j < 4; ++j) {
                    const float xv = bf2f(XT[(pc + j) * SST + lrow]);
                    const float yv = yd[pt][j] + el * yo[pt][j] + Dh * xv;
                    gv[j] = yv * silu_f(zz[j]);
                    ssq += gv[j] * gv[j];
                }
                *(f32x4*)(gbuf + tok * 512 + head * 64 + pc) = gv;
            }
        }
    }
    ssq += __shfl_xor(ssq, 16); ssq += __shfl_xor(ssq, 32);
    const float rstd = rsqrtf(ssq * (1.0f / 512.0f) + EPS);
    bf16_t* mix = (bf16_t*)(p.ws + WS_MIX);
#pragma unroll
    for (int head = 0; head < 8; ++head)
#pragma unroll
        for (int pt = 0; pt < 4; ++pt) {
            const int pc = pt * 16 + g4 * 4;
            const f32x4 gv = *(const f32x4*)(gbuf + tok * 512 + head * 64 + pc);
            u32x2 w; w.x = cvt_pk(gv[0] * rstd, gv[1] * rstd); w.y = cvt_pk(gv[2] * rstd, gv[3] * rstd);
            *(u32x2*)(mix + tok * DM + 512 + head * 64 + pc) = w;
        }
}

constexpr int N_FOX = 512, N_S1 = 256, N_DIL = 1536;
DEVI void phase_mix1(const Params& p, int l, char* lds) {
    unsigned char* ws = p.ws;
    const bf16_t* proj = (const bf16_t*)(ws + WS_PROJ);
    bf16_t* mix = (bf16_t*)(ws + WS_MIX);
    for (int t = BIDX(); t < N_FOX + N_S1 + N_DIL; t += gridDim.x) {
        if (t < N_FOX) {
            const int bh = t & 31, k = t >> 5;
            const int qb = k < 8 ? 15 - k : k - 8;
            const int b = bh >> 2, h = bh & 3;
            const float* cum = (const float*)(ws + WS_CUMF) + (size_t)bh * S;
            attn_task<64, 0>(proj + C_FQ + h * 64, NPROJ, b * S, 1, proj + C_FK + h * 64, proj + C_FV + h * 64, NPROJ, b * S, 1,
                             qb * 128, 0, 2 * qb + 2, 0.125f, cum, nullptr, mix + h * 64, DM, nullptr, nullptr, nullptr, lds);
        } else if (t < N_FOX + N_S1) {
            const int u = t - N_FOX, g = u & 1, c = (u >> 1) & 15, b = u >> 5;
            ssd_states_task(p, l, b, c, g, lds);
        } else {
            const int u = t - N_FOX - N_S1, bh = u & 31, v = u >> 5;
            const int b = bh >> 2, h = bh & 3;
            int br, dil, r, pb;
            if (v < 16) { br = 0; dil = 1; r = 0; pb = v; }
            else if (v < 32) { br = 1; dil = 4; r = (v - 16) & 3; pb = (v - 16) >> 2; }
            else { br = 2; dil = 16; r = v - 32; pb = 0; }
            float* Of = (float*)(ws + WS_DILO) + (size_t)br * T * 256 + h * 64;
            float* Om = (float*)(ws + WS_DILM) + (size_t)br * T * 4 + h;
            float* Ol = (float*)(ws + WS_DILL) + (size_t)br * T * 4 + h;
            const int klo = pb > 0 ? 2 * pb - 2 : 0;
            attn_task<64, 1>(proj + C_DQ + h * 64, NPROJ, b * S + r, dil, proj + C_DK + h * 64, proj + C_DV + h * 64, NPROJ, b * S + r, dil,
                             pb * 128, klo, 2 * pb + 2, 0.125f, nullptr, nullptr, nullptr, 0, Of, Om, Ol, lds);
        }
    }
}
DEVI void phase_mix3(const Params& p, int l, char* lds) {
    unsigned char* ws = p.ws;
    for (int t = BIDX(); t < NB * 16; t += gridDim.x) ssd_out_task(p, l, t >> 4, t & 15, lds);
    const int tid = TIDX(), wid = tid >> 6, lane = tid & 63, head = lane >> 4, d4 = (lane & 15) * 4;
    const float* Of = (const float*)(ws + WS_DILO);
    const float* Om = (const float*)(ws + WS_DILM);
    const float* Ol = (const float*)(ws + WS_DILL);
    bf16_t* mix = (bf16_t*)(ws + WS_MIX);
    for (int row = ((BIDX() + gridDim.x - 128) % gridDim.x) * 8 + wid; row < T; row += gridDim.x * 8) {
        float m[3], lsum[3];
#pragma unroll
        for (int br = 0; br < 3; ++br) { m[br] = Om[((size_t)br * T + row) * 4 + head]; lsum[br] = Ol[((size_t)br * T + row) * 4 + head]; }
        const float M = fmaxf(m[0], fmaxf(m[1], m[2]));
        f32x4 num = (f32x4){0.f, 0.f, 0.f, 0.f}; float den = 0.f;
#pragma unroll
        for (int br = 0; br < 3; ++br) {
            const float w = __expf(m[br] - M);
            const f32x4 o = *(const f32x4*)(Of + ((size_t)br * T + row) * 256 + head * 64 + d4);
            num += o * w; den += w * lsum[br];
        }
        const float inv = 1.0f / den;
        u32x2 w; w.x = cvt_pk(num[0] * inv, num[1] * inv); w.y = cvt_pk(num[2] * inv, num[3] * inv);
        *(u32x2*)(mix + (size_t)row * DM + 256 + head * 64 + d4) = w;
    }
}
DEVI void phase_xattn(const Params& p, int l, char* lds) {
    unsigned char* ws = p.ws;
    const bf16_t* qbuf = (const bf16_t*)(ws + WS_QBUF);
    const bf16_t* kv = (const bf16_t*)(ws + WS_KV);
    bf16_t* obuf = (bf16_t*)(ws + WS_OBUF);
    for (int t = BIDX(); t < NB * 4 * 16; t += gridDim.x) {
        const int qb = t & 15, h = (t >> 4) & 3, b = t >> 6;
        attn_task<256, 2>(qbuf + h * 256, DM, b * S, 1, kv + h * 256, kv + DM + h * 256, 2 * DM, b * MEMLEN, 1,
                          qb * 128, 0, 4, 0.0625f, nullptr, p.in[20] + l * 256, obuf + h * 256, DM, nullptr, nullptr, nullptr, lds);
    }
}
struct AMapGather { const bf16_t* A; int K; const int* ent; int nvalid; int shift;
    DEVI const bf16_t* operator()(int r) const { const int e = ent[r < nvalid ? r : 0]; return A + (size_t)(e >> shift) * K; } };
struct EpiSwiglu { bf16_t* act; const int* ent; int nvalid; int col0;
    DEVI void operator()(const f32x4 (&acc)[4][4], int rb, int cb) const {
#pragma unroll
        for (int m = 0; m < 4; ++m) {
            const int r = rb + m * 16;
            if (r < nvalid) {
                const int a = ent[r];
#pragma unroll
                for (int np = 0; np < 2; ++np) {
                    const f32x4 x1 = acc[m][2 * np], x3 = acc[m][2 * np + 1];
                    float o[4];
#pragma unroll
                    for (int j = 0; j < 4; ++j) o[j] = silu_f(x1[j]) * x3[j];
                    const int cg = col0 + (cb & 64) + np * 32;
                    u32x2 w; w.x = cvt_pk(o[0], o[1]); w.y = cvt_pk(o[2], o[3]);
                    *(u32x2*)(act + (size_t)a * EFF + (cg >> 1) + (cb & 15)) = w;
                }
            }
        }
    } };
struct EpiMoeOut { bf16_t* y; const int* ent; const float* gate; int nvalid; int col0;
    DEVI void operator()(const f32x4 (&acc)[4][4], int rb, int cb) const {
#pragma unroll
        for (int m = 0; m < 4; ++m) {
            const int r = rb + m * 16;
            if (r < nvalid) {
                const int a = ent[r]; const float gt = gate[a];
#pragma unroll
                for (int n = 0; n < 4; ++n) { u32x2 w; w.x = cvt_pk(acc[m][n][0] * gt, acc[m][n][1] * gt); w.y = cvt_pk(acc[m][n][2] * gt, acc[m][n][3] * gt);
                    *(u32x2*)(y + (size_t)a * DM + col0 + cb + n * 16) = w; }
            }
        }
    } };
template <int WHICH>
DEVI void phase_moe(const Params& p, int l, char* lds) {
    unsigned char* ws = p.ws;
    const int* cnt = (const int*)(ws + WS_CNT) + l * 64;
    const int* list = (const int*)(ws + WS_LIST);
    int ubase = 0;
    for (int e = 0; e < NEXP; ++e) {
        const int ce = cnt[e], ntile = (ce + G_BM - 1) / G_BM, nun = ntile * 8;
        int u = ubase + ((BIDX() - ubase % (int)gridDim.x) + gridDim.x) % gridDim.x;
        for (; u < ubase + nun; u += gridDim.x) {
            const int lu = u - ubase, pm = lu >> 3, pn = lu & 7;
            const int* ent = list + (size_t)e * (2 * T) + pm * G_BM;
            const int nvalid = ce - pm * G_BM;
            if (WHICH == 0) {
                AMapGather am{(const bf16_t*)(ws + WS_HBUF), DM, ent, nvalid, 1};
                EpiSwiglu ep{(bf16_t*)(ws + WS_ACT), ent, nvalid, pn * G_BN};
                gemm_tile(am, (const bf16_t*)(ws + WS_W_13) + ((size_t)e * 1024 + pn * G_BN) * DM, DM, ep, lds);
            } else {
                AMapGather am{(const bf16_t*)(ws + WS_ACT), EFF, ent, nvalid, 0};
                EpiMoeOut ep{(bf16_t*)(ws + WS_YBUF), ent, (const float*)(ws + WS_GATE), nvalid, pn * G_BN};
                gemm_tile(am, (const bf16_t*)(ws + WS_W_2) + ((size_t)e * DM + pn * G_BN) * EFF, EFF, ep, lds);
            }
        }
        ubase += nun;
    }
}
DEVI void phase_final(const Params& p) {
    const int tid = TIDX(), wid = tid >> 6, lane = tid & 63;
    const bf16_t* ybuf = (const bf16_t*)(p.ws + WS_YBUF);
    for (int row = BIDX() * 8 + wid; row < T; row += gridDim.x * 8) {
        float x[16];
        load_row_f32(p.out + (size_t)row * DM, x, lane);
        add_row_bf16(ybuf + (size_t)(2 * row) * DM, x, lane);
        add_row_bf16(ybuf + (size_t)(2 * row + 1) * DM, x, lane);
        store_row_f32(p.out + (size_t)row * DM, x, lane);
    }
}

constexpr int N_PHASES = 30;
typedef __attribute__((address_space(4))) const unsigned long long* karg_ptr;
DEVI Params load_params(karg_ptr kp) {
    Params q;
    unsigned long long* d = (unsigned long long*)&q;
#pragma unroll
    for (int i = 0; i < (int)(sizeof(Params) / 8); ++i) d[i] = kp[i];
    return q;
}
__global__ void __launch_bounds__(NTHR) hybrid_fwd(Params p_unused) {
    extern __shared__ __attribute__((aligned(16))) char lds[];
    karg_ptr kp = (karg_ptr)__builtin_amdgcn_kernarg_segment_ptr();
    int ph_lo, ph_hi, use_gs;
    { const Params q = load_params(kp); ph_lo = q.ph_lo; ph_hi = q.ph_hi; use_gs = q.use_grid_sync; }
    for (int ph = ph_lo; ph < ph_hi; ++ph) {
        if (ph > ph_lo) { if (use_gs) cg::this_grid().sync(); }
        asm volatile("" : "+s"(kp) :: "memory");
        const Params p = load_params(kp);
        unsigned char* ws = p.ws;
        if (ph == 0) {
            prep_small(p);
            for (int u = BIDX(); u < PREP_UNITS; u += gridDim.x) prep_unit(p, 0, u, (float*)lds);
        } else if (ph == 29) {
            phase_final(p);
        } else {
            const int l = (ph - 1) / 14, s = (ph - 1) % 14;
            const float* x_in = l == 0 ? p.in[0] : p.out;
            float* x1 = l == 0 ? p.out : (float*)(ws + WS_XB);
            float* x2 = l == 0 ? (float*)(ws + WS_XB) : p.out;
            switch (s) {
            case 0:
                if (l == 1) for (int u = BIDX(); u < PREP_UNITS; u += gridDim.x) prep_unit(p, 1, u, (float*)lds);
                __syncthreads();
                phase_norm1(p, l, lds); break;
            case 1: phase_inproj(p, l, lds); break;
            case 2: phase_post(p, l); break;
            case 3: phase_mix1(p, l, lds); break;
            case 4: phase_ssd_scan(p); break;
            case 5: phase_mix3(p, l, lds); break;
            case 6: { auto mk = [&](int r0, int c0) { return EpiResF32{x_in + (size_t)r0 * DM + c0, x1 + (size_t)r0 * DM + c0, DM}; };
                      gemm_dense_units((const bf16_t*)(ws + WS_MIX), (const bf16_t*)(ws + WS_W_OUT), T, DM, DM, mk, lds, BIDX(), gridDim.x); } break;
            case 7: phase_norm2(p, l, x1); break;
            case 8: { bf16_t* qb = (bf16_t*)(ws + WS_QBUF);
                      auto mk = [&](int r0, int c0) { return EpiBf16Out{qb + (size_t)r0 * DM + c0, DM}; };
                      gemm_dense_units((const bf16_t*)(ws + WS_HBUF), (const bf16_t*)(ws + WS_W_Q), T, DM, DM, mk, lds, BIDX(), gridDim.x); } break;
            case 9: phase_xattn(p, l, lds); break;
            case 10: { auto mk = [&](int r0, int c0) { return EpiResF32{x1 + (size_t)r0 * DM + c0, x2 + (size_t)r0 * DM + c0, DM}; };
                       gemm_dense_units((const bf16_t*)(ws + WS_OBUF), (const bf16_t*)(ws + WS_W_O), T, DM, DM, mk, lds, BIDX(), gridDim.x); } break;
            case 11: phase_norm3(p, l, x2, lds); break;
            case 12: phase_moe<0>(p, l, lds); break;
            case 13: phase_moe<1>(p, l, lds); break;
            }
        }
    }
}

extern "C" void kernel_launch(void* const* d_in, const int* in_sizes, int n_in, void* d_out, int out_size, void* d_ws, size_t ws_size, hipStream_t stream) {
    static int grid = 0;
    if (grid == 0) {
        if (n_in != 31 || out_size != T * DM || ws_size < WS_END) { fprintf(stderr, "kernel_launch: unexpected shapes (n_in %d out %d ws %zu need %zu)\n", n_in, out_size, ws_size, (size_t)WS_END); grid = -1; return; }
        int dev = 0, cus = 0, per_cu = 0;
        hipGetDevice(&dev);
        hipDeviceGetAttribute(&cus, hipDeviceAttributeMultiprocessorCount, dev);
        hipFuncSetAttribute((const void*)hybrid_fwd, hipFuncAttributeMaxDynamicSharedMemorySize, LDS_BYTES);
        hipOccupancyMaxActiveBlocksPerMultiprocessor(&per_cu, (const void*)hybrid_fwd, NTHR, LDS_BYTES);
        if (per_cu < 1) { fprintf(stderr, "kernel_launch: occupancy query says %d blocks per CU\n", per_cu); per_cu = 1; }
        (void)hipGetLastError();
        grid = cus;
    }
    if (grid < 0) return;
    Params p{};
    for (int i = 0; i < 31; ++i) p.in[i] = (const float*)d_in[i];
    p.out = (float*)d_out; p.ws = (unsigned char*)d_ws;
    p.use_grid_sync = 0; p.pad = 0;
#ifndef MAX_PHASE
#define MAX_PHASE N_PHASES
#endif
    for (int ph = 0; ph < MAX_PHASE; ++ph) {
        p.ph_lo = ph; p.ph_hi = ph + 1;
        hipLaunchKernelGGL(hybrid_fwd, dim3(grid), dim3(NTHR), LDS_BYTES, stream, p);
    }
}
```

```cpp
#include <hip/hip_runtime.h>
#include <hip/hip_cooperative_groups.h>
#include <cstdio>
#include <cstdint>
namespace cg = cooperative_groups;

typedef unsigned short bf16_t;
typedef short bf16x8 __attribute__((ext_vector_type(8)));
typedef short s16x4 __attribute__((ext_vector_type(4)));
typedef float f32x4 __attribute__((ext_vector_type(4)));
typedef unsigned u32x4 __attribute__((ext_vector_type(4)));
typedef unsigned u32x2 __attribute__((ext_vector_type(2)));
#define DEVI __device__ __forceinline__
#define LAS __attribute__((address_space(3)))

constexpr int NB = 8, S = 2048, DM = 1024, T = NB * S, DEPTH = 2;
constexpr int INP = 3084, NPROJ = 3072;
constexpr int C_FQ = 0, C_FK = 256, C_FV = 512, C_DQ = 768, C_DK = 1024, C_DV = 1280, C_Z = 1536, C_XBC = 2048;
constexpr int MEMLEN = 256, MROWS = NB * MEMLEN;
constexpr int NEXP = 32, EFF = 512;
constexpr float EPS = 1e-6f;
constexpr int NTHR = 512;
constexpr int LDS_BYTES = 151552;

constexpr size_t al256(size_t x) { return (x + 255) & ~(size_t)255; }
constexpr size_t WS_W_IN = 0;
constexpr size_t WS_W_OUT = WS_W_IN + (size_t)NPROJ * DM * 2;
constexpr size_t WS_W_Q = WS_W_OUT + (size_t)DM * DM * 2;
constexpr size_t WS_W_KV = WS_W_Q + (size_t)DM * DM * 2;
constexpr size_t WS_W_O = WS_W_KV + (size_t)2 * DM * DM * 2;
constexpr size_t WS_W_13 = WS_W_O + (size_t)DM * DM * 2;
constexpr size_t WS_W_2 = WS_W_13 + (size_t)NEXP * 1024 * DM * 2;
constexpr size_t WS_WSMALL = WS_W_2 + (size_t)NEXP * DM * EFF * 2;
constexpr size_t WS_WROUT = WS_WSMALL + (size_t)DEPTH * 12 * DM * 4;
constexpr size_t WS_XB = WS_WROUT + (size_t)DEPTH * 36 * DM * 4;
constexpr size_t WS_HBUF = WS_XB + (size_t)T * DM * 4;
constexpr size_t WS_PROJ = WS_HBUF + (size_t)T * DM * 2;
constexpr size_t WS_QBUF = WS_PROJ;
constexpr size_t WS_OBUF = WS_PROJ + (size_t)T * DM * 2;
constexpr size_t WS_ACT = WS_PROJ;
constexpr size_t WS_MIX = WS_PROJ + (size_t)T * NPROJ * 2;
constexpr size_t WS_U = WS_MIX + (size_t)T * DM * 2;
constexpr size_t WS_YBUF = WS_U;
constexpr size_t WS_DILO = WS_U;
constexpr size_t WS_DILM = WS_DILO + (size_t)3 * T * 256 * 4;
constexpr size_t WS_DILL = WS_DILM + (size_t)3 * T * 4 * 4;
constexpr size_t WS_SSTATE = WS_DILL + (size_t)3 * T * 4 * 4;
constexpr size_t WS_HIN = WS_SSTATE + (size_t)NB * 16 * 8 * 8192 * 4;
constexpr size_t WS_GBUF = WS_HIN + (size_t)NB * 16 * 8 * 8192 * 2;
constexpr size_t WS_U_END = WS_GBUF + (size_t)T * 512 * 4;
constexpr size_t WS_MEMN = WS_U_END;
constexpr size_t WS_KV = WS_MEMN + (size_t)MROWS * DM * 2;
constexpr size_t WS_LOGF = WS_KV + (size_t)MROWS * 2 * DM * 2;
constexpr size_t WS_CUMF = WS_LOGF + (size_t)T * 4 * 4;
constexpr size_t WS_DTV = WS_CUMF + (size_t)T * 4 * 4;
constexpr size_t WS_DECAY = WS_DTV + (size_t)T * 8 * 4;
constexpr size_t WS_CNT = WS_DECAY + (size_t)NB * 16 * 8 * 4;
constexpr size_t WS_LIST = WS_CNT + 1024;
constexpr size_t WS_GATE = WS_LIST + (size_t)NEXP * 2 * T * 4;
constexpr size_t WS_BAR = WS_GATE + (size_t)2 * T * 4;
constexpr size_t WS_END = WS_BAR + 65536;
static_assert(WS_YBUF + (size_t)2 * T * DM * 2 <= WS_U_END, "ybuf alias");
static_assert(WS_OBUF + (size_t)T * DM * 2 <= WS_MIX, "obuf alias");

struct Params {
    const float* in[31];
    float* out;
    unsigned char* ws;
    int ph_lo, ph_hi;
    int use_grid_sync, pad;
};

DEVI int TIDX() { int t = threadIdx.x; asm volatile("" : "+v"(t)); return t; }
DEVI int BIDX() { int b = blockIdx.x; asm volatile("" : "+s"(b)); return b; }
DEVI float bf2f(bf16_t v) { return __uint_as_float(((unsigned)v) << 16); }
typedef float f32x2 __attribute__((ext_vector_type(2)));
typedef __bf16 bf16x2_t __attribute__((ext_vector_type(2)));
DEVI unsigned cvt_pk(float lo, float hi) { f32x2 v = {lo, hi}; bf16x2_t b = __builtin_convertvector(v, bf16x2_t); return __builtin_bit_cast(unsigned, b); }
DEVI bf16_t f2bf(float f) { return (bf16_t)(cvt_pk(f, 0.f) & 0xffffu); }
DEVI float bflo(unsigned w) { return __uint_as_float(w << 16); }
DEVI float bfhi(unsigned w) { return __uint_as_float(w & 0xffff0000u); }
DEVI float wave_sum(float v) {
#pragma unroll
    for (int m = 32; m >= 1; m >>= 1) v += __shfl_xor(v, m);
    return v;
}
DEVI float silu_f(float x) { return x / (1.f + __expf(-x)); }
DEVI float softplus_f(float x) { return x > 20.f ? x : log1pf(__expf(x)); }
DEVI float logsigmoid_f(float x) { return x >= 0.f ? -log1pf(__expf(-x)) : x - log1pf(__expf(x)); }
#define MFMA16(a, b, c) __builtin_amdgcn_mfma_f32_16x16x32_bf16(a, b, c, 0, 0, 0)
DEVI s16x4 tr_read(const bf16_t* p) {
    return __builtin_bit_cast(s16x4, __builtin_amdgcn_ds_read_tr16_b64_v4i16((LAS s16x4*)p));
}

DEVI int maprow(int mode, int n) { return mode == 0 ? n : ((n >> 4) * 32 + (n & 15) + (mode == 2 ? 16 : 0)); }
DEVI void prep_tile(const float* __restrict__ src, int ld, int k0, int c0, bf16_t* __restrict__ dst, int dstld, int mode, int n0,
                    const float* __restrict__ kscale, int ks_from, float* tl) {
    const int tid = TIDX();
#pragma unroll
    for (int i = 0; i < 2; ++i) {
        const int k = (tid >> 4) + 32 * i, n4 = (tid & 15) * 4;
        const float4 v = *(const float4*)(src + (size_t)(k0 + k) * ld + c0 + n4);
        float sc = 1.f;
        if (kscale != nullptr && (k0 + k) >= ks_from) sc = kscale[k0 + k - ks_from];
        tl[k * 65 + n4 + 0] = v.x * sc; tl[k * 65 + n4 + 1] = v.y * sc; tl[k * 65 + n4 + 2] = v.z * sc; tl[k * 65 + n4 + 3] = v.w * sc;
    }
    __syncthreads();
    {
        const int n = tid >> 3, kc = (tid & 7) * 8;
        u32x4 w;
        w.x = cvt_pk(tl[(kc + 0) * 65 + n], tl[(kc + 1) * 65 + n]);
        w.y = cvt_pk(tl[(kc + 2) * 65 + n], tl[(kc + 3) * 65 + n]);
        w.z = cvt_pk(tl[(kc + 4) * 65 + n], tl[(kc + 5) * 65 + n]);
        w.w = cvt_pk(tl[(kc + 6) * 65 + n], tl[(kc + 7) * 65 + n]);
        const int drow = maprow(mode, n0 + n);
        *(u32x4*)(dst + (size_t)drow * dstld + k0 + kc) = w;
    }
    __syncthreads();
}

constexpr int PREP_UNITS = 2048 + 3 * 4096;
DEVI void prep_unit(const Params& p, int l, int u, float* tl) {
    unsigned char* ws = p.ws;
    if (u < 768) {
        const int kt = u / 48, nt = u % 48, n0 = nt * 64, c0 = n0 < 768 ? n0 : n0 + 4;
        prep_tile(p.in[3] + (size_t)l * DM * INP, INP, kt * 64, c0, (bf16_t*)(ws + WS_W_IN), DM, 0, n0, nullptr, 0, tl);
    } else if (u < 1024) {
        const int v = u - 768, kt = v / 16, nt = v % 16;
        prep_tile(p.in[15] + (size_t)l * DM * DM, DM, kt * 64, nt * 64, (bf16_t*)(ws + WS_W_OUT), DM, 0, nt * 64, p.in[14] + l * 512, 512, tl);
    } else if (u < 1280) {
        const int v = u - 1024, kt = v / 16, nt = v % 16;
        prep_tile(p.in[18] + (size_t)l * DM * DM, DM, kt * 64, nt * 64, (bf16_t*)(ws + WS_W_Q), DM, 0, nt * 64, nullptr, 0, tl);
    } else if (u < 1792) {
        const int v = u - 1280, kt = v / 32, nt = v % 32;
        prep_tile(p.in[19] + (size_t)l * DM * 2 * DM, 2 * DM, kt * 64, nt * 64, (bf16_t*)(ws + WS_W_KV), DM, 0, nt * 64, nullptr, 0, tl);
    } else if (u < 2048) {
        const int v = u - 1792, kt = v / 16, nt = v % 16;
        prep_tile(p.in[22] + (size_t)l * DM * DM, DM, kt * 64, nt * 64, (bf16_t*)(ws + WS_W_O), DM, 0, nt * 64, nullptr, 0, tl);
    } else if (u < 2048 + 8192) {
        const int v = u - 2048, which = v / 4096, w = v % 4096, e = w / 128, tI = w % 128, kt = tI / 8, nt = tI % 8;
        const float* src = (which == 0 ? p.in[28] : p.in[29]) + ((size_t)l * NEXP + e) * DM * EFF;
        prep_tile(src, EFF, kt * 64, nt * 64, (bf16_t*)(ws + WS_W_13) + (size_t)e * 1024 * DM, DM, which == 0 ? 1 : 2, nt * 64, nullptr, 0, tl);
    } else {
        const int w = u - 2048 - 8192, e = w / 128, tI = w % 128, kt = tI / 16, nt = tI % 16;
        const float* src = p.in[30] + ((size_t)l * NEXP + e) * EFF * DM;
        prep_tile(src, DM, kt * 64, nt * 64, (bf16_t*)(ws + WS_W_2) + (size_t)e * DM * EFF, EFF, 0, nt * 64, nullptr, 0, tl);
    }
}
DEVI void prep_small(const Params& p) {
    float* wsm = (float*)(p.ws + WS_WSMALL);
    float* wro = (float*)(p.ws + WS_WROUT);
    const int gtid = BIDX() * NTHR + TIDX(), gn = gridDim.x * NTHR;
    for (int i = gtid; i < DEPTH * 12 * DM; i += gn) {
        const int l = i / (12 * DM), r = i % (12 * DM), c = r / DM, k = r % DM;
        const int col = c < 4 ? 768 + c : 3076 + (c - 4);
        wsm[i] = p.in[3][((size_t)l * DM + k) * INP + col];
    }
    for (int i = gtid; i < DEPTH * 36 * DM; i += gn) {
        const int l = i / (36 * DM), r = i % (36 * DM), c = r / DM, k = r % DM;
        wro[i] = c < 4 ? p.in[24][((size_t)l * DM + k) * 4 + c] : p.in[26][((size_t)l * DM + k) * 32 + (c - 4)];
    }
    if (BIDX() == 0 && TIDX() < 128) ((int*)(p.ws + WS_CNT))[TIDX()] = 0;
}

DEVI void store_h_bf16(bf16_t* hrow, const float (&h)[16], int lane) {
#pragma unroll
    for (int j = 0; j < 4; ++j) {
        u32x2 w; w.x = cvt_pk(h[4 * j], h[4 * j + 1]); w.y = cvt_pk(h[4 * j + 2], h[4 * j + 3]);
        *(u32x2*)(hrow + j * 256 + lane * 4) = w;
    }
}
DEVI void load_row_f32(const float* xr, float (&x)[16], int lane) {
#pragma unroll
    for (int j = 0; j < 4; ++j) { const float4 v = *(const float4*)(xr + j * 256 + lane * 4); x[4 * j] = v.x; x[4 * j + 1] = v.y; x[4 * j + 2] = v.z; x[4 * j + 3] = v.w; }
}
DEVI void add_row_bf16(const bf16_t* yr, float (&x)[16], int lane) {
#pragma unroll
    for (int j = 0; j < 4; ++j) { const u32x2 w = *(const u32x2*)(yr + j * 256 + lane * 4); x[4 * j] += bflo(w.x); x[4 * j + 1] += bfhi(w.x); x[4 * j + 2] += bflo(w.y); x[4 * j + 3] += bfhi(w.y); }
}
DEVI void store_row_f32(float* xr, const float (&x)[16], int lane) {
#pragma unroll
    for (int j = 0; j < 4; ++j) *(float4*)(xr + j * 256 + lane * 4) = make_float4(x[4 * j], x[4 * j + 1], x[4 * j + 2], x[4 * j + 3]);
}
DEVI void norm_row(const float (&x)[16], const float* g, float (&h)[16], int lane) {
    float ss = 0.f;
#pragma unroll
    for (int i = 0; i < 16; ++i) ss += x[i] * x[i];
    ss = wave_sum(ss);
    const float rstd = rsqrtf(ss * (1.0f / DM) + EPS);
#pragma unroll
    for (int j = 0; j < 4; ++j) { const float4 gv = *(const float4*)(g + j * 256 + lane * 4);
        h[4 * j] = x[4 * j] * rstd * gv.x; h[4 * j + 1] = x[4 * j + 1] * rstd * gv.y; h[4 * j + 2] = x[4 * j + 2] * rstd * gv.z; h[4 * j + 3] = x[4 * j + 3] * rstd * gv.w; }
}
DEVI float dot_lds(const float (&h)[16], const float* wrow, int lane) {
    float a = 0.f;
#pragma unroll
    for (int j = 0; j < 4; ++j) { const float4 w = *(const float4*)(wrow + j * 256 + lane * 4); a += h[4 * j] * w.x + h[4 * j + 1] * w.y + h[4 * j + 2] * w.z + h[4 * j + 3] * w.w; }
    return a;
}

DEVI void phase_norm1(const Params& p, int l, char* lds) {
    const int tid = TIDX(), wid = tid >> 6, lane = tid & 63;
    unsigned char* ws = p.ws;
    float* wsl = (float*)lds;
    { const float4* src = (const float4*)((const float*)(ws + WS_WSMALL) + (size_t)l * 12 * DM);
      for (int i = tid; i < 12 * DM / 4; i += NTHR) ((float4*)wsl)[i] = src[i]; }
    __syncthreads();
    const float* xin = l == 0 ? p.in[0] : (const float*)(ws + WS_XB);
    float* xout = p.out;
    const bf16_t* ybuf = (const bf16_t*)(ws + WS_YBUF);
    bf16_t* hbuf = (bf16_t*)(ws + WS_HBUF);
    const float* g1 = p.in[2] + l * DM;
    float* logf = (float*)(ws + WS_LOGF);
    float* dtv = (float*)(ws + WS_DTV);
    for (int row = BIDX() * 8 + wid; row < T; row += gridDim.x * 8) {
        float x[16], h[16];
        load_row_f32(xin + (size_t)row * DM, x, lane);
        if (l > 0) {
            add_row_bf16(ybuf + (size_t)(2 * row) * DM, x, lane);
            add_row_bf16(ybuf + (size_t)(2 * row + 1) * DM, x, lane);
            store_row_f32(xout + (size_t)row * DM, x, lane);
        }
        norm_row(x, g1, h, lane);
        store_h_bf16(hbuf + (size_t)row * DM, h, lane);
        float acc[12];
#pragma unroll
        for (int c = 0; c < 12; ++c) acc[c] = wave_sum(dot_lds(h, wsl + c * DM, lane));
        if (lane == 0) {
#pragma unroll
            for (int c = 0; c < 4; ++c) logf[(size_t)row * 4 + c] = logsigmoid_f(acc[c] + p.in[4][l * 4 + c]);
#pragma unroll
            for (int c = 0; c < 8; ++c) dtv[(size_t)row * 8 + c] = softplus_f(acc[4 + c] + p.in[11][l * 8 + c]);
        }
    }
    const float* gm = p.in[17] + l * DM;
    bf16_t* memn = (bf16_t*)(ws + WS_MEMN);
    for (int row = BIDX() * 8 + wid; row < MROWS; row += gridDim.x * 8) {
        float x[16], h[16];
        load_row_f32(p.in[1] + (size_t)row * DM, x, lane);
        norm_row(x, gm, h, lane);
        store_h_bf16(memn + (size_t)row * DM, h, lane);
    }
}
DEVI void phase_norm2(const Params& p, int l, const float* xin) {
    const int tid = TIDX(), wid = tid >> 6, lane = tid & 63;
    bf16_t* hbuf = (bf16_t*)(p.ws + WS_HBUF);
    const float* g = p.in[16] + l * DM;
    for (int row = BIDX() * 8 + wid; row < T; row += gridDim.x * 8) {
        float x[16], h[16];
        load_row_f32(xin + (size_t)row * DM, x, lane);
        norm_row(x, g, h, lane);
        store_h_bf16(hbuf + (size_t)row * DM, h, lane);
    }
}
DEVI void phase_norm3(const Params& p, int l, const float* xin, char* lds) {
    const int tid = TIDX(), wid = tid >> 6, lane = tid & 63;
    unsigned char* ws = p.ws;
    float* wr = (float*)lds;
    { const float4* src = (const float4*)((const float*)(ws + WS_WROUT) + (size_t)l * 36 * DM);
      for (int i = tid; i < 36 * DM / 4; i += NTHR) ((float4*)wr)[i] = src[i]; }
    __syncthreads();
    bf16_t* hbuf = (bf16_t*)(ws + WS_HBUF);
    const float* g = p.in[23] + l * DM;
    int* cnt = (int*)(ws + WS_CNT) + l * 64;
    int* list = (int*)(ws + WS_LIST);
    float* gate = (float*)(ws + WS_GATE);
    const float* bg = p.in[25] + l * 4;
    const float* be = p.in[27] + l * 32;
    for (int row = BIDX() * 8 + wid; row < T; row += gridDim.x * 8) {
        float x[16], h[16];
        load_row_f32(xin + (size_t)row * DM, x, lane);
        norm_row(x, g, h, lane);
        store_h_bf16(hbuf + (size_t)row * DM, h, lane);
        float gl[4];
#pragma unroll
        for (int c = 0; c < 4; ++c) gl[c] = wave_sum(dot_lds(h, wr + c * DM, lane)) + bg[c];
        int gsel = 0; float gmax = gl[0];
#pragma unroll
        for (int c = 1; c < 4; ++c) if (gl[c] > gmax) { gmax = gl[c]; gsel = c; }
        float gden = 0.f;
#pragma unroll
        for (int c = 0; c < 4; ++c) gden += __expf(gl[c] - gmax);
        const float ggate = 1.0f / gden;
        gsel = __builtin_amdgcn_readfirstlane(gsel);
        float el[8];
#pragma unroll
        for (int c = 0; c < 8; ++c) el[c] = wave_sum(dot_lds(h, wr + (4 + gsel * 8 + c) * DM, lane)) + be[gsel * 8 + c];
        int i1 = 0; float v1 = el[0];
#pragma unroll
        for (int c = 1; c < 8; ++c) if (el[c] > v1) { v1 = el[c]; i1 = c; }
        int i2 = (i1 == 0) ? 1 : 0; float v2 = -3.0e38f;
#pragma unroll
        for (int c = 0; c < 8; ++c) if (c != i1 && el[c] > v2) { v2 = el[c]; i2 = c; }
        const float e2 = __expf(v2 - v1), inv = 1.0f / (1.0f + e2);
        const float ga = inv * ggate, gb = e2 * inv * ggate;
        if (lane == 0) {
            const int ea = gsel * 8 + i1, eb = gsel * 8 + i2;
            const int sa = atomicAdd(&cnt[ea], 1);
            list[(size_t)ea * (2 * T) + sa] = 2 * row;
            const int sb = atomicAdd(&cnt[eb], 1);
            list[(size_t)eb * (2 * T) + sb] = 2 * row + 1;
            gate[2 * row] = ga; gate[2 * row + 1] = gb;
        }
    }
}

constexpr int G_BM = 256, G_BN = 128, G_BK = 64, G_ST = 72;
constexpr int G_ABUF = G_BM * G_ST, G_BBUF = G_BN * G_ST;
template <class AMap, class Epi>
DEVI void gemm_tile(const AMap& amap, const bf16_t* __restrict__ Bt, int K, const Epi& epi, char* lds) {
    const int tid = TIDX(), wid = tid >> 6, lane = tid & 63, r16 = lane & 15, g4 = lane >> 4;
    const int wr = wid >> 1, wc = wid & 1;
    bf16_t* As = (bf16_t*)lds;
    bf16_t* Bs = As + 2 * G_ABUF;
    const int srow = tid >> 3, skc = (tid & 7) * 8;
    const bf16_t* ap[4];
#pragma unroll
    for (int i = 0; i < 4; ++i) ap[i] = amap(srow + 64 * i) + skc;
    const bf16_t* bp[2];
#pragma unroll
    for (int i = 0; i < 2; ++i) bp[i] = Bt + (size_t)(srow + 64 * i) * K + skc;
    u32x4 ra[4], rb[2];
#pragma unroll
    for (int i = 0; i < 4; ++i) ra[i] = *(const u32x4*)(ap[i]);
#pragma unroll
    for (int i = 0; i < 2; ++i) rb[i] = *(const u32x4*)(bp[i]);
    f32x4 acc[4][4];
#pragma unroll
    for (int m = 0; m < 4; ++m)
#pragma unroll
        for (int n = 0; n < 4; ++n) acc[m][n] = (f32x4){0.f, 0.f, 0.f, 0.f};
    const int nt = K / G_BK;
    for (int t = 0; t < nt; ++t) {
        bf16_t* Ab = As + (t & 1) * G_ABUF;
        bf16_t* Bb = Bs + (t & 1) * G_BBUF;
#pragma unroll
        for (int i = 0; i < 4; ++i) *(u32x4*)(Ab + (srow + 64 * i) * G_ST + skc) = ra[i];
#pragma unroll
        for (int i = 0; i < 2; ++i) *(u32x4*)(Bb + (srow + 64 * i) * G_ST + skc) = rb[i];
        __syncthreads();
        if (t + 1 < nt) {
#pragma unroll
            for (int i = 0; i < 4; ++i) ra[i] = *(const u32x4*)(ap[i] + (size_t)(t + 1) * G_BK);
#pragma unroll
            for (int i = 0; i < 2; ++i) rb[i] = *(const u32x4*)(bp[i] + (size_t)(t + 1) * G_BK);
        }
#pragma unroll
        for (int kk = 0; kk < 2; ++kk) {
            bf16x8 af[4], bfr[4];
#pragma unroll
            for (int m = 0; m < 4; ++m) af[m] = *(const bf16x8*)(Ab + (wr * 64 + m * 16 + r16) * G_ST + kk * 32 + g4 * 8);
#pragma unroll
            for (int n = 0; n < 4; ++n) bfr[n] = *(const bf16x8*)(Bb + (wc * 64 + n * 16 + r16) * G_ST + kk * 32 + g4 * 8);
#pragma unroll
            for (int m = 0; m < 4; ++m)
#pragma unroll
                for (int n = 0; n < 4; ++n) acc[m][n] = MFMA16(bfr[n], af[m], acc[m][n]);
        }
    }
    epi(acc, wr * 64 + r16, wc * 64 + g4 * 4);
    __syncthreads();
}

struct AMapDense { const bf16_t* A; int K; DEVI const bf16_t* operator()(int r) const { return A + (size_t)r * K; } };
struct EpiBf16Out { bf16_t* O; int ldo;
    DEVI void operator()(const f32x4 (&acc)[4][4], int rb, int cb) const {
#pragma unroll
        for (int m = 0; m < 4; ++m)
#pragma unroll
            for (int n = 0; n < 4; ++n) { u32x2 w; w.x = cvt_pk(acc[m][n][0], acc[m][n][1]); w.y = cvt_pk(acc[m][n][2], acc[m][n][3]);
                *(u32x2*)(O + (size_t)(rb + m * 16) * ldo + cb + n * 16) = w; }
    } };
struct EpiResF32 { const float* R; float* O; int ld;
    DEVI void operator()(const f32x4 (&acc)[4][4], int rb, int cb) const {
#pragma unroll
        for (int m = 0; m < 4; ++m)
#pragma unroll
            for (int n = 0; n < 4; ++n) { const size_t off = (size_t)(rb + m * 16) * ld + cb + n * 16;
                const f32x4 r = *(const f32x4*)(R + off); *(f32x4*)(O + off) = r + acc[m][n]; }
    } };

template <class MakeEpi>
DEVI void gemm_dense_units(const bf16_t* A, const bf16_t* Bt, int M, int N, int K, const MakeEpi& mk, char* lds, int u0, int ustride) {
    const int nN = N / G_BN, nU = (M / G_BM) * nN;
    for (int u = u0; u < nU; u += ustride) {
        const int pm = u / nN, pn = u % nN;
        AMapDense am{A + (size_t)pm * G_BM * K, K};
        gemm_tile(am, Bt + (size_t)pn * G_BN * K, K, mk(pm * G_BM, pn * G_BN), lds);
    }
}

DEVI void cumsum_task(const Params& p, int bh, char* lds) {
    const int tid = TIDX(), wid = tid >> 6, lane = tid & 63;
    const int b = bh >> 2, h = bh & 3;
    const float* logf = (const float*)(p.ws + WS_LOGF);
    float* cumf = (float*)(p.ws + WS_CUMF);
    float* wtot = (float*)lds;
    float v[4];
#pragma unroll
    for (int j = 0; j < 4; ++j) v[j] = logf[((size_t)b * S + tid * 4 + j) * 4 + h];
    v[1] += v[0]; v[2] += v[1]; v[3] += v[2];
    float incl = v[3];
#pragma unroll
    for (int d = 1; d < 64; d <<= 1) { const float t = __shfl_up(incl, d); if (lane >= d) incl += t; }
    if (lane == 63) wtot[wid] = incl;
    __syncthreads();
    float woff = 0.f;
    for (int w = 0; w < wid; ++w) woff += wtot[w];
    const float base = woff + incl - v[3];
    *(float4*)(cumf + (size_t)bh * S + tid * 4) = make_float4(base + v[0], base + v[1], base + v[2], base + v[3]);
    __syncthreads();
}
DEVI void phase_inproj(const Params& p, int l, char* lds) {
    unsigned char* ws = p.ws;
    for (int t = BIDX(); t < 32; t += gridDim.x) cumsum_task(p, t, lds);
    bf16_t* proj = (bf16_t*)(ws + WS_PROJ);
    auto mk1 = [&](int r0, int c0) { return EpiBf16Out{proj + (size_t)r0 * NPROJ + c0, NPROJ}; };
    gemm_dense_units((const bf16_t*)(ws + WS_HBUF), (const bf16_t*)(ws + WS_W_IN), T, NPROJ, DM, mk1, lds, BIDX(), gridDim.x);
    bf16_t* kv = (bf16_t*)(ws + WS_KV);
    auto mk2 = [&](int r0, int c0) { return EpiBf16Out{kv + (size_t)r0 * 2 * DM + c0, 2 * DM}; };
    gemm_dense_units((const bf16_t*)(ws + WS_MEMN), (const bf16_t*)(ws + WS_W_KV), MROWS, 2 * DM, DM, mk2, lds, gridDim.x - 1 - BIDX(), gridDim.x);
}

DEVI void phase_post(const Params& p, int l) {
    const int tid = TIDX(), wid = tid >> 6, lane = tid & 63;
    unsigned char* ws = p.ws;
    bf16_t* proj = (bf16_t*)(ws + WS_PROJ);
    const int sl = lane >> 2, qt = lane & 3, type = sl >> 2, head = sl & 3;
    const int col0 = (type < 2 ? type * 256 : 768 + (type - 2) * 256) + head * 64 + qt * 16;
    const float *gq0 = p.in[5], *gq1 = p.in[6], *gq2 = p.in[7], *gq3 = p.in[8];
    asm volatile("" : "+s"(gq0), "+s"(gq1), "+s"(gq2), "+s"(gq3));
    const float* gain = (type == 0 ? gq0 : type == 1 ? gq1 : type == 2 ? gq2 : gq3) + l * 64 + qt * 16;
    float gv[16];
#pragma unroll
    for (int i = 0; i < 16; ++i) gv[i] = gain[i];
    float inv[8];
#pragma unroll
    for (int i = 0; i < 8; ++i) inv[i] = powf(500000.0f, -(float)i / 8.0f);
    for (int row = BIDX() * 8 + wid; row < T; row += gridDim.x * 8) {
        bf16_t* ptr = proj + (size_t)row * NPROJ + col0;
        const u32x4 w0 = *(const u32x4*)ptr, w1 = *(const u32x4*)(ptr + 8);
        float v[16];
        v[0] = bflo(w0.x); v[1] = bfhi(w0.x); v[2] = bflo(w0.y); v[3] = bfhi(w0.y); v[4] = bflo(w0.z); v[5] = bfhi(w0.z); v[6] = bflo(w0.w); v[7] = bfhi(w0.w);
        v[8] = bflo(w1.x); v[9] = bfhi(w1.x); v[10] = bflo(w1.y); v[11] = bfhi(w1.y); v[12] = bflo(w1.z); v[13] = bfhi(w1.z); v[14] = bflo(w1.w); v[15] = bfhi(w1.w);
        float ss = 0.f;
#pragma unroll
        for (int i = 0; i < 16; ++i) ss += v[i] * v[i];
        ss += __shfl_xor(ss, 1); ss += __shfl_xor(ss, 2);
        const float rstd = rsqrtf(ss * (1.0f / 64.0f) + EPS);
#pragma unroll
        for (int i = 0; i < 16; ++i) v[i] = v[i] * rstd * gv[i];
        if (type >= 2 && qt == 0) {
            const float pos = (float)(row & (S - 1));
#pragma unroll
            for (int i = 0; i < 8; ++i) { float sn, cs; sincosf(pos * inv[i], &sn, &cs);
                const float a = v[i], b = v[i + 8]; v[i] = a * cs - b * sn; v[i + 8] = b * cs + a * sn; }
        }
        u32x4 o0, o1;
        o0.x = cvt_pk(v[0], v[1]); o0.y = cvt_pk(v[2], v[3]); o0.z = cvt_pk(v[4], v[5]); o0.w = cvt_pk(v[6], v[7]);
        o1.x = cvt_pk(v[8], v[9]); o1.y = cvt_pk(v[10], v[11]); o1.z = cvt_pk(v[12], v[13]); o1.w = cvt_pk(v[14], v[15]);
        *(u32x4*)ptr = o0; *(u32x4*)(ptr + 8) = o1;
    }
    bf16_t* kv = (bf16_t*)(ws + WS_KV);
    const float* kg = p.in[21] + l * 256 + (lane & 15) * 16;
    float kgv[16];
#pragma unroll
    for (int i = 0; i < 16; ++i) kgv[i] = kg[i];
    for (int row = BIDX() * 8 + wid; row < MROWS; row += gridDim.x * 8) {
        bf16_t* ptr = kv + (size_t)row * 2 * DM + lane * 16;
        const u32x4 w0 = *(const u32x4*)ptr, w1 = *(const u32x4*)(ptr + 8);
        float v[16];
        v[0] = bflo(w0.x); v[1] = bfhi(w0.x); v[2] = bflo(w0.y); v[3] = bfhi(w0.y); v[4] = bflo(w0.z); v[5] = bfhi(w0.z); v[6] = bflo(w0.w); v[7] = bfhi(w0.w);
        v[8] = bflo(w1.x); v[9] = bfhi(w1.x); v[10] = bflo(w1.y); v[11] = bfhi(w1.y); v[12] = bflo(w1.z); v[13] = bfhi(w1.z); v[14] = bflo(w1.w); v[15] = bfhi(w1.w);
        float ss = 0.f;
#pragma unroll
        for (int i = 0; i < 16; ++i) ss += v[i] * v[i];
        ss += __shfl_xor(ss, 1); ss += __shfl_xor(ss, 2); ss += __shfl_xor(ss, 4); ss += __shfl_xor(ss, 8);
        const float rstd = rsqrtf(ss * (1.0f / 256.0f) + EPS);
#pragma unroll
        for (int i = 0; i < 16; ++i) v[i] = v[i] * rstd * kgv[i];
        u32x4 o0, o1;
        o0.x = cvt_pk(v[0], v[1]); o0.y = cvt_pk(v[2], v[3]); o0.z = cvt_pk(v[4], v[5]); o0.w = cvt_pk(v[6], v[7]);
        o1.x = cvt_pk(v[8], v[9]); o1.y = cvt_pk(v[10], v[11]); o1.z = cvt_pk(v[12], v[13]); o1.w = cvt_pk(v[14], v[15]);
        *(u32x4*)ptr = o0; *(u32x4*)(ptr + 8) = o1;
    }
}

template <int DH> struct AttnLds { static constexpr int KST = DH + 8, PST = 72; static constexpr int BYTES = (2 * 64 * KST + 8 * 16 * PST) * 2; };
template <int DH, int MODE>
DEVI void attn_task(const bf16_t* __restrict__ Qb, int ldq, int qtok0, int qstep,
                    const bf16_t* __restrict__ Kb, const bf16_t* __restrict__ Vb, int ldk, int ktok0, int kstep,
                    int p0, int kt_lo, int kt_hi, float scale,
                    const float* __restrict__ cum, const float* __restrict__ qgain,
                    bf16_t* Ob, int ldo, float* Of, float* Om, float* Ol, char* lds) {
    constexpr int KST = AttnLds<DH>::KST, PST = AttnLds<DH>::PST, NKK = DH / 32, ND = DH / 16;
    const int tid = TIDX(), wid = tid >> 6, lane = tid & 63, r16 = lane & 15, g4 = lane >> 4;
    bf16_t* Ks = (bf16_t*)lds;
    bf16_t* Vs = Ks + 64 * KST;
    bf16_t* Ps = Vs + 64 * KST + wid * 16 * PST;
    bf16x8 qf[NKK];
    {
        const bf16_t* qp = Qb + (size_t)(qtok0 + (p0 + wid * 16 + r16) * qstep) * ldq + g4 * 8;
#pragma unroll
        for (int kk = 0; kk < NKK; ++kk) qf[kk] = *(const bf16x8*)(qp + kk * 32);
    }
    if (MODE == 2) {
        float ss = 0.f;
#pragma unroll
        for (int kk = 0; kk < NKK; ++kk)
#pragma unroll
            for (int j = 0; j < 8; ++j) { const float v = bf2f((bf16_t)qf[kk][j]); ss += v * v; }
        ss += __shfl_xor(ss, 16); ss += __shfl_xor(ss, 32);
        const float rstd = rsqrtf(ss * (1.0f / DH) + EPS);
#pragma unroll
        for (int kk = 0; kk < NKK; ++kk)
#pragma unroll
            for (int j = 0; j < 8; ++j) { const float v = bf2f((bf16_t)qf[kk][j]) * rstd * qgain[kk * 32 + g4 * 8 + j]; qf[kk][j] = (short)f2bf(v); }
    }
    float m_[4], l_[4], cq[4];
    f32x4 o[ND];
#pragma unroll
    for (int j = 0; j < 4; ++j) { m_[j] = -1.0e30f; l_[j] = 0.f; cq[j] = 0.f; }
#pragma unroll
    for (int n = 0; n < ND; ++n) o[n] = (f32x4){0.f, 0.f, 0.f, 0.f};
    if (MODE == 0) {
#pragma unroll
        for (int j = 0; j < 4; ++j) cq[j] = cum[p0 + wid * 16 + g4 * 4 + j];
    }
    for (int kt = kt_lo; kt < kt_hi; ++kt) {
        __syncthreads();
        for (int c = tid; c < 64 * DH / 8; c += NTHR) {
            const int key = c / (DH / 8), dc = c % (DH / 8);
            const size_t tok = (size_t)(ktok0 + (kt * 64 + key) * kstep);
            *(u32x4*)(Ks + key * KST + dc * 8) = *(const u32x4*)(Kb + tok * ldk + dc * 8);
            *(u32x4*)(Vs + key * KST + dc * 8) = *(const u32x4*)(Vb + tok * ldk + dc * 8);
        }
        __syncthreads();
        f32x4 s[4];
#pragma unroll
        for (int n = 0; n < 4; ++n) {
            s[n] = (f32x4){0.f, 0.f, 0.f, 0.f};
#pragma unroll
            for (int kk = 0; kk < NKK; ++kk) {
                const bf16x8 kf = *(const bf16x8*)(Ks + (n * 16 + r16) * KST + kk * 32 + g4 * 8);
                s[n] = MFMA16(qf[kk], kf, s[n]);
            }
        }
        float ck[4];
#pragma unroll
        for (int n = 0; n < 4; ++n) ck[n] = (MODE == 0) ? cum[kt * 64 + n * 16 + r16] : 0.f;
#pragma unroll
        for (int j = 0; j < 4; ++j) {
            const int qpos = p0 + wid * 16 + g4 * 4 + j;
            float v[4];
            float mx = -INFINITY;
#pragma unroll
            for (int n = 0; n < 4; ++n) {
                const int kpos = kt * 64 + n * 16 + r16;
                float t = s[n][j] * scale;
                if (MODE == 0) { t += cq[j] - ck[n]; if (kpos > qpos) t = -INFINITY; }
                if (MODE == 1) { const int dd = qpos - kpos; if (dd < 0 || dd > 128) t = -INFINITY; }
                v[n] = t; mx = fmaxf(mx, t);
            }
            mx = fmaxf(mx, __shfl_xor(mx, 1)); mx = fmaxf(mx, __shfl_xor(mx, 2)); mx = fmaxf(mx, __shfl_xor(mx, 4)); mx = fmaxf(mx, __shfl_xor(mx, 8));
            const float mn = fmaxf(m_[j], mx);
            const float alpha = __expf(m_[j] - mn);
            float rs = 0.f;
#pragma unroll
            for (int n = 0; n < 4; ++n) { const float pv = __expf(v[n] - mn); rs += pv; Ps[(g4 * 4 + j) * PST + n * 16 + r16] = f2bf(pv); }
            rs += __shfl_xor(rs, 1); rs += __shfl_xor(rs, 2); rs += __shfl_xor(rs, 4); rs += __shfl_xor(rs, 8);
            l_[j] = l_[j] * alpha + rs; m_[j] = mn;
#pragma unroll
            for (int n = 0; n < ND; ++n) o[n][j] *= alpha;
        }
        __builtin_amdgcn_wave_barrier();
        asm volatile("s_waitcnt lgkmcnt(0)" ::: "memory");
#pragma unroll
        for (int kk = 0; kk < 2; ++kk) {
            const bf16x8 pf = *(const bf16x8*)(Ps + r16 * PST + kk * 32 + g4 * 8);
            const bf16_t* vb = Vs + (kk * 32 + 8 * g4 + (r16 >> 2)) * KST + 4 * (r16 & 3);
#pragma unroll
            for (int n = 0; n < ND; ++n) {
                const s16x4 lo = tr_read(vb + n * 16), hi = tr_read(vb + 4 * KST + n * 16);
                bf16x8 vf; vf[0] = lo[0]; vf[1] = lo[1]; vf[2] = lo[2]; vf[3] = lo[3]; vf[4] = hi[0]; vf[5] = hi[1]; vf[6] = hi[2]; vf[7] = hi[3];
                o[n] = MFMA16(pf, vf, o[n]);
            }
        }
        __builtin_amdgcn_wave_barrier();
    }
#pragma unroll
    for (int j = 0; j < 4; ++j) {
        const int prow = p0 + wid * 16 + g4 * 4 + j;
        const size_t tok = (size_t)(qtok0 + prow * qstep);
        if (MODE == 1) {
#pragma unroll
            for (int n = 0; n < ND; ++n) Of[tok * 256 + n * 16 + r16] = o[n][j];
            if (r16 == 0) { Om[tok * 4] = m_[j]; Ol[tok * 4] = l_[j]; }
        } else {
            const float inv = 1.0f / l_[j];
#pragma unroll
            for (int n = 0; n < ND; ++n) Ob[tok * ldo + n * 16 + r16] = f2bf(o[n][j] * inv);
        }
    }
}

DEVI void ssd_acs(const Params& p, int l, int b, int c, int g, float* acs, float* dts) {
    const int tid = TIDX(), wid = tid >> 6, lane = tid & 63;
    if (wid < 4) {
        const int head = g * 4 + wid;
        const float* dtv = (const float*)(p.ws + WS_DTV);
        const float A = -__expf(p.in[12][l * 8 + head]);
        const size_t t0 = (size_t)b * S + c * 128 + 2 * lane;
        const float d0 = dtv[t0 * 8 + head], d1 = dtv[(t0 + 1) * 8 + head];
        const float a0 = d0 * A, a1 = d1 * A;
        float incl = a0 + a1;
#pragma unroll
        for (int d = 1; d < 64; d <<= 1) { const float t = __shfl_up(incl, d); if (lane >= d) incl += t; }
        const float ex = incl - (a0 + a1);
        acs[wid * 128 + 2 * lane] = ex + a0; acs[wid * 128 + 2 * lane + 1] = ex + a0 + a1;
        dts[wid * 128 + 2 * lane] = d0; dts[wid * 128 + 2 * lane + 1] = d1;
    }
}
DEVI void conv8_chan(const Params& p, int l, const bf16_t* proj, int b, int c, int chan, int l0, float (&out)[8]) {
    const float* cw = p.in[9] + (size_t)l * 4 * 1024 + chan;
    const float w0 = cw[0], w1 = cw[1024], w2 = cw[2048], w3 = cw[3072], cb = p.in[10][l * 1024 + chan];
    float v[11];
    const int sbase = c * 128 + l0 - 3;
#pragma unroll
    for (int i = 0; i < 11; ++i) { const int sp = sbase + i; v[i] = sp >= 0 ? bf2f(proj[((size_t)b * S + sp) * NPROJ + C_XBC + chan]) : 0.f; }
#pragma unroll
    for (int i = 0; i < 8; ++i) out[i] = silu_f(cb + w0 * v[i] + w1 * v[i + 1] + w2 * v[i + 2] + w3 * v[i + 3]);
}
DEVI void conv8_pos(const Params& p, int l, const bf16_t* proj, int b, int sp, int chan0, float (&out)[8]) {
    float a[8];
    const float* cb = p.in[10] + l * 1024 + chan0;
#pragma unroll
    for (int i = 0; i < 8; ++i) a[i] = cb[i];
#pragma unroll
    for (int j = 0; j < 4; ++j) {
        const int s2 = sp - 3 + j;
        if (s2 >= 0) {
            const u32x4 w = *(const u32x4*)(proj + ((size_t)b * S + s2) * NPROJ + C_XBC + chan0);
            const float* cw = p.in[9] + ((size_t)l * 4 + j) * 1024 + chan0;
            a[0] += cw[0] * bflo(w.x); a[1] += cw[1] * bfhi(w.x); a[2] += cw[2] * bflo(w.y); a[3] += cw[3] * bfhi(w.y);
            a[4] += cw[4] * bflo(w.z); a[5] += cw[5] * bfhi(w.z); a[6] += cw[6] * bflo(w.w); a[7] += cw[7] * bfhi(w.w);
        }
    }
#pragma unroll
    for (int i = 0; i < 8; ++i) out[i] = silu_f(a[i]);
}
DEVI u32x4 pack8(const float (&v)[8]) { u32x4 w; w.x = cvt_pk(v[0], v[1]); w.y = cvt_pk(v[2], v[3]); w.z = cvt_pk(v[4], v[5]); w.w = cvt_pk(v[6], v[7]); return w; }

constexpr int SST = 136;
DEVI void ssd_states_task(const Params& p, int l, int b, int c, int g, char* lds) {
    const int tid = TIDX(), wid = tid >> 6, lane = tid & 63, r16 = lane & 15, g4 = lane >> 4;
    const bf16_t* proj = (const bf16_t*)(p.ws + WS_PROJ);
    bf16_t* BT = (bf16_t*)lds;
    bf16_t* XT = BT + 128 * SST;
    float* acs = (float*)(XT + 256 * SST);
    float* dts = acs + 512;
    __syncthreads();
    ssd_acs(p, l, b, c, g, acs, dts);
    __syncthreads();
    if (tid < 4) ((float*)(p.ws + WS_DECAY))[((size_t)b * 16 + c) * 8 + g * 4 + tid] = __expf(acs[tid * 128 + 127]);
    for (int it = tid; it < 2048; it += NTHR) {
        const int n = it & 127, lc = it >> 7;
        float v[8]; conv8_chan(p, l, proj, b, c, 512 + g * 128 + n, lc * 8, v);
        *(u32x4*)(BT + n * SST + lc * 8) = pack8(v);
    }
    for (int it = tid; it < 4096; it += NTHR) {
        const int ch = it & 255, lc = it >> 8, hl = ch >> 6;
        float v[8]; conv8_chan(p, l, proj, b, c, g * 256 + ch, lc * 8, v);
        const float alast = acs[hl * 128 + 127];
#pragma unroll
        for (int i = 0; i < 8; ++i) { const int ll = lc * 8 + i; v[i] *= dts[hl * 128 + ll] * __expf(alast - acs[hl * 128 + ll]); }
        *(u32x4*)(XT + ch * SST + lc * 8) = pack8(v);
    }
    __syncthreads();
    const int hl = wid >> 1, nh = wid & 1;
    f32x4 acc[4][4];
#pragma unroll
    for (int m = 0; m < 4; ++m)
#pragma unroll
        for (int n = 0; n < 4; ++n) acc[m][n] = (f32x4){0.f, 0.f, 0.f, 0.f};
#pragma unroll
    for (int kk = 0; kk < 4; ++kk) {
        bf16x8 af[4], bfr[4];
#pragma unroll
        for (int m = 0; m < 4; ++m) af[m] = *(const bf16x8*)(XT + (hl * 64 + m * 16 + r16) * SST + kk * 32 + g4 * 8);
#pragma unroll
        for (int n = 0; n < 4; ++n) bfr[n] = *(const bf16x8*)(BT + (nh * 64 + n * 16 + r16) * SST + kk * 32 + g4 * 8);
#pragma unroll
        for (int m = 0; m < 4; ++m)
#pragma unroll
            for (int n = 0; n < 4; ++n) acc[m][n] = MFMA16(bfr[n], af[m], acc[m][n]);
    }
    float* st = (float*)(p.ws + WS_SSTATE) + (((size_t)b * 16 + c) * 8 + g * 4 + hl) * 8192;
#pragma unroll
    for (int m = 0; m < 4; ++m)
#pragma unroll
        for (int n = 0; n < 4; ++n) *(f32x4*)(st + (m * 16 + r16) * 128 + nh * 64 + n * 16 + g4 * 4) = acc[m][n];
}
DEVI void phase_ssd_scan(const Params& p) {
    const float* st = (const float*)(p.ws + WS_SSTATE);
    bf16_t* hin = (bf16_t*)(p.ws + WS_HIN);
    const float* decay = (const float*)(p.ws + WS_DECAY);
    const int total = NB * 8 * 2048;
    for (int i = BIDX() * NTHR + TIDX(); i < total; i += gridDim.x * NTHR) {
        const int e4 = i & 2047, head = (i >> 11) & 7, b = i >> 14;
        f32x4 h = (f32x4){0.f, 0.f, 0.f, 0.f};
        for (int c = 0; c < 16; ++c) {
            const size_t off = (((size_t)b * 16 + c) * 8 + head) * 8192 + e4 * 4;
            u32x2 w; w.x = cvt_pk(h[0], h[1]); w.y = cvt_pk(h[2], h[3]);
            *(u32x2*)(hin + off) = w;
            const f32x4 s = *(const f32x4*)(st + off);
            const float d = decay[((size_t)b * 16 + c) * 8 + head];
            h = h * d + s;
        }
    }
}
DEVI void ssd_out_task(const Params& p, int l, int b, int c, char* lds) {
    const int tid = TIDX(), wid = tid >> 6, lane = tid & 63, r16 = lane & 15, g4 = lane >> 4;
    const bf16_t* proj = (const bf16_t*)(p.ws + WS_PROJ);
    bf16_t* Cs = (bf16_t*)lds;
    bf16_t* Bs = Cs + 128 * SST;
    bf16_t* XT = Bs + 128 * SST;
    bf16_t* Hs = XT + 64 * SST;
    bf16_t* Mw = Hs + 64 * SST + wid * 16 * SST;
    float* acs = (float*)(Hs + 64 * SST + 8 * 16 * SST);
    float* dts = acs + 512;
    const int lrow = wid * 16 + r16;
    const size_t tok = (size_t)b * S + c * 128 + lrow;
    float* gbuf = (float*)(p.ws + WS_GBUF);
    float ssq = 0.f;
    for (int g = 0; g < 2; ++g) {
        __syncthreads();
        ssd_acs(p, l, b, c, g, acs, dts);
        for (int it = tid; it < 2048; it += NTHR) {
            const int ll = it >> 4, nc = (it & 15) * 8;
            float v[8];
            conv8_pos(p, l, proj, b, c * 128 + ll, 768 + g * 128 + nc, v);
            *(u32x4*)(Cs + ll * SST + nc) = pack8(v);
            conv8_pos(p, l, proj, b, c * 128 + ll, 512 + g * 128 + nc, v);
            *(u32x4*)(Bs + ll * SST + nc) = pack8(v);
        }
        __syncthreads();
        bf16x8 cfr[4];
#pragma unroll
        for (int kk = 0; kk < 4; ++kk) cfr[kk] = *(const bf16x8*)(Cs + lrow * SST + kk * 32 + g4 * 8);
        f32x4 cb[8];
#pragma unroll
        for (int st = 0; st < 8; ++st) {
            cb[st] = (f32x4){0.f, 0.f, 0.f, 0.f};
#pragma unroll
            for (int kk = 0; kk < 4; ++kk) {
                const bf16x8 bfr = *(const bf16x8*)(Bs + (st * 16 + r16) * SST + kk * 32 + g4 * 8);
                cb[st] = MFMA16(bfr, cfr[kk], cb[st]);
            }
        }
        for (int hl = 0; hl < 4; ++hl) {
            const int head = g * 4 + hl;
            __syncthreads();
            for (int it = tid; it < 1024; it += NTHR) {
                const int pp = it & 63, sc = it >> 6;
                float v[8]; conv8_chan(p, l, proj, b, c, g * 256 + hl * 64 + pp, sc * 8, v);
                *(u32x4*)(XT + pp * SST + sc * 8) = pack8(v);
                const bf16_t* hsrc = (const bf16_t*)(p.ws + WS_HIN) + (((size_t)b * 16 + c) * 8 + head) * 8192 + (size_t)it * 8;
                *(u32x4*)(Hs + (it >> 4) * SST + (it & 15) * 8) = *(const u32x4*)hsrc;
            }
            __syncthreads();
            const float al = acs[hl * 128 + lrow];
#pragma unroll
            for (int st = 0; st < 8; ++st) {
                float mv[4];
#pragma unroll
                for (int j = 0; j < 4; ++j) { const int sidx = st * 16 + g4 * 4 + j;
                    mv[j] = (sidx <= lrow) ? cb[st][j] * __expf(al - acs[hl * 128 + sidx]) * dts[hl * 128 + sidx] : 0.f; }
                u32x2 w; w.x = cvt_pk(mv[0], mv[1]); w.y = cvt_pk(mv[2], mv[3]);
                *(u32x2*)(Mw + r16 * SST + st * 16 + g4 * 4) = w;
            }
            __builtin_amdgcn_wave_barrier();
            asm volatile("s_waitcnt lgkmcnt(0)" ::: "memory");
            f32x4 yd[4], yo[4];
#pragma unroll
            for (int pt = 0; pt < 4; ++pt) { yd[pt] = (f32x4){0.f, 0.f, 0.f, 0.f}; yo[pt] = (f32x4){0.f, 0.f, 0.f, 0.f}; }
#pragma unroll
            for (int kk = 0; kk < 4; ++kk) {
                const bf16x8 mf = *(const bf16x8*)(Mw + r16 * SST + kk * 32 + g4 * 8);
#pragma unroll
                for (int pt = 0; pt < 4; ++pt) {
                    const bf16x8 xf = *(const bf16x8*)(XT + (pt * 16 + r16) * SST + kk * 32 + g4 * 8);
                    yd[pt] = MFMA16(xf, mf, yd[pt]);
                    const bf16x8 hf = *(const bf16x8*)(Hs + (pt * 16 + r16) * SST + kk * 32 + g4 * 8);
                    yo[pt] = MFMA16(hf, cfr[kk], yo[pt]);
                }
            }
            __builtin_amdgcn_wave_barrier();
            const float el = __expf(al), Dh = p.in[13][l * 8 + head];
#pragma unroll
            for (int pt = 0; pt < 4; ++pt) {
                const int pc = pt * 16 + g4 * 4;
                const u32x2 zw = *(const u32x2*)(proj + tok * NPROJ + C_Z + head * 64 + pc);
                const float zz[4] = {bflo(zw.x), bfhi(zw.x), bflo(zw.y), bfhi(zw.y)};
                f32x4 gv;
#pragma unroll
                for (int j = 0; j < 4; ++j) {
                    const float xv = bf2f(XT[(pc + j) * SST + lrow]);
                    const float yv = yd[pt][j] + el * yo[pt][j] + Dh * xv;
                    gv[j] = yv * silu_f(zz[j]);
                    ssq += gv[j] * gv[j];
                }
                *(f32x4*)(gbuf + tok * 512 + head * 64 + pc) = gv;
            }
        }
    }
    ssq += __shfl_xor(ssq, 16); ssq += __shfl_xor(ssq, 32);
    const float rstd = rsqrtf(ssq * (1.0f / 512.0f) + EPS);
    bf16_t* mix = (bf16_t*)(p.ws + WS_MIX);
#pragma unroll
    for (int head = 0; head < 8; ++head)
#pragma unroll
        for (int pt = 0; pt < 4; ++pt) {
            const int pc = pt * 16 + g4 * 4;
            const f32x4 gv = *(const f32x4*)(gbuf + tok * 512 + head * 64 + pc);
            u32x2 w; w.x = cvt_pk(gv[0] * rstd, gv[1] * rstd); w.y = cvt_pk(gv[2] * rstd, gv[3] * rstd);
            *(u32x2*)(mix + tok * DM + 512 + head * 64 + pc) = w;
        }
}

constexpr int N_FOX = 512, N_S1 = 256, N_DIL = 1536;
DEVI void phase_mix1(const Params& p, int l, char* lds) {
    unsigned char* ws = p.ws;
    const bf16_t* proj = (const bf16_t*)(ws + WS_PROJ);
    bf16_t* mix = (bf16_t*)(ws + WS_MIX);
    for (int t = BIDX(); t < N_FOX + N_S1 + N_DIL; t += gridDim.x) {
        if (t < N_FOX) {
            const int bh = t & 31, k = t >> 5;
            const int qb = k < 8 ? 15 - k : k - 8;
            const int b = bh >> 2, h = bh & 3;
            const float* cum = (const float*)(ws + WS_CUMF) + (size_t)bh * S;
            attn_task<64, 0>(proj + C_FQ + h * 64, NPROJ, b * S, 1, proj + C_FK + h * 64, proj + C_FV + h * 64, NPROJ, b * S, 1,
                             qb * 128, 0, 2 * qb + 2, 0.125f, cum, nullptr, mix + h * 64, DM, nullptr, nullptr, nullptr, lds);
        } else if (t < N_FOX + N_S1) {
            const int u = t - N_FOX, g = u & 1, c = (u >> 1) & 15, b = u >> 5;
            ssd_states_task(p, l, b, c, g, lds);
        } else {
            const int u = t - N_FOX - N_S1, bh = u & 31, v = u >> 5;
            const int b = bh >> 2, h = bh & 3;
            int br, dil, r, pb;
            if (v < 16) { br = 0; dil = 1; r = 0; pb = v; }
            else if (v < 32) { br = 1; dil = 4; r = (v - 16) & 3; pb = (v - 16) >> 2; }
            else { br = 2; dil = 16; r = v - 32; pb = 0; }
            float* Of = (float*)(ws + WS_DILO) + (size_t)br * T * 256 + h * 64;
            float* Om = (float*)(ws + WS_DILM) + (size_t)br * T * 4 + h;
            float* Ol = (float*)(ws + WS_DILL) + (size_t)br * T * 4 + h;
            const int klo = pb > 0 ? 2 * pb - 2 : 0;
            attn_task<64, 1>(proj + C_DQ + h * 64, NPROJ, b * S + r, dil, proj + C_DK + h * 64, proj + C_DV + h * 64, NPROJ, b * S + r, dil,
                             pb * 128, klo, 2 * pb + 2, 0.125f, nullptr, nullptr, nullptr, 0, Of, Om, Ol, lds);
        }
    }
}
DEVI void phase_mix3(const Params& p, int l, char* lds) {
    unsigned char* ws = p.ws;
    for (int t = BIDX(); t < NB * 16; t += gridDim.x) ssd_out_task(p, l, t >> 4, t & 15, lds);
    const int tid = TIDX(), wid = tid >> 6, lane = tid & 63, head = lane >> 4, d4 = (lane & 15) * 4;
    const float* Of = (const float*)(ws + WS_DILO);
    const float* Om = (const float*)(ws + WS_DILM);
    const float* Ol = (const float*)(ws + WS_DILL);
    bf16_t* mix = (bf16_t*)(ws + WS_MIX);
    for (int row = ((BIDX() + gridDim.x - 128) % gridDim.x) * 8 + wid; row < T; row += gridDim.x * 8) {
        float m[3], lsum[3];
#pragma unroll
        for (int br = 0; br < 3; ++br) { m[br] = Om[((size_t)br * T + row) * 4 + head]; lsum[br] = Ol[((size_t)br * T + row) * 4 + head]; }
        const float M = fmaxf(m[0], fmaxf(m[1], m[2]));
        f32x4 num = (f32x4){0.f, 0.f, 0.f, 0.f}; float den = 0.f;
#pragma unroll
        for (int br = 0; br < 3; ++br) {
            const float w = __expf(m[br] - M);
            const f32x4 o = *(const f32x4*)(Of + ((size_t)br * T + row) * 256 + head * 64 + d4);
            num += o * w; den += w * lsum[br];
        }
        const float inv = 1.0f / den;
        u32x2 w; w.x = cvt_pk(num[0] * inv, num[1] * inv); w.y = cvt_pk(num[2] * inv, num[3] * inv);
        *(u32x2*)(mix + (size_t)row * DM + 256 + head * 64 + d4) = w;
    }
}
DEVI void phase_xattn(const Params& p, int l, char* lds) {
    unsigned char* ws = p.ws;
    const bf16_t* qbuf = (const bf16_t*)(ws + WS_QBUF);
    const bf16_t* kv = (const bf16_t*)(ws + WS_KV);
    bf16_t* obuf = (bf16_t*)(ws + WS_OBUF);
    for (int t = BIDX(); t < NB * 4 * 16; t += gridDim.x) {
        const int qb = t & 15, h = (t >> 4) & 3, b = t >> 6;
        attn_task<256, 2>(qbuf + h * 256, DM, b * S, 1, kv + h * 256, kv + DM + h * 256, 2 * DM, b * MEMLEN, 1,
                          qb * 128, 0, 4, 0.0625f, nullptr, p.in[20] + l * 256, obuf + h * 256, DM, nullptr, nullptr, nullptr, lds);
    }
}
struct AMapGather { const bf16_t* A; int K; const int* ent; int nvalid; int shift;
    DEVI const bf16_t* operator()(int r) const { const int e = ent[r < nvalid ? r : 0]; return A + (size_t)(e >> shift) * K; } };
struct EpiSwiglu { bf16_t* act; const int* ent; int nvalid; int col0;
    DEVI void operator()(const f32x4 (&acc)[4][4], int rb, int cb) const {
#pragma unroll
        for (int m = 0; m < 4; ++m) {
            const int r = rb + m * 16;
            if (r < nvalid) {
                const int a = ent[r];
#pragma unroll
                for (int np = 0; np < 2; ++np) {
                    const f32x4 x1 = acc[m][2 * np], x3 = acc[m][2 * np + 1];
                    float o[4];
#pragma unroll
                    for (int j = 0; j < 4; ++j) o[j] = silu_f(x1[j]) * x3[j];
                    const int cg = col0 + (cb & 64) + np * 32;
                    u32x2 w; w.x = cvt_pk(o[0], o[1]); w.y = cvt_pk(o[2], o[3]);
                    *(u32x2*)(act + (size_t)a * EFF + (cg >> 1) + (cb & 15)) = w;
                }
            }
        }
    } };
struct EpiMoeOut { bf16_t* y; const int* ent; const float* gate; int nvalid; int col0;
    DEVI void operator()(const f32x4 (&acc)[4][4], int rb, int cb) const {
#pragma unroll
        for (int m = 0; m < 4; ++m) {
            const int r = rb + m * 16;
            if (r < nvalid) {
                const int a = ent[r]; const float gt = gate[a];
#pragma unroll
                for (int n = 0; n < 4; ++n) { u32x2 w; w.x = cvt_pk(acc[m][n][0] * gt, acc[m][n][1] * gt); w.y = cvt_pk(acc[m][n][2] * gt, acc[m][n][3] * gt);
                    *(u32x2*)(y + (size_t)a * DM + col0 + cb + n * 16) = w; }
            }
        }
    } };
template <int WHICH>
DEVI void phase_moe(const Params& p, int l, char* lds) {
    unsigned char* ws = p.ws;
    const int* cnt = (const int*)(ws + WS_CNT) + l * 64;
    const int* list = (const int*)(ws + WS_LIST);
    int ubase = 0;
    for (int e = 0; e < NEXP; ++e) {
        const int ce = cnt[e], ntile = (ce + G_BM - 1) / G_BM, nun = ntile * 8;
        int u = ubase + ((BIDX() - ubase % (int)gridDim.x) + gridDim.x) % gridDim.x;
        for (; u < ubase + nun; u += gridDim.x) {
            const int lu = u - ubase, pm = lu >> 3, pn = lu & 7;
            const int* ent = list + (size_t)e * (2 * T) + pm * G_BM;
            const int nvalid = ce - pm * G_BM;
            if (WHICH == 0) {
                AMapGather am{(const bf16_t*)(ws + WS_HBUF), DM, ent, nvalid, 1};
                EpiSwiglu ep{(bf16_t*)(ws + WS_ACT), ent, nvalid, pn * G_BN};
                gemm_tile(am, (const bf16_t*)(ws + WS_W_13) + ((size_t)e * 1024 + pn * G_BN) * DM, DM, ep, lds);
            } else {
                AMapGather am{(const bf16_t*)(ws + WS_ACT), EFF, ent, nvalid, 0};
                EpiMoeOut ep{(bf16_t*)(ws + WS_YBUF), ent, (const float*)(ws + WS_GATE), nvalid, pn * G_BN};
                gemm_tile(am, (const bf16_t*)(ws + WS_W_2) + ((size_t)e * DM + pn * G_BN) * EFF, EFF, ep, lds);
            }
        }
        ubase += nun;
    }
}
DEVI void phase_final(const Params& p) {
    const int tid = TIDX(), wid = tid >> 6, lane = tid & 63;
    const bf16_t* ybuf = (const bf16_t*)(p.ws + WS_YBUF);
    for (int row = BIDX() * 8 + wid; row < T; row += gridDim.x * 8) {
        float x[16];
        load_row_f32(p.out + (size_t)row * DM, x, lane);
        add_row_bf16(ybuf + (size_t)(2 * row) * DM, x, lane);
        add_row_bf16(ybuf + (size_t)(2 * row + 1) * DM, x, lane);
        store_row_f32(p.out + (size_t)row * DM, x, lane);
    }
}

constexpr int N_PHASES = 30;
typedef __attribute__((address_space(4))) const unsigned long long* karg_ptr;
DEVI Params load_params(karg_ptr kp) {
    Params q;
    unsigned long long* d = (unsigned long long*)&q;
#pragma unroll
    for (int i = 0; i < (int)(sizeof(Params) / 8); ++i) d[i] = kp[i];
    return q;
}
__global__ void __launch_bounds__(NTHR) hybrid_fwd(Params p_unused) {
    extern __shared__ __attribute__((aligned(16))) char lds[];
    karg_ptr kp = (karg_ptr)__builtin_amdgcn_kernarg_segment_ptr();
    int ph_lo, ph_hi, use_gs;
    { const Params q = load_params(kp); ph_lo = q.ph_lo; ph_hi = q.ph_hi; use_gs = q.use_grid_sync; }
    for (int ph = ph_lo; ph < ph_hi; ++ph) {
        if (ph > ph_lo) { if (use_gs) cg::this_grid().sync(); }
        asm volatile("" : "+s"(kp) :: "memory");
        const Params p = load_params(kp);
        unsigned char* ws = p.ws;
        if (ph == 0) {
            prep_small(p);
            for (int u = BIDX(); u < PREP_UNITS; u += gridDim.x) prep_unit(p, 0, u, (float*)lds);
        } else if (ph == 29) {
            phase_final(p);
        } else {
            const int l = (ph - 1) / 14, s = (ph - 1) % 14;
            const float* x_in = l == 0 ? p.in[0] : p.out;
            float* x1 = l == 0 ? p.out : (float*)(ws + WS_XB);
            float* x2 = l == 0 ? (float*)(ws + WS_XB) : p.out;
            switch (s) {
            case 0:
                if (l == 1) for (int u = BIDX(); u < PREP_UNITS; u += gridDim.x) prep_unit(p, 1, u, (float*)lds);
                __syncthreads();
                phase_norm1(p, l, lds); break;
            case 1: phase_inproj(p, l, lds); break;
            case 2: phase_post(p, l); break;
            case 3: phase_mix1(p, l, lds); break;
            case 4: phase_ssd_scan(p); break;
            case 5: phase_mix3(p, l, lds); break;
            case 6: { auto mk = [&](int r0, int c0) { return EpiResF32{x_in + (size_t)r0 * DM + c0, x1 + (size_t)r0 * DM + c0, DM}; };
                      gemm_dense_units((const bf16_t*)(ws + WS_MIX), (const bf16_t*)(ws + WS_W_OUT), T, DM, DM, mk, lds, BIDX(), gridDim.x); } break;
            case 7: phase_norm2(p, l, x1); break;
            case 8: { bf16_t* qb = (bf16_t*)(ws + WS_QBUF);
                      auto mk = [&](int r0, int c0) { return EpiBf16Out{qb + (size_t)r0 * DM + c0, DM}; };
                      gemm_dense_units((const bf16_t*)(ws + WS_HBUF), (const bf16_t*)(ws + WS_W_Q), T, DM, DM, mk, lds, BIDX(), gridDim.x); } break;
            case 9: phase_xattn(p, l, lds); break;
            case 10: { auto mk = [&](int r0, int c0) { return EpiResF32{x1 + (size_t)r0 * DM + c0, x2 + (size_t)r0 * DM + c0, DM}; };
                       gemm_dense_units((const bf16_t*)(ws + WS_OBUF), (const bf16_t*)(ws + WS_W_O), T, DM, DM, mk, lds, BIDX(), gridDim.x); } break;
            case 11: phase_norm3(p, l, x2, lds); break;
            case 12: phase_moe<0>(p, l, lds); break;
            case 13: phase_moe<1>(p, l, lds); break;
            }
        }
    }
}

extern "C" void kernel_launch(void* const* d_in, const int* in_sizes, int n_in, void* d_out, int out_size, void* d_ws, size_t ws_size, hipStream_t stream) {
    static int grid = 0;
    if (grid == 0) {
        if (n_in != 31 || out_size != T * DM || ws_size < WS_END) { fprintf(stderr, "kernel_launch: unexpected shapes (n_in %d out %d ws %zu need %zu)\n", n_in, out_size, ws_size, (size_t)WS_END); grid = -1; return; }
        int dev = 0, cus = 0, per_cu = 0;
        hipGetDevice(&dev);
        hipDeviceGetAttribute(&cus, hipDeviceAttributeMultiprocessorCount, dev);
        hipFuncSetAttribute((const void*)hybrid_fwd, hipFuncAttributeMaxDynamicSharedMemorySize, LDS_BYTES);
        hipOccupancyMaxActiveBlocksPerMultiprocessor(&per_cu, (const void*)hybrid_fwd, NTHR, LDS_BYTES);
        if (per_cu < 1) { fprintf(stderr, "kernel_launch: occupancy query says %d blocks per CU\n", per_cu); per_cu = 1; }
        (void)hipGetLastError();
        grid = cus;
    }
    if (grid < 0) return;
    Params p{};
    for (int i = 0; i < 31; ++i) p.in[i] = (const float*)d_in[i];
    p.out = (float*)d_out; p.ws = (unsigned char*)d_ws;
    p.use_grid_sync = 1; p.pad = 0;
    p.ph_lo = 0; p.ph_hi = N_PHASES;
    void* args[] = {&p};
    hipError_t e = hipLaunchCooperativeKernel((const void*)hybrid_fwd, dim3(grid), dim3(NTHR), args, LDS_BYTES, stream);
    if (e != hipSuccess) fprintf(stderr, "kernel_launch: cooperative launch failed: %s (grid %d)\n", hipGetErrorString(e), grid);
}
```

```cpp
#include <hip/hip_runtime.h>
#include <hip/hip_cooperative_groups.h>
#include <cstdio>
#include <cstdint>
namespace cg = cooperative_groups;

typedef unsigned short bf16_t;
typedef short bf16x8 __attribute__((ext_vector_type(8)));
typedef short s16x4 __attribute__((ext_vector_type(4)));
typedef float f32x4 __attribute__((ext_vector_type(4)));
typedef unsigned u32x4 __attribute__((ext_vector_type(4)));
typedef unsigned u32x2 __attribute__((ext_vector_type(2)));
#define DEVI __device__ __forceinline__
#define LAS __attribute__((address_space(3)))

constexpr int NB = 8, S = 2048, DM = 1024, T = NB * S, DEPTH = 2;
constexpr int INP = 3084, NPROJ = 3072;
constexpr int C_FQ = 0, C_FK = 256, C_FV = 512, C_DQ = 768, C_DK = 1024, C_DV = 1280, C_Z = 1536, C_XBC = 2048;
constexpr int MEMLEN = 256, MROWS = NB * MEMLEN;
constexpr int NEXP = 32, EFF = 512;
constexpr float EPS = 1e-6f;
constexpr int NTHR = 512;
constexpr int LDS_BYTES = 151552;

constexpr size_t al256(size_t x) { return (x + 255) & ~(size_t)255; }
constexpr size_t WS_W_IN = 0;
constexpr size_t WS_W_OUT = WS_W_IN + (size_t)NPROJ * DM * 2;
constexpr size_t WS_W_Q = WS_W_OUT + (size_t)DM * DM * 2;
constexpr size_t WS_W_KV = WS_W_Q + (size_t)DM * DM * 2;
constexpr size_t WS_W_O = WS_W_KV + (size_t)2 * DM * DM * 2;
constexpr size_t WS_W_13 = WS_W_O + (size_t)DM * DM * 2;
constexpr size_t WS_W_2 = WS_W_13 + (size_t)NEXP * 1024 * DM * 2;
constexpr size_t WS_WSMALL = WS_W_2 + (size_t)NEXP * DM * EFF * 2;
constexpr size_t WS_WROUT = WS_WSMALL + (size_t)DEPTH * 12 * DM * 4;
constexpr size_t WS_XB = WS_WROUT + (size_t)DEPTH * 36 * DM * 4;
constexpr size_t WS_HBUF = WS_XB + (size_t)T * DM * 4;
constexpr size_t WS_PROJ = WS_HBUF + (size_t)T * DM * 2;
constexpr size_t WS_QBUF = WS_PROJ;
constexpr size_t WS_OBUF = WS_PROJ + (size_t)T * DM * 2;
constexpr size_t WS_ACT = WS_PROJ;
constexpr size_t WS_MIX = WS_PROJ + (size_t)T * NPROJ * 2;
constexpr size_t WS_U = WS_MIX + (size_t)T * DM * 2;
constexpr size_t WS_YBUF = WS_U;
constexpr size_t WS_DILO = WS_U;
constexpr size_t WS_DILM = WS_DILO + (size_t)3 * T * 256 * 4;
constexpr size_t WS_DILL = WS_DILM + (size_t)3 * T * 4 * 4;
constexpr size_t WS_SSTATE = WS_DILL + (size_t)3 * T * 4 * 4;
constexpr size_t WS_HIN = WS_SSTATE + (size_t)NB * 16 * 8 * 8192 * 4;
constexpr size_t WS_GBUF = WS_HIN + (size_t)NB * 16 * 8 * 8192 * 2;
constexpr size_t WS_U_END = WS_GBUF + (size_t)T * 512 * 4;
constexpr size_t WS_MEMN = WS_U_END;
constexpr size_t WS_KV = WS_MEMN + (size_t)MROWS * DM * 2;
constexpr size_t WS_LOGF = WS_KV + (size_t)MROWS * 2 * DM * 2;
constexpr size_t WS_CUMF = WS_LOGF + (size_t)T * 4 * 4;
constexpr size_t WS_DTV = WS_CUMF + (size_t)T * 4 * 4;
constexpr size_t WS_DECAY = WS_DTV + (size_t)T * 8 * 4;
constexpr size_t WS_CNT = WS_DECAY + (size_t)NB * 16 * 8 * 4;
constexpr size_t WS_LIST = WS_CNT + 1024;
constexpr size_t WS_GATE = WS_LIST + (size_t)NEXP * 2 * T * 4;
constexpr size_t WS_BAR = WS_GATE + (size_t)2 * T * 4;
constexpr size_t WS_END = WS_BAR + 65536;
static_assert(WS_YBUF + (size_t)2 * T * DM * 2 <= WS_U_END, "ybuf alias");
static_assert(WS_OBUF + (size_t)T * DM * 2 <= WS_MIX, "obuf alias");

struct Params {
    const float* in[31];
    float* out;
    unsigned char* ws;
    int ph_lo, ph_hi;
    int use_grid_sync, pad;
};

DEVI int TIDX() { int t = threadIdx.x; asm volatile("" : "+v"(t)); return t; }
DEVI int BIDX() { int b = blockIdx.x; asm volatile("" : "+s"(b)); return b; }
DEVI float bf2f(bf16_t v) { return __uint_as_float(((unsigned)v) << 16); }
typedef float f32x2 __attribute__((ext_vector_type(2)));
typedef __bf16 bf16x2_t __attribute__((ext_vector_type(2)));
DEVI unsigned cvt_pk(float lo, float hi) { f32x2 v = {lo, hi}; bf16x2_t b = __builtin_convertvector(v, bf16x2_t); return __builtin_bit_cast(unsigned, b); }
DEVI bf16_t f2bf(float f) { return (bf16_t)(cvt_pk(f, 0.f) & 0xffffu); }
DEVI float bflo(unsigned w) { return __uint_as_float(w << 16); }
DEVI float bfhi(unsigned w) { return __uint_as_float(w & 0xffff0000u); }
DEVI float wave_sum(float v) {
#pragma unroll
    for (int m = 32; m >= 1; m >>= 1) v += __shfl_xor(v, m);
    return v;
}
DEVI float silu_f(float x) { return x / (1.f + __expf(-x)); }
DEVI float softplus_f(float x) { return x > 20.f ? x : log1pf(__expf(x)); }
DEVI float logsigmoid_f(float x) { return x >= 0.f ? -log1pf(__expf(-x)) : x - log1pf(__expf(x)); }
#define MFMA16(a, b, c) __builtin_amdgcn_mfma_f32_16x16x32_bf16(a, b, c, 0, 0, 0)
DEVI s16x4 tr_read(const bf16_t* p) {
    return __builtin_bit_cast(s16x4, __builtin_amdgcn_ds_read_tr16_b64_v4i16((LAS s16x4*)p));
}

DEVI int maprow(int mode, int n) { return mode == 0 ? n : ((n >> 4) * 32 + (n & 15) + (mode == 2 ? 16 : 0)); }
DEVI void prep_tile(const float* __restrict__ src, int ld, int k0, int c0, bf16_t* __restrict__ dst, int dstld, int mode, int n0,
                    const float* __restrict__ kscale, int ks_from, float* tl) {
    const int tid = TIDX();
#pragma unroll
    for (int i = 0; i < 2; ++i) {
        const int k = (tid >> 4) + 32 * i, n4 = (tid & 15) * 4;
        const float4 v = *(const float4*)(src + (size_t)(k0 + k) * ld + c0 + n4);
        float sc = 1.f;
        if (kscale != nullptr && (k0 + k) >= ks_from) sc = kscale[k0 + k - ks_from];
        tl[k * 65 + n4 + 0] = v.x * sc; tl[k * 65 + n4 + 1] = v.y * sc; tl[k * 65 + n4 + 2] = v.z * sc; tl[k * 65 + n4 + 3] = v.w * sc;
    }
    __syncthreads();
    {
        const int n = tid >> 3, kc = (tid & 7) * 8;
        u32x4 w;
        w.x = cvt_pk(tl[(kc + 0) * 65 + n], tl[(kc + 1) * 65 + n]);
        w.y = cvt_pk(tl[(kc + 2) * 65 + n], tl[(kc + 3) * 65 + n]);
        w.z = cvt_pk(tl[(kc + 4) * 65 + n], tl[(kc + 5) * 65 + n]);
        w.w = cvt_pk(tl[(kc + 6) * 65 + n], tl[(kc + 7) * 65 + n]);
        const int drow = maprow(mode, n0 + n);
        *(u32x4*)(dst + (size_t)drow * dstld + k0 + kc) = w;
    }
    __syncthreads();
}

constexpr int PREP_UNITS = 2048 + 3 * 4096;
DEVI void prep_unit(const Params& p, int l, int u, float* tl) {
    unsigned char* ws = p.ws;
    if (u < 768) {
        const int kt = u / 48, nt = u % 48, n0 = nt * 64, c0 = n0 < 768 ? n0 : n0 + 4;
        prep_tile(p.in[3] + (size_t)l * DM * INP, INP, kt * 64, c0, (bf16_t*)(ws + WS_W_IN), DM, 0, n0, nullptr, 0, tl);
    } else if (u < 1024) {
        const int v = u - 768, kt = v / 16, nt = v % 16;
        prep_tile(p.in[15] + (size_t)l * DM * DM, DM, kt * 64, nt * 64, (bf16_t*)(ws + WS_W_OUT), DM, 0, nt * 64, p.in[14] + l * 512, 512, tl);
    } else if (u < 1280) {
        const int v = u - 1024, kt = v / 16, nt = v % 16;
        prep_tile(p.in[18] + (size_t)l * DM * DM, DM, kt * 64, nt * 64, (bf16_t*)(ws + WS_W_Q), DM, 0, nt * 64, nullptr, 0, tl);
    } else if (u < 1792) {
        const int v = u - 1280, kt = v / 32, nt = v % 32;
        prep_tile(p.in[19] + (size_t)l * DM * 2 * DM, 2 * DM, kt * 64, nt * 64, (bf16_t*)(ws + WS_W_KV), DM, 0, nt * 64, nullptr, 0, tl);
    } else if (u < 2048) {
        const int v = u - 1792, kt = v / 16, nt = v % 16;
        prep_tile(p.in[22] + (size_t)l * DM * DM, DM, kt * 64, nt * 64, (bf16_t*)(ws + WS_W_O), DM, 0, nt * 64, nullptr, 0, tl);
    } else if (u < 2048 + 8192) {
        const int v = u - 2048, which = v / 4096, w = v % 4096, e = w / 128, tI = w % 128, kt = tI / 8, nt = tI % 8;
        const float* src = (which == 0 ? p.in[28] : p.in[29]) + ((size_t)l * NEXP + e) * DM * EFF;
        prep_tile(src, EFF, kt * 64, nt * 64, (bf16_t*)(ws + WS_W_13) + (size_t)e * 1024 * DM, DM, which == 0 ? 1 : 2, nt * 64, nullptr, 0, tl);
    } else {
        const int w = u - 2048 - 8192, e = w / 128, tI = w % 128, kt = tI / 16, nt = tI % 16;
        const float* src = p.in[30] + ((size_t)l * NEXP + e) * EFF * DM;
        prep_tile(src, DM, kt * 64, nt * 64, (bf16_t*)(ws + WS_W_2) + (size_t)e * DM * EFF, EFF, 0, nt * 64, nullptr, 0, tl);
    }
}
DEVI void prep_small(const Params& p) {
    float* wsm = (float*)(p.ws + WS_WSMALL);
    float* wro = (float*)(p.ws + WS_WROUT);
    const int gtid = BIDX() * NTHR + TIDX(), gn = gridDim.x * NTHR;
    for (int i = gtid; i < DEPTH * 12 * DM; i += gn) {
        const int l = i / (12 * DM), r = i % (12 * DM), c = r / DM, k = r % DM;
        const int col = c < 4 ? 768 + c : 3076 + (c - 4);
        wsm[i] = p.in[3][((size_t)l * DM + k) * INP + col];
    }
    for (int i = gtid; i < DEPTH * 36 * DM; i += gn) {
        const int l = i / (36 * DM), r = i % (36 * DM), c = r / DM, k = r % DM;
        wro[i] = c < 4 ? p.in[24][((size_t)l * DM + k) * 4 + c] : p.in[26][((size_t)l * DM + k) * 32 + (c - 4)];
    }
    if (BIDX() == 0 && TIDX() < 128) ((int*)(p.ws + WS_CNT))[TIDX()] = 0;
}

DEVI void store_h_bf16(bf16_t* hrow, const float (&h)[16], int lane) {
#pragma unroll
    for (int j = 0; j < 4; ++j) {
        u32x2 w; w.x = cvt_pk(h[4 * j], h[4 * j + 1]); w.y = cvt_pk(h[4 * j + 2], h[4 * j + 3]);
        *(u32x2*)(hrow + j * 256 + lane * 4) = w;
    }
}
DEVI void load_row_f32(const float* xr, float (&x)[16], int lane) {
#pragma unroll
    for (int j = 0; j < 4; ++j) { const float4 v = *(const float4*)(xr + j * 256 + lane * 4); x[4 * j] = v.x; x[4 * j + 1] = v.y; x[4 * j + 2] = v.z; x[4 * j + 3] = v.w; }
}
DEVI void add_row_bf16(const bf16_t* yr, float (&x)[16], int lane) {
#pragma unroll
    for (int j = 0; j < 4; ++j) { const u32x2 w = *(const u32x2*)(yr + j * 256 + lane * 4); x[4 * j] += bflo(w.x); x[4 * j + 1] += bfhi(w.x); x[4 * j + 2] += bflo(w.y); x[4 * j + 3] += bfhi(w.y); }
}
DEVI void store_row_f32(float* xr, const float (&x)[16], int lane) {
#pragma unroll
    for (int j = 0; j < 4; ++j) *(float4*)(xr + j * 256 + lane * 4) = make_float4(x[4 * j], x[4 * j + 1], x[4 * j + 2], x[4 * j + 3]);
}
DEVI void norm_row(const float (&x)[16], const float* g, float (&h)[16], int lane) {
    float ss = 0.f;
#pragma unroll
    for (int i = 0; i < 16; ++i) ss += x[i] * x[i];
    ss = wave_sum(ss);
    const float rstd = rsqrtf(ss * (1.0f / DM) + EPS);
#pragma unroll
    for (int j = 0; j < 4; ++j) { const float4 gv = *(const float4*)(g + j * 256 + lane * 4);
        h[4 * j] = x[4 * j] * rstd * gv.x; h[4 * j + 1] = x[4 * j + 1] * rstd * gv.y; h[4 * j + 2] = x[4 * j + 2] * rstd * gv.z; h[4 * j + 3] = x[4 * j + 3] * rstd * gv.w; }
}
DEVI float dot_lds(const float (&h)[16], const float* wrow, int lane) {
    float a = 0.f;
#pragma unroll
    for (int j = 0; j < 4; ++j) { const float4 w = *(const float4*)(wrow + j * 256 + lane * 4); a += h[4 * j] * w.x + h[4 * j + 1] * w.y + h[4 * j + 2] * w.z + h[4 * j + 3] * w.w; }
    return a;
}

DEVI void phase_norm1(const Params& p, int l, char* lds) {
    const int tid = TIDX(), wid = tid >> 6, lane = tid & 63;
    unsigned char* ws = p.ws;
    float* wsl = (float*)lds;
    { const float4* src = (const float4*)((const float*)(ws + WS_WSMALL) + (size_t)l * 12 * DM);
      for (int i = tid; i < 12 * DM / 4; i += NTHR) ((float4*)wsl)[i] = src[i]; }
    __syncthreads();
    const float* xin = l == 0 ? p.in[0] : (const float*)(ws + WS_XB);
    float* xout = p.out;
    const bf16_t* ybuf = (const bf16_t*)(ws + WS_YBUF);
    bf16_t* hbuf = (bf16_t*)(ws + WS_HBUF);
    const float* g1 = p.in[2] + l * DM;
    float* logf = (float*)(ws + WS_LOGF);
    float* dtv = (float*)(ws + WS_DTV);
    for (int row = BIDX() * 8 + wid; row < T; row += gridDim.x * 8) {
        float x[16], h[16];
        load_row_f32(xin + (size_t)row * DM, x, lane);
        if (l > 0) {
            add_row_bf16(ybuf + (size_t)(2 * row) * DM, x, lane);
            add_row_bf16(ybuf + (size_t)(2 * row + 1) * DM, x, lane);
            store_row_f32(xout + (size_t)row * DM, x, lane);
        }
        norm_row(x, g1, h, lane);
        store_h_bf16(hbuf + (size_t)row * DM, h, lane);
        float keep = 0.f;
#pragma unroll 2
        for (int c = 0; c < 12; ++c) { const float v = wave_sum(dot_lds(h, wsl + c * DM, lane)); keep = (lane == c) ? v : keep; }
        if (lane < 4) logf[(size_t)row * 4 + lane] = logsigmoid_f(keep + p.in[4][l * 4 + lane]);
        else if (lane < 12) dtv[(size_t)row * 8 + lane - 4] = softplus_f(keep + p.in[11][l * 8 + lane - 4]);
    }
    const float* gm = p.in[17] + l * DM;
    bf16_t* memn = (bf16_t*)(ws + WS_MEMN);
    for (int row = BIDX() * 8 + wid; row < MROWS; row += gridDim.x * 8) {
        float x[16], h[16];
        load_row_f32(p.in[1] + (size_t)row * DM, x, lane);
        norm_row(x, gm, h, lane);
        store_h_bf16(memn + (size_t)row * DM, h, lane);
    }
}
DEVI void phase_norm2(const Params& p, int l, const float* xin) {
    const int tid = TIDX(), wid = tid >> 6, lane = tid & 63;
    bf16_t* hbuf = (bf16_t*)(p.ws + WS_HBUF);
    const float* g = p.in[16] + l * DM;
    for (int row = BIDX() * 8 + wid; row < T; row += gridDim.x * 8) {
        float x[16], h[16];
        load_row_f32(xin + (size_t)row * DM, x, lane);
        norm_row(x, g, h, lane);
        store_h_bf16(hbuf + (size_t)row * DM, h, lane);
    }
}
DEVI void phase_norm3(const Params& p, int l, const float* xin, char* lds) {
    const int tid = TIDX(), wid = tid >> 6, lane = tid & 63;
    unsigned char* ws = p.ws;
    float* wr = (float*)lds;
    { const float4* src = (const float4*)((const float*)(ws + WS_WROUT) + (size_t)l * 36 * DM);
      for (int i = tid; i < 36 * DM / 4; i += NTHR) ((float4*)wr)[i] = src[i]; }
    __syncthreads();
    bf16_t* hbuf = (bf16_t*)(ws + WS_HBUF);
    const float* g = p.in[23] + l * DM;
    int* cnt = (int*)(ws + WS_CNT) + l * 64;
    int* list = (int*)(ws + WS_LIST);
    float* gate = (float*)(ws + WS_GATE);
    const float* bg = p.in[25] + l * 4;
    const float* be = p.in[27] + l * 32;
    for (int row = BIDX() * 8 + wid; row < T; row += gridDim.x * 8) {
        float x[16], h[16];
        load_row_f32(xin + (size_t)row * DM, x, lane);
        norm_row(x, g, h, lane);
        store_h_bf16(hbuf + (size_t)row * DM, h, lane);
        float gl[4];
#pragma unroll
        for (int c = 0; c < 4; ++c) gl[c] = wave_sum(dot_lds(h, wr + c * DM, lane)) + bg[c];
        int gsel = 0; float gmax = gl[0];
#pragma unroll
        for (int c = 1; c < 4; ++c) if (gl[c] > gmax) { gmax = gl[c]; gsel = c; }
        float gden = 0.f;
#pragma unroll
        for (int c = 0; c < 4; ++c) gden += __expf(gl[c] - gmax);
        const float ggate = 1.0f / gden;
        gsel = __builtin_amdgcn_readfirstlane(gsel);
        float el[8];
#pragma unroll
        for (int c = 0; c < 8; ++c) el[c] = wave_sum(dot_lds(h, wr + (4 + gsel * 8 + c) * DM, lane)) + be[gsel * 8 + c];
        int i1 = 0; float v1 = el[0];
#pragma unroll
        for (int c = 1; c < 8; ++c) if (el[c] > v1) { v1 = el[c]; i1 = c; }
        int i2 = (i1 == 0) ? 1 : 0; float v2 = -3.0e38f;
#pragma unroll
        for (int c = 0; c < 8; ++c) if (c != i1 && el[c] > v2) { v2 = el[c]; i2 = c; }
        const float e2 = __expf(v2 - v1), inv = 1.0f / (1.0f + e2);
        const float ga = inv * ggate, gb = e2 * inv * ggate;
        if (lane == 0) {
            const int ea = gsel * 8 + i1, eb = gsel * 8 + i2;
            const int sa = atomicAdd(&cnt[ea], 1);
            list[(size_t)ea * (2 * T) + sa] = 2 * row;
            const int sb = atomicAdd(&cnt[eb], 1);
            list[(size_t)eb * (2 * T) + sb] = 2 * row + 1;
            gate[2 * row] = ga; gate[2 * row + 1] = gb;
        }
    }
}

constexpr int G_BM = 256, G_BN = 128, G_BK = 64, G_ST = 72;
constexpr int G_ABUF = G_BM * G_ST, G_BBUF = G_BN * G_ST;
template <class AMap, class Epi>
DEVI void gemm_tile(const AMap& amap, const bf16_t* __restrict__ Bt, int K, const Epi& epi, char* lds) {
    const int tid = TIDX(), wid = tid >> 6, lane = tid & 63, r16 = lane & 15, g4 = lane >> 4;
    const int wr = wid >> 1, wc = wid & 1;
    bf16_t* As = (bf16_t*)lds;
    bf16_t* Bs = As + 2 * G_ABUF;
    const int srow = tid >> 3, skc = (tid & 7) * 8;
    const bf16_t* ap[4];
#pragma unroll
    for (int i = 0; i < 4; ++i) ap[i] = amap(srow + 64 * i) + skc;
    const bf16_t* bp[2];
#pragma unroll
    for (int i = 0; i < 2; ++i) bp[i] = Bt + (size_t)(srow + 64 * i) * K + skc;
    u32x4 ra[4], rb[2];
#pragma unroll
    for (int i = 0; i < 4; ++i) ra[i] = *(const u32x4*)(ap[i]);
#pragma unroll
    for (int i = 0; i < 2; ++i) rb[i] = *(const u32x4*)(bp[i]);
    f32x4 acc[4][4];
#pragma unroll
    for (int m = 0; m < 4; ++m)
#pragma unroll
        for (int n = 0; n < 4; ++n) acc[m][n] = (f32x4){0.f, 0.f, 0.f, 0.f};
    const int nt = K / G_BK;
    for (int t = 0; t < nt; ++t) {
        bf16_t* Ab = As + (t & 1) * G_ABUF;
        bf16_t* Bb = Bs + (t & 1) * G_BBUF;
#pragma unroll
        for (int i = 0; i < 4; ++i) *(u32x4*)(Ab + (srow + 64 * i) * G_ST + skc) = ra[i];
#pragma unroll
        for (int i = 0; i < 2; ++i) *(u32x4*)(Bb + (srow + 64 * i) * G_ST + skc) = rb[i];
        __syncthreads();
        if (t + 1 < nt) {
#pragma unroll
            for (int i = 0; i < 4; ++i) ra[i] = *(const u32x4*)(ap[i] + (size_t)(t + 1) * G_BK);
#pragma unroll
            for (int i = 0; i < 2; ++i) rb[i] = *(const u32x4*)(bp[i] + (size_t)(t + 1) * G_BK);
        }
#pragma unroll
        for (int kk = 0; kk < 2; ++kk) {
            bf16x8 af[4], bfr[4];
#pragma unroll
            for (int m = 0; m < 4; ++m) af[m] = *(const bf16x8*)(Ab + (wr * 64 + m * 16 + r16) * G_ST + kk * 32 + g4 * 8);
#pragma unroll
            for (int n = 0; n < 4; ++n) bfr[n] = *(const bf16x8*)(Bb + (wc * 64 + n * 16 + r16) * G_ST + kk * 32 + g4 * 8);
#pragma unroll
            for (int m = 0; m < 4; ++m)
#pragma unroll
                for (int n = 0; n < 4; ++n) acc[m][n] = MFMA16(bfr[n], af[m], acc[m][n]);
        }
    }
    epi(acc, wr * 64 + r16, wc * 64 + g4 * 4);
    __syncthreads();
}

struct AMapDense { const bf16_t* A; int K; DEVI const bf16_t* operator()(int r) const { return A + (size_t)r * K; } };
struct EpiBf16Out { bf16_t* O; int ldo;
    DEVI void operator()(const f32x4 (&acc)[4][4], int rb, int cb) const {
#pragma unroll
        for (int m = 0; m < 4; ++m)
#pragma unroll
            for (int n = 0; n < 4; ++n) { u32x2 w; w.x = cvt_pk(acc[m][n][0], acc[m][n][1]); w.y = cvt_pk(acc[m][n][2], acc[m][n][3]);
                *(u32x2*)(O + (size_t)(rb + m * 16) * ldo + cb + n * 16) = w; }
    } };
struct EpiResF32 { const float* R; float* O; int ld;
    DEVI void operator()(const f32x4 (&acc)[4][4], int rb, int cb) const {
#pragma unroll
        for (int m = 0; m < 4; ++m)
#pragma unroll
            for (int n = 0; n < 4; ++n) { const size_t off = (size_t)(rb + m * 16) * ld + cb + n * 16;
                const f32x4 r = *(const f32x4*)(R + off); *(f32x4*)(O + off) = r + acc[m][n]; }
    } };

template <class MakeEpi>
DEVI void gemm_dense_units(const bf16_t* A, const bf16_t* Bt, int M, int N, int K, const MakeEpi& mk, char* lds, int u0, int ustride) {
    const int nN = N / G_BN, nU = (M / G_BM) * nN;
    for (int u = u0; u < nU; u += ustride) {
        const int pm = u / nN, pn = u % nN;
        AMapDense am{A + (size_t)pm * G_BM * K, K};
        gemm_tile(am, Bt + (size_t)pn * G_BN * K, K, mk(pm * G_BM, pn * G_BN), lds);
    }
}

DEVI void cumsum_task(const Params& p, int bh, char* lds) {
    const int tid = TIDX(), wid = tid >> 6, lane = tid & 63;
    const int b = bh >> 2, h = bh & 3;
    const float* logf = (const float*)(p.ws + WS_LOGF);
    float* cumf = (float*)(p.ws + WS_CUMF);
    float* wtot = (float*)lds;
    float v[4];
#pragma unroll
    for (int j = 0; j < 4; ++j) v[j] = logf[((size_t)b * S + tid * 4 + j) * 4 + h];
    v[1] += v[0]; v[2] += v[1]; v[3] += v[2];
    float incl = v[3];
#pragma unroll
    for (int d = 1; d < 64; d <<= 1) { const float t = __shfl_up(incl, d); if (lane >= d) incl += t; }
    if (lane == 63) wtot[wid] = incl;
    __syncthreads();
    float woff = 0.f;
    for (int w = 0; w < wid; ++w) woff += wtot[w];
    const float base = woff + incl - v[3];
    *(float4*)(cumf + (size_t)bh * S + tid * 4) = make_float4(base + v[0], base + v[1], base + v[2], base + v[3]);
    __syncthreads();
}
DEVI void phase_inproj(const Params& p, int l, char* lds) {
    unsigned char* ws = p.ws;
    for (int t = BIDX(); t < 32; t += gridDim.x) cumsum_task(p, t, lds);
    bf16_t* proj = (bf16_t*)(ws + WS_PROJ);
    auto mk1 = [&](int r0, int c0) { return EpiBf16Out{proj + (size_t)r0 * NPROJ + c0, NPROJ}; };
    gemm_dense_units((const bf16_t*)(ws + WS_HBUF), (const bf16_t*)(ws + WS_W_IN), T, NPROJ, DM, mk1, lds, BIDX(), gridDim.x);
    bf16_t* kv = (bf16_t*)(ws + WS_KV);
    auto mk2 = [&](int r0, int c0) { return EpiBf16Out{kv + (size_t)r0 * 2 * DM + c0, 2 * DM}; };
    gemm_dense_units((const bf16_t*)(ws + WS_MEMN), (const bf16_t*)(ws + WS_W_KV), MROWS, 2 * DM, DM, mk2, lds, gridDim.x - 1 - BIDX(), gridDim.x);
}

DEVI void phase_post(const Params& p, int l) {
    const int tid = TIDX(), wid = tid >> 6, lane = tid & 63;
    unsigned char* ws = p.ws;
    bf16_t* proj = (bf16_t*)(ws + WS_PROJ);
    const int sl = lane >> 2, qt = lane & 3, type = sl >> 2, head = sl & 3;
    const int col0 = (type < 2 ? type * 256 : 768 + (type - 2) * 256) + head * 64 + qt * 16;
    const float *gq0 = p.in[5], *gq1 = p.in[6], *gq2 = p.in[7], *gq3 = p.in[8];
    asm volatile("" : "+s"(gq0), "+s"(gq1), "+s"(gq2), "+s"(gq3));
    const float* gain = (type == 0 ? gq0 : type == 1 ? gq1 : type == 2 ? gq2 : gq3) + l * 64 + qt * 16;
    float gv[16];
#pragma unroll
    for (int i = 0; i < 16; ++i) gv[i] = gain[i];
    float inv[8];
#pragma unroll
    for (int i = 0; i < 8; ++i) inv[i] = powf(500000.0f, -(float)i / 8.0f);
    for (int row = BIDX() * 8 + wid; row < T; row += gridDim.x * 8) {
        bf16_t* ptr = proj + (size_t)row * NPROJ + col0;
        const u32x4 w0 = *(const u32x4*)ptr, w1 = *(const u32x4*)(ptr + 8);
        float v[16];
        v[0] = bflo(w0.x); v[1] = bfhi(w0.x); v[2] = bflo(w0.y); v[3] = bfhi(w0.y); v[4] = bflo(w0.z); v[5] = bfhi(w0.z); v[6] = bflo(w0.w); v[7] = bfhi(w0.w);
        v[8] = bflo(w1.x); v[9] = bfhi(w1.x); v[10] = bflo(w1.y); v[11] = bfhi(w1.y); v[12] = bflo(w1.z); v[13] = bfhi(w1.z); v[14] = bflo(w1.w); v[15] = bfhi(w1.w);
        float ss = 0.f;
#pragma unroll
        for (int i = 0; i < 16; ++i) ss += v[i] * v[i];
        ss += __shfl_xor(ss, 1); ss += __shfl_xor(ss, 2);
        const float rstd = rsqrtf(ss * (1.0f / 64.0f) + EPS);
#pragma unroll
        for (int i = 0; i < 16; ++i) v[i] = v[i] * rstd * gv[i];
        if (type >= 2 && qt == 0) {
            const float pos = (float)(row & (S - 1));
#pragma unroll
            for (int i = 0; i < 8; ++i) { float sn, cs; sincosf(pos * inv[i], &sn, &cs);
                const float a = v[i], b = v[i + 8]; v[i] = a * cs - b * sn; v[i + 8] = b * cs + a * sn; }
        }
        u32x4 o0, o1;
        o0.x = cvt_pk(v[0], v[1]); o0.y = cvt_pk(v[2], v[3]); o0.z = cvt_pk(v[4], v[5]); o0.w = cvt_pk(v[6], v[7]);
        o1.x = cvt_pk(v[8], v[9]); o1.y = cvt_pk(v[10], v[11]); o1.z = cvt_pk(v[12], v[13]); o1.w = cvt_pk(v[14], v[15]);
        *(u32x4*)ptr = o0; *(u32x4*)(ptr + 8) = o1;
    }
    bf16_t* kv = (bf16_t*)(ws + WS_KV);
    const float* kg = p.in[21] + l * 256 + (lane & 15) * 16;
    float kgv[16];
#pragma unroll
    for (int i = 0; i < 16; ++i) kgv[i] = kg[i];
    for (int row = BIDX() * 8 + wid; row < MROWS; row += gridDim.x * 8) {
        bf16_t* ptr = kv + (size_t)row * 2 * DM + lane * 16;
        const u32x4 w0 = *(const u32x4*)ptr, w1 = *(const u32x4*)(ptr + 8);
        float v[16];
        v[0] = bflo(w0.x); v[1] = bfhi(w0.x); v[2] = bflo(w0.y); v[3] = bfhi(w0.y); v[4] = bflo(w0.z); v[5] = bfhi(w0.z); v[6] = bflo(w0.w); v[7] = bfhi(w0.w);
        v[8] = bflo(w1.x); v[9] = bfhi(w1.x); v[10] = bflo(w1.y); v[11] = bfhi(w1.y); v[12] = bflo(w1.z); v[13] = bfhi(w1.z); v[14] = bflo(w1.w); v[15] = bfhi(w1.w);
        float ss = 0.f;
#pragma unroll
        for (int i = 0; i < 16; ++i) ss += v[i] * v[i];
        ss += __shfl_xor(ss, 1); ss += __shfl_xor(ss, 2); ss += __shfl_xor(ss, 4); ss += __shfl_xor(ss, 8);
        const float rstd = rsqrtf(ss * (1.0f / 256.0f) + EPS);
#pragma unroll
        for (int i = 0; i < 16; ++i) v[i] = v[i] * rstd * kgv[i];
        u32x4 o0, o1;
        o0.x = cvt_pk(v[0], v[1]); o0.y = cvt_pk(v[2], v[3]); o0.z = cvt_pk(v[4], v[5]); o0.w = cvt_pk(v[6], v[7]);
        o1.x = cvt_pk(v[8], v[9]); o1.y = cvt_pk(v[10], v[11]); o1.z = cvt_pk(v[12], v[13]); o1.w = cvt_pk(v[14], v[15]);
        *(u32x4*)ptr = o0; *(u32x4*)(ptr + 8) = o1;
    }
}

template <int DH> struct AttnLds { static constexpr int KST = DH + 8, PST = 72; static constexpr int BYTES = (2 * 64 * KST + 8 * 16 * PST) * 2; };
template <int DH, int MODE>
DEVI void attn_task(const bf16_t* __restrict__ Qb, int ldq, int qtok0, int qstep,
                    const bf16_t* __restrict__ Kb, const bf16_t* __restrict__ Vb, int ldk, int ktok0, int kstep,
                    int p0, int kt_lo, int kt_hi, float scale,
                    const float* __restrict__ cum, const float* __restrict__ qgain,
                    bf16_t* Ob, int ldo, float* Of, float* Om, float* Ol, char* lds) {
    constexpr int KST = AttnLds<DH>::KST, PST = AttnLds<DH>::PST, NKK = DH / 32, ND = DH / 16;
    const int tid = TIDX(), wid = tid >> 6, lane = tid & 63, r16 = lane & 15, g4 = lane >> 4;
    bf16_t* Ks = (bf16_t*)lds;
    bf16_t* Vs = Ks + 64 * KST;
    bf16_t* Ps = Vs + 64 * KST + wid * 16 * PST;
    bf16x8 qf[NKK];
    {
        const bf16_t* qp = Qb + (size_t)(qtok0 + (p0 + wid * 16 + r16) * qstep) * ldq + g4 * 8;
#pragma unroll
        for (int kk = 0; kk < NKK; ++kk) qf[kk] = *(const bf16x8*)(qp + kk * 32);
    }
    if (MODE == 2) {
        float ss = 0.f;
#pragma unroll
        for (int kk = 0; kk < NKK; ++kk)
#pragma unroll
            for (int j = 0; j < 8; ++j) { const float v = bf2f((bf16_t)qf[kk][j]); ss += v * v; }
        ss += __shfl_xor(ss, 16); ss += __shfl_xor(ss, 32);
        const float rstd = rsqrtf(ss * (1.0f / DH) + EPS);
#pragma unroll
        for (int kk = 0; kk < NKK; ++kk)
#pragma unroll
            for (int j = 0; j < 8; ++j) { const float v = bf2f((bf16_t)qf[kk][j]) * rstd * qgain[kk * 32 + g4 * 8 + j]; qf[kk][j] = (short)f2bf(v); }
    }
    float m_[4], l_[4], cq[4];
    f32x4 o[ND];
#pragma unroll
    for (int j = 0; j < 4; ++j) { m_[j] = -1.0e30f; l_[j] = 0.f; cq[j] = 0.f; }
#pragma unroll
    for (int n = 0; n < ND; ++n) o[n] = (f32x4){0.f, 0.f, 0.f, 0.f};
    if (MODE == 0) {
#pragma unroll
        for (int j = 0; j < 4; ++j) cq[j] = cum[p0 + wid * 16 + g4 * 4 + j];
    }
    for (int kt = kt_lo; kt < kt_hi; ++kt) {
        __syncthreads();
        for (int c = tid; c < 64 * DH / 8; c += NTHR) {
            const int key = c / (DH / 8), dc = c % (DH / 8);
            const size_t tok = (size_t)(ktok0 + (kt * 64 + key) * kstep);
            *(u32x4*)(Ks + key * KST + dc * 8) = *(const u32x4*)(Kb + tok * ldk + dc * 8);
            *(u32x4*)(Vs + key * KST + dc * 8) = *(const u32x4*)(Vb + tok * ldk + dc * 8);
        }
        __syncthreads();
        f32x4 s[4];
#pragma unroll
        for (int n = 0; n < 4; ++n) {
            s[n] = (f32x4){0.f, 0.f, 0.f, 0.f};
#pragma unroll
            for (int kk = 0; kk < NKK; ++kk) {
                const bf16x8 kf = *(const bf16x8*)(Ks + (n * 16 + r16) * KST + kk * 32 + g4 * 8);
                s[n] = MFMA16(qf[kk], kf, s[n]);
            }
        }
        float ck[4];
#pragma unroll
        for (int n = 0; n < 4; ++n) ck[n] = (MODE == 0) ? cum[kt * 64 + n * 16 + r16] : 0.f;
#pragma unroll
        for (int j = 0; j < 4; ++j) {
            const int qpos = p0 + wid * 16 + g4 * 4 + j;
            float v[4];
            float mx = -INFINITY;
#pragma unroll
            for (int n = 0; n < 4; ++n) {
                const int kpos = kt * 64 + n * 16 + r16;
                float t = s[n][j] * scale;
                if (MODE == 0) { t += cq[j] - ck[n]; if (kpos > qpos) t = -INFINITY; }
                if (MODE == 1) { const int dd = qpos - kpos; if (dd < 0 || dd > 128) t = -INFINITY; }
                v[n] = t; mx = fmaxf(mx, t);
            }
            mx = fmaxf(mx, __shfl_xor(mx, 1)); mx = fmaxf(mx, __shfl_xor(mx, 2)); mx = fmaxf(mx, __shfl_xor(mx, 4)); mx = fmaxf(mx, __shfl_xor(mx, 8));
            const float mn = fmaxf(m_[j], mx);
            const float alpha = __expf(m_[j] - mn);
            float rs = 0.f;
#pragma unroll
            for (int n = 0; n < 4; ++n) { const float pv = __expf(v[n] - mn); rs += pv; Ps[(g4 * 4 + j) * PST + n * 16 + r16] = f2bf(pv); }
            rs += __shfl_xor(rs, 1); rs += __shfl_xor(rs, 2); rs += __shfl_xor(rs, 4); rs += __shfl_xor(rs, 8);
            l_[j] = l_[j] * alpha + rs; m_[j] = mn;
#pragma unroll
            for (int n = 0; n < ND; ++n) o[n][j] *= alpha;
        }
        __builtin_amdgcn_wave_barrier();
        asm volatile("s_waitcnt lgkmcnt(0)" ::: "memory");
#pragma unroll
        for (int kk = 0; kk < 2; ++kk) {
            const bf16x8 pf = *(const bf16x8*)(Ps + r16 * PST + kk * 32 + g4 * 8);
            const bf16_t* vb = Vs + (kk * 32 + 8 * g4 + (r16 >> 2)) * KST + 4 * (r16 & 3);
#pragma unroll
            for (int n = 0; n < ND; ++n) {
                const s16x4 lo = tr_read(vb + n * 16), hi = tr_read(vb + 4 * KST + n * 16);
                bf16x8 vf; vf[0] = lo[0]; vf[1] = lo[1]; vf[2] = lo[2]; vf[3] = lo[3]; vf[4] = hi[0]; vf[5] = hi[1]; vf[6] = hi[2]; vf[7] = hi[3];
                o[n] = MFMA16(pf, vf, o[n]);
            }
        }
        __builtin_amdgcn_wave_barrier();
    }
#pragma unroll
    for (int j = 0; j < 4; ++j) {
        const int prow = p0 + wid * 16 + g4 * 4 + j;
        const size_t tok = (size_t)(qtok0 + prow * qstep);
        if (MODE == 1) {
#pragma unroll
            for (int n = 0; n < ND; ++n) Of[tok * 256 + n * 16 + r16] = o[n][j];
            if (r16 == 0) { Om[tok * 4] = m_[j]; Ol[tok * 4] = l_[j]; }
        } else {
            const float inv = 1.0f / l_[j];
#pragma unroll
            for (int n = 0; n < ND; ++n) Ob[tok * ldo + n * 16 + r16] = f2bf(o[n][j] * inv);
        }
    }
}

DEVI void ssd_acs(const Params& p, int l, int b, int c, int g, float* acs, float* dts) {
    const int tid = TIDX(), wid = tid >> 6, lane = tid & 63;
    if (wid < 4) {
        const int head = g * 4 + wid;
        const float* dtv = (const float*)(p.ws + WS_DTV);
        const float A = -__expf(p.in[12][l * 8 + head]);
        const size_t t0 = (size_t)b * S + c * 128 + 2 * lane;
        const float d0 = dtv[t0 * 8 + head], d1 = dtv[(t0 + 1) * 8 + head];
        const float a0 = d0 * A, a1 = d1 * A;
        float incl = a0 + a1;
#pragma unroll
        for (int d = 1; d < 64; d <<= 1) { const float t = __shfl_up(incl, d); if (lane >= d) incl += t; }
        const float ex = incl - (a0 + a1);
        acs[wid * 128 + 2 * lane] = ex + a0; acs[wid * 128 + 2 * lane + 1] = ex + a0 + a1;
        dts[wid * 128 + 2 * lane] = d0; dts[wid * 128 + 2 * lane + 1] = d1;
    }
}
DEVI void conv8_chan(const Params& p, int l, const bf16_t* proj, int b, int c, int chan, int l0, float (&out)[8]) {
    const float* cw = p.in[9] + (size_t)l * 4 * 1024 + chan;
    const float w0 = cw[0], w1 = cw[1024], w2 = cw[2048], w3 = cw[3072], cb = p.in[10][l * 1024 + chan];
    float v[11];
    const int sbase = c * 128 + l0 - 3;
#pragma unroll
    for (int i = 0; i < 11; ++i) { const int sp = sbase + i; v[i] = sp >= 0 ? bf2f(proj[((size_t)b * S + sp) * NPROJ + C_XBC + chan]) : 0.f; }
#pragma unroll
    for (int i = 0; i < 8; ++i) out[i] = silu_f(cb + w0 * v[i] + w1 * v[i + 1] + w2 * v[i + 2] + w3 * v[i + 3]);
}
DEVI void conv8_pos(const Params& p, int l, const bf16_t* proj, int b, int sp, int chan0, float (&out)[8]) {
    float a[8];
    const float* cb = p.in[10] + l * 1024 + chan0;
#pragma unroll
    for (int i = 0; i < 8; ++i) a[i] = cb[i];
#pragma unroll
    for (int j = 0; j < 4; ++j) {
        const int s2 = sp - 3 + j;
        if (s2 >= 0) {
            const u32x4 w = *(const u32x4*)(proj + ((size_t)b * S + s2) * NPROJ + C_XBC + chan0);
            const float* cw = p.in[9] + ((size_t)l * 4 + j) * 1024 + chan0;
            a[0] += cw[0] * bflo(w.x); a[1] += cw[1] * bfhi(w.x); a[2] += cw[2] * bflo(w.y); a[3] += cw[3] * bfhi(w.y);
            a[4] += cw[4] * bflo(w.z); a[5] += cw[5] * bfhi(w.z); a[6] += cw[6] * bflo(w.w); a[7] += cw[7] * bfhi(w.w);
        }
    }
#pragma unroll
    for (int i = 0; i < 8; ++i) out[i] = silu_f(a[i]);
}
DEVI u32x4 pack8(const float (&v)[8]) { u32x4 w; w.x = cvt_pk(v[0], v[1]); w.y = cvt_pk(v[2], v[3]); w.z = cvt_pk(v[4], v[5]); w.w = cvt_pk(v[6], v[7]); return w; }

constexpr int SST = 136;
DEVI void ssd_states_task(const Params& p, int l, int b, int c, int g, char* lds) {
    const int tid = TIDX(), wid = tid >> 6, lane = tid & 63, r16 = lane & 15, g4 = lane >> 4;
    const bf16_t* proj = (const bf16_t*)(p.ws + WS_PROJ);
    bf16_t* BT = (bf16_t*)lds;
    bf16_t* XT = BT + 128 * SST;
    float* acs = (float*)(XT + 256 * SST);
    float* dts = acs + 512;
    __syncthreads();
    ssd_acs(p, l, b, c, g, acs, dts);
    __syncthreads();
    if (tid < 4) ((float*)(p.ws + WS_DECAY))[((size_t)b * 16 + c) * 8 + g * 4 + tid] = __expf(acs[tid * 128 + 127]);
    for (int it = tid; it < 2048; it += NTHR) {
        const int n = it & 127, lc = it >> 7;
        float v[8]; conv8_chan(p, l, proj, b, c, 512 + g * 128 + n, lc * 8, v);
        *(u32x4*)(BT + n * SST + lc * 8) = pack8(v);
    }
    for (int it = tid; it < 4096; it += NTHR) {
        const int ch = it & 255, lc = it >> 8, hl = ch >> 6;
        float v[8]; conv8_chan(p, l, proj, b, c, g * 256 + ch, lc * 8, v);
        const float alast = acs[hl * 128 + 127];
#pragma unroll
        for (int i = 0; i < 8; ++i) { const int ll = lc * 8 + i; v[i] *= dts[hl * 128 + ll] * __expf(alast - acs[hl * 128 + ll]); }
        *(u32x4*)(XT + ch * SST + lc * 8) = pack8(v);
    }
    __syncthreads();
    const int hl = wid >> 1, nh = wid & 1;
    f32x4 acc[4][4];
#pragma unroll
    for (int m = 0; m < 4; ++m)
#pragma unroll
        for (int n = 0; n < 4; ++n) acc[m][n] = (f32x4){0.f, 0.f, 0.f, 0.f};
#pragma unroll
    for (int kk = 0; kk < 4; ++kk) {
        bf16x8 af[4], bfr[4];
#pragma unroll
        for (int m = 0; m < 4; ++m) af[m] = *(const bf16x8*)(XT + (hl * 64 + m * 16 + r16) * SST + kk * 32 + g4 * 8);
#pragma unroll
        for (int n = 0; n < 4; ++n) bfr[n] = *(const bf16x8*)(BT + (nh * 64 + n * 16 + r16) * SST + kk * 32 + g4 * 8);
#pragma unroll
        for (int m = 0; m < 4; ++m)
#pragma unroll
            for (int n = 0; n < 4; ++n) acc[m][n] = MFMA16(bfr[n], af[m], acc[m][n]);
    }
    float* st = (float*)(p.ws + WS_SSTATE) + (((size_t)b * 16 + c) * 8 + g * 4 + hl) * 8192;
#pragma unroll
    for (int m = 0; m < 4; ++m)
#pragma unroll
        for (int n = 0; n < 4; ++n) *(f32x4*)(st + (m * 16 + r16) * 128 + nh * 64 + n * 16 + g4 * 4) = acc[m][n];
}
DEVI void phase_ssd_scan(const Params& p) {
    const float* st = (const float*)(p.ws + WS_SSTATE);
    bf16_t* hin = (bf16_t*)(p.ws + WS_HIN);
    const float* decay = (const float*)(p.ws + WS_DECAY);
    const int total = NB * 8 * 2048;
    for (int i = BIDX() * NTHR + TIDX(); i < total; i += gridDim.x * NTHR) {
        const int e4 = i & 2047, head = (i >> 11) & 7, b = i >> 14;
        f32x4 h = (f32x4){0.f, 0.f, 0.f, 0.f};
        for (int c = 0; c < 16; ++c) {
            const size_t off = (((size_t)b * 16 + c) * 8 + head) * 8192 + e4 * 4;
            u32x2 w; w.x = cvt_pk(h[0], h[1]); w.y = cvt_pk(h[2], h[3]);
            *(u32x2*)(hin + off) = w;
            const f32x4 s = *(const f32x4*)(st + off);
            const float d = decay[((size_t)b * 16 + c) * 8 + head];
            h = h * d + s;
        }
    }
}
DEVI void ssd_out_task(const Params& p, int l, int b, int c, char* lds) {
    const int tid = TIDX(), wid = tid >> 6, lane = tid & 63, r16 = lane & 15, g4 = lane >> 4;
    const bf16_t* proj = (const bf16_t*)(p.ws + WS_PROJ);
    bf16_t* Cs = (bf16_t*)lds;
    bf16_t* Bs = Cs + 128 * SST;
    bf16_t* XT = Bs + 128 * SST;
    bf16_t* Hs = XT + 64 * SST;
    bf16_t* Mw = Hs + 64 * SST + wid * 16 * SST;
    float* acs = (float*)(Hs + 64 * SST + 8 * 16 * SST);
    float* dts = acs + 512;
    const int lrow = wid * 16 + r16;
    const size_t tok = (size_t)b * S + c * 128 + lrow;
    float* gbuf = (float*)(p.ws + WS_GBUF);
    float ssq = 0.f;
    for (int g = 0; g < 2; ++g) {
        __syncthreads();
        ssd_acs(p, l, b, c, g, acs, dts);
        for (int it = tid; it < 2048; it += NTHR) {
            const int ll = it >> 4, nc = (it & 15) * 8;
            float v[8];
            conv8_pos(p, l, proj, b, c * 128 + ll, 768 + g * 128 + nc, v);
            *(u32x4*)(Cs + ll * SST + nc) = pack8(v);
            conv8_pos(p, l, proj, b, c * 128 + ll, 512 + g * 128 + nc, v);
            *(u32x4*)(Bs + ll * SST + nc) = pack8(v);
        }
        __syncthreads();
        bf16x8 cfr[4];
#pragma unroll
        for (int kk = 0; kk < 4; ++kk) cfr[kk] = *(const bf16x8*)(Cs + lrow * SST + kk * 32 + g4 * 8);
        f32x4 cb[8];
#pragma unroll
        for (int st = 0; st < 8; ++st) {
            cb[st] = (f32x4){0.f, 0.f, 0.f, 0.f};
#pragma unroll
            for (int kk = 0; kk < 4; ++kk) {
                const bf16x8 bfr = *(const bf16x8*)(Bs + (st * 16 + r16) * SST + kk * 32 + g4 * 8);
                cb[st] = MFMA16(bfr, cfr[kk], cb[st]);
            }
        }
        for (int hl = 0; hl < 4; ++hl) {
            const int head = g * 4 + hl;
            __syncthreads();
            for (int it = tid; it < 1024; it += NTHR) {
                const int pp = it & 63, sc = it >> 6;
                float v[8]; conv8_chan(p, l, proj, b, c, g * 256 + hl * 64 + pp, sc * 8, v);
                *(u32x4*)(XT + pp * SST + sc * 8) = pack8(v);
                const bf16_t* hsrc = (const bf16_t*)(p.ws + WS_HIN) + (((size_t)b * 16 + c) * 8 + head) * 8192 + (size_t)it * 8;
                *(u32x4*)(Hs + (it >> 4) * SST + (it & 15) * 8) = *(const u32x4*)hsrc;
            }
            __syncthreads();
            const float al = acs[hl * 128 + lrow];
#pragma unroll
            for (int st = 0; st < 8; ++st) {
                float mv[4];
#pragma unroll
                for (int j = 0; j < 4; ++j) { const int sidx = st * 16 + g4 * 4 + j;
                    mv[j] = (sidx <= lrow) ? cb[st][j] * __expf(al - acs[hl * 128 + sidx]) * dts[hl * 128 + sidx] : 0.f; }
                u32x2 w; w.x = cvt_pk(mv[0], mv[1]); w.y = cvt_pk(mv[2], mv[3]);
                *(u32x2*)(Mw + r16 * SST + st * 16 + g4 * 4) = w;
            }
            __builtin_amdgcn_wave_barrier();
            asm volatile("s_waitcnt lgkmcnt(0)" ::: "memory");
            f32x4 yd[4], yo[4];
#pragma unroll
            for (int pt = 0; pt < 4; ++pt) { yd[pt] = (f32x4){0.f, 0.f, 0.f, 0.f}; yo[pt] = (f32x4){0.f, 0.f, 0.f, 0.f}; }
#pragma unroll
            for (int kk = 0; kk < 4; ++kk) {
                const bf16x8 mf = *(const bf16x8*)(Mw + r16 * SST + kk * 32 + g4 * 8);
#pragma unroll
                for (int pt = 0; pt < 4; ++pt) {
                    const bf16x8 xf = *(const bf16x8*)(XT + (pt * 16 + r16) * SST + kk * 32 + g4 * 8);
                    yd[pt] = MFMA16(xf, mf, yd[pt]);
                    const bf16x8 hf = *(const bf16x8*)(Hs + (pt * 16 + r16) * SST + kk * 32 + g4 * 8);
                    yo[pt] = MFMA16(hf, cfr[kk], yo[pt]);
                }
            }
            __builtin_amdgcn_wave_barrier();
            const float el = __expf(al), Dh = p.in[13][l * 8 + head];
#pragma unroll
            for (int pt = 0; pt < 4; ++pt) {
                const int pc = pt * 16 + g4 * 4;
                const u32x2 zw = *(const u32x2*)(proj + tok * NPROJ + C_Z + head * 64 + pc);
                const float zz[4] = {bflo(zw.x), bfhi(zw.x), bflo(zw.y), bfhi(zw.y)};
                f32x4 gv;
#pragma unroll
                for (int j = 0; j < 4; ++j) {
                    const float xv = bf2f(XT[(pc + j) * SST + lrow]);
                    const float yv = yd[pt][j] + el * yo[pt][j] + Dh * xv;
                    gv[j] = yv * silu_f(zz[j]);
                    ssq += gv[j] * gv[j];
                }
                *(f32x4*)(gbuf + tok * 512 + head * 64 + pc) = gv;
            }
        }
    }
    ssq += __shfl_xor(ssq, 16); ssq += __shfl_xor(ssq, 32);
    const float rstd = rsqrtf(ssq * (1.0f / 512.0f) + EPS);
    bf16_t* mix = (bf16_t*)(p.ws + WS_MIX);
#pragma unroll
    for (int head = 0; head < 8; ++head)
#pragma unroll
        for (int pt = 0; pt < 4; ++pt) {
            const int pc = pt * 16 + g4 * 4;
            const f32x4 gv = *(const f32x4*)(gbuf + tok * 512 + head * 64 + pc);
            u32x2 w; w.x = cvt_pk(gv[0] * rstd, gv[1] * rstd); w.y = cvt_pk(gv[2] * rstd, gv[3] * rstd);
            *(u32x2*)(mix + tok * DM + 512 + head * 64 + pc) = w;
        }
}

constexpr int N_FOX = 512, N_S1 = 256, N_DIL = 1536;
DEVI void phase_mix1(const Params& p, int l, char* lds) {
    unsigned char* ws = p.ws;
    const bf16_t* proj = (const bf16_t*)(ws + WS_PROJ);
    bf16_t* mix = (bf16_t*)(ws + WS_MIX);
    for (int t = BIDX(); t < N_FOX + N_S1 + N_DIL; t += gridDim.x) {
        if (t < N_FOX) {
            const int bh = t & 31, k = t >> 5;
            const int qb = k < 8 ? 15 - k : k - 8;
            const int b = bh >> 2, h = bh & 3;
            const float* cum = (const float*)(ws + WS_CUMF) + (size_t)bh * S;
            attn_task<64, 0>(proj + C_FQ + h * 64, NPROJ, b * S, 1, proj + C_FK + h * 64, proj + C_FV + h * 64, NPROJ, b * S, 1,
                             qb * 128, 0, 2 * qb + 2, 0.125f, cum, nullptr, mix + h * 64, DM, nullptr, nullptr, nullptr, lds);
        } else if (t < N_FOX + N_S1) {
            const int u = t - N_FOX, g = u & 1, c = (u >> 1) & 15, b = u >> 5;
            ssd_states_task(p, l, b, c, g, lds);
        } else {
            const int u = t - N_FOX - N_S1, bh = u & 31, v = u >> 5;
            const int b = bh >> 2, h = bh & 3;
            int br, dil, r, pb;
            if (v < 16) { br = 0; dil = 1; r = 0; pb = v; }
            else if (v < 32) { br = 1; dil = 4; r = (v - 16) & 3; pb = (v - 16) >> 2; }
            else { br = 2; dil = 16; r = v - 32; pb = 0; }
            float* Of = (float*)(ws + WS_DILO) + (size_t)br * T * 256 + h * 64;
            float* Om = (float*)(ws + WS_DILM) + (size_t)br * T * 4 + h;
            float* Ol = (float*)(ws + WS_DILL) + (size_t)br * T * 4 + h;
            const int klo = pb > 0 ? 2 * pb - 2 : 0;
            attn_task<64, 1>(proj + C_DQ + h * 64, NPROJ, b * S + r, dil, proj + C_DK + h * 64, proj + C_DV + h * 64, NPROJ, b * S + r, dil,
                             pb * 128, klo, 2 * pb + 2, 0.125f, nullptr, nullptr, nullptr, 0, Of, Om, Ol, lds);
        }
    }
}
DEVI void phase_mix3(const Params& p, int l, char* lds) {
    unsigned char* ws = p.ws;
    for (int t = BIDX(); t < NB * 16; t += gridDim.x) ssd_out_task(p, l, t >> 4, t & 15, lds);
    const int tid = TIDX(), wid = tid >> 6, lane = tid & 63, head = lane >> 4, d4 = (lane & 15) * 4;
    const float* Of = (const float*)(ws + WS_DILO);
    const float* Om = (const float*)(ws + WS_DILM);
    const float* Ol = (const float*)(ws + WS_DILL);
    bf16_t* mix = (bf16_t*)(ws + WS_MIX);
    for (int row = ((BIDX() + gridDim.x - 128) % gridDim.x) * 8 + wid; row < T; row += gridDim.x * 8) {
        float m[3], lsum[3];
#pragma unroll
        for (int br = 0; br < 3; ++br) { m[br] = Om[((size_t)br * T + row) * 4 + head]; lsum[br] = Ol[((size_t)br * T + row) * 4 + head]; }
        const float M = fmaxf(m[0], fmaxf(m[1], m[2]));
        f32x4 num = (f32x4){0.f, 0.f, 0.f, 0.f}; float den = 0.f;
#pragma unroll
        for (int br = 0; br < 3; ++br) {
            const float w = __expf(m[br] - M);
            const f32x4 o = *(const f32x4*)(Of + ((size_t)br * T + row) * 256 + head * 64 + d4);
            num += o * w; den += w * lsum[br];
        }
        const float inv = 1.0f / den;
        u32x2 w; w.x = cvt_pk(num[0] * inv, num[1] * inv); w.y = cvt_pk(num[2] * inv, num[3] * inv);
        *(u32x2*)(mix + (size_t)row * DM + 256 + head * 64 + d4) = w;
    }
}
DEVI void phase_xattn(const Params& p, int l, char* lds) {
    unsigned char* ws = p.ws;
    const bf16_t* qbuf = (const bf16_t*)(ws + WS_QBUF);
    const bf16_t* kv = (const bf16_t*)(ws + WS_KV);
    bf16_t* obuf = (bf16_t*)(ws + WS_OBUF);
    for (int t = BIDX(); t < NB * 4 * 16; t += gridDim.x) {
        const int qb = t & 15, h = (t >> 4) & 3, b = t >> 6;
        attn_task<256, 2>(qbuf + h * 256, DM, b * S, 1, kv + h * 256, kv + DM + h * 256, 2 * DM, b * MEMLEN, 1,
                          qb * 128, 0, 4, 0.0625f, nullptr, p.in[20] + l * 256, obuf + h * 256, DM, nullptr, nullptr, nullptr, lds);
    }
}
struct AMapGather { const bf16_t* A; int K; const int* ent; int nvalid; int shift;
    DEVI const bf16_t* operator()(int r) const { const int e = ent[r < nvalid ? r : 0]; return A + (size_t)(e >> shift) * K; } };
struct EpiSwiglu { bf16_t* act; const int* ent; int nvalid; int col0;
    DEVI void operator()(const f32x4 (&acc)[4][4], int rb, int cb) const {
#pragma unroll
        for (int m = 0; m < 4; ++m) {
            const int r = rb + m * 16;
            if (r < nvalid) {
                const int a = ent[r];
#pragma unroll
                for (int np = 0; np < 2; ++np) {
                    const f32x4 x1 = acc[m][2 * np], x3 = acc[m][2 * np + 1];
                    float o[4];
#pragma unroll
                    for (int j = 0; j < 4; ++j) o[j] = silu_f(x1[j]) * x3[j];
                    const int cg = col0 + (cb & 64) + np * 32;
                    u32x2 w; w.x = cvt_pk(o[0], o[1]); w.y = cvt_pk(o[2], o[3]);
                    *(u32x2*)(act + (size_t)a * EFF + (cg >> 1) + (cb & 15)) = w;
                }
            }
        }
    } };
struct EpiMoeOut { bf16_t* y; const int* ent; const float* gate; int nvalid; int col0;
    DEVI void operator()(const f32x4 (&acc)[4][4], int rb, int cb) const {
#pragma unroll
        for (int m = 0; m < 4; ++m) {
            const int r = rb + m * 16;
            if (r < nvalid) {
                const int a = ent[r]; const float gt = gate[a];
#pragma unroll
                for (int n = 0; n < 4; ++n) { u32x2 w; w.x = cvt_pk(acc[m][n][0] * gt, acc[m][n][1] * gt); w.y = cvt_pk(acc[m][n][2] * gt, acc[m][n][3] * gt);
                    *(u32x2*)(y + (size_t)a * DM + col0 + cb + n * 16) = w; }
            }
        }
    } };
template <int WHICH>
DEVI void phase_moe(const Params& p, int l, char* lds) {
    unsigned char* ws = p.ws;
    const int* cnt = (const int*)(ws + WS_CNT) + l * 64;
    const int* list = (const int*)(ws + WS_LIST);
    int ubase = 0;
    for (int e = 0; e < NEXP; ++e) {
        const int ce = cnt[e], ntile = (ce + G_BM - 1) / G_BM, nun = ntile * 8;
        int u = ubase + ((BIDX() - ubase % (int)gridDim.x) + gridDim.x) % gridDim.x;
        for (; u < ubase + nun; u += gridDim.x) {
            const int lu = u - ubase, pm = lu >> 3, pn = lu & 7;
            const int* ent = list + (size_t)e * (2 * T) + pm * G_BM;
            const int nvalid = ce - pm * G_BM;
            if (WHICH == 0) {
                AMapGather am{(const bf16_t*)(ws + WS_HBUF), DM, ent, nvalid, 1};
                EpiSwiglu ep{(bf16_t*)(ws + WS_ACT), ent, nvalid, pn * G_BN};
                gemm_tile(am, (const bf16_t*)(ws + WS_W_13) + ((size_t)e * 1024 + pn * G_BN) * DM, DM, ep, lds);
            } else {
                AMapGather am{(const bf16_t*)(ws + WS_ACT), EFF, ent, nvalid, 0};
                EpiMoeOut ep{(bf16_t*)(ws + WS_YBUF), ent, (const float*)(ws + WS_GATE), nvalid, pn * G_BN};
                gemm_tile(am, (const bf16_t*)(ws + WS_W_2) + ((size_t)e * DM + pn * G_BN) * EFF, EFF, ep, lds);
            }
        }
        ubase += nun;
    }
}
DEVI void phase_final(const Params& p) {
    const int tid = TIDX(), wid = tid >> 6, lane = tid & 63;
    const bf16_t* ybuf = (const bf16_t*)(p.ws + WS_YBUF);
    for (int row = BIDX() * 8 + wid; row < T; row += gridDim.x * 8) {
        float x[16];
        load_row_f32(p.out + (size_t)row * DM, x, lane);
        add_row_bf16(ybuf + (size_t)(2 * row) * DM, x, lane);
        add_row_bf16(ybuf + (size_t)(2 * row + 1) * DM, x, lane);
        store_row_f32(p.out + (size_t)row * DM, x, lane);
    }
}


#define XB_TMO      128
#define XB_XCNT(j)  (256  + 64 * (j))
#define XB_XSUB(j)  (1280 + 64 * (j))
#define XB_XGEN(j)  (2304 + 64 * (j))
#define XB_TOP      3328
#define XB_TOPGEN   3392
#define XCD_BAR_WORDS 3456
#define XB_SPIN_CAP (1u << 22)
DEVI unsigned xb_ld(unsigned* p)              { return __hip_atomic_load(p, __ATOMIC_RELAXED, __HIP_MEMORY_SCOPE_AGENT); }
DEVI unsigned xb_add(unsigned* p, unsigned v) { return __hip_atomic_fetch_add(p, v, __ATOMIC_RELAXED, __HIP_MEMORY_SCOPE_AGENT); }
DEVI unsigned xb_xcc_id() { return (unsigned)__builtin_amdgcn_s_getreg((3 << 11) | 20) & 0xFu; }
#define XB_SPIN(cond, bar) do { unsigned _sp = 0; while (cond) { __builtin_amdgcn_s_sleep(1); \
    if ((++_sp & 255u) == 0u) { if (xb_ld(&(bar)[XB_TMO])) break; if (_sp > XB_SPIN_CAP) { atomicAdd(&(bar)[XB_TMO], 1u); break; } } } } while (0)
struct XcdBarrier { unsigned* bar; unsigned x; volatile LAS unsigned* st; };
DEVI XcdBarrier xcd_barrier_post(unsigned* bar, volatile LAS unsigned* st) {
    XcdBarrier b; b.bar = bar; b.x = xb_xcc_id(); b.st = st;
    if (threadIdx.x == 0) (void)xb_add(&bar[XB_XCNT(b.x)], 1u);
    return b;
}
DEVI void xcd_barrier_complete(unsigned* bar, unsigned x, unsigned& nloc, unsigned& nx) {
    const unsigned G = gridDim.x * gridDim.y * gridDim.z;
    unsigned sum, cnt, mine, sp = 0u;
    for (;;) {
        sum = 0u; cnt = 0u; mine = 0u;
#pragma unroll
        for (unsigned j = 0; j < 16; ++j) { const unsigned c = xb_ld(&bar[XB_XCNT(j)]); sum += c; cnt += (c > 0u) ? 1u : 0u; mine = (j == x) ? c : mine; }
        if (sum == G) break;
        __builtin_amdgcn_s_sleep(1);
        if ((++sp & 255u) == 0u) { if (xb_ld(&bar[XB_TMO])) break; if (sp > XB_SPIN_CAP) { atomicAdd(&bar[XB_TMO], 1u); break; } }
    }
    nloc = mine > 0u ? mine : 1u; nx = cnt > 0u ? cnt : 1u;
}
DEVI void xcd_barrier(const XcdBarrier& b) {
    asm volatile("s_waitcnt vmcnt(0)" ::: "memory");
    __syncthreads();
    if (threadIdx.x == 0) {
        unsigned* bar = b.bar;
        __builtin_amdgcn_s_waitcnt(0);
        unsigned nloc = b.st[0], nx = b.st[1];
        if (nloc == 0u) { xcd_barrier_complete(bar, b.x, nloc, nx); b.st[0] = nloc; b.st[1] = nx; }
        const unsigned old = xb_add(&bar[XB_XSUB(b.x)], 1u);
        const unsigned gen = old / nloc;
        if (old + 1u == (gen + 1u) * nloc) {
            __builtin_amdgcn_fence(__ATOMIC_RELEASE, "agent");
            asm volatile("s_waitcnt vmcnt(0)" ::: "memory");
            const unsigned og = xb_add(&bar[XB_TOP], 1u);
            const unsigned tg = og / nx;
            if (og + 1u == (tg + 1u) * nx) xb_add(&bar[XB_TOPGEN], 1u);
            else XB_SPIN(xb_ld(&bar[XB_TOPGEN]) == tg, bar);
            __builtin_amdgcn_fence(__ATOMIC_ACQUIRE, "agent");
            xb_add(&bar[XB_XGEN(b.x)], 1u);
            asm volatile("s_waitcnt vmcnt(0)" ::: "memory");
        } else {
            XB_SPIN(xb_ld(&bar[XB_XGEN(b.x)]) == gen, bar);
            __builtin_amdgcn_fence(__ATOMIC_ACQUIRE, "agent");
            asm volatile("s_waitcnt vmcnt(0)" ::: "memory");
        }
    }
    __syncthreads();
}

constexpr int N_PHASES = 30;
typedef __attribute__((address_space(4))) const unsigned long long* karg_ptr;
typedef __attribute__((address_space(1))) const float* gcf_ptr;
typedef __attribute__((address_space(1))) float* gf_ptr;
typedef __attribute__((address_space(1))) unsigned char* gb_ptr;
DEVI Params load_params(karg_ptr kp) {
    Params q;
#pragma unroll
    for (int i = 0; i < 31; ++i) q.in[i] = (const float*)(gcf_ptr)(kp[i]);
    q.out = (float*)(gf_ptr)(kp[31]);
    q.ws = (unsigned char*)(gb_ptr)(kp[32]);
    const unsigned long long a = kp[33], b = kp[34];
    q.ph_lo = (int)(unsigned)a; q.ph_hi = (int)(unsigned)(a >> 32); q.use_grid_sync = (int)(unsigned)b; q.pad = 0;
    return q;
}
__global__ void __launch_bounds__(NTHR) hybrid_fwd(Params p_unused) {
    extern __shared__ __attribute__((aligned(16))) char lds[];
    karg_ptr kp = (karg_ptr)__builtin_amdgcn_kernarg_segment_ptr();
    int ph_lo, ph_hi, use_gs;
    { const Params q = load_params(kp); ph_lo = q.ph_lo; ph_hi = q.ph_hi; use_gs = q.use_grid_sync; }
    volatile LAS unsigned* xst = (volatile LAS unsigned*)(LAS char*)(lds + LDS_BYTES - 16);
    if (threadIdx.x == 0) { xst[0] = 0u; xst[1] = 0u; }
    __syncthreads();
    XcdBarrier xb; xb.bar = nullptr; xb.x = 0; xb.st = xst;
    if (use_gs == 1) { const Params q = load_params(kp); xb = xcd_barrier_post((unsigned*)(q.ws + WS_BAR), xst); }
    for (int ph = ph_lo; ph < ph_hi; ++ph) {
        if (ph > ph_lo) { if (use_gs == 1) xcd_barrier(xb); else if (use_gs == 2) cg::this_grid().sync(); }
        asm volatile("" : "+s"(kp) :: "memory");
        const Params p = load_params(kp);
        unsigned char* ws = p.ws;
        if (ph == 0) {
            prep_small(p);
            for (int u = BIDX(); u < PREP_UNITS; u += gridDim.x) prep_unit(p, 0, u, (float*)lds);
        } else if (ph == 29) {
            phase_final(p);
        } else {
            const int l = (ph - 1) / 14, s = (ph - 1) % 14;
            const float* x_in = l == 0 ? p.in[0] : p.out;
            float* x1 = l == 0 ? p.out : (float*)(ws + WS_XB);
            float* x2 = l == 0 ? (float*)(ws + WS_XB) : p.out;
            switch (s) {
            case 0:
                if (l == 1) for (int u = BIDX(); u < PREP_UNITS; u += gridDim.x) prep_unit(p, 1, u, (float*)lds);
                __syncthreads();
                phase_norm1(p, l, lds); break;
            case 1: phase_inproj(p, l, lds); break;
            case 2: phase_post(p, l); break;
            case 3: phase_mix1(p, l, lds); break;
            case 4: phase_ssd_scan(p); break;
            case 5: phase_mix3(p, l, lds); break;
            case 6: { auto mk = [&](int r0, int c0) { return EpiResF32{x_in + (size_t)r0 * DM + c0, x1 + (size_t)r0 * DM + c0, DM}; };
                      gemm_dense_units((const bf16_t*)(ws + WS_MIX), (const bf16_t*)(ws + WS_W_OUT), T, DM, DM, mk, lds, BIDX(), gridDim.x); } break;
            case 7: phase_norm2(p, l, x1); break;
            case 8: { bf16_t* qb = (bf16_t*)(ws + WS_QBUF);
                      auto mk = [&](int r0, int c0) { return EpiBf16Out{qb + (size_t)r0 * DM + c0, DM}; };
                      gemm_dense_units((const bf16_t*)(ws + WS_HBUF), (const bf16_t*)(ws + WS_W_Q), T, DM, DM, mk, lds, BIDX(), gridDim.x); } break;
            case 9: phase_xattn(p, l, lds); break;
            case 10: { auto mk = [&](int r0, int c0) { return EpiResF32{x1 + (size_t)r0 * DM + c0, x2 + (size_t)r0 * DM + c0, DM}; };
                       gemm_dense_units((const bf16_t*)(ws + WS_OBUF), (const bf16_t*)(ws + WS_W_O), T, DM, DM, mk, lds, BIDX(), gridDim.x); } break;
            case 11: phase_norm3(p, l, x2, lds); break;
            case 12: phase_moe<0>(p, l, lds); break;
            case 13: phase_moe<1>(p, l, lds); break;
            }
        }
    }
}

extern "C" void kernel_launch(void* const* d_in, const int* in_sizes, int n_in, void* d_out, int out_size, void* d_ws, size_t ws_size, hipStream_t stream) {
    static int grid = 0;
    if (grid == 0) {
        if (n_in != 31 || out_size != T * DM || ws_size < WS_END) { fprintf(stderr, "kernel_launch: unexpected shapes (n_in %d out %d ws %zu need %zu)\n", n_in, out_size, ws_size, (size_t)WS_END); grid = -1; return; }
        int dev = 0, cus = 0, per_cu = 0;
        hipGetDevice(&dev);
        hipDeviceGetAttribute(&cus, hipDeviceAttributeMultiprocessorCount, dev);
        hipFuncSetAttribute((const void*)hybrid_fwd, hipFuncAttributeMaxDynamicSharedMemorySize, LDS_BYTES);
        hipOccupancyMaxActiveBlocksPerMultiprocessor(&per_cu, (const void*)hybrid_fwd, NTHR, LDS_BYTES);
        if (per_cu < 1) { fprintf(stderr, "kernel_launch: occupancy query says %d blocks per CU\n", per_cu); per_cu = 1; }
        (void)hipGetLastError();
        grid = cus;
    }
    if (grid < 0) return;
    Params p{};
    for (int i = 0; i < 31; ++i) p.in[i] = (const float*)d_in[i];
    p.out = (float*)d_out; p.ws = (unsigned char*)d_ws;
    p.use_grid_sync = 1; p.pad = 0;
    p.ph_lo = 0; p.ph_hi = N_PHASES;
    if (hipMemsetAsync((unsigned char*)d_ws + WS_BAR, 0, XCD_BAR_WORDS * 4, stream) != hipSuccess) { fprintf(stderr, "kernel_launch: memset failed\n"); return; }
    void* args[] = {&p};
    hipError_t e = hipLaunchCooperativeKernel((const void*)hybrid_fwd, dim3(grid), dim3(NTHR), args, LDS_BYTES, stream);
    if (e != hipSuccess) fprintf(stderr, "kernel_launch: cooperative launch failed: %s (grid %d)\n", hipGetErrorString(e), grid);
}
```

```cpp
#include <hip/hip_runtime.h>
#include <hip/hip_cooperative_groups.h>
#include <cstdio>
#include <cstdint>
namespace cg = cooperative_groups;

typedef unsigned short bf16_t;
typedef short bf16x8 __attribute__((ext_vector_type(8)));
typedef short s16x4 __attribute__((ext_vector_type(4)));
typedef float f32x4 __attribute__((ext_vector_type(4)));
typedef unsigned u32x4 __attribute__((ext_vector_type(4)));
typedef unsigned u32x2 __attribute__((ext_vector_type(2)));
#define DEVI __device__ __forceinline__
#define LAS __attribute__((address_space(3)))

constexpr int NB = 8, S = 2048, DM = 1024, T = NB * S, DEPTH = 2;
constexpr int INP = 3084, NPROJ = 3072;
constexpr int C_FQ = 0, C_FK = 256, C_FV = 512, C_DQ = 768, C_DK = 1024, C_DV = 1280, C_Z = 1536, C_XBC = 2048;
constexpr int MEMLEN = 256, MROWS = NB * MEMLEN;
constexpr int NEXP = 32, EFF = 512;
constexpr float EPS = 1e-6f;
constexpr int NTHR = 512;
constexpr int LDS_BYTES = 151552;

constexpr size_t al256(size_t x) { return (x + 255) & ~(size_t)255; }
constexpr size_t WS_W_IN = 0;
constexpr size_t WS_W_OUT = WS_W_IN + (size_t)NPROJ * DM * 2;
constexpr size_t WS_W_Q = WS_W_OUT + (size_t)DM * DM * 2;
constexpr size_t WS_W_KV = WS_W_Q + (size_t)DM * DM * 2;
constexpr size_t WS_W_O = WS_W_KV + (size_t)2 * DM * DM * 2;
constexpr size_t WS_W_13 = WS_W_O + (size_t)DM * DM * 2;
constexpr size_t WS_W_2 = WS_W_13 + (size_t)NEXP * 1024 * DM * 2;
constexpr size_t WS_WSMALL = WS_W_2 + (size_t)NEXP * DM * EFF * 2;
constexpr size_t WS_WROUT = WS_WSMALL + (size_t)DEPTH * 12 * DM * 4;
constexpr size_t WS_XB = WS_WROUT + (size_t)DEPTH * 36 * DM * 4;
constexpr size_t WS_HBUF = WS_XB + (size_t)T * DM * 4;
constexpr size_t WS_PROJ = WS_HBUF + (size_t)T * DM * 2;
constexpr size_t WS_QBUF = WS_PROJ;
constexpr size_t WS_OBUF = WS_PROJ + (size_t)T * DM * 2;
constexpr size_t WS_ACT = WS_PROJ;
constexpr size_t WS_MIX = WS_PROJ + (size_t)T * NPROJ * 2;
constexpr size_t WS_U = WS_MIX + (size_t)T * DM * 2;
constexpr size_t WS_YBUF = WS_U;
constexpr size_t WS_DILO = WS_U;
constexpr size_t WS_DILM = WS_DILO + (size_t)3 * T * 256 * 4;
constexpr size_t WS_DILL = WS_DILM + (size_t)3 * T * 4 * 4;
constexpr size_t WS_SSTATE = WS_DILL + (size_t)3 * T * 4 * 4;
constexpr size_t WS_HIN = WS_SSTATE + (size_t)NB * 16 * 8 * 8192 * 4;
constexpr size_t WS_GBUF = WS_HIN + (size_t)NB * 16 * 8 * 8192 * 2;
constexpr size_t WS_U_END = WS_GBUF + (size_t)T * 512 * 4;
constexpr size_t WS_MEMN = WS_U_END;
constexpr size_t WS_KV = WS_MEMN + (size_t)MROWS * DM * 2;
constexpr size_t WS_LOGF = WS_KV + (size_t)MROWS * 2 * DM * 2;
constexpr size_t WS_CUMF = WS_LOGF + (size_t)T * 4 * 4;
constexpr size_t WS_DTV = WS_CUMF + (size_t)T * 4 * 4;
constexpr size_t WS_DECAY = WS_DTV + (size_t)T * 8 * 4;
constexpr size_t WS_CNT = WS_DECAY + (size_t)NB * 16 * 8 * 4;
constexpr size_t WS_LIST = WS_CNT + 1024;
constexpr size_t WS_GATE = WS_LIST + (size_t)NEXP * 2 * T * 4;
constexpr size_t WS_BAR = WS_GATE + (size_t)2 * T * 4;
constexpr size_t WS_END = WS_BAR + 65536;
static_assert(WS_YBUF + (size_t)2 * T * DM * 2 <= WS_U_END, "ybuf alias");
static_assert(WS_OBUF + (size_t)T * DM * 2 <= WS_MIX, "obuf alias");

struct Params {
    const float* in[31];
    float* out;
    unsigned char* ws;
    int ph_lo, ph_hi;
    int use_grid_sync, pad;
};


typedef __attribute__((address_space(4))) const unsigned long long* karg_ptr;
typedef __attribute__((address_space(1))) const float* gcf_ptr;
typedef __attribute__((address_space(1))) float* gf_ptr;
typedef __attribute__((address_space(1))) unsigned char* gb_ptr;
struct DP {
    karg_ptr kp;
    DEVI const float* in(int i) const { return (const float*)(gcf_ptr)(kp[i]); }
    DEVI float* out() const { return (float*)(gf_ptr)(kp[31]); }
    DEVI unsigned char* ws() const { return (unsigned char*)(gb_ptr)(kp[32]); }
    DEVI int ph_lo() const { return (int)(unsigned)kp[33]; }
    DEVI int ph_hi() const { return (int)(unsigned)(kp[33] >> 32); }
    DEVI int use_gs() const { return (int)(unsigned)kp[34]; }
};

DEVI int TIDX() { int t = threadIdx.x; asm volatile("" : "+v"(t)); return t; }
DEVI int BIDX() { int b = blockIdx.x; asm volatile("" : "+s"(b)); return b; }
DEVI float bf2f(bf16_t v) { return __uint_as_float(((unsigned)v) << 16); }
typedef float f32x2 __attribute__((ext_vector_type(2)));
typedef __bf16 bf16x2_t __attribute__((ext_vector_type(2)));
DEVI unsigned cvt_pk(float lo, float hi) { f32x2 v = {lo, hi}; bf16x2_t b = __builtin_convertvector(v, bf16x2_t); return __builtin_bit_cast(unsigned, b); }
DEVI bf16_t f2bf(float f) { return (bf16_t)(cvt_pk(f, 0.f) & 0xffffu); }
DEVI float bflo(unsigned w) { return __uint_as_float(w << 16); }
DEVI float bfhi(unsigned w) { return __uint_as_float(w & 0xffff0000u); }
DEVI float wave_sum(float v) {
#pragma unroll
    for (int m = 32; m >= 1; m >>= 1) v += __shfl_xor(v, m);
    return v;
}
DEVI float silu_f(float x) { return x / (1.f + __expf(-x)); }
DEVI float softplus_f(float x) { return x > 20.f ? x : log1pf(__expf(x)); }
DEVI float logsigmoid_f(float x) { return x >= 0.f ? -log1pf(__expf(-x)) : x - log1pf(__expf(x)); }
#define MFMA16(a, b, c) __builtin_amdgcn_mfma_f32_16x16x32_bf16(a, b, c, 0, 0, 0)
DEVI s16x4 tr_read(const bf16_t* p) {
    return __builtin_bit_cast(s16x4, __builtin_amdgcn_ds_read_tr16_b64_v4i16((LAS s16x4*)p));
}

DEVI int maprow(int mode, int n) { return mode == 0 ? n : ((n >> 4) * 32 + (n & 15) + (mode == 2 ? 16 : 0)); }
DEVI void prep_tile(const float* __restrict__ src, int ld, int k0, int c0, bf16_t* __restrict__ dst, int dstld, int mode, int n0,
                    const float* __restrict__ kscale, int ks_from, float* tl) {
    const int tid = TIDX();
#pragma unroll
    for (int i = 0; i < 2; ++i) {
        const int k = (tid >> 4) + 32 * i, n4 = (tid & 15) * 4;
        const float4 v = *(const float4*)(src + (size_t)(k0 + k) * ld + c0 + n4);
        float sc = 1.f;
        if (kscale != nullptr && (k0 + k) >= ks_from) sc = kscale[k0 + k - ks_from];
        tl[k * 65 + n4 + 0] = v.x * sc; tl[k * 65 + n4 + 1] = v.y * sc; tl[k * 65 + n4 + 2] = v.z * sc; tl[k * 65 + n4 + 3] = v.w * sc;
    }
    __syncthreads();
    {
        const int n = tid >> 3, kc = (tid & 7) * 8;
        u32x4 w;
        w.x = cvt_pk(tl[(kc + 0) * 65 + n], tl[(kc + 1) * 65 + n]);
        w.y = cvt_pk(tl[(kc + 2) * 65 + n], tl[(kc + 3) * 65 + n]);
        w.z = cvt_pk(tl[(kc + 4) * 65 + n], tl[(kc + 5) * 65 + n]);
        w.w = cvt_pk(tl[(kc + 6) * 65 + n], tl[(kc + 7) * 65 + n]);
        const int drow = maprow(mode, n0 + n);
        *(u32x4*)(dst + (size_t)drow * dstld + k0 + kc) = w;
    }
    __syncthreads();
}

constexpr int PREP_UNITS = 2048 + 3 * 4096;
DEVI void prep_unit(const DP& p, int l, int u, float* tl) {
    unsigned char* ws = p.ws();
    if (u < 768) {
        const int kt = u / 48, nt = u % 48, n0 = nt * 64, c0 = n0 < 768 ? n0 : n0 + 4;
        prep_tile(p.in(3) + (size_t)l * DM * INP, INP, kt * 64, c0, (bf16_t*)(ws + WS_W_IN), DM, 0, n0, nullptr, 0, tl);
    } else if (u < 1024) {
        const int v = u - 768, kt = v / 16, nt = v % 16;
        prep_tile(p.in(15) + (size_t)l * DM * DM, DM, kt * 64, nt * 64, (bf16_t*)(ws + WS_W_OUT), DM, 0, nt * 64, p.in(14) + l * 512, 512, tl);
    } else if (u < 1280) {
        const int v = u - 1024, kt = v / 16, nt = v % 16;
        prep_tile(p.in(18) + (size_t)l * DM * DM, DM, kt * 64, nt * 64, (bf16_t*)(ws + WS_W_Q), DM, 0, nt * 64, nullptr, 0, tl);
    } else if (u < 1792) {
        const int v = u - 1280, kt = v / 32, nt = v % 32;
        prep_tile(p.in(19) + (size_t)l * DM * 2 * DM, 2 * DM, kt * 64, nt * 64, (bf16_t*)(ws + WS_W_KV), DM, 0, nt * 64, nullptr, 0, tl);
    } else if (u < 2048) {
        const int v = u - 1792, kt = v / 16, nt = v % 16;
        prep_tile(p.in(22) + (size_t)l * DM * DM, DM, kt * 64, nt * 64, (bf16_t*)(ws + WS_W_O), DM, 0, nt * 64, nullptr, 0, tl);
    } else if (u < 2048 + 8192) {
        const int v = u - 2048, which = v / 4096, w = v % 4096, e = w / 128, tI = w % 128, kt = tI / 8, nt = tI % 8;
        const float* src = (which == 0 ? p.in(28) : p.in(29)) + ((size_t)l * NEXP + e) * DM * EFF;
        prep_tile(src, EFF, kt * 64, nt * 64, (bf16_t*)(ws + WS_W_13) + (size_t)e * 1024 * DM, DM, which == 0 ? 1 : 2, nt * 64, nullptr, 0, tl);
    } else {
        const int w = u - 2048 - 8192, e = w / 128, tI = w % 128, kt = tI / 16, nt = tI % 16;
        const float* src = p.in(30) + ((size_t)l * NEXP + e) * EFF * DM;
        prep_tile(src, DM, kt * 64, nt * 64, (bf16_t*)(ws + WS_W_2) + (size_t)e * DM * EFF, EFF, 0, nt * 64, nullptr, 0, tl);
    }
}
DEVI void prep_small(const DP& p) {
    float* wsm = (float*)(p.ws() + WS_WSMALL);
    float* wro = (float*)(p.ws() + WS_WROUT);
    const int gtid = BIDX() * NTHR + TIDX(), gn = gridDim.x * NTHR;
    for (int i = gtid; i < DEPTH * 12 * DM; i += gn) {
        const int l = i / (12 * DM), r = i % (12 * DM), c = r / DM, k = r % DM;
        const int col = c < 4 ? 768 + c : 3076 + (c - 4);
        wsm[i] = p.in(3)[((size_t)l * DM + k) * INP + col];
    }
    for (int i = gtid; i < DEPTH * 36 * DM; i += gn) {
        const int l = i / (36 * DM), r = i % (36 * DM), c = r / DM, k = r % DM;
        wro[i] = c < 4 ? p.in(24)[((size_t)l * DM + k) * 4 + c] : p.in(26)[((size_t)l * DM + k) * 32 + (c - 4)];
    }
    if (BIDX() == 0 && TIDX() < 128) ((int*)(p.ws() + WS_CNT))[TIDX()] = 0;
}

DEVI void store_h_bf16(bf16_t* hrow, const float (&h)[16], int lane) {
#pragma unroll
    for (int j = 0; j < 4; ++j) {
        u32x2 w; w.x = cvt_pk(h[4 * j], h[4 * j + 1]); w.y = cvt_pk(h[4 * j + 2], h[4 * j + 3]);
        *(u32x2*)(hrow + j * 256 + lane * 4) = w;
    }
}
DEVI void load_row_f32(const float* xr, float (&x)[16], int lane) {
#pragma unroll
    for (int j = 0; j < 4; ++j) { const float4 v = *(const float4*)(xr + j * 256 + lane * 4); x[4 * j] = v.x; x[4 * j + 1] = v.y; x[4 * j + 2] = v.z; x[4 * j + 3] = v.w; }
}
DEVI void add_row_bf16(const bf16_t* yr, float (&x)[16], int lane) {
#pragma unroll
    for (int j = 0; j < 4; ++j) { const u32x2 w = *(const u32x2*)(yr + j * 256 + lane * 4); x[4 * j] += bflo(w.x); x[4 * j + 1] += bfhi(w.x); x[4 * j + 2] += bflo(w.y); x[4 * j + 3] += bfhi(w.y); }
}
DEVI void store_row_f32(float* xr, const float (&x)[16], int lane) {
#pragma unroll
    for (int j = 0; j < 4; ++j) *(float4*)(xr + j * 256 + lane * 4) = make_float4(x[4 * j], x[4 * j + 1], x[4 * j + 2], x[4 * j + 3]);
}
DEVI void norm_row(const float (&x)[16], const float* g, float (&h)[16], int lane) {
    float ss = 0.f;
#pragma unroll
    for (int i = 0; i < 16; ++i) ss += x[i] * x[i];
    ss = wave_sum(ss);
    const float rstd = rsqrtf(ss * (1.0f / DM) + EPS);
#pragma unroll
    for (int j = 0; j < 4; ++j) { const float4 gv = *(const float4*)(g + j * 256 + lane * 4);
        h[4 * j] = x[4 * j] * rstd * gv.x; h[4 * j + 1] = x[4 * j + 1] * rstd * gv.y; h[4 * j + 2] = x[4 * j + 2] * rstd * gv.z; h[4 * j + 3] = x[4 * j + 3] * rstd * gv.w; }
}
DEVI float dot_lds(const float (&h)[16], const float* wrow, int lane) {
    float a = 0.f;
#pragma unroll
    for (int j = 0; j < 4; ++j) { const float4 w = *(const float4*)(wrow + j * 256 + lane * 4); a += h[4 * j] * w.x + h[4 * j + 1] * w.y + h[4 * j + 2] * w.z + h[4 * j + 3] * w.w; }
    return a;
}

DEVI void phase_norm1(const DP& p, int l, char* lds) {
    const int tid = TIDX(), wid = tid >> 6, lane = tid & 63;
    unsigned char* ws = p.ws();
    float* wsl = (float*)lds;
    { const float4* src = (const float4*)((const float*)(ws + WS_WSMALL) + (size_t)l * 12 * DM);
      for (int i = tid; i < 12 * DM / 4; i += NTHR) ((float4*)wsl)[i] = src[i]; }
    __syncthreads();
    const float* xin = l == 0 ? p.in(0) : (const float*)(ws + WS_XB);
    float* xout = p.out();
    const bf16_t* ybuf = (const bf16_t*)(ws + WS_YBUF);
    bf16_t* hbuf = (bf16_t*)(ws + WS_HBUF);
    const float* g1 = p.in(2) + l * DM;
    float* logf = (float*)(ws + WS_LOGF);
    float* dtv = (float*)(ws + WS_DTV);
    for (int row = BIDX() * 8 + wid; row < T; row += gridDim.x * 8) {
        float x[16], h[16];
        load_row_f32(xin + (size_t)row * DM, x, lane);
        if (l > 0) {
            add_row_bf16(ybuf + (size_t)(2 * row) * DM, x, lane);
            add_row_bf16(ybuf + (size_t)(2 * row + 1) * DM, x, lane);
            store_row_f32(xout + (size_t)row * DM, x, lane);
        }
        norm_row(x, g1, h, lane);
        store_h_bf16(hbuf + (size_t)row * DM, h, lane);
        float keep = 0.f;
#pragma unroll 2
        for (int c = 0; c < 12; ++c) { const float v = wave_sum(dot_lds(h, wsl + c * DM, lane)); keep = (lane == c) ? v : keep; }
        if (lane < 4) logf[(size_t)row * 4 + lane] = logsigmoid_f(keep + p.in(4)[l * 4 + lane]);
        else if (lane < 12) dtv[(size_t)row * 8 + lane - 4] = softplus_f(keep + p.in(11)[l * 8 + lane - 4]);
    }
    const float* gm = p.in(17) + l * DM;
    bf16_t* memn = (bf16_t*)(ws + WS_MEMN);
    for (int row = BIDX() * 8 + wid; row < MROWS; row += gridDim.x * 8) {
        float x[16], h[16];
        load_row_f32(p.in(1) + (size_t)row * DM, x, lane);
        norm_row(x, gm, h, lane);
        store_h_bf16(memn + (size_t)row * DM, h, lane);
    }
}
DEVI void phase_norm2(const DP& p, int l, const float* xin) {
    const int tid = TIDX(), wid = tid >> 6, lane = tid & 63;
    bf16_t* hbuf = (bf16_t*)(p.ws() + WS_HBUF);
    const float* g = p.in(16) + l * DM;
    for (int row = BIDX() * 8 + wid; row < T; row += gridDim.x * 8) {
        float x[16], h[16];
        load_row_f32(xin + (size_t)row * DM, x, lane);
        norm_row(x, g, h, lane);
        store_h_bf16(hbuf + (size_t)row * DM, h, lane);
    }
}
DEVI void phase_norm3(const DP& p, int l, const float* xin, char* lds) {
    const int tid = TIDX(), wid = tid >> 6, lane = tid & 63;
    unsigned char* ws = p.ws();
    float* wr = (float*)lds;
    { const float4* src = (const float4*)((const float*)(ws + WS_WROUT) + (size_t)l * 36 * DM);
      for (int i = tid; i < 36 * DM / 4; i += NTHR) ((float4*)wr)[i] = src[i]; }
    __syncthreads();
    bf16_t* hbuf = (bf16_t*)(ws + WS_HBUF);
    const float* g = p.in(23) + l * DM;
    int* cnt = (int*)(ws + WS_CNT) + l * 64;
    int* list = (int*)(ws + WS_LIST);
    float* gate = (float*)(ws + WS_GATE);
    const float* bg = p.in(25) + l * 4;
    const float* be = p.in(27) + l * 32;
    for (int row = BIDX() * 8 + wid; row < T; row += gridDim.x * 8) {
        float x[16], h[16];
        load_row_f32(xin + (size_t)row * DM, x, lane);
        norm_row(x, g, h, lane);
        store_h_bf16(hbuf + (size_t)row * DM, h, lane);
        float gl[4];
#pragma unroll
        for (int c = 0; c < 4; ++c) gl[c] = wave_sum(dot_lds(h, wr + c * DM, lane)) + bg[c];
        int gsel = 0; float gmax = gl[0];
#pragma unroll
        for (int c = 1; c < 4; ++c) if (gl[c] > gmax) { gmax = gl[c]; gsel = c; }
        float gden = 0.f;
#pragma unroll
        for (int c = 0; c < 4; ++c) gden += __expf(gl[c] - gmax);
        const float ggate = 1.0f / gden;
        gsel = __builtin_amdgcn_readfirstlane(gsel);
        float el[8];
#pragma unroll
        for (int c = 0; c < 8; ++c) el[c] = wave_sum(dot_lds(h, wr + (4 + gsel * 8 + c) * DM, lane)) + be[gsel * 8 + c];
        int i1 = 0; float v1 = el[0];
#pragma unroll
        for (int c = 1; c < 8; ++c) if (el[c] > v1) { v1 = el[c]; i1 = c; }
        int i2 = (i1 == 0) ? 1 : 0; float v2 = -3.0e38f;
#pragma unroll
        for (int c = 0; c < 8; ++c) if (c != i1 && el[c] > v2) { v2 = el[c]; i2 = c; }
        const float e2 = __expf(v2 - v1), inv = 1.0f / (1.0f + e2);
        const float ga = inv * ggate, gb = e2 * inv * ggate;
        if (lane == 0) {
            const int ea = gsel * 8 + i1, eb = gsel * 8 + i2;
            const int sa = atomicAdd(&cnt[ea], 1);
            list[(size_t)ea * (2 * T) + sa] = 2 * row;
            const int sb = atomicAdd(&cnt[eb], 1);
            list[(size_t)eb * (2 * T) + sb] = 2 * row + 1;
            gate[2 * row] = ga; gate[2 * row + 1] = gb;
        }
    }
}

constexpr int G_BM = 256, G_BN = 128, G_BK = 64, G_ST = 72;
constexpr int G_ABUF = G_BM * G_ST, G_BBUF = G_BN * G_ST;
template <class AMap, class Epi>
DEVI void gemm_tile(const AMap& amap, const bf16_t* __restrict__ Bt, int K, const Epi& epi, char* lds) {
    const int tid = TIDX(), wid = tid >> 6, lane = tid & 63, r16 = lane & 15, g4 = lane >> 4;
    const int wr = wid >> 1, wc = wid & 1;
    bf16_t* As = (bf16_t*)lds;
    bf16_t* Bs = As + 2 * G_ABUF;
    const int srow = tid >> 3, skc = (tid & 7) * 8;
    const bf16_t* ap[4];
#pragma unroll
    for (int i = 0; i < 4; ++i) ap[i] = amap(srow + 64 * i) + skc;
    const bf16_t* bp[2];
#pragma unroll
    for (int i = 0; i < 2; ++i) bp[i] = Bt + (size_t)(srow + 64 * i) * K + skc;
    u32x4 ra[4], rb[2];
#pragma unroll
    for (int i = 0; i < 4; ++i) ra[i] = *(const u32x4*)(ap[i]);
#pragma unroll
    for (int i = 0; i < 2; ++i) rb[i] = *(const u32x4*)(bp[i]);
    f32x4 acc[4][4];
#pragma unroll
    for (int m = 0; m < 4; ++m)
#pragma unroll
        for (int n = 0; n < 4; ++n) acc[m][n] = (f32x4){0.f, 0.f, 0.f, 0.f};
    const int nt = K / G_BK;
    for (int t = 0; t < nt; ++t) {
        bf16_t* Ab = As + (t & 1) * G_ABUF;
        bf16_t* Bb = Bs + (t & 1) * G_BBUF;
#pragma unroll
        for (int i = 0; i < 4; ++i) *(u32x4*)(Ab + (srow + 64 * i) * G_ST + skc) = ra[i];
#pragma unroll
        for (int i = 0; i < 2; ++i) *(u32x4*)(Bb + (srow + 64 * i) * G_ST + skc) = rb[i];
        __syncthreads();
        if (t + 1 < nt) {
#pragma unroll
            for (int i = 0; i < 4; ++i) ra[i] = *(const u32x4*)(ap[i] + (size_t)(t + 1) * G_BK);
#pragma unroll
            for (int i = 0; i < 2; ++i) rb[i] = *(const u32x4*)(bp[i] + (size_t)(t + 1) * G_BK);
        }
#pragma unroll
        for (int kk = 0; kk < 2; ++kk) {
            bf16x8 af[4], bfr[4];
#pragma unroll
            for (int m = 0; m < 4; ++m) af[m] = *(const bf16x8*)(Ab + (wr * 64 + m * 16 + r16) * G_ST + kk * 32 + g4 * 8);
#pragma unroll
            for (int n = 0; n < 4; ++n) bfr[n] = *(const bf16x8*)(Bb + (wc * 64 + n * 16 + r16) * G_ST + kk * 32 + g4 * 8);
#pragma unroll
            for (int m = 0; m < 4; ++m)
#pragma unroll
                for (int n = 0; n < 4; ++n) acc[m][n] = MFMA16(bfr[n], af[m], acc[m][n]);
        }
    }
    epi(acc, wr * 64 + r16, wc * 64 + g4 * 4);
    __syncthreads();
}

struct AMapDense { const bf16_t* A; int K; DEVI const bf16_t* operator()(int r) const { return A + (size_t)r * K; } };
struct EpiBf16Out { bf16_t* O; int ldo;
    DEVI void operator()(const f32x4 (&acc)[4][4], int rb, int cb) const {
#pragma unroll
        for (int m = 0; m < 4; ++m)
#pragma unroll
            for (int n = 0; n < 4; ++n) { u32x2 w; w.x = cvt_pk(acc[m][n][0], acc[m][n][1]); w.y = cvt_pk(acc[m][n][2], acc[m][n][3]);
                *(u32x2*)(O + (size_t)(rb + m * 16) * ldo + cb + n * 16) = w; }
    } };
struct EpiResF32 { const float* R; float* O; int ld;
    DEVI void operator()(const f32x4 (&acc)[4][4], int rb, int cb) const {
#pragma unroll
        for (int m = 0; m < 4; ++m)
#pragma unroll
            for (int n = 0; n < 4; ++n) { const size_t off = (size_t)(rb + m * 16) * ld + cb + n * 16;
                const f32x4 r = *(const f32x4*)(R + off); *(f32x4*)(O + off) = r + acc[m][n]; }
    } };

template <class MakeEpi>
DEVI void gemm_dense_units(const bf16_t* A, const bf16_t* Bt, int M, int N, int K, const MakeEpi& mk, char* lds, int u0, int ustride) {
    const int nN = N / G_BN, nU = (M / G_BM) * nN;
    for (int u = u0; u < nU; u += ustride) {
        const int pm = u / nN, pn = u % nN;
        AMapDense am{A + (size_t)pm * G_BM * K, K};
        gemm_tile(am, Bt + (size_t)pn * G_BN * K, K, mk(pm * G_BM, pn * G_BN), lds);
    }
}


DEVI const char* uni_ptr(const char* p) {
    const unsigned long long v = (unsigned long long)p;
    const unsigned lo = __builtin_amdgcn_readfirstlane((unsigned)v), hi = __builtin_amdgcn_readfirstlane((unsigned)(v >> 32));
    return (const char*)(gb_ptr)(((unsigned long long)hi << 32) | lo);
}
namespace g8 {
constexpr int BM = 256, BK = 64, HALF = 128, HTB = HALF * BK * 2, STAGE_BYTES = 8 * HTB;
DEVI int lds_byte(int r, int c) { const int st = (r >> 4) * 2 + (c >> 5), rr = r & 15, cc = c & 31, ob = rr * 64 + cc * 2; return st * 1024 + (ob ^ (((ob >> 9) & 1) << 5)); }
DEVI void stage_rc(int b, int& R, int& C) { const int st = b / 1024, sb = b % 1024, swz = sb ^ (((sb >> 9) & 1) << 5); R = (st >> 1) * 16 + swz / 64; C = (st & 1) * 32 + (swz % 64) / 2; }
DEVI int perm32(int rho) { const int n = rho >> 4, i = rho & 15; return 8 * (i >> 2) + 4 * n + (i & 3); }
struct UnitU { const char* A; const char* B; int i0, i1, i2, i3; };

template <class Epi, class Sched>
DEVI void gemm8(char* lds_generic, int K, Sched& S, const Epi& E) {
    LAS unsigned char* lds = (LAS unsigned char*)lds_generic;
    const int tid = TIDX(), wid = __builtin_amdgcn_readfirstlane(tid >> 6), lane = tid & 63, wr = wid >> 2, wc = wid & 3, fr = lane & 15, fq = lane >> 4;
    const int nt = K / BK;
    int R0, C0, R1, C1; stage_rc(tid * 16, R0, C0); stage_rc(tid * 16 + 8192, R1, C1);
    unsigned voffB[2];
    { const int Rb0 = Epi::PERM ? ((R0 & ~31) + perm32(R0 & 31)) : R0, Rb1 = Epi::PERM ? ((R1 & ~31) + perm32(R1 & 31)) : R1;
      voffB[0] = (unsigned)(Rb0 * K + C0) * 2u; voffB[1] = (unsigned)(Rb1 * K + C1) * 2u; }
    const size_t kstep = (size_t)(BK * 2), hstepB = (size_t)HALF * K * 2;
    const unsigned ldsw = (unsigned)wid * 1024u;
    const int aoff = lds_byte(wr * 64 + fr, fq * 8), boff = lds_byte(wc * 32 + fr, fq * 8);
#define G8_SA(b, h) (((b) * 2 + (h)) * HTB)
#define G8_SB(b, h) ((4 + (b) * 2 + (h)) * HTB)
#define G8_STG(bufoff, gbase, v0, v1) do { const char* _gb = uni_ptr((const char*)(gbase));     \
        __builtin_amdgcn_global_load_lds((const unsigned*)(_gb + (v0)), (LAS unsigned*)(lds + (bufoff) + ldsw), 16, 0, 0); \
        __builtin_amdgcn_global_load_lds((const unsigned*)(_gb + (v1)), (LAS unsigned*)(lds + (bufoff) + ldsw + 8192), 16, 0, 0); } while (0)
#define G8_LDA(dst, b, h) do { _Pragma("unroll") for (int m = 0; m < 4; ++m) _Pragma("unroll") for (int k = 0; k < 2; ++k) dst[m][k] = *(const LAS bf16x8*)(lds + G8_SA(b, h) + aoff + m * 2048 + k * 1024); } while (0)
#define G8_LDB(dst, b, h) do { _Pragma("unroll") for (int n = 0; n < 2; ++n) _Pragma("unroll") for (int k = 0; k < 2; ++k) dst[n][k] = *(const LAS bf16x8*)(lds + G8_SB(b, h) + boff + n * 2048 + k * 1024); } while (0)
#define G8_MMA(ai, bj, At, Bt) do { __builtin_amdgcn_s_setprio(1); _Pragma("unroll") for (int m = 0; m < 4; ++m) _Pragma("unroll") for (int n = 0; n < 2; ++n) _Pragma("unroll") for (int k = 0; k < 2; ++k) \
        acc[ai][bj][m][n] = __builtin_amdgcn_mfma_f32_16x16x32_bf16(Bt[n][k], At[m][k], acc[ai][bj][m][n], 0, 0, 0); __builtin_amdgcn_s_setprio(0); } while (0)
#define G8_WAIT_V(n) asm volatile("s_waitcnt vmcnt(" #n ")" ::: "memory")
#define G8_WAIT_L(n) asm volatile("s_waitcnt lgkmcnt(" #n ")" ::: "memory")
#define G8_BAR __builtin_amdgcn_s_barrier()
#define G8_SCHED __builtin_amdgcn_sched_barrier(0)
    UnitU cur, nxt;
    if (!S.next(cur)) return;
    unsigned va00, va01, va10, va11;
    S.lane_va(cur, R0, C0, R1, C1, va00, va01, va10, va11);
    f32x4 acc[2][2][4][2];
#pragma unroll
    for (int a = 0; a < 2; ++a)
#pragma unroll
        for (int b = 0; b < 2; ++b)
#pragma unroll
            for (int m = 0; m < 4; ++m)
#pragma unroll
                for (int n = 0; n < 2; ++n) acc[a][b][m][n] = (f32x4){0.f, 0.f, 0.f, 0.f};
    bf16x8 At[4][2], B0[2][2], B1[2][2];
    const char* cA = cur.A; const char* cB = cur.B;
    G8_STG(G8_SB(0, 0), cB, voffB[0], voffB[1]); G8_STG(G8_SA(0, 0), cA, va00, va01); G8_STG(G8_SB(0, 1), cB + hstepB, voffB[0], voffB[1]); G8_STG(G8_SA(0, 1), cA, va10, va11);
    if (wr == 1) G8_BAR;
    G8_WAIT_V(4); G8_BAR;
    G8_STG(G8_SB(1, 0), cB + kstep, voffB[0], voffB[1]); G8_STG(G8_SA(1, 0), cA + kstep, va00, va01); G8_STG(G8_SB(1, 1), cB + hstepB + kstep, voffB[0], voffB[1]);
    G8_WAIT_V(6); G8_BAR;
    for (;;) {
        const bool has_next = S.next(nxt);
        const char* nA = has_next ? nxt.A : cA; const char* nB = has_next ? nxt.B : cB;
        unsigned x00 = va00, x01 = va01, x10 = va10, x11 = va11;
        for (int t = 0; t < nt; t += 2) {
            const bool last = (t == nt - 2);
            const char* a1 = cA + (size_t)(t + 1) * kstep;
            const char* a2 = last ? nA : cA + (size_t)(t + 2) * kstep; const char* b2 = last ? nB : cB + (size_t)(t + 2) * kstep;
            const char* a3 = a2 + kstep; const char* b3 = b2 + kstep;
            if (Sched::GATHER) { if (last && has_next) S.lane_va(nxt, R0, C0, R1, C1, x00, x01, x10, x11); }
            G8_LDB(B0, 0, 0); G8_SCHED; G8_LDA(At, 0, 0); G8_STG(G8_SA(1, 1), a1, va10, va11);
            G8_WAIT_L(8); G8_BAR; G8_WAIT_L(0); G8_MMA(0, 0, At, B0); G8_BAR; G8_SCHED;
            G8_LDB(B1, 0, 1); G8_STG(G8_SB(0, 0), b2, voffB[0], voffB[1]);
            G8_BAR; G8_WAIT_L(0); G8_MMA(0, 1, At, B1); G8_BAR;
            G8_LDA(At, 0, 1); G8_STG(G8_SA(0, 0), a2, x00, x01);
            G8_BAR; G8_WAIT_L(0); G8_MMA(1, 0, At, B0); G8_BAR; G8_SCHED;
            G8_STG(G8_SB(0, 1), b2 + hstepB, voffB[0], voffB[1]);
            G8_WAIT_V(6); G8_BAR; G8_MMA(1, 1, At, B1); G8_BAR;
            G8_LDB(B0, 1, 0); G8_SCHED; G8_LDA(At, 1, 0); G8_STG(G8_SA(0, 1), a2, x10, x11);
            G8_WAIT_L(8); G8_BAR; G8_WAIT_L(0); G8_MMA(0, 0, At, B0); G8_BAR; G8_SCHED;
            G8_LDB(B1, 1, 1); G8_STG(G8_SB(1, 0), b3, voffB[0], voffB[1]);
            G8_BAR; G8_WAIT_L(0); G8_MMA(0, 1, At, B1); G8_BAR;
            G8_LDA(At, 1, 1); G8_STG(G8_SA(1, 0), a3, x00, x01);
            G8_BAR; G8_WAIT_L(0); G8_MMA(1, 0, At, B0); G8_BAR; G8_SCHED;
            G8_STG(G8_SB(1, 1), b3 + hstepB, voffB[0], voffB[1]);
            G8_WAIT_V(6); G8_BAR; G8_MMA(1, 1, At, B1); G8_BAR;
        }
        E(acc, cur, wr, wc, fr, fq);
        if (!has_next) break;
#pragma unroll
        for (int a = 0; a < 2; ++a)
#pragma unroll
            for (int b = 0; b < 2; ++b)
#pragma unroll
                for (int m = 0; m < 4; ++m)
#pragma unroll
                    for (int n = 0; n < 2; ++n) acc[a][b][m][n] = (f32x4){0.f, 0.f, 0.f, 0.f};
        cur = nxt; cA = nA; cB = nB; va00 = x00; va01 = x01; va10 = x10; va11 = x11;
    }
    G8_WAIT_V(0);
    if (wr == 0) G8_BAR;
    G8_BAR;
#undef G8_SA
#undef G8_SB
#undef G8_STG
#undef G8_LDA
#undef G8_LDB
#undef G8_MMA
#undef G8_WAIT_V
#undef G8_WAIT_L
#undef G8_BAR
#undef G8_SCHED
}

struct DenseSched {
    static constexpr bool GATHER = false;
    const char* A; const char* Bt; int K, nM, nN, nwg, G, c, i;
    DEVI void init(const bf16_t* A_, const bf16_t* Bt_, int M, int N, int K_, int G_, int c_) { A = (const char*)A_; Bt = (const char*)Bt_; K = K_; nM = M / BM; nN = N / BM; nwg = nM * nN; G = G_; c = c_; i = 0; }
    DEVI bool next(UnitU& u) {
        const long L = (long)i * G + c; if (L >= nwg) return false;
        ++i;
        int wgid = (int)L; { const int q = nwg / 8, r = nwg % 8, xcd = wgid % 8, off = wgid / 8; wgid = (xcd < r ? xcd * (q + 1) : r * (q + 1) + (xcd - r) * q) + off; }
        const int nig = 8 * nN, gid = wgid / nig, fm = gid * 8, gsz = (nM - fm) < 8 ? (nM - fm) : 8;
        const int pm = fm + ((wgid % nig) % gsz), pn = (wgid % nig) / gsz;
        u.A = A + (size_t)pm * BM * K * 2; u.B = Bt + (size_t)pn * BM * K * 2; u.i0 = pm; u.i1 = pn; u.i2 = 0; u.i3 = 0;
        return true;
    }
    DEVI void lane_va(const UnitU&, int R0, int C0, int R1, int C1, unsigned& v00, unsigned& v01, unsigned& v10, unsigned& v11) const {
        v00 = (unsigned)(R0 * K + C0) * 2u; v01 = (unsigned)(R1 * K + C1) * 2u; v10 = v00 + (unsigned)(HALF * K * 2); v11 = v01 + (unsigned)(HALF * K * 2);
    }
};
struct EpiBf16 { static constexpr bool PERM = true; bf16_t* O; int ldo;
    DEVI void operator()(const f32x4 (&acc)[2][2][4][2], const UnitU& u, int wr, int wc, int fr, int fq) const {
        bf16_t* base = O + (size_t)(u.i0 * BM + wr * 64 + fr) * ldo + u.i1 * BM + wc * 32 + 8 * fq;
#pragma unroll
        for (int ai = 0; ai < 2; ++ai)
#pragma unroll
            for (int m = 0; m < 4; ++m) { bf16_t* rowp = base + (size_t)(ai * HALF + m * 16) * ldo;
#pragma unroll
                for (int bj = 0; bj < 2; ++bj) { const f32x4 v0 = acc[ai][bj][m][0], v1 = acc[ai][bj][m][1];
                    u32x4 w; w.x = cvt_pk(v0[0], v0[1]); w.y = cvt_pk(v0[2], v0[3]); w.z = cvt_pk(v1[0], v1[1]); w.w = cvt_pk(v1[2], v1[3]);
                    *(u32x4*)(rowp + bj * HALF) = w; } }
    } };
struct EpiRes { static constexpr bool PERM = false; const float* R; float* O; int ld;
    DEVI void operator()(const f32x4 (&acc)[2][2][4][2], const UnitU& u, int wr, int wc, int fr, int fq) const {
        const size_t off0 = (size_t)(u.i0 * BM + wr * 64 + fr) * ld + u.i1 * BM + wc * 32 + 4 * fq;
#pragma unroll
        for (int ai = 0; ai < 2; ++ai)
#pragma unroll
            for (int m = 0; m < 4; ++m) { const size_t off = off0 + (size_t)(ai * HALF + m * 16) * ld;
#pragma unroll
                for (int bj = 0; bj < 2; ++bj)
#pragma unroll
                    for (int n = 0; n < 2; ++n) { const f32x4 r = *(const f32x4*)(R + off + bj * HALF + n * 16); *(f32x4*)(O + off + bj * HALF + n * 16) = r + acc[ai][bj][m][n]; } }
    } };
}

DEVI void cumsum_task(const DP& p, int bh, char* lds) {
    const int tid = TIDX(), wid = tid >> 6, lane = tid & 63;
    const int b = bh >> 2, h = bh & 3;
    const float* logf = (const float*)(p.ws() + WS_LOGF);
    float* cumf = (float*)(p.ws() + WS_CUMF);
    float* wtot = (float*)lds;
    float v[4];
#pragma unroll
    for (int j = 0; j < 4; ++j) v[j] = logf[((size_t)b * S + tid * 4 + j) * 4 + h];
    v[1] += v[0]; v[2] += v[1]; v[3] += v[2];
    float incl = v[3];
#pragma unroll
    for (int d = 1; d < 64; d <<= 1) { const float t = __shfl_up(incl, d); if (lane >= d) incl += t; }
    if (lane == 63) wtot[wid] = incl;
    __syncthreads();
    float woff = 0.f;
    for (int w = 0; w < wid; ++w) woff += wtot[w];
    const float base = woff + incl - v[3];
    *(float4*)(cumf + (size_t)bh * S + tid * 4) = make_float4(base + v[0], base + v[1], base + v[2], base + v[3]);
    __syncthreads();
}
DEVI void phase_inproj(const DP& p, int l, char* lds) {
    unsigned char* ws = p.ws();
    for (int t = BIDX(); t < 32; t += gridDim.x) cumsum_task(p, t, lds);
    g8::DenseSched S; S.init((const bf16_t*)(ws + WS_HBUF), (const bf16_t*)(ws + WS_W_IN), T, NPROJ, DM, gridDim.x, BIDX());
    g8::EpiBf16 E{(bf16_t*)(ws + WS_PROJ), NPROJ};
    g8::gemm8(lds, DM, S, E);
}
DEVI void kv_gemm(const DP& p, char* lds) {
    unsigned char* ws = p.ws();
    const int c = BIDX() - ((int)gridDim.x - 64);
    if (c < 0) return;
    g8::DenseSched S; S.init((const bf16_t*)(ws + WS_MEMN), (const bf16_t*)(ws + WS_W_KV), MROWS, 2 * DM, DM, 64, c);
    g8::EpiBf16 E{(bf16_t*)(ws + WS_KV), 2 * DM};
    g8::gemm8(lds, DM, S, E);
}

DEVI void phase_post(const DP& p, int l) {
    const int tid = TIDX(), wid = tid >> 6, lane = tid & 63;
    unsigned char* ws = p.ws();
    bf16_t* proj = (bf16_t*)(ws + WS_PROJ);
    const int sl = lane >> 2, qt = lane & 3, type = sl >> 2, head = sl & 3;
    const int col0 = (type < 2 ? type * 256 : 768 + (type - 2) * 256) + head * 64 + qt * 16;
    const float *gq0 = p.in(5), *gq1 = p.in(6), *gq2 = p.in(7), *gq3 = p.in(8);
    asm volatile("" : "+s"(gq0), "+s"(gq1), "+s"(gq2), "+s"(gq3));
    const float* gain = (type == 0 ? gq0 : type == 1 ? gq1 : type == 2 ? gq2 : gq3) + l * 64 + qt * 16;
    float gv[16];
#pragma unroll
    for (int i = 0; i < 16; ++i) gv[i] = gain[i];
    const float inv[8] = {1.000000000e+00f, 1.939227432e-01f, 3.760603070e-02f, 7.292664610e-03f, 1.414213562e-03f, 2.742481884e-04f, 5.318295734e-05f, 1.031338525e-05f};
    for (int row = BIDX() * 8 + wid; row < T; row += gridDim.x * 8) {
        bf16_t* ptr = proj + (size_t)row * NPROJ + col0;
        const u32x4 w0 = *(const u32x4*)ptr, w1 = *(const u32x4*)(ptr + 8);
        float v[16];
        v[0] = bflo(w0.x); v[1] = bfhi(w0.x); v[2] = bflo(w0.y); v[3] = bfhi(w0.y); v[4] = bflo(w0.z); v[5] = bfhi(w0.z); v[6] = bflo(w0.w); v[7] = bfhi(w0.w);
        v[8] = bflo(w1.x); v[9] = bfhi(w1.x); v[10] = bflo(w1.y); v[11] = bfhi(w1.y); v[12] = bflo(w1.z); v[13] = bfhi(w1.z); v[14] = bflo(w1.w); v[15] = bfhi(w1.w);
        float ss = 0.f;
#pragma unroll
        for (int i = 0; i < 16; ++i) ss += v[i] * v[i];
        ss += __shfl_xor(ss, 1); ss += __shfl_xor(ss, 2);
        const float rstd = rsqrtf(ss * (1.0f / 64.0f) + EPS);
#pragma unroll
        for (int i = 0; i < 16; ++i) v[i] = v[i] * rstd * gv[i];
        if (type >= 2 && qt == 0) {
            const float pos = (float)(row & (S - 1));
#pragma unroll
            for (int i = 0; i < 8; ++i) { float sn, cs; sincosf(pos * inv[i], &sn, &cs);
                const float a = v[i], b = v[i + 8]; v[i] = a * cs - b * sn; v[i + 8] = b * cs + a * sn; }
        }
        u32x4 o0, o1;
        o0.x = cvt_pk(v[0], v[1]); o0.y = cvt_pk(v[2], v[3]); o0.z = cvt_pk(v[4], v[5]); o0.w = cvt_pk(v[6], v[7]);
        o1.x = cvt_pk(v[8], v[9]); o1.y = cvt_pk(v[10], v[11]); o1.z = cvt_pk(v[12], v[13]); o1.w = cvt_pk(v[14], v[15]);
        *(u32x4*)ptr = o0; *(u32x4*)(ptr + 8) = o1;
    }
}
DEVI void phase_knorm(const DP& p, int l) {
    const int tid = TIDX(), wid = tid >> 6, lane = tid & 63;
    unsigned char* ws = p.ws();
    bf16_t* kv = (bf16_t*)(ws + WS_KV);
    const float* kg = p.in(21) + l * 256 + (lane & 15) * 16;
    float kgv[16];
#pragma unroll
    for (int i = 0; i < 16; ++i) kgv[i] = kg[i];
    for (int row = BIDX() * 8 + wid; row < MROWS; row += gridDim.x * 8) {
        bf16_t* ptr = kv + (size_t)row * 2 * DM + lane * 16;
        const u32x4 w0 = *(const u32x4*)ptr, w1 = *(const u32x4*)(ptr + 8);
        float v[16];
        v[0] = bflo(w0.x); v[1] = bfhi(w0.x); v[2] = bflo(w0.y); v[3] = bfhi(w0.y); v[4] = bflo(w0.z); v[5] = bfhi(w0.z); v[6] = bflo(w0.w); v[7] = bfhi(w0.w);
        v[8] = bflo(w1.x); v[9] = bfhi(w1.x); v[10] = bflo(w1.y); v[11] = bfhi(w1.y); v[12] = bflo(w1.z); v[13] = bfhi(w1.z); v[14] = bflo(w1.w); v[15] = bfhi(w1.w);
        float ss = 0.f;
#pragma unroll
        for (int i = 0; i < 16; ++i) ss += v[i] * v[i];
        ss += __shfl_xor(ss, 1); ss += __shfl_xor(ss, 2); ss += __shfl_xor(ss, 4); ss += __shfl_xor(ss, 8);
        const float rstd = rsqrtf(ss * (1.0f / 256.0f) + EPS);
#pragma unroll
        for (int i = 0; i < 16; ++i) v[i] = v[i] * rstd * kgv[i];
        u32x4 o0, o1;
        o0.x = cvt_pk(v[0], v[1]); o0.y = cvt_pk(v[2], v[3]); o0.z = cvt_pk(v[4], v[5]); o0.w = cvt_pk(v[6], v[7]);
        o1.x = cvt_pk(v[8], v[9]); o1.y = cvt_pk(v[10], v[11]); o1.z = cvt_pk(v[12], v[13]); o1.w = cvt_pk(v[14], v[15]);
        *(u32x4*)ptr = o0; *(u32x4*)(ptr + 8) = o1;
    }
}
constexpr float LOG2E = 1.4426950408889634f;
template <int DH> struct AttnLds { static constexpr int KST = DH + 8; static constexpr int TILE = 64 * KST; static constexpr int BYTES = 4 * TILE * 2; };
DEVI float xor16_max(float v) { return fmaxf(v, __shfl_xor(v, 16)); }
DEVI float xor32_max(float v) { auto r = __builtin_amdgcn_permlane32_swap(__float_as_uint(v), __float_as_uint(v), false, false); return fmaxf(__uint_as_float(r[0]), __uint_as_float(r[1])); }
DEVI float xor32_sum(float v) { auto r = __builtin_amdgcn_permlane32_swap(__float_as_uint(v), __float_as_uint(v), false, false); return __uint_as_float(r[0]) + __uint_as_float(r[1]); }
template <int DH, int MODE>
DEVI void attn_task(const bf16_t* __restrict__ Qb, int ldq, int qtok0, int qstep,
                    const bf16_t* __restrict__ Kb, const bf16_t* __restrict__ Vb, int ldk, int ktok0, int kstep,
                    int p0, int kt_lo, int kt_hi, float scale,
                    const float* __restrict__ cum, const float* __restrict__ qgain,
                    bf16_t* Ob, int ldo, float* Of, float* Om, float* Ol, char* lds) {
    constexpr int KST = AttnLds<DH>::KST, TILE = AttnLds<DH>::TILE, NKK = DH / 32, ND = DH / 16, NCH = (64 * DH / 8) / NTHR;
    const int tid = TIDX(), wid = tid >> 6, lane = tid & 63, r16 = lane & 15, g4 = lane >> 4;
    bf16_t* Ks = (bf16_t*)lds;
    bf16_t* Vs = Ks + 2 * TILE;
    const float c2 = scale * LOG2E;
    bf16x8 qf[NKK];
    {
        const bf16_t* qp = Qb + (size_t)(qtok0 + (p0 + wid * 16 + r16) * qstep) * ldq + g4 * 8;
#pragma unroll
        for (int kk = 0; kk < NKK; ++kk) qf[kk] = *(const bf16x8*)(qp + kk * 32);
    }
    if (MODE == 2) {
        float ss = 0.f;
#pragma unroll
        for (int kk = 0; kk < NKK; ++kk)
#pragma unroll
            for (int j = 0; j < 8; ++j) { const float v = bf2f((bf16_t)qf[kk][j]); ss += v * v; }
        ss += __shfl_xor(ss, 16); ss += __shfl_xor(ss, 32);
        const float rstd = rsqrtf(ss * (1.0f / DH) + EPS);
#pragma unroll
        for (int kk = 0; kk < NKK; ++kk)
#pragma unroll
            for (int j = 0; j < 8; ++j) { const float v = bf2f((bf16_t)qf[kk][j]) * rstd * qgain[kk * 32 + g4 * 8 + j]; qf[kk][j] = (short)f2bf(v); }
    }
    const int qpos = p0 + wid * 16 + r16;
    float m_ = -1.0e30f, l_ = 0.f;
    const float cq = (MODE == 0) ? cum[qpos] * LOG2E : 0.f;
    f32x4 o[ND];
#pragma unroll
    for (int n = 0; n < ND; ++n) o[n] = (f32x4){0.f, 0.f, 0.f, 0.f};
    u32x4 rk[NCH], rv[NCH];
    auto gload = [&](int kt) {
#pragma unroll
        for (int i = 0; i < NCH; ++i) { const int c = tid + i * NTHR, key = c / (DH / 8), dc = c % (DH / 8);
            const size_t tok = (size_t)(ktok0 + (kt * 64 + key) * kstep);
            rk[i] = *(const u32x4*)(Kb + tok * ldk + dc * 8); rv[i] = *(const u32x4*)(Vb + tok * ldk + dc * 8); }
    };
    gload(kt_lo);
    __syncthreads();
    int buf = 0;
    for (int kt = kt_lo; kt < kt_hi; ++kt, buf ^= 1) {
        bf16_t* Kt = Ks + buf * TILE;
        bf16_t* Vt = Vs + buf * TILE;
#pragma unroll
        for (int i = 0; i < NCH; ++i) { const int c = tid + i * NTHR, key = c / (DH / 8), dc = c % (DH / 8);
            *(u32x4*)(Kt + key * KST + dc * 8) = rk[i]; *(u32x4*)(Vt + key * KST + dc * 8) = rv[i]; }
        __syncthreads();
        if (kt + 1 < kt_hi) gload(kt + 1);
        f32x4 s[4];
#pragma unroll
        for (int n = 0; n < 4; ++n) {
            s[n] = (f32x4){0.f, 0.f, 0.f, 0.f};
#pragma unroll
            for (int kk = 0; kk < NKK; ++kk) {
                const bf16x8 kf = *(const bf16x8*)(Kt + (n * 16 + r16) * KST + kk * 32 + g4 * 8);
                s[n] = MFMA16(kf, qf[kk], s[n]);
            }
            if (DH > 64) __builtin_amdgcn_sched_barrier(0);
        }
        float mx = -INFINITY;
#pragma unroll
        for (int n = 0; n < 4; ++n) {
            f32x4 ck = (f32x4){0.f, 0.f, 0.f, 0.f};
            if (MODE == 0) ck = *(const f32x4*)(cum + kt * 64 + n * 16 + g4 * 4);
#pragma unroll
            for (int j = 0; j < 4; ++j) {
                const int kpos = kt * 64 + n * 16 + g4 * 4 + j;
                float t = s[n][j] * c2;
                if (MODE == 0) { t += cq - ck[j] * LOG2E; if (kpos > qpos) t = -INFINITY; }
                if (MODE == 1) { const int dd = qpos - kpos; if (dd < 0 || dd > 128) t = -INFINITY; }
                s[n][j] = t; mx = fmaxf(mx, t);
            }
        }
        mx = xor32_max(xor16_max(mx));
        const float mn = fmaxf(m_, mx);
        const float alpha = __builtin_amdgcn_exp2f(m_ - mn);
        float rs = 0.f;
#pragma unroll
        for (int n = 0; n < 4; ++n)
#pragma unroll
            for (int j = 0; j < 4; ++j) { const float pv = __builtin_amdgcn_exp2f(s[n][j] - mn); s[n][j] = pv; rs += pv; }
        rs += __shfl_xor(rs, 16); rs = xor32_sum(rs);
        l_ = l_ * alpha + rs; m_ = mn;
#pragma unroll
        for (int n = 0; n < ND; ++n) o[n] *= alpha;
#pragma unroll
        for (int kk = 0; kk < 2; ++kk) {
            bf16x8 pb;
            { const unsigned w0 = cvt_pk(s[2 * kk][0], s[2 * kk][1]), w1 = cvt_pk(s[2 * kk][2], s[2 * kk][3]), w2 = cvt_pk(s[2 * kk + 1][0], s[2 * kk + 1][1]), w3 = cvt_pk(s[2 * kk + 1][2], s[2 * kk + 1][3]);
              u32x4 w; w.x = w0; w.y = w1; w.z = w2; w.w = w3; pb = __builtin_bit_cast(bf16x8, w); }
            const bf16_t* vb = Vt + (kk * 32 + 4 * g4 + (r16 >> 2)) * KST + 4 * (r16 & 3);
#pragma unroll
            for (int n = 0; n < ND; ++n) {
                const s16x4 lo = tr_read(vb + n * 16), hi = tr_read(vb + 16 * KST + n * 16);
                bf16x8 vf; vf[0] = lo[0]; vf[1] = lo[1]; vf[2] = lo[2]; vf[3] = lo[3]; vf[4] = hi[0]; vf[5] = hi[1]; vf[6] = hi[2]; vf[7] = hi[3];
                o[n] = MFMA16(vf, pb, o[n]);
                if (DH > 64 && (n & 3) == 3) __builtin_amdgcn_sched_barrier(0);
            }
        }
    }
    const size_t tok = (size_t)(qtok0 + qpos * qstep);
    if (MODE == 1) {
#pragma unroll
        for (int n = 0; n < ND; ++n) *(f32x4*)(Of + tok * 256 + n * 16 + g4 * 4) = o[n];
        if (g4 == 0) { Om[tok * 4] = m_; Ol[tok * 4] = l_; }
    } else {
        const float inv = 1.0f / l_;
#pragma unroll
        for (int n = 0; n < ND; ++n) { u32x2 w; w.x = cvt_pk(o[n][0] * inv, o[n][1] * inv); w.y = cvt_pk(o[n][2] * inv, o[n][3] * inv);
            *(u32x2*)(Ob + tok * ldo + n * 16 + g4 * 4) = w; }
    }
}

DEVI void ssd_acs(const DP& p, int l, int b, int c, int g, float* acs, float* dts) {
    const int tid = TIDX(), wid = tid >> 6, lane = tid & 63;
    if (wid < 4) {
        const int head = g * 4 + wid;
        const float* dtv = (const float*)(p.ws() + WS_DTV);
        const float A = -__expf(p.in(12)[l * 8 + head]);
        const size_t t0 = (size_t)b * S + c * 128 + 2 * lane;
        const float d0 = dtv[t0 * 8 + head], d1 = dtv[(t0 + 1) * 8 + head];
        const float a0 = d0 * A, a1 = d1 * A;
        float incl = a0 + a1;
#pragma unroll
        for (int d = 1; d < 64; d <<= 1) { const float t = __shfl_up(incl, d); if (lane >= d) incl += t; }
        const float ex = incl - (a0 + a1);
        acs[wid * 128 + 2 * lane] = ex + a0; acs[wid * 128 + 2 * lane + 1] = ex + a0 + a1;
        dts[wid * 128 + 2 * lane] = d0; dts[wid * 128 + 2 * lane + 1] = d1;
    }
}
DEVI void conv8_chan(const DP& p, int l, const bf16_t* proj, int b, int c, int chan, int l0, float (&out)[8]) {
    const float* cw = p.in(9) + (size_t)l * 4 * 1024 + chan;
    const float w0 = cw[0], w1 = cw[1024], w2 = cw[2048], w3 = cw[3072], cb = p.in(10)[l * 1024 + chan];
    float v[11];
    const int sbase = c * 128 + l0 - 3;
#pragma unroll
    for (int i = 0; i < 11; ++i) { const int sp = sbase + i; v[i] = sp >= 0 ? bf2f(proj[((size_t)b * S + sp) * NPROJ + C_XBC + chan]) : 0.f; }
#pragma unroll
    for (int i = 0; i < 8; ++i) out[i] = silu_f(cb + w0 * v[i] + w1 * v[i + 1] + w2 * v[i + 2] + w3 * v[i + 3]);
}
DEVI void conv8_pos(const DP& p, int l, const bf16_t* proj, int b, int sp, int chan0, float (&out)[8]) {
    float a[8];
    const float* cb = p.in(10) + l * 1024 + chan0;
#pragma unroll
    for (int i = 0; i < 8; ++i) a[i] = cb[i];
#pragma unroll
    for (int j = 0; j < 4; ++j) {
        const int s2 = sp - 3 + j;
        if (s2 >= 0) {
            const u32x4 w = *(const u32x4*)(proj + ((size_t)b * S + s2) * NPROJ + C_XBC + chan0);
            const float* cw = p.in(9) + ((size_t)l * 4 + j) * 1024 + chan0;
            a[0] += cw[0] * bflo(w.x); a[1] += cw[1] * bfhi(w.x); a[2] += cw[2] * bflo(w.y); a[3] += cw[3] * bfhi(w.y);
            a[4] += cw[4] * bflo(w.z); a[5] += cw[5] * bfhi(w.z); a[6] += cw[6] * bflo(w.w); a[7] += cw[7] * bfhi(w.w);
        }
    }
#pragma unroll
    for (int i = 0; i < 8; ++i) out[i] = silu_f(a[i]);
}
DEVI u32x4 pack8(const float (&v)[8]) { u32x4 w; w.x = cvt_pk(v[0], v[1]); w.y = cvt_pk(v[2], v[3]); w.z = cvt_pk(v[4], v[5]); w.w = cvt_pk(v[6], v[7]); return w; }

constexpr int SST = 136;
DEVI void ssd_states_task(const DP& p, int l, int b, int c, int g, char* lds) {
    const int tid = TIDX(), wid = tid >> 6, lane = tid & 63, r16 = lane & 15, g4 = lane >> 4;
    const bf16_t* proj = (const bf16_t*)(p.ws() + WS_PROJ);
    bf16_t* BT = (bf16_t*)lds;
    bf16_t* XT = BT + 128 * SST;
    float* acs = (float*)(XT + 256 * SST);
    float* dts = acs + 512;
    __syncthreads();
    ssd_acs(p, l, b, c, g, acs, dts);
    __syncthreads();
    if (tid < 4) ((float*)(p.ws() + WS_DECAY))[((size_t)b * 16 + c) * 8 + g * 4 + tid] = __expf(acs[tid * 128 + 127]);
    for (int it = tid; it < 2048; it += NTHR) {
        const int n = it & 127, lc = it >> 7;
        float v[8]; conv8_chan(p, l, proj, b, c, 512 + g * 128 + n, lc * 8, v);
        *(u32x4*)(BT + n * SST + lc * 8) = pack8(v);
    }
    for (int it = tid; it < 4096; it += NTHR) {
        const int ch = it & 255, lc = it >> 8, hl = ch >> 6;
        float v[8]; conv8_chan(p, l, proj, b, c, g * 256 + ch, lc * 8, v);
        const float alast = acs[hl * 128 + 127];
#pragma unroll
        for (int i = 0; i < 8; ++i) { const int ll = lc * 8 + i; v[i] *= dts[hl * 128 + ll] * __expf(alast - acs[hl * 128 + ll]); }
        *(u32x4*)(XT + ch * SST + lc * 8) = pack8(v);
    }
    __syncthreads();
    const int hl = wid >> 1, nh = wid & 1;
    f32x4 acc[4][4];
#pragma unroll
    for (int m = 0; m < 4; ++m)
#pragma unroll
        for (int n = 0; n < 4; ++n) acc[m][n] = (f32x4){0.f, 0.f, 0.f, 0.f};
#pragma unroll
    for (int kk = 0; kk < 4; ++kk) {
        bf16x8 af[4], bfr[4];
#pragma unroll
        for (int m = 0; m < 4; ++m) af[m] = *(const bf16x8*)(XT + (hl * 64 + m * 16 + r16) * SST + kk * 32 + g4 * 8);
#pragma unroll
        for (int n = 0; n < 4; ++n) bfr[n] = *(const bf16x8*)(BT + (nh * 64 + n * 16 + r16) * SST + kk * 32 + g4 * 8);
#pragma unroll
        for (int m = 0; m < 4; ++m)
#pragma unroll
            for (int n = 0; n < 4; ++n) acc[m][n] = MFMA16(bfr[n], af[m], acc[m][n]);
    }
    float* st = (float*)(p.ws() + WS_SSTATE) + (((size_t)b * 16 + c) * 8 + g * 4 + hl) * 8192;
#pragma unroll
    for (int m = 0; m < 4; ++m)
#pragma unroll
        for (int n = 0; n < 4; ++n) *(f32x4*)(st + (m * 16 + r16) * 128 + nh * 64 + n * 16 + g4 * 4) = acc[m][n];
}
DEVI void phase_ssd_scan(const DP& p) {
    const float* st = (const float*)(p.ws() + WS_SSTATE);
    bf16_t* hin = (bf16_t*)(p.ws() + WS_HIN);
    const float* decay = (const float*)(p.ws() + WS_DECAY);
    const int total = NB * 8 * 2048;
    for (int i = BIDX() * NTHR + TIDX(); i < total; i += gridDim.x * NTHR) {
        const int e4 = i & 2047, head = (i >> 11) & 7, b = i >> 14;
        f32x4 h = (f32x4){0.f, 0.f, 0.f, 0.f};
        for (int c = 0; c < 16; ++c) {
            const size_t off = (((size_t)b * 16 + c) * 8 + head) * 8192 + e4 * 4;
            u32x2 w; w.x = cvt_pk(h[0], h[1]); w.y = cvt_pk(h[2], h[3]);
            *(u32x2*)(hin + off) = w;
            const f32x4 s = *(const f32x4*)(st + off);
            const float d = decay[((size_t)b * 16 + c) * 8 + head];
            h = h * d + s;
        }
    }
}
DEVI void ssd_out_task(const DP& p, int l, int b, int c, char* lds) {
    const int tid = TIDX(), wid = tid >> 6, lane = tid & 63, r16 = lane & 15, g4 = lane >> 4;
    const bf16_t* proj = (const bf16_t*)(p.ws() + WS_PROJ);
    bf16_t* Cs = (bf16_t*)lds;
    bf16_t* Bs = Cs + 128 * SST;
    bf16_t* XT = Bs + 128 * SST;
    bf16_t* Hs = XT + 64 * SST;
    bf16_t* Mw = Hs + 64 * SST + wid * 16 * SST;
    float* acs = (float*)(Hs + 64 * SST + 8 * 16 * SST);
    float* dts = acs + 512;
    const int lrow = wid * 16 + r16;
    const size_t tok = (size_t)b * S + c * 128 + lrow;
    float* gbuf = (float*)(p.ws() + WS_GBUF);
    float ssq = 0.f;
    for (int g = 0; g < 2; ++g) {
        __syncthreads();
        ssd_acs(p, l, b, c, g, acs, dts);
        for (int it = tid; it < 2048; it += NTHR) {
            const int ll = it >> 4, nc = (it & 15) * 8;
            float v[8];
            conv8_pos(p, l, proj, b, c * 128 + ll, 768 + g * 128 + nc, v);
            *(u32x4*)(Cs + ll * SST + nc) = pack8(v);
            conv8_pos(p, l, proj, b, c * 128 + ll, 512 + g * 128 + nc, v);
            *(u32x4*)(Bs + ll * SST + nc) = pack8(v);
        }
        __syncthreads();
        bf16x8 cfr[4];
#pragma unroll
        for (int kk = 0; kk < 4; ++kk) cfr[kk] = *(const bf16x8*)(Cs + lrow * SST + kk * 32 + g4 * 8);
        f32x4 cb[8];
#pragma unroll
        for (int st = 0; st < 8; ++st) {
            cb[st] = (f32x4){0.f, 0.f, 0.f, 0.f};
#pragma unroll
            for (int kk = 0; kk < 4; ++kk) {
                const bf16x8 bfr = *(const bf16x8*)(Bs + (st * 16 + r16) * SST + kk * 32 + g4 * 8);
                cb[st] = MFMA16(bfr, cfr[kk], cb[st]);
            }
        }
        for (int hl = 0; hl < 4; ++hl) {
            const int head = g * 4 + hl;
            __syncthreads();
            for (int it = tid; it < 1024; it += NTHR) {
                const int pp = it & 63, sc = it >> 6;
                float v[8]; conv8_chan(p, l, proj, b, c, g * 256 + hl * 64 + pp, sc * 8, v);
                *(u32x4*)(XT + pp * SST + sc * 8) = pack8(v);
                const bf16_t* hsrc = (const bf16_t*)(p.ws() + WS_HIN) + (((size_t)b * 16 + c) * 8 + head) * 8192 + (size_t)it * 8;
                *(u32x4*)(Hs + (it >> 4) * SST + (it & 15) * 8) = *(const u32x4*)hsrc;
            }
            __syncthreads();
            const float al = acs[hl * 128 + lrow];
#pragma unroll
            for (int st = 0; st < 8; ++st) {
                float mv[4];
#pragma unroll
                for (int j = 0; j < 4; ++j) { const int sidx = st * 16 + g4 * 4 + j;
                    mv[j] = (sidx <= lrow) ? cb[st][j] * __expf(al - acs[hl * 128 + sidx]) * dts[hl * 128 + sidx] : 0.f; }
                u32x2 w; w.x = cvt_pk(mv[0], mv[1]); w.y = cvt_pk(mv[2], mv[3]);
                *(u32x2*)(Mw + r16 * SST + st * 16 + g4 * 4) = w;
            }
            __builtin_amdgcn_wave_barrier();
            asm volatile("s_waitcnt lgkmcnt(0)" ::: "memory");
            f32x4 yd[4], yo[4];
#pragma unroll
            for (int pt = 0; pt < 4; ++pt) { yd[pt] = (f32x4){0.f, 0.f, 0.f, 0.f}; yo[pt] = (f32x4){0.f, 0.f, 0.f, 0.f}; }
#pragma unroll
            for (int kk = 0; kk < 4; ++kk) {
                const bf16x8 mf = *(const bf16x8*)(Mw + r16 * SST + kk * 32 + g4 * 8);
#pragma unroll
                for (int pt = 0; pt < 4; ++pt) {
                    const bf16x8 xf = *(const bf16x8*)(XT + (pt * 16 + r16) * SST + kk * 32 + g4 * 8);
                    yd[pt] = MFMA16(xf, mf, yd[pt]);
                    const bf16x8 hf = *(const bf16x8*)(Hs + (pt * 16 + r16) * SST + kk * 32 + g4 * 8);
                    yo[pt] = MFMA16(hf, cfr[kk], yo[pt]);
                }
            }
            __builtin_amdgcn_wave_barrier();
            const float el = __expf(al), Dh = p.in(13)[l * 8 + head];
#pragma unroll
            for (int pt = 0; pt < 4; ++pt) {
                const int pc = pt * 16 + g4 * 4;
                const u32x2 zw = *(const u32x2*)(proj + tok * NPROJ + C_Z + head * 64 + pc);
                const float zz[4] = {bflo(zw.x), bfhi(zw.x), bflo(zw.y), bfhi(zw.y)};
                f32x4 gv;
#pragma unroll
                for (int j = 0; j < 4; ++j) {
                    const float xv = bf2f(XT[(pc + j) * SST + lrow]);
                    const float yv = yd[pt][j] + el * yo[pt][j] + Dh * xv;
                    gv[j] = yv * silu_f(zz[j]);
                    ssq += gv[j] * gv[j];
                }
                *(f32x4*)(gbuf + tok * 512 + head * 64 + pc) = gv;
            }
        }
    }
    ssq += __shfl_xor(ssq, 16); ssq += __shfl_xor(ssq, 32);
    const float rstd = rsqrtf(ssq * (1.0f / 512.0f) + EPS);
    bf16_t* mix = (bf16_t*)(p.ws() + WS_MIX);
#pragma unroll
    for (int head = 0; head < 8; ++head)
#pragma unroll
        for (int pt = 0; pt < 4; ++pt) {
            const int pc = pt * 16 + g4 * 4;
            const f32x4 gv = *(const f32x4*)(gbuf + tok * 512 + head * 64 + pc);
            u32x2 w; w.x = cvt_pk(gv[0] * rstd, gv[1] * rstd); w.y = cvt_pk(gv[2] * rstd, gv[3] * rstd);
            *(u32x2*)(mix + tok * DM + 512 + head * 64 + pc) = w;
        }
}

constexpr int N_FOX = 512, N_S1 = 256, N_DIL = 1536;
DEVI void phase_mix1(const DP& p, int l, char* lds) {
    unsigned char* ws = p.ws();
    kv_gemm(p, lds);
    const bf16_t* proj = (const bf16_t*)(ws + WS_PROJ);
    bf16_t* mix = (bf16_t*)(ws + WS_MIX);
    for (int t = BIDX(); t < N_FOX + N_S1 + N_DIL; t += gridDim.x) {
        if (t < N_FOX) {
            const int bh = t & 31, k = t >> 5;
            const int qb = k < 8 ? 15 - k : k - 8;
            const int b = bh >> 2, h = bh & 3;
            const float* cum = (const float*)(ws + WS_CUMF) + (size_t)bh * S;
            attn_task<64, 0>(proj + C_FQ + h * 64, NPROJ, b * S, 1, proj + C_FK + h * 64, proj + C_FV + h * 64, NPROJ, b * S, 1,
                             qb * 128, 0, 2 * qb + 2, 0.125f, cum, nullptr, mix + h * 64, DM, nullptr, nullptr, nullptr, lds);
        } else if (t < N_FOX + N_S1) {
            const int u = t - N_FOX, g = u & 1, c = (u >> 1) & 15, b = u >> 5;
            ssd_states_task(p, l, b, c, g, lds);
        } else {
            const int u = t - N_FOX - N_S1, bh = u & 31, v = u >> 5;
            const int b = bh >> 2, h = bh & 3;
            int br, dil, r, pb;
            if (v < 16) { br = 0; dil = 1; r = 0; pb = v; }
            else if (v < 32) { br = 1; dil = 4; r = (v - 16) & 3; pb = (v - 16) >> 2; }
            else { br = 2; dil = 16; r = v - 32; pb = 0; }
            float* Of = (float*)(ws + WS_DILO) + (size_t)br * T * 256 + h * 64;
            float* Om = (float*)(ws + WS_DILM) + (size_t)br * T * 4 + h;
            float* Ol = (float*)(ws + WS_DILL) + (size_t)br * T * 4 + h;
            const int klo = pb > 0 ? 2 * pb - 2 : 0;
            attn_task<64, 1>(proj + C_DQ + h * 64, NPROJ, b * S + r, dil, proj + C_DK + h * 64, proj + C_DV + h * 64, NPROJ, b * S + r, dil,
                             pb * 128, klo, 2 * pb + 2, 0.125f, nullptr, nullptr, nullptr, 0, Of, Om, Ol, lds);
        }
    }
}
DEVI void phase_mix3(const DP& p, int l, char* lds) {
    unsigned char* ws = p.ws();
    for (int t = BIDX(); t < NB * 16; t += gridDim.x) ssd_out_task(p, l, t >> 4, t & 15, lds);
    const int tid = TIDX(), wid = tid >> 6, lane = tid & 63, head = lane >> 4, d4 = (lane & 15) * 4;
    const float* Of = (const float*)(ws + WS_DILO);
    const float* Om = (const float*)(ws + WS_DILM);
    const float* Ol = (const float*)(ws + WS_DILL);
    bf16_t* mix = (bf16_t*)(ws + WS_MIX);
    for (int row = ((BIDX() + gridDim.x - 128) % gridDim.x) * 8 + wid; row < T; row += gridDim.x * 8) {
        float m[3], lsum[3];
#pragma unroll
        for (int br = 0; br < 3; ++br) { m[br] = Om[((size_t)br * T + row) * 4 + head]; lsum[br] = Ol[((size_t)br * T + row) * 4 + head]; }
        const float M = fmaxf(m[0], fmaxf(m[1], m[2]));
        f32x4 num = (f32x4){0.f, 0.f, 0.f, 0.f}; float den = 0.f;
#pragma unroll
        for (int br = 0; br < 3; ++br) {
            const float w = __builtin_amdgcn_exp2f(m[br] - M);
            const f32x4 o = *(const f32x4*)(Of + ((size_t)br * T + row) * 256 + head * 64 + d4);
            num += o * w; den += w * lsum[br];
        }
        const float inv = 1.0f / den;
        u32x2 w; w.x = cvt_pk(num[0] * inv, num[1] * inv); w.y = cvt_pk(num[2] * inv, num[3] * inv);
        *(u32x2*)(mix + (size_t)row * DM + 256 + head * 64 + d4) = w;
    }
}
DEVI void phase_xattn(const DP& p, int l, char* lds) {
    unsigned char* ws = p.ws();
    const bf16_t* qbuf = (const bf16_t*)(ws + WS_QBUF);
    const bf16_t* kv = (const bf16_t*)(ws + WS_KV);
    bf16_t* obuf = (bf16_t*)(ws + WS_OBUF);
    for (int t = BIDX(); t < NB * 4 * 16; t += gridDim.x) {
        const int qb = t & 15, h = (t >> 4) & 3, b = t >> 6;
        attn_task<256, 2>(qbuf + h * 256, DM, b * S, 1, kv + h * 256, kv + DM + h * 256, 2 * DM, b * MEMLEN, 1,
                          qb * 128, 0, 4, 0.0625f, nullptr, p.in(20) + l * 256, obuf + h * 256, DM, nullptr, nullptr, nullptr, lds);
    }
}
namespace g8 {
template <bool GATHER_> struct MoeSched {
    static constexpr bool GATHER = GATHER_;
    const int* cnt; const int* list; const char* Abase; const char* Bbase; size_t bstride; int K, G;
    int e, ubase, tbase, u;
    DEVI void init(const int* cnt_, const int* list_, const void* A_, const void* B_, size_t bstride_, int K_, int G_, int c_) {
        cnt = cnt_; list = list_; Abase = (const char*)A_; Bbase = (const char*)B_; bstride = bstride_; K = K_; G = G_; e = 0; ubase = 0; tbase = 0; u = c_; }
    DEVI bool next(UnitU& o) {
        while (e < NEXP) {
            const int ce = cnt[e], nte = (ce + BM - 1) / BM, nun = nte * 4;
            if (u < ubase + nun) {
                const int lu = u - ubase, pm = lu >> 2, pn = lu & 3;
                o.i0 = tbase + pm; o.i1 = pn; o.i2 = e * (2 * T) + pm * BM; o.i3 = ce - pm * BM;
                o.A = GATHER ? Abase : Abase + (size_t)(tbase + pm) * BM * K * 2;
                o.B = Bbase + (size_t)e * bstride + (size_t)pn * BM * K * 2;
                u += G; return true;
            }
            ubase += nun; tbase += nte; ++e;
        }
        return false;
    }
    DEVI void lane_va(const UnitU& o, int R0, int C0, int R1, int C1, unsigned& v00, unsigned& v01, unsigned& v10, unsigned& v11) const {
        if (GATHER) {
            const int nv = o.i3; const int* ent = list + o.i2;
            const int t00 = ent[R0 < nv ? R0 : 0] >> 1, t01 = ent[R1 < nv ? R1 : 0] >> 1, t10 = ent[R0 + HALF < nv ? R0 + HALF : 0] >> 1, t11 = ent[R1 + HALF < nv ? R1 + HALF : 0] >> 1;
            v00 = (unsigned)(t00 * K + C0) * 2u; v01 = (unsigned)(t01 * K + C1) * 2u; v10 = (unsigned)(t10 * K + C0) * 2u; v11 = (unsigned)(t11 * K + C1) * 2u;
        } else {
            v00 = (unsigned)(R0 * K + C0) * 2u; v01 = (unsigned)(R1 * K + C1) * 2u; v10 = v00 + (unsigned)(HALF * K * 2); v11 = v01 + (unsigned)(HALF * K * 2);
        }
    }
};
struct EpiSwiglu { static constexpr bool PERM = false; bf16_t* act;
    DEVI void operator()(const f32x4 (&acc)[2][2][4][2], const UnitU& u, int wr, int wc, int fr, int fq) const {
        const int nv = u.i3;
#pragma unroll
        for (int ai = 0; ai < 2; ++ai)
#pragma unroll
            for (int m = 0; m < 4; ++m) {
                const int r = ai * HALF + wr * 64 + m * 16 + fr;
                if (r < nv) {
                    bf16_t* rowp = act + (size_t)(u.i0 * BM + r) * EFF + u.i1 * 128 + wc * 16 + 4 * fq;
#pragma unroll
                    for (int bj = 0; bj < 2; ++bj) { const f32x4 x1 = acc[ai][bj][m][0], x3 = acc[ai][bj][m][1];
                        u32x2 w; w.x = cvt_pk(silu_f(x1[0]) * x3[0], silu_f(x1[1]) * x3[1]); w.y = cvt_pk(silu_f(x1[2]) * x3[2], silu_f(x1[3]) * x3[3]);
                        *(u32x2*)(rowp + bj * 64) = w; }
                }
            }
    } };
struct EpiMoeOut { static constexpr bool PERM = true; bf16_t* y; const int* list; const float* gate;
    DEVI void operator()(const f32x4 (&acc)[2][2][4][2], const UnitU& u, int wr, int wc, int fr, int fq) const {
        const int nv = u.i3; const int* ent = list + u.i2;
#pragma unroll
        for (int ai = 0; ai < 2; ++ai)
#pragma unroll
            for (int m = 0; m < 4; ++m) {
                const int r = ai * HALF + wr * 64 + m * 16 + fr;
                if (r < nv) {
                    const int a = ent[r]; const float gt = gate[a];
                    bf16_t* rowp = y + (size_t)a * DM + u.i1 * BM + wc * 32 + 8 * fq;
#pragma unroll
                    for (int bj = 0; bj < 2; ++bj) { const f32x4 v0 = acc[ai][bj][m][0] * gt, v1 = acc[ai][bj][m][1] * gt;
                        u32x4 w; w.x = cvt_pk(v0[0], v0[1]); w.y = cvt_pk(v0[2], v0[3]); w.z = cvt_pk(v1[0], v1[1]); w.w = cvt_pk(v1[2], v1[3]);
                        *(u32x4*)(rowp + bj * HALF) = w; }
                }
            }
    } };
}
template <int WHICH>
DEVI void phase_moe(const DP& p, int l, char* lds) {
    unsigned char* ws = p.ws();
    const int* cnt = (const int*)(ws + WS_CNT) + l * 64;
    const int* list = (const int*)(ws + WS_LIST);
    if (WHICH == 0) {
        g8::MoeSched<true> S;
        S.init(cnt, list, ws + WS_HBUF, ws + WS_W_13, (size_t)1024 * DM * 2, DM, gridDim.x, BIDX());
        g8::EpiSwiglu E{(bf16_t*)(ws + WS_ACT)};
        g8::gemm8(lds, DM, S, E);
    } else {
        g8::MoeSched<false> S;
        S.init(cnt, list, ws + WS_ACT, ws + WS_W_2, (size_t)DM * EFF * 2, EFF, gridDim.x, BIDX());
        g8::EpiMoeOut E{(bf16_t*)(ws + WS_YBUF), list, (const float*)(ws + WS_GATE)};
        g8::gemm8(lds, EFF, S, E);
    }
}
DEVI void phase_final(const DP& p) {
    const int tid = TIDX(), wid = tid >> 6, lane = tid & 63;
    const bf16_t* ybuf = (const bf16_t*)(p.ws() + WS_YBUF);
    for (int row = BIDX() * 8 + wid; row < T; row += gridDim.x * 8) {
        float x[16];
        load_row_f32(p.out() + (size_t)row * DM, x, lane);
        add_row_bf16(ybuf + (size_t)(2 * row) * DM, x, lane);
        add_row_bf16(ybuf + (size_t)(2 * row + 1) * DM, x, lane);
        store_row_f32(p.out() + (size_t)row * DM, x, lane);
    }
}


#define XB_TMO      128
#define XB_XCNT(j)  (256  + 64 * (j))
#define XB_XSUB(j)  (1280 + 64 * (j))
#define XB_XGEN(j)  (2304 + 64 * (j))
#define XB_TOP      3328
#define XB_TOPGEN   3392
#define XCD_BAR_WORDS 3456
#define XB_SPIN_CAP (1u << 22)
DEVI unsigned xb_ld(unsigned* p)              { return __hip_atomic_load(p, __ATOMIC_RELAXED, __HIP_MEMORY_SCOPE_AGENT); }
DEVI unsigned xb_add(unsigned* p, unsigned v) { return __hip_atomic_fetch_add(p, v, __ATOMIC_RELAXED, __HIP_MEMORY_SCOPE_AGENT); }
DEVI unsigned xb_xcc_id() { return (unsigned)__builtin_amdgcn_s_getreg((3 << 11) | 20) & 0xFu; }
#define XB_SPIN(cond, bar) do { unsigned _sp = 0; while (cond) { __builtin_amdgcn_s_sleep(1); \
    if ((++_sp & 255u) == 0u) { if (xb_ld(&(bar)[XB_TMO])) break; if (_sp > XB_SPIN_CAP) { atomicAdd(&(bar)[XB_TMO], 1u); break; } } } } while (0)
struct XcdBarrier { unsigned* bar; unsigned x; volatile LAS unsigned* st; };
DEVI XcdBarrier xcd_barrier_post(unsigned* bar, volatile LAS unsigned* st) {
    XcdBarrier b; b.bar = bar; b.x = xb_xcc_id(); b.st = st;
    if (threadIdx.x == 0) (void)xb_add(&bar[XB_XCNT(b.x)], 1u);
    return b;
}
DEVI void xcd_barrier_complete(unsigned* bar, unsigned x, unsigned& nloc, unsigned& nx) {
    const unsigned G = gridDim.x * gridDim.y * gridDim.z;
    unsigned sum, cnt, mine, sp = 0u;
    for (;;) {
        sum = 0u; cnt = 0u; mine = 0u;
#pragma unroll
        for (unsigned j = 0; j < 16; ++j) { const unsigned c = xb_ld(&bar[XB_XCNT(j)]); sum += c; cnt += (c > 0u) ? 1u : 0u; mine = (j == x) ? c : mine; }
        if (sum == G) break;
        __builtin_amdgcn_s_sleep(1);
        if ((++sp & 255u) == 0u) { if (xb_ld(&bar[XB_TMO])) break; if (sp > XB_SPIN_CAP) { atomicAdd(&bar[XB_TMO], 1u); break; } }
    }
    nloc = mine > 0u ? mine : 1u; nx = cnt > 0u ? cnt : 1u;
}
DEVI void xcd_barrier(const XcdBarrier& b) {
    asm volatile("s_waitcnt vmcnt(0)" ::: "memory");
    __syncthreads();
    if (threadIdx.x == 0) {
        unsigned* bar = b.bar;
        __builtin_amdgcn_s_waitcnt(0);
        unsigned nloc = b.st[0], nx = b.st[1];
        if (nloc == 0u) { xcd_barrier_complete(bar, b.x, nloc, nx); b.st[0] = nloc; b.st[1] = nx; }
        const unsigned old = xb_add(&bar[XB_XSUB(b.x)], 1u);
        const unsigned gen = old / nloc;
        if (old + 1u == (gen + 1u) * nloc) {
            __builtin_amdgcn_fence(__ATOMIC_RELEASE, "agent");
            asm volatile("s_waitcnt vmcnt(0)" ::: "memory");
            const unsigned og = xb_add(&bar[XB_TOP], 1u);
            const unsigned tg = og / nx;
            if (og + 1u == (tg + 1u) * nx) xb_add(&bar[XB_TOPGEN], 1u);
            else XB_SPIN(xb_ld(&bar[XB_TOPGEN]) == tg, bar);
            __builtin_amdgcn_fence(__ATOMIC_ACQUIRE, "agent");
            xb_add(&bar[XB_XGEN(b.x)], 1u);
            asm volatile("s_waitcnt vmcnt(0)" ::: "memory");
        } else {
            XB_SPIN(xb_ld(&bar[XB_XGEN(b.x)]) == gen, bar);
            __builtin_amdgcn_fence(__ATOMIC_ACQUIRE, "agent");
            asm volatile("s_waitcnt vmcnt(0)" ::: "memory");
        }
    }
    __syncthreads();
}

constexpr int N_PHASES = 30;
__global__ void __launch_bounds__(NTHR) hybrid_fwd(Params p_unused) {
    extern __shared__ __attribute__((aligned(16))) char lds_base[];
    karg_ptr kp = (karg_ptr)__builtin_amdgcn_kernarg_segment_ptr();
    int ph_lo, ph_hi, use_gs;
    { DP q{kp}; ph_lo = q.ph_lo(); ph_hi = q.ph_hi(); use_gs = q.use_gs(); }
    volatile LAS unsigned* xst = (volatile LAS unsigned*)(LAS char*)(lds_base + LDS_BYTES - 16);
    if (threadIdx.x == 0) { xst[0] = 0u; xst[1] = 0u; }
    __syncthreads();
    XcdBarrier xb; xb.bar = nullptr; xb.x = 0; xb.st = xst;
    if (use_gs == 1) { DP q{kp}; xb = xcd_barrier_post((unsigned*)(q.ws() + WS_BAR), xst); }
#define RUN_PHASE(PH, ...) \
    if (ph_lo <= (PH) && (PH) < ph_hi) { \
        if ((PH) > ph_lo) { if (use_gs == 1) xcd_barrier(xb); else if (use_gs == 2) cg::this_grid().sync(); } \
        asm volatile("" : "+s"(kp) :: "memory"); \
        const DP p{kp}; \
        unsigned lds_off = 0; asm volatile("" : "+s"(lds_off)); \
        char* lds = lds_base + lds_off; \
        unsigned char* ws = p.ws(); (void)ws; (void)lds; \
        __VA_ARGS__ \
    }
#define LAYER_PHASES(L, B0) \
    RUN_PHASE((B0) + 0, { if ((L) == 1) { for (int u = BIDX(); u < PREP_UNITS; u += gridDim.x) prep_unit(p, 1, u, (float*)lds); } __syncthreads(); phase_norm1(p, (L), lds); }) \
    RUN_PHASE((B0) + 1, { phase_inproj(p, (L), lds); }) \
    RUN_PHASE((B0) + 2, { phase_post(p, (L)); }) \
    RUN_PHASE((B0) + 3, { phase_mix1(p, (L), lds); }) \
    RUN_PHASE((B0) + 4, { phase_ssd_scan(p); phase_knorm(p, (L)); }) \
    RUN_PHASE((B0) + 5, { phase_mix3(p, (L), lds); }) \
    RUN_PHASE((B0) + 6, { const float* x_in = (L) == 0 ? p.in(0) : p.out(); float* x1 = (L) == 0 ? p.out() : (float*)(ws + WS_XB); \
                          g8::DenseSched S; S.init((const bf16_t*)(ws + WS_MIX), (const bf16_t*)(ws + WS_W_OUT), T, DM, DM, gridDim.x, BIDX()); \
                          g8::EpiRes E{x_in, x1, DM}; g8::gemm8(lds, DM, S, E); }) \
    RUN_PHASE((B0) + 7, { const float* x1 = (L) == 0 ? p.out() : (const float*)(ws + WS_XB); phase_norm2(p, (L), x1); }) \
    RUN_PHASE((B0) + 8, { g8::DenseSched S; S.init((const bf16_t*)(ws + WS_HBUF), (const bf16_t*)(ws + WS_W_Q), T, DM, DM, gridDim.x, BIDX()); \
                          g8::EpiBf16 E{(bf16_t*)(ws + WS_QBUF), DM}; g8::gemm8(lds, DM, S, E); }) \
    RUN_PHASE((B0) + 9, { phase_xattn(p, (L), lds); }) \
    RUN_PHASE((B0) + 10, { const float* x1 = (L) == 0 ? p.out() : (const float*)(ws + WS_XB); float* x2 = (L) == 0 ? (float*)(ws + WS_XB) : p.out(); \
                           g8::DenseSched S; S.init((const bf16_t*)(ws + WS_OBUF), (const bf16_t*)(ws + WS_W_O), T, DM, DM, gridDim.x, BIDX()); \
                           g8::EpiRes E{x1, x2, DM}; g8::gemm8(lds, DM, S, E); }) \
    RUN_PHASE((B0) + 11, { const float* x2 = (L) == 0 ? (const float*)(ws + WS_XB) : p.out(); phase_norm3(p, (L), x2, lds); }) \
    RUN_PHASE((B0) + 12, { phase_moe<0>(p, (L), lds); }) \
    RUN_PHASE((B0) + 13, { phase_moe<1>(p, (L), lds); })

    RUN_PHASE(0, { prep_small(p); for (int u = BIDX(); u < PREP_UNITS; u += gridDim.x) prep_unit(p, 0, u, (float*)lds); })
    LAYER_PHASES(0, 1)
    LAYER_PHASES(1, 15)
    RUN_PHASE(29, { phase_final(p); })
#undef LAYER_PHASES
#undef RUN_PHASE
}

extern "C" void kernel_launch(void* const* d_in, const int* in_sizes, int n_in, void* d_out, int out_size, void* d_ws, size_t ws_size, hipStream_t stream) {
    static int grid = 0;
    if (grid == 0) {
        if (n_in != 31 || out_size != T * DM || ws_size < WS_END) { fprintf(stderr, "kernel_launch: unexpected shapes (n_in %d out %d ws %zu need %zu)\n", n_in, out_size, ws_size, (size_t)WS_END); grid = -1; return; }
        int dev = 0, cus = 0, per_cu = 0;
        hipGetDevice(&dev);
        hipDeviceGetAttribute(&cus, hipDeviceAttributeMultiprocessorCount, dev);
        hipFuncSetAttribute((const void*)hybrid_fwd, hipFuncAttributeMaxDynamicSharedMemorySize, LDS_BYTES);
        hipOccupancyMaxActiveBlocksPerMultiprocessor(&per_cu, (const void*)hybrid_fwd, NTHR, LDS_BYTES);
        if (per_cu < 1) { fprintf(stderr, "kernel_launch: occupancy query says %d blocks per CU\n", per_cu); per_cu = 1; }
        (void)hipGetLastError();
        grid = cus;
    }
    if (grid < 0) return;
    Params p{};
    for (int i = 0; i < 31; ++i) p.in[i] = (const float*)d_in[i];
    p.out = (float*)d_out; p.ws = (unsigned char*)d_ws;
    p.use_grid_sync = 1; p.pad = 0;
    p.ph_lo = 0; p.ph_hi = N_PHASES;
    if (hipMemsetAsync((unsigned char*)d_ws + WS_BAR, 0, XCD_BAR_WORDS * 4, stream) != hipSuccess) { fprintf(stderr, "kernel_launch: memset failed\n"); return; }
    void* args[] = {&p};
    hipError_t e = hipLaunchCooperativeKernel((const void*)hybrid_fwd, dim3(grid), dim3(NTHR), args, LDS_BYTES, stream);
    if (e != hipSuccess) fprintf(stderr, "kernel_launch: cooperative launch failed: %s (grid %d)\n", hipGetErrorString(e), grid);
}
```

```cpp
#include <hip/hip_runtime.h>
#include <hip/hip_cooperative_groups.h>
#include <cstdio>
#include <cstdint>
namespace cg = cooperative_groups;

typedef unsigned short bf16_t;
typedef short bf16x8 __attribute__((ext_vector_type(8)));
typedef short s16x4 __attribute__((ext_vector_type(4)));
typedef float f32x4 __attribute__((ext_vector_type(4)));
typedef unsigned u32x4 __attribute__((ext_vector_type(4)));
typedef unsigned u32x2 __attribute__((ext_vector_type(2)));
#define DEVI __device__ __forceinline__
#define LAS __attribute__((address_space(3)))

constexpr int NB = 8, S = 2048, DM = 1024, T = NB * S, DEPTH = 2;
constexpr int INP = 3084, NPROJ = 3072;
constexpr int C_FQ = 0, C_FK = 256, C_FV = 512, C_DQ = 768, C_DK = 1024, C_DV = 1280, C_Z = 1536, C_XBC = 2048;
constexpr int MEMLEN = 256, MROWS = NB * MEMLEN;
constexpr int NEXP = 32, EFF = 512;
constexpr float EPS = 1e-6f;
constexpr int NTHR = 512;
constexpr int LDS_BYTES = 151552;

constexpr size_t al256(size_t x) { return (x + 255) & ~(size_t)255; }
constexpr size_t WS_W_IN = 0;
constexpr size_t WS_W_OUT = WS_W_IN + (size_t)NPROJ * DM * 2;
constexpr size_t WS_W_Q = WS_W_OUT + (size_t)DM * DM * 2;
constexpr size_t WS_W_KV = WS_W_Q + (size_t)DM * DM * 2;
constexpr size_t WS_W_O = WS_W_KV + (size_t)2 * DM * DM * 2;
constexpr size_t WS_W_13 = WS_W_O + (size_t)DM * DM * 2;
constexpr size_t WS_W_2 = WS_W_13 + (size_t)NEXP * 1024 * DM * 2;
constexpr size_t WS_WSMALL = WS_W_2 + (size_t)NEXP * DM * EFF * 2;
constexpr size_t WS_WROUT = WS_WSMALL + (size_t)DEPTH * 12 * DM * 4;
constexpr size_t WS_XB = WS_WROUT + (size_t)DEPTH * 36 * DM * 4;
constexpr size_t WS_HBUF = WS_XB + (size_t)T * DM * 4;
constexpr size_t WS_PROJ = WS_HBUF + (size_t)T * DM * 2;
constexpr size_t WS_QBUF = WS_PROJ;
constexpr size_t WS_OBUF = WS_PROJ + (size_t)T * DM * 2;
constexpr size_t WS_ACT = WS_PROJ;
constexpr size_t WS_MIX = WS_PROJ + (size_t)T * NPROJ * 2;
constexpr size_t WS_U = WS_MIX + (size_t)T * DM * 2;
constexpr size_t WS_YBUF = WS_U;
constexpr size_t WS_DILO = WS_U;
constexpr size_t WS_DILM = WS_DILO + (size_t)3 * T * 256 * 4;
constexpr size_t WS_DILL = WS_DILM + (size_t)3 * T * 4 * 4;
constexpr size_t WS_SSTATE = WS_DILL + (size_t)3 * T * 4 * 4;
constexpr size_t WS_HIN = WS_SSTATE + (size_t)NB * 16 * 8 * 8192 * 4;
constexpr size_t WS_GBUF = WS_HIN + (size_t)NB * 16 * 8 * 8192 * 2;
constexpr size_t WS_U_END = WS_GBUF + (size_t)T * 512 * 4;
constexpr size_t WS_MEMN = WS_U_END;
constexpr size_t WS_KV = WS_MEMN + (size_t)MROWS * DM * 2;
constexpr size_t WS_LOGF = WS_KV + (size_t)MROWS * 2 * DM * 2;
constexpr size_t WS_CUMF = WS_LOGF + (size_t)T * 4 * 4;
constexpr size_t WS_DTV = WS_CUMF + (size_t)T * 4 * 4;
constexpr size_t WS_DECAY = WS_DTV + (size_t)T * 8 * 4;
constexpr size_t WS_CNT = WS_DECAY + (size_t)NB * 16 * 8 * 4;
constexpr size_t WS_LIST = WS_CNT + 1024;
constexpr size_t WS_GATE = WS_LIST + (size_t)NEXP * 2 * T * 4;
constexpr size_t WS_BAR = WS_GATE + (size_t)2 * T * 4;
constexpr size_t WS_XC = WS_BAR + 65536;
constexpr size_t WS_SSQ = WS_XC + (size_t)T * 1024 * 2;
constexpr size_t WS_END = WS_SSQ + (size_t)T * 2 * 4;
static_assert(WS_YBUF + (size_t)2 * T * DM * 2 <= WS_U_END, "ybuf alias");
static_assert(WS_OBUF + (size_t)T * DM * 2 <= WS_MIX, "obuf alias");

struct Params {
    const float* in[31];
    float* out;
    unsigned char* ws;
    int ph_lo, ph_hi;
    int use_grid_sync, pad;
};


typedef __attribute__((address_space(4))) const unsigned long long* karg_ptr;
typedef __attribute__((address_space(1))) const float* gcf_ptr;
typedef __attribute__((address_space(1))) float* gf_ptr;
typedef __attribute__((address_space(1))) unsigned char* gb_ptr;
struct DP {
    karg_ptr kp;
    DEVI const float* in(int i) const { return (const float*)(gcf_ptr)(kp[i]); }
    DEVI float* out() const { return (float*)(gf_ptr)(kp[31]); }
    DEVI unsigned char* ws() const { return (unsigned char*)(gb_ptr)(kp[32]); }
    DEVI int ph_lo() const { return (int)(unsigned)kp[33]; }
    DEVI int ph_hi() const { return (int)(unsigned)(kp[33] >> 32); }
    DEVI int use_gs() const { return (int)(unsigned)kp[34]; }
};

DEVI int TIDX() { int t = threadIdx.x; asm volatile("" : "+v"(t)); return t; }
DEVI int BIDX() { int b = blockIdx.x; asm volatile("" : "+s"(b)); return b; }
DEVI float bf2f(bf16_t v) { return __uint_as_float(((unsigned)v) << 16); }
typedef float f32x2 __attribute__((ext_vector_type(2)));
typedef __bf16 bf16x2_t __attribute__((ext_vector_type(2)));
DEVI unsigned cvt_pk(float lo, float hi) { f32x2 v = {lo, hi}; bf16x2_t b = __builtin_convertvector(v, bf16x2_t); return __builtin_bit_cast(unsigned, b); }
DEVI bf16_t f2bf(float f) { return (bf16_t)(cvt_pk(f, 0.f) & 0xffffu); }
DEVI float bflo(unsigned w) { return __uint_as_float(w << 16); }
DEVI float bfhi(unsigned w) { return __uint_as_float(w & 0xffff0000u); }
DEVI float wave_sum(float v) {
#pragma unroll
    for (int m = 32; m >= 1; m >>= 1) v += __shfl_xor(v, m);
    return v;
}
DEVI float silu_f(float x) { return x / (1.f + __expf(-x)); }
DEVI float softplus_f(float x) { return x > 20.f ? x : log1pf(__expf(x)); }
DEVI float logsigmoid_f(float x) { return x >= 0.f ? -log1pf(__expf(-x)) : x - log1pf(__expf(x)); }
#define MFMA16(a, b, c) __builtin_amdgcn_mfma_f32_16x16x32_bf16(a, b, c, 0, 0, 0)
DEVI s16x4 tr_read(const bf16_t* p) {
    return __builtin_bit_cast(s16x4, __builtin_amdgcn_ds_read_tr16_b64_v4i16((LAS s16x4*)p));
}

DEVI int maprow(int mode, int n) { return mode == 0 ? n : ((n >> 4) * 32 + (n & 15) + (mode == 2 ? 16 : 0)); }
DEVI void prep_tile(const float* __restrict__ src, int ld, int k0, int c0, bf16_t* __restrict__ dst, int dstld, int mode, int n0,
                    const float* __restrict__ kscale, int ks_from, float* tl) {
    const int tid = TIDX();
#pragma unroll
    for (int i = 0; i < 2; ++i) {
        const int k = (tid >> 4) + 32 * i, n4 = (tid & 15) * 4;
        const float4 v = *(const float4*)(src + (size_t)(k0 + k) * ld + c0 + n4);
        float sc = 1.f;
        if (kscale != nullptr && (k0 + k) >= ks_from) sc = kscale[k0 + k - ks_from];
        tl[k * 65 + n4 + 0] = v.x * sc; tl[k * 65 + n4 + 1] = v.y * sc; tl[k * 65 + n4 + 2] = v.z * sc; tl[k * 65 + n4 + 3] = v.w * sc;
    }
    __syncthreads();
    {
        const int n = tid >> 3, kc = (tid & 7) * 8;
        u32x4 w;
        w.x = cvt_pk(tl[(kc + 0) * 65 + n], tl[(kc + 1) * 65 + n]);
        w.y = cvt_pk(tl[(kc + 2) * 65 + n], tl[(kc + 3) * 65 + n]);
        w.z = cvt_pk(tl[(kc + 4) * 65 + n], tl[(kc + 5) * 65 + n]);
        w.w = cvt_pk(tl[(kc + 6) * 65 + n], tl[(kc + 7) * 65 + n]);
        const int drow = maprow(mode, n0 + n);
        *(u32x4*)(dst + (size_t)drow * dstld + k0 + kc) = w;
    }
    __syncthreads();
}

constexpr int PREP_UNITS = 2048 + 3 * 4096;
DEVI void prep_unit(const DP& p, int l, int u, float* tl) {
    unsigned char* ws = p.ws();
    if (u < 768) {
        const int kt = u / 48, nt = u % 48, n0 = nt * 64, c0 = n0 < 768 ? n0 : n0 + 4;
        prep_tile(p.in(3) + (size_t)l * DM * INP, INP, kt * 64, c0, (bf16_t*)(ws + WS_W_IN), DM, 0, n0, nullptr, 0, tl);
    } else if (u < 1024) {
        const int v = u - 768, kt = v / 16, nt = v % 16;
        prep_tile(p.in(15) + (size_t)l * DM * DM, DM, kt * 64, nt * 64, (bf16_t*)(ws + WS_W_OUT), DM, 0, nt * 64, p.in(14) + l * 512, 512, tl);
    } else if (u < 1280) {
        const int v = u - 1024, kt = v / 16, nt = v % 16;
        prep_tile(p.in(18) + (size_t)l * DM * DM, DM, kt * 64, nt * 64, (bf16_t*)(ws + WS_W_Q), DM, 0, nt * 64, nullptr, 0, tl);
    } else if (u < 1792) {
        const int v = u - 1280, kt = v / 32, nt = v % 32;
        prep_tile(p.in(19) + (size_t)l * DM * 2 * DM, 2 * DM, kt * 64, nt * 64, (bf16_t*)(ws + WS_W_KV), DM, 0, nt * 64, nullptr, 0, tl);
    } else if (u < 2048) {
        const int v = u - 1792, kt = v / 16, nt = v % 16;
        prep_tile(p.in(22) + (size_t)l * DM * DM, DM, kt * 64, nt * 64, (bf16_t*)(ws + WS_W_O), DM, 0, nt * 64, nullptr, 0, tl);
    } else if (u < 2048 + 8192) {
        const int v = u - 2048, which = v / 4096, w = v % 4096, e = w / 128, tI = w % 128, kt = tI / 8, nt = tI % 8;
        const float* src = (which == 0 ? p.in(28) : p.in(29)) + ((size_t)l * NEXP + e) * DM * EFF;
        prep_tile(src, EFF, kt * 64, nt * 64, (bf16_t*)(ws + WS_W_13) + (size_t)e * 1024 * DM, DM, which == 0 ? 1 : 2, nt * 64, nullptr, 0, tl);
    } else {
        const int w = u - 2048 - 8192, e = w / 128, tI = w % 128, kt = tI / 16, nt = tI % 16;
        const float* src = p.in(30) + ((size_t)l * NEXP + e) * EFF * DM;
        prep_tile(src, DM, kt * 64, nt * 64, (bf16_t*)(ws + WS_W_2) + (size_t)e * DM * EFF, EFF, 0, nt * 64, nullptr, 0, tl);
    }
}
DEVI void prep_small(const DP& p) {
    float* wsm = (float*)(p.ws() + WS_WSMALL);
    float* wro = (float*)(p.ws() + WS_WROUT);
    const int gtid = BIDX() * NTHR + TIDX(), gn = gridDim.x * NTHR;
    for (int i = gtid; i < DEPTH * 12 * DM; i += gn) {
        const int l = i / (12 * DM), r = i % (12 * DM), c = r / DM, k = r % DM;
        const int col = c < 4 ? 768 + c : 3076 + (c - 4);
        wsm[i] = p.in(3)[((size_t)l * DM + k) * INP + col];
    }
    for (int i = gtid; i < DEPTH * 36 * DM; i += gn) {
        const int l = i / (36 * DM), r = i % (36 * DM), c = r / DM, k = r % DM;
        wro[i] = c < 4 ? p.in(24)[((size_t)l * DM + k) * 4 + c] : p.in(26)[((size_t)l * DM + k) * 32 + (c - 4)];
    }
    if (BIDX() == 0 && TIDX() < 128) ((int*)(p.ws() + WS_CNT))[TIDX()] = 0;
}

DEVI void store_h_bf16(bf16_t* hrow, const float (&h)[16], int lane) {
#pragma unroll
    for (int j = 0; j < 4; ++j) {
        u32x2 w; w.x = cvt_pk(h[4 * j], h[4 * j + 1]); w.y = cvt_pk(h[4 * j + 2], h[4 * j + 3]);
        *(u32x2*)(hrow + j * 256 + lane * 4) = w;
    }
}
DEVI void load_row_f32(const float* xr, float (&x)[16], int lane) {
#pragma unroll
    for (int j = 0; j < 4; ++j) { const float4 v = *(const float4*)(xr + j * 256 + lane * 4); x[4 * j] = v.x; x[4 * j + 1] = v.y; x[4 * j + 2] = v.z; x[4 * j + 3] = v.w; }
}
DEVI void add_row_bf16(const bf16_t* yr, float (&x)[16], int lane) {
#pragma unroll
    for (int j = 0; j < 4; ++j) { const u32x2 w = *(const u32x2*)(yr + j * 256 + lane * 4); x[4 * j] += bflo(w.x); x[4 * j + 1] += bfhi(w.x); x[4 * j + 2] += bflo(w.y); x[4 * j + 3] += bfhi(w.y); }
}
DEVI void store_row_f32(float* xr, const float (&x)[16], int lane) {
#pragma unroll
    for (int j = 0; j < 4; ++j) *(float4*)(xr + j * 256 + lane * 4) = make_float4(x[4 * j], x[4 * j + 1], x[4 * j + 2], x[4 * j + 3]);
}
DEVI void norm_row(const float (&x)[16], const float* g, float (&h)[16], int lane) {
    float ss = 0.f;
#pragma unroll
    for (int i = 0; i < 16; ++i) ss += x[i] * x[i];
    ss = wave_sum(ss);
    const float rstd = rsqrtf(ss * (1.0f / DM) + EPS);
#pragma unroll
    for (int j = 0; j < 4; ++j) { const float4 gv = *(const float4*)(g + j * 256 + lane * 4);
        h[4 * j] = x[4 * j] * rstd * gv.x; h[4 * j + 1] = x[4 * j + 1] * rstd * gv.y; h[4 * j + 2] = x[4 * j + 2] * rstd * gv.z; h[4 * j + 3] = x[4 * j + 3] * rstd * gv.w; }
}
DEVI float dot_lds(const float (&h)[16], const float* wrow, int lane) {
    float a = 0.f;
#pragma unroll
    for (int j = 0; j < 4; ++j) { const float4 w = *(const float4*)(wrow + j * 256 + lane * 4); a += h[4 * j] * w.x + h[4 * j + 1] * w.y + h[4 * j + 2] * w.z + h[4 * j + 3] * w.w; }
    return a;
}

DEVI void phase_norm1(const DP& p, int l, char* lds) {
    const int tid = TIDX(), wid = tid >> 6, lane = tid & 63;
    unsigned char* ws = p.ws();
    float* wsl = (float*)lds;
    { const float4* src = (const float4*)((const float*)(ws + WS_WSMALL) + (size_t)l * 12 * DM);
      for (int i = tid; i < 12 * DM / 4; i += NTHR) ((float4*)wsl)[i] = src[i]; }
    __syncthreads();
    const float* xin = l == 0 ? p.in(0) : (const float*)(ws + WS_XB);
    float* xout = p.out();
    const bf16_t* ybuf = (const bf16_t*)(ws + WS_YBUF);
    bf16_t* hbuf = (bf16_t*)(ws + WS_HBUF);
    const float* g1 = p.in(2) + l * DM;
    float* logf = (float*)(ws + WS_LOGF);
    float* dtv = (float*)(ws + WS_DTV);
    for (int row = BIDX() * 8 + wid; row < T; row += gridDim.x * 8) {
        float x[16], h[16];
        load_row_f32(xin + (size_t)row * DM, x, lane);
        if (l > 0) {
            add_row_bf16(ybuf + (size_t)(2 * row) * DM, x, lane);
            add_row_bf16(ybuf + (size_t)(2 * row + 1) * DM, x, lane);
            store_row_f32(xout + (size_t)row * DM, x, lane);
        }
        norm_row(x, g1, h, lane);
        store_h_bf16(hbuf + (size_t)row * DM, h, lane);
        float keep = 0.f;
#pragma unroll 2
        for (int c = 0; c < 12; ++c) { const float v = wave_sum(dot_lds(h, wsl + c * DM, lane)); keep = (lane == c) ? v : keep; }
        if (lane < 4) logf[(size_t)row * 4 + lane] = logsigmoid_f(keep + p.in(4)[l * 4 + lane]);
        else if (lane < 12) dtv[(size_t)row * 8 + lane - 4] = softplus_f(keep + p.in(11)[l * 8 + lane - 4]);
    }
    const float* gm = p.in(17) + l * DM;
    bf16_t* memn = (bf16_t*)(ws + WS_MEMN);
    for (int row = BIDX() * 8 + wid; row < MROWS; row += gridDim.x * 8) {
        float x[16], h[16];
        load_row_f32(p.in(1) + (size_t)row * DM, x, lane);
        norm_row(x, gm, h, lane);
        store_h_bf16(memn + (size_t)row * DM, h, lane);
    }
}
DEVI void phase_norm2(const DP& p, int l, const float* xin) {
    const int tid = TIDX(), wid = tid >> 6, lane = tid & 63;
    bf16_t* hbuf = (bf16_t*)(p.ws() + WS_HBUF);
    const float* g = p.in(16) + l * DM;
    for (int row = BIDX() * 8 + wid; row < T; row += gridDim.x * 8) {
        float x[16], h[16];
        load_row_f32(xin + (size_t)row * DM, x, lane);
        norm_row(x, g, h, lane);
        store_h_bf16(hbuf + (size_t)row * DM, h, lane);
    }
}
DEVI void phase_norm3(const DP& p, int l, const float* xin, char* lds) {
    const int tid = TIDX(), wid = tid >> 6, lane = tid & 63;
    unsigned char* ws = p.ws();
    float* wr = (float*)lds;
    { const float4* src = (const float4*)((const float*)(ws + WS_WROUT) + (size_t)l * 36 * DM);
      for (int i = tid; i < 36 * DM / 4; i += NTHR) ((float4*)wr)[i] = src[i]; }
    __syncthreads();
    bf16_t* hbuf = (bf16_t*)(ws + WS_HBUF);
    const float* g = p.in(23) + l * DM;
    int* cnt = (int*)(ws + WS_CNT) + l * 64;
    int* list = (int*)(ws + WS_LIST);
    float* gate = (float*)(ws + WS_GATE);
    const float* bg = p.in(25) + l * 4;
    const float* be = p.in(27) + l * 32;
    for (int row = BIDX() * 8 + wid; row < T; row += gridDim.x * 8) {
        float x[16], h[16];
        load_row_f32(xin + (size_t)row * DM, x, lane);
        norm_row(x, g, h, lane);
        store_h_bf16(hbuf + (size_t)row * DM, h, lane);
        float gl[4];
#pragma unroll
        for (int c = 0; c < 4; ++c) gl[c] = wave_sum(dot_lds(h, wr + c * DM, lane)) + bg[c];
        int gsel = 0; float gmax = gl[0];
#pragma unroll
        for (int c = 1; c < 4; ++c) if (gl[c] > gmax) { gmax = gl[c]; gsel = c; }
        float gden = 0.f;
#pragma unroll
        for (int c = 0; c < 4; ++c) gden += __expf(gl[c] - gmax);
        const float ggate = 1.0f / gden;
        gsel = __builtin_amdgcn_readfirstlane(gsel);
        float el[8];
#pragma unroll
        for (int c = 0; c < 8; ++c) el[c] = wave_sum(dot_lds(h, wr + (4 + gsel * 8 + c) * DM, lane)) + be[gsel * 8 + c];
        int i1 = 0; float v1 = el[0];
#pragma unroll
        for (int c = 1; c < 8; ++c) if (el[c] > v1) { v1 = el[c]; i1 = c; }
        int i2 = (i1 == 0) ? 1 : 0; float v2 = -3.0e38f;
#pragma unroll
        for (int c = 0; c < 8; ++c) if (c != i1 && el[c] > v2) { v2 = el[c]; i2 = c; }
        const float e2 = __expf(v2 - v1), inv = 1.0f / (1.0f + e2);
        const float ga = inv * ggate, gb = e2 * inv * ggate;
        if (lane == 0) {
            const int ea = gsel * 8 + i1, eb = gsel * 8 + i2;
            const int sa = atomicAdd(&cnt[ea], 1);
            list[(size_t)ea * (2 * T) + sa] = 2 * row;
            const int sb = atomicAdd(&cnt[eb], 1);
            list[(size_t)eb * (2 * T) + sb] = 2 * row + 1;
            gate[2 * row] = ga; gate[2 * row + 1] = gb;
        }
    }
}

constexpr int G_BM = 256, G_BN = 128, G_BK = 64, G_ST = 72;
constexpr int G_ABUF = G_BM * G_ST, G_BBUF = G_BN * G_ST;
template <class AMap, class Epi>
DEVI void gemm_tile(const AMap& amap, const bf16_t* __restrict__ Bt, int K, const Epi& epi, char* lds) {
    const int tid = TIDX(), wid = tid >> 6, lane = tid & 63, r16 = lane & 15, g4 = lane >> 4;
    const int wr = wid >> 1, wc = wid & 1;
    bf16_t* As = (bf16_t*)lds;
    bf16_t* Bs = As + 2 * G_ABUF;
    const int srow = tid >> 3, skc = (tid & 7) * 8;
    const bf16_t* ap[4];
#pragma unroll
    for (int i = 0; i < 4; ++i) ap[i] = amap(srow + 64 * i) + skc;
    const bf16_t* bp[2];
#pragma unroll
    for (int i = 0; i < 2; ++i) bp[i] = Bt + (size_t)(srow + 64 * i) * K + skc;
    u32x4 ra[4], rb[2];
#pragma unroll
    for (int i = 0; i < 4; ++i) ra[i] = *(const u32x4*)(ap[i]);
#pragma unroll
    for (int i = 0; i < 2; ++i) rb[i] = *(const u32x4*)(bp[i]);
    f32x4 acc[4][4];
#pragma unroll
    for (int m = 0; m < 4; ++m)
#pragma unroll
        for (int n = 0; n < 4; ++n) acc[m][n] = (f32x4){0.f, 0.f, 0.f, 0.f};
    const int nt = K / G_BK;
    for (int t = 0; t < nt; ++t) {
        bf16_t* Ab = As + (t & 1) * G_ABUF;
        bf16_t* Bb = Bs + (t & 1) * G_BBUF;
#pragma unroll
        for (int i = 0; i < 4; ++i) *(u32x4*)(Ab + (srow + 64 * i) * G_ST + skc) = ra[i];
#pragma unroll
        for (int i = 0; i < 2; ++i) *(u32x4*)(Bb + (srow + 64 * i) * G_ST + skc) = rb[i];
        __syncthreads();
        if (t + 1 < nt) {
#pragma unroll
            for (int i = 0; i < 4; ++i) ra[i] = *(const u32x4*)(ap[i] + (size_t)(t + 1) * G_BK);
#pragma unroll
            for (int i = 0; i < 2; ++i) rb[i] = *(const u32x4*)(bp[i] + (size_t)(t + 1) * G_BK);
        }
#pragma unroll
        for (int kk = 0; kk < 2; ++kk) {
            bf16x8 af[4], bfr[4];
#pragma unroll
            for (int m = 0; m < 4; ++m) af[m] = *(const bf16x8*)(Ab + (wr * 64 + m * 16 + r16) * G_ST + kk * 32 + g4 * 8);
#pragma unroll
            for (int n = 0; n < 4; ++n) bfr[n] = *(const bf16x8*)(Bb + (wc * 64 + n * 16 + r16) * G_ST + kk * 32 + g4 * 8);
#pragma unroll
            for (int m = 0; m < 4; ++m)
#pragma unroll
                for (int n = 0; n < 4; ++n) acc[m][n] = MFMA16(bfr[n], af[m], acc[m][n]);
        }
    }
    epi(acc, wr * 64 + r16, wc * 64 + g4 * 4);
    __syncthreads();
}

struct AMapDense { const bf16_t* A; int K; DEVI const bf16_t* operator()(int r) const { return A + (size_t)r * K; } };
struct EpiBf16Out { bf16_t* O; int ldo;
    DEVI void operator()(const f32x4 (&acc)[4][4], int rb, int cb) const {
#pragma unroll
        for (int m = 0; m < 4; ++m)
#pragma unroll
            for (int n = 0; n < 4; ++n) { u32x2 w; w.x = cvt_pk(acc[m][n][0], acc[m][n][1]); w.y = cvt_pk(acc[m][n][2], acc[m][n][3]);
                *(u32x2*)(O + (size_t)(rb + m * 16) * ldo + cb + n * 16) = w; }
    } };
struct EpiResF32 { const float* R; float* O; int ld;
    DEVI void operator()(const f32x4 (&acc)[4][4], int rb, int cb) const {
#pragma unroll
        for (int m = 0; m < 4; ++m)
#pragma unroll
            for (int n = 0; n < 4; ++n) { const size_t off = (size_t)(rb + m * 16) * ld + cb + n * 16;
                const f32x4 r = *(const f32x4*)(R + off); *(f32x4*)(O + off) = r + acc[m][n]; }
    } };

template <class MakeEpi>
DEVI void gemm_dense_units(const bf16_t* A, const bf16_t* Bt, int M, int N, int K, const MakeEpi& mk, char* lds, int u0, int ustride) {
    const int nN = N / G_BN, nU = (M / G_BM) * nN;
    for (int u = u0; u < nU; u += ustride) {
        const int pm = u / nN, pn = u % nN;
        AMapDense am{A + (size_t)pm * G_BM * K, K};
        gemm_tile(am, Bt + (size_t)pn * G_BN * K, K, mk(pm * G_BM, pn * G_BN), lds);
    }
}


DEVI const char* uni_ptr(const char* p) {
    const unsigned long long v = (unsigned long long)p;
    const unsigned lo = __builtin_amdgcn_readfirstlane((unsigned)v), hi = __builtin_amdgcn_readfirstlane((unsigned)(v >> 32));
    return (const char*)(gb_ptr)(((unsigned long long)hi << 32) | lo);
}
namespace g8 {
constexpr int BM = 256, BK = 64, HALF = 128, HTB = HALF * BK * 2, STAGE_BYTES = 8 * HTB;
DEVI int lds_byte(int r, int c) { const int st = (r >> 4) * 2 + (c >> 5), rr = r & 15, cc = c & 31, ob = rr * 64 + cc * 2; return st * 1024 + (ob ^ (((ob >> 9) & 1) << 5)); }
DEVI void stage_rc(int b, int& R, int& C) { const int st = b / 1024, sb = b % 1024, swz = sb ^ (((sb >> 9) & 1) << 5); R = (st >> 1) * 16 + swz / 64; C = (st & 1) * 32 + (swz % 64) / 2; }
DEVI int perm32(int rho) { const int n = rho >> 4, i = rho & 15; return 8 * (i >> 2) + 4 * n + (i & 3); }
struct UnitU { const char* A; const char* B; int i0, i1, i2, i3; int flags; };

template <class Epi, class Sched>
DEVI void gemm8(char* lds_generic, int K, int klen, Sched& S, const Epi& E) {
    LAS unsigned char* lds = (LAS unsigned char*)lds_generic;
    const int tid = TIDX(), wid = __builtin_amdgcn_readfirstlane(tid >> 6), lane = tid & 63, wr = wid >> 2, wc = wid & 3, fr = lane & 15, fq = lane >> 4;
    const int nt = klen / BK;
    int R0, C0, R1, C1; stage_rc(tid * 16, R0, C0); stage_rc(tid * 16 + 8192, R1, C1);
    unsigned voffB[2];
    { const int Rb0 = Epi::PERM ? ((R0 & ~31) + perm32(R0 & 31)) : R0, Rb1 = Epi::PERM ? ((R1 & ~31) + perm32(R1 & 31)) : R1;
      voffB[0] = (unsigned)(Rb0 * K + C0) * 2u; voffB[1] = (unsigned)(Rb1 * K + C1) * 2u; }
    const size_t kstep = (size_t)(BK * 2), hstepB = (size_t)HALF * K * 2;
    const unsigned ldsw = (unsigned)wid * 1024u;
    const int aoff = lds_byte(wr * 64 + fr, fq * 8), boff = lds_byte(wc * 32 + fr, fq * 8);
#define G8_SA(b, h) (((b) * 2 + (h)) * HTB)
#define G8_SB(b, h) ((4 + (b) * 2 + (h)) * HTB)
#define G8_STG(bufoff, gbase, v0, v1) do { const char* _gb = uni_ptr((const char*)(gbase));     \
        __builtin_amdgcn_global_load_lds((const unsigned*)(_gb + (v0)), (LAS unsigned*)(lds + (bufoff) + ldsw), 16, 0, 0); \
        __builtin_amdgcn_global_load_lds((const unsigned*)(_gb + (v1)), (LAS unsigned*)(lds + (bufoff) + ldsw + 8192), 16, 0, 0); } while (0)
#define G8_LDA(dst, b, h) do { _Pragma("unroll") for (int m = 0; m < 4; ++m) _Pragma("unroll") for (int k = 0; k < 2; ++k) dst[m][k] = *(const LAS bf16x8*)(lds + G8_SA(b, h) + aoff + m * 2048 + k * 1024); } while (0)
#define G8_LDB(dst, b, h) do { _Pragma("unroll") for (int n = 0; n < 2; ++n) _Pragma("unroll") for (int k = 0; k < 2; ++k) dst[n][k] = *(const LAS bf16x8*)(lds + G8_SB(b, h) + boff + n * 2048 + k * 1024); } while (0)
#define G8_MMA(ai, bj, At, Bt) do { __builtin_amdgcn_s_setprio(1); _Pragma("unroll") for (int m = 0; m < 4; ++m) _Pragma("unroll") for (int n = 0; n < 2; ++n) _Pragma("unroll") for (int k = 0; k < 2; ++k) \
        acc[ai][bj][m][n] = __builtin_amdgcn_mfma_f32_16x16x32_bf16(Bt[n][k], At[m][k], acc[ai][bj][m][n], 0, 0, 0); __builtin_amdgcn_s_setprio(0); } while (0)
#define G8_WAIT_V(n) asm volatile("s_waitcnt vmcnt(" #n ")" ::: "memory")
#define G8_WAIT_L(n) asm volatile("s_waitcnt lgkmcnt(" #n ")" ::: "memory")
#define G8_BAR __builtin_amdgcn_s_barrier()
#define G8_SCHED __builtin_amdgcn_sched_barrier(0)
    UnitU cur, nxt;
    if (!S.next(cur)) return;
    unsigned va00, va01, va10, va11;
    S.lane_va(cur, R0, C0, R1, C1, va00, va01, va10, va11);
    f32x4 acc[2][2][4][2];
#pragma unroll
    for (int a = 0; a < 2; ++a)
#pragma unroll
        for (int b = 0; b < 2; ++b)
#pragma unroll
            for (int m = 0; m < 4; ++m)
#pragma unroll
                for (int n = 0; n < 2; ++n) acc[a][b][m][n] = (f32x4){0.f, 0.f, 0.f, 0.f};
    bf16x8 At[4][2], B0[2][2], B1[2][2];
    const char* cA = cur.A; const char* cB = cur.B;
    G8_STG(G8_SB(0, 0), cB, voffB[0], voffB[1]); G8_STG(G8_SA(0, 0), cA, va00, va01); G8_STG(G8_SB(0, 1), cB + hstepB, voffB[0], voffB[1]); G8_STG(G8_SA(0, 1), cA, va10, va11);
    if (wr == 1) G8_BAR;
    G8_WAIT_V(4); G8_BAR;
    G8_STG(G8_SB(1, 0), cB + kstep, voffB[0], voffB[1]); G8_STG(G8_SA(1, 0), cA + kstep, va00, va01); G8_STG(G8_SB(1, 1), cB + hstepB + kstep, voffB[0], voffB[1]);
    G8_WAIT_V(6); G8_BAR;
    for (;;) {
        const bool has_next = S.next(nxt);
        const char* nA = has_next ? nxt.A : cA; const char* nB = has_next ? nxt.B : cB;
        unsigned x00 = va00, x01 = va01, x10 = va10, x11 = va11;
        for (int t = 0; t < nt; t += 2) {
            const bool last = (t == nt - 2);
            const char* a1 = cA + (size_t)(t + 1) * kstep;
            const char* a2 = last ? nA : cA + (size_t)(t + 2) * kstep; const char* b2 = last ? nB : cB + (size_t)(t + 2) * kstep;
            const char* a3 = a2 + kstep; const char* b3 = b2 + kstep;
            if (Sched::GATHER) { if (last && has_next) S.lane_va(nxt, R0, C0, R1, C1, x00, x01, x10, x11); }
            G8_LDB(B0, 0, 0); G8_SCHED; G8_LDA(At, 0, 0); G8_STG(G8_SA(1, 1), a1, va10, va11);
            G8_WAIT_L(8); G8_BAR; G8_WAIT_L(0); G8_MMA(0, 0, At, B0); G8_BAR; G8_SCHED;
            G8_LDB(B1, 0, 1); G8_STG(G8_SB(0, 0), b2, voffB[0], voffB[1]);
            G8_BAR; G8_WAIT_L(0); G8_MMA(0, 1, At, B1); G8_BAR;
            G8_LDA(At, 0, 1); G8_STG(G8_SA(0, 0), a2, x00, x01);
            G8_BAR; G8_WAIT_L(0); G8_MMA(1, 0, At, B0); G8_BAR; G8_SCHED;
            G8_STG(G8_SB(0, 1), b2 + hstepB, voffB[0], voffB[1]);
            G8_WAIT_V(6); G8_BAR; G8_MMA(1, 1, At, B1); G8_BAR;
            G8_LDB(B0, 1, 0); G8_SCHED; G8_LDA(At, 1, 0); G8_STG(G8_SA(0, 1), a2, x10, x11);
            G8_WAIT_L(8); G8_BAR; G8_WAIT_L(0); G8_MMA(0, 0, At, B0); G8_BAR; G8_SCHED;
            G8_LDB(B1, 1, 1); G8_STG(G8_SB(1, 0), b3, voffB[0], voffB[1]);
            G8_BAR; G8_WAIT_L(0); G8_MMA(0, 1, At, B1); G8_BAR;
            G8_LDA(At, 1, 1); G8_STG(G8_SA(1, 0), a3, x00, x01);
            G8_BAR; G8_WAIT_L(0); G8_MMA(1, 0, At, B0); G8_BAR; G8_SCHED;
            G8_STG(G8_SB(1, 1), b3 + hstepB, voffB[0], voffB[1]);
            G8_WAIT_V(6); G8_BAR; G8_MMA(1, 1, At, B1); G8_BAR;
        }
        if (cur.flags & 2) E(acc, cur, wr, wc, fr, fq); else E.mid(acc, cur, wr, wc, fr, fq);
        if (!has_next) break;
        if (nxt.flags & 1) {
#pragma unroll
        for (int a = 0; a < 2; ++a)
#pragma unroll
            for (int b = 0; b < 2; ++b)
#pragma unroll
                for (int m = 0; m < 4; ++m)
#pragma unroll
                    for (int n = 0; n < 2; ++n) acc[a][b][m][n] = (f32x4){0.f, 0.f, 0.f, 0.f};
        }
        cur = nxt; cA = nA; cB = nB; va00 = x00; va01 = x01; va10 = x10; va11 = x11;
    }
    G8_WAIT_V(0);
    if (wr == 0) G8_BAR;
    G8_BAR;
#undef G8_SA
#undef G8_SB
#undef G8_STG
#undef G8_LDA
#undef G8_LDB
#undef G8_MMA
#undef G8_WAIT_V
#undef G8_WAIT_L
#undef G8_BAR
#undef G8_SCHED
}

struct DenseSched {
    static constexpr bool GATHER = false;
    const char* A; const char* Bt; int K, nM, nN, nwg, G, c, i;
    DEVI void init(const bf16_t* A_, const bf16_t* Bt_, int M, int N, int K_, int G_, int c_) { A = (const char*)A_; Bt = (const char*)Bt_; K = K_; nM = M / BM; nN = N / BM; nwg = nM * nN; G = G_; c = c_; i = 0; }
    DEVI bool next(UnitU& u) {
        const long L = (long)i * G + c; if (L >= nwg) return false;
        ++i;
        int wgid = (int)L; { const int q = nwg / 8, r = nwg % 8, xcd = wgid % 8, off = wgid / 8; wgid = (xcd < r ? xcd * (q + 1) : r * (q + 1) + (xcd - r) * q) + off; }
        const int nig = 8 * nN, gid = wgid / nig, fm = gid * 8, gsz = (nM - fm) < 8 ? (nM - fm) : 8;
        const int pm = fm + ((wgid % nig) % gsz), pn = (wgid % nig) / gsz;
        u.A = A + (size_t)pm * BM * K * 2; u.B = Bt + (size_t)pn * BM * K * 2; u.i0 = pm; u.i1 = pn; u.i2 = 0; u.i3 = 0; u.flags = 3;
        return true;
    }
    DEVI void lane_va(const UnitU&, int R0, int C0, int R1, int C1, unsigned& v00, unsigned& v01, unsigned& v10, unsigned& v11) const {
        v00 = (unsigned)(R0 * K + C0) * 2u; v01 = (unsigned)(R1 * K + C1) * 2u; v10 = v00 + (unsigned)(HALF * K * 2); v11 = v01 + (unsigned)(HALF * K * 2);
    }
};
struct EpiBf16 { static constexpr bool PERM = true; bf16_t* O; int ldo;
    DEVI void mid(f32x4 (&)[2][2][4][2], const UnitU&, int, int, int, int) const {}
    DEVI void operator()(const f32x4 (&acc)[2][2][4][2], const UnitU& u, int wr, int wc, int fr, int fq) const {
        bf16_t* base = O + (size_t)(u.i0 * BM + wr * 64 + fr) * ldo + u.i1 * BM + wc * 32 + 8 * fq;
#pragma unroll
        for (int ai = 0; ai < 2; ++ai)
#pragma unroll
            for (int m = 0; m < 4; ++m) { bf16_t* rowp = base + (size_t)(ai * HALF + m * 16) * ldo;
#pragma unroll
                for (int bj = 0; bj < 2; ++bj) { const f32x4 v0 = acc[ai][bj][m][0], v1 = acc[ai][bj][m][1];
                    u32x4 w; w.x = cvt_pk(v0[0], v0[1]); w.y = cvt_pk(v0[2], v0[3]); w.z = cvt_pk(v1[0], v1[1]); w.w = cvt_pk(v1[2], v1[3]);
                    *(u32x4*)(rowp + bj * HALF) = w; } }
    } };
struct EpiRes { static constexpr bool PERM = false; const float* R; float* O; int ld;
    DEVI void mid(f32x4 (&)[2][2][4][2], const UnitU&, int, int, int, int) const {}
    DEVI void operator()(const f32x4 (&acc)[2][2][4][2], const UnitU& u, int wr, int wc, int fr, int fq) const {
        const size_t off0 = (size_t)(u.i0 * BM + wr * 64 + fr) * ld + u.i1 * BM + wc * 32 + 4 * fq;
#pragma unroll
        for (int ai = 0; ai < 2; ++ai)
#pragma unroll
            for (int m = 0; m < 4; ++m) { const size_t off = off0 + (size_t)(ai * HALF + m * 16) * ld;
#pragma unroll
                for (int bj = 0; bj < 2; ++bj)
#pragma unroll
                    for (int n = 0; n < 2; ++n) { const f32x4 r = *(const f32x4*)(R + off + bj * HALF + n * 16); *(f32x4*)(O + off + bj * HALF + n * 16) = r + acc[ai][bj][m][n]; } }
    } };
struct DenseSched2 {
    static constexpr bool GATHER = false;
    DenseSched D; int sub;
    DEVI void init(const bf16_t* A_, const bf16_t* Bt_, int M, int N, int K_, int G_, int c_) { D.init(A_, Bt_, M, N, K_, G_, c_); sub = 0; }
    UnitU pend;
    DEVI bool next(UnitU& u) {
        if (sub == 0) { if (!D.next(pend)) return false; u = pend; u.A = pend.A + (size_t)(D.K / 2) * 2; u.B = pend.B + (size_t)(D.K / 2) * 2; u.flags = 1; sub = 1; return true; }
        u = pend; u.flags = 2; sub = 0; return true;
    }
    DEVI void lane_va(const UnitU& u, int R0, int C0, int R1, int C1, unsigned& v00, unsigned& v01, unsigned& v10, unsigned& v11) const { D.lane_va(u, R0, C0, R1, C1, v00, v01, v10, v11); }
};
struct EpiResScale : EpiRes { const float* ssq;
    DEVI void mid(f32x4 (&acc)[2][2][4][2], const UnitU& u, int wr, int wc, int fr, int fq) const {
#pragma unroll
        for (int ai = 0; ai < 2; ++ai)
#pragma unroll
            for (int m = 0; m < 4; ++m) {
                const int row = u.i0 * BM + ai * HALF + wr * 64 + m * 16 + fr;
                const float2 sq = *(const float2*)(ssq + (size_t)row * 2);
                const float rs = rsqrtf((sq.x + sq.y) * (1.0f / 512.0f) + EPS);
#pragma unroll
                for (int bj = 0; bj < 2; ++bj)
#pragma unroll
                    for (int n = 0; n < 2; ++n) acc[ai][bj][m][n] *= rs;
            }
    } };
}

DEVI void cumsum_task(const DP& p, int bh, char* lds) {
    const int tid = TIDX(), wid = tid >> 6, lane = tid & 63;
    const int b = bh >> 2, h = bh & 3;
    const float* logf = (const float*)(p.ws() + WS_LOGF);
    float* cumf = (float*)(p.ws() + WS_CUMF);
    float* wtot = (float*)lds;
    float v[4];
#pragma unroll
    for (int j = 0; j < 4; ++j) v[j] = logf[((size_t)b * S + tid * 4 + j) * 4 + h];
    v[1] += v[0]; v[2] += v[1]; v[3] += v[2];
    float incl = v[3];
#pragma unroll
    for (int d = 1; d < 64; d <<= 1) { const float t = __shfl_up(incl, d); if (lane >= d) incl += t; }
    if (lane == 63) wtot[wid] = incl;
    __syncthreads();
    float woff = 0.f;
    for (int w = 0; w < wid; ++w) woff += wtot[w];
    const float base = woff + incl - v[3];
    *(float4*)(cumf + (size_t)bh * S + tid * 4) = make_float4(base + v[0], base + v[1], base + v[2], base + v[3]);
    __syncthreads();
}
DEVI void phase_inproj(const DP& p, int l, char* lds) {
    unsigned char* ws = p.ws();
    for (int t = BIDX(); t < 32; t += gridDim.x) cumsum_task(p, t, lds);
    g8::DenseSched S; S.init((const bf16_t*)(ws + WS_HBUF), (const bf16_t*)(ws + WS_W_IN), T, NPROJ, DM, gridDim.x, BIDX());
    g8::EpiBf16 E{(bf16_t*)(ws + WS_PROJ), NPROJ};
    g8::gemm8(lds, DM, DM, S, E);
}
DEVI void kv_gemm(const DP& p, char* lds) {
    unsigned char* ws = p.ws();
    const int c = BIDX() - ((int)gridDim.x - 64);
    if (c < 0) return;
    g8::DenseSched S; S.init((const bf16_t*)(ws + WS_MEMN), (const bf16_t*)(ws + WS_W_KV), MROWS, 2 * DM, DM, 64, c);
    g8::EpiBf16 E{(bf16_t*)(ws + WS_KV), 2 * DM};
    g8::gemm8(lds, DM, DM, S, E);
}

DEVI void conv8_pos(const DP& p, int l, const bf16_t* proj, int b, int sp, int chan0, float (&out)[8]) {
    float a[8];
    const float* cb = p.in(10) + l * 1024 + chan0;
#pragma unroll
    for (int i = 0; i < 8; ++i) a[i] = cb[i];
#pragma unroll
    for (int j = 0; j < 4; ++j) {
        const int s2 = sp - 3 + j;
        if (s2 >= 0) {
            const u32x4 w = *(const u32x4*)(proj + ((size_t)b * S + s2) * NPROJ + C_XBC + chan0);
            const float* cw = p.in(9) + ((size_t)l * 4 + j) * 1024 + chan0;
            a[0] += cw[0] * bflo(w.x); a[1] += cw[1] * bfhi(w.x); a[2] += cw[2] * bflo(w.y); a[3] += cw[3] * bfhi(w.y);
            a[4] += cw[4] * bflo(w.z); a[5] += cw[5] * bfhi(w.z); a[6] += cw[6] * bflo(w.w); a[7] += cw[7] * bfhi(w.w);
        }
    }
#pragma unroll
    for (int i = 0; i < 8; ++i) out[i] = silu_f(a[i]);
}
DEVI u32x4 pack8(const float (&v)[8]) { u32x4 w; w.x = cvt_pk(v[0], v[1]); w.y = cvt_pk(v[2], v[3]); w.z = cvt_pk(v[4], v[5]); w.w = cvt_pk(v[6], v[7]); return w; }


DEVI void phase_post(const DP& p, int l) {
    const int tid = TIDX(), wid = tid >> 6, lane = tid & 63;
    unsigned char* ws = p.ws();
    bf16_t* proj = (bf16_t*)(ws + WS_PROJ);
    const int sl = lane >> 2, qt = lane & 3, type = sl >> 2, head = sl & 3;
    const int col0 = (type < 2 ? type * 256 : 768 + (type - 2) * 256) + head * 64 + qt * 16;
    const float *gq0 = p.in(5), *gq1 = p.in(6), *gq2 = p.in(7), *gq3 = p.in(8);
    asm volatile("" : "+s"(gq0), "+s"(gq1), "+s"(gq2), "+s"(gq3));
    const float* gain = (type == 0 ? gq0 : type == 1 ? gq1 : type == 2 ? gq2 : gq3) + l * 64 + qt * 16;
    float gv[16];
#pragma unroll
    for (int i = 0; i < 16; ++i) gv[i] = gain[i];
    const float inv[8] = {1.000000000e+00f, 1.939227432e-01f, 3.760603070e-02f, 7.292664610e-03f, 1.414213562e-03f, 2.742481884e-04f, 5.318295734e-05f, 1.031338525e-05f};
    for (int row = BIDX() * 8 + wid; row < T; row += gridDim.x * 8) {
        bf16_t* ptr = proj + (size_t)row * NPROJ + col0;
        const u32x4 w0 = *(const u32x4*)ptr, w1 = *(const u32x4*)(ptr + 8);
        float v[16];
        v[0] = bflo(w0.x); v[1] = bfhi(w0.x); v[2] = bflo(w0.y); v[3] = bfhi(w0.y); v[4] = bflo(w0.z); v[5] = bfhi(w0.z); v[6] = bflo(w0.w); v[7] = bfhi(w0.w);
        v[8] = bflo(w1.x); v[9] = bfhi(w1.x); v[10] = bflo(w1.y); v[11] = bfhi(w1.y); v[12] = bflo(w1.z); v[13] = bfhi(w1.z); v[14] = bflo(w1.w); v[15] = bfhi(w1.w);
        float ss = 0.f;
#pragma unroll
        for (int i = 0; i < 16; ++i) ss += v[i] * v[i];
        ss += __shfl_xor(ss, 1); ss += __shfl_xor(ss, 2);
        const float rstd = rsqrtf(ss * (1.0f / 64.0f) + EPS);
#pragma unroll
        for (int i = 0; i < 16; ++i) v[i] = v[i] * rstd * gv[i];
        if (type >= 2 && qt == 0) {
            const float pos = (float)(row & (S - 1));
#pragma unroll
            for (int i = 0; i < 8; ++i) { float sn, cs; sincosf(pos * inv[i], &sn, &cs);
                const float a = v[i], b = v[i + 8]; v[i] = a * cs - b * sn; v[i + 8] = b * cs + a * sn; }
        }
        u32x4 o0, o1;
        o0.x = cvt_pk(v[0], v[1]); o0.y = cvt_pk(v[2], v[3]); o0.z = cvt_pk(v[4], v[5]); o0.w = cvt_pk(v[6], v[7]);
        o1.x = cvt_pk(v[8], v[9]); o1.y = cvt_pk(v[10], v[11]); o1.z = cvt_pk(v[12], v[13]); o1.w = cvt_pk(v[14], v[15]);
        *(u32x4*)ptr = o0; *(u32x4*)(ptr + 8) = o1;
    }
    bf16_t* xc = (bf16_t*)(ws + WS_XC);
    for (int item = BIDX() * NTHR + tid; item < T * 128; item += gridDim.x * NTHR) {
        const int t = item >> 7, c8 = (item & 127) * 8;
        float v[8]; conv8_pos(p, l, proj, t / S, t % S, c8, v);
        *(u32x4*)(xc + (size_t)t * 1024 + c8) = pack8(v);
    }
}
DEVI void phase_knorm(const DP& p, int l) {
    const int tid = TIDX(), wid = tid >> 6, lane = tid & 63;
    unsigned char* ws = p.ws();
    bf16_t* kv = (bf16_t*)(ws + WS_KV);
    const float* kg = p.in(21) + l * 256 + (lane & 15) * 16;
    float kgv[16];
#pragma unroll
    for (int i = 0; i < 16; ++i) kgv[i] = kg[i];
    for (int row = BIDX() * 8 + wid; row < MROWS; row += gridDim.x * 8) {
        bf16_t* ptr = kv + (size_t)row * 2 * DM + lane * 16;
        const u32x4 w0 = *(const u32x4*)ptr, w1 = *(const u32x4*)(ptr + 8);
        float v[16];
        v[0] = bflo(w0.x); v[1] = bfhi(w0.x); v[2] = bflo(w0.y); v[3] = bfhi(w0.y); v[4] = bflo(w0.z); v[5] = bfhi(w0.z); v[6] = bflo(w0.w); v[7] = bfhi(w0.w);
        v[8] = bflo(w1.x); v[9] = bfhi(w1.x); v[10] = bflo(w1.y); v[11] = bfhi(w1.y); v[12] = bflo(w1.z); v[13] = bfhi(w1.z); v[14] = bflo(w1.w); v[15] = bfhi(w1.w);
        float ss = 0.f;
#pragma unroll
        for (int i = 0; i < 16; ++i) ss += v[i] * v[i];
        ss += __shfl_xor(ss, 1); ss += __shfl_xor(ss, 2); ss += __shfl_xor(ss, 4); ss += __shfl_xor(ss, 8);
        const float rstd = rsqrtf(ss * (1.0f / 256.0f) + EPS);
#pragma unroll
        for (int i = 0; i < 16; ++i) v[i] = v[i] * rstd * kgv[i];
        u32x4 o0, o1;
        o0.x = cvt_pk(v[0], v[1]); o0.y = cvt_pk(v[2], v[3]); o0.z = cvt_pk(v[4], v[5]); o0.w = cvt_pk(v[6], v[7]);
        o1.x = cvt_pk(v[8], v[9]); o1.y = cvt_pk(v[10], v[11]); o1.z = cvt_pk(v[12], v[13]); o1.w = cvt_pk(v[14], v[15]);
        *(u32x4*)ptr = o0; *(u32x4*)(ptr + 8) = o1;
    }
}
constexpr float LOG2E = 1.4426950408889634f;
template <int DH> struct AttnLds { static constexpr int KST = DH + 8; static constexpr int TILE = 64 * KST; static constexpr int BYTES = 4 * TILE * 2; };
DEVI float xor16_max(float v) { return fmaxf(v, __shfl_xor(v, 16)); }
DEVI float xor32_max(float v) { auto r = __builtin_amdgcn_permlane32_swap(__float_as_uint(v), __float_as_uint(v), false, false); return fmaxf(__uint_as_float(r[0]), __uint_as_float(r[1])); }
DEVI float xor32_sum(float v) { auto r = __builtin_amdgcn_permlane32_swap(__float_as_uint(v), __float_as_uint(v), false, false); return __uint_as_float(r[0]) + __uint_as_float(r[1]); }
template <int DH, int MODE>
DEVI void attn_task(const bf16_t* __restrict__ Qb, int ldq, int qtok0, int qstep,
                    const bf16_t* __restrict__ Kb, const bf16_t* __restrict__ Vb, int ldk, int ktok0, int kstep,
                    int p0, int kt_lo, int kt_hi, float scale,
                    const float* __restrict__ cum, const float* __restrict__ qgain,
                    bf16_t* Ob, int ldo, float* Of, float* Om, float* Ol, char* lds) {
    constexpr int KST = AttnLds<DH>::KST, TILE = AttnLds<DH>::TILE, NKK = DH / 32, ND = DH / 16, NCH = (64 * DH / 8) / NTHR;
    const int tid = TIDX(), wid = tid >> 6, lane = tid & 63, r16 = lane & 15, g4 = lane >> 4;
    bf16_t* Ks = (bf16_t*)lds;
    bf16_t* Vs = Ks + 2 * TILE;
    const float c2 = scale * LOG2E;
    bf16x8 qf[NKK];
    {
        const bf16_t* qp = Qb + (size_t)(qtok0 + (p0 + wid * 16 + r16) * qstep) * ldq + g4 * 8;
#pragma unroll
        for (int kk = 0; kk < NKK; ++kk) qf[kk] = *(const bf16x8*)(qp + kk * 32);
    }
    if (MODE == 2) {
        float ss = 0.f;
#pragma unroll
        for (int kk = 0; kk < NKK; ++kk)
#pragma unroll
            for (int j = 0; j < 8; ++j) { const float v = bf2f((bf16_t)qf[kk][j]); ss += v * v; }
        ss += __shfl_xor(ss, 16); ss += __shfl_xor(ss, 32);
        const float rstd = rsqrtf(ss * (1.0f / DH) + EPS);
#pragma unroll
        for (int kk = 0; kk < NKK; ++kk)
#pragma unroll
            for (int j = 0; j < 8; ++j) { const float v = bf2f((bf16_t)qf[kk][j]) * rstd * qgain[kk * 32 + g4 * 8 + j]; qf[kk][j] = (short)f2bf(v); }
    }
    const int qpos = p0 + wid * 16 + r16;
    float m_ = -1.0e30f, l_ = 0.f;
    const float cq = (MODE == 0) ? cum[qpos] * LOG2E : 0.f;
    f32x4 o[ND];
#pragma unroll
    for (int n = 0; n < ND; ++n) o[n] = (f32x4){0.f, 0.f, 0.f, 0.f};
    u32x4 rk[NCH], rv[NCH];
    auto gload = [&](int kt) {
#pragma unroll
        for (int i = 0; i < NCH; ++i) { const int c = tid + i * NTHR, key = c / (DH / 8), dc = c % (DH / 8);
            const size_t tok = (size_t)(ktok0 + (kt * 64 + key) * kstep);
            rk[i] = *(const u32x4*)(Kb + tok * ldk + dc * 8); rv[i] = *(const u32x4*)(Vb + tok * ldk + dc * 8); }
    };
    gload(kt_lo);
    __syncthreads();
    int buf = 0;
    for (int kt = kt_lo; kt < kt_hi; ++kt, buf ^= 1) {
        bf16_t* Kt = Ks + buf * TILE;
        bf16_t* Vt = Vs + buf * TILE;
#pragma unroll
        for (int i = 0; i < NCH; ++i) { const int c = tid + i * NTHR, key = c / (DH / 8), dc = c % (DH / 8);
            *(u32x4*)(Kt + key * KST + dc * 8) = rk[i]; *(u32x4*)(Vt + key * KST + dc * 8) = rv[i]; }
        __syncthreads();
        if (kt + 1 < kt_hi) gload(kt + 1);
        f32x4 s[4];
#pragma unroll
        for (int n = 0; n < 4; ++n) {
            s[n] = (f32x4){0.f, 0.f, 0.f, 0.f};
#pragma unroll
            for (int kk = 0; kk < NKK; ++kk) {
                const bf16x8 kf = *(const bf16x8*)(Kt + (n * 16 + r16) * KST + kk * 32 + g4 * 8);
                s[n] = MFMA16(kf, qf[kk], s[n]);
            }
            if (DH > 64) __builtin_amdgcn_sched_barrier(0);
        }
        float mx = -INFINITY;
#pragma unroll
        for (int n = 0; n < 4; ++n) {
            f32x4 ck = (f32x4){0.f, 0.f, 0.f, 0.f};
            if (MODE == 0) ck = *(const f32x4*)(cum + kt * 64 + n * 16 + g4 * 4);
#pragma unroll
            for (int j = 0; j < 4; ++j) {
                const int kpos = kt * 64 + n * 16 + g4 * 4 + j;
                float t = s[n][j] * c2;
                if (MODE == 0) { t += cq - ck[j] * LOG2E; if (kpos > qpos) t = -INFINITY; }
                if (MODE == 1) { const int dd = qpos - kpos; if (dd < 0 || dd > 128) t = -INFINITY; }
                s[n][j] = t; mx = fmaxf(mx, t);
            }
        }
        mx = xor32_max(xor16_max(mx));
        const float mn = fmaxf(m_, mx);
        const float alpha = __builtin_amdgcn_exp2f(m_ - mn);
        float rs = 0.f;
#pragma unroll
        for (int n = 0; n < 4; ++n)
#pragma unroll
            for (int j = 0; j < 4; ++j) { const float pv = __builtin_amdgcn_exp2f(s[n][j] - mn); s[n][j] = pv; rs += pv; }
        rs += __shfl_xor(rs, 16); rs = xor32_sum(rs);
        l_ = l_ * alpha + rs; m_ = mn;
#pragma unroll
        for (int n = 0; n < ND; ++n) o[n] *= alpha;
#pragma unroll
        for (int kk = 0; kk < 2; ++kk) {
            bf16x8 pb;
            { const unsigned w0 = cvt_pk(s[2 * kk][0], s[2 * kk][1]), w1 = cvt_pk(s[2 * kk][2], s[2 * kk][3]), w2 = cvt_pk(s[2 * kk + 1][0], s[2 * kk + 1][1]), w3 = cvt_pk(s[2 * kk + 1][2], s[2 * kk + 1][3]);
              u32x4 w; w.x = w0; w.y = w1; w.z = w2; w.w = w3; pb = __builtin_bit_cast(bf16x8, w); }
            const bf16_t* vb = Vt + (kk * 32 + 4 * g4 + (r16 >> 2)) * KST + 4 * (r16 & 3);
#pragma unroll
            for (int n = 0; n < ND; ++n) {
                const s16x4 lo = tr_read(vb + n * 16), hi = tr_read(vb + 16 * KST + n * 16);
                bf16x8 vf; vf[0] = lo[0]; vf[1] = lo[1]; vf[2] = lo[2]; vf[3] = lo[3]; vf[4] = hi[0]; vf[5] = hi[1]; vf[6] = hi[2]; vf[7] = hi[3];
                o[n] = MFMA16(vf, pb, o[n]);
                if (DH > 64 && (n & 3) == 3) __builtin_amdgcn_sched_barrier(0);
            }
        }
    }
    const size_t tok = (size_t)(qtok0 + qpos * qstep);
    if (MODE == 1) {
#pragma unroll
        for (int n = 0; n < ND; ++n) *(f32x4*)(Of + tok * 256 + n * 16 + g4 * 4) = o[n];
        if (g4 == 0) { Om[tok * 4] = m_; Ol[tok * 4] = l_; }
    } else {
        const float inv = 1.0f / l_;
#pragma unroll
        for (int n = 0; n < ND; ++n) { u32x2 w; w.x = cvt_pk(o[n][0] * inv, o[n][1] * inv); w.y = cvt_pk(o[n][2] * inv, o[n][3] * inv);
            *(u32x2*)(Ob + tok * ldo + n * 16 + g4 * 4) = w; }
    }
}

DEVI void ssd_acs(const DP& p, int l, int b, int c, int g, float* acs, float* dts) {
    const int tid = TIDX(), wid = tid >> 6, lane = tid & 63;
    if (wid < 4) {
        const int head = g * 4 + wid;
        const float* dtv = (const float*)(p.ws() + WS_DTV);
        const float A = -__expf(p.in(12)[l * 8 + head]);
        const size_t t0 = (size_t)b * S + c * 128 + 2 * lane;
        const float d0 = dtv[t0 * 8 + head], d1 = dtv[(t0 + 1) * 8 + head];
        const float a0 = d0 * A, a1 = d1 * A;
        float incl = a0 + a1;
#pragma unroll
        for (int d = 1; d < 64; d <<= 1) { const float t = __shfl_up(incl, d); if (lane >= d) incl += t; }
        const float ex = incl - (a0 + a1);
        acs[wid * 128 + 2 * lane] = ex + a0; acs[wid * 128 + 2 * lane + 1] = ex + a0 + a1;
        dts[wid * 128 + 2 * lane] = d0; dts[wid * 128 + 2 * lane + 1] = d1;
    }
}
DEVI void conv8_chan(const DP& p, int l, const bf16_t* proj, int b, int c, int chan, int l0, float (&out)[8]) {
    const float* cw = p.in(9) + (size_t)l * 4 * 1024 + chan;
    const float w0 = cw[0], w1 = cw[1024], w2 = cw[2048], w3 = cw[3072], cb = p.in(10)[l * 1024 + chan];
    float v[11];
    const int sbase = c * 128 + l0 - 3;
#pragma unroll
    for (int i = 0; i < 11; ++i) { const int sp = sbase + i; v[i] = sp >= 0 ? bf2f(proj[((size_t)b * S + sp) * NPROJ + C_XBC + chan]) : 0.f; }
#pragma unroll
    for (int i = 0; i < 8; ++i) out[i] = silu_f(cb + w0 * v[i] + w1 * v[i + 1] + w2 * v[i + 2] + w3 * v[i + 3]);
}
constexpr int SST = 136;
constexpr int XST4 = 264;
DEVI void ssd_states_task(const DP& p, int l, int b, int c, int g, char* lds) {
    const int tid = TIDX(), wid = tid >> 6, lane = tid & 63, r16 = lane & 15, g4 = lane >> 4;
    const bf16_t* xc = (const bf16_t*)(p.ws() + WS_XC);
    bf16_t* Bn = (bf16_t*)lds;
    bf16_t* Xn = Bn + 128 * SST;
    float* acs = (float*)(Xn + 128 * XST4);
    float* dts = acs + 512;
    __syncthreads();
    ssd_acs(p, l, b, c, g, acs, dts);
    __syncthreads();
    if (tid < 4) ((float*)(p.ws() + WS_DECAY))[((size_t)b * 16 + c) * 8 + g * 4 + tid] = __expf(acs[tid * 128 + 127]);
    const size_t tok0 = (size_t)b * S + c * 128;
    for (int it = tid; it < 2048; it += NTHR) {
        const int ll = it >> 4, nc = (it & 15) * 8;
        *(u32x4*)(Bn + ll * SST + nc) = *(const u32x4*)(xc + (tok0 + ll) * 1024 + 512 + g * 128 + nc);
    }
    for (int it = tid; it < 4096; it += NTHR) {
        const int ll = it >> 5, ch = (it & 31) * 8, hl = ch >> 6;
        const u32x4 w = *(const u32x4*)(xc + (tok0 + ll) * 1024 + g * 256 + ch);
        const float sc = dts[hl * 128 + ll] * __expf(acs[hl * 128 + 127] - acs[hl * 128 + ll]);
        u32x4 o; o.x = cvt_pk(bflo(w.x) * sc, bfhi(w.x) * sc); o.y = cvt_pk(bflo(w.y) * sc, bfhi(w.y) * sc); o.z = cvt_pk(bflo(w.z) * sc, bfhi(w.z) * sc); o.w = cvt_pk(bflo(w.w) * sc, bfhi(w.w) * sc);
        *(u32x4*)(Xn + ll * XST4 + ch) = o;
    }
    __syncthreads();
    const int hl = wid >> 1, nh = wid & 1;
    f32x4 acc[4][4];
#pragma unroll
    for (int m = 0; m < 4; ++m)
#pragma unroll
        for (int n = 0; n < 4; ++n) acc[m][n] = (f32x4){0.f, 0.f, 0.f, 0.f};
#pragma unroll
    for (int kk = 0; kk < 4; ++kk) {
        bf16x8 af[4], bfr[4];
        const int lrow = kk * 32 + 8 * g4 + (r16 >> 2), cq = 4 * (r16 & 3);
#pragma unroll
        for (int m = 0; m < 4; ++m) { const bf16_t* a = Xn + lrow * XST4 + hl * 64 + m * 16 + cq; const s16x4 lo = tr_read(a), hi = tr_read(a + 4 * XST4);
            af[m][0] = lo[0]; af[m][1] = lo[1]; af[m][2] = lo[2]; af[m][3] = lo[3]; af[m][4] = hi[0]; af[m][5] = hi[1]; af[m][6] = hi[2]; af[m][7] = hi[3]; }
#pragma unroll
        for (int n = 0; n < 4; ++n) { const bf16_t* a = Bn + lrow * SST + nh * 64 + n * 16 + cq; const s16x4 lo = tr_read(a), hi = tr_read(a + 4 * SST);
            bfr[n][0] = lo[0]; bfr[n][1] = lo[1]; bfr[n][2] = lo[2]; bfr[n][3] = lo[3]; bfr[n][4] = hi[0]; bfr[n][5] = hi[1]; bfr[n][6] = hi[2]; bfr[n][7] = hi[3]; }
#pragma unroll
        for (int m = 0; m < 4; ++m)
#pragma unroll
            for (int n = 0; n < 4; ++n) acc[m][n] = MFMA16(bfr[n], af[m], acc[m][n]);
    }
    float* st = (float*)(p.ws() + WS_SSTATE) + (((size_t)b * 16 + c) * 8 + g * 4 + hl) * 8192;
#pragma unroll
    for (int m = 0; m < 4; ++m)
#pragma unroll
        for (int n = 0; n < 4; ++n) *(f32x4*)(st + (m * 16 + r16) * 128 + nh * 64 + n * 16 + g4 * 4) = acc[m][n];
}
DEVI void phase_ssd_scan(const DP& p) {
    const float* st = (const float*)(p.ws() + WS_SSTATE);
    bf16_t* hin = (bf16_t*)(p.ws() + WS_HIN);
    const float* decay = (const float*)(p.ws() + WS_DECAY);
    const int total = NB * 8 * 2048;
    for (int i = BIDX() * NTHR + TIDX(); i < total; i += gridDim.x * NTHR) {
        const int e4 = i & 2047, head = (i >> 11) & 7, b = i >> 14;
        f32x4 h = (f32x4){0.f, 0.f, 0.f, 0.f};
        for (int c = 0; c < 16; ++c) {
            const size_t off = (((size_t)b * 16 + c) * 8 + head) * 8192 + e4 * 4;
            u32x2 w; w.x = cvt_pk(h[0], h[1]); w.y = cvt_pk(h[2], h[3]);
            *(u32x2*)(hin + off) = w;
            const f32x4 s = *(const f32x4*)(st + off);
            const float d = decay[((size_t)b * 16 + c) * 8 + head];
            h = h * d + s;
        }
    }
}
constexpr int XST1 = 72;
DEVI void ssd_out_task(const DP& p, int l, int b, int c, int g, char* lds) {
    const int tid = TIDX(), wid = tid >> 6, lane = tid & 63, r16 = lane & 15, g4 = lane >> 4;
    const bf16_t* proj = (const bf16_t*)(p.ws() + WS_PROJ);
    const bf16_t* xc = (const bf16_t*)(p.ws() + WS_XC);
    bf16_t* Cs = (bf16_t*)lds;
    bf16_t* Bs = Cs + 128 * SST;
    bf16_t* Xn = Bs + 128 * SST;
    bf16_t* Hs = Xn + 128 * XST1;
    bf16_t* Mw = Hs + 64 * SST + wid * 16 * SST;
    float* acs = (float*)(Hs + 64 * SST + 8 * 16 * SST);
    float* dts = acs + 512;
    const int lrow = wid * 16 + r16;
    const size_t tok0 = (size_t)b * S + c * 128, tok = tok0 + lrow;
    bf16_t* mix = (bf16_t*)(p.ws() + WS_MIX);
    float ssq = 0.f;
    __syncthreads();
    ssd_acs(p, l, b, c, g, acs, dts);
    for (int it = tid; it < 2048; it += NTHR) {
        const int ll = it >> 4, nc = (it & 15) * 8;
        *(u32x4*)(Cs + ll * SST + nc) = *(const u32x4*)(xc + (tok0 + ll) * 1024 + 768 + g * 128 + nc);
        *(u32x4*)(Bs + ll * SST + nc) = *(const u32x4*)(xc + (tok0 + ll) * 1024 + 512 + g * 128 + nc);
    }
    __syncthreads();
    bf16x8 cfr[4];
#pragma unroll
    for (int kk = 0; kk < 4; ++kk) cfr[kk] = *(const bf16x8*)(Cs + lrow * SST + kk * 32 + g4 * 8);
    f32x4 cb[8];
#pragma unroll
    for (int st = 0; st < 8; ++st) {
        cb[st] = (f32x4){0.f, 0.f, 0.f, 0.f};
#pragma unroll
        for (int kk = 0; kk < 4; ++kk) {
            const bf16x8 bfr = *(const bf16x8*)(Bs + (st * 16 + r16) * SST + kk * 32 + g4 * 8);
            cb[st] = MFMA16(bfr, cfr[kk], cb[st]);
        }
    }
    for (int hl = 0; hl < 4; ++hl) {
        const int head = g * 4 + hl;
        __syncthreads();
        for (int it = tid; it < 1024; it += NTHR) {
            const int ss = it >> 3, pc8 = (it & 7) * 8;
            *(u32x4*)(Xn + ss * XST1 + pc8) = *(const u32x4*)(xc + (tok0 + ss) * 1024 + head * 64 + pc8);
            const bf16_t* hsrc = (const bf16_t*)(p.ws() + WS_HIN) + (((size_t)b * 16 + c) * 8 + head) * 8192 + (size_t)it * 8;
            *(u32x4*)(Hs + (it >> 4) * SST + (it & 15) * 8) = *(const u32x4*)hsrc;
        }
        __syncthreads();
        const float al = acs[hl * 128 + lrow];
#pragma unroll
        for (int st = 0; st < 8; ++st) {
            float mv[4];
#pragma unroll
            for (int j = 0; j < 4; ++j) { const int sidx = st * 16 + g4 * 4 + j;
                mv[j] = (sidx <= lrow) ? cb[st][j] * __expf(al - acs[hl * 128 + sidx]) * dts[hl * 128 + sidx] : 0.f; }
            u32x2 w; w.x = cvt_pk(mv[0], mv[1]); w.y = cvt_pk(mv[2], mv[3]);
            *(u32x2*)(Mw + r16 * SST + st * 16 + g4 * 4) = w;
        }
        __builtin_amdgcn_wave_barrier();
        asm volatile("s_waitcnt lgkmcnt(0)" ::: "memory");
        f32x4 yd[4], yo[4];
#pragma unroll
        for (int pt = 0; pt < 4; ++pt) { yd[pt] = (f32x4){0.f, 0.f, 0.f, 0.f}; yo[pt] = (f32x4){0.f, 0.f, 0.f, 0.f}; }
#pragma unroll
        for (int kk = 0; kk < 4; ++kk) {
            const bf16x8 mf = *(const bf16x8*)(Mw + r16 * SST + kk * 32 + g4 * 8);
            const bf16_t* xa = Xn + (kk * 32 + 8 * g4 + (r16 >> 2)) * XST1 + 4 * (r16 & 3);
#pragma unroll
            for (int pt = 0; pt < 4; ++pt) {
                const s16x4 lo = tr_read(xa + pt * 16), hi = tr_read(xa + 4 * XST1 + pt * 16);
                bf16x8 xf; xf[0] = lo[0]; xf[1] = lo[1]; xf[2] = lo[2]; xf[3] = lo[3]; xf[4] = hi[0]; xf[5] = hi[1]; xf[6] = hi[2]; xf[7] = hi[3];
                yd[pt] = MFMA16(xf, mf, yd[pt]);
                const bf16x8 hf = *(const bf16x8*)(Hs + (pt * 16 + r16) * SST + kk * 32 + g4 * 8);
                yo[pt] = MFMA16(hf, cfr[kk], yo[pt]);
            }
        }
        __builtin_amdgcn_wave_barrier();
        const float el = __expf(al), Dh = p.in(13)[l * 8 + head];
#pragma unroll
        for (int pt = 0; pt < 4; ++pt) {
            const int pc = pt * 16 + g4 * 4;
            const u32x2 zw = *(const u32x2*)(proj + tok * NPROJ + C_Z + head * 64 + pc);
            const u32x2 xw = *(const u32x2*)(Xn + lrow * XST1 + pc);
            const float zz[4] = {bflo(zw.x), bfhi(zw.x), bflo(zw.y), bfhi(zw.y)};
            const float xx[4] = {bflo(xw.x), bfhi(xw.x), bflo(xw.y), bfhi(xw.y)};
            float gv[4];
#pragma unroll
            for (int j = 0; j < 4; ++j) { const float yv = yd[pt][j] + el * yo[pt][j] + Dh * xx[j]; gv[j] = yv * silu_f(zz[j]); ssq += gv[j] * gv[j]; }
            u32x2 w; w.x = cvt_pk(gv[0], gv[1]); w.y = cvt_pk(gv[2], gv[3]);
            *(u32x2*)(mix + tok * DM + 512 + head * 64 + pc) = w;
        }
    }
    ssq += __shfl_xor(ssq, 16); ssq += __shfl_xor(ssq, 32);
    if (g4 == 0) ((float*)(p.ws() + WS_SSQ))[tok * 2 + g] = ssq;
}
constexpr int N_FOX = 512, N_S1 = 256, N_DIL = 1536;
DEVI void phase_mix1(const DP& p, int l, char* lds) {
    unsigned char* ws = p.ws();
    kv_gemm(p, lds);
    const bf16_t* proj = (const bf16_t*)(ws + WS_PROJ);
    bf16_t* mix = (bf16_t*)(ws + WS_MIX);
    for (int t = BIDX(); t < N_FOX + N_S1 + N_DIL; t += gridDim.x) {
        if (t < N_FOX) {
            const int bh = t & 31, k = t >> 5;
            const int qb = k < 8 ? 15 - k : k - 8;
            const int b = bh >> 2, h = bh & 3;
            const float* cum = (const float*)(ws + WS_CUMF) + (size_t)bh * S;
            attn_task<64, 0>(proj + C_FQ + h * 64, NPROJ, b * S, 1, proj + C_FK + h * 64, proj + C_FV + h * 64, NPROJ, b * S, 1,
                             qb * 128, 0, 2 * qb + 2, 0.125f, cum, nullptr, mix + h * 64, DM, nullptr, nullptr, nullptr, lds);
        } else if (t < N_FOX + N_S1) {
            const int u = t - N_FOX, g = u & 1, c = (u >> 1) & 15, b = u >> 5;
            ssd_states_task(p, l, b, c, g, lds);
        } else {
            const int u = t - N_FOX - N_S1, bh = u & 31, v = u >> 5;
            const int b = bh >> 2, h = bh & 3;
            int br, dil, r, pb;
            if (v < 16) { br = 0; dil = 1; r = 0; pb = v; }
            else if (v < 32) { br = 1; dil = 4; r = (v - 16) & 3; pb = (v - 16) >> 2; }
            else { br = 2; dil = 16; r = v - 32; pb = 0; }
            float* Of = (float*)(ws + WS_DILO) + (size_t)br * T * 256 + h * 64;
            float* Om = (float*)(ws + WS_DILM) + (size_t)br * T * 4 + h;
            float* Ol = (float*)(ws + WS_DILL) + (size_t)br * T * 4 + h;
            const int klo = pb > 0 ? 2 * pb - 2 : 0;
            attn_task<64, 1>(proj + C_DQ + h * 64, NPROJ, b * S + r, dil, proj + C_DK + h * 64, proj + C_DV + h * 64, NPROJ, b * S + r, dil,
                             pb * 128, klo, 2 * pb + 2, 0.125f, nullptr, nullptr, nullptr, 0, Of, Om, Ol, lds);
        }
    }
}
DEVI void phase_mix3(const DP& p, int l, char* lds) {
    unsigned char* ws = p.ws();
    for (int t = BIDX(); t < NB * 16 * 2; t += gridDim.x) ssd_out_task(p, l, t >> 5, (t >> 1) & 15, t & 1, lds);
    const int tid = TIDX(), wid = tid >> 6, lane = tid & 63, head = lane >> 4, d4 = (lane & 15) * 4;
    const float* Of = (const float*)(ws + WS_DILO);
    const float* Om = (const float*)(ws + WS_DILM);
    const float* Ol = (const float*)(ws + WS_DILL);
    bf16_t* mix = (bf16_t*)(ws + WS_MIX);
    for (int row = BIDX() * 8 + wid; row < T; row += gridDim.x * 8) {
        float m[3], lsum[3];
#pragma unroll
        for (int br = 0; br < 3; ++br) { m[br] = Om[((size_t)br * T + row) * 4 + head]; lsum[br] = Ol[((size_t)br * T + row) * 4 + head]; }
        const float M = fmaxf(m[0], fmaxf(m[1], m[2]));
        f32x4 num = (f32x4){0.f, 0.f, 0.f, 0.f}; float den = 0.f;
#pragma unroll
        for (int br = 0; br < 3; ++br) {
            const float w = __builtin_amdgcn_exp2f(m[br] - M);
            const f32x4 o = *(const f32x4*)(Of + ((size_t)br * T + row) * 256 + head * 64 + d4);
            num += o * w; den += w * lsum[br];
        }
        const float inv = 1.0f / den;
        u32x2 w; w.x = cvt_pk(num[0] * inv, num[1] * inv); w.y = cvt_pk(num[2] * inv, num[3] * inv);
        *(u32x2*)(mix + (size_t)row * DM + 256 + head * 64 + d4) = w;
    }
}
DEVI void phase_xattn(const DP& p, int l, char* lds) {
    unsigned char* ws = p.ws();
    const bf16_t* qbuf = (const bf16_t*)(ws + WS_QBUF);
    const bf16_t* kv = (const bf16_t*)(ws + WS_KV);
    bf16_t* obuf = (bf16_t*)(ws + WS_OBUF);
    for (int t = BIDX(); t < NB * 4 * 16; t += gridDim.x) {
        const int qb = t & 15, h = (t >> 4) & 3, b = t >> 6;
        attn_task<256, 2>(qbuf + h * 256, DM, b * S, 1, kv + h * 256, kv + DM + h * 256, 2 * DM, b * MEMLEN, 1,
                          qb * 128, 0, 4, 0.0625f, nullptr, p.in(20) + l * 256, obuf + h * 256, DM, nullptr, nullptr, nullptr, lds);
    }
}
namespace g8 {
template <bool GATHER_> struct MoeSched {
    static constexpr bool GATHER = GATHER_;
    const int* cnt; const int* list; const char* Abase; const char* Bbase; size_t bstride; int K, G;
    int e, ubase, tbase, u;
    DEVI void init(const int* cnt_, const int* list_, const void* A_, const void* B_, size_t bstride_, int K_, int G_, int c_) {
        cnt = cnt_; list = list_; Abase = (const char*)A_; Bbase = (const char*)B_; bstride = bstride_; K = K_; G = G_; e = 0; ubase = 0; tbase = 0; u = c_; }
    DEVI bool next(UnitU& o) {
        while (e < NEXP) {
            const int ce = cnt[e], nte = (ce + BM - 1) / BM, nun = nte * 4;
            if (u < ubase + nun) {
                const int lu = u - ubase, pm = lu >> 2, pn = lu & 3;
                o.i0 = tbase + pm; o.i1 = pn; o.i2 = e * (2 * T) + pm * BM; o.i3 = ce - pm * BM; o.flags = 3;
                o.A = GATHER ? Abase : Abase + (size_t)(tbase + pm) * BM * K * 2;
                o.B = Bbase + (size_t)e * bstride + (size_t)pn * BM * K * 2;
                u += G; return true;
            }
            ubase += nun; tbase += nte; ++e;
        }
        return false;
    }
    DEVI void lane_va(const UnitU& o, int R0, int C0, int R1, int C1, unsigned& v00, unsigned& v01, unsigned& v10, unsigned& v11) const {
        if (GATHER) {
            const int nv = o.i3; const int* ent = list + o.i2;
            const int t00 = ent[R0 < nv ? R0 : 0] >> 1, t01 = ent[R1 < nv ? R1 : 0] >> 1, t10 = ent[R0 + HALF < nv ? R0 + HALF : 0] >> 1, t11 = ent[R1 + HALF < nv ? R1 + HALF : 0] >> 1;
            v00 = (unsigned)(t00 * K + C0) * 2u; v01 = (unsigned)(t01 * K + C1) * 2u; v10 = (unsigned)(t10 * K + C0) * 2u; v11 = (unsigned)(t11 * K + C1) * 2u;
        } else {
            v00 = (unsigned)(R0 * K + C0) * 2u; v01 = (unsigned)(R1 * K + C1) * 2u; v10 = v00 + (unsigned)(HALF * K * 2); v11 = v01 + (unsigned)(HALF * K * 2);
        }
    }
};
struct EpiSwiglu { static constexpr bool PERM = false; bf16_t* act;
    DEVI void mid(f32x4 (&)[2][2][4][2], const UnitU&, int, int, int, int) const {}
    DEVI void operator()(const f32x4 (&acc)[2][2][4][2], const UnitU& u, int wr, int wc, int fr, int fq) const {
        const int nv = u.i3;
#pragma unroll
        for (int ai = 0; ai < 2; ++ai)
#pragma unroll
            for (int m = 0; m < 4; ++m) {
                const int r = ai * HALF + wr * 64 + m * 16 + fr;
                if (r < nv) {
                    bf16_t* rowp = act + (size_t)(u.i0 * BM + r) * EFF + u.i1 * 128 + wc * 16 + 4 * fq;
#pragma unroll
                    for (int bj = 0; bj < 2; ++bj) { const f32x4 x1 = acc[ai][bj][m][0], x3 = acc[ai][bj][m][1];
                        u32x2 w; w.x = cvt_pk(silu_f(x1[0]) * x3[0], silu_f(x1[1]) * x3[1]); w.y = cvt_pk(silu_f(x1[2]) * x3[2], silu_f(x1[3]) * x3[3]);
                        *(u32x2*)(rowp + bj * 64) = w; }
                }
            }
    } };
struct EpiMoeOut { static constexpr bool PERM = true; bf16_t* y; const int* list; const float* gate;
    DEVI void mid(f32x4 (&)[2][2][4][2], const UnitU&, int, int, int, int) const {}
    DEVI void operator()(const f32x4 (&acc)[2][2][4][2], const UnitU& u, int wr, int wc, int fr, int fq) const {
        const int nv = u.i3; const int* ent = list + u.i2;
#pragma unroll
        for (int ai = 0; ai < 2; ++ai)
#pragma unroll
            for (int m = 0; m < 4; ++m) {
                const int r = ai * HALF + wr * 64 + m * 16 + fr;
                if (r < nv) {
                    const int a = ent[r]; const float gt = gate[a];
                    bf16_t* rowp = y + (size_t)a * DM + u.i1 * BM + wc * 32 + 8 * fq;
#pragma unroll
                    for (int bj = 0; bj < 2; ++bj) { const f32x4 v0 = acc[ai][bj][m][0] * gt, v1 = acc[ai][bj][m][1] * gt;
                        u32x4 w; w.x = cvt_pk(v0[0], v0[1]); w.y = cvt_pk(v0[2], v0[3]); w.z = cvt_pk(v1[0], v1[1]); w.w = cvt_pk(v1[2], v1[3]);
                        *(u32x4*)(rowp + bj * HALF) = w; }
                }
            }
    } };
}
template <int WHICH>
DEVI void phase_moe(const DP& p, int l, char* lds) {
    unsigned char* ws = p.ws();
    const int* cnt = (const int*)(ws + WS_CNT) + l * 64;
    const int* list = (const int*)(ws + WS_LIST);
    if (WHICH == 0) {
        g8::MoeSched<true> S;
        S.init(cnt, list, ws + WS_HBUF, ws + WS_W_13, (size_t)1024 * DM * 2, DM, gridDim.x, BIDX());
        g8::EpiSwiglu E{(bf16_t*)(ws + WS_ACT)};
        g8::gemm8(lds, DM, DM, S, E);
    } else {
        g8::MoeSched<false> S;
        S.init(cnt, list, ws + WS_ACT, ws + WS_W_2, (size_t)DM * EFF * 2, EFF, gridDim.x, BIDX());
        g8::EpiMoeOut E{(bf16_t*)(ws + WS_YBUF), list, (const float*)(ws + WS_GATE)};
        g8::gemm8(lds, EFF, EFF, S, E);
    }
}
DEVI void phase_final(const DP& p) {
    const int tid = TIDX(), wid = tid >> 6, lane = tid & 63;
    const bf16_t* ybuf = (const bf16_t*)(p.ws() + WS_YBUF);
    for (int row = BIDX() * 8 + wid; row < T; row += gridDim.x * 8) {
        float x[16];
        load_row_f32(p.out() + (size_t)row * DM, x, lane);
        add_row_bf16(ybuf + (size_t)(2 * row) * DM, x, lane);
        add_row_bf16(ybuf + (size_t)(2 * row + 1) * DM, x, lane);
        store_row_f32(p.out() + (size_t)row * DM, x, lane);
    }
}


#define XB_TMO      128
#define XB_XCNT(j)  (256  + 64 * (j))
#define XB_XSUB(j)  (1280 + 64 * (j))
#define XB_XGEN(j)  (2304 + 64 * (j))
#define XB_TOP      3328
#define XB_TOPGEN   3392
#define XCD_BAR_WORDS 3456
#define XB_SPIN_CAP (1u << 22)
DEVI unsigned xb_ld(unsigned* p)              { return __hip_atomic_load(p, __ATOMIC_RELAXED, __HIP_MEMORY_SCOPE_AGENT); }
DEVI unsigned xb_add(unsigned* p, unsigned v) { return __hip_atomic_fetch_add(p, v, __ATOMIC_RELAXED, __HIP_MEMORY_SCOPE_AGENT); }
DEVI unsigned xb_xcc_id() { return (unsigned)__builtin_amdgcn_s_getreg((3 << 11) | 20) & 0xFu; }
#define XB_SPIN(cond, bar) do { unsigned _sp = 0; while (cond) { __builtin_amdgcn_s_sleep(1); \
    if ((++_sp & 255u) == 0u) { if (xb_ld(&(bar)[XB_TMO])) break; if (_sp > XB_SPIN_CAP) { atomicAdd(&(bar)[XB_TMO], 1u); break; } } } } while (0)
struct XcdBarrier { unsigned* bar; unsigned x; volatile LAS unsigned* st; };
DEVI XcdBarrier xcd_barrier_post(unsigned* bar, volatile LAS unsigned* st) {
    XcdBarrier b; b.bar = bar; b.x = xb_xcc_id(); b.st = st;
    if (threadIdx.x == 0) (void)xb_add(&bar[XB_XCNT(b.x)], 1u);
    return b;
}
DEVI void xcd_barrier_complete(unsigned* bar, unsigned x, unsigned& nloc, unsigned& nx) {
    const unsigned G = gridDim.x * gridDim.y * gridDim.z;
    unsigned sum, cnt, mine, sp = 0u;
    for (;;) {
        sum = 0u; cnt = 0u; mine = 0u;
#pragma unroll
        for (unsigned j = 0; j < 16; ++j) { const unsigned c = xb_ld(&bar[XB_XCNT(j)]); sum += c; cnt += (c > 0u) ? 1u : 0u; mine = (j == x) ? c : mine; }
        if (sum == G) break;
        __builtin_amdgcn_s_sleep(1);
        if ((++sp & 255u) == 0u) { if (xb_ld(&bar[XB_TMO])) break; if (sp > XB_SPIN_CAP) { atomicAdd(&bar[XB_TMO], 1u); break; } }
    }
    nloc = mine > 0u ? mine : 1u; nx = cnt > 0u ? cnt : 1u;
}
DEVI void xcd_barrier(const XcdBarrier& b) {
    asm volatile("s_waitcnt vmcnt(0)" ::: "memory");
    __syncthreads();
    if (threadIdx.x == 0) {
        unsigned* bar = b.bar;
        __builtin_amdgcn_s_waitcnt(0);
        unsigned nloc = b.st[0], nx = b.st[1];
        if (nloc == 0u) { xcd_barrier_complete(bar, b.x, nloc, nx); b.st[0] = nloc; b.st[1] = nx; }
        const unsigned old = xb_add(&bar[XB_XSUB(b.x)], 1u);
        const unsigned gen = old / nloc;
        if (old + 1u == (gen + 1u) * nloc) {
            __builtin_amdgcn_fence(__ATOMIC_RELEASE, "agent");
            asm volatile("s_waitcnt vmcnt(0)" ::: "memory");
            const unsigned og = xb_add(&bar[XB_TOP], 1u);
            const unsigned tg = og / nx;
            if (og + 1u == (tg + 1u) * nx) xb_add(&bar[XB_TOPGEN], 1u);
            else XB_SPIN(xb_ld(&bar[XB_TOPGEN]) == tg, bar);
            __builtin_amdgcn_fence(__ATOMIC_ACQUIRE, "agent");
            xb_add(&bar[XB_XGEN(b.x)], 1u);
            asm volatile("s_waitcnt vmcnt(0)" ::: "memory");
        } else {
            XB_SPIN(xb_ld(&bar[XB_XGEN(b.x)]) == gen, bar);
            __builtin_amdgcn_fence(__ATOMIC_ACQUIRE, "agent");
            asm volatile("s_waitcnt vmcnt(0)" ::: "memory");
        }
    }
    __syncthreads();
}

constexpr int N_PHASES = 30;
__global__ void __launch_bounds__(NTHR) hybrid_fwd(Params p_unused) {
    extern __shared__ __attribute__((aligned(16))) char lds_base[];
    karg_ptr kp = (karg_ptr)__builtin_amdgcn_kernarg_segment_ptr();
    int ph_lo, ph_hi, use_gs;
    { DP q{kp}; ph_lo = q.ph_lo(); ph_hi = q.ph_hi(); use_gs = q.use_gs(); }
    volatile LAS unsigned* xst = (volatile LAS unsigned*)(LAS char*)(lds_base + LDS_BYTES - 16);
    if (threadIdx.x == 0) { xst[0] = 0u; xst[1] = 0u; }
    __syncthreads();
    XcdBarrier xb; xb.bar = nullptr; xb.x = 0; xb.st = xst;
    if (use_gs == 1) { DP q{kp}; xb = xcd_barrier_post((unsigned*)(q.ws() + WS_BAR), xst); }
#define RUN_PHASE(PH, ...) \
    if (ph_lo <= (PH) && (PH) < ph_hi) { \
        if ((PH) > ph_lo) { if (use_gs == 1) xcd_barrier(xb); else if (use_gs == 2) cg::this_grid().sync(); } \
        asm volatile("" : "+s"(kp) :: "memory"); \
        const DP p{kp}; \
        unsigned lds_off = 0; asm volatile("" : "+s"(lds_off)); \
        char* lds = lds_base + lds_off; \
        unsigned char* ws = p.ws(); (void)ws; (void)lds; \
        __VA_ARGS__ \
    }
#define LAYER_PHASES(L, B0) \
    RUN_PHASE((B0) + 0, { if ((L) == 1) { for (int u = BIDX(); u < PREP_UNITS; u += gridDim.x) prep_unit(p, 1, u, (float*)lds); } __syncthreads(); phase_norm1(p, (L), lds); }) \
    RUN_PHASE((B0) + 1, { phase_inproj(p, (L), lds); }) \
    RUN_PHASE((B0) + 2, { phase_post(p, (L)); }) \
    RUN_PHASE((B0) + 3, { phase_mix1(p, (L), lds); }) \
    RUN_PHASE((B0) + 4, { phase_ssd_scan(p); phase_knorm(p, (L)); }) \
    RUN_PHASE((B0) + 5, { phase_mix3(p, (L), lds); }) \
    RUN_PHASE((B0) + 6, { const float* x_in = (L) == 0 ? p.in(0) : p.out(); float* x1 = (L) == 0 ? p.out() : (float*)(ws + WS_XB); \
                          g8::DenseSched2 S; S.init((const bf16_t*)(ws + WS_MIX), (const bf16_t*)(ws + WS_W_OUT), T, DM, DM, gridDim.x, BIDX()); \
                          g8::EpiResScale E{{x_in, x1, DM}, (const float*)(ws + WS_SSQ)}; g8::gemm8(lds, DM, DM / 2, S, E); }) \
    RUN_PHASE((B0) + 7, { const float* x1 = (L) == 0 ? p.out() : (const float*)(ws + WS_XB); phase_norm2(p, (L), x1); }) \
    RUN_PHASE((B0) + 8, { g8::DenseSched S; S.init((const bf16_t*)(ws + WS_HBUF), (const bf16_t*)(ws + WS_W_Q), T, DM, DM, gridDim.x, BIDX()); \
                          g8::EpiBf16 E{(bf16_t*)(ws + WS_QBUF), DM}; g8::gemm8(lds, DM, DM, S, E); }) \
    RUN_PHASE((B0) + 9, { phase_xattn(p, (L), lds); }) \
    RUN_PHASE((B0) + 10, { const float* x1 = (L) == 0 ? p.out() : (const float*)(ws + WS_XB); float* x2 = (L) == 0 ? (float*)(ws + WS_XB) : p.out(); \
                           g8::DenseSched S; S.init((const bf16_t*)(ws + WS_OBUF), (const bf16_t*)(ws + WS_W_O), T, DM, DM, gridDim.x, BIDX()); \
                           g8::EpiRes E{x1, x2, DM}; g8::gemm8(lds, DM, DM, S, E); }) \
    RUN_PHASE((B0) + 11, { const float* x2 = (L) == 0 ? (const float*)(ws + WS_XB) : p.out(); phase_norm3(p, (L), x2, lds); }) \
    RUN_PHASE((B0) + 12, { phase_moe<0>(p, (L), lds); }) \
    RUN_PHASE((B0) + 13, { phase_moe<1>(p, (L), lds); })

    RUN_PHASE(0, { prep_small(p); for (int u = BIDX(); u < PREP_UNITS; u += gridDim.x) prep_unit(p, 0, u, (float*)lds); })
    LAYER_PHASES(0, 1)
    LAYER_PHASES(1, 15)
    RUN_PHASE(29, { phase_final(p); })
#undef LAYER_PHASES
#undef RUN_PHASE
}

extern "C" void kernel_launch(void* const* d_in, const int* in_sizes, int n_in, void* d_out, int out_size, void* d_ws, size_t ws_size, hipStream_t stream) {
    static int grid = 0;
    if (grid == 0) {
        if (n_in != 31 || out_size != T * DM || ws_size < WS_END) { fprintf(stderr, "kernel_launch: unexpected shapes (n_in %d out %d ws %zu need %zu)\n", n_in, out_size, ws_size, (size_t)WS_END); grid = -1; return; }
        int dev = 0, cus = 0, per_cu = 0;
        hipGetDevice(&dev);
        hipDeviceGetAttribute(&cus, hipDeviceAttributeMultiprocessorCount, dev);
        hipFuncSetAttribute((const void*)hybrid_fwd, hipFuncAttributeMaxDynamicSharedMemorySize, LDS_BYTES);
        hipOccupancyMaxActiveBlocksPerMultiprocessor(&per_cu, (const void*)hybrid_fwd, NTHR, LDS_BYTES);
        if (per_cu < 1) { fprintf(stderr, "kernel_launch: occupancy query says %d blocks per CU\n", per_cu); per_cu = 1; }
        (void)hipGetLastError();
        grid = cus;
    }
    if (grid < 0) return;
    Params p{};
    for (int i = 0; i < 31; ++i) p.in[i] = (const float*)d_in[i];
    p.out = (float*)d_out; p.ws = (unsigned char*)d_ws;
    p.use_grid_sync = 1; p.pad = 0;
    p.ph_lo = 0; p.ph_hi = N_PHASES;
    if (hipMemsetAsync((unsigned char*)d_ws + WS_BAR, 0, XCD_BAR_WORDS * 4, stream) != hipSuccess) { fprintf(stderr, "kernel_launch: memset failed\n"); return; }
    void* args[] = {&p};
    hipError_t e = hipLaunchCooperativeKernel((const void*)hybrid_fwd, dim3(grid), dim3(NTHR), args, LDS_BYTES, stream);
    if (e != hipSuccess) fprintf(stderr, "kernel_launch: cooperative launch failed: %s (grid %d)\n", hipGetErrorString(e), grid);
}
```

```cpp
#include <hip/hip_runtime.h>
#include <hip/hip_cooperative_groups.h>
#include <cstdio>
#include <cstdint>
namespace cg = cooperative_groups;

typedef unsigned short bf16_t;
typedef short bf16x8 __attribute__((ext_vector_type(8)));
typedef short s16x4 __attribute__((ext_vector_type(4)));
typedef float f32x4 __attribute__((ext_vector_type(4)));
typedef unsigned u32x4 __attribute__((ext_vector_type(4)));
typedef unsigned u32x2 __attribute__((ext_vector_type(2)));
#define DEVI __device__ __forceinline__
#define LAS __attribute__((address_space(3)))

constexpr int NB = 8, S = 2048, DM = 1024, T = NB * S, DEPTH = 2;
constexpr int INP = 3084, NPROJ = 3072;
constexpr int C_FQ = 0, C_FK = 256, C_FV = 512, C_DQ = 768, C_DK = 1024, C_DV = 1280, C_Z = 1536, C_XBC = 2048;
constexpr int MEMLEN = 256, MROWS = NB * MEMLEN;
constexpr int NEXP = 32, EFF = 512;
constexpr float EPS = 1e-6f;
constexpr int NTHR = 512;
constexpr int LDS_BYTES = 151552;

constexpr size_t al256(size_t x) { return (x + 255) & ~(size_t)255; }
constexpr size_t WS_W_IN = 0;
constexpr size_t WS_W_OUT = WS_W_IN + (size_t)NPROJ * DM * 2;
constexpr size_t WS_W_Q = WS_W_OUT + (size_t)DM * DM * 2;
constexpr size_t WS_W_KV = WS_W_Q + (size_t)DM * DM * 2;
constexpr size_t WS_W_O = WS_W_KV + (size_t)2 * DM * DM * 2;
constexpr size_t WS_W_13 = WS_W_O + (size_t)DM * DM * 2;
constexpr size_t WS_W_2 = WS_W_13 + (size_t)NEXP * 1024 * DM * 2;
constexpr size_t WS_WSMALL = WS_W_2 + (size_t)NEXP * DM * EFF * 2;
constexpr size_t WS_WROUT = WS_WSMALL + (size_t)DEPTH * 12 * DM * 4;
constexpr size_t WS_XB = WS_WROUT + (size_t)DEPTH * 36 * DM * 4;
constexpr size_t WS_HBUF = WS_XB + (size_t)T * DM * 4;
constexpr size_t WS_PROJ = WS_HBUF + (size_t)T * DM * 2;
constexpr size_t WS_QBUF = WS_PROJ;
constexpr size_t WS_OBUF = WS_PROJ + (size_t)T * DM * 2;
constexpr size_t WS_ACT = WS_PROJ;
constexpr size_t WS_MIX = WS_PROJ + (size_t)T * NPROJ * 2;
constexpr size_t WS_U = WS_MIX + (size_t)T * DM * 2;
constexpr size_t WS_YBUF = WS_U;
constexpr size_t WS_DILO = WS_U;
constexpr size_t WS_DILM = WS_DILO + (size_t)3 * T * 256 * 4;
constexpr size_t WS_DILL = WS_DILM + (size_t)3 * T * 4 * 4;
constexpr size_t WS_SSTATE = WS_DILL + (size_t)3 * T * 4 * 4;
constexpr size_t WS_HIN = WS_SSTATE + (size_t)NB * 16 * 8 * 8192 * 4;
constexpr size_t WS_GBUF = WS_HIN + (size_t)NB * 16 * 8 * 8192 * 2;
constexpr size_t WS_U_END = WS_GBUF + (size_t)T * 512 * 4;
constexpr size_t WS_MEMN = WS_U_END;
constexpr size_t WS_KV = WS_MEMN + (size_t)MROWS * DM * 2;
constexpr size_t WS_LOGF = WS_KV + (size_t)MROWS * 2 * DM * 2;
constexpr size_t WS_CUMF = WS_LOGF + (size_t)T * 4 * 4;
constexpr size_t WS_DTV = WS_CUMF + (size_t)T * 4 * 4;
constexpr size_t WS_DECAY = WS_DTV + (size_t)T * 8 * 4;
constexpr size_t WS_CNT = WS_DECAY + (size_t)NB * 16 * 8 * 4;
constexpr size_t WS_LIST = WS_CNT + 1024;
constexpr size_t WS_GATE = WS_LIST + (size_t)NEXP * 2 * T * 4;
constexpr size_t WS_BAR = WS_GATE + (size_t)2 * T * 4;
constexpr size_t WS_XC = WS_BAR + 65536;
constexpr size_t WS_SSQ = WS_XC + (size_t)T * 1024 * 2;
constexpr size_t WS_RSTD1 = WS_SSQ + (size_t)T * 2 * 4;
constexpr size_t WS_RSTD3 = WS_RSTD1 + (size_t)T * 4;
constexpr size_t WS_END = WS_RSTD3 + (size_t)T * 4;
static_assert(WS_YBUF + (size_t)2 * T * DM * 2 <= WS_U_END, "ybuf alias");
static_assert(WS_OBUF + (size_t)T * DM * 2 <= WS_MIX, "obuf alias");

struct Params {
    const float* in[31];
    float* out;
    unsigned char* ws;
    int ph_lo, ph_hi;
    int use_grid_sync, pad;
};


typedef __attribute__((address_space(4))) const unsigned long long* karg_ptr;
typedef __attribute__((address_space(1))) const float* gcf_ptr;
typedef __attribute__((address_space(1))) float* gf_ptr;
typedef __attribute__((address_space(1))) unsigned char* gb_ptr;
struct DP {
    karg_ptr kp;
    DEVI const float* in(int i) const { return (const float*)(gcf_ptr)(kp[i]); }
    DEVI float* out() const { return (float*)(gf_ptr)(kp[31]); }
    DEVI unsigned char* ws() const { return (unsigned char*)(gb_ptr)(kp[32]); }
    DEVI int ph_lo() const { return (int)(unsigned)kp[33]; }
    DEVI int ph_hi() const { return (int)(unsigned)(kp[33] >> 32); }
    DEVI int use_gs() const { return (int)(unsigned)kp[34]; }
};

DEVI int TIDX() { int t = threadIdx.x; asm volatile("" : "+v"(t)); return t; }
DEVI int BIDX() { int b = blockIdx.x; asm volatile("" : "+s"(b)); return b; }
DEVI float bf2f(bf16_t v) { return __uint_as_float(((unsigned)v) << 16); }
typedef float f32x2 __attribute__((ext_vector_type(2)));
typedef __bf16 bf16x2_t __attribute__((ext_vector_type(2)));
DEVI unsigned cvt_pk(float lo, float hi) { f32x2 v = {lo, hi}; bf16x2_t b = __builtin_convertvector(v, bf16x2_t); return __builtin_bit_cast(unsigned, b); }
DEVI bf16_t f2bf(float f) { return (bf16_t)(cvt_pk(f, 0.f) & 0xffffu); }
DEVI float bflo(unsigned w) { return __uint_as_float(w << 16); }
DEVI float bfhi(unsigned w) { return __uint_as_float(w & 0xffff0000u); }
DEVI float wave_sum(float v) {
#pragma unroll
    for (int m = 32; m >= 1; m >>= 1) v += __shfl_xor(v, m);
    return v;
}
DEVI float silu_f(float x) { return x / (1.f + __expf(-x)); }
DEVI float softplus_f(float x) { return x > 20.f ? x : log1pf(__expf(x)); }
DEVI float logsigmoid_f(float x) { return x >= 0.f ? -log1pf(__expf(-x)) : x - log1pf(__expf(x)); }
#define MFMA16(a, b, c) __builtin_amdgcn_mfma_f32_16x16x32_bf16(a, b, c, 0, 0, 0)
DEVI s16x4 tr_read(const bf16_t* p) {
    return __builtin_bit_cast(s16x4, __builtin_amdgcn_ds_read_tr16_b64_v4i16((LAS s16x4*)p));
}

DEVI int maprow(int mode, int n) { return mode == 0 ? n : ((n >> 4) * 32 + (n & 15) + (mode == 2 ? 16 : 0)); }
DEVI void prep_tile(const float* __restrict__ src, int ld, int k0, int c0, bf16_t* __restrict__ dst, int dstld, int mode, int n0,
                    const float* __restrict__ kscale, int ks_from, float* tl) {
    const int tid = TIDX();
#pragma unroll
    for (int i = 0; i < 2; ++i) {
        const int k = (tid >> 4) + 32 * i, n4 = (tid & 15) * 4;
        const float4 v = *(const float4*)(src + (size_t)(k0 + k) * ld + c0 + n4);
        float sc = 1.f;
        if (kscale != nullptr && (k0 + k) >= ks_from) sc = kscale[k0 + k - ks_from];
        tl[k * 65 + n4 + 0] = v.x * sc; tl[k * 65 + n4 + 1] = v.y * sc; tl[k * 65 + n4 + 2] = v.z * sc; tl[k * 65 + n4 + 3] = v.w * sc;
    }
    __syncthreads();
    {
        const int n = tid >> 3, kc = (tid & 7) * 8;
        u32x4 w;
        w.x = cvt_pk(tl[(kc + 0) * 65 + n], tl[(kc + 1) * 65 + n]);
        w.y = cvt_pk(tl[(kc + 2) * 65 + n], tl[(kc + 3) * 65 + n]);
        w.z = cvt_pk(tl[(kc + 4) * 65 + n], tl[(kc + 5) * 65 + n]);
        w.w = cvt_pk(tl[(kc + 6) * 65 + n], tl[(kc + 7) * 65 + n]);
        const int drow = maprow(mode, n0 + n);
        *(u32x4*)(dst + (size_t)drow * dstld + k0 + kc) = w;
    }
    __syncthreads();
}

constexpr int PREP_UNITS = 2048 + 3 * 4096;
DEVI void prep_unit(const DP& p, int l, int u, float* tl) {
    unsigned char* ws = p.ws();
    if (u < 768) {
        const int kt = u / 48, nt = u % 48, n0 = nt * 64, c0 = n0 < 768 ? n0 : n0 + 4;
        prep_tile(p.in(3) + (size_t)l * DM * INP, INP, kt * 64, c0, (bf16_t*)(ws + WS_W_IN), DM, 0, n0, p.in(2) + l * DM, 0, tl);
    } else if (u < 1024) {
        const int v = u - 768, kt = v / 16, nt = v % 16;
        prep_tile(p.in(15) + (size_t)l * DM * DM, DM, kt * 64, nt * 64, (bf16_t*)(ws + WS_W_OUT), DM, 0, nt * 64, p.in(14) + l * 512, 512, tl);
    } else if (u < 1280) {
        const int v = u - 1024, kt = v / 16, nt = v % 16;
        prep_tile(p.in(18) + (size_t)l * DM * DM, DM, kt * 64, nt * 64, (bf16_t*)(ws + WS_W_Q), DM, 0, nt * 64, p.in(16) + l * DM, 0, tl);
    } else if (u < 1792) {
        const int v = u - 1280, kt = v / 32, nt = v % 32;
        prep_tile(p.in(19) + (size_t)l * DM * 2 * DM, 2 * DM, kt * 64, nt * 64, (bf16_t*)(ws + WS_W_KV), DM, 0, nt * 64, nullptr, 0, tl);
    } else if (u < 2048) {
        const int v = u - 1792, kt = v / 16, nt = v % 16;
        prep_tile(p.in(22) + (size_t)l * DM * DM, DM, kt * 64, nt * 64, (bf16_t*)(ws + WS_W_O), DM, 0, nt * 64, nullptr, 0, tl);
    } else if (u < 2048 + 8192) {
        const int v = u - 2048, which = v / 4096, w = v % 4096, e = w / 128, tI = w % 128, kt = tI / 8, nt = tI % 8;
        const float* src = (which == 0 ? p.in(28) : p.in(29)) + ((size_t)l * NEXP + e) * DM * EFF;
        prep_tile(src, EFF, kt * 64, nt * 64, (bf16_t*)(ws + WS_W_13) + (size_t)e * 1024 * DM, DM, which == 0 ? 1 : 2, nt * 64, p.in(23) + l * DM, 0, tl);
    } else {
        const int w = u - 2048 - 8192, e = w / 128, tI = w % 128, kt = tI / 16, nt = tI % 16;
        const float* src = p.in(30) + ((size_t)l * NEXP + e) * EFF * DM;
        prep_tile(src, DM, kt * 64, nt * 64, (bf16_t*)(ws + WS_W_2) + (size_t)e * DM * EFF, EFF, 0, nt * 64, nullptr, 0, tl);
    }
}
DEVI void prep_small(const DP& p) {
    float* wsm = (float*)(p.ws() + WS_WSMALL);
    float* wro = (float*)(p.ws() + WS_WROUT);
    const int gtid = BIDX() * NTHR + TIDX(), gn = gridDim.x * NTHR;
    for (int i = gtid; i < DEPTH * 12 * DM; i += gn) {
        const int l = i / (12 * DM), r = i % (12 * DM), c = r / DM, k = r % DM;
        const int col = c < 4 ? 768 + c : 3076 + (c - 4);
        wsm[i] = p.in(3)[((size_t)l * DM + k) * INP + col] * p.in(2)[l * DM + k];
    }
    for (int i = gtid; i < DEPTH * 36 * DM; i += gn) {
        const int l = i / (36 * DM), r = i % (36 * DM), c = r / DM, k = r % DM;
        wro[i] = (c < 4 ? p.in(24)[((size_t)l * DM + k) * 4 + c] : p.in(26)[((size_t)l * DM + k) * 32 + (c - 4)]) * p.in(23)[l * DM + k];
    }
    if (BIDX() == 0 && TIDX() < 128) ((int*)(p.ws() + WS_CNT))[TIDX()] = 0;
}

DEVI void store_h_bf16(bf16_t* hrow, const float (&h)[16], int lane) {
#pragma unroll
    for (int j = 0; j < 4; ++j) {
        u32x2 w; w.x = cvt_pk(h[4 * j], h[4 * j + 1]); w.y = cvt_pk(h[4 * j + 2], h[4 * j + 3]);
        *(u32x2*)(hrow + j * 256 + lane * 4) = w;
    }
}
DEVI void load_row_f32(const float* xr, float (&x)[16], int lane) {
#pragma unroll
    for (int j = 0; j < 4; ++j) { const float4 v = *(const float4*)(xr + j * 256 + lane * 4); x[4 * j] = v.x; x[4 * j + 1] = v.y; x[4 * j + 2] = v.z; x[4 * j + 3] = v.w; }
}
DEVI void add_row_bf16(const bf16_t* yr, float (&x)[16], int lane) {
#pragma unroll
    for (int j = 0; j < 4; ++j) { const u32x2 w = *(const u32x2*)(yr + j * 256 + lane * 4); x[4 * j] += bflo(w.x); x[4 * j + 1] += bfhi(w.x); x[4 * j + 2] += bflo(w.y); x[4 * j + 3] += bfhi(w.y); }
}
DEVI void store_row_f32(float* xr, const float (&x)[16], int lane) {
#pragma unroll
    for (int j = 0; j < 4; ++j) *(float4*)(xr + j * 256 + lane * 4) = make_float4(x[4 * j], x[4 * j + 1], x[4 * j + 2], x[4 * j + 3]);
}
DEVI void norm_row(const float (&x)[16], const float* g, float (&h)[16], int lane) {
    float ss = 0.f;
#pragma unroll
    for (int i = 0; i < 16; ++i) ss += x[i] * x[i];
    ss = wave_sum(ss);
    const float rstd = rsqrtf(ss * (1.0f / DM) + EPS);
#pragma unroll
    for (int j = 0; j < 4; ++j) { const float4 gv = *(const float4*)(g + j * 256 + lane * 4);
        h[4 * j] = x[4 * j] * rstd * gv.x; h[4 * j + 1] = x[4 * j + 1] * rstd * gv.y; h[4 * j + 2] = x[4 * j + 2] * rstd * gv.z; h[4 * j + 3] = x[4 * j + 3] * rstd * gv.w; }
}
DEVI float dot_lds(const float (&h)[16], const float* wrow, int lane) {
    float a = 0.f;
#pragma unroll
    for (int j = 0; j < 4; ++j) { const float4 w = *(const float4*)(wrow + j * 256 + lane * 4); a += h[4 * j] * w.x + h[4 * j + 1] * w.y + h[4 * j + 2] * w.z + h[4 * j + 3] * w.w; }
    return a;
}

#define MFMA_F32(a, b, c) __builtin_amdgcn_mfma_f32_16x16x4f32(a, b, c, 0, 0, 0)
DEVI void phase_norm1(const DP& p, int l, char* lds) {
    const int tid = TIDX(), wid = tid >> 6, lane = tid & 63, r = lane & 15, q = lane >> 4;
    unsigned char* ws = p.ws();
    const float* xin = l == 0 ? p.in(0) : (const float*)(ws + WS_XB);
    float* xout = p.out();
    const bf16_t* ybuf = (const bf16_t*)(ws + WS_YBUF);
    bf16_t* hbuf = (bf16_t*)(ws + WS_HBUF);
    const float* wt = (const float*)(ws + WS_WSMALL) + (size_t)l * 12 * DM + (size_t)(r < 12 ? r : 0) * DM + 4 * q;
    float* logf = (float*)(ws + WS_LOGF);
    float* dtv = (float*)(ws + WS_DTV);
    float* rstd1 = (float*)(ws + WS_RSTD1);
    for (int grp = BIDX() * 8 + wid; grp < T / 16; grp += gridDim.x * 8) {
        const size_t row = (size_t)grp * 16 + r;
        const float* xr = xin + row * DM + 4 * q;
        f32x4 acc = (f32x4){0.f, 0.f, 0.f, 0.f};
        float ss = 0.f;
        for (int jo = 0; jo < 64; jo += 16) {
            float4 xb[16];
#pragma unroll
            for (int jj = 0; jj < 16; ++jj) xb[jj] = *(const float4*)(xr + 16 * (jo + jj));
            if (l > 0) {
                u32x2 ya[16], yb[16];
#pragma unroll
                for (int jj = 0; jj < 16; ++jj) { ya[jj] = *(const u32x2*)(ybuf + (2 * row) * DM + 16 * (jo + jj) + 4 * q); yb[jj] = *(const u32x2*)(ybuf + (2 * row + 1) * DM + 16 * (jo + jj) + 4 * q); }
#pragma unroll
                for (int jj = 0; jj < 16; ++jj) {
                    xb[jj].x += bflo(ya[jj].x) + bflo(yb[jj].x); xb[jj].y += bfhi(ya[jj].x) + bfhi(yb[jj].x); xb[jj].z += bflo(ya[jj].y) + bflo(yb[jj].y); xb[jj].w += bfhi(ya[jj].y) + bfhi(yb[jj].y);
                    *(float4*)(xout + row * DM + 16 * (jo + jj) + 4 * q) = xb[jj];
                }
            }
#pragma unroll
            for (int jj = 0; jj < 16; ++jj) {
                const float4 xv = xb[jj]; const int j = jo + jj;
                ss += xv.x * xv.x + xv.y * xv.y + xv.z * xv.z + xv.w * xv.w;
                u32x2 hw; hw.x = cvt_pk(xv.x, xv.y); hw.y = cvt_pk(xv.z, xv.w);
                *(u32x2*)(hbuf + row * DM + 16 * j + 4 * q) = hw;
                float4 wv = *(const float4*)(wt + 16 * j);
                if (r >= 12) wv = make_float4(0.f, 0.f, 0.f, 0.f);
                acc = MFMA_F32(xv.x, wv.x, acc); acc = MFMA_F32(xv.y, wv.y, acc); acc = MFMA_F32(xv.z, wv.z, acc); acc = MFMA_F32(xv.w, wv.w, acc);
            }
        }
        ss += __shfl_xor(ss, 16); ss += __shfl_xor(ss, 32);
        const float rstd = rsqrtf(ss * (1.0f / DM) + EPS);
        if (q == 0) rstd1[row] = rstd;
#pragma unroll
        for (int reg = 0; reg < 4; ++reg) {
            const float rs = __shfl(rstd, 4 * q + reg);
            const float v = acc[reg] * rs;
            const size_t orow = (size_t)grp * 16 + 4 * q + reg;
            if (r < 4) logf[orow * 4 + r] = logsigmoid_f(v + p.in(4)[l * 4 + r]);
            else if (r < 12) dtv[orow * 8 + r - 4] = softplus_f(v + p.in(11)[l * 8 + r - 4]);
        }
    }
    const float* gm = p.in(17) + l * DM;
    bf16_t* memn = (bf16_t*)(ws + WS_MEMN);
    for (int row = BIDX() * 8 + wid; row < MROWS; row += gridDim.x * 8) {
        float x[16], h[16];
        load_row_f32(p.in(1) + (size_t)row * DM, x, lane);
        norm_row(x, gm, h, lane);
        store_h_bf16(memn + (size_t)row * DM, h, lane);
    }
}
DEVI void phase_norm3(const DP& p, int l, const float* xin, char* lds) {
    const int tid = TIDX(), wid = tid >> 6, lane = tid & 63, r = lane & 15, q = lane >> 4;
    unsigned char* ws = p.ws();
    float* lg = (float*)lds + wid * 16 * 40;
    const float* wbase = (const float*)(ws + WS_WROUT) + (size_t)l * 36 * DM + 4 * q;
    const float* wt0 = wbase + (size_t)r * DM;
    const float* wt1 = wbase + (size_t)(16 + r) * DM;
    const float* wt2 = wbase + (size_t)(r < 4 ? 32 + r : 0) * DM;
    int* cnt = (int*)(ws + WS_CNT) + l * 64;
    int* list = (int*)(ws + WS_LIST);
    float* gate = (float*)(ws + WS_GATE);
    float* rstd3 = (float*)(ws + WS_RSTD3);
    const float* bg = p.in(25) + l * 4;
    const float* be = p.in(27) + l * 32;
    for (int grp = BIDX() * 8 + wid; grp < T / 16; grp += gridDim.x * 8) {
        const size_t row = (size_t)grp * 16 + r;
        const float* xr = xin + row * DM + 4 * q;
        f32x4 a0 = (f32x4){0.f, 0.f, 0.f, 0.f}, a1 = a0, a2 = a0;
        float ss = 0.f;
        for (int jo = 0; jo < 64; jo += 8) {
            float4 xb[8], wa[8], wb[8], wc[8];
#pragma unroll
            for (int jj = 0; jj < 8; ++jj) { xb[jj] = *(const float4*)(xr + 16 * (jo + jj)); wa[jj] = *(const float4*)(wt0 + 16 * (jo + jj)); wb[jj] = *(const float4*)(wt1 + 16 * (jo + jj)); wc[jj] = *(const float4*)(wt2 + 16 * (jo + jj)); }
#pragma unroll
            for (int jj = 0; jj < 8; ++jj) {
                const float4 xv = xb[jj], w0 = wa[jj], w1 = wb[jj];
                float4 w2 = wc[jj];
                if (r >= 4) w2 = make_float4(0.f, 0.f, 0.f, 0.f);
                ss += xv.x * xv.x + xv.y * xv.y + xv.z * xv.z + xv.w * xv.w;
                a0 = MFMA_F32(xv.x, w0.x, a0); a1 = MFMA_F32(xv.x, w1.x, a1); a2 = MFMA_F32(xv.x, w2.x, a2);
                a0 = MFMA_F32(xv.y, w0.y, a0); a1 = MFMA_F32(xv.y, w1.y, a1); a2 = MFMA_F32(xv.y, w2.y, a2);
                a0 = MFMA_F32(xv.z, w0.z, a0); a1 = MFMA_F32(xv.z, w1.z, a1); a2 = MFMA_F32(xv.z, w2.z, a2);
                a0 = MFMA_F32(xv.w, w0.w, a0); a1 = MFMA_F32(xv.w, w1.w, a1); a2 = MFMA_F32(xv.w, w2.w, a2);
            }
        }
        ss += __shfl_xor(ss, 16); ss += __shfl_xor(ss, 32);
        const float rstd = rsqrtf(ss * (1.0f / DM) + EPS);
        if (q == 0) rstd3[row] = rstd;
#pragma unroll
        for (int reg = 0; reg < 4; ++reg) {
            const float rs = __shfl(rstd, 4 * q + reg);
            float* lr = lg + (4 * q + reg) * 40;
            lr[r] = a0[reg] * rs; lr[16 + r] = a1[reg] * rs;
            if (r < 4) lr[32 + r] = a2[reg] * rs;
        }
        __builtin_amdgcn_wave_barrier();
        asm volatile("s_waitcnt lgkmcnt(0)" ::: "memory");
        if (lane < 16) {
            const float* lr = lg + lane * 40;
            float gl[4];
#pragma unroll
            for (int c = 0; c < 4; ++c) gl[c] = lr[c] + bg[c];
            int gsel = 0; float gmax = gl[0];
#pragma unroll
            for (int c = 1; c < 4; ++c) if (gl[c] > gmax) { gmax = gl[c]; gsel = c; }
            float gden = 0.f;
#pragma unroll
            for (int c = 0; c < 4; ++c) gden += __expf(gl[c] - gmax);
            const float ggate = 1.0f / gden;
            float v1 = -3.0e38f, v2 = -3.0e38f; int i1 = 0, i2 = 1;
#pragma unroll
            for (int c = 0; c < 8; ++c) {
                const float v = lr[4 + gsel * 8 + c] + be[gsel * 8 + c];
                if (v > v1) { v2 = v1; i2 = i1; v1 = v; i1 = c; } else if (v > v2) { v2 = v; i2 = c; }
            }
            const float e2 = __expf(v2 - v1), inv = 1.0f / (1.0f + e2);
            const int trow = grp * 16 + lane;
            const int ea = gsel * 8 + i1, eb = gsel * 8 + i2;
            const int sa = atomicAdd(&cnt[ea], 1);
            list[(size_t)ea * (2 * T) + sa] = 2 * trow;
            const int sb = atomicAdd(&cnt[eb], 1);
            list[(size_t)eb * (2 * T) + sb] = 2 * trow + 1;
            gate[2 * trow] = inv * ggate; gate[2 * trow + 1] = e2 * inv * ggate;
        }
        __builtin_amdgcn_wave_barrier();
    }
}

constexpr int G_BM = 256, G_BN = 128, G_BK = 64, G_ST = 72;
constexpr int G_ABUF = G_BM * G_ST, G_BBUF = G_BN * G_ST;
template <class AMap, class Epi>
DEVI void gemm_tile(const AMap& amap, const bf16_t* __restrict__ Bt, int K, const Epi& epi, char* lds) {
    const int tid = TIDX(), wid = tid >> 6, lane = tid & 63, r16 = lane & 15, g4 = lane >> 4;
    const int wr = wid >> 1, wc = wid & 1;
    bf16_t* As = (bf16_t*)lds;
    bf16_t* Bs = As + 2 * G_ABUF;
    const int srow = tid >> 3, skc = (tid & 7) * 8;
    const bf16_t* ap[4];
#pragma unroll
    for (int i = 0; i < 4; ++i) ap[i] = amap(srow + 64 * i) + skc;
    const bf16_t* bp[2];
#pragma unroll
    for (int i = 0; i < 2; ++i) bp[i] = Bt + (size_t)(srow + 64 * i) * K + skc;
    u32x4 ra[4], rb[2];
#pragma unroll
    for (int i = 0; i < 4; ++i) ra[i] = *(const u32x4*)(ap[i]);
#pragma unroll
    for (int i = 0; i < 2; ++i) rb[i] = *(const u32x4*)(bp[i]);
    f32x4 acc[4][4];
#pragma unroll
    for (int m = 0; m < 4; ++m)
#pragma unroll
        for (int n = 0; n < 4; ++n) acc[m][n] = (f32x4){0.f, 0.f, 0.f, 0.f};
    const int nt = K / G_BK;
    for (int t = 0; t < nt; ++t) {
        bf16_t* Ab = As + (t & 1) * G_ABUF;
        bf16_t* Bb = Bs + (t & 1) * G_BBUF;
#pragma unroll
        for (int i = 0; i < 4; ++i) *(u32x4*)(Ab + (srow + 64 * i) * G_ST + skc) = ra[i];
#pragma unroll
        for (int i = 0; i < 2; ++i) *(u32x4*)(Bb + (srow + 64 * i) * G_ST + skc) = rb[i];
        __syncthreads();
        if (t + 1 < nt) {
#pragma unroll
            for (int i = 0; i < 4; ++i) ra[i] = *(const u32x4*)(ap[i] + (size_t)(t + 1) * G_BK);
#pragma unroll
            for (int i = 0; i < 2; ++i) rb[i] = *(const u32x4*)(bp[i] + (size_t)(t + 1) * G_BK);
        }
#pragma unroll
        for (int kk = 0; kk < 2; ++kk) {
            bf16x8 af[4], bfr[4];
#pragma unroll
            for (int m = 0; m < 4; ++m) af[m] = *(const bf16x8*)(Ab + (wr * 64 + m * 16 + r16) * G_ST + kk * 32 + g4 * 8);
#pragma unroll
            for (int n = 0; n < 4; ++n) bfr[n] = *(const bf16x8*)(Bb + (wc * 64 + n * 16 + r16) * G_ST + kk * 32 + g4 * 8);
#pragma unroll
            for (int m = 0; m < 4; ++m)
#pragma unroll
                for (int n = 0; n < 4; ++n) acc[m][n] = MFMA16(bfr[n], af[m], acc[m][n]);
        }
    }
    epi(acc, wr * 64 + r16, wc * 64 + g4 * 4);
    __syncthreads();
}

struct AMapDense { const bf16_t* A; int K; DEVI const bf16_t* operator()(int r) const { return A + (size_t)r * K; } };
struct EpiBf16Out { bf16_t* O; int ldo;
    DEVI void operator()(const f32x4 (&acc)[4][4], int rb, int cb) const {
#pragma unroll
        for (int m = 0; m < 4; ++m)
#pragma unroll
            for (int n = 0; n < 4; ++n) { u32x2 w; w.x = cvt_pk(acc[m][n][0], acc[m][n][1]); w.y = cvt_pk(acc[m][n][2], acc[m][n][3]);
                *(u32x2*)(O + (size_t)(rb + m * 16) * ldo + cb + n * 16) = w; }
    } };
struct EpiResF32 { const float* R; float* O; int ld;
    DEVI void operator()(const f32x4 (&acc)[4][4], int rb, int cb) const {
#pragma unroll
        for (int m = 0; m < 4; ++m)
#pragma unroll
            for (int n = 0; n < 4; ++n) { const size_t off = (size_t)(rb + m * 16) * ld + cb + n * 16;
                const f32x4 r = *(const f32x4*)(R + off); *(f32x4*)(O + off) = r + acc[m][n]; }
    } };

template <class MakeEpi>
DEVI void gemm_dense_units(const bf16_t* A, const bf16_t* Bt, int M, int N, int K, const MakeEpi& mk, char* lds, int u0, int ustride) {
    const int nN = N / G_BN, nU = (M / G_BM) * nN;
    for (int u = u0; u < nU; u += ustride) {
        const int pm = u / nN, pn = u % nN;
        AMapDense am{A + (size_t)pm * G_BM * K, K};
        gemm_tile(am, Bt + (size_t)pn * G_BN * K, K, mk(pm * G_BM, pn * G_BN), lds);
    }
}


DEVI const char* uni_ptr(const char* p) {
    const unsigned long long v = (unsigned long long)p;
    const unsigned lo = __builtin_amdgcn_readfirstlane((unsigned)v), hi = __builtin_amdgcn_readfirstlane((unsigned)(v >> 32));
    return (const char*)(gb_ptr)(((unsigned long long)hi << 32) | lo);
}
namespace g8 {
constexpr int BM = 256, BK = 64, HALF = 128, HTB = HALF * BK * 2, STAGE_BYTES = 8 * HTB;
DEVI int lds_byte(int r, int c) { const int st = (r >> 4) * 2 + (c >> 5), rr = r & 15, cc = c & 31, ob = rr * 64 + cc * 2; return st * 1024 + (ob ^ (((ob >> 9) & 1) << 5)); }
DEVI void stage_rc(int b, int& R, int& C) { const int st = b / 1024, sb = b % 1024, swz = sb ^ (((sb >> 9) & 1) << 5); R = (st >> 1) * 16 + swz / 64; C = (st & 1) * 32 + (swz % 64) / 2; }
DEVI int perm32(int rho) { const int n = rho >> 4, i = rho & 15; return 8 * (i >> 2) + 4 * n + (i & 3); }
struct UnitU { const char* A; const char* B; int i0, i1, i2, i3; int flags; };

template <class Epi, class Sched>
DEVI void gemm8(char* lds_generic, int K, int klen, Sched& S, const Epi& E) {
    LAS unsigned char* lds = (LAS unsigned char*)lds_generic;
    const int tid = TIDX(), wid = __builtin_amdgcn_readfirstlane(tid >> 6), lane = tid & 63, wr = wid >> 2, wc = wid & 3, fr = lane & 15, fq = lane >> 4;
    const int nt = klen / BK;
    int R0, C0, R1, C1; stage_rc(tid * 16, R0, C0); stage_rc(tid * 16 + 8192, R1, C1);
    unsigned voffB[2];
    { const int Rb0 = Epi::PERM ? ((R0 & ~31) + perm32(R0 & 31)) : R0, Rb1 = Epi::PERM ? ((R1 & ~31) + perm32(R1 & 31)) : R1;
      voffB[0] = (unsigned)(Rb0 * K + C0) * 2u; voffB[1] = (unsigned)(Rb1 * K + C1) * 2u; }
    const size_t kstep = (size_t)(BK * 2), hstepB = (size_t)HALF * K * 2;
    const unsigned ldsw = (unsigned)wid * 1024u;
    const int aoff = lds_byte(wr * 64 + fr, fq * 8), boff = lds_byte(wc * 32 + fr, fq * 8);
#define G8_SA(b, h) (((b) * 2 + (h)) * HTB)
#define G8_SB(b, h) ((4 + (b) * 2 + (h)) * HTB)
#define G8_STG(bufoff, gbase, v0, v1) do { const char* _gb = uni_ptr((const char*)(gbase));     \
        __builtin_amdgcn_global_load_lds((const unsigned*)(_gb + (v0)), (LAS unsigned*)(lds + (bufoff) + ldsw), 16, 0, 0); \
        __builtin_amdgcn_global_load_lds((const unsigned*)(_gb + (v1)), (LAS unsigned*)(lds + (bufoff) + ldsw + 8192), 16, 0, 0); } while (0)
#define G8_LDA(dst, b, h) do { _Pragma("unroll") for (int m = 0; m < 4; ++m) _Pragma("unroll") for (int k = 0; k < 2; ++k) dst[m][k] = *(const LAS bf16x8*)(lds + G8_SA(b, h) + aoff + m * 2048 + k * 1024); } while (0)
#define G8_LDB(dst, b, h) do { _Pragma("unroll") for (int n = 0; n < 2; ++n) _Pragma("unroll") for (int k = 0; k < 2; ++k) dst[n][k] = *(const LAS bf16x8*)(lds + G8_SB(b, h) + boff + n * 2048 + k * 1024); } while (0)
#define G8_MMA(ai, bj, At, Bt) do { __builtin_amdgcn_s_setprio(1); _Pragma("unroll") for (int m = 0; m < 4; ++m) _Pragma("unroll") for (int n = 0; n < 2; ++n) _Pragma("unroll") for (int k = 0; k < 2; ++k) \
        acc[ai][bj][m][n] = __builtin_amdgcn_mfma_f32_16x16x32_bf16(Bt[n][k], At[m][k], acc[ai][bj][m][n], 0, 0, 0); __builtin_amdgcn_s_setprio(0); } while (0)
#define G8_WAIT_V(n) asm volatile("s_waitcnt vmcnt(" #n ")" ::: "memory")
#define G8_WAIT_L(n) asm volatile("s_waitcnt lgkmcnt(" #n ")" ::: "memory")
#define G8_BAR __builtin_amdgcn_s_barrier()
#define G8_SCHED __builtin_amdgcn_sched_barrier(0)
    UnitU cur, nxt;
    if (!S.next(cur)) return;
    unsigned va00, va01, va10, va11;
    S.lane_va(cur, R0, C0, R1, C1, va00, va01, va10, va11);
    f32x4 acc[2][2][4][2];
#pragma unroll
    for (int a = 0; a < 2; ++a)
#pragma unroll
        for (int b = 0; b < 2; ++b)
#pragma unroll
            for (int m = 0; m < 4; ++m)
#pragma unroll
                for (int n = 0; n < 2; ++n) acc[a][b][m][n] = (f32x4){0.f, 0.f, 0.f, 0.f};
    bf16x8 At[4][2], B0[2][2], B1[2][2];
    const char* cA = cur.A; const char* cB = cur.B;
    G8_STG(G8_SB(0, 0), cB, voffB[0], voffB[1]); G8_STG(G8_SA(0, 0), cA, va00, va01); G8_STG(G8_SB(0, 1), cB + hstepB, voffB[0], voffB[1]); G8_STG(G8_SA(0, 1), cA, va10, va11);
    if (wr == 1) G8_BAR;
    G8_WAIT_V(4); G8_BAR;
    G8_STG(G8_SB(1, 0), cB + kstep, voffB[0], voffB[1]); G8_STG(G8_SA(1, 0), cA + kstep, va00, va01); G8_STG(G8_SB(1, 1), cB + hstepB + kstep, voffB[0], voffB[1]);
    G8_WAIT_V(6); G8_BAR;
    for (;;) {
        const bool has_next = S.next(nxt);
        const char* nA = has_next ? nxt.A : cA; const char* nB = has_next ? nxt.B : cB;
        unsigned x00 = va00, x01 = va01, x10 = va10, x11 = va11;
        for (int t = 0; t < nt; t += 2) {
            const bool last = (t == nt - 2);
            const char* a1 = cA + (size_t)(t + 1) * kstep;
            const char* a2 = last ? nA : cA + (size_t)(t + 2) * kstep; const char* b2 = last ? nB : cB + (size_t)(t + 2) * kstep;
            const char* a3 = a2 + kstep; const char* b3 = b2 + kstep;
            if (Sched::GATHER) { if (last && has_next) S.lane_va(nxt, R0, C0, R1, C1, x00, x01, x10, x11); }
            G8_LDB(B0, 0, 0); G8_SCHED; G8_LDA(At, 0, 0); G8_STG(G8_SA(1, 1), a1, va10, va11);
            G8_WAIT_L(8); G8_BAR; G8_WAIT_L(0); G8_MMA(0, 0, At, B0); G8_BAR; G8_SCHED;
            G8_LDB(B1, 0, 1); G8_STG(G8_SB(0, 0), b2, voffB[0], voffB[1]);
            G8_BAR; G8_WAIT_L(0); G8_MMA(0, 1, At, B1); G8_BAR;
            G8_LDA(At, 0, 1); G8_STG(G8_SA(0, 0), a2, x00, x01);
            G8_BAR; G8_WAIT_L(0); G8_MMA(1, 0, At, B0); G8_BAR; G8_SCHED;
            G8_STG(G8_SB(0, 1), b2 + hstepB, voffB[0], voffB[1]);
            G8_WAIT_V(6); G8_BAR; G8_MMA(1, 1, At, B1); G8_BAR;
            G8_LDB(B0, 1, 0); G8_SCHED; G8_LDA(At, 1, 0); G8_STG(G8_SA(0, 1), a2, x10, x11);
            G8_WAIT_L(8); G8_BAR; G8_WAIT_L(0); G8_MMA(0, 0, At, B0); G8_BAR; G8_SCHED;
            G8_LDB(B1, 1, 1); G8_STG(G8_SB(1, 0), b3, voffB[0], voffB[1]);
            G8_BAR; G8_WAIT_L(0); G8_MMA(0, 1, At, B1); G8_BAR;
            G8_LDA(At, 1, 1); G8_STG(G8_SA(1, 0), a3, x00, x01);
            G8_BAR; G8_WAIT_L(0); G8_MMA(1, 0, At, B0); G8_BAR; G8_SCHED;
            G8_STG(G8_SB(1, 1), b3 + hstepB, voffB[0], voffB[1]);
            G8_WAIT_V(6); G8_BAR; G8_MMA(1, 1, At, B1); G8_BAR;
        }
        if (cur.flags & 2) E(acc, cur, wr, wc, fr, fq); else E.mid(acc, cur, wr, wc, fr, fq);
        if (!has_next) break;
        if (nxt.flags & 1) {
#pragma unroll
        for (int a = 0; a < 2; ++a)
#pragma unroll
            for (int b = 0; b < 2; ++b)
#pragma unroll
                for (int m = 0; m < 4; ++m)
#pragma unroll
                    for (int n = 0; n < 2; ++n) acc[a][b][m][n] = (f32x4){0.f, 0.f, 0.f, 0.f};
        }
        cur = nxt; cA = nA; cB = nB; va00 = x00; va01 = x01; va10 = x10; va11 = x11;
    }
    G8_WAIT_V(0);
    if (wr == 0) G8_BAR;
    G8_BAR;
#undef G8_SA
#undef G8_SB
#undef G8_STG
#undef G8_LDA
#undef G8_LDB
#undef G8_MMA
#undef G8_WAIT_V
#undef G8_WAIT_L
#undef G8_BAR
#undef G8_SCHED
}

struct DenseSched {
    static constexpr bool GATHER = false;
    const char* A; const char* Bt; int K, nM, nN, nwg, G, c, i;
    DEVI void init(const bf16_t* A_, const bf16_t* Bt_, int M, int N, int K_, int G_, int c_) { A = (const char*)A_; Bt = (const char*)Bt_; K = K_; nM = M / BM; nN = N / BM; nwg = nM * nN; G = G_; c = c_; i = 0; }
    DEVI bool next(UnitU& u) {
        const long L = (long)i * G + c; if (L >= nwg) return false;
        ++i;
        int wgid = (int)L; { const int q = nwg / 8, r = nwg % 8, xcd = wgid % 8, off = wgid / 8; wgid = (xcd < r ? xcd * (q + 1) : r * (q + 1) + (xcd - r) * q) + off; }
        const int nig = 8 * nN, gid = wgid / nig, fm = gid * 8, gsz = (nM - fm) < 8 ? (nM - fm) : 8;
        const int pm = fm + ((wgid % nig) % gsz), pn = (wgid % nig) / gsz;
        u.A = A + (size_t)pm * BM * K * 2; u.B = Bt + (size_t)pn * BM * K * 2; u.i0 = pm; u.i1 = pn; u.i2 = 0; u.i3 = 0; u.flags = 3;
        return true;
    }
    DEVI void lane_va(const UnitU&, int R0, int C0, int R1, int C1, unsigned& v00, unsigned& v01, unsigned& v10, unsigned& v11) const {
        v00 = (unsigned)(R0 * K + C0) * 2u; v01 = (unsigned)(R1 * K + C1) * 2u; v10 = v00 + (unsigned)(HALF * K * 2); v11 = v01 + (unsigned)(HALF * K * 2);
    }
};
struct EpiBf16Scale { static constexpr bool PERM = true; bf16_t* O; int ldo; const float* rstd;
    DEVI void mid(f32x4 (&)[2][2][4][2], const UnitU&, int, int, int, int) const {}
    DEVI void operator()(const f32x4 (&acc)[2][2][4][2], const UnitU& u, int wr, int wc, int fr, int fq) const {
        const int row0 = u.i0 * BM + wr * 64 + fr;
        bf16_t* base = O + (size_t)row0 * ldo + u.i1 * BM + wc * 32 + 8 * fq;
#pragma unroll
        for (int ai = 0; ai < 2; ++ai)
#pragma unroll
            for (int m = 0; m < 4; ++m) { bf16_t* rowp = base + (size_t)(ai * HALF + m * 16) * ldo; const float rs = rstd[row0 + ai * HALF + m * 16];
#pragma unroll
                for (int bj = 0; bj < 2; ++bj) { const f32x4 v0 = acc[ai][bj][m][0] * rs, v1 = acc[ai][bj][m][1] * rs;
                    u32x4 w; w.x = cvt_pk(v0[0], v0[1]); w.y = cvt_pk(v0[2], v0[3]); w.z = cvt_pk(v1[0], v1[1]); w.w = cvt_pk(v1[2], v1[3]);
                    *(u32x4*)(rowp + bj * HALF) = w; } }
    } };
struct EpiBf16 { static constexpr bool PERM = true; bf16_t* O; int ldo;
    DEVI void mid(f32x4 (&)[2][2][4][2], const UnitU&, int, int, int, int) const {}
    DEVI void operator()(const f32x4 (&acc)[2][2][4][2], const UnitU& u, int wr, int wc, int fr, int fq) const {
        bf16_t* base = O + (size_t)(u.i0 * BM + wr * 64 + fr) * ldo + u.i1 * BM + wc * 32 + 8 * fq;
#pragma unroll
        for (int ai = 0; ai < 2; ++ai)
#pragma unroll
            for (int m = 0; m < 4; ++m) { bf16_t* rowp = base + (size_t)(ai * HALF + m * 16) * ldo;
#pragma unroll
                for (int bj = 0; bj < 2; ++bj) { const f32x4 v0 = acc[ai][bj][m][0], v1 = acc[ai][bj][m][1];
                    u32x4 w; w.x = cvt_pk(v0[0], v0[1]); w.y = cvt_pk(v0[2], v0[3]); w.z = cvt_pk(v1[0], v1[1]); w.w = cvt_pk(v1[2], v1[3]);
                    *(u32x4*)(rowp + bj * HALF) = w; } }
    } };
struct EpiRes { static constexpr bool PERM = false; const float* R; float* O; int ld; bf16_t* H;
    DEVI void mid(f32x4 (&)[2][2][4][2], const UnitU&, int, int, int, int) const {}
    DEVI void operator()(const f32x4 (&acc)[2][2][4][2], const UnitU& u, int wr, int wc, int fr, int fq) const {
        const size_t off0 = (size_t)(u.i0 * BM + wr * 64 + fr) * ld + u.i1 * BM + wc * 32 + 4 * fq;
#pragma unroll
        for (int ai = 0; ai < 2; ++ai)
#pragma unroll
            for (int m = 0; m < 4; ++m) { const size_t off = off0 + (size_t)(ai * HALF + m * 16) * ld;
#pragma unroll
                for (int bj = 0; bj < 2; ++bj)
#pragma unroll
                    for (int n = 0; n < 2; ++n) { const f32x4 r = *(const f32x4*)(R + off + bj * HALF + n * 16); const f32x4 o = r + acc[ai][bj][m][n];
                        *(f32x4*)(O + off + bj * HALF + n * 16) = o;
                        u32x2 w; w.x = cvt_pk(o[0], o[1]); w.y = cvt_pk(o[2], o[3]); *(u32x2*)(H + off + bj * HALF + n * 16) = w; } }
    } };
struct DenseSched2 {
    static constexpr bool GATHER = false;
    DenseSched D; int sub;
    DEVI void init(const bf16_t* A_, const bf16_t* Bt_, int M, int N, int K_, int G_, int c_) { D.init(A_, Bt_, M, N, K_, G_, c_); sub = 0; }
    UnitU pend;
    DEVI bool next(UnitU& u) {
        if (sub == 0) { if (!D.next(pend)) return false; u = pend; u.A = pend.A + (size_t)(D.K / 2) * 2; u.B = pend.B + (size_t)(D.K / 2) * 2; u.flags = 1; sub = 1; return true; }
        u = pend; u.flags = 2; sub = 0; return true;
    }
    DEVI void lane_va(const UnitU& u, int R0, int C0, int R1, int C1, unsigned& v00, unsigned& v01, unsigned& v10, unsigned& v11) const { D.lane_va(u, R0, C0, R1, C1, v00, v01, v10, v11); }
};
struct EpiResScale : EpiRes { const float* ssq;
    DEVI void mid(f32x4 (&acc)[2][2][4][2], const UnitU& u, int wr, int wc, int fr, int fq) const {
#pragma unroll
        for (int ai = 0; ai < 2; ++ai)
#pragma unroll
            for (int m = 0; m < 4; ++m) {
                const int row = u.i0 * BM + ai * HALF + wr * 64 + m * 16 + fr;
                const float2 sq = *(const float2*)(ssq + (size_t)row * 2);
                const float rs = rsqrtf((sq.x + sq.y) * (1.0f / 512.0f) + EPS);
#pragma unroll
                for (int bj = 0; bj < 2; ++bj)
#pragma unroll
                    for (int n = 0; n < 2; ++n) acc[ai][bj][m][n] *= rs;
            }
    } };
}

DEVI void cumsum_task(const DP& p, int bh, char* lds) {
    const int tid = TIDX(), wid = tid >> 6, lane = tid & 63;
    const int b = bh >> 2, h = bh & 3;
    const float* logf = (const float*)(p.ws() + WS_LOGF);
    float* cumf = (float*)(p.ws() + WS_CUMF);
    float* wtot = (float*)lds;
    float v[4];
#pragma unroll
    for (int j = 0; j < 4; ++j) v[j] = logf[((size_t)b * S + tid * 4 + j) * 4 + h];
    v[1] += v[0]; v[2] += v[1]; v[3] += v[2];
    float incl = v[3];
#pragma unroll
    for (int d = 1; d < 64; d <<= 1) { const float t = __shfl_up(incl, d); if (lane >= d) incl += t; }
    if (lane == 63) wtot[wid] = incl;
    __syncthreads();
    float woff = 0.f;
    for (int w = 0; w < wid; ++w) woff += wtot[w];
    const float base = woff + incl - v[3];
    *(float4*)(cumf + (size_t)bh * S + tid * 4) = make_float4(base + v[0], base + v[1], base + v[2], base + v[3]);
    __syncthreads();
}
DEVI void phase_inproj(const DP& p, int l, char* lds) {
    unsigned char* ws = p.ws();
    for (int t = BIDX(); t < 32; t += gridDim.x) cumsum_task(p, t, lds);
    g8::DenseSched S; S.init((const bf16_t*)(ws + WS_HBUF), (const bf16_t*)(ws + WS_W_IN), T, NPROJ, DM, gridDim.x, BIDX());
    g8::EpiBf16Scale E{(bf16_t*)(ws + WS_PROJ), NPROJ, (const float*)(ws + WS_RSTD1)};
    g8::gemm8(lds, DM, DM, S, E);
}
DEVI void kv_gemm(const DP& p, char* lds) {
    unsigned char* ws = p.ws();
    const int c = BIDX() - ((int)gridDim.x - 64);
    if (c < 0) return;
    g8::DenseSched S; S.init((const bf16_t*)(ws + WS_MEMN), (const bf16_t*)(ws + WS_W_KV), MROWS, 2 * DM, DM, 64, c);
    g8::EpiBf16 E{(bf16_t*)(ws + WS_KV), 2 * DM};
    g8::gemm8(lds, DM, DM, S, E);
}

DEVI void conv8_pos(const DP& p, int l, const bf16_t* proj, int b, int sp, int chan0, float (&out)[8]) {
    float a[8];
    const float* cb = p.in(10) + l * 1024 + chan0;
#pragma unroll
    for (int i = 0; i < 8; ++i) a[i] = cb[i];
#pragma unroll
    for (int j = 0; j < 4; ++j) {
        const int s2 = sp - 3 + j;
        if (s2 >= 0) {
            const u32x4 w = *(const u32x4*)(proj + ((size_t)b * S + s2) * NPROJ + C_XBC + chan0);
            const float* cw = p.in(9) + ((size_t)l * 4 + j) * 1024 + chan0;
            a[0] += cw[0] * bflo(w.x); a[1] += cw[1] * bfhi(w.x); a[2] += cw[2] * bflo(w.y); a[3] += cw[3] * bfhi(w.y);
            a[4] += cw[4] * bflo(w.z); a[5] += cw[5] * bfhi(w.z); a[6] += cw[6] * bflo(w.w); a[7] += cw[7] * bfhi(w.w);
        }
    }
#pragma unroll
    for (int i = 0; i < 8; ++i) out[i] = silu_f(a[i]);
}
DEVI u32x4 pack8(const float (&v)[8]) { u32x4 w; w.x = cvt_pk(v[0], v[1]); w.y = cvt_pk(v[2], v[3]); w.z = cvt_pk(v[4], v[5]); w.w = cvt_pk(v[6], v[7]); return w; }


DEVI void phase_post(const DP& p, int l) {
    const int tid = TIDX(), wid = tid >> 6, lane = tid & 63;
    unsigned char* ws = p.ws();
    bf16_t* proj = (bf16_t*)(ws + WS_PROJ);
    const int sl = lane >> 2, qt = lane & 3, type = sl >> 2, head = sl & 3;
    const int col0 = (type < 2 ? type * 256 : 768 + (type - 2) * 256) + head * 64 + qt * 16;
    const float *gq0 = p.in(5), *gq1 = p.in(6), *gq2 = p.in(7), *gq3 = p.in(8);
    asm volatile("" : "+s"(gq0), "+s"(gq1), "+s"(gq2), "+s"(gq3));
    const float* gain = (type == 0 ? gq0 : type == 1 ? gq1 : type == 2 ? gq2 : gq3) + l * 64 + qt * 16;
    float gv[16];
#pragma unroll
    for (int i = 0; i < 16; ++i) gv[i] = gain[i];
    const float inv[8] = {1.000000000e+00f, 1.939227432e-01f, 3.760603070e-02f, 7.292664610e-03f, 1.414213562e-03f, 2.742481884e-04f, 5.318295734e-05f, 1.031338525e-05f};
    for (int row = BIDX() * 8 + wid; row < T; row += gridDim.x * 8) {
        bf16_t* ptr = proj + (size_t)row * NPROJ + col0;
        const u32x4 w0 = *(const u32x4*)ptr, w1 = *(const u32x4*)(ptr + 8);
        float v[16];
        v[0] = bflo(w0.x); v[1] = bfhi(w0.x); v[2] = bflo(w0.y); v[3] = bfhi(w0.y); v[4] = bflo(w0.z); v[5] = bfhi(w0.z); v[6] = bflo(w0.w); v[7] = bfhi(w0.w);
        v[8] = bflo(w1.x); v[9] = bfhi(w1.x); v[10] = bflo(w1.y); v[11] = bfhi(w1.y); v[12] = bflo(w1.z); v[13] = bfhi(w1.z); v[14] = bflo(w1.w); v[15] = bfhi(w1.w);
        float ss = 0.f;
#pragma unroll
        for (int i = 0; i < 16; ++i) ss += v[i] * v[i];
        ss += __shfl_xor(ss, 1); ss += __shfl_xor(ss, 2);
        const float rstd = rsqrtf(ss * (1.0f / 64.0f) + EPS);
#pragma unroll
        for (int i = 0; i < 16; ++i) v[i] = v[i] * rstd * gv[i];
        if (type >= 2 && qt == 0) {
            const float pos = (float)(row & (S - 1));
#pragma unroll
            for (int i = 0; i < 8; ++i) { float sn, cs; sincosf(pos * inv[i], &sn, &cs);
                const float a = v[i], b = v[i + 8]; v[i] = a * cs - b * sn; v[i + 8] = b * cs + a * sn; }
        }
        u32x4 o0, o1;
        o0.x = cvt_pk(v[0], v[1]); o0.y = cvt_pk(v[2], v[3]); o0.z = cvt_pk(v[4], v[5]); o0.w = cvt_pk(v[6], v[7]);
        o1.x = cvt_pk(v[8], v[9]); o1.y = cvt_pk(v[10], v[11]); o1.z = cvt_pk(v[12], v[13]); o1.w = cvt_pk(v[14], v[15]);
        *(u32x4*)ptr = o0; *(u32x4*)(ptr + 8) = o1;
    }
    bf16_t* xc = (bf16_t*)(ws + WS_XC);
    for (int item = BIDX() * NTHR + tid; item < T * 128; item += gridDim.x * NTHR) {
        const int t = item >> 7, c8 = (item & 127) * 8;
        float v[8]; conv8_pos(p, l, proj, t / S, t % S, c8, v);
        *(u32x4*)(xc + (size_t)t * 1024 + c8) = pack8(v);
    }
}
DEVI void phase_knorm(const DP& p, int l) {
    const int tid = TIDX(), wid = tid >> 6, lane = tid & 63;
    unsigned char* ws = p.ws();
    bf16_t* kv = (bf16_t*)(ws + WS_KV);
    const float* kg = p.in(21) + l * 256 + (lane & 15) * 16;
    float kgv[16];
#pragma unroll
    for (int i = 0; i < 16; ++i) kgv[i] = kg[i];
    for (int row = BIDX() * 8 + wid; row < MROWS; row += gridDim.x * 8) {
        bf16_t* ptr = kv + (size_t)row * 2 * DM + lane * 16;
        const u32x4 w0 = *(const u32x4*)ptr, w1 = *(const u32x4*)(ptr + 8);
        float v[16];
        v[0] = bflo(w0.x); v[1] = bfhi(w0.x); v[2] = bflo(w0.y); v[3] = bfhi(w0.y); v[4] = bflo(w0.z); v[5] = bfhi(w0.z); v[6] = bflo(w0.w); v[7] = bfhi(w0.w);
        v[8] = bflo(w1.x); v[9] = bfhi(w1.x); v[10] = bflo(w1.y); v[11] = bfhi(w1.y); v[12] = bflo(w1.z); v[13] = bfhi(w1.z); v[14] = bflo(w1.w); v[15] = bfhi(w1.w);
        float ss = 0.f;
#pragma unroll
        for (int i = 0; i < 16; ++i) ss += v[i] * v[i];
        ss += __shfl_xor(ss, 1); ss += __shfl_xor(ss, 2); ss += __shfl_xor(ss, 4); ss += __shfl_xor(ss, 8);
        const float rstd = rsqrtf(ss * (1.0f / 256.0f) + EPS);
#pragma unroll
        for (int i = 0; i < 16; ++i) v[i] = v[i] * rstd * kgv[i];
        u32x4 o0, o1;
        o0.x = cvt_pk(v[0], v[1]); o0.y = cvt_pk(v[2], v[3]); o0.z = cvt_pk(v[4], v[5]); o0.w = cvt_pk(v[6], v[7]);
        o1.x = cvt_pk(v[8], v[9]); o1.y = cvt_pk(v[10], v[11]); o1.z = cvt_pk(v[12], v[13]); o1.w = cvt_pk(v[14], v[15]);
        *(u32x4*)ptr = o0; *(u32x4*)(ptr + 8) = o1;
    }
}
constexpr float LOG2E = 1.4426950408889634f;
template <int DH> struct AttnLds { static constexpr int KST = DH + 8; static constexpr int TILE = 64 * KST; static constexpr int BYTES = 4 * TILE * 2; };
DEVI float xor16_max(float v) { return fmaxf(v, __shfl_xor(v, 16)); }
DEVI float xor32_max(float v) { auto r = __builtin_amdgcn_permlane32_swap(__float_as_uint(v), __float_as_uint(v), false, false); return fmaxf(__uint_as_float(r[0]), __uint_as_float(r[1])); }
DEVI float xor32_sum(float v) { auto r = __builtin_amdgcn_permlane32_swap(__float_as_uint(v), __float_as_uint(v), false, false); return __uint_as_float(r[0]) + __uint_as_float(r[1]); }
template <int DH, int MODE>
DEVI void attn_task(const bf16_t* __restrict__ Qb, int ldq, int qtok0, int qstep,
                    const bf16_t* __restrict__ Kb, const bf16_t* __restrict__ Vb, int ldk, int ktok0, int kstep,
                    int p0, int kt_lo, int kt_hi, float scale,
                    const float* __restrict__ cum, const float* __restrict__ qgain,
                    bf16_t* Ob, int ldo, float* Of, float* Om, float* Ol, char* lds) {
    constexpr int KST = AttnLds<DH>::KST, TILE = AttnLds<DH>::TILE, NKK = DH / 32, ND = DH / 16, NCH = (64 * DH / 8) / NTHR;
    const int tid = TIDX(), wid = tid >> 6, lane = tid & 63, r16 = lane & 15, g4 = lane >> 4;
    bf16_t* Ks = (bf16_t*)lds;
    bf16_t* Vs = Ks + 2 * TILE;
    const float c2 = scale * LOG2E;
    bf16x8 qf[NKK];
    {
        const bf16_t* qp = Qb + (size_t)(qtok0 + (p0 + wid * 16 + r16) * qstep) * ldq + g4 * 8;
#pragma unroll
        for (int kk = 0; kk < NKK; ++kk) qf[kk] = *(const bf16x8*)(qp + kk * 32);
    }
    if (MODE == 2) {
        float ss = 0.f;
#pragma unroll
        for (int kk = 0; kk < NKK; ++kk)
#pragma unroll
            for (int j = 0; j < 8; ++j) { const float v = bf2f((bf16_t)qf[kk][j]); ss += v * v; }
        ss += __shfl_xor(ss, 16); ss += __shfl_xor(ss, 32);
        const float rstd = rsqrtf(ss * (1.0f / DH) + EPS);
#pragma unroll
        for (int kk = 0; kk < NKK; ++kk)
#pragma unroll
            for (int j = 0; j < 8; ++j) { const float v = bf2f((bf16_t)qf[kk][j]) * rstd * qgain[kk * 32 + g4 * 8 + j]; qf[kk][j] = (short)f2bf(v); }
    }
    const int qpos = p0 + wid * 16 + r16;
    float m_ = -1.0e30f, l_ = 0.f;
    const float cq = (MODE == 0) ? cum[qpos] * LOG2E : 0.f;
    f32x4 o[ND];
#pragma unroll
    for (int n = 0; n < ND; ++n) o[n] = (f32x4){0.f, 0.f, 0.f, 0.f};
    u32x4 rk[NCH], rv[NCH];
    auto gload = [&](int kt) {
#pragma unroll
        for (int i = 0; i < NCH; ++i) { const int c = tid + i * NTHR, key = c / (DH / 8), dc = c % (DH / 8);
            const size_t tok = (size_t)(ktok0 + (kt * 64 + key) * kstep);
            rk[i] = *(const u32x4*)(Kb + tok * ldk + dc * 8); rv[i] = *(const u32x4*)(Vb + tok * ldk + dc * 8); }
    };
    gload(kt_lo);
    __syncthreads();
    int buf = 0;
    for (int kt = kt_lo; kt < kt_hi; ++kt, buf ^= 1) {
        bf16_t* Kt = Ks + buf * TILE;
        bf16_t* Vt = Vs + buf * TILE;
#pragma unroll
        for (int i = 0; i < NCH; ++i) { const int c = tid + i * NTHR, key = c / (DH / 8), dc = c % (DH / 8);
            *(u32x4*)(Kt + key * KST + dc * 8) = rk[i]; *(u32x4*)(Vt + key * KST + dc * 8) = rv[i]; }
        __syncthreads();
        if (kt + 1 < kt_hi) gload(kt + 1);
        f32x4 s[4];
#pragma unroll
        for (int n = 0; n < 4; ++n) {
            s[n] = (f32x4){0.f, 0.f, 0.f, 0.f};
#pragma unroll
            for (int kk = 0; kk < NKK; ++kk) {
                const bf16x8 kf = *(const bf16x8*)(Kt + (n * 16 + r16) * KST + kk * 32 + g4 * 8);
                s[n] = MFMA16(kf, qf[kk], s[n]);
            }
            if (DH > 64) __builtin_amdgcn_sched_barrier(0);
        }
        float mx = -INFINITY;
#pragma unroll
        for (int n = 0; n < 4; ++n) {
            f32x4 ck = (f32x4){0.f, 0.f, 0.f, 0.f};
            if (MODE == 0) ck = *(const f32x4*)(cum + kt * 64 + n * 16 + g4 * 4);
#pragma unroll
            for (int j = 0; j < 4; ++j) {
                const int kpos = kt * 64 + n * 16 + g4 * 4 + j;
                float t = s[n][j] * c2;
                if (MODE == 0) { t += cq - ck[j] * LOG2E; if (kpos > qpos) t = -INFINITY; }
                if (MODE == 1) { const int dd = qpos - kpos; if (dd < 0 || dd > 128) t = -INFINITY; }
                s[n][j] = t; mx = fmaxf(mx, t);
            }
        }
        mx = xor32_max(xor16_max(mx));
        const float mn = fmaxf(m_, mx);
        const float alpha = __builtin_amdgcn_exp2f(m_ - mn);
        float rs = 0.f;
#pragma unroll
        for (int n = 0; n < 4; ++n)
#pragma unroll
            for (int j = 0; j < 4; ++j) { const float pv = __builtin_amdgcn_exp2f(s[n][j] - mn); s[n][j] = pv; rs += pv; }
        rs += __shfl_xor(rs, 16); rs = xor32_sum(rs);
        l_ = l_ * alpha + rs; m_ = mn;
#pragma unroll
        for (int n = 0; n < ND; ++n) o[n] *= alpha;
#pragma unroll
        for (int kk = 0; kk < 2; ++kk) {
            bf16x8 pb;
            { const unsigned w0 = cvt_pk(s[2 * kk][0], s[2 * kk][1]), w1 = cvt_pk(s[2 * kk][2], s[2 * kk][3]), w2 = cvt_pk(s[2 * kk + 1][0], s[2 * kk + 1][1]), w3 = cvt_pk(s[2 * kk + 1][2], s[2 * kk + 1][3]);
              u32x4 w; w.x = w0; w.y = w1; w.z = w2; w.w = w3; pb = __builtin_bit_cast(bf16x8, w); }
            const bf16_t* vb = Vt + (kk * 32 + 4 * g4 + (r16 >> 2)) * KST + 4 * (r16 & 3);
#pragma unroll
            for (int n = 0; n < ND; ++n) {
                const s16x4 lo = tr_read(vb + n * 16), hi = tr_read(vb + 16 * KST + n * 16);
                bf16x8 vf; vf[0] = lo[0]; vf[1] = lo[1]; vf[2] = lo[2]; vf[3] = lo[3]; vf[4] = hi[0]; vf[5] = hi[1]; vf[6] = hi[2]; vf[7] = hi[3];
                o[n] = MFMA16(vf, pb, o[n]);
                if (DH > 64 && (n & 3) == 3) __builtin_amdgcn_sched_barrier(0);
            }
        }
    }
    const size_t tok = (size_t)(qtok0 + qpos * qstep);
    if (MODE == 1) {
#pragma unroll
        for (int n = 0; n < ND; ++n) *(f32x4*)(Of + tok * 256 + n * 16 + g4 * 4) = o[n];
        if (g4 == 0) { Om[tok * 4] = m_; Ol[tok * 4] = l_; }
    } else {
        const float inv = 1.0f / l_;
#pragma unroll
        for (int n = 0; n < ND; ++n) { u32x2 w; w.x = cvt_pk(o[n][0] * inv, o[n][1] * inv); w.y = cvt_pk(o[n][2] * inv, o[n][3] * inv);
            *(u32x2*)(Ob + tok * ldo + n * 16 + g4 * 4) = w; }
    }
}

DEVI void ssd_acs(const DP& p, int l, int b, int c, int g, float* acs, float* dts) {
    const int tid = TIDX(), wid = tid >> 6, lane = tid & 63;
    if (wid < 4) {
        const int head = g * 4 + wid;
        const float* dtv = (const float*)(p.ws() + WS_DTV);
        const float A = -__expf(p.in(12)[l * 8 + head]);
        const size_t t0 = (size_t)b * S + c * 128 + 2 * lane;
        const float d0 = dtv[t0 * 8 + head], d1 = dtv[(t0 + 1) * 8 + head];
        const float a0 = d0 * A, a1 = d1 * A;
        float incl = a0 + a1;
#pragma unroll
        for (int d = 1; d < 64; d <<= 1) { const float t = __shfl_up(incl, d); if (lane >= d) incl += t; }
        const float ex = incl - (a0 + a1);
        acs[wid * 128 + 2 * lane] = ex + a0; acs[wid * 128 + 2 * lane + 1] = ex + a0 + a1;
        dts[wid * 128 + 2 * lane] = d0; dts[wid * 128 + 2 * lane + 1] = d1;
    }
}
DEVI void conv8_chan(const DP& p, int l, const bf16_t* proj, int b, int c, int chan, int l0, float (&out)[8]) {
    const float* cw = p.in(9) + (size_t)l * 4 * 1024 + chan;
    const float w0 = cw[0], w1 = cw[1024], w2 = cw[2048], w3 = cw[3072], cb = p.in(10)[l * 1024 + chan];
    float v[11];
    const int sbase = c * 128 + l0 - 3;
#pragma unroll
    for (int i = 0; i < 11; ++i) { const int sp = sbase + i; v[i] = sp >= 0 ? bf2f(proj[((size_t)b * S + sp) * NPROJ + C_XBC + chan]) : 0.f; }
#pragma unroll
    for (int i = 0; i < 8; ++i) out[i] = silu_f(cb + w0 * v[i] + w1 * v[i + 1] + w2 * v[i + 2] + w3 * v[i + 3]);
}
constexpr int SST = 136;
constexpr int XST4 = 264;
DEVI void ssd_states_task(const DP& p, int l, int b, int c, int g, char* lds) {
    const int tid = TIDX(), wid = tid >> 6, lane = tid & 63, r16 = lane & 15, g4 = lane >> 4;
    const bf16_t* xc = (const bf16_t*)(p.ws() + WS_XC);
    bf16_t* Bn = (bf16_t*)lds;
    bf16_t* Xn = Bn + 128 * SST;
    float* acs = (float*)(Xn + 128 * XST4);
    float* dts = acs + 512;
    __syncthreads();
    ssd_acs(p, l, b, c, g, acs, dts);
    __syncthreads();
    if (tid < 4) ((float*)(p.ws() + WS_DECAY))[((size_t)b * 16 + c) * 8 + g * 4 + tid] = __expf(acs[tid * 128 + 127]);
    const size_t tok0 = (size_t)b * S + c * 128;
    for (int it = tid; it < 2048; it += NTHR) {
        const int ll = it >> 4, nc = (it & 15) * 8;
        *(u32x4*)(Bn + ll * SST + nc) = *(const u32x4*)(xc + (tok0 + ll) * 1024 + 512 + g * 128 + nc);
    }
    for (int it = tid; it < 4096; it += NTHR) {
        const int ll = it >> 5, ch = (it & 31) * 8, hl = ch >> 6;
        const u32x4 w = *(const u32x4*)(xc + (tok0 + ll) * 1024 + g * 256 + ch);
        const float sc = dts[hl * 128 + ll] * __expf(acs[hl * 128 + 127] - acs[hl * 128 + ll]);
        u32x4 o; o.x = cvt_pk(bflo(w.x) * sc, bfhi(w.x) * sc); o.y = cvt_pk(bflo(w.y) * sc, bfhi(w.y) * sc); o.z = cvt_pk(bflo(w.z) * sc, bfhi(w.z) * sc); o.w = cvt_pk(bflo(w.w) * sc, bfhi(w.w) * sc);
        *(u32x4*)(Xn + ll * XST4 + ch) = o;
    }
    __syncthreads();
    const int hl = wid >> 1, nh = wid & 1;
    f32x4 acc[4][4];
#pragma unroll
    for (int m = 0; m < 4; ++m)
#pragma unroll
        for (int n = 0; n < 4; ++n) acc[m][n] = (f32x4){0.f, 0.f, 0.f, 0.f};
#pragma unroll
    for (int kk = 0; kk < 4; ++kk) {
        bf16x8 af[4], bfr[4];
        const int lrow = kk * 32 + 8 * g4 + (r16 >> 2), cq = 4 * (r16 & 3);
#pragma unroll
        for (int m = 0; m < 4; ++m) { const bf16_t* a = Xn + lrow * XST4 + hl * 64 + m * 16 + cq; const s16x4 lo = tr_read(a), hi = tr_read(a + 4 * XST4);
            af[m][0] = lo[0]; af[m][1] = lo[1]; af[m][2] = lo[2]; af[m][3] = lo[3]; af[m][4] = hi[0]; af[m][5] = hi[1]; af[m][6] = hi[2]; af[m][7] = hi[3]; }
#pragma unroll
        for (int n = 0; n < 4; ++n) { const bf16_t* a = Bn + lrow * SST + nh * 64 + n * 16 + cq; const s16x4 lo = tr_read(a), hi = tr_read(a + 4 * SST);
            bfr[n][0] = lo[0]; bfr[n][1] = lo[1]; bfr[n][2] = lo[2]; bfr[n][3] = lo[3]; bfr[n][4] = hi[0]; bfr[n][5] = hi[1]; bfr[n][6] = hi[2]; bfr[n][7] = hi[3]; }
#pragma unroll
        for (int m = 0; m < 4; ++m)
#pragma unroll
            for (int n = 0; n < 4; ++n) acc[m][n] = MFMA16(bfr[n], af[m], acc[m][n]);
    }
    float* st = (float*)(p.ws() + WS_SSTATE) + (((size_t)b * 16 + c) * 8 + g * 4 + hl) * 8192;
#pragma unroll
    for (int m = 0; m < 4; ++m)
#pragma unroll
        for (int n = 0; n < 4; ++n) *(f32x4*)(st + (m * 16 + r16) * 128 + nh * 64 + n * 16 + g4 * 4) = acc[m][n];
}
DEVI void phase_ssd_scan(const DP& p) {
    const float* st = (const float*)(p.ws() + WS_SSTATE);
    bf16_t* hin = (bf16_t*)(p.ws() + WS_HIN);
    const float* decay = (const float*)(p.ws() + WS_DECAY);
    const int total = NB * 8 * 2048;
    for (int i = BIDX() * NTHR + TIDX(); i < total; i += gridDim.x * NTHR) {
        const int e4 = i & 2047, head = (i >> 11) & 7, b = i >> 14;
        f32x4 h = (f32x4){0.f, 0.f, 0.f, 0.f};
        for (int c = 0; c < 16; ++c) {
            const size_t off = (((size_t)b * 16 + c) * 8 + head) * 8192 + e4 * 4;
            u32x2 w; w.x = cvt_pk(h[0], h[1]); w.y = cvt_pk(h[2], h[3]);
            *(u32x2*)(hin + off) = w;
            const f32x4 s = *(const f32x4*)(st + off);
            const float d = decay[((size_t)b * 16 + c) * 8 + head];
            h = h * d + s;
        }
    }
}
constexpr int XST1 = 72;
DEVI void ssd_out_task(const DP& p, int l, int b, int c, int g, char* lds) {
    const int tid = TIDX(), wid = tid >> 6, lane = tid & 63, r16 = lane & 15, g4 = lane >> 4;
    const bf16_t* proj = (const bf16_t*)(p.ws() + WS_PROJ);
    const bf16_t* xc = (const bf16_t*)(p.ws() + WS_XC);
    bf16_t* Cs = (bf16_t*)lds;
    bf16_t* Bs = Cs + 128 * SST;
    bf16_t* Xn = Bs + 128 * SST;
    bf16_t* Hs = Xn + 128 * XST1;
    bf16_t* Mw = Hs + 64 * SST + wid * 16 * SST;
    float* acs = (float*)(Hs + 64 * SST + 8 * 16 * SST);
    float* dts = acs + 512;
    const int lrow = wid * 16 + r16;
    const size_t tok0 = (size_t)b * S + c * 128, tok = tok0 + lrow;
    bf16_t* mix = (bf16_t*)(p.ws() + WS_MIX);
    float ssq = 0.f;
    __syncthreads();
    ssd_acs(p, l, b, c, g, acs, dts);
    for (int it = tid; it < 2048; it += NTHR) {
        const int ll = it >> 4, nc = (it & 15) * 8;
        *(u32x4*)(Cs + ll * SST + nc) = *(const u32x4*)(xc + (tok0 + ll) * 1024 + 768 + g * 128 + nc);
        *(u32x4*)(Bs + ll * SST + nc) = *(const u32x4*)(xc + (tok0 + ll) * 1024 + 512 + g * 128 + nc);
    }
    __syncthreads();
    bf16x8 cfr[4];
#pragma unroll
    for (int kk = 0; kk < 4; ++kk) cfr[kk] = *(const bf16x8*)(Cs + lrow * SST + kk * 32 + g4 * 8);
    f32x4 cb[8];
#pragma unroll
    for (int st = 0; st < 8; ++st) {
        cb[st] = (f32x4){0.f, 0.f, 0.f, 0.f};
#pragma unroll
        for (int kk = 0; kk < 4; ++kk) {
            const bf16x8 bfr = *(const bf16x8*)(Bs + (st * 16 + r16) * SST + kk * 32 + g4 * 8);
            cb[st] = MFMA16(bfr, cfr[kk], cb[st]);
        }
    }
    for (int hl = 0; hl < 4; ++hl) {
        const int head = g * 4 + hl;
        __syncthreads();
        for (int it = tid; it < 1024; it += NTHR) {
            const int ss = it >> 3, pc8 = (it & 7) * 8;
            *(u32x4*)(Xn + ss * XST1 + pc8) = *(const u32x4*)(xc + (tok0 + ss) * 1024 + head * 64 + pc8);
            const bf16_t* hsrc = (const bf16_t*)(p.ws() + WS_HIN) + (((size_t)b * 16 + c) * 8 + head) * 8192 + (size_t)it * 8;
            *(u32x4*)(Hs + (it >> 4) * SST + (it & 15) * 8) = *(const u32x4*)hsrc;
        }
        __syncthreads();
        const float al = acs[hl * 128 + lrow];
#pragma unroll
        for (int st = 0; st < 8; ++st) {
            float mv[4];
#pragma unroll
            for (int j = 0; j < 4; ++j) { const int sidx = st * 16 + g4 * 4 + j;
                mv[j] = (sidx <= lrow) ? cb[st][j] * __expf(al - acs[hl * 128 + sidx]) * dts[hl * 128 + sidx] : 0.f; }
            u32x2 w; w.x = cvt_pk(mv[0], mv[1]); w.y = cvt_pk(mv[2], mv[3]);
            *(u32x2*)(Mw + r16 * SST + st * 16 + g4 * 4) = w;
        }
        __builtin_amdgcn_wave_barrier();
        asm volatile("s_waitcnt lgkmcnt(0)" ::: "memory");
        f32x4 yd[4], yo[4];
#pragma unroll
        for (int pt = 0; pt < 4; ++pt) { yd[pt] = (f32x4){0.f, 0.f, 0.f, 0.f}; yo[pt] = (f32x4){0.f, 0.f, 0.f, 0.f}; }
#pragma unroll
        for (int kk = 0; kk < 4; ++kk) {
            const bf16x8 mf = *(const bf16x8*)(Mw + r16 * SST + kk * 32 + g4 * 8);
            const bf16_t* xa = Xn + (kk * 32 + 8 * g4 + (r16 >> 2)) * XST1 + 4 * (r16 & 3);
#pragma unroll
            for (int pt = 0; pt < 4; ++pt) {
                const s16x4 lo = tr_read(xa + pt * 16), hi = tr_read(xa + 4 * XST1 + pt * 16);
                bf16x8 xf; xf[0] = lo[0]; xf[1] = lo[1]; xf[2] = lo[2]; xf[3] = lo[3]; xf[4] = hi[0]; xf[5] = hi[1]; xf[6] = hi[2]; xf[7] = hi[3];
                yd[pt] = MFMA16(xf, mf, yd[pt]);
                const bf16x8 hf = *(const bf16x8*)(Hs + (pt * 16 + r16) * SST + kk * 32 + g4 * 8);
                yo[pt] = MFMA16(hf, cfr[kk], yo[pt]);
            }
        }
        __builtin_amdgcn_wave_barrier();
        const float el = __expf(al), Dh = p.in(13)[l * 8 + head];
#pragma unroll
        for (int pt = 0; pt < 4; ++pt) {
            const int pc = pt * 16 + g4 * 4;
            const u32x2 zw = *(const u32x2*)(proj + tok * NPROJ + C_Z + head * 64 + pc);
            const u32x2 xw = *(const u32x2*)(Xn + lrow * XST1 + pc);
            const float zz[4] = {bflo(zw.x), bfhi(zw.x), bflo(zw.y), bfhi(zw.y)};
            const float xx[4] = {bflo(xw.x), bfhi(xw.x), bflo(xw.y), bfhi(xw.y)};
            float gv[4];
#pragma unroll
            for (int j = 0; j < 4; ++j) { const float yv = yd[pt][j] + el * yo[pt][j] + Dh * xx[j]; gv[j] = yv * silu_f(zz[j]); ssq += gv[j] * gv[j]; }
            u32x2 w; w.x = cvt_pk(gv[0], gv[1]); w.y = cvt_pk(gv[2], gv[3]);
            *(u32x2*)(mix + tok * DM + 512 + head * 64 + pc) = w;
        }
    }
    ssq += __shfl_xor(ssq, 16); ssq += __shfl_xor(ssq, 32);
    if (g4 == 0) ((float*)(p.ws() + WS_SSQ))[tok * 2 + g] = ssq;
}
constexpr int N_FOX = 512, N_S1 = 256, N_DIL = 1536;
DEVI void phase_mix1(const DP& p, int l, char* lds) {
    unsigned char* ws = p.ws();
    kv_gemm(p, lds);
    const bf16_t* proj = (const bf16_t*)(ws + WS_PROJ);
    bf16_t* mix = (bf16_t*)(ws + WS_MIX);
    for (int t = BIDX(); t < N_FOX + N_S1 + N_DIL; t += gridDim.x) {
        if (t < N_FOX) {
            const int bh = t & 31, k = t >> 5;
            const int qb = k < 8 ? 15 - k : k - 8;
            const int b = bh >> 2, h = bh & 3;
            const float* cum = (const float*)(ws + WS_CUMF) + (size_t)bh * S;
            attn_task<64, 0>(proj + C_FQ + h * 64, NPROJ, b * S, 1, proj + C_FK + h * 64, proj + C_FV + h * 64, NPROJ, b * S, 1,
                             qb * 128, 0, 2 * qb + 2, 0.125f, cum, nullptr, mix + h * 64, DM, nullptr, nullptr, nullptr, lds);
        } else if (t < N_FOX + N_S1) {
            const int u = t - N_FOX, g = u & 1, c = (u >> 1) & 15, b = u >> 5;
            ssd_states_task(p, l, b, c, g, lds);
        } else {
            const int u = t - N_FOX - N_S1, bh = u & 31, v = u >> 5;
            const int b = bh >> 2, h = bh & 3;
            int br, dil, r, pb;
            if (v < 16) { br = 0; dil = 1; r = 0; pb = v; }
            else if (v < 32) { br = 1; dil = 4; r = (v - 16) & 3; pb = (v - 16) >> 2; }
            else { br = 2; dil = 16; r = v - 32; pb = 0; }
            float* Of = (float*)(ws + WS_DILO) + (size_t)br * T * 256 + h * 64;
            float* Om = (float*)(ws + WS_DILM) + (size_t)br * T * 4 + h;
            float* Ol = (float*)(ws + WS_DILL) + (size_t)br * T * 4 + h;
            const int klo = pb > 0 ? 2 * pb - 2 : 0;
            attn_task<64, 1>(proj + C_DQ + h * 64, NPROJ, b * S + r, dil, proj + C_DK + h * 64, proj + C_DV + h * 64, NPROJ, b * S + r, dil,
                             pb * 128, klo, 2 * pb + 2, 0.125f, nullptr, nullptr, nullptr, 0, Of, Om, Ol, lds);
        }
    }
}
DEVI void phase_mix3(const DP& p, int l, char* lds) {
    unsigned char* ws = p.ws();
    for (int t = BIDX(); t < NB * 16 * 2; t += gridDim.x) ssd_out_task(p, l, t >> 5, (t >> 1) & 15, t & 1, lds);
    const int tid = TIDX(), wid = tid >> 6, lane = tid & 63, head = lane >> 4, d4 = (lane & 15) * 4;
    const float* Of = (const float*)(ws + WS_DILO);
    const float* Om = (const float*)(ws + WS_DILM);
    const float* Ol = (const float*)(ws + WS_DILL);
    bf16_t* mix = (bf16_t*)(ws + WS_MIX);
    for (int row = BIDX() * 8 + wid; row < T; row += gridDim.x * 8) {
        float m[3], lsum[3];
#pragma unroll
        for (int br = 0; br < 3; ++br) { m[br] = Om[((size_t)br * T + row) * 4 + head]; lsum[br] = Ol[((size_t)br * T + row) * 4 + head]; }
        const float M = fmaxf(m[0], fmaxf(m[1], m[2]));
        f32x4 num = (f32x4){0.f, 0.f, 0.f, 0.f}; float den = 0.f;
#pragma unroll
        for (int br = 0; br < 3; ++br) {
            const float w = __builtin_amdgcn_exp2f(m[br] - M);
            const f32x4 o = *(const f32x4*)(Of + ((size_t)br * T + row) * 256 + head * 64 + d4);
            num += o * w; den += w * lsum[br];
        }
        const float inv = 1.0f / den;
        u32x2 w; w.x = cvt_pk(num[0] * inv, num[1] * inv); w.y = cvt_pk(num[2] * inv, num[3] * inv);
        *(u32x2*)(mix + (size_t)row * DM + 256 + head * 64 + d4) = w;
    }
}
DEVI void phase_xattn(const DP& p, int l, char* lds) {
    unsigned char* ws = p.ws();
    const bf16_t* qbuf = (const bf16_t*)(ws + WS_QBUF);
    const bf16_t* kv = (const bf16_t*)(ws + WS_KV);
    bf16_t* obuf = (bf16_t*)(ws + WS_OBUF);
    for (int t = BIDX(); t < NB * 4 * 16; t += gridDim.x) {
        const int qb = t & 15, h = (t >> 4) & 3, b = t >> 6;
        attn_task<256, 2>(qbuf + h * 256, DM, b * S, 1, kv + h * 256, kv + DM + h * 256, 2 * DM, b * MEMLEN, 1,
                          qb * 128, 0, 4, 0.0625f, nullptr, p.in(20) + l * 256, obuf + h * 256, DM, nullptr, nullptr, nullptr, lds);
    }
}
namespace g8 {
template <bool GATHER_> struct MoeSched {
    static constexpr bool GATHER = GATHER_;
    const int* cnt; const int* list; const char* Abase; const char* Bbase; size_t bstride; int K, G;
    int e, ubase, tbase, u;
    DEVI void init(const int* cnt_, const int* list_, const void* A_, const void* B_, size_t bstride_, int K_, int G_, int c_) {
        cnt = cnt_; list = list_; Abase = (const char*)A_; Bbase = (const char*)B_; bstride = bstride_; K = K_; G = G_; e = 0; ubase = 0; tbase = 0; u = c_; }
    DEVI bool next(UnitU& o) {
        while (e < NEXP) {
            const int ce = cnt[e], nte = (ce + BM - 1) / BM, nun = nte * 4;
            if (u < ubase + nun) {
                const int lu = u - ubase, pm = lu >> 2, pn = lu & 3;
                o.i0 = tbase + pm; o.i1 = pn; o.i2 = e * (2 * T) + pm * BM; o.i3 = ce - pm * BM; o.flags = 3;
                o.A = GATHER ? Abase : Abase + (size_t)(tbase + pm) * BM * K * 2;
                o.B = Bbase + (size_t)e * bstride + (size_t)pn * BM * K * 2;
                u += G; return true;
            }
            ubase += nun; tbase += nte; ++e;
        }
        return false;
    }
    DEVI void lane_va(const UnitU& o, int R0, int C0, int R1, int C1, unsigned& v00, unsigned& v01, unsigned& v10, unsigned& v11) const {
        if (GATHER) {
            const int nv = o.i3; const int* ent = list + o.i2;
            const int t00 = ent[R0 < nv ? R0 : 0] >> 1, t01 = ent[R1 < nv ? R1 : 0] >> 1, t10 = ent[R0 + HALF < nv ? R0 + HALF : 0] >> 1, t11 = ent[R1 + HALF < nv ? R1 + HALF : 0] >> 1;
            v00 = (unsigned)(t00 * K + C0) * 2u; v01 = (unsigned)(t01 * K + C1) * 2u; v10 = (unsigned)(t10 * K + C0) * 2u; v11 = (unsigned)(t11 * K + C1) * 2u;
        } else {
            v00 = (unsigned)(R0 * K + C0) * 2u; v01 = (unsigned)(R1 * K + C1) * 2u; v10 = v00 + (unsigned)(HALF * K * 2); v11 = v01 + (unsigned)(HALF * K * 2);
        }
    }
};
struct EpiSwiglu { static constexpr bool PERM = false; bf16_t* act; const int* list; const float* rstd;
    DEVI void mid(f32x4 (&)[2][2][4][2], const UnitU&, int, int, int, int) const {}
    DEVI void operator()(const f32x4 (&acc)[2][2][4][2], const UnitU& u, int wr, int wc, int fr, int fq) const {
        const int nv = u.i3;
#pragma unroll
        for (int ai = 0; ai < 2; ++ai)
#pragma unroll
            for (int m = 0; m < 4; ++m) {
                const int r = ai * HALF + wr * 64 + m * 16 + fr;
                if (r < nv) {
                    bf16_t* rowp = act + (size_t)(u.i0 * BM + r) * EFF + u.i1 * 128 + wc * 16 + 4 * fq;
                    const float rs = rstd[list[u.i2 + r] >> 1];
#pragma unroll
                    for (int bj = 0; bj < 2; ++bj) { const f32x4 x1 = acc[ai][bj][m][0] * rs, x3 = acc[ai][bj][m][1] * rs;
                        u32x2 w; w.x = cvt_pk(silu_f(x1[0]) * x3[0], silu_f(x1[1]) * x3[1]); w.y = cvt_pk(silu_f(x1[2]) * x3[2], silu_f(x1[3]) * x3[3]);
                        *(u32x2*)(rowp + bj * 64) = w; }
                }
            }
    } };
struct EpiMoeOut { static constexpr bool PERM = true; bf16_t* y; const int* list; const float* gate;
    DEVI void mid(f32x4 (&)[2][2][4][2], const UnitU&, int, int, int, int) const {}
    DEVI void operator()(const f32x4 (&acc)[2][2][4][2], const UnitU& u, int wr, int wc, int fr, int fq) const {
        const int nv = u.i3; const int* ent = list + u.i2;
#pragma unroll
        for (int ai = 0; ai < 2; ++ai)
#pragma unroll
            for (int m = 0; m < 4; ++m) {
                const int r = ai * HALF + wr * 64 + m * 16 + fr;
                if (r < nv) {
                    const int a = ent[r]; const float gt = gate[a];
                    bf16_t* rowp = y + (size_t)a * DM + u.i1 * BM + wc * 32 + 8 * fq;
#pragma unroll
                    for (int bj = 0; bj < 2; ++bj) { const f32x4 v0 = acc[ai][bj][m][0] * gt, v1 = acc[ai][bj][m][1] * gt;
                        u32x4 w; w.x = cvt_pk(v0[0], v0[1]); w.y = cvt_pk(v0[2], v0[3]); w.z = cvt_pk(v1[0], v1[1]); w.w = cvt_pk(v1[2], v1[3]);
                        *(u32x4*)(rowp + bj * HALF) = w; }
                }
            }
    } };
}
template <int WHICH>
DEVI void phase_moe(const DP& p, int l, char* lds) {
    unsigned char* ws = p.ws();
    const int* cnt = (const int*)(ws + WS_CNT) + l * 64;
    const int* list = (const int*)(ws + WS_LIST);
    if (WHICH == 0) {
        g8::MoeSched<true> S;
        S.init(cnt, list, ws + WS_HBUF, ws + WS_W_13, (size_t)1024 * DM * 2, DM, gridDim.x, BIDX());
        g8::EpiSwiglu E{(bf16_t*)(ws + WS_ACT), list, (const float*)(ws + WS_RSTD3)};
        g8::gemm8(lds, DM, DM, S, E);
    } else {
        g8::MoeSched<false> S;
        S.init(cnt, list, ws + WS_ACT, ws + WS_W_2, (size_t)DM * EFF * 2, EFF, gridDim.x, BIDX());
        g8::EpiMoeOut E{(bf16_t*)(ws + WS_YBUF), list, (const float*)(ws + WS_GATE)};
        g8::gemm8(lds, EFF, EFF, S, E);
    }
}
DEVI void phase_final(const DP& p) {
    const int tid = TIDX(), wid = tid >> 6, lane = tid & 63;
    const bf16_t* ybuf = (const bf16_t*)(p.ws() + WS_YBUF);
    for (int row = BIDX() * 8 + wid; row < T; row += gridDim.x * 8) {
        float x[16];
        load_row_f32(p.out() + (size_t)row * DM, x, lane);
        add_row_bf16(ybuf + (size_t)(2 * row) * DM, x, lane);
        add_row_bf16(ybuf + (size_t)(2 * row + 1) * DM, x, lane);
        store_row_f32(p.out() + (size_t)row * DM, x, lane);
    }
}


#define XB_TMO      128
#define XB_XCNT(j)  (256  + 64 * (j))
#define XB_XSUB(j)  (1280 + 64 * (j))
#define XB_XGEN(j)  (2304 + 64 * (j))
#define XB_TOP      3328
#define XB_TOPGEN   3392
#define XCD_BAR_WORDS 3456
#define XB_SPIN_CAP (1u << 22)
DEVI unsigned xb_ld(unsigned* p)              { return __hip_atomic_load(p, __ATOMIC_RELAXED, __HIP_MEMORY_SCOPE_AGENT); }
DEVI unsigned xb_add(unsigned* p, unsigned v) { return __hip_atomic_fetch_add(p, v, __ATOMIC_RELAXED, __HIP_MEMORY_SCOPE_AGENT); }
DEVI unsigned xb_xcc_id() { return (unsigned)__builtin_amdgcn_s_getreg((3 << 11) | 20) & 0xFu; }
#define XB_SPIN(cond, bar) do { unsigned _sp = 0; while (cond) { __builtin_amdgcn_s_sleep(1); \
    if ((++_sp & 255u) == 0u) { if (xb_ld(&(bar)[XB_TMO])) break; if (_sp > XB_SPIN_CAP) { atomicAdd(&(bar)[XB_TMO], 1u); break; } } } } while (0)
struct XcdBarrier { unsigned* bar; unsigned x; volatile LAS unsigned* st; };
DEVI XcdBarrier xcd_barrier_post(unsigned* bar, volatile LAS unsigned* st) {
    XcdBarrier b; b.bar = bar; b.x = xb_xcc_id(); b.st = st;
    if (threadIdx.x == 0) (void)xb_add(&bar[XB_XCNT(b.x)], 1u);
    return b;
}
DEVI void xcd_barrier_complete(unsigned* bar, unsigned x, unsigned& nloc, unsigned& nx) {
    const unsigned G = gridDim.x * gridDim.y * gridDim.z;
    unsigned sum, cnt, mine, sp = 0u;
    for (;;) {
        sum = 0u; cnt = 0u; mine = 0u;
#pragma unroll
        for (unsigned j = 0; j < 16; ++j) { const unsigned c = xb_ld(&bar[XB_XCNT(j)]); sum += c; cnt += (c > 0u) ? 1u : 0u; mine = (j == x) ? c : mine; }
        if (sum == G) break;
        __builtin_amdgcn_s_sleep(1);
        if ((++sp & 255u) == 0u) { if (xb_ld(&bar[XB_TMO])) break; if (sp > XB_SPIN_CAP) { atomicAdd(&bar[XB_TMO], 1u); break; } }
    }
    nloc = mine > 0u ? mine : 1u; nx = cnt > 0u ? cnt : 1u;
}
DEVI void xcd_barrier(const XcdBarrier& b) {
    asm volatile("s_waitcnt vmcnt(0)" ::: "memory");
    __syncthreads();
    if (threadIdx.x == 0) {
        unsigned* bar = b.bar;
        __builtin_amdgcn_s_waitcnt(0);
        unsigned nloc = b.st[0], nx = b.st[1];
        if (nloc == 0u) { xcd_barrier_complete(bar, b.x, nloc, nx); b.st[0] = nloc; b.st[1] = nx; }
        const unsigned old = xb_add(&bar[XB_XSUB(b.x)], 1u);
        const unsigned gen = old / nloc;
        if (old + 1u == (gen + 1u) * nloc) {
            __builtin_amdgcn_fence(__ATOMIC_RELEASE, "agent");
            asm volatile("s_waitcnt vmcnt(0)" ::: "memory");
            const unsigned og = xb_add(&bar[XB_TOP], 1u);
            const unsigned tg = og / nx;
            if (og + 1u == (tg + 1u) * nx) xb_add(&bar[XB_TOPGEN], 1u);
            else XB_SPIN(xb_ld(&bar[XB_TOPGEN]) == tg, bar);
            __builtin_amdgcn_fence(__ATOMIC_ACQUIRE, "agent");
            xb_add(&bar[XB_XGEN(b.x)], 1u);
            asm volatile("s_waitcnt vmcnt(0)" ::: "memory");
        } else {
            XB_SPIN(xb_ld(&bar[XB_XGEN(b.x)]) == gen, bar);
            __builtin_amdgcn_fence(__ATOMIC_ACQUIRE, "agent");
            asm volatile("s_waitcnt vmcnt(0)" ::: "memory");
        }
    }
    __syncthreads();
}

constexpr int N_PHASES = 28;
__global__ void __launch_bounds__(NTHR) hybrid_fwd(Params p_unused) {
    extern __shared__ __attribute__((aligned(16))) char lds_base[];
    karg_ptr kp = (karg_ptr)__builtin_amdgcn_kernarg_segment_ptr();
    int ph_lo, ph_hi, use_gs;
    { DP q{kp}; ph_lo = q.ph_lo(); ph_hi = q.ph_hi(); use_gs = q.use_gs(); }
    volatile LAS unsigned* xst = (volatile LAS unsigned*)(LAS char*)(lds_base + LDS_BYTES - 16);
    if (threadIdx.x == 0) { xst[0] = 0u; xst[1] = 0u; }
    __syncthreads();
    XcdBarrier xb; xb.bar = nullptr; xb.x = 0; xb.st = xst;
    if (use_gs == 1) { DP q{kp}; xb = xcd_barrier_post((unsigned*)(q.ws() + WS_BAR), xst); }
#define RUN_PHASE(PH, ...) \
    if (ph_lo <= (PH) && (PH) < ph_hi) { \
        if ((PH) > ph_lo) { if (use_gs == 1) xcd_barrier(xb); else if (use_gs == 2) cg::this_grid().sync(); } \
        asm volatile("" : "+s"(kp) :: "memory"); \
        const DP p{kp}; \
        unsigned lds_off = 0; asm volatile("" : "+s"(lds_off)); \
        char* lds = lds_base + lds_off; \
        unsigned char* ws = p.ws(); (void)ws; (void)lds; \
        __VA_ARGS__ \
    }
#define LAYER_PHASES(L, B0) \
    RUN_PHASE((B0) + 0, { if ((L) == 1) { for (int u = BIDX(); u < PREP_UNITS; u += gridDim.x) prep_unit(p, 1, u, (float*)lds); } __syncthreads(); phase_norm1(p, (L), lds); }) \
    RUN_PHASE((B0) + 1, { phase_inproj(p, (L), lds); }) \
    RUN_PHASE((B0) + 2, { phase_post(p, (L)); }) \
    RUN_PHASE((B0) + 3, { phase_mix1(p, (L), lds); }) \
    RUN_PHASE((B0) + 4, { phase_ssd_scan(p); phase_knorm(p, (L)); }) \
    RUN_PHASE((B0) + 5, { phase_mix3(p, (L), lds); }) \
    RUN_PHASE((B0) + 6, { const float* x_in = (L) == 0 ? p.in(0) : p.out(); float* x1 = (L) == 0 ? p.out() : (float*)(ws + WS_XB); \
                          g8::DenseSched2 S; S.init((const bf16_t*)(ws + WS_MIX), (const bf16_t*)(ws + WS_W_OUT), T, DM, DM, gridDim.x, BIDX()); \
                          g8::EpiResScale E{{x_in, x1, DM, (bf16_t*)(ws + WS_HBUF)}, (const float*)(ws + WS_SSQ)}; g8::gemm8(lds, DM, DM / 2, S, E); }) \
    RUN_PHASE((B0) + 7, { g8::DenseSched S; S.init((const bf16_t*)(ws + WS_HBUF), (const bf16_t*)(ws + WS_W_Q), T, DM, DM, gridDim.x, BIDX()); \
                          g8::EpiBf16 E{(bf16_t*)(ws + WS_QBUF), DM}; g8::gemm8(lds, DM, DM, S, E); }) \
    RUN_PHASE((B0) + 8, { phase_xattn(p, (L), lds); }) \
    RUN_PHASE((B0) + 9, { const float* x1 = (L) == 0 ? p.out() : (const float*)(ws + WS_XB); float* x2 = (L) == 0 ? (float*)(ws + WS_XB) : p.out(); \
                          g8::DenseSched S; S.init((const bf16_t*)(ws + WS_OBUF), (const bf16_t*)(ws + WS_W_O), T, DM, DM, gridDim.x, BIDX()); \
                          g8::EpiRes E{x1, x2, DM, (bf16_t*)(ws + WS_HBUF)}; g8::gemm8(lds, DM, DM, S, E); }) \
    RUN_PHASE((B0) + 10, { const float* x2 = (L) == 0 ? (const float*)(ws + WS_XB) : p.out(); phase_norm3(p, (L), x2, lds); }) \
    RUN_PHASE((B0) + 11, { phase_moe<0>(p, (L), lds); }) \
    RUN_PHASE((B0) + 12, { phase_moe<1>(p, (L), lds); })

    RUN_PHASE(0, { prep_small(p); for (int u = BIDX(); u < PREP_UNITS; u += gridDim.x) prep_unit(p, 0, u, (float*)lds); })
    LAYER_PHASES(0, 1)
    LAYER_PHASES(1, 14)
    RUN_PHASE(27, { phase_final(p); })
#undef LAYER_PHASES
#undef RUN_PHASE
}

extern "C" void kernel_launch(void* const* d_in, const int* in_sizes, int n_in, void* d_out, int out_size, void* d_ws, size_t ws_size, hipStream_t stream) {
    static int grid = 0;
    if (grid == 0) {
        if (n_in != 31 || out_size != T * DM || ws_size < WS_END) { fprintf(stderr, "kernel_launch: unexpected shapes (n_in %d out %d ws %zu need %zu)\n", n_in, out_size, ws_size, (size_t)WS_END); grid = -1; return; }
        int dev = 0, cus = 0, per_cu = 0;
        hipGetDevice(&dev);
        hipDeviceGetAttribute(&cus, hipDeviceAttributeMultiprocessorCount, dev);
        hipFuncSetAttribute((const void*)hybrid_fwd, hipFuncAttributeMaxDynamicSharedMemorySize, LDS_BYTES);
        hipOccupancyMaxActiveBlocksPerMultiprocessor(&per_cu, (const void*)hybrid_fwd, NTHR, LDS_BYTES);
        if (per_cu < 1) { fprintf(stderr, "kernel_launch: occupancy query says %d blocks per CU\n", per_cu); per_cu = 1; }
        (void)hipGetLastError();
        grid = cus;
    }
    if (grid < 0) return;
    Params p{};
    for (int i = 0; i < 31; ++i) p.in[i] = (const float*)d_in[i];
    p.out = (float*)d_out; p.ws = (unsigned char*)d_ws;
    p.use_grid_sync = 1; p.pad = 0;
    p.ph_lo = 0; p.ph_hi = N_PHASES;
    if (hipMemsetAsync((unsigned char*)d_ws + WS_BAR, 0, XCD_BAR_WORDS * 4, stream) != hipSuccess) { fprintf(stderr, "kernel_launch: memset failed\n"); return; }
    void* args[] = {&p};
    hipError_t e = hipLaunchCooperativeKernel((const void*)hybrid_fwd, dim3(grid), dim3(NTHR), args, LDS_BYTES, stream);
    if (e != hipSuccess) fprintf(stderr, "kernel_launch: cooperative launch failed: %s (grid %d)\n", hipGetErrorString(e), grid);
}
```

```cpp
#include <hip/hip_runtime.h>
#include <hip/hip_cooperative_groups.h>
#include <cstdio>
#include <cstdint>
namespace cg = cooperative_groups;

typedef unsigned short bf16_t;
typedef short bf16x8 __attribute__((ext_vector_type(8)));
typedef short s16x4 __attribute__((ext_vector_type(4)));
typedef float f32x4 __attribute__((ext_vector_type(4)));
typedef unsigned u32x4 __attribute__((ext_vector_type(4)));
typedef unsigned u32x2 __attribute__((ext_vector_type(2)));
#define DEVI __device__ __forceinline__
#define LAS __attribute__((address_space(3)))

constexpr int NB = 8, S = 2048, DM = 1024, T = NB * S, DEPTH = 2;
constexpr int INP = 3084, NPROJ = 3072;
constexpr int C_FQ = 0, C_FK = 256, C_FV = 512, C_DQ = 768, C_DK = 1024, C_DV = 1280, C_Z = 1536, C_XBC = 2048;
constexpr int MEMLEN = 256, MROWS = NB * MEMLEN;
constexpr int NEXP = 32, EFF = 512;
constexpr float EPS = 1e-6f;
constexpr int NTHR = 512;
constexpr int LDS_BYTES = 151552;

constexpr size_t al256(size_t x) { return (x + 255) & ~(size_t)255; }
constexpr size_t WS_W_IN = 0;
constexpr size_t WS_W_OUT = WS_W_IN + (size_t)NPROJ * DM * 2;
constexpr size_t WS_W_Q = WS_W_OUT + (size_t)DM * DM * 2;
constexpr size_t WS_W_KV = WS_W_Q + (size_t)DM * DM * 2;
constexpr size_t WS_W_O = WS_W_KV + (size_t)2 * DM * DM * 2;
constexpr size_t WS_W_13 = WS_W_O + (size_t)DM * DM * 2;
constexpr size_t WS_W_2 = WS_W_13 + (size_t)NEXP * 1024 * DM * 2;
constexpr size_t WS_WSMALL = WS_W_2 + (size_t)NEXP * DM * EFF * 2;
constexpr size_t WS_WROUT = WS_WSMALL + (size_t)DEPTH * 12 * DM * 4;
constexpr size_t WS_XB = WS_WROUT + (size_t)DEPTH * 36 * DM * 4;
constexpr size_t WS_HBUF = WS_XB + (size_t)T * DM * 4;
constexpr size_t WS_PROJ = WS_HBUF + (size_t)T * DM * 2;
constexpr size_t WS_QBUF = WS_PROJ;
constexpr size_t WS_OBUF = WS_PROJ + (size_t)T * DM * 2;
constexpr size_t WS_ACT = WS_PROJ;
constexpr size_t WS_MIX = WS_PROJ + (size_t)T * NPROJ * 2;
constexpr size_t WS_U = WS_MIX + (size_t)T * DM * 2;
constexpr size_t WS_YBUF = WS_U;
constexpr size_t WS_DILO = WS_U;
constexpr size_t WS_DILM = WS_DILO + (size_t)3 * T * 256 * 4;
constexpr size_t WS_DILL = WS_DILM + (size_t)3 * T * 4 * 4;
constexpr size_t WS_SSTATE = WS_DILL + (size_t)3 * T * 4 * 4;
constexpr size_t WS_HIN = WS_SSTATE + (size_t)NB * 16 * 8 * 8192 * 4;
constexpr size_t WS_GBUF = WS_HIN + (size_t)NB * 16 * 8 * 8192 * 2;
constexpr size_t WS_U_END = WS_GBUF + (size_t)T * 512 * 4;
constexpr size_t WS_MEMN = WS_U_END;
constexpr size_t WS_KV = WS_MEMN + (size_t)MROWS * DM * 2;
constexpr size_t WS_LOGF = WS_KV + (size_t)MROWS * 2 * DM * 2;
constexpr size_t WS_CUMF = WS_LOGF + (size_t)T * 4 * 4;
constexpr size_t WS_DTV = WS_CUMF + (size_t)T * 4 * 4;
constexpr size_t WS_DECAY = WS_DTV + (size_t)T * 8 * 4;
constexpr size_t WS_CNT = WS_DECAY + (size_t)NB * 16 * 8 * 4;
constexpr size_t WS_LIST = WS_CNT + 1024;
constexpr size_t WS_GATE = WS_LIST + (size_t)NEXP * 2 * T * 4;
constexpr size_t WS_BAR = WS_GATE + (size_t)2 * T * 4;
constexpr size_t WS_XC = WS_BAR + 65536;
constexpr size_t WS_SSQ = WS_XC + (size_t)T * 1024 * 2;
constexpr size_t WS_RSTD1 = WS_SSQ + (size_t)T * 2 * 4;
constexpr size_t WS_RSTD3 = WS_RSTD1 + (size_t)T * 4;
constexpr size_t WS_END = WS_RSTD3 + (size_t)T * 4;
static_assert(WS_YBUF + (size_t)2 * T * DM * 2 <= WS_U_END, "ybuf alias");
static_assert(WS_OBUF + (size_t)T * DM * 2 <= WS_MIX, "obuf alias");

struct Params {
    const float* in[31];
    float* out;
    unsigned char* ws;
    int ph_lo, ph_hi;
    int use_grid_sync, pad;
};


typedef __attribute__((address_space(4))) const unsigned long long* karg_ptr;
typedef __attribute__((address_space(1))) const float* gcf_ptr;
typedef __attribute__((address_space(1))) float* gf_ptr;
typedef __attribute__((address_space(1))) unsigned char* gb_ptr;
struct DP {
    karg_ptr kp;
    DEVI const float* in(int i) const { return (const float*)(gcf_ptr)(kp[i]); }
    DEVI float* out() const { return (float*)(gf_ptr)(kp[31]); }
    DEVI unsigned char* ws() const { return (unsigned char*)(gb_ptr)(kp[32]); }
    DEVI int ph_lo() const { return (int)(unsigned)kp[33]; }
    DEVI int ph_hi() const { return (int)(unsigned)(kp[33] >> 32); }
    DEVI int use_gs() const { return (int)(unsigned)kp[34]; }
};

DEVI int TIDX() { int t = threadIdx.x; asm volatile("" : "+v"(t)); return t; }
DEVI int BIDX() { int b = blockIdx.x; asm volatile("" : "+s"(b)); return b; }
DEVI float bf2f(bf16_t v) { return __uint_as_float(((unsigned)v) << 16); }
typedef float f32x2 __attribute__((ext_vector_type(2)));
typedef __bf16 bf16x2_t __attribute__((ext_vector_type(2)));
DEVI unsigned cvt_pk(float lo, float hi) { f32x2 v = {lo, hi}; bf16x2_t b = __builtin_convertvector(v, bf16x2_t); return __builtin_bit_cast(unsigned, b); }
DEVI bf16_t f2bf(float f) { return (bf16_t)(cvt_pk(f, 0.f) & 0xffffu); }
DEVI float bflo(unsigned w) { return __uint_as_float(w << 16); }
DEVI float bfhi(unsigned w) { return __uint_as_float(w & 0xffff0000u); }
DEVI float wave_sum(float v) {
#pragma unroll
    for (int m = 32; m >= 1; m >>= 1) v += __shfl_xor(v, m);
    return v;
}
template <int CTRL> DEVI float dpp_mov(float v) { return __uint_as_float(__builtin_amdgcn_update_dpp(0u, __float_as_uint(v), CTRL, 0xf, 0xf, false)); }
DEVI float wave_sum_fast(float v) {
    v += dpp_mov<0xB1>(v);
    v += dpp_mov<0x4E>(v);
    v += dpp_mov<0x124>(v);
    v += dpp_mov<0x128>(v);
    const int iv = __float_as_int(v);
    return (__int_as_float(__builtin_amdgcn_readlane(iv, 0)) + __int_as_float(__builtin_amdgcn_readlane(iv, 16))) + (__int_as_float(__builtin_amdgcn_readlane(iv, 32)) + __int_as_float(__builtin_amdgcn_readlane(iv, 48)));
}
DEVI float silu_f(float x) { return x / (1.f + __expf(-x)); }
DEVI float softplus_f(float x) { return x > 20.f ? x : log1pf(__expf(x)); }
DEVI float logsigmoid_f(float x) { return x >= 0.f ? -log1pf(__expf(-x)) : x - log1pf(__expf(x)); }
#define MFMA16(a, b, c) __builtin_amdgcn_mfma_f32_16x16x32_bf16(a, b, c, 0, 0, 0)
DEVI s16x4 tr_read(const bf16_t* p) {
    return __builtin_bit_cast(s16x4, __builtin_amdgcn_ds_read_tr16_b64_v4i16((LAS s16x4*)p));
}

DEVI int maprow(int mode, int n) { return mode == 0 ? n : ((n >> 4) * 32 + (n & 15) + (mode == 2 ? 16 : 0)); }
DEVI void prep_tile(const float* __restrict__ src, int ld, int k0, int c0, bf16_t* __restrict__ dst, int dstld, int mode, int n0,
                    const float* __restrict__ kscale, int ks_from, float* tl) {
    const int tid = TIDX();
#pragma unroll
    for (int i = 0; i < 2; ++i) {
        const int k = (tid >> 4) + 32 * i, n4 = (tid & 15) * 4;
        const float4 v = *(const float4*)(src + (size_t)(k0 + k) * ld + c0 + n4);
        float sc = 1.f;
        if (kscale != nullptr && (k0 + k) >= ks_from) sc = kscale[k0 + k - ks_from];
        tl[k * 65 + n4 + 0] = v.x * sc; tl[k * 65 + n4 + 1] = v.y * sc; tl[k * 65 + n4 + 2] = v.z * sc; tl[k * 65 + n4 + 3] = v.w * sc;
    }
    __syncthreads();
    {
        const int n = tid >> 3, kc = (tid & 7) * 8;
        u32x4 w;
        w.x = cvt_pk(tl[(kc + 0) * 65 + n], tl[(kc + 1) * 65 + n]);
        w.y = cvt_pk(tl[(kc + 2) * 65 + n], tl[(kc + 3) * 65 + n]);
        w.z = cvt_pk(tl[(kc + 4) * 65 + n], tl[(kc + 5) * 65 + n]);
        w.w = cvt_pk(tl[(kc + 6) * 65 + n], tl[(kc + 7) * 65 + n]);
        const int drow = maprow(mode, n0 + n);
        *(u32x4*)(dst + (size_t)drow * dstld + k0 + kc) = w;
    }
    __syncthreads();
}

constexpr int PREP_UNITS = 2048 + 3 * 4096;
DEVI void prep_unit(const DP& p, int l, int u, float* tl) {
    unsigned char* ws = p.ws();
    if (u < 768) {
        const int kt = u / 48, nt = u % 48, n0 = nt * 64, c0 = n0 < 768 ? n0 : n0 + 4;
        prep_tile(p.in(3) + (size_t)l * DM * INP, INP, kt * 64, c0, (bf16_t*)(ws + WS_W_IN), DM, 0, n0, p.in(2) + l * DM, 0, tl);
    } else if (u < 1024) {
        const int v = u - 768, kt = v / 16, nt = v % 16;
        prep_tile(p.in(15) + (size_t)l * DM * DM, DM, kt * 64, nt * 64, (bf16_t*)(ws + WS_W_OUT), DM, 0, nt * 64, p.in(14) + l * 512, 512, tl);
    } else if (u < 1280) {
        const int v = u - 1024, kt = v / 16, nt = v % 16;
        prep_tile(p.in(18) + (size_t)l * DM * DM, DM, kt * 64, nt * 64, (bf16_t*)(ws + WS_W_Q), DM, 0, nt * 64, p.in(16) + l * DM, 0, tl);
    } else if (u < 1792) {
        const int v = u - 1280, kt = v / 32, nt = v % 32;
        prep_tile(p.in(19) + (size_t)l * DM * 2 * DM, 2 * DM, kt * 64, nt * 64, (bf16_t*)(ws + WS_W_KV), DM, 0, nt * 64, nullptr, 0, tl);
    } else if (u < 2048) {
        const int v = u - 1792, kt = v / 16, nt = v % 16;
        prep_tile(p.in(22) + (size_t)l * DM * DM, DM, kt * 64, nt * 64, (bf16_t*)(ws + WS_W_O), DM, 0, nt * 64, nullptr, 0, tl);
    } else if (u < 2048 + 8192) {
        const int v = u - 2048, which = v / 4096, w = v % 4096, e = w / 128, tI = w % 128, kt = tI / 8, nt = tI % 8;
        const float* src = (which == 0 ? p.in(28) : p.in(29)) + ((size_t)l * NEXP + e) * DM * EFF;
        prep_tile(src, EFF, kt * 64, nt * 64, (bf16_t*)(ws + WS_W_13) + (size_t)e * 1024 * DM, DM, which == 0 ? 1 : 2, nt * 64, p.in(23) + l * DM, 0, tl);
    } else {
        const int w = u - 2048 - 8192, e = w / 128, tI = w % 128, kt = tI / 16, nt = tI % 16;
        const float* src = p.in(30) + ((size_t)l * NEXP + e) * EFF * DM;
        prep_tile(src, DM, kt * 64, nt * 64, (bf16_t*)(ws + WS_W_2) + (size_t)e * DM * EFF, EFF, 0, nt * 64, nullptr, 0, tl);
    }
}
DEVI void prep_small(const DP& p) {
    float* wsm = (float*)(p.ws() + WS_WSMALL);
    float* wro = (float*)(p.ws() + WS_WROUT);
    const int gtid = BIDX() * NTHR + TIDX(), gn = gridDim.x * NTHR;
    for (int i = gtid; i < DEPTH * 12 * DM; i += gn) {
        const int l = i / (12 * DM), r = i % (12 * DM), c = r / DM, k = r % DM;
        const int col = c < 4 ? 768 + c : 3076 + (c - 4);
        wsm[i] = p.in(3)[((size_t)l * DM + k) * INP + col] * p.in(2)[l * DM + k];
    }
    for (int i = gtid; i < DEPTH * 36 * DM; i += gn) {
        const int l = i / (36 * DM), r = i % (36 * DM), c = r / DM, k = r % DM;
        wro[i] = (c < 4 ? p.in(24)[((size_t)l * DM + k) * 4 + c] : p.in(26)[((size_t)l * DM + k) * 32 + (c - 4)]) * p.in(23)[l * DM + k];
    }
    if (BIDX() == 0 && TIDX() < 128) ((int*)(p.ws() + WS_CNT))[TIDX()] = 0;
}

DEVI void store_h_bf16(bf16_t* hrow, const float (&h)[16], int lane) {
#pragma unroll
    for (int j = 0; j < 4; ++j) {
        u32x2 w; w.x = cvt_pk(h[4 * j], h[4 * j + 1]); w.y = cvt_pk(h[4 * j + 2], h[4 * j + 3]);
        *(u32x2*)(hrow + j * 256 + lane * 4) = w;
    }
}
DEVI void load_row_f32(const float* xr, float (&x)[16], int lane) {
#pragma unroll
    for (int j = 0; j < 4; ++j) { const float4 v = *(const float4*)(xr + j * 256 + lane * 4); x[4 * j] = v.x; x[4 * j + 1] = v.y; x[4 * j + 2] = v.z; x[4 * j + 3] = v.w; }
}
DEVI void add_row_bf16(const bf16_t* yr, float (&x)[16], int lane) {
#pragma unroll
    for (int j = 0; j < 4; ++j) { const u32x2 w = *(const u32x2*)(yr + j * 256 + lane * 4); x[4 * j] += bflo(w.x); x[4 * j + 1] += bfhi(w.x); x[4 * j + 2] += bflo(w.y); x[4 * j + 3] += bfhi(w.y); }
}
DEVI void store_row_f32(float* xr, const float (&x)[16], int lane) {
#pragma unroll
    for (int j = 0; j < 4; ++j) *(float4*)(xr + j * 256 + lane * 4) = make_float4(x[4 * j], x[4 * j + 1], x[4 * j + 2], x[4 * j + 3]);
}
DEVI void norm_row(const float (&x)[16], const float* g, float (&h)[16], int lane) {
    float ss = 0.f;
#pragma unroll
    for (int i = 0; i < 16; ++i) ss += x[i] * x[i];
    ss = wave_sum(ss);
    const float rstd = rsqrtf(ss * (1.0f / DM) + EPS);
#pragma unroll
    for (int j = 0; j < 4; ++j) { const float4 gv = *(const float4*)(g + j * 256 + lane * 4);
        h[4 * j] = x[4 * j] * rstd * gv.x; h[4 * j + 1] = x[4 * j + 1] * rstd * gv.y; h[4 * j + 2] = x[4 * j + 2] * rstd * gv.z; h[4 * j + 3] = x[4 * j + 3] * rstd * gv.w; }
}
DEVI float dot_lds(const float (&h)[16], const float* wrow, int lane) {
    float a = 0.f;
#pragma unroll
    for (int j = 0; j < 4; ++j) { const float4 w = *(const float4*)(wrow + j * 256 + lane * 4); a += h[4 * j] * w.x + h[4 * j + 1] * w.y + h[4 * j + 2] * w.z + h[4 * j + 3] * w.w; }
    return a;
}

#define MFMA_F32(a, b, c) __builtin_amdgcn_mfma_f32_16x16x4f32(a, b, c, 0, 0, 0)
DEVI void load_row_pre(const float* xin, const bf16_t* ybuf, int l, int row, int lane, float (&x)[16]) {
    load_row_f32(xin + (size_t)row * DM, x, lane);
    if (l > 0) { add_row_bf16(ybuf + (size_t)(2 * row) * DM, x, lane); add_row_bf16(ybuf + (size_t)(2 * row + 1) * DM, x, lane); }
}
DEVI void phase_norm1(const DP& p, int l, char* lds) {
    const int tid = TIDX(), wid = tid >> 6, lane = tid & 63;
    unsigned char* ws = p.ws();
    float* wsl = (float*)lds;
    { const float4* src = (const float4*)((const float*)(ws + WS_WSMALL) + (size_t)l * 12 * DM);
      for (int i = tid; i < 12 * DM / 4; i += NTHR) ((float4*)wsl)[i] = src[i]; }
    __syncthreads();
    const float* xin = l == 0 ? p.in(0) : (const float*)(ws + WS_XB);
    float* xout = p.out();
    const bf16_t* ybuf = (const bf16_t*)(ws + WS_YBUF);
    bf16_t* hbuf = (bf16_t*)(ws + WS_HBUF);
    float* logf = (float*)(ws + WS_LOGF);
    float* dtv = (float*)(ws + WS_DTV);
    float* rstd1 = (float*)(ws + WS_RSTD1);
    const int stride = gridDim.x * 8;
    int row = BIDX() * 8 + wid;
    float xn[16];
    if (row < T) load_row_pre(xin, ybuf, l, row, lane, xn);
    for (; row < T; row += stride) {
        float x[16];
#pragma unroll
        for (int i = 0; i < 16; ++i) x[i] = xn[i];
        if (row + stride < T) load_row_pre(xin, ybuf, l, row + stride, lane, xn);
        if (l > 0) store_row_f32(xout + (size_t)row * DM, x, lane);
        store_h_bf16(hbuf + (size_t)row * DM, x, lane);
        float ss = 0.f;
#pragma unroll
        for (int i = 0; i < 16; ++i) ss += x[i] * x[i];
        const float rstd = rsqrtf(wave_sum_fast(ss) * (1.0f / DM) + EPS);
        float keep = 0.f;
#pragma unroll
        for (int c = 0; c < 12; ++c) { const float v = wave_sum_fast(dot_lds(x, wsl + c * DM, lane)); keep = (lane == c) ? v : keep; if (c & 1) __builtin_amdgcn_sched_barrier(0); }
        keep *= rstd;
        if (lane == 0) rstd1[row] = rstd;
        if (lane < 4) logf[(size_t)row * 4 + lane] = logsigmoid_f(keep + p.in(4)[l * 4 + lane]);
        else if (lane < 12) dtv[(size_t)row * 8 + lane - 4] = softplus_f(keep + p.in(11)[l * 8 + lane - 4]);
    }
    const float* gm = p.in(17) + l * DM;
    bf16_t* memn = (bf16_t*)(ws + WS_MEMN);
    for (int row = BIDX() * 8 + wid; row < MROWS; row += gridDim.x * 8) {
        float x[16], h[16];
        load_row_f32(p.in(1) + (size_t)row * DM, x, lane);
        norm_row(x, gm, h, lane);
        store_h_bf16(memn + (size_t)row * DM, h, lane);
    }
}
DEVI void phase_norm3(const DP& p, int l, const float* xin, char* lds) {
    const int tid = TIDX(), wid = tid >> 6, lane = tid & 63;
    unsigned char* ws = p.ws();
    float* wr = (float*)lds;
    int* lcnt = (int*)(lds + 36 * DM * 4);
    int* lbase = lcnt + 32;
    int* rinfo = lbase + 32;
    { const float4* src = (const float4*)((const float*)(ws + WS_WROUT) + (size_t)l * 36 * DM);
      for (int i = tid; i < 36 * DM / 4; i += NTHR) ((float4*)wr)[i] = src[i]; }
    if (tid < 32) lcnt[tid] = 0;
    __syncthreads();
    int* cnt = (int*)(ws + WS_CNT) + l * 64;
    int* list = (int*)(ws + WS_LIST);
    float* gate = (float*)(ws + WS_GATE);
    float* rstd3 = (float*)(ws + WS_RSTD3);
    const float* bg = p.in(25) + l * 4;
    const int be_i = __float_as_int(lane < 32 ? p.in(27)[l * 32 + lane] : 0.f);
    const int stride = gridDim.x * 8;
    int row = BIDX() * 8 + wid;
    float xn[16];
    if (row < T) load_row_f32(xin + (size_t)row * DM, xn, lane);
    for (int it = 0; row < T; row += stride, ++it) {
        float x[16];
#pragma unroll
        for (int i = 0; i < 16; ++i) x[i] = xn[i];
        if (row + stride < T) load_row_f32(xin + (size_t)(row + stride) * DM, xn, lane);
        float ss = 0.f;
#pragma unroll
        for (int i = 0; i < 16; ++i) ss += x[i] * x[i];
        const float rstd = rsqrtf(wave_sum_fast(ss) * (1.0f / DM) + EPS);
        float gl[4];
#pragma unroll
        for (int c = 0; c < 4; ++c) gl[c] = wave_sum_fast(dot_lds(x, wr + c * DM, lane)) * rstd + bg[c];
        int gsel = 0; float gmax = gl[0];
#pragma unroll
        for (int c = 1; c < 4; ++c) if (gl[c] > gmax) { gmax = gl[c]; gsel = c; }
        float gden = 0.f;
#pragma unroll
        for (int c = 0; c < 4; ++c) gden += __expf(gl[c] - gmax);
        const float ggate = 1.0f / gden;
        gsel = __builtin_amdgcn_readfirstlane(gsel);
        float v1 = -3.0e38f, v2 = -3.0e38f; int i1 = 0, i2 = 1;
#pragma unroll
        for (int c = 0; c < 8; ++c) {
            const float v = wave_sum_fast(dot_lds(x, wr + (4 + gsel * 8 + c) * DM, lane)) * rstd + __int_as_float(__builtin_amdgcn_readlane(be_i, gsel * 8 + c));
            if (v > v1) { v2 = v1; i2 = i1; v1 = v; i1 = c; } else if (v > v2) { v2 = v; i2 = c; }
            if (c & 1) __builtin_amdgcn_sched_barrier(0);
        }
        const float e2 = __expf(v2 - v1), inv = 1.0f / (1.0f + e2);
        if (lane == 0) {
            rstd3[row] = rstd;
            const int ea = gsel * 8 + i1, eb = gsel * 8 + i2;
            const int sa = atomicAdd(&lcnt[ea], 1), sb = atomicAdd(&lcnt[eb], 1);
            int* ri = rinfo + (it * 8 + wid) * 4;
            ri[0] = ea; ri[1] = sa; ri[2] = eb; ri[3] = sb;
            gate[2 * row] = inv * ggate; gate[2 * row + 1] = e2 * inv * ggate;
        }
    }
    __syncthreads();
    if (tid < 32) lbase[tid] = atomicAdd(&cnt[tid], lcnt[tid]);
    __syncthreads();
    {
        const int nit = (T - (BIDX() * 8) + stride - 1) / stride;
        if (tid < nit * 8) {
            const int it = tid >> 3, w = tid & 7, r = BIDX() * 8 + w + it * stride;
            if (r < T) {
                const int* ri = rinfo + tid * 4;
                list[(size_t)ri[0] * (2 * T) + lbase[ri[0]] + ri[1]] = 2 * r;
                list[(size_t)ri[2] * (2 * T) + lbase[ri[2]] + ri[3]] = 2 * r + 1;
            }
        }
    }
    __syncthreads();
}

constexpr int G_BM = 256, G_BN = 128, G_BK = 64, G_ST = 72;
constexpr int G_ABUF = G_BM * G_ST, G_BBUF = G_BN * G_ST;
template <class AMap, class Epi>
DEVI void gemm_tile(const AMap& amap, const bf16_t* __restrict__ Bt, int K, const Epi& epi, char* lds) {
    const int tid = TIDX(), wid = tid >> 6, lane = tid & 63, r16 = lane & 15, g4 = lane >> 4;
    const int wr = wid >> 1, wc = wid & 1;
    bf16_t* As = (bf16_t*)lds;
    bf16_t* Bs = As + 2 * G_ABUF;
    const int srow = tid >> 3, skc = (tid & 7) * 8;
    const bf16_t* ap[4];
#pragma unroll
    for (int i = 0; i < 4; ++i) ap[i] = amap(srow + 64 * i) + skc;
    const bf16_t* bp[2];
#pragma unroll
    for (int i = 0; i < 2; ++i) bp[i] = Bt + (size_t)(srow + 64 * i) * K + skc;
    u32x4 ra[4], rb[2];
#pragma unroll
    for (int i = 0; i < 4; ++i) ra[i] = *(const u32x4*)(ap[i]);
#pragma unroll
    for (int i = 0; i < 2; ++i) rb[i] = *(const u32x4*)(bp[i]);
    f32x4 acc[4][4];
#pragma unroll
    for (int m = 0; m < 4; ++m)
#pragma unroll
        for (int n = 0; n < 4; ++n) acc[m][n] = (f32x4){0.f, 0.f, 0.f, 0.f};
    const int nt = K / G_BK;
    for (int t = 0; t < nt; ++t) {
        bf16_t* Ab = As + (t & 1) * G_ABUF;
        bf16_t* Bb = Bs + (t & 1) * G_BBUF;
#pragma unroll
        for (int i = 0; i < 4; ++i) *(u32x4*)(Ab + (srow + 64 * i) * G_ST + skc) = ra[i];
#pragma unroll
        for (int i = 0; i < 2; ++i) *(u32x4*)(Bb + (srow + 64 * i) * G_ST + skc) = rb[i];
        __syncthreads();
        if (t + 1 < nt) {
#pragma unroll
            for (int i = 0; i < 4; ++i) ra[i] = *(const u32x4*)(ap[i] + (size_t)(t + 1) * G_BK);
#pragma unroll
            for (int i = 0; i < 2; ++i) rb[i] = *(const u32x4*)(bp[i] + (size_t)(t + 1) * G_BK);
        }
#pragma unroll
        for (int kk = 0; kk < 2; ++kk) {
            bf16x8 af[4], bfr[4];
#pragma unroll
            for (int m = 0; m < 4; ++m) af[m] = *(const bf16x8*)(Ab + (wr * 64 + m * 16 + r16) * G_ST + kk * 32 + g4 * 8);
#pragma unroll
            for (int n = 0; n < 4; ++n) bfr[n] = *(const bf16x8*)(Bb + (wc * 64 + n * 16 + r16) * G_ST + kk * 32 + g4 * 8);
#pragma unroll
            for (int m = 0; m < 4; ++m)
#pragma unroll
                for (int n = 0; n < 4; ++n) acc[m][n] = MFMA16(bfr[n], af[m], acc[m][n]);
        }
    }
    epi(acc, wr * 64 + r16, wc * 64 + g4 * 4);
    __syncthreads();
}

struct AMapDense { const bf16_t* A; int K; DEVI const bf16_t* operator()(int r) const { return A + (size_t)r * K; } };
struct EpiBf16Out { bf16_t* O; int ldo;
    DEVI void operator()(const f32x4 (&acc)[4][4], int rb, int cb) const {
#pragma unroll
        for (int m = 0; m < 4; ++m)
#pragma unroll
            for (int n = 0; n < 4; ++n) { u32x2 w; w.x = cvt_pk(acc[m][n][0], acc[m][n][1]); w.y = cvt_pk(acc[m][n][2], acc[m][n][3]);
                *(u32x2*)(O + (size_t)(rb + m * 16) * ldo + cb + n * 16) = w; }
    } };
struct EpiResF32 { const float* R; float* O; int ld;
    DEVI void operator()(const f32x4 (&acc)[4][4], int rb, int cb) const {
#pragma unroll
        for (int m = 0; m < 4; ++m)
#pragma unroll
            for (int n = 0; n < 4; ++n) { const size_t off = (size_t)(rb + m * 16) * ld + cb + n * 16;
                const f32x4 r = *(const f32x4*)(R + off); *(f32x4*)(O + off) = r + acc[m][n]; }
    } };

template <class MakeEpi>
DEVI void gemm_dense_units(const bf16_t* A, const bf16_t* Bt, int M, int N, int K, const MakeEpi& mk, char* lds, int u0, int ustride) {
    const int nN = N / G_BN, nU = (M / G_BM) * nN;
    for (int u = u0; u < nU; u += ustride) {
        const int pm = u / nN, pn = u % nN;
        AMapDense am{A + (size_t)pm * G_BM * K, K};
        gemm_tile(am, Bt + (size_t)pn * G_BN * K, K, mk(pm * G_BM, pn * G_BN), lds);
    }
}


DEVI const char* uni_ptr(const char* p) {
    const unsigned long long v = (unsigned long long)p;
    const unsigned lo = __builtin_amdgcn_readfirstlane((unsigned)v), hi = __builtin_amdgcn_readfirstlane((unsigned)(v >> 32));
    return (const char*)(gb_ptr)(((unsigned long long)hi << 32) | lo);
}
namespace g8 {
constexpr int BM = 256, BK = 64, HALF = 128, HTB = HALF * BK * 2, STAGE_BYTES = 8 * HTB;
DEVI int lds_byte(int r, int c) { const int st = (r >> 4) * 2 + (c >> 5), rr = r & 15, cc = c & 31, ob = rr * 64 + cc * 2; return st * 1024 + (ob ^ (((ob >> 9) & 1) << 5)); }
DEVI void stage_rc(int b, int& R, int& C) { const int st = b / 1024, sb = b % 1024, swz = sb ^ (((sb >> 9) & 1) << 5); R = (st >> 1) * 16 + swz / 64; C = (st & 1) * 32 + (swz % 64) / 2; }
DEVI int perm32(int rho) { const int n = rho >> 4, i = rho & 15; return 8 * (i >> 2) + 4 * n + (i & 3); }
struct UnitU { const char* A; const char* B; int i0, i1, i2, i3; int flags; };

template <class Epi, class Sched>
DEVI void gemm8(char* lds_generic, int K, int klen, Sched& S, const Epi& E) {
    LAS unsigned char* lds = (LAS unsigned char*)lds_generic;
    const int tid = TIDX(), wid = __builtin_amdgcn_readfirstlane(tid >> 6), lane = tid & 63, wr = wid >> 2, wc = wid & 3, fr = lane & 15, fq = lane >> 4;
    const int nt = klen / BK;
    int R0, C0, R1, C1; stage_rc(tid * 16, R0, C0); stage_rc(tid * 16 + 8192, R1, C1);
    unsigned voffB[2];
    { const int Rb0 = Epi::PERM ? ((R0 & ~31) + perm32(R0 & 31)) : R0, Rb1 = Epi::PERM ? ((R1 & ~31) + perm32(R1 & 31)) : R1;
      voffB[0] = (unsigned)(Rb0 * K + C0) * 2u; voffB[1] = (unsigned)(Rb1 * K + C1) * 2u; }
    const size_t kstep = (size_t)(BK * 2), hstepB = (size_t)HALF * K * 2;
    const unsigned ldsw = (unsigned)wid * 1024u;
    const int aoff = lds_byte(wr * 64 + fr, fq * 8), boff = lds_byte(wc * 32 + fr, fq * 8);
#define G8_SA(b, h) (((b) * 2 + (h)) * HTB)
#define G8_SB(b, h) ((4 + (b) * 2 + (h)) * HTB)
#define G8_STG(bufoff, gbase, v0, v1) do { const char* _gb = uni_ptr((const char*)(gbase));     \
        __builtin_amdgcn_global_load_lds((const unsigned*)(_gb + (v0)), (LAS unsigned*)(lds + (bufoff) + ldsw), 16, 0, 0); \
        __builtin_amdgcn_global_load_lds((const unsigned*)(_gb + (v1)), (LAS unsigned*)(lds + (bufoff) + ldsw + 8192), 16, 0, 0); } while (0)
#define G8_LDA(dst, b, h) do { _Pragma("unroll") for (int m = 0; m < 4; ++m) _Pragma("unroll") for (int k = 0; k < 2; ++k) dst[m][k] = *(const LAS bf16x8*)(lds + G8_SA(b, h) + aoff + m * 2048 + k * 1024); } while (0)
#define G8_LDB(dst, b, h) do { _Pragma("unroll") for (int n = 0; n < 2; ++n) _Pragma("unroll") for (int k = 0; k < 2; ++k) dst[n][k] = *(const LAS bf16x8*)(lds + G8_SB(b, h) + boff + n * 2048 + k * 1024); } while (0)
#define G8_MMA(ai, bj, At, Bt) do { __builtin_amdgcn_s_setprio(1); _Pragma("unroll") for (int m = 0; m < 4; ++m) _Pragma("unroll") for (int n = 0; n < 2; ++n) _Pragma("unroll") for (int k = 0; k < 2; ++k) \
        acc[ai][bj][m][n] = __builtin_amdgcn_mfma_f32_16x16x32_bf16(Bt[n][k], At[m][k], acc[ai][bj][m][n], 0, 0, 0); __builtin_amdgcn_s_setprio(0); } while (0)
#define G8_WAIT_V(n) asm volatile("s_waitcnt vmcnt(" #n ")" ::: "memory")
#define G8_WAIT_L(n) asm volatile("s_waitcnt lgkmcnt(" #n ")" ::: "memory")
#define G8_BAR __builtin_amdgcn_s_barrier()
#define G8_SCHED __builtin_amdgcn_sched_barrier(0)
    UnitU cur, nxt;
    if (!S.next(cur)) return;
    unsigned va00, va01, va10, va11;
    S.lane_va(cur, R0, C0, R1, C1, va00, va01, va10, va11);
    f32x4 acc[2][2][4][2];
#pragma unroll
    for (int a = 0; a < 2; ++a)
#pragma unroll
        for (int b = 0; b < 2; ++b)
#pragma unroll
            for (int m = 0; m < 4; ++m)
#pragma unroll
                for (int n = 0; n < 2; ++n) acc[a][b][m][n] = (f32x4){0.f, 0.f, 0.f, 0.f};
    bf16x8 At[4][2], B0[2][2], B1[2][2];
    const char* cA = cur.A; const char* cB = cur.B;
    G8_STG(G8_SB(0, 0), cB, voffB[0], voffB[1]); G8_STG(G8_SA(0, 0), cA, va00, va01); G8_STG(G8_SB(0, 1), cB + hstepB, voffB[0], voffB[1]); G8_STG(G8_SA(0, 1), cA, va10, va11);
    if (wr == 1) G8_BAR;
    G8_WAIT_V(4); G8_BAR;
    G8_STG(G8_SB(1, 0), cB + kstep, voffB[0], voffB[1]); G8_STG(G8_SA(1, 0), cA + kstep, va00, va01); G8_STG(G8_SB(1, 1), cB + hstepB + kstep, voffB[0], voffB[1]);
    G8_WAIT_V(6); G8_BAR;
    for (;;) {
        const bool has_next = S.next(nxt);
        const char* nA = has_next ? nxt.A : cA; const char* nB = has_next ? nxt.B : cB;
        unsigned x00 = va00, x01 = va01, x10 = va10, x11 = va11;
        for (int t = 0; t < nt; t += 2) {
            const bool last = (t == nt - 2);
            const char* a1 = cA + (size_t)(t + 1) * kstep;
            const char* a2 = last ? nA : cA + (size_t)(t + 2) * kstep; const char* b2 = last ? nB : cB + (size_t)(t + 2) * kstep;
            const char* a3 = a2 + kstep; const char* b3 = b2 + kstep;
            if (Sched::GATHER) { if (last && has_next) S.lane_va(nxt, R0, C0, R1, C1, x00, x01, x10, x11); }
            G8_LDB(B0, 0, 0); G8_SCHED; G8_LDA(At, 0, 0); G8_STG(G8_SA(1, 1), a1, va10, va11);
            G8_WAIT_L(8); G8_BAR; G8_WAIT_L(0); G8_MMA(0, 0, At, B0); G8_BAR; G8_SCHED;
            G8_LDB(B1, 0, 1); G8_STG(G8_SB(0, 0), b2, voffB[0], voffB[1]);
            G8_BAR; G8_WAIT_L(0); G8_MMA(0, 1, At, B1); G8_BAR;
            G8_LDA(At, 0, 1); G8_STG(G8_SA(0, 0), a2, x00, x01);
            G8_BAR; G8_WAIT_L(0); G8_MMA(1, 0, At, B0); G8_BAR; G8_SCHED;
            G8_STG(G8_SB(0, 1), b2 + hstepB, voffB[0], voffB[1]);
            G8_WAIT_V(6); G8_BAR; G8_MMA(1, 1, At, B1); G8_BAR;
            G8_LDB(B0, 1, 0); G8_SCHED; G8_LDA(At, 1, 0); G8_STG(G8_SA(0, 1), a2, x10, x11);
            G8_WAIT_L(8); G8_BAR; G8_WAIT_L(0); G8_MMA(0, 0, At, B0); G8_BAR; G8_SCHED;
            G8_LDB(B1, 1, 1); G8_STG(G8_SB(1, 0), b3, voffB[0], voffB[1]);
            G8_BAR; G8_WAIT_L(0); G8_MMA(0, 1, At, B1); G8_BAR;
            G8_LDA(At, 1, 1); G8_STG(G8_SA(1, 0), a3, x00, x01);
            G8_BAR; G8_WAIT_L(0); G8_MMA(1, 0, At, B0); G8_BAR; G8_SCHED;
            G8_STG(G8_SB(1, 1), b3 + hstepB, voffB[0], voffB[1]);
            G8_WAIT_V(6); G8_BAR; G8_MMA(1, 1, At, B1); G8_BAR;
        }
        if (cur.flags & 2) E(acc, cur, wr, wc, fr, fq); else E.mid(acc, cur, wr, wc, fr, fq);
        if (!has_next) break;
        if (nxt.flags & 1) {
#pragma unroll
        for (int a = 0; a < 2; ++a)
#pragma unroll
            for (int b = 0; b < 2; ++b)
#pragma unroll
                for (int m = 0; m < 4; ++m)
#pragma unroll
                    for (int n = 0; n < 2; ++n) acc[a][b][m][n] = (f32x4){0.f, 0.f, 0.f, 0.f};
        }
        cur = nxt; cA = nA; cB = nB; va00 = x00; va01 = x01; va10 = x10; va11 = x11;
    }
    G8_WAIT_V(0);
    if (wr == 0) G8_BAR;
    G8_BAR;
#undef G8_SA
#undef G8_SB
#undef G8_STG
#undef G8_LDA
#undef G8_LDB
#undef G8_MMA
#undef G8_WAIT_V
#undef G8_WAIT_L
#undef G8_BAR
#undef G8_SCHED
}

struct DenseSched {
    static constexpr bool GATHER = false;
    const char* A; const char* Bt; int K, nM, nN, nwg, G, c, i;
    DEVI void init(const bf16_t* A_, const bf16_t* Bt_, int M, int N, int K_, int G_, int c_) { A = (const char*)A_; Bt = (const char*)Bt_; K = K_; nM = M / BM; nN = N / BM; nwg = nM * nN; G = G_; c = c_; i = 0; }
    DEVI bool next(UnitU& u) {
        const long L = (long)i * G + c; if (L >= nwg) return false;
        ++i;
        int wgid = (int)L; { const int q = nwg / 8, r = nwg % 8, xcd = wgid % 8, off = wgid / 8; wgid = (xcd < r ? xcd * (q + 1) : r * (q + 1) + (xcd - r) * q) + off; }
        const int nig = 8 * nN, gid = wgid / nig, fm = gid * 8, gsz = (nM - fm) < 8 ? (nM - fm) : 8;
        const int pm = fm + ((wgid % nig) % gsz), pn = (wgid % nig) / gsz;
        u.A = A + (size_t)pm * BM * K * 2; u.B = Bt + (size_t)pn * BM * K * 2; u.i0 = pm; u.i1 = pn; u.i2 = 0; u.i3 = 0; u.flags = 3;
        return true;
    }
    DEVI void lane_va(const UnitU&, int R0, int C0, int R1, int C1, unsigned& v00, unsigned& v01, unsigned& v10, unsigned& v11) const {
        v00 = (unsigned)(R0 * K + C0) * 2u; v01 = (unsigned)(R1 * K + C1) * 2u; v10 = v00 + (unsigned)(HALF * K * 2); v11 = v01 + (unsigned)(HALF * K * 2);
    }
};
struct EpiBf16Scale { static constexpr bool PERM = true; bf16_t* O; int ldo; const float* rstd;
    DEVI void mid(f32x4 (&)[2][2][4][2], const UnitU&, int, int, int, int) const {}
    DEVI void operator()(const f32x4 (&acc)[2][2][4][2], const UnitU& u, int wr, int wc, int fr, int fq) const {
        const int row0 = u.i0 * BM + wr * 64 + fr;
        bf16_t* base = O + (size_t)row0 * ldo + u.i1 * BM + wc * 32 + 8 * fq;
#pragma unroll
        for (int ai = 0; ai < 2; ++ai)
#pragma unroll
            for (int m = 0; m < 4; ++m) { bf16_t* rowp = base + (size_t)(ai * HALF + m * 16) * ldo; const float rs = rstd[row0 + ai * HALF + m * 16];
#pragma unroll
                for (int bj = 0; bj < 2; ++bj) { const f32x4 v0 = acc[ai][bj][m][0] * rs, v1 = acc[ai][bj][m][1] * rs;
                    u32x4 w; w.x = cvt_pk(v0[0], v0[1]); w.y = cvt_pk(v0[2], v0[3]); w.z = cvt_pk(v1[0], v1[1]); w.w = cvt_pk(v1[2], v1[3]);
                    *(u32x4*)(rowp + bj * HALF) = w; } }
    } };
struct EpiBf16 { static constexpr bool PERM = true; bf16_t* O; int ldo;
    DEVI void mid(f32x4 (&)[2][2][4][2], const UnitU&, int, int, int, int) const {}
    DEVI void operator()(const f32x4 (&acc)[2][2][4][2], const UnitU& u, int wr, int wc, int fr, int fq) const {
        bf16_t* base = O + (size_t)(u.i0 * BM + wr * 64 + fr) * ldo + u.i1 * BM + wc * 32 + 8 * fq;
#pragma unroll
        for (int ai = 0; ai < 2; ++ai)
#pragma unroll
            for (int m = 0; m < 4; ++m) { bf16_t* rowp = base + (size_t)(ai * HALF + m * 16) * ldo;
#pragma unroll
                for (int bj = 0; bj < 2; ++bj) { const f32x4 v0 = acc[ai][bj][m][0], v1 = acc[ai][bj][m][1];
                    u32x4 w; w.x = cvt_pk(v0[0], v0[1]); w.y = cvt_pk(v0[2], v0[3]); w.z = cvt_pk(v1[0], v1[1]); w.w = cvt_pk(v1[2], v1[3]);
                    *(u32x4*)(rowp + bj * HALF) = w; } }
    } };
struct EpiRes { static constexpr bool PERM = false; const float* R; float* O; int ld; bf16_t* H;
    DEVI void mid(f32x4 (&)[2][2][4][2], const UnitU&, int, int, int, int) const {}
    DEVI void operator()(const f32x4 (&acc)[2][2][4][2], const UnitU& u, int wr, int wc, int fr, int fq) const {
        const size_t off0 = (size_t)(u.i0 * BM + wr * 64 + fr) * ld + u.i1 * BM + wc * 32 + 4 * fq;
#pragma unroll
        for (int ai = 0; ai < 2; ++ai)
#pragma unroll
            for (int m = 0; m < 4; ++m) { const size_t off = off0 + (size_t)(ai * HALF + m * 16) * ld;
#pragma unroll
                for (int bj = 0; bj < 2; ++bj)
#pragma unroll
                    for (int n = 0; n < 2; ++n) { const f32x4 r = *(const f32x4*)(R + off + bj * HALF + n * 16); const f32x4 o = r + acc[ai][bj][m][n];
                        *(f32x4*)(O + off + bj * HALF + n * 16) = o;
                        u32x2 w; w.x = cvt_pk(o[0], o[1]); w.y = cvt_pk(o[2], o[3]); *(u32x2*)(H + off + bj * HALF + n * 16) = w; } }
    } };
struct DenseSched2 {
    static constexpr bool GATHER = false;
    DenseSched D; int sub;
    DEVI void init(const bf16_t* A_, const bf16_t* Bt_, int M, int N, int K_, int G_, int c_) { D.init(A_, Bt_, M, N, K_, G_, c_); sub = 0; }
    UnitU pend;
    DEVI bool next(UnitU& u) {
        if (sub == 0) { if (!D.next(pend)) return false; u = pend; u.A = pend.A + (size_t)(D.K / 2) * 2; u.B = pend.B + (size_t)(D.K / 2) * 2; u.flags = 1; sub = 1; return true; }
        u = pend; u.flags = 2; sub = 0; return true;
    }
    DEVI void lane_va(const UnitU& u, int R0, int C0, int R1, int C1, unsigned& v00, unsigned& v01, unsigned& v10, unsigned& v11) const { D.lane_va(u, R0, C0, R1, C1, v00, v01, v10, v11); }
};
struct EpiResScale : EpiRes { const float* ssq;
    DEVI void mid(f32x4 (&acc)[2][2][4][2], const UnitU& u, int wr, int wc, int fr, int fq) const {
#pragma unroll
        for (int ai = 0; ai < 2; ++ai)
#pragma unroll
            for (int m = 0; m < 4; ++m) {
                const int row = u.i0 * BM + ai * HALF + wr * 64 + m * 16 + fr;
                const float2 sq = *(const float2*)(ssq + (size_t)row * 2);
                const float rs = rsqrtf((sq.x + sq.y) * (1.0f / 512.0f) + EPS);
#pragma unroll
                for (int bj = 0; bj < 2; ++bj)
#pragma unroll
                    for (int n = 0; n < 2; ++n) acc[ai][bj][m][n] *= rs;
            }
    } };
}

DEVI void cumsum_task(const DP& p, int bh, char* lds) {
    const int tid = TIDX(), wid = tid >> 6, lane = tid & 63;
    const int b = bh >> 2, h = bh & 3;
    const float* logf = (const float*)(p.ws() + WS_LOGF);
    float* cumf = (float*)(p.ws() + WS_CUMF);
    float* wtot = (float*)lds;
    float v[4];
#pragma unroll
    for (int j = 0; j < 4; ++j) v[j] = logf[((size_t)b * S + tid * 4 + j) * 4 + h];
    v[1] += v[0]; v[2] += v[1]; v[3] += v[2];
    float incl = v[3];
#pragma unroll
    for (int d = 1; d < 64; d <<= 1) { const float t = __shfl_up(incl, d); if (lane >= d) incl += t; }
    if (lane == 63) wtot[wid] = incl;
    __syncthreads();
    float woff = 0.f;
    for (int w = 0; w < wid; ++w) woff += wtot[w];
    const float base = woff + incl - v[3];
    *(float4*)(cumf + (size_t)bh * S + tid * 4) = make_float4(base + v[0], base + v[1], base + v[2], base + v[3]);
    __syncthreads();
}
DEVI void phase_inproj(const DP& p, int l, char* lds) {
    unsigned char* ws = p.ws();
    for (int t = BIDX(); t < 32; t += gridDim.x) cumsum_task(p, t, lds);
    g8::DenseSched S; S.init((const bf16_t*)(ws + WS_HBUF), (const bf16_t*)(ws + WS_W_IN), T, NPROJ, DM, gridDim.x, BIDX());
    g8::EpiBf16Scale E{(bf16_t*)(ws + WS_PROJ), NPROJ, (const float*)(ws + WS_RSTD1)};
    g8::gemm8(lds, DM, DM, S, E);
}
DEVI void kv_gemm(const DP& p, char* lds) {
    unsigned char* ws = p.ws();
    const int c = BIDX() - ((int)gridDim.x - 64);
    if (c < 0) return;
    g8::DenseSched S; S.init((const bf16_t*)(ws + WS_MEMN), (const bf16_t*)(ws + WS_W_KV), MROWS, 2 * DM, DM, 64, c);
    g8::EpiBf16 E{(bf16_t*)(ws + WS_KV), 2 * DM};
    g8::gemm8(lds, DM, DM, S, E);
}

DEVI void conv8_pos(const DP& p, int l, const bf16_t* proj, int b, int sp, int chan0, float (&out)[8]) {
    float a[8];
    const float* cb = p.in(10) + l * 1024 + chan0;
#pragma unroll
    for (int i = 0; i < 8; ++i) a[i] = cb[i];
#pragma unroll
    for (int j = 0; j < 4; ++j) {
        const int s2 = sp - 3 + j;
        if (s2 >= 0) {
            const u32x4 w = *(const u32x4*)(proj + ((size_t)b * S + s2) * NPROJ + C_XBC + chan0);
            const float* cw = p.in(9) + ((size_t)l * 4 + j) * 1024 + chan0;
            a[0] += cw[0] * bflo(w.x); a[1] += cw[1] * bfhi(w.x); a[2] += cw[2] * bflo(w.y); a[3] += cw[3] * bfhi(w.y);
            a[4] += cw[4] * bflo(w.z); a[5] += cw[5] * bfhi(w.z); a[6] += cw[6] * bflo(w.w); a[7] += cw[7] * bfhi(w.w);
        }
    }
#pragma unroll
    for (int i = 0; i < 8; ++i) out[i] = silu_f(a[i]);
}
DEVI u32x4 pack8(const float (&v)[8]) { u32x4 w; w.x = cvt_pk(v[0], v[1]); w.y = cvt_pk(v[2], v[3]); w.z = cvt_pk(v[4], v[5]); w.w = cvt_pk(v[6], v[7]); return w; }


DEVI void phase_post(const DP& p, int l) {
    const int tid = TIDX(), wid = tid >> 6, lane = tid & 63;
    unsigned char* ws = p.ws();
    bf16_t* proj = (bf16_t*)(ws + WS_PROJ);
    const int sl = lane >> 2, qt = lane & 3, type = sl >> 2, head = sl & 3;
    const int col0 = (type < 2 ? type * 256 : 768 + (type - 2) * 256) + head * 64 + qt * 16;
    const float *gq0 = p.in(5), *gq1 = p.in(6), *gq2 = p.in(7), *gq3 = p.in(8);
    asm volatile("" : "+s"(gq0), "+s"(gq1), "+s"(gq2), "+s"(gq3));
    const float* gain = (type == 0 ? gq0 : type == 1 ? gq1 : type == 2 ? gq2 : gq3) + l * 64 + qt * 16;
    float gv[16];
#pragma unroll
    for (int i = 0; i < 16; ++i) gv[i] = gain[i];
    const float inv[8] = {1.000000000e+00f, 1.939227432e-01f, 3.760603070e-02f, 7.292664610e-03f, 1.414213562e-03f, 2.742481884e-04f, 5.318295734e-05f, 1.031338525e-05f};
    for (int row = BIDX() * 8 + wid; row < T; row += gridDim.x * 8) {
        bf16_t* ptr = proj + (size_t)row * NPROJ + col0;
        const u32x4 w0 = *(const u32x4*)ptr, w1 = *(const u32x4*)(ptr + 8);
        float v[16];
        v[0] = bflo(w0.x); v[1] = bfhi(w0.x); v[2] = bflo(w0.y); v[3] = bfhi(w0.y); v[4] = bflo(w0.z); v[5] = bfhi(w0.z); v[6] = bflo(w0.w); v[7] = bfhi(w0.w);
        v[8] = bflo(w1.x); v[9] = bfhi(w1.x); v[10] = bflo(w1.y); v[11] = bfhi(w1.y); v[12] = bflo(w1.z); v[13] = bfhi(w1.z); v[14] = bflo(w1.w); v[15] = bfhi(w1.w);
        float ss = 0.f;
#pragma unroll
        for (int i = 0; i < 16; ++i) ss += v[i] * v[i];
        ss += __shfl_xor(ss, 1); ss += __shfl_xor(ss, 2);
        const float rstd = rsqrtf(ss * (1.0f / 64.0f) + EPS);
#pragma unroll
        for (int i = 0; i < 16; ++i) v[i] = v[i] * rstd * gv[i];
        if (type >= 2 && qt == 0) {
            const float pos = (float)(row & (S - 1));
#pragma unroll
            for (int i = 0; i < 8; ++i) { float sn, cs; sincosf(pos * inv[i], &sn, &cs);
                const float a = v[i], b = v[i + 8]; v[i] = a * cs - b * sn; v[i + 8] = b * cs + a * sn; }
        }
        u32x4 o0, o1;
        o0.x = cvt_pk(v[0], v[1]); o0.y = cvt_pk(v[2], v[3]); o0.z = cvt_pk(v[4], v[5]); o0.w = cvt_pk(v[6], v[7]);
        o1.x = cvt_pk(v[8], v[9]); o1.y = cvt_pk(v[10], v[11]); o1.z = cvt_pk(v[12], v[13]); o1.w = cvt_pk(v[14], v[15]);
        *(u32x4*)ptr = o0; *(u32x4*)(ptr + 8) = o1;
    }
    bf16_t* xc = (bf16_t*)(ws + WS_XC);
    for (int item = BIDX() * NTHR + tid; item < T * 128; item += gridDim.x * NTHR) {
        const int t = item >> 7, c8 = (item & 127) * 8;
        float v[8]; conv8_pos(p, l, proj, t / S, t % S, c8, v);
        *(u32x4*)(xc + (size_t)t * 1024 + c8) = pack8(v);
    }
}
DEVI void phase_knorm(const DP& p, int l) {
    const int tid = TIDX(), wid = tid >> 6, lane = tid & 63;
    unsigned char* ws = p.ws();
    bf16_t* kv = (bf16_t*)(ws + WS_KV);
    const float* kg = p.in(21) + l * 256 + (lane & 15) * 16;
    float kgv[16];
#pragma unroll
    for (int i = 0; i < 16; ++i) kgv[i] = kg[i];
    for (int row = BIDX() * 8 + wid; row < MROWS; row += gridDim.x * 8) {
        bf16_t* ptr = kv + (size_t)row * 2 * DM + lane * 16;
        const u32x4 w0 = *(const u32x4*)ptr, w1 = *(const u32x4*)(ptr + 8);
        float v[16];
        v[0] = bflo(w0.x); v[1] = bfhi(w0.x); v[2] = bflo(w0.y); v[3] = bfhi(w0.y); v[4] = bflo(w0.z); v[5] = bfhi(w0.z); v[6] = bflo(w0.w); v[7] = bfhi(w0.w);
        v[8] = bflo(w1.x); v[9] = bfhi(w1.x); v[10] = bflo(w1.y); v[11] = bfhi(w1.y); v[12] = bflo(w1.z); v[13] = bfhi(w1.z); v[14] = bflo(w1.w); v[15] = bfhi(w1.w);
        float ss = 0.f;
#pragma unroll
        for (int i = 0; i < 16; ++i) ss += v[i] * v[i];
        ss += __shfl_xor(ss, 1); ss += __shfl_xor(ss, 2); ss += __shfl_xor(ss, 4); ss += __shfl_xor(ss, 8);
        const float rstd = rsqrtf(ss * (1.0f / 256.0f) + EPS);
#pragma unroll
        for (int i = 0; i < 16; ++i) v[i] = v[i] * rstd * kgv[i];
        u32x4 o0, o1;
        o0.x = cvt_pk(v[0], v[1]); o0.y = cvt_pk(v[2], v[3]); o0.z = cvt_pk(v[4], v[5]); o0.w = cvt_pk(v[6], v[7]);
        o1.x = cvt_pk(v[8], v[9]); o1.y = cvt_pk(v[10], v[11]); o1.z = cvt_pk(v[12], v[13]); o1.w = cvt_pk(v[14], v[15]);
        *(u32x4*)ptr = o0; *(u32x4*)(ptr + 8) = o1;
    }
}
constexpr float LOG2E = 1.4426950408889634f;
template <int DH> struct AttnLds { static constexpr int KST = DH + 8; static constexpr int TILE = 64 * KST; static constexpr int BYTES = 4 * TILE * 2; };
DEVI float xor16_max(float v) { return fmaxf(v, __shfl_xor(v, 16)); }
DEVI float xor32_max(float v) { auto r = __builtin_amdgcn_permlane32_swap(__float_as_uint(v), __float_as_uint(v), false, false); return fmaxf(__uint_as_float(r[0]), __uint_as_float(r[1])); }
DEVI float xor32_sum(float v) { auto r = __builtin_amdgcn_permlane32_swap(__float_as_uint(v), __float_as_uint(v), false, false); return __uint_as_float(r[0]) + __uint_as_float(r[1]); }
template <int DH, int MODE>
DEVI void attn_task(const bf16_t* __restrict__ Qb, int ldq, int qtok0, int qstep,
                    const bf16_t* __restrict__ Kb, const bf16_t* __restrict__ Vb, int ldk, int ktok0, int kstep,
                    int p0, int kt_lo, int kt_hi, float scale,
                    const float* __restrict__ cum, const float* __restrict__ qgain,
                    bf16_t* Ob, int ldo, float* Of, float* Om, float* Ol, char* lds) {
    constexpr int KST = AttnLds<DH>::KST, TILE = AttnLds<DH>::TILE, NKK = DH / 32, ND = DH / 16, NCH = (64 * DH / 8) / NTHR;
    const int tid = TIDX(), wid = tid >> 6, lane = tid & 63, r16 = lane & 15, g4 = lane >> 4;
    bf16_t* Ks = (bf16_t*)lds;
    bf16_t* Vs = Ks + 2 * TILE;
    const float c2 = scale * LOG2E;
    bf16x8 qf[NKK];
    {
        const bf16_t* qp = Qb + (size_t)(qtok0 + (p0 + wid * 16 + r16) * qstep) * ldq + g4 * 8;
#pragma unroll
        for (int kk = 0; kk < NKK; ++kk) qf[kk] = *(const bf16x8*)(qp + kk * 32);
    }
    if (MODE == 2) {
        float ss = 0.f;
#pragma unroll
        for (int kk = 0; kk < NKK; ++kk)
#pragma unroll
            for (int j = 0; j < 8; ++j) { const float v = bf2f((bf16_t)qf[kk][j]); ss += v * v; }
        ss += __shfl_xor(ss, 16); ss += __shfl_xor(ss, 32);
        const float rstd = rsqrtf(ss * (1.0f / DH) + EPS);
#pragma unroll
        for (int kk = 0; kk < NKK; ++kk)
#pragma unroll
            for (int j = 0; j < 8; ++j) { const float v = bf2f((bf16_t)qf[kk][j]) * rstd * qgain[kk * 32 + g4 * 8 + j]; qf[kk][j] = (short)f2bf(v); }
    }
    const int qpos = p0 + wid * 16 + r16;
    float m_ = -1.0e30f, l_ = 0.f;
    const float cq = (MODE == 0) ? cum[qpos] * LOG2E : 0.f;
    f32x4 o[ND];
#pragma unroll
    for (int n = 0; n < ND; ++n) o[n] = (f32x4){0.f, 0.f, 0.f, 0.f};
    u32x4 rk[NCH], rv[NCH];
    auto gload = [&](int kt) {
#pragma unroll
        for (int i = 0; i < NCH; ++i) { const int c = tid + i * NTHR, key = c / (DH / 8), dc = c % (DH / 8);
            const size_t tok = (size_t)(ktok0 + (kt * 64 + key) * kstep);
            rk[i] = *(const u32x4*)(Kb + tok * ldk + dc * 8); rv[i] = *(const u32x4*)(Vb + tok * ldk + dc * 8); }
    };
    gload(kt_lo);
    __syncthreads();
    int buf = 0;
    for (int kt = kt_lo; kt < kt_hi; ++kt, buf ^= 1) {
        bf16_t* Kt = Ks + buf * TILE;
        bf16_t* Vt = Vs + buf * TILE;
#pragma unroll
        for (int i = 0; i < NCH; ++i) { const int c = tid + i * NTHR, key = c / (DH / 8), dc = c % (DH / 8);
            *(u32x4*)(Kt + key * KST + dc * 8) = rk[i]; *(u32x4*)(Vt + key * KST + dc * 8) = rv[i]; }
        __syncthreads();
        if (kt + 1 < kt_hi) gload(kt + 1);
        f32x4 s[4];
#pragma unroll
        for (int n = 0; n < 4; ++n) {
            s[n] = (f32x4){0.f, 0.f, 0.f, 0.f};
#pragma unroll
            for (int kk = 0; kk < NKK; ++kk) {
                const bf16x8 kf = *(const bf16x8*)(Kt + (n * 16 + r16) * KST + kk * 32 + g4 * 8);
                s[n] = MFMA16(kf, qf[kk], s[n]);
            }
            if (DH > 64) __builtin_amdgcn_sched_barrier(0);
        }
        float mx = -INFINITY;
#pragma unroll
        for (int n = 0; n < 4; ++n) {
            f32x4 ck = (f32x4){0.f, 0.f, 0.f, 0.f};
            if (MODE == 0) ck = *(const f32x4*)(cum + kt * 64 + n * 16 + g4 * 4);
#pragma unroll
            for (int j = 0; j < 4; ++j) {
                const int kpos = kt * 64 + n * 16 + g4 * 4 + j;
                float t = s[n][j] * c2;
                if (MODE == 0) { t += cq - ck[j] * LOG2E; if (kpos > qpos) t = -INFINITY; }
                if (MODE == 1) { const int dd = qpos - kpos; if (dd < 0 || dd > 128) t = -INFINITY; }
                s[n][j] = t; mx = fmaxf(mx, t);
            }
        }
        mx = xor32_max(xor16_max(mx));
        const float mn = fmaxf(m_, mx);
        const float alpha = __builtin_amdgcn_exp2f(m_ - mn);
        float rs = 0.f;
#pragma unroll
        for (int n = 0; n < 4; ++n)
#pragma unroll
            for (int j = 0; j < 4; ++j) { const float pv = __builtin_amdgcn_exp2f(s[n][j] - mn); s[n][j] = pv; rs += pv; }
        rs += __shfl_xor(rs, 16); rs = xor32_sum(rs);
        l_ = l_ * alpha + rs; m_ = mn;
#pragma unroll
        for (int n = 0; n < ND; ++n) o[n] *= alpha;
#pragma unroll
        for (int kk = 0; kk < 2; ++kk) {
            bf16x8 pb;
            { const unsigned w0 = cvt_pk(s[2 * kk][0], s[2 * kk][1]), w1 = cvt_pk(s[2 * kk][2], s[2 * kk][3]), w2 = cvt_pk(s[2 * kk + 1][0], s[2 * kk + 1][1]), w3 = cvt_pk(s[2 * kk + 1][2], s[2 * kk + 1][3]);
              u32x4 w; w.x = w0; w.y = w1; w.z = w2; w.w = w3; pb = __builtin_bit_cast(bf16x8, w); }
            const bf16_t* vb = Vt + (kk * 32 + 4 * g4 + (r16 >> 2)) * KST + 4 * (r16 & 3);
#pragma unroll
            for (int n = 0; n < ND; ++n) {
                const s16x4 lo = tr_read(vb + n * 16), hi = tr_read(vb + 16 * KST + n * 16);
                bf16x8 vf; vf[0] = lo[0]; vf[1] = lo[1]; vf[2] = lo[2]; vf[3] = lo[3]; vf[4] = hi[0]; vf[5] = hi[1]; vf[6] = hi[2]; vf[7] = hi[3];
                o[n] = MFMA16(vf, pb, o[n]);
                if (DH > 64 && (n & 3) == 3) __builtin_amdgcn_sched_barrier(0);
            }
        }
    }
    const size_t tok = (size_t)(qtok0 + qpos * qstep);
    if (MODE == 1) {
#pragma unroll
        for (int n = 0; n < ND; ++n) *(f32x4*)(Of + tok * 256 + n * 16 + g4 * 4) = o[n];
        if (g4 == 0) { Om[tok * 4] = m_; Ol[tok * 4] = l_; }
    } else {
        const float inv = 1.0f / l_;
#pragma unroll
        for (int n = 0; n < ND; ++n) { u32x2 w; w.x = cvt_pk(o[n][0] * inv, o[n][1] * inv); w.y = cvt_pk(o[n][2] * inv, o[n][3] * inv);
            *(u32x2*)(Ob + tok * ldo + n * 16 + g4 * 4) = w; }
    }
}

DEVI void ssd_acs(const DP& p, int l, int b, int c, int g, float* acs, float* dts) {
    const int tid = TIDX(), wid = tid >> 6, lane = tid & 63;
    if (wid < 4) {
        const int head = g * 4 + wid;
        const float* dtv = (const float*)(p.ws() + WS_DTV);
        const float A = -__expf(p.in(12)[l * 8 + head]);
        const size_t t0 = (size_t)b * S + c * 128 + 2 * lane;
        const float d0 = dtv[t0 * 8 + head], d1 = dtv[(t0 + 1) * 8 + head];
        const float a0 = d0 * A, a1 = d1 * A;
        float incl = a0 + a1;
#pragma unroll
        for (int d = 1; d < 64; d <<= 1) { const float t = __shfl_up(incl, d); if (lane >= d) incl += t; }
        const float ex = incl - (a0 + a1);
        acs[wid * 128 + 2 * lane] = ex + a0; acs[wid * 128 + 2 * lane + 1] = ex + a0 + a1;
        dts[wid * 128 + 2 * lane] = d0; dts[wid * 128 + 2 * lane + 1] = d1;
    }
}
DEVI void conv8_chan(const DP& p, int l, const bf16_t* proj, int b, int c, int chan, int l0, float (&out)[8]) {
    const float* cw = p.in(9) + (size_t)l * 4 * 1024 + chan;
    const float w0 = cw[0], w1 = cw[1024], w2 = cw[2048], w3 = cw[3072], cb = p.in(10)[l * 1024 + chan];
    float v[11];
    const int sbase = c * 128 + l0 - 3;
#pragma unroll
    for (int i = 0; i < 11; ++i) { const int sp = sbase + i; v[i] = sp >= 0 ? bf2f(proj[((size_t)b * S + sp) * NPROJ + C_XBC + chan]) : 0.f; }
#pragma unroll
    for (int i = 0; i < 8; ++i) out[i] = silu_f(cb + w0 * v[i] + w1 * v[i + 1] + w2 * v[i + 2] + w3 * v[i + 3]);
}
constexpr int SST = 136;
constexpr int XST4 = 264;
DEVI void ssd_states_task(const DP& p, int l, int b, int c, int g, char* lds) {
    const int tid = TIDX(), wid = tid >> 6, lane = tid & 63, r16 = lane & 15, g4 = lane >> 4;
    const bf16_t* xc = (const bf16_t*)(p.ws() + WS_XC);
    bf16_t* Bn = (bf16_t*)lds;
    bf16_t* Xn = Bn + 128 * SST;
    float* acs = (float*)(Xn + 128 * XST4);
    float* dts = acs + 512;
    __syncthreads();
    ssd_acs(p, l, b, c, g, acs, dts);
    __syncthreads();
    if (tid < 4) ((float*)(p.ws() + WS_DECAY))[((size_t)b * 16 + c) * 8 + g * 4 + tid] = __expf(acs[tid * 128 + 127]);
    const size_t tok0 = (size_t)b * S + c * 128;
    for (int it = tid; it < 2048; it += NTHR) {
        const int ll = it >> 4, nc = (it & 15) * 8;
        *(u32x4*)(Bn + ll * SST + nc) = *(const u32x4*)(xc + (tok0 + ll) * 1024 + 512 + g * 128 + nc);
    }
    for (int it = tid; it < 4096; it += NTHR) {
        const int ll = it >> 5, ch = (it & 31) * 8, hl = ch >> 6;
        const u32x4 w = *(const u32x4*)(xc + (tok0 + ll) * 1024 + g * 256 + ch);
        const float sc = dts[hl * 128 + ll] * __expf(acs[hl * 128 + 127] - acs[hl * 128 + ll]);
        u32x4 o; o.x = cvt_pk(bflo(w.x) * sc, bfhi(w.x) * sc); o.y = cvt_pk(bflo(w.y) * sc, bfhi(w.y) * sc); o.z = cvt_pk(bflo(w.z) * sc, bfhi(w.z) * sc); o.w = cvt_pk(bflo(w.w) * sc, bfhi(w.w) * sc);
        *(u32x4*)(Xn + ll * XST4 + ch) = o;
    }
    __syncthreads();
    const int hl = wid >> 1, nh = wid & 1;
    f32x4 acc[4][4];
#pragma unroll
    for (int m = 0; m < 4; ++m)
#pragma unroll
        for (int n = 0; n < 4; ++n) acc[m][n] = (f32x4){0.f, 0.f, 0.f, 0.f};
#pragma unroll
    for (int kk = 0; kk < 4; ++kk) {
        bf16x8 af[4], bfr[4];
        const int lrow = kk * 32 + 8 * g4 + (r16 >> 2), cq = 4 * (r16 & 3);
#pragma unroll
        for (int m = 0; m < 4; ++m) { const bf16_t* a = Xn + lrow * XST4 + hl * 64 + m * 16 + cq; const s16x4 lo = tr_read(a), hi = tr_read(a + 4 * XST4);
            af[m][0] = lo[0]; af[m][1] = lo[1]; af[m][2] = lo[2]; af[m][3] = lo[3]; af[m][4] = hi[0]; af[m][5] = hi[1]; af[m][6] = hi[2]; af[m][7] = hi[3]; }
#pragma unroll
        for (int n = 0; n < 4; ++n) { const bf16_t* a = Bn + lrow * SST + nh * 64 + n * 16 + cq; const s16x4 lo = tr_read(a), hi = tr_read(a + 4 * SST);
            bfr[n][0] = lo[0]; bfr[n][1] = lo[1]; bfr[n][2] = lo[2]; bfr[n][3] = lo[3]; bfr[n][4] = hi[0]; bfr[n][5] = hi[1]; bfr[n][6] = hi[2]; bfr[n][7] = hi[3]; }
#pragma unroll
        for (int m = 0; m < 4; ++m)
#pragma unroll
            for (int n = 0; n < 4; ++n) acc[m][n] = MFMA16(bfr[n], af[m], acc[m][n]);
    }
    float* st = (float*)(p.ws() + WS_SSTATE) + (((size_t)b * 16 + c) * 8 + g * 4 + hl) * 8192;
#pragma unroll
    for (int m = 0; m < 4; ++m)
#pragma unroll
        for (int n = 0; n < 4; ++n) *(f32x4*)(st + (m * 16 + r16) * 128 + nh * 64 + n * 16 + g4 * 4) = acc[m][n];
}
DEVI void phase_ssd_scan(const DP& p) {
    const float* st = (const float*)(p.ws() + WS_SSTATE);
    bf16_t* hin = (bf16_t*)(p.ws() + WS_HIN);
    const float* decay = (const float*)(p.ws() + WS_DECAY);
    const int total = NB * 8 * 2048;
    for (int i = BIDX() * NTHR + TIDX(); i < total; i += gridDim.x * NTHR) {
        const int e4 = i & 2047, head = (i >> 11) & 7, b = i >> 14;
        f32x4 h = (f32x4){0.f, 0.f, 0.f, 0.f};
        for (int c = 0; c < 16; ++c) {
            const size_t off = (((size_t)b * 16 + c) * 8 + head) * 8192 + e4 * 4;
            u32x2 w; w.x = cvt_pk(h[0], h[1]); w.y = cvt_pk(h[2], h[3]);
            *(u32x2*)(hin + off) = w;
            const f32x4 s = *(const f32x4*)(st + off);
            const float d = decay[((size_t)b * 16 + c) * 8 + head];
            h = h * d + s;
        }
    }
}
constexpr int XST1 = 72;
DEVI void ssd_out_task(const DP& p, int l, int b, int c, int g, char* lds) {
    const int tid = TIDX(), wid = tid >> 6, lane = tid & 63, r16 = lane & 15, g4 = lane >> 4;
    const bf16_t* proj = (const bf16_t*)(p.ws() + WS_PROJ);
    const bf16_t* xc = (const bf16_t*)(p.ws() + WS_XC);
    bf16_t* Cs = (bf16_t*)lds;
    bf16_t* Bs = Cs + 128 * SST;
    bf16_t* Xn = Bs + 128 * SST;
    bf16_t* Hs = Xn + 128 * XST1;
    bf16_t* Mw = Hs + 64 * SST + wid * 16 * SST;
    float* acs = (float*)(Hs + 64 * SST + 8 * 16 * SST);
    float* dts = acs + 512;
    const int lrow = wid * 16 + r16;
    const size_t tok0 = (size_t)b * S + c * 128, tok = tok0 + lrow;
    bf16_t* mix = (bf16_t*)(p.ws() + WS_MIX);
    float ssq = 0.f;
    __syncthreads();
    ssd_acs(p, l, b, c, g, acs, dts);
    for (int it = tid; it < 2048; it += NTHR) {
        const int ll = it >> 4, nc = (it & 15) * 8;
        *(u32x4*)(Cs + ll * SST + nc) = *(const u32x4*)(xc + (tok0 + ll) * 1024 + 768 + g * 128 + nc);
        *(u32x4*)(Bs + ll * SST + nc) = *(const u32x4*)(xc + (tok0 + ll) * 1024 + 512 + g * 128 + nc);
    }
    __syncthreads();
    bf16x8 cfr[4];
#pragma unroll
    for (int kk = 0; kk < 4; ++kk) cfr[kk] = *(const bf16x8*)(Cs + lrow * SST + kk * 32 + g4 * 8);
    f32x4 cb[8];
#pragma unroll
    for (int st = 0; st < 8; ++st) {
        cb[st] = (f32x4){0.f, 0.f, 0.f, 0.f};
#pragma unroll
        for (int kk = 0; kk < 4; ++kk) {
            const bf16x8 bfr = *(const bf16x8*)(Bs + (st * 16 + r16) * SST + kk * 32 + g4 * 8);
            cb[st] = MFMA16(bfr, cfr[kk], cb[st]);
        }
    }
    for (int hl = 0; hl < 4; ++hl) {
        const int head = g * 4 + hl;
        __syncthreads();
        for (int it = tid; it < 1024; it += NTHR) {
            const int ss = it >> 3, pc8 = (it & 7) * 8;
            *(u32x4*)(Xn + ss * XST1 + pc8) = *(const u32x4*)(xc + (tok0 + ss) * 1024 + head * 64 + pc8);
            const bf16_t* hsrc = (const bf16_t*)(p.ws() + WS_HIN) + (((size_t)b * 16 + c) * 8 + head) * 8192 + (size_t)it * 8;
            *(u32x4*)(Hs + (it >> 4) * SST + (it & 15) * 8) = *(const u32x4*)hsrc;
        }
        __syncthreads();
        const float al = acs[hl * 128 + lrow];
#pragma unroll
        for (int st = 0; st < 8; ++st) {
            float mv[4];
#pragma unroll
            for (int j = 0; j < 4; ++j) { const int sidx = st * 16 + g4 * 4 + j;
                mv[j] = (sidx <= lrow) ? cb[st][j] * __expf(al - acs[hl * 128 + sidx]) * dts[hl * 128 + sidx] : 0.f; }
            u32x2 w; w.x = cvt_pk(mv[0], mv[1]); w.y = cvt_pk(mv[2], mv[3]);
            *(u32x2*)(Mw + r16 * SST + st * 16 + g4 * 4) = w;
        }
        __builtin_amdgcn_wave_barrier();
        asm volatile("s_waitcnt lgkmcnt(0)" ::: "memory");
        f32x4 yd[4], yo[4];
#pragma unroll
        for (int pt = 0; pt < 4; ++pt) { yd[pt] = (f32x4){0.f, 0.f, 0.f, 0.f}; yo[pt] = (f32x4){0.f, 0.f, 0.f, 0.f}; }
#pragma unroll
        for (int kk = 0; kk < 4; ++kk) {
            const bf16x8 mf = *(const bf16x8*)(Mw + r16 * SST + kk * 32 + g4 * 8);
            const bf16_t* xa = Xn + (kk * 32 + 8 * g4 + (r16 >> 2)) * XST1 + 4 * (r16 & 3);
#pragma unroll
            for (int pt = 0; pt < 4; ++pt) {
                const s16x4 lo = tr_read(xa + pt * 16), hi = tr_read(xa + 4 * XST1 + pt * 16);
                bf16x8 xf; xf[0] = lo[0]; xf[1] = lo[1]; xf[2] = lo[2]; xf[3] = lo[3]; xf[4] = hi[0]; xf[5] = hi[1]; xf[6] = hi[2]; xf[7] = hi[3];
                yd[pt] = MFMA16(xf, mf, yd[pt]);
                const bf16x8 hf = *(const bf16x8*)(Hs + (pt * 16 + r16) * SST + kk * 32 + g4 * 8);
                yo[pt] = MFMA16(hf, cfr[kk], yo[pt]);
            }
        }
        __builtin_amdgcn_wave_barrier();
        const float el = __expf(al), Dh = p.in(13)[l * 8 + head];
#pragma unroll
        for (int pt = 0; pt < 4; ++pt) {
            const int pc = pt * 16 + g4 * 4;
            const u32x2 zw = *(const u32x2*)(proj + tok * NPROJ + C_Z + head * 64 + pc);
            const u32x2 xw = *(const u32x2*)(Xn + lrow * XST1 + pc);
            const float zz[4] = {bflo(zw.x), bfhi(zw.x), bflo(zw.y), bfhi(zw.y)};
            const float xx[4] = {bflo(xw.x), bfhi(xw.x), bflo(xw.y), bfhi(xw.y)};
            float gv[4];
#pragma unroll
            for (int j = 0; j < 4; ++j) { const float yv = yd[pt][j] + el * yo[pt][j] + Dh * xx[j]; gv[j] = yv * silu_f(zz[j]); ssq += gv[j] * gv[j]; }
            u32x2 w; w.x = cvt_pk(gv[0], gv[1]); w.y = cvt_pk(gv[2], gv[3]);
            *(u32x2*)(mix + tok * DM + 512 + head * 64 + pc) = w;
        }
    }
    ssq += __shfl_xor(ssq, 16); ssq += __shfl_xor(ssq, 32);
    if (g4 == 0) ((float*)(p.ws() + WS_SSQ))[tok * 2 + g] = ssq;
}
constexpr int N_FOX = 512, N_S1 = 256, N_DIL = 1536;
DEVI void phase_mix1(const DP& p, int l, char* lds) {
    unsigned char* ws = p.ws();
    kv_gemm(p, lds);
    const bf16_t* proj = (const bf16_t*)(ws + WS_PROJ);
    bf16_t* mix = (bf16_t*)(ws + WS_MIX);
    for (int t = BIDX(); t < N_FOX + N_S1 + N_DIL; t += gridDim.x) {
        if (t < N_FOX) {
            const int bh = t & 31, k = t >> 5;
            const int qb = k < 8 ? 15 - k : k - 8;
            const int b = bh >> 2, h = bh & 3;
            const float* cum = (const float*)(ws + WS_CUMF) + (size_t)bh * S;
            attn_task<64, 0>(proj + C_FQ + h * 64, NPROJ, b * S, 1, proj + C_FK + h * 64, proj + C_FV + h * 64, NPROJ, b * S, 1,
                             qb * 128, 0, 2 * qb + 2, 0.125f, cum, nullptr, mix + h * 64, DM, nullptr, nullptr, nullptr, lds);
        } else if (t < N_FOX + N_S1) {
            const int u = t - N_FOX, g = u & 1, c = (u >> 1) & 15, b = u >> 5;
            ssd_states_task(p, l, b, c, g, lds);
        } else {
            const int u = t - N_FOX - N_S1, bh = u & 31, v = u >> 5;
            const int b = bh >> 2, h = bh & 3;
            int br, dil, r, pb;
            if (v < 16) { br = 0; dil = 1; r = 0; pb = v; }
            else if (v < 32) { br = 1; dil = 4; r = (v - 16) & 3; pb = (v - 16) >> 2; }
            else { br = 2; dil = 16; r = v - 32; pb = 0; }
            float* Of = (float*)(ws + WS_DILO) + (size_t)br * T * 256 + h * 64;
            float* Om = (float*)(ws + WS_DILM) + (size_t)br * T * 4 + h;
            float* Ol = (float*)(ws + WS_DILL) + (size_t)br * T * 4 + h;
            const int klo = pb > 0 ? 2 * pb - 2 : 0;
            attn_task<64, 1>(proj + C_DQ + h * 64, NPROJ, b * S + r, dil, proj + C_DK + h * 64, proj + C_DV + h * 64, NPROJ, b * S + r, dil,
                             pb * 128, klo, 2 * pb + 2, 0.125f, nullptr, nullptr, nullptr, 0, Of, Om, Ol, lds);
        }
    }
}
DEVI void phase_mix3(const DP& p, int l, char* lds) {
    unsigned char* ws = p.ws();
    for (int t = BIDX(); t < NB * 16 * 2; t += gridDim.x) ssd_out_task(p, l, t >> 5, (t >> 1) & 15, t & 1, lds);
    const int tid = TIDX(), wid = tid >> 6, lane = tid & 63, head = lane >> 4, d4 = (lane & 15) * 4;
    const float* Of = (const float*)(ws + WS_DILO);
    const float* Om = (const float*)(ws + WS_DILM);
    const float* Ol = (const float*)(ws + WS_DILL);
    bf16_t* mix = (bf16_t*)(ws + WS_MIX);
    for (int row = BIDX() * 8 + wid; row < T; row += gridDim.x * 8) {
        float m[3], lsum[3];
#pragma unroll
        for (int br = 0; br < 3; ++br) { m[br] = Om[((size_t)br * T + row) * 4 + head]; lsum[br] = Ol[((size_t)br * T + row) * 4 + head]; }
        const float M = fmaxf(m[0], fmaxf(m[1], m[2]));
        f32x4 num = (f32x4){0.f, 0.f, 0.f, 0.f}; float den = 0.f;
#pragma unroll
        for (int br = 0; br < 3; ++br) {
            const float w = __builtin_amdgcn_exp2f(m[br] - M);
            const f32x4 o = *(const f32x4*)(Of + ((size_t)br * T + row) * 256 + head * 64 + d4);
            num += o * w; den += w * lsum[br];
        }
        const float inv = 1.0f / den;
        u32x2 w; w.x = cvt_pk(num[0] * inv, num[1] * inv); w.y = cvt_pk(num[2] * inv, num[3] * inv);
        *(u32x2*)(mix + (size_t)row * DM + 256 + head * 64 + d4) = w;
    }
}
DEVI void phase_xattn(const DP& p, int l, char* lds) {
    unsigned char* ws = p.ws();
    const bf16_t* qbuf = (const bf16_t*)(ws + WS_QBUF);
    const bf16_t* kv = (const bf16_t*)(ws + WS_KV);
    bf16_t* obuf = (bf16_t*)(ws + WS_OBUF);
    for (int t = BIDX(); t < NB * 4 * 16; t += gridDim.x) {
        const int qb = t & 15, h = (t >> 4) & 3, b = t >> 6;
        attn_task<256, 2>(qbuf + h * 256, DM, b * S, 1, kv + h * 256, kv + DM + h * 256, 2 * DM, b * MEMLEN, 1,
                          qb * 128, 0, 4, 0.0625f, nullptr, p.in(20) + l * 256, obuf + h * 256, DM, nullptr, nullptr, nullptr, lds);
    }
}
namespace g8 {
template <bool GATHER_> struct MoeSched {
    static constexpr bool GATHER = GATHER_;
    const int* cnt; const int* list; const char* Abase; const char* Bbase; size_t bstride; int K, G;
    int e, ubase, tbase, u;
    DEVI void init(const int* cnt_, const int* list_, const void* A_, const void* B_, size_t bstride_, int K_, int G_, int c_) {
        cnt = cnt_; list = list_; Abase = (const char*)A_; Bbase = (const char*)B_; bstride = bstride_; K = K_; G = G_; e = 0; ubase = 0; tbase = 0; u = c_; }
    DEVI bool next(UnitU& o) {
        while (e < NEXP) {
            const int ce = cnt[e], nte = (ce + BM - 1) / BM, nun = nte * 4;
            if (u < ubase + nun) {
                const int lu = u - ubase, pm = lu >> 2, pn = lu & 3;
                o.i0 = tbase + pm; o.i1 = pn; o.i2 = e * (2 * T) + pm * BM; o.i3 = ce - pm * BM; o.flags = 3;
                o.A = GATHER ? Abase : Abase + (size_t)(tbase + pm) * BM * K * 2;
                o.B = Bbase + (size_t)e * bstride + (size_t)pn * BM * K * 2;
                u += G; return true;
            }
            ubase += nun; tbase += nte; ++e;
        }
        return false;
    }
    DEVI void lane_va(const UnitU& o, int R0, int C0, int R1, int C1, unsigned& v00, unsigned& v01, unsigned& v10, unsigned& v11) const {
        if (GATHER) {
            const int nv = o.i3; const int* ent = list + o.i2;
            const int t00 = ent[R0 < nv ? R0 : 0] >> 1, t01 = ent[R1 < nv ? R1 : 0] >> 1, t10 = ent[R0 + HALF < nv ? R0 + HALF : 0] >> 1, t11 = ent[R1 + HALF < nv ? R1 + HALF : 0] >> 1;
            v00 = (unsigned)(t00 * K + C0) * 2u; v01 = (unsigned)(t01 * K + C1) * 2u; v10 = (unsigned)(t10 * K + C0) * 2u; v11 = (unsigned)(t11 * K + C1) * 2u;
        } else {
            v00 = (unsigned)(R0 * K + C0) * 2u; v01 = (unsigned)(R1 * K + C1) * 2u; v10 = v00 + (unsigned)(HALF * K * 2); v11 = v01 + (unsigned)(HALF * K * 2);
        }
    }
};
struct EpiSwiglu { static constexpr bool PERM = false; bf16_t* act; const int* list; const float* rstd;
    DEVI void mid(f32x4 (&)[2][2][4][2], const UnitU&, int, int, int, int) const {}
    DEVI void operator()(const f32x4 (&acc)[2][2][4][2], const UnitU& u, int wr, int wc, int fr, int fq) const {
        const int nv = u.i3;
#pragma unroll
        for (int ai = 0; ai < 2; ++ai)
#pragma unroll
            for (int m = 0; m < 4; ++m) {
                const int r = ai * HALF + wr * 64 + m * 16 + fr;
                if (r < nv) {
                    bf16_t* rowp = act + (size_t)(u.i0 * BM + r) * EFF + u.i1 * 128 + wc * 16 + 4 * fq;
                    const float rs = rstd[list[u.i2 + r] >> 1];
#pragma unroll
                    for (int bj = 0; bj < 2; ++bj) { const f32x4 x1 = acc[ai][bj][m][0] * rs, x3 = acc[ai][bj][m][1] * rs;
                        u32x2 w; w.x = cvt_pk(silu_f(x1[0]) * x3[0], silu_f(x1[1]) * x3[1]); w.y = cvt_pk(silu_f(x1[2]) * x3[2], silu_f(x1[3]) * x3[3]);
                        *(u32x2*)(rowp + bj * 64) = w; }
                }
            }
    } };
struct EpiMoeOut { static constexpr bool PERM = true; bf16_t* y; const int* list; const float* gate;
    DEVI void mid(f32x4 (&)[2][2][4][2], const UnitU&, int, int, int, int) const {}
    DEVI void operator()(const f32x4 (&acc)[2][2][4][2], const UnitU& u, int wr, int wc, int fr, int fq) const {
        const int nv = u.i3; const int* ent = list + u.i2;
#pragma unroll
        for (int ai = 0; ai < 2; ++ai)
#pragma unroll
            for (int m = 0; m < 4; ++m) {
                const int r = ai * HALF + wr * 64 + m * 16 + fr;
                if (r < nv) {
                    const int a = ent[r]; const float gt = gate[a];
                    bf16_t* rowp = y + (size_t)a * DM + u.i1 * BM + wc * 32 + 8 * fq;
#pragma unroll
                    for (int bj = 0; bj < 2; ++bj) { const f32x4 v0 = acc[ai][bj][m][0] * gt, v1 = acc[ai][bj][m][1] * gt;
                        u32x4 w; w.x = cvt_pk(v0[0], v0[1]); w.y = cvt_pk(v0[2], v0[3]); w.z = cvt_pk(v1[0], v1[1]); w.w = cvt_pk(v1[2], v1[3]);
                        *(u32x4*)(rowp + bj * HALF) = w; }
                }
            }
    } };
}
template <int WHICH>
DEVI void phase_moe(const DP& p, int l, char* lds) {
    unsigned char* ws = p.ws();
    const int* cnt = (const int*)(ws + WS_CNT) + l * 64;
    const int* list = (const int*)(ws + WS_LIST);
    if (WHICH == 0) {
        g8::MoeSched<true> S;
        S.init(cnt, list, ws + WS_HBUF, ws + WS_W_13, (size_t)1024 * DM * 2, DM, gridDim.x, BIDX());
        g8::EpiSwiglu E{(bf16_t*)(ws + WS_ACT), list, (const float*)(ws + WS_RSTD3)};
        g8::gemm8(lds, DM, DM, S, E);
    } else {
        g8::MoeSched<false> S;
        S.init(cnt, list, ws + WS_ACT, ws + WS_W_2, (size_t)DM * EFF * 2, EFF, gridDim.x, BIDX());
        g8::EpiMoeOut E{(bf16_t*)(ws + WS_YBUF), list, (const float*)(ws + WS_GATE)};
        g8::gemm8(lds, EFF, EFF, S, E);
    }
}
DEVI void phase_final(const DP& p) {
    const int tid = TIDX(), wid = tid >> 6, lane = tid & 63;
    const bf16_t* ybuf = (const bf16_t*)(p.ws() + WS_YBUF);
    for (int row = BIDX() * 8 + wid; row < T; row += gridDim.x * 8) {
        float x[16];
        load_row_f32(p.out() + (size_t)row * DM, x, lane);
        add_row_bf16(ybuf + (size_t)(2 * row) * DM, x, lane);
        add_row_bf16(ybuf + (size_t)(2 * row + 1) * DM, x, lane);
        store_row_f32(p.out() + (size_t)row * DM, x, lane);
    }
}


#define XB_TMO      128
#define XB_XCNT(j)  (256  + 64 * (j))
#define XB_XSUB(j)  (1280 + 64 * (j))
#define XB_XGEN(j)  (2304 + 64 * (j))
#define XB_TOP      3328
#define XB_TOPGEN   3392
#define XCD_BAR_WORDS 3456
#define XB_SPIN_CAP (1u << 22)
DEVI unsigned xb_ld(unsigned* p)              { return __hip_atomic_load(p, __ATOMIC_RELAXED, __HIP_MEMORY_SCOPE_AGENT); }
DEVI unsigned xb_add(unsigned* p, unsigned v) { return __hip_atomic_fetch_add(p, v, __ATOMIC_RELAXED, __HIP_MEMORY_SCOPE_AGENT); }
DEVI unsigned xb_xcc_id() { return (unsigned)__builtin_amdgcn_s_getreg((3 << 11) | 20) & 0xFu; }
#define XB_SPIN(cond, bar) do { unsigned _sp = 0; while (cond) { __builtin_amdgcn_s_sleep(1); \
    if ((++_sp & 255u) == 0u) { if (xb_ld(&(bar)[XB_TMO])) break; if (_sp > XB_SPIN_CAP) { atomicAdd(&(bar)[XB_TMO], 1u); break; } } } } while (0)
struct XcdBarrier { unsigned* bar; unsigned x; volatile LAS unsigned* st; };
DEVI XcdBarrier xcd_barrier_post(unsigned* bar, volatile LAS unsigned* st) {
    XcdBarrier b; b.bar = bar; b.x = xb_xcc_id(); b.st = st;
    if (threadIdx.x == 0) (void)xb_add(&bar[XB_XCNT(b.x)], 1u);
    return b;
}
DEVI void xcd_barrier_complete(unsigned* bar, unsigned x, unsigned& nloc, unsigned& nx) {
    const unsigned G = gridDim.x * gridDim.y * gridDim.z;
    unsigned sum, cnt, mine, sp = 0u;
    for (;;) {
        sum = 0u; cnt = 0u; mine = 0u;
#pragma unroll
        for (unsigned j = 0; j < 16; ++j) { const unsigned c = xb_ld(&bar[XB_XCNT(j)]); sum += c; cnt += (c > 0u) ? 1u : 0u; mine = (j == x) ? c : mine; }
        if (sum == G) break;
        __builtin_amdgcn_s_sleep(1);
        if ((++sp & 255u) == 0u) { if (xb_ld(&bar[XB_TMO])) break; if (sp > XB_SPIN_CAP) { atomicAdd(&bar[XB_TMO], 1u); break; } }
    }
    nloc = mine > 0u ? mine : 1u; nx = cnt > 0u ? cnt : 1u;
}
DEVI void xcd_barrier(const XcdBarrier& b) {
    asm volatile("s_waitcnt vmcnt(0)" ::: "memory");
    __syncthreads();
    if (threadIdx.x == 0) {
        unsigned* bar = b.bar;
        __builtin_amdgcn_s_waitcnt(0);
        unsigned nloc = b.st[0], nx = b.st[1];
        if (nloc == 0u) { xcd_barrier_complete(bar, b.x, nloc, nx); b.st[0] = nloc; b.st[1] = nx; }
        const unsigned old = xb_add(&bar[XB_XSUB(b.x)], 1u);
        const unsigned gen = old / nloc;
        if (old + 1u == (gen + 1u) * nloc) {
            __builtin_amdgcn_fence(__ATOMIC_RELEASE, "agent");
            asm volatile("s_waitcnt vmcnt(0)" ::: "memory");
            const unsigned og = xb_add(&bar[XB_TOP], 1u);
            const unsigned tg = og / nx;
            if (og + 1u == (tg + 1u) * nx) xb_add(&bar[XB_TOPGEN], 1u);
            else XB_SPIN(xb_ld(&bar[XB_TOPGEN]) == tg, bar);
            __builtin_amdgcn_fence(__ATOMIC_ACQUIRE, "agent");
            xb_add(&bar[XB_XGEN(b.x)], 1u);
            asm volatile("s_waitcnt vmcnt(0)" ::: "memory");
        } else {
            XB_SPIN(xb_ld(&bar[XB_XGEN(b.x)]) == gen, bar);
            __builtin_amdgcn_fence(__ATOMIC_ACQUIRE, "agent");
            asm volatile("s_waitcnt vmcnt(0)" ::: "memory");
        }
    }
    __syncthreads();
}

constexpr int N_PHASES = 28;
__global__ void __launch_bounds__(NTHR) hybrid_fwd(Params p_unused) {
    extern __shared__ __attribute__((aligned(16))) char lds_base[];
    karg_ptr kp = (karg_ptr)__builtin_amdgcn_kernarg_segment_ptr();
    int ph_lo, ph_hi, use_gs;
    { DP q{kp}; ph_lo = q.ph_lo(); ph_hi = q.ph_hi(); use_gs = q.use_gs(); }
    volatile LAS unsigned* xst = (volatile LAS unsigned*)(LAS char*)(lds_base + LDS_BYTES - 16);
    if (threadIdx.x == 0) { xst[0] = 0u; xst[1] = 0u; }
    __syncthreads();
    XcdBarrier xb; xb.bar = nullptr; xb.x = 0; xb.st = xst;
    if (use_gs == 1) { DP q{kp}; xb = xcd_barrier_post((unsigned*)(q.ws() + WS_BAR), xst); }
#define RUN_PHASE(PH, ...) \
    if (ph_lo <= (PH) && (PH) < ph_hi) { \
        if ((PH) > ph_lo) { if (use_gs == 1) xcd_barrier(xb); else if (use_gs == 2) cg::this_grid().sync(); } \
        asm volatile("" : "+s"(kp) :: "memory"); \
        const DP p{kp}; \
        unsigned lds_off = 0; asm volatile("" : "+s"(lds_off)); \
        char* lds = lds_base + lds_off; \
        unsigned char* ws = p.ws(); (void)ws; (void)lds; \
        __VA_ARGS__ \
    }
#define LAYER_PHASES(L, B0) \
    RUN_PHASE((B0) + 0, { if ((L) == 1) { for (int u = BIDX(); u < PREP_UNITS; u += gridDim.x) prep_unit(p, 1, u, (float*)lds); } __syncthreads(); phase_norm1(p, (L), lds); }) \
    RUN_PHASE((B0) + 1, { phase_inproj(p, (L), lds); }) \
    RUN_PHASE((B0) + 2, { phase_post(p, (L)); }) \
    RUN_PHASE((B0) + 3, { phase_mix1(p, (L), lds); }) \
    RUN_PHASE((B0) + 4, { phase_ssd_scan(p); phase_knorm(p, (L)); }) \
    RUN_PHASE((B0) + 5, { phase_mix3(p, (L), lds); }) \
    RUN_PHASE((B0) + 6, { const float* x_in = (L) == 0 ? p.in(0) : p.out(); float* x1 = (L) == 0 ? p.out() : (float*)(ws + WS_XB); \
                          g8::DenseSched2 S; S.init((const bf16_t*)(ws + WS_MIX), (const bf16_t*)(ws + WS_W_OUT), T, DM, DM, gridDim.x, BIDX()); \
                          g8::EpiResScale E{{x_in, x1, DM, (bf16_t*)(ws + WS_HBUF)}, (const float*)(ws + WS_SSQ)}; g8::gemm8(lds, DM, DM / 2, S, E); }) \
    RUN_PHASE((B0) + 7, { g8::DenseSched S; S.init((const bf16_t*)(ws + WS_HBUF), (const bf16_t*)(ws + WS_W_Q), T, DM, DM, gridDim.x, BIDX()); \
                          g8::EpiBf16 E{(bf16_t*)(ws + WS_QBUF), DM}; g8::gemm8(lds, DM, DM, S, E); }) \
    RUN_PHASE((B0) + 8, { phase_xattn(p, (L), lds); }) \
    RUN_PHASE((B0) + 9, { const float* x1 = (L) == 0 ? p.out() : (const float*)(ws + WS_XB); float* x2 = (L) == 0 ? (float*)(ws + WS_XB) : p.out(); \
                          g8::DenseSched S; S.init((const bf16_t*)(ws + WS_OBUF), (const bf16_t*)(ws + WS_W_O), T, DM, DM, gridDim.x, BIDX()); \
                          g8::EpiRes E{x1, x2, DM, (bf16_t*)(ws + WS_HBUF)}; g8::gemm8(lds, DM, DM, S, E); }) \
    RUN_PHASE((B0) + 10, { const float* x2 = (L) == 0 ? (const float*)(ws + WS_XB) : p.out(); phase_norm3(p, (L), x2, lds); }) \
    RUN_PHASE((B0) + 11, { phase_moe<0>(p, (L), lds); }) \
    RUN_PHASE((B0) + 12, { phase_moe<1>(p, (L), lds); })

    RUN_PHASE(0, { prep_small(p); for (int u = BIDX(); u < PREP_UNITS; u += gridDim.x) prep_unit(p, 0, u, (float*)lds); })
    LAYER_PHASES(0, 1)
    LAYER_PHASES(1, 14)
    RUN_PHASE(27, { phase_final(p); })
#undef LAYER_PHASES
#undef RUN_PHASE
}

extern "C" void kernel_launch(void* const* d_in, const int* in_sizes, int n_in, void* d_out, int out_size, void* d_ws, size_t ws_size, hipStream_t stream) {
    static int grid = 0;
    if (grid == 0) {
        if (n_in != 31 || out_size != T * DM || ws_size < WS_END) { fprintf(stderr, "kernel_launch: unexpected shapes (n_in %d out %d ws %zu need %zu)\n", n_in, out_size, ws_size, (size_t)WS_END); grid = -1; return; }
        int dev = 0, cus = 0, per_cu = 0;
        hipGetDevice(&dev);
        hipDeviceGetAttribute(&cus, hipDeviceAttributeMultiprocessorCount, dev);
        hipFuncSetAttribute((const void*)hybrid_fwd, hipFuncAttributeMaxDynamicSharedMemorySize, LDS_BYTES);
        hipOccupancyMaxActiveBlocksPerMultiprocessor(&per_cu, (const void*)hybrid_fwd, NTHR, LDS_BYTES);
        if (per_cu < 1) { fprintf(stderr, "kernel_launch: occupancy query says %d blocks per CU\n", per_cu); per_cu = 1; }
        (void)hipGetLastError();
        grid = cus;
    }
    if (grid < 0) return;
    Params p{};
    for (int i = 0; i < 31; ++i) p.in[i] = (const float*)d_in[i];
    p.out = (float*)d_out; p.ws = (unsigned char*)d_ws;
    p.use_grid_sync = 1; p.pad = 0;
    p.ph_lo = 0; p.ph_hi = N_PHASES;
    if (hipMemsetAsync((unsigned char*)d_ws + WS_BAR, 0, XCD_BAR_WORDS * 4, stream) != hipSuccess) { fprintf(stderr, "kernel_launch: memset failed\n"); return; }
    void* args[] = {&p};
    hipError_t e = hipLaunchCooperativeKernel((const void*)hybrid_fwd, dim3(grid), dim3(NTHR), args, LDS_BYTES, stream);
    if (e != hipSuccess) fprintf(stderr, "kernel_launch: cooperative launch failed: %s (grid %d)\n", hipGetErrorString(e), grid);
}
```

```cpp
#include <hip/hip_runtime.h>
#include <hip/hip_cooperative_groups.h>
#include <cstdio>
#include <cstdint>
namespace cg = cooperative_groups;

typedef unsigned short bf16_t;
typedef short bf16x8 __attribute__((ext_vector_type(8)));
typedef short s16x4 __attribute__((ext_vector_type(4)));
typedef float f32x4 __attribute__((ext_vector_type(4)));
typedef unsigned u32x4 __attribute__((ext_vector_type(4)));
typedef unsigned u32x2 __attribute__((ext_vector_type(2)));
#define DEVI __device__ __forceinline__
#define LAS __attribute__((address_space(3)))

constexpr int NB = 8, S = 2048, DM = 1024, T = NB * S, DEPTH = 2;
constexpr int INP = 3084, NPROJ = 3072;
constexpr int C_FQ = 0, C_FK = 256, C_FV = 512, C_DQ = 768, C_DK = 1024, C_DV = 1280, C_Z = 1536, C_XBC = 2048;
constexpr int MEMLEN = 256, MROWS = NB * MEMLEN;
constexpr int NEXP = 32, EFF = 512;
constexpr float EPS = 1e-6f;
constexpr int NTHR = 512;
constexpr int LDS_BYTES = 151552;

constexpr size_t al256(size_t x) { return (x + 255) & ~(size_t)255; }
constexpr size_t WS_W_IN = 0;
constexpr size_t WS_W_OUT = WS_W_IN + (size_t)NPROJ * DM * 2;
constexpr size_t WS_W_Q = WS_W_OUT + (size_t)DM * DM * 2;
constexpr size_t WS_W_KV = WS_W_Q + (size_t)DM * DM * 2;
constexpr size_t WS_W_O = WS_W_KV + (size_t)2 * DM * DM * 2;
constexpr size_t WS_W_13 = WS_W_O + (size_t)DM * DM * 2;
constexpr size_t WS_W_2 = WS_W_13 + (size_t)NEXP * 1024 * DM * 2;
constexpr size_t WS_WSMALL = WS_W_2 + (size_t)NEXP * DM * EFF * 2;
constexpr size_t WS_WROUT = WS_WSMALL + (size_t)DEPTH * 12 * DM * 4;
constexpr size_t WS_XB = WS_WROUT + (size_t)DEPTH * 36 * DM * 4;
constexpr size_t WS_H1 = WS_XB;
constexpr size_t WS_H3 = WS_XB + (size_t)T * DM * 2;
constexpr size_t WS_HBUF = WS_XB + (size_t)T * DM * 4;
constexpr size_t WS_PROJ = WS_HBUF + (size_t)T * DM * 2;
constexpr size_t WS_QBUF = WS_PROJ;
constexpr size_t WS_OBUF = WS_PROJ + (size_t)T * DM * 2;
constexpr size_t WS_ACT = WS_PROJ;
constexpr size_t WS_MIX = WS_PROJ + (size_t)T * NPROJ * 2;
constexpr size_t WS_U = WS_MIX + (size_t)T * DM * 2;
constexpr size_t WS_YBUF = WS_U;
constexpr size_t WS_DILO = WS_U;
constexpr size_t WS_DILM = WS_DILO + (size_t)3 * T * 256 * 4;
constexpr size_t WS_DILL = WS_DILM + (size_t)3 * T * 4 * 4;
constexpr size_t WS_SSTATE = WS_DILL + (size_t)3 * T * 4 * 4;
constexpr size_t WS_HIN = WS_SSTATE + (size_t)NB * 16 * 8 * 8192 * 4;
constexpr size_t WS_GBUF = WS_HIN + (size_t)NB * 16 * 8 * 8192 * 2;
constexpr size_t WS_U_END = WS_GBUF + (size_t)T * 512 * 4;
constexpr size_t WS_MEMN = WS_U_END;
constexpr size_t WS_KV = WS_MEMN + (size_t)MROWS * DM * 2;
constexpr size_t WS_LOGF = WS_KV + (size_t)MROWS * 2 * DM * 2;
constexpr size_t WS_CUMF = WS_LOGF + (size_t)T * 4 * 4;
constexpr size_t WS_DTV = WS_CUMF + (size_t)T * 4 * 4;
constexpr size_t WS_DECAY = WS_DTV + (size_t)T * 8 * 4;
constexpr size_t WS_CNT = WS_DECAY + (size_t)NB * 16 * 8 * 4;
constexpr size_t WS_LIST = WS_CNT + 1024;
constexpr size_t WS_GATE = WS_LIST + (size_t)NEXP * 2 * T * 4;
constexpr size_t WS_BAR = WS_GATE + (size_t)2 * T * 4;
constexpr size_t WS_XC = WS_BAR + 65536;
constexpr size_t WS_SSQ = WS_XC + (size_t)T * 1024 * 2;
constexpr size_t WS_RSTD1 = WS_SSQ + (size_t)T * 2 * 4;
constexpr size_t WS_RSTD3 = WS_RSTD1 + (size_t)T * 4;
constexpr size_t WS_END = WS_RSTD3 + (size_t)T * 4;
static_assert(WS_YBUF + (size_t)2 * T * DM * 2 <= WS_U_END, "ybuf alias");
static_assert(WS_OBUF + (size_t)T * DM * 2 <= WS_MIX, "obuf alias");

struct Params {
    const float* in[31];
    float* out;
    unsigned char* ws;
    int ph_lo, ph_hi;
    int use_grid_sync, pad;
};


typedef __attribute__((address_space(4))) const unsigned long long* karg_ptr;
typedef __attribute__((address_space(1))) const float* gcf_ptr;
typedef __attribute__((address_space(1))) float* gf_ptr;
typedef __attribute__((address_space(1))) unsigned char* gb_ptr;
struct DP {
    karg_ptr kp;
    DEVI const float* in(int i) const { return (const float*)(gcf_ptr)(kp[i]); }
    DEVI float* out() const { return (float*)(gf_ptr)(kp[31]); }
    DEVI unsigned char* ws() const { return (unsigned char*)(gb_ptr)(kp[32]); }
    DEVI int ph_lo() const { return (int)(unsigned)kp[33]; }
    DEVI int ph_hi() const { return (int)(unsigned)(kp[33] >> 32); }
    DEVI int use_gs() const { return (int)(unsigned)kp[34]; }
};

DEVI int TIDX() { int t = threadIdx.x; asm volatile("" : "+v"(t)); return t; }
DEVI int BIDX() { int b = blockIdx.x; asm volatile("" : "+s"(b)); return b; }
DEVI float bf2f(bf16_t v) { return __uint_as_float(((unsigned)v) << 16); }
typedef float f32x2 __attribute__((ext_vector_type(2)));
typedef __bf16 bf16x2_t __attribute__((ext_vector_type(2)));
DEVI unsigned cvt_pk(float lo, float hi) { f32x2 v = {lo, hi}; bf16x2_t b = __builtin_convertvector(v, bf16x2_t); return __builtin_bit_cast(unsigned, b); }
DEVI bf16_t f2bf(float f) { return (bf16_t)(cvt_pk(f, 0.f) & 0xffffu); }
DEVI float bflo(unsigned w) { return __uint_as_float(w << 16); }
DEVI float bfhi(unsigned w) { return __uint_as_float(w & 0xffff0000u); }
DEVI float wave_sum(float v) {
#pragma unroll
    for (int m = 32; m >= 1; m >>= 1) v += __shfl_xor(v, m);
    return v;
}
template <int CTRL> DEVI float dpp_mov(float v) { return __uint_as_float(__builtin_amdgcn_update_dpp(0u, __float_as_uint(v), CTRL, 0xf, 0xf, false)); }
DEVI float wave_sum_fast(float v) {
    v += dpp_mov<0xB1>(v);
    v += dpp_mov<0x4E>(v);
    v += dpp_mov<0x124>(v);
    v += dpp_mov<0x128>(v);
    const int iv = __float_as_int(v);
    return (__int_as_float(__builtin_amdgcn_readlane(iv, 0)) + __int_as_float(__builtin_amdgcn_readlane(iv, 16))) + (__int_as_float(__builtin_amdgcn_readlane(iv, 32)) + __int_as_float(__builtin_amdgcn_readlane(iv, 48)));
}
DEVI float silu_f(float x) { return x / (1.f + __expf(-x)); }
DEVI float softplus_f(float x) { return x > 20.f ? x : log1pf(__expf(x)); }
DEVI float logsigmoid_f(float x) { return x >= 0.f ? -log1pf(__expf(-x)) : x - log1pf(__expf(x)); }
#define MFMA16(a, b, c) __builtin_amdgcn_mfma_f32_16x16x32_bf16(a, b, c, 0, 0, 0)
DEVI s16x4 tr_read(const bf16_t* p) {
    return __builtin_bit_cast(s16x4, __builtin_amdgcn_ds_read_tr16_b64_v4i16((LAS s16x4*)p));
}

DEVI int maprow(int mode, int n) { return mode == 0 ? n : ((n >> 4) * 32 + (n & 15) + (mode == 2 ? 16 : 0)); }
DEVI void prep_tile(const float* __restrict__ src, int ld, int k0, int c0, bf16_t* __restrict__ dst, int dstld, int mode, int n0,
                    const float* __restrict__ kscale, int ks_from, float* tl) {
    const int tid = TIDX();
#pragma unroll
    for (int i = 0; i < 2; ++i) {
        const int k = (tid >> 4) + 32 * i, n4 = (tid & 15) * 4;
        const float4 v = *(const float4*)(src + (size_t)(k0 + k) * ld + c0 + n4);
        float sc = 1.f;
        if (kscale != nullptr && (k0 + k) >= ks_from) sc = kscale[k0 + k - ks_from];
        tl[k * 65 + n4 + 0] = v.x * sc; tl[k * 65 + n4 + 1] = v.y * sc; tl[k * 65 + n4 + 2] = v.z * sc; tl[k * 65 + n4 + 3] = v.w * sc;
    }
    __syncthreads();
    {
        const int n = tid >> 3, kc = (tid & 7) * 8;
        u32x4 w;
        w.x = cvt_pk(tl[(kc + 0) * 65 + n], tl[(kc + 1) * 65 + n]);
        w.y = cvt_pk(tl[(kc + 2) * 65 + n], tl[(kc + 3) * 65 + n]);
        w.z = cvt_pk(tl[(kc + 4) * 65 + n], tl[(kc + 5) * 65 + n]);
        w.w = cvt_pk(tl[(kc + 6) * 65 + n], tl[(kc + 7) * 65 + n]);
        const int drow = maprow(mode, n0 + n);
        *(u32x4*)(dst + (size_t)drow * dstld + k0 + kc) = w;
    }
    __syncthreads();
}

constexpr int PREP_UNITS = 2048 + 3 * 4096;
DEVI void prep_unit(const DP& p, int l, int u, float* tl) {
    unsigned char* ws = p.ws();
    if (u < 768) {
        const int kt = u / 48, nt = u % 48, n0 = nt * 64, c0 = n0 < 768 ? n0 : n0 + 4;
        prep_tile(p.in(3) + (size_t)l * DM * INP, INP, kt * 64, c0, (bf16_t*)(ws + WS_W_IN), DM, 0, n0, p.in(2) + l * DM, 0, tl);
    } else if (u < 1024) {
        const int v = u - 768, kt = v / 16, nt = v % 16;
        prep_tile(p.in(15) + (size_t)l * DM * DM, DM, kt * 64, nt * 64, (bf16_t*)(ws + WS_W_OUT), DM, 0, nt * 64, p.in(14) + l * 512, 512, tl);
    } else if (u < 1280) {
        const int v = u - 1024, kt = v / 16, nt = v % 16;
        prep_tile(p.in(18) + (size_t)l * DM * DM, DM, kt * 64, nt * 64, (bf16_t*)(ws + WS_W_Q), DM, 0, nt * 64, p.in(16) + l * DM, 0, tl);
    } else if (u < 1792) {
        const int v = u - 1280, kt = v / 32, nt = v % 32;
        prep_tile(p.in(19) + (size_t)l * DM * 2 * DM, 2 * DM, kt * 64, nt * 64, (bf16_t*)(ws + WS_W_KV), DM, 0, nt * 64, nullptr, 0, tl);
    } else if (u < 2048) {
        const int v = u - 1792, kt = v / 16, nt = v % 16;
        prep_tile(p.in(22) + (size_t)l * DM * DM, DM, kt * 64, nt * 64, (bf16_t*)(ws + WS_W_O), DM, 0, nt * 64, nullptr, 0, tl);
    } else if (u < 2048 + 8192) {
        const int v = u - 2048, which = v / 4096, w = v % 4096, e = w / 128, tI = w % 128, kt = tI / 8, nt = tI % 8;
        const float* src = (which == 0 ? p.in(28) : p.in(29)) + ((size_t)l * NEXP + e) * DM * EFF;
        prep_tile(src, EFF, kt * 64, nt * 64, (bf16_t*)(ws + WS_W_13) + (size_t)e * 1024 * DM, DM, which == 0 ? 1 : 2, nt * 64, p.in(23) + l * DM, 0, tl);
    } else {
        const int w = u - 2048 - 8192, e = w / 128, tI = w % 128, kt = tI / 16, nt = tI % 16;
        const float* src = p.in(30) + ((size_t)l * NEXP + e) * EFF * DM;
        prep_tile(src, DM, kt * 64, nt * 64, (bf16_t*)(ws + WS_W_2) + (size_t)e * DM * EFF, EFF, 0, nt * 64, nullptr, 0, tl);
    }
}
DEVI void prep_small(const DP& p) {
    float* wsm = (float*)(p.ws() + WS_WSMALL);
    float* wro = (float*)(p.ws() + WS_WROUT);
    const int gtid = BIDX() * NTHR + TIDX(), gn = gridDim.x * NTHR;
    for (int i = gtid; i < DEPTH * 12 * DM; i += gn) {
        const int l = i / (12 * DM), r = i % (12 * DM), c = r / DM, k = r % DM;
        const int col = c < 4 ? 768 + c : 3076 + (c - 4);
        wsm[i] = p.in(3)[((size_t)l * DM + k) * INP + col] * p.in(2)[l * DM + k];
    }
    for (int i = gtid; i < DEPTH * 36 * DM; i += gn) {
        const int l = i / (36 * DM), r = i % (36 * DM), c = r / DM, k = r % DM;
        wro[i] = (c < 4 ? p.in(24)[((size_t)l * DM + k) * 4 + c] : p.in(26)[((size_t)l * DM + k) * 32 + (c - 4)]) * p.in(23)[l * DM + k];
    }
    if (BIDX() == 0 && TIDX() < 128) ((int*)(p.ws() + WS_CNT))[TIDX()] = 0;
}

DEVI void store_h_bf16(bf16_t* hrow, const float (&h)[16], int lane) {
#pragma unroll
    for (int j = 0; j < 4; ++j) {
        u32x2 w; w.x = cvt_pk(h[4 * j], h[4 * j + 1]); w.y = cvt_pk(h[4 * j + 2], h[4 * j + 3]);
        *(u32x2*)(hrow + j * 256 + lane * 4) = w;
    }
}
DEVI void load_row_f32(const float* xr, float (&x)[16], int lane) {
#pragma unroll
    for (int j = 0; j < 4; ++j) { const float4 v = *(const float4*)(xr + j * 256 + lane * 4); x[4 * j] = v.x; x[4 * j + 1] = v.y; x[4 * j + 2] = v.z; x[4 * j + 3] = v.w; }
}
DEVI void add_row_bf16(const bf16_t* yr, float (&x)[16], int lane) {
#pragma unroll
    for (int j = 0; j < 4; ++j) { const u32x2 w = *(const u32x2*)(yr + j * 256 + lane * 4); x[4 * j] += bflo(w.x); x[4 * j + 1] += bfhi(w.x); x[4 * j + 2] += bflo(w.y); x[4 * j + 3] += bfhi(w.y); }
}
DEVI void store_row_f32(float* xr, const float (&x)[16], int lane) {
#pragma unroll
    for (int j = 0; j < 4; ++j) *(float4*)(xr + j * 256 + lane * 4) = make_float4(x[4 * j], x[4 * j + 1], x[4 * j + 2], x[4 * j + 3]);
}
DEVI void norm_row(const float (&x)[16], const float* g, float (&h)[16], int lane) {
    float ss = 0.f;
#pragma unroll
    for (int i = 0; i < 16; ++i) ss += x[i] * x[i];
    ss = wave_sum(ss);
    const float rstd = rsqrtf(ss * (1.0f / DM) + EPS);
#pragma unroll
    for (int j = 0; j < 4; ++j) { const float4 gv = *(const float4*)(g + j * 256 + lane * 4);
        h[4 * j] = x[4 * j] * rstd * gv.x; h[4 * j + 1] = x[4 * j + 1] * rstd * gv.y; h[4 * j + 2] = x[4 * j + 2] * rstd * gv.z; h[4 * j + 3] = x[4 * j + 3] * rstd * gv.w; }
}
DEVI float dot_lds(const float (&h)[16], const float* wrow, int lane) {
    float a = 0.f;
#pragma unroll
    for (int j = 0; j < 4; ++j) { const float4 w = *(const float4*)(wrow + j * 256 + lane * 4); a += h[4 * j] * w.x + h[4 * j + 1] * w.y + h[4 * j + 2] * w.z + h[4 * j + 3] * w.w; }
    return a;
}

DEVI void load_row_bf16(const bf16_t* xr, float (&x)[16], int lane) {
#pragma unroll
    for (int j = 0; j < 2; ++j) { const u32x4 w = *(const u32x4*)(xr + j * 512 + lane * 8);
        x[8 * j] = bflo(w.x); x[8 * j + 1] = bfhi(w.x); x[8 * j + 2] = bflo(w.y); x[8 * j + 3] = bfhi(w.y); x[8 * j + 4] = bflo(w.z); x[8 * j + 5] = bfhi(w.z); x[8 * j + 6] = bflo(w.w); x[8 * j + 7] = bfhi(w.w); }
}
DEVI void add_row_bf16_b(const bf16_t* yr, float (&x)[16], int lane) {
#pragma unroll
    for (int j = 0; j < 2; ++j) { const u32x4 w = *(const u32x4*)(yr + j * 512 + lane * 8);
        x[8 * j] += bflo(w.x); x[8 * j + 1] += bfhi(w.x); x[8 * j + 2] += bflo(w.y); x[8 * j + 3] += bfhi(w.y); x[8 * j + 4] += bflo(w.z); x[8 * j + 5] += bfhi(w.z); x[8 * j + 6] += bflo(w.w); x[8 * j + 7] += bfhi(w.w); }
}
DEVI void store_row_bf16_b(bf16_t* hr, const float (&h)[16], int lane) {
#pragma unroll
    for (int j = 0; j < 2; ++j) { u32x4 w; w.x = cvt_pk(h[8 * j], h[8 * j + 1]); w.y = cvt_pk(h[8 * j + 2], h[8 * j + 3]); w.z = cvt_pk(h[8 * j + 4], h[8 * j + 5]); w.w = cvt_pk(h[8 * j + 6], h[8 * j + 7]);
        *(u32x4*)(hr + j * 512 + lane * 8) = w; }
}
DEVI float dot_lds_b(const float (&h)[16], const float* wrow, int lane) {
    float a = 0.f;
#pragma unroll
    for (int j = 0; j < 2; ++j) { const float4 w0 = *(const float4*)(wrow + j * 512 + lane * 8), w1 = *(const float4*)(wrow + j * 512 + lane * 8 + 4);
        a += h[8 * j] * w0.x + h[8 * j + 1] * w0.y + h[8 * j + 2] * w0.z + h[8 * j + 3] * w0.w + h[8 * j + 4] * w1.x + h[8 * j + 5] * w1.y + h[8 * j + 6] * w1.z + h[8 * j + 7] * w1.w; }
    return a;
}
#define MFMA_F32(a, b, c) __builtin_amdgcn_mfma_f32_16x16x4f32(a, b, c, 0, 0, 0)
template <int L>
DEVI void load_row_pre(const float* xin, const bf16_t* h0, const bf16_t* ybuf, int row, int lane, float (&x)[16]) {
    if (L == 0) load_row_f32(xin + (size_t)row * DM, x, lane);
    else { load_row_bf16(h0 + (size_t)row * DM, x, lane); add_row_bf16_b(ybuf + (size_t)(2 * row) * DM, x, lane); add_row_bf16_b(ybuf + (size_t)(2 * row + 1) * DM, x, lane); }
}
template <int L>
DEVI void norm1_rows(const DP& p, char* lds) {
    const int tid = TIDX(), wid = tid >> 6, lane = tid & 63;
    unsigned char* ws = p.ws();
    const float* wsl = (const float*)lds;
    const float* xin = p.in(0);
    const bf16_t* ybuf = (const bf16_t*)(ws + WS_YBUF);
    bf16_t* hbuf = (bf16_t*)(ws + WS_HBUF);
    float* logf = (float*)(ws + WS_LOGF);
    float* dtv = (float*)(ws + WS_DTV);
    float* rstd1 = (float*)(ws + WS_RSTD1);
    const int stride = gridDim.x * 8;
    int row = BIDX() * 8 + wid;
    float xn[16];
    if (row < T) load_row_pre<L>(xin, hbuf, ybuf, row, lane, xn);
    for (; row < T; row += stride) {
        float x[16];
#pragma unroll
        for (int i = 0; i < 16; ++i) x[i] = xn[i];
        if (row + stride < T) load_row_pre<L>(xin, hbuf, ybuf, row + stride, lane, xn);
        if (L == 0) store_h_bf16(hbuf + (size_t)row * DM, x, lane); else store_row_bf16_b(hbuf + (size_t)row * DM, x, lane);
        float ss = 0.f;
#pragma unroll
        for (int i = 0; i < 16; ++i) ss += x[i] * x[i];
        const float rstd = rsqrtf(wave_sum_fast(ss) * (1.0f / DM) + EPS);
        float keep = 0.f;
#pragma unroll
        for (int c = 0; c < 12; ++c) { const float v = wave_sum_fast(L == 0 ? dot_lds(x, wsl + c * DM, lane) : dot_lds_b(x, wsl + c * DM, lane)); keep = (lane == c) ? v : keep; if (c & 1) __builtin_amdgcn_sched_barrier(0); }
        keep *= rstd;
        if (lane == 0) rstd1[row] = rstd;
        if (lane < 4) logf[(size_t)row * 4 + lane] = logsigmoid_f(keep + p.in(4)[L * 4 + lane]);
        else if (lane < 12) dtv[(size_t)row * 8 + lane - 4] = softplus_f(keep + p.in(11)[L * 8 + lane - 4]);
    }
}
DEVI void phase_norm1(const DP& p, int l, char* lds) {
    const int tid = TIDX(), wid = tid >> 6, lane = tid & 63;
    unsigned char* ws = p.ws();
    float* wsl = (float*)lds;
    { const float4* src = (const float4*)((const float*)(ws + WS_WSMALL) + (size_t)l * 12 * DM);
      for (int i = tid; i < 12 * DM / 4; i += NTHR) ((float4*)wsl)[i] = src[i]; }
    __syncthreads();
    if (l == 0) norm1_rows<0>(p, lds); else norm1_rows<1>(p, lds);
    const float* gm = p.in(17) + l * DM;
    bf16_t* memn = (bf16_t*)(ws + WS_MEMN);
    for (int row = BIDX() * 8 + wid; row < MROWS; row += gridDim.x * 8) {
        float x[16], h[16];
        load_row_f32(p.in(1) + (size_t)row * DM, x, lane);
        norm_row(x, gm, h, lane);
        store_h_bf16(memn + (size_t)row * DM, h, lane);
    }
}
DEVI void phase_norm3(const DP& p, int l, char* lds) {
    const int tid = TIDX(), wid = tid >> 6, lane = tid & 63;
    unsigned char* ws = p.ws();
    float* wr = (float*)lds;
    int* lcnt = (int*)(lds + 36 * DM * 4);
    int* lbase = lcnt + 32;
    int* rinfo = lbase + 32;
    { const float4* src = (const float4*)((const float*)(ws + WS_WROUT) + (size_t)l * 36 * DM);
      for (int i = tid; i < 36 * DM / 4; i += NTHR) ((float4*)wr)[i] = src[i]; }
    if (tid < 32) lcnt[tid] = 0;
    __syncthreads();
    int* cnt = (int*)(ws + WS_CNT) + l * 64;
    int* list = (int*)(ws + WS_LIST);
    const bf16_t* xin = (const bf16_t*)(ws + WS_HBUF);
    bf16_t* h3 = (bf16_t*)(ws + WS_H3);
    const float* bg = p.in(25) + l * 4;
    const int be_i = __float_as_int(lane < 32 ? p.in(27)[l * 32 + lane] : 0.f);
    const int stride = gridDim.x * 8;
    int row = BIDX() * 8 + wid;
    float xn[16];
    if (row < T) load_row_bf16(xin + (size_t)row * DM, xn, lane);
    for (int it = 0; row < T; row += stride, ++it) {
        float x[16];
#pragma unroll
        for (int i = 0; i < 16; ++i) x[i] = xn[i];
        if (row + stride < T) load_row_bf16(xin + (size_t)(row + stride) * DM, xn, lane);
        float ss = 0.f;
#pragma unroll
        for (int i = 0; i < 16; ++i) ss += x[i] * x[i];
        const float rstd = rsqrtf(wave_sum_fast(ss) * (1.0f / DM) + EPS);
        { float hn[16];
#pragma unroll
          for (int i = 0; i < 16; ++i) hn[i] = x[i] * rstd;
          store_row_bf16_b(h3 + (size_t)row * DM, hn, lane); }
        float gl[4];
#pragma unroll
        for (int c = 0; c < 4; ++c) gl[c] = wave_sum_fast(dot_lds_b(x, wr + c * DM, lane)) * rstd + bg[c];
        int gsel = 0; float gmax = gl[0];
#pragma unroll
        for (int c = 1; c < 4; ++c) if (gl[c] > gmax) { gmax = gl[c]; gsel = c; }
        float gden = 0.f;
#pragma unroll
        for (int c = 0; c < 4; ++c) gden += __expf(gl[c] - gmax);
        const float ggate = 1.0f / gden;
        gsel = __builtin_amdgcn_readfirstlane(gsel);
        float v1 = -3.0e38f, v2 = -3.0e38f; int i1 = 0, i2 = 1;
#pragma unroll
        for (int c = 0; c < 8; ++c) {
            const float v = wave_sum_fast(dot_lds_b(x, wr + (4 + gsel * 8 + c) * DM, lane)) * rstd + __int_as_float(__builtin_amdgcn_readlane(be_i, gsel * 8 + c));
            if (v > v1) { v2 = v1; i2 = i1; v1 = v; i1 = c; } else if (v > v2) { v2 = v; i2 = c; }
            if (c & 1) __builtin_amdgcn_sched_barrier(0);
        }
        const float e2 = __expf(v2 - v1), inv = 1.0f / (1.0f + e2);
        if (lane == 0) {
            const int ea = gsel * 8 + i1, eb = gsel * 8 + i2;
            const int sa = atomicAdd(&lcnt[ea], 1), sb = atomicAdd(&lcnt[eb], 1);
            int* ri = rinfo + (it * 8 + wid) * 4;
            const unsigned gpk = cvt_pk(inv * ggate, e2 * inv * ggate);
            ri[0] = ea | (sa << 8); ri[1] = eb | (sb << 8); ri[2] = (int)(gpk << 16); ri[3] = (int)(gpk & 0xffff0000u);
        }
    }
    __syncthreads();
    if (tid < 32) lbase[tid] = atomicAdd(&cnt[tid], lcnt[tid]);
    __syncthreads();
    {
        const int nit = (T - (BIDX() * 8) + stride - 1) / stride;
        if (tid < nit * 8) {
            const int it = tid >> 3, w = tid & 7, r = BIDX() * 8 + w + it * stride;
            if (r < T) {
                const int* ri = rinfo + tid * 4;
                const int ea = ri[0] & 255, sa = ri[0] >> 8, eb = ri[1] & 255, sb = ri[1] >> 8;
                list[(size_t)ea * (2 * T) + lbase[ea] + sa] = ri[2] | (2 * r);
                list[(size_t)eb * (2 * T) + lbase[eb] + sb] = ri[3] | (2 * r + 1);
            }
        }
    }
    __syncthreads();
}

constexpr int G_BM = 256, G_BN = 128, G_BK = 64, G_ST = 72;
constexpr int G_ABUF = G_BM * G_ST, G_BBUF = G_BN * G_ST;
template <class AMap, class Epi>
DEVI void gemm_tile(const AMap& amap, const bf16_t* __restrict__ Bt, int K, const Epi& epi, char* lds) {
    const int tid = TIDX(), wid = tid >> 6, lane = tid & 63, r16 = lane & 15, g4 = lane >> 4;
    const int wr = wid >> 1, wc = wid & 1;
    bf16_t* As = (bf16_t*)lds;
    bf16_t* Bs = As + 2 * G_ABUF;
    const int srow = tid >> 3, skc = (tid & 7) * 8;
    const bf16_t* ap[4];
#pragma unroll
    for (int i = 0; i < 4; ++i) ap[i] = amap(srow + 64 * i) + skc;
    const bf16_t* bp[2];
#pragma unroll
    for (int i = 0; i < 2; ++i) bp[i] = Bt + (size_t)(srow + 64 * i) * K + skc;
    u32x4 ra[4], rb[2];
#pragma unroll
    for (int i = 0; i < 4; ++i) ra[i] = *(const u32x4*)(ap[i]);
#pragma unroll
    for (int i = 0; i < 2; ++i) rb[i] = *(const u32x4*)(bp[i]);
    f32x4 acc[4][4];
#pragma unroll
    for (int m = 0; m < 4; ++m)
#pragma unroll
        for (int n = 0; n < 4; ++n) acc[m][n] = (f32x4){0.f, 0.f, 0.f, 0.f};
    const int nt = K / G_BK;
    for (int t = 0; t < nt; ++t) {
        bf16_t* Ab = As + (t & 1) * G_ABUF;
        bf16_t* Bb = Bs + (t & 1) * G_BBUF;
#pragma unroll
        for (int i = 0; i < 4; ++i) *(u32x4*)(Ab + (srow + 64 * i) * G_ST + skc) = ra[i];
#pragma unroll
        for (int i = 0; i < 2; ++i) *(u32x4*)(Bb + (srow + 64 * i) * G_ST + skc) = rb[i];
        __syncthreads();
        if (t + 1 < nt) {
#pragma unroll
            for (int i = 0; i < 4; ++i) ra[i] = *(const u32x4*)(ap[i] + (size_t)(t + 1) * G_BK);
#pragma unroll
            for (int i = 0; i < 2; ++i) rb[i] = *(const u32x4*)(bp[i] + (size_t)(t + 1) * G_BK);
        }
#pragma unroll
        for (int kk = 0; kk < 2; ++kk) {
            bf16x8 af[4], bfr[4];
#pragma unroll
            for (int m = 0; m < 4; ++m) af[m] = *(const bf16x8*)(Ab + (wr * 64 + m * 16 + r16) * G_ST + kk * 32 + g4 * 8);
#pragma unroll
            for (int n = 0; n < 4; ++n) bfr[n] = *(const bf16x8*)(Bb + (wc * 64 + n * 16 + r16) * G_ST + kk * 32 + g4 * 8);
#pragma unroll
            for (int m = 0; m < 4; ++m)
#pragma unroll
                for (int n = 0; n < 4; ++n) acc[m][n] = MFMA16(bfr[n], af[m], acc[m][n]);
        }
    }
    epi(acc, wr * 64 + r16, wc * 64 + g4 * 4);
    __syncthreads();
}

struct AMapDense { const bf16_t* A; int K; DEVI const bf16_t* operator()(int r) const { return A + (size_t)r * K; } };
struct EpiBf16Out { bf16_t* O; int ldo;
    DEVI void operator()(const f32x4 (&acc)[4][4], int rb, int cb) const {
#pragma unroll
        for (int m = 0; m < 4; ++m)
#pragma unroll
            for (int n = 0; n < 4; ++n) { u32x2 w; w.x = cvt_pk(acc[m][n][0], acc[m][n][1]); w.y = cvt_pk(acc[m][n][2], acc[m][n][3]);
                *(u32x2*)(O + (size_t)(rb + m * 16) * ldo + cb + n * 16) = w; }
    } };
struct EpiResF32 { const float* R; float* O; int ld;
    DEVI void operator()(const f32x4 (&acc)[4][4], int rb, int cb) const {
#pragma unroll
        for (int m = 0; m < 4; ++m)
#pragma unroll
            for (int n = 0; n < 4; ++n) { const size_t off = (size_t)(rb + m * 16) * ld + cb + n * 16;
                const f32x4 r = *(const f32x4*)(R + off); *(f32x4*)(O + off) = r + acc[m][n]; }
    } };

template <class MakeEpi>
DEVI void gemm_dense_units(const bf16_t* A, const bf16_t* Bt, int M, int N, int K, const MakeEpi& mk, char* lds, int u0, int ustride) {
    const int nN = N / G_BN, nU = (M / G_BM) * nN;
    for (int u = u0; u < nU; u += ustride) {
        const int pm = u / nN, pn = u % nN;
        AMapDense am{A + (size_t)pm * G_BM * K, K};
        gemm_tile(am, Bt + (size_t)pn * G_BN * K, K, mk(pm * G_BM, pn * G_BN), lds);
    }
}


DEVI const char* uni_ptr(const char* p) {
    const unsigned long long v = (unsigned long long)p;
    const unsigned lo = __builtin_amdgcn_readfirstlane((unsigned)v), hi = __builtin_amdgcn_readfirstlane((unsigned)(v >> 32));
    return (const char*)(gb_ptr)(((unsigned long long)hi << 32) | lo);
}
namespace g8 {
constexpr int BM = 256, BK = 64, HALF = 128, HTB = HALF * BK * 2, STAGE_BYTES = 8 * HTB;
DEVI int lds_byte(int r, int c) { const int st = (r >> 4) * 2 + (c >> 5), rr = r & 15, cc = c & 31, ob = rr * 64 + cc * 2; return st * 1024 + (ob ^ (((ob >> 9) & 1) << 5)); }
DEVI void stage_rc(int b, int& R, int& C) { const int st = b / 1024, sb = b % 1024, swz = sb ^ (((sb >> 9) & 1) << 5); R = (st >> 1) * 16 + swz / 64; C = (st & 1) * 32 + (swz % 64) / 2; }
DEVI int perm32(int rho) { const int n = rho >> 4, i = rho & 15; return 8 * (i >> 2) + 4 * n + (i & 3); }
struct UnitU { const char* A; const char* B; int i0, i1, i2, i3; int flags; };

template <class Epi, class Sched>
DEVI void gemm8(char* lds_generic, int K, int klen, Sched& S, const Epi& E) {
    LAS unsigned char* lds = (LAS unsigned char*)lds_generic;
    const int tid = TIDX(), wid = __builtin_amdgcn_readfirstlane(tid >> 6), lane = tid & 63, wr = wid >> 2, wc = wid & 3, fr = lane & 15, fq = lane >> 4;
    const int nt = klen / BK;
    int R0, C0, R1, C1; stage_rc(tid * 16, R0, C0); stage_rc(tid * 16 + 8192, R1, C1);
    unsigned voffB[2];
    { const int Rb0 = Epi::PERM ? ((R0 & ~31) + perm32(R0 & 31)) : R0, Rb1 = Epi::PERM ? ((R1 & ~31) + perm32(R1 & 31)) : R1;
      voffB[0] = (unsigned)(Rb0 * K + C0) * 2u; voffB[1] = (unsigned)(Rb1 * K + C1) * 2u; }
    const size_t kstep = (size_t)(BK * 2), hstepB = (size_t)HALF * K * 2;
    const unsigned ldsw = (unsigned)wid * 1024u;
    const int aoff = lds_byte(wr * 64 + fr, fq * 8), boff = lds_byte(wc * 32 + fr, fq * 8);
#define G8_SA(b, h) (((b) * 2 + (h)) * HTB)
#define G8_SB(b, h) ((4 + (b) * 2 + (h)) * HTB)
#define G8_STG(bufoff, gbase, v0, v1) do { const char* _gb = uni_ptr((const char*)(gbase));     \
        __builtin_amdgcn_global_load_lds((const unsigned*)(_gb + (v0)), (LAS unsigned*)(lds + (bufoff) + ldsw), 16, 0, 0); \
        __builtin_amdgcn_global_load_lds((const unsigned*)(_gb + (v1)), (LAS unsigned*)(lds + (bufoff) + ldsw + 8192), 16, 0, 0); } while (0)
#define G8_LDA(dst, b, h) do { _Pragma("unroll") for (int m = 0; m < 4; ++m) _Pragma("unroll") for (int k = 0; k < 2; ++k) dst[m][k] = *(const LAS bf16x8*)(lds + G8_SA(b, h) + aoff + m * 2048 + k * 1024); } while (0)
#define G8_LDB(dst, b, h) do { _Pragma("unroll") for (int n = 0; n < 2; ++n) _Pragma("unroll") for (int k = 0; k < 2; ++k) dst[n][k] = *(const LAS bf16x8*)(lds + G8_SB(b, h) + boff + n * 2048 + k * 1024); } while (0)
#define G8_MMA(ai, bj, At, Bt) do { __builtin_amdgcn_s_setprio(1); _Pragma("unroll") for (int m = 0; m < 4; ++m) _Pragma("unroll") for (int n = 0; n < 2; ++n) _Pragma("unroll") for (int k = 0; k < 2; ++k) \
        acc[ai][bj][m][n] = __builtin_amdgcn_mfma_f32_16x16x32_bf16(Bt[n][k], At[m][k], acc[ai][bj][m][n], 0, 0, 0); __builtin_amdgcn_s_setprio(0); } while (0)
#define G8_WAIT_V(n) asm volatile("s_waitcnt vmcnt(" #n ")" ::: "memory")
#define G8_WAIT_L(n) asm volatile("s_waitcnt lgkmcnt(" #n ")" ::: "memory")
#define G8_BAR __builtin_amdgcn_s_barrier()
#define G8_SCHED __builtin_amdgcn_sched_barrier(0)
    UnitU cur, nxt;
    if (!S.next(cur)) return;
    unsigned va00, va01, va10, va11;
    S.lane_va(cur, R0, C0, R1, C1, va00, va01, va10, va11);
    f32x4 acc[2][2][4][2];
#pragma unroll
    for (int a = 0; a < 2; ++a)
#pragma unroll
        for (int b = 0; b < 2; ++b)
#pragma unroll
            for (int m = 0; m < 4; ++m)
#pragma unroll
                for (int n = 0; n < 2; ++n) acc[a][b][m][n] = (f32x4){0.f, 0.f, 0.f, 0.f};
    bf16x8 At[4][2], B0[2][2], B1[2][2];
    const char* cA = cur.A; const char* cB = cur.B;
    G8_STG(G8_SB(0, 0), cB, voffB[0], voffB[1]); G8_STG(G8_SA(0, 0), cA, va00, va01); G8_STG(G8_SB(0, 1), cB + hstepB, voffB[0], voffB[1]); G8_STG(G8_SA(0, 1), cA, va10, va11);
    if (wr == 1) G8_BAR;
    G8_WAIT_V(4); G8_BAR;
    G8_STG(G8_SB(1, 0), cB + kstep, voffB[0], voffB[1]); G8_STG(G8_SA(1, 0), cA + kstep, va00, va01); G8_STG(G8_SB(1, 1), cB + hstepB + kstep, voffB[0], voffB[1]);
    G8_WAIT_V(6); G8_BAR;
    for (;;) {
        const bool has_next = S.next(nxt);
        const char* nA = has_next ? nxt.A : cA; const char* nB = has_next ? nxt.B : cB;
        unsigned x00 = va00, x01 = va01, x10 = va10, x11 = va11;
        for (int t = 0; t < nt; t += 2) {
            const bool last = (t == nt - 2);
            const char* a1 = cA + (size_t)(t + 1) * kstep;
            const char* a2 = last ? nA : cA + (size_t)(t + 2) * kstep; const char* b2 = last ? nB : cB + (size_t)(t + 2) * kstep;
            const char* a3 = a2 + kstep; const char* b3 = b2 + kstep;
            if (Sched::GATHER) { if (last && has_next) S.lane_va(nxt, R0, C0, R1, C1, x00, x01, x10, x11); }
            G8_LDB(B0, 0, 0); G8_SCHED; G8_LDA(At, 0, 0); G8_STG(G8_SA(1, 1), a1, va10, va11);
            G8_WAIT_L(8); G8_BAR; G8_WAIT_L(0); G8_MMA(0, 0, At, B0); G8_BAR; G8_SCHED;
            G8_LDB(B1, 0, 1); G8_STG(G8_SB(0, 0), b2, voffB[0], voffB[1]);
            G8_BAR; G8_WAIT_L(0); G8_MMA(0, 1, At, B1); G8_BAR;
            G8_LDA(At, 0, 1); G8_STG(G8_SA(0, 0), a2, x00, x01);
            G8_BAR; G8_WAIT_L(0); G8_MMA(1, 0, At, B0); G8_BAR; G8_SCHED;
            G8_STG(G8_SB(0, 1), b2 + hstepB, voffB[0], voffB[1]);
            G8_WAIT_V(6); G8_BAR; G8_MMA(1, 1, At, B1); G8_BAR;
            G8_LDB(B0, 1, 0); G8_SCHED; G8_LDA(At, 1, 0); G8_STG(G8_SA(0, 1), a2, x10, x11);
            G8_WAIT_L(8); G8_BAR; G8_WAIT_L(0); G8_MMA(0, 0, At, B0); G8_BAR; G8_SCHED;
            G8_LDB(B1, 1, 1); G8_STG(G8_SB(1, 0), b3, voffB[0], voffB[1]);
            G8_BAR; G8_WAIT_L(0); G8_MMA(0, 1, At, B1); G8_BAR;
            G8_LDA(At, 1, 1); G8_STG(G8_SA(1, 0), a3, x00, x01);
            G8_BAR; G8_WAIT_L(0); G8_MMA(1, 0, At, B0); G8_BAR; G8_SCHED;
            G8_STG(G8_SB(1, 1), b3 + hstepB, voffB[0], voffB[1]);
            G8_WAIT_V(6); G8_BAR; G8_MMA(1, 1, At, B1); G8_BAR;
        }
        if (cur.flags & 2) E(acc, cur, wr, wc, fr, fq); else E.mid(acc, cur, wr, wc, fr, fq);
        if (!has_next) break;
        if (nxt.flags & 1) {
#pragma unroll
        for (int a = 0; a < 2; ++a)
#pragma unroll
            for (int b = 0; b < 2; ++b)
#pragma unroll
                for (int m = 0; m < 4; ++m)
#pragma unroll
                    for (int n = 0; n < 2; ++n) acc[a][b][m][n] = (f32x4){0.f, 0.f, 0.f, 0.f};
        }
        cur = nxt; cA = nA; cB = nB; va00 = x00; va01 = x01; va10 = x10; va11 = x11;
    }
    G8_WAIT_V(0);
    if (wr == 0) G8_BAR;
    G8_BAR;
#undef G8_SA
#undef G8_SB
#undef G8_STG
#undef G8_LDA
#undef G8_LDB
#undef G8_MMA
#undef G8_WAIT_V
#undef G8_WAIT_L
#undef G8_BAR
#undef G8_SCHED
}

struct DenseSched {
    static constexpr bool GATHER = false;
    const char* A; const char* Bt; int K, nM, nN, nwg, G, c, i;
    DEVI void init(const bf16_t* A_, const bf16_t* Bt_, int M, int N, int K_, int G_, int c_) { A = (const char*)A_; Bt = (const char*)Bt_; K = K_; nM = M / BM; nN = N / BM; nwg = nM * nN; G = G_; c = c_; i = 0; }
    DEVI bool next(UnitU& u) {
        const long L = (long)i * G + c; if (L >= nwg) return false;
        ++i;
        int wgid = (int)L; { const int q = nwg / 8, r = nwg % 8, xcd = wgid % 8, off = wgid / 8; wgid = (xcd < r ? xcd * (q + 1) : r * (q + 1) + (xcd - r) * q) + off; }
        const int nig = 8 * nN, gid = wgid / nig, fm = gid * 8, gsz = (nM - fm) < 8 ? (nM - fm) : 8;
        const int pm = fm + ((wgid % nig) % gsz), pn = (wgid % nig) / gsz;
        u.A = A + (size_t)pm * BM * K * 2; u.B = Bt + (size_t)pn * BM * K * 2; u.i0 = pm; u.i1 = pn; u.i2 = 0; u.i3 = 0; u.flags = 3;
        return true;
    }
    DEVI void lane_va(const UnitU&, int R0, int C0, int R1, int C1, unsigned& v00, unsigned& v01, unsigned& v10, unsigned& v11) const {
        v00 = (unsigned)(R0 * K + C0) * 2u; v01 = (unsigned)(R1 * K + C1) * 2u; v10 = v00 + (unsigned)(HALF * K * 2); v11 = v01 + (unsigned)(HALF * K * 2);
    }
};
struct EpiBf16Scale { static constexpr bool PERM = true; bf16_t* O; int ldo; const float* rstd;
    DEVI void mid(f32x4 (&)[2][2][4][2], const UnitU&, int, int, int, int) const {}
    DEVI void operator()(const f32x4 (&acc)[2][2][4][2], const UnitU& u, int wr, int wc, int fr, int fq) const {
        const int row0 = u.i0 * BM + wr * 64 + fr;
        bf16_t* base = O + (size_t)row0 * ldo + u.i1 * BM + wc * 32 + 8 * fq;
#pragma unroll
        for (int ai = 0; ai < 2; ++ai)
#pragma unroll
            for (int m = 0; m < 4; ++m) { bf16_t* rowp = base + (size_t)(ai * HALF + m * 16) * ldo; const float rs = rstd[row0 + ai * HALF + m * 16];
#pragma unroll
                for (int bj = 0; bj < 2; ++bj) { const f32x4 v0 = acc[ai][bj][m][0] * rs, v1 = acc[ai][bj][m][1] * rs;
                    u32x4 w; w.x = cvt_pk(v0[0], v0[1]); w.y = cvt_pk(v0[2], v0[3]); w.z = cvt_pk(v1[0], v1[1]); w.w = cvt_pk(v1[2], v1[3]);
                    *(u32x4*)(rowp + bj * HALF) = w; } }
    } };
struct EpiBf16 { static constexpr bool PERM = true; bf16_t* O; int ldo;
    DEVI void mid(f32x4 (&)[2][2][4][2], const UnitU&, int, int, int, int) const {}
    DEVI void operator()(const f32x4 (&acc)[2][2][4][2], const UnitU& u, int wr, int wc, int fr, int fq) const {
        bf16_t* base = O + (size_t)(u.i0 * BM + wr * 64 + fr) * ldo + u.i1 * BM + wc * 32 + 8 * fq;
#pragma unroll
        for (int ai = 0; ai < 2; ++ai)
#pragma unroll
            for (int m = 0; m < 4; ++m) { bf16_t* rowp = base + (size_t)(ai * HALF + m * 16) * ldo;
#pragma unroll
                for (int bj = 0; bj < 2; ++bj) { const f32x4 v0 = acc[ai][bj][m][0], v1 = acc[ai][bj][m][1];
                    u32x4 w; w.x = cvt_pk(v0[0], v0[1]); w.y = cvt_pk(v0[2], v0[3]); w.z = cvt_pk(v1[0], v1[1]); w.w = cvt_pk(v1[2], v1[3]);
                    *(u32x4*)(rowp + bj * HALF) = w; } }
    } };
struct EpiResBf { static constexpr bool PERM = true; const bf16_t* R; bf16_t* O; int ld;
    DEVI void mid(f32x4 (&)[2][2][4][2], const UnitU&, int, int, int, int) const {}
    DEVI void operator()(const f32x4 (&acc)[2][2][4][2], const UnitU& u, int wr, int wc, int fr, int fq) const {
        const size_t off0 = (size_t)(u.i0 * BM + wr * 64 + fr) * ld + u.i1 * BM + wc * 32 + 8 * fq;
#pragma unroll
        for (int ai = 0; ai < 2; ++ai)
#pragma unroll
            for (int m = 0; m < 4; ++m) { const size_t off = off0 + (size_t)(ai * HALF + m * 16) * ld;
#pragma unroll
                for (int bj = 0; bj < 2; ++bj) { const u32x4 r = *(const u32x4*)(R + off + bj * HALF); const f32x4 v0 = acc[ai][bj][m][0], v1 = acc[ai][bj][m][1];
                    u32x4 w; w.x = cvt_pk(bflo(r.x) + v0[0], bfhi(r.x) + v0[1]); w.y = cvt_pk(bflo(r.y) + v0[2], bfhi(r.y) + v0[3]);
                    w.z = cvt_pk(bflo(r.z) + v1[0], bfhi(r.z) + v1[1]); w.w = cvt_pk(bflo(r.w) + v1[2], bfhi(r.w) + v1[3]);
                    *(u32x4*)(O + off + bj * HALF) = w; } }
    } };
struct EpiRes { static constexpr bool PERM = false; const float* R; float* O; int ld; bf16_t* H;
    DEVI void mid(f32x4 (&)[2][2][4][2], const UnitU&, int, int, int, int) const {}
    DEVI void operator()(const f32x4 (&acc)[2][2][4][2], const UnitU& u, int wr, int wc, int fr, int fq) const {
        const size_t off0 = (size_t)(u.i0 * BM + wr * 64 + fr) * ld + u.i1 * BM + wc * 32 + 4 * fq;
#pragma unroll
        for (int ai = 0; ai < 2; ++ai)
#pragma unroll
            for (int m = 0; m < 4; ++m) { const size_t off = off0 + (size_t)(ai * HALF + m * 16) * ld;
#pragma unroll
                for (int bj = 0; bj < 2; ++bj)
#pragma unroll
                    for (int n = 0; n < 2; ++n) { const f32x4 r = *(const f32x4*)(R + off + bj * HALF + n * 16); const f32x4 o = r + acc[ai][bj][m][n];
                        *(f32x4*)(O + off + bj * HALF + n * 16) = o;
                        u32x2 w; w.x = cvt_pk(o[0], o[1]); w.y = cvt_pk(o[2], o[3]); *(u32x2*)(H + off + bj * HALF + n * 16) = w; } }
    } };
struct DenseSched2 {
    static constexpr bool GATHER = false;
    DenseSched D; int sub;
    DEVI void init(const bf16_t* A_, const bf16_t* Bt_, int M, int N, int K_, int G_, int c_) { D.init(A_, Bt_, M, N, K_, G_, c_); sub = 0; }
    UnitU pend;
    DEVI bool next(UnitU& u) {
        if (sub == 0) { if (!D.next(pend)) return false; u = pend; u.A = pend.A + (size_t)(D.K / 2) * 2; u.B = pend.B + (size_t)(D.K / 2) * 2; u.flags = 1; sub = 1; return true; }
        u = pend; u.flags = 2; sub = 0; return true;
    }
    DEVI void lane_va(const UnitU& u, int R0, int C0, int R1, int C1, unsigned& v00, unsigned& v01, unsigned& v10, unsigned& v11) const { D.lane_va(u, R0, C0, R1, C1, v00, v01, v10, v11); }
};
struct EpiResScale : EpiResBf { const float* ssq;
    DEVI void mid(f32x4 (&acc)[2][2][4][2], const UnitU& u, int wr, int wc, int fr, int fq) const {
#pragma unroll
        for (int ai = 0; ai < 2; ++ai)
#pragma unroll
            for (int m = 0; m < 4; ++m) {
                const int row = u.i0 * BM + ai * HALF + wr * 64 + m * 16 + fr;
                const float2 sq = *(const float2*)(ssq + (size_t)row * 2);
                const float rs = rsqrtf((sq.x + sq.y) * (1.0f / 512.0f) + EPS);
#pragma unroll
                for (int bj = 0; bj < 2; ++bj)
#pragma unroll
                    for (int n = 0; n < 2; ++n) acc[ai][bj][m][n] *= rs;
            }
    } };
}

DEVI void cumsum_task(const DP& p, int bh, char* lds) {
    const int tid = TIDX(), wid = tid >> 6, lane = tid & 63;
    const int b = bh >> 2, h = bh & 3;
    const float* logf = (const float*)(p.ws() + WS_LOGF);
    float* cumf = (float*)(p.ws() + WS_CUMF);
    float* wtot = (float*)lds;
    float v[4];
#pragma unroll
    for (int j = 0; j < 4; ++j) v[j] = logf[((size_t)b * S + tid * 4 + j) * 4 + h];
    v[1] += v[0]; v[2] += v[1]; v[3] += v[2];
    float incl = v[3];
#pragma unroll
    for (int d = 1; d < 64; d <<= 1) { const float t = __shfl_up(incl, d); if (lane >= d) incl += t; }
    if (lane == 63) wtot[wid] = incl;
    __syncthreads();
    float woff = 0.f;
    for (int w = 0; w < wid; ++w) woff += wtot[w];
    const float base = woff + incl - v[3];
    *(float4*)(cumf + (size_t)bh * S + tid * 4) = make_float4(base + v[0], base + v[1], base + v[2], base + v[3]);
    __syncthreads();
}
DEVI void phase_inproj(const DP& p, int l, char* lds) {
    unsigned char* ws = p.ws();
    for (int t = BIDX(); t < 32; t += gridDim.x) cumsum_task(p, t, lds);
    g8::DenseSched S; S.init((const bf16_t*)(ws + WS_HBUF), (const bf16_t*)(ws + WS_W_IN), T, NPROJ, DM, gridDim.x, BIDX());
    g8::EpiBf16Scale E{(bf16_t*)(ws + WS_PROJ), NPROJ, (const float*)(ws + WS_RSTD1)};
    g8::gemm8(lds, DM, DM, S, E);
}
DEVI void kv_gemm(const DP& p, char* lds) {
    unsigned char* ws = p.ws();
    const int c = BIDX() - ((int)gridDim.x - 64);
    if (c < 0) return;
    g8::DenseSched S; S.init((const bf16_t*)(ws + WS_MEMN), (const bf16_t*)(ws + WS_W_KV), MROWS, 2 * DM, DM, 64, c);
    g8::EpiBf16 E{(bf16_t*)(ws + WS_KV), 2 * DM};
    g8::gemm8(lds, DM, DM, S, E);
}

DEVI void conv8_pos(const DP& p, int l, const bf16_t* proj, int b, int sp, int chan0, float (&out)[8]) {
    float a[8];
    const float* cb = p.in(10) + l * 1024 + chan0;
#pragma unroll
    for (int i = 0; i < 8; ++i) a[i] = cb[i];
#pragma unroll
    for (int j = 0; j < 4; ++j) {
        const int s2 = sp - 3 + j;
        if (s2 >= 0) {
            const u32x4 w = *(const u32x4*)(proj + ((size_t)b * S + s2) * NPROJ + C_XBC + chan0);
            const float* cw = p.in(9) + ((size_t)l * 4 + j) * 1024 + chan0;
            a[0] += cw[0] * bflo(w.x); a[1] += cw[1] * bfhi(w.x); a[2] += cw[2] * bflo(w.y); a[3] += cw[3] * bfhi(w.y);
            a[4] += cw[4] * bflo(w.z); a[5] += cw[5] * bfhi(w.z); a[6] += cw[6] * bflo(w.w); a[7] += cw[7] * bfhi(w.w);
        }
    }
#pragma unroll
    for (int i = 0; i < 8; ++i) out[i] = silu_f(a[i]);
}
DEVI u32x4 pack8(const float (&v)[8]) { u32x4 w; w.x = cvt_pk(v[0], v[1]); w.y = cvt_pk(v[2], v[3]); w.z = cvt_pk(v[4], v[5]); w.w = cvt_pk(v[6], v[7]); return w; }


DEVI void phase_post(const DP& p, int l) {
    const int tid = TIDX(), wid = tid >> 6, lane = tid & 63;
    unsigned char* ws = p.ws();
    bf16_t* proj = (bf16_t*)(ws + WS_PROJ);
    const int sl = lane >> 2, qt = lane & 3, type = sl >> 2, head = sl & 3;
    const int col0 = (type < 2 ? type * 256 : 768 + (type - 2) * 256) + head * 64 + qt * 16;
    const float *gq0 = p.in(5), *gq1 = p.in(6), *gq2 = p.in(7), *gq3 = p.in(8);
    asm volatile("" : "+s"(gq0), "+s"(gq1), "+s"(gq2), "+s"(gq3));
    const float* gain = (type == 0 ? gq0 : type == 1 ? gq1 : type == 2 ? gq2 : gq3) + l * 64 + qt * 16;
    float gv[16];
#pragma unroll
    for (int i = 0; i < 16; ++i) gv[i] = gain[i];
    const float inv[8] = {1.000000000e+00f, 1.939227432e-01f, 3.760603070e-02f, 7.292664610e-03f, 1.414213562e-03f, 2.742481884e-04f, 5.318295734e-05f, 1.031338525e-05f};
    for (int row = BIDX() * 8 + wid; row < T; row += gridDim.x * 8) {
        bf16_t* ptr = proj + (size_t)row * NPROJ + col0;
        const u32x4 w0 = *(const u32x4*)ptr, w1 = *(const u32x4*)(ptr + 8);
        float v[16];
        v[0] = bflo(w0.x); v[1] = bfhi(w0.x); v[2] = bflo(w0.y); v[3] = bfhi(w0.y); v[4] = bflo(w0.z); v[5] = bfhi(w0.z); v[6] = bflo(w0.w); v[7] = bfhi(w0.w);
        v[8] = bflo(w1.x); v[9] = bfhi(w1.x); v[10] = bflo(w1.y); v[11] = bfhi(w1.y); v[12] = bflo(w1.z); v[13] = bfhi(w1.z); v[14] = bflo(w1.w); v[15] = bfhi(w1.w);
        float ss = 0.f;
#pragma unroll
        for (int i = 0; i < 16; ++i) ss += v[i] * v[i];
        ss += __shfl_xor(ss, 1); ss += __shfl_xor(ss, 2);
        const float rstd = rsqrtf(ss * (1.0f / 64.0f) + EPS);
#pragma unroll
        for (int i = 0; i < 16; ++i) v[i] = v[i] * rstd * gv[i];
        if (type >= 2 && qt == 0) {
            const float pos = (float)(row & (S - 1));
#pragma unroll
            for (int i = 0; i < 8; ++i) { float sn, cs; sincosf(pos * inv[i], &sn, &cs);
                const float a = v[i], b = v[i + 8]; v[i] = a * cs - b * sn; v[i + 8] = b * cs + a * sn; }
        }
        u32x4 o0, o1;
        o0.x = cvt_pk(v[0], v[1]); o0.y = cvt_pk(v[2], v[3]); o0.z = cvt_pk(v[4], v[5]); o0.w = cvt_pk(v[6], v[7]);
        o1.x = cvt_pk(v[8], v[9]); o1.y = cvt_pk(v[10], v[11]); o1.z = cvt_pk(v[12], v[13]); o1.w = cvt_pk(v[14], v[15]);
        *(u32x4*)ptr = o0; *(u32x4*)(ptr + 8) = o1;
    }
    bf16_t* xc = (bf16_t*)(ws + WS_XC);
    for (int item = BIDX() * NTHR + tid; item < T * 128; item += gridDim.x * NTHR) {
        const int t = item >> 7, c8 = (item & 127) * 8;
        float v[8]; conv8_pos(p, l, proj, t / S, t % S, c8, v);
        *(u32x4*)(xc + (size_t)t * 1024 + c8) = pack8(v);
    }
}
DEVI void phase_knorm(const DP& p, int l) {
    const int tid = TIDX(), wid = tid >> 6, lane = tid & 63;
    unsigned char* ws = p.ws();
    bf16_t* kv = (bf16_t*)(ws + WS_KV);
    const float* kg = p.in(21) + l * 256 + (lane & 15) * 16;
    float kgv[16];
#pragma unroll
    for (int i = 0; i < 16; ++i) kgv[i] = kg[i];
    for (int row = BIDX() * 8 + wid; row < MROWS; row += gridDim.x * 8) {
        bf16_t* ptr = kv + (size_t)row * 2 * DM + lane * 16;
        const u32x4 w0 = *(const u32x4*)ptr, w1 = *(const u32x4*)(ptr + 8);
        float v[16];
        v[0] = bflo(w0.x); v[1] = bfhi(w0.x); v[2] = bflo(w0.y); v[3] = bfhi(w0.y); v[4] = bflo(w0.z); v[5] = bfhi(w0.z); v[6] = bflo(w0.w); v[7] = bfhi(w0.w);
        v[8] = bflo(w1.x); v[9] = bfhi(w1.x); v[10] = bflo(w1.y); v[11] = bfhi(w1.y); v[12] = bflo(w1.z); v[13] = bfhi(w1.z); v[14] = bflo(w1.w); v[15] = bfhi(w1.w);
        float ss = 0.f;
#pragma unroll
        for (int i = 0; i < 16; ++i) ss += v[i] * v[i];
        ss += __shfl_xor(ss, 1); ss += __shfl_xor(ss, 2); ss += __shfl_xor(ss, 4); ss += __shfl_xor(ss, 8);
        const float rstd = rsqrtf(ss * (1.0f / 256.0f) + EPS);
#pragma unroll
        for (int i = 0; i < 16; ++i) v[i] = v[i] * rstd * kgv[i];
        u32x4 o0, o1;
        o0.x = cvt_pk(v[0], v[1]); o0.y = cvt_pk(v[2], v[3]); o0.z = cvt_pk(v[4], v[5]); o0.w = cvt_pk(v[6], v[7]);
        o1.x = cvt_pk(v[8], v[9]); o1.y = cvt_pk(v[10], v[11]); o1.z = cvt_pk(v[12], v[13]); o1.w = cvt_pk(v[14], v[15]);
        *(u32x4*)ptr = o0; *(u32x4*)(ptr + 8) = o1;
    }
}
constexpr float LOG2E = 1.4426950408889634f;
template <int DH> struct AttnLds { static constexpr int KST = DH + 8; static constexpr int TILE = 64 * KST; static constexpr int BYTES = 4 * TILE * 2; };
DEVI float xor16_max(float v) { return fmaxf(v, __shfl_xor(v, 16)); }
DEVI float xor32_max(float v) { auto r = __builtin_amdgcn_permlane32_swap(__float_as_uint(v), __float_as_uint(v), false, false); return fmaxf(__uint_as_float(r[0]), __uint_as_float(r[1])); }
DEVI float xor32_sum(float v) { auto r = __builtin_amdgcn_permlane32_swap(__float_as_uint(v), __float_as_uint(v), false, false); return __uint_as_float(r[0]) + __uint_as_float(r[1]); }
template <int DH, int MODE>
DEVI void attn_task(const bf16_t* __restrict__ Qb, int ldq, int qtok0, int qstep,
                    const bf16_t* __restrict__ Kb, const bf16_t* __restrict__ Vb, int ldk, int ktok0, int kstep,
                    int p0, int kt_lo, int kt_hi, float scale,
                    const float* __restrict__ cum, const float* __restrict__ qgain,
                    bf16_t* Ob, int ldo, float* Of, float* Om, float* Ol, char* lds) {
    constexpr int KST = AttnLds<DH>::KST, TILE = AttnLds<DH>::TILE, NKK = DH / 32, ND = DH / 16, NCH = (64 * DH / 8) / NTHR;
    const int tid = TIDX(), wid = tid >> 6, lane = tid & 63, r16 = lane & 15, g4 = lane >> 4;
    bf16_t* Ks = (bf16_t*)lds;
    bf16_t* Vs = Ks + 2 * TILE;
    const float c2 = scale * LOG2E;
    bf16x8 qf[NKK];
    {
        const bf16_t* qp = Qb + (size_t)(qtok0 + (p0 + wid * 16 + r16) * qstep) * ldq + g4 * 8;
#pragma unroll
        for (int kk = 0; kk < NKK; ++kk) qf[kk] = *(const bf16x8*)(qp + kk * 32);
    }
    if (MODE == 2) {
        float ss = 0.f;
#pragma unroll
        for (int kk = 0; kk < NKK; ++kk)
#pragma unroll
            for (int j = 0; j < 8; ++j) { const float v = bf2f((bf16_t)qf[kk][j]); ss += v * v; }
        ss += __shfl_xor(ss, 16); ss += __shfl_xor(ss, 32);
        const float rstd = rsqrtf(ss * (1.0f / DH) + EPS);
#pragma unroll
        for (int kk = 0; kk < NKK; ++kk)
#pragma unroll
            for (int j = 0; j < 8; ++j) { const float v = bf2f((bf16_t)qf[kk][j]) * rstd * qgain[kk * 32 + g4 * 8 + j]; qf[kk][j] = (short)f2bf(v); }
    }
    const int qpos = p0 + wid * 16 + r16;
    float m_ = -1.0e30f, l_ = 0.f;
    const float cq = (MODE == 0) ? cum[qpos] * LOG2E : 0.f;
    f32x4 o[ND];
#pragma unroll
    for (int n = 0; n < ND; ++n) o[n] = (f32x4){0.f, 0.f, 0.f, 0.f};
    u32x4 rk[NCH], rv[NCH];
    auto gload = [&](int kt) {
#pragma unroll
        for (int i = 0; i < NCH; ++i) { const int c = tid + i * NTHR, key = c / (DH / 8), dc = c % (DH / 8);
            const size_t tok = (size_t)(ktok0 + (kt * 64 + key) * kstep);
            rk[i] = *(const u32x4*)(Kb + tok * ldk + dc * 8); rv[i] = *(const u32x4*)(Vb + tok * ldk + dc * 8); }
    };
    gload(kt_lo);
    __syncthreads();
    int buf = 0;
    for (int kt = kt_lo; kt < kt_hi; ++kt, buf ^= 1) {
        bf16_t* Kt = Ks + buf * TILE;
        bf16_t* Vt = Vs + buf * TILE;
#pragma unroll
        for (int i = 0; i < NCH; ++i) { const int c = tid + i * NTHR, key = c / (DH / 8), dc = c % (DH / 8);
            *(u32x4*)(Kt + key * KST + dc * 8) = rk[i]; *(u32x4*)(Vt + key * KST + dc * 8) = rv[i]; }
        __syncthreads();
        if (kt + 1 < kt_hi) gload(kt + 1);
        f32x4 s[4];
#pragma unroll
        for (int n = 0; n < 4; ++n) {
            s[n] = (f32x4){0.f, 0.f, 0.f, 0.f};
#pragma unroll
            for (int kk = 0; kk < NKK; ++kk) {
                const bf16x8 kf = *(const bf16x8*)(Kt + (n * 16 + r16) * KST + kk * 32 + g4 * 8);
                s[n] = MFMA16(kf, qf[kk], s[n]);
            }
            if (DH > 64) __builtin_amdgcn_sched_barrier(0);
        }
        float mx = -INFINITY;
#pragma unroll
        for (int n = 0; n < 4; ++n) {
            f32x4 ck = (f32x4){0.f, 0.f, 0.f, 0.f};
            if (MODE == 0) ck = *(const f32x4*)(cum + kt * 64 + n * 16 + g4 * 4);
#pragma unroll
            for (int j = 0; j < 4; ++j) {
                const int kpos = kt * 64 + n * 16 + g4 * 4 + j;
                float t = s[n][j] * c2;
                if (MODE == 0) { t += cq - ck[j] * LOG2E; if (kpos > qpos) t = -INFINITY; }
                if (MODE == 1) { const int dd = qpos - kpos; if (dd < 0 || dd > 128) t = -INFINITY; }
                s[n][j] = t; mx = fmaxf(mx, t);
            }
        }
        mx = xor32_max(xor16_max(mx));
        const float mn = fmaxf(m_, mx);
        const float alpha = __builtin_amdgcn_exp2f(m_ - mn);
        float rs = 0.f;
#pragma unroll
        for (int n = 0; n < 4; ++n)
#pragma unroll
            for (int j = 0; j < 4; ++j) { const float pv = __builtin_amdgcn_exp2f(s[n][j] - mn); s[n][j] = pv; rs += pv; }
        rs += __shfl_xor(rs, 16); rs = xor32_sum(rs);
        l_ = l_ * alpha + rs; m_ = mn;
#pragma unroll
        for (int n = 0; n < ND; ++n) o[n] *= alpha;
#pragma unroll
        for (int kk = 0; kk < 2; ++kk) {
            bf16x8 pb;
            { const unsigned w0 = cvt_pk(s[2 * kk][0], s[2 * kk][1]), w1 = cvt_pk(s[2 * kk][2], s[2 * kk][3]), w2 = cvt_pk(s[2 * kk + 1][0], s[2 * kk + 1][1]), w3 = cvt_pk(s[2 * kk + 1][2], s[2 * kk + 1][3]);
              u32x4 w; w.x = w0; w.y = w1; w.z = w2; w.w = w3; pb = __builtin_bit_cast(bf16x8, w); }
            const bf16_t* vb = Vt + (kk * 32 + 4 * g4 + (r16 >> 2)) * KST + 4 * (r16 & 3);
#pragma unroll
            for (int n = 0; n < ND; ++n) {
                const s16x4 lo = tr_read(vb + n * 16), hi = tr_read(vb + 16 * KST + n * 16);
                bf16x8 vf; vf[0] = lo[0]; vf[1] = lo[1]; vf[2] = lo[2]; vf[3] = lo[3]; vf[4] = hi[0]; vf[5] = hi[1]; vf[6] = hi[2]; vf[7] = hi[3];
                o[n] = MFMA16(vf, pb, o[n]);
                if (DH > 64 && (n & 3) == 3) __builtin_amdgcn_sched_barrier(0);
            }
        }
    }
    const size_t tok = (size_t)(qtok0 + qpos * qstep);
    if (MODE == 1) {
#pragma unroll
        for (int n = 0; n < ND; ++n) *(f32x4*)(Of + tok * 256 + n * 16 + g4 * 4) = o[n];
        if (g4 == 0) { Om[tok * 4] = m_; Ol[tok * 4] = l_; }
    } else {
        const float inv = 1.0f / l_;
#pragma unroll
        for (int n = 0; n < ND; ++n) { u32x2 w; w.x = cvt_pk(o[n][0] * inv, o[n][1] * inv); w.y = cvt_pk(o[n][2] * inv, o[n][3] * inv);
            *(u32x2*)(Ob + tok * ldo + n * 16 + g4 * 4) = w; }
    }
}

DEVI void ssd_acs(const DP& p, int l, int b, int c, int g, float* acs, float* dts) {
    const int tid = TIDX(), wid = tid >> 6, lane = tid & 63;
    if (wid < 4) {
        const int head = g * 4 + wid;
        const float* dtv = (const float*)(p.ws() + WS_DTV);
        const float A = -__expf(p.in(12)[l * 8 + head]);
        const size_t t0 = (size_t)b * S + c * 128 + 2 * lane;
        const float d0 = dtv[t0 * 8 + head], d1 = dtv[(t0 + 1) * 8 + head];
        const float a0 = d0 * A, a1 = d1 * A;
        float incl = a0 + a1;
#pragma unroll
        for (int d = 1; d < 64; d <<= 1) { const float t = __shfl_up(incl, d); if (lane >= d) incl += t; }
        const float ex = incl - (a0 + a1);
        acs[wid * 128 + 2 * lane] = ex + a0; acs[wid * 128 + 2 * lane + 1] = ex + a0 + a1;
        dts[wid * 128 + 2 * lane] = d0; dts[wid * 128 + 2 * lane + 1] = d1;
    }
}
DEVI void conv8_chan(const DP& p, int l, const bf16_t* proj, int b, int c, int chan, int l0, float (&out)[8]) {
    const float* cw = p.in(9) + (size_t)l * 4 * 1024 + chan;
    const float w0 = cw[0], w1 = cw[1024], w2 = cw[2048], w3 = cw[3072], cb = p.in(10)[l * 1024 + chan];
    float v[11];
    const int sbase = c * 128 + l0 - 3;
#pragma unroll
    for (int i = 0; i < 11; ++i) { const int sp = sbase + i; v[i] = sp >= 0 ? bf2f(proj[((size_t)b * S + sp) * NPROJ + C_XBC + chan]) : 0.f; }
#pragma unroll
    for (int i = 0; i < 8; ++i) out[i] = silu_f(cb + w0 * v[i] + w1 * v[i + 1] + w2 * v[i + 2] + w3 * v[i + 3]);
}
constexpr int SST = 136;
constexpr int XST4 = 264;
DEVI void ssd_states_task(const DP& p, int l, int b, int c, int g, char* lds) {
    const int tid = TIDX(), wid = tid >> 6, lane = tid & 63, r16 = lane & 15, g4 = lane >> 4;
    const bf16_t* xc = (const bf16_t*)(p.ws() + WS_XC);
    bf16_t* Bn = (bf16_t*)lds;
    bf16_t* Xn = Bn + 128 * SST;
    float* acs = (float*)(Xn + 128 * XST4);
    float* dts = acs + 512;
    __syncthreads();
    ssd_acs(p, l, b, c, g, acs, dts);
    __syncthreads();
    if (tid < 4) ((float*)(p.ws() + WS_DECAY))[((size_t)b * 16 + c) * 8 + g * 4 + tid] = __expf(acs[tid * 128 + 127]);
    const size_t tok0 = (size_t)b * S + c * 128;
    for (int it = tid; it < 2048; it += NTHR) {
        const int ll = it >> 4, nc = (it & 15) * 8;
        *(u32x4*)(Bn + ll * SST + nc) = *(const u32x4*)(xc + (tok0 + ll) * 1024 + 512 + g * 128 + nc);
    }
    for (int it = tid; it < 4096; it += NTHR) {
        const int ll = it >> 5, ch = (it & 31) * 8, hl = ch >> 6;
        const u32x4 w = *(const u32x4*)(xc + (tok0 + ll) * 1024 + g * 256 + ch);
        const float sc = dts[hl * 128 + ll] * __expf(acs[hl * 128 + 127] - acs[hl * 128 + ll]);
        u32x4 o; o.x = cvt_pk(bflo(w.x) * sc, bfhi(w.x) * sc); o.y = cvt_pk(bflo(w.y) * sc, bfhi(w.y) * sc); o.z = cvt_pk(bflo(w.z) * sc, bfhi(w.z) * sc); o.w = cvt_pk(bflo(w.w) * sc, bfhi(w.w) * sc);
        *(u32x4*)(Xn + ll * XST4 + ch) = o;
    }
    __syncthreads();
    const int hl = wid >> 1, nh = wid & 1;
    f32x4 acc[4][4];
#pragma unroll
    for (int m = 0; m < 4; ++m)
#pragma unroll
        for (int n = 0; n < 4; ++n) acc[m][n] = (f32x4){0.f, 0.f, 0.f, 0.f};
#pragma unroll
    for (int kk = 0; kk < 4; ++kk) {
        bf16x8 af[4], bfr[4];
        const int lrow = kk * 32 + 8 * g4 + (r16 >> 2), cq = 4 * (r16 & 3);
#pragma unroll
        for (int m = 0; m < 4; ++m) { const bf16_t* a = Xn + lrow * XST4 + hl * 64 + m * 16 + cq; const s16x4 lo = tr_read(a), hi = tr_read(a + 4 * XST4);
            af[m][0] = lo[0]; af[m][1] = lo[1]; af[m][2] = lo[2]; af[m][3] = lo[3]; af[m][4] = hi[0]; af[m][5] = hi[1]; af[m][6] = hi[2]; af[m][7] = hi[3]; }
#pragma unroll
        for (int n = 0; n < 4; ++n) { const bf16_t* a = Bn + lrow * SST + nh * 64 + n * 16 + cq; const s16x4 lo = tr_read(a), hi = tr_read(a + 4 * SST);
            bfr[n][0] = lo[0]; bfr[n][1] = lo[1]; bfr[n][2] = lo[2]; bfr[n][3] = lo[3]; bfr[n][4] = hi[0]; bfr[n][5] = hi[1]; bfr[n][6] = hi[2]; bfr[n][7] = hi[3]; }
#pragma unroll
        for (int m = 0; m < 4; ++m)
#pragma unroll
            for (int n = 0; n < 4; ++n) acc[m][n] = MFMA16(bfr[n], af[m], acc[m][n]);
    }
    float* st = (float*)(p.ws() + WS_SSTATE) + (((size_t)b * 16 + c) * 8 + g * 4 + hl) * 8192;
#pragma unroll
    for (int m = 0; m < 4; ++m)
#pragma unroll
        for (int n = 0; n < 4; ++n) *(f32x4*)(st + (m * 16 + r16) * 128 + nh * 64 + n * 16 + g4 * 4) = acc[m][n];
}
DEVI void phase_ssd_scan(const DP& p) {
    const float* st = (const float*)(p.ws() + WS_SSTATE);
    bf16_t* hin = (bf16_t*)(p.ws() + WS_HIN);
    const float* decay = (const float*)(p.ws() + WS_DECAY);
    const int total = NB * 8 * 2048;
    for (int i = BIDX() * NTHR + TIDX(); i < total; i += gridDim.x * NTHR) {
        const int e4 = i & 2047, head = (i >> 11) & 7, b = i >> 14;
        f32x4 h = (f32x4){0.f, 0.f, 0.f, 0.f};
        for (int c = 0; c < 16; ++c) {
            const size_t off = (((size_t)b * 16 + c) * 8 + head) * 8192 + e4 * 4;
            u32x2 w; w.x = cvt_pk(h[0], h[1]); w.y = cvt_pk(h[2], h[3]);
            *(u32x2*)(hin + off) = w;
            const f32x4 s = *(const f32x4*)(st + off);
            const float d = decay[((size_t)b * 16 + c) * 8 + head];
            h = h * d + s;
        }
    }
}
constexpr int XST1 = 72;
DEVI void ssd_out_task(const DP& p, int l, int b, int c, int g, char* lds) {
    const int tid = TIDX(), wid = tid >> 6, lane = tid & 63, r16 = lane & 15, g4 = lane >> 4;
    const bf16_t* proj = (const bf16_t*)(p.ws() + WS_PROJ);
    const bf16_t* xc = (const bf16_t*)(p.ws() + WS_XC);
    bf16_t* Cs = (bf16_t*)lds;
    bf16_t* Bs = Cs + 128 * SST;
    bf16_t* Xn = Bs + 128 * SST;
    bf16_t* Hs = Xn + 128 * XST1;
    bf16_t* Mw = Hs + 64 * SST + wid * 16 * SST;
    float* acs = (float*)(Hs + 64 * SST + 8 * 16 * SST);
    float* dts = acs + 512;
    const int lrow = wid * 16 + r16;
    const size_t tok0 = (size_t)b * S + c * 128, tok = tok0 + lrow;
    bf16_t* mix = (bf16_t*)(p.ws() + WS_MIX);
    float ssq = 0.f;
    __syncthreads();
    ssd_acs(p, l, b, c, g, acs, dts);
    for (int it = tid; it < 2048; it += NTHR) {
        const int ll = it >> 4, nc = (it & 15) * 8;
        *(u32x4*)(Cs + ll * SST + nc) = *(const u32x4*)(xc + (tok0 + ll) * 1024 + 768 + g * 128 + nc);
        *(u32x4*)(Bs + ll * SST + nc) = *(const u32x4*)(xc + (tok0 + ll) * 1024 + 512 + g * 128 + nc);
    }
    __syncthreads();
    bf16x8 cfr[4];
#pragma unroll
    for (int kk = 0; kk < 4; ++kk) cfr[kk] = *(const bf16x8*)(Cs + lrow * SST + kk * 32 + g4 * 8);
    f32x4 cb[8];
#pragma unroll
    for (int st = 0; st < 8; ++st) {
        cb[st] = (f32x4){0.f, 0.f, 0.f, 0.f};
#pragma unroll
        for (int kk = 0; kk < 4; ++kk) {
            const bf16x8 bfr = *(const bf16x8*)(Bs + (st * 16 + r16) * SST + kk * 32 + g4 * 8);
            cb[st] = MFMA16(bfr, cfr[kk], cb[st]);
        }
    }
    for (int hl = 0; hl < 4; ++hl) {
        const int head = g * 4 + hl;
        __syncthreads();
        for (int it = tid; it < 1024; it += NTHR) {
            const int ss = it >> 3, pc8 = (it & 7) * 8;
            *(u32x4*)(Xn + ss * XST1 + pc8) = *(const u32x4*)(xc + (tok0 + ss) * 1024 + head * 64 + pc8);
            const bf16_t* hsrc = (const bf16_t*)(p.ws() + WS_HIN) + (((size_t)b * 16 + c) * 8 + head) * 8192 + (size_t)it * 8;
            *(u32x4*)(Hs + (it >> 4) * SST + (it & 15) * 8) = *(const u32x4*)hsrc;
        }
        __syncthreads();
        const float al = acs[hl * 128 + lrow];
#pragma unroll
        for (int st = 0; st < 8; ++st) {
            float mv[4];
#pragma unroll
            for (int j = 0; j < 4; ++j) { const int sidx = st * 16 + g4 * 4 + j;
                mv[j] = (sidx <= lrow) ? cb[st][j] * __expf(al - acs[hl * 128 + sidx]) * dts[hl * 128 + sidx] : 0.f; }
            u32x2 w; w.x = cvt_pk(mv[0], mv[1]); w.y = cvt_pk(mv[2], mv[3]);
            *(u32x2*)(Mw + r16 * SST + st * 16 + g4 * 4) = w;
        }
        __builtin_amdgcn_wave_barrier();
        asm volatile("s_waitcnt lgkmcnt(0)" ::: "memory");
        f32x4 yd[4], yo[4];
#pragma unroll
        for (int pt = 0; pt < 4; ++pt) { yd[pt] = (f32x4){0.f, 0.f, 0.f, 0.f}; yo[pt] = (f32x4){0.f, 0.f, 0.f, 0.f}; }
#pragma unroll
        for (int kk = 0; kk < 4; ++kk) {
            const bf16x8 mf = *(const bf16x8*)(Mw + r16 * SST + kk * 32 + g4 * 8);
            const bf16_t* xa = Xn + (kk * 32 + 8 * g4 + (r16 >> 2)) * XST1 + 4 * (r16 & 3);
#pragma unroll
            for (int pt = 0; pt < 4; ++pt) {
                const s16x4 lo = tr_read(xa + pt * 16), hi = tr_read(xa + 4 * XST1 + pt * 16);
                bf16x8 xf; xf[0] = lo[0]; xf[1] = lo[1]; xf[2] = lo[2]; xf[3] = lo[3]; xf[4] = hi[0]; xf[5] = hi[1]; xf[6] = hi[2]; xf[7] = hi[3];
                yd[pt] = MFMA16(xf, mf, yd[pt]);
                const bf16x8 hf = *(const bf16x8*)(Hs + (pt * 16 + r16) * SST + kk * 32 + g4 * 8);
                yo[pt] = MFMA16(hf, cfr[kk], yo[pt]);
            }
        }
        __builtin_amdgcn_wave_barrier();
        const float el = __expf(al), Dh = p.in(13)[l * 8 + head];
#pragma unroll
        for (int pt = 0; pt < 4; ++pt) {
            const int pc = pt * 16 + g4 * 4;
            const u32x2 zw = *(const u32x2*)(proj + tok * NPROJ + C_Z + head * 64 + pc);
            const u32x2 xw = *(const u32x2*)(Xn + lrow * XST1 + pc);
            const float zz[4] = {bflo(zw.x), bfhi(zw.x), bflo(zw.y), bfhi(zw.y)};
            const float xx[4] = {bflo(xw.x), bfhi(xw.x), bflo(xw.y), bfhi(xw.y)};
            float gv[4];
#pragma unroll
            for (int j = 0; j < 4; ++j) { const float yv = yd[pt][j] + el * yo[pt][j] + Dh * xx[j]; gv[j] = yv * silu_f(zz[j]); ssq += gv[j] * gv[j]; }
            u32x2 w; w.x = cvt_pk(gv[0], gv[1]); w.y = cvt_pk(gv[2], gv[3]);
            *(u32x2*)(mix + tok * DM + 512 + head * 64 + pc) = w;
        }
    }
    ssq += __shfl_xor(ssq, 16); ssq += __shfl_xor(ssq, 32);
    if (g4 == 0) ((float*)(p.ws() + WS_SSQ))[tok * 2 + g] = ssq;
}
constexpr int N_FOX = 512, N_S1 = 256, N_DIL = 1536;
DEVI void phase_mix1(const DP& p, int l, char* lds) {
    unsigned char* ws = p.ws();
    kv_gemm(p, lds);
    const bf16_t* proj = (const bf16_t*)(ws + WS_PROJ);
    bf16_t* mix = (bf16_t*)(ws + WS_MIX);
    for (int t = BIDX(); t < N_FOX + N_S1 + N_DIL; t += gridDim.x) {
        if (t < N_FOX) {
            const int bh = t & 31, k = t >> 5;
            const int qb = k < 8 ? 15 - k : k - 8;
            const int b = bh >> 2, h = bh & 3;
            const float* cum = (const float*)(ws + WS_CUMF) + (size_t)bh * S;
            attn_task<64, 0>(proj + C_FQ + h * 64, NPROJ, b * S, 1, proj + C_FK + h * 64, proj + C_FV + h * 64, NPROJ, b * S, 1,
                             qb * 128, 0, 2 * qb + 2, 0.125f, cum, nullptr, mix + h * 64, DM, nullptr, nullptr, nullptr, lds);
        } else if (t < N_FOX + N_S1) {
            const int u = t - N_FOX, g = u & 1, c = (u >> 1) & 15, b = u >> 5;
            ssd_states_task(p, l, b, c, g, lds);
        } else {
            const int u = t - N_FOX - N_S1, bh = u & 31, v = u >> 5;
            const int b = bh >> 2, h = bh & 3;
            int br, dil, r, pb;
            if (v < 16) { br = 0; dil = 1; r = 0; pb = v; }
            else if (v < 32) { br = 1; dil = 4; r = (v - 16) & 3; pb = (v - 16) >> 2; }
            else { br = 2; dil = 16; r = v - 32; pb = 0; }
            float* Of = (float*)(ws + WS_DILO) + (size_t)br * T * 256 + h * 64;
            float* Om = (float*)(ws + WS_DILM) + (size_t)br * T * 4 + h;
            float* Ol = (float*)(ws + WS_DILL) + (size_t)br * T * 4 + h;
            const int klo = pb > 0 ? 2 * pb - 2 : 0;
            attn_task<64, 1>(proj + C_DQ + h * 64, NPROJ, b * S + r, dil, proj + C_DK + h * 64, proj + C_DV + h * 64, NPROJ, b * S + r, dil,
                             pb * 128, klo, 2 * pb + 2, 0.125f, nullptr, nullptr, nullptr, 0, Of, Om, Ol, lds);
        }
    }
}
DEVI void phase_mix3(const DP& p, int l, char* lds) {
    unsigned char* ws = p.ws();
    for (int t = BIDX(); t < NB * 16 * 2; t += gridDim.x) ssd_out_task(p, l, t >> 5, (t >> 1) & 15, t & 1, lds);
    const int tid = TIDX(), wid = tid >> 6, lane = tid & 63, head = lane >> 4, d4 = (lane & 15) * 4;
    const float* Of = (const float*)(ws + WS_DILO);
    const float* Om = (const float*)(ws + WS_DILM);
    const float* Ol = (const float*)(ws + WS_DILL);
    bf16_t* mix = (bf16_t*)(ws + WS_MIX);
    for (int row = BIDX() * 8 + wid; row < T; row += gridDim.x * 8) {
        float m[3], lsum[3];
#pragma unroll
        for (int br = 0; br < 3; ++br) { m[br] = Om[((size_t)br * T + row) * 4 + head]; lsum[br] = Ol[((size_t)br * T + row) * 4 + head]; }
        const float M = fmaxf(m[0], fmaxf(m[1], m[2]));
        f32x4 num = (f32x4){0.f, 0.f, 0.f, 0.f}; float den = 0.f;
#pragma unroll
        for (int br = 0; br < 3; ++br) {
            const float w = __builtin_amdgcn_exp2f(m[br] - M);
            const f32x4 o = *(const f32x4*)(Of + ((size_t)br * T + row) * 256 + head * 64 + d4);
            num += o * w; den += w * lsum[br];
        }
        const float inv = 1.0f / den;
        u32x2 w; w.x = cvt_pk(num[0] * inv, num[1] * inv); w.y = cvt_pk(num[2] * inv, num[3] * inv);
        *(u32x2*)(mix + (size_t)row * DM + 256 + head * 64 + d4) = w;
    }
}
DEVI void phase_xattn(const DP& p, int l, char* lds) {
    unsigned char* ws = p.ws();
    const bf16_t* qbuf = (const bf16_t*)(ws + WS_QBUF);
    const bf16_t* kv = (const bf16_t*)(ws + WS_KV);
    bf16_t* obuf = (bf16_t*)(ws + WS_OBUF);
    for (int t = BIDX(); t < NB * 4 * 16; t += gridDim.x) {
        const int qb = t & 15, h = (t >> 4) & 3, b = t >> 6;
        attn_task<256, 2>(qbuf + h * 256, DM, b * S, 1, kv + h * 256, kv + DM + h * 256, 2 * DM, b * MEMLEN, 1,
                          qb * 128, 0, 4, 0.0625f, nullptr, p.in(20) + l * 256, obuf + h * 256, DM, nullptr, nullptr, nullptr, lds);
    }
}
namespace g8 {
template <bool GATHER_> struct MoeSched {
    static constexpr bool GATHER = GATHER_;
    const int* cnt; const int* list; const char* Abase; const char* Bbase; size_t bstride; int K, G;
    int e, ubase, tbase, u;
    DEVI void init(const int* cnt_, const int* list_, const void* A_, const void* B_, size_t bstride_, int K_, int G_, int c_) {
        cnt = cnt_; list = list_; Abase = (const char*)A_; Bbase = (const char*)B_; bstride = bstride_; K = K_; G = G_; e = 0; ubase = 0; tbase = 0; u = c_; }
    DEVI bool next(UnitU& o) {
        while (e < NEXP) {
            const int ce = cnt[e], nte = (ce + BM - 1) / BM, nun = nte * 4;
            if (u < ubase + nun) {
                const int lu = u - ubase, pm = lu >> 2, pn = lu & 3;
                o.i0 = tbase + pm; o.i1 = pn; o.i2 = e * (2 * T) + pm * BM; o.i3 = ce - pm * BM; o.flags = 3;
                o.A = GATHER ? Abase : Abase + (size_t)(tbase + pm) * BM * K * 2;
                o.B = Bbase + (size_t)e * bstride + (size_t)pn * BM * K * 2;
                u += G; return true;
            }
            ubase += nun; tbase += nte; ++e;
        }
        return false;
    }
    DEVI void lane_va(const UnitU& o, int R0, int C0, int R1, int C1, unsigned& v00, unsigned& v01, unsigned& v10, unsigned& v11) const {
        if (GATHER) {
            const int nv = o.i3; const int* ent = list + o.i2;
            const int t00 = (ent[R0 < nv ? R0 : 0] & 0xffff) >> 1, t01 = (ent[R1 < nv ? R1 : 0] & 0xffff) >> 1, t10 = (ent[R0 + HALF < nv ? R0 + HALF : 0] & 0xffff) >> 1, t11 = (ent[R1 + HALF < nv ? R1 + HALF : 0] & 0xffff) >> 1;
            v00 = (unsigned)(t00 * K + C0) * 2u; v01 = (unsigned)(t01 * K + C1) * 2u; v10 = (unsigned)(t10 * K + C0) * 2u; v11 = (unsigned)(t11 * K + C1) * 2u;
        } else {
            v00 = (unsigned)(R0 * K + C0) * 2u; v01 = (unsigned)(R1 * K + C1) * 2u; v10 = v00 + (unsigned)(HALF * K * 2); v11 = v01 + (unsigned)(HALF * K * 2);
        }
    }
};
struct EpiSwiglu { static constexpr bool PERM = false; bf16_t* act;
    DEVI void mid(f32x4 (&)[2][2][4][2], const UnitU&, int, int, int, int) const {}
    DEVI void operator()(const f32x4 (&acc)[2][2][4][2], const UnitU& u, int wr, int wc, int fr, int fq) const {
        const int nv = u.i3;
#pragma unroll
        for (int ai = 0; ai < 2; ++ai)
#pragma unroll
            for (int m = 0; m < 4; ++m) {
                const int r = ai * HALF + wr * 64 + m * 16 + fr;
                if (r < nv) {
                    bf16_t* rowp = act + (size_t)(u.i0 * BM + r) * EFF + u.i1 * 128 + wc * 16 + 4 * fq;
#pragma unroll
                    for (int bj = 0; bj < 2; ++bj) { const f32x4 x1 = acc[ai][bj][m][0], x3 = acc[ai][bj][m][1];
                        u32x2 w; w.x = cvt_pk(silu_f(x1[0]) * x3[0], silu_f(x1[1]) * x3[1]); w.y = cvt_pk(silu_f(x1[2]) * x3[2], silu_f(x1[3]) * x3[3]);
                        *(u32x2*)(rowp + bj * 64) = w; }
                }
            }
    } };
struct EpiMoeOut { static constexpr bool PERM = true; bf16_t* y; const int* list;
    DEVI void mid(f32x4 (&)[2][2][4][2], const UnitU&, int, int, int, int) const {}
    DEVI void operator()(const f32x4 (&acc)[2][2][4][2], const UnitU& u, int wr, int wc, int fr, int fq) const {
        const int nv = u.i3; const int* ent = list + u.i2;
#pragma unroll
        for (int ai = 0; ai < 2; ++ai)
#pragma unroll
            for (int m = 0; m < 4; ++m) {
                const int r = ai * HALF + wr * 64 + m * 16 + fr;
                if (r < nv) {
                    const unsigned en = (unsigned)ent[r]; const int a = (int)(en & 0xffffu); const float gt = __uint_as_float(en & 0xffff0000u);
                    bf16_t* rowp = y + (size_t)a * DM + u.i1 * BM + wc * 32 + 8 * fq;
#pragma unroll
                    for (int bj = 0; bj < 2; ++bj) { const f32x4 v0 = acc[ai][bj][m][0] * gt, v1 = acc[ai][bj][m][1] * gt;
                        u32x4 w; w.x = cvt_pk(v0[0], v0[1]); w.y = cvt_pk(v0[2], v0[3]); w.z = cvt_pk(v1[0], v1[1]); w.w = cvt_pk(v1[2], v1[3]);
                        *(u32x4*)(rowp + bj * HALF) = w; }
                }
            }
    } };
}
template <int WHICH>
DEVI void phase_moe(const DP& p, int l, char* lds) {
    unsigned char* ws = p.ws();
    const int* cnt = (const int*)(ws + WS_CNT) + l * 64;
    const int* list = (const int*)(ws + WS_LIST);
    if (WHICH == 0) {
        g8::MoeSched<true> S;
        S.init(cnt, list, ws + WS_H3, ws + WS_W_13, (size_t)1024 * DM * 2, DM, gridDim.x, BIDX());
        g8::EpiSwiglu E{(bf16_t*)(ws + WS_ACT)};
        g8::gemm8(lds, DM, DM, S, E);
    } else {
        g8::MoeSched<false> S;
        S.init(cnt, list, ws + WS_ACT, ws + WS_W_2, (size_t)DM * EFF * 2, EFF, gridDim.x, BIDX());
        g8::EpiMoeOut E{(bf16_t*)(ws + WS_YBUF), list};
        g8::gemm8(lds, EFF, EFF, S, E);
    }
}
DEVI void phase_final(const DP& p) {
    const int tid = TIDX(), wid = tid >> 6, lane = tid & 63;
    const bf16_t* ybuf = (const bf16_t*)(p.ws() + WS_YBUF);
    const bf16_t* h0 = (const bf16_t*)(p.ws() + WS_HBUF);
    float* out = p.out();
    for (int row = BIDX() * 8 + wid; row < T; row += gridDim.x * 8) {
        float x[16];
        load_row_bf16(h0 + (size_t)row * DM, x, lane);
        add_row_bf16_b(ybuf + (size_t)(2 * row) * DM, x, lane);
        add_row_bf16_b(ybuf + (size_t)(2 * row + 1) * DM, x, lane);
#pragma unroll
        for (int j = 0; j < 2; ++j) {
            *(float4*)(out + (size_t)row * DM + j * 512 + lane * 8) = make_float4(x[8 * j], x[8 * j + 1], x[8 * j + 2], x[8 * j + 3]);
            *(float4*)(out + (size_t)row * DM + j * 512 + lane * 8 + 4) = make_float4(x[8 * j + 4], x[8 * j + 5], x[8 * j + 6], x[8 * j + 7]);
        }
    }
}

#define XB_TMO      128
#define XB_XCNT(j)  (256  + 64 * (j))
#define XB_XSUB(j)  (1280 + 64 * (j))
#define XB_XGEN(j)  (2304 + 64 * (j))
#define XB_TOP      3328
#define XB_TOPGEN   3392
#define XCD_BAR_WORDS 3456
#define XB_SPIN_CAP (1u << 22)
DEVI unsigned xb_ld(unsigned* p)              { return __hip_atomic_load(p, __ATOMIC_RELAXED, __HIP_MEMORY_SCOPE_AGENT); }
DEVI unsigned xb_add(unsigned* p, unsigned v) { return __hip_atomic_fetch_add(p, v, __ATOMIC_RELAXED, __HIP_MEMORY_SCOPE_AGENT); }
DEVI unsigned xb_xcc_id() { return (unsigned)__builtin_amdgcn_s_getreg((3 << 11) | 20) & 0xFu; }
#define XB_SPIN(cond, bar) do { unsigned _sp = 0; while (cond) { __builtin_amdgcn_s_sleep(1); \
    if ((++_sp & 255u) == 0u) { if (xb_ld(&(bar)[XB_TMO])) break; if (_sp > XB_SPIN_CAP) { atomicAdd(&(bar)[XB_TMO], 1u); break; } } } } while (0)
struct XcdBarrier { unsigned* bar; unsigned x; volatile LAS unsigned* st; };
DEVI XcdBarrier xcd_barrier_post(unsigned* bar, volatile LAS unsigned* st) {
    XcdBarrier b; b.bar = bar; b.x = xb_xcc_id(); b.st = st;
    if (threadIdx.x == 0) (void)xb_add(&bar[XB_XCNT(b.x)], 1u);
    return b;
}
DEVI void xcd_barrier_complete(unsigned* bar, unsigned x, unsigned& nloc, unsigned& nx) {
    const unsigned G = gridDim.x * gridDim.y * gridDim.z;
    unsigned sum, cnt, mine, sp = 0u;
    for (;;) {
        sum = 0u; cnt = 0u; mine = 0u;
#pragma unroll
        for (unsigned j = 0; j < 16; ++j) { const unsigned c = xb_ld(&bar[XB_XCNT(j)]); sum += c; cnt += (c > 0u) ? 1u : 0u; mine = (j == x) ? c : mine; }
        if (sum == G) break;
        __builtin_amdgcn_s_sleep(1);
        if ((++sp & 255u) == 0u) { if (xb_ld(&bar[XB_TMO])) break; if (sp > XB_SPIN_CAP) { atomicAdd(&bar[XB_TMO], 1u); break; } }
    }
    nloc = mine > 0u ? mine : 1u; nx = cnt > 0u ? cnt : 1u;
}
DEVI void xcd_barrier(const XcdBarrier& b) {
    asm volatile("s_waitcnt vmcnt(0)" ::: "memory");
    __syncthreads();
    if (threadIdx.x == 0) {
        unsigned* bar = b.bar;
        __builtin_amdgcn_s_waitcnt(0);
        unsigned nloc = b.st[0], nx = b.st[1];
        if (nloc == 0u) { xcd_barrier_complete(bar, b.x, nloc, nx); b.st[0] = nloc; b.st[1] = nx; }
        const unsigned old = xb_add(&bar[XB_XSUB(b.x)], 1u);
        const unsigned gen = old / nloc;
        if (old + 1u == (gen + 1u) * nloc) {
            __builtin_amdgcn_fence(__ATOMIC_RELEASE, "agent");
            asm volatile("s_waitcnt vmcnt(0)" ::: "memory");
            const unsigned og = xb_add(&bar[XB_TOP], 1u);
            const unsigned tg = og / nx;
            if (og + 1u == (tg + 1u) * nx) xb_add(&bar[XB_TOPGEN], 1u);
            else XB_SPIN(xb_ld(&bar[XB_TOPGEN]) == tg, bar);
            __builtin_amdgcn_fence(__ATOMIC_ACQUIRE, "agent");
            xb_add(&bar[XB_XGEN(b.x)], 1u);
            asm volatile("s_waitcnt vmcnt(0)" ::: "memory");
        } else {
            XB_SPIN(xb_ld(&bar[XB_XGEN(b.x)]) == gen, bar);
            __builtin_amdgcn_fence(__ATOMIC_ACQUIRE, "agent");
            asm volatile("s_waitcnt vmcnt(0)" ::: "memory");
        }
    }
    __syncthreads();
}

constexpr int N_PHASES = 28;
__global__ void __launch_bounds__(NTHR) hybrid_fwd(Params p_unused) {
    extern __shared__ __attribute__((aligned(16))) char lds_base[];
    karg_ptr kp = (karg_ptr)__builtin_amdgcn_kernarg_segment_ptr();
    int ph_lo, ph_hi, use_gs;
    { DP q{kp}; ph_lo = q.ph_lo(); ph_hi = q.ph_hi(); use_gs = q.use_gs(); }
    volatile LAS unsigned* xst = (volatile LAS unsigned*)(LAS char*)(lds_base + LDS_BYTES - 16);
    if (threadIdx.x == 0) { xst[0] = 0u; xst[1] = 0u; }
    __syncthreads();
    XcdBarrier xb; xb.bar = nullptr; xb.x = 0; xb.st = xst;
    if (use_gs == 1) { DP q{kp}; xb = xcd_barrier_post((unsigned*)(q.ws() + WS_BAR), xst); }
#define RUN_PHASE(PH, ...) \
    if (ph_lo <= (PH) && (PH) < ph_hi) { \
        if ((PH) > ph_lo) { if (use_gs == 1) xcd_barrier(xb); else if (use_gs == 2) cg::this_grid().sync(); } \
        asm volatile("" : "+s"(kp) :: "memory"); \
        const DP p{kp}; \
        unsigned lds_off = 0; asm volatile("" : "+s"(lds_off)); \
        char* lds = lds_base + lds_off; \
        unsigned char* ws = p.ws(); (void)ws; (void)lds; \
        __VA_ARGS__ \
    }
#define LAYER_PHASES(L, B0) \
    RUN_PHASE((B0) + 0, { if ((L) == 1) { for (int u = BIDX(); u < PREP_UNITS; u += gridDim.x) prep_unit(p, 1, u, (float*)lds); } __syncthreads(); phase_norm1(p, (L), lds); }) \
    RUN_PHASE((B0) + 1, { phase_inproj(p, (L), lds); }) \
    RUN_PHASE((B0) + 2, { phase_post(p, (L)); }) \
    RUN_PHASE((B0) + 3, { phase_mix1(p, (L), lds); }) \
    RUN_PHASE((B0) + 4, { phase_ssd_scan(p); phase_knorm(p, (L)); }) \
    RUN_PHASE((B0) + 5, { phase_mix3(p, (L), lds); }) \
    RUN_PHASE((B0) + 6, { g8::DenseSched2 S; S.init((const bf16_t*)(ws + WS_MIX), (const bf16_t*)(ws + WS_W_OUT), T, DM, DM, gridDim.x, BIDX()); \
                          g8::EpiResScale E{{(const bf16_t*)(ws + WS_HBUF), (bf16_t*)(ws + WS_H1), DM}, (const float*)(ws + WS_SSQ)}; g8::gemm8(lds, DM, DM / 2, S, E); }) \
    RUN_PHASE((B0) + 7, { g8::DenseSched S; S.init((const bf16_t*)(ws + WS_H1), (const bf16_t*)(ws + WS_W_Q), T, DM, DM, gridDim.x, BIDX()); \
                          g8::EpiBf16 E{(bf16_t*)(ws + WS_QBUF), DM}; g8::gemm8(lds, DM, DM, S, E); }) \
    RUN_PHASE((B0) + 8, { phase_xattn(p, (L), lds); }) \
    RUN_PHASE((B0) + 9, { g8::DenseSched S; S.init((const bf16_t*)(ws + WS_OBUF), (const bf16_t*)(ws + WS_W_O), T, DM, DM, gridDim.x, BIDX()); \
                          g8::EpiResBf E{(const bf16_t*)(ws + WS_H1), (bf16_t*)(ws + WS_HBUF), DM}; g8::gemm8(lds, DM, DM, S, E); }) \
    RUN_PHASE((B0) + 10, { phase_norm3(p, (L), lds); }) \
    RUN_PHASE((B0) + 11, { phase_moe<0>(p, (L), lds); }) \
    RUN_PHASE((B0) + 12, { phase_moe<1>(p, (L), lds); })

    RUN_PHASE(0, { prep_small(p); for (int u = BIDX(); u < PREP_UNITS; u += gridDim.x) prep_unit(p, 0, u, (float*)lds); })
    LAYER_PHASES(0, 1)
    LAYER_PHASES(1, 14)
    RUN_PHASE(27, { phase_final(p); })
#undef LAYER_PHASES
#undef RUN_PHASE
}

extern "C" void kernel_launch(void* const* d_in, const int* in_sizes, int n_in, void* d_out, int out_size, void* d_ws, size_t ws_size, hipStream_t stream) {
    static int grid = 0;
    if (grid == 0) {
        if (n_in != 31 || out_size != T * DM || ws_size < WS_END) { fprintf(stderr, "kernel_launch: unexpected shapes (n_in %d out %d ws %zu need %zu)\n", n_in, out_size, ws_size, (size_t)WS_END); grid = -1; return; }
        int dev = 0, cus = 0, per_cu = 0;
        hipGetDevice(&dev);
        hipDeviceGetAttribute(&cus, hipDeviceAttributeMultiprocessorCount, dev);
        hipFuncSetAttribute((const void*)hybrid_fwd, hipFuncAttributeMaxDynamicSharedMemorySize, LDS_BYTES);
        hipOccupancyMaxActiveBlocksPerMultiprocessor(&per_cu, (const void*)hybrid_fwd, NTHR, LDS_BYTES);
        if (per_cu < 1) { fprintf(stderr, "kernel_launch: occupancy query says %d blocks per CU\n", per_cu); per_cu = 1; }
        (void)hipGetLastError();
        grid = cus;
    }
    if (grid < 0) return;
    Params p{};
    for (int i = 0; i < 31; ++i) p.in[i] = (const float*)d_in[i];
    p.out = (float*)d_out; p.ws = (unsigned char*)d_ws;
    p.use_grid_sync = 1; p.pad = 0;
    p.ph_lo = 0; p.ph_hi = N_PHASES;
    if (hipMemsetAsync((unsigned char*)d_ws + WS_BAR, 0, XCD_BAR_WORDS * 4, stream) != hipSuccess) { fprintf(stderr, "kernel_launch: memset failed\n"); return; }
    void* args[] = {&p};
    hipError_t e = hipLaunchCooperativeKernel((const void*)hybrid_fwd, dim3(grid), dim3(NTHR), args, LDS_BYTES, stream);
    if (e != hipSuccess) fprintf(stderr, "kernel_launch: cooperative launch failed: %s (grid %d)\n", hipGetErrorString(e), grid);
}
```

```cpp
#include <hip/hip_runtime.h>
#include <hip/hip_cooperative_groups.h>
#include <cstdio>
#include <cstdint>
namespace cg = cooperative_groups;

typedef unsigned short bf16_t;
typedef short bf16x8 __attribute__((ext_vector_type(8)));
typedef short s16x4 __attribute__((ext_vector_type(4)));
typedef float f32x4 __attribute__((ext_vector_type(4)));
typedef unsigned u32x4 __attribute__((ext_vector_type(4)));
typedef unsigned u32x2 __attribute__((ext_vector_type(2)));
#define DEVI __device__ __forceinline__
#define LAS __attribute__((address_space(3)))

constexpr int NB = 8, S = 2048, DM = 1024, T = NB * S, DEPTH = 2;
constexpr int INP = 3084, NPROJ = 3072;
constexpr int C_FQ = 0, C_FK = 256, C_FV = 512, C_DQ = 768, C_DK = 1024, C_DV = 1280, C_Z = 1536, C_XBC = 2048;
constexpr int MEMLEN = 256, MROWS = NB * MEMLEN;
constexpr int NEXP = 32, EFF = 512;
constexpr float EPS = 1e-6f;
constexpr int NTHR = 512;
constexpr int LDS_BYTES = 151552;

constexpr size_t al256(size_t x) { return (x + 255) & ~(size_t)255; }
constexpr size_t WS_W_IN = 0;
constexpr size_t WS_W_OUT = WS_W_IN + (size_t)NPROJ * DM * 2;
constexpr size_t WS_W_Q = WS_W_OUT + (size_t)DM * DM * 2;
constexpr size_t WS_W_KV = WS_W_Q + (size_t)DM * DM * 2;
constexpr size_t WS_W_O = WS_W_KV + (size_t)2 * DM * DM * 2;
constexpr size_t WS_W_13 = WS_W_O + (size_t)DM * DM * 2;
constexpr size_t WS_W_2 = WS_W_13 + (size_t)NEXP * 1024 * DM * 2;
constexpr size_t WS_WSMALL = WS_W_2 + (size_t)NEXP * DM * EFF * 2;
constexpr size_t WS_WROUT = WS_WSMALL + (size_t)DEPTH * 12 * DM * 4;
constexpr size_t WS_XB = WS_WROUT + (size_t)DEPTH * 36 * DM * 4;
constexpr size_t WS_H1 = WS_XB;
constexpr size_t WS_H3 = WS_XB + (size_t)T * DM * 2;
constexpr size_t WS_HBUF = WS_XB + (size_t)T * DM * 4;
constexpr size_t WS_PROJ = WS_HBUF + (size_t)T * DM * 2;
constexpr size_t WS_QBUF = WS_PROJ;
constexpr size_t WS_OBUF = WS_PROJ + (size_t)T * DM * 2;
constexpr size_t WS_ACT = WS_PROJ;
constexpr size_t WS_MIX = WS_PROJ + (size_t)T * NPROJ * 2;
constexpr size_t WS_U = WS_MIX + (size_t)T * DM * 2;
constexpr size_t WS_YBUF = WS_U;
constexpr size_t WS_DILO = WS_U;
constexpr size_t WS_DILM = WS_DILO + (size_t)3 * T * 256 * 4;
constexpr size_t WS_DILL = WS_DILM + (size_t)3 * T * 4 * 4;
constexpr size_t WS_SSTATE = WS_DILL + (size_t)3 * T * 4 * 4;
constexpr size_t WS_HIN = WS_SSTATE + (size_t)NB * 16 * 8 * 8192 * 4;
constexpr size_t WS_GBUF = WS_HIN + (size_t)NB * 16 * 8 * 8192 * 2;
constexpr size_t WS_U_END = WS_GBUF + (size_t)T * 512 * 4;
constexpr size_t WS_MEMN = WS_U_END;
constexpr size_t WS_KV = WS_MEMN + (size_t)MROWS * DM * 2;
constexpr size_t WS_LOGF = WS_KV + (size_t)MROWS * 2 * DM * 2;
constexpr size_t WS_CUMF = WS_LOGF + (size_t)T * 4 * 4;
constexpr size_t WS_DTV = WS_CUMF + (size_t)T * 4 * 4;
constexpr size_t WS_DECAY = WS_DTV + (size_t)T * 8 * 4;
constexpr size_t WS_CNT = WS_DECAY + (size_t)NB * 16 * 8 * 4;
constexpr size_t WS_LIST = WS_CNT + 1024;
constexpr size_t WS_GATE = WS_LIST + (size_t)NEXP * 2 * T * 4;
constexpr size_t WS_BAR = WS_GATE + (size_t)2 * T * 4;
constexpr size_t WS_XC = WS_BAR + 65536;
constexpr size_t WS_SSQ = WS_XC + (size_t)T * 1024 * 2;
constexpr size_t WS_RSTD1 = WS_SSQ + (size_t)T * 2 * 4;
constexpr size_t WS_RSTD3 = WS_RSTD1 + (size_t)T * 4;
constexpr size_t WS_END = WS_RSTD3 + (size_t)T * 4;
static_assert(WS_YBUF + (size_t)2 * T * DM * 2 <= WS_U_END, "ybuf alias");
static_assert(WS_OBUF + (size_t)T * DM * 2 <= WS_MIX, "obuf alias");

struct Params {
    const float* in[31];
    float* out;
    unsigned char* ws;
    int ph_lo, ph_hi;
    int use_grid_sync, pad;
};


typedef __attribute__((address_space(4))) const unsigned long long* karg_ptr;
typedef __attribute__((address_space(1))) const float* gcf_ptr;
typedef __attribute__((address_space(1))) float* gf_ptr;
typedef __attribute__((address_space(1))) unsigned char* gb_ptr;
struct DP {
    karg_ptr kp;
    DEVI const float* in(int i) const { return (const float*)(gcf_ptr)(kp[i]); }
    DEVI float* out() const { return (float*)(gf_ptr)(kp[31]); }
    DEVI unsigned char* ws() const { return (unsigned char*)(gb_ptr)(kp[32]); }
    DEVI int ph_lo() const { return (int)(unsigned)kp[33]; }
    DEVI int ph_hi() const { return (int)(unsigned)(kp[33] >> 32); }
    DEVI int use_gs() const { return (int)(unsigned)kp[34]; }
};

DEVI int TIDX() { int t = threadIdx.x; asm volatile("" : "+v"(t)); return t; }
DEVI int BIDX() { int b = blockIdx.x; asm volatile("" : "+s"(b)); return b; }
DEVI float bf2f(bf16_t v) { return __uint_as_float(((unsigned)v) << 16); }
typedef float f32x2 __attribute__((ext_vector_type(2)));
typedef __bf16 bf16x2_t __attribute__((ext_vector_type(2)));
DEVI unsigned cvt_pk(float lo, float hi) { f32x2 v = {lo, hi}; bf16x2_t b = __builtin_convertvector(v, bf16x2_t); return __builtin_bit_cast(unsigned, b); }
DEVI bf16_t f2bf(float f) { return (bf16_t)(cvt_pk(f, 0.f) & 0xffffu); }
DEVI float bflo(unsigned w) { return __uint_as_float(w << 16); }
DEVI float bfhi(unsigned w) { return __uint_as_float(w & 0xffff0000u); }
DEVI float wave_sum(float v) {
#pragma unroll
    for (int m = 32; m >= 1; m >>= 1) v += __shfl_xor(v, m);
    return v;
}
template <int CTRL> DEVI float dpp_mov(float v) { return __uint_as_float(__builtin_amdgcn_update_dpp(0u, __float_as_uint(v), CTRL, 0xf, 0xf, false)); }
DEVI float wave_sum_fast(float v) {
    v += dpp_mov<0xB1>(v);
    v += dpp_mov<0x4E>(v);
    v += dpp_mov<0x124>(v);
    v += dpp_mov<0x128>(v);
    const int iv = __float_as_int(v);
    return (__int_as_float(__builtin_amdgcn_readlane(iv, 0)) + __int_as_float(__builtin_amdgcn_readlane(iv, 16))) + (__int_as_float(__builtin_amdgcn_readlane(iv, 32)) + __int_as_float(__builtin_amdgcn_readlane(iv, 48)));
}
DEVI float silu_f(float x) { return x / (1.f + __expf(-x)); }
DEVI float softplus_f(float x) { return x > 20.f ? x : log1pf(__expf(x)); }
DEVI float logsigmoid_f(float x) { return x >= 0.f ? -log1pf(__expf(-x)) : x - log1pf(__expf(x)); }
#define MFMA16(a, b, c) __builtin_amdgcn_mfma_f32_16x16x32_bf16(a, b, c, 0, 0, 0)
DEVI s16x4 tr_read(const bf16_t* p) {
    return __builtin_bit_cast(s16x4, __builtin_amdgcn_ds_read_tr16_b64_v4i16((LAS s16x4*)p));
}

DEVI int maprow(int mode, int n) { return mode == 0 ? n : ((n >> 4) * 32 + (n & 15) + (mode == 2 ? 16 : 0)); }
DEVI void prep_tile(const float* __restrict__ src, int ld, int k0, int c0, bf16_t* __restrict__ dst, int dstld, int mode, int n0,
                    const float* __restrict__ kscale, int ks_from, float* tl) {
    const int tid = TIDX();
#pragma unroll
    for (int i = 0; i < 2; ++i) {
        const int k = (tid >> 4) + 32 * i, n4 = (tid & 15) * 4;
        const float4 v = *(const float4*)(src + (size_t)(k0 + k) * ld + c0 + n4);
        float sc = 1.f;
        if (kscale != nullptr && (k0 + k) >= ks_from) sc = kscale[k0 + k - ks_from];
        tl[k * 65 + n4 + 0] = v.x * sc; tl[k * 65 + n4 + 1] = v.y * sc; tl[k * 65 + n4 + 2] = v.z * sc; tl[k * 65 + n4 + 3] = v.w * sc;
    }
    __syncthreads();
    {
        const int n = tid >> 3, kc = (tid & 7) * 8;
        u32x4 w;
        w.x = cvt_pk(tl[(kc + 0) * 65 + n], tl[(kc + 1) * 65 + n]);
        w.y = cvt_pk(tl[(kc + 2) * 65 + n], tl[(kc + 3) * 65 + n]);
        w.z = cvt_pk(tl[(kc + 4) * 65 + n], tl[(kc + 5) * 65 + n]);
        w.w = cvt_pk(tl[(kc + 6) * 65 + n], tl[(kc + 7) * 65 + n]);
        const int drow = maprow(mode, n0 + n);
        *(u32x4*)(dst + (size_t)drow * dstld + k0 + kc) = w;
    }
    __syncthreads();
}

constexpr int PREP_UNITS = 2048 + 3 * 4096;
DEVI void prep_unit(const DP& p, int l, int u, float* tl) {
    unsigned char* ws = p.ws();
    if (u < 768) {
        const int kt = u / 48, nt = u % 48, n0 = nt * 64, c0 = n0 < 768 ? n0 : n0 + 4;
        prep_tile(p.in(3) + (size_t)l * DM * INP, INP, kt * 64, c0, (bf16_t*)(ws + WS_W_IN), DM, 0, n0, p.in(2) + l * DM, 0, tl);
    } else if (u < 1024) {
        const int v = u - 768, kt = v / 16, nt = v % 16;
        prep_tile(p.in(15) + (size_t)l * DM * DM, DM, kt * 64, nt * 64, (bf16_t*)(ws + WS_W_OUT), DM, 0, nt * 64, p.in(14) + l * 512, 512, tl);
    } else if (u < 1280) {
        const int v = u - 1024, kt = v / 16, nt = v % 16;
        prep_tile(p.in(18) + (size_t)l * DM * DM, DM, kt * 64, nt * 64, (bf16_t*)(ws + WS_W_Q), DM, 0, nt * 64, p.in(16) + l * DM, 0, tl);
    } else if (u < 1792) {
        const int v = u - 1280, kt = v / 32, nt = v % 32;
        prep_tile(p.in(19) + (size_t)l * DM * 2 * DM, 2 * DM, kt * 64, nt * 64, (bf16_t*)(ws + WS_W_KV), DM, 0, nt * 64, nullptr, 0, tl);
    } else if (u < 2048) {
        const int v = u - 1792, kt = v / 16, nt = v % 16;
        prep_tile(p.in(22) + (size_t)l * DM * DM, DM, kt * 64, nt * 64, (bf16_t*)(ws + WS_W_O), DM, 0, nt * 64, nullptr, 0, tl);
    } else if (u < 2048 + 8192) {
        const int v = u - 2048, which = v / 4096, w = v % 4096, e = w / 128, tI = w % 128, kt = tI / 8, nt = tI % 8;
        const float* src = (which == 0 ? p.in(28) : p.in(29)) + ((size_t)l * NEXP + e) * DM * EFF;
        prep_tile(src, EFF, kt * 64, nt * 64, (bf16_t*)(ws + WS_W_13) + (size_t)e * 1024 * DM, DM, which == 0 ? 1 : 2, nt * 64, p.in(23) + l * DM, 0, tl);
    } else {
        const int w = u - 2048 - 8192, e = w / 128, tI = w % 128, kt = tI / 16, nt = tI % 16;
        const float* src = p.in(30) + ((size_t)l * NEXP + e) * EFF * DM;
        prep_tile(src, DM, kt * 64, nt * 64, (bf16_t*)(ws + WS_W_2) + (size_t)e * DM * EFF, EFF, 0, nt * 64, nullptr, 0, tl);
    }
}
DEVI void prep_small(const DP& p) {
    float* wsm = (float*)(p.ws() + WS_WSMALL);
    float* wro = (float*)(p.ws() + WS_WROUT);
    const int gtid = BIDX() * NTHR + TIDX(), gn = gridDim.x * NTHR;
    for (int i = gtid; i < DEPTH * 12 * DM; i += gn) {
        const int l = i / (12 * DM), r = i % (12 * DM), c = r / DM, k = r % DM;
        const int col = c < 4 ? 768 + c : 3076 + (c - 4);
        wsm[i] = p.in(3)[((size_t)l * DM + k) * INP + col] * p.in(2)[l * DM + k];
    }
    for (int i = gtid; i < DEPTH * 36 * DM; i += gn) {
        const int l = i / (36 * DM), r = i % (36 * DM), c = r / DM, k = r % DM;
        wro[i] = (c < 4 ? p.in(24)[((size_t)l * DM + k) * 4 + c] : p.in(26)[((size_t)l * DM + k) * 32 + (c - 4)]) * p.in(23)[l * DM + k];
    }
    if (BIDX() == 0 && TIDX() < 128) ((int*)(p.ws() + WS_CNT))[TIDX()] = 0;
}

DEVI void store_h_bf16(bf16_t* hrow, const float (&h)[16], int lane) {
#pragma unroll
    for (int j = 0; j < 4; ++j) {
        u32x2 w; w.x = cvt_pk(h[4 * j], h[4 * j + 1]); w.y = cvt_pk(h[4 * j + 2], h[4 * j + 3]);
        *(u32x2*)(hrow + j * 256 + lane * 4) = w;
    }
}
DEVI void load_row_f32(const float* xr, float (&x)[16], int lane) {
#pragma unroll
    for (int j = 0; j < 4; ++j) { const float4 v = *(const float4*)(xr + j * 256 + lane * 4); x[4 * j] = v.x; x[4 * j + 1] = v.y; x[4 * j + 2] = v.z; x[4 * j + 3] = v.w; }
}
DEVI void add_row_bf16(const bf16_t* yr, float (&x)[16], int lane) {
#pragma unroll
    for (int j = 0; j < 4; ++j) { const u32x2 w = *(const u32x2*)(yr + j * 256 + lane * 4); x[4 * j] += bflo(w.x); x[4 * j + 1] += bfhi(w.x); x[4 * j + 2] += bflo(w.y); x[4 * j + 3] += bfhi(w.y); }
}
DEVI void store_row_f32(float* xr, const float (&x)[16], int lane) {
#pragma unroll
    for (int j = 0; j < 4; ++j) *(float4*)(xr + j * 256 + lane * 4) = make_float4(x[4 * j], x[4 * j + 1], x[4 * j + 2], x[4 * j + 3]);
}
DEVI void norm_row(const float (&x)[16], const float* g, float (&h)[16], int lane) {
    float ss = 0.f;
#pragma unroll
    for (int i = 0; i < 16; ++i) ss += x[i] * x[i];
    ss = wave_sum(ss);
    const float rstd = rsqrtf(ss * (1.0f / DM) + EPS);
#pragma unroll
    for (int j = 0; j < 4; ++j) { const float4 gv = *(const float4*)(g + j * 256 + lane * 4);
        h[4 * j] = x[4 * j] * rstd * gv.x; h[4 * j + 1] = x[4 * j + 1] * rstd * gv.y; h[4 * j + 2] = x[4 * j + 2] * rstd * gv.z; h[4 * j + 3] = x[4 * j + 3] * rstd * gv.w; }
}
DEVI float dot_lds(const float (&h)[16], const float* wrow, int lane) {
    float a = 0.f;
#pragma unroll
    for (int j = 0; j < 4; ++j) { const float4 w = *(const float4*)(wrow + j * 256 + lane * 4); a += h[4 * j] * w.x + h[4 * j + 1] * w.y + h[4 * j + 2] * w.z + h[4 * j + 3] * w.w; }
    return a;
}

DEVI void load_row_bf16(const bf16_t* xr, float (&x)[16], int lane) {
#pragma unroll
    for (int j = 0; j < 2; ++j) { const u32x4 w = *(const u32x4*)(xr + j * 512 + lane * 8);
        x[8 * j] = bflo(w.x); x[8 * j + 1] = bfhi(w.x); x[8 * j + 2] = bflo(w.y); x[8 * j + 3] = bfhi(w.y); x[8 * j + 4] = bflo(w.z); x[8 * j + 5] = bfhi(w.z); x[8 * j + 6] = bflo(w.w); x[8 * j + 7] = bfhi(w.w); }
}
DEVI void add_row_bf16_b(const bf16_t* yr, float (&x)[16], int lane) {
#pragma unroll
    for (int j = 0; j < 2; ++j) { const u32x4 w = *(const u32x4*)(yr + j * 512 + lane * 8);
        x[8 * j] += bflo(w.x); x[8 * j + 1] += bfhi(w.x); x[8 * j + 2] += bflo(w.y); x[8 * j + 3] += bfhi(w.y); x[8 * j + 4] += bflo(w.z); x[8 * j + 5] += bfhi(w.z); x[8 * j + 6] += bflo(w.w); x[8 * j + 7] += bfhi(w.w); }
}
DEVI void store_row_bf16_b(bf16_t* hr, const float (&h)[16], int lane) {
#pragma unroll
    for (int j = 0; j < 2; ++j) { u32x4 w; w.x = cvt_pk(h[8 * j], h[8 * j + 1]); w.y = cvt_pk(h[8 * j + 2], h[8 * j + 3]); w.z = cvt_pk(h[8 * j + 4], h[8 * j + 5]); w.w = cvt_pk(h[8 * j + 6], h[8 * j + 7]);
        *(u32x4*)(hr + j * 512 + lane * 8) = w; }
}
DEVI float dot_lds_b(const float (&h)[16], const float* wrow, int lane) {
    float a = 0.f;
#pragma unroll
    for (int j = 0; j < 2; ++j) { const float4 w0 = *(const float4*)(wrow + j * 512 + lane * 8), w1 = *(const float4*)(wrow + j * 512 + lane * 8 + 4);
        a += h[8 * j] * w0.x + h[8 * j + 1] * w0.y + h[8 * j + 2] * w0.z + h[8 * j + 3] * w0.w + h[8 * j + 4] * w1.x + h[8 * j + 5] * w1.y + h[8 * j + 6] * w1.z + h[8 * j + 7] * w1.w; }
    return a;
}
#define MFMA_F32(a, b, c) __builtin_amdgcn_mfma_f32_16x16x4f32(a, b, c, 0, 0, 0)
template <int L>
DEVI void load_row_pre(const float* xin, const bf16_t* h0, const bf16_t* ybuf, int row, int lane, float (&x)[16]) {
    if (L == 0) load_row_f32(xin + (size_t)row * DM, x, lane);
    else { load_row_bf16(h0 + (size_t)row * DM, x, lane); add_row_bf16_b(ybuf + (size_t)(2 * row) * DM, x, lane); add_row_bf16_b(ybuf + (size_t)(2 * row + 1) * DM, x, lane); }
}
template <int L>
DEVI void norm1_rows(const DP& p, char* lds) {
    const int tid = TIDX(), wid = tid >> 6, lane = tid & 63;
    unsigned char* ws = p.ws();
    const float* wsl = (const float*)lds;
    const float* xin = p.in(0);
    const bf16_t* ybuf = (const bf16_t*)(ws + WS_YBUF);
    bf16_t* hbuf = (bf16_t*)(ws + WS_HBUF);
    float* logf = (float*)(ws + WS_LOGF);
    float* dtv = (float*)(ws + WS_DTV);
    float* rstd1 = (float*)(ws + WS_RSTD1);
    const int stride = gridDim.x * 8;
    int row = BIDX() * 8 + wid;
    float xn[16];
    if (row < T) load_row_pre<L>(xin, hbuf, ybuf, row, lane, xn);
    for (; row < T; row += stride) {
        float x[16];
#pragma unroll
        for (int i = 0; i < 16; ++i) x[i] = xn[i];
        if (row + stride < T) load_row_pre<L>(xin, hbuf, ybuf, row + stride, lane, xn);
        if (L == 0) store_h_bf16(hbuf + (size_t)row * DM, x, lane); else store_row_bf16_b(hbuf + (size_t)row * DM, x, lane);
        float ss = 0.f;
#pragma unroll
        for (int i = 0; i < 16; ++i) ss += x[i] * x[i];
        const float rstd = rsqrtf(wave_sum_fast(ss) * (1.0f / DM) + EPS);
        float keep = 0.f;
#pragma unroll
        for (int c = 0; c < 12; ++c) { const float v = wave_sum_fast(L == 0 ? dot_lds(x, wsl + c * DM, lane) : dot_lds_b(x, wsl + c * DM, lane)); keep = (lane == c) ? v : keep; if (c & 1) __builtin_amdgcn_sched_barrier(0); }
        keep *= rstd;
        if (lane == 0) rstd1[row] = rstd;
        if (lane < 4) logf[(size_t)row * 4 + lane] = logsigmoid_f(keep + p.in(4)[L * 4 + lane]);
        else if (lane < 12) dtv[(size_t)row * 8 + lane - 4] = softplus_f(keep + p.in(11)[L * 8 + lane - 4]);
    }
}
DEVI void phase_norm1(const DP& p, int l, char* lds) {
    const int tid = TIDX(), wid = tid >> 6, lane = tid & 63;
    unsigned char* ws = p.ws();
    float* wsl = (float*)lds;
    { const float4* src = (const float4*)((const float*)(ws + WS_WSMALL) + (size_t)l * 12 * DM);
      for (int i = tid; i < 12 * DM / 4; i += NTHR) ((float4*)wsl)[i] = src[i]; }
    __syncthreads();
    if (l == 0) norm1_rows<0>(p, lds); else norm1_rows<1>(p, lds);
    const float* gm = p.in(17) + l * DM;
    bf16_t* memn = (bf16_t*)(ws + WS_MEMN);
    for (int row = BIDX() * 8 + wid; row < MROWS; row += gridDim.x * 8) {
        float x[16], h[16];
        load_row_f32(p.in(1) + (size_t)row * DM, x, lane);
        norm_row(x, gm, h, lane);
        store_h_bf16(memn + (size_t)row * DM, h, lane);
    }
}
DEVI void phase_norm3(const DP& p, int l, char* lds) {
    const int tid = TIDX(), wid = tid >> 6, lane = tid & 63;
    unsigned char* ws = p.ws();
    float* wr = (float*)lds;
    int* lcnt = (int*)(lds + 36 * DM * 4);
    int* lbase = lcnt + 32;
    int* rinfo = lbase + 32;
    { const float4* src = (const float4*)((const float*)(ws + WS_WROUT) + (size_t)l * 36 * DM);
      for (int i = tid; i < 36 * DM / 4; i += NTHR) ((float4*)wr)[i] = src[i]; }
    if (tid < 32) lcnt[tid] = 0;
    __syncthreads();
    int* cnt = (int*)(ws + WS_CNT) + l * 64;
    int* list = (int*)(ws + WS_LIST);
    const bf16_t* xin = (const bf16_t*)(ws + WS_HBUF);
    bf16_t* h3 = (bf16_t*)(ws + WS_H3);
    const float* bg = p.in(25) + l * 4;
    const int be_i = __float_as_int(lane < 32 ? p.in(27)[l * 32 + lane] : 0.f);
    const int stride = gridDim.x * 8;
    int row = BIDX() * 8 + wid;
    float xn[16];
    if (row < T) load_row_bf16(xin + (size_t)row * DM, xn, lane);
    for (int it = 0; row < T; row += stride, ++it) {
        float x[16];
#pragma unroll
        for (int i = 0; i < 16; ++i) x[i] = xn[i];
        if (row + stride < T) load_row_bf16(xin + (size_t)(row + stride) * DM, xn, lane);
        float ss = 0.f;
#pragma unroll
        for (int i = 0; i < 16; ++i) ss += x[i] * x[i];
        const float rstd = rsqrtf(wave_sum_fast(ss) * (1.0f / DM) + EPS);
        { float hn[16];
#pragma unroll
          for (int i = 0; i < 16; ++i) hn[i] = x[i] * rstd;
          store_row_bf16_b(h3 + (size_t)row * DM, hn, lane); }
        float gl[4];
#pragma unroll
        for (int c = 0; c < 4; ++c) gl[c] = wave_sum_fast(dot_lds_b(x, wr + c * DM, lane)) * rstd + bg[c];
        int gsel = 0; float gmax = gl[0];
#pragma unroll
        for (int c = 1; c < 4; ++c) if (gl[c] > gmax) { gmax = gl[c]; gsel = c; }
        float gden = 0.f;
#pragma unroll
        for (int c = 0; c < 4; ++c) gden += __expf(gl[c] - gmax);
        const float ggate = 1.0f / gden;
        gsel = __builtin_amdgcn_readfirstlane(gsel);
        float v1 = -3.0e38f, v2 = -3.0e38f; int i1 = 0, i2 = 1;
#pragma unroll
        for (int c = 0; c < 8; ++c) {
            const float v = wave_sum_fast(dot_lds_b(x, wr + (4 + gsel * 8 + c) * DM, lane)) * rstd + __int_as_float(__builtin_amdgcn_readlane(be_i, gsel * 8 + c));
            if (v > v1) { v2 = v1; i2 = i1; v1 = v; i1 = c; } else if (v > v2) { v2 = v; i2 = c; }
            if (c & 1) __builtin_amdgcn_sched_barrier(0);
        }
        const float e2 = __expf(v2 - v1), inv = 1.0f / (1.0f + e2);
        if (lane == 0) {
            const int ea = gsel * 8 + i1, eb = gsel * 8 + i2;
            const int sa = atomicAdd(&lcnt[ea], 1), sb = atomicAdd(&lcnt[eb], 1);
            int* ri = rinfo + (it * 8 + wid) * 4;
            const unsigned gpk = cvt_pk(inv * ggate, e2 * inv * ggate);
            ri[0] = ea | (sa << 8); ri[1] = eb | (sb << 8); ri[2] = (int)(gpk << 16); ri[3] = (int)(gpk & 0xffff0000u);
        }
    }
    __syncthreads();
    if (tid < 32) lbase[tid] = atomicAdd(&cnt[tid], lcnt[tid]);
    __syncthreads();
    {
        const int nit = (T - (BIDX() * 8) + stride - 1) / stride;
        if (tid < nit * 8) {
            const int it = tid >> 3, w = tid & 7, r = BIDX() * 8 + w + it * stride;
            if (r < T) {
                const int* ri = rinfo + tid * 4;
                const int ea = ri[0] & 255, sa = ri[0] >> 8, eb = ri[1] & 255, sb = ri[1] >> 8;
                list[(size_t)ea * (2 * T) + lbase[ea] + sa] = ri[2] | (2 * r);
                list[(size_t)eb * (2 * T) + lbase[eb] + sb] = ri[3] | (2 * r + 1);
            }
        }
    }
    __syncthreads();
}

constexpr int G_BM = 256, G_BN = 128, G_BK = 64, G_ST = 72;
constexpr int G_ABUF = G_BM * G_ST, G_BBUF = G_BN * G_ST;
template <class AMap, class Epi>
DEVI void gemm_tile(const AMap& amap, const bf16_t* __restrict__ Bt, int K, const Epi& epi, char* lds) {
    const int tid = TIDX(), wid = tid >> 6, lane = tid & 63, r16 = lane & 15, g4 = lane >> 4;
    const int wr = wid >> 1, wc = wid & 1;
    bf16_t* As = (bf16_t*)lds;
    bf16_t* Bs = As + 2 * G_ABUF;
    const int srow = tid >> 3, skc = (tid & 7) * 8;
    const bf16_t* ap[4];
#pragma unroll
    for (int i = 0; i < 4; ++i) ap[i] = amap(srow + 64 * i) + skc;
    const bf16_t* bp[2];
#pragma unroll
    for (int i = 0; i < 2; ++i) bp[i] = Bt + (size_t)(srow + 64 * i) * K + skc;
    u32x4 ra[4], rb[2];
#pragma unroll
    for (int i = 0; i < 4; ++i) ra[i] = *(const u32x4*)(ap[i]);
#pragma unroll
    for (int i = 0; i < 2; ++i) rb[i] = *(const u32x4*)(bp[i]);
    f32x4 acc[4][4];
#pragma unroll
    for (int m = 0; m < 4; ++m)
#pragma unroll
        for (int n = 0; n < 4; ++n) acc[m][n] = (f32x4){0.f, 0.f, 0.f, 0.f};
    const int nt = K / G_BK;
    for (int t = 0; t < nt; ++t) {
        bf16_t* Ab = As + (t & 1) * G_ABUF;
        bf16_t* Bb = Bs + (t & 1) * G_BBUF;
#pragma unroll
        for (int i = 0; i < 4; ++i) *(u32x4*)(Ab + (srow + 64 * i) * G_ST + skc) = ra[i];
#pragma unroll
        for (int i = 0; i < 2; ++i) *(u32x4*)(Bb + (srow + 64 * i) * G_ST + skc) = rb[i];
        __syncthreads();
        if (t + 1 < nt) {
#pragma unroll
            for (int i = 0; i < 4; ++i) ra[i] = *(const u32x4*)(ap[i] + (size_t)(t + 1) * G_BK);
#pragma unroll
            for (int i = 0; i < 2; ++i) rb[i] = *(const u32x4*)(bp[i] + (size_t)(t + 1) * G_BK);
        }
#pragma unroll
        for (int kk = 0; kk < 2; ++kk) {
            bf16x8 af[4], bfr[4];
#pragma unroll
            for (int m = 0; m < 4; ++m) af[m] = *(const bf16x8*)(Ab + (wr * 64 + m * 16 + r16) * G_ST + kk * 32 + g4 * 8);
#pragma unroll
            for (int n = 0; n < 4; ++n) bfr[n] = *(const bf16x8*)(Bb + (wc * 64 + n * 16 + r16) * G_ST + kk * 32 + g4 * 8);
#pragma unroll
            for (int m = 0; m < 4; ++m)
#pragma unroll
                for (int n = 0; n < 4; ++n) acc[m][n] = MFMA16(bfr[n], af[m], acc[m][n]);
        }
    }
    epi(acc, wr * 64 + r16, wc * 64 + g4 * 4);
    __syncthreads();
}

struct AMapDense { const bf16_t* A; int K; DEVI const bf16_t* operator()(int r) const { return A + (size_t)r * K; } };
struct EpiBf16Out { bf16_t* O; int ldo;
    DEVI void operator()(const f32x4 (&acc)[4][4], int rb, int cb) const {
#pragma unroll
        for (int m = 0; m < 4; ++m)
#pragma unroll
            for (int n = 0; n < 4; ++n) { u32x2 w; w.x = cvt_pk(acc[m][n][0], acc[m][n][1]); w.y = cvt_pk(acc[m][n][2], acc[m][n][3]);
                *(u32x2*)(O + (size_t)(rb + m * 16) * ldo + cb + n * 16) = w; }
    } };
struct EpiResF32 { const float* R; float* O; int ld;
    DEVI void operator()(const f32x4 (&acc)[4][4], int rb, int cb) const {
#pragma unroll
        for (int m = 0; m < 4; ++m)
#pragma unroll
            for (int n = 0; n < 4; ++n) { const size_t off = (size_t)(rb + m * 16) * ld + cb + n * 16;
                const f32x4 r = *(const f32x4*)(R + off); *(f32x4*)(O + off) = r + acc[m][n]; }
    } };

template <class MakeEpi>
DEVI void gemm_dense_units(const bf16_t* A, const bf16_t* Bt, int M, int N, int K, const MakeEpi& mk, char* lds, int u0, int ustride) {
    const int nN = N / G_BN, nU = (M / G_BM) * nN;
    for (int u = u0; u < nU; u += ustride) {
        const int pm = u / nN, pn = u % nN;
        AMapDense am{A + (size_t)pm * G_BM * K, K};
        gemm_tile(am, Bt + (size_t)pn * G_BN * K, K, mk(pm * G_BM, pn * G_BN), lds);
    }
}


DEVI const char* uni_ptr(const char* p) {
    const unsigned long long v = (unsigned long long)p;
    const unsigned lo = __builtin_amdgcn_readfirstlane((unsigned)v), hi = __builtin_amdgcn_readfirstlane((unsigned)(v >> 32));
    return (const char*)(gb_ptr)(((unsigned long long)hi << 32) | lo);
}
namespace g8 {
constexpr int BM = 256, BK = 64, HALF = 128, HTB = HALF * BK * 2, STAGE_BYTES = 8 * HTB;
DEVI int lds_byte(int r, int c) { const int st = (r >> 4) * 2 + (c >> 5), rr = r & 15, cc = c & 31, ob = rr * 64 + cc * 2; return st * 1024 + (ob ^ (((ob >> 9) & 1) << 5)); }
DEVI void stage_rc(int b, int& R, int& C) { const int st = b / 1024, sb = b % 1024, swz = sb ^ (((sb >> 9) & 1) << 5); R = (st >> 1) * 16 + swz / 64; C = (st & 1) * 32 + (swz % 64) / 2; }
DEVI int perm32(int rho) { const int n = rho >> 4, i = rho & 15; return 8 * (i >> 2) + 4 * n + (i & 3); }
struct UnitU { const char* A; const char* B; int i0, i1, i2, i3; int flags; };

template <class Epi, class Sched>
DEVI void gemm8(char* lds_generic, int K, int klen, Sched& S, const Epi& E) {
    LAS unsigned char* lds = (LAS unsigned char*)lds_generic;
    const int tid = TIDX(), wid = __builtin_amdgcn_readfirstlane(tid >> 6), lane = tid & 63, wr = wid >> 2, wc = wid & 3, fr = lane & 15, fq = lane >> 4;
    const int nt = klen / BK;
    int R0, C0, R1, C1; stage_rc(tid * 16, R0, C0); stage_rc(tid * 16 + 8192, R1, C1);
    unsigned voffB[2];
    { const int Rb0 = Epi::PERM ? ((R0 & ~31) + perm32(R0 & 31)) : R0, Rb1 = Epi::PERM ? ((R1 & ~31) + perm32(R1 & 31)) : R1;
      voffB[0] = (unsigned)(Rb0 * K + C0) * 2u; voffB[1] = (unsigned)(Rb1 * K + C1) * 2u; }
    const size_t kstep = (size_t)(BK * 2), hstepB = (size_t)HALF * K * 2;
    const unsigned ldsw = (unsigned)wid * 1024u;
    const int aoff = lds_byte(wr * 64 + fr, fq * 8), boff = lds_byte(wc * 32 + fr, fq * 8);
#define G8_SA(b, h) (((b) * 2 + (h)) * HTB)
#define G8_SB(b, h) ((4 + (b) * 2 + (h)) * HTB)
#define G8_STG(bufoff, gbase, v0, v1) do { const char* _gb = uni_ptr((const char*)(gbase));     \
        __builtin_amdgcn_global_load_lds((const unsigned*)(_gb + (v0)), (LAS unsigned*)(lds + (bufoff) + ldsw), 16, 0, 0); \
        __builtin_amdgcn_global_load_lds((const unsigned*)(_gb + (v1)), (LAS unsigned*)(lds + (bufoff) + ldsw + 8192), 16, 0, 0); } while (0)
#define G8_LDA(dst, b, h) do { _Pragma("unroll") for (int m = 0; m < 4; ++m) _Pragma("unroll") for (int k = 0; k < 2; ++k) dst[m][k] = *(const LAS bf16x8*)(lds + G8_SA(b, h) + aoff + m * 2048 + k * 1024); } while (0)
#define G8_LDB(dst, b, h) do { _Pragma("unroll") for (int n = 0; n < 2; ++n) _Pragma("unroll") for (int k = 0; k < 2; ++k) dst[n][k] = *(const LAS bf16x8*)(lds + G8_SB(b, h) + boff + n * 2048 + k * 1024); } while (0)
#define G8_MMA(ai, bj, At, Bt) do { __builtin_amdgcn_s_setprio(1); _Pragma("unroll") for (int m = 0; m < 4; ++m) _Pragma("unroll") for (int n = 0; n < 2; ++n) _Pragma("unroll") for (int k = 0; k < 2; ++k) \
        acc[ai][bj][m][n] = __builtin_amdgcn_mfma_f32_16x16x32_bf16(Bt[n][k], At[m][k], acc[ai][bj][m][n], 0, 0, 0); __builtin_amdgcn_s_setprio(0); } while (0)
#define G8_WAIT_V(n) asm volatile("s_waitcnt vmcnt(" #n ")" ::: "memory")
#define G8_WAIT_L(n) asm volatile("s_waitcnt lgkmcnt(" #n ")" ::: "memory")
#define G8_BAR __builtin_amdgcn_s_barrier()
#define G8_SCHED __builtin_amdgcn_sched_barrier(0)
    UnitU cur, nxt;
    if (!S.next(cur)) return;
    unsigned va00, va01, va10, va11;
    S.lane_va(cur, R0, C0, R1, C1, va00, va01, va10, va11);
    f32x4 acc[2][2][4][2];
#pragma unroll
    for (int a = 0; a < 2; ++a)
#pragma unroll
        for (int b = 0; b < 2; ++b)
#pragma unroll
            for (int m = 0; m < 4; ++m)
#pragma unroll
                for (int n = 0; n < 2; ++n) acc[a][b][m][n] = (f32x4){0.f, 0.f, 0.f, 0.f};
    bf16x8 At[4][2], B0[2][2], B1[2][2];
    const char* cA = cur.A; const char* cB = cur.B;
    G8_STG(G8_SB(0, 0), cB, voffB[0], voffB[1]); G8_STG(G8_SA(0, 0), cA, va00, va01); G8_STG(G8_SB(0, 1), cB + hstepB, voffB[0], voffB[1]); G8_STG(G8_SA(0, 1), cA, va10, va11);
    if (wr == 1) G8_BAR;
    G8_WAIT_V(4); G8_BAR;
    G8_STG(G8_SB(1, 0), cB + kstep, voffB[0], voffB[1]); G8_STG(G8_SA(1, 0), cA + kstep, va00, va01); G8_STG(G8_SB(1, 1), cB + hstepB + kstep, voffB[0], voffB[1]);
    G8_WAIT_V(6); G8_BAR;
    for (;;) {
        const bool has_next = S.next(nxt);
        const char* nA = has_next ? nxt.A : cA; const char* nB = has_next ? nxt.B : cB;
        unsigned x00 = va00, x01 = va01, x10 = va10, x11 = va11;
        for (int t = 0; t < nt; t += 2) {
            const bool last = (t == nt - 2);
            const char* a1 = cA + (size_t)(t + 1) * kstep;
            const char* a2 = last ? nA : cA + (size_t)(t + 2) * kstep; const char* b2 = last ? nB : cB + (size_t)(t + 2) * kstep;
            const char* a3 = a2 + kstep; const char* b3 = b2 + kstep;
            if (Sched::GATHER) { if (last && has_next) S.lane_va(nxt, R0, C0, R1, C1, x00, x01, x10, x11); }
            G8_LDB(B0, 0, 0); G8_SCHED; G8_LDA(At, 0, 0); G8_STG(G8_SA(1, 1), a1, va10, va11);
            G8_WAIT_L(8); G8_BAR; G8_WAIT_L(0); G8_MMA(0, 0, At, B0); G8_BAR; G8_SCHED;
            G8_LDB(B1, 0, 1); G8_STG(G8_SB(0, 0), b2, voffB[0], voffB[1]);
            G8_BAR; G8_WAIT_L(0); G8_MMA(0, 1, At, B1); G8_BAR;
            G8_LDA(At, 0, 1); G8_STG(G8_SA(0, 0), a2, x00, x01);
            G8_BAR; G8_WAIT_L(0); G8_MMA(1, 0, At, B0); G8_BAR; G8_SCHED;
            G8_STG(G8_SB(0, 1), b2 + hstepB, voffB[0], voffB[1]);
            G8_WAIT_V(6); G8_BAR; G8_MMA(1, 1, At, B1); G8_BAR;
            G8_LDB(B0, 1, 0); G8_SCHED; G8_LDA(At, 1, 0); G8_STG(G8_SA(0, 1), a2, x10, x11);
            G8_WAIT_L(8); G8_BAR; G8_WAIT_L(0); G8_MMA(0, 0, At, B0); G8_BAR; G8_SCHED;
            G8_LDB(B1, 1, 1); G8_STG(G8_SB(1, 0), b3, voffB[0], voffB[1]);
            G8_BAR; G8_WAIT_L(0); G8_MMA(0, 1, At, B1); G8_BAR;
            G8_LDA(At, 1, 1); G8_STG(G8_SA(1, 0), a3, x00, x01);
            G8_BAR; G8_WAIT_L(0); G8_MMA(1, 0, At, B0); G8_BAR; G8_SCHED;
            G8_STG(G8_SB(1, 1), b3 + hstepB, voffB[0], voffB[1]);
            G8_WAIT_V(6); G8_BAR; G8_MMA(1, 1, At, B1); G8_BAR;
        }
        if (cur.flags & 2) E(acc, cur, wr, wc, fr, fq); else E.mid(acc, cur, wr, wc, fr, fq);
        if (!has_next) break;
        if (nxt.flags & 1) {
#pragma unroll
        for (int a = 0; a < 2; ++a)
#pragma unroll
            for (int b = 0; b < 2; ++b)
#pragma unroll
                for (int m = 0; m < 4; ++m)
#pragma unroll
                    for (int n = 0; n < 2; ++n) acc[a][b][m][n] = (f32x4){0.f, 0.f, 0.f, 0.f};
        }
        cur = nxt; cA = nA; cB = nB; va00 = x00; va01 = x01; va10 = x10; va11 = x11;
    }
    G8_WAIT_V(0);
    if (wr == 0) G8_BAR;
    G8_BAR;
#undef G8_SA
#undef G8_SB
#undef G8_STG
#undef G8_LDA
#undef G8_LDB
#undef G8_MMA
#undef G8_WAIT_V
#undef G8_WAIT_L
#undef G8_BAR
#undef G8_SCHED
}

struct DenseSched {
    static constexpr bool GATHER = false;
    const char* A; const char* Bt; int K, nM, nN, nwg, G, c, i;
    DEVI void init(const bf16_t* A_, const bf16_t* Bt_, int M, int N, int K_, int G_, int c_) { A = (const char*)A_; Bt = (const char*)Bt_; K = K_; nM = M / BM; nN = N / BM; nwg = nM * nN; G = G_; c = c_; i = 0; }
    DEVI bool next(UnitU& u) {
        const long L = (long)i * G + c; if (L >= nwg) return false;
        ++i;
        int wgid = (int)L; { const int q = nwg / 8, r = nwg % 8, xcd = wgid % 8, off = wgid / 8; wgid = (xcd < r ? xcd * (q + 1) : r * (q + 1) + (xcd - r) * q) + off; }
        const int nig = 8 * nN, gid = wgid / nig, fm = gid * 8, gsz = (nM - fm) < 8 ? (nM - fm) : 8;
        const int pm = fm + ((wgid % nig) % gsz), pn = (wgid % nig) / gsz;
        u.A = A + (size_t)pm * BM * K * 2; u.B = Bt + (size_t)pn * BM * K * 2; u.i0 = pm; u.i1 = pn; u.i2 = 0; u.i3 = 0; u.flags = 3;
        return true;
    }
    DEVI void lane_va(const UnitU&, int R0, int C0, int R1, int C1, unsigned& v00, unsigned& v01, unsigned& v10, unsigned& v11) const {
        v00 = (unsigned)(R0 * K + C0) * 2u; v01 = (unsigned)(R1 * K + C1) * 2u; v10 = v00 + (unsigned)(HALF * K * 2); v11 = v01 + (unsigned)(HALF * K * 2);
    }
};
struct EpiBf16Scale { static constexpr bool PERM = true; bf16_t* O; int ldo; const float* rstd;
    DEVI void mid(f32x4 (&)[2][2][4][2], const UnitU&, int, int, int, int) const {}
    DEVI void operator()(const f32x4 (&acc)[2][2][4][2], const UnitU& u, int wr, int wc, int fr, int fq) const {
        const int row0 = u.i0 * BM + wr * 64 + fr;
        bf16_t* base = O + (size_t)row0 * ldo + u.i1 * BM + wc * 32 + 8 * fq;
        float rsv[2][4];
#pragma unroll
        for (int ai = 0; ai < 2; ++ai)
#pragma unroll
            for (int m = 0; m < 4; ++m) rsv[ai][m] = rstd[row0 + ai * HALF + m * 16];
#pragma unroll
        for (int ai = 0; ai < 2; ++ai)
#pragma unroll
            for (int m = 0; m < 4; ++m) { bf16_t* rowp = base + (size_t)(ai * HALF + m * 16) * ldo; const float rs = rsv[ai][m];
#pragma unroll
                for (int bj = 0; bj < 2; ++bj) { const f32x4 v0 = acc[ai][bj][m][0] * rs, v1 = acc[ai][bj][m][1] * rs;
                    u32x4 w; w.x = cvt_pk(v0[0], v0[1]); w.y = cvt_pk(v0[2], v0[3]); w.z = cvt_pk(v1[0], v1[1]); w.w = cvt_pk(v1[2], v1[3]);
                    *(u32x4*)(rowp + bj * HALF) = w; } }
    } };
struct EpiBf16 { static constexpr bool PERM = true; bf16_t* O; int ldo;
    DEVI void mid(f32x4 (&)[2][2][4][2], const UnitU&, int, int, int, int) const {}
    DEVI void operator()(const f32x4 (&acc)[2][2][4][2], const UnitU& u, int wr, int wc, int fr, int fq) const {
        bf16_t* base = O + (size_t)(u.i0 * BM + wr * 64 + fr) * ldo + u.i1 * BM + wc * 32 + 8 * fq;
#pragma unroll
        for (int ai = 0; ai < 2; ++ai)
#pragma unroll
            for (int m = 0; m < 4; ++m) { bf16_t* rowp = base + (size_t)(ai * HALF + m * 16) * ldo;
#pragma unroll
                for (int bj = 0; bj < 2; ++bj) { const f32x4 v0 = acc[ai][bj][m][0], v1 = acc[ai][bj][m][1];
                    u32x4 w; w.x = cvt_pk(v0[0], v0[1]); w.y = cvt_pk(v0[2], v0[3]); w.z = cvt_pk(v1[0], v1[1]); w.w = cvt_pk(v1[2], v1[3]);
                    *(u32x4*)(rowp + bj * HALF) = w; } }
    } };
struct EpiResBf { static constexpr bool PERM = true; const bf16_t* R; bf16_t* O; int ld;
    DEVI void mid(f32x4 (&)[2][2][4][2], const UnitU&, int, int, int, int) const {}
    DEVI void operator()(const f32x4 (&acc)[2][2][4][2], const UnitU& u, int wr, int wc, int fr, int fq) const {
        const size_t off0 = (size_t)(u.i0 * BM + wr * 64 + fr) * ld + u.i1 * BM + wc * 32 + 8 * fq;
#pragma unroll
        for (int ai = 0; ai < 2; ++ai) {
            u32x4 rr[4][2];
#pragma unroll
            for (int m = 0; m < 4; ++m)
#pragma unroll
                for (int bj = 0; bj < 2; ++bj) rr[m][bj] = *(const u32x4*)(R + off0 + (size_t)(ai * HALF + m * 16) * ld + bj * HALF);
#pragma unroll
            for (int m = 0; m < 4; ++m) { const size_t off = off0 + (size_t)(ai * HALF + m * 16) * ld;
#pragma unroll
                for (int bj = 0; bj < 2; ++bj) { const u32x4 r = rr[m][bj]; const f32x4 v0 = acc[ai][bj][m][0], v1 = acc[ai][bj][m][1];
                    u32x4 w; w.x = cvt_pk(bflo(r.x) + v0[0], bfhi(r.x) + v0[1]); w.y = cvt_pk(bflo(r.y) + v0[2], bfhi(r.y) + v0[3]);
                    w.z = cvt_pk(bflo(r.z) + v1[0], bfhi(r.z) + v1[1]); w.w = cvt_pk(bflo(r.w) + v1[2], bfhi(r.w) + v1[3]);
                    *(u32x4*)(O + off + bj * HALF) = w; } }
        }
    } };
struct EpiRes { static constexpr bool PERM = false; const float* R; float* O; int ld; bf16_t* H;
    DEVI void mid(f32x4 (&)[2][2][4][2], const UnitU&, int, int, int, int) const {}
    DEVI void operator()(const f32x4 (&acc)[2][2][4][2], const UnitU& u, int wr, int wc, int fr, int fq) const {
        const size_t off0 = (size_t)(u.i0 * BM + wr * 64 + fr) * ld + u.i1 * BM + wc * 32 + 4 * fq;
#pragma unroll
        for (int ai = 0; ai < 2; ++ai)
#pragma unroll
            for (int m = 0; m < 4; ++m) { const size_t off = off0 + (size_t)(ai * HALF + m * 16) * ld;
#pragma unroll
                for (int bj = 0; bj < 2; ++bj)
#pragma unroll
                    for (int n = 0; n < 2; ++n) { const f32x4 r = *(const f32x4*)(R + off + bj * HALF + n * 16); const f32x4 o = r + acc[ai][bj][m][n];
                        *(f32x4*)(O + off + bj * HALF + n * 16) = o;
                        u32x2 w; w.x = cvt_pk(o[0], o[1]); w.y = cvt_pk(o[2], o[3]); *(u32x2*)(H + off + bj * HALF + n * 16) = w; } }
    } };
struct DenseSched2 {
    static constexpr bool GATHER = false;
    DenseSched D; int sub;
    DEVI void init(const bf16_t* A_, const bf16_t* Bt_, int M, int N, int K_, int G_, int c_) { D.init(A_, Bt_, M, N, K_, G_, c_); sub = 0; }
    UnitU pend;
    DEVI bool next(UnitU& u) {
        if (sub == 0) { if (!D.next(pend)) return false; u = pend; u.A = pend.A + (size_t)(D.K / 2) * 2; u.B = pend.B + (size_t)(D.K / 2) * 2; u.flags = 1; sub = 1; return true; }
        u = pend; u.flags = 2; sub = 0; return true;
    }
    DEVI void lane_va(const UnitU& u, int R0, int C0, int R1, int C1, unsigned& v00, unsigned& v01, unsigned& v10, unsigned& v11) const { D.lane_va(u, R0, C0, R1, C1, v00, v01, v10, v11); }
};
struct EpiResScale : EpiResBf { const float* ssq;
    DEVI void mid(f32x4 (&acc)[2][2][4][2], const UnitU& u, int wr, int wc, int fr, int fq) const {
        float2 sqv[2][4];
#pragma unroll
        for (int ai = 0; ai < 2; ++ai)
#pragma unroll
            for (int m = 0; m < 4; ++m) sqv[ai][m] = *(const float2*)(ssq + (size_t)(u.i0 * BM + ai * HALF + wr * 64 + m * 16 + fr) * 2);
#pragma unroll
        for (int ai = 0; ai < 2; ++ai)
#pragma unroll
            for (int m = 0; m < 4; ++m) {
                const float2 sq = sqv[ai][m];
                const float rs = rsqrtf((sq.x + sq.y) * (1.0f / 512.0f) + EPS);
#pragma unroll
                for (int bj = 0; bj < 2; ++bj)
#pragma unroll
                    for (int n = 0; n < 2; ++n) acc[ai][bj][m][n] *= rs;
            }
    } };
}

constexpr float LOG2E_C = 1.4426950408889634f;
DEVI void cumsum_task(const DP& p, int bh, char* lds) {
    const int tid = TIDX(), wid = tid >> 6, lane = tid & 63;
    const int b = bh >> 2, h = bh & 3;
    const float* logf = (const float*)(p.ws() + WS_LOGF);
    float* cumf = (float*)(p.ws() + WS_CUMF);
    float* wtot = (float*)lds;
    float v[4];
#pragma unroll
    for (int j = 0; j < 4; ++j) v[j] = logf[((size_t)b * S + tid * 4 + j) * 4 + h];
    v[1] += v[0]; v[2] += v[1]; v[3] += v[2];
    float incl = v[3];
#pragma unroll
    for (int d = 1; d < 64; d <<= 1) { const float t = __shfl_up(incl, d); if (lane >= d) incl += t; }
    if (lane == 63) wtot[wid] = incl;
    __syncthreads();
    float woff = 0.f;
    for (int w = 0; w < wid; ++w) woff += wtot[w];
    const float base = woff + incl - v[3];
    *(float4*)(cumf + (size_t)bh * S + tid * 4) = make_float4((base + v[0]) * LOG2E_C, (base + v[1]) * LOG2E_C, (base + v[2]) * LOG2E_C, (base + v[3]) * LOG2E_C);
    __syncthreads();
}
DEVI void phase_inproj(const DP& p, int l, char* lds) {
    unsigned char* ws = p.ws();
    for (int t = BIDX(); t < 32; t += gridDim.x) cumsum_task(p, t, lds);
    g8::DenseSched S; S.init((const bf16_t*)(ws + WS_HBUF), (const bf16_t*)(ws + WS_W_IN), T, NPROJ, DM, gridDim.x, BIDX());
    g8::EpiBf16Scale E{(bf16_t*)(ws + WS_PROJ), NPROJ, (const float*)(ws + WS_RSTD1)};
    g8::gemm8(lds, DM, DM, S, E);
}
DEVI void kv_gemm(const DP& p, char* lds) {
    unsigned char* ws = p.ws();
    const int c = BIDX() - ((int)gridDim.x - 64);
    if (c < 0) return;
    g8::DenseSched S; S.init((const bf16_t*)(ws + WS_MEMN), (const bf16_t*)(ws + WS_W_KV), MROWS, 2 * DM, DM, 64, c);
    g8::EpiBf16 E{(bf16_t*)(ws + WS_KV), 2 * DM};
    g8::gemm8(lds, DM, DM, S, E);
}

DEVI void conv8_pos(const DP& p, int l, const bf16_t* proj, int b, int sp, int chan0, float (&out)[8]) {
    float a[8];
    const float* cb = p.in(10) + l * 1024 + chan0;
#pragma unroll
    for (int i = 0; i < 8; ++i) a[i] = cb[i];
#pragma unroll
    for (int j = 0; j < 4; ++j) {
        const int s2 = sp - 3 + j;
        if (s2 >= 0) {
            const u32x4 w = *(const u32x4*)(proj + ((size_t)b * S + s2) * NPROJ + C_XBC + chan0);
            const float* cw = p.in(9) + ((size_t)l * 4 + j) * 1024 + chan0;
            a[0] += cw[0] * bflo(w.x); a[1] += cw[1] * bfhi(w.x); a[2] += cw[2] * bflo(w.y); a[3] += cw[3] * bfhi(w.y);
            a[4] += cw[4] * bflo(w.z); a[5] += cw[5] * bfhi(w.z); a[6] += cw[6] * bflo(w.w); a[7] += cw[7] * bfhi(w.w);
        }
    }
#pragma unroll
    for (int i = 0; i < 8; ++i) out[i] = silu_f(a[i]);
}
DEVI u32x4 pack8(const float (&v)[8]) { u32x4 w; w.x = cvt_pk(v[0], v[1]); w.y = cvt_pk(v[2], v[3]); w.z = cvt_pk(v[4], v[5]); w.w = cvt_pk(v[6], v[7]); return w; }


DEVI void phase_post(const DP& p, int l) {
    const int tid = TIDX(), wid = tid >> 6, lane = tid & 63;
    unsigned char* ws = p.ws();
    bf16_t* proj = (bf16_t*)(ws + WS_PROJ);
    const int sl = lane >> 2, qt = lane & 3, type = sl >> 2, head = sl & 3;
    const int col0 = (type < 2 ? type * 256 : 768 + (type - 2) * 256) + head * 64 + qt * 16;
    const float *gq0 = p.in(5), *gq1 = p.in(6), *gq2 = p.in(7), *gq3 = p.in(8);
    asm volatile("" : "+s"(gq0), "+s"(gq1), "+s"(gq2), "+s"(gq3));
    const float* gain = (type == 0 ? gq0 : type == 1 ? gq1 : type == 2 ? gq2 : gq3) + l * 64 + qt * 16;
    float gv[16];
#pragma unroll
    for (int i = 0; i < 16; ++i) gv[i] = gain[i];
    const float inv[8] = {1.000000000e+00f, 1.939227432e-01f, 3.760603070e-02f, 7.292664610e-03f, 1.414213562e-03f, 2.742481884e-04f, 5.318295734e-05f, 1.031338525e-05f};
    for (int row = BIDX() * 8 + wid; row < T; row += gridDim.x * 8) {
        bf16_t* ptr = proj + (size_t)row * NPROJ + col0;
        const u32x4 w0 = *(const u32x4*)ptr, w1 = *(const u32x4*)(ptr + 8);
        float v[16];
        v[0] = bflo(w0.x); v[1] = bfhi(w0.x); v[2] = bflo(w0.y); v[3] = bfhi(w0.y); v[4] = bflo(w0.z); v[5] = bfhi(w0.z); v[6] = bflo(w0.w); v[7] = bfhi(w0.w);
        v[8] = bflo(w1.x); v[9] = bfhi(w1.x); v[10] = bflo(w1.y); v[11] = bfhi(w1.y); v[12] = bflo(w1.z); v[13] = bfhi(w1.z); v[14] = bflo(w1.w); v[15] = bfhi(w1.w);
        float ss = 0.f;
#pragma unroll
        for (int i = 0; i < 16; ++i) ss += v[i] * v[i];
        ss += __shfl_xor(ss, 1); ss += __shfl_xor(ss, 2);
        const float rstd = rsqrtf(ss * (1.0f / 64.0f) + EPS);
        const float qs = (type == 0 || type == 2) ? rstd * (0.125f * 1.4426950408889634f) : rstd;
#pragma unroll
        for (int i = 0; i < 16; ++i) v[i] = v[i] * qs * gv[i];
        if (type >= 2 && qt == 0) {
            const float pos = (float)(row & (S - 1));
#pragma unroll
            for (int i = 0; i < 8; ++i) { float sn, cs; sincosf(pos * inv[i], &sn, &cs);
                const float a = v[i], b = v[i + 8]; v[i] = a * cs - b * sn; v[i + 8] = b * cs + a * sn; }
        }
        u32x4 o0, o1;
        o0.x = cvt_pk(v[0], v[1]); o0.y = cvt_pk(v[2], v[3]); o0.z = cvt_pk(v[4], v[5]); o0.w = cvt_pk(v[6], v[7]);
        o1.x = cvt_pk(v[8], v[9]); o1.y = cvt_pk(v[10], v[11]); o1.z = cvt_pk(v[12], v[13]); o1.w = cvt_pk(v[14], v[15]);
        *(u32x4*)ptr = o0; *(u32x4*)(ptr + 8) = o1;
    }
    bf16_t* xc = (bf16_t*)(ws + WS_XC);
    for (int item = BIDX() * NTHR + tid; item < T * 128; item += gridDim.x * NTHR) {
        const int t = item >> 7, c8 = (item & 127) * 8;
        float v[8]; conv8_pos(p, l, proj, t / S, t % S, c8, v);
        *(u32x4*)(xc + (size_t)t * 1024 + c8) = pack8(v);
    }
}
DEVI void phase_knorm(const DP& p, int l) {
    const int tid = TIDX(), wid = tid >> 6, lane = tid & 63;
    unsigned char* ws = p.ws();
    bf16_t* kv = (bf16_t*)(ws + WS_KV);
    const float* kg = p.in(21) + l * 256 + (lane & 15) * 16;
    float kgv[16];
#pragma unroll
    for (int i = 0; i < 16; ++i) kgv[i] = kg[i];
    for (int row = BIDX() * 8 + wid; row < MROWS; row += gridDim.x * 8) {
        bf16_t* ptr = kv + (size_t)row * 2 * DM + lane * 16;
        const u32x4 w0 = *(const u32x4*)ptr, w1 = *(const u32x4*)(ptr + 8);
        float v[16];
        v[0] = bflo(w0.x); v[1] = bfhi(w0.x); v[2] = bflo(w0.y); v[3] = bfhi(w0.y); v[4] = bflo(w0.z); v[5] = bfhi(w0.z); v[6] = bflo(w0.w); v[7] = bfhi(w0.w);
        v[8] = bflo(w1.x); v[9] = bfhi(w1.x); v[10] = bflo(w1.y); v[11] = bfhi(w1.y); v[12] = bflo(w1.z); v[13] = bfhi(w1.z); v[14] = bflo(w1.w); v[15] = bfhi(w1.w);
        float ss = 0.f;
#pragma unroll
        for (int i = 0; i < 16; ++i) ss += v[i] * v[i];
        ss += __shfl_xor(ss, 1); ss += __shfl_xor(ss, 2); ss += __shfl_xor(ss, 4); ss += __shfl_xor(ss, 8);
        const float rstd = rsqrtf(ss * (1.0f / 256.0f) + EPS);
#pragma unroll
        for (int i = 0; i < 16; ++i) v[i] = v[i] * rstd * kgv[i];
        u32x4 o0, o1;
        o0.x = cvt_pk(v[0], v[1]); o0.y = cvt_pk(v[2], v[3]); o0.z = cvt_pk(v[4], v[5]); o0.w = cvt_pk(v[6], v[7]);
        o1.x = cvt_pk(v[8], v[9]); o1.y = cvt_pk(v[10], v[11]); o1.z = cvt_pk(v[12], v[13]); o1.w = cvt_pk(v[14], v[15]);
        *(u32x4*)ptr = o0; *(u32x4*)(ptr + 8) = o1;
    }
}
constexpr float LOG2E = 1.4426950408889634f;
template <int DH> struct AttnLds { static constexpr int KST = DH + 8; static constexpr int TILE = 64 * KST; static constexpr int BYTES = 4 * TILE * 2; };
DEVI float xor16_max(float v) { return fmaxf(v, __shfl_xor(v, 16)); }
DEVI float xor32_max(float v) { auto r = __builtin_amdgcn_permlane32_swap(__float_as_uint(v), __float_as_uint(v), false, false); return fmaxf(__uint_as_float(r[0]), __uint_as_float(r[1])); }
DEVI float xor32_sum(float v) { auto r = __builtin_amdgcn_permlane32_swap(__float_as_uint(v), __float_as_uint(v), false, false); return __uint_as_float(r[0]) + __uint_as_float(r[1]); }
template <int DH, int MODE>
DEVI void attn_task(const bf16_t* __restrict__ Qb, int ldq, int qtok0, int qstep,
                    const bf16_t* __restrict__ Kb, const bf16_t* __restrict__ Vb, int ldk, int ktok0, int kstep,
                    int p0, int kt_lo, int kt_hi, float scale,
                    const float* __restrict__ cum, const float* __restrict__ qgain,
                    bf16_t* Ob, int ldo, float* Of, float* Om, float* Ol, char* lds) {
    constexpr int KST = AttnLds<DH>::KST, TILE = AttnLds<DH>::TILE, NKK = DH / 32, ND = DH / 16, NCH = (64 * DH / 8) / NTHR;
    const int tid = TIDX(), wid = tid >> 6, lane = tid & 63, r16 = lane & 15, g4 = lane >> 4;
    bf16_t* Ks = (bf16_t*)lds;
    bf16_t* Vs = Ks + 2 * TILE;
    const float c2 = scale * LOG2E;
    bf16x8 qf[NKK];
    {
        const bf16_t* qp = Qb + (size_t)(qtok0 + (p0 + wid * 16 + r16) * qstep) * ldq + g4 * 8;
#pragma unroll
        for (int kk = 0; kk < NKK; ++kk) qf[kk] = *(const bf16x8*)(qp + kk * 32);
    }
    if (MODE == 2) {
        float ss = 0.f;
#pragma unroll
        for (int kk = 0; kk < NKK; ++kk)
#pragma unroll
            for (int j = 0; j < 8; ++j) { const float v = bf2f((bf16_t)qf[kk][j]); ss += v * v; }
        ss += __shfl_xor(ss, 16); ss += __shfl_xor(ss, 32);
        const float rstd = rsqrtf(ss * (1.0f / DH) + EPS);
#pragma unroll
        for (int kk = 0; kk < NKK; ++kk)
#pragma unroll
            for (int j = 0; j < 8; ++j) { const float v = bf2f((bf16_t)qf[kk][j]) * (rstd * c2) * qgain[kk * 32 + g4 * 8 + j]; qf[kk][j] = (short)f2bf(v); }
    }
    const int qpos = p0 + wid * 16 + r16;
    float m_ = -1.0e30f, l_ = 0.f;
    const float cq = (MODE == 0) ? cum[qpos] : 0.f;
    f32x4 o[ND];
#pragma unroll
    for (int n = 0; n < ND; ++n) o[n] = (f32x4){0.f, 0.f, 0.f, 0.f};
    u32x4 rk[NCH], rv[NCH];
    auto gload = [&](int kt) {
#pragma unroll
        for (int i = 0; i < NCH; ++i) { const int c = tid + i * NTHR, key = c / (DH / 8), dc = c % (DH / 8);
            const size_t tok = (size_t)(ktok0 + (kt * 64 + key) * kstep);
            rk[i] = *(const u32x4*)(Kb + tok * ldk + dc * 8); rv[i] = *(const u32x4*)(Vb + tok * ldk + dc * 8); }
    };
    gload(kt_lo);
    __syncthreads();
    int buf = 0;
    for (int kt = kt_lo; kt < kt_hi; ++kt, buf ^= 1) {
        bf16_t* Kt = Ks + buf * TILE;
        bf16_t* Vt = Vs + buf * TILE;
#pragma unroll
        for (int i = 0; i < NCH; ++i) { const int c = tid + i * NTHR, key = c / (DH / 8), dc = c % (DH / 8);
            *(u32x4*)(Kt + key * KST + dc * 8) = rk[i]; *(u32x4*)(Vt + key * KST + dc * 8) = rv[i]; }
        __syncthreads();
        if (kt + 1 < kt_hi) gload(kt + 1);
        const int qmin = p0 + wid * 16, kmin = kt * 64;
        bool skip = false, interior = true;
        if (MODE == 0) { skip = kmin > qmin + 15; interior = kmin + 63 <= qmin; }
        if (MODE == 1) { skip = (qmin + 15 - kmin < 0) || (qmin - (kmin + 63) > 128); interior = (qmin - (kmin + 63) >= 0) && (qmin + 15 - kmin <= 128); }
        if (skip) continue;
        f32x4 s[4];
#pragma unroll
        for (int n = 0; n < 4; ++n) {
            s[n] = (f32x4){0.f, 0.f, 0.f, 0.f};
#pragma unroll
            for (int kk = 0; kk < NKK; ++kk) {
                const bf16x8 kf = *(const bf16x8*)(Kt + (n * 16 + r16) * KST + kk * 32 + g4 * 8);
                s[n] = MFMA16(kf, qf[kk], s[n]);
            }
            if (DH > 64) __builtin_amdgcn_sched_barrier(0);
        }
        float mx = -INFINITY;
#pragma unroll
        for (int n = 0; n < 4; ++n) {
            f32x4 ck = (f32x4){0.f, 0.f, 0.f, 0.f};
            if (MODE == 0) ck = *(const f32x4*)(cum + kt * 64 + n * 16 + g4 * 4);
#pragma unroll
            for (int j = 0; j < 4; ++j) {
                float t = s[n][j];
                if (MODE == 0) t += cq - ck[j];
                if (!interior) {
                    const int kpos = kt * 64 + n * 16 + g4 * 4 + j;
                    if (MODE == 0) { if (kpos > qpos) t = -INFINITY; }
                    if (MODE == 1) { const int dd = qpos - kpos; if (dd < 0 || dd > 128) t = -INFINITY; }
                }
                s[n][j] = t; mx = fmaxf(mx, t);
            }
        }
        mx = xor32_max(xor16_max(mx));
        const float mn = fmaxf(m_, mx);
        const float alpha = __builtin_amdgcn_exp2f(m_ - mn);
        float rs = 0.f;
#pragma unroll
        for (int n = 0; n < 4; ++n)
#pragma unroll
            for (int j = 0; j < 4; ++j) { const float pv = __builtin_amdgcn_exp2f(s[n][j] - mn); s[n][j] = pv; rs += pv; }
        rs += __shfl_xor(rs, 16); rs = xor32_sum(rs);
        l_ = l_ * alpha + rs; m_ = mn;
#pragma unroll
        for (int n = 0; n < ND; ++n) o[n] *= alpha;
#pragma unroll
        for (int kk = 0; kk < 2; ++kk) {
            bf16x8 pb;
            { const unsigned w0 = cvt_pk(s[2 * kk][0], s[2 * kk][1]), w1 = cvt_pk(s[2 * kk][2], s[2 * kk][3]), w2 = cvt_pk(s[2 * kk + 1][0], s[2 * kk + 1][1]), w3 = cvt_pk(s[2 * kk + 1][2], s[2 * kk + 1][3]);
              u32x4 w; w.x = w0; w.y = w1; w.z = w2; w.w = w3; pb = __builtin_bit_cast(bf16x8, w); }
            const bf16_t* vb = Vt + (kk * 32 + 4 * g4 + (r16 >> 2)) * KST + 4 * (r16 & 3);
#pragma unroll
            for (int n = 0; n < ND; ++n) {
                const s16x4 lo = tr_read(vb + n * 16), hi = tr_read(vb + 16 * KST + n * 16);
                bf16x8 vf; vf[0] = lo[0]; vf[1] = lo[1]; vf[2] = lo[2]; vf[3] = lo[3]; vf[4] = hi[0]; vf[5] = hi[1]; vf[6] = hi[2]; vf[7] = hi[3];
                o[n] = MFMA16(vf, pb, o[n]);
                if (DH > 64 && (n & 3) == 3) __builtin_amdgcn_sched_barrier(0);
            }
        }
    }
    const size_t tok = (size_t)(qtok0 + qpos * qstep);
    if (MODE == 1) {
#pragma unroll
        for (int n = 0; n < ND; ++n) *(f32x4*)(Of + tok * 256 + n * 16 + g4 * 4) = o[n];
        if (g4 == 0) { Om[tok * 4] = m_; Ol[tok * 4] = l_; }
    } else {
        const float inv = 1.0f / l_;
#pragma unroll
        for (int n = 0; n < ND; ++n) { u32x2 w; w.x = cvt_pk(o[n][0] * inv, o[n][1] * inv); w.y = cvt_pk(o[n][2] * inv, o[n][3] * inv);
            *(u32x2*)(Ob + tok * ldo + n * 16 + g4 * 4) = w; }
    }
}

DEVI void ssd_acs(const DP& p, int l, int b, int c, int g, float* acs, float* dts) {
    const int tid = TIDX(), wid = tid >> 6, lane = tid & 63;
    if (wid < 4) {
        const int head = g * 4 + wid;
        const float* dtv = (const float*)(p.ws() + WS_DTV);
        const float A = -__expf(p.in(12)[l * 8 + head]);
        const size_t t0 = (size_t)b * S + c * 128 + 2 * lane;
        const float d0 = dtv[t0 * 8 + head], d1 = dtv[(t0 + 1) * 8 + head];
        const float a0 = d0 * A, a1 = d1 * A;
        float incl = a0 + a1;
#pragma unroll
        for (int d = 1; d < 64; d <<= 1) { const float t = __shfl_up(incl, d); if (lane >= d) incl += t; }
        const float ex = incl - (a0 + a1);
        acs[wid * 128 + 2 * lane] = ex + a0; acs[wid * 128 + 2 * lane + 1] = ex + a0 + a1;
        dts[wid * 128 + 2 * lane] = d0; dts[wid * 128 + 2 * lane + 1] = d1;
    }
}
DEVI void conv8_chan(const DP& p, int l, const bf16_t* proj, int b, int c, int chan, int l0, float (&out)[8]) {
    const float* cw = p.in(9) + (size_t)l * 4 * 1024 + chan;
    const float w0 = cw[0], w1 = cw[1024], w2 = cw[2048], w3 = cw[3072], cb = p.in(10)[l * 1024 + chan];
    float v[11];
    const int sbase = c * 128 + l0 - 3;
#pragma unroll
    for (int i = 0; i < 11; ++i) { const int sp = sbase + i; v[i] = sp >= 0 ? bf2f(proj[((size_t)b * S + sp) * NPROJ + C_XBC + chan]) : 0.f; }
#pragma unroll
    for (int i = 0; i < 8; ++i) out[i] = silu_f(cb + w0 * v[i] + w1 * v[i + 1] + w2 * v[i + 2] + w3 * v[i + 3]);
}
constexpr int SST = 136;
constexpr int XST4 = 264;
DEVI void ssd_states_task(const DP& p, int l, int b, int c, int g, char* lds) {
    const int tid = TIDX(), wid = tid >> 6, lane = tid & 63, r16 = lane & 15, g4 = lane >> 4;
    const bf16_t* xc = (const bf16_t*)(p.ws() + WS_XC);
    bf16_t* Bn = (bf16_t*)lds;
    bf16_t* Xn = Bn + 128 * SST;
    float* acs = (float*)(Xn + 128 * XST4);
    float* dts = acs + 512;
    __syncthreads();
    ssd_acs(p, l, b, c, g, acs, dts);
    __syncthreads();
    if (tid < 4) ((float*)(p.ws() + WS_DECAY))[((size_t)b * 16 + c) * 8 + g * 4 + tid] = __expf(acs[tid * 128 + 127]);
    const size_t tok0 = (size_t)b * S + c * 128;
    for (int it = tid; it < 2048; it += NTHR) {
        const int ll = it >> 4, nc = (it & 15) * 8;
        *(u32x4*)(Bn + ll * SST + nc) = *(const u32x4*)(xc + (tok0 + ll) * 1024 + 512 + g * 128 + nc);
    }
    for (int it = tid; it < 4096; it += NTHR) {
        const int ll = it >> 5, ch = (it & 31) * 8, hl = ch >> 6;
        const u32x4 w = *(const u32x4*)(xc + (tok0 + ll) * 1024 + g * 256 + ch);
        const float sc = dts[hl * 128 + ll] * __expf(acs[hl * 128 + 127] - acs[hl * 128 + ll]);
        u32x4 o; o.x = cvt_pk(bflo(w.x) * sc, bfhi(w.x) * sc); o.y = cvt_pk(bflo(w.y) * sc, bfhi(w.y) * sc); o.z = cvt_pk(bflo(w.z) * sc, bfhi(w.z) * sc); o.w = cvt_pk(bflo(w.w) * sc, bfhi(w.w) * sc);
        *(u32x4*)(Xn + ll * XST4 + ch) = o;
    }
    __syncthreads();
    const int hl = wid >> 1, nh = wid & 1;
    f32x4 acc[4][4];
#pragma unroll
    for (int m = 0; m < 4; ++m)
#pragma unroll
        for (int n = 0; n < 4; ++n) acc[m][n] = (f32x4){0.f, 0.f, 0.f, 0.f};
#pragma unroll
    for (int kk = 0; kk < 4; ++kk) {
        bf16x8 af[4], bfr[4];
        const int lrow = kk * 32 + 8 * g4 + (r16 >> 2), cq = 4 * (r16 & 3);
#pragma unroll
        for (int m = 0; m < 4; ++m) { const bf16_t* a = Xn + lrow * XST4 + hl * 64 + m * 16 + cq; const s16x4 lo = tr_read(a), hi = tr_read(a + 4 * XST4);
            af[m][0] = lo[0]; af[m][1] = lo[1]; af[m][2] = lo[2]; af[m][3] = lo[3]; af[m][4] = hi[0]; af[m][5] = hi[1]; af[m][6] = hi[2]; af[m][7] = hi[3]; }
#pragma unroll
        for (int n = 0; n < 4; ++n) { const bf16_t* a = Bn + lrow * SST + nh * 64 + n * 16 + cq; const s16x4 lo = tr_read(a), hi = tr_read(a + 4 * SST);
            bfr[n][0] = lo[0]; bfr[n][1] = lo[1]; bfr[n][2] = lo[2]; bfr[n][3] = lo[3]; bfr[n][4] = hi[0]; bfr[n][5] = hi[1]; bfr[n][6] = hi[2]; bfr[n][7] = hi[3]; }
#pragma unroll
        for (int m = 0; m < 4; ++m)
#pragma unroll
            for (int n = 0; n < 4; ++n) acc[m][n] = MFMA16(bfr[n], af[m], acc[m][n]);
    }
    float* st = (float*)(p.ws() + WS_SSTATE) + (((size_t)b * 16 + c) * 8 + g * 4 + hl) * 8192;
#pragma unroll
    for (int m = 0; m < 4; ++m)
#pragma unroll
        for (int n = 0; n < 4; ++n) *(f32x4*)(st + (m * 16 + r16) * 128 + nh * 64 + n * 16 + g4 * 4) = acc[m][n];
}
DEVI void phase_ssd_scan(const DP& p) {
    const float* st = (const float*)(p.ws() + WS_SSTATE);
    bf16_t* hin = (bf16_t*)(p.ws() + WS_HIN);
    const float* decay = (const float*)(p.ws() + WS_DECAY);
    const int total = NB * 8 * 2048;
    for (int i = BIDX() * NTHR + TIDX(); i < total; i += gridDim.x * NTHR) {
        const int e4 = i & 2047, head = (i >> 11) & 7, b = i >> 14;
        f32x4 h = (f32x4){0.f, 0.f, 0.f, 0.f};
        for (int c = 0; c < 16; ++c) {
            const size_t off = (((size_t)b * 16 + c) * 8 + head) * 8192 + e4 * 4;
            u32x2 w; w.x = cvt_pk(h[0], h[1]); w.y = cvt_pk(h[2], h[3]);
            *(u32x2*)(hin + off) = w;
            const f32x4 s = *(const f32x4*)(st + off);
            const float d = decay[((size_t)b * 16 + c) * 8 + head];
            h = h * d + s;
        }
    }
}
constexpr int XST1 = 72;
DEVI void ssd_out_task(const DP& p, int l, int b, int c, int g, char* lds) {
    const int tid = TIDX(), wid = tid >> 6, lane = tid & 63, r16 = lane & 15, g4 = lane >> 4;
    const bf16_t* proj = (const bf16_t*)(p.ws() + WS_PROJ);
    const bf16_t* xc = (const bf16_t*)(p.ws() + WS_XC);
    bf16_t* Cs = (bf16_t*)lds;
    bf16_t* Bs = Cs + 128 * SST;
    bf16_t* Xn = Bs + 128 * SST;
    bf16_t* Hs = Xn + 128 * XST1;
    bf16_t* Mw = Hs + 64 * SST + wid * 16 * SST;
    float* acs = (float*)(Hs + 64 * SST + 8 * 16 * SST);
    float* dts = acs + 512;
    const int lrow = wid * 16 + r16;
    const size_t tok0 = (size_t)b * S + c * 128, tok = tok0 + lrow;
    bf16_t* mix = (bf16_t*)(p.ws() + WS_MIX);
    float ssq = 0.f;
    __syncthreads();
    ssd_acs(p, l, b, c, g, acs, dts);
    for (int it = tid; it < 2048; it += NTHR) {
        const int ll = it >> 4, nc = (it & 15) * 8;
        *(u32x4*)(Cs + ll * SST + nc) = *(const u32x4*)(xc + (tok0 + ll) * 1024 + 768 + g * 128 + nc);
        *(u32x4*)(Bs + ll * SST + nc) = *(const u32x4*)(xc + (tok0 + ll) * 1024 + 512 + g * 128 + nc);
    }
    __syncthreads();
    bf16x8 cfr[4];
#pragma unroll
    for (int kk = 0; kk < 4; ++kk) cfr[kk] = *(const bf16x8*)(Cs + lrow * SST + kk * 32 + g4 * 8);
    f32x4 cb[8];
#pragma unroll
    for (int st = 0; st < 8; ++st) {
        cb[st] = (f32x4){0.f, 0.f, 0.f, 0.f};
#pragma unroll
        for (int kk = 0; kk < 4; ++kk) {
            const bf16x8 bfr = *(const bf16x8*)(Bs + (st * 16 + r16) * SST + kk * 32 + g4 * 8);
            cb[st] = MFMA16(bfr, cfr[kk], cb[st]);
        }
    }
    for (int hl = 0; hl < 4; ++hl) {
        const int head = g * 4 + hl;
        __syncthreads();
        for (int it = tid; it < 1024; it += NTHR) {
            const int ss = it >> 3, pc8 = (it & 7) * 8;
            *(u32x4*)(Xn + ss * XST1 + pc8) = *(const u32x4*)(xc + (tok0 + ss) * 1024 + head * 64 + pc8);
            const bf16_t* hsrc = (const bf16_t*)(p.ws() + WS_HIN) + (((size_t)b * 16 + c) * 8 + head) * 8192 + (size_t)it * 8;
            *(u32x4*)(Hs + (it >> 4) * SST + (it & 15) * 8) = *(const u32x4*)hsrc;
        }
        __syncthreads();
        const float al = acs[hl * 128 + lrow];
#pragma unroll
        for (int st = 0; st < 8; ++st) {
            float mv[4];
#pragma unroll
            for (int j = 0; j < 4; ++j) { const int sidx = st * 16 + g4 * 4 + j;
                mv[j] = (sidx <= lrow) ? cb[st][j] * __expf(al - acs[hl * 128 + sidx]) * dts[hl * 128 + sidx] : 0.f; }
            u32x2 w; w.x = cvt_pk(mv[0], mv[1]); w.y = cvt_pk(mv[2], mv[3]);
            *(u32x2*)(Mw + r16 * SST + st * 16 + g4 * 4) = w;
        }
        __builtin_amdgcn_wave_barrier();
        asm volatile("s_waitcnt lgkmcnt(0)" ::: "memory");
        f32x4 yd[4], yo[4];
#pragma unroll
        for (int pt = 0; pt < 4; ++pt) { yd[pt] = (f32x4){0.f, 0.f, 0.f, 0.f}; yo[pt] = (f32x4){0.f, 0.f, 0.f, 0.f}; }
#pragma unroll
        for (int kk = 0; kk < 4; ++kk) {
            const bf16x8 mf = *(const bf16x8*)(Mw + r16 * SST + kk * 32 + g4 * 8);
            const bf16_t* xa = Xn + (kk * 32 + 8 * g4 + (r16 >> 2)) * XST1 + 4 * (r16 & 3);
#pragma unroll
            for (int pt = 0; pt < 4; ++pt) {
                const s16x4 lo = tr_read(xa + pt * 16), hi = tr_read(xa + 4 * XST1 + pt * 16);
                bf16x8 xf; xf[0] = lo[0]; xf[1] = lo[1]; xf[2] = lo[2]; xf[3] = lo[3]; xf[4] = hi[0]; xf[5] = hi[1]; xf[6] = hi[2]; xf[7] = hi[3];
                yd[pt] = MFMA16(xf, mf, yd[pt]);
                const bf16x8 hf = *(const bf16x8*)(Hs + (pt * 16 + r16) * SST + kk * 32 + g4 * 8);
                yo[pt] = MFMA16(hf, cfr[kk], yo[pt]);
            }
        }
        __builtin_amdgcn_wave_barrier();
        const float el = __expf(al), Dh = p.in(13)[l * 8 + head];
#pragma unroll
        for (int pt = 0; pt < 4; ++pt) {
            const int pc = pt * 16 + g4 * 4;
            const u32x2 zw = *(const u32x2*)(proj + tok * NPROJ + C_Z + head * 64 + pc);
            const u32x2 xw = *(const u32x2*)(Xn + lrow * XST1 + pc);
            const float zz[4] = {bflo(zw.x), bfhi(zw.x), bflo(zw.y), bfhi(zw.y)};
            const float xx[4] = {bflo(xw.x), bfhi(xw.x), bflo(xw.y), bfhi(xw.y)};
            float gv[4];
#pragma unroll
            for (int j = 0; j < 4; ++j) { const float yv = yd[pt][j] + el * yo[pt][j] + Dh * xx[j]; gv[j] = yv * silu_f(zz[j]); ssq += gv[j] * gv[j]; }
            u32x2 w; w.x = cvt_pk(gv[0], gv[1]); w.y = cvt_pk(gv[2], gv[3]);
            *(u32x2*)(mix + tok * DM + 512 + head * 64 + pc) = w;
        }
    }
    ssq += __shfl_xor(ssq, 16); ssq += __shfl_xor(ssq, 32);
    if (g4 == 0) ((float*)(p.ws() + WS_SSQ))[tok * 2 + g] = ssq;
}
constexpr int N_FOX = 512, N_S1 = 256, N_DIL = 1536;
DEVI void phase_mix1(const DP& p, int l, char* lds) {
    unsigned char* ws = p.ws();
    kv_gemm(p, lds);
    const bf16_t* proj = (const bf16_t*)(ws + WS_PROJ);
    bf16_t* mix = (bf16_t*)(ws + WS_MIX);
    for (int t = BIDX(); t < N_FOX + N_S1; t += gridDim.x) {
        if (t < N_FOX) {
            const int bh = t & 31, k = t >> 5;
            const int qb = k < 8 ? 15 - k : k - 8;
            const int b = bh >> 2, h = bh & 3;
            const float* cum = (const float*)(ws + WS_CUMF) + (size_t)bh * S;
            attn_task<64, 0>(proj + C_FQ + h * 64, NPROJ, b * S, 1, proj + C_FK + h * 64, proj + C_FV + h * 64, NPROJ, b * S, 1,
                             qb * 128, 0, 2 * qb + 2, 0.125f, cum, nullptr, mix + h * 64, DM, nullptr, nullptr, nullptr, lds);
        } else {
            const int u = t - N_FOX, g = u & 1, c = (u >> 1) & 15, b = u >> 5;
            ssd_states_task(p, l, b, c, g, lds);
        }
    }
    const int ndw = (int)gridDim.x > 64 ? (int)gridDim.x - 64 : (int)gridDim.x;
    if (BIDX() < ndw) {
        for (int u = BIDX(); u < N_DIL; u += ndw) {
            const int bh = u & 31, v = u >> 5;
            const int b = bh >> 2, h = bh & 3;
            int br, dil, r, pb;
            if (v < 16) { br = 0; dil = 1; r = 0; pb = v; }
            else if (v < 32) { br = 1; dil = 4; r = (v - 16) & 3; pb = (v - 16) >> 2; }
            else { br = 2; dil = 16; r = v - 32; pb = 0; }
            float* Of = (float*)(ws + WS_DILO) + (size_t)br * T * 256 + h * 64;
            float* Om = (float*)(ws + WS_DILM) + (size_t)br * T * 4 + h;
            float* Ol = (float*)(ws + WS_DILL) + (size_t)br * T * 4 + h;
            const int klo = pb > 0 ? 2 * pb - 2 : 0;
            attn_task<64, 1>(proj + C_DQ + h * 64, NPROJ, b * S + r, dil, proj + C_DK + h * 64, proj + C_DV + h * 64, NPROJ, b * S + r, dil,
                             pb * 128, klo, 2 * pb + 2, 0.125f, nullptr, nullptr, nullptr, 0, Of, Om, Ol, lds);
        }
    }
}
DEVI void phase_mix3(const DP& p, int l, char* lds) {
    unsigned char* ws = p.ws();
    for (int t = BIDX(); t < NB * 16 * 2; t += gridDim.x) ssd_out_task(p, l, t >> 5, (t >> 1) & 15, t & 1, lds);
    const int tid = TIDX(), wid = tid >> 6, lane = tid & 63, head = lane >> 4, d4 = (lane & 15) * 4;
    const float* Of = (const float*)(ws + WS_DILO);
    const float* Om = (const float*)(ws + WS_DILM);
    const float* Ol = (const float*)(ws + WS_DILL);
    bf16_t* mix = (bf16_t*)(ws + WS_MIX);
    for (int row = BIDX() * 8 + wid; row < T; row += gridDim.x * 8) {
        float m[3], lsum[3];
#pragma unroll
        for (int br = 0; br < 3; ++br) { m[br] = Om[((size_t)br * T + row) * 4 + head]; lsum[br] = Ol[((size_t)br * T + row) * 4 + head]; }
        const float M = fmaxf(m[0], fmaxf(m[1], m[2]));
        f32x4 num = (f32x4){0.f, 0.f, 0.f, 0.f}; float den = 0.f;
#pragma unroll
        for (int br = 0; br < 3; ++br) {
            const float w = __builtin_amdgcn_exp2f(m[br] - M);
            const f32x4 o = *(const f32x4*)(Of + ((size_t)br * T + row) * 256 + head * 64 + d4);
            num += o * w; den += w * lsum[br];
        }
        const float inv = 1.0f / den;
        u32x2 w; w.x = cvt_pk(num[0] * inv, num[1] * inv); w.y = cvt_pk(num[2] * inv, num[3] * inv);
        *(u32x2*)(mix + (size_t)row * DM + 256 + head * 64 + d4) = w;
    }
}
DEVI void phase_xattn(const DP& p, int l, char* lds) {
    unsigned char* ws = p.ws();
    const bf16_t* qbuf = (const bf16_t*)(ws + WS_QBUF);
    const bf16_t* kv = (const bf16_t*)(ws + WS_KV);
    bf16_t* obuf = (bf16_t*)(ws + WS_OBUF);
    for (int t = BIDX(); t < NB * 4 * 16; t += gridDim.x) {
        const int qb = t & 15, h = (t >> 4) & 3, b = t >> 6;
        attn_task<256, 2>(qbuf + h * 256, DM, b * S, 1, kv + h * 256, kv + DM + h * 256, 2 * DM, b * MEMLEN, 1,
                          qb * 128, 0, 4, 0.0625f, nullptr, p.in(20) + l * 256, obuf + h * 256, DM, nullptr, nullptr, nullptr, lds);
    }
}
namespace g8 {
template <bool GATHER_> struct MoeSched {
    static constexpr bool GATHER = GATHER_;
    const int* cnt; const int* list; const char* Abase; const char* Bbase; size_t bstride; int K, G;
    int e, ubase, tbase, u;
    DEVI void init(const int* cnt_, const int* list_, const void* A_, const void* B_, size_t bstride_, int K_, int G_, int c_) {
        cnt = cnt_; list = list_; Abase = (const char*)A_; Bbase = (const char*)B_; bstride = bstride_; K = K_; G = G_; e = 0; ubase = 0; tbase = 0; u = c_; }
    DEVI bool next(UnitU& o) {
        while (e < NEXP) {
            const int ce = cnt[e], nte = (ce + BM - 1) / BM, nun = nte * 4;
            if (u < ubase + nun) {
                const int lu = u - ubase, pm = lu >> 2, pn = lu & 3;
                o.i0 = tbase + pm; o.i1 = pn; o.i2 = e * (2 * T) + pm * BM; o.i3 = ce - pm * BM; o.flags = 3;
                o.A = GATHER ? Abase : Abase + (size_t)(tbase + pm) * BM * K * 2;
                o.B = Bbase + (size_t)e * bstride + (size_t)pn * BM * K * 2;
                u += G; return true;
            }
            ubase += nun; tbase += nte; ++e;
        }
        return false;
    }
    DEVI void lane_va(const UnitU& o, int R0, int C0, int R1, int C1, unsigned& v00, unsigned& v01, unsigned& v10, unsigned& v11) const {
        if (GATHER) {
            const int nv = o.i3; const int* ent = list + o.i2;
            const int t00 = (ent[R0 < nv ? R0 : 0] & 0xffff) >> 1, t01 = (ent[R1 < nv ? R1 : 0] & 0xffff) >> 1, t10 = (ent[R0 + HALF < nv ? R0 + HALF : 0] & 0xffff) >> 1, t11 = (ent[R1 + HALF < nv ? R1 + HALF : 0] & 0xffff) >> 1;
            v00 = (unsigned)(t00 * K + C0) * 2u; v01 = (unsigned)(t01 * K + C1) * 2u; v10 = (unsigned)(t10 * K + C0) * 2u; v11 = (unsigned)(t11 * K + C1) * 2u;
        } else {
            v00 = (unsigned)(R0 * K + C0) * 2u; v01 = (unsigned)(R1 * K + C1) * 2u; v10 = v00 + (unsigned)(HALF * K * 2); v11 = v01 + (unsigned)(HALF * K * 2);
        }
    }
};
struct EpiSwiglu { static constexpr bool PERM = false; bf16_t* act;
    DEVI void mid(f32x4 (&)[2][2][4][2], const UnitU&, int, int, int, int) const {}
    DEVI void operator()(const f32x4 (&acc)[2][2][4][2], const UnitU& u, int wr, int wc, int fr, int fq) const {
        const int nv = u.i3;
#pragma unroll
        for (int ai = 0; ai < 2; ++ai)
#pragma unroll
            for (int m = 0; m < 4; ++m) {
                const int r = ai * HALF + wr * 64 + m * 16 + fr;
                if (r < nv) {
                    bf16_t* rowp = act + (size_t)(u.i0 * BM + r) * EFF + u.i1 * 128 + wc * 16 + 4 * fq;
#pragma unroll
                    for (int bj = 0; bj < 2; ++bj) { const f32x4 x1 = acc[ai][bj][m][0], x3 = acc[ai][bj][m][1];
                        u32x2 w; w.x = cvt_pk(silu_f(x1[0]) * x3[0], silu_f(x1[1]) * x3[1]); w.y = cvt_pk(silu_f(x1[2]) * x3[2], silu_f(x1[3]) * x3[3]);
                        *(u32x2*)(rowp + bj * 64) = w; }
                }
            }
    } };
struct EpiMoeOut { static constexpr bool PERM = true; bf16_t* y; const int* list;
    DEVI void mid(f32x4 (&)[2][2][4][2], const UnitU&, int, int, int, int) const {}
    DEVI void operator()(const f32x4 (&acc)[2][2][4][2], const UnitU& u, int wr, int wc, int fr, int fq) const {
        const int nv = u.i3; const int* ent = list + u.i2;
        unsigned env[2][4];
#pragma unroll
        for (int ai = 0; ai < 2; ++ai)
#pragma unroll
            for (int m = 0; m < 4; ++m) { const int r = ai * HALF + wr * 64 + m * 16 + fr; env[ai][m] = (unsigned)ent[r < nv ? r : 0]; }
#pragma unroll
        for (int ai = 0; ai < 2; ++ai)
#pragma unroll
            for (int m = 0; m < 4; ++m) {
                const int r = ai * HALF + wr * 64 + m * 16 + fr;
                if (r < nv) {
                    const unsigned en = env[ai][m]; const int a = (int)(en & 0xffffu); const float gt = __uint_as_float(en & 0xffff0000u);
                    bf16_t* rowp = y + (size_t)a * DM + u.i1 * BM + wc * 32 + 8 * fq;
#pragma unroll
                    for (int bj = 0; bj < 2; ++bj) { const f32x4 v0 = acc[ai][bj][m][0] * gt, v1 = acc[ai][bj][m][1] * gt;
                        u32x4 w; w.x = cvt_pk(v0[0], v0[1]); w.y = cvt_pk(v0[2], v0[3]); w.z = cvt_pk(v1[0], v1[1]); w.w = cvt_pk(v1[2], v1[3]);
                        *(u32x4*)(rowp + bj * HALF) = w; }
                }
            }
    } };
}
template <int WHICH>
DEVI void phase_moe(const DP& p, int l, char* lds) {
    unsigned char* ws = p.ws();
    const int* cnt = (const int*)(ws + WS_CNT) + l * 64;
    const int* list = (const int*)(ws + WS_LIST);
    if (WHICH == 0) {
        g8::MoeSched<true> S;
        S.init(cnt, list, ws + WS_H3, ws + WS_W_13, (size_t)1024 * DM * 2, DM, gridDim.x, BIDX());
        g8::EpiSwiglu E{(bf16_t*)(ws + WS_ACT)};
        g8::gemm8(lds, DM, DM, S, E);
    } else {
        g8::MoeSched<false> S;
        S.init(cnt, list, ws + WS_ACT, ws + WS_W_2, (size_t)DM * EFF * 2, EFF, gridDim.x, BIDX());
        g8::EpiMoeOut E{(bf16_t*)(ws + WS_YBUF), list};
        g8::gemm8(lds, EFF, EFF, S, E);
    }
}
DEVI void phase_final(const DP& p) {
    const int tid = TIDX(), wid = tid >> 6, lane = tid & 63;
    const bf16_t* ybuf = (const bf16_t*)(p.ws() + WS_YBUF);
    const bf16_t* h0 = (const bf16_t*)(p.ws() + WS_HBUF);
    float* out = p.out();
    for (int row = BIDX() * 8 + wid; row < T; row += gridDim.x * 8) {
        float x[16];
        load_row_bf16(h0 + (size_t)row * DM, x, lane);
        add_row_bf16_b(ybuf + (size_t)(2 * row) * DM, x, lane);
        add_row_bf16_b(ybuf + (size_t)(2 * row + 1) * DM, x, lane);
#pragma unroll
        for (int j = 0; j < 2; ++j) {
            *(float4*)(out + (size_t)row * DM + j * 512 + lane * 8) = make_float4(x[8 * j], x[8 * j + 1], x[8 * j + 2], x[8 * j + 3]);
            *(float4*)(out + (size_t)row * DM + j * 512 + lane * 8 + 4) = make_float4(x[8 * j + 4], x[8 * j + 5], x[8 * j + 6], x[8 * j + 7]);
        }
    }
}

#define XB_TMO      128
#define XB_XCNT(j)  (256  + 64 * (j))
#define XB_XSUB(j)  (1280 + 64 * (j))
#define XB_XGEN(j)  (2304 + 64 * (j))
#define XB_TOP      3328
#define XB_TOPGEN   3392
#define XCD_BAR_WORDS 3456
#define XB_SPIN_CAP (1u << 22)
DEVI unsigned xb_ld(unsigned* p)              { return __hip_atomic_load(p, __ATOMIC_RELAXED, __HIP_MEMORY_SCOPE_AGENT); }
DEVI unsigned xb_add(unsigned* p, unsigned v) { return __hip_atomic_fetch_add(p, v, __ATOMIC_RELAXED, __HIP_MEMORY_SCOPE_AGENT); }
DEVI unsigned xb_xcc_id() { return (unsigned)__builtin_amdgcn_s_getreg((3 << 11) | 20) & 0xFu; }
#define XB_SPIN(cond, bar) do { unsigned _sp = 0; while (cond) { __builtin_amdgcn_s_sleep(1); \
    if ((++_sp & 255u) == 0u) { if (xb_ld(&(bar)[XB_TMO])) break; if (_sp > XB_SPIN_CAP) { atomicAdd(&(bar)[XB_TMO], 1u); break; } } } } while (0)
struct XcdBarrier { unsigned* bar; unsigned x; volatile LAS unsigned* st; };
DEVI XcdBarrier xcd_barrier_post(unsigned* bar, volatile LAS unsigned* st) {
    XcdBarrier b; b.bar = bar; b.x = xb_xcc_id(); b.st = st;
    if (threadIdx.x == 0) (void)xb_add(&bar[XB_XCNT(b.x)], 1u);
    return b;
}
DEVI void xcd_barrier_complete(unsigned* bar, unsigned x, unsigned& nloc, unsigned& nx) {
    const unsigned G = gridDim.x * gridDim.y * gridDim.z;
    unsigned sum, cnt, mine, sp = 0u;
    for (;;) {
        sum = 0u; cnt = 0u; mine = 0u;
#pragma unroll
        for (unsigned j = 0; j < 16; ++j) { const unsigned c = xb_ld(&bar[XB_XCNT(j)]); sum += c; cnt += (c > 0u) ? 1u : 0u; mine = (j == x) ? c : mine; }
        if (sum == G) break;
        __builtin_amdgcn_s_sleep(1);
        if ((++sp & 255u) == 0u) { if (xb_ld(&bar[XB_TMO])) break; if (sp > XB_SPIN_CAP) { atomicAdd(&bar[XB_TMO], 1u); break; } }
    }
    nloc = mine > 0u ? mine : 1u; nx = cnt > 0u ? cnt : 1u;
}
DEVI void xcd_barrier(const XcdBarrier& b) {
    asm volatile("s_waitcnt vmcnt(0)" ::: "memory");
    __syncthreads();
    if (threadIdx.x == 0) {
        unsigned* bar = b.bar;
        __builtin_amdgcn_s_waitcnt(0);
        unsigned nloc = b.st[0], nx = b.st[1];
        if (nloc == 0u) { xcd_barrier_complete(bar, b.x, nloc, nx); b.st[0] = nloc; b.st[1] = nx; }
        const unsigned old = xb_add(&bar[XB_XSUB(b.x)], 1u);
        const unsigned gen = old / nloc;
        if (old + 1u == (gen + 1u) * nloc) {
            __builtin_amdgcn_fence(__ATOMIC_RELEASE, "agent");
            asm volatile("s_waitcnt vmcnt(0)" ::: "memory");
            const unsigned og = xb_add(&bar[XB_TOP], 1u);
            const unsigned tg = og / nx;
            if (og + 1u == (tg + 1u) * nx) xb_add(&bar[XB_TOPGEN], 1u);
            else XB_SPIN(xb_ld(&bar[XB_TOPGEN]) == tg, bar);
            __builtin_amdgcn_fence(__ATOMIC_ACQUIRE, "agent");
            xb_add(&bar[XB_XGEN(b.x)], 1u);
            asm volatile("s_waitcnt vmcnt(0)" ::: "memory");
        } else {
            XB_SPIN(xb_ld(&bar[XB_XGEN(b.x)]) == gen, bar);
            __builtin_amdgcn_fence(__ATOMIC_ACQUIRE, "agent");
            asm volatile("s_waitcnt vmcnt(0)" ::: "memory");
        }
    }
    __syncthreads();
}

constexpr int N_PHASES = 28;
__global__ void __launch_bounds__(NTHR) hybrid_fwd(Params p_unused) {
    extern __shared__ __attribute__((aligned(16))) char lds_base[];
    karg_ptr kp = (karg_ptr)__builtin_amdgcn_kernarg_segment_ptr();
    int ph_lo, ph_hi, use_gs;
    { DP q{kp}; ph_lo = q.ph_lo(); ph_hi = q.ph_hi(); use_gs = q.use_gs(); }
    volatile LAS unsigned* xst = (volatile LAS unsigned*)(LAS char*)(lds_base + LDS_BYTES - 16);
    if (threadIdx.x == 0) { xst[0] = 0u; xst[1] = 0u; }
    __syncthreads();
    XcdBarrier xb; xb.bar = nullptr; xb.x = 0; xb.st = xst;
    if (use_gs == 1) { DP q{kp}; xb = xcd_barrier_post((unsigned*)(q.ws() + WS_BAR), xst); }
#define RUN_PHASE(PH, ...) \
    if (ph_lo <= (PH) && (PH) < ph_hi) { \
        if ((PH) > ph_lo) { if (use_gs == 1) xcd_barrier(xb); else if (use_gs == 2) cg::this_grid().sync(); } \
        asm volatile("" : "+s"(kp) :: "memory"); \
        const DP p{kp}; \
        unsigned lds_off = 0; asm volatile("" : "+s"(lds_off)); \
        char* lds = lds_base + lds_off; \
        unsigned char* ws = p.ws(); (void)ws; (void)lds; \
        __VA_ARGS__ \
    }
#define LAYER_PHASES(L, B0) \
    RUN_PHASE((B0) + 0, { if ((L) == 1) { for (int u = BIDX(); u < PREP_UNITS; u += gridDim.x) prep_unit(p, 1, u, (float*)lds); } __syncthreads(); phase_norm1(p, (L), lds); }) \
    RUN_PHASE((B0) + 1, { phase_inproj(p, (L), lds); }) \
    RUN_PHASE((B0) + 2, { phase_post(p, (L)); }) \
    RUN_PHASE((B0) + 3, { phase_mix1(p, (L), lds); }) \
    RUN_PHASE((B0) + 4, { phase_ssd_scan(p); phase_knorm(p, (L)); }) \
    RUN_PHASE((B0) + 5, { phase_mix3(p, (L), lds); }) \
    RUN_PHASE((B0) + 6, { g8::DenseSched2 S; S.init((const bf16_t*)(ws + WS_MIX), (const bf16_t*)(ws + WS_W_OUT), T, DM, DM, gridDim.x, BIDX()); \
                          g8::EpiResScale E{{(const bf16_t*)(ws + WS_HBUF), (bf16_t*)(ws + WS_H1), DM}, (const float*)(ws + WS_SSQ)}; g8::gemm8(lds, DM, DM / 2, S, E); }) \
    RUN_PHASE((B0) + 7, { g8::DenseSched S; S.init((const bf16_t*)(ws + WS_H1), (const bf16_t*)(ws + WS_W_Q), T, DM, DM, gridDim.x, BIDX()); \
                          g8::EpiBf16 E{(bf16_t*)(ws + WS_QBUF), DM}; g8::gemm8(lds, DM, DM, S, E); }) \
    RUN_PHASE((B0) + 8, { phase_xattn(p, (L), lds); }) \
    RUN_PHASE((B0) + 9, { g8::DenseSched S; S.init((const bf16_t*)(ws + WS_OBUF), (const bf16_t*)(ws + WS_W_O), T, DM, DM, gridDim.x, BIDX()); \
                          g8::EpiResBf E{(const bf16_t*)(ws + WS_H1), (bf16_t*)(ws + WS_HBUF), DM}; g8::gemm8(lds, DM, DM, S, E); }) \
    RUN_PHASE((B0) + 10, { phase_norm3(p, (L), lds); }) \
    RUN_PHASE((B0) + 11, { phase_moe<0>(p, (L), lds); }) \
    RUN_PHASE((B0) + 12, { phase_moe<1>(p, (L), lds); })

    RUN_PHASE(0, { prep_small(p); for (int u = BIDX(); u < PREP_UNITS; u += gridDim.x) prep_unit(p, 0, u, (float*)lds); })
    LAYER_PHASES(0, 1)
    LAYER_PHASES(1, 14)
    RUN_PHASE(27, { phase_final(p); })
#undef LAYER_PHASES
#undef RUN_PHASE
}

extern "C" void kernel_launch(void* const* d_in, const int* in_sizes, int n_in, void* d_out, int out_size, void* d_ws, size_t ws_size, hipStream_t stream) {
    static int grid = 0;
    if (grid == 0) {
        if (n_in != 31 || out_size != T * DM || ws_size < WS_END) { fprintf(stderr, "kernel_launch: unexpected shapes (n_in %d out %d ws %zu need %zu)\n", n_in, out_size, ws_size, (size_t)WS_END); grid = -1; return; }
        int dev = 0, cus = 0, per_cu = 0;
        hipGetDevice(&dev);
        hipDeviceGetAttribute(&cus, hipDeviceAttributeMultiprocessorCount, dev);
        hipFuncSetAttribute((const void*)hybrid_fwd, hipFuncAttributeMaxDynamicSharedMemorySize, LDS_BYTES);
        hipOccupancyMaxActiveBlocksPerMultiprocessor(&per_cu, (const void*)hybrid_fwd, NTHR, LDS_BYTES);
        if (per_cu < 1) { fprintf(stderr, "kernel_launch: occupancy query says %d blocks per CU\n", per_cu); per_cu = 1; }
        (void)hipGetLastError();
        grid = cus;
    }
    if (grid < 0) return;
    Params p{};
    for (int i = 0; i < 31; ++i) p.in[i] = (const float*)d_in[i];
    p.out = (float*)d_out; p.ws = (unsigned char*)d_ws;
    p.use_grid_sync = 1; p.pad = 0;
    p.ph_lo = 0; p.ph_hi = N_PHASES;
    if (hipMemsetAsync((unsigned char*)d_ws + WS_BAR, 0, XCD_BAR_WORDS * 4, stream) != hipSuccess) { fprintf(stderr, "kernel_launch: memset failed\n"); return; }
    void* args[] = {&p};
    hipError_t e = hipLaunchCooperativeKernel((const void*)hybrid_fwd, dim3(grid), dim3(NTHR), args, LDS_BYTES, stream);
    if (e != hipSuccess) fprintf(stderr, "kernel_launch: cooperative launch failed: %s (grid %d)\n", hipGetErrorString(e), grid);
}
```

```cpp
#include <hip/hip_runtime.h>
#include <hip/hip_cooperative_groups.h>
#include <cstdio>
#include <cstdint>
namespace cg = cooperative_groups;

typedef unsigned short bf16_t;
typedef short bf16x8 __attribute__((ext_vector_type(8)));
typedef short s16x4 __attribute__((ext_vector_type(4)));
typedef float f32x4 __attribute__((ext_vector_type(4)));
typedef unsigned u32x4 __attribute__((ext_vector_type(4)));
typedef unsigned u32x2 __attribute__((ext_vector_type(2)));
#define DEVI __device__ __forceinline__
#define LAS __attribute__((address_space(3)))

constexpr int NB = 8, S = 2048, DM = 1024, T = NB * S, DEPTH = 2;
constexpr int INP = 3084, NPROJ = 3072;
constexpr int C_FQ = 0, C_FK = 256, C_FV = 512, C_DQ = 768, C_DK = 1024, C_DV = 1280, C_Z = 1536, C_XBC = 2048;
constexpr int MEMLEN = 256, MROWS = NB * MEMLEN;
constexpr int NEXP = 32, EFF = 512;
constexpr float EPS = 1e-6f;
constexpr int NTHR = 512;
constexpr int LDS_BYTES = 151552;

constexpr size_t al256(size_t x) { return (x + 255) & ~(size_t)255; }
constexpr size_t WS_W_IN = 0;
constexpr size_t WS_W_OUT = WS_W_IN + (size_t)NPROJ * DM * 2;
constexpr size_t WS_W_Q = WS_W_OUT + (size_t)DM * DM * 2;
constexpr size_t WS_W_KV = WS_W_Q + (size_t)DM * DM * 2;
constexpr size_t WS_W_O = WS_W_KV + (size_t)2 * DM * DM * 2;
constexpr size_t WS_W_13 = WS_W_O + (size_t)DM * DM * 2;
constexpr size_t WS_W_2 = WS_W_13 + (size_t)NEXP * 1024 * DM * 2;
constexpr size_t WS_WSMALL = WS_W_2 + (size_t)NEXP * DM * EFF * 2;
constexpr size_t WS_WROUT = WS_WSMALL + (size_t)DEPTH * 12 * DM * 4;
constexpr size_t WS_XB = WS_WROUT + (size_t)DEPTH * 36 * DM * 4;
constexpr size_t WS_H1 = WS_XB;
constexpr size_t WS_H3 = WS_XB + (size_t)T * DM * 2;
constexpr size_t WS_HBUF = WS_XB + (size_t)T * DM * 4;
constexpr size_t WS_PROJ = WS_HBUF + (size_t)T * DM * 2;
constexpr size_t WS_QBUF = WS_PROJ;
constexpr size_t WS_OBUF = WS_PROJ + (size_t)T * DM * 2;
constexpr size_t WS_ACT = WS_PROJ;
constexpr size_t WS_MIX = WS_PROJ + (size_t)T * NPROJ * 2;
constexpr size_t WS_U = WS_MIX + (size_t)T * DM * 2;
constexpr size_t WS_YBUF = WS_U;
constexpr size_t WS_DILO = WS_U;
constexpr size_t WS_DILM = WS_DILO + (size_t)3 * T * 256 * 4;
constexpr size_t WS_DILL = WS_DILM + (size_t)3 * T * 4 * 4;
constexpr size_t WS_SSTATE = WS_DILL + (size_t)3 * T * 4 * 4;
constexpr size_t WS_HIN = WS_SSTATE + (size_t)NB * 16 * 8 * 8192 * 4;
constexpr size_t WS_GBUF = WS_HIN + (size_t)NB * 16 * 8 * 8192 * 2;
constexpr size_t WS_U_END = WS_GBUF + (size_t)T * 512 * 4;
constexpr size_t WS_MEMN = WS_U_END;
constexpr size_t WS_KV = WS_MEMN + (size_t)MROWS * DM * 2;
constexpr size_t WS_LOGF = WS_KV + (size_t)MROWS * 2 * DM * 2;
constexpr size_t WS_CUMF = WS_LOGF + (size_t)T * 4 * 4;
constexpr size_t WS_DTV = WS_CUMF + (size_t)T * 4 * 4;
constexpr size_t WS_DECAY = WS_DTV + (size_t)T * 8 * 4;
constexpr size_t WS_CNT = WS_DECAY + (size_t)NB * 16 * 8 * 4;
constexpr size_t WS_LIST = WS_CNT + 1024;
constexpr size_t WS_GATE = WS_LIST + (size_t)NEXP * 2 * T * 4;
constexpr size_t WS_BAR = WS_GATE + (size_t)2 * T * 4;
constexpr size_t WS_XC = WS_BAR + 65536;
constexpr size_t WS_SSQ = WS_XC + (size_t)T * 1024 * 2;
constexpr size_t WS_RSTD1 = WS_SSQ + (size_t)T * 2 * 4;
constexpr size_t WS_RSTD3 = WS_RSTD1 + (size_t)T * 4;
constexpr size_t WS_END = WS_RSTD3 + (size_t)T * 4;
static_assert(WS_YBUF + (size_t)2 * T * DM * 2 <= WS_U_END, "ybuf alias");
static_assert(WS_OBUF + (size_t)T * DM * 2 <= WS_MIX, "obuf alias");

struct Params {
    const float* in[31];
    float* out;
    unsigned char* ws;
    int ph_lo, ph_hi;
    int use_grid_sync, pad;
};


typedef __attribute__((address_space(4))) const unsigned long long* karg_ptr;
typedef __attribute__((address_space(1))) const float* gcf_ptr;
typedef __attribute__((address_space(1))) float* gf_ptr;
typedef __attribute__((address_space(1))) unsigned char* gb_ptr;
struct DP {
    karg_ptr kp;
    DEVI const float* in(int i) const { return (const float*)(gcf_ptr)(kp[i]); }
    DEVI float* out() const { return (float*)(gf_ptr)(kp[31]); }
    DEVI unsigned char* ws() const { return (unsigned char*)(gb_ptr)(kp[32]); }
    DEVI int ph_lo() const { return (int)(unsigned)kp[33]; }
    DEVI int ph_hi() const { return (int)(unsigned)(kp[33] >> 32); }
    DEVI int use_gs() const { return (int)(unsigned)kp[34]; }
};

DEVI int TIDX() { int t = threadIdx.x; asm volatile("" : "+v"(t)); return t; }
DEVI int BIDX() { int b = blockIdx.x; asm volatile("" : "+s"(b)); return b; }
DEVI float bf2f(bf16_t v) { return __uint_as_float(((unsigned)v) << 16); }
typedef float f32x2 __attribute__((ext_vector_type(2)));
typedef __bf16 bf16x2_t __attribute__((ext_vector_type(2)));
DEVI unsigned cvt_pk(float lo, float hi) { f32x2 v = {lo, hi}; bf16x2_t b = __builtin_convertvector(v, bf16x2_t); return __builtin_bit_cast(unsigned, b); }
DEVI bf16_t f2bf(float f) { return (bf16_t)(cvt_pk(f, 0.f) & 0xffffu); }
DEVI float bflo(unsigned w) { return __uint_as_float(w << 16); }
DEVI float bfhi(unsigned w) { return __uint_as_float(w & 0xffff0000u); }
DEVI float wave_sum(float v) {
#pragma unroll
    for (int m = 32; m >= 1; m >>= 1) v += __shfl_xor(v, m);
    return v;
}
template <int CTRL> DEVI float dpp_mov(float v) { return __uint_as_float(__builtin_amdgcn_update_dpp(0u, __float_as_uint(v), CTRL, 0xf, 0xf, false)); }
DEVI float wave_sum_fast(float v) {
    v += dpp_mov<0xB1>(v);
    v += dpp_mov<0x4E>(v);
    v += dpp_mov<0x124>(v);
    v += dpp_mov<0x128>(v);
    const int iv = __float_as_int(v);
    return (__int_as_float(__builtin_amdgcn_readlane(iv, 0)) + __int_as_float(__builtin_amdgcn_readlane(iv, 16))) + (__int_as_float(__builtin_amdgcn_readlane(iv, 32)) + __int_as_float(__builtin_amdgcn_readlane(iv, 48)));
}
DEVI float silu_f(float x) { return x / (1.f + __expf(-x)); }
DEVI float softplus_f(float x) { return x > 20.f ? x : log1pf(__expf(x)); }
DEVI float logsigmoid_f(float x) { return x >= 0.f ? -log1pf(__expf(-x)) : x - log1pf(__expf(x)); }
#define MFMA16(a, b, c) __builtin_amdgcn_mfma_f32_16x16x32_bf16(a, b, c, 0, 0, 0)
DEVI s16x4 tr_read(const bf16_t* p) {
    return __builtin_bit_cast(s16x4, __builtin_amdgcn_ds_read_tr16_b64_v4i16((LAS s16x4*)p));
}

DEVI int maprow(int mode, int n) { return mode == 0 ? n : ((n >> 4) * 32 + (n & 15) + (mode == 2 ? 16 : 0)); }
DEVI void prep_tile(const float* __restrict__ src, int ld, int k0, int c0, bf16_t* __restrict__ dst, int dstld, int mode, int n0,
                    const float* __restrict__ kscale, int ks_from, float* tl) {
    const int tid = TIDX();
#pragma unroll
    for (int i = 0; i < 2; ++i) {
        const int k = (tid >> 4) + 32 * i, n4 = (tid & 15) * 4;
        const float4 v = *(const float4*)(src + (size_t)(k0 + k) * ld + c0 + n4);
        float sc = 1.f;
        if (kscale != nullptr && (k0 + k) >= ks_from) sc = kscale[k0 + k - ks_from];
        tl[k * 65 + n4 + 0] = v.x * sc; tl[k * 65 + n4 + 1] = v.y * sc; tl[k * 65 + n4 + 2] = v.z * sc; tl[k * 65 + n4 + 3] = v.w * sc;
    }
    __syncthreads();
    {
        const int n = tid >> 3, kc = (tid & 7) * 8;
        u32x4 w;
        w.x = cvt_pk(tl[(kc + 0) * 65 + n], tl[(kc + 1) * 65 + n]);
        w.y = cvt_pk(tl[(kc + 2) * 65 + n], tl[(kc + 3) * 65 + n]);
        w.z = cvt_pk(tl[(kc + 4) * 65 + n], tl[(kc + 5) * 65 + n]);
        w.w = cvt_pk(tl[(kc + 6) * 65 + n], tl[(kc + 7) * 65 + n]);
        const int drow = maprow(mode, n0 + n);
        *(u32x4*)(dst + (size_t)drow * dstld + k0 + kc) = w;
    }
    __syncthreads();
}

constexpr int PREP_UNITS = 2048 + 3 * 4096;
DEVI void prep_unit(const DP& p, int l, int u, float* tl) {
    unsigned char* ws = p.ws();
    if (u < 768) {
        const int kt = u / 48, nt = u % 48, n0 = nt * 64, c0 = n0 < 768 ? n0 : n0 + 4;
        prep_tile(p.in(3) + (size_t)l * DM * INP, INP, kt * 64, c0, (bf16_t*)(ws + WS_W_IN), DM, 0, n0, p.in(2) + l * DM, 0, tl);
    } else if (u < 1024) {
        const int v = u - 768, kt = v / 16, nt = v % 16;
        prep_tile(p.in(15) + (size_t)l * DM * DM, DM, kt * 64, nt * 64, (bf16_t*)(ws + WS_W_OUT), DM, 0, nt * 64, p.in(14) + l * 512, 512, tl);
    } else if (u < 1280) {
        const int v = u - 1024, kt = v / 16, nt = v % 16;
        prep_tile(p.in(18) + (size_t)l * DM * DM, DM, kt * 64, nt * 64, (bf16_t*)(ws + WS_W_Q), DM, 0, nt * 64, p.in(16) + l * DM, 0, tl);
    } else if (u < 1792) {
        const int v = u - 1280, kt = v / 32, nt = v % 32;
        prep_tile(p.in(19) + (size_t)l * DM * 2 * DM, 2 * DM, kt * 64, nt * 64, (bf16_t*)(ws + WS_W_KV), DM, 0, nt * 64, nullptr, 0, tl);
    } else if (u < 2048) {
        const int v = u - 1792, kt = v / 16, nt = v % 16;
        prep_tile(p.in(22) + (size_t)l * DM * DM, DM, kt * 64, nt * 64, (bf16_t*)(ws + WS_W_O), DM, 0, nt * 64, nullptr, 0, tl);
    } else if (u < 2048 + 8192) {
        const int v = u - 2048, which = v / 4096, w = v % 4096, e = w / 128, tI = w % 128, kt = tI / 8, nt = tI % 8;
        const float* src = (which == 0 ? p.in(28) : p.in(29)) + ((size_t)l * NEXP + e) * DM * EFF;
        prep_tile(src, EFF, kt * 64, nt * 64, (bf16_t*)(ws + WS_W_13) + (size_t)e * 1024 * DM, DM, which == 0 ? 1 : 2, nt * 64, p.in(23) + l * DM, 0, tl);
    } else {
        const int w = u - 2048 - 8192, e = w / 128, tI = w % 128, kt = tI / 16, nt = tI % 16;
        const float* src = p.in(30) + ((size_t)l * NEXP + e) * EFF * DM;
        prep_tile(src, DM, kt * 64, nt * 64, (bf16_t*)(ws + WS_W_2) + (size_t)e * DM * EFF, EFF, 0, nt * 64, nullptr, 0, tl);
    }
}
DEVI void prep_small(const DP& p) {
    float* wsm = (float*)(p.ws() + WS_WSMALL);
    float* wro = (float*)(p.ws() + WS_WROUT);
    const int gtid = BIDX() * NTHR + TIDX(), gn = gridDim.x * NTHR;
    for (int i = gtid; i < DEPTH * 12 * DM; i += gn) {
        const int l = i / (12 * DM), r = i % (12 * DM), c = r / DM, k = r % DM;
        const int col = c < 4 ? 768 + c : 3076 + (c - 4);
        wsm[i] = p.in(3)[((size_t)l * DM + k) * INP + col] * p.in(2)[l * DM + k];
    }
    for (int i = gtid; i < DEPTH * 36 * DM; i += gn) {
        const int l = i / (36 * DM), r = i % (36 * DM), c = r / DM, k = r % DM;
        wro[i] = (c < 4 ? p.in(24)[((size_t)l * DM + k) * 4 + c] : p.in(26)[((size_t)l * DM + k) * 32 + (c - 4)]) * p.in(23)[l * DM + k];
    }
    if (BIDX() == 0 && TIDX() < 128) ((int*)(p.ws() + WS_CNT))[TIDX()] = 0;
}

DEVI void store_h_bf16(bf16_t* hrow, const float (&h)[16], int lane) {
#pragma unroll
    for (int j = 0; j < 4; ++j) {
        u32x2 w; w.x = cvt_pk(h[4 * j], h[4 * j + 1]); w.y = cvt_pk(h[4 * j + 2], h[4 * j + 3]);
        *(u32x2*)(hrow + j * 256 + lane * 4) = w;
    }
}
DEVI void load_row_f32(const float* xr, float (&x)[16], int lane) {
#pragma unroll
    for (int j = 0; j < 4; ++j) { const float4 v = *(const float4*)(xr + j * 256 + lane * 4); x[4 * j] = v.x; x[4 * j + 1] = v.y; x[4 * j + 2] = v.z; x[4 * j + 3] = v.w; }
}
DEVI void add_row_bf16(const bf16_t* yr, float (&x)[16], int lane) {
#pragma unroll
    for (int j = 0; j < 4; ++j) { const u32x2 w = *(const u32x2*)(yr + j * 256 + lane * 4); x[4 * j] += bflo(w.x); x[4 * j + 1] += bfhi(w.x); x[4 * j + 2] += bflo(w.y); x[4 * j + 3] += bfhi(w.y); }
}
DEVI void store_row_f32(float* xr, const float (&x)[16], int lane) {
#pragma unroll
    for (int j = 0; j < 4; ++j) *(float4*)(xr + j * 256 + lane * 4) = make_float4(x[4 * j], x[4 * j + 1], x[4 * j + 2], x[4 * j + 3]);
}
DEVI void norm_row(const float (&x)[16], const float* g, float (&h)[16], int lane) {
    float ss = 0.f;
#pragma unroll
    for (int i = 0; i < 16; ++i) ss += x[i] * x[i];
    ss = wave_sum(ss);
    const float rstd = rsqrtf(ss * (1.0f / DM) + EPS);
#pragma unroll
    for (int j = 0; j < 4; ++j) { const float4 gv = *(const float4*)(g + j * 256 + lane * 4);
        h[4 * j] = x[4 * j] * rstd * gv.x; h[4 * j + 1] = x[4 * j + 1] * rstd * gv.y; h[4 * j + 2] = x[4 * j + 2] * rstd * gv.z; h[4 * j + 3] = x[4 * j + 3] * rstd * gv.w; }
}
DEVI float dot_lds(const float (&h)[16], const float* wrow, int lane) {
    float a = 0.f;
#pragma unroll
    for (int j = 0; j < 4; ++j) { const float4 w = *(const float4*)(wrow + j * 256 + lane * 4); a += h[4 * j] * w.x + h[4 * j + 1] * w.y + h[4 * j + 2] * w.z + h[4 * j + 3] * w.w; }
    return a;
}

DEVI void load_row_bf16(const bf16_t* xr, float (&x)[16], int lane) {
#pragma unroll
    for (int j = 0; j < 2; ++j) { const u32x4 w = *(const u32x4*)(xr + j * 512 + lane * 8);
        x[8 * j] = bflo(w.x); x[8 * j + 1] = bfhi(w.x); x[8 * j + 2] = bflo(w.y); x[8 * j + 3] = bfhi(w.y); x[8 * j + 4] = bflo(w.z); x[8 * j + 5] = bfhi(w.z); x[8 * j + 6] = bflo(w.w); x[8 * j + 7] = bfhi(w.w); }
}
DEVI void add_row_bf16_b(const bf16_t* yr, float (&x)[16], int lane) {
#pragma unroll
    for (int j = 0; j < 2; ++j) { const u32x4 w = *(const u32x4*)(yr + j * 512 + lane * 8);
        x[8 * j] += bflo(w.x); x[8 * j + 1] += bfhi(w.x); x[8 * j + 2] += bflo(w.y); x[8 * j + 3] += bfhi(w.y); x[8 * j + 4] += bflo(w.z); x[8 * j + 5] += bfhi(w.z); x[8 * j + 6] += bflo(w.w); x[8 * j + 7] += bfhi(w.w); }
}
DEVI void store_row_bf16_b(bf16_t* hr, const float (&h)[16], int lane) {
#pragma unroll
    for (int j = 0; j < 2; ++j) { u32x4 w; w.x = cvt_pk(h[8 * j], h[8 * j + 1]); w.y = cvt_pk(h[8 * j + 2], h[8 * j + 3]); w.z = cvt_pk(h[8 * j + 4], h[8 * j + 5]); w.w = cvt_pk(h[8 * j + 6], h[8 * j + 7]);
        *(u32x4*)(hr + j * 512 + lane * 8) = w; }
}
DEVI float dot_lds_b(const float (&h)[16], const float* wrow, int lane) {
    float a = 0.f;
#pragma unroll
    for (int j = 0; j < 2; ++j) { const float4 w0 = *(const float4*)(wrow + j * 512 + lane * 8), w1 = *(const float4*)(wrow + j * 512 + lane * 8 + 4);
        a += h[8 * j] * w0.x + h[8 * j + 1] * w0.y + h[8 * j + 2] * w0.z + h[8 * j + 3] * w0.w + h[8 * j + 4] * w1.x + h[8 * j + 5] * w1.y + h[8 * j + 6] * w1.z + h[8 * j + 7] * w1.w; }
    return a;
}
#define MFMA_F32(a, b, c) __builtin_amdgcn_mfma_f32_16x16x4f32(a, b, c, 0, 0, 0)
template <int L>
DEVI void load_row_pre(const float* xin, const bf16_t* h0, const bf16_t* ybuf, int row, int lane, float (&x)[16]) {
    if (L == 0) load_row_f32(xin + (size_t)row * DM, x, lane);
    else { load_row_bf16(h0 + (size_t)row * DM, x, lane); add_row_bf16_b(ybuf + (size_t)(2 * row) * DM, x, lane); add_row_bf16_b(ybuf + (size_t)(2 * row + 1) * DM, x, lane); }
}
template <int L>
DEVI void norm1_rows(const DP& p, char* lds) {
    const int tid = TIDX(), wid = tid >> 6, lane = tid & 63;
    unsigned char* ws = p.ws();
    const float* wsl = (const float*)lds;
    const float* xin = p.in(0);
    const bf16_t* ybuf = (const bf16_t*)(ws + WS_YBUF);
    bf16_t* hbuf = (bf16_t*)(ws + WS_HBUF);
    float* logf = (float*)(ws + WS_LOGF);
    float* dtv = (float*)(ws + WS_DTV);
    float* rstd1 = (float*)(ws + WS_RSTD1);
    const int stride = gridDim.x * 8;
    int row = BIDX() * 8 + wid;
    float xn[16];
    if (row < T) load_row_pre<L>(xin, hbuf, ybuf, row, lane, xn);
    for (; row < T; row += stride) {
        float x[16];
#pragma unroll
        for (int i = 0; i < 16; ++i) x[i] = xn[i];
        if (row + stride < T) load_row_pre<L>(xin, hbuf, ybuf, row + stride, lane, xn);
        if (L == 0) store_h_bf16(hbuf + (size_t)row * DM, x, lane); else store_row_bf16_b(hbuf + (size_t)row * DM, x, lane);
        float ss = 0.f;
#pragma unroll
        for (int i = 0; i < 16; ++i) ss += x[i] * x[i];
        const float rstd = rsqrtf(wave_sum_fast(ss) * (1.0f / DM) + EPS);
        float keep = 0.f;
#pragma unroll
        for (int c = 0; c < 12; ++c) { const float v = wave_sum_fast(L == 0 ? dot_lds(x, wsl + c * DM, lane) : dot_lds_b(x, wsl + c * DM, lane)); keep = (lane == c) ? v : keep; if (c & 1) __builtin_amdgcn_sched_barrier(0); }
        keep *= rstd;
        if (lane == 0) rstd1[row] = rstd;
        {
            const float bias = lane < 4 ? p.in(4)[L * 4 + (lane & 3)] : p.in(11)[L * 8 + ((lane - 4) & 7)];
            const float xv = keep + bias;
            const float lt = __logf(1.0f + __expf(-fabsf(xv)));
            if (lane < 4) logf[(size_t)row * 4 + lane] = fminf(xv, 0.f) - lt;
            else if (lane < 12) dtv[(size_t)row * 8 + lane - 4] = fmaxf(xv, 0.f) + lt;
        }
    }
}
DEVI void phase_norm1(const DP& p, int l, char* lds) {
    const int tid = TIDX(), wid = tid >> 6, lane = tid & 63;
    unsigned char* ws = p.ws();
    float* wsl = (float*)lds;
    { const float4* src = (const float4*)((const float*)(ws + WS_WSMALL) + (size_t)l * 12 * DM);
      for (int i = tid; i < 12 * DM / 4; i += NTHR) ((float4*)wsl)[i] = src[i]; }
    __syncthreads();
    if (l == 0) norm1_rows<0>(p, lds); else norm1_rows<1>(p, lds);
    const float* gm = p.in(17) + l * DM;
    bf16_t* memn = (bf16_t*)(ws + WS_MEMN);
    for (int row = BIDX() * 8 + wid; row < MROWS; row += gridDim.x * 8) {
        float x[16], h[16];
        load_row_f32(p.in(1) + (size_t)row * DM, x, lane);
        norm_row(x, gm, h, lane);
        store_h_bf16(memn + (size_t)row * DM, h, lane);
    }
}
DEVI void phase_norm3(const DP& p, int l, char* lds) {
    const int tid = TIDX(), wid = tid >> 6, lane = tid & 63;
    unsigned char* ws = p.ws();
    float* wr = (float*)lds;
    int* lcnt = (int*)(lds + 36 * DM * 4);
    int* lbase = lcnt + 32;
    int* rinfo = lbase + 32;
    { const float4* src = (const float4*)((const float*)(ws + WS_WROUT) + (size_t)l * 36 * DM);
      for (int i = tid; i < 36 * DM / 4; i += NTHR) ((float4*)wr)[i] = src[i]; }
    if (tid < 32) lcnt[tid] = 0;
    __syncthreads();
    int* cnt = (int*)(ws + WS_CNT) + l * 64;
    int* list = (int*)(ws + WS_LIST);
    const bf16_t* xin = (const bf16_t*)(ws + WS_HBUF);
    bf16_t* h3 = (bf16_t*)(ws + WS_H3);
    const float* bg = p.in(25) + l * 4;
    const int be_i = __float_as_int(lane < 32 ? p.in(27)[l * 32 + lane] : 0.f);
    const int stride = gridDim.x * 8;
    int row = BIDX() * 8 + wid;
    float xn[16];
    if (row < T) load_row_bf16(xin + (size_t)row * DM, xn, lane);
    for (int it = 0; row < T; row += stride, ++it) {
        float x[16];
#pragma unroll
        for (int i = 0; i < 16; ++i) x[i] = xn[i];
        if (row + stride < T) load_row_bf16(xin + (size_t)(row + stride) * DM, xn, lane);
        float ss = 0.f;
#pragma unroll
        for (int i = 0; i < 16; ++i) ss += x[i] * x[i];
        const float rstd = rsqrtf(wave_sum_fast(ss) * (1.0f / DM) + EPS);
        { float hn[16];
#pragma unroll
          for (int i = 0; i < 16; ++i) hn[i] = x[i] * rstd;
          store_row_bf16_b(h3 + (size_t)row * DM, hn, lane); }
        float gl[4];
#pragma unroll
        for (int c = 0; c < 4; ++c) gl[c] = wave_sum_fast(dot_lds_b(x, wr + c * DM, lane)) * rstd + bg[c];
        int gsel = 0; float gmax = gl[0];
#pragma unroll
        for (int c = 1; c < 4; ++c) if (gl[c] > gmax) { gmax = gl[c]; gsel = c; }
        float gden = 0.f;
#pragma unroll
        for (int c = 0; c < 4; ++c) gden += __expf(gl[c] - gmax);
        const float ggate = 1.0f / gden;
        gsel = __builtin_amdgcn_readfirstlane(gsel);
        float v1 = -3.0e38f, v2 = -3.0e38f; int i1 = 0, i2 = 1;
#pragma unroll
        for (int c = 0; c < 8; ++c) {
            const float v = wave_sum_fast(dot_lds_b(x, wr + (4 + gsel * 8 + c) * DM, lane)) * rstd + __int_as_float(__builtin_amdgcn_readlane(be_i, gsel * 8 + c));
            if (v > v1) { v2 = v1; i2 = i1; v1 = v; i1 = c; } else if (v > v2) { v2 = v; i2 = c; }
            if (c & 1) __builtin_amdgcn_sched_barrier(0);
        }
        const float e2 = __expf(v2 - v1), inv = 1.0f / (1.0f + e2);
        if (lane == 0) {
            const int ea = gsel * 8 + i1, eb = gsel * 8 + i2;
            const int sa = atomicAdd(&lcnt[ea], 1), sb = atomicAdd(&lcnt[eb], 1);
            int* ri = rinfo + (it * 8 + wid) * 4;
            const unsigned gpk = cvt_pk(inv * ggate, e2 * inv * ggate);
            ri[0] = ea | (sa << 8); ri[1] = eb | (sb << 8); ri[2] = (int)(gpk << 16); ri[3] = (int)(gpk & 0xffff0000u);
        }
    }
    __syncthreads();
    if (tid < 32) lbase[tid] = atomicAdd(&cnt[tid], lcnt[tid]);
    __syncthreads();
    {
        const int nit = (T - (BIDX() * 8) + stride - 1) / stride;
        if (tid < nit * 8) {
            const int it = tid >> 3, w = tid & 7, r = BIDX() * 8 + w + it * stride;
            if (r < T) {
                const int* ri = rinfo + tid * 4;
                const int ea = ri[0] & 255, sa = ri[0] >> 8, eb = ri[1] & 255, sb = ri[1] >> 8;
                list[(size_t)ea * (2 * T) + lbase[ea] + sa] = ri[2] | (2 * r);
                list[(size_t)eb * (2 * T) + lbase[eb] + sb] = ri[3] | (2 * r + 1);
            }
        }
    }
    __syncthreads();
}

constexpr int G_BM = 256, G_BN = 128, G_BK = 64, G_ST = 72;
constexpr int G_ABUF = G_BM * G_ST, G_BBUF = G_BN * G_ST;
template <class AMap, class Epi>
DEVI void gemm_tile(const AMap& amap, const bf16_t* __restrict__ Bt, int K, const Epi& epi, char* lds) {
    const int tid = TIDX(), wid = tid >> 6, lane = tid & 63, r16 = lane & 15, g4 = lane >> 4;
    const int wr = wid >> 1, wc = wid & 1;
    bf16_t* As = (bf16_t*)lds;
    bf16_t* Bs = As + 2 * G_ABUF;
    const int srow = tid >> 3, skc = (tid & 7) * 8;
    const bf16_t* ap[4];
#pragma unroll
    for (int i = 0; i < 4; ++i) ap[i] = amap(srow + 64 * i) + skc;
    const bf16_t* bp[2];
#pragma unroll
    for (int i = 0; i < 2; ++i) bp[i] = Bt + (size_t)(srow + 64 * i) * K + skc;
    u32x4 ra[4], rb[2];
#pragma unroll
    for (int i = 0; i < 4; ++i) ra[i] = *(const u32x4*)(ap[i]);
#pragma unroll
    for (int i = 0; i < 2; ++i) rb[i] = *(const u32x4*)(bp[i]);
    f32x4 acc[4][4];
#pragma unroll
    for (int m = 0; m < 4; ++m)
#pragma unroll
        for (int n = 0; n < 4; ++n) acc[m][n] = (f32x4){0.f, 0.f, 0.f, 0.f};
    const int nt = K / G_BK;
    for (int t = 0; t < nt; ++t) {
        bf16_t* Ab = As + (t & 1) * G_ABUF;
        bf16_t* Bb = Bs + (t & 1) * G_BBUF;
#pragma unroll
        for (int i = 0; i < 4; ++i) *(u32x4*)(Ab + (srow + 64 * i) * G_ST + skc) = ra[i];
#pragma unroll
        for (int i = 0; i < 2; ++i) *(u32x4*)(Bb + (srow + 64 * i) * G_ST + skc) = rb[i];
        __syncthreads();
        if (t + 1 < nt) {
#pragma unroll
            for (int i = 0; i < 4; ++i) ra[i] = *(const u32x4*)(ap[i] + (size_t)(t + 1) * G_BK);
#pragma unroll
            for (int i = 0; i < 2; ++i) rb[i] = *(const u32x4*)(bp[i] + (size_t)(t + 1) * G_BK);
        }
#pragma unroll
        for (int kk = 0; kk < 2; ++kk) {
            bf16x8 af[4], bfr[4];
#pragma unroll
            for (int m = 0; m < 4; ++m) af[m] = *(const bf16x8*)(Ab + (wr * 64 + m * 16 + r16) * G_ST + kk * 32 + g4 * 8);
#pragma unroll
            for (int n = 0; n < 4; ++n) bfr[n] = *(const bf16x8*)(Bb + (wc * 64 + n * 16 + r16) * G_ST + kk * 32 + g4 * 8);
#pragma unroll
            for (int m = 0; m < 4; ++m)
#pragma unroll
                for (int n = 0; n < 4; ++n) acc[m][n] = MFMA16(bfr[n], af[m], acc[m][n]);
        }
    }
    epi(acc, wr * 64 + r16, wc * 64 + g4 * 4);
    __syncthreads();
}

struct AMapDense { const bf16_t* A; int K; DEVI const bf16_t* operator()(int r) const { return A + (size_t)r * K; } };
struct EpiBf16Out { bf16_t* O; int ldo;
    DEVI void operator()(const f32x4 (&acc)[4][4], int rb, int cb) const {
#pragma unroll
        for (int m = 0; m < 4; ++m)
#pragma unroll
            for (int n = 0; n < 4; ++n) { u32x2 w; w.x = cvt_pk(acc[m][n][0], acc[m][n][1]); w.y = cvt_pk(acc[m][n][2], acc[m][n][3]);
                *(u32x2*)(O + (size_t)(rb + m * 16) * ldo + cb + n * 16) = w; }
    } };
struct EpiResF32 { const float* R; float* O; int ld;
    DEVI void operator()(const f32x4 (&acc)[4][4], int rb, int cb) const {
#pragma unroll
        for (int m = 0; m < 4; ++m)
#pragma unroll
            for (int n = 0; n < 4; ++n) { const size_t off = (size_t)(rb + m * 16) * ld + cb + n * 16;
                const f32x4 r = *(const f32x4*)(R + off); *(f32x4*)(O + off) = r + acc[m][n]; }
    } };

template <class MakeEpi>
DEVI void gemm_dense_units(const bf16_t* A, const bf16_t* Bt, int M, int N, int K, const MakeEpi& mk, char* lds, int u0, int ustride) {
    const int nN = N / G_BN, nU = (M / G_BM) * nN;
    for (int u = u0; u < nU; u += ustride) {
        const int pm = u / nN, pn = u % nN;
        AMapDense am{A + (size_t)pm * G_BM * K, K};
        gemm_tile(am, Bt + (size_t)pn * G_BN * K, K, mk(pm * G_BM, pn * G_BN), lds);
    }
}


DEVI const char* uni_ptr(const char* p) {
    const unsigned long long v = (unsigned long long)p;
    const unsigned lo = __builtin_amdgcn_readfirstlane((unsigned)v), hi = __builtin_amdgcn_readfirstlane((unsigned)(v >> 32));
    return (const char*)(gb_ptr)(((unsigned long long)hi << 32) | lo);
}
namespace g8 {
constexpr int BM = 256, BK = 64, HALF = 128, HTB = HALF * BK * 2, STAGE_BYTES = 8 * HTB;
DEVI int lds_byte(int r, int c) { const int st = (r >> 4) * 2 + (c >> 5), rr = r & 15, cc = c & 31, ob = rr * 64 + cc * 2; return st * 1024 + (ob ^ (((ob >> 9) & 1) << 5)); }
DEVI void stage_rc(int b, int& R, int& C) { const int st = b / 1024, sb = b % 1024, swz = sb ^ (((sb >> 9) & 1) << 5); R = (st >> 1) * 16 + swz / 64; C = (st & 1) * 32 + (swz % 64) / 2; }
DEVI int perm32(int rho) { const int n = rho >> 4, i = rho & 15; return 8 * (i >> 2) + 4 * n + (i & 3); }
struct UnitU { const char* A; const char* B; int i0, i1, i2, i3; int flags; };

template <class Epi, class Sched>
DEVI void gemm8(char* lds_generic, int K, int klen, Sched& S, const Epi& E) {
    LAS unsigned char* lds = (LAS unsigned char*)lds_generic;
    const int tid = TIDX(), wid = __builtin_amdgcn_readfirstlane(tid >> 6), lane = tid & 63, wr = wid >> 2, wc = wid & 3, fr = lane & 15, fq = lane >> 4;
    const int nt = klen / BK;
    int R0, C0, R1, C1; stage_rc(tid * 16, R0, C0); stage_rc(tid * 16 + 8192, R1, C1);
    unsigned voffB[2];
    { const int Rb0 = Epi::PERM ? ((R0 & ~31) + perm32(R0 & 31)) : R0, Rb1 = Epi::PERM ? ((R1 & ~31) + perm32(R1 & 31)) : R1;
      voffB[0] = (unsigned)(Rb0 * K + C0) * 2u; voffB[1] = (unsigned)(Rb1 * K + C1) * 2u; }
    const size_t kstep = (size_t)(BK * 2), hstepB = (size_t)HALF * K * 2;
    const unsigned ldsw = (unsigned)wid * 1024u;
    const int aoff = lds_byte(wr * 64 + fr, fq * 8), boff = lds_byte(wc * 32 + fr, fq * 8);
#define G8_SA(b, h) (((b) * 2 + (h)) * HTB)
#define G8_SB(b, h) ((4 + (b) * 2 + (h)) * HTB)
#define G8_STG(bufoff, gbase, v0, v1) do { const char* _gb = uni_ptr((const char*)(gbase));     \
        __builtin_amdgcn_global_load_lds((const unsigned*)(_gb + (v0)), (LAS unsigned*)(lds + (bufoff) + ldsw), 16, 0, 0); \
        __builtin_amdgcn_global_load_lds((const unsigned*)(_gb + (v1)), (LAS unsigned*)(lds + (bufoff) + ldsw + 8192), 16, 0, 0); } while (0)
#define G8_LDA(dst, b, h) do { _Pragma("unroll") for (int m = 0; m < 4; ++m) _Pragma("unroll") for (int k = 0; k < 2; ++k) dst[m][k] = *(const LAS bf16x8*)(lds + G8_SA(b, h) + aoff + m * 2048 + k * 1024); } while (0)
#define G8_LDB(dst, b, h) do { _Pragma("unroll") for (int n = 0; n < 2; ++n) _Pragma("unroll") for (int k = 0; k < 2; ++k) dst[n][k] = *(const LAS bf16x8*)(lds + G8_SB(b, h) + boff + n * 2048 + k * 1024); } while (0)
#define G8_MMA(ai, bj, At, Bt) do { __builtin_amdgcn_s_setprio(1); _Pragma("unroll") for (int m = 0; m < 4; ++m) _Pragma("unroll") for (int n = 0; n < 2; ++n) _Pragma("unroll") for (int k = 0; k < 2; ++k) \
        acc[ai][bj][m][n] = __builtin_amdgcn_mfma_f32_16x16x32_bf16(Bt[n][k], At[m][k], acc[ai][bj][m][n], 0, 0, 0); __builtin_amdgcn_s_setprio(0); } while (0)
#define G8_WAIT_V(n) asm volatile("s_waitcnt vmcnt(" #n ")" ::: "memory")
#define G8_WAIT_L(n) asm volatile("s_waitcnt lgkmcnt(" #n ")" ::: "memory")
#define G8_BAR __builtin_amdgcn_s_barrier()
#define G8_SCHED __builtin_amdgcn_sched_barrier(0)
    UnitU cur, nxt;
    if (!S.next(cur)) return;
    unsigned va00, va01, va10, va11;
    S.lane_va(cur, R0, C0, R1, C1, va00, va01, va10, va11);
    f32x4 acc[2][2][4][2];
#pragma unroll
    for (int a = 0; a < 2; ++a)
#pragma unroll
        for (int b = 0; b < 2; ++b)
#pragma unroll
            for (int m = 0; m < 4; ++m)
#pragma unroll
                for (int n = 0; n < 2; ++n) acc[a][b][m][n] = (f32x4){0.f, 0.f, 0.f, 0.f};
    bf16x8 At[4][2], B0[2][2], B1[2][2];
    const char* cA = cur.A; const char* cB = cur.B;
    G8_STG(G8_SB(0, 0), cB, voffB[0], voffB[1]); G8_STG(G8_SA(0, 0), cA, va00, va01); G8_STG(G8_SB(0, 1), cB + hstepB, voffB[0], voffB[1]); G8_STG(G8_SA(0, 1), cA, va10, va11);
    if (wr == 1) G8_BAR;
    G8_WAIT_V(4); G8_BAR;
    G8_STG(G8_SB(1, 0), cB + kstep, voffB[0], voffB[1]); G8_STG(G8_SA(1, 0), cA + kstep, va00, va01); G8_STG(G8_SB(1, 1), cB + hstepB + kstep, voffB[0], voffB[1]);
    G8_WAIT_V(6); G8_BAR;
    for (;;) {
        const bool has_next = S.next(nxt);
        const char* nA = has_next ? nxt.A : cA; const char* nB = has_next ? nxt.B : cB;
        unsigned x00 = va00, x01 = va01, x10 = va10, x11 = va11;
        for (int t = 0; t < nt; t += 2) {
            const bool last = (t == nt - 2);
            const char* a1 = cA + (size_t)(t + 1) * kstep;
            const char* a2 = last ? nA : cA + (size_t)(t + 2) * kstep; const char* b2 = last ? nB : cB + (size_t)(t + 2) * kstep;
            const char* a3 = a2 + kstep; const char* b3 = b2 + kstep;
            if (Sched::GATHER) { if (last && has_next) S.lane_va(nxt, R0, C0, R1, C1, x00, x01, x10, x11); }
            G8_LDB(B0, 0, 0); G8_SCHED; G8_LDA(At, 0, 0); G8_STG(G8_SA(1, 1), a1, va10, va11);
            G8_WAIT_L(8); G8_BAR; G8_WAIT_L(0); G8_MMA(0, 0, At, B0); G8_BAR; G8_SCHED;
            G8_LDB(B1, 0, 1); G8_STG(G8_SB(0, 0), b2, voffB[0], voffB[1]);
            G8_BAR; G8_WAIT_L(0); G8_MMA(0, 1, At, B1); G8_BAR;
            G8_LDA(At, 0, 1); G8_STG(G8_SA(0, 0), a2, x00, x01);
            G8_BAR; G8_WAIT_L(0); G8_MMA(1, 0, At, B0); G8_BAR; G8_SCHED;
            G8_STG(G8_SB(0, 1), b2 + hstepB, voffB[0], voffB[1]);
            G8_WAIT_V(6); G8_BAR; G8_MMA(1, 1, At, B1); G8_BAR;
            G8_LDB(B0, 1, 0); G8_SCHED; G8_LDA(At, 1, 0); G8_STG(G8_SA(0, 1), a2, x10, x11);
            G8_WAIT_L(8); G8_BAR; G8_WAIT_L(0); G8_MMA(0, 0, At, B0); G8_BAR; G8_SCHED;
            G8_LDB(B1, 1, 1); G8_STG(G8_SB(1, 0), b3, voffB[0], voffB[1]);
            G8_BAR; G8_WAIT_L(0); G8_MMA(0, 1, At, B1); G8_BAR;
            G8_LDA(At, 1, 1); G8_STG(G8_SA(1, 0), a3, x00, x01);
            G8_BAR; G8_WAIT_L(0); G8_MMA(1, 0, At, B0); G8_BAR; G8_SCHED;
            G8_STG(G8_SB(1, 1), b3 + hstepB, voffB[0], voffB[1]);
            G8_WAIT_V(6); G8_BAR; G8_MMA(1, 1, At, B1); G8_BAR;
        }
        if (cur.flags & 2) E(acc, cur, wr, wc, fr, fq); else E.mid(acc, cur, wr, wc, fr, fq);
        if (!has_next) break;
        if (nxt.flags & 1) {
#pragma unroll
        for (int a = 0; a < 2; ++a)
#pragma unroll
            for (int b = 0; b < 2; ++b)
#pragma unroll
                for (int m = 0; m < 4; ++m)
#pragma unroll
                    for (int n = 0; n < 2; ++n) acc[a][b][m][n] = (f32x4){0.f, 0.f, 0.f, 0.f};
        }
        cur = nxt; cA = nA; cB = nB; va00 = x00; va01 = x01; va10 = x10; va11 = x11;
    }
    G8_WAIT_V(0);
    if (wr == 0) G8_BAR;
    G8_BAR;
#undef G8_SA
#undef G8_SB
#undef G8_STG
#undef G8_LDA
#undef G8_LDB
#undef G8_MMA
#undef G8_WAIT_V
#undef G8_WAIT_L
#undef G8_BAR
#undef G8_SCHED
}

struct DenseSched {
    static constexpr bool GATHER = false;
    const char* A; const char* Bt; int K, nM, nN, nwg, G, c, i;
    DEVI void init(const bf16_t* A_, const bf16_t* Bt_, int M, int N, int K_, int G_, int c_) { A = (const char*)A_; Bt = (const char*)Bt_; K = K_; nM = M / BM; nN = N / BM; nwg = nM * nN; G = G_; c = c_; i = 0; }
    DEVI bool next(UnitU& u) {
        const long L = (long)i * G + c; if (L >= nwg) return false;
        ++i;
        int wgid = (int)L; { const int q = nwg / 8, r = nwg % 8, xcd = wgid % 8, off = wgid / 8; wgid = (xcd < r ? xcd * (q + 1) : r * (q + 1) + (xcd - r) * q) + off; }
        const int nig = 8 * nN, gid = wgid / nig, fm = gid * 8, gsz = (nM - fm) < 8 ? (nM - fm) : 8;
        const int pm = fm + ((wgid % nig) % gsz), pn = (wgid % nig) / gsz;
        u.A = A + (size_t)pm * BM * K * 2; u.B = Bt + (size_t)pn * BM * K * 2; u.i0 = pm; u.i1 = pn; u.i2 = 0; u.i3 = 0; u.flags = 3;
        return true;
    }
    DEVI void lane_va(const UnitU&, int R0, int C0, int R1, int C1, unsigned& v00, unsigned& v01, unsigned& v10, unsigned& v11) const {
        v00 = (unsigned)(R0 * K + C0) * 2u; v01 = (unsigned)(R1 * K + C1) * 2u; v10 = v00 + (unsigned)(HALF * K * 2); v11 = v01 + (unsigned)(HALF * K * 2);
    }
};
struct EpiBf16Scale { static constexpr bool PERM = true; bf16_t* O; int ldo; const float* rstd;
    DEVI void mid(f32x4 (&)[2][2][4][2], const UnitU&, int, int, int, int) const {}
    DEVI void operator()(const f32x4 (&acc)[2][2][4][2], const UnitU& u, int wr, int wc, int fr, int fq) const {
        const int row0 = u.i0 * BM + wr * 64 + fr;
        bf16_t* base = O + (size_t)row0 * ldo + u.i1 * BM + wc * 32 + 8 * fq;
        float rsv[2][4];
#pragma unroll
        for (int ai = 0; ai < 2; ++ai)
#pragma unroll
            for (int m = 0; m < 4; ++m) rsv[ai][m] = rstd[row0 + ai * HALF + m * 16];
#pragma unroll
        for (int ai = 0; ai < 2; ++ai)
#pragma unroll
            for (int m = 0; m < 4; ++m) { bf16_t* rowp = base + (size_t)(ai * HALF + m * 16) * ldo; const float rs = rsv[ai][m];
#pragma unroll
                for (int bj = 0; bj < 2; ++bj) { const f32x4 v0 = acc[ai][bj][m][0] * rs, v1 = acc[ai][bj][m][1] * rs;
                    u32x4 w; w.x = cvt_pk(v0[0], v0[1]); w.y = cvt_pk(v0[2], v0[3]); w.z = cvt_pk(v1[0], v1[1]); w.w = cvt_pk(v1[2], v1[3]);
                    *(u32x4*)(rowp + bj * HALF) = w; } }
    } };
struct EpiBf16 { static constexpr bool PERM = true; bf16_t* O; int ldo;
    DEVI void mid(f32x4 (&)[2][2][4][2], const UnitU&, int, int, int, int) const {}
    DEVI void operator()(const f32x4 (&acc)[2][2][4][2], const UnitU& u, int wr, int wc, int fr, int fq) const {
        bf16_t* base = O + (size_t)(u.i0 * BM + wr * 64 + fr) * ldo + u.i1 * BM + wc * 32 + 8 * fq;
#pragma unroll
        for (int ai = 0; ai < 2; ++ai)
#pragma unroll
            for (int m = 0; m < 4; ++m) { bf16_t* rowp = base + (size_t)(ai * HALF + m * 16) * ldo;
#pragma unroll
                for (int bj = 0; bj < 2; ++bj) { const f32x4 v0 = acc[ai][bj][m][0], v1 = acc[ai][bj][m][1];
                    u32x4 w; w.x = cvt_pk(v0[0], v0[1]); w.y = cvt_pk(v0[2], v0[3]); w.z = cvt_pk(v1[0], v1[1]); w.w = cvt_pk(v1[2], v1[3]);
                    *(u32x4*)(rowp + bj * HALF) = w; } }
    } };
struct EpiResBf { static constexpr bool PERM = true; const bf16_t* R; bf16_t* O; int ld;
    DEVI void mid(f32x4 (&)[2][2][4][2], const UnitU&, int, int, int, int) const {}
    DEVI void operator()(const f32x4 (&acc)[2][2][4][2], const UnitU& u, int wr, int wc, int fr, int fq) const {
        const size_t off0 = (size_t)(u.i0 * BM + wr * 64 + fr) * ld + u.i1 * BM + wc * 32 + 8 * fq;
#pragma unroll
        for (int ai = 0; ai < 2; ++ai) {
            u32x4 rr[4][2];
#pragma unroll
            for (int m = 0; m < 4; ++m)
#pragma unroll
                for (int bj = 0; bj < 2; ++bj) rr[m][bj] = *(const u32x4*)(R + off0 + (size_t)(ai * HALF + m * 16) * ld + bj * HALF);
#pragma unroll
            for (int m = 0; m < 4; ++m) { const size_t off = off0 + (size_t)(ai * HALF + m * 16) * ld;
#pragma unroll
                for (int bj = 0; bj < 2; ++bj) { const u32x4 r = rr[m][bj]; const f32x4 v0 = acc[ai][bj][m][0], v1 = acc[ai][bj][m][1];
                    u32x4 w; w.x = cvt_pk(bflo(r.x) + v0[0], bfhi(r.x) + v0[1]); w.y = cvt_pk(bflo(r.y) + v0[2], bfhi(r.y) + v0[3]);
                    w.z = cvt_pk(bflo(r.z) + v1[0], bfhi(r.z) + v1[1]); w.w = cvt_pk(bflo(r.w) + v1[2], bfhi(r.w) + v1[3]);
                    *(u32x4*)(O + off + bj * HALF) = w; } }
        }
    } };
struct EpiRes { static constexpr bool PERM = false; const float* R; float* O; int ld; bf16_t* H;
    DEVI void mid(f32x4 (&)[2][2][4][2], const UnitU&, int, int, int, int) const {}
    DEVI void operator()(const f32x4 (&acc)[2][2][4][2], const UnitU& u, int wr, int wc, int fr, int fq) const {
        const size_t off0 = (size_t)(u.i0 * BM + wr * 64 + fr) * ld + u.i1 * BM + wc * 32 + 4 * fq;
#pragma unroll
        for (int ai = 0; ai < 2; ++ai)
#pragma unroll
            for (int m = 0; m < 4; ++m) { const size_t off = off0 + (size_t)(ai * HALF + m * 16) * ld;
#pragma unroll
                for (int bj = 0; bj < 2; ++bj)
#pragma unroll
                    for (int n = 0; n < 2; ++n) { const f32x4 r = *(const f32x4*)(R + off + bj * HALF + n * 16); const f32x4 o = r + acc[ai][bj][m][n];
                        *(f32x4*)(O + off + bj * HALF + n * 16) = o;
                        u32x2 w; w.x = cvt_pk(o[0], o[1]); w.y = cvt_pk(o[2], o[3]); *(u32x2*)(H + off + bj * HALF + n * 16) = w; } }
    } };
struct DenseSched2 {
    static constexpr bool GATHER = false;
    DenseSched D; int sub;
    DEVI void init(const bf16_t* A_, const bf16_t* Bt_, int M, int N, int K_, int G_, int c_) { D.init(A_, Bt_, M, N, K_, G_, c_); sub = 0; }
    UnitU pend;
    DEVI bool next(UnitU& u) {
        if (sub == 0) { if (!D.next(pend)) return false; u = pend; u.A = pend.A + (size_t)(D.K / 2) * 2; u.B = pend.B + (size_t)(D.K / 2) * 2; u.flags = 1; sub = 1; return true; }
        u = pend; u.flags = 2; sub = 0; return true;
    }
    DEVI void lane_va(const UnitU& u, int R0, int C0, int R1, int C1, unsigned& v00, unsigned& v01, unsigned& v10, unsigned& v11) const { D.lane_va(u, R0, C0, R1, C1, v00, v01, v10, v11); }
};
struct EpiResScale : EpiResBf { const float* ssq;
    DEVI void mid(f32x4 (&acc)[2][2][4][2], const UnitU& u, int wr, int wc, int fr, int fq) const {
        float2 sqv[2][4];
#pragma unroll
        for (int ai = 0; ai < 2; ++ai)
#pragma unroll
            for (int m = 0; m < 4; ++m) sqv[ai][m] = *(const float2*)(ssq + (size_t)(u.i0 * BM + ai * HALF + wr * 64 + m * 16 + fr) * 2);
#pragma unroll
        for (int ai = 0; ai < 2; ++ai)
#pragma unroll
            for (int m = 0; m < 4; ++m) {
                const float2 sq = sqv[ai][m];
                const float rs = rsqrtf((sq.x + sq.y) * (1.0f / 512.0f) + EPS);
#pragma unroll
                for (int bj = 0; bj < 2; ++bj)
#pragma unroll
                    for (int n = 0; n < 2; ++n) acc[ai][bj][m][n] *= rs;
            }
    } };
}

constexpr float LOG2E_C = 1.4426950408889634f;
DEVI void cumsum_task(const DP& p, int bh, char* lds) {
    const int tid = TIDX(), wid = tid >> 6, lane = tid & 63;
    const int b = bh >> 2, h = bh & 3;
    const float* logf = (const float*)(p.ws() + WS_LOGF);
    float* cumf = (float*)(p.ws() + WS_CUMF);
    float* wtot = (float*)lds;
    float v[4];
#pragma unroll
    for (int j = 0; j < 4; ++j) v[j] = logf[((size_t)b * S + tid * 4 + j) * 4 + h];
    v[1] += v[0]; v[2] += v[1]; v[3] += v[2];
    float incl = v[3];
#pragma unroll
    for (int d = 1; d < 64; d <<= 1) { const float t = __shfl_up(incl, d); if (lane >= d) incl += t; }
    if (lane == 63) wtot[wid] = incl;
    __syncthreads();
    float woff = 0.f;
    for (int w = 0; w < wid; ++w) woff += wtot[w];
    const float base = woff + incl - v[3];
    *(float4*)(cumf + (size_t)bh * S + tid * 4) = make_float4((base + v[0]) * LOG2E_C, (base + v[1]) * LOG2E_C, (base + v[2]) * LOG2E_C, (base + v[3]) * LOG2E_C);
    __syncthreads();
}
DEVI void phase_inproj(const DP& p, int l, char* lds) {
    unsigned char* ws = p.ws();
    for (int t = BIDX(); t < 32; t += gridDim.x) cumsum_task(p, t, lds);
    g8::DenseSched S; S.init((const bf16_t*)(ws + WS_HBUF), (const bf16_t*)(ws + WS_W_IN), T, NPROJ, DM, gridDim.x, BIDX());
    g8::EpiBf16Scale E{(bf16_t*)(ws + WS_PROJ), NPROJ, (const float*)(ws + WS_RSTD1)};
    g8::gemm8(lds, DM, DM, S, E);
}
DEVI void kv_gemm(const DP& p, char* lds) {
    unsigned char* ws = p.ws();
    const int c = BIDX() - ((int)gridDim.x - 64);
    if (c < 0) return;
    g8::DenseSched S; S.init((const bf16_t*)(ws + WS_MEMN), (const bf16_t*)(ws + WS_W_KV), MROWS, 2 * DM, DM, 64, c);
    g8::EpiBf16 E{(bf16_t*)(ws + WS_KV), 2 * DM};
    g8::gemm8(lds, DM, DM, S, E);
}

DEVI void conv8_pos(const DP& p, int l, const bf16_t* proj, int b, int sp, int chan0, float (&out)[8]) {
    float a[8];
    const float* cb = p.in(10) + l * 1024 + chan0;
#pragma unroll
    for (int i = 0; i < 8; ++i) a[i] = cb[i];
#pragma unroll
    for (int j = 0; j < 4; ++j) {
        const int s2 = sp - 3 + j;
        if (s2 >= 0) {
            const u32x4 w = *(const u32x4*)(proj + ((size_t)b * S + s2) * NPROJ + C_XBC + chan0);
            const float* cw = p.in(9) + ((size_t)l * 4 + j) * 1024 + chan0;
            a[0] += cw[0] * bflo(w.x); a[1] += cw[1] * bfhi(w.x); a[2] += cw[2] * bflo(w.y); a[3] += cw[3] * bfhi(w.y);
            a[4] += cw[4] * bflo(w.z); a[5] += cw[5] * bfhi(w.z); a[6] += cw[6] * bflo(w.w); a[7] += cw[7] * bfhi(w.w);
        }
    }
#pragma unroll
    for (int i = 0; i < 8; ++i) out[i] = silu_f(a[i]);
}
DEVI u32x4 pack8(const float (&v)[8]) { u32x4 w; w.x = cvt_pk(v[0], v[1]); w.y = cvt_pk(v[2], v[3]); w.z = cvt_pk(v[4], v[5]); w.w = cvt_pk(v[6], v[7]); return w; }


DEVI void phase_post(const DP& p, int l) {
    const int tid = TIDX(), wid = tid >> 6, lane = tid & 63;
    unsigned char* ws = p.ws();
    bf16_t* proj = (bf16_t*)(ws + WS_PROJ);
    const int sl = lane >> 2, qt = lane & 3, type = sl >> 2, head = sl & 3;
    const int col0 = (type < 2 ? type * 256 : 768 + (type - 2) * 256) + head * 64 + qt * 16;
    const float *gq0 = p.in(5), *gq1 = p.in(6), *gq2 = p.in(7), *gq3 = p.in(8);
    asm volatile("" : "+s"(gq0), "+s"(gq1), "+s"(gq2), "+s"(gq3));
    const float* gain = (type == 0 ? gq0 : type == 1 ? gq1 : type == 2 ? gq2 : gq3) + l * 64 + qt * 16;
    float gv[16];
#pragma unroll
    for (int i = 0; i < 16; ++i) gv[i] = gain[i];
    const float inv[8] = {1.000000000e+00f, 1.939227432e-01f, 3.760603070e-02f, 7.292664610e-03f, 1.414213562e-03f, 2.742481884e-04f, 5.318295734e-05f, 1.031338525e-05f};
    for (int row = BIDX() * 8 + wid; row < T; row += gridDim.x * 8) {
        bf16_t* ptr = proj + (size_t)row * NPROJ + col0;
        const u32x4 w0 = *(const u32x4*)ptr, w1 = *(const u32x4*)(ptr + 8);
        float v[16];
        v[0] = bflo(w0.x); v[1] = bfhi(w0.x); v[2] = bflo(w0.y); v[3] = bfhi(w0.y); v[4] = bflo(w0.z); v[5] = bfhi(w0.z); v[6] = bflo(w0.w); v[7] = bfhi(w0.w);
        v[8] = bflo(w1.x); v[9] = bfhi(w1.x); v[10] = bflo(w1.y); v[11] = bfhi(w1.y); v[12] = bflo(w1.z); v[13] = bfhi(w1.z); v[14] = bflo(w1.w); v[15] = bfhi(w1.w);
        float ss = 0.f;
#pragma unroll
        for (int i = 0; i < 16; ++i) ss += v[i] * v[i];
        ss += __shfl_xor(ss, 1); ss += __shfl_xor(ss, 2);
        const float rstd = rsqrtf(ss * (1.0f / 64.0f) + EPS);
        const float qs = (type == 0 || type == 2) ? rstd * (0.125f * 1.4426950408889634f) : rstd;
#pragma unroll
        for (int i = 0; i < 16; ++i) v[i] = v[i] * qs * gv[i];
        if (type >= 2 && qt == 0) {
            const float pos = (float)(row & (S - 1));
#pragma unroll
            for (int i = 0; i < 8; ++i) { const float rev = __builtin_amdgcn_fractf(pos * inv[i] * 0.15915494309189535f);
                const float sn = __builtin_amdgcn_sinf(rev), cs = __builtin_amdgcn_cosf(rev);
                const float a = v[i], b = v[i + 8]; v[i] = a * cs - b * sn; v[i + 8] = b * cs + a * sn; }
        }
        u32x4 o0, o1;
        o0.x = cvt_pk(v[0], v[1]); o0.y = cvt_pk(v[2], v[3]); o0.z = cvt_pk(v[4], v[5]); o0.w = cvt_pk(v[6], v[7]);
        o1.x = cvt_pk(v[8], v[9]); o1.y = cvt_pk(v[10], v[11]); o1.z = cvt_pk(v[12], v[13]); o1.w = cvt_pk(v[14], v[15]);
        *(u32x4*)ptr = o0; *(u32x4*)(ptr + 8) = o1;
    }
    bf16_t* xc = (bf16_t*)(ws + WS_XC);
    for (int item = BIDX() * NTHR + tid; item < T * 128; item += gridDim.x * NTHR) {
        const int t = item >> 7, c8 = (item & 127) * 8;
        float v[8]; conv8_pos(p, l, proj, t / S, t % S, c8, v);
        *(u32x4*)(xc + (size_t)t * 1024 + c8) = pack8(v);
    }
}
DEVI void phase_knorm(const DP& p, int l) {
    const int tid = TIDX(), wid = tid >> 6, lane = tid & 63;
    unsigned char* ws = p.ws();
    bf16_t* kv = (bf16_t*)(ws + WS_KV);
    const float* kg = p.in(21) + l * 256 + (lane & 15) * 16;
    float kgv[16];
#pragma unroll
    for (int i = 0; i < 16; ++i) kgv[i] = kg[i];
    for (int row = BIDX() * 8 + wid; row < MROWS; row += gridDim.x * 8) {
        bf16_t* ptr = kv + (size_t)row * 2 * DM + lane * 16;
        const u32x4 w0 = *(const u32x4*)ptr, w1 = *(const u32x4*)(ptr + 8);
        float v[16];
        v[0] = bflo(w0.x); v[1] = bfhi(w0.x); v[2] = bflo(w0.y); v[3] = bfhi(w0.y); v[4] = bflo(w0.z); v[5] = bfhi(w0.z); v[6] = bflo(w0.w); v[7] = bfhi(w0.w);
        v[8] = bflo(w1.x); v[9] = bfhi(w1.x); v[10] = bflo(w1.y); v[11] = bfhi(w1.y); v[12] = bflo(w1.z); v[13] = bfhi(w1.z); v[14] = bflo(w1.w); v[15] = bfhi(w1.w);
        float ss = 0.f;
#pragma unroll
        for (int i = 0; i < 16; ++i) ss += v[i] * v[i];
        ss += __shfl_xor(ss, 1); ss += __shfl_xor(ss, 2); ss += __shfl_xor(ss, 4); ss += __shfl_xor(ss, 8);
        const float rstd = rsqrtf(ss * (1.0f / 256.0f) + EPS);
#pragma unroll
        for (int i = 0; i < 16; ++i) v[i] = v[i] * rstd * kgv[i];
        u32x4 o0, o1;
        o0.x = cvt_pk(v[0], v[1]); o0.y = cvt_pk(v[2], v[3]); o0.z = cvt_pk(v[4], v[5]); o0.w = cvt_pk(v[6], v[7]);
        o1.x = cvt_pk(v[8], v[9]); o1.y = cvt_pk(v[10], v[11]); o1.z = cvt_pk(v[12], v[13]); o1.w = cvt_pk(v[14], v[15]);
        *(u32x4*)ptr = o0; *(u32x4*)(ptr + 8) = o1;
    }
}
constexpr float LOG2E = 1.4426950408889634f;
template <int DH> struct AttnLds { static constexpr int KST = DH + 8; static constexpr int TILE = 64 * KST; static constexpr int BYTES = 4 * TILE * 2; };
DEVI float xor16_max(float v) { auto r = __builtin_amdgcn_permlane16_swap(__float_as_uint(v), __float_as_uint(v), false, false); return fmaxf(__uint_as_float(r[0]), __uint_as_float(r[1])); }
DEVI float xor16_sum(float v) { auto r = __builtin_amdgcn_permlane16_swap(__float_as_uint(v), __float_as_uint(v), false, false); return __uint_as_float(r[0]) + __uint_as_float(r[1]); }
DEVI float xor32_max(float v) { auto r = __builtin_amdgcn_permlane32_swap(__float_as_uint(v), __float_as_uint(v), false, false); return fmaxf(__uint_as_float(r[0]), __uint_as_float(r[1])); }
DEVI float xor32_sum(float v) { auto r = __builtin_amdgcn_permlane32_swap(__float_as_uint(v), __float_as_uint(v), false, false); return __uint_as_float(r[0]) + __uint_as_float(r[1]); }
template <int DH, int MODE, int QR>
DEVI void attn_task(const bf16_t* __restrict__ Qb, int ldq, int qtok0, int qstep,
                    const bf16_t* __restrict__ Kb, const bf16_t* __restrict__ Vb, int ldk, int ktok0, int kstep,
                    int p0, int kt_lo, int kt_hi, float scale,
                    const float* __restrict__ cum, const float* __restrict__ qgain,
                    bf16_t* Ob, int ldo, float* Of, float* Om, float* Ol, char* lds) {
    constexpr int KST = AttnLds<DH>::KST, TILE = AttnLds<DH>::TILE, NKK = DH / 32, ND = DH / 16, NCH = (64 * DH / 8) / NTHR;
    constexpr int WR = 16 * QR;
    const int tid = TIDX(), wid = tid >> 6, lane = tid & 63, r16 = lane & 15, g4 = lane >> 4;
    bf16_t* Ks = (bf16_t*)lds;
    bf16_t* Vs = Ks + 2 * TILE;
    const float c2 = scale * LOG2E;
    bf16x8 qf[QR][NKK];
    int qpos[QR];
#pragma unroll
    for (int g = 0; g < QR; ++g) {
        qpos[g] = p0 + wid * WR + g * 16 + r16;
        const bf16_t* qp = Qb + (size_t)(qtok0 + qpos[g] * qstep) * ldq + g4 * 8;
#pragma unroll
        for (int kk = 0; kk < NKK; ++kk) qf[g][kk] = *(const bf16x8*)(qp + kk * 32);
    }
    if (MODE == 2) {
#pragma unroll
        for (int g = 0; g < QR; ++g) {
            float ss = 0.f;
#pragma unroll
            for (int kk = 0; kk < NKK; ++kk)
#pragma unroll
                for (int j = 0; j < 8; ++j) { const float v = bf2f((bf16_t)qf[g][kk][j]); ss += v * v; }
            ss += __shfl_xor(ss, 16); ss += __shfl_xor(ss, 32);
            const float rstd = rsqrtf(ss * (1.0f / DH) + EPS);
#pragma unroll
            for (int kk = 0; kk < NKK; ++kk)
#pragma unroll
                for (int j = 0; j < 8; ++j) { const float v = bf2f((bf16_t)qf[g][kk][j]) * (rstd * c2) * qgain[kk * 32 + g4 * 8 + j]; qf[g][kk][j] = (short)f2bf(v); }
        }
    }
    float m_[QR], l_[QR], cq[QR];
    f32x4 o[QR][ND];
#pragma unroll
    for (int g = 0; g < QR; ++g) {
        m_[g] = -1.0e30f; l_[g] = 0.f; cq[g] = (MODE == 0) ? cum[qpos[g]] : 0.f;
#pragma unroll
        for (int n = 0; n < ND; ++n) o[g][n] = (f32x4){0.f, 0.f, 0.f, 0.f};
    }
    u32x4 rk[NCH], rv[NCH];
    auto gload = [&](int kt) {
#pragma unroll
        for (int i = 0; i < NCH; ++i) { const int c = tid + i * NTHR, key = c / (DH / 8), dc = c % (DH / 8);
            const size_t tok = (size_t)(ktok0 + (kt * 64 + key) * kstep);
            rk[i] = *(const u32x4*)(Kb + tok * ldk + dc * 8); rv[i] = *(const u32x4*)(Vb + tok * ldk + dc * 8); }
    };
    gload(kt_lo);
    __syncthreads();
    int buf = 0;
    for (int kt = kt_lo; kt < kt_hi; ++kt, buf ^= 1) {
        bf16_t* Kt = Ks + buf * TILE;
        bf16_t* Vt = Vs + buf * TILE;
#pragma unroll
        for (int i = 0; i < NCH; ++i) { const int c = tid + i * NTHR, key = c / (DH / 8), dc = c % (DH / 8);
            *(u32x4*)(Kt + key * KST + dc * 8) = rk[i]; *(u32x4*)(Vt + key * KST + dc * 8) = rv[i]; }
        __syncthreads();
        if (kt + 1 < kt_hi) gload(kt + 1);
        const int qmin = p0 + wid * WR, kmin = kt * 64;
        bool skip = false, interior = true;
        if (MODE == 0) { skip = kmin > qmin + WR - 1; interior = kmin + 63 <= qmin; }
        if (MODE == 1) { skip = (qmin + WR - 1 - kmin < 0) || (qmin - (kmin + 63) > 128); interior = (qmin - (kmin + 63) >= 0) && (qmin + WR - 1 - kmin <= 128); }
        if (skip) continue;
        f32x4 s[QR][4];
#pragma unroll
        for (int n = 0; n < 4; ++n) {
#pragma unroll
            for (int g = 0; g < QR; ++g) s[g][n] = (f32x4){0.f, 0.f, 0.f, 0.f};
#pragma unroll
            for (int kk = 0; kk < NKK; ++kk) {
                const bf16x8 kf = *(const bf16x8*)(Kt + (n * 16 + r16) * KST + kk * 32 + g4 * 8);
#pragma unroll
                for (int g = 0; g < QR; ++g) s[g][n] = MFMA16(kf, qf[g][kk], s[g][n]);
            }
            if (DH > 64) __builtin_amdgcn_sched_barrier(0);
        }
        float mx[QR];
#pragma unroll
        for (int g = 0; g < QR; ++g) mx[g] = -INFINITY;
#pragma unroll
        for (int n = 0; n < 4; ++n) {
            f32x4 ck = (f32x4){0.f, 0.f, 0.f, 0.f};
            if (MODE == 0) ck = *(const f32x4*)(cum + kt * 64 + n * 16 + g4 * 4);
#pragma unroll
            for (int g = 0; g < QR; ++g)
#pragma unroll
                for (int j = 0; j < 4; ++j) {
                    float t = s[g][n][j];
                    if (MODE == 0) t += cq[g] - ck[j];
                    if (!interior) {
                        const int kpos = kt * 64 + n * 16 + g4 * 4 + j;
                        if (MODE == 0) { if (kpos > qpos[g]) t = -INFINITY; }
                        if (MODE == 1) { const int dd = qpos[g] - kpos; if (dd < 0 || dd > 128) t = -INFINITY; }
                    }
                    s[g][n][j] = t; mx[g] = fmaxf(mx[g], t);
                }
        }
        bool grow = false;
#pragma unroll
        for (int g = 0; g < QR; ++g) { mx[g] = xor32_max(xor16_max(mx[g])); grow = grow || (mx[g] > m_[g] + 8.0f); }
        if (__any(grow)) {
#pragma unroll
            for (int g = 0; g < QR; ++g) {
                const float mn = fmaxf(m_[g], mx[g]);
                const float alpha = __builtin_amdgcn_exp2f(m_[g] - mn);
                l_[g] *= alpha; m_[g] = mn;
#pragma unroll
                for (int n = 0; n < ND; ++n) o[g][n] *= alpha;
            }
        }
#pragma unroll
        for (int g = 0; g < QR; ++g) {
            float rs = 0.f;
#pragma unroll
            for (int n = 0; n < 4; ++n)
#pragma unroll
                for (int j = 0; j < 4; ++j) { const float pv = __builtin_amdgcn_exp2f(s[g][n][j] - m_[g]); s[g][n][j] = pv; rs += pv; }
            l_[g] += xor32_sum(xor16_sum(rs));
        }
#pragma unroll
        for (int kk = 0; kk < 2; ++kk) {
            bf16x8 pb[QR];
#pragma unroll
            for (int g = 0; g < QR; ++g) {
                u32x4 w; w.x = cvt_pk(s[g][2 * kk][0], s[g][2 * kk][1]); w.y = cvt_pk(s[g][2 * kk][2], s[g][2 * kk][3]); w.z = cvt_pk(s[g][2 * kk + 1][0], s[g][2 * kk + 1][1]); w.w = cvt_pk(s[g][2 * kk + 1][2], s[g][2 * kk + 1][3]);
                pb[g] = __builtin_bit_cast(bf16x8, w); }
            const bf16_t* vb = Vt + (kk * 32 + 4 * g4 + (r16 >> 2)) * KST + 4 * (r16 & 3);
#pragma unroll
            for (int n = 0; n < ND; ++n) {
                const s16x4 lo = tr_read(vb + n * 16), hi = tr_read(vb + 16 * KST + n * 16);
                bf16x8 vf; vf[0] = lo[0]; vf[1] = lo[1]; vf[2] = lo[2]; vf[3] = lo[3]; vf[4] = hi[0]; vf[5] = hi[1]; vf[6] = hi[2]; vf[7] = hi[3];
#pragma unroll
                for (int g = 0; g < QR; ++g) o[g][n] = MFMA16(vf, pb[g], o[g][n]);
                if (DH > 64 && (n & 3) == 3) __builtin_amdgcn_sched_barrier(0);
            }
        }
    }
#pragma unroll
    for (int g = 0; g < QR; ++g) {
        const size_t tok = (size_t)(qtok0 + qpos[g] * qstep);
        if (MODE == 1) {
#pragma unroll
            for (int n = 0; n < ND; ++n) *(f32x4*)(Of + tok * 256 + n * 16 + g4 * 4) = o[g][n];
            if (g4 == 0) { Om[tok * 4] = m_[g]; Ol[tok * 4] = l_[g]; }
        } else {
            const float inv = 1.0f / l_[g];
#pragma unroll
            for (int n = 0; n < ND; ++n) { u32x2 w; w.x = cvt_pk(o[g][n][0] * inv, o[g][n][1] * inv); w.y = cvt_pk(o[g][n][2] * inv, o[g][n][3] * inv);
                *(u32x2*)(Ob + tok * ldo + n * 16 + g4 * 4) = w; }
        }
    }
}

DEVI void ssd_acs(const DP& p, int l, int b, int c, int g, float* acs, float* dts) {
    const int tid = TIDX(), wid = tid >> 6, lane = tid & 63;
    if (wid < 4) {
        const int head = g * 4 + wid;
        const float* dtv = (const float*)(p.ws() + WS_DTV);
        const float A = -__expf(p.in(12)[l * 8 + head]);
        const size_t t0 = (size_t)b * S + c * 128 + 2 * lane;
        const float d0 = dtv[t0 * 8 + head], d1 = dtv[(t0 + 1) * 8 + head];
        const float a0 = d0 * A, a1 = d1 * A;
        float incl = a0 + a1;
#pragma unroll
        for (int d = 1; d < 64; d <<= 1) { const float t = __shfl_up(incl, d); if (lane >= d) incl += t; }
        const float ex = incl - (a0 + a1);
        acs[wid * 128 + 2 * lane] = ex + a0; acs[wid * 128 + 2 * lane + 1] = ex + a0 + a1;
        dts[wid * 128 + 2 * lane] = d0; dts[wid * 128 + 2 * lane + 1] = d1;
    }
}
DEVI void conv8_chan(const DP& p, int l, const bf16_t* proj, int b, int c, int chan, int l0, float (&out)[8]) {
    const float* cw = p.in(9) + (size_t)l * 4 * 1024 + chan;
    const float w0 = cw[0], w1 = cw[1024], w2 = cw[2048], w3 = cw[3072], cb = p.in(10)[l * 1024 + chan];
    float v[11];
    const int sbase = c * 128 + l0 - 3;
#pragma unroll
    for (int i = 0; i < 11; ++i) { const int sp = sbase + i; v[i] = sp >= 0 ? bf2f(proj[((size_t)b * S + sp) * NPROJ + C_XBC + chan]) : 0.f; }
#pragma unroll
    for (int i = 0; i < 8; ++i) out[i] = silu_f(cb + w0 * v[i] + w1 * v[i + 1] + w2 * v[i + 2] + w3 * v[i + 3]);
}
constexpr int SST = 136;
constexpr int XST4 = 264;
DEVI void ssd_states_task(const DP& p, int l, int b, int c, int g, char* lds) {
    const int tid = TIDX(), wid = tid >> 6, lane = tid & 63, r16 = lane & 15, g4 = lane >> 4;
    const bf16_t* xc = (const bf16_t*)(p.ws() + WS_XC);
    bf16_t* Bn = (bf16_t*)lds;
    bf16_t* Xn = Bn + 128 * SST;
    float* acs = (float*)(Xn + 128 * XST4);
    float* dts = acs + 512;
    __syncthreads();
    ssd_acs(p, l, b, c, g, acs, dts);
    __syncthreads();
    if (tid < 4) ((float*)(p.ws() + WS_DECAY))[((size_t)b * 16 + c) * 8 + g * 4 + tid] = __expf(acs[tid * 128 + 127]);
    const size_t tok0 = (size_t)b * S + c * 128;
    for (int it = tid; it < 2048; it += NTHR) {
        const int ll = it >> 4, nc = (it & 15) * 8;
        *(u32x4*)(Bn + ll * SST + nc) = *(const u32x4*)(xc + (tok0 + ll) * 1024 + 512 + g * 128 + nc);
    }
    for (int it = tid; it < 4096; it += NTHR) {
        const int ll = it >> 5, ch = (it & 31) * 8, hl = ch >> 6;
        const u32x4 w = *(const u32x4*)(xc + (tok0 + ll) * 1024 + g * 256 + ch);
        const float sc = dts[hl * 128 + ll] * __expf(acs[hl * 128 + 127] - acs[hl * 128 + ll]);
        u32x4 o; o.x = cvt_pk(bflo(w.x) * sc, bfhi(w.x) * sc); o.y = cvt_pk(bflo(w.y) * sc, bfhi(w.y) * sc); o.z = cvt_pk(bflo(w.z) * sc, bfhi(w.z) * sc); o.w = cvt_pk(bflo(w.w) * sc, bfhi(w.w) * sc);
        *(u32x4*)(Xn + ll * XST4 + ch) = o;
    }
    __syncthreads();
    const int hl = wid >> 1, nh = wid & 1;
    f32x4 acc[4][4];
#pragma unroll
    for (int m = 0; m < 4; ++m)
#pragma unroll
        for (int n = 0; n < 4; ++n) acc[m][n] = (f32x4){0.f, 0.f, 0.f, 0.f};
#pragma unroll
    for (int kk = 0; kk < 4; ++kk) {
        bf16x8 af[4], bfr[4];
        const int lrow = kk * 32 + 8 * g4 + (r16 >> 2), cq = 4 * (r16 & 3);
#pragma unroll
        for (int m = 0; m < 4; ++m) { const bf16_t* a = Xn + lrow * XST4 + hl * 64 + m * 16 + cq; const s16x4 lo = tr_read(a), hi = tr_read(a + 4 * XST4);
            af[m][0] = lo[0]; af[m][1] = lo[1]; af[m][2] = lo[2]; af[m][3] = lo[3]; af[m][4] = hi[0]; af[m][5] = hi[1]; af[m][6] = hi[2]; af[m][7] = hi[3]; }
#pragma unroll
        for (int n = 0; n < 4; ++n) { const bf16_t* a = Bn + lrow * SST + nh * 64 + n * 16 + cq; const s16x4 lo = tr_read(a), hi = tr_read(a + 4 * SST);
            bfr[n][0] = lo[0]; bfr[n][1] = lo[1]; bfr[n][2] = lo[2]; bfr[n][3] = lo[3]; bfr[n][4] = hi[0]; bfr[n][5] = hi[1]; bfr[n][6] = hi[2]; bfr[n][7] = hi[3]; }
#pragma unroll
        for (int m = 0; m < 4; ++m)
#pragma unroll
            for (int n = 0; n < 4; ++n) acc[m][n] = MFMA16(bfr[n], af[m], acc[m][n]);
    }
    float* st = (float*)(p.ws() + WS_SSTATE) + (((size_t)b * 16 + c) * 8 + g * 4 + hl) * 8192;
#pragma unroll
    for (int m = 0; m < 4; ++m)
#pragma unroll
        for (int n = 0; n < 4; ++n) *(f32x4*)(st + (m * 16 + r16) * 128 + nh * 64 + n * 16 + g4 * 4) = acc[m][n];
}
DEVI void phase_ssd_scan(const DP& p) {
    const float* st = (const float*)(p.ws() + WS_SSTATE);
    bf16_t* hin = (bf16_t*)(p.ws() + WS_HIN);
    const float* decay = (const float*)(p.ws() + WS_DECAY);
    const int total = NB * 8 * 2048;
    for (int i = BIDX() * NTHR + TIDX(); i < total; i += gridDim.x * NTHR) {
        const int e4 = i & 2047, head = (i >> 11) & 7, b = i >> 14;
        f32x4 h = (f32x4){0.f, 0.f, 0.f, 0.f};
        for (int c = 0; c < 16; ++c) {
            const size_t off = (((size_t)b * 16 + c) * 8 + head) * 8192 + e4 * 4;
            u32x2 w; w.x = cvt_pk(h[0], h[1]); w.y = cvt_pk(h[2], h[3]);
            *(u32x2*)(hin + off) = w;
            const f32x4 s = *(const f32x4*)(st + off);
            const float d = decay[((size_t)b * 16 + c) * 8 + head];
            h = h * d + s;
        }
    }
}
constexpr int XST1 = 72;
DEVI void ssd_out_task(const DP& p, int l, int b, int c, int g, char* lds) {
    const int tid = TIDX(), wid = tid >> 6, lane = tid & 63, r16 = lane & 15, g4 = lane >> 4;
    const bf16_t* proj = (const bf16_t*)(p.ws() + WS_PROJ);
    const bf16_t* xc = (const bf16_t*)(p.ws() + WS_XC);
    bf16_t* Cs = (bf16_t*)lds;
    bf16_t* Bs = Cs + 128 * SST;
    bf16_t* Xn = Bs + 128 * SST;
    bf16_t* Hs = Xn + 128 * XST1;
    bf16_t* Mw = Hs + 64 * SST + wid * 16 * SST;
    float* acs = (float*)(Hs + 64 * SST + 8 * 16 * SST);
    float* dts = acs + 512;
    const int lrow = wid * 16 + r16;
    const size_t tok0 = (size_t)b * S + c * 128, tok = tok0 + lrow;
    bf16_t* mix = (bf16_t*)(p.ws() + WS_MIX);
    float ssq = 0.f;
    __syncthreads();
    ssd_acs(p, l, b, c, g, acs, dts);
    for (int it = tid; it < 2048; it += NTHR) {
        const int ll = it >> 4, nc = (it & 15) * 8;
        *(u32x4*)(Cs + ll * SST + nc) = *(const u32x4*)(xc + (tok0 + ll) * 1024 + 768 + g * 128 + nc);
        *(u32x4*)(Bs + ll * SST + nc) = *(const u32x4*)(xc + (tok0 + ll) * 1024 + 512 + g * 128 + nc);
    }
    __syncthreads();
    bf16x8 cfr[4];
#pragma unroll
    for (int kk = 0; kk < 4; ++kk) cfr[kk] = *(const bf16x8*)(Cs + lrow * SST + kk * 32 + g4 * 8);
    f32x4 cb[8];
#pragma unroll
    for (int st = 0; st < 8; ++st) {
        cb[st] = (f32x4){0.f, 0.f, 0.f, 0.f};
#pragma unroll
        for (int kk = 0; kk < 4; ++kk) {
            const bf16x8 bfr = *(const bf16x8*)(Bs + (st * 16 + r16) * SST + kk * 32 + g4 * 8);
            cb[st] = MFMA16(bfr, cfr[kk], cb[st]);
        }
    }
    for (int hl = 0; hl < 4; ++hl) {
        const int head = g * 4 + hl;
        __syncthreads();
        for (int it = tid; it < 1024; it += NTHR) {
            const int ss = it >> 3, pc8 = (it & 7) * 8;
            *(u32x4*)(Xn + ss * XST1 + pc8) = *(const u32x4*)(xc + (tok0 + ss) * 1024 + head * 64 + pc8);
            const bf16_t* hsrc = (const bf16_t*)(p.ws() + WS_HIN) + (((size_t)b * 16 + c) * 8 + head) * 8192 + (size_t)it * 8;
            *(u32x4*)(Hs + (it >> 4) * SST + (it & 15) * 8) = *(const u32x4*)hsrc;
        }
        __syncthreads();
        const float al = acs[hl * 128 + lrow];
#pragma unroll
        for (int st = 0; st < 8; ++st) {
            float mv[4];
#pragma unroll
            for (int j = 0; j < 4; ++j) { const int sidx = st * 16 + g4 * 4 + j;
                mv[j] = (sidx <= lrow) ? cb[st][j] * __expf(al - acs[hl * 128 + sidx]) * dts[hl * 128 + sidx] : 0.f; }
            u32x2 w; w.x = cvt_pk(mv[0], mv[1]); w.y = cvt_pk(mv[2], mv[3]);
            *(u32x2*)(Mw + r16 * SST + st * 16 + g4 * 4) = w;
        }
        __builtin_amdgcn_wave_barrier();
        asm volatile("s_waitcnt lgkmcnt(0)" ::: "memory");
        f32x4 yd[4], yo[4];
#pragma unroll
        for (int pt = 0; pt < 4; ++pt) { yd[pt] = (f32x4){0.f, 0.f, 0.f, 0.f}; yo[pt] = (f32x4){0.f, 0.f, 0.f, 0.f}; }
#pragma unroll
        for (int kk = 0; kk < 4; ++kk) {
            const bf16x8 mf = *(const bf16x8*)(Mw + r16 * SST + kk * 32 + g4 * 8);
            const bf16_t* xa = Xn + (kk * 32 + 8 * g4 + (r16 >> 2)) * XST1 + 4 * (r16 & 3);
#pragma unroll
            for (int pt = 0; pt < 4; ++pt) {
                const s16x4 lo = tr_read(xa + pt * 16), hi = tr_read(xa + 4 * XST1 + pt * 16);
                bf16x8 xf; xf[0] = lo[0]; xf[1] = lo[1]; xf[2] = lo[2]; xf[3] = lo[3]; xf[4] = hi[0]; xf[5] = hi[1]; xf[6] = hi[2]; xf[7] = hi[3];
                yd[pt] = MFMA16(xf, mf, yd[pt]);
                const bf16x8 hf = *(const bf16x8*)(Hs + (pt * 16 + r16) * SST + kk * 32 + g4 * 8);
                yo[pt] = MFMA16(hf, cfr[kk], yo[pt]);
            }
        }
        __builtin_amdgcn_wave_barrier();
        const float el = __expf(al), Dh = p.in(13)[l * 8 + head];
#pragma unroll
        for (int pt = 0; pt < 4; ++pt) {
            const int pc = pt * 16 + g4 * 4;
            const u32x2 zw = *(const u32x2*)(proj + tok * NPROJ + C_Z + head * 64 + pc);
            const u32x2 xw = *(const u32x2*)(Xn + lrow * XST1 + pc);
            const float zz[4] = {bflo(zw.x), bfhi(zw.x), bflo(zw.y), bfhi(zw.y)};
            const float xx[4] = {bflo(xw.x), bfhi(xw.x), bflo(xw.y), bfhi(xw.y)};
            float gv[4];
#pragma unroll
            for (int j = 0; j < 4; ++j) { const float yv = yd[pt][j] + el * yo[pt][j] + Dh * xx[j]; gv[j] = yv * silu_f(zz[j]); ssq += gv[j] * gv[j]; }
            u32x2 w; w.x = cvt_pk(gv[0], gv[1]); w.y = cvt_pk(gv[2], gv[3]);
            *(u32x2*)(mix + tok * DM + 512 + head * 64 + pc) = w;
        }
    }
    ssq += __shfl_xor(ssq, 16); ssq += __shfl_xor(ssq, 32);
    if (g4 == 0) ((float*)(p.ws() + WS_SSQ))[tok * 2 + g] = ssq;
}
constexpr int N_FOX = 512, N_S1 = 256, N_DIL = 1536;
DEVI void phase_mix1(const DP& p, int l, char* lds) {
    unsigned char* ws = p.ws();
    kv_gemm(p, lds);
    const bf16_t* proj = (const bf16_t*)(ws + WS_PROJ);
    bf16_t* mix = (bf16_t*)(ws + WS_MIX);
    const int G = gridDim.x, bid = BIDX();
    for (int u = bid; u < N_S1; u += G) { const int g = u & 1, c = (u >> 1) & 15, b = u >> 5; ssd_states_task(p, l, b, c, g, lds); }
    const int nfw = G / 2;
    if (bid < nfw) {
        for (int t = bid; t < 128; t += nfw) {
            const int bh = t & 31, k = t >> 5, b = bh >> 2, h = bh & 3;
            const float* cum = (const float*)(ws + WS_CUMF) + (size_t)bh * S;
#pragma unroll 1
            for (int half = 0; half < 2; ++half) {
                const int qb = half == 0 ? 7 - k : k;
                attn_task<64, 0, 2>(proj + C_FQ + h * 64, NPROJ, b * S, 1, proj + C_FK + h * 64, proj + C_FV + h * 64, NPROJ, b * S, 1,
                                    qb * 256, 0, 4 * qb + 4, 0.125f, cum, nullptr, mix + h * 64, DM, nullptr, nullptr, nullptr, lds);
            }
        }
    } else {
        const int ndw = G - nfw;
        for (int u = bid - nfw; u < 1024; u += ndw) {
            const int bh = u & 31, v = u >> 5, b = bh >> 2, h = bh & 3;
            if (v < 16) {
                const int br = v >> 3, dil = br ? 4 : 1, r = br ? ((v - 8) & 3) : 0, pb = br ? ((v - 8) >> 2) : v;
                float* Of = (float*)(ws + WS_DILO) + (size_t)br * T * 256 + h * 64;
                float* Om = (float*)(ws + WS_DILM) + (size_t)br * T * 4 + h;
                float* Ol = (float*)(ws + WS_DILL) + (size_t)br * T * 4 + h;
                const int klo = pb > 0 ? 4 * pb - 2 : 0;
                attn_task<64, 1, 2>(proj + C_DQ + h * 64, NPROJ, b * S + r, dil, proj + C_DK + h * 64, proj + C_DV + h * 64, NPROJ, b * S + r, dil,
                                    pb * 256, klo, 4 * pb + 4, 0.125f, nullptr, nullptr, nullptr, 0, Of, Om, Ol, lds);
            } else {
                const int r = v - 16;
                float* Of = (float*)(ws + WS_DILO) + (size_t)2 * T * 256 + h * 64;
                float* Om = (float*)(ws + WS_DILM) + (size_t)2 * T * 4 + h;
                float* Ol = (float*)(ws + WS_DILL) + (size_t)2 * T * 4 + h;
                attn_task<64, 1, 1>(proj + C_DQ + h * 64, NPROJ, b * S + r, 16, proj + C_DK + h * 64, proj + C_DV + h * 64, NPROJ, b * S + r, 16,
                                    0, 0, 2, 0.125f, nullptr, nullptr, nullptr, 0, Of, Om, Ol, lds);
            }
        }
    }
}
DEVI void phase_mix3(const DP& p, int l, char* lds) {
    unsigned char* ws = p.ws();
    for (int t = BIDX(); t < NB * 16 * 2; t += gridDim.x) ssd_out_task(p, l, t >> 5, (t >> 1) & 15, t & 1, lds);
    const int tid = TIDX(), wid = tid >> 6, lane = tid & 63, head = lane >> 4, d4 = (lane & 15) * 4;
    const float* Of = (const float*)(ws + WS_DILO);
    const float* Om = (const float*)(ws + WS_DILM);
    const float* Ol = (const float*)(ws + WS_DILL);
    bf16_t* mix = (bf16_t*)(ws + WS_MIX);
    for (int row = BIDX() * 8 + wid; row < T; row += gridDim.x * 8) {
        float m[3], lsum[3];
#pragma unroll
        for (int br = 0; br < 3; ++br) { m[br] = Om[((size_t)br * T + row) * 4 + head]; lsum[br] = Ol[((size_t)br * T + row) * 4 + head]; }
        const float M = fmaxf(m[0], fmaxf(m[1], m[2]));
        f32x4 num = (f32x4){0.f, 0.f, 0.f, 0.f}; float den = 0.f;
#pragma unroll
        for (int br = 0; br < 3; ++br) {
            const float w = __builtin_amdgcn_exp2f(m[br] - M);
            const f32x4 o = *(const f32x4*)(Of + ((size_t)br * T + row) * 256 + head * 64 + d4);
            num += o * w; den += w * lsum[br];
        }
        const float inv = 1.0f / den;
        u32x2 w; w.x = cvt_pk(num[0] * inv, num[1] * inv); w.y = cvt_pk(num[2] * inv, num[3] * inv);
        *(u32x2*)(mix + (size_t)row * DM + 256 + head * 64 + d4) = w;
    }
}
DEVI void phase_xattn(const DP& p, int l, char* lds) {
    unsigned char* ws = p.ws();
    const bf16_t* qbuf = (const bf16_t*)(ws + WS_QBUF);
    const bf16_t* kv = (const bf16_t*)(ws + WS_KV);
    bf16_t* obuf = (bf16_t*)(ws + WS_OBUF);
    for (int t = BIDX(); t < NB * 4 * 16; t += gridDim.x) {
        const int qb = t & 15, h = (t >> 4) & 3, b = t >> 6;
        attn_task<256, 2, 1>(qbuf + h * 256, DM, b * S, 1, kv + h * 256, kv + DM + h * 256, 2 * DM, b * MEMLEN, 1,
                          qb * 128, 0, 4, 0.0625f, nullptr, p.in(20) + l * 256, obuf + h * 256, DM, nullptr, nullptr, nullptr, lds);
    }
}
namespace g8 {
template <bool GATHER_> struct MoeSched {
    static constexpr bool GATHER = GATHER_;
    const int* cnt; const int* list; const char* Abase; const char* Bbase; size_t bstride; int K, G;
    int e, ubase, tbase, u;
    DEVI void init(const int* cnt_, const int* list_, const void* A_, const void* B_, size_t bstride_, int K_, int G_, int c_) {
        cnt = cnt_; list = list_; Abase = (const char*)A_; Bbase = (const char*)B_; bstride = bstride_; K = K_; G = G_; e = 0; ubase = 0; tbase = 0; u = c_; }
    DEVI bool next(UnitU& o) {
        while (e < NEXP) {
            const int ce = cnt[e], nte = (ce + BM - 1) / BM, nun = nte * 4;
            if (u < ubase + nun) {
                const int lu = u - ubase, pm = lu >> 2, pn = lu & 3;
                o.i0 = tbase + pm; o.i1 = pn; o.i2 = e * (2 * T) + pm * BM; o.i3 = ce - pm * BM; o.flags = 3;
                o.A = GATHER ? Abase : Abase + (size_t)(tbase + pm) * BM * K * 2;
                o.B = Bbase + (size_t)e * bstride + (size_t)pn * BM * K * 2;
                u += G; return true;
            }
            ubase += nun; tbase += nte; ++e;
        }
        return false;
    }
    DEVI void lane_va(const UnitU& o, int R0, int C0, int R1, int C1, unsigned& v00, unsigned& v01, unsigned& v10, unsigned& v11) const {
        if (GATHER) {
            const int nv = o.i3; const int* ent = list + o.i2;
            const int t00 = (ent[R0 < nv ? R0 : 0] & 0xffff) >> 1, t01 = (ent[R1 < nv ? R1 : 0] & 0xffff) >> 1, t10 = (ent[R0 + HALF < nv ? R0 + HALF : 0] & 0xffff) >> 1, t11 = (ent[R1 + HALF < nv ? R1 + HALF : 0] & 0xffff) >> 1;
            v00 = (unsigned)(t00 * K + C0) * 2u; v01 = (unsigned)(t01 * K + C1) * 2u; v10 = (unsigned)(t10 * K + C0) * 2u; v11 = (unsigned)(t11 * K + C1) * 2u;
        } else {
            v00 = (unsigned)(R0 * K + C0) * 2u; v01 = (unsigned)(R1 * K + C1) * 2u; v10 = v00 + (unsigned)(HALF * K * 2); v11 = v01 + (unsigned)(HALF * K * 2);
        }
    }
};
struct EpiSwiglu { static constexpr bool PERM = false; bf16_t* act;
    DEVI void mid(f32x4 (&)[2][2][4][2], const UnitU&, int, int, int, int) const {}
    DEVI void operator()(const f32x4 (&acc)[2][2][4][2], const UnitU& u, int wr, int wc, int fr, int fq) const {
        const int nv = u.i3;
#pragma unroll
        for (int ai = 0; ai < 2; ++ai)
#pragma unroll
            for (int m = 0; m < 4; ++m) {
                const int r = ai * HALF + wr * 64 + m * 16 + fr;
                if (r < nv) {
                    bf16_t* rowp = act + (size_t)(u.i0 * BM + r) * EFF + u.i1 * 128 + wc * 16 + 4 * fq;
#pragma unroll
                    for (int bj = 0; bj < 2; ++bj) { const f32x4 x1 = acc[ai][bj][m][0], x3 = acc[ai][bj][m][1];
                        u32x2 w; w.x = cvt_pk(silu_f(x1[0]) * x3[0], silu_f(x1[1]) * x3[1]); w.y = cvt_pk(silu_f(x1[2]) * x3[2], silu_f(x1[3]) * x3[3]);
                        *(u32x2*)(rowp + bj * 64) = w; }
                }
            }
    } };
struct EpiMoeOut { static constexpr bool PERM = true; bf16_t* y; const int* list;
    DEVI void mid(f32x4 (&)[2][2][4][2], const UnitU&, int, int, int, int) const {}
    DEVI void operator()(const f32x4 (&acc)[2][2][4][2], const UnitU& u, int wr, int wc, int fr, int fq) const {
        const int nv = u.i3; const int* ent = list + u.i2;
        unsigned env[2][4];
#pragma unroll
        for (int ai = 0; ai < 2; ++ai)
#pragma unroll
            for (int m = 0; m < 4; ++m) { const int r = ai * HALF + wr * 64 + m * 16 + fr; env[ai][m] = (unsigned)ent[r < nv ? r : 0]; }
#pragma unroll
        for (int ai = 0; ai < 2; ++ai)
#pragma unroll
            for (int m = 0; m < 4; ++m) {
                const int r = ai * HALF + wr * 64 + m * 16 + fr;
                if (r < nv) {
                    const unsigned en = env[ai][m]; const int a = (int)(en & 0xffffu); const float gt = __uint_as_float(en & 0xffff0000u);
                    bf16_t* rowp = y + (size_t)a * DM + u.i1 * BM + wc * 32 + 8 * fq;
#pragma unroll
                    for (int bj = 0; bj < 2; ++bj) { const f32x4 v0 = acc[ai][bj][m][0] * gt, v1 = acc[ai][bj][m][1] * gt;
                        u32x4 w; w.x = cvt_pk(v0[0], v0[1]); w.y = cvt_pk(v0[2], v0[3]); w.z = cvt_pk(v1[0], v1[1]); w.w = cvt_pk(v1[2], v1[3]);
                        *(u32x4*)(rowp + bj * HALF) = w; }
                }
            }
    } };
}
template <int WHICH>
DEVI void phase_moe(const DP& p, int l, char* lds) {
    unsigned char* ws = p.ws();
    const int* cnt = (const int*)(ws + WS_CNT) + l * 64;
    const int* list = (const int*)(ws + WS_LIST);
    if (WHICH == 0) {
        g8::MoeSched<true> S;
        S.init(cnt, list, ws + WS_H3, ws + WS_W_13, (size_t)1024 * DM * 2, DM, gridDim.x, BIDX());
        g8::EpiSwiglu E{(bf16_t*)(ws + WS_ACT)};
        g8::gemm8(lds, DM, DM, S, E);
    } else {
        g8::MoeSched<false> S;
        S.init(cnt, list, ws + WS_ACT, ws + WS_W_2, (size_t)DM * EFF * 2, EFF, gridDim.x, BIDX());
        g8::EpiMoeOut E{(bf16_t*)(ws + WS_YBUF), list};
        g8::gemm8(lds, EFF, EFF, S, E);
    }
}
DEVI void phase_final(const DP& p) {
    const int tid = TIDX(), wid = tid >> 6, lane = tid & 63;
    const bf16_t* ybuf = (const bf16_t*)(p.ws() + WS_YBUF);
    const bf16_t* h0 = (const bf16_t*)(p.ws() + WS_HBUF);
    float* out = p.out();
    for (int row = BIDX() * 8 + wid; row < T; row += gridDim.x * 8) {
        float x[16];
        load_row_bf16(h0 + (size_t)row * DM, x, lane);
        add_row_bf16_b(ybuf + (size_t)(2 * row) * DM, x, lane);
        add_row_bf16_b(ybuf + (size_t)(2 * row + 1) * DM, x, lane);
#pragma unroll
        for (int j = 0; j < 2; ++j) {
            *(float4*)(out + (size_t)row * DM + j * 512 + lane * 8) = make_float4(x[8 * j], x[8 * j + 1], x[8 * j + 2], x[8 * j + 3]);
            *(float4*)(out + (size_t)row * DM + j * 512 + lane * 8 + 4) = make_float4(x[8 * j + 4], x[8 * j + 5], x[8 * j + 6], x[8 * j + 7]);
        }
    }
}

#define XB_TMO      128
#define XB_XCNT(j)  (256  + 64 * (j))
#define XB_XSUB(j)  (1280 + 64 * (j))
#define XB_XGEN(j)  (2304 + 64 * (j))
#define XB_TOP      3328
#define XB_TOPGEN   3392
#define XCD_BAR_WORDS 3456
#define XB_SPIN_CAP (1u << 22)
DEVI unsigned xb_ld(unsigned* p)              { return __hip_atomic_load(p, __ATOMIC_RELAXED, __HIP_MEMORY_SCOPE_AGENT); }
DEVI unsigned xb_add(unsigned* p, unsigned v) { return __hip_atomic_fetch_add(p, v, __ATOMIC_RELAXED, __HIP_MEMORY_SCOPE_AGENT); }
DEVI unsigned xb_xcc_id() { return (unsigned)__builtin_amdgcn_s_getreg((3 << 11) | 20) & 0xFu; }
#define XB_SPIN(cond, bar) do { unsigned _sp = 0; while (cond) { __builtin_amdgcn_s_sleep(1); \
    if ((++_sp & 255u) == 0u) { if (xb_ld(&(bar)[XB_TMO])) break; if (_sp > XB_SPIN_CAP) { atomicAdd(&(bar)[XB_TMO], 1u); break; } } } } while (0)
struct XcdBarrier { unsigned* bar; unsigned x; volatile LAS unsigned* st; };
DEVI XcdBarrier xcd_barrier_post(unsigned* bar, volatile LAS unsigned* st) {
    XcdBarrier b; b.bar = bar; b.x = xb_xcc_id(); b.st = st;
    if (threadIdx.x == 0) (void)xb_add(&bar[XB_XCNT(b.x)], 1u);
    return b;
}
DEVI void xcd_barrier_complete(unsigned* bar, unsigned x, unsigned& nloc, unsigned& nx) {
    const unsigned G = gridDim.x * gridDim.y * gridDim.z;
    unsigned sum, cnt, mine, sp = 0u;
    for (;;) {
        sum = 0u; cnt = 0u; mine = 0u;
#pragma unroll
        for (unsigned j = 0; j < 16; ++j) { const unsigned c = xb_ld(&bar[XB_XCNT(j)]); sum += c; cnt += (c > 0u) ? 1u : 0u; mine = (j == x) ? c : mine; }
        if (sum == G) break;
        __builtin_amdgcn_s_sleep(1);
        if ((++sp & 255u) == 0u) { if (xb_ld(&bar[XB_TMO])) break; if (sp > XB_SPIN_CAP) { atomicAdd(&bar[XB_TMO], 1u); break; } }
    }
    nloc = mine > 0u ? mine : 1u; nx = cnt > 0u ? cnt : 1u;
}
DEVI void xcd_barrier(const XcdBarrier& b) {
    asm volatile("s_waitcnt vmcnt(0)" ::: "memory");
    __syncthreads();
    if (threadIdx.x == 0) {
        unsigned* bar = b.bar;
        __builtin_amdgcn_s_waitcnt(0);
        unsigned nloc = b.st[0], nx = b.st[1];
        if (nloc == 0u) { xcd_barrier_complete(bar, b.x, nloc, nx); b.st[0] = nloc; b.st[1] = nx; }
        const unsigned old = xb_add(&bar[XB_XSUB(b.x)], 1u);
        const unsigned gen = old / nloc;
        if (old + 1u == (gen + 1u) * nloc) {
            __builtin_amdgcn_fence(__ATOMIC_RELEASE, "agent");
            asm volatile("s_waitcnt vmcnt(0)" ::: "memory");
            const unsigned og = xb_add(&bar[XB_TOP], 1u);
            const unsigned tg = og / nx;
            if (og + 1u == (tg + 1u) * nx) xb_add(&bar[XB_TOPGEN], 1u);
            else XB_SPIN(xb_ld(&bar[XB_TOPGEN]) == tg, bar);
            __builtin_amdgcn_fence(__ATOMIC_ACQUIRE, "agent");
            xb_add(&bar[XB_XGEN(b.x)], 1u);
            asm volatile("s_waitcnt vmcnt(0)" ::: "memory");
        } else {
            XB_SPIN(xb_ld(&bar[XB_XGEN(b.x)]) == gen, bar);
            __builtin_amdgcn_fence(__ATOMIC_ACQUIRE, "agent");
            asm volatile("s_waitcnt vmcnt(0)" ::: "memory");
        }
    }
    __syncthreads();
}

constexpr int N_PHASES = 28;
__global__ void __launch_bounds__(NTHR) hybrid_fwd(Params p_unused) {
    extern __shared__ __attribute__((aligned(16))) char lds_base[];
    karg_ptr kp = (karg_ptr)__builtin_amdgcn_kernarg_segment_ptr();
    int ph_lo, ph_hi, use_gs;
    { DP q{kp}; ph_lo = q.ph_lo(); ph_hi = q.ph_hi(); use_gs = q.use_gs(); }
    volatile LAS unsigned* xst = (volatile LAS unsigned*)(LAS char*)(lds_base + LDS_BYTES - 16);
    if (threadIdx.x == 0) { xst[0] = 0u; xst[1] = 0u; }
    __syncthreads();
    XcdBarrier xb; xb.bar = nullptr; xb.x = 0; xb.st = xst;
    if (use_gs == 1) { DP q{kp}; xb = xcd_barrier_post((unsigned*)(q.ws() + WS_BAR), xst); }
#define RUN_PHASE(PH, ...) \
    if (ph_lo <= (PH) && (PH) < ph_hi) { \
        if ((PH) > ph_lo) { if (use_gs == 1) xcd_barrier(xb); else if (use_gs == 2) cg::this_grid().sync(); } \
        asm volatile("" : "+s"(kp) :: "memory"); \
        const DP p{kp}; \
        unsigned lds_off = 0; asm volatile("" : "+s"(lds_off)); \
        char* lds = lds_base + lds_off; \
        unsigned char* ws = p.ws(); (void)ws; (void)lds; \
        __VA_ARGS__ \
    }
#define LAYER_PHASES(L, B0) \
    RUN_PHASE((B0) + 0, { if ((L) == 1) { for (int u = BIDX(); u < PREP_UNITS; u += gridDim.x) prep_unit(p, 1, u, (float*)lds); } __syncthreads(); phase_norm1(p, (L), lds); }) \
    RUN_PHASE((B0) + 1, { phase_inproj(p, (L), lds); }) \
    RUN_PHASE((B0) + 2, { phase_post(p, (L)); }) \
    RUN_PHASE((B0) + 3, { phase_mix1(p, (L), lds); }) \
    RUN_PHASE((B0) + 4, { phase_ssd_scan(p); phase_knorm(p, (L)); }) \
    RUN_PHASE((B0) + 5, { phase_mix3(p, (L), lds); }) \
    RUN_PHASE((B0) + 6, { g8::DenseSched2 S; S.init((const bf16_t*)(ws + WS_MIX), (const bf16_t*)(ws + WS_W_OUT), T, DM, DM, gridDim.x, BIDX()); \
                          g8::EpiResScale E{{(const bf16_t*)(ws + WS_HBUF), (bf16_t*)(ws + WS_H1), DM}, (const float*)(ws + WS_SSQ)}; g8::gemm8(lds, DM, DM / 2, S, E); }) \
    RUN_PHASE((B0) + 7, { g8::DenseSched S; S.init((const bf16_t*)(ws + WS_H1), (const bf16_t*)(ws + WS_W_Q), T, DM, DM, gridDim.x, BIDX()); \
                          g8::EpiBf16 E{(bf16_t*)(ws + WS_QBUF), DM}; g8::gemm8(lds, DM, DM, S, E); }) \
    RUN_PHASE((B0) + 8, { phase_xattn(p, (L), lds); }) \
    RUN_PHASE((B0) + 9, { g8::DenseSched S; S.init((const bf16_t*)(ws + WS_OBUF), (const bf16_t*)(ws + WS_W_O), T, DM, DM, gridDim.x, BIDX()); \
                          g8::EpiResBf E{(const bf16_t*)(ws + WS_H1), (bf16_t*)(ws + WS_HBUF), DM}; g8::gemm8(lds, DM, DM, S, E); }) \
    RUN_PHASE((B0) + 10, { phase_norm3(p, (L), lds); }) \
    RUN_PHASE((B0) + 11, { phase_moe<0>(p, (L), lds); }) \
    RUN_PHASE((B0) + 12, { phase_moe<1>(p, (L), lds); })

    RUN_PHASE(0, { prep_small(p); for (int u = BIDX(); u < PREP_UNITS; u += gridDim.x) prep_unit(p, 0, u, (float*)lds); })
    LAYER_PHASES(0, 1)
    LAYER_PHASES(1, 14)
    RUN_PHASE(27, { phase_final(p); })
#undef LAYER_PHASES
#undef RUN_PHASE
}

extern "C" void kernel_launch(void* const* d_in, const int* in_sizes, int n_in, void* d_out, int out_size, void* d_ws, size_t ws_size, hipStream_t stream) {
    static int grid = 0;
    if (grid == 0) {
        if (n_in != 31 || out_size != T * DM || ws_size < WS_END) { fprintf(stderr, "kernel_launch: unexpected shapes (n_in %d out %d ws %zu need %zu)\n", n_in, out_size, ws_size, (size_t)WS_END); grid = -1; return; }
        int dev = 0, cus = 0, per_cu = 0;
        hipGetDevice(&dev);
        hipDeviceGetAttribute(&cus, hipDeviceAttributeMultiprocessorCount, dev);
        hipFuncSetAttribute((const void*)hybrid_fwd, hipFuncAttributeMaxDynamicSharedMemorySize, LDS_BYTES);
        hipOccupancyMaxActiveBlocksPerMultiprocessor(&per_cu, (const void*)hybrid_fwd, NTHR, LDS_BYTES);
        if (per_cu < 1) { fprintf(stderr, "kernel_launch: occupancy query says %d blocks per CU\n", per_cu); per_cu = 1; }
        (void)hipGetLastError();
        grid = cus;
    }
    if (grid < 0) return;
    Params p{};
    for (int i = 0; i < 31; ++i) p.in[i] = (const float*)d_in[i];
    p.out = (float*)d_out; p.ws = (unsigned char*)d_ws;
    p.use_grid_sync = 1; p.pad = 0;
    p.ph_lo = 0; p.ph_hi = N_PHASES;
    if (hipMemsetAsync((unsigned char*)d_ws + WS_BAR, 0, XCD_BAR_WORDS * 4, stream) != hipSuccess) { fprintf(stderr, "kernel_launch: memset failed\n"); return; }
    void* args[] = {&p};
    hipError_t e = hipLaunchCooperativeKernel((const void*)hybrid_fwd, dim3(grid), dim3(NTHR), args, LDS_BYTES, stream);
    if (e != hipSuccess) fprintf(stderr, "kernel_launch: cooperative launch failed: %s (grid %d)\n", hipGetErrorString(e), grid);
}
```

```cpp
#include <hip/hip_runtime.h>
#include <hip/hip_cooperative_groups.h>
#include <cstdio>
#include <cstdint>
namespace cg = cooperative_groups;

typedef unsigned short bf16_t;
typedef short bf16x8 __attribute__((ext_vector_type(8)));
typedef short s16x4 __attribute__((ext_vector_type(4)));
typedef float f32x4 __attribute__((ext_vector_type(4)));
typedef unsigned u32x4 __attribute__((ext_vector_type(4)));
typedef unsigned u32x2 __attribute__((ext_vector_type(2)));
#define DEVI __device__ __forceinline__
#define LAS __attribute__((address_space(3)))

constexpr int NB = 8, S = 2048, DM = 1024, T = NB * S, DEPTH = 2;
constexpr int INP = 3084, NPROJ = 3072;
constexpr int C_FQ = 0, C_FK = 256, C_FV = 512, C_DQ = 768, C_DK = 1024, C_DV = 1280, C_Z = 1536, C_XBC = 2048;
constexpr int MEMLEN = 256, MROWS = NB * MEMLEN;
constexpr int NEXP = 32, EFF = 512;
constexpr float EPS = 1e-6f;
constexpr int NTHR = 512;
constexpr int LDS_BYTES = 151552;

constexpr size_t al256(size_t x) { return (x + 255) & ~(size_t)255; }
constexpr size_t WS_W_IN = 0;
constexpr size_t WS_W_OUT = WS_W_IN + (size_t)NPROJ * DM * 2;
constexpr size_t WS_W_Q = WS_W_OUT + (size_t)DM * DM * 2;
constexpr size_t WS_W_KV = WS_W_Q + (size_t)DM * DM * 2;
constexpr size_t WS_W_O = WS_W_KV + (size_t)2 * DM * DM * 2;
constexpr size_t WS_W_13 = WS_W_O + (size_t)DM * DM * 2;
constexpr size_t WS_W_2 = WS_W_13 + (size_t)NEXP * 1024 * DM * 2;
constexpr size_t WS_WSMALL = WS_W_2 + (size_t)NEXP * DM * EFF * 2;
constexpr size_t WS_WROUT = WS_WSMALL + (size_t)DEPTH * 12 * DM * 4;
constexpr size_t WS_XB = WS_WROUT + (size_t)DEPTH * 36 * DM * 4;
constexpr size_t WS_H1 = WS_XB;
constexpr size_t WS_H3 = WS_XB + (size_t)T * DM * 2;
constexpr size_t WS_HBUF = WS_XB + (size_t)T * DM * 4;
constexpr size_t WS_PROJ = WS_HBUF + (size_t)T * DM * 2;
constexpr size_t WS_QBUF = WS_PROJ;
constexpr size_t WS_OBUF = WS_PROJ + (size_t)T * DM * 2;
constexpr size_t WS_ACT = WS_PROJ;
constexpr size_t WS_MIX = WS_PROJ + (size_t)T * NPROJ * 2;
constexpr size_t WS_U = WS_MIX + (size_t)T * DM * 2;
constexpr size_t WS_YBUF = WS_U;
constexpr size_t WS_DILO = WS_U;
constexpr size_t WS_DILM = WS_DILO + (size_t)3 * T * 256 * 4;
constexpr size_t WS_DILL = WS_DILM + (size_t)3 * T * 4 * 4;
constexpr size_t WS_SSTATE = WS_DILL + (size_t)3 * T * 4 * 4;
constexpr size_t WS_HIN = WS_SSTATE + (size_t)NB * 16 * 8 * 8192 * 4;
constexpr size_t WS_GBUF = WS_HIN + (size_t)NB * 16 * 8 * 8192 * 2;
constexpr size_t WS_U_END = WS_GBUF + (size_t)T * 512 * 4;
constexpr size_t WS_MEMN = WS_U_END;
constexpr size_t WS_KV = WS_MEMN + (size_t)MROWS * DM * 2;
constexpr size_t WS_LOGF = WS_KV + (size_t)MROWS * 2 * DM * 2;
constexpr size_t WS_CUMF = WS_LOGF + (size_t)T * 4 * 4;
constexpr size_t WS_DTV = WS_CUMF + (size_t)T * 4 * 4;
constexpr size_t WS_DECAY = WS_DTV + (size_t)T * 8 * 4;
constexpr size_t WS_CNT = WS_DECAY + (size_t)NB * 16 * 8 * 4;
constexpr size_t WS_LIST = WS_CNT + 1024;
constexpr size_t WS_GATE = WS_LIST + (size_t)NEXP * 2 * T * 4;
constexpr size_t WS_BAR = WS_GATE + (size_t)2 * T * 4;
constexpr size_t WS_XC = WS_BAR + 65536;
constexpr size_t WS_SSQ = WS_XC + (size_t)T * 1024 * 2;
constexpr size_t WS_RSTD1 = WS_SSQ + (size_t)T * 2 * 4;
constexpr size_t WS_RSTD3 = WS_RSTD1 + (size_t)T * 4;
constexpr size_t WS_END = WS_RSTD3 + (size_t)T * 4;
static_assert(WS_YBUF + (size_t)2 * T * DM * 2 <= WS_U_END, "ybuf alias");
static_assert(WS_OBUF + (size_t)T * DM * 2 <= WS_MIX, "obuf alias");

struct Params {
    const float* in[31];
    float* out;
    unsigned char* ws;
    int ph_lo, ph_hi;
    int use_grid_sync, pad;
};


typedef __attribute__((address_space(4))) const unsigned long long* karg_ptr;
typedef __attribute__((address_space(1))) const float* gcf_ptr;
typedef __attribute__((address_space(1))) float* gf_ptr;
typedef __attribute__((address_space(1))) unsigned char* gb_ptr;
struct DP {
    karg_ptr kp;
    DEVI const float* in(int i) const { return (const float*)(gcf_ptr)(kp[i]); }
    DEVI float* out() const { return (float*)(gf_ptr)(kp[31]); }
    DEVI unsigned char* ws() const { return (unsigned char*)(gb_ptr)(kp[32]); }
    DEVI int ph_lo() const { return (int)(unsigned)kp[33]; }
    DEVI int ph_hi() const { return (int)(unsigned)(kp[33] >> 32); }
    DEVI int use_gs() const { return (int)(unsigned)kp[34]; }
};

DEVI int TIDX() { int t = threadIdx.x; asm volatile("" : "+v"(t)); return t; }
DEVI int BIDX() { int b = blockIdx.x; asm volatile("" : "+s"(b)); return b; }
DEVI float bf2f(bf16_t v) { return __uint_as_float(((unsigned)v) << 16); }
typedef float f32x2 __attribute__((ext_vector_type(2)));
typedef __bf16 bf16x2_t __attribute__((ext_vector_type(2)));
DEVI unsigned cvt_pk(float lo, float hi) { f32x2 v = {lo, hi}; bf16x2_t b = __builtin_convertvector(v, bf16x2_t); return __builtin_bit_cast(unsigned, b); }
DEVI bf16_t f2bf(float f) { return (bf16_t)(cvt_pk(f, 0.f) & 0xffffu); }
DEVI float bflo(unsigned w) { return __uint_as_float(w << 16); }
DEVI float bfhi(unsigned w) { return __uint_as_float(w & 0xffff0000u); }
DEVI float wave_sum(float v) {
#pragma unroll
    for (int m = 32; m >= 1; m >>= 1) v += __shfl_xor(v, m);
    return v;
}
template <int CTRL> DEVI float dpp_mov(float v) { return __uint_as_float(__builtin_amdgcn_update_dpp(0u, __float_as_uint(v), CTRL, 0xf, 0xf, false)); }
DEVI float wave_sum_fast(float v) {
    v += dpp_mov<0xB1>(v);
    v += dpp_mov<0x4E>(v);
    v += dpp_mov<0x124>(v);
    v += dpp_mov<0x128>(v);
    const int iv = __float_as_int(v);
    return (__int_as_float(__builtin_amdgcn_readlane(iv, 0)) + __int_as_float(__builtin_amdgcn_readlane(iv, 16))) + (__int_as_float(__builtin_amdgcn_readlane(iv, 32)) + __int_as_float(__builtin_amdgcn_readlane(iv, 48)));
}
DEVI float silu_f(float x) { return x * __builtin_amdgcn_rcpf(1.f + __expf(-x)); }
DEVI float softplus_f(float x) { return x > 20.f ? x : log1pf(__expf(x)); }
DEVI float logsigmoid_f(float x) { return x >= 0.f ? -log1pf(__expf(-x)) : x - log1pf(__expf(x)); }
#define MFMA16(a, b, c) __builtin_amdgcn_mfma_f32_16x16x32_bf16(a, b, c, 0, 0, 0)
DEVI s16x4 tr_read(const bf16_t* p) {
    return __builtin_bit_cast(s16x4, __builtin_amdgcn_ds_read_tr16_b64_v4i16((LAS s16x4*)p));
}

DEVI int maprow(int mode, int n) { return mode == 0 ? n : ((n >> 4) * 32 + (n & 15) + (mode == 2 ? 16 : 0)); }
DEVI void prep_tile(const float* __restrict__ src, int ld, int k0, int c0, bf16_t* __restrict__ dst, int dstld, int mode, int n0,
                    const float* __restrict__ kscale, int ks_from, float* tl) {
    const int tid = TIDX();
#pragma unroll
    for (int i = 0; i < 2; ++i) {
        const int k = (tid >> 4) + 32 * i, n4 = (tid & 15) * 4;
        const float4 v = *(const float4*)(src + (size_t)(k0 + k) * ld + c0 + n4);
        float sc = 1.f;
        if (kscale != nullptr && (k0 + k) >= ks_from) sc = kscale[k0 + k - ks_from];
        tl[k * 65 + n4 + 0] = v.x * sc; tl[k * 65 + n4 + 1] = v.y * sc; tl[k * 65 + n4 + 2] = v.z * sc; tl[k * 65 + n4 + 3] = v.w * sc;
    }
    __syncthreads();
    {
        const int n = tid >> 3, kc = (tid & 7) * 8;
        u32x4 w;
        w.x = cvt_pk(tl[(kc + 0) * 65 + n], tl[(kc + 1) * 65 + n]);
        w.y = cvt_pk(tl[(kc + 2) * 65 + n], tl[(kc + 3) * 65 + n]);
        w.z = cvt_pk(tl[(kc + 4) * 65 + n], tl[(kc + 5) * 65 + n]);
        w.w = cvt_pk(tl[(kc + 6) * 65 + n], tl[(kc + 7) * 65 + n]);
        const int drow = maprow(mode, n0 + n);
        *(u32x4*)(dst + (size_t)drow * dstld + k0 + kc) = w;
    }
    __syncthreads();
}

constexpr int PREP_UNITS = 2048 + 3 * 4096;
DEVI void prep_unit(const DP& p, int l, int u, float* tl) {
    unsigned char* ws = p.ws();
    if (u < 768) {
        const int kt = u / 48, nt = u % 48, n0 = nt * 64, c0 = n0 < 768 ? n0 : n0 + 4;
        prep_tile(p.in(3) + (size_t)l * DM * INP, INP, kt * 64, c0, (bf16_t*)(ws + WS_W_IN), DM, 0, n0, p.in(2) + l * DM, 0, tl);
    } else if (u < 1024) {
        const int v = u - 768, kt = v / 16, nt = v % 16;
        prep_tile(p.in(15) + (size_t)l * DM * DM, DM, kt * 64, nt * 64, (bf16_t*)(ws + WS_W_OUT), DM, 0, nt * 64, p.in(14) + l * 512, 512, tl);
    } else if (u < 1280) {
        const int v = u - 1024, kt = v / 16, nt = v % 16;
        prep_tile(p.in(18) + (size_t)l * DM * DM, DM, kt * 64, nt * 64, (bf16_t*)(ws + WS_W_Q), DM, 0, nt * 64, p.in(16) + l * DM, 0, tl);
    } else if (u < 1792) {
        const int v = u - 1280, kt = v / 32, nt = v % 32;
        prep_tile(p.in(19) + (size_t)l * DM * 2 * DM, 2 * DM, kt * 64, nt * 64, (bf16_t*)(ws + WS_W_KV), DM, 0, nt * 64, nullptr, 0, tl);
    } else if (u < 2048) {
        const int v = u - 1792, kt = v / 16, nt = v % 16;
        prep_tile(p.in(22) + (size_t)l * DM * DM, DM, kt * 64, nt * 64, (bf16_t*)(ws + WS_W_O), DM, 0, nt * 64, nullptr, 0, tl);
    } else if (u < 2048 + 8192) {
        const int v = u - 2048, which = v / 4096, w = v % 4096, e = w / 128, tI = w % 128, kt = tI / 8, nt = tI % 8;
        const float* src = (which == 0 ? p.in(28) : p.in(29)) + ((size_t)l * NEXP + e) * DM * EFF;
        prep_tile(src, EFF, kt * 64, nt * 64, (bf16_t*)(ws + WS_W_13) + (size_t)e * 1024 * DM, DM, which == 0 ? 1 : 2, nt * 64, p.in(23) + l * DM, 0, tl);
    } else {
        const int w = u - 2048 - 8192, e = w / 128, tI = w % 128, kt = tI / 16, nt = tI % 16;
        const float* src = p.in(30) + ((size_t)l * NEXP + e) * EFF * DM;
        prep_tile(src, DM, kt * 64, nt * 64, (bf16_t*)(ws + WS_W_2) + (size_t)e * DM * EFF, EFF, 0, nt * 64, nullptr, 0, tl);
    }
}
DEVI void prep_small(const DP& p) {
    float* wsm = (float*)(p.ws() + WS_WSMALL);
    float* wro = (float*)(p.ws() + WS_WROUT);
    const int gtid = BIDX() * NTHR + TIDX(), gn = gridDim.x * NTHR;
    for (int i = gtid; i < DEPTH * 12 * DM; i += gn) {
        const int l = i / (12 * DM), r = i % (12 * DM), c = r / DM, k = r % DM;
        const int col = c < 4 ? 768 + c : 3076 + (c - 4);
        wsm[i] = p.in(3)[((size_t)l * DM + k) * INP + col] * p.in(2)[l * DM + k];
    }
    for (int i = gtid; i < DEPTH * 36 * DM; i += gn) {
        const int l = i / (36 * DM), r = i % (36 * DM), c = r / DM, k = r % DM;
        wro[i] = (c < 4 ? p.in(24)[((size_t)l * DM + k) * 4 + c] : p.in(26)[((size_t)l * DM + k) * 32 + (c - 4)]) * p.in(23)[l * DM + k];
    }
    if (BIDX() == 0 && TIDX() < 128) ((int*)(p.ws() + WS_CNT))[TIDX()] = 0;
}

DEVI void store_h_bf16(bf16_t* hrow, const float (&h)[16], int lane) {
#pragma unroll
    for (int j = 0; j < 4; ++j) {
        u32x2 w; w.x = cvt_pk(h[4 * j], h[4 * j + 1]); w.y = cvt_pk(h[4 * j + 2], h[4 * j + 3]);
        *(u32x2*)(hrow + j * 256 + lane * 4) = w;
    }
}
DEVI void load_row_f32(const float* xr, float (&x)[16], int lane) {
#pragma unroll
    for (int j = 0; j < 4; ++j) { const float4 v = *(const float4*)(xr + j * 256 + lane * 4); x[4 * j] = v.x; x[4 * j + 1] = v.y; x[4 * j + 2] = v.z; x[4 * j + 3] = v.w; }
}
DEVI void add_row_bf16(const bf16_t* yr, float (&x)[16], int lane) {
#pragma unroll
    for (int j = 0; j < 4; ++j) { const u32x2 w = *(const u32x2*)(yr + j * 256 + lane * 4); x[4 * j] += bflo(w.x); x[4 * j + 1] += bfhi(w.x); x[4 * j + 2] += bflo(w.y); x[4 * j + 3] += bfhi(w.y); }
}
DEVI void store_row_f32(float* xr, const float (&x)[16], int lane) {
#pragma unroll
    for (int j = 0; j < 4; ++j) *(float4*)(xr + j * 256 + lane * 4) = make_float4(x[4 * j], x[4 * j + 1], x[4 * j + 2], x[4 * j + 3]);
}
DEVI void norm_row(const float (&x)[16], const float* g, float (&h)[16], int lane) {
    float ss = 0.f;
#pragma unroll
    for (int i = 0; i < 16; ++i) ss += x[i] * x[i];
    ss = wave_sum(ss);
    const float rstd = rsqrtf(ss * (1.0f / DM) + EPS);
#pragma unroll
    for (int j = 0; j < 4; ++j) { const float4 gv = *(const float4*)(g + j * 256 + lane * 4);
        h[4 * j] = x[4 * j] * rstd * gv.x; h[4 * j + 1] = x[4 * j + 1] * rstd * gv.y; h[4 * j + 2] = x[4 * j + 2] * rstd * gv.z; h[4 * j + 3] = x[4 * j + 3] * rstd * gv.w; }
}
DEVI float dot_lds(const float (&h)[16], const float* wrow, int lane) {
    float a = 0.f;
#pragma unroll
    for (int j = 0; j < 4; ++j) { const float4 w = *(const float4*)(wrow + j * 256 + lane * 4); a += h[4 * j] * w.x + h[4 * j + 1] * w.y + h[4 * j + 2] * w.z + h[4 * j + 3] * w.w; }
    return a;
}

DEVI void load_row_bf16(const bf16_t* xr, float (&x)[16], int lane) {
#pragma unroll
    for (int j = 0; j < 2; ++j) { const u32x4 w = *(const u32x4*)(xr + j * 512 + lane * 8);
        x[8 * j] = bflo(w.x); x[8 * j + 1] = bfhi(w.x); x[8 * j + 2] = bflo(w.y); x[8 * j + 3] = bfhi(w.y); x[8 * j + 4] = bflo(w.z); x[8 * j + 5] = bfhi(w.z); x[8 * j + 6] = bflo(w.w); x[8 * j + 7] = bfhi(w.w); }
}
DEVI void add_row_bf16_b(const bf16_t* yr, float (&x)[16], int lane) {
#pragma unroll
    for (int j = 0; j < 2; ++j) { const u32x4 w = *(const u32x4*)(yr + j * 512 + lane * 8);
        x[8 * j] += bflo(w.x); x[8 * j + 1] += bfhi(w.x); x[8 * j + 2] += bflo(w.y); x[8 * j + 3] += bfhi(w.y); x[8 * j + 4] += bflo(w.z); x[8 * j + 5] += bfhi(w.z); x[8 * j + 6] += bflo(w.w); x[8 * j + 7] += bfhi(w.w); }
}
DEVI void store_row_bf16_b(bf16_t* hr, const float (&h)[16], int lane) {
#pragma unroll
    for (int j = 0; j < 2; ++j) { u32x4 w; w.x = cvt_pk(h[8 * j], h[8 * j + 1]); w.y = cvt_pk(h[8 * j + 2], h[8 * j + 3]); w.z = cvt_pk(h[8 * j + 4], h[8 * j + 5]); w.w = cvt_pk(h[8 * j + 6], h[8 * j + 7]);
        *(u32x4*)(hr + j * 512 + lane * 8) = w; }
}
DEVI float dot_lds_b(const float (&h)[16], const float* wrow, int lane) {
    float a = 0.f;
#pragma unroll
    for (int j = 0; j < 2; ++j) { const float4 w0 = *(const float4*)(wrow + j * 512 + lane * 8), w1 = *(const float4*)(wrow + j * 512 + lane * 8 + 4);
        a += h[8 * j] * w0.x + h[8 * j + 1] * w0.y + h[8 * j + 2] * w0.z + h[8 * j + 3] * w0.w + h[8 * j + 4] * w1.x + h[8 * j + 5] * w1.y + h[8 * j + 6] * w1.z + h[8 * j + 7] * w1.w; }
    return a;
}
#define MFMA_F32(a, b, c) __builtin_amdgcn_mfma_f32_16x16x4f32(a, b, c, 0, 0, 0)
template <int L>
DEVI void load_row_pre(const float* xin, const bf16_t* h0, const bf16_t* ybuf, int row, int lane, float (&x)[16]) {
    if (L == 0) load_row_f32(xin + (size_t)row * DM, x, lane);
    else { load_row_bf16(h0 + (size_t)row * DM, x, lane); add_row_bf16_b(ybuf + (size_t)(2 * row) * DM, x, lane); add_row_bf16_b(ybuf + (size_t)(2 * row + 1) * DM, x, lane); }
}
template <int L>
DEVI void norm1_rows(const DP& p, char* lds) {
    const int tid = TIDX(), wid = tid >> 6, lane = tid & 63;
    unsigned char* ws = p.ws();
    const float* wsl = (const float*)lds;
    const float* xin = p.in(0);
    const bf16_t* ybuf = (const bf16_t*)(ws + WS_YBUF);
    bf16_t* hbuf = (bf16_t*)(ws + WS_HBUF);
    float* logf = (float*)(ws + WS_LOGF);
    float* dtv = (float*)(ws + WS_DTV);
    float* rstd1 = (float*)(ws + WS_RSTD1);
    const int stride = gridDim.x * 8;
    int row = BIDX() * 8 + wid;
    float xn[16];
    if (row < T) load_row_pre<L>(xin, hbuf, ybuf, row, lane, xn);
    for (; row < T; row += stride) {
        float x[16];
#pragma unroll
        for (int i = 0; i < 16; ++i) x[i] = xn[i];
        if (row + stride < T) load_row_pre<L>(xin, hbuf, ybuf, row + stride, lane, xn);
        if (L == 0) store_h_bf16(hbuf + (size_t)row * DM, x, lane); else store_row_bf16_b(hbuf + (size_t)row * DM, x, lane);
        float ss = 0.f;
#pragma unroll
        for (int i = 0; i < 16; ++i) ss += x[i] * x[i];
        const float rstd = rsqrtf(wave_sum_fast(ss) * (1.0f / DM) + EPS);
        float keep = 0.f;
#pragma unroll
        for (int c = 0; c < 12; ++c) { const float v = wave_sum_fast(L == 0 ? dot_lds(x, wsl + c * DM, lane) : dot_lds_b(x, wsl + c * DM, lane)); keep = (lane == c) ? v : keep; if (c & 1) __builtin_amdgcn_sched_barrier(0); }
        keep *= rstd;
        if (lane == 0) rstd1[row] = rstd;
        {
            const float bias = lane < 4 ? p.in(4)[L * 4 + (lane & 3)] : p.in(11)[L * 8 + ((lane - 4) & 7)];
            const float xv = keep + bias;
            const float lt = __logf(1.0f + __expf(-fabsf(xv)));
            if (lane < 4) logf[(size_t)row * 4 + lane] = fminf(xv, 0.f) - lt;
            else if (lane < 12) dtv[(size_t)row * 8 + lane - 4] = fmaxf(xv, 0.f) + lt;
        }
    }
}
DEVI void phase_norm1(const DP& p, int l, char* lds) {
    const int tid = TIDX(), wid = tid >> 6, lane = tid & 63;
    unsigned char* ws = p.ws();
    float* wsl = (float*)lds;
    { const float4* src = (const float4*)((const float*)(ws + WS_WSMALL) + (size_t)l * 12 * DM);
      for (int i = tid; i < 12 * DM / 4; i += NTHR) ((float4*)wsl)[i] = src[i]; }
    __syncthreads();
    if (l == 0) norm1_rows<0>(p, lds); else norm1_rows<1>(p, lds);
    const float* gm = p.in(17) + l * DM;
    bf16_t* memn = (bf16_t*)(ws + WS_MEMN);
    for (int row = BIDX() * 8 + wid; row < MROWS; row += gridDim.x * 8) {
        float x[16], h[16];
        load_row_f32(p.in(1) + (size_t)row * DM, x, lane);
        norm_row(x, gm, h, lane);
        store_h_bf16(memn + (size_t)row * DM, h, lane);
    }
}
DEVI void phase_norm3(const DP& p, int l, char* lds) {
    const int tid = TIDX(), wid = tid >> 6, lane = tid & 63;
    unsigned char* ws = p.ws();
    float* wr = (float*)lds;
    int* lcnt = (int*)(lds + 36 * DM * 4);
    int* lbase = lcnt + 32;
    int* rinfo = lbase + 32;
    { const float4* src = (const float4*)((const float*)(ws + WS_WROUT) + (size_t)l * 36 * DM);
      for (int i = tid; i < 36 * DM / 4; i += NTHR) ((float4*)wr)[i] = src[i]; }
    if (tid < 32) lcnt[tid] = 0;
    __syncthreads();
    int* cnt = (int*)(ws + WS_CNT) + l * 64;
    int* list = (int*)(ws + WS_LIST);
    const bf16_t* xin = (const bf16_t*)(ws + WS_HBUF);
    bf16_t* h3 = (bf16_t*)(ws + WS_H3);
    const float* bg = p.in(25) + l * 4;
    const int be_i = __float_as_int(lane < 32 ? p.in(27)[l * 32 + lane] : 0.f);
    const int stride = gridDim.x * 8;
    int row = BIDX() * 8 + wid;
    float xn[16];
    if (row < T) load_row_bf16(xin + (size_t)row * DM, xn, lane);
    for (int it = 0; row < T; row += stride, ++it) {
        float x[16];
#pragma unroll
        for (int i = 0; i < 16; ++i) x[i] = xn[i];
        if (row + stride < T) load_row_bf16(xin + (size_t)(row + stride) * DM, xn, lane);
        float ss = 0.f;
#pragma unroll
        for (int i = 0; i < 16; ++i) ss += x[i] * x[i];
        const float rstd = rsqrtf(wave_sum_fast(ss) * (1.0f / DM) + EPS);
        { float hn[16];
#pragma unroll
          for (int i = 0; i < 16; ++i) hn[i] = x[i] * rstd;
          store_row_bf16_b(h3 + (size_t)row * DM, hn, lane); }
        float gl[4];
#pragma unroll
        for (int c = 0; c < 4; ++c) gl[c] = wave_sum_fast(dot_lds_b(x, wr + c * DM, lane)) * rstd + bg[c];
        int gsel = 0; float gmax = gl[0];
#pragma unroll
        for (int c = 1; c < 4; ++c) if (gl[c] > gmax) { gmax = gl[c]; gsel = c; }
        float gden = 0.f;
#pragma unroll
        for (int c = 0; c < 4; ++c) gden += __expf(gl[c] - gmax);
        const float ggate = 1.0f / gden;
        gsel = __builtin_amdgcn_readfirstlane(gsel);
        float v1 = -3.0e38f, v2 = -3.0e38f; int i1 = 0, i2 = 1;
#pragma unroll
        for (int c = 0; c < 8; ++c) {
            const float v = wave_sum_fast(dot_lds_b(x, wr + (4 + gsel * 8 + c) * DM, lane)) * rstd + __int_as_float(__builtin_amdgcn_readlane(be_i, gsel * 8 + c));
            if (v > v1) { v2 = v1; i2 = i1; v1 = v; i1 = c; } else if (v > v2) { v2 = v; i2 = c; }
            if (c & 1) __builtin_amdgcn_sched_barrier(0);
        }
        const float e2 = __expf(v2 - v1), inv = 1.0f / (1.0f + e2);
        if (lane == 0) {
            const int ea = gsel * 8 + i1, eb = gsel * 8 + i2;
            const int sa = atomicAdd(&lcnt[ea], 1), sb = atomicAdd(&lcnt[eb], 1);
            int* ri = rinfo + (it * 8 + wid) * 4;
            const unsigned gpk = cvt_pk(inv * ggate, e2 * inv * ggate);
            ri[0] = ea | (sa << 8); ri[1] = eb | (sb << 8); ri[2] = (int)(gpk << 16); ri[3] = (int)(gpk & 0xffff0000u);
        }
    }
    __syncthreads();
    if (tid < 32) lbase[tid] = atomicAdd(&cnt[tid], lcnt[tid]);
    __syncthreads();
    {
        const int nit = (T - (BIDX() * 8) + stride - 1) / stride;
        if (tid < nit * 8) {
            const int it = tid >> 3, w = tid & 7, r = BIDX() * 8 + w + it * stride;
            if (r < T) {
                const int* ri = rinfo + tid * 4;
                const int ea = ri[0] & 255, sa = ri[0] >> 8, eb = ri[1] & 255, sb = ri[1] >> 8;
                list[(size_t)ea * (2 * T) + lbase[ea] + sa] = ri[2] | (2 * r);
                list[(size_t)eb * (2 * T) + lbase[eb] + sb] = ri[3] | (2 * r + 1);
            }
        }
    }
    __syncthreads();
}

constexpr int G_BM = 256, G_BN = 128, G_BK = 64, G_ST = 72;
constexpr int G_ABUF = G_BM * G_ST, G_BBUF = G_BN * G_ST;
template <class AMap, class Epi>
DEVI void gemm_tile(const AMap& amap, const bf16_t* __restrict__ Bt, int K, const Epi& epi, char* lds) {
    const int tid = TIDX(), wid = tid >> 6, lane = tid & 63, r16 = lane & 15, g4 = lane >> 4;
    const int wr = wid >> 1, wc = wid & 1;
    bf16_t* As = (bf16_t*)lds;
    bf16_t* Bs = As + 2 * G_ABUF;
    const int srow = tid >> 3, skc = (tid & 7) * 8;
    const bf16_t* ap[4];
#pragma unroll
    for (int i = 0; i < 4; ++i) ap[i] = amap(srow + 64 * i) + skc;
    const bf16_t* bp[2];
#pragma unroll
    for (int i = 0; i < 2; ++i) bp[i] = Bt + (size_t)(srow + 64 * i) * K + skc;
    u32x4 ra[4], rb[2];
#pragma unroll
    for (int i = 0; i < 4; ++i) ra[i] = *(const u32x4*)(ap[i]);
#pragma unroll
    for (int i = 0; i < 2; ++i) rb[i] = *(const u32x4*)(bp[i]);
    f32x4 acc[4][4];
#pragma unroll
    for (int m = 0; m < 4; ++m)
#pragma unroll
        for (int n = 0; n < 4; ++n) acc[m][n] = (f32x4){0.f, 0.f, 0.f, 0.f};
    const int nt = K / G_BK;
    for (int t = 0; t < nt; ++t) {
        bf16_t* Ab = As + (t & 1) * G_ABUF;
        bf16_t* Bb = Bs + (t & 1) * G_BBUF;
#pragma unroll
        for (int i = 0; i < 4; ++i) *(u32x4*)(Ab + (srow + 64 * i) * G_ST + skc) = ra[i];
#pragma unroll
        for (int i = 0; i < 2; ++i) *(u32x4*)(Bb + (srow + 64 * i) * G_ST + skc) = rb[i];
        __syncthreads();
        if (t + 1 < nt) {
#pragma unroll
            for (int i = 0; i < 4; ++i) ra[i] = *(const u32x4*)(ap[i] + (size_t)(t + 1) * G_BK);
#pragma unroll
            for (int i = 0; i < 2; ++i) rb[i] = *(const u32x4*)(bp[i] + (size_t)(t + 1) * G_BK);
        }
#pragma unroll
        for (int kk = 0; kk < 2; ++kk) {
            bf16x8 af[4], bfr[4];
#pragma unroll
            for (int m = 0; m < 4; ++m) af[m] = *(const bf16x8*)(Ab + (wr * 64 + m * 16 + r16) * G_ST + kk * 32 + g4 * 8);
#pragma unroll
            for (int n = 0; n < 4; ++n) bfr[n] = *(const bf16x8*)(Bb + (wc * 64 + n * 16 + r16) * G_ST + kk * 32 + g4 * 8);
#pragma unroll
            for (int m = 0; m < 4; ++m)
#pragma unroll
                for (int n = 0; n < 4; ++n) acc[m][n] = MFMA16(bfr[n], af[m], acc[m][n]);
        }
    }
    epi(acc, wr * 64 + r16, wc * 64 + g4 * 4);
    __syncthreads();
}

struct AMapDense { const bf16_t* A; int K; DEVI const bf16_t* operator()(int r) const { return A + (size_t)r * K; } };
struct EpiBf16Out { bf16_t* O; int ldo;
    DEVI void operator()(const f32x4 (&acc)[4][4], int rb, int cb) const {
#pragma unroll
        for (int m = 0; m < 4; ++m)
#pragma unroll
            for (int n = 0; n < 4; ++n) { u32x2 w; w.x = cvt_pk(acc[m][n][0], acc[m][n][1]); w.y = cvt_pk(acc[m][n][2], acc[m][n][3]);
                *(u32x2*)(O + (size_t)(rb + m * 16) * ldo + cb + n * 16) = w; }
    } };
struct EpiResF32 { const float* R; float* O; int ld;
    DEVI void operator()(const f32x4 (&acc)[4][4], int rb, int cb) const {
#pragma unroll
        for (int m = 0; m < 4; ++m)
#pragma unroll
            for (int n = 0; n < 4; ++n) { const size_t off = (size_t)(rb + m * 16) * ld + cb + n * 16;
                const f32x4 r = *(const f32x4*)(R + off); *(f32x4*)(O + off) = r + acc[m][n]; }
    } };

template <class MakeEpi>
DEVI void gemm_dense_units(const bf16_t* A, const bf16_t* Bt, int M, int N, int K, const MakeEpi& mk, char* lds, int u0, int ustride) {
    const int nN = N / G_BN, nU = (M / G_BM) * nN;
    for (int u = u0; u < nU; u += ustride) {
        const int pm = u / nN, pn = u % nN;
        AMapDense am{A + (size_t)pm * G_BM * K, K};
        gemm_tile(am, Bt + (size_t)pn * G_BN * K, K, mk(pm * G_BM, pn * G_BN), lds);
    }
}


DEVI const char* uni_ptr(const char* p) {
    const unsigned long long v = (unsigned long long)p;
    const unsigned lo = __builtin_amdgcn_readfirstlane((unsigned)v), hi = __builtin_amdgcn_readfirstlane((unsigned)(v >> 32));
    return (const char*)(gb_ptr)(((unsigned long long)hi << 32) | lo);
}
namespace g8 {
constexpr int BM = 256, BK = 64, HALF = 128, HTB = HALF * BK * 2, STAGE_BYTES = 8 * HTB;
DEVI int lds_byte(int r, int c) { const int st = (r >> 4) * 2 + (c >> 5), rr = r & 15, cc = c & 31, ob = rr * 64 + cc * 2; return st * 1024 + (ob ^ (((ob >> 9) & 1) << 5)); }
DEVI void stage_rc(int b, int& R, int& C) { const int st = b / 1024, sb = b % 1024, swz = sb ^ (((sb >> 9) & 1) << 5); R = (st >> 1) * 16 + swz / 64; C = (st & 1) * 32 + (swz % 64) / 2; }
DEVI int perm32(int rho) { const int n = rho >> 4, i = rho & 15; return 8 * (i >> 2) + 4 * n + (i & 3); }
struct UnitU { const char* A; const char* B; int i0, i1, i2, i3; int flags; };

template <class Epi, class Sched>
DEVI void gemm8(char* lds_generic, int K, int klen, Sched& S, const Epi& E) {
    LAS unsigned char* lds = (LAS unsigned char*)lds_generic;
    const int tid = TIDX(), wid = __builtin_amdgcn_readfirstlane(tid >> 6), lane = tid & 63, wr = wid >> 2, wc = wid & 3, fr = lane & 15, fq = lane >> 4;
    const int nt = klen / BK;
    int R0, C0, R1, C1; stage_rc(tid * 16, R0, C0); stage_rc(tid * 16 + 8192, R1, C1);
    unsigned voffB[2];
    { const int Rb0 = Epi::PERM ? ((R0 & ~31) + perm32(R0 & 31)) : R0, Rb1 = Epi::PERM ? ((R1 & ~31) + perm32(R1 & 31)) : R1;
      voffB[0] = (unsigned)(Rb0 * K + C0) * 2u; voffB[1] = (unsigned)(Rb1 * K + C1) * 2u; }
    const size_t kstep = (size_t)(BK * 2), hstepB = (size_t)HALF * K * 2;
    const unsigned ldsw = (unsigned)wid * 1024u;
    const int aoff = lds_byte(wr * 64 + fr, fq * 8), boff = lds_byte(wc * 32 + fr, fq * 8);
#define G8_SA(b, h) (((b) * 2 + (h)) * HTB)
#define G8_SB(b, h) ((4 + (b) * 2 + (h)) * HTB)
#define G8_STG(bufoff, gbase, v0, v1) do { const char* _gb = uni_ptr((const char*)(gbase));     \
        __builtin_amdgcn_global_load_lds((const unsigned*)(_gb + (v0)), (LAS unsigned*)(lds + (bufoff) + ldsw), 16, 0, 0); \
        __builtin_amdgcn_global_load_lds((const unsigned*)(_gb + (v1)), (LAS unsigned*)(lds + (bufoff) + ldsw + 8192), 16, 0, 0); } while (0)
#define G8_LDA(dst, b, h) do { _Pragma("unroll") for (int m = 0; m < 4; ++m) _Pragma("unroll") for (int k = 0; k < 2; ++k) dst[m][k] = *(const LAS bf16x8*)(lds + G8_SA(b, h) + aoff + m * 2048 + k * 1024); } while (0)
#define G8_LDB(dst, b, h) do { _Pragma("unroll") for (int n = 0; n < 2; ++n) _Pragma("unroll") for (int k = 0; k < 2; ++k) dst[n][k] = *(const LAS bf16x8*)(lds + G8_SB(b, h) + boff + n * 2048 + k * 1024); } while (0)
#define G8_MMA(ai, bj, At, Bt) do { __builtin_amdgcn_s_setprio(1); _Pragma("unroll") for (int m = 0; m < 4; ++m) _Pragma("unroll") for (int n = 0; n < 2; ++n) _Pragma("unroll") for (int k = 0; k < 2; ++k) \
        acc[ai][bj][m][n] = __builtin_amdgcn_mfma_f32_16x16x32_bf16(Bt[n][k], At[m][k], acc[ai][bj][m][n], 0, 0, 0); __builtin_amdgcn_s_setprio(0); } while (0)
#define G8_WAIT_V(n) asm volatile("s_waitcnt vmcnt(" #n ")" ::: "memory")
#define G8_WAIT_L(n) asm volatile("s_waitcnt lgkmcnt(" #n ")" ::: "memory")
#define G8_BAR __builtin_amdgcn_s_barrier()
#define G8_SCHED __builtin_amdgcn_sched_barrier(0)
    UnitU cur, nxt;
    if (!S.next(cur)) return;
    unsigned va00, va01, va10, va11;
    S.lane_va(cur, R0, C0, R1, C1, va00, va01, va10, va11);
    f32x4 acc[2][2][4][2];
#pragma unroll
    for (int a = 0; a < 2; ++a)
#pragma unroll
        for (int b = 0; b < 2; ++b)
#pragma unroll
            for (int m = 0; m < 4; ++m)
#pragma unroll
                for (int n = 0; n < 2; ++n) acc[a][b][m][n] = (f32x4){0.f, 0.f, 0.f, 0.f};
    bf16x8 At[4][2], B0[2][2], B1[2][2];
    const char* cA = cur.A; const char* cB = cur.B;
    G8_STG(G8_SB(0, 0), cB, voffB[0], voffB[1]); G8_STG(G8_SA(0, 0), cA, va00, va01); G8_STG(G8_SB(0, 1), cB + hstepB, voffB[0], voffB[1]); G8_STG(G8_SA(0, 1), cA, va10, va11);
    if (wr == 1) G8_BAR;
    G8_WAIT_V(4); G8_BAR;
    G8_STG(G8_SB(1, 0), cB + kstep, voffB[0], voffB[1]); G8_STG(G8_SA(1, 0), cA + kstep, va00, va01); G8_STG(G8_SB(1, 1), cB + hstepB + kstep, voffB[0], voffB[1]);
    G8_WAIT_V(6); G8_BAR;
    for (;;) {
        const bool has_next = S.next(nxt);
        const char* nA = has_next ? nxt.A : cA; const char* nB = has_next ? nxt.B : cB;
        unsigned x00 = va00, x01 = va01, x10 = va10, x11 = va11;
        for (int t = 0; t < nt; t += 2) {
            const bool last = (t == nt - 2);
            const char* a1 = cA + (size_t)(t + 1) * kstep;
            const char* a2 = last ? nA : cA + (size_t)(t + 2) * kstep; const char* b2 = last ? nB : cB + (size_t)(t + 2) * kstep;
            const char* a3 = a2 + kstep; const char* b3 = b2 + kstep;
            if (Sched::GATHER) { if (last && has_next) S.lane_va(nxt, R0, C0, R1, C1, x00, x01, x10, x11); }
            G8_LDB(B0, 0, 0); G8_SCHED; G8_LDA(At, 0, 0); G8_STG(G8_SA(1, 1), a1, va10, va11);
            G8_WAIT_L(8); G8_BAR; G8_WAIT_L(0); G8_MMA(0, 0, At, B0); G8_BAR; G8_SCHED;
            G8_LDB(B1, 0, 1); G8_STG(G8_SB(0, 0), b2, voffB[0], voffB[1]);
            G8_BAR; G8_WAIT_L(0); G8_MMA(0, 1, At, B1); G8_BAR;
            G8_LDA(At, 0, 1); G8_STG(G8_SA(0, 0), a2, x00, x01);
            G8_BAR; G8_WAIT_L(0); G8_MMA(1, 0, At, B0); G8_BAR; G8_SCHED;
            G8_STG(G8_SB(0, 1), b2 + hstepB, voffB[0], voffB[1]);
            G8_WAIT_V(6); G8_BAR; G8_MMA(1, 1, At, B1); G8_BAR;
            G8_LDB(B0, 1, 0); G8_SCHED; G8_LDA(At, 1, 0); G8_STG(G8_SA(0, 1), a2, x10, x11);
            G8_WAIT_L(8); G8_BAR; G8_WAIT_L(0); G8_MMA(0, 0, At, B0); G8_BAR; G8_SCHED;
            G8_LDB(B1, 1, 1); G8_STG(G8_SB(1, 0), b3, voffB[0], voffB[1]);
            G8_BAR; G8_WAIT_L(0); G8_MMA(0, 1, At, B1); G8_BAR;
            G8_LDA(At, 1, 1); G8_STG(G8_SA(1, 0), a3, x00, x01);
            G8_BAR; G8_WAIT_L(0); G8_MMA(1, 0, At, B0); G8_BAR; G8_SCHED;
            G8_STG(G8_SB(1, 1), b3 + hstepB, voffB[0], voffB[1]);
            G8_WAIT_V(6); G8_BAR; G8_MMA(1, 1, At, B1); G8_BAR;
        }
        if (cur.flags & 2) E(acc, cur, wr, wc, fr, fq); else E.mid(acc, cur, wr, wc, fr, fq);
        if (!has_next) break;
        if (nxt.flags & 1) {
#pragma unroll
        for (int a = 0; a < 2; ++a)
#pragma unroll
            for (int b = 0; b < 2; ++b)
#pragma unroll
                for (int m = 0; m < 4; ++m)
#pragma unroll
                    for (int n = 0; n < 2; ++n) acc[a][b][m][n] = (f32x4){0.f, 0.f, 0.f, 0.f};
        }
        cur = nxt; cA = nA; cB = nB; va00 = x00; va01 = x01; va10 = x10; va11 = x11;
    }
    G8_WAIT_V(0);
    if (wr == 0) G8_BAR;
    G8_BAR;
#undef G8_SA
#undef G8_SB
#undef G8_STG
#undef G8_LDA
#undef G8_LDB
#undef G8_MMA
#undef G8_WAIT_V
#undef G8_WAIT_L
#undef G8_BAR
#undef G8_SCHED
}

struct DenseSched {
    static constexpr bool GATHER = false;
    const char* A; const char* Bt; int K, nM, nN, nwg, G, c, i;
    DEVI void init(const bf16_t* A_, const bf16_t* Bt_, int M, int N, int K_, int G_, int c_) { A = (const char*)A_; Bt = (const char*)Bt_; K = K_; nM = M / BM; nN = N / BM; nwg = nM * nN; G = G_; c = c_; i = 0; }
    DEVI bool next(UnitU& u) {
        const long L = (long)i * G + c; if (L >= nwg) return false;
        ++i;
        int wgid = (int)L; { const int q = nwg / 8, r = nwg % 8, xcd = wgid % 8, off = wgid / 8; wgid = (xcd < r ? xcd * (q + 1) : r * (q + 1) + (xcd - r) * q) + off; }
        const int nig = 8 * nN, gid = wgid / nig, fm = gid * 8, gsz = (nM - fm) < 8 ? (nM - fm) : 8;
        const int pm = fm + ((wgid % nig) % gsz), pn = (wgid % nig) / gsz;
        u.A = A + (size_t)pm * BM * K * 2; u.B = Bt + (size_t)pn * BM * K * 2; u.i0 = pm; u.i1 = pn; u.i2 = 0; u.i3 = 0; u.flags = 3;
        return true;
    }
    DEVI void lane_va(const UnitU&, int R0, int C0, int R1, int C1, unsigned& v00, unsigned& v01, unsigned& v10, unsigned& v11) const {
        v00 = (unsigned)(R0 * K + C0) * 2u; v01 = (unsigned)(R1 * K + C1) * 2u; v10 = v00 + (unsigned)(HALF * K * 2); v11 = v01 + (unsigned)(HALF * K * 2);
    }
};
struct EpiBf16Scale { static constexpr bool PERM = true; bf16_t* O; int ldo; const float* rstd;
    DEVI void mid(f32x4 (&)[2][2][4][2], const UnitU&, int, int, int, int) const {}
    DEVI void operator()(const f32x4 (&acc)[2][2][4][2], const UnitU& u, int wr, int wc, int fr, int fq) const {
        const int row0 = u.i0 * BM + wr * 64 + fr;
        bf16_t* base = O + (size_t)row0 * ldo + u.i1 * BM + wc * 32 + 8 * fq;
        float rsv[2][4];
#pragma unroll
        for (int ai = 0; ai < 2; ++ai)
#pragma unroll
            for (int m = 0; m < 4; ++m) rsv[ai][m] = rstd[row0 + ai * HALF + m * 16];
#pragma unroll
        for (int ai = 0; ai < 2; ++ai)
#pragma unroll
            for (int m = 0; m < 4; ++m) { bf16_t* rowp = base + (size_t)(ai * HALF + m * 16) * ldo; const float rs = rsv[ai][m];
#pragma unroll
                for (int bj = 0; bj < 2; ++bj) { const f32x4 v0 = acc[ai][bj][m][0] * rs, v1 = acc[ai][bj][m][1] * rs;
                    u32x4 w; w.x = cvt_pk(v0[0], v0[1]); w.y = cvt_pk(v0[2], v0[3]); w.z = cvt_pk(v1[0], v1[1]); w.w = cvt_pk(v1[2], v1[3]);
                    *(u32x4*)(rowp + bj * HALF) = w; } }
    } };
struct EpiBf16 { static constexpr bool PERM = true; bf16_t* O; int ldo;
    DEVI void mid(f32x4 (&)[2][2][4][2], const UnitU&, int, int, int, int) const {}
    DEVI void operator()(const f32x4 (&acc)[2][2][4][2], const UnitU& u, int wr, int wc, int fr, int fq) const {
        bf16_t* base = O + (size_t)(u.i0 * BM + wr * 64 + fr) * ldo + u.i1 * BM + wc * 32 + 8 * fq;
#pragma unroll
        for (int ai = 0; ai < 2; ++ai)
#pragma unroll
            for (int m = 0; m < 4; ++m) { bf16_t* rowp = base + (size_t)(ai * HALF + m * 16) * ldo;
#pragma unroll
                for (int bj = 0; bj < 2; ++bj) { const f32x4 v0 = acc[ai][bj][m][0], v1 = acc[ai][bj][m][1];
                    u32x4 w; w.x = cvt_pk(v0[0], v0[1]); w.y = cvt_pk(v0[2], v0[3]); w.z = cvt_pk(v1[0], v1[1]); w.w = cvt_pk(v1[2], v1[3]);
                    *(u32x4*)(rowp + bj * HALF) = w; } }
    } };
struct EpiResBf { static constexpr bool PERM = true; const bf16_t* R; bf16_t* O; int ld;
    DEVI void mid(f32x4 (&)[2][2][4][2], const UnitU&, int, int, int, int) const {}
    DEVI void operator()(const f32x4 (&acc)[2][2][4][2], const UnitU& u, int wr, int wc, int fr, int fq) const {
        const size_t off0 = (size_t)(u.i0 * BM + wr * 64 + fr) * ld + u.i1 * BM + wc * 32 + 8 * fq;
#pragma unroll
        for (int ai = 0; ai < 2; ++ai) {
            u32x4 rr[4][2];
#pragma unroll
            for (int m = 0; m < 4; ++m)
#pragma unroll
                for (int bj = 0; bj < 2; ++bj) rr[m][bj] = *(const u32x4*)(R + off0 + (size_t)(ai * HALF + m * 16) * ld + bj * HALF);
#pragma unroll
            for (int m = 0; m < 4; ++m) { const size_t off = off0 + (size_t)(ai * HALF + m * 16) * ld;
#pragma unroll
                for (int bj = 0; bj < 2; ++bj) { const u32x4 r = rr[m][bj]; const f32x4 v0 = acc[ai][bj][m][0], v1 = acc[ai][bj][m][1];
                    u32x4 w; w.x = cvt_pk(bflo(r.x) + v0[0], bfhi(r.x) + v0[1]); w.y = cvt_pk(bflo(r.y) + v0[2], bfhi(r.y) + v0[3]);
                    w.z = cvt_pk(bflo(r.z) + v1[0], bfhi(r.z) + v1[1]); w.w = cvt_pk(bflo(r.w) + v1[2], bfhi(r.w) + v1[3]);
                    *(u32x4*)(O + off + bj * HALF) = w; } }
        }
    } };
struct EpiRes { static constexpr bool PERM = false; const float* R; float* O; int ld; bf16_t* H;
    DEVI void mid(f32x4 (&)[2][2][4][2], const UnitU&, int, int, int, int) const {}
    DEVI void operator()(const f32x4 (&acc)[2][2][4][2], const UnitU& u, int wr, int wc, int fr, int fq) const {
        const size_t off0 = (size_t)(u.i0 * BM + wr * 64 + fr) * ld + u.i1 * BM + wc * 32 + 4 * fq;
#pragma unroll
        for (int ai = 0; ai < 2; ++ai)
#pragma unroll
            for (int m = 0; m < 4; ++m) { const size_t off = off0 + (size_t)(ai * HALF + m * 16) * ld;
#pragma unroll
                for (int bj = 0; bj < 2; ++bj)
#pragma unroll
                    for (int n = 0; n < 2; ++n) { const f32x4 r = *(const f32x4*)(R + off + bj * HALF + n * 16); const f32x4 o = r + acc[ai][bj][m][n];
                        *(f32x4*)(O + off + bj * HALF + n * 16) = o;
                        u32x2 w; w.x = cvt_pk(o[0], o[1]); w.y = cvt_pk(o[2], o[3]); *(u32x2*)(H + off + bj * HALF + n * 16) = w; } }
    } };
struct DenseSched2 {
    static constexpr bool GATHER = false;
    DenseSched D; int sub;
    DEVI void init(const bf16_t* A_, const bf16_t* Bt_, int M, int N, int K_, int G_, int c_) { D.init(A_, Bt_, M, N, K_, G_, c_); sub = 0; }
    UnitU pend;
    DEVI bool next(UnitU& u) {
        if (sub == 0) { if (!D.next(pend)) return false; u = pend; u.A = pend.A + (size_t)(D.K / 2) * 2; u.B = pend.B + (size_t)(D.K / 2) * 2; u.flags = 1; sub = 1; return true; }
        u = pend; u.flags = 2; sub = 0; return true;
    }
    DEVI void lane_va(const UnitU& u, int R0, int C0, int R1, int C1, unsigned& v00, unsigned& v01, unsigned& v10, unsigned& v11) const { D.lane_va(u, R0, C0, R1, C1, v00, v01, v10, v11); }
};
struct EpiResScale : EpiResBf { const float* ssq;
    DEVI void mid(f32x4 (&acc)[2][2][4][2], const UnitU& u, int wr, int wc, int fr, int fq) const {
        float2 sqv[2][4];
#pragma unroll
        for (int ai = 0; ai < 2; ++ai)
#pragma unroll
            for (int m = 0; m < 4; ++m) sqv[ai][m] = *(const float2*)(ssq + (size_t)(u.i0 * BM + ai * HALF + wr * 64 + m * 16 + fr) * 2);
#pragma unroll
        for (int ai = 0; ai < 2; ++ai)
#pragma unroll
            for (int m = 0; m < 4; ++m) {
                const float2 sq = sqv[ai][m];
                const float rs = rsqrtf((sq.x + sq.y) * (1.0f / 512.0f) + EPS);
#pragma unroll
                for (int bj = 0; bj < 2; ++bj)
#pragma unroll
                    for (int n = 0; n < 2; ++n) acc[ai][bj][m][n] *= rs;
            }
    } };
}

constexpr float LOG2E_C = 1.4426950408889634f;
DEVI void cumsum_task(const DP& p, int bh, char* lds) {
    const int tid = TIDX(), wid = tid >> 6, lane = tid & 63;
    const int b = bh >> 2, h = bh & 3;
    const float* logf = (const float*)(p.ws() + WS_LOGF);
    float* cumf = (float*)(p.ws() + WS_CUMF);
    float* wtot = (float*)lds;
    float v[4];
#pragma unroll
    for (int j = 0; j < 4; ++j) v[j] = logf[((size_t)b * S + tid * 4 + j) * 4 + h];
    v[1] += v[0]; v[2] += v[1]; v[3] += v[2];
    float incl = v[3];
#pragma unroll
    for (int d = 1; d < 64; d <<= 1) { const float t = __shfl_up(incl, d); if (lane >= d) incl += t; }
    if (lane == 63) wtot[wid] = incl;
    __syncthreads();
    float woff = 0.f;
    for (int w = 0; w < wid; ++w) woff += wtot[w];
    const float base = woff + incl - v[3];
    *(float4*)(cumf + (size_t)bh * S + tid * 4) = make_float4((base + v[0]) * LOG2E_C, (base + v[1]) * LOG2E_C, (base + v[2]) * LOG2E_C, (base + v[3]) * LOG2E_C);
    __syncthreads();
}
DEVI void phase_inproj(const DP& p, int l, char* lds) {
    unsigned char* ws = p.ws();
    g8::DenseSched S; S.init((const bf16_t*)(ws + WS_HBUF), (const bf16_t*)(ws + WS_W_IN), T, NPROJ, DM, gridDim.x, BIDX());
    g8::EpiBf16Scale E{(bf16_t*)(ws + WS_PROJ), NPROJ, (const float*)(ws + WS_RSTD1)};
    g8::gemm8(lds, DM, DM, S, E);
}
DEVI void kv_gemm(const DP& p, char* lds) {
    unsigned char* ws = p.ws();
    const int c = BIDX() - ((int)gridDim.x - 64);
    if (c < 0) return;
    g8::DenseSched S; S.init((const bf16_t*)(ws + WS_MEMN), (const bf16_t*)(ws + WS_W_KV), MROWS, 2 * DM, DM, 64, c);
    g8::EpiBf16 E{(bf16_t*)(ws + WS_KV), 2 * DM};
    g8::gemm8(lds, DM, DM, S, E);
}

DEVI void conv8_pos(const DP& p, int l, const bf16_t* proj, int b, int sp, int chan0, float (&out)[8]) {
    float a[8];
    const float* cb = p.in(10) + l * 1024 + chan0;
#pragma unroll
    for (int i = 0; i < 8; ++i) a[i] = cb[i];
#pragma unroll
    for (int j = 0; j < 4; ++j) {
        const int s2 = sp - 3 + j;
        if (s2 >= 0) {
            const u32x4 w = *(const u32x4*)(proj + ((size_t)b * S + s2) * NPROJ + C_XBC + chan0);
            const float* cw = p.in(9) + ((size_t)l * 4 + j) * 1024 + chan0;
            a[0] += cw[0] * bflo(w.x); a[1] += cw[1] * bfhi(w.x); a[2] += cw[2] * bflo(w.y); a[3] += cw[3] * bfhi(w.y);
            a[4] += cw[4] * bflo(w.z); a[5] += cw[5] * bfhi(w.z); a[6] += cw[6] * bflo(w.w); a[7] += cw[7] * bfhi(w.w);
        }
    }
#pragma unroll
    for (int i = 0; i < 8; ++i) out[i] = silu_f(a[i]);
}
DEVI u32x4 pack8(const float (&v)[8]) { u32x4 w; w.x = cvt_pk(v[0], v[1]); w.y = cvt_pk(v[2], v[3]); w.z = cvt_pk(v[4], v[5]); w.w = cvt_pk(v[6], v[7]); return w; }


DEVI void phase_post(const DP& p, int l) {
    const int tid = TIDX(), wid = tid >> 6, lane = tid & 63;
    unsigned char* ws = p.ws();
    bf16_t* proj = (bf16_t*)(ws + WS_PROJ);
    const int sl = lane >> 2, qt = lane & 3, type = sl >> 2, head = sl & 3;
    const int col0 = (type < 2 ? type * 256 : 768 + (type - 2) * 256) + head * 64 + qt * 16;
    const float *gq0 = p.in(5), *gq1 = p.in(6), *gq2 = p.in(7), *gq3 = p.in(8);
    asm volatile("" : "+s"(gq0), "+s"(gq1), "+s"(gq2), "+s"(gq3));
    const float* gain = (type == 0 ? gq0 : type == 1 ? gq1 : type == 2 ? gq2 : gq3) + l * 64 + qt * 16;
    float gv[16];
#pragma unroll
    for (int i = 0; i < 16; ++i) gv[i] = gain[i];
    const float inv[8] = {1.000000000e+00f, 1.939227432e-01f, 3.760603070e-02f, 7.292664610e-03f, 1.414213562e-03f, 2.742481884e-04f, 5.318295734e-05f, 1.031338525e-05f};
    for (int row = BIDX() * 8 + wid; row < T; row += gridDim.x * 8) {
        bf16_t* ptr = proj + (size_t)row * NPROJ + col0;
        const u32x4 w0 = *(const u32x4*)ptr, w1 = *(const u32x4*)(ptr + 8);
        float v[16];
        v[0] = bflo(w0.x); v[1] = bfhi(w0.x); v[2] = bflo(w0.y); v[3] = bfhi(w0.y); v[4] = bflo(w0.z); v[5] = bfhi(w0.z); v[6] = bflo(w0.w); v[7] = bfhi(w0.w);
        v[8] = bflo(w1.x); v[9] = bfhi(w1.x); v[10] = bflo(w1.y); v[11] = bfhi(w1.y); v[12] = bflo(w1.z); v[13] = bfhi(w1.z); v[14] = bflo(w1.w); v[15] = bfhi(w1.w);
        float ss = 0.f;
#pragma unroll
        for (int i = 0; i < 16; ++i) ss += v[i] * v[i];
        ss += __shfl_xor(ss, 1); ss += __shfl_xor(ss, 2);
        const float rstd = rsqrtf(ss * (1.0f / 64.0f) + EPS);
        const float qs = (type == 0 || type == 2) ? rstd * (0.125f * 1.4426950408889634f) : rstd;
#pragma unroll
        for (int i = 0; i < 16; ++i) v[i] = v[i] * qs * gv[i];
        if (type >= 2 && qt == 0) {
            const float pos = (float)(row & (S - 1));
#pragma unroll
            for (int i = 0; i < 8; ++i) { const float rev = __builtin_amdgcn_fractf(pos * inv[i] * 0.15915494309189535f);
                const float sn = __builtin_amdgcn_sinf(rev), cs = __builtin_amdgcn_cosf(rev);
                const float a = v[i], b = v[i + 8]; v[i] = a * cs - b * sn; v[i + 8] = b * cs + a * sn; }
        }
        u32x4 o0, o1;
        o0.x = cvt_pk(v[0], v[1]); o0.y = cvt_pk(v[2], v[3]); o0.z = cvt_pk(v[4], v[5]); o0.w = cvt_pk(v[6], v[7]);
        o1.x = cvt_pk(v[8], v[9]); o1.y = cvt_pk(v[10], v[11]); o1.z = cvt_pk(v[12], v[13]); o1.w = cvt_pk(v[14], v[15]);
        *(u32x4*)ptr = o0; *(u32x4*)(ptr + 8) = o1;
    }
    bf16_t* xc = (bf16_t*)(ws + WS_XC);
    for (int item = BIDX() * NTHR + tid; item < T * 128; item += gridDim.x * NTHR) {
        const int t = item >> 7, c8 = (item & 127) * 8;
        float v[8]; conv8_pos(p, l, proj, t / S, t % S, c8, v);
        *(u32x4*)(xc + (size_t)t * 1024 + c8) = pack8(v);
    }
}
DEVI void phase_knorm(const DP& p, int l) {
    const int tid = TIDX(), wid = tid >> 6, lane = tid & 63;
    unsigned char* ws = p.ws();
    bf16_t* kv = (bf16_t*)(ws + WS_KV);
    const float* kg = p.in(21) + l * 256 + (lane & 15) * 16;
    float kgv[16];
#pragma unroll
    for (int i = 0; i < 16; ++i) kgv[i] = kg[i];
    for (int row = BIDX() * 8 + wid; row < MROWS; row += gridDim.x * 8) {
        bf16_t* ptr = kv + (size_t)row * 2 * DM + lane * 16;
        const u32x4 w0 = *(const u32x4*)ptr, w1 = *(const u32x4*)(ptr + 8);
        float v[16];
        v[0] = bflo(w0.x); v[1] = bfhi(w0.x); v[2] = bflo(w0.y); v[3] = bfhi(w0.y); v[4] = bflo(w0.z); v[5] = bfhi(w0.z); v[6] = bflo(w0.w); v[7] = bfhi(w0.w);
        v[8] = bflo(w1.x); v[9] = bfhi(w1.x); v[10] = bflo(w1.y); v[11] = bfhi(w1.y); v[12] = bflo(w1.z); v[13] = bfhi(w1.z); v[14] = bflo(w1.w); v[15] = bfhi(w1.w);
        float ss = 0.f;
#pragma unroll
        for (int i = 0; i < 16; ++i) ss += v[i] * v[i];
        ss += __shfl_xor(ss, 1); ss += __shfl_xor(ss, 2); ss += __shfl_xor(ss, 4); ss += __shfl_xor(ss, 8);
        const float rstd = rsqrtf(ss * (1.0f / 256.0f) + EPS);
#pragma unroll
        for (int i = 0; i < 16; ++i) v[i] = v[i] * rstd * kgv[i];
        u32x4 o0, o1;
        o0.x = cvt_pk(v[0], v[1]); o0.y = cvt_pk(v[2], v[3]); o0.z = cvt_pk(v[4], v[5]); o0.w = cvt_pk(v[6], v[7]);
        o1.x = cvt_pk(v[8], v[9]); o1.y = cvt_pk(v[10], v[11]); o1.z = cvt_pk(v[12], v[13]); o1.w = cvt_pk(v[14], v[15]);
        *(u32x4*)ptr = o0; *(u32x4*)(ptr + 8) = o1;
    }
}
constexpr float LOG2E = 1.4426950408889634f;
template <int DH> struct AttnLds { static constexpr int KST = DH + 8; static constexpr int TILE = 64 * KST; static constexpr int BYTES = 4 * TILE * 2; };
DEVI float xor16_max(float v) { auto r = __builtin_amdgcn_permlane16_swap(__float_as_uint(v), __float_as_uint(v), false, false); return fmaxf(__uint_as_float(r[0]), __uint_as_float(r[1])); }
DEVI float xor16_sum(float v) { auto r = __builtin_amdgcn_permlane16_swap(__float_as_uint(v), __float_as_uint(v), false, false); return __uint_as_float(r[0]) + __uint_as_float(r[1]); }
DEVI float xor32_max(float v) { auto r = __builtin_amdgcn_permlane32_swap(__float_as_uint(v), __float_as_uint(v), false, false); return fmaxf(__uint_as_float(r[0]), __uint_as_float(r[1])); }
DEVI float xor32_sum(float v) { auto r = __builtin_amdgcn_permlane32_swap(__float_as_uint(v), __float_as_uint(v), false, false); return __uint_as_float(r[0]) + __uint_as_float(r[1]); }
template <int DH, int MODE, int QR>
DEVI void attn_task(const bf16_t* __restrict__ Qb, int ldq, int qtok0, int qstep,
                    const bf16_t* __restrict__ Kb, const bf16_t* __restrict__ Vb, int ldk, int ktok0, int kstep,
                    int p0, int kt_lo, int kt_hi, float scale,
                    const float* __restrict__ cum, const float* __restrict__ qgain,
                    bf16_t* Ob, int ldo, float* Of, float* Om, float* Ol, char* lds) {
    constexpr int KST = AttnLds<DH>::KST, TILE = AttnLds<DH>::TILE, NKK = DH / 32, ND = DH / 16, NCH = (64 * DH / 8) / NTHR;
    constexpr int WR = 16 * QR;
    const int tid = TIDX(), wid = tid >> 6, lane = tid & 63, r16 = lane & 15, g4 = lane >> 4;
    bf16_t* Ks = (bf16_t*)lds;
    bf16_t* Vs = Ks + 2 * TILE;
    const float c2 = scale * LOG2E;
    bf16x8 qf[QR][NKK];
    int qpos[QR];
#pragma unroll
    for (int g = 0; g < QR; ++g) {
        qpos[g] = p0 + wid * WR + g * 16 + r16;
        const bf16_t* qp = Qb + (size_t)(qtok0 + qpos[g] * qstep) * ldq + g4 * 8;
#pragma unroll
        for (int kk = 0; kk < NKK; ++kk) qf[g][kk] = *(const bf16x8*)(qp + kk * 32);
    }
    if (MODE == 2) {
#pragma unroll
        for (int g = 0; g < QR; ++g) {
            float ss = 0.f;
#pragma unroll
            for (int kk = 0; kk < NKK; ++kk)
#pragma unroll
                for (int j = 0; j < 8; ++j) { const float v = bf2f((bf16_t)qf[g][kk][j]); ss += v * v; }
            ss += __shfl_xor(ss, 16); ss += __shfl_xor(ss, 32);
            const float rstd = rsqrtf(ss * (1.0f / DH) + EPS);
#pragma unroll
            for (int kk = 0; kk < NKK; ++kk)
#pragma unroll
                for (int j = 0; j < 8; ++j) { const float v = bf2f((bf16_t)qf[g][kk][j]) * (rstd * c2) * qgain[kk * 32 + g4 * 8 + j]; qf[g][kk][j] = (short)f2bf(v); }
        }
    }
    float m_[QR], cq[QR];
    f32x4 o[QR][ND], o1[QR];
#pragma unroll
    for (int g = 0; g < QR; ++g) {
        m_[g] = 0.f; cq[g] = (MODE == 0) ? cum[qpos[g]] : 0.f;
        o1[g] = (f32x4){0.f, 0.f, 0.f, 0.f};
#pragma unroll
        for (int n = 0; n < ND; ++n) o[g][n] = (f32x4){0.f, 0.f, 0.f, 0.f};
    }
    bf16x8 vones;
#pragma unroll
    for (int j = 0; j < 8; ++j) vones[j] = (short)(r16 == 0 ? 0x3f80 : 0);
    u32x4 rk[NCH], rv[NCH];
    auto gload = [&](int kt) {
#pragma unroll
        for (int i = 0; i < NCH; ++i) { const int c = tid + i * NTHR, key = c / (DH / 8), dc = c % (DH / 8);
            const size_t tok = (size_t)(ktok0 + (kt * 64 + key) * kstep);
            rk[i] = *(const u32x4*)(Kb + tok * ldk + dc * 8); rv[i] = *(const u32x4*)(Vb + tok * ldk + dc * 8); }
    };
    gload(kt_lo);
    __syncthreads();
    int buf = 0;
    for (int kt = kt_lo; kt < kt_hi; ++kt, buf ^= 1) {
        bf16_t* Kt = Ks + buf * TILE;
        bf16_t* Vt = Vs + buf * TILE;
#pragma unroll
        for (int i = 0; i < NCH; ++i) { const int c = tid + i * NTHR, key = c / (DH / 8), dc = c % (DH / 8);
            *(u32x4*)(Kt + key * KST + dc * 8) = rk[i]; *(u32x4*)(Vt + key * KST + dc * 8) = rv[i]; }
        __syncthreads();
        if (kt + 1 < kt_hi) gload(kt + 1);
        const int qmin = p0 + wid * WR, kmin = kt * 64;
        bool skip = false, interior = true;
        if (MODE == 0) { skip = kmin > qmin + WR - 1; interior = kmin + 63 <= qmin; }
        if (MODE == 1) { skip = (qmin + WR - 1 - kmin < 0) || (qmin - (kmin + 63) > 128); interior = (qmin - (kmin + 63) >= 0) && (qmin + WR - 1 - kmin <= 128); }
        if (skip) continue;
        f32x4 s[QR][4];
        float cm[QR];
#pragma unroll
        for (int g = 0; g < QR; ++g) cm[g] = cq[g] - m_[g];
#pragma unroll
        for (int n = 0; n < 4; ++n) {
            f32x4 ck = (f32x4){0.f, 0.f, 0.f, 0.f};
            if (MODE == 0) ck = *(const f32x4*)(cum + kt * 64 + n * 16 + g4 * 4);
#pragma unroll
            for (int g = 0; g < QR; ++g) s[g][n] = (f32x4){cm[g] - ck[0], cm[g] - ck[1], cm[g] - ck[2], cm[g] - ck[3]};
#pragma unroll
            for (int kk = 0; kk < NKK; ++kk) {
                const bf16x8 kf = *(const bf16x8*)(Kt + (n * 16 + r16) * KST + kk * 32 + g4 * 8);
#pragma unroll
                for (int g = 0; g < QR; ++g) s[g][n] = MFMA16(kf, qf[g][kk], s[g][n]);
            }
            if (DH > 64) __builtin_amdgcn_sched_barrier(0);
        }
        float mx[QR];
#pragma unroll
        for (int g = 0; g < QR; ++g) mx[g] = -INFINITY;
#pragma unroll
        for (int n = 0; n < 4; ++n)
#pragma unroll
            for (int g = 0; g < QR; ++g)
#pragma unroll
                for (int j = 0; j < 4; ++j) {
                    float t = s[g][n][j];
                    if (!interior) {
                        const int kpos = kt * 64 + n * 16 + g4 * 4 + j;
                        if (MODE == 0) { if (kpos > qpos[g]) t = -INFINITY; }
                        if (MODE == 1) { const int dd = qpos[g] - kpos; if (dd < 0 || dd > 128) t = -INFINITY; }
                        s[g][n][j] = t;
                    }
                    mx[g] = fmaxf(mx[g], t);
                }
        bool grow = false;
#pragma unroll
        for (int g = 0; g < QR; ++g) { mx[g] = xor32_max(xor16_max(mx[g])); grow = grow || (mx[g] > 8.0f); }
        if (__any(grow)) {
#pragma unroll
            for (int g = 0; g < QR; ++g) {
                const float delta = fmaxf(mx[g], 0.f);
                const float alpha = __builtin_amdgcn_exp2f(-delta);
                m_[g] += delta; o1[g] *= alpha;
#pragma unroll
                for (int n = 0; n < ND; ++n) o[g][n] *= alpha;
#pragma unroll
                for (int n = 0; n < 4; ++n) s[g][n] -= delta;
            }
        }
#pragma unroll
        for (int g = 0; g < QR; ++g)
#pragma unroll
            for (int n = 0; n < 4; ++n)
#pragma unroll
                for (int j = 0; j < 4; ++j) s[g][n][j] = __builtin_amdgcn_exp2f(s[g][n][j]);
#pragma unroll
        for (int kk = 0; kk < 2; ++kk) {
            bf16x8 pb[QR];
#pragma unroll
            for (int g = 0; g < QR; ++g) {
                u32x4 w; w.x = cvt_pk(s[g][2 * kk][0], s[g][2 * kk][1]); w.y = cvt_pk(s[g][2 * kk][2], s[g][2 * kk][3]); w.z = cvt_pk(s[g][2 * kk + 1][0], s[g][2 * kk + 1][1]); w.w = cvt_pk(s[g][2 * kk + 1][2], s[g][2 * kk + 1][3]);
                pb[g] = __builtin_bit_cast(bf16x8, w);
                o1[g] = MFMA16(vones, pb[g], o1[g]);
            }
            const bf16_t* vb = Vt + (kk * 32 + 4 * g4 + (r16 >> 2)) * KST + 4 * (r16 & 3);
#pragma unroll
            for (int n = 0; n < ND; ++n) {
                const s16x4 lo = tr_read(vb + n * 16), hi = tr_read(vb + 16 * KST + n * 16);
                bf16x8 vf; vf[0] = lo[0]; vf[1] = lo[1]; vf[2] = lo[2]; vf[3] = lo[3]; vf[4] = hi[0]; vf[5] = hi[1]; vf[6] = hi[2]; vf[7] = hi[3];
#pragma unroll
                for (int g = 0; g < QR; ++g) o[g][n] = MFMA16(vf, pb[g], o[g][n]);
                if (DH > 64 && (n & 3) == 3) __builtin_amdgcn_sched_barrier(0);
            }
        }
    }
#pragma unroll
    for (int g = 0; g < QR; ++g) {
        const size_t tok = (size_t)(qtok0 + qpos[g] * qstep);
        const float lsum = __shfl(o1[g][0], r16);
        if (MODE == 1) {
#pragma unroll
            for (int n = 0; n < ND; ++n) *(f32x4*)(Of + tok * 256 + n * 16 + g4 * 4) = o[g][n];
            if (g4 == 0) { Om[tok * 4] = m_[g]; Ol[tok * 4] = lsum; }
        } else {
            const float inv = 1.0f / lsum;
#pragma unroll
            for (int n = 0; n < ND; ++n) { u32x2 w; w.x = cvt_pk(o[g][n][0] * inv, o[g][n][1] * inv); w.y = cvt_pk(o[g][n][2] * inv, o[g][n][3] * inv);
                *(u32x2*)(Ob + tok * ldo + n * 16 + g4 * 4) = w; }
        }
    }
}

DEVI void ssd_acs(const DP& p, int l, int b, int c, int g, float* acs, float* dts) {
    const int tid = TIDX(), wid = tid >> 6, lane = tid & 63;
    if (wid < 4) {
        const int head = g * 4 + wid;
        const float* dtv = (const float*)(p.ws() + WS_DTV);
        const float A = -__expf(p.in(12)[l * 8 + head]);
        const size_t t0 = (size_t)b * S + c * 128 + 2 * lane;
        const float d0 = dtv[t0 * 8 + head], d1 = dtv[(t0 + 1) * 8 + head];
        const float a0 = d0 * A, a1 = d1 * A;
        float incl = a0 + a1;
#pragma unroll
        for (int d = 1; d < 64; d <<= 1) { const float t = __shfl_up(incl, d); if (lane >= d) incl += t; }
        const float ex = incl - (a0 + a1);
        acs[wid * 128 + 2 * lane] = ex + a0; acs[wid * 128 + 2 * lane + 1] = ex + a0 + a1;
        dts[wid * 128 + 2 * lane] = d0; dts[wid * 128 + 2 * lane + 1] = d1;
    }
}
DEVI void conv8_chan(const DP& p, int l, const bf16_t* proj, int b, int c, int chan, int l0, float (&out)[8]) {
    const float* cw = p.in(9) + (size_t)l * 4 * 1024 + chan;
    const float w0 = cw[0], w1 = cw[1024], w2 = cw[2048], w3 = cw[3072], cb = p.in(10)[l * 1024 + chan];
    float v[11];
    const int sbase = c * 128 + l0 - 3;
#pragma unroll
    for (int i = 0; i < 11; ++i) { const int sp = sbase + i; v[i] = sp >= 0 ? bf2f(proj[((size_t)b * S + sp) * NPROJ + C_XBC + chan]) : 0.f; }
#pragma unroll
    for (int i = 0; i < 8; ++i) out[i] = silu_f(cb + w0 * v[i] + w1 * v[i + 1] + w2 * v[i + 2] + w3 * v[i + 3]);
}
constexpr int SST = 136;
constexpr int XST4 = 264;
DEVI void ssd_states_task(const DP& p, int l, int b, int c, int g, char* lds) {
    const int tid = TIDX(), wid = tid >> 6, lane = tid & 63, r16 = lane & 15, g4 = lane >> 4;
    const bf16_t* xc = (const bf16_t*)(p.ws() + WS_XC);
    bf16_t* Bn = (bf16_t*)lds;
    bf16_t* Xn = Bn + 128 * SST;
    float* acs = (float*)(Xn + 128 * XST4);
    float* dts = acs + 512;
    __syncthreads();
    ssd_acs(p, l, b, c, g, acs, dts);
    __syncthreads();
    if (tid < 4) ((float*)(p.ws() + WS_DECAY))[((size_t)b * 16 + c) * 8 + g * 4 + tid] = __expf(acs[tid * 128 + 127]);
    const size_t tok0 = (size_t)b * S + c * 128;
    for (int it = tid; it < 2048; it += NTHR) {
        const int ll = it >> 4, nc = (it & 15) * 8;
        *(u32x4*)(Bn + ll * SST + nc) = *(const u32x4*)(xc + (tok0 + ll) * 1024 + 512 + g * 128 + nc);
    }
    for (int it = tid; it < 4096; it += NTHR) {
        const int ll = it >> 5, ch = (it & 31) * 8, hl = ch >> 6;
        const u32x4 w = *(const u32x4*)(xc + (tok0 + ll) * 1024 + g * 256 + ch);
        const float sc = dts[hl * 128 + ll] * __expf(acs[hl * 128 + 127] - acs[hl * 128 + ll]);
        u32x4 o; o.x = cvt_pk(bflo(w.x) * sc, bfhi(w.x) * sc); o.y = cvt_pk(bflo(w.y) * sc, bfhi(w.y) * sc); o.z = cvt_pk(bflo(w.z) * sc, bfhi(w.z) * sc); o.w = cvt_pk(bflo(w.w) * sc, bfhi(w.w) * sc);
        *(u32x4*)(Xn + ll * XST4 + ch) = o;
    }
    __syncthreads();
    const int hl = wid >> 1, nh = wid & 1;
    f32x4 acc[4][4];
#pragma unroll
    for (int m = 0; m < 4; ++m)
#pragma unroll
        for (int n = 0; n < 4; ++n) acc[m][n] = (f32x4){0.f, 0.f, 0.f, 0.f};
#pragma unroll
    for (int kk = 0; kk < 4; ++kk) {
        bf16x8 af[4], bfr[4];
        const int lrow = kk * 32 + 8 * g4 + (r16 >> 2), cq = 4 * (r16 & 3);
#pragma unroll
        for (int m = 0; m < 4; ++m) { const bf16_t* a = Xn + lrow * XST4 + hl * 64 + m * 16 + cq; const s16x4 lo = tr_read(a), hi = tr_read(a + 4 * XST4);
            af[m][0] = lo[0]; af[m][1] = lo[1]; af[m][2] = lo[2]; af[m][3] = lo[3]; af[m][4] = hi[0]; af[m][5] = hi[1]; af[m][6] = hi[2]; af[m][7] = hi[3]; }
#pragma unroll
        for (int n = 0; n < 4; ++n) { const bf16_t* a = Bn + lrow * SST + nh * 64 + n * 16 + cq; const s16x4 lo = tr_read(a), hi = tr_read(a + 4 * SST);
            bfr[n][0] = lo[0]; bfr[n][1] = lo[1]; bfr[n][2] = lo[2]; bfr[n][3] = lo[3]; bfr[n][4] = hi[0]; bfr[n][5] = hi[1]; bfr[n][6] = hi[2]; bfr[n][7] = hi[3]; }
#pragma unroll
        for (int m = 0; m < 4; ++m)
#pragma unroll
            for (int n = 0; n < 4; ++n) acc[m][n] = MFMA16(bfr[n], af[m], acc[m][n]);
    }
    float* st = (float*)(p.ws() + WS_SSTATE) + (((size_t)b * 16 + c) * 8 + g * 4 + hl) * 8192;
#pragma unroll
    for (int m = 0; m < 4; ++m)
#pragma unroll
        for (int n = 0; n < 4; ++n) *(f32x4*)(st + (m * 16 + r16) * 128 + nh * 64 + n * 16 + g4 * 4) = acc[m][n];
}
DEVI void phase_ssd_scan(const DP& p) {
    const float* st = (const float*)(p.ws() + WS_SSTATE);
    bf16_t* hin = (bf16_t*)(p.ws() + WS_HIN);
    const float* decay = (const float*)(p.ws() + WS_DECAY);
    const int total = NB * 8 * 2048;
    for (int i = BIDX() * NTHR + TIDX(); i < total; i += gridDim.x * NTHR) {
        const int e4 = i & 2047, head = (i >> 11) & 7, b = i >> 14;
        f32x4 h = (f32x4){0.f, 0.f, 0.f, 0.f};
        for (int c = 0; c < 16; ++c) {
            const size_t off = (((size_t)b * 16 + c) * 8 + head) * 8192 + e4 * 4;
            u32x2 w; w.x = cvt_pk(h[0], h[1]); w.y = cvt_pk(h[2], h[3]);
            *(u32x2*)(hin + off) = w;
            const f32x4 s = *(const f32x4*)(st + off);
            const float d = decay[((size_t)b * 16 + c) * 8 + head];
            h = h * d + s;
        }
    }
}
constexpr int XST1 = 72;
DEVI void ssd_out_task(const DP& p, int l, int b, int c, int g, char* lds) {
    const int tid = TIDX(), wid = tid >> 6, lane = tid & 63, r16 = lane & 15, g4 = lane >> 4;
    const bf16_t* proj = (const bf16_t*)(p.ws() + WS_PROJ);
    const bf16_t* xc = (const bf16_t*)(p.ws() + WS_XC);
    bf16_t* Cs = (bf16_t*)lds;
    bf16_t* Bs = Cs + 128 * SST;
    bf16_t* Xn = Bs + 128 * SST;
    bf16_t* Hs = Xn + 128 * XST1;
    bf16_t* Mw = Hs + 64 * SST + wid * 16 * SST;
    float* acs = (float*)(Hs + 64 * SST + 8 * 16 * SST);
    float* dts = acs + 512;
    const int lrow = wid * 16 + r16;
    const size_t tok0 = (size_t)b * S + c * 128, tok = tok0 + lrow;
    bf16_t* mix = (bf16_t*)(p.ws() + WS_MIX);
    float ssq = 0.f;
    __syncthreads();
    ssd_acs(p, l, b, c, g, acs, dts);
    for (int it = tid; it < 2048; it += NTHR) {
        const int ll = it >> 4, nc = (it & 15) * 8;
        *(u32x4*)(Cs + ll * SST + nc) = *(const u32x4*)(xc + (tok0 + ll) * 1024 + 768 + g * 128 + nc);
        *(u32x4*)(Bs + ll * SST + nc) = *(const u32x4*)(xc + (tok0 + ll) * 1024 + 512 + g * 128 + nc);
    }
    __syncthreads();
    bf16x8 cfr[4];
#pragma unroll
    for (int kk = 0; kk < 4; ++kk) cfr[kk] = *(const bf16x8*)(Cs + lrow * SST + kk * 32 + g4 * 8);
    f32x4 cb[8];
#pragma unroll
    for (int st = 0; st < 8; ++st) {
        cb[st] = (f32x4){0.f, 0.f, 0.f, 0.f};
#pragma unroll
        for (int kk = 0; kk < 4; ++kk) {
            const bf16x8 bfr = *(const bf16x8*)(Bs + (st * 16 + r16) * SST + kk * 32 + g4 * 8);
            cb[st] = MFMA16(bfr, cfr[kk], cb[st]);
        }
    }
    u32x4 px[2], ph[2];
    auto hload = [&](int hl_) {
        const int head_ = g * 4 + hl_;
#pragma unroll
        for (int i = 0; i < 2; ++i) { const int it = tid + i * NTHR, ss = it >> 3, pc8 = (it & 7) * 8;
            px[i] = *(const u32x4*)(xc + (tok0 + ss) * 1024 + head_ * 64 + pc8);
            ph[i] = *(const u32x4*)((const bf16_t*)(p.ws() + WS_HIN) + (((size_t)b * 16 + c) * 8 + head_) * 8192 + (size_t)it * 8); }
    };
    hload(0);
    for (int hl = 0; hl < 4; ++hl) {
        const int head = g * 4 + hl;
        __syncthreads();
#pragma unroll
        for (int i = 0; i < 2; ++i) { const int it = tid + i * NTHR, ss = it >> 3, pc8 = (it & 7) * 8;
            *(u32x4*)(Xn + ss * XST1 + pc8) = px[i];
            *(u32x4*)(Hs + (it >> 4) * SST + (it & 15) * 8) = ph[i]; }
        __syncthreads();
        if (hl + 1 < 4) hload(hl + 1);
        u32x2 zpre[4];
#pragma unroll
        for (int pt = 0; pt < 4; ++pt) zpre[pt] = *(const u32x2*)(proj + tok * NPROJ + C_Z + head * 64 + pt * 16 + g4 * 4);
        const float al = acs[hl * 128 + lrow];
#pragma unroll
        for (int st = 0; st < 8; ++st) {
            float mv[4];
            const float4 a4 = *(const float4*)(acs + hl * 128 + st * 16 + g4 * 4), d4 = *(const float4*)(dts + hl * 128 + st * 16 + g4 * 4);
            const float av[4] = {a4.x, a4.y, a4.z, a4.w}, dv[4] = {d4.x, d4.y, d4.z, d4.w};
#pragma unroll
            for (int j = 0; j < 4; ++j) { const int sidx = st * 16 + g4 * 4 + j;
                mv[j] = (sidx <= lrow) ? cb[st][j] * __expf(al - av[j]) * dv[j] : 0.f; }
            u32x2 w; w.x = cvt_pk(mv[0], mv[1]); w.y = cvt_pk(mv[2], mv[3]);
            *(u32x2*)(Mw + r16 * SST + st * 16 + g4 * 4) = w;
        }
        __builtin_amdgcn_wave_barrier();
        asm volatile("s_waitcnt lgkmcnt(0)" ::: "memory");
        f32x4 yd[4], yo[4];
#pragma unroll
        for (int pt = 0; pt < 4; ++pt) { yd[pt] = (f32x4){0.f, 0.f, 0.f, 0.f}; yo[pt] = (f32x4){0.f, 0.f, 0.f, 0.f}; }
#pragma unroll
        for (int kk = 0; kk < 4; ++kk) {
            const bf16x8 mf = *(const bf16x8*)(Mw + r16 * SST + kk * 32 + g4 * 8);
            const bf16_t* xa = Xn + (kk * 32 + 8 * g4 + (r16 >> 2)) * XST1 + 4 * (r16 & 3);
#pragma unroll
            for (int pt = 0; pt < 4; ++pt) {
                const s16x4 lo = tr_read(xa + pt * 16), hi = tr_read(xa + 4 * XST1 + pt * 16);
                bf16x8 xf; xf[0] = lo[0]; xf[1] = lo[1]; xf[2] = lo[2]; xf[3] = lo[3]; xf[4] = hi[0]; xf[5] = hi[1]; xf[6] = hi[2]; xf[7] = hi[3];
                yd[pt] = MFMA16(xf, mf, yd[pt]);
                const bf16x8 hf = *(const bf16x8*)(Hs + (pt * 16 + r16) * SST + kk * 32 + g4 * 8);
                yo[pt] = MFMA16(hf, cfr[kk], yo[pt]);
            }
        }
        __builtin_amdgcn_wave_barrier();
        const float el = __expf(al), Dh = p.in(13)[l * 8 + head];
#pragma unroll
        for (int pt = 0; pt < 4; ++pt) {
            const int pc = pt * 16 + g4 * 4;
            const u32x2 zw = zpre[pt];
            const u32x2 xw = *(const u32x2*)(Xn + lrow * XST1 + pc);
            const float zz[4] = {bflo(zw.x), bfhi(zw.x), bflo(zw.y), bfhi(zw.y)};
            const float xx[4] = {bflo(xw.x), bfhi(xw.x), bflo(xw.y), bfhi(xw.y)};
            float gv[4];
#pragma unroll
            for (int j = 0; j < 4; ++j) { const float yv = yd[pt][j] + el * yo[pt][j] + Dh * xx[j]; gv[j] = yv * silu_f(zz[j]); ssq += gv[j] * gv[j]; }
            u32x2 w; w.x = cvt_pk(gv[0], gv[1]); w.y = cvt_pk(gv[2], gv[3]);
            *(u32x2*)(mix + tok * DM + 512 + head * 64 + pc) = w;
        }
    }
    ssq += __shfl_xor(ssq, 16); ssq += __shfl_xor(ssq, 32);
    if (g4 == 0) ((float*)(p.ws() + WS_SSQ))[tok * 2 + g] = ssq;
}
constexpr int N_FOX = 512, N_S1 = 256, N_DIL = 1536;
DEVI void phase_mix1(const DP& p, int l, char* lds) {
    unsigned char* ws = p.ws();
    kv_gemm(p, lds);
    const bf16_t* proj = (const bf16_t*)(ws + WS_PROJ);
    bf16_t* mix = (bf16_t*)(ws + WS_MIX);
    const int G = gridDim.x, bid = BIDX();
    for (int u = bid; u < N_S1; u += G) { const int g = u & 1, c = (u >> 1) & 15, b = u >> 5; ssd_states_task(p, l, b, c, g, lds); }
    const int nfw = G / 2;
    if (bid < nfw) {
        for (int t = bid; t < 128; t += nfw) {
            const int bh = t & 31, k = t >> 5, b = bh >> 2, h = bh & 3;
            const float* cum = (const float*)(ws + WS_CUMF) + (size_t)bh * S;
#pragma unroll 1
            for (int half = 0; half < 2; ++half) {
                const int qb = half == 0 ? 7 - k : k;
                attn_task<64, 0, 2>(proj + C_FQ + h * 64, NPROJ, b * S, 1, proj + C_FK + h * 64, proj + C_FV + h * 64, NPROJ, b * S, 1,
                                    qb * 256, 0, 4 * qb + 4, 0.125f, cum, nullptr, mix + h * 64, DM, nullptr, nullptr, nullptr, lds);
            }
        }
    } else {
        const int ndw = G - nfw;
        for (int u = bid - nfw; u < 1024; u += ndw) {
            const int bh = u & 31, v = u >> 5, b = bh >> 2, h = bh & 3;
            if (v < 16) {
                const int br = v >> 3, dil = br ? 4 : 1, r = br ? ((v - 8) & 3) : 0, pb = br ? ((v - 8) >> 2) : v;
                float* Of = (float*)(ws + WS_DILO) + (size_t)br * T * 256 + h * 64;
                float* Om = (float*)(ws + WS_DILM) + (size_t)br * T * 4 + h;
                float* Ol = (float*)(ws + WS_DILL) + (size_t)br * T * 4 + h;
                const int klo = pb > 0 ? 4 * pb - 2 : 0;
                attn_task<64, 1, 2>(proj + C_DQ + h * 64, NPROJ, b * S + r, dil, proj + C_DK + h * 64, proj + C_DV + h * 64, NPROJ, b * S + r, dil,
                                    pb * 256, klo, 4 * pb + 4, 0.125f, nullptr, nullptr, nullptr, 0, Of, Om, Ol, lds);
            } else {
                const int r = v - 16;
                float* Of = (float*)(ws + WS_DILO) + (size_t)2 * T * 256 + h * 64;
                float* Om = (float*)(ws + WS_DILM) + (size_t)2 * T * 4 + h;
                float* Ol = (float*)(ws + WS_DILL) + (size_t)2 * T * 4 + h;
                attn_task<64, 1, 1>(proj + C_DQ + h * 64, NPROJ, b * S + r, 16, proj + C_DK + h * 64, proj + C_DV + h * 64, NPROJ, b * S + r, 16,
                                    0, 0, 2, 0.125f, nullptr, nullptr, nullptr, 0, Of, Om, Ol, lds);
            }
        }
    }
}
DEVI void phase_mix3(const DP& p, int l, char* lds) {
    unsigned char* ws = p.ws();
    for (int t = BIDX(); t < NB * 16 * 2; t += gridDim.x) ssd_out_task(p, l, t >> 5, (t >> 1) & 15, t & 1, lds);
    const int tid = TIDX(), wid = tid >> 6, lane = tid & 63, head = lane >> 4, d4 = (lane & 15) * 4;
    const float* Of = (const float*)(ws + WS_DILO);
    const float* Om = (const float*)(ws + WS_DILM);
    const float* Ol = (const float*)(ws + WS_DILL);
    bf16_t* mix = (bf16_t*)(ws + WS_MIX);
    for (int row = BIDX() * 8 + wid; row < T; row += gridDim.x * 8) {
        float m[3], lsum[3];
#pragma unroll
        for (int br = 0; br < 3; ++br) { m[br] = Om[((size_t)br * T + row) * 4 + head]; lsum[br] = Ol[((size_t)br * T + row) * 4 + head]; }
        const float M = fmaxf(m[0], fmaxf(m[1], m[2]));
        f32x4 num = (f32x4){0.f, 0.f, 0.f, 0.f}; float den = 0.f;
#pragma unroll
        for (int br = 0; br < 3; ++br) {
            const float w = __builtin_amdgcn_exp2f(m[br] - M);
            const f32x4 o = *(const f32x4*)(Of + ((size_t)br * T + row) * 256 + head * 64 + d4);
            num += o * w; den += w * lsum[br];
        }
        const float inv = 1.0f / den;
        u32x2 w; w.x = cvt_pk(num[0] * inv, num[1] * inv); w.y = cvt_pk(num[2] * inv, num[3] * inv);
        *(u32x2*)(mix + (size_t)row * DM + 256 + head * 64 + d4) = w;
    }
}
DEVI void phase_xattn(const DP& p, int l, char* lds) {
    unsigned char* ws = p.ws();
    const bf16_t* qbuf = (const bf16_t*)(ws + WS_QBUF);
    const bf16_t* kv = (const bf16_t*)(ws + WS_KV);
    bf16_t* obuf = (bf16_t*)(ws + WS_OBUF);
    for (int t = BIDX(); t < NB * 4 * 16; t += gridDim.x) {
        const int qb = t & 15, h = (t >> 4) & 3, b = t >> 6;
        attn_task<256, 2, 1>(qbuf + h * 256, DM, b * S, 1, kv + h * 256, kv + DM + h * 256, 2 * DM, b * MEMLEN, 1,
                          qb * 128, 0, 4, 0.0625f, nullptr, p.in(20) + l * 256, obuf + h * 256, DM, nullptr, nullptr, nullptr, lds);
    }
}
namespace g8 {
template <bool GATHER_> struct MoeSched {
    static constexpr bool GATHER = GATHER_;
    const int* cnt; const int* list; const char* Abase; const char* Bbase; size_t bstride; int K, G;
    int e, ubase, tbase, u;
    DEVI void init(const int* cnt_, const int* list_, const void* A_, const void* B_, size_t bstride_, int K_, int G_, int c_) {
        cnt = cnt_; list = list_; Abase = (const char*)A_; Bbase = (const char*)B_; bstride = bstride_; K = K_; G = G_; e = 0; ubase = 0; tbase = 0; u = c_; }
    DEVI bool next(UnitU& o) {
        while (e < NEXP) {
            const int ce = cnt[e], nte = (ce + BM - 1) / BM, nun = nte * 4;
            if (u < ubase + nun) {
                const int lu = u - ubase, pm = lu >> 2, pn = lu & 3;
                o.i0 = tbase + pm; o.i1 = pn; o.i2 = e * (2 * T) + pm * BM; o.i3 = ce - pm * BM; o.flags = 3;
                o.A = GATHER ? Abase : Abase + (size_t)(tbase + pm) * BM * K * 2;
                o.B = Bbase + (size_t)e * bstride + (size_t)pn * BM * K * 2;
                u += G; return true;
            }
            ubase += nun; tbase += nte; ++e;
        }
        return false;
    }
    DEVI void lane_va(const UnitU& o, int R0, int C0, int R1, int C1, unsigned& v00, unsigned& v01, unsigned& v10, unsigned& v11) const {
        if (GATHER) {
            const int nv = o.i3; const int* ent = list + o.i2;
            const int t00 = (ent[R0 < nv ? R0 : 0] & 0xffff) >> 1, t01 = (ent[R1 < nv ? R1 : 0] & 0xffff) >> 1, t10 = (ent[R0 + HALF < nv ? R0 + HALF : 0] & 0xffff) >> 1, t11 = (ent[R1 + HALF < nv ? R1 + HALF : 0] & 0xffff) >> 1;
            v00 = (unsigned)(t00 * K + C0) * 2u; v01 = (unsigned)(t01 * K + C1) * 2u; v10 = (unsigned)(t10 * K + C0) * 2u; v11 = (unsigned)(t11 * K + C1) * 2u;
        } else {
            v00 = (unsigned)(R0 * K + C0) * 2u; v01 = (unsigned)(R1 * K + C1) * 2u; v10 = v00 + (unsigned)(HALF * K * 2); v11 = v01 + (unsigned)(HALF * K * 2);
        }
    }
};
struct EpiSwiglu { static constexpr bool PERM = false; bf16_t* act;
    DEVI void mid(f32x4 (&)[2][2][4][2], const UnitU&, int, int, int, int) const {}
    DEVI void operator()(const f32x4 (&acc)[2][2][4][2], const UnitU& u, int wr, int wc, int fr, int fq) const {
        const int nv = u.i3;
#pragma unroll
        for (int ai = 0; ai < 2; ++ai)
#pragma unroll
            for (int m = 0; m < 4; ++m) {
                const int r = ai * HALF + wr * 64 + m * 16 + fr;
                if (r < nv) {
                    bf16_t* rowp = act + (size_t)(u.i0 * BM + r) * EFF + u.i1 * 128 + wc * 16 + 4 * fq;
#pragma unroll
                    for (int bj = 0; bj < 2; ++bj) { const f32x4 x1 = acc[ai][bj][m][0], x3 = acc[ai][bj][m][1];
                        u32x2 w; w.x = cvt_pk(silu_f(x1[0]) * x3[0], silu_f(x1[1]) * x3[1]); w.y = cvt_pk(silu_f(x1[2]) * x3[2], silu_f(x1[3]) * x3[3]);
                        *(u32x2*)(rowp + bj * 64) = w; }
                }
            }
    } };
struct EpiMoeOut { static constexpr bool PERM = true; bf16_t* y; const int* list;
    DEVI void mid(f32x4 (&)[2][2][4][2], const UnitU&, int, int, int, int) const {}
    DEVI void operator()(const f32x4 (&acc)[2][2][4][2], const UnitU& u, int wr, int wc, int fr, int fq) const {
        const int nv = u.i3; const int* ent = list + u.i2;
        unsigned env[2][4];
#pragma unroll
        for (int ai = 0; ai < 2; ++ai)
#pragma unroll
            for (int m = 0; m < 4; ++m) { const int r = ai * HALF + wr * 64 + m * 16 + fr; env[ai][m] = (unsigned)ent[r < nv ? r : 0]; }
#pragma unroll
        for (int ai = 0; ai < 2; ++ai)
#pragma unroll
            for (int m = 0; m < 4; ++m) {
                const int r = ai * HALF + wr * 64 + m * 16 + fr;
                if (r < nv) {
                    const unsigned en = env[ai][m]; const int a = (int)(en & 0xffffu); const float gt = __uint_as_float(en & 0xffff0000u);
                    bf16_t* rowp = y + (size_t)a * DM + u.i1 * BM + wc * 32 + 8 * fq;
#pragma unroll
                    for (int bj = 0; bj < 2; ++bj) { const f32x4 v0 = acc[ai][bj][m][0] * gt, v1 = acc[ai][bj][m][1] * gt;
                        u32x4 w; w.x = cvt_pk(v0[0], v0[1]); w.y = cvt_pk(v0[2], v0[3]); w.z = cvt_pk(v1[0], v1[1]); w.w = cvt_pk(v1[2], v1[3]);
                        *(u32x4*)(rowp + bj * HALF) = w; }
                }
            }
    } };
}
template <int WHICH>
DEVI void phase_moe(const DP& p, int l, char* lds) {
    unsigned char* ws = p.ws();
    const int* cnt = (const int*)(ws + WS_CNT) + l * 64;
    const int* list = (const int*)(ws + WS_LIST);
    if (WHICH == 0) {
        g8::MoeSched<true> S;
        S.init(cnt, list, ws + WS_H3, ws + WS_W_13, (size_t)1024 * DM * 2, DM, gridDim.x, BIDX());
        g8::EpiSwiglu E{(bf16_t*)(ws + WS_ACT)};
        g8::gemm8(lds, DM, DM, S, E);
    } else {
        g8::MoeSched<false> S;
        S.init(cnt, list, ws + WS_ACT, ws + WS_W_2, (size_t)DM * EFF * 2, EFF, gridDim.x, BIDX());
        g8::EpiMoeOut E{(bf16_t*)(ws + WS_YBUF), list};
        g8::gemm8(lds, EFF, EFF, S, E);
    }
}
DEVI void phase_final(const DP& p) {
    const int tid = TIDX(), wid = tid >> 6, lane = tid & 63;
    const bf16_t* ybuf = (const bf16_t*)(p.ws() + WS_YBUF);
    const bf16_t* h0 = (const bf16_t*)(p.ws() + WS_HBUF);
    float* out = p.out();
    for (int row = BIDX() * 8 + wid; row < T; row += gridDim.x * 8) {
        float x[16];
        load_row_bf16(h0 + (size_t)row * DM, x, lane);
        add_row_bf16_b(ybuf + (size_t)(2 * row) * DM, x, lane);
        add_row_bf16_b(ybuf + (size_t)(2 * row + 1) * DM, x, lane);
#pragma unroll
        for (int j = 0; j < 2; ++j) {
            *(float4*)(out + (size_t)row * DM + j * 512 + lane * 8) = make_float4(x[8 * j], x[8 * j + 1], x[8 * j + 2], x[8 * j + 3]);
            *(float4*)(out + (size_t)row * DM + j * 512 + lane * 8 + 4) = make_float4(x[8 * j + 4], x[8 * j + 5], x[8 * j + 6], x[8 * j + 7]);
        }
    }
}

#define XB_TMO      128
#define XB_XCNT(j)  (256  + 64 * (j))
#define XB_XSUB(j)  (1280 + 64 * (j))
#define XB_XGEN(j)  (2304 + 64 * (j))
#define XB_TOP      3328
#define XB_TOPGEN   3392
#define XCD_BAR_WORDS 3456
#define XB_SPIN_CAP (1u << 22)
DEVI unsigned xb_ld(unsigned* p)              { return __hip_atomic_load(p, __ATOMIC_RELAXED, __HIP_MEMORY_SCOPE_AGENT); }
DEVI unsigned xb_add(unsigned* p, unsigned v) { return __hip_atomic_fetch_add(p, v, __ATOMIC_RELAXED, __HIP_MEMORY_SCOPE_AGENT); }
DEVI unsigned xb_xcc_id() { return (unsigned)__builtin_amdgcn_s_getreg((3 << 11) | 20) & 0xFu; }
#define XB_SPIN(cond, bar) do { unsigned _sp = 0; while (cond) { __builtin_amdgcn_s_sleep(1); \
    if ((++_sp & 255u) == 0u) { if (xb_ld(&(bar)[XB_TMO])) break; if (_sp > XB_SPIN_CAP) { atomicAdd(&(bar)[XB_TMO], 1u); break; } } } } while (0)
struct XcdBarrier { unsigned* bar; unsigned x; volatile LAS unsigned* st; };
DEVI XcdBarrier xcd_barrier_post(unsigned* bar, volatile LAS unsigned* st) {
    XcdBarrier b; b.bar = bar; b.x = xb_xcc_id(); b.st = st;
    if (threadIdx.x == 0) (void)xb_add(&bar[XB_XCNT(b.x)], 1u);
    return b;
}
DEVI void xcd_barrier_complete(unsigned* bar, unsigned x, unsigned& nloc, unsigned& nx) {
    const unsigned G = gridDim.x * gridDim.y * gridDim.z;
    unsigned sum, cnt, mine, sp = 0u;
    for (;;) {
        sum = 0u; cnt = 0u; mine = 0u;
#pragma unroll
        for (unsigned j = 0; j < 16; ++j) { const unsigned c = xb_ld(&bar[XB_XCNT(j)]); sum += c; cnt += (c > 0u) ? 1u : 0u; mine = (j == x) ? c : mine; }
        if (sum == G) break;
        __builtin_amdgcn_s_sleep(1);
        if ((++sp & 255u) == 0u) { if (xb_ld(&bar[XB_TMO])) break; if (sp > XB_SPIN_CAP) { atomicAdd(&bar[XB_TMO], 1u); break; } }
    }
    nloc = mine > 0u ? mine : 1u; nx = cnt > 0u ? cnt : 1u;
}
DEVI void xcd_barrier(const XcdBarrier& b) {
    asm volatile("s_waitcnt vmcnt(0)" ::: "memory");
    __syncthreads();
    if (threadIdx.x == 0) {
        unsigned* bar = b.bar;
        __builtin_amdgcn_s_waitcnt(0);
        unsigned nloc = b.st[0], nx = b.st[1];
        if (nloc == 0u) { xcd_barrier_complete(bar, b.x, nloc, nx); b.st[0] = nloc; b.st[1] = nx; }
        const unsigned old = xb_add(&bar[XB_XSUB(b.x)], 1u);
        const unsigned gen = old / nloc;
        if (old + 1u == (gen + 1u) * nloc) {
            __builtin_amdgcn_fence(__ATOMIC_RELEASE, "agent");
            asm volatile("s_waitcnt vmcnt(0)" ::: "memory");
            const unsigned og = xb_add(&bar[XB_TOP], 1u);
            const unsigned tg = og / nx;
            if (og + 1u == (tg + 1u) * nx) xb_add(&bar[XB_TOPGEN], 1u);
            else XB_SPIN(xb_ld(&bar[XB_TOPGEN]) == tg, bar);
            __builtin_amdgcn_fence(__ATOMIC_ACQUIRE, "agent");
            xb_add(&bar[XB_XGEN(b.x)], 1u);
            asm volatile("s_waitcnt vmcnt(0)" ::: "memory");
        } else {
            XB_SPIN(xb_ld(&bar[XB_XGEN(b.x)]) == gen, bar);
            __builtin_amdgcn_fence(__ATOMIC_ACQUIRE, "agent");
            asm volatile("s_waitcnt vmcnt(0)" ::: "memory");
        }
    }
    __syncthreads();
}

constexpr int N_PHASES = 28;
__global__ void __launch_bounds__(NTHR) hybrid_fwd(Params p_unused) {
    extern __shared__ __attribute__((aligned(16))) char lds_base[];
    karg_ptr kp = (karg_ptr)__builtin_amdgcn_kernarg_segment_ptr();
    int ph_lo, ph_hi, use_gs;
    { DP q{kp}; ph_lo = q.ph_lo(); ph_hi = q.ph_hi(); use_gs = q.use_gs(); }
    volatile LAS unsigned* xst = (volatile LAS unsigned*)(LAS char*)(lds_base + LDS_BYTES - 16);
    if (threadIdx.x == 0) { xst[0] = 0u; xst[1] = 0u; }
    __syncthreads();
    XcdBarrier xb; xb.bar = nullptr; xb.x = 0; xb.st = xst;
    if (use_gs == 1) { DP q{kp}; xb = xcd_barrier_post((unsigned*)(q.ws() + WS_BAR), xst); }
#define RUN_PHASE(PH, ...) \
    if (ph_lo <= (PH) && (PH) < ph_hi) { \
        if ((PH) > ph_lo) { if (use_gs == 1) xcd_barrier(xb); else if (use_gs == 2) cg::this_grid().sync(); } \
        asm volatile("" : "+s"(kp) :: "memory"); \
        const DP p{kp}; \
        unsigned lds_off = 0; asm volatile("" : "+s"(lds_off)); \
        char* lds = lds_base + lds_off; \
        unsigned char* ws = p.ws(); (void)ws; (void)lds; \
        __VA_ARGS__ \
    }
#define LAYER_PHASES(L, B0) \
    RUN_PHASE((B0) + 0, { if ((L) == 1) { for (int u = BIDX(); u < PREP_UNITS; u += gridDim.x) prep_unit(p, 1, u, (float*)lds); } __syncthreads(); phase_norm1(p, (L), lds); }) \
    RUN_PHASE((B0) + 1, { phase_inproj(p, (L), lds); }) \
    RUN_PHASE((B0) + 2, { for (int t = (int)gridDim.x - 1 - BIDX(); t < 32; t += gridDim.x) cumsum_task(p, t, lds); phase_post(p, (L)); }) \
    RUN_PHASE((B0) + 3, { phase_mix1(p, (L), lds); }) \
    RUN_PHASE((B0) + 4, { phase_ssd_scan(p); phase_knorm(p, (L)); }) \
    RUN_PHASE((B0) + 5, { phase_mix3(p, (L), lds); }) \
    RUN_PHASE((B0) + 6, { g8::DenseSched2 S; S.init((const bf16_t*)(ws + WS_MIX), (const bf16_t*)(ws + WS_W_OUT), T, DM, DM, gridDim.x, BIDX()); \
                          g8::EpiResScale E{{(const bf16_t*)(ws + WS_HBUF), (bf16_t*)(ws + WS_H1), DM}, (const float*)(ws + WS_SSQ)}; g8::gemm8(lds, DM, DM / 2, S, E); }) \
    RUN_PHASE((B0) + 7, { g8::DenseSched S; S.init((const bf16_t*)(ws + WS_H1), (const bf16_t*)(ws + WS_W_Q), T, DM, DM, gridDim.x, BIDX()); \
                          g8::EpiBf16 E{(bf16_t*)(ws + WS_QBUF), DM}; g8::gemm8(lds, DM, DM, S, E); }) \
    RUN_PHASE((B0) + 8, { phase_xattn(p, (L), lds); }) \
    RUN_PHASE((B0) + 9, { g8::DenseSched S; S.init((const bf16_t*)(ws + WS_OBUF), (const bf16_t*)(ws + WS_W_O), T, DM, DM, gridDim.x, BIDX()); \
                          g8::EpiResBf E{(const bf16_t*)(ws + WS_H1), (bf16_t*)(ws + WS_HBUF), DM}; g8::gemm8(lds, DM, DM, S, E); }) \
    RUN_PHASE((B0) + 10, { phase_norm3(p, (L), lds); }) \
    RUN_PHASE((B0) + 11, { phase_moe<0>(p, (L), lds); }) \
    RUN_PHASE((B0) + 12, { phase_moe<1>(p, (L), lds); })

    RUN_PHASE(0, { prep_small(p); for (int u = BIDX(); u < PREP_UNITS; u += gridDim.x) prep_unit(p, 0, u, (float*)lds); })
    LAYER_PHASES(0, 1)
    LAYER_PHASES(1, 14)
    RUN_PHASE(27, { phase_final(p); })
#undef LAYER_PHASES
#undef RUN_PHASE
}

extern "C" void kernel_launch(void* const* d_in, const int* in_sizes, int n_in, void* d_out, int out_size, void* d_ws, size_t ws_size, hipStream_t stream) {
    static int grid = 0;
    if (grid == 0) {
        if (n_in != 31 || out_size != T * DM || ws_size < WS_END) { fprintf(stderr, "kernel_launch: unexpected shapes (n_in %d out %d ws %zu need %zu)\n", n_in, out_size, ws_size, (size_t)WS_END); grid = -1; return; }
        int dev = 0, cus = 0, per_cu = 0;
        hipGetDevice(&dev);
        hipDeviceGetAttribute(&cus, hipDeviceAttributeMultiprocessorCount, dev);
        hipFuncSetAttribute((const void*)hybrid_fwd, hipFuncAttributeMaxDynamicSharedMemorySize, LDS_BYTES);
        hipOccupancyMaxActiveBlocksPerMultiprocessor(&per_cu, (const void*)hybrid_fwd, NTHR, LDS_BYTES);
        if (per_cu < 1) { fprintf(stderr, "kernel_launch: occupancy query says %d blocks per CU\n", per_cu); per_cu = 1; }
        (void)hipGetLastError();
        grid = cus;
    }
    if (grid < 0) return;
    Params p{};
    for (int i = 0; i < 31; ++i) p.in[i] = (const float*)d_in[i];
    p.out = (float*)d_out; p.ws = (unsigned char*)d_ws;
    p.use_grid_sync = 1; p.pad = 0;
    p.ph_lo = 0; p.ph_hi = N_PHASES;
    if (hipMemsetAsync((unsigned char*)d_ws + WS_BAR, 0, XCD_BAR_WORDS * 4, stream) != hipSuccess) { fprintf(stderr, "kernel_launch: memset failed\n"); return; }
    void* args[] = {&p};
    hipError_t e = hipLaunchCooperativeKernel((const void*)hybrid_fwd, dim3(grid), dim3(NTHR), args, LDS_BYTES, stream);
    if (e != hipSuccess) fprintf(stderr, "kernel_launch: cooperative launch failed: %s (grid %d)\n", hipGetErrorString(e), grid);
}
```

```cpp
#include <hip/hip_runtime.h>
#include <hip/hip_cooperative_groups.h>
#include <cstdio>
#include <cstdint>
namespace cg = cooperative_groups;

typedef unsigned short bf16_t;
typedef short bf16x8 __attribute__((ext_vector_type(8)));
typedef short s16x4 __attribute__((ext_vector_type(4)));
typedef float f32x4 __attribute__((ext_vector_type(4)));
typedef unsigned u32x4 __attribute__((ext_vector_type(4)));
typedef unsigned u32x2 __attribute__((ext_vector_type(2)));
#define DEVI __device__ __forceinline__
#define LAS __attribute__((address_space(3)))

constexpr int NB = 8, S = 2048, DM = 1024, T = NB * S, DEPTH = 2;
constexpr int INP = 3084, NPROJ = 3072;
constexpr int C_FQ = 0, C_FK = 256, C_FV = 512, C_DQ = 768, C_DK = 1024, C_DV = 1280, C_Z = 1536, C_XBC = 2048;
constexpr int MEMLEN = 256, MROWS = NB * MEMLEN;
constexpr int NEXP = 32, EFF = 512;
constexpr float EPS = 1e-6f;
constexpr int NTHR = 512;
constexpr int LDS_BYTES = 151552;

constexpr size_t al256(size_t x) { return (x + 255) & ~(size_t)255; }
constexpr size_t WS_W_IN = 0;
constexpr size_t WS_W_OUT = WS_W_IN + (size_t)NPROJ * DM * 2;
constexpr size_t WS_W_Q = WS_W_OUT + (size_t)DM * DM * 2;
constexpr size_t WS_W_KV = WS_W_Q + (size_t)DM * DM * 2;
constexpr size_t WS_W_O = WS_W_KV + (size_t)2 * DM * DM * 2;
constexpr size_t WS_W_13 = WS_W_O + (size_t)DM * DM * 2;
constexpr size_t WS_W_2 = WS_W_13 + (size_t)NEXP * 1024 * DM * 2;
constexpr size_t WS_WSMALL = WS_W_2 + (size_t)NEXP * DM * EFF * 2;
constexpr size_t WS_WROUT = WS_WSMALL + (size_t)DEPTH * 12 * DM * 4;
constexpr size_t WS_XB = WS_WROUT + (size_t)DEPTH * 36 * DM * 4;
constexpr size_t WS_H1 = WS_XB;
constexpr size_t WS_H3 = WS_XB + (size_t)T * DM * 2;
constexpr size_t WS_HBUF = WS_XB + (size_t)T * DM * 4;
constexpr size_t WS_PROJ = WS_HBUF + (size_t)T * DM * 2;
constexpr size_t WS_QBUF = WS_PROJ;
constexpr size_t WS_OBUF = WS_PROJ + (size_t)T * DM * 2;
constexpr size_t WS_ACT = WS_PROJ;
constexpr size_t WS_MIX = WS_PROJ + (size_t)T * NPROJ * 2;
constexpr size_t WS_U = WS_MIX + (size_t)T * DM * 2;
constexpr size_t WS_YBUF = WS_U;
constexpr size_t WS_DILO = WS_U;
constexpr size_t WS_DILM = WS_DILO + (size_t)3 * T * 256 * 4;
constexpr size_t WS_DILL = WS_DILM + (size_t)3 * T * 4 * 4;
constexpr size_t WS_SSTATE = WS_DILL + (size_t)3 * T * 4 * 4;
constexpr size_t WS_HIN = WS_SSTATE + (size_t)NB * 16 * 8 * 8192 * 4;
constexpr size_t WS_GBUF = WS_HIN + (size_t)NB * 16 * 8 * 8192 * 2;
constexpr size_t WS_U_END = WS_GBUF + (size_t)T * 512 * 4;
constexpr size_t WS_MEMN = WS_U_END;
constexpr size_t WS_KV = WS_MEMN + (size_t)MROWS * DM * 2;
constexpr size_t WS_LOGF = WS_KV + (size_t)MROWS * 2 * DM * 2;
constexpr size_t WS_CUMF = WS_LOGF + (size_t)T * 4 * 4;
constexpr size_t WS_DTV = WS_CUMF + (size_t)T * 4 * 4;
constexpr size_t WS_DECAY = WS_DTV + (size_t)T * 8 * 4;
constexpr size_t WS_CNT = WS_DECAY + (size_t)NB * 16 * 8 * 4;
constexpr size_t WS_LIST = WS_CNT + 1024;
constexpr size_t WS_GATE = WS_LIST + (size_t)NEXP * 2 * T * 4;
constexpr size_t WS_BAR = WS_GATE + (size_t)2 * T * 4;
constexpr size_t WS_XC = WS_BAR + 65536;
constexpr size_t WS_SSQ = WS_XC + (size_t)T * 1024 * 2;
constexpr size_t WS_RSTD1 = WS_SSQ + (size_t)T * 2 * 4;
constexpr size_t WS_RSTD3 = WS_RSTD1 + (size_t)T * 4;
constexpr size_t WS_END = WS_RSTD3 + (size_t)T * 4;
static_assert(WS_YBUF + (size_t)2 * T * DM * 2 <= WS_U_END, "ybuf alias");
static_assert(WS_OBUF + (size_t)T * DM * 2 <= WS_MIX, "obuf alias");

struct Params {
    const float* in[31];
    float* out;
    unsigned char* ws;
    int ph_lo, ph_hi;
    int use_grid_sync, pad;
};


typedef __attribute__((address_space(4))) const unsigned long long* karg_ptr;
typedef __attribute__((address_space(1))) const float* gcf_ptr;
typedef __attribute__((address_space(1))) float* gf_ptr;
typedef __attribute__((address_space(1))) unsigned char* gb_ptr;
struct DP {
    karg_ptr kp;
    DEVI const float* in(int i) const { return (const float*)(gcf_ptr)(kp[i]); }
    DEVI float* out() const { return (float*)(gf_ptr)(kp[31]); }
    DEVI unsigned char* ws() const { return (unsigned char*)(gb_ptr)(kp[32]); }
    DEVI int ph_lo() const { return (int)(unsigned)kp[33]; }
    DEVI int ph_hi() const { return (int)(unsigned)(kp[33] >> 32); }
    DEVI int use_gs() const { return (int)(unsigned)kp[34]; }
};

DEVI int TIDX() { int t = threadIdx.x; asm volatile("" : "+v"(t)); return t; }
DEVI int BIDX() { int b = blockIdx.x; asm volatile("" : "+s"(b)); return b; }
DEVI float bf2f(bf16_t v) { return __uint_as_float(((unsigned)v) << 16); }
typedef float f32x2 __attribute__((ext_vector_type(2)));
typedef __bf16 bf16x2_t __attribute__((ext_vector_type(2)));
DEVI unsigned cvt_pk(float lo, float hi) { f32x2 v = {lo, hi}; bf16x2_t b = __builtin_convertvector(v, bf16x2_t); return __builtin_bit_cast(unsigned, b); }
DEVI bf16_t f2bf(float f) { return (bf16_t)(cvt_pk(f, 0.f) & 0xffffu); }
DEVI float bflo(unsigned w) { return __uint_as_float(w << 16); }
DEVI float bfhi(unsigned w) { return __uint_as_float(w & 0xffff0000u); }
DEVI float wave_sum(float v) {
#pragma unroll
    for (int m = 32; m >= 1; m >>= 1) v += __shfl_xor(v, m);
    return v;
}
template <int CTRL> DEVI float dpp_mov(float v) { return __uint_as_float(__builtin_amdgcn_update_dpp(0u, __float_as_uint(v), CTRL, 0xf, 0xf, false)); }
DEVI float wave_sum_fast(float v) {
    v += dpp_mov<0xB1>(v);
    v += dpp_mov<0x4E>(v);
    v += dpp_mov<0x124>(v);
    v += dpp_mov<0x128>(v);
    const int iv = __float_as_int(v);
    return (__int_as_float(__builtin_amdgcn_readlane(iv, 0)) + __int_as_float(__builtin_amdgcn_readlane(iv, 16))) + (__int_as_float(__builtin_amdgcn_readlane(iv, 32)) + __int_as_float(__builtin_amdgcn_readlane(iv, 48)));
}
DEVI float silu_f(float x) { return x * __builtin_amdgcn_rcpf(1.f + __expf(-x)); }
DEVI float softplus_f(float x) { return x > 20.f ? x : log1pf(__expf(x)); }
DEVI float logsigmoid_f(float x) { return x >= 0.f ? -log1pf(__expf(-x)) : x - log1pf(__expf(x)); }
#define MFMA16(a, b, c) __builtin_amdgcn_mfma_f32_16x16x32_bf16(a, b, c, 0, 0, 0)
DEVI s16x4 tr_read(const bf16_t* p) {
    return __builtin_bit_cast(s16x4, __builtin_amdgcn_ds_read_tr16_b64_v4i16((LAS s16x4*)p));
}

DEVI int maprow(int mode, int n) { return mode == 0 ? n : ((n >> 4) * 32 + (n & 15) + (mode == 2 ? 16 : 0)); }
struct PrepD { const float* src; int ld, k0, c0; bf16_t* dst; int dstld, mode, n0; const float* ks; int ksf; };
DEVI void prep_ld(const PrepD& d, float4 (&v)[2], float (&sc)[2], int tid) {
#pragma unroll
    for (int i = 0; i < 2; ++i) {
        const int k = (tid >> 4) + 32 * i, n4 = (tid & 15) * 4;
        v[i] = *(const float4*)(d.src + (size_t)(d.k0 + k) * d.ld + d.c0 + n4);
        sc[i] = (d.ks != nullptr && (d.k0 + k) >= d.ksf) ? d.ks[d.k0 + k - d.ksf] : 1.f;
    }
}
DEVI void prep_tl(const float4 (&v)[2], const float (&sc)[2], float* tl, int tid) {
#pragma unroll
    for (int i = 0; i < 2; ++i) {
        const int k = (tid >> 4) + 32 * i, n4 = (tid & 15) * 4;
        tl[k * 65 + n4 + 0] = v[i].x * sc[i]; tl[k * 65 + n4 + 1] = v[i].y * sc[i]; tl[k * 65 + n4 + 2] = v[i].z * sc[i]; tl[k * 65 + n4 + 3] = v[i].w * sc[i];
    }
}
DEVI void prep_st(const PrepD& d, const float* tl, int tid) {
    const int n = tid >> 3, kc = (tid & 7) * 8;
    u32x4 w;
    w.x = cvt_pk(tl[(kc + 0) * 65 + n], tl[(kc + 1) * 65 + n]);
    w.y = cvt_pk(tl[(kc + 2) * 65 + n], tl[(kc + 3) * 65 + n]);
    w.z = cvt_pk(tl[(kc + 4) * 65 + n], tl[(kc + 5) * 65 + n]);
    w.w = cvt_pk(tl[(kc + 6) * 65 + n], tl[(kc + 7) * 65 + n]);
    const int drow = maprow(d.mode, d.n0 + n);
    *(u32x4*)(d.dst + (size_t)drow * d.dstld + d.k0 + kc) = w;
}

constexpr int PREP_UNITS = 2048 + 3 * 4096;
DEVI PrepD prep_decode(const DP& p, int l, int u) {
    unsigned char* ws = p.ws();
    PrepD d;
    if (u < 768) {
        const int kt = u / 48, nt = u % 48, n0 = nt * 64, c0 = n0 < 768 ? n0 : n0 + 4;
        d = PrepD{p.in(3) + (size_t)l * DM * INP, INP, kt * 64, c0, (bf16_t*)(ws + WS_W_IN), DM, 0, n0, p.in(2) + l * DM, 0};
    } else if (u < 1024) {
        const int v = u - 768, kt = v / 16, nt = v % 16;
        d = PrepD{p.in(15) + (size_t)l * DM * DM, DM, kt * 64, nt * 64, (bf16_t*)(ws + WS_W_OUT), DM, 0, nt * 64, p.in(14) + l * 512, 512};
    } else if (u < 1280) {
        const int v = u - 1024, kt = v / 16, nt = v % 16;
        d = PrepD{p.in(18) + (size_t)l * DM * DM, DM, kt * 64, nt * 64, (bf16_t*)(ws + WS_W_Q), DM, 0, nt * 64, p.in(16) + l * DM, 0};
    } else if (u < 1792) {
        const int v = u - 1280, kt = v / 32, nt = v % 32;
        d = PrepD{p.in(19) + (size_t)l * DM * 2 * DM, 2 * DM, kt * 64, nt * 64, (bf16_t*)(ws + WS_W_KV), DM, 0, nt * 64, nullptr, 0};
    } else if (u < 2048) {
        const int v = u - 1792, kt = v / 16, nt = v % 16;
        d = PrepD{p.in(22) + (size_t)l * DM * DM, DM, kt * 64, nt * 64, (bf16_t*)(ws + WS_W_O), DM, 0, nt * 64, nullptr, 0};
    } else if (u < 2048 + 8192) {
        const int v = u - 2048, which = v / 4096, w = v % 4096, e = w / 128, tI = w % 128, kt = tI / 8, nt = tI % 8;
        const float* src = (which == 0 ? p.in(28) : p.in(29)) + ((size_t)l * NEXP + e) * DM * EFF;
        d = PrepD{src, EFF, kt * 64, nt * 64, (bf16_t*)(ws + WS_W_13) + (size_t)e * 1024 * DM, DM, which == 0 ? 1 : 2, nt * 64, p.in(23) + l * DM, 0};
    } else {
        const int w = u - 2048 - 8192, e = w / 128, tI = w % 128, kt = tI / 16, nt = tI % 16;
        const float* src = p.in(30) + ((size_t)l * NEXP + e) * EFF * DM;
        d = PrepD{src, DM, kt * 64, nt * 64, (bf16_t*)(ws + WS_W_2) + (size_t)e * DM * EFF, EFF, 0, nt * 64, nullptr, 0};
    }
    return d;
}
DEVI void prep_all(const DP& p, int l, char* lds) {
    const int tid = TIDX(), G = gridDim.x;
    float* tl = (float*)lds;
    constexpr int NT = 4, TLS = 64 * 65;
    for (int u0 = BIDX(); u0 < PREP_UNITS; u0 += NT * G) {
        PrepD d[NT]; float4 v[NT][2]; float sc[NT][2];
#pragma unroll
        for (int i = 0; i < NT; ++i) { const int u = u0 + i * G; d[i] = prep_decode(p, l, u < PREP_UNITS ? u : u0); prep_ld(d[i], v[i], sc[i], tid); }
#pragma unroll
        for (int i = 0; i < NT; ++i) prep_tl(v[i], sc[i], tl + i * TLS, tid);
        __syncthreads();
#pragma unroll
        for (int i = 0; i < NT; ++i) if (u0 + i * G < PREP_UNITS) prep_st(d[i], tl + i * TLS, tid);
        __syncthreads();
    }
}
DEVI void prep_small(const DP& p) {
    float* wsm = (float*)(p.ws() + WS_WSMALL);
    float* wro = (float*)(p.ws() + WS_WROUT);
    const int gtid = BIDX() * NTHR + TIDX(), gn = gridDim.x * NTHR;
    for (int i = gtid; i < DEPTH * 12 * DM; i += gn) {
        const int l = i / (12 * DM), r = i % (12 * DM), c = r / DM, k = r % DM;
        const int col = c < 4 ? 768 + c : 3076 + (c - 4);
        wsm[i] = p.in(3)[((size_t)l * DM + k) * INP + col] * p.in(2)[l * DM + k];
    }
    for (int i = gtid; i < DEPTH * 36 * DM; i += gn) {
        const int l = i / (36 * DM), r = i % (36 * DM), c = r / DM, k = r % DM;
        wro[i] = (c < 4 ? p.in(24)[((size_t)l * DM + k) * 4 + c] : p.in(26)[((size_t)l * DM + k) * 32 + (c - 4)]) * p.in(23)[l * DM + k];
    }
    if (BIDX() == 0 && TIDX() < 128) ((int*)(p.ws() + WS_CNT))[TIDX()] = 0;
}

DEVI void store_h_bf16(bf16_t* hrow, const float (&h)[16], int lane) {
#pragma unroll
    for (int j = 0; j < 4; ++j) {
        u32x2 w; w.x = cvt_pk(h[4 * j], h[4 * j + 1]); w.y = cvt_pk(h[4 * j + 2], h[4 * j + 3]);
        *(u32x2*)(hrow + j * 256 + lane * 4) = w;
    }
}
DEVI void load_row_f32(const float* xr, float (&x)[16], int lane) {
#pragma unroll
    for (int j = 0; j < 4; ++j) { const float4 v = *(const float4*)(xr + j * 256 + lane * 4); x[4 * j] = v.x; x[4 * j + 1] = v.y; x[4 * j + 2] = v.z; x[4 * j + 3] = v.w; }
}
DEVI void add_row_bf16(const bf16_t* yr, float (&x)[16], int lane) {
#pragma unroll
    for (int j = 0; j < 4; ++j) { const u32x2 w = *(const u32x2*)(yr + j * 256 + lane * 4); x[4 * j] += bflo(w.x); x[4 * j + 1] += bfhi(w.x); x[4 * j + 2] += bflo(w.y); x[4 * j + 3] += bfhi(w.y); }
}
DEVI void store_row_f32(float* xr, const float (&x)[16], int lane) {
#pragma unroll
    for (int j = 0; j < 4; ++j) *(float4*)(xr + j * 256 + lane * 4) = make_float4(x[4 * j], x[4 * j + 1], x[4 * j + 2], x[4 * j + 3]);
}
DEVI void norm_row(const float (&x)[16], const float* g, float (&h)[16], int lane) {
    float ss = 0.f;
#pragma unroll
    for (int i = 0; i < 16; ++i) ss += x[i] * x[i];
    ss = wave_sum(ss);
    const float rstd = rsqrtf(ss * (1.0f / DM) + EPS);
#pragma unroll
    for (int j = 0; j < 4; ++j) { const float4 gv = *(const float4*)(g + j * 256 + lane * 4);
        h[4 * j] = x[4 * j] * rstd * gv.x; h[4 * j + 1] = x[4 * j + 1] * rstd * gv.y; h[4 * j + 2] = x[4 * j + 2] * rstd * gv.z; h[4 * j + 3] = x[4 * j + 3] * rstd * gv.w; }
}
DEVI float dot_lds(const float (&h)[16], const float* wrow, int lane) {
    f32x2 a0 = {0.f, 0.f}, a1 = {0.f, 0.f};
#pragma unroll
    for (int j = 0; j < 4; ++j) { const f32x4 w = *(const f32x4*)(wrow + j * 256 + lane * 4);
        a0 += (f32x2){h[4 * j], h[4 * j + 1]} * (f32x2){w[0], w[1]}; a1 += (f32x2){h[4 * j + 2], h[4 * j + 3]} * (f32x2){w[2], w[3]}; }
    a0 += a1;
    return a0[0] + a0[1];
}

DEVI void load_row_bf16(const bf16_t* xr, float (&x)[16], int lane) {
#pragma unroll
    for (int j = 0; j < 2; ++j) { const u32x4 w = *(const u32x4*)(xr + j * 512 + lane * 8);
        x[8 * j] = bflo(w.x); x[8 * j + 1] = bfhi(w.x); x[8 * j + 2] = bflo(w.y); x[8 * j + 3] = bfhi(w.y); x[8 * j + 4] = bflo(w.z); x[8 * j + 5] = bfhi(w.z); x[8 * j + 6] = bflo(w.w); x[8 * j + 7] = bfhi(w.w); }
}
DEVI void add_row_bf16_b(const bf16_t* yr, float (&x)[16], int lane) {
#pragma unroll
    for (int j = 0; j < 2; ++j) { const u32x4 w = *(const u32x4*)(yr + j * 512 + lane * 8);
        x[8 * j] += bflo(w.x); x[8 * j + 1] += bfhi(w.x); x[8 * j + 2] += bflo(w.y); x[8 * j + 3] += bfhi(w.y); x[8 * j + 4] += bflo(w.z); x[8 * j + 5] += bfhi(w.z); x[8 * j + 6] += bflo(w.w); x[8 * j + 7] += bfhi(w.w); }
}
DEVI void store_row_bf16_b(bf16_t* hr, const float (&h)[16], int lane) {
#pragma unroll
    for (int j = 0; j < 2; ++j) { u32x4 w; w.x = cvt_pk(h[8 * j], h[8 * j + 1]); w.y = cvt_pk(h[8 * j + 2], h[8 * j + 3]); w.z = cvt_pk(h[8 * j + 4], h[8 * j + 5]); w.w = cvt_pk(h[8 * j + 6], h[8 * j + 7]);
        *(u32x4*)(hr + j * 512 + lane * 8) = w; }
}
DEVI float dot_lds_b(const float (&h)[16], const float* wrow, int lane) {
    f32x2 a0 = {0.f, 0.f}, a1 = {0.f, 0.f};
#pragma unroll
    for (int j = 0; j < 2; ++j) { const f32x4 w0 = *(const f32x4*)(wrow + j * 512 + lane * 8), w1 = *(const f32x4*)(wrow + j * 512 + lane * 8 + 4);
        a0 += (f32x2){h[8 * j], h[8 * j + 1]} * (f32x2){w0[0], w0[1]}; a1 += (f32x2){h[8 * j + 2], h[8 * j + 3]} * (f32x2){w0[2], w0[3]};
        a0 += (f32x2){h[8 * j + 4], h[8 * j + 5]} * (f32x2){w1[0], w1[1]}; a1 += (f32x2){h[8 * j + 6], h[8 * j + 7]} * (f32x2){w1[2], w1[3]}; }
    a0 += a1;
    return a0[0] + a0[1];
}
#define MFMA_F32(a, b, c) __builtin_amdgcn_mfma_f32_16x16x4f32(a, b, c, 0, 0, 0)
template <int L>
DEVI void load_row_pre(const float* xin, const bf16_t* h0, const bf16_t* ybuf, int row, int lane, float (&x)[16]) {
    if (L == 0) load_row_f32(xin + (size_t)row * DM, x, lane);
    else { load_row_bf16(h0 + (size_t)row * DM, x, lane); add_row_bf16_b(ybuf + (size_t)(2 * row) * DM, x, lane); add_row_bf16_b(ybuf + (size_t)(2 * row + 1) * DM, x, lane); }
}
template <int L>
DEVI void norm1_rows(const DP& p, char* lds) {
    const int tid = TIDX(), wid = tid >> 6, lane = tid & 63;
    unsigned char* ws = p.ws();
    const float* wsl = (const float*)lds;
    const float* xin = p.in(0);
    const bf16_t* ybuf = (const bf16_t*)(ws + WS_YBUF);
    bf16_t* hbuf = (bf16_t*)(ws + WS_HBUF);
    float* logf = (float*)(ws + WS_LOGF);
    float* dtv = (float*)(ws + WS_DTV);
    float* rstd1 = (float*)(ws + WS_RSTD1);
    const int stride = gridDim.x * 8;
    int row = BIDX() * 8 + wid;
    float xn[16];
    if (row < T) load_row_pre<L>(xin, hbuf, ybuf, row, lane, xn);
    for (; row < T; row += stride) {
        float x[16];
#pragma unroll
        for (int i = 0; i < 16; ++i) x[i] = xn[i];
        if (row + stride < T) load_row_pre<L>(xin, hbuf, ybuf, row + stride, lane, xn);
        if (L == 0) store_h_bf16(hbuf + (size_t)row * DM, x, lane); else store_row_bf16_b(hbuf + (size_t)row * DM, x, lane);
        float ss = 0.f;
#pragma unroll
        for (int i = 0; i < 16; ++i) ss += x[i] * x[i];
        const float rstd = rsqrtf(wave_sum_fast(ss) * (1.0f / DM) + EPS);
        float keep = 0.f;
#pragma unroll
        for (int c = 0; c < 12; ++c) { const float v = wave_sum_fast(L == 0 ? dot_lds(x, wsl + c * DM, lane) : dot_lds_b(x, wsl + c * DM, lane)); keep = (lane == c) ? v : keep; if (c & 1) __builtin_amdgcn_sched_barrier(0); }
        keep *= rstd;
        if (lane == 0) rstd1[row] = rstd;
        {
            const float bias = lane < 4 ? p.in(4)[L * 4 + (lane & 3)] : p.in(11)[L * 8 + ((lane - 4) & 7)];
            const float xv = keep + bias;
            const float lt = __logf(1.0f + __expf(-fabsf(xv)));
            if (lane < 4) logf[(size_t)row * 4 + lane] = fminf(xv, 0.f) - lt;
            else if (lane < 12) dtv[(size_t)row * 8 + lane - 4] = fmaxf(xv, 0.f) + lt;
        }
    }
}
DEVI void phase_norm1(const DP& p, int l, char* lds) {
    const int tid = TIDX(), wid = tid >> 6, lane = tid & 63;
    unsigned char* ws = p.ws();
    float* wsl = (float*)lds;
    if (l == 0) {
        for (int i = tid; i < 12 * DM; i += NTHR) { const int c = i / DM, k = i % DM, col = c < 4 ? 768 + c : 3076 + (c - 4);
            wsl[i] = p.in(3)[(size_t)k * INP + col] * p.in(2)[k]; }
    } else {
        const float4* src = (const float4*)((const float*)(ws + WS_WSMALL) + (size_t)l * 12 * DM);
        for (int i = tid; i < 12 * DM / 4; i += NTHR) ((float4*)wsl)[i] = src[i];
    }
    __syncthreads();
    if (l == 0) norm1_rows<0>(p, lds); else norm1_rows<1>(p, lds);
    const float* gm = p.in(17) + l * DM;
    bf16_t* memn = (bf16_t*)(ws + WS_MEMN);
    for (int row = BIDX() * 8 + wid; row < MROWS; row += gridDim.x * 8) {
        float x[16], h[16];
        load_row_f32(p.in(1) + (size_t)row * DM, x, lane);
        norm_row(x, gm, h, lane);
        store_h_bf16(memn + (size_t)row * DM, h, lane);
    }
}
DEVI void phase_norm3(const DP& p, int l, char* lds) {
    const int tid = TIDX(), wid = tid >> 6, lane = tid & 63;
    unsigned char* ws = p.ws();
    float* wr = (float*)lds;
    int* lcnt = (int*)(lds + 36 * DM * 4);
    int* lbase = lcnt + 32;
    int* rinfo = lbase + 32;
    { const float4* src = (const float4*)((const float*)(ws + WS_WROUT) + (size_t)l * 36 * DM);
      for (int i = tid; i < 36 * DM / 4; i += NTHR) ((float4*)wr)[i] = src[i]; }
    if (tid < 32) lcnt[tid] = 0;
    __syncthreads();
    int* cnt = (int*)(ws + WS_CNT) + l * 64;
    int* list = (int*)(ws + WS_LIST);
    const bf16_t* xin = (const bf16_t*)(ws + WS_HBUF);
    bf16_t* h3 = (bf16_t*)(ws + WS_H3);
    const float* bg = p.in(25) + l * 4;
    const int be_i = __float_as_int(lane < 32 ? p.in(27)[l * 32 + lane] : 0.f);
    const int stride = gridDim.x * 8;
    int row = BIDX() * 8 + wid;
    float xn[16];
    if (row < T) load_row_bf16(xin + (size_t)row * DM, xn, lane);
    for (int it = 0; row < T; row += stride, ++it) {
        float x[16];
#pragma unroll
        for (int i = 0; i < 16; ++i) x[i] = xn[i];
        if (row + stride < T) load_row_bf16(xin + (size_t)(row + stride) * DM, xn, lane);
        float ss = 0.f;
#pragma unroll
        for (int i = 0; i < 16; ++i) ss += x[i] * x[i];
        const float rstd = rsqrtf(wave_sum_fast(ss) * (1.0f / DM) + EPS);
        { float hn[16];
#pragma unroll
          for (int i = 0; i < 16; ++i) hn[i] = x[i] * rstd;
          store_row_bf16_b(h3 + (size_t)row * DM, hn, lane); }
        float gl[4];
#pragma unroll
        for (int c = 0; c < 4; ++c) gl[c] = wave_sum_fast(dot_lds_b(x, wr + c * DM, lane)) * rstd + bg[c];
        int gsel = 0; float gmax = gl[0];
#pragma unroll
        for (int c = 1; c < 4; ++c) if (gl[c] > gmax) { gmax = gl[c]; gsel = c; }
        float gden = 0.f;
#pragma unroll
        for (int c = 0; c < 4; ++c) gden += __expf(gl[c] - gmax);
        const float ggate = 1.0f / gden;
        gsel = __builtin_amdgcn_readfirstlane(gsel);
        float v1 = -3.0e38f, v2 = -3.0e38f; int i1 = 0, i2 = 1;
#pragma unroll
        for (int c = 0; c < 8; ++c) {
            const float v = wave_sum_fast(dot_lds_b(x, wr + (4 + gsel * 8 + c) * DM, lane)) * rstd + __int_as_float(__builtin_amdgcn_readlane(be_i, gsel * 8 + c));
            if (v > v1) { v2 = v1; i2 = i1; v1 = v; i1 = c; } else if (v > v2) { v2 = v; i2 = c; }
            if (c & 1) __builtin_amdgcn_sched_barrier(0);
        }
        const float e2 = __expf(v2 - v1), inv = 1.0f / (1.0f + e2);
        if (lane == 0) {
            const int ea = gsel * 8 + i1, eb = gsel * 8 + i2;
            const int sa = atomicAdd(&lcnt[ea], 1), sb = atomicAdd(&lcnt[eb], 1);
            int* ri = rinfo + (it * 8 + wid) * 4;
            const unsigned gpk = cvt_pk(inv * ggate, e2 * inv * ggate);
            ri[0] = ea | (sa << 8); ri[1] = eb | (sb << 8); ri[2] = (int)(gpk << 16); ri[3] = (int)(gpk & 0xffff0000u);
        }
    }
    __syncthreads();
    if (tid < 32) lbase[tid] = atomicAdd(&cnt[tid], lcnt[tid]);
    __syncthreads();
    {
        const int nit = (T - (BIDX() * 8) + stride - 1) / stride;
        if (tid < nit * 8) {
            const int it = tid >> 3, w = tid & 7, r = BIDX() * 8 + w + it * stride;
            if (r < T) {
                const int* ri = rinfo + tid * 4;
                const int ea = ri[0] & 255, sa = ri[0] >> 8, eb = ri[1] & 255, sb = ri[1] >> 8;
                list[(size_t)ea * (2 * T) + lbase[ea] + sa] = ri[2] | (2 * r);
                list[(size_t)eb * (2 * T) + lbase[eb] + sb] = ri[3] | (2 * r + 1);
            }
        }
    }
    __syncthreads();
}

constexpr int G_BM = 256, G_BN = 128, G_BK = 64, G_ST = 72;
constexpr int G_ABUF = G_BM * G_ST, G_BBUF = G_BN * G_ST;
template <class AMap, class Epi>
DEVI void gemm_tile(const AMap& amap, const bf16_t* __restrict__ Bt, int K, const Epi& epi, char* lds) {
    const int tid = TIDX(), wid = tid >> 6, lane = tid & 63, r16 = lane & 15, g4 = lane >> 4;
    const int wr = wid >> 1, wc = wid & 1;
    bf16_t* As = (bf16_t*)lds;
    bf16_t* Bs = As + 2 * G_ABUF;
    const int srow = tid >> 3, skc = (tid & 7) * 8;
    const bf16_t* ap[4];
#pragma unroll
    for (int i = 0; i < 4; ++i) ap[i] = amap(srow + 64 * i) + skc;
    const bf16_t* bp[2];
#pragma unroll
    for (int i = 0; i < 2; ++i) bp[i] = Bt + (size_t)(srow + 64 * i) * K + skc;
    u32x4 ra[4], rb[2];
#pragma unroll
    for (int i = 0; i < 4; ++i) ra[i] = *(const u32x4*)(ap[i]);
#pragma unroll
    for (int i = 0; i < 2; ++i) rb[i] = *(const u32x4*)(bp[i]);
    f32x4 acc[4][4];
#pragma unroll
    for (int m = 0; m < 4; ++m)
#pragma unroll
        for (int n = 0; n < 4; ++n) acc[m][n] = (f32x4){0.f, 0.f, 0.f, 0.f};
    const int nt = K / G_BK;
    for (int t = 0; t < nt; ++t) {
        bf16_t* Ab = As + (t & 1) * G_ABUF;
        bf16_t* Bb = Bs + (t & 1) * G_BBUF;
#pragma unroll
        for (int i = 0; i < 4; ++i) *(u32x4*)(Ab + (srow + 64 * i) * G_ST + skc) = ra[i];
#pragma unroll
        for (int i = 0; i < 2; ++i) *(u32x4*)(Bb + (srow + 64 * i) * G_ST + skc) = rb[i];
        __syncthreads();
        if (t + 1 < nt) {
#pragma unroll
            for (int i = 0; i < 4; ++i) ra[i] = *(const u32x4*)(ap[i] + (size_t)(t + 1) * G_BK);
#pragma unroll
            for (int i = 0; i < 2; ++i) rb[i] = *(const u32x4*)(bp[i] + (size_t)(t + 1) * G_BK);
        }
#pragma unroll
        for (int kk = 0; kk < 2; ++kk) {
            bf16x8 af[4], bfr[4];
#pragma unroll
            for (int m = 0; m < 4; ++m) af[m] = *(const bf16x8*)(Ab + (wr * 64 + m * 16 + r16) * G_ST + kk * 32 + g4 * 8);
#pragma unroll
            for (int n = 0; n < 4; ++n) bfr[n] = *(const bf16x8*)(Bb + (wc * 64 + n * 16 + r16) * G_ST + kk * 32 + g4 * 8);
#pragma unroll
            for (int m = 0; m < 4; ++m)
#pragma unroll
                for (int n = 0; n < 4; ++n) acc[m][n] = MFMA16(bfr[n], af[m], acc[m][n]);
        }
    }
    epi(acc, wr * 64 + r16, wc * 64 + g4 * 4);
    __syncthreads();
}

struct AMapDense { const bf16_t* A; int K; DEVI const bf16_t* operator()(int r) const { return A + (size_t)r * K; } };
struct EpiBf16Out { bf16_t* O; int ldo;
    DEVI void operator()(const f32x4 (&acc)[4][4], int rb, int cb) const {
#pragma unroll
        for (int m = 0; m < 4; ++m)
#pragma unroll
            for (int n = 0; n < 4; ++n) { u32x2 w; w.x = cvt_pk(acc[m][n][0], acc[m][n][1]); w.y = cvt_pk(acc[m][n][2], acc[m][n][3]);
                *(u32x2*)(O + (size_t)(rb + m * 16) * ldo + cb + n * 16) = w; }
    } };
struct EpiResF32 { const float* R; float* O; int ld;
    DEVI void operator()(const f32x4 (&acc)[4][4], int rb, int cb) const {
#pragma unroll
        for (int m = 0; m < 4; ++m)
#pragma unroll
            for (int n = 0; n < 4; ++n) { const size_t off = (size_t)(rb + m * 16) * ld + cb + n * 16;
                const f32x4 r = *(const f32x4*)(R + off); *(f32x4*)(O + off) = r + acc[m][n]; }
    } };

template <class MakeEpi>
DEVI void gemm_dense_units(const bf16_t* A, const bf16_t* Bt, int M, int N, int K, const MakeEpi& mk, char* lds, int u0, int ustride) {
    const int nN = N / G_BN, nU = (M / G_BM) * nN;
    for (int u = u0; u < nU; u += ustride) {
        const int pm = u / nN, pn = u % nN;
        AMapDense am{A + (size_t)pm * G_BM * K, K};
        gemm_tile(am, Bt + (size_t)pn * G_BN * K, K, mk(pm * G_BM, pn * G_BN), lds);
    }
}


DEVI const char* uni_ptr(const char* p) {
    const unsigned long long v = (unsigned long long)p;
    const unsigned lo = __builtin_amdgcn_readfirstlane((unsigned)v), hi = __builtin_amdgcn_readfirstlane((unsigned)(v >> 32));
    return (const char*)(gb_ptr)(((unsigned long long)hi << 32) | lo);
}
namespace g8 {
constexpr int BM = 256, BK = 64, HALF = 128, HTB = HALF * BK * 2, STAGE_BYTES = 8 * HTB;
DEVI int lds_byte(int r, int c) { const int st = (r >> 4) * 2 + (c >> 5), rr = r & 15, cc = c & 31, ob = rr * 64 + cc * 2; return st * 1024 + (ob ^ (((ob >> 9) & 1) << 5)); }
DEVI void stage_rc(int b, int& R, int& C) { const int st = b / 1024, sb = b % 1024, swz = sb ^ (((sb >> 9) & 1) << 5); R = (st >> 1) * 16 + swz / 64; C = (st & 1) * 32 + (swz % 64) / 2; }
DEVI int perm32(int rho) { const int n = rho >> 4, i = rho & 15; return 8 * (i >> 2) + 4 * n + (i & 3); }
struct UnitU { const char* A; const char* B; int i0, i1, i2, i3; int flags; };

template <class Epi, class Sched>
DEVI void gemm8(char* lds_generic, int K, int klen, Sched& S, const Epi& E) {
    LAS unsigned char* lds = (LAS unsigned char*)lds_generic;
    const int tid = TIDX(), wid = __builtin_amdgcn_readfirstlane(tid >> 6), lane = tid & 63, wr = wid >> 2, wc = wid & 3, fr = lane & 15, fq = lane >> 4;
    const int nt = klen / BK;
    int R0, C0, R1, C1; stage_rc(tid * 16, R0, C0); stage_rc(tid * 16 + 8192, R1, C1);
    unsigned voffB[2];
    { const int Rb0 = Epi::PERM ? ((R0 & ~31) + perm32(R0 & 31)) : R0, Rb1 = Epi::PERM ? ((R1 & ~31) + perm32(R1 & 31)) : R1;
      voffB[0] = (unsigned)(Rb0 * K + C0) * 2u; voffB[1] = (unsigned)(Rb1 * K + C1) * 2u; }
    const size_t kstep = (size_t)(BK * 2), hstepB = (size_t)HALF * K * 2;
    const unsigned ldsw = (unsigned)wid * 1024u;
    const int aoff = lds_byte(wr * 64 + fr, fq * 8), boff = lds_byte(wc * 32 + fr, fq * 8);
#define G8_SA(b, h) (((b) * 2 + (h)) * HTB)
#define G8_SB(b, h) ((4 + (b) * 2 + (h)) * HTB)
#define G8_STG(bufoff, gbase, v0, v1) do { const char* _gb = uni_ptr((const char*)(gbase));     \
        __builtin_amdgcn_global_load_lds((const unsigned*)(_gb + (v0)), (LAS unsigned*)(lds + (bufoff) + ldsw), 16, 0, 0); \
        __builtin_amdgcn_global_load_lds((const unsigned*)(_gb + (v1)), (LAS unsigned*)(lds + (bufoff) + ldsw + 8192), 16, 0, 0); } while (0)
#define G8_LDA(dst, b, h) do { _Pragma("unroll") for (int m = 0; m < 4; ++m) _Pragma("unroll") for (int k = 0; k < 2; ++k) dst[m][k] = *(const LAS bf16x8*)(lds + G8_SA(b, h) + aoff + m * 2048 + k * 1024); } while (0)
#define G8_LDB(dst, b, h) do { _Pragma("unroll") for (int n = 0; n < 2; ++n) _Pragma("unroll") for (int k = 0; k < 2; ++k) dst[n][k] = *(const LAS bf16x8*)(lds + G8_SB(b, h) + boff + n * 2048 + k * 1024); } while (0)
#define G8_MMA(ai, bj, At, Bt) do { __builtin_amdgcn_s_setprio(1); _Pragma("unroll") for (int m = 0; m < 4; ++m) _Pragma("unroll") for (int n = 0; n < 2; ++n) _Pragma("unroll") for (int k = 0; k < 2; ++k) \
        acc[ai][bj][m][n] = __builtin_amdgcn_mfma_f32_16x16x32_bf16(Bt[n][k], At[m][k], acc[ai][bj][m][n], 0, 0, 0); __builtin_amdgcn_s_setprio(0); } while (0)
#define G8_WAIT_V(n) asm volatile("s_waitcnt vmcnt(" #n ")" ::: "memory")
#define G8_WAIT_L(n) asm volatile("s_waitcnt lgkmcnt(" #n ")" ::: "memory")
#define G8_BAR __builtin_amdgcn_s_barrier()
#define G8_SCHED __builtin_amdgcn_sched_barrier(0)
    UnitU cur, nxt;
    if (!S.next(cur)) return;
    unsigned va00, va01, va10, va11;
    S.lane_va(cur, R0, C0, R1, C1, va00, va01, va10, va11);
    f32x4 acc[2][2][4][2];
#pragma unroll
    for (int a = 0; a < 2; ++a)
#pragma unroll
        for (int b = 0; b < 2; ++b)
#pragma unroll
            for (int m = 0; m < 4; ++m)
#pragma unroll
                for (int n = 0; n < 2; ++n) acc[a][b][m][n] = (f32x4){0.f, 0.f, 0.f, 0.f};
    bf16x8 At[4][2], B0[2][2], B1[2][2];
    const char* cA = cur.A; const char* cB = cur.B;
    G8_STG(G8_SB(0, 0), cB, voffB[0], voffB[1]); G8_STG(G8_SA(0, 0), cA, va00, va01); G8_STG(G8_SB(0, 1), cB + hstepB, voffB[0], voffB[1]); G8_STG(G8_SA(0, 1), cA, va10, va11);
    if (wr == 1) G8_BAR;
    G8_WAIT_V(4); G8_BAR;
    G8_STG(G8_SB(1, 0), cB + kstep, voffB[0], voffB[1]); G8_STG(G8_SA(1, 0), cA + kstep, va00, va01); G8_STG(G8_SB(1, 1), cB + hstepB + kstep, voffB[0], voffB[1]);
    G8_WAIT_V(6); G8_BAR;
    for (;;) {
        const bool has_next = S.next(nxt);
        const char* nA = has_next ? nxt.A : cA; const char* nB = has_next ? nxt.B : cB;
        unsigned x00 = va00, x01 = va01, x10 = va10, x11 = va11;
        for (int t = 0; t < nt; t += 2) {
            const bool last = (t == nt - 2);
            const char* a1 = cA + (size_t)(t + 1) * kstep;
            const char* a2 = last ? nA : cA + (size_t)(t + 2) * kstep; const char* b2 = last ? nB : cB + (size_t)(t + 2) * kstep;
            const char* a3 = a2 + kstep; const char* b3 = b2 + kstep;
            if (Sched::GATHER) { if (last && has_next) S.lane_va(nxt, R0, C0, R1, C1, x00, x01, x10, x11); }
            G8_LDB(B0, 0, 0); G8_SCHED; G8_LDA(At, 0, 0); G8_STG(G8_SA(1, 1), a1, va10, va11);
            G8_WAIT_L(8); G8_BAR; G8_WAIT_L(0); G8_MMA(0, 0, At, B0); G8_BAR; G8_SCHED;
            G8_LDB(B1, 0, 1); G8_STG(G8_SB(0, 0), b2, voffB[0], voffB[1]);
            G8_BAR; G8_WAIT_L(0); G8_MMA(0, 1, At, B1); G8_BAR;
            G8_LDA(At, 0, 1); G8_STG(G8_SA(0, 0), a2, x00, x01);
            G8_BAR; G8_WAIT_L(0); G8_MMA(1, 0, At, B0); G8_BAR; G8_SCHED;
            G8_STG(G8_SB(0, 1), b2 + hstepB, voffB[0], voffB[1]);
            G8_WAIT_V(6); G8_BAR; G8_MMA(1, 1, At, B1); G8_BAR;
            G8_LDB(B0, 1, 0); G8_SCHED; G8_LDA(At, 1, 0); G8_STG(G8_SA(0, 1), a2, x10, x11);
            G8_WAIT_L(8); G8_BAR; G8_WAIT_L(0); G8_MMA(0, 0, At, B0); G8_BAR; G8_SCHED;
            G8_LDB(B1, 1, 1); G8_STG(G8_SB(1, 0), b3, voffB[0], voffB[1]);
            G8_BAR; G8_WAIT_L(0); G8_MMA(0, 1, At, B1); G8_BAR;
            G8_LDA(At, 1, 1); G8_STG(G8_SA(1, 0), a3, x00, x01);
            G8_BAR; G8_WAIT_L(0); G8_MMA(1, 0, At, B0); G8_BAR; G8_SCHED;
            G8_STG(G8_SB(1, 1), b3 + hstepB, voffB[0], voffB[1]);
            G8_WAIT_V(6); G8_BAR; G8_MMA(1, 1, At, B1); G8_BAR;
        }
        if (cur.flags & 2) E(acc, cur, wr, wc, fr, fq); else E.mid(acc, cur, wr, wc, fr, fq);
        if (!has_next) break;
        if (nxt.flags & 1) {
#pragma unroll
        for (int a = 0; a < 2; ++a)
#pragma unroll
            for (int b = 0; b < 2; ++b)
#pragma unroll
                for (int m = 0; m < 4; ++m)
#pragma unroll
                    for (int n = 0; n < 2; ++n) acc[a][b][m][n] = (f32x4){0.f, 0.f, 0.f, 0.f};
        }
        cur = nxt; cA = nA; cB = nB; va00 = x00; va01 = x01; va10 = x10; va11 = x11;
    }
    G8_WAIT_V(0);
    if (wr == 0) G8_BAR;
    G8_BAR;
#undef G8_SA
#undef G8_SB
#undef G8_STG
#undef G8_LDA
#undef G8_LDB
#undef G8_MMA
#undef G8_WAIT_V
#undef G8_WAIT_L
#undef G8_BAR
#undef G8_SCHED
}

struct DenseSched {
    static constexpr bool GATHER = false;
    const char* A; const char* Bt; int K, nM, nN, nwg, G, c, i;
    DEVI void init(const bf16_t* A_, const bf16_t* Bt_, int M, int N, int K_, int G_, int c_) { A = (const char*)A_; Bt = (const char*)Bt_; K = K_; nM = M / BM; nN = N / BM; nwg = nM * nN; G = G_; c = c_; i = 0; }
    DEVI bool next(UnitU& u) {
        const long L = (long)i * G + c; if (L >= nwg) return false;
        ++i;
        int wgid = (int)L; { const int q = nwg / 8, r = nwg % 8, xcd = wgid % 8, off = wgid / 8; wgid = (xcd < r ? xcd * (q + 1) : r * (q + 1) + (xcd - r) * q) + off; }
        const int nig = 8 * nN, gid = wgid / nig, fm = gid * 8, gsz = (nM - fm) < 8 ? (nM - fm) : 8;
        const int pm = fm + ((wgid % nig) % gsz), pn = (wgid % nig) / gsz;
        u.A = A + (size_t)pm * BM * K * 2; u.B = Bt + (size_t)pn * BM * K * 2; u.i0 = pm; u.i1 = pn; u.i2 = 0; u.i3 = 0; u.flags = 3;
        return true;
    }
    DEVI void lane_va(const UnitU&, int R0, int C0, int R1, int C1, unsigned& v00, unsigned& v01, unsigned& v10, unsigned& v11) const {
        v00 = (unsigned)(R0 * K + C0) * 2u; v01 = (unsigned)(R1 * K + C1) * 2u; v10 = v00 + (unsigned)(HALF * K * 2); v11 = v01 + (unsigned)(HALF * K * 2);
    }
};
struct EpiBf16Scale { static constexpr bool PERM = true; bf16_t* O; int ldo; const float* rstd;
    DEVI void mid(f32x4 (&)[2][2][4][2], const UnitU&, int, int, int, int) const {}
    DEVI void operator()(const f32x4 (&acc)[2][2][4][2], const UnitU& u, int wr, int wc, int fr, int fq) const {
        const int row0 = u.i0 * BM + wr * 64 + fr;
        bf16_t* base = O + (size_t)row0 * ldo + u.i1 * BM + wc * 32 + 8 * fq;
        float rsv[2][4];
#pragma unroll
        for (int ai = 0; ai < 2; ++ai)
#pragma unroll
            for (int m = 0; m < 4; ++m) rsv[ai][m] = rstd[row0 + ai * HALF + m * 16];
#pragma unroll
        for (int ai = 0; ai < 2; ++ai)
#pragma unroll
            for (int m = 0; m < 4; ++m) { bf16_t* rowp = base + (size_t)(ai * HALF + m * 16) * ldo; const float rs = rsv[ai][m];
#pragma unroll
                for (int bj = 0; bj < 2; ++bj) { const f32x4 v0 = acc[ai][bj][m][0] * rs, v1 = acc[ai][bj][m][1] * rs;
                    u32x4 w; w.x = cvt_pk(v0[0], v0[1]); w.y = cvt_pk(v0[2], v0[3]); w.z = cvt_pk(v1[0], v1[1]); w.w = cvt_pk(v1[2], v1[3]);
                    *(u32x4*)(rowp + bj * HALF) = w; } }
    } };
struct EpiBf16 { static constexpr bool PERM = true; bf16_t* O; int ldo;
    DEVI void mid(f32x4 (&)[2][2][4][2], const UnitU&, int, int, int, int) const {}
    DEVI void operator()(const f32x4 (&acc)[2][2][4][2], const UnitU& u, int wr, int wc, int fr, int fq) const {
        bf16_t* base = O + (size_t)(u.i0 * BM + wr * 64 + fr) * ldo + u.i1 * BM + wc * 32 + 8 * fq;
#pragma unroll
        for (int ai = 0; ai < 2; ++ai)
#pragma unroll
            for (int m = 0; m < 4; ++m) { bf16_t* rowp = base + (size_t)(ai * HALF + m * 16) * ldo;
#pragma unroll
                for (int bj = 0; bj < 2; ++bj) { const f32x4 v0 = acc[ai][bj][m][0], v1 = acc[ai][bj][m][1];
                    u32x4 w; w.x = cvt_pk(v0[0], v0[1]); w.y = cvt_pk(v0[2], v0[3]); w.z = cvt_pk(v1[0], v1[1]); w.w = cvt_pk(v1[2], v1[3]);
                    *(u32x4*)(rowp + bj * HALF) = w; } }
    } };
struct EpiResBf { static constexpr bool PERM = true; const bf16_t* R; bf16_t* O; int ld;
    DEVI void mid(f32x4 (&)[2][2][4][2], const UnitU&, int, int, int, int) const {}
    DEVI void operator()(const f32x4 (&acc)[2][2][4][2], const UnitU& u, int wr, int wc, int fr, int fq) const {
        const size_t off0 = (size_t)(u.i0 * BM + wr * 64 + fr) * ld + u.i1 * BM + wc * 32 + 8 * fq;
#pragma unroll
        for (int ai = 0; ai < 2; ++ai) {
            u32x4 rr[4][2];
#pragma unroll
            for (int m = 0; m < 4; ++m)
#pragma unroll
                for (int bj = 0; bj < 2; ++bj) rr[m][bj] = *(const u32x4*)(R + off0 + (size_t)(ai * HALF + m * 16) * ld + bj * HALF);
#pragma unroll
            for (int m = 0; m < 4; ++m) { const size_t off = off0 + (size_t)(ai * HALF + m * 16) * ld;
#pragma unroll
                for (int bj = 0; bj < 2; ++bj) { const u32x4 r = rr[m][bj]; const f32x4 v0 = acc[ai][bj][m][0], v1 = acc[ai][bj][m][1];
                    u32x4 w; w.x = cvt_pk(bflo(r.x) + v0[0], bfhi(r.x) + v0[1]); w.y = cvt_pk(bflo(r.y) + v0[2], bfhi(r.y) + v0[3]);
                    w.z = cvt_pk(bflo(r.z) + v1[0], bfhi(r.z) + v1[1]); w.w = cvt_pk(bflo(r.w) + v1[2], bfhi(r.w) + v1[3]);
                    *(u32x4*)(O + off + bj * HALF) = w; } }
        }
    } };
struct EpiRes { static constexpr bool PERM = false; const float* R; float* O; int ld; bf16_t* H;
    DEVI void mid(f32x4 (&)[2][2][4][2], const UnitU&, int, int, int, int) const {}
    DEVI void operator()(const f32x4 (&acc)[2][2][4][2], const UnitU& u, int wr, int wc, int fr, int fq) const {
        const size_t off0 = (size_t)(u.i0 * BM + wr * 64 + fr) * ld + u.i1 * BM + wc * 32 + 4 * fq;
#pragma unroll
        for (int ai = 0; ai < 2; ++ai)
#pragma unroll
            for (int m = 0; m < 4; ++m) { const size_t off = off0 + (size_t)(ai * HALF + m * 16) * ld;
#pragma unroll
                for (int bj = 0; bj < 2; ++bj)
#pragma unroll
                    for (int n = 0; n < 2; ++n) { const f32x4 r = *(const f32x4*)(R + off + bj * HALF + n * 16); const f32x4 o = r + acc[ai][bj][m][n];
                        *(f32x4*)(O + off + bj * HALF + n * 16) = o;
                        u32x2 w; w.x = cvt_pk(o[0], o[1]); w.y = cvt_pk(o[2], o[3]); *(u32x2*)(H + off + bj * HALF + n * 16) = w; } }
    } };
struct DenseSched2 {
    static constexpr bool GATHER = false;
    DenseSched D; int sub;
    DEVI void init(const bf16_t* A_, const bf16_t* Bt_, int M, int N, int K_, int G_, int c_) { D.init(A_, Bt_, M, N, K_, G_, c_); sub = 0; }
    UnitU pend;
    DEVI bool next(UnitU& u) {
        if (sub == 0) { if (!D.next(pend)) return false; u = pend; u.A = pend.A + (size_t)(D.K / 2) * 2; u.B = pend.B + (size_t)(D.K / 2) * 2; u.flags = 1; sub = 1; return true; }
        u = pend; u.flags = 2; sub = 0; return true;
    }
    DEVI void lane_va(const UnitU& u, int R0, int C0, int R1, int C1, unsigned& v00, unsigned& v01, unsigned& v10, unsigned& v11) const { D.lane_va(u, R0, C0, R1, C1, v00, v01, v10, v11); }
};
struct EpiResScale : EpiResBf { const float* ssq;
    DEVI void mid(f32x4 (&acc)[2][2][4][2], const UnitU& u, int wr, int wc, int fr, int fq) const {
        float2 sqv[2][4];
#pragma unroll
        for (int ai = 0; ai < 2; ++ai)
#pragma unroll
            for (int m = 0; m < 4; ++m) sqv[ai][m] = *(const float2*)(ssq + (size_t)(u.i0 * BM + ai * HALF + wr * 64 + m * 16 + fr) * 2);
#pragma unroll
        for (int ai = 0; ai < 2; ++ai)
#pragma unroll
            for (int m = 0; m < 4; ++m) {
                const float2 sq = sqv[ai][m];
                const float rs = rsqrtf((sq.x + sq.y) * (1.0f / 512.0f) + EPS);
#pragma unroll
                for (int bj = 0; bj < 2; ++bj)
#pragma unroll
                    for (int n = 0; n < 2; ++n) acc[ai][bj][m][n] *= rs;
            }
    } };
}

constexpr float LOG2E_C = 1.4426950408889634f;
DEVI void cumsum_task(const DP& p, int bh, char* lds) {
    const int tid = TIDX(), wid = tid >> 6, lane = tid & 63;
    const int b = bh >> 2, h = bh & 3;
    const float* logf = (const float*)(p.ws() + WS_LOGF);
    float* cumf = (float*)(p.ws() + WS_CUMF);
    float* wtot = (float*)lds;
    float v[4];
#pragma unroll
    for (int j = 0; j < 4; ++j) v[j] = logf[((size_t)b * S + tid * 4 + j) * 4 + h];
    v[1] += v[0]; v[2] += v[1]; v[3] += v[2];
    float incl = v[3];
#pragma unroll
    for (int d = 1; d < 64; d <<= 1) { const float t = __shfl_up(incl, d); if (lane >= d) incl += t; }
    if (lane == 63) wtot[wid] = incl;
    __syncthreads();
    float woff = 0.f;
    for (int w = 0; w < wid; ++w) woff += wtot[w];
    const float base = woff + incl - v[3];
    *(float4*)(cumf + (size_t)bh * S + tid * 4) = make_float4((base + v[0]) * LOG2E_C, (base + v[1]) * LOG2E_C, (base + v[2]) * LOG2E_C, (base + v[3]) * LOG2E_C);
    __syncthreads();
}
DEVI void phase_inproj(const DP& p, int l, char* lds) {
    unsigned char* ws = p.ws();
    g8::DenseSched S; S.init((const bf16_t*)(ws + WS_HBUF), (const bf16_t*)(ws + WS_W_IN), T, NPROJ, DM, gridDim.x, BIDX());
    g8::EpiBf16Scale E{(bf16_t*)(ws + WS_PROJ), NPROJ, (const float*)(ws + WS_RSTD1)};
    g8::gemm8(lds, DM, DM, S, E);
}
DEVI void kv_gemm(const DP& p, char* lds) {
    unsigned char* ws = p.ws();
    const int c = BIDX() - ((int)gridDim.x - 64);
    if (c < 0) return;
    g8::DenseSched S; S.init((const bf16_t*)(ws + WS_MEMN), (const bf16_t*)(ws + WS_W_KV), MROWS, 2 * DM, DM, 64, c);
    g8::EpiBf16 E{(bf16_t*)(ws + WS_KV), 2 * DM};
    g8::gemm8(lds, DM, DM, S, E);
}

DEVI void conv8_pos(const DP& p, int l, const bf16_t* proj, int b, int sp, int chan0, float (&out)[8]) {
    float a[8];
    const float* cb = p.in(10) + l * 1024 + chan0;
#pragma unroll
    for (int i = 0; i < 8; ++i) a[i] = cb[i];
#pragma unroll
    for (int j = 0; j < 4; ++j) {
        const int s2 = sp - 3 + j;
        if (s2 >= 0) {
            const u32x4 w = *(const u32x4*)(proj + ((size_t)b * S + s2) * NPROJ + C_XBC + chan0);
            const float* cw = p.in(9) + ((size_t)l * 4 + j) * 1024 + chan0;
            a[0] += cw[0] * bflo(w.x); a[1] += cw[1] * bfhi(w.x); a[2] += cw[2] * bflo(w.y); a[3] += cw[3] * bfhi(w.y);
            a[4] += cw[4] * bflo(w.z); a[5] += cw[5] * bfhi(w.z); a[6] += cw[6] * bflo(w.w); a[7] += cw[7] * bfhi(w.w);
        }
    }
#pragma unroll
    for (int i = 0; i < 8; ++i) out[i] = silu_f(a[i]);
}
DEVI u32x4 pack8(const float (&v)[8]) { u32x4 w; w.x = cvt_pk(v[0], v[1]); w.y = cvt_pk(v[2], v[3]); w.z = cvt_pk(v[4], v[5]); w.w = cvt_pk(v[6], v[7]); return w; }


DEVI void phase_post(const DP& p, int l) {
    const int tid = TIDX(), wid = tid >> 6, lane = tid & 63;
    unsigned char* ws = p.ws();
    bf16_t* proj = (bf16_t*)(ws + WS_PROJ);
    const int sl = lane >> 2, qt = lane & 3, type = sl >> 2, head = sl & 3;
    const int col0 = (type < 2 ? type * 256 : 768 + (type - 2) * 256) + head * 64 + qt * 16;
    const float *gq0 = p.in(5), *gq1 = p.in(6), *gq2 = p.in(7), *gq3 = p.in(8);
    asm volatile("" : "+s"(gq0), "+s"(gq1), "+s"(gq2), "+s"(gq3));
    const float* gain = (type == 0 ? gq0 : type == 1 ? gq1 : type == 2 ? gq2 : gq3) + l * 64 + qt * 16;
    float gv[16];
#pragma unroll
    for (int i = 0; i < 16; ++i) gv[i] = gain[i];
    const float inv[8] = {1.000000000e+00f, 1.939227432e-01f, 3.760603070e-02f, 7.292664610e-03f, 1.414213562e-03f, 2.742481884e-04f, 5.318295734e-05f, 1.031338525e-05f};
    for (int row = BIDX() * 8 + wid; row < T; row += gridDim.x * 8) {
        bf16_t* ptr = proj + (size_t)row * NPROJ + col0;
        const u32x4 w0 = *(const u32x4*)ptr, w1 = *(const u32x4*)(ptr + 8);
        float v[16];
        v[0] = bflo(w0.x); v[1] = bfhi(w0.x); v[2] = bflo(w0.y); v[3] = bfhi(w0.y); v[4] = bflo(w0.z); v[5] = bfhi(w0.z); v[6] = bflo(w0.w); v[7] = bfhi(w0.w);
        v[8] = bflo(w1.x); v[9] = bfhi(w1.x); v[10] = bflo(w1.y); v[11] = bfhi(w1.y); v[12] = bflo(w1.z); v[13] = bfhi(w1.z); v[14] = bflo(w1.w); v[15] = bfhi(w1.w);
        float ss = 0.f;
#pragma unroll
        for (int i = 0; i < 16; ++i) ss += v[i] * v[i];
        ss += __shfl_xor(ss, 1); ss += __shfl_xor(ss, 2);
        const float rstd = rsqrtf(ss * (1.0f / 64.0f) + EPS);
        const float qs = (type == 0 || type == 2) ? rstd * (0.125f * 1.4426950408889634f) : rstd;
#pragma unroll
        for (int i = 0; i < 16; ++i) v[i] = v[i] * qs * gv[i];
        if (type >= 2 && qt == 0) {
            const float pos = (float)(row & (S - 1));
#pragma unroll
            for (int i = 0; i < 8; ++i) { const float rev = __builtin_amdgcn_fractf(pos * inv[i] * 0.15915494309189535f);
                const float sn = __builtin_amdgcn_sinf(rev), cs = __builtin_amdgcn_cosf(rev);
                const float a = v[i], b = v[i + 8]; v[i] = a * cs - b * sn; v[i + 8] = b * cs + a * sn; }
        }
        u32x4 o0, o1;
        o0.x = cvt_pk(v[0], v[1]); o0.y = cvt_pk(v[2], v[3]); o0.z = cvt_pk(v[4], v[5]); o0.w = cvt_pk(v[6], v[7]);
        o1.x = cvt_pk(v[8], v[9]); o1.y = cvt_pk(v[10], v[11]); o1.z = cvt_pk(v[12], v[13]); o1.w = cvt_pk(v[14], v[15]);
        *(u32x4*)ptr = o0; *(u32x4*)(ptr + 8) = o1;
    }
    bf16_t* xc = (bf16_t*)(ws + WS_XC);
    for (int item = BIDX() * NTHR + tid; item < T * 128; item += gridDim.x * NTHR) {
        const int t = item >> 7, c8 = (item & 127) * 8;
        float v[8]; conv8_pos(p, l, proj, t / S, t % S, c8, v);
        *(u32x4*)(xc + (size_t)t * 1024 + c8) = pack8(v);
    }
}
DEVI void phase_knorm(const DP& p, int l) {
    const int tid = TIDX(), wid = tid >> 6, lane = tid & 63;
    unsigned char* ws = p.ws();
    bf16_t* kv = (bf16_t*)(ws + WS_KV);
    const float* kg = p.in(21) + l * 256 + (lane & 15) * 16;
    float kgv[16];
#pragma unroll
    for (int i = 0; i < 16; ++i) kgv[i] = kg[i];
    for (int row = BIDX() * 8 + wid; row < MROWS; row += gridDim.x * 8) {
        bf16_t* ptr = kv + (size_t)row * 2 * DM + lane * 16;
        const u32x4 w0 = *(const u32x4*)ptr, w1 = *(const u32x4*)(ptr + 8);
        float v[16];
        v[0] = bflo(w0.x); v[1] = bfhi(w0.x); v[2] = bflo(w0.y); v[3] = bfhi(w0.y); v[4] = bflo(w0.z); v[5] = bfhi(w0.z); v[6] = bflo(w0.w); v[7] = bfhi(w0.w);
        v[8] = bflo(w1.x); v[9] = bfhi(w1.x); v[10] = bflo(w1.y); v[11] = bfhi(w1.y); v[12] = bflo(w1.z); v[13] = bfhi(w1.z); v[14] = bflo(w1.w); v[15] = bfhi(w1.w);
        float ss = 0.f;
#pragma unroll
        for (int i = 0; i < 16; ++i) ss += v[i] * v[i];
        ss += __shfl_xor(ss, 1); ss += __shfl_xor(ss, 2); ss += __shfl_xor(ss, 4); ss += __shfl_xor(ss, 8);
        const float rstd = rsqrtf(ss * (1.0f / 256.0f) + EPS);
#pragma unroll
        for (int i = 0; i < 16; ++i) v[i] = v[i] * rstd * kgv[i];
        u32x4 o0, o1;
        o0.x = cvt_pk(v[0], v[1]); o0.y = cvt_pk(v[2], v[3]); o0.z = cvt_pk(v[4], v[5]); o0.w = cvt_pk(v[6], v[7]);
        o1.x = cvt_pk(v[8], v[9]); o1.y = cvt_pk(v[10], v[11]); o1.z = cvt_pk(v[12], v[13]); o1.w = cvt_pk(v[14], v[15]);
        *(u32x4*)ptr = o0; *(u32x4*)(ptr + 8) = o1;
    }
}
constexpr float LOG2E = 1.4426950408889634f;
template <int DH> struct AttnLds { static constexpr int KST = DH + 8; static constexpr int TILE = 64 * KST; static constexpr int BYTES = 4 * TILE * 2; };
DEVI float xor16_max(float v) { auto r = __builtin_amdgcn_permlane16_swap(__float_as_uint(v), __float_as_uint(v), false, false); return fmaxf(__uint_as_float(r[0]), __uint_as_float(r[1])); }
DEVI float xor16_sum(float v) { auto r = __builtin_amdgcn_permlane16_swap(__float_as_uint(v), __float_as_uint(v), false, false); return __uint_as_float(r[0]) + __uint_as_float(r[1]); }
DEVI float xor32_max(float v) { auto r = __builtin_amdgcn_permlane32_swap(__float_as_uint(v), __float_as_uint(v), false, false); return fmaxf(__uint_as_float(r[0]), __uint_as_float(r[1])); }
DEVI float xor32_sum(float v) { auto r = __builtin_amdgcn_permlane32_swap(__float_as_uint(v), __float_as_uint(v), false, false); return __uint_as_float(r[0]) + __uint_as_float(r[1]); }
template <int DH, int MODE, int QR>
DEVI void attn_task(const bf16_t* __restrict__ Qb, int ldq, int qtok0, int qstep,
                    const bf16_t* __restrict__ Kb, const bf16_t* __restrict__ Vb, int ldk, int ktok0, int kstep,
                    int p0, int kt_lo, int kt_hi, float scale,
                    const float* __restrict__ cum, const float* __restrict__ qgain,
                    bf16_t* Ob, int ldo, float* Of, float* Om, float* Ol, char* lds) {
    constexpr int KST = AttnLds<DH>::KST, TILE = AttnLds<DH>::TILE, NKK = DH / 32, ND = DH / 16, NCH = (64 * DH / 8) / NTHR;
    constexpr int WR = 16 * QR;
    const int tid = TIDX(), wid = tid >> 6, lane = tid & 63, r16 = lane & 15, g4 = lane >> 4;
    bf16_t* Ks = (bf16_t*)lds;
    bf16_t* Vs = Ks + 2 * TILE;
    const float c2 = scale * LOG2E;
    bf16x8 qf[QR][NKK];
    int qpos[QR];
#pragma unroll
    for (int g = 0; g < QR; ++g) {
        qpos[g] = p0 + wid * WR + g * 16 + r16;
        const bf16_t* qp = Qb + (size_t)(qtok0 + qpos[g] * qstep) * ldq + g4 * 8;
#pragma unroll
        for (int kk = 0; kk < NKK; ++kk) qf[g][kk] = *(const bf16x8*)(qp + kk * 32);
    }
    if (MODE == 2) {
#pragma unroll
        for (int g = 0; g < QR; ++g) {
            float ss = 0.f;
#pragma unroll
            for (int kk = 0; kk < NKK; ++kk)
#pragma unroll
                for (int j = 0; j < 8; ++j) { const float v = bf2f((bf16_t)qf[g][kk][j]); ss += v * v; }
            ss += __shfl_xor(ss, 16); ss += __shfl_xor(ss, 32);
            const float rstd = rsqrtf(ss * (1.0f / DH) + EPS);
#pragma unroll
            for (int kk = 0; kk < NKK; ++kk)
#pragma unroll
                for (int j = 0; j < 8; ++j) { const float v = bf2f((bf16_t)qf[g][kk][j]) * (rstd * c2) * qgain[kk * 32 + g4 * 8 + j]; qf[g][kk][j] = (short)f2bf(v); }
        }
    }
    float m_[QR], cq[QR];
    f32x4 o[QR][ND], o1[QR];
#pragma unroll
    for (int g = 0; g < QR; ++g) {
        m_[g] = 0.f; cq[g] = (MODE == 0) ? cum[qpos[g]] : 0.f;
        o1[g] = (f32x4){0.f, 0.f, 0.f, 0.f};
#pragma unroll
        for (int n = 0; n < ND; ++n) o[g][n] = (f32x4){0.f, 0.f, 0.f, 0.f};
    }
    bf16x8 vones;
#pragma unroll
    for (int j = 0; j < 8; ++j) vones[j] = (short)(r16 == 0 ? 0x3f80 : 0);
    u32x4 rk[NCH], rv[NCH];
    auto gload = [&](int kt) {
#pragma unroll
        for (int i = 0; i < NCH; ++i) { const int c = tid + i * NTHR, key = c / (DH / 8), dc = c % (DH / 8);
            const size_t tok = (size_t)(ktok0 + (kt * 64 + key) * kstep);
            rk[i] = *(const u32x4*)(Kb + tok * ldk + dc * 8); rv[i] = *(const u32x4*)(Vb + tok * ldk + dc * 8); }
    };
    gload(kt_lo);
    __syncthreads();
    int buf = 0;
    for (int kt = kt_lo; kt < kt_hi; ++kt, buf ^= 1) {
        bf16_t* Kt = Ks + buf * TILE;
        bf16_t* Vt = Vs + buf * TILE;
#pragma unroll
        for (int i = 0; i < NCH; ++i) { const int c = tid + i * NTHR, key = c / (DH / 8), dc = c % (DH / 8);
            *(u32x4*)(Kt + key * KST + dc * 8) = rk[i]; *(u32x4*)(Vt + key * KST + dc * 8) = rv[i]; }
        __syncthreads();
        if (kt + 1 < kt_hi) gload(kt + 1);
        const int qmin = p0 + wid * WR, kmin = kt * 64;
        bool skip = false, interior = true;
        if (MODE == 0) { skip = kmin > qmin + WR - 1; interior = kmin + 63 <= qmin; }
        if (MODE == 1) { skip = (qmin + WR - 1 - kmin < 0) || (qmin - (kmin + 63) > 128); interior = (qmin - (kmin + 63) >= 0) && (qmin + WR - 1 - kmin <= 128); }
        if (skip) continue;
        f32x4 s[QR][4];
        float cm[QR];
#pragma unroll
        for (int g = 0; g < QR; ++g) cm[g] = cq[g] - m_[g];
#pragma unroll
        for (int n = 0; n < 4; ++n) {
            f32x4 ck = (f32x4){0.f, 0.f, 0.f, 0.f};
            if (MODE == 0) ck = *(const f32x4*)(cum + kt * 64 + n * 16 + g4 * 4);
#pragma unroll
            for (int g = 0; g < QR; ++g) s[g][n] = (f32x4){cm[g] - ck[0], cm[g] - ck[1], cm[g] - ck[2], cm[g] - ck[3]};
#pragma unroll
            for (int kk = 0; kk < NKK; ++kk) {
                const bf16x8 kf = *(const bf16x8*)(Kt + (n * 16 + r16) * KST + kk * 32 + g4 * 8);
#pragma unroll
                for (int g = 0; g < QR; ++g) s[g][n] = MFMA16(kf, qf[g][kk], s[g][n]);
            }
            if (DH > 64) __builtin_amdgcn_sched_barrier(0);
        }
        float mx[QR];
#pragma unroll
        for (int g = 0; g < QR; ++g) mx[g] = -INFINITY;
#pragma unroll
        for (int n = 0; n < 4; ++n)
#pragma unroll
            for (int g = 0; g < QR; ++g)
#pragma unroll
                for (int j = 0; j < 4; ++j) {
                    float t = s[g][n][j];
                    if (!interior) {
                        const int kpos = kt * 64 + n * 16 + g4 * 4 + j;
                        if (MODE == 0) { if (kpos > qpos[g]) t = -INFINITY; }
                        if (MODE == 1) { const int dd = qpos[g] - kpos; if (dd < 0 || dd > 128) t = -INFINITY; }
                        s[g][n][j] = t;
                    }
                    mx[g] = fmaxf(mx[g], t);
                }
        bool grow = false;
#pragma unroll
        for (int g = 0; g < QR; ++g) { mx[g] = xor32_max(xor16_max(mx[g])); grow = grow || (mx[g] > 8.0f); }
        if (__any(grow)) {
#pragma unroll
            for (int g = 0; g < QR; ++g) {
                const float delta = fmaxf(mx[g], 0.f);
                const float alpha = __builtin_amdgcn_exp2f(-delta);
                m_[g] += delta; o1[g] *= alpha;
#pragma unroll
                for (int n = 0; n < ND; ++n) o[g][n] *= alpha;
#pragma unroll
                for (int n = 0; n < 4; ++n) s[g][n] -= delta;
            }
        }
#pragma unroll
        for (int g = 0; g < QR; ++g)
#pragma unroll
            for (int n = 0; n < 4; ++n)
#pragma unroll
                for (int j = 0; j < 4; ++j) s[g][n][j] = __builtin_amdgcn_exp2f(s[g][n][j]);
#pragma unroll
        for (int kk = 0; kk < 2; ++kk) {
            bf16x8 pb[QR];
#pragma unroll
            for (int g = 0; g < QR; ++g) {
                u32x4 w; w.x = cvt_pk(s[g][2 * kk][0], s[g][2 * kk][1]); w.y = cvt_pk(s[g][2 * kk][2], s[g][2 * kk][3]); w.z = cvt_pk(s[g][2 * kk + 1][0], s[g][2 * kk + 1][1]); w.w = cvt_pk(s[g][2 * kk + 1][2], s[g][2 * kk + 1][3]);
                pb[g] = __builtin_bit_cast(bf16x8, w);
                o1[g] = MFMA16(vones, pb[g], o1[g]);
            }
            const bf16_t* vb = Vt + (kk * 32 + 4 * g4 + (r16 >> 2)) * KST + 4 * (r16 & 3);
#pragma unroll
            for (int n = 0; n < ND; ++n) {
                const s16x4 lo = tr_read(vb + n * 16), hi = tr_read(vb + 16 * KST + n * 16);
                bf16x8 vf; vf[0] = lo[0]; vf[1] = lo[1]; vf[2] = lo[2]; vf[3] = lo[3]; vf[4] = hi[0]; vf[5] = hi[1]; vf[6] = hi[2]; vf[7] = hi[3];
#pragma unroll
                for (int g = 0; g < QR; ++g) o[g][n] = MFMA16(vf, pb[g], o[g][n]);
                if (DH > 64 && (n & 3) == 3) __builtin_amdgcn_sched_barrier(0);
            }
        }
    }
#pragma unroll
    for (int g = 0; g < QR; ++g) {
        const size_t tok = (size_t)(qtok0 + qpos[g] * qstep);
        const float lsum = __shfl(o1[g][0], r16);
        if (MODE == 1) {
#pragma unroll
            for (int n = 0; n < ND; ++n) *(f32x4*)(Of + tok * 256 + n * 16 + g4 * 4) = o[g][n];
            if (g4 == 0) { Om[tok * 4] = m_[g]; Ol[tok * 4] = lsum; }
        } else {
            const float inv = 1.0f / lsum;
#pragma unroll
            for (int n = 0; n < ND; ++n) { u32x2 w; w.x = cvt_pk(o[g][n][0] * inv, o[g][n][1] * inv); w.y = cvt_pk(o[g][n][2] * inv, o[g][n][3] * inv);
                *(u32x2*)(Ob + tok * ldo + n * 16 + g4 * 4) = w; }
        }
    }
}

DEVI void ssd_acs(const DP& p, int l, int b, int c, int g, float* acs, float* dts) {
    const int tid = TIDX(), wid = tid >> 6, lane = tid & 63;
    if (wid < 4) {
        const int head = g * 4 + wid;
        const float* dtv = (const float*)(p.ws() + WS_DTV);
        const float A = -__expf(p.in(12)[l * 8 + head]);
        const size_t t0 = (size_t)b * S + c * 128 + 2 * lane;
        const float d0 = dtv[t0 * 8 + head], d1 = dtv[(t0 + 1) * 8 + head];
        const float a0 = d0 * A, a1 = d1 * A;
        float incl = a0 + a1;
#pragma unroll
        for (int d = 1; d < 64; d <<= 1) { const float t = __shfl_up(incl, d); if (lane >= d) incl += t; }
        const float ex = incl - (a0 + a1);
        acs[wid * 128 + 2 * lane] = ex + a0; acs[wid * 128 + 2 * lane + 1] = ex + a0 + a1;
        dts[wid * 128 + 2 * lane] = d0; dts[wid * 128 + 2 * lane + 1] = d1;
    }
}
DEVI void conv8_chan(const DP& p, int l, const bf16_t* proj, int b, int c, int chan, int l0, float (&out)[8]) {
    const float* cw = p.in(9) + (size_t)l * 4 * 1024 + chan;
    const float w0 = cw[0], w1 = cw[1024], w2 = cw[2048], w3 = cw[3072], cb = p.in(10)[l * 1024 + chan];
    float v[11];
    const int sbase = c * 128 + l0 - 3;
#pragma unroll
    for (int i = 0; i < 11; ++i) { const int sp = sbase + i; v[i] = sp >= 0 ? bf2f(proj[((size_t)b * S + sp) * NPROJ + C_XBC + chan]) : 0.f; }
#pragma unroll
    for (int i = 0; i < 8; ++i) out[i] = silu_f(cb + w0 * v[i] + w1 * v[i + 1] + w2 * v[i + 2] + w3 * v[i + 3]);
}
constexpr int SST = 136;
constexpr int XST4 = 264;
DEVI void ssd_states_task(const DP& p, int l, int b, int c, int g, char* lds) {
    const int tid = TIDX(), wid = tid >> 6, lane = tid & 63, r16 = lane & 15, g4 = lane >> 4;
    const bf16_t* xc = (const bf16_t*)(p.ws() + WS_XC);
    bf16_t* Bn = (bf16_t*)lds;
    bf16_t* Xn = Bn + 128 * SST;
    float* acs = (float*)(Xn + 128 * XST4);
    float* dts = acs + 512;
    __syncthreads();
    ssd_acs(p, l, b, c, g, acs, dts);
    __syncthreads();
    if (tid < 4) ((float*)(p.ws() + WS_DECAY))[((size_t)b * 16 + c) * 8 + g * 4 + tid] = __expf(acs[tid * 128 + 127]);
    const size_t tok0 = (size_t)b * S + c * 128;
    for (int it = tid; it < 2048; it += NTHR) {
        const int ll = it >> 4, nc = (it & 15) * 8;
        *(u32x4*)(Bn + ll * SST + nc) = *(const u32x4*)(xc + (tok0 + ll) * 1024 + 512 + g * 128 + nc);
    }
    for (int it = tid; it < 4096; it += NTHR) {
        const int ll = it >> 5, ch = (it & 31) * 8, hl = ch >> 6;
        const u32x4 w = *(const u32x4*)(xc + (tok0 + ll) * 1024 + g * 256 + ch);
        const float sc = dts[hl * 128 + ll] * __expf(acs[hl * 128 + 127] - acs[hl * 128 + ll]);
        u32x4 o; o.x = cvt_pk(bflo(w.x) * sc, bfhi(w.x) * sc); o.y = cvt_pk(bflo(w.y) * sc, bfhi(w.y) * sc); o.z = cvt_pk(bflo(w.z) * sc, bfhi(w.z) * sc); o.w = cvt_pk(bflo(w.w) * sc, bfhi(w.w) * sc);
        *(u32x4*)(Xn + ll * XST4 + ch) = o;
    }
    __syncthreads();
    const int hl = wid >> 1, nh = wid & 1;
    f32x4 acc[4][4];
#pragma unroll
    for (int m = 0; m < 4; ++m)
#pragma unroll
        for (int n = 0; n < 4; ++n) acc[m][n] = (f32x4){0.f, 0.f, 0.f, 0.f};
#pragma unroll
    for (int kk = 0; kk < 4; ++kk) {
        bf16x8 af[4], bfr[4];
        const int lrow = kk * 32 + 8 * g4 + (r16 >> 2), cq = 4 * (r16 & 3);
#pragma unroll
        for (int m = 0; m < 4; ++m) { const bf16_t* a = Xn + lrow * XST4 + hl * 64 + m * 16 + cq; const s16x4 lo = tr_read(a), hi = tr_read(a + 4 * XST4);
            af[m][0] = lo[0]; af[m][1] = lo[1]; af[m][2] = lo[2]; af[m][3] = lo[3]; af[m][4] = hi[0]; af[m][5] = hi[1]; af[m][6] = hi[2]; af[m][7] = hi[3]; }
#pragma unroll
        for (int n = 0; n < 4; ++n) { const bf16_t* a = Bn + lrow * SST + nh * 64 + n * 16 + cq; const s16x4 lo = tr_read(a), hi = tr_read(a + 4 * SST);
            bfr[n][0] = lo[0]; bfr[n][1] = lo[1]; bfr[n][2] = lo[2]; bfr[n][3] = lo[3]; bfr[n][4] = hi[0]; bfr[n][5] = hi[1]; bfr[n][6] = hi[2]; bfr[n][7] = hi[3]; }
#pragma unroll
        for (int m = 0; m < 4; ++m)
#pragma unroll
            for (int n = 0; n < 4; ++n) acc[m][n] = MFMA16(bfr[n], af[m], acc[m][n]);
    }
    float* st = (float*)(p.ws() + WS_SSTATE) + (((size_t)b * 16 + c) * 8 + g * 4 + hl) * 8192;
#pragma unroll
    for (int m = 0; m < 4; ++m)
#pragma unroll
        for (int n = 0; n < 4; ++n) *(f32x4*)(st + (m * 16 + r16) * 128 + nh * 64 + n * 16 + g4 * 4) = acc[m][n];
}
DEVI void phase_ssd_scan(const DP& p) {
    const float* st = (const float*)(p.ws() + WS_SSTATE);
    bf16_t* hin = (bf16_t*)(p.ws() + WS_HIN);
    const float* decay = (const float*)(p.ws() + WS_DECAY);
    const int total = NB * 8 * 2048;
    for (int i = BIDX() * NTHR + TIDX(); i < total; i += gridDim.x * NTHR) {
        const int e4 = i & 2047, head = (i >> 11) & 7, b = i >> 14;
        f32x4 h = (f32x4){0.f, 0.f, 0.f, 0.f};
        for (int c = 0; c < 16; ++c) {
            const size_t off = (((size_t)b * 16 + c) * 8 + head) * 8192 + e4 * 4;
            u32x2 w; w.x = cvt_pk(h[0], h[1]); w.y = cvt_pk(h[2], h[3]);
            *(u32x2*)(hin + off) = w;
            const f32x4 s = *(const f32x4*)(st + off);
            const float d = decay[((size_t)b * 16 + c) * 8 + head];
            h = h * d + s;
        }
    }
}
constexpr int XST1 = 72;
DEVI void ssd_out_task(const DP& p, int l, int b, int c, int g, char* lds) {
    const int tid = TIDX(), wid = tid >> 6, lane = tid & 63, r16 = lane & 15, g4 = lane >> 4;
    const bf16_t* proj = (const bf16_t*)(p.ws() + WS_PROJ);
    const bf16_t* xc = (const bf16_t*)(p.ws() + WS_XC);
    bf16_t* Cs = (bf16_t*)lds;
    bf16_t* Bs = Cs + 128 * SST;
    bf16_t* Xn = Bs + 128 * SST;
    bf16_t* Hs = Xn + 128 * XST1;
    bf16_t* Mw = Hs + 64 * SST + wid * 16 * SST;
    float* acs = (float*)(Hs + 64 * SST + 8 * 16 * SST);
    float* dts = acs + 512;
    const int lrow = wid * 16 + r16;
    const size_t tok0 = (size_t)b * S + c * 128, tok = tok0 + lrow;
    bf16_t* mix = (bf16_t*)(p.ws() + WS_MIX);
    float ssq = 0.f;
    __syncthreads();
    ssd_acs(p, l, b, c, g, acs, dts);
    for (int it = tid; it < 2048; it += NTHR) {
        const int ll = it >> 4, nc = (it & 15) * 8;
        *(u32x4*)(Cs + ll * SST + nc) = *(const u32x4*)(xc + (tok0 + ll) * 1024 + 768 + g * 128 + nc);
        *(u32x4*)(Bs + ll * SST + nc) = *(const u32x4*)(xc + (tok0 + ll) * 1024 + 512 + g * 128 + nc);
    }
    __syncthreads();
    bf16x8 cfr[4];
#pragma unroll
    for (int kk = 0; kk < 4; ++kk) cfr[kk] = *(const bf16x8*)(Cs + lrow * SST + kk * 32 + g4 * 8);
    f32x4 cb[8];
#pragma unroll
    for (int st = 0; st < 8; ++st) {
        cb[st] = (f32x4){0.f, 0.f, 0.f, 0.f};
#pragma unroll
        for (int kk = 0; kk < 4; ++kk) {
            const bf16x8 bfr = *(const bf16x8*)(Bs + (st * 16 + r16) * SST + kk * 32 + g4 * 8);
            cb[st] = MFMA16(bfr, cfr[kk], cb[st]);
        }
    }
    u32x4 px[2], ph[2];
    auto hload = [&](int hl_) {
        const int head_ = g * 4 + hl_;
#pragma unroll
        for (int i = 0; i < 2; ++i) { const int it = tid + i * NTHR, ss = it >> 3, pc8 = (it & 7) * 8;
            px[i] = *(const u32x4*)(xc + (tok0 + ss) * 1024 + head_ * 64 + pc8);
            ph[i] = *(const u32x4*)((const bf16_t*)(p.ws() + WS_HIN) + (((size_t)b * 16 + c) * 8 + head_) * 8192 + (size_t)it * 8); }
    };
    hload(0);
    for (int hl = 0; hl < 4; ++hl) {
        const int head = g * 4 + hl;
        __syncthreads();
#pragma unroll
        for (int i = 0; i < 2; ++i) { const int it = tid + i * NTHR, ss = it >> 3, pc8 = (it & 7) * 8;
            *(u32x4*)(Xn + ss * XST1 + pc8) = px[i];
            *(u32x4*)(Hs + (it >> 4) * SST + (it & 15) * 8) = ph[i]; }
        __syncthreads();
        if (hl + 1 < 4) hload(hl + 1);
        u32x2 zpre[4];
#pragma unroll
        for (int pt = 0; pt < 4; ++pt) zpre[pt] = *(const u32x2*)(proj + tok * NPROJ + C_Z + head * 64 + pt * 16 + g4 * 4);
        const float al = acs[hl * 128 + lrow];
#pragma unroll
        for (int st = 0; st < 8; ++st) {
            float mv[4];
            const float4 a4 = *(const float4*)(acs + hl * 128 + st * 16 + g4 * 4), d4 = *(const float4*)(dts + hl * 128 + st * 16 + g4 * 4);
            const float av[4] = {a4.x, a4.y, a4.z, a4.w}, dv[4] = {d4.x, d4.y, d4.z, d4.w};
#pragma unroll
            for (int j = 0; j < 4; ++j) { const int sidx = st * 16 + g4 * 4 + j;
                mv[j] = (sidx <= lrow) ? cb[st][j] * __expf(al - av[j]) * dv[j] : 0.f; }
            u32x2 w; w.x = cvt_pk(mv[0], mv[1]); w.y = cvt_pk(mv[2], mv[3]);
            *(u32x2*)(Mw + r16 * SST + st * 16 + g4 * 4) = w;
        }
        __builtin_amdgcn_wave_barrier();
        asm volatile("s_waitcnt lgkmcnt(0)" ::: "memory");
        f32x4 yd[4], yo[4];
#pragma unroll
        for (int pt = 0; pt < 4; ++pt) { yd[pt] = (f32x4){0.f, 0.f, 0.f, 0.f}; yo[pt] = (f32x4){0.f, 0.f, 0.f, 0.f}; }
#pragma unroll
        for (int kk = 0; kk < 4; ++kk) {
            const bf16x8 mf = *(const bf16x8*)(Mw + r16 * SST + kk * 32 + g4 * 8);
            const bf16_t* xa = Xn + (kk * 32 + 8 * g4 + (r16 >> 2)) * XST1 + 4 * (r16 & 3);
#pragma unroll
            for (int pt = 0; pt < 4; ++pt) {
                const s16x4 lo = tr_read(xa + pt * 16), hi = tr_read(xa + 4 * XST1 + pt * 16);
                bf16x8 xf; xf[0] = lo[0]; xf[1] = lo[1]; xf[2] = lo[2]; xf[3] = lo[3]; xf[4] = hi[0]; xf[5] = hi[1]; xf[6] = hi[2]; xf[7] = hi[3];
                yd[pt] = MFMA16(xf, mf, yd[pt]);
                const bf16x8 hf = *(const bf16x8*)(Hs + (pt * 16 + r16) * SST + kk * 32 + g4 * 8);
                yo[pt] = MFMA16(hf, cfr[kk], yo[pt]);
            }
        }
        __builtin_amdgcn_wave_barrier();
        const float el = __expf(al), Dh = p.in(13)[l * 8 + head];
#pragma unroll
        for (int pt = 0; pt < 4; ++pt) {
            const int pc = pt * 16 + g4 * 4;
            const u32x2 zw = zpre[pt];
            const u32x2 xw = *(const u32x2*)(Xn + lrow * XST1 + pc);
            const float zz[4] = {bflo(zw.x), bfhi(zw.x), bflo(zw.y), bfhi(zw.y)};
            const float xx[4] = {bflo(xw.x), bfhi(xw.x), bflo(xw.y), bfhi(xw.y)};
            float gv[4];
#pragma unroll
            for (int j = 0; j < 4; ++j) { const float yv = yd[pt][j] + el * yo[pt][j] + Dh * xx[j]; gv[j] = yv * silu_f(zz[j]); ssq += gv[j] * gv[j]; }
            u32x2 w; w.x = cvt_pk(gv[0], gv[1]); w.y = cvt_pk(gv[2], gv[3]);
            *(u32x2*)(mix + tok * DM + 512 + head * 64 + pc) = w;
        }
    }
    ssq += __shfl_xor(ssq, 16); ssq += __shfl_xor(ssq, 32);
    if (g4 == 0) ((float*)(p.ws() + WS_SSQ))[tok * 2 + g] = ssq;
}
constexpr int N_FOX = 512, N_S1 = 256, N_DIL = 1536;
DEVI void phase_mix1(const DP& p, int l, char* lds) {
    unsigned char* ws = p.ws();
    kv_gemm(p, lds);
    const bf16_t* proj = (const bf16_t*)(ws + WS_PROJ);
    bf16_t* mix = (bf16_t*)(ws + WS_MIX);
    const int G = gridDim.x, bid = BIDX();
    for (int u = bid; u < N_S1; u += G) { const int g = u & 1, c = (u >> 1) & 15, b = u >> 5; ssd_states_task(p, l, b, c, g, lds); }
    const int nfw = G / 2;
    if (bid < nfw) {
        for (int t = bid; t < 128; t += nfw) {
            const int bh = t & 31, k = t >> 5, b = bh >> 2, h = bh & 3;
            const float* cum = (const float*)(ws + WS_CUMF) + (size_t)bh * S;
#pragma unroll 1
            for (int half = 0; half < 2; ++half) {
                const int qb = half == 0 ? 7 - k : k;
                attn_task<64, 0, 2>(proj + C_FQ + h * 64, NPROJ, b * S, 1, proj + C_FK + h * 64, proj + C_FV + h * 64, NPROJ, b * S, 1,
                                    qb * 256, 0, 4 * qb + 4, 0.125f, cum, nullptr, mix + h * 64, DM, nullptr, nullptr, nullptr, lds);
            }
        }
    } else {
        const int ndw = G - nfw;
        for (int u = bid - nfw; u < 1024; u += ndw) {
            const int bh = u & 31, v = u >> 5, b = bh >> 2, h = bh & 3;
            if (v < 16) {
                const int br = v >> 3, dil = br ? 4 : 1, r = br ? ((v - 8) & 3) : 0, pb = br ? ((v - 8) >> 2) : v;
                float* Of = (float*)(ws + WS_DILO) + (size_t)br * T * 256 + h * 64;
                float* Om = (float*)(ws + WS_DILM) + (size_t)br * T * 4 + h;
                float* Ol = (float*)(ws + WS_DILL) + (size_t)br * T * 4 + h;
                const int klo = pb > 0 ? 4 * pb - 2 : 0;
                attn_task<64, 1, 2>(proj + C_DQ + h * 64, NPROJ, b * S + r, dil, proj + C_DK + h * 64, proj + C_DV + h * 64, NPROJ, b * S + r, dil,
                                    pb * 256, klo, 4 * pb + 4, 0.125f, nullptr, nullptr, nullptr, 0, Of, Om, Ol, lds);
            } else {
                const int r = v - 16;
                float* Of = (float*)(ws + WS_DILO) + (size_t)2 * T * 256 + h * 64;
                float* Om = (float*)(ws + WS_DILM) + (size_t)2 * T * 4 + h;
                float* Ol = (float*)(ws + WS_DILL) + (size_t)2 * T * 4 + h;
                attn_task<64, 1, 1>(proj + C_DQ + h * 64, NPROJ, b * S + r, 16, proj + C_DK + h * 64, proj + C_DV + h * 64, NPROJ, b * S + r, 16,
                                    0, 0, 2, 0.125f, nullptr, nullptr, nullptr, 0, Of, Om, Ol, lds);
            }
        }
    }
}
DEVI void phase_mix3(const DP& p, int l, char* lds) {
    unsigned char* ws = p.ws();
    for (int t = BIDX(); t < NB * 16 * 2; t += gridDim.x) ssd_out_task(p, l, t >> 5, (t >> 1) & 15, t & 1, lds);
    const int tid = TIDX(), wid = tid >> 6, lane = tid & 63, head = lane >> 4, d4 = (lane & 15) * 4;
    const float* Of = (const float*)(ws + WS_DILO);
    const float* Om = (const float*)(ws + WS_DILM);
    const float* Ol = (const float*)(ws + WS_DILL);
    bf16_t* mix = (bf16_t*)(ws + WS_MIX);
    for (int row = BIDX() * 8 + wid; row < T; row += gridDim.x * 8) {
        float m[3], lsum[3];
#pragma unroll
        for (int br = 0; br < 3; ++br) { m[br] = Om[((size_t)br * T + row) * 4 + head]; lsum[br] = Ol[((size_t)br * T + row) * 4 + head]; }
        const float M = fmaxf(m[0], fmaxf(m[1], m[2]));
        f32x4 num = (f32x4){0.f, 0.f, 0.f, 0.f}; float den = 0.f;
#pragma unroll
        for (int br = 0; br < 3; ++br) {
            const float w = __builtin_amdgcn_exp2f(m[br] - M);
            const f32x4 o = *(const f32x4*)(Of + ((size_t)br * T + row) * 256 + head * 64 + d4);
            num += o * w; den += w * lsum[br];
        }
        const float inv = 1.0f / den;
        u32x2 w; w.x = cvt_pk(num[0] * inv, num[1] * inv); w.y = cvt_pk(num[2] * inv, num[3] * inv);
        *(u32x2*)(mix + (size_t)row * DM + 256 + head * 64 + d4) = w;
    }
}
DEVI void phase_xattn(const DP& p, int l, char* lds) {
    unsigned char* ws = p.ws();
    const bf16_t* qbuf = (const bf16_t*)(ws + WS_QBUF);
    const bf16_t* kv = (const bf16_t*)(ws + WS_KV);
    bf16_t* obuf = (bf16_t*)(ws + WS_OBUF);
    for (int t = BIDX(); t < NB * 4 * 16; t += gridDim.x) {
        const int qb = t & 15, h = (t >> 4) & 3, b = t >> 6;
        attn_task<256, 2, 1>(qbuf + h * 256, DM, b * S, 1, kv + h * 256, kv + DM + h * 256, 2 * DM, b * MEMLEN, 1,
                          qb * 128, 0, 4, 0.0625f, nullptr, p.in(20) + l * 256, obuf + h * 256, DM, nullptr, nullptr, nullptr, lds);
    }
}
namespace g8 {
template <bool GATHER_> struct MoeSched {
    static constexpr bool GATHER = GATHER_;
    const int* cnt; const int* list; const char* Abase; const char* Bbase; size_t bstride; int K, G;
    int e, ubase, tbase, u;
    DEVI void init(const int* cnt_, const int* list_, const void* A_, const void* B_, size_t bstride_, int K_, int G_, int c_) {
        cnt = cnt_; list = list_; Abase = (const char*)A_; Bbase = (const char*)B_; bstride = bstride_; K = K_; G = G_; e = 0; ubase = 0; tbase = 0; u = c_; }
    DEVI bool next(UnitU& o) {
        while (e < NEXP) {
            const int ce = cnt[e], nte = (ce + BM - 1) / BM, nun = nte * 4;
            if (u < ubase + nun) {
                const int lu = u - ubase, pm = lu >> 2, pn = lu & 3;
                o.i0 = tbase + pm; o.i1 = pn; o.i2 = e * (2 * T) + pm * BM; o.i3 = ce - pm * BM; o.flags = 3;
                o.A = GATHER ? Abase : Abase + (size_t)(tbase + pm) * BM * K * 2;
                o.B = Bbase + (size_t)e * bstride + (size_t)pn * BM * K * 2;
                u += G; return true;
            }
            ubase += nun; tbase += nte; ++e;
        }
        return false;
    }
    DEVI void lane_va(const UnitU& o, int R0, int C0, int R1, int C1, unsigned& v00, unsigned& v01, unsigned& v10, unsigned& v11) const {
        if (GATHER) {
            const int nv = o.i3; const int* ent = list + o.i2;
            const int t00 = (ent[R0 < nv ? R0 : 0] & 0xffff) >> 1, t01 = (ent[R1 < nv ? R1 : 0] & 0xffff) >> 1, t10 = (ent[R0 + HALF < nv ? R0 + HALF : 0] & 0xffff) >> 1, t11 = (ent[R1 + HALF < nv ? R1 + HALF : 0] & 0xffff) >> 1;
            v00 = (unsigned)(t00 * K + C0) * 2u; v01 = (unsigned)(t01 * K + C1) * 2u; v10 = (unsigned)(t10 * K + C0) * 2u; v11 = (unsigned)(t11 * K + C1) * 2u;
        } else {
            v00 = (unsigned)(R0 * K + C0) * 2u; v01 = (unsigned)(R1 * K + C1) * 2u; v10 = v00 + (unsigned)(HALF * K * 2); v11 = v01 + (unsigned)(HALF * K * 2);
        }
    }
};
struct EpiSwiglu { static constexpr bool PERM = false; bf16_t* act;
    DEVI void mid(f32x4 (&)[2][2][4][2], const UnitU&, int, int, int, int) const {}
    DEVI void operator()(const f32x4 (&acc)[2][2][4][2], const UnitU& u, int wr, int wc, int fr, int fq) const {
        const int nv = u.i3;
#pragma unroll
        for (int ai = 0; ai < 2; ++ai)
#pragma unroll
            for (int m = 0; m < 4; ++m) {
                const int r = ai * HALF + wr * 64 + m * 16 + fr;
                if (r < nv) {
                    bf16_t* rowp = act + (size_t)(u.i0 * BM + r) * EFF + u.i1 * 128 + wc * 16 + 4 * fq;
#pragma unroll
                    for (int bj = 0; bj < 2; ++bj) { const f32x4 x1 = acc[ai][bj][m][0], x3 = acc[ai][bj][m][1];
                        u32x2 w; w.x = cvt_pk(silu_f(x1[0]) * x3[0], silu_f(x1[1]) * x3[1]); w.y = cvt_pk(silu_f(x1[2]) * x3[2], silu_f(x1[3]) * x3[3]);
                        *(u32x2*)(rowp + bj * 64) = w; }
                }
            }
    } };
struct EpiMoeOut { static constexpr bool PERM = true; bf16_t* y; const int* list;
    DEVI void mid(f32x4 (&)[2][2][4][2], const UnitU&, int, int, int, int) const {}
    DEVI void operator()(const f32x4 (&acc)[2][2][4][2], const UnitU& u, int wr, int wc, int fr, int fq) const {
        const int nv = u.i3; const int* ent = list + u.i2;
        unsigned env[2][4];
#pragma unroll
        for (int ai = 0; ai < 2; ++ai)
#pragma unroll
            for (int m = 0; m < 4; ++m) { const int r = ai * HALF + wr * 64 + m * 16 + fr; env[ai][m] = (unsigned)ent[r < nv ? r : 0]; }
#pragma unroll
        for (int ai = 0; ai < 2; ++ai)
#pragma unroll
            for (int m = 0; m < 4; ++m) {
                const int r = ai * HALF + wr * 64 + m * 16 + fr;
                if (r < nv) {
                    const unsigned en = env[ai][m]; const int a = (int)(en & 0xffffu); const float gt = __uint_as_float(en & 0xffff0000u);
                    bf16_t* rowp = y + (size_t)a * DM + u.i1 * BM + wc * 32 + 8 * fq;
#pragma unroll
                    for (int bj = 0; bj < 2; ++bj) { const f32x4 v0 = acc[ai][bj][m][0] * gt, v1 = acc[ai][bj][m][1] * gt;
                        u32x4 w; w.x = cvt_pk(v0[0], v0[1]); w.y = cvt_pk(v0[2], v0[3]); w.z = cvt_pk(v1[0], v1[1]); w.w = cvt_pk(v1[2], v1[3]);
                        *(u32x4*)(rowp + bj * HALF) = w; }
                }
            }
    } };
}
template <int WHICH>
DEVI void phase_moe(const DP& p, int l, char* lds) {
    unsigned char* ws = p.ws();
    const int* cnt = (const int*)(ws + WS_CNT) + l * 64;
    const int* list = (const int*)(ws + WS_LIST);
    if (WHICH == 0) {
        g8::MoeSched<true> S;
        S.init(cnt, list, ws + WS_H3, ws + WS_W_13, (size_t)1024 * DM * 2, DM, gridDim.x, BIDX());
        g8::EpiSwiglu E{(bf16_t*)(ws + WS_ACT)};
        g8::gemm8(lds, DM, DM, S, E);
    } else {
        g8::MoeSched<false> S;
        S.init(cnt, list, ws + WS_ACT, ws + WS_W_2, (size_t)DM * EFF * 2, EFF, gridDim.x, BIDX());
        g8::EpiMoeOut E{(bf16_t*)(ws + WS_YBUF), list};
        g8::gemm8(lds, EFF, EFF, S, E);
    }
}
DEVI void phase_final(const DP& p) {
    const int tid = TIDX(), wid = tid >> 6, lane = tid & 63;
    const bf16_t* ybuf = (const bf16_t*)(p.ws() + WS_YBUF);
    const bf16_t* h0 = (const bf16_t*)(p.ws() + WS_HBUF);
    float* out = p.out();
    for (int row = BIDX() * 8 + wid; row < T; row += gridDim.x * 8) {
        float x[16];
        load_row_bf16(h0 + (size_t)row * DM, x, lane);
        add_row_bf16_b(ybuf + (size_t)(2 * row) * DM, x, lane);
        add_row_bf16_b(ybuf + (size_t)(2 * row + 1) * DM, x, lane);
#pragma unroll
        for (int j = 0; j < 2; ++j) {
            *(float4*)(out + (size_t)row * DM + j * 512 + lane * 8) = make_float4(x[8 * j], x[8 * j + 1], x[8 * j + 2], x[8 * j + 3]);
            *(float4*)(out + (size_t)row * DM + j * 512 + lane * 8 + 4) = make_float4(x[8 * j + 4], x[8 * j + 5], x[8 * j + 6], x[8 * j + 7]);
        }
    }
}

#define XB_TMO      128
#define XB_XCNT(j)  (256  + 64 * (j))
#define XB_XSUB(j)  (1280 + 64 * (j))
#define XB_XGEN(j)  (2304 + 64 * (j))
#define XB_TOP      3328
#define XB_TOPGEN   3392
#define XCD_BAR_WORDS 3456
#define XB_SPIN_CAP (1u << 22)
DEVI unsigned xb_ld(unsigned* p)              { return __hip_atomic_load(p, __ATOMIC_RELAXED, __HIP_MEMORY_SCOPE_AGENT); }
DEVI unsigned xb_add(unsigned* p, unsigned v) { return __hip_atomic_fetch_add(p, v, __ATOMIC_RELAXED, __HIP_MEMORY_SCOPE_AGENT); }
DEVI unsigned xb_xcc_id() { return (unsigned)__builtin_amdgcn_s_getreg((3 << 11) | 20) & 0xFu; }
#define XB_SPIN(cond, bar) do { unsigned _sp = 0; while (cond) { __builtin_amdgcn_s_sleep(1); \
    if ((++_sp & 255u) == 0u) { if (xb_ld(&(bar)[XB_TMO])) break; if (_sp > XB_SPIN_CAP) { atomicAdd(&(bar)[XB_TMO], 1u); break; } } } } while (0)
struct XcdBarrier { unsigned* bar; unsigned x; volatile LAS unsigned* st; };
DEVI XcdBarrier xcd_barrier_post(unsigned* bar, volatile LAS unsigned* st) {
    XcdBarrier b; b.bar = bar; b.x = xb_xcc_id(); b.st = st;
    if (threadIdx.x == 0) (void)xb_add(&bar[XB_XCNT(b.x)], 1u);
    return b;
}
DEVI void xcd_barrier_complete(unsigned* bar, unsigned x, unsigned& nloc, unsigned& nx) {
    const unsigned G = gridDim.x * gridDim.y * gridDim.z;
    unsigned sum, cnt, mine, sp = 0u;
    for (;;) {
        sum = 0u; cnt = 0u; mine = 0u;
#pragma unroll
        for (unsigned j = 0; j < 16; ++j) { const unsigned c = xb_ld(&bar[XB_XCNT(j)]); sum += c; cnt += (c > 0u) ? 1u : 0u; mine = (j == x) ? c : mine; }
        if (sum == G) break;
        __builtin_amdgcn_s_sleep(1);
        if ((++sp & 255u) == 0u) { if (xb_ld(&bar[XB_TMO])) break; if (sp > XB_SPIN_CAP) { atomicAdd(&bar[XB_TMO], 1u); break; } }
    }
    nloc = mine > 0u ? mine : 1u; nx = cnt > 0u ? cnt : 1u;
}
DEVI void xcd_barrier(const XcdBarrier& b) {
    asm volatile("s_waitcnt vmcnt(0)" ::: "memory");
    __syncthreads();
    if (threadIdx.x == 0) {
        unsigned* bar = b.bar;
        __builtin_amdgcn_s_waitcnt(0);
        unsigned nloc = b.st[0], nx = b.st[1];
        if (nloc == 0u) { xcd_barrier_complete(bar, b.x, nloc, nx); b.st[0] = nloc; b.st[1] = nx; }
        const unsigned old = xb_add(&bar[XB_XSUB(b.x)], 1u);
        const unsigned gen = old / nloc;
        if (old + 1u == (gen + 1u) * nloc) {
            __builtin_amdgcn_fence(__ATOMIC_RELEASE, "agent");
            asm volatile("s_waitcnt vmcnt(0)" ::: "memory");
            const unsigned og = xb_add(&bar[XB_TOP], 1u);
            const unsigned tg = og / nx;
            if (og + 1u == (tg + 1u) * nx) xb_add(&bar[XB_TOPGEN], 1u);
            else XB_SPIN(xb_ld(&bar[XB_TOPGEN]) == tg, bar);
            __builtin_amdgcn_fence(__ATOMIC_ACQUIRE, "agent");
            xb_add(&bar[XB_XGEN(b.x)], 1u);
            asm volatile("s_waitcnt vmcnt(0)" ::: "memory");
        } else {
            XB_SPIN(xb_ld(&bar[XB_XGEN(b.x)]) == gen, bar);
            __builtin_amdgcn_fence(__ATOMIC_ACQUIRE, "agent");
            asm volatile("s_waitcnt vmcnt(0)" ::: "memory");
        }
    }
    __syncthreads();
}

constexpr int N_PHASES = 27;
__global__ void __launch_bounds__(NTHR) hybrid_fwd(Params p_unused) {
    extern __shared__ __attribute__((aligned(16))) char lds_base[];
    karg_ptr kp = (karg_ptr)__builtin_amdgcn_kernarg_segment_ptr();
    int ph_lo, ph_hi, use_gs;
    { DP q{kp}; ph_lo = q.ph_lo(); ph_hi = q.ph_hi(); use_gs = q.use_gs(); }
    volatile LAS unsigned* xst = (volatile LAS unsigned*)(LAS char*)(lds_base + LDS_BYTES - 16);
    if (threadIdx.x == 0) { xst[0] = 0u; xst[1] = 0u; }
    __syncthreads();
    XcdBarrier xb; xb.bar = nullptr; xb.x = 0; xb.st = xst;
    if (use_gs == 1) { DP q{kp}; xb = xcd_barrier_post((unsigned*)(q.ws() + WS_BAR), xst); }
#define RUN_PHASE(PH, ...) \
    if (ph_lo <= (PH) && (PH) < ph_hi) { \
        if ((PH) > ph_lo) { if (use_gs == 1) xcd_barrier(xb); else if (use_gs == 2) cg::this_grid().sync(); } \
        asm volatile("" : "+s"(kp) :: "memory"); \
        const DP p{kp}; \
        unsigned lds_off = 0; asm volatile("" : "+s"(lds_off)); \
        char* lds = lds_base + lds_off; \
        unsigned char* ws = p.ws(); (void)ws; (void)lds; \
        __VA_ARGS__ \
    }
#define LAYER_PHASES(L, B0) \
    RUN_PHASE((B0) + 0, { if ((L) == 0) prep_small(p); prep_all(p, (L), lds); __syncthreads(); phase_norm1(p, (L), lds); }) \
    RUN_PHASE((B0) + 1, { phase_inproj(p, (L), lds); }) \
    RUN_PHASE((B0) + 2, { for (int t = (int)gridDim.x - 1 - BIDX(); t < 32; t += gridDim.x) cumsum_task(p, t, lds); phase_post(p, (L)); }) \
    RUN_PHASE((B0) + 3, { phase_mix1(p, (L), lds); }) \
    RUN_PHASE((B0) + 4, { phase_ssd_scan(p); phase_knorm(p, (L)); }) \
    RUN_PHASE((B0) + 5, { phase_mix3(p, (L), lds); }) \
    RUN_PHASE((B0) + 6, { g8::DenseSched2 S; S.init((const bf16_t*)(ws + WS_MIX), (const bf16_t*)(ws + WS_W_OUT), T, DM, DM, gridDim.x, BIDX()); \
                          g8::EpiResScale E{{(const bf16_t*)(ws + WS_HBUF), (bf16_t*)(ws + WS_H1), DM}, (const float*)(ws + WS_SSQ)}; g8::gemm8(lds, DM, DM / 2, S, E); }) \
    RUN_PHASE((B0) + 7, { g8::DenseSched S; S.init((const bf16_t*)(ws + WS_H1), (const bf16_t*)(ws + WS_W_Q), T, DM, DM, gridDim.x, BIDX()); \
                          g8::EpiBf16 E{(bf16_t*)(ws + WS_QBUF), DM}; g8::gemm8(lds, DM, DM, S, E); }) \
    RUN_PHASE((B0) + 8, { phase_xattn(p, (L), lds); }) \
    RUN_PHASE((B0) + 9, { g8::DenseSched S; S.init((const bf16_t*)(ws + WS_OBUF), (const bf16_t*)(ws + WS_W_O), T, DM, DM, gridDim.x, BIDX()); \
                          g8::EpiResBf E{(const bf16_t*)(ws + WS_H1), (bf16_t*)(ws + WS_HBUF), DM}; g8::gemm8(lds, DM, DM, S, E); }) \
    RUN_PHASE((B0) + 10, { phase_norm3(p, (L), lds); }) \
    RUN_PHASE((B0) + 11, { phase_moe<0>(p, (L), lds); }) \
    RUN_PHASE((B0) + 12, { phase_moe<1>(p, (L), lds); })

    LAYER_PHASES(0, 0)
    LAYER_PHASES(1, 13)
    RUN_PHASE(26, { phase_final(p); })
#undef LAYER_PHASES
#undef RUN_PHASE
}

extern "C" void kernel_launch(void* const* d_in, const int* in_sizes, int n_in, void* d_out, int out_size, void* d_ws, size_t ws_size, hipStream_t stream) {
    static int grid = 0;
    if (grid == 0) {
        if (n_in != 31 || out_size != T * DM || ws_size < WS_END) { fprintf(stderr, "kernel_launch: unexpected shapes (n_in %d out %d ws %zu need %zu)\n", n_in, out_size, ws_size, (size_t)WS_END); grid = -1; return; }
        int dev = 0, cus = 0, per_cu = 0;
        hipGetDevice(&dev);
        hipDeviceGetAttribute(&cus, hipDeviceAttributeMultiprocessorCount, dev);
        hipFuncSetAttribute((const void*)hybrid_fwd, hipFuncAttributeMaxDynamicSharedMemorySize, LDS_BYTES);
        hipOccupancyMaxActiveBlocksPerMultiprocessor(&per_cu, (const void*)hybrid_fwd, NTHR, LDS_BYTES);
        if (per_cu < 1) { fprintf(stderr, "kernel_launch: occupancy query says %d blocks per CU\n", per_cu); per_cu = 1; }
        (void)hipGetLastError();
        grid = cus;
    }
    if (grid < 0) return;
    Params p{};
    for (int i = 0; i < 31; ++i) p.in[i] = (const float*)d_in[i];
    p.out = (float*)d_out; p.ws = (unsigned char*)d_ws;
    p.use_grid_sync = 1; p.pad = 0;
    p.ph_lo = 0; p.ph_hi = N_PHASES;
    if (hipMemsetAsync((unsigned char*)d_ws + WS_BAR, 0, XCD_BAR_WORDS * 4, stream) != hipSuccess) { fprintf(stderr, "kernel_launch: memset failed\n"); return; }
    void* args[] = {&p};
    hipError_t e = hipLaunchCooperativeKernel((const void*)hybrid_fwd, dim3(grid), dim3(NTHR), args, LDS_BYTES, stream);
    if (e != hipSuccess) fprintf(stderr, "kernel_launch: cooperative launch failed: %s (grid %d)\n", hipGetErrorString(e), grid);
}
```

```cpp
#include <hip/hip_runtime.h>
#include <hip/hip_cooperative_groups.h>
#include <cstdio>
#include <cstdint>
namespace cg = cooperative_groups;

typedef unsigned short bf16_t;
typedef short bf16x8 __attribute__((ext_vector_type(8)));
typedef short s16x4 __attribute__((ext_vector_type(4)));
typedef float f32x4 __attribute__((ext_vector_type(4)));
typedef unsigned u32x4 __attribute__((ext_vector_type(4)));
typedef unsigned u32x2 __attribute__((ext_vector_type(2)));
#define DEVI __device__ __forceinline__
#define LAS __attribute__((address_space(3)))

constexpr int NB = 8, S = 2048, DM = 1024, T = NB * S, DEPTH = 2;
constexpr int INP = 3084, NPROJ = 3072;
constexpr int C_FQ = 0, C_FK = 256, C_FV = 512, C_DQ = 768, C_DK = 1024, C_DV = 1280, C_Z = 1536, C_XBC = 2048;
constexpr int MEMLEN = 256, MROWS = NB * MEMLEN;
constexpr int NEXP = 32, EFF = 512;
constexpr float EPS = 1e-6f;
constexpr int NTHR = 512;
constexpr int LDS_BYTES = 151552;

constexpr size_t al256(size_t x) { return (x + 255) & ~(size_t)255; }
constexpr size_t WS_W_IN = 0;
constexpr size_t WS_W_OUT = WS_W_IN + (size_t)NPROJ * DM * 2;
constexpr size_t WS_W_Q = WS_W_OUT + (size_t)DM * DM * 2;
constexpr size_t WS_W_KV = WS_W_Q + (size_t)DM * DM * 2;
constexpr size_t WS_W_O = WS_W_KV + (size_t)2 * DM * DM * 2;
constexpr size_t WS_W_13 = WS_W_O + (size_t)DM * DM * 2;
constexpr size_t WS_W_2 = WS_W_13 + (size_t)NEXP * 1024 * DM * 2;
constexpr size_t WS_WSMALL = WS_W_2 + (size_t)NEXP * DM * EFF * 2;
constexpr size_t WS_WROUT = WS_WSMALL + (size_t)DEPTH * 12 * DM * 4;
constexpr size_t WS_XB = WS_WROUT + (size_t)DEPTH * 36 * DM * 4;
constexpr size_t WS_H1 = WS_XB;
constexpr size_t WS_H3 = WS_XB + (size_t)T * DM * 2;
constexpr size_t WS_HBUF = WS_XB + (size_t)T * DM * 4;
constexpr size_t WS_PROJ = WS_HBUF + (size_t)T * DM * 2;
constexpr size_t WS_QBUF = WS_PROJ;
constexpr size_t WS_OBUF = WS_PROJ + (size_t)T * DM * 2;
constexpr size_t WS_ACT = WS_PROJ;
constexpr size_t WS_MIX = WS_PROJ + (size_t)T * NPROJ * 2;
constexpr size_t WS_U = WS_MIX + (size_t)T * DM * 2;
constexpr size_t WS_YBUF = WS_U;
constexpr size_t WS_DILO = WS_U;
constexpr size_t WS_DILM = WS_DILO + (size_t)3 * T * 256 * 4;
constexpr size_t WS_DILL = WS_DILM + (size_t)3 * T * 4 * 4;
constexpr size_t WS_SSTATE = WS_DILL + (size_t)3 * T * 4 * 4;
constexpr size_t WS_HIN = WS_SSTATE + (size_t)NB * 16 * 8 * 8192 * 4;
constexpr size_t WS_GBUF = WS_HIN + (size_t)NB * 16 * 8 * 8192 * 2;
constexpr size_t WS_U_END = WS_GBUF + (size_t)T * 512 * 4;
constexpr size_t WS_MEMN = WS_U_END;
constexpr size_t WS_KV = WS_MEMN + (size_t)MROWS * DM * 2;
constexpr size_t WS_LOGF = WS_KV + (size_t)MROWS * 2 * DM * 2;
constexpr size_t WS_CUMF = WS_LOGF + (size_t)T * 4 * 4;
constexpr size_t WS_DTV = WS_CUMF + (size_t)T * 4 * 4;
constexpr size_t WS_DECAY = WS_DTV + (size_t)T * 8 * 4;
constexpr size_t WS_CNT = WS_DECAY + (size_t)NB * 16 * 8 * 4;
constexpr size_t WS_LIST = WS_CNT + 1024;
constexpr size_t WS_GATE = WS_LIST + (size_t)NEXP * 2 * T * 4;
constexpr size_t WS_BAR = WS_GATE + (size_t)2 * T * 4;
constexpr size_t WS_XC = WS_BAR + 65536;
constexpr size_t WS_SSQ = WS_XC + (size_t)T * 1024 * 2;
constexpr size_t WS_RSTD1 = WS_SSQ + (size_t)T * 2 * 4;
constexpr size_t WS_RSTD3 = WS_RSTD1 + (size_t)T * 4;
constexpr size_t WS_END = WS_RSTD3 + (size_t)T * 4;
static_assert(WS_YBUF + (size_t)2 * T * DM * 2 <= WS_U_END, "ybuf alias");
static_assert(WS_OBUF + (size_t)T * DM * 2 <= WS_MIX, "obuf alias");

struct Params {
    const float* in[31];
    float* out;
    unsigned char* ws;
    int ph_lo, ph_hi;
    int use_grid_sync, pad;
};


typedef __attribute__((address_space(4))) const unsigned long long* karg_ptr;
typedef __attribute__((address_space(1))) const float* gcf_ptr;
typedef __attribute__((address_space(1))) float* gf_ptr;
typedef __attribute__((address_space(1))) unsigned char* gb_ptr;
struct DP {
    karg_ptr kp;
    DEVI const float* in(int i) const { return (const float*)(gcf_ptr)(kp[i]); }
    DEVI float* out() const { return (float*)(gf_ptr)(kp[31]); }
    DEVI unsigned char* ws() const { return (unsigned char*)(gb_ptr)(kp[32]); }
    DEVI int ph_lo() const { return (int)(unsigned)kp[33]; }
    DEVI int ph_hi() const { return (int)(unsigned)(kp[33] >> 32); }
    DEVI int use_gs() const { return (int)(unsigned)kp[34]; }
};

DEVI int TIDX() { int t = threadIdx.x; asm volatile("" : "+v"(t)); return t; }
DEVI int BIDX() { int b = blockIdx.x; asm volatile("" : "+s"(b)); return b; }
DEVI float bf2f(bf16_t v) { return __uint_as_float(((unsigned)v) << 16); }
typedef float f32x2 __attribute__((ext_vector_type(2)));
typedef __bf16 bf16x2_t __attribute__((ext_vector_type(2)));
DEVI unsigned cvt_pk(float lo, float hi) { f32x2 v = {lo, hi}; bf16x2_t b = __builtin_convertvector(v, bf16x2_t); return __builtin_bit_cast(unsigned, b); }
DEVI bf16_t f2bf(float f) { return (bf16_t)(cvt_pk(f, 0.f) & 0xffffu); }
DEVI float bflo(unsigned w) { return __uint_as_float(w << 16); }
DEVI float bfhi(unsigned w) { return __uint_as_float(w & 0xffff0000u); }
DEVI float wave_sum(float v) {
#pragma unroll
    for (int m = 32; m >= 1; m >>= 1) v += __shfl_xor(v, m);
    return v;
}
template <int CTRL> DEVI float dpp_mov(float v) { return __uint_as_float(__builtin_amdgcn_update_dpp(0u, __float_as_uint(v), CTRL, 0xf, 0xf, false)); }
DEVI float wave_sum_fast(float v) {
    v += dpp_mov<0xB1>(v);
    v += dpp_mov<0x4E>(v);
    v += dpp_mov<0x124>(v);
    v += dpp_mov<0x128>(v);
    const int iv = __float_as_int(v);
    return (__int_as_float(__builtin_amdgcn_readlane(iv, 0)) + __int_as_float(__builtin_amdgcn_readlane(iv, 16))) + (__int_as_float(__builtin_amdgcn_readlane(iv, 32)) + __int_as_float(__builtin_amdgcn_readlane(iv, 48)));
}
DEVI float silu_f(float x) { return x * __builtin_amdgcn_rcpf(1.f + __expf(-x)); }
DEVI float softplus_f(float x) { return x > 20.f ? x : log1pf(__expf(x)); }
DEVI float logsigmoid_f(float x) { return x >= 0.f ? -log1pf(__expf(-x)) : x - log1pf(__expf(x)); }
#define MFMA16(a, b, c) __builtin_amdgcn_mfma_f32_16x16x32_bf16(a, b, c, 0, 0, 0)
DEVI s16x4 tr_read(const bf16_t* p) {
    return __builtin_bit_cast(s16x4, __builtin_amdgcn_ds_read_tr16_b64_v4i16((LAS s16x4*)p));
}

DEVI int maprow(int mode, int n) { return mode == 0 ? n : ((n >> 4) * 32 + (n & 15) + (mode == 2 ? 16 : 0)); }
struct PrepD { const float* src; int ld, k0, c0; bf16_t* dst; int dstld, mode, n0; const float* ks; int ksf; };
DEVI void prep_ld(const PrepD& d, float4 (&v)[2], float (&sc)[2], int tid) {
#pragma unroll
    for (int i = 0; i < 2; ++i) {
        const int k = (tid >> 4) + 32 * i, n4 = (tid & 15) * 4;
        v[i] = *(const float4*)(d.src + (size_t)(d.k0 + k) * d.ld + d.c0 + n4);
        sc[i] = (d.ks != nullptr && (d.k0 + k) >= d.ksf) ? d.ks[d.k0 + k - d.ksf] : 1.f;
    }
}
DEVI void prep_tl(const float4 (&v)[2], const float (&sc)[2], float* tl, int tid) {
#pragma unroll
    for (int i = 0; i < 2; ++i) {
        const int k = (tid >> 4) + 32 * i, n4 = (tid & 15) * 4;
        tl[k * 65 + n4 + 0] = v[i].x * sc[i]; tl[k * 65 + n4 + 1] = v[i].y * sc[i]; tl[k * 65 + n4 + 2] = v[i].z * sc[i]; tl[k * 65 + n4 + 3] = v[i].w * sc[i];
    }
}
DEVI void prep_st(const PrepD& d, const float* tl, int tid) {
    const int n = tid >> 3, kc = (tid & 7) * 8;
    u32x4 w;
    w.x = cvt_pk(tl[(kc + 0) * 65 + n], tl[(kc + 1) * 65 + n]);
    w.y = cvt_pk(tl[(kc + 2) * 65 + n], tl[(kc + 3) * 65 + n]);
    w.z = cvt_pk(tl[(kc + 4) * 65 + n], tl[(kc + 5) * 65 + n]);
    w.w = cvt_pk(tl[(kc + 6) * 65 + n], tl[(kc + 7) * 65 + n]);
    const int drow = maprow(d.mode, d.n0 + n);
    *(u32x4*)(d.dst + (size_t)drow * d.dstld + d.k0 + kc) = w;
}

constexpr int PREP_UNITS = 2048 + 3 * 4096;
DEVI PrepD prep_decode(const DP& p, int l, int u) {
    unsigned char* ws = p.ws();
    PrepD d;
    if (u < 768) {
        const int kt = u / 48, nt = u % 48, n0 = nt * 64, c0 = n0 < 768 ? n0 : n0 + 4;
        d = PrepD{p.in(3) + (size_t)l * DM * INP, INP, kt * 64, c0, (bf16_t*)(ws + WS_W_IN), DM, 0, n0, p.in(2) + l * DM, 0};
    } else if (u < 1024) {
        const int v = u - 768, kt = v / 16, nt = v % 16;
        d = PrepD{p.in(15) + (size_t)l * DM * DM, DM, kt * 64, nt * 64, (bf16_t*)(ws + WS_W_OUT), DM, 0, nt * 64, p.in(14) + l * 512, 512};
    } else if (u < 1280) {
        const int v = u - 1024, kt = v / 16, nt = v % 16;
        d = PrepD{p.in(18) + (size_t)l * DM * DM, DM, kt * 64, nt * 64, (bf16_t*)(ws + WS_W_Q), DM, 0, nt * 64, p.in(16) + l * DM, 0};
    } else if (u < 1792) {
        const int v = u - 1280, kt = v / 32, nt = v % 32;
        d = PrepD{p.in(19) + (size_t)l * DM * 2 * DM, 2 * DM, kt * 64, nt * 64, (bf16_t*)(ws + WS_W_KV), DM, 0, nt * 64, nullptr, 0};
    } else if (u < 2048) {
        const int v = u - 1792, kt = v / 16, nt = v % 16;
        d = PrepD{p.in(22) + (size_t)l * DM * DM, DM, kt * 64, nt * 64, (bf16_t*)(ws + WS_W_O), DM, 0, nt * 64, nullptr, 0};
    } else if (u < 2048 + 8192) {
        const int v = u - 2048, which = v / 4096, w = v % 4096, e = w / 128, tI = w % 128, kt = tI / 8, nt = tI % 8;
        const float* src = (which == 0 ? p.in(28) : p.in(29)) + ((size_t)l * NEXP + e) * DM * EFF;
        d = PrepD{src, EFF, kt * 64, nt * 64, (bf16_t*)(ws + WS_W_13) + (size_t)e * 1024 * DM, DM, which == 0 ? 1 : 2, nt * 64, p.in(23) + l * DM, 0};
    } else {
        const int w = u - 2048 - 8192, e = w / 128, tI = w % 128, kt = tI / 16, nt = tI % 16;
        const float* src = p.in(30) + ((size_t)l * NEXP + e) * EFF * DM;
        d = PrepD{src, DM, kt * 64, nt * 64, (bf16_t*)(ws + WS_W_2) + (size_t)e * DM * EFF, EFF, 0, nt * 64, nullptr, 0};
    }
    return d;
}
DEVI void prep_all(const DP& p, int l, char* lds) {
    const int tid = TIDX(), G = gridDim.x;
    float* tl = (float*)lds;
    constexpr int NT = 4, TLS = 64 * 65;
    for (int u0 = BIDX(); u0 < PREP_UNITS; u0 += NT * G) {
        PrepD d[NT]; float4 v[NT][2]; float sc[NT][2];
#pragma unroll
        for (int i = 0; i < NT; ++i) { const int u = u0 + i * G; d[i] = prep_decode(p, l, u < PREP_UNITS ? u : u0); prep_ld(d[i], v[i], sc[i], tid); }
#pragma unroll
        for (int i = 0; i < NT; ++i) prep_tl(v[i], sc[i], tl + i * TLS, tid);
        __syncthreads();
#pragma unroll
        for (int i = 0; i < NT; ++i) if (u0 + i * G < PREP_UNITS) prep_st(d[i], tl + i * TLS, tid);
        __syncthreads();
    }
}
DEVI void prep_small(const DP& p) {
    float* wsm = (float*)(p.ws() + WS_WSMALL);
    float* wro = (float*)(p.ws() + WS_WROUT);
    const int gtid = BIDX() * NTHR + TIDX(), gn = gridDim.x * NTHR;
    for (int i = gtid; i < DEPTH * 12 * DM; i += gn) {
        const int l = i / (12 * DM), r = i % (12 * DM), c = r / DM, k = r % DM;
        const int col = c < 4 ? 768 + c : 3076 + (c - 4);
        wsm[i] = p.in(3)[((size_t)l * DM + k) * INP + col] * p.in(2)[l * DM + k];
    }
    for (int i = gtid; i < DEPTH * 36 * DM; i += gn) {
        const int l = i / (36 * DM), r = i % (36 * DM), c = r / DM, k = r % DM;
        wro[i] = (c < 4 ? p.in(24)[((size_t)l * DM + k) * 4 + c] : p.in(26)[((size_t)l * DM + k) * 32 + (c - 4)]) * p.in(23)[l * DM + k];
    }
    if (BIDX() == 0 && TIDX() < 128) ((int*)(p.ws() + WS_CNT))[TIDX()] = 0;
}

DEVI void store_h_bf16(bf16_t* hrow, const float (&h)[16], int lane) {
#pragma unroll
    for (int j = 0; j < 4; ++j) {
        u32x2 w; w.x = cvt_pk(h[4 * j], h[4 * j + 1]); w.y = cvt_pk(h[4 * j + 2], h[4 * j + 3]);
        *(u32x2*)(hrow + j * 256 + lane * 4) = w;
    }
}
DEVI void load_row_f32(const float* xr, float (&x)[16], int lane) {
#pragma unroll
    for (int j = 0; j < 4; ++j) { const float4 v = *(const float4*)(xr + j * 256 + lane * 4); x[4 * j] = v.x; x[4 * j + 1] = v.y; x[4 * j + 2] = v.z; x[4 * j + 3] = v.w; }
}
DEVI void add_row_bf16(const bf16_t* yr, float (&x)[16], int lane) {
#pragma unroll
    for (int j = 0; j < 4; ++j) { const u32x2 w = *(const u32x2*)(yr + j * 256 + lane * 4); x[4 * j] += bflo(w.x); x[4 * j + 1] += bfhi(w.x); x[4 * j + 2] += bflo(w.y); x[4 * j + 3] += bfhi(w.y); }
}
DEVI void store_row_f32(float* xr, const float (&x)[16], int lane) {
#pragma unroll
    for (int j = 0; j < 4; ++j) *(float4*)(xr + j * 256 + lane * 4) = make_float4(x[4 * j], x[4 * j + 1], x[4 * j + 2], x[4 * j + 3]);
}
DEVI void norm_row(const float (&x)[16], const float* g, float (&h)[16], int lane) {
    float ss = 0.f;
#pragma unroll
    for (int i = 0; i < 16; ++i) ss += x[i] * x[i];
    ss = wave_sum(ss);
    const float rstd = rsqrtf(ss * (1.0f / DM) + EPS);
#pragma unroll
    for (int j = 0; j < 4; ++j) { const float4 gv = *(const float4*)(g + j * 256 + lane * 4);
        h[4 * j] = x[4 * j] * rstd * gv.x; h[4 * j + 1] = x[4 * j + 1] * rstd * gv.y; h[4 * j + 2] = x[4 * j + 2] * rstd * gv.z; h[4 * j + 3] = x[4 * j + 3] * rstd * gv.w; }
}
DEVI float dot_lds(const float (&h)[16], const float* wrow, int lane) {
    f32x2 a0 = {0.f, 0.f}, a1 = {0.f, 0.f};
#pragma unroll
    for (int j = 0; j < 4; ++j) { const f32x4 w = *(const f32x4*)(wrow + j * 256 + lane * 4);
        a0 += (f32x2){h[4 * j], h[4 * j + 1]} * (f32x2){w[0], w[1]}; a1 += (f32x2){h[4 * j + 2], h[4 * j + 3]} * (f32x2){w[2], w[3]}; }
    a0 += a1;
    return a0[0] + a0[1];
}

DEVI void load_row_bf16(const bf16_t* xr, float (&x)[16], int lane) {
#pragma unroll
    for (int j = 0; j < 2; ++j) { const u32x4 w = *(const u32x4*)(xr + j * 512 + lane * 8);
        x[8 * j] = bflo(w.x); x[8 * j + 1] = bfhi(w.x); x[8 * j + 2] = bflo(w.y); x[8 * j + 3] = bfhi(w.y); x[8 * j + 4] = bflo(w.z); x[8 * j + 5] = bfhi(w.z); x[8 * j + 6] = bflo(w.w); x[8 * j + 7] = bfhi(w.w); }
}
DEVI void add_row_bf16_b(const bf16_t* yr, float (&x)[16], int lane) {
#pragma unroll
    for (int j = 0; j < 2; ++j) { const u32x4 w = *(const u32x4*)(yr + j * 512 + lane * 8);
        x[8 * j] += bflo(w.x); x[8 * j + 1] += bfhi(w.x); x[8 * j + 2] += bflo(w.y); x[8 * j + 3] += bfhi(w.y); x[8 * j + 4] += bflo(w.z); x[8 * j + 5] += bfhi(w.z); x[8 * j + 6] += bflo(w.w); x[8 * j + 7] += bfhi(w.w); }
}
DEVI void store_row_bf16_b(bf16_t* hr, const float (&h)[16], int lane) {
#pragma unroll
    for (int j = 0; j < 2; ++j) { u32x4 w; w.x = cvt_pk(h[8 * j], h[8 * j + 1]); w.y = cvt_pk(h[8 * j + 2], h[8 * j + 3]); w.z = cvt_pk(h[8 * j + 4], h[8 * j + 5]); w.w = cvt_pk(h[8 * j + 6], h[8 * j + 7]);
        *(u32x4*)(hr + j * 512 + lane * 8) = w; }
}
DEVI float dot_lds_b(const float (&h)[16], const float* wrow, int lane) {
    f32x2 a0 = {0.f, 0.f}, a1 = {0.f, 0.f};
#pragma unroll
    for (int j = 0; j < 2; ++j) { const f32x4 w0 = *(const f32x4*)(wrow + j * 512 + lane * 8), w1 = *(const f32x4*)(wrow + j * 512 + lane * 8 + 4);
        a0 += (f32x2){h[8 * j], h[8 * j + 1]} * (f32x2){w0[0], w0[1]}; a1 += (f32x2){h[8 * j + 2], h[8 * j + 3]} * (f32x2){w0[2], w0[3]};
        a0 += (f32x2){h[8 * j + 4], h[8 * j + 5]} * (f32x2){w1[0], w1[1]}; a1 += (f32x2){h[8 * j + 6], h[8 * j + 7]} * (f32x2){w1[2], w1[3]}; }
    a0 += a1;
    return a0[0] + a0[1];
}
#define MFMA_F32(a, b, c) __builtin_amdgcn_mfma_f32_16x16x4f32(a, b, c, 0, 0, 0)
template <int L>
DEVI void load_row_pre(const float* xin, const bf16_t* h0, const bf16_t* ybuf, int row, int lane, float (&x)[16]) {
    if (L == 0) load_row_f32(xin + (size_t)row * DM, x, lane);
    else { load_row_bf16(h0 + (size_t)row * DM, x, lane); add_row_bf16_b(ybuf + (size_t)(2 * row) * DM, x, lane); add_row_bf16_b(ybuf + (size_t)(2 * row + 1) * DM, x, lane); }
}
template <int L>
DEVI void norm1_rows(const DP& p, char* lds) {
    const int tid = TIDX(), wid = tid >> 6, lane = tid & 63;
    unsigned char* ws = p.ws();
    const float* wsl = (const float*)lds;
    const float* xin = p.in(0);
    const bf16_t* ybuf = (const bf16_t*)(ws + WS_YBUF);
    bf16_t* hbuf = (bf16_t*)(ws + WS_HBUF);
    float* logf = (float*)(ws + WS_LOGF);
    float* dtv = (float*)(ws + WS_DTV);
    float* rstd1 = (float*)(ws + WS_RSTD1);
    const int stride = gridDim.x * 8;
    int row = BIDX() * 8 + wid;
    float xn[16];
    if (row < T) load_row_pre<L>(xin, hbuf, ybuf, row, lane, xn);
    for (; row < T; row += stride) {
        float x[16];
#pragma unroll
        for (int i = 0; i < 16; ++i) x[i] = xn[i];
        if (row + stride < T) load_row_pre<L>(xin, hbuf, ybuf, row + stride, lane, xn);
        if (L == 0) store_h_bf16(hbuf + (size_t)row * DM, x, lane); else store_row_bf16_b(hbuf + (size_t)row * DM, x, lane);
        float ss = 0.f;
#pragma unroll
        for (int i = 0; i < 16; ++i) ss += x[i] * x[i];
        const float rstd = rsqrtf(wave_sum_fast(ss) * (1.0f / DM) + EPS);
        float keep = 0.f;
#pragma unroll
        for (int c = 0; c < 12; ++c) { const float v = wave_sum_fast(L == 0 ? dot_lds(x, wsl + c * DM, lane) : dot_lds_b(x, wsl + c * DM, lane)); keep = (lane == c) ? v : keep; if (c & 1) __builtin_amdgcn_sched_barrier(0); }
        keep *= rstd;
        if (lane == 0) rstd1[row] = rstd;
        {
            const float bias = lane < 4 ? p.in(4)[L * 4 + (lane & 3)] : p.in(11)[L * 8 + ((lane - 4) & 7)];
            const float xv = keep + bias;
            const float lt = __logf(1.0f + __expf(-fabsf(xv)));
            if (lane < 4) logf[(size_t)row * 4 + lane] = fminf(xv, 0.f) - lt;
            else if (lane < 12) dtv[(size_t)row * 8 + lane - 4] = fmaxf(xv, 0.f) + lt;
        }
    }
}
DEVI void phase_norm1(const DP& p, int l, char* lds) {
    const int tid = TIDX(), wid = tid >> 6, lane = tid & 63;
    unsigned char* ws = p.ws();
    float* wsl = (float*)lds;
    if (l == 0) {
        for (int i = tid; i < 12 * DM; i += NTHR) { const int c = i / DM, k = i % DM, col = c < 4 ? 768 + c : 3076 + (c - 4);
            wsl[i] = p.in(3)[(size_t)k * INP + col] * p.in(2)[k]; }
    } else {
        const float4* src = (const float4*)((const float*)(ws + WS_WSMALL) + (size_t)l * 12 * DM);
        for (int i = tid; i < 12 * DM / 4; i += NTHR) ((float4*)wsl)[i] = src[i];
    }
    __syncthreads();
    if (l == 0) norm1_rows<0>(p, lds); else norm1_rows<1>(p, lds);
    const float* gm = p.in(17) + l * DM;
    bf16_t* memn = (bf16_t*)(ws + WS_MEMN);
    for (int row = BIDX() * 8 + wid; row < MROWS; row += gridDim.x * 8) {
        float x[16], h[16];
        load_row_f32(p.in(1) + (size_t)row * DM, x, lane);
        norm_row(x, gm, h, lane);
        store_h_bf16(memn + (size_t)row * DM, h, lane);
    }
}
DEVI void phase_norm3(const DP& p, int l, char* lds) {
    const int tid = TIDX(), wid = tid >> 6, lane = tid & 63;
    unsigned char* ws = p.ws();
    float* wr = (float*)lds;
    int* lcnt = (int*)(lds + 36 * DM * 4);
    int* lbase = lcnt + 32;
    int* rinfo = lbase + 32;
    { const float4* src = (const float4*)((const float*)(ws + WS_WROUT) + (size_t)l * 36 * DM);
      for (int i = tid; i < 36 * DM / 4; i += NTHR) ((float4*)wr)[i] = src[i]; }
    if (tid < 32) lcnt[tid] = 0;
    __syncthreads();
    int* cnt = (int*)(ws + WS_CNT) + l * 64;
    int* list = (int*)(ws + WS_LIST);
    const bf16_t* xin = (const bf16_t*)(ws + WS_HBUF);
    bf16_t* h3 = (bf16_t*)(ws + WS_H3);
    const float* bg = p.in(25) + l * 4;
    const int be_i = __float_as_int(lane < 32 ? p.in(27)[l * 32 + lane] : 0.f);
    const int stride = gridDim.x * 8;
    int row = BIDX() * 8 + wid;
    float xn[16];
    if (row < T) load_row_bf16(xin + (size_t)row * DM, xn, lane);
    for (int it = 0; row < T; row += stride, ++it) {
        float x[16];
#pragma unroll
        for (int i = 0; i < 16; ++i) x[i] = xn[i];
        if (row + stride < T) load_row_bf16(xin + (size_t)(row + stride) * DM, xn, lane);
        float ss = 0.f;
#pragma unroll
        for (int i = 0; i < 16; ++i) ss += x[i] * x[i];
        const float rstd = rsqrtf(wave_sum_fast(ss) * (1.0f / DM) + EPS);
        { float hn[16];
#pragma unroll
          for (int i = 0; i < 16; ++i) hn[i] = x[i] * rstd;
          store_row_bf16_b(h3 + (size_t)row * DM, hn, lane); }
        float gl[4];
#pragma unroll
        for (int c = 0; c < 4; ++c) gl[c] = wave_sum_fast(dot_lds_b(x, wr + c * DM, lane)) * rstd + bg[c];
        int gsel = 0; float gmax = gl[0];
#pragma unroll
        for (int c = 1; c < 4; ++c) if (gl[c] > gmax) { gmax = gl[c]; gsel = c; }
        float gden = 0.f;
#pragma unroll
        for (int c = 0; c < 4; ++c) gden += __expf(gl[c] - gmax);
        const float ggate = 1.0f / gden;
        gsel = __builtin_amdgcn_readfirstlane(gsel);
        float v1 = -3.0e38f, v2 = -3.0e38f; int i1 = 0, i2 = 1;
#pragma unroll
        for (int c = 0; c < 8; ++c) {
            const float v = wave_sum_fast(dot_lds_b(x, wr + (4 + gsel * 8 + c) * DM, lane)) * rstd + __int_as_float(__builtin_amdgcn_readlane(be_i, gsel * 8 + c));
            if (v > v1) { v2 = v1; i2 = i1; v1 = v; i1 = c; } else if (v > v2) { v2 = v; i2 = c; }
            if (c & 1) __builtin_amdgcn_sched_barrier(0);
        }
        const float e2 = __expf(v2 - v1), inv = 1.0f / (1.0f + e2);
        if (lane == 0) {
            const int ea = gsel * 8 + i1, eb = gsel * 8 + i2;
            const int sa = atomicAdd(&lcnt[ea], 1), sb = atomicAdd(&lcnt[eb], 1);
            int* ri = rinfo + (it * 8 + wid) * 4;
            const unsigned gpk = cvt_pk(inv * ggate, e2 * inv * ggate);
            ri[0] = ea | (sa << 8); ri[1] = eb | (sb << 8); ri[2] = (int)(gpk << 16); ri[3] = (int)(gpk & 0xffff0000u);
        }
    }
    __syncthreads();
    if (tid < 32) lbase[tid] = atomicAdd(&cnt[tid], lcnt[tid]);
    __syncthreads();
    {
        const int nit = (T - (BIDX() * 8) + stride - 1) / stride;
        if (tid < nit * 8) {
            const int it = tid >> 3, w = tid & 7, r = BIDX() * 8 + w + it * stride;
            if (r < T) {
                const int* ri = rinfo + tid * 4;
                const int ea = ri[0] & 255, sa = ri[0] >> 8, eb = ri[1] & 255, sb = ri[1] >> 8;
                list[(size_t)ea * (2 * T) + lbase[ea] + sa] = ri[2] | (2 * r);
                list[(size_t)eb * (2 * T) + lbase[eb] + sb] = ri[3] | (2 * r + 1);
            }
        }
    }
    __syncthreads();
}

constexpr int G_BM = 256, G_BN = 128, G_BK = 64, G_ST = 72;
constexpr int G_ABUF = G_BM * G_ST, G_BBUF = G_BN * G_ST;
template <class AMap, class Epi>
DEVI void gemm_tile(const AMap& amap, const bf16_t* __restrict__ Bt, int K, const Epi& epi, char* lds) {
    const int tid = TIDX(), wid = tid >> 6, lane = tid & 63, r16 = lane & 15, g4 = lane >> 4;
    const int wr = wid >> 1, wc = wid & 1;
    bf16_t* As = (bf16_t*)lds;
    bf16_t* Bs = As + 2 * G_ABUF;
    const int srow = tid >> 3, skc = (tid & 7) * 8;
    const bf16_t* ap[4];
#pragma unroll
    for (int i = 0; i < 4; ++i) ap[i] = amap(srow + 64 * i) + skc;
    const bf16_t* bp[2];
#pragma unroll
    for (int i = 0; i < 2; ++i) bp[i] = Bt + (size_t)(srow + 64 * i) * K + skc;
    u32x4 ra[4], rb[2];
#pragma unroll
    for (int i = 0; i < 4; ++i) ra[i] = *(const u32x4*)(ap[i]);
#pragma unroll
    for (int i = 0; i < 2; ++i) rb[i] = *(const u32x4*)(bp[i]);
    f32x4 acc[4][4];
#pragma unroll
    for (int m = 0; m < 4; ++m)
#pragma unroll
        for (int n = 0; n < 4; ++n) acc[m][n] = (f32x4){0.f, 0.f, 0.f, 0.f};
    const int nt = K / G_BK;
    for (int t = 0; t < nt; ++t) {
        bf16_t* Ab = As + (t & 1) * G_ABUF;
        bf16_t* Bb = Bs + (t & 1) * G_BBUF;
#pragma unroll
        for (int i = 0; i < 4; ++i) *(u32x4*)(Ab + (srow + 64 * i) * G_ST + skc) = ra[i];
#pragma unroll
        for (int i = 0; i < 2; ++i) *(u32x4*)(Bb + (srow + 64 * i) * G_ST + skc) = rb[i];
        __syncthreads();
        if (t + 1 < nt) {
#pragma unroll
            for (int i = 0; i < 4; ++i) ra[i] = *(const u32x4*)(ap[i] + (size_t)(t + 1) * G_BK);
#pragma unroll
            for (int i = 0; i < 2; ++i) rb[i] = *(const u32x4*)(bp[i] + (size_t)(t + 1) * G_BK);
        }
#pragma unroll
        for (int kk = 0; kk < 2; ++kk) {
            bf16x8 af[4], bfr[4];
#pragma unroll
            for (int m = 0; m < 4; ++m) af[m] = *(const bf16x8*)(Ab + (wr * 64 + m * 16 + r16) * G_ST + kk * 32 + g4 * 8);
#pragma unroll
            for (int n = 0; n < 4; ++n) bfr[n] = *(const bf16x8*)(Bb + (wc * 64 + n * 16 + r16) * G_ST + kk * 32 + g4 * 8);
#pragma unroll
            for (int m = 0; m < 4; ++m)
#pragma unroll
                for (int n = 0; n < 4; ++n) acc[m][n] = MFMA16(bfr[n], af[m], acc[m][n]);
        }
    }
    epi(acc, wr * 64 + r16, wc * 64 + g4 * 4);
    __syncthreads();
}

struct AMapDense { const bf16_t* A; int K; DEVI const bf16_t* operator()(int r) const { return A + (size_t)r * K; } };
struct EpiBf16Out { bf16_t* O; int ldo;
    DEVI void operator()(const f32x4 (&acc)[4][4], int rb, int cb) const {
#pragma unroll
        for (int m = 0; m < 4; ++m)
#pragma unroll
            for (int n = 0; n < 4; ++n) { u32x2 w; w.x = cvt_pk(acc[m][n][0], acc[m][n][1]); w.y = cvt_pk(acc[m][n][2], acc[m][n][3]);
                *(u32x2*)(O + (size_t)(rb + m * 16) * ldo + cb + n * 16) = w; }
    } };
struct EpiResF32 { const float* R; float* O; int ld;
    DEVI void operator()(const f32x4 (&acc)[4][4], int rb, int cb) const {
#pragma unroll
        for (int m = 0; m < 4; ++m)
#pragma unroll
            for (int n = 0; n < 4; ++n) { const size_t off = (size_t)(rb + m * 16) * ld + cb + n * 16;
                const f32x4 r = *(const f32x4*)(R + off); *(f32x4*)(O + off) = r + acc[m][n]; }
    } };

template <class MakeEpi>
DEVI void gemm_dense_units(const bf16_t* A, const bf16_t* Bt, int M, int N, int K, const MakeEpi& mk, char* lds, int u0, int ustride) {
    const int nN = N / G_BN, nU = (M / G_BM) * nN;
    for (int u = u0; u < nU; u += ustride) {
        const int pm = u / nN, pn = u % nN;
        AMapDense am{A + (size_t)pm * G_BM * K, K};
        gemm_tile(am, Bt + (size_t)pn * G_BN * K, K, mk(pm * G_BM, pn * G_BN), lds);
    }
}


DEVI const char* uni_ptr(const char* p) {
    const unsigned long long v = (unsigned long long)p;
    const unsigned lo = __builtin_amdgcn_readfirstlane((unsigned)v), hi = __builtin_amdgcn_readfirstlane((unsigned)(v >> 32));
    return (const char*)(gb_ptr)(((unsigned long long)hi << 32) | lo);
}
namespace g8 {
constexpr int BM = 256, BK = 64, HALF = 128, HTB = HALF * BK * 2, STAGE_BYTES = 8 * HTB;
DEVI int lds_byte(int r, int c) { const int st = (r >> 4) * 2 + (c >> 5), rr = r & 15, cc = c & 31, ob = rr * 64 + cc * 2; return st * 1024 + (ob ^ (((ob >> 9) & 1) << 5)); }
DEVI void stage_rc(int b, int& R, int& C) { const int st = b / 1024, sb = b % 1024, swz = sb ^ (((sb >> 9) & 1) << 5); R = (st >> 1) * 16 + swz / 64; C = (st & 1) * 32 + (swz % 64) / 2; }
DEVI int perm32(int rho) { const int n = rho >> 4, i = rho & 15; return 8 * (i >> 2) + 4 * n + (i & 3); }
struct UnitU { const char* A; const char* B; int i0, i1, i2, i3; int flags; };

template <class Epi, class Sched>
DEVI void gemm8(char* lds_generic, int K, int klen, Sched& S, const Epi& E) {
    LAS unsigned char* lds = (LAS unsigned char*)lds_generic;
    const int tid = TIDX(), wid = __builtin_amdgcn_readfirstlane(tid >> 6), lane = tid & 63, wr = wid >> 2, wc = wid & 3, fr = lane & 15, fq = lane >> 4;
    const int nt = klen / BK;
    int R0, C0, R1, C1; stage_rc(tid * 16, R0, C0); stage_rc(tid * 16 + 8192, R1, C1);
    unsigned voffB[2];
    { const int Rb0 = Epi::PERM ? ((R0 & ~31) + perm32(R0 & 31)) : R0, Rb1 = Epi::PERM ? ((R1 & ~31) + perm32(R1 & 31)) : R1;
      voffB[0] = (unsigned)(Rb0 * K + C0) * 2u; voffB[1] = (unsigned)(Rb1 * K + C1) * 2u; }
    const size_t kstep = (size_t)(BK * 2), hstepB = (size_t)HALF * K * 2;
    const unsigned ldsw = (unsigned)wid * 1024u;
    const int aoff = lds_byte(wr * 64 + fr, fq * 8), boff = lds_byte(wc * 32 + fr, fq * 8);
#define G8_SA(b, h) (((b) * 2 + (h)) * HTB)
#define G8_SB(b, h) ((4 + (b) * 2 + (h)) * HTB)
#define G8_STG(bufoff, gbase, v0, v1) do { const char* _gb = uni_ptr((const char*)(gbase));     \
        __builtin_amdgcn_global_load_lds((const unsigned*)(_gb + (v0)), (LAS unsigned*)(lds + (bufoff) + ldsw), 16, 0, 0); \
        __builtin_amdgcn_global_load_lds((const unsigned*)(_gb + (v1)), (LAS unsigned*)(lds + (bufoff) + ldsw + 8192), 16, 0, 0); } while (0)
#define G8_LDA(dst, b, h) do { _Pragma("unroll") for (int m = 0; m < 4; ++m) _Pragma("unroll") for (int k = 0; k < 2; ++k) dst[m][k] = *(const LAS bf16x8*)(lds + G8_SA(b, h) + aoff + m * 2048 + k * 1024); } while (0)
#define G8_LDB(dst, b, h) do { _Pragma("unroll") for (int n = 0; n < 2; ++n) _Pragma("unroll") for (int k = 0; k < 2; ++k) dst[n][k] = *(const LAS bf16x8*)(lds + G8_SB(b, h) + boff + n * 2048 + k * 1024); } while (0)
#define G8_MMA(ai, bj, At, Bt) do { __builtin_amdgcn_s_setprio(1); _Pragma("unroll") for (int m = 0; m < 4; ++m) _Pragma("unroll") for (int n = 0; n < 2; ++n) _Pragma("unroll") for (int k = 0; k < 2; ++k) \
        acc[ai][bj][m][n] = __builtin_amdgcn_mfma_f32_16x16x32_bf16(Bt[n][k], At[m][k], acc[ai][bj][m][n], 0, 0, 0); __builtin_amdgcn_s_setprio(0); } while (0)
#define G8_WAIT_V(n) asm volatile("s_waitcnt vmcnt(" #n ")" ::: "memory")
#define G8_WAIT_L(n) asm volatile("s_waitcnt lgkmcnt(" #n ")" ::: "memory")
#define G8_BAR __builtin_amdgcn_s_barrier()
#define G8_SCHED __builtin_amdgcn_sched_barrier(0)
    UnitU cur, nxt;
    if (!S.next(cur)) return;
    unsigned va00, va01, va10, va11;
    S.lane_va(cur, R0, C0, R1, C1, va00, va01, va10, va11);
    f32x4 acc[2][2][4][2];
#pragma unroll
    for (int a = 0; a < 2; ++a)
#pragma unroll
        for (int b = 0; b < 2; ++b)
#pragma unroll
            for (int m = 0; m < 4; ++m)
#pragma unroll
                for (int n = 0; n < 2; ++n) acc[a][b][m][n] = (f32x4){0.f, 0.f, 0.f, 0.f};
    bf16x8 At[4][2], B0[2][2], B1[2][2];
    const char* cA = cur.A; const char* cB = cur.B;
    G8_STG(G8_SB(0, 0), cB, voffB[0], voffB[1]); G8_STG(G8_SA(0, 0), cA, va00, va01); G8_STG(G8_SB(0, 1), cB + hstepB, voffB[0], voffB[1]); G8_STG(G8_SA(0, 1), cA, va10, va11);
    if (wr == 1) G8_BAR;
    G8_WAIT_V(4); G8_BAR;
    G8_STG(G8_SB(1, 0), cB + kstep, voffB[0], voffB[1]); G8_STG(G8_SA(1, 0), cA + kstep, va00, va01); G8_STG(G8_SB(1, 1), cB + hstepB + kstep, voffB[0], voffB[1]);
    G8_WAIT_V(6); G8_BAR;
    for (;;) {
        const bool has_next = S.next(nxt);
        const char* nA = has_next ? nxt.A : cA; const char* nB = has_next ? nxt.B : cB;
        unsigned x00 = va00, x01 = va01, x10 = va10, x11 = va11;
        for (int t = 0; t < nt; t += 2) {
            const bool last = (t == nt - 2);
            const char* a1 = cA + (size_t)(t + 1) * kstep;
            const char* a2 = last ? nA : cA + (size_t)(t + 2) * kstep; const char* b2 = last ? nB : cB + (size_t)(t + 2) * kstep;
            const char* a3 = a2 + kstep; const char* b3 = b2 + kstep;
            if (Sched::GATHER) { if (last && has_next) S.lane_va(nxt, R0, C0, R1, C1, x00, x01, x10, x11); }
            G8_LDB(B0, 0, 0); G8_SCHED; G8_LDA(At, 0, 0); G8_STG(G8_SA(1, 1), a1, va10, va11);
            G8_WAIT_L(8); G8_BAR; G8_WAIT_L(0); G8_MMA(0, 0, At, B0); G8_BAR; G8_SCHED;
            G8_LDB(B1, 0, 1); G8_STG(G8_SB(0, 0), b2, voffB[0], voffB[1]);
            G8_BAR; G8_WAIT_L(0); G8_MMA(0, 1, At, B1); G8_BAR;
            G8_LDA(At, 0, 1); G8_STG(G8_SA(0, 0), a2, x00, x01);
            G8_BAR; G8_WAIT_L(0); G8_MMA(1, 0, At, B0); G8_BAR; G8_SCHED;
            G8_STG(G8_SB(0, 1), b2 + hstepB, voffB[0], voffB[1]);
            G8_WAIT_V(6); G8_BAR; G8_MMA(1, 1, At, B1); G8_BAR;
            G8_LDB(B0, 1, 0); G8_SCHED; G8_LDA(At, 1, 0); G8_STG(G8_SA(0, 1), a2, x10, x11);
            G8_WAIT_L(8); G8_BAR; G8_WAIT_L(0); G8_MMA(0, 0, At, B0); G8_BAR; G8_SCHED;
            G8_LDB(B1, 1, 1); G8_STG(G8_SB(1, 0), b3, voffB[0], voffB[1]);
            G8_BAR; G8_WAIT_L(0); G8_MMA(0, 1, At, B1); G8_BAR;
            G8_LDA(At, 1, 1); G8_STG(G8_SA(1, 0), a3, x00, x01);
            G8_BAR; G8_WAIT_L(0); G8_MMA(1, 0, At, B0); G8_BAR; G8_SCHED;
            G8_STG(G8_SB(1, 1), b3 + hstepB, voffB[0], voffB[1]);
            G8_WAIT_V(6); G8_BAR; G8_MMA(1, 1, At, B1); G8_BAR;
        }
        if (cur.flags & 2) E(acc, cur, wr, wc, fr, fq); else E.mid(acc, cur, wr, wc, fr, fq);
        if (!has_next) break;
        if (nxt.flags & 1) {
#pragma unroll
        for (int a = 0; a < 2; ++a)
#pragma unroll
            for (int b = 0; b < 2; ++b)
#pragma unroll
                for (int m = 0; m < 4; ++m)
#pragma unroll
                    for (int n = 0; n < 2; ++n) acc[a][b][m][n] = (f32x4){0.f, 0.f, 0.f, 0.f};
        }
        cur = nxt; cA = nA; cB = nB; va00 = x00; va01 = x01; va10 = x10; va11 = x11;
    }
    G8_WAIT_V(0);
    if (wr == 0) G8_BAR;
    G8_BAR;
#undef G8_SA
#undef G8_SB
#undef G8_STG
#undef G8_LDA
#undef G8_LDB
#undef G8_MMA
#undef G8_WAIT_V
#undef G8_WAIT_L
#undef G8_BAR
#undef G8_SCHED
}

struct DenseSched {
    static constexpr bool GATHER = false;
    const char* A; const char* Bt; int K, nM, nN, nwg, G, c, i;
    DEVI void init(const bf16_t* A_, const bf16_t* Bt_, int M, int N, int K_, int G_, int c_) { A = (const char*)A_; Bt = (const char*)Bt_; K = K_; nM = M / BM; nN = N / BM; nwg = nM * nN; G = G_; c = c_; i = 0; }
    DEVI bool next(UnitU& u) {
        const long L = (long)i * G + c; if (L >= nwg) return false;
        ++i;
        int wgid = (int)L; { const int q = nwg / 8, r = nwg % 8, xcd = wgid % 8, off = wgid / 8; wgid = (xcd < r ? xcd * (q + 1) : r * (q + 1) + (xcd - r) * q) + off; }
        const int nig = 8 * nN, gid = wgid / nig, fm = gid * 8, gsz = (nM - fm) < 8 ? (nM - fm) : 8;
        const int pm = fm + ((wgid % nig) % gsz), pn = (wgid % nig) / gsz;
        u.A = A + (size_t)pm * BM * K * 2; u.B = Bt + (size_t)pn * BM * K * 2; u.i0 = pm; u.i1 = pn; u.i2 = 0; u.i3 = 0; u.flags = 3;
        return true;
    }
    DEVI void lane_va(const UnitU&, int R0, int C0, int R1, int C1, unsigned& v00, unsigned& v01, unsigned& v10, unsigned& v11) const {
        v00 = (unsigned)(R0 * K + C0) * 2u; v01 = (unsigned)(R1 * K + C1) * 2u; v10 = v00 + (unsigned)(HALF * K * 2); v11 = v01 + (unsigned)(HALF * K * 2);
    }
};
struct EpiBf16Scale { static constexpr bool PERM = true; bf16_t* O; int ldo; const float* rstd;
    DEVI void mid(f32x4 (&)[2][2][4][2], const UnitU&, int, int, int, int) const {}
    DEVI void operator()(const f32x4 (&acc)[2][2][4][2], const UnitU& u, int wr, int wc, int fr, int fq) const {
        const int row0 = u.i0 * BM + wr * 64 + fr;
        bf16_t* base = O + (size_t)row0 * ldo + u.i1 * BM + wc * 32 + 8 * fq;
        float rsv[2][4];
#pragma unroll
        for (int ai = 0; ai < 2; ++ai)
#pragma unroll
            for (int m = 0; m < 4; ++m) rsv[ai][m] = rstd[row0 + ai * HALF + m * 16];
#pragma unroll
        for (int ai = 0; ai < 2; ++ai)
#pragma unroll
            for (int m = 0; m < 4; ++m) { bf16_t* rowp = base + (size_t)(ai * HALF + m * 16) * ldo; const float rs = rsv[ai][m];
#pragma unroll
                for (int bj = 0; bj < 2; ++bj) { const f32x4 v0 = acc[ai][bj][m][0] * rs, v1 = acc[ai][bj][m][1] * rs;
                    u32x4 w; w.x = cvt_pk(v0[0], v0[1]); w.y = cvt_pk(v0[2], v0[3]); w.z = cvt_pk(v1[0], v1[1]); w.w = cvt_pk(v1[2], v1[3]);
                    *(u32x4*)(rowp + bj * HALF) = w; } }
    } };
struct EpiBf16 { static constexpr bool PERM = true; bf16_t* O; int ldo;
    DEVI void mid(f32x4 (&)[2][2][4][2], const UnitU&, int, int, int, int) const {}
    DEVI void operator()(const f32x4 (&acc)[2][2][4][2], const UnitU& u, int wr, int wc, int fr, int fq) const {
        bf16_t* base = O + (size_t)(u.i0 * BM + wr * 64 + fr) * ldo + u.i1 * BM + wc * 32 + 8 * fq;
#pragma unroll
        for (int ai = 0; ai < 2; ++ai)
#pragma unroll
            for (int m = 0; m < 4; ++m) { bf16_t* rowp = base + (size_t)(ai * HALF + m * 16) * ldo;
#pragma unroll
                for (int bj = 0; bj < 2; ++bj) { const f32x4 v0 = acc[ai][bj][m][0], v1 = acc[ai][bj][m][1];
                    u32x4 w; w.x = cvt_pk(v0[0], v0[1]); w.y = cvt_pk(v0[2], v0[3]); w.z = cvt_pk(v1[0], v1[1]); w.w = cvt_pk(v1[2], v1[3]);
                    *(u32x4*)(rowp + bj * HALF) = w; } }
    } };
struct EpiResBf { static constexpr bool PERM = true; const bf16_t* R; bf16_t* O; int ld;
    DEVI void mid(f32x4 (&)[2][2][4][2], const UnitU&, int, int, int, int) const {}
    DEVI void operator()(const f32x4 (&acc)[2][2][4][2], const UnitU& u, int wr, int wc, int fr, int fq) const {
        const size_t off0 = (size_t)(u.i0 * BM + wr * 64 + fr) * ld + u.i1 * BM + wc * 32 + 8 * fq;
#pragma unroll
        for (int ai = 0; ai < 2; ++ai) {
            u32x4 rr[4][2];
#pragma unroll
            for (int m = 0; m < 4; ++m)
#pragma unroll
                for (int bj = 0; bj < 2; ++bj) rr[m][bj] = *(const u32x4*)(R + off0 + (size_t)(ai * HALF + m * 16) * ld + bj * HALF);
#pragma unroll
            for (int m = 0; m < 4; ++m) { const size_t off = off0 + (size_t)(ai * HALF + m * 16) * ld;
#pragma unroll
                for (int bj = 0; bj < 2; ++bj) { const u32x4 r = rr[m][bj]; const f32x4 v0 = acc[ai][bj][m][0], v1 = acc[ai][bj][m][1];
                    u32x4 w; w.x = cvt_pk(bflo(r.x) + v0[0], bfhi(r.x) + v0[1]); w.y = cvt_pk(bflo(r.y) + v0[2], bfhi(r.y) + v0[3]);
                    w.z = cvt_pk(bflo(r.z) + v1[0], bfhi(r.z) + v1[1]); w.w = cvt_pk(bflo(r.w) + v1[2], bfhi(r.w) + v1[3]);
                    *(u32x4*)(O + off + bj * HALF) = w; } }
        }
    } };
struct EpiRes { static constexpr bool PERM = false; const float* R; float* O; int ld; bf16_t* H;
    DEVI void mid(f32x4 (&)[2][2][4][2], const UnitU&, int, int, int, int) const {}
    DEVI void operator()(const f32x4 (&acc)[2][2][4][2], const UnitU& u, int wr, int wc, int fr, int fq) const {
        const size_t off0 = (size_t)(u.i0 * BM + wr * 64 + fr) * ld + u.i1 * BM + wc * 32 + 4 * fq;
#pragma unroll
        for (int ai = 0; ai < 2; ++ai)
#pragma unroll
            for (int m = 0; m < 4; ++m) { const size_t off = off0 + (size_t)(ai * HALF + m * 16) * ld;
#pragma unroll
                for (int bj = 0; bj < 2; ++bj)
#pragma unroll
                    for (int n = 0; n < 2; ++n) { const f32x4 r = *(const f32x4*)(R + off + bj * HALF + n * 16); const f32x4 o = r + acc[ai][bj][m][n];
                        *(f32x4*)(O + off + bj * HALF + n * 16) = o;
                        u32x2 w; w.x = cvt_pk(o[0], o[1]); w.y = cvt_pk(o[2], o[3]); *(u32x2*)(H + off + bj * HALF + n * 16) = w; } }
    } };
struct DenseSched2 {
    static constexpr bool GATHER = false;
    DenseSched D; int sub;
    DEVI void init(const bf16_t* A_, const bf16_t* Bt_, int M, int N, int K_, int G_, int c_) { D.init(A_, Bt_, M, N, K_, G_, c_); sub = 0; }
    UnitU pend;
    DEVI bool next(UnitU& u) {
        if (sub == 0) { if (!D.next(pend)) return false; u = pend; u.A = pend.A + (size_t)(D.K / 2) * 2; u.B = pend.B + (size_t)(D.K / 2) * 2; u.flags = 1; sub = 1; return true; }
        u = pend; u.flags = 2; sub = 0; return true;
    }
    DEVI void lane_va(const UnitU& u, int R0, int C0, int R1, int C1, unsigned& v00, unsigned& v01, unsigned& v10, unsigned& v11) const { D.lane_va(u, R0, C0, R1, C1, v00, v01, v10, v11); }
};
struct EpiResScale : EpiResBf { const float* ssq;
    DEVI void mid(f32x4 (&acc)[2][2][4][2], const UnitU& u, int wr, int wc, int fr, int fq) const {
        float2 sqv[2][4];
#pragma unroll
        for (int ai = 0; ai < 2; ++ai)
#pragma unroll
            for (int m = 0; m < 4; ++m) sqv[ai][m] = *(const float2*)(ssq + (size_t)(u.i0 * BM + ai * HALF + wr * 64 + m * 16 + fr) * 2);
#pragma unroll
        for (int ai = 0; ai < 2; ++ai)
#pragma unroll
            for (int m = 0; m < 4; ++m) {
                const float2 sq = sqv[ai][m];
                const float rs = rsqrtf((sq.x + sq.y) * (1.0f / 512.0f) + EPS);
#pragma unroll
                for (int bj = 0; bj < 2; ++bj)
#pragma unroll
                    for (int n = 0; n < 2; ++n) acc[ai][bj][m][n] *= rs;
            }
    } };
}

constexpr float LOG2E_C = 1.4426950408889634f;
DEVI void cumsum_task(const DP& p, int bh, char* lds) {
    const int tid = TIDX(), wid = tid >> 6, lane = tid & 63;
    const int b = bh >> 2, h = bh & 3;
    const float* logf = (const float*)(p.ws() + WS_LOGF);
    float* cumf = (float*)(p.ws() + WS_CUMF);
    float* wtot = (float*)lds;
    float v[4];
#pragma unroll
    for (int j = 0; j < 4; ++j) v[j] = logf[((size_t)b * S + tid * 4 + j) * 4 + h];
    v[1] += v[0]; v[2] += v[1]; v[3] += v[2];
    float incl = v[3];
#pragma unroll
    for (int d = 1; d < 64; d <<= 1) { const float t = __shfl_up(incl, d); if (lane >= d) incl += t; }
    if (lane == 63) wtot[wid] = incl;
    __syncthreads();
    float woff = 0.f;
    for (int w = 0; w < wid; ++w) woff += wtot[w];
    const float base = woff + incl - v[3];
    *(float4*)(cumf + (size_t)bh * S + tid * 4) = make_float4((base + v[0]) * LOG2E_C, (base + v[1]) * LOG2E_C, (base + v[2]) * LOG2E_C, (base + v[3]) * LOG2E_C);
    __syncthreads();
}
DEVI void phase_inproj(const DP& p, int l, char* lds) {
    unsigned char* ws = p.ws();
    g8::DenseSched S; S.init((const bf16_t*)(ws + WS_HBUF), (const bf16_t*)(ws + WS_W_IN), T, NPROJ, DM, gridDim.x, BIDX());
    g8::EpiBf16Scale E{(bf16_t*)(ws + WS_PROJ), NPROJ, (const float*)(ws + WS_RSTD1)};
    g8::gemm8(lds, DM, DM, S, E);
}
DEVI void kv_gemm(const DP& p, char* lds) {
    unsigned char* ws = p.ws();
    const int c = BIDX() - ((int)gridDim.x - 64);
    if (c < 0) return;
    g8::DenseSched S; S.init((const bf16_t*)(ws + WS_MEMN), (const bf16_t*)(ws + WS_W_KV), MROWS, 2 * DM, DM, 64, c);
    g8::EpiBf16 E{(bf16_t*)(ws + WS_KV), 2 * DM};
    g8::gemm8(lds, DM, DM, S, E);
}

DEVI void conv8_pos(const DP& p, int l, const bf16_t* proj, int b, int sp, int chan0, float (&out)[8]) {
    float a[8];
    const float* cb = p.in(10) + l * 1024 + chan0;
#pragma unroll
    for (int i = 0; i < 8; ++i) a[i] = cb[i];
#pragma unroll
    for (int j = 0; j < 4; ++j) {
        const int s2 = sp - 3 + j;
        if (s2 >= 0) {
            const u32x4 w = *(const u32x4*)(proj + ((size_t)b * S + s2) * NPROJ + C_XBC + chan0);
            const float* cw = p.in(9) + ((size_t)l * 4 + j) * 1024 + chan0;
            a[0] += cw[0] * bflo(w.x); a[1] += cw[1] * bfhi(w.x); a[2] += cw[2] * bflo(w.y); a[3] += cw[3] * bfhi(w.y);
            a[4] += cw[4] * bflo(w.z); a[5] += cw[5] * bfhi(w.z); a[6] += cw[6] * bflo(w.w); a[7] += cw[7] * bfhi(w.w);
        }
    }
#pragma unroll
    for (int i = 0; i < 8; ++i) out[i] = silu_f(a[i]);
}
DEVI u32x4 pack8(const float (&v)[8]) { u32x4 w; w.x = cvt_pk(v[0], v[1]); w.y = cvt_pk(v[2], v[3]); w.z = cvt_pk(v[4], v[5]); w.w = cvt_pk(v[6], v[7]); return w; }


DEVI void phase_post(const DP& p, int l) {
    const int tid = TIDX(), wid = tid >> 6, lane = tid & 63;
    unsigned char* ws = p.ws();
    bf16_t* proj = (bf16_t*)(ws + WS_PROJ);
    const int sl = lane >> 2, qt = lane & 3, type = sl >> 2, head = sl & 3;
    const int col0 = (type < 2 ? type * 256 : 768 + (type - 2) * 256) + head * 64 + qt * 16;
    const float *gq0 = p.in(5), *gq1 = p.in(6), *gq2 = p.in(7), *gq3 = p.in(8);
    asm volatile("" : "+s"(gq0), "+s"(gq1), "+s"(gq2), "+s"(gq3));
    const float* gain = (type == 0 ? gq0 : type == 1 ? gq1 : type == 2 ? gq2 : gq3) + l * 64 + qt * 16;
    float gv[16];
#pragma unroll
    for (int i = 0; i < 16; ++i) gv[i] = gain[i];
    const float inv[8] = {1.000000000e+00f, 1.939227432e-01f, 3.760603070e-02f, 7.292664610e-03f, 1.414213562e-03f, 2.742481884e-04f, 5.318295734e-05f, 1.031338525e-05f};
    for (int row = BIDX() * 8 + wid; row < T; row += gridDim.x * 8) {
        bf16_t* ptr = proj + (size_t)row * NPROJ + col0;
        const u32x4 w0 = *(const u32x4*)ptr, w1 = *(const u32x4*)(ptr + 8);
        float v[16];
        v[0] = bflo(w0.x); v[1] = bfhi(w0.x); v[2] = bflo(w0.y); v[3] = bfhi(w0.y); v[4] = bflo(w0.z); v[5] = bfhi(w0.z); v[6] = bflo(w0.w); v[7] = bfhi(w0.w);
        v[8] = bflo(w1.x); v[9] = bfhi(w1.x); v[10] = bflo(w1.y); v[11] = bfhi(w1.y); v[12] = bflo(w1.z); v[13] = bfhi(w1.z); v[14] = bflo(w1.w); v[15] = bfhi(w1.w);
        float ss = 0.f;
#pragma unroll
        for (int i = 0; i < 16; ++i) ss += v[i] * v[i];
        ss += __shfl_xor(ss, 1); ss += __shfl_xor(ss, 2);
        const float rstd = rsqrtf(ss * (1.0f / 64.0f) + EPS);
        const float qs = (type == 0 || type == 2) ? rstd * (0.125f * 1.4426950408889634f) : rstd;
#pragma unroll
        for (int i = 0; i < 16; ++i) v[i] = v[i] * qs * gv[i];
        if (type >= 2 && qt == 0) {
            const float pos = (float)(row & (S - 1));
#pragma unroll
            for (int i = 0; i < 8; ++i) { const float rev = __builtin_amdgcn_fractf(pos * inv[i] * 0.15915494309189535f);
                const float sn = __builtin_amdgcn_sinf(rev), cs = __builtin_amdgcn_cosf(rev);
                const float a = v[i], b = v[i + 8]; v[i] = a * cs - b * sn; v[i + 8] = b * cs + a * sn; }
        }
        u32x4 o0, o1;
        o0.x = cvt_pk(v[0], v[1]); o0.y = cvt_pk(v[2], v[3]); o0.z = cvt_pk(v[4], v[5]); o0.w = cvt_pk(v[6], v[7]);
        o1.x = cvt_pk(v[8], v[9]); o1.y = cvt_pk(v[10], v[11]); o1.z = cvt_pk(v[12], v[13]); o1.w = cvt_pk(v[14], v[15]);
        *(u32x4*)ptr = o0; *(u32x4*)(ptr + 8) = o1;
    }
    bf16_t* xc = (bf16_t*)(ws + WS_XC);
    for (int item = BIDX() * NTHR + tid; item < T * 128; item += gridDim.x * NTHR) {
        const int t = item >> 7, c8 = (item & 127) * 8;
        float v[8]; conv8_pos(p, l, proj, t / S, t % S, c8, v);
        *(u32x4*)(xc + (size_t)t * 1024 + c8) = pack8(v);
    }
}
DEVI void phase_knorm(const DP& p, int l) {
    const int tid = TIDX(), wid = tid >> 6, lane = tid & 63;
    unsigned char* ws = p.ws();
    bf16_t* kv = (bf16_t*)(ws + WS_KV);
    const float* kg = p.in(21) + l * 256 + (lane & 15) * 16;
    float kgv[16];
#pragma unroll
    for (int i = 0; i < 16; ++i) kgv[i] = kg[i];
    for (int row = BIDX() * 8 + wid; row < MROWS; row += gridDim.x * 8) {
        bf16_t* ptr = kv + (size_t)row * 2 * DM + lane * 16;
        const u32x4 w0 = *(const u32x4*)ptr, w1 = *(const u32x4*)(ptr + 8);
        float v[16];
        v[0] = bflo(w0.x); v[1] = bfhi(w0.x); v[2] = bflo(w0.y); v[3] = bfhi(w0.y); v[4] = bflo(w0.z); v[5] = bfhi(w0.z); v[6] = bflo(w0.w); v[7] = bfhi(w0.w);
        v[8] = bflo(w1.x); v[9] = bfhi(w1.x); v[10] = bflo(w1.y); v[11] = bfhi(w1.y); v[12] = bflo(w1.z); v[13] = bfhi(w1.z); v[14] = bflo(w1.w); v[15] = bfhi(w1.w);
        float ss = 0.f;
#pragma unroll
        for (int i = 0; i < 16; ++i) ss += v[i] * v[i];
        ss += __shfl_xor(ss, 1); ss += __shfl_xor(ss, 2); ss += __shfl_xor(ss, 4); ss += __shfl_xor(ss, 8);
        const float rstd = rsqrtf(ss * (1.0f / 256.0f) + EPS);
#pragma unroll
        for (int i = 0; i < 16; ++i) v[i] = v[i] * rstd * kgv[i];
        u32x4 o0, o1;
        o0.x = cvt_pk(v[0], v[1]); o0.y = cvt_pk(v[2], v[3]); o0.z = cvt_pk(v[4], v[5]); o0.w = cvt_pk(v[6], v[7]);
        o1.x = cvt_pk(v[8], v[9]); o1.y = cvt_pk(v[10], v[11]); o1.z = cvt_pk(v[12], v[13]); o1.w = cvt_pk(v[14], v[15]);
        *(u32x4*)ptr = o0; *(u32x4*)(ptr + 8) = o1;
    }
}
constexpr float LOG2E = 1.4426950408889634f;
template <int DH> struct AttnLds { static constexpr int KST = DH + 8; static constexpr int TILE = 64 * KST; static constexpr int BYTES = 4 * TILE * 2; };
DEVI float xor16_max(float v) { auto r = __builtin_amdgcn_permlane16_swap(__float_as_uint(v), __float_as_uint(v), false, false); return fmaxf(__uint_as_float(r[0]), __uint_as_float(r[1])); }
DEVI float xor16_sum(float v) { auto r = __builtin_amdgcn_permlane16_swap(__float_as_uint(v), __float_as_uint(v), false, false); return __uint_as_float(r[0]) + __uint_as_float(r[1]); }
DEVI float xor32_max(float v) { auto r = __builtin_amdgcn_permlane32_swap(__float_as_uint(v), __float_as_uint(v), false, false); return fmaxf(__uint_as_float(r[0]), __uint_as_float(r[1])); }
DEVI float xor32_sum(float v) { auto r = __builtin_amdgcn_permlane32_swap(__float_as_uint(v), __float_as_uint(v), false, false); return __uint_as_float(r[0]) + __uint_as_float(r[1]); }
template <int DH, int MODE, int QR>
DEVI void attn_task(const bf16_t* __restrict__ Qb, int ldq, int qtok0, int qstep,
                    const bf16_t* __restrict__ Kb, const bf16_t* __restrict__ Vb, int ldk, int ktok0, int kstep,
                    int p0, int kt_lo, int kt_hi, float scale,
                    const float* __restrict__ cum, const float* __restrict__ qgain,
                    bf16_t* Ob, int ldo, float* Of, float* Om, float* Ol, char* lds) {
    constexpr int KST = AttnLds<DH>::KST, TILE = AttnLds<DH>::TILE, NKK = DH / 32, ND = DH / 16, NCH = (64 * DH / 8) / NTHR;
    constexpr int WR = 16 * QR;
    const int tid = TIDX(), wid = tid >> 6, lane = tid & 63, r16 = lane & 15, g4 = lane >> 4;
    bf16_t* Ks = (bf16_t*)lds;
    bf16_t* Vs = Ks + 2 * TILE;
    const float c2 = scale * LOG2E;
    bf16x8 qf[QR][NKK];
    int qpos[QR];
#pragma unroll
    for (int g = 0; g < QR; ++g) {
        qpos[g] = p0 + wid * WR + g * 16 + r16;
        const bf16_t* qp = Qb + (size_t)(qtok0 + qpos[g] * qstep) * ldq + g4 * 8;
#pragma unroll
        for (int kk = 0; kk < NKK; ++kk) qf[g][kk] = *(const bf16x8*)(qp + kk * 32);
    }
    if (MODE == 2) {
#pragma unroll
        for (int g = 0; g < QR; ++g) {
            float ss = 0.f;
#pragma unroll
            for (int kk = 0; kk < NKK; ++kk)
#pragma unroll
                for (int j = 0; j < 8; ++j) { const float v = bf2f((bf16_t)qf[g][kk][j]); ss += v * v; }
            ss += __shfl_xor(ss, 16); ss += __shfl_xor(ss, 32);
            const float rstd = rsqrtf(ss * (1.0f / DH) + EPS);
#pragma unroll
            for (int kk = 0; kk < NKK; ++kk)
#pragma unroll
                for (int j = 0; j < 8; ++j) { const float v = bf2f((bf16_t)qf[g][kk][j]) * (rstd * c2) * qgain[kk * 32 + g4 * 8 + j]; qf[g][kk][j] = (short)f2bf(v); }
        }
    }
    float m_[QR], cq[QR];
    f32x4 o[QR][ND], o1[QR];
#pragma unroll
    for (int g = 0; g < QR; ++g) {
        m_[g] = 0.f; cq[g] = (MODE == 0) ? cum[qpos[g]] : 0.f;
        o1[g] = (f32x4){0.f, 0.f, 0.f, 0.f};
#pragma unroll
        for (int n = 0; n < ND; ++n) o[g][n] = (f32x4){0.f, 0.f, 0.f, 0.f};
    }
    bf16x8 vones;
#pragma unroll
    for (int j = 0; j < 8; ++j) vones[j] = (short)(r16 == 0 ? 0x3f80 : 0);
    u32x4 rk[NCH], rv[NCH];
    auto gload = [&](int kt) {
#pragma unroll
        for (int i = 0; i < NCH; ++i) { const int c = tid + i * NTHR, key = c / (DH / 8), dc = c % (DH / 8);
            const size_t tok = (size_t)(ktok0 + (kt * 64 + key) * kstep);
            rk[i] = *(const u32x4*)(Kb + tok * ldk + dc * 8); rv[i] = *(const u32x4*)(Vb + tok * ldk + dc * 8); }
    };
    gload(kt_lo);
    __syncthreads();
    int buf = 0;
    for (int kt = kt_lo; kt < kt_hi; ++kt, buf ^= 1) {
        bf16_t* Kt = Ks + buf * TILE;
        bf16_t* Vt = Vs + buf * TILE;
#pragma unroll
        for (int i = 0; i < NCH; ++i) { const int c = tid + i * NTHR, key = c / (DH / 8), dc = c % (DH / 8);
            *(u32x4*)(Kt + key * KST + dc * 8) = rk[i]; *(u32x4*)(Vt + key * KST + dc * 8) = rv[i]; }
        __syncthreads();
        if (kt + 1 < kt_hi) gload(kt + 1);
        const int qmin = p0 + wid * WR, kmin = kt * 64;
        bool skip = false, interior = true;
        if (MODE == 0) { skip = kmin > qmin + WR - 1; interior = kmin + 63 <= qmin; }
        if (MODE == 1) { skip = (qmin + WR - 1 - kmin < 0) || (qmin - (kmin + 63) > 128); interior = (qmin - (kmin + 63) >= 0) && (qmin + WR - 1 - kmin <= 128); }
        if (skip) continue;
        f32x4 s[QR][4];
        float cm[QR];
#pragma unroll
        for (int g = 0; g < QR; ++g) cm[g] = cq[g] - m_[g];
#pragma unroll
        for (int n = 0; n < 4; ++n) {
            f32x4 ck = (f32x4){0.f, 0.f, 0.f, 0.f};
            if (MODE == 0) ck = *(const f32x4*)(cum + kt * 64 + n * 16 + g4 * 4);
#pragma unroll
            for (int g = 0; g < QR; ++g) s[g][n] = (f32x4){cm[g] - ck[0], cm[g] - ck[1], cm[g] - ck[2], cm[g] - ck[3]};
#pragma unroll
            for (int kk = 0; kk < NKK; ++kk) {
                const bf16x8 kf = *(const bf16x8*)(Kt + (n * 16 + r16) * KST + kk * 32 + g4 * 8);
#pragma unroll
                for (int g = 0; g < QR; ++g) s[g][n] = MFMA16(kf, qf[g][kk], s[g][n]);
            }
            if (DH > 64) __builtin_amdgcn_sched_barrier(0);
        }
        float mx[QR];
#pragma unroll
        for (int g = 0; g < QR; ++g) mx[g] = -INFINITY;
#pragma unroll
        for (int n = 0; n < 4; ++n)
#pragma unroll
            for (int g = 0; g < QR; ++g)
#pragma unroll
                for (int j = 0; j < 4; ++j) {
                    float t = s[g][n][j];
                    if (!interior) {
                        const int kpos = kt * 64 + n * 16 + g4 * 4 + j;
                        if (MODE == 0) { if (kpos > qpos[g]) t = -INFINITY; }
                        if (MODE == 1) { const int dd = qpos[g] - kpos; if (dd < 0 || dd > 128) t = -INFINITY; }
                        s[g][n][j] = t;
                    }
                    mx[g] = fmaxf(mx[g], t);
                }
        bool grow = false;
#pragma unroll
        for (int g = 0; g < QR; ++g) { mx[g] = xor32_max(xor16_max(mx[g])); grow = grow || (mx[g] > 8.0f); }
        if (__any(grow)) {
#pragma unroll
            for (int g = 0; g < QR; ++g) {
                const float delta = fmaxf(mx[g], 0.f);
                const float alpha = __builtin_amdgcn_exp2f(-delta);
                m_[g] += delta; o1[g] *= alpha;
#pragma unroll
                for (int n = 0; n < ND; ++n) o[g][n] *= alpha;
#pragma unroll
                for (int n = 0; n < 4; ++n) s[g][n] -= delta;
            }
        }
#pragma unroll
        for (int g = 0; g < QR; ++g)
#pragma unroll
            for (int n = 0; n < 4; ++n)
#pragma unroll
                for (int j = 0; j < 4; ++j) s[g][n][j] = __builtin_amdgcn_exp2f(s[g][n][j]);
#pragma unroll
        for (int kk = 0; kk < 2; ++kk) {
            bf16x8 pb[QR];
#pragma unroll
            for (int g = 0; g < QR; ++g) {
                u32x4 w; w.x = cvt_pk(s[g][2 * kk][0], s[g][2 * kk][1]); w.y = cvt_pk(s[g][2 * kk][2], s[g][2 * kk][3]); w.z = cvt_pk(s[g][2 * kk + 1][0], s[g][2 * kk + 1][1]); w.w = cvt_pk(s[g][2 * kk + 1][2], s[g][2 * kk + 1][3]);
                pb[g] = __builtin_bit_cast(bf16x8, w);
                o1[g] = MFMA16(vones, pb[g], o1[g]);
            }
            const bf16_t* vb = Vt + (kk * 32 + 4 * g4 + (r16 >> 2)) * KST + 4 * (r16 & 3);
#pragma unroll
            for (int n = 0; n < ND; ++n) {
                const s16x4 lo = tr_read(vb + n * 16), hi = tr_read(vb + 16 * KST + n * 16);
                bf16x8 vf; vf[0] = lo[0]; vf[1] = lo[1]; vf[2] = lo[2]; vf[3] = lo[3]; vf[4] = hi[0]; vf[5] = hi[1]; vf[6] = hi[2]; vf[7] = hi[3];
#pragma unroll
                for (int g = 0; g < QR; ++g) o[g][n] = MFMA16(vf, pb[g], o[g][n]);
                if (DH > 64 && (n & 3) == 3) __builtin_amdgcn_sched_barrier(0);
            }
        }
    }
#pragma unroll
    for (int g = 0; g < QR; ++g) {
        const size_t tok = (size_t)(qtok0 + qpos[g] * qstep);
        const float lsum = __shfl(o1[g][0], r16);
        if (MODE == 1) {
#pragma unroll
            for (int n = 0; n < ND; ++n) *(f32x4*)(Of + tok * 256 + n * 16 + g4 * 4) = o[g][n];
            if (g4 == 0) { Om[tok * 4] = m_[g]; Ol[tok * 4] = lsum; }
        } else {
            const float inv = 1.0f / lsum;
#pragma unroll
            for (int n = 0; n < ND; ++n) { u32x2 w; w.x = cvt_pk(o[g][n][0] * inv, o[g][n][1] * inv); w.y = cvt_pk(o[g][n][2] * inv, o[g][n][3] * inv);
                *(u32x2*)(Ob + tok * ldo + n * 16 + g4 * 4) = w; }
        }
    }
}

DEVI void ssd_acs(const DP& p, int l, int b, int c, int g, float* acs, float* dts) {
    const int tid = TIDX(), wid = tid >> 6, lane = tid & 63;
    if (wid < 4) {
        const int head = g * 4 + wid;
        const float* dtv = (const float*)(p.ws() + WS_DTV);
        const float A = -__expf(p.in(12)[l * 8 + head]);
        const size_t t0 = (size_t)b * S + c * 128 + 2 * lane;
        const float d0 = dtv[t0 * 8 + head], d1 = dtv[(t0 + 1) * 8 + head];
        const float a0 = d0 * A, a1 = d1 * A;
        float incl = a0 + a1;
#pragma unroll
        for (int d = 1; d < 64; d <<= 1) { const float t = __shfl_up(incl, d); if (lane >= d) incl += t; }
        const float ex = incl - (a0 + a1);
        acs[wid * 128 + 2 * lane] = ex + a0; acs[wid * 128 + 2 * lane + 1] = ex + a0 + a1;
        dts[wid * 128 + 2 * lane] = d0; dts[wid * 128 + 2 * lane + 1] = d1;
    }
}
DEVI void conv8_chan(const DP& p, int l, const bf16_t* proj, int b, int c, int chan, int l0, float (&out)[8]) {
    const float* cw = p.in(9) + (size_t)l * 4 * 1024 + chan;
    const float w0 = cw[0], w1 = cw[1024], w2 = cw[2048], w3 = cw[3072], cb = p.in(10)[l * 1024 + chan];
    float v[11];
    const int sbase = c * 128 + l0 - 3;
#pragma unroll
    for (int i = 0; i < 11; ++i) { const int sp = sbase + i; v[i] = sp >= 0 ? bf2f(proj[((size_t)b * S + sp) * NPROJ + C_XBC + chan]) : 0.f; }
#pragma unroll
    for (int i = 0; i < 8; ++i) out[i] = silu_f(cb + w0 * v[i] + w1 * v[i + 1] + w2 * v[i + 2] + w3 * v[i + 3]);
}
constexpr int SST = 136;
constexpr int XST4 = 264;
DEVI void ssd_states_task(const DP& p, int l, int b, int c, int g, char* lds) {
    const int tid = TIDX(), wid = tid >> 6, lane = tid & 63, r16 = lane & 15, g4 = lane >> 4;
    const bf16_t* xc = (const bf16_t*)(p.ws() + WS_XC);
    bf16_t* Bn = (bf16_t*)lds;
    bf16_t* Xn = Bn + 128 * SST;
    float* acs = (float*)(Xn + 128 * XST4);
    float* dts = acs + 512;
    __syncthreads();
    ssd_acs(p, l, b, c, g, acs, dts);
    __syncthreads();
    if (tid < 4) ((float*)(p.ws() + WS_DECAY))[((size_t)b * 16 + c) * 8 + g * 4 + tid] = __expf(acs[tid * 128 + 127]);
    const size_t tok0 = (size_t)b * S + c * 128;
    for (int it = tid; it < 2048; it += NTHR) {
        const int ll = it >> 4, nc = (it & 15) * 8;
        *(u32x4*)(Bn + ll * SST + nc) = *(const u32x4*)(xc + (tok0 + ll) * 1024 + 512 + g * 128 + nc);
    }
    for (int it = tid; it < 4096; it += NTHR) {
        const int ll = it >> 5, ch = (it & 31) * 8, hl = ch >> 6;
        const u32x4 w = *(const u32x4*)(xc + (tok0 + ll) * 1024 + g * 256 + ch);
        const float sc = dts[hl * 128 + ll] * __expf(acs[hl * 128 + 127] - acs[hl * 128 + ll]);
        u32x4 o; o.x = cvt_pk(bflo(w.x) * sc, bfhi(w.x) * sc); o.y = cvt_pk(bflo(w.y) * sc, bfhi(w.y) * sc); o.z = cvt_pk(bflo(w.z) * sc, bfhi(w.z) * sc); o.w = cvt_pk(bflo(w.w) * sc, bfhi(w.w) * sc);
        *(u32x4*)(Xn + ll * XST4 + ch) = o;
    }
    __syncthreads();
    const int hl = wid >> 1, nh = wid & 1;
    f32x4 acc[4][4];
#pragma unroll
    for (int m = 0; m < 4; ++m)
#pragma unroll
        for (int n = 0; n < 4; ++n) acc[m][n] = (f32x4){0.f, 0.f, 0.f, 0.f};
#pragma unroll
    for (int kk = 0; kk < 4; ++kk) {
        bf16x8 af[4], bfr[4];
        const int lrow = kk * 32 + 8 * g4 + (r16 >> 2), cq = 4 * (r16 & 3);
#pragma unroll
        for (int m = 0; m < 4; ++m) { const bf16_t* a = Xn + lrow * XST4 + hl * 64 + m * 16 + cq; const s16x4 lo = tr_read(a), hi = tr_read(a + 4 * XST4);
            af[m][0] = lo[0]; af[m][1] = lo[1]; af[m][2] = lo[2]; af[m][3] = lo[3]; af[m][4] = hi[0]; af[m][5] = hi[1]; af[m][6] = hi[2]; af[m][7] = hi[3]; }
#pragma unroll
        for (int n = 0; n < 4; ++n) { const bf16_t* a = Bn + lrow * SST + nh * 64 + n * 16 + cq; const s16x4 lo = tr_read(a), hi = tr_read(a + 4 * SST);
            bfr[n][0] = lo[0]; bfr[n][1] = lo[1]; bfr[n][2] = lo[2]; bfr[n][3] = lo[3]; bfr[n][4] = hi[0]; bfr[n][5] = hi[1]; bfr[n][6] = hi[2]; bfr[n][7] = hi[3]; }
#pragma unroll
        for (int m = 0; m < 4; ++m)
#pragma unroll
            for (int n = 0; n < 4; ++n) acc[m][n] = MFMA16(bfr[n], af[m], acc[m][n]);
    }
    float* st = (float*)(p.ws() + WS_SSTATE) + (((size_t)b * 16 + c) * 8 + g * 4 + hl) * 8192;
#pragma unroll
    for (int m = 0; m < 4; ++m)
#pragma unroll
        for (int n = 0; n < 4; ++n) *(f32x4*)(st + (m * 16 + r16) * 128 + nh * 64 + n * 16 + g4 * 4) = acc[m][n];
}
DEVI void phase_ssd_scan(const DP& p) {
    const float* st = (const float*)(p.ws() + WS_SSTATE);
    bf16_t* hin = (bf16_t*)(p.ws() + WS_HIN);
    const float* decay = (const float*)(p.ws() + WS_DECAY);
    const int total = NB * 8 * 2048;
    for (int i = BIDX() * NTHR + TIDX(); i < total; i += gridDim.x * NTHR) {
        const int e4 = i & 2047, head = (i >> 11) & 7, b = i >> 14;
        f32x4 h = (f32x4){0.f, 0.f, 0.f, 0.f};
        for (int c = 0; c < 16; ++c) {
            const size_t off = (((size_t)b * 16 + c) * 8 + head) * 8192 + e4 * 4;
            u32x2 w; w.x = cvt_pk(h[0], h[1]); w.y = cvt_pk(h[2], h[3]);
            *(u32x2*)(hin + off) = w;
            const f32x4 s = *(const f32x4*)(st + off);
            const float d = decay[((size_t)b * 16 + c) * 8 + head];
            h = h * d + s;
        }
    }
}
constexpr int XST1 = 72;
DEVI void ssd_out_task(const DP& p, int l, int b, int c, int g, char* lds) {
    const int tid = TIDX(), wid = tid >> 6, lane = tid & 63, r16 = lane & 15, g4 = lane >> 4;
    const bf16_t* proj = (const bf16_t*)(p.ws() + WS_PROJ);
    const bf16_t* xc = (const bf16_t*)(p.ws() + WS_XC);
    bf16_t* Cs = (bf16_t*)lds;
    bf16_t* Bs = Cs + 128 * SST;
    bf16_t* Xn = Bs + 128 * SST;
    bf16_t* Hs = Xn + 128 * XST1;
    bf16_t* Mw = Hs + 64 * SST + wid * 16 * SST;
    float* acs = (float*)(Hs + 64 * SST + 8 * 16 * SST);
    float* dts = acs + 512;
    const int lrow = wid * 16 + r16;
    const size_t tok0 = (size_t)b * S + c * 128, tok = tok0 + lrow;
    bf16_t* mix = (bf16_t*)(p.ws() + WS_MIX);
    float ssq = 0.f;
    __syncthreads();
    ssd_acs(p, l, b, c, g, acs, dts);
    for (int it = tid; it < 2048; it += NTHR) {
        const int ll = it >> 4, nc = (it & 15) * 8;
        *(u32x4*)(Cs + ll * SST + nc) = *(const u32x4*)(xc + (tok0 + ll) * 1024 + 768 + g * 128 + nc);
        *(u32x4*)(Bs + ll * SST + nc) = *(const u32x4*)(xc + (tok0 + ll) * 1024 + 512 + g * 128 + nc);
    }
    __syncthreads();
    bf16x8 cfr[4];
#pragma unroll
    for (int kk = 0; kk < 4; ++kk) cfr[kk] = *(const bf16x8*)(Cs + lrow * SST + kk * 32 + g4 * 8);
    f32x4 cb[8];
#pragma unroll
    for (int st = 0; st < 8; ++st) {
        cb[st] = (f32x4){0.f, 0.f, 0.f, 0.f};
#pragma unroll
        for (int kk = 0; kk < 4; ++kk) {
            const bf16x8 bfr = *(const bf16x8*)(Bs + (st * 16 + r16) * SST + kk * 32 + g4 * 8);
            cb[st] = MFMA16(bfr, cfr[kk], cb[st]);
        }
    }
    u32x4 px[2], ph[2];
    auto hload = [&](int hl_) {
        const int head_ = g * 4 + hl_;
#pragma unroll
        for (int i = 0; i < 2; ++i) { const int it = tid + i * NTHR, ss = it >> 3, pc8 = (it & 7) * 8;
            px[i] = *(const u32x4*)(xc + (tok0 + ss) * 1024 + head_ * 64 + pc8);
            ph[i] = *(const u32x4*)((const bf16_t*)(p.ws() + WS_HIN) + (((size_t)b * 16 + c) * 8 + head_) * 8192 + (size_t)it * 8); }
    };
    hload(0);
    for (int hl = 0; hl < 4; ++hl) {
        const int head = g * 4 + hl;
        __syncthreads();
#pragma unroll
        for (int i = 0; i < 2; ++i) { const int it = tid + i * NTHR, ss = it >> 3, pc8 = (it & 7) * 8;
            *(u32x4*)(Xn + ss * XST1 + pc8) = px[i];
            *(u32x4*)(Hs + (it >> 4) * SST + (it & 15) * 8) = ph[i]; }
        __syncthreads();
        if (hl + 1 < 4) hload(hl + 1);
        u32x2 zpre[4];
#pragma unroll
        for (int pt = 0; pt < 4; ++pt) zpre[pt] = *(const u32x2*)(proj + tok * NPROJ + C_Z + head * 64 + pt * 16 + g4 * 4);
        const float al = acs[hl * 128 + lrow];
#pragma unroll
        for (int st = 0; st < 8; ++st) {
            float mv[4];
            const float4 a4 = *(const float4*)(acs + hl * 128 + st * 16 + g4 * 4), d4 = *(const float4*)(dts + hl * 128 + st * 16 + g4 * 4);
            const float av[4] = {a4.x, a4.y, a4.z, a4.w}, dv[4] = {d4.x, d4.y, d4.z, d4.w};
#pragma unroll
            for (int j = 0; j < 4; ++j) { const int sidx = st * 16 + g4 * 4 + j;
                mv[j] = (sidx <= lrow) ? cb[st][j] * __expf(al - av[j]) * dv[j] : 0.f; }
            u32x2 w; w.x = cvt_pk(mv[0], mv[1]); w.y = cvt_pk(mv[2], mv[3]);
            *(u32x2*)(Mw + r16 * SST + st * 16 + g4 * 4) = w;
        }
        __builtin_amdgcn_wave_barrier();
        asm volatile("s_waitcnt lgkmcnt(0)" ::: "memory");
        f32x4 yd[4], yo[4];
#pragma unroll
        for (int pt = 0; pt < 4; ++pt) { yd[pt] = (f32x4){0.f, 0.f, 0.f, 0.f}; yo[pt] = (f32x4){0.f, 0.f, 0.f, 0.f}; }
#pragma unroll
        for (int kk = 0; kk < 4; ++kk) {
            const bf16x8 mf = *(const bf16x8*)(Mw + r16 * SST + kk * 32 + g4 * 8);
            const bf16_t* xa = Xn + (kk * 32 + 8 * g4 + (r16 >> 2)) * XST1 + 4 * (r16 & 3);
#pragma unroll
            for (int pt = 0; pt < 4; ++pt) {
                const s16x4 lo = tr_read(xa + pt * 16), hi = tr_read(xa + 4 * XST1 + pt * 16);
                bf16x8 xf; xf[0] = lo[0]; xf[1] = lo[1]; xf[2] = lo[2]; xf[3] = lo[3]; xf[4] = hi[0]; xf[5] = hi[1]; xf[6] = hi[2]; xf[7] = hi[3];
                yd[pt] = MFMA16(xf, mf, yd[pt]);
                const bf16x8 hf = *(const bf16x8*)(Hs + (pt * 16 + r16) * SST + kk * 32 + g4 * 8);
                yo[pt] = MFMA16(hf, cfr[kk], yo[pt]);
            }
        }
        __builtin_amdgcn_wave_barrier();
        const float el = __expf(al), Dh = p.in(13)[l * 8 + head];
#pragma unroll
        for (int pt = 0; pt < 4; ++pt) {
            const int pc = pt * 16 + g4 * 4;
            const u32x2 zw = zpre[pt];
            const u32x2 xw = *(const u32x2*)(Xn + lrow * XST1 + pc);
            const float zz[4] = {bflo(zw.x), bfhi(zw.x), bflo(zw.y), bfhi(zw.y)};
            const float xx[4] = {bflo(xw.x), bfhi(xw.x), bflo(xw.y), bfhi(xw.y)};
            float gv[4];
#pragma unroll
            for (int j = 0; j < 4; ++j) { const float yv = yd[pt][j] + el * yo[pt][j] + Dh * xx[j]; gv[j] = yv * silu_f(zz[j]); ssq += gv[j] * gv[j]; }
            u32x2 w; w.x = cvt_pk(gv[0], gv[1]); w.y = cvt_pk(gv[2], gv[3]);
            *(u32x2*)(mix + tok * DM + 512 + head * 64 + pc) = w;
        }
    }
    ssq += __shfl_xor(ssq, 16); ssq += __shfl_xor(ssq, 32);
    if (g4 == 0) ((float*)(p.ws() + WS_SSQ))[tok * 2 + g] = ssq;
}
constexpr int N_FOX = 512, N_S1 = 256, N_DIL = 1536;
DEVI void phase_mix1(const DP& p, int l, char* lds) {
    unsigned char* ws = p.ws();
    kv_gemm(p, lds);
    const bf16_t* proj = (const bf16_t*)(ws + WS_PROJ);
    bf16_t* mix = (bf16_t*)(ws + WS_MIX);
    const int G = gridDim.x, bid = BIDX();
    for (int u = bid; u < N_S1; u += G) { const int g = u & 1, c = (u >> 1) & 15, b = u >> 5; ssd_states_task(p, l, b, c, g, lds); }
    const int nfw = G / 2;
    if (bid < nfw) {
        for (int t = bid; t < 128; t += nfw) {
            const int bh = t & 31, k = t >> 5, b = bh >> 2, h = bh & 3;
            const float* cum = (const float*)(ws + WS_CUMF) + (size_t)bh * S;
#pragma unroll 1
            for (int half = 0; half < 2; ++half) {
                const int qb = half == 0 ? 7 - k : k;
                attn_task<64, 0, 2>(proj + C_FQ + h * 64, NPROJ, b * S, 1, proj + C_FK + h * 64, proj + C_FV + h * 64, NPROJ, b * S, 1,
                                    qb * 256, 0, 4 * qb + 4, 0.125f, cum, nullptr, mix + h * 64, DM, nullptr, nullptr, nullptr, lds);
            }
        }
    } else {
        const int ndw = G - nfw;
        for (int u = bid - nfw; u < 1024; u += ndw) {
            const int bh = u & 31, v = u >> 5, b = bh >> 2, h = bh & 3;
            if (v < 16) {
                const int br = v >> 3, dil = br ? 4 : 1, r = br ? ((v - 8) & 3) : 0, pb = br ? ((v - 8) >> 2) : v;
                float* Of = (float*)(ws + WS_DILO) + (size_t)br * T * 256 + h * 64;
                float* Om = (float*)(ws + WS_DILM) + (size_t)br * T * 4 + h;
                float* Ol = (float*)(ws + WS_DILL) + (size_t)br * T * 4 + h;
                const int klo = pb > 0 ? 4 * pb - 2 : 0;
                attn_task<64, 1, 2>(proj + C_DQ + h * 64, NPROJ, b * S + r, dil, proj + C_DK + h * 64, proj + C_DV + h * 64, NPROJ, b * S + r, dil,
                                    pb * 256, klo, 4 * pb + 4, 0.125f, nullptr, nullptr, nullptr, 0, Of, Om, Ol, lds);
            } else {
                const int r = v - 16;
                float* Of = (float*)(ws + WS_DILO) + (size_t)2 * T * 256 + h * 64;
                float* Om = (float*)(ws + WS_DILM) + (size_t)2 * T * 4 + h;
                float* Ol = (float*)(ws + WS_DILL) + (size_t)2 * T * 4 + h;
                attn_task<64, 1, 1>(proj + C_DQ + h * 64, NPROJ, b * S + r, 16, proj + C_DK + h * 64, proj + C_DV + h * 64, NPROJ, b * S + r, 16,
                                    0, 0, 2, 0.125f, nullptr, nullptr, nullptr, 0, Of, Om, Ol, lds);
            }
        }
    }
}
DEVI void phase_mix3(const DP& p, int l, char* lds) {
    unsigned char* ws = p.ws();
    for (int t = BIDX(); t < NB * 16 * 2; t += gridDim.x) ssd_out_task(p, l, t >> 5, (t >> 1) & 15, t & 1, lds);
    const int tid = TIDX(), wid = tid >> 6, lane = tid & 63, head = lane >> 4, d4 = (lane & 15) * 4;
    const float* Of = (const float*)(ws + WS_DILO);
    const float* Om = (const float*)(ws + WS_DILM);
    const float* Ol = (const float*)(ws + WS_DILL);
    bf16_t* mix = (bf16_t*)(ws + WS_MIX);
    for (int row = BIDX() * 8 + wid; row < T; row += gridDim.x * 8) {
        float m[3], lsum[3];
#pragma unroll
        for (int br = 0; br < 3; ++br) { m[br] = Om[((size_t)br * T + row) * 4 + head]; lsum[br] = Ol[((size_t)br * T + row) * 4 + head]; }
        const float M = fmaxf(m[0], fmaxf(m[1], m[2]));
        f32x4 num = (f32x4){0.f, 0.f, 0.f, 0.f}; float den = 0.f;
#pragma unroll
        for (int br = 0; br < 3; ++br) {
            const float w = __builtin_amdgcn_exp2f(m[br] - M);
            const f32x4 o = *(const f32x4*)(Of + ((size_t)br * T + row) * 256 + head * 64 + d4);
            num += o * w; den += w * lsum[br];
        }
        const float inv = 1.0f / den;
        u32x2 w; w.x = cvt_pk(num[0] * inv, num[1] * inv); w.y = cvt_pk(num[2] * inv, num[3] * inv);
        *(u32x2*)(mix + (size_t)row * DM + 256 + head * 64 + d4) = w;
    }
}
DEVI void phase_xattn(const DP& p, int l, char* lds) {
    unsigned char* ws = p.ws();
    const bf16_t* qbuf = (const bf16_t*)(ws + WS_QBUF);
    const bf16_t* kv = (const bf16_t*)(ws + WS_KV);
    bf16_t* obuf = (bf16_t*)(ws + WS_OBUF);
    for (int t = BIDX(); t < NB * 4 * 16; t += gridDim.x) {
        const int qb = t & 15, h = (t >> 4) & 3, b = t >> 6;
        attn_task<256, 2, 1>(qbuf + h * 256, DM, b * S, 1, kv + h * 256, kv + DM + h * 256, 2 * DM, b * MEMLEN, 1,
                          qb * 128, 0, 4, 0.0625f, nullptr, p.in(20) + l * 256, obuf + h * 256, DM, nullptr, nullptr, nullptr, lds);
    }
}
namespace g8 {
template <bool GATHER_> struct MoeSched {
    static constexpr bool GATHER = GATHER_;
    const int* cnt; const int* list; const char* Abase; const char* Bbase; size_t bstride; int K, G;
    int ei, ubase, u, step, x, nxcd;
    DEVI void init(const int* cnt_, const int* list_, const void* A_, const void* B_, size_t bstride_, int K_, int G_, int c_) {
        cnt = cnt_; list = list_; Abase = (const char*)A_; Bbase = (const char*)B_; bstride = bstride_; K = K_; G = G_;
        nxcd = (G_ % 8 == 0) ? 8 : 1; x = c_ % nxcd; step = G_ / nxcd; u = c_ / nxcd; ei = 0; ubase = 0; }
    DEVI bool next(UnitU& o) {
        while (x + nxcd * ei < NEXP) {
            const int e = x + nxcd * ei;
            const int ce = cnt[e], nte = (ce + BM - 1) / BM, nun = nte * 4;
            if (u < ubase + nun) {
                const int lu = u - ubase, pm = lu >> 2, pn = lu & 3;
                int tbase = 0;
                for (int e2 = 0; e2 < e; ++e2) tbase += (cnt[e2] + BM - 1) / BM;
                o.i0 = tbase + pm; o.i1 = pn; o.i2 = e * (2 * T) + pm * BM; o.i3 = ce - pm * BM; o.flags = 3;
                o.A = GATHER ? Abase : Abase + (size_t)(tbase + pm) * BM * K * 2;
                o.B = Bbase + (size_t)e * bstride + (size_t)pn * BM * K * 2;
                u += step; return true;
            }
            ubase += nun; ++ei;
        }
        return false;
    }
    DEVI void lane_va(const UnitU& o, int R0, int C0, int R1, int C1, unsigned& v00, unsigned& v01, unsigned& v10, unsigned& v11) const {
        if (GATHER) {
            const int nv = o.i3; const int* ent = list + o.i2;
            const int t00 = (ent[R0 < nv ? R0 : 0] & 0xffff) >> 1, t01 = (ent[R1 < nv ? R1 : 0] & 0xffff) >> 1, t10 = (ent[R0 + HALF < nv ? R0 + HALF : 0] & 0xffff) >> 1, t11 = (ent[R1 + HALF < nv ? R1 + HALF : 0] & 0xffff) >> 1;
            v00 = (unsigned)(t00 * K + C0) * 2u; v01 = (unsigned)(t01 * K + C1) * 2u; v10 = (unsigned)(t10 * K + C0) * 2u; v11 = (unsigned)(t11 * K + C1) * 2u;
        } else {
            v00 = (unsigned)(R0 * K + C0) * 2u; v01 = (unsigned)(R1 * K + C1) * 2u; v10 = v00 + (unsigned)(HALF * K * 2); v11 = v01 + (unsigned)(HALF * K * 2);
        }
    }
};
struct EpiSwiglu { static constexpr bool PERM = false; bf16_t* act;
    DEVI void mid(f32x4 (&)[2][2][4][2], const UnitU&, int, int, int, int) const {}
    DEVI void operator()(const f32x4 (&acc)[2][2][4][2], const UnitU& u, int wr, int wc, int fr, int fq) const {
        const int nv = u.i3;
#pragma unroll
        for (int ai = 0; ai < 2; ++ai)
#pragma unroll
            for (int m = 0; m < 4; ++m) {
                const int r = ai * HALF + wr * 64 + m * 16 + fr;
                if (r < nv) {
                    bf16_t* rowp = act + (size_t)(u.i0 * BM + r) * EFF + u.i1 * 128 + wc * 16 + 4 * fq;
#pragma unroll
                    for (int bj = 0; bj < 2; ++bj) { const f32x4 x1 = acc[ai][bj][m][0], x3 = acc[ai][bj][m][1];
                        u32x2 w; w.x = cvt_pk(silu_f(x1[0]) * x3[0], silu_f(x1[1]) * x3[1]); w.y = cvt_pk(silu_f(x1[2]) * x3[2], silu_f(x1[3]) * x3[3]);
                        *(u32x2*)(rowp + bj * 64) = w; }
                }
            }
    } };
struct EpiMoeOut { static constexpr bool PERM = true; bf16_t* y; const int* list;
    DEVI void mid(f32x4 (&)[2][2][4][2], const UnitU&, int, int, int, int) const {}
    DEVI void operator()(const f32x4 (&acc)[2][2][4][2], const UnitU& u, int wr, int wc, int fr, int fq) const {
        const int nv = u.i3; const int* ent = list + u.i2;
        unsigned env[2][4];
#pragma unroll
        for (int ai = 0; ai < 2; ++ai)
#pragma unroll
            for (int m = 0; m < 4; ++m) { const int r = ai * HALF + wr * 64 + m * 16 + fr; env[ai][m] = (unsigned)ent[r < nv ? r : 0]; }
#pragma unroll
        for (int ai = 0; ai < 2; ++ai)
#pragma unroll
            for (int m = 0; m < 4; ++m) {
                const int r = ai * HALF + wr * 64 + m * 16 + fr;
                if (r < nv) {
                    const unsigned en = env[ai][m]; const int a = (int)(en & 0xffffu); const float gt = __uint_as_float(en & 0xffff0000u);
                    bf16_t* rowp = y + (size_t)a * DM + u.i1 * BM + wc * 32 + 8 * fq;
#pragma unroll
                    for (int bj = 0; bj < 2; ++bj) { const f32x4 v0 = acc[ai][bj][m][0] * gt, v1 = acc[ai][bj][m][1] * gt;
                        u32x4 w; w.x = cvt_pk(v0[0], v0[1]); w.y = cvt_pk(v0[2], v0[3]); w.z = cvt_pk(v1[0], v1[1]); w.w = cvt_pk(v1[2], v1[3]);
                        *(u32x4*)(rowp + bj * HALF) = w; }
                }
            }
    } };
}
template <int WHICH>
DEVI void phase_moe(const DP& p, int l, char* lds) {
    unsigned char* ws = p.ws();
    const int* cnt = (const int*)(ws + WS_CNT) + l * 64;
    const int* list = (const int*)(ws + WS_LIST);
    if (WHICH == 0) {
        g8::MoeSched<true> S;
        S.init(cnt, list, ws + WS_H3, ws + WS_W_13, (size_t)1024 * DM * 2, DM, gridDim.x, BIDX());
        g8::EpiSwiglu E{(bf16_t*)(ws + WS_ACT)};
        g8::gemm8(lds, DM, DM, S, E);
    } else {
        g8::MoeSched<false> S;
        S.init(cnt, list, ws + WS_ACT, ws + WS_W_2, (size_t)DM * EFF * 2, EFF, gridDim.x, BIDX());
        g8::EpiMoeOut E{(bf16_t*)(ws + WS_YBUF), list};
        g8::gemm8(lds, EFF, EFF, S, E);
    }
}
DEVI void phase_final(const DP& p) {
    const int tid = TIDX(), wid = tid >> 6, lane = tid & 63;
    const bf16_t* ybuf = (const bf16_t*)(p.ws() + WS_YBUF);
    const bf16_t* h0 = (const bf16_t*)(p.ws() + WS_HBUF);
    float* out = p.out();
    for (int row = BIDX() * 8 + wid; row < T; row += gridDim.x * 8) {
        float x[16];
        load_row_bf16(h0 + (size_t)row * DM, x, lane);
        add_row_bf16_b(ybuf + (size_t)(2 * row) * DM, x, lane);
        add_row_bf16_b(ybuf + (size_t)(2 * row + 1) * DM, x, lane);
#pragma unroll
        for (int j = 0; j < 2; ++j) {
            *(float4*)(out + (size_t)row * DM + j * 512 + lane * 8) = make_float4(x[8 * j], x[8 * j + 1], x[8 * j + 2], x[8 * j + 3]);
            *(float4*)(out + (size_t)row * DM + j * 512 + lane * 8 + 4) = make_float4(x[8 * j + 4], x[8 * j + 5], x[8 * j + 6], x[8 * j + 7]);
        }
    }
}

#define XB_TMO      128
#define XB_XCNT(j)  (256  + 64 * (j))
#define XB_XSUB(j)  (1280 + 64 * (j))
#define XB_XGEN(j)  (2304 + 64 * (j))
#define XB_TOP      3328
#define XB_TOPGEN   3392
#define XCD_BAR_WORDS 3456
#define XB_SPIN_CAP (1u << 22)
DEVI unsigned xb_ld(unsigned* p)              { return __hip_atomic_load(p, __ATOMIC_RELAXED, __HIP_MEMORY_SCOPE_AGENT); }
DEVI unsigned xb_add(unsigned* p, unsigned v) { return __hip_atomic_fetch_add(p, v, __ATOMIC_RELAXED, __HIP_MEMORY_SCOPE_AGENT); }
DEVI unsigned xb_xcc_id() { return (unsigned)__builtin_amdgcn_s_getreg((3 << 11) | 20) & 0xFu; }
#define XB_SPIN(cond, bar) do { unsigned _sp = 0; while (cond) { __builtin_amdgcn_s_sleep(1); \
    if ((++_sp & 255u) == 0u) { if (xb_ld(&(bar)[XB_TMO])) break; if (_sp > XB_SPIN_CAP) { atomicAdd(&(bar)[XB_TMO], 1u); break; } } } } while (0)
struct XcdBarrier { unsigned* bar; unsigned x; volatile LAS unsigned* st; };
DEVI XcdBarrier xcd_barrier_post(unsigned* bar, volatile LAS unsigned* st) {
    XcdBarrier b; b.bar = bar; b.x = xb_xcc_id(); b.st = st;
    if (threadIdx.x == 0) (void)xb_add(&bar[XB_XCNT(b.x)], 1u);
    return b;
}
DEVI void xcd_barrier_complete(unsigned* bar, unsigned x, unsigned& nloc, unsigned& nx) {
    const unsigned G = gridDim.x * gridDim.y * gridDim.z;
    unsigned sum, cnt, mine, sp = 0u;
    for (;;) {
        sum = 0u; cnt = 0u; mine = 0u;
#pragma unroll
        for (unsigned j = 0; j < 16; ++j) { const unsigned c = xb_ld(&bar[XB_XCNT(j)]); sum += c; cnt += (c > 0u) ? 1u : 0u; mine = (j == x) ? c : mine; }
        if (sum == G) break;
        __builtin_amdgcn_s_sleep(1);
        if ((++sp & 255u) == 0u) { if (xb_ld(&bar[XB_TMO])) break; if (sp > XB_SPIN_CAP) { atomicAdd(&bar[XB_TMO], 1u); break; } }
    }
    nloc = mine > 0u ? mine : 1u; nx = cnt > 0u ? cnt : 1u;
}
DEVI void xcd_barrier(const XcdBarrier& b) {
    asm volatile("s_waitcnt vmcnt(0)" ::: "memory");
    __syncthreads();
    if (threadIdx.x == 0) {
        unsigned* bar = b.bar;
        __builtin_amdgcn_s_waitcnt(0);
        unsigned nloc = b.st[0], nx = b.st[1];
        if (nloc == 0u) { xcd_barrier_complete(bar, b.x, nloc, nx); b.st[0] = nloc; b.st[1] = nx; }
        const unsigned old = xb_add(&bar[XB_XSUB(b.x)], 1u);
        const unsigned gen = old / nloc;
        if (old + 1u == (gen + 1u) * nloc) {
            __builtin_amdgcn_fence(__ATOMIC_RELEASE, "agent");
            asm volatile("s_waitcnt vmcnt(0)" ::: "memory");
            const unsigned og = xb_add(&bar[XB_TOP], 1u);
            const unsigned tg = og / nx;
            if (og + 1u == (tg + 1u) * nx) xb_add(&bar[XB_TOPGEN], 1u);
            else XB_SPIN(xb_ld(&bar[XB_TOPGEN]) == tg, bar);
            __builtin_amdgcn_fence(__ATOMIC_ACQUIRE, "agent");
            xb_add(&bar[XB_XGEN(b.x)], 1u);
            asm volatile("s_waitcnt vmcnt(0)" ::: "memory");
        } else {
            XB_SPIN(xb_ld(&bar[XB_XGEN(b.x)]) == gen, bar);
            __builtin_amdgcn_fence(__ATOMIC_ACQUIRE, "agent");
            asm volatile("s_waitcnt vmcnt(0)" ::: "memory");
        }
    }
    __syncthreads();
}

constexpr int N_PHASES = 27;
__global__ void __launch_bounds__(NTHR) hybrid_fwd(Params p_unused) {
    extern __shared__ __attribute__((aligned(16))) char lds_base[];
    karg_ptr kp = (karg_ptr)__builtin_amdgcn_kernarg_segment_ptr();
    int ph_lo, ph_hi, use_gs;
    { DP q{kp}; ph_lo = q.ph_lo(); ph_hi = q.ph_hi(); use_gs = q.use_gs(); }
    volatile LAS unsigned* xst = (volatile LAS unsigned*)(LAS char*)(lds_base + LDS_BYTES - 16);
    if (threadIdx.x == 0) { xst[0] = 0u; xst[1] = 0u; }
    __syncthreads();
    XcdBarrier xb; xb.bar = nullptr; xb.x = 0; xb.st = xst;
    if (use_gs == 1) { DP q{kp}; xb = xcd_barrier_post((unsigned*)(q.ws() + WS_BAR), xst); }
#define RUN_PHASE(PH, ...) \
    if (ph_lo <= (PH) && (PH) < ph_hi) { \
        if ((PH) > ph_lo) { if (use_gs == 1) xcd_barrier(xb); else if (use_gs == 2) cg::this_grid().sync(); } \
        asm volatile("" : "+s"(kp) :: "memory"); \
        const DP p{kp}; \
        unsigned lds_off = 0; asm volatile("" : "+s"(lds_off)); \
        char* lds = lds_base + lds_off; \
        unsigned char* ws = p.ws(); (void)ws; (void)lds; \
        __VA_ARGS__ \
    }
#define LAYER_PHASES(L, B0) \
    RUN_PHASE((B0) + 0, { if ((L) == 0) prep_small(p); prep_all(p, (L), lds); __syncthreads(); phase_norm1(p, (L), lds); }) \
    RUN_PHASE((B0) + 1, { phase_inproj(p, (L), lds); }) \
    RUN_PHASE((B0) + 2, { for (int t = (int)gridDim.x - 1 - BIDX(); t < 32; t += gridDim.x) cumsum_task(p, t, lds); phase_post(p, (L)); }) \
    RUN_PHASE((B0) + 3, { phase_mix1(p, (L), lds); }) \
    RUN_PHASE((B0) + 4, { phase_ssd_scan(p); phase_knorm(p, (L)); }) \
    RUN_PHASE((B0) + 5, { phase_mix3(p, (L), lds); }) \
    RUN_PHASE((B0) + 6, { g8::DenseSched2 S; S.init((const bf16_t*)(ws + WS_MIX), (const bf16_t*)(ws + WS_W_OUT), T, DM, DM, gridDim.x, BIDX()); \
                          g8::EpiResScale E{{(const bf16_t*)(ws + WS_HBUF), (bf16_t*)(ws + WS_H1), DM}, (const float*)(ws + WS_SSQ)}; g8::gemm8(lds, DM, DM / 2, S, E); }) \
    RUN_PHASE((B0) + 7, { g8::DenseSched S; S.init((const bf16_t*)(ws + WS_H1), (const bf16_t*)(ws + WS_W_Q), T, DM, DM, gridDim.x, BIDX()); \
                          g8::EpiBf16 E{(bf16_t*)(ws + WS_QBUF), DM}; g8::gemm8(lds, DM, DM, S, E); }) \
    RUN_PHASE((B0) + 8, { phase_xattn(p, (L), lds); }) \
    RUN_PHASE((B0) + 9, { g8::DenseSched S; S.init((const bf16_t*)(ws + WS_OBUF), (const bf16_t*)(ws + WS_W_O), T, DM, DM, gridDim.x, BIDX()); \
                          g8::EpiResBf E{(const bf16_t*)(ws + WS_H1), (bf16_t*)(ws + WS_HBUF), DM}; g8::gemm8(lds, DM, DM, S, E); }) \
    RUN_PHASE((B0) + 10, { phase_norm3(p, (L), lds); }) \
    RUN_PHASE((B0) + 11, { phase_moe<0>(p, (L), lds); }) \
    RUN_PHASE((B0) + 12, { phase_moe<1>(p, (L), lds); })

    LAYER_PHASES(0, 0)
    LAYER_PHASES(1, 13)
    RUN_PHASE(26, { phase_final(p); })
#undef LAYER_PHASES
#undef RUN_PHASE
}

extern "C" void kernel_launch(void* const* d_in, const int* in_sizes, int n_in, void* d_out, int out_size, void* d_ws, size_t ws_size, hipStream_t stream) {
    static int grid = 0;
    if (grid == 0) {
        if (n_in != 31 || out_size != T * DM || ws_size < WS_END) { fprintf(stderr, "kernel_launch: unexpected shapes (n_in %d out %d ws %zu need %zu)\n", n_in, out_size, ws_size, (size_t)WS_END); grid = -1; return; }
        int dev = 0, cus = 0, per_cu = 0;
        hipGetDevice(&dev);
        hipDeviceGetAttribute(&cus, hipDeviceAttributeMultiprocessorCount, dev);
        hipFuncSetAttribute((const void*)hybrid_fwd, hipFuncAttributeMaxDynamicSharedMemorySize, LDS_BYTES);
        hipOccupancyMaxActiveBlocksPerMultiprocessor(&per_cu, (const void*)hybrid_fwd, NTHR, LDS_BYTES);
        if (per_cu < 1) { fprintf(stderr, "kernel_launch: occupancy query says %d blocks per CU\n", per_cu); per_cu = 1; }
        (void)hipGetLastError();
        grid = cus;
    }
    if (grid < 0) return;
    Params p{};
    for (int i = 0; i < 31; ++i) p.in[i] = (const float*)d_in[i];
    p.out = (float*)d_out; p.ws = (unsigned char*)d_ws;
    p.use_grid_sync = 1; p.pad = 0;
    p.ph_lo = 0; p.ph_hi = N_PHASES;
    if (hipMemsetAsync((unsigned char*)d_ws + WS_BAR, 0, XCD_BAR_WORDS * 4, stream) != hipSuccess) { fprintf(stderr, "kernel_launch: memset failed\n"); return; }
    void* args[] = {&p};
    hipError_t e = hipLaunchCooperativeKernel((const void*)hybrid_fwd, dim3(grid), dim3(NTHR), args, LDS_BYTES, stream);
    if (e != hipSuccess) fprintf(stderr, "kernel_launch: cooperative launch failed: %s (grid %d)\n", hipGetErrorString(e), grid);
}
```

```cpp
#include <hip/hip_runtime.h>
#include <hip/hip_cooperative_groups.h>
#include <cstdio>
#include <cstdint>
namespace cg = cooperative_groups;

typedef unsigned short bf16_t;
typedef short bf16x8 __attribute__((ext_vector_type(8)));
typedef short s16x4 __attribute__((ext_vector_type(4)));
typedef float f32x4 __attribute__((ext_vector_type(4)));
typedef unsigned u32x4 __attribute__((ext_vector_type(4)));
typedef unsigned u32x2 __attribute__((ext_vector_type(2)));
#define DEVI __device__ __forceinline__
#define LAS __attribute__((address_space(3)))

constexpr int NB = 8, S = 2048, DM = 1024, T = NB * S, DEPTH = 2;
constexpr int INP = 3084, NPROJ = 3072;
constexpr int C_FQ = 0, C_FK = 256, C_FV = 512, C_DQ = 768, C_DK = 1024, C_DV = 1280, C_Z = 1536, C_XBC = 2048;
constexpr int MEMLEN = 256, MROWS = NB * MEMLEN;
constexpr int NEXP = 32, EFF = 512;
constexpr float EPS = 1e-6f;
constexpr int NTHR = 512;
constexpr int LDS_BYTES = 151552;

constexpr size_t al256(size_t x) { return (x + 255) & ~(size_t)255; }
constexpr size_t WS_W_IN = 0;
constexpr size_t WS_W_OUT = WS_W_IN + (size_t)NPROJ * DM * 2;
constexpr size_t WS_W_Q = WS_W_OUT + (size_t)DM * DM * 2;
constexpr size_t WS_W_KV = WS_W_Q + (size_t)DM * DM * 2;
constexpr size_t WS_W_O = WS_W_KV + (size_t)2 * DM * DM * 2;
constexpr size_t WS_W_13 = WS_W_O + (size_t)DM * DM * 2;
constexpr size_t WS_W_2 = WS_W_13 + (size_t)NEXP * 1024 * DM * 2;
constexpr size_t WS_WSMALL = WS_W_2 + (size_t)NEXP * DM * EFF * 2;
constexpr size_t WS_WROUT = WS_WSMALL + (size_t)DEPTH * 12 * DM * 4;
constexpr size_t WS_XB = WS_WROUT + (size_t)DEPTH * 36 * DM * 4;
constexpr size_t WS_H1 = WS_XB;
constexpr size_t WS_H3 = WS_XB + (size_t)T * DM * 2;
constexpr size_t WS_HBUF = WS_XB + (size_t)T * DM * 4;
constexpr size_t WS_PROJ = WS_HBUF + (size_t)T * DM * 2;
constexpr size_t WS_QBUF = WS_PROJ;
constexpr size_t WS_OBUF = WS_PROJ + (size_t)T * DM * 2;
constexpr size_t WS_ACT = WS_PROJ;
constexpr size_t WS_MIX = WS_PROJ + (size_t)T * NPROJ * 2;
constexpr size_t WS_U = WS_MIX + (size_t)T * DM * 2;
constexpr size_t WS_YBUF = WS_U;
constexpr size_t WS_DILO = WS_U;
constexpr size_t WS_DILM = WS_DILO + (size_t)3 * T * 256 * 4;
constexpr size_t WS_DILL = WS_DILM + (size_t)3 * T * 4 * 4;
constexpr size_t WS_SSTATE = WS_DILL + (size_t)3 * T * 4 * 4;
constexpr size_t WS_HIN = WS_SSTATE + (size_t)NB * 16 * 8 * 8192 * 4;
constexpr size_t WS_GBUF = WS_HIN + (size_t)NB * 16 * 8 * 8192 * 2;
constexpr size_t WS_U_END = WS_GBUF + (size_t)T * 512 * 4;
constexpr size_t WS_MEMN = WS_U_END;
constexpr size_t WS_KV = WS_MEMN + (size_t)MROWS * DM * 2;
constexpr size_t WS_LOGF = WS_KV + (size_t)MROWS * 2 * DM * 2;
constexpr size_t WS_CUMF = WS_LOGF + (size_t)T * 4 * 4;
constexpr size_t WS_DTV = WS_CUMF + (size_t)T * 4 * 4;
constexpr size_t WS_DECAY = WS_DTV + (size_t)T * 8 * 4;
constexpr size_t WS_CNT = WS_DECAY + (size_t)NB * 16 * 8 * 4;
constexpr size_t WS_LIST = WS_CNT + 1024;
constexpr size_t WS_GATE = WS_LIST + (size_t)NEXP * 2 * T * 4;
constexpr size_t WS_BAR = WS_GATE + (size_t)2 * T * 4;
constexpr size_t WS_XC = WS_BAR + 65536;
constexpr size_t WS_SSQ = WS_XC + (size_t)T * 1024 * 2;
constexpr size_t WS_RSTD1 = WS_SSQ + (size_t)T * 2 * 4;
constexpr size_t WS_RSTD3 = WS_RSTD1 + (size_t)T * 4;
constexpr size_t WS_END = WS_RSTD3 + (size_t)T * 4;
static_assert(WS_YBUF + (size_t)2 * T * DM * 2 <= WS_U_END, "ybuf alias");
static_assert(WS_OBUF + (size_t)T * DM * 2 <= WS_MIX, "obuf alias");

struct Params {
    const float* in[31];
    float* out;
    unsigned char* ws;
    int ph_lo, ph_hi;
    int use_grid_sync, pad;
};


typedef __attribute__((address_space(4))) const unsigned long long* karg_ptr;
typedef __attribute__((address_space(1))) const float* gcf_ptr;
typedef __attribute__((address_space(1))) float* gf_ptr;
typedef __attribute__((address_space(1))) unsigned char* gb_ptr;
struct DP {
    karg_ptr kp;
    DEVI const float* in(int i) const { return (const float*)(gcf_ptr)(kp[i]); }
    DEVI float* out() const { return (float*)(gf_ptr)(kp[31]); }
    DEVI unsigned char* ws() const { return (unsigned char*)(gb_ptr)(kp[32]); }
    DEVI int ph_lo() const { return (int)(unsigned)kp[33]; }
    DEVI int ph_hi() const { return (int)(unsigned)(kp[33] >> 32); }
    DEVI int use_gs() const { return (int)(unsigned)kp[34]; }
};

DEVI int TIDX() { int t = threadIdx.x; asm volatile("" : "+v"(t)); return t; }
DEVI int BIDX() { int b = blockIdx.x; asm volatile("" : "+s"(b)); return b; }
DEVI float bf2f(bf16_t v) { return __uint_as_float(((unsigned)v) << 16); }
typedef float f32x2 __attribute__((ext_vector_type(2)));
typedef __bf16 bf16x2_t __attribute__((ext_vector_type(2)));
DEVI unsigned cvt_pk(float lo, float hi) { f32x2 v = {lo, hi}; bf16x2_t b = __builtin_convertvector(v, bf16x2_t); return __builtin_bit_cast(unsigned, b); }
DEVI bf16_t f2bf(float f) { return (bf16_t)(cvt_pk(f, 0.f) & 0xffffu); }
DEVI float bflo(unsigned w) { return __uint_as_float(w << 16); }
DEVI float bfhi(unsigned w) { return __uint_as_float(w & 0xffff0000u); }
DEVI float wave_sum(float v) {
#pragma unroll
    for (int m = 32; m >= 1; m >>= 1) v += __shfl_xor(v, m);
    return v;
}
template <int CTRL> DEVI float dpp_mov(float v) { return __uint_as_float(__builtin_amdgcn_update_dpp(0u, __float_as_uint(v), CTRL, 0xf, 0xf, false)); }
DEVI float wave_sum_fast(float v) {
    v += dpp_mov<0xB1>(v);
    v += dpp_mov<0x4E>(v);
    v += dpp_mov<0x124>(v);
    v += dpp_mov<0x128>(v);
    const int iv = __float_as_int(v);
    return (__int_as_float(__builtin_amdgcn_readlane(iv, 0)) + __int_as_float(__builtin_amdgcn_readlane(iv, 16))) + (__int_as_float(__builtin_amdgcn_readlane(iv, 32)) + __int_as_float(__builtin_amdgcn_readlane(iv, 48)));
}
DEVI float silu_f(float x) { return x * __builtin_amdgcn_rcpf(1.f + __expf(-x)); }
DEVI float softplus_f(float x) { return x > 20.f ? x : log1pf(__expf(x)); }
DEVI float logsigmoid_f(float x) { return x >= 0.f ? -log1pf(__expf(-x)) : x - log1pf(__expf(x)); }
#define MFMA16(a, b, c) __builtin_amdgcn_mfma_f32_16x16x32_bf16(a, b, c, 0, 0, 0)
DEVI s16x4 tr_read(const bf16_t* p) {
    return __builtin_bit_cast(s16x4, __builtin_amdgcn_ds_read_tr16_b64_v4i16((LAS s16x4*)p));
}

DEVI int maprow(int mode, int n) { return mode == 0 ? n : ((n >> 4) * 32 + (n & 15) + (mode == 2 ? 16 : 0)); }
struct PrepD { const float* src; int ld, k0, c0; bf16_t* dst; int dstld, mode, n0; const float* ks; int ksf; };
DEVI void prep_ld(const PrepD& d, float4 (&v)[2], float (&sc)[2], int tid) {
#pragma unroll
    for (int i = 0; i < 2; ++i) {
        const int k = (tid >> 4) + 32 * i, n4 = (tid & 15) * 4;
        v[i] = *(const float4*)(d.src + (size_t)(d.k0 + k) * d.ld + d.c0 + n4);
        sc[i] = (d.ks != nullptr && (d.k0 + k) >= d.ksf) ? d.ks[d.k0 + k - d.ksf] : 1.f;
    }
}
DEVI void prep_tl(const float4 (&v)[2], const float (&sc)[2], float* tl, int tid) {
#pragma unroll
    for (int i = 0; i < 2; ++i) {
        const int k = (tid >> 4) + 32 * i, n4 = (tid & 15) * 4;
        tl[k * 65 + n4 + 0] = v[i].x * sc[i]; tl[k * 65 + n4 + 1] = v[i].y * sc[i]; tl[k * 65 + n4 + 2] = v[i].z * sc[i]; tl[k * 65 + n4 + 3] = v[i].w * sc[i];
    }
}
DEVI void prep_st(const PrepD& d, const float* tl, int tid) {
    const int n = tid >> 3, kc = (tid & 7) * 8;
    u32x4 w;
    w.x = cvt_pk(tl[(kc + 0) * 65 + n], tl[(kc + 1) * 65 + n]);
    w.y = cvt_pk(tl[(kc + 2) * 65 + n], tl[(kc + 3) * 65 + n]);
    w.z = cvt_pk(tl[(kc + 4) * 65 + n], tl[(kc + 5) * 65 + n]);
    w.w = cvt_pk(tl[(kc + 6) * 65 + n], tl[(kc + 7) * 65 + n]);
    const int drow = maprow(d.mode, d.n0 + n);
    *(u32x4*)(d.dst + (size_t)drow * d.dstld + d.k0 + kc) = w;
}

constexpr int PREP_UNITS = 2048 + 3 * 4096;
DEVI PrepD prep_decode(const DP& p, int l, int u) {
    unsigned char* ws = p.ws();
    PrepD d;
    if (u < 768) {
        const int kt = u / 48, nt = u % 48, n0 = nt * 64, c0 = n0 < 768 ? n0 : n0 + 4;
        d = PrepD{p.in(3) + (size_t)l * DM * INP, INP, kt * 64, c0, (bf16_t*)(ws + WS_W_IN), DM, 0, n0, p.in(2) + l * DM, 0};
    } else if (u < 1024) {
        const int v = u - 768, kt = v / 16, nt = v % 16;
        d = PrepD{p.in(15) + (size_t)l * DM * DM, DM, kt * 64, nt * 64, (bf16_t*)(ws + WS_W_OUT), DM, 0, nt * 64, p.in(14) + l * 512, 512};
    } else if (u < 1280) {
        const int v = u - 1024, kt = v / 16, nt = v % 16;
        d = PrepD{p.in(18) + (size_t)l * DM * DM, DM, kt * 64, nt * 64, (bf16_t*)(ws + WS_W_Q), DM, 0, nt * 64, p.in(16) + l * DM, 0};
    } else if (u < 1792) {
        const int v = u - 1280, kt = v / 32, nt = v % 32;
        d = PrepD{p.in(19) + (size_t)l * DM * 2 * DM, 2 * DM, kt * 64, nt * 64, (bf16_t*)(ws + WS_W_KV), DM, 0, nt * 64, nullptr, 0};
    } else if (u < 2048) {
        const int v = u - 1792, kt = v / 16, nt = v % 16;
        d = PrepD{p.in(22) + (size_t)l * DM * DM, DM, kt * 64, nt * 64, (bf16_t*)(ws + WS_W_O), DM, 0, nt * 64, nullptr, 0};
    } else if (u < 2048 + 8192) {
        const int v = u - 2048, which = v / 4096, w = v % 4096, e = w / 128, tI = w % 128, kt = tI / 8, nt = tI % 8;
        const float* src = (which == 0 ? p.in(28) : p.in(29)) + ((size_t)l * NEXP + e) * DM * EFF;
        d = PrepD{src, EFF, kt * 64, nt * 64, (bf16_t*)(ws + WS_W_13) + (size_t)e * 1024 * DM, DM, which == 0 ? 1 : 2, nt * 64, p.in(23) + l * DM, 0};
    } else {
        const int w = u - 2048 - 8192, e = w / 128, tI = w % 128, kt = tI / 16, nt = tI % 16;
        const float* src = p.in(30) + ((size_t)l * NEXP + e) * EFF * DM;
        d = PrepD{src, DM, kt * 64, nt * 64, (bf16_t*)(ws + WS_W_2) + (size_t)e * DM * EFF, EFF, 0, nt * 64, nullptr, 0};
    }
    return d;
}
DEVI void prep_all(const DP& p, int l, char* lds) {
    const int tid = TIDX(), G = gridDim.x;
    float* tl = (float*)lds;
    constexpr int NT = 4, TLS = 64 * 65;
    for (int u0 = BIDX(); u0 < PREP_UNITS; u0 += NT * G) {
        PrepD d[NT]; float4 v[NT][2]; float sc[NT][2];
#pragma unroll
        for (int i = 0; i < NT; ++i) { const int u = u0 + i * G; d[i] = prep_decode(p, l, u < PREP_UNITS ? u : u0); prep_ld(d[i], v[i], sc[i], tid); }
#pragma unroll
        for (int i = 0; i < NT; ++i) prep_tl(v[i], sc[i], tl + i * TLS, tid);
        __syncthreads();
#pragma unroll
        for (int i = 0; i < NT; ++i) if (u0 + i * G < PREP_UNITS) prep_st(d[i], tl + i * TLS, tid);
        __syncthreads();
    }
}
DEVI void prep_small(const DP& p) {
    float* wsm = (float*)(p.ws() + WS_WSMALL);
    float* wro = (float*)(p.ws() + WS_WROUT);
    const int gtid = BIDX() * NTHR + TIDX(), gn = gridDim.x * NTHR;
    for (int i = gtid; i < DEPTH * 12 * DM; i += gn) {
        const int l = i / (12 * DM), r = i % (12 * DM), c = r / DM, k = r % DM;
        const int col = c < 4 ? 768 + c : 3076 + (c - 4);
        wsm[i] = p.in(3)[((size_t)l * DM + k) * INP + col] * p.in(2)[l * DM + k];
    }
    for (int i = gtid; i < DEPTH * 36 * DM; i += gn) {
        const int l = i / (36 * DM), r = i % (36 * DM), c = r / DM, k = r % DM;
        wro[i] = (c < 4 ? p.in(24)[((size_t)l * DM + k) * 4 + c] : p.in(26)[((size_t)l * DM + k) * 32 + (c - 4)]) * p.in(23)[l * DM + k];
    }
    if (BIDX() == 0 && TIDX() < 128) ((int*)(p.ws() + WS_CNT))[TIDX()] = 0;
}

DEVI void store_h_bf16(bf16_t* hrow, const float (&h)[16], int lane) {
#pragma unroll
    for (int j = 0; j < 4; ++j) {
        u32x2 w; w.x = cvt_pk(h[4 * j], h[4 * j + 1]); w.y = cvt_pk(h[4 * j + 2], h[4 * j + 3]);
        *(u32x2*)(hrow + j * 256 + lane * 4) = w;
    }
}
DEVI void load_row_f32(const float* xr, float (&x)[16], int lane) {
#pragma unroll
    for (int j = 0; j < 4; ++j) { const float4 v = *(const float4*)(xr + j * 256 + lane * 4); x[4 * j] = v.x; x[4 * j + 1] = v.y; x[4 * j + 2] = v.z; x[4 * j + 3] = v.w; }
}
DEVI void add_row_bf16(const bf16_t* yr, float (&x)[16], int lane) {
#pragma unroll
    for (int j = 0; j < 4; ++j) { const u32x2 w = *(const u32x2*)(yr + j * 256 + lane * 4); x[4 * j] += bflo(w.x); x[4 * j + 1] += bfhi(w.x); x[4 * j + 2] += bflo(w.y); x[4 * j + 3] += bfhi(w.y); }
}
DEVI void store_row_f32(float* xr, const float (&x)[16], int lane) {
#pragma unroll
    for (int j = 0; j < 4; ++j) *(float4*)(xr + j * 256 + lane * 4) = make_float4(x[4 * j], x[4 * j + 1], x[4 * j + 2], x[4 * j + 3]);
}
DEVI void norm_row(const float (&x)[16], const float* g, float (&h)[16], int lane) {
    float ss = 0.f;
#pragma unroll
    for (int i = 0; i < 16; ++i) ss += x[i] * x[i];
    ss = wave_sum(ss);
    const float rstd = rsqrtf(ss * (1.0f / DM) + EPS);
#pragma unroll
    for (int j = 0; j < 4; ++j) { const float4 gv = *(const float4*)(g + j * 256 + lane * 4);
        h[4 * j] = x[4 * j] * rstd * gv.x; h[4 * j + 1] = x[4 * j + 1] * rstd * gv.y; h[4 * j + 2] = x[4 * j + 2] * rstd * gv.z; h[4 * j + 3] = x[4 * j + 3] * rstd * gv.w; }
}
DEVI float dot_lds(const float (&h)[16], const float* wrow, int lane) {
    f32x2 a0 = {0.f, 0.f}, a1 = {0.f, 0.f};
#pragma unroll
    for (int j = 0; j < 4; ++j) { const f32x4 w = *(const f32x4*)(wrow + j * 256 + lane * 4);
        a0 += (f32x2){h[4 * j], h[4 * j + 1]} * (f32x2){w[0], w[1]}; a1 += (f32x2){h[4 * j + 2], h[4 * j + 3]} * (f32x2){w[2], w[3]}; }
    a0 += a1;
    return a0[0] + a0[1];
}

DEVI void load_row_bf16(const bf16_t* xr, float (&x)[16], int lane) {
#pragma unroll
    for (int j = 0; j < 2; ++j) { const u32x4 w = *(const u32x4*)(xr + j * 512 + lane * 8);
        x[8 * j] = bflo(w.x); x[8 * j + 1] = bfhi(w.x); x[8 * j + 2] = bflo(w.y); x[8 * j + 3] = bfhi(w.y); x[8 * j + 4] = bflo(w.z); x[8 * j + 5] = bfhi(w.z); x[8 * j + 6] = bflo(w.w); x[8 * j + 7] = bfhi(w.w); }
}
DEVI void add_row_bf16_b(const bf16_t* yr, float (&x)[16], int lane) {
#pragma unroll
    for (int j = 0; j < 2; ++j) { const u32x4 w = *(const u32x4*)(yr + j * 512 + lane * 8);
        x[8 * j] += bflo(w.x); x[8 * j + 1] += bfhi(w.x); x[8 * j + 2] += bflo(w.y); x[8 * j + 3] += bfhi(w.y); x[8 * j + 4] += bflo(w.z); x[8 * j + 5] += bfhi(w.z); x[8 * j + 6] += bflo(w.w); x[8 * j + 7] += bfhi(w.w); }
}
DEVI void store_row_bf16_b(bf16_t* hr, const float (&h)[16], int lane) {
#pragma unroll
    for (int j = 0; j < 2; ++j) { u32x4 w; w.x = cvt_pk(h[8 * j], h[8 * j + 1]); w.y = cvt_pk(h[8 * j + 2], h[8 * j + 3]); w.z = cvt_pk(h[8 * j + 4], h[8 * j + 5]); w.w = cvt_pk(h[8 * j + 6], h[8 * j + 7]);
        *(u32x4*)(hr + j * 512 + lane * 8) = w; }
}
DEVI float dot_lds_b(const float (&h)[16], const float* wrow, int lane) {
    f32x2 a0 = {0.f, 0.f}, a1 = {0.f, 0.f};
#pragma unroll
    for (int j = 0; j < 2; ++j) { const f32x4 w0 = *(const f32x4*)(wrow + j * 512 + lane * 8), w1 = *(const f32x4*)(wrow + j * 512 + lane * 8 + 4);
        a0 += (f32x2){h[8 * j], h[8 * j + 1]} * (f32x2){w0[0], w0[1]}; a1 += (f32x2){h[8 * j + 2], h[8 * j + 3]} * (f32x2){w0[2], w0[3]};
        a0 += (f32x2){h[8 * j + 4], h[8 * j + 5]} * (f32x2){w1[0], w1[1]}; a1 += (f32x2){h[8 * j + 6], h[8 * j + 7]} * (f32x2){w1[2], w1[3]}; }
    a0 += a1;
    return a0[0] + a0[1];
}
#define MFMA_F32(a, b, c) __builtin_amdgcn_mfma_f32_16x16x4f32(a, b, c, 0, 0, 0)
template <int L>
DEVI void load_row_pre(const float* xin, const bf16_t* h0, const bf16_t* ybuf, int row, int lane, float (&x)[16]) {
    if (L == 0) load_row_f32(xin + (size_t)row * DM, x, lane);
    else { load_row_bf16(h0 + (size_t)row * DM, x, lane); add_row_bf16_b(ybuf + (size_t)(2 * row) * DM, x, lane); add_row_bf16_b(ybuf + (size_t)(2 * row + 1) * DM, x, lane); }
}
template <int L>
DEVI void norm1_rows(const DP& p, char* lds) {
    const int tid = TIDX(), wid = tid >> 6, lane = tid & 63;
    unsigned char* ws = p.ws();
    const float* wsl = (const float*)lds;
    const float* xin = p.in(0);
    const bf16_t* ybuf = (const bf16_t*)(ws + WS_YBUF);
    bf16_t* hbuf = (bf16_t*)(ws + WS_HBUF);
    float* logf = (float*)(ws + WS_LOGF);
    float* dtv = (float*)(ws + WS_DTV);
    float* rstd1 = (float*)(ws + WS_RSTD1);
    const int stride = gridDim.x * 8;
    int row = BIDX() * 8 + wid;
    float xn[16];
    if (row < T) load_row_pre<L>(xin, hbuf, ybuf, row, lane, xn);
    for (; row < T; row += stride) {
        float x[16];
#pragma unroll
        for (int i = 0; i < 16; ++i) x[i] = xn[i];
        if (row + stride < T) load_row_pre<L>(xin, hbuf, ybuf, row + stride, lane, xn);
        if (L == 0) store_h_bf16(hbuf + (size_t)row * DM, x, lane); else store_row_bf16_b(hbuf + (size_t)row * DM, x, lane);
        float ss = 0.f;
#pragma unroll
        for (int i = 0; i < 16; ++i) ss += x[i] * x[i];
        const float rstd = rsqrtf(wave_sum_fast(ss) * (1.0f / DM) + EPS);
        float keep = 0.f;
#pragma unroll
        for (int c = 0; c < 12; ++c) { const float v = wave_sum_fast(L == 0 ? dot_lds(x, wsl + c * DM, lane) : dot_lds_b(x, wsl + c * DM, lane)); keep = (lane == c) ? v : keep; if (c & 1) __builtin_amdgcn_sched_barrier(0); }
        keep *= rstd;
        if (lane == 0) rstd1[row] = rstd;
        {
            const float bias = lane < 4 ? p.in(4)[L * 4 + (lane & 3)] : p.in(11)[L * 8 + ((lane - 4) & 7)];
            const float xv = keep + bias;
            const float lt = __logf(1.0f + __expf(-fabsf(xv)));
            if (lane < 4) logf[(size_t)row * 4 + lane] = fminf(xv, 0.f) - lt;
            else if (lane < 12) dtv[(size_t)row * 8 + lane - 4] = fmaxf(xv, 0.f) + lt;
        }
    }
}
DEVI void phase_norm1(const DP& p, int l, char* lds) {
    const int tid = TIDX(), wid = tid >> 6, lane = tid & 63;
    unsigned char* ws = p.ws();
    float* wsl = (float*)lds;
    if (l == 0) {
        for (int i = tid; i < 12 * DM; i += NTHR) { const int c = i / DM, k = i % DM, col = c < 4 ? 768 + c : 3076 + (c - 4);
            wsl[i] = p.in(3)[(size_t)k * INP + col] * p.in(2)[k]; }
    } else {
        const float4* src = (const float4*)((const float*)(ws + WS_WSMALL) + (size_t)l * 12 * DM);
        for (int i = tid; i < 12 * DM / 4; i += NTHR) ((float4*)wsl)[i] = src[i];
    }
    __syncthreads();
    if (l == 0) norm1_rows<0>(p, lds); else norm1_rows<1>(p, lds);
    const float* gm = p.in(17) + l * DM;
    bf16_t* memn = (bf16_t*)(ws + WS_MEMN);
    for (int row = BIDX() * 8 + wid; row < MROWS; row += gridDim.x * 8) {
        float x[16], h[16];
        load_row_f32(p.in(1) + (size_t)row * DM, x, lane);
        norm_row(x, gm, h, lane);
        store_h_bf16(memn + (size_t)row * DM, h, lane);
    }
}
DEVI void phase_norm3(const DP& p, int l, char* lds) {
    const int tid = TIDX(), wid = tid >> 6, lane = tid & 63;
    unsigned char* ws = p.ws();
    float* wr = (float*)lds;
    int* lcnt = (int*)(lds + 36 * DM * 4);
    int* lbase = lcnt + 32;
    int* rinfo = lbase + 32;
    { const float4* src = (const float4*)((const float*)(ws + WS_WROUT) + (size_t)l * 36 * DM);
      for (int i = tid; i < 36 * DM / 4; i += NTHR) ((float4*)wr)[i] = src[i]; }
    if (tid < 32) lcnt[tid] = 0;
    __syncthreads();
    int* cnt = (int*)(ws + WS_CNT) + l * 64;
    int* list = (int*)(ws + WS_LIST);
    const bf16_t* xin = (const bf16_t*)(ws + WS_HBUF);
    bf16_t* h3 = (bf16_t*)(ws + WS_H3);
    const float* bg = p.in(25) + l * 4;
    const int be_i = __float_as_int(lane < 32 ? p.in(27)[l * 32 + lane] : 0.f);
    const int stride = gridDim.x * 8;
    int row = BIDX() * 8 + wid;
    float xn[16];
    if (row < T) load_row_bf16(xin + (size_t)row * DM, xn, lane);
    for (int it = 0; row < T; row += stride, ++it) {
        float x[16];
#pragma unroll
        for (int i = 0; i < 16; ++i) x[i] = xn[i];
        if (row + stride < T) load_row_bf16(xin + (size_t)(row + stride) * DM, xn, lane);
        float ss = 0.f;
#pragma unroll
        for (int i = 0; i < 16; ++i) ss += x[i] * x[i];
        const float rstd = rsqrtf(wave_sum_fast(ss) * (1.0f / DM) + EPS);
        { float hn[16];
#pragma unroll
          for (int i = 0; i < 16; ++i) hn[i] = x[i] * rstd;
          store_row_bf16_b(h3 + (size_t)row * DM, hn, lane); }
        float gl[4];
#pragma unroll
        for (int c = 0; c < 4; ++c) gl[c] = wave_sum_fast(dot_lds_b(x, wr + c * DM, lane)) * rstd + bg[c];
        int gsel = 0; float gmax = gl[0];
#pragma unroll
        for (int c = 1; c < 4; ++c) if (gl[c] > gmax) { gmax = gl[c]; gsel = c; }
        float gden = 0.f;
#pragma unroll
        for (int c = 0; c < 4; ++c) gden += __expf(gl[c] - gmax);
        const float ggate = 1.0f / gden;
        gsel = __builtin_amdgcn_readfirstlane(gsel);
        float v1 = -3.0e38f, v2 = -3.0e38f; int i1 = 0, i2 = 1;
#pragma unroll
        for (int c = 0; c < 8; ++c) {
            const float v = wave_sum_fast(dot_lds_b(x, wr + (4 + gsel * 8 + c) * DM, lane)) * rstd + __int_as_float(__builtin_amdgcn_readlane(be_i, gsel * 8 + c));
            if (v > v1) { v2 = v1; i2 = i1; v1 = v; i1 = c; } else if (v > v2) { v2 = v; i2 = c; }
            if (c & 1) __builtin_amdgcn_sched_barrier(0);
        }
        const float e2 = __expf(v2 - v1), inv = 1.0f / (1.0f + e2);
        if (lane == 0) {
            const int ea = gsel * 8 + i1, eb = gsel * 8 + i2;
            const int sa = atomicAdd(&lcnt[ea], 1), sb = atomicAdd(&lcnt[eb], 1);
            int* ri = rinfo + (it * 8 + wid) * 4;
            const unsigned gpk = cvt_pk(inv * ggate, e2 * inv * ggate);
            ri[0] = ea | (sa << 8); ri[1] = eb | (sb << 8); ri[2] = (int)(gpk << 16); ri[3] = (int)(gpk & 0xffff0000u);
        }
    }
    __syncthreads();
    if (tid < 32) lbase[tid] = atomicAdd(&cnt[tid], lcnt[tid]);
    __syncthreads();
    {
        const int nit = (T - (BIDX() * 8) + stride - 1) / stride;
        if (tid < nit * 8) {
            const int it = tid >> 3, w = tid & 7, r = BIDX() * 8 + w + it * stride;
            if (r < T) {
                const int* ri = rinfo + tid * 4;
                const int ea = ri[0] & 255, sa = ri[0] >> 8, eb = ri[1] & 255, sb = ri[1] >> 8;
                list[(size_t)ea * (2 * T) + lbase[ea] + sa] = ri[2] | (2 * r);
                list[(size_t)eb * (2 * T) + lbase[eb] + sb] = ri[3] | (2 * r + 1);
            }
        }
    }
    __syncthreads();
}

constexpr int G_BM = 256, G_BN = 128, G_BK = 64, G_ST = 72;
constexpr int G_ABUF = G_BM * G_ST, G_BBUF = G_BN * G_ST;
template <class AMap, class Epi>
DEVI void gemm_tile(const AMap& amap, const bf16_t* __restrict__ Bt, int K, const Epi& epi, char* lds) {
    const int tid = TIDX(), wid = tid >> 6, lane = tid & 63, r16 = lane & 15, g4 = lane >> 4;
    const int wr = wid >> 1, wc = wid & 1;
    bf16_t* As = (bf16_t*)lds;
    bf16_t* Bs = As + 2 * G_ABUF;
    const int srow = tid >> 3, skc = (tid & 7) * 8;
    const bf16_t* ap[4];
#pragma unroll
    for (int i = 0; i < 4; ++i) ap[i] = amap(srow + 64 * i) + skc;
    const bf16_t* bp[2];
#pragma unroll
    for (int i = 0; i < 2; ++i) bp[i] = Bt + (size_t)(srow + 64 * i) * K + skc;
    u32x4 ra[4], rb[2];
#pragma unroll
    for (int i = 0; i < 4; ++i) ra[i] = *(const u32x4*)(ap[i]);
#pragma unroll
    for (int i = 0; i < 2; ++i) rb[i] = *(const u32x4*)(bp[i]);
    f32x4 acc[4][4];
#pragma unroll
    for (int m = 0; m < 4; ++m)
#pragma unroll
        for (int n = 0; n < 4; ++n) acc[m][n] = (f32x4){0.f, 0.f, 0.f, 0.f};
    const int nt = K / G_BK;
    for (int t = 0; t < nt; ++t) {
        bf16_t* Ab = As + (t & 1) * G_ABUF;
        bf16_t* Bb = Bs + (t & 1) * G_BBUF;
#pragma unroll
        for (int i = 0; i < 4; ++i) *(u32x4*)(Ab + (srow + 64 * i) * G_ST + skc) = ra[i];
#pragma unroll
        for (int i = 0; i < 2; ++i) *(u32x4*)(Bb + (srow + 64 * i) * G_ST + skc) = rb[i];
        __syncthreads();
        if (t + 1 < nt) {
#pragma unroll
            for (int i = 0; i < 4; ++i) ra[i] = *(const u32x4*)(ap[i] + (size_t)(t + 1) * G_BK);
#pragma unroll
            for (int i = 0; i < 2; ++i) rb[i] = *(const u32x4*)(bp[i] + (size_t)(t + 1) * G_BK);
        }
#pragma unroll
        for (int kk = 0; kk < 2; ++kk) {
            bf16x8 af[4], bfr[4];
#pragma unroll
            for (int m = 0; m < 4; ++m) af[m] = *(const bf16x8*)(Ab + (wr * 64 + m * 16 + r16) * G_ST + kk * 32 + g4 * 8);
#pragma unroll
            for (int n = 0; n < 4; ++n) bfr[n] = *(const bf16x8*)(Bb + (wc * 64 + n * 16 + r16) * G_ST + kk * 32 + g4 * 8);
#pragma unroll
            for (int m = 0; m < 4; ++m)
#pragma unroll
                for (int n = 0; n < 4; ++n) acc[m][n] = MFMA16(bfr[n], af[m], acc[m][n]);
        }
    }
    epi(acc, wr * 64 + r16, wc * 64 + g4 * 4);
    __syncthreads();
}

struct AMapDense { const bf16_t* A; int K; DEVI const bf16_t* operator()(int r) const { return A + (size_t)r * K; } };
struct EpiBf16Out { bf16_t* O; int ldo;
    DEVI void operator()(const f32x4 (&acc)[4][4], int rb, int cb) const {
#pragma unroll
        for (int m = 0; m < 4; ++m)
#pragma unroll
            for (int n = 0; n < 4; ++n) { u32x2 w; w.x = cvt_pk(acc[m][n][0], acc[m][n][1]); w.y = cvt_pk(acc[m][n][2], acc[m][n][3]);
                *(u32x2*)(O + (size_t)(rb + m * 16) * ldo + cb + n * 16) = w; }
    } };
struct EpiResF32 { const float* R; float* O; int ld;
    DEVI void operator()(const f32x4 (&acc)[4][4], int rb, int cb) const {
#pragma unroll
        for (int m = 0; m < 4; ++m)
#pragma unroll
            for (int n = 0; n < 4; ++n) { const size_t off = (size_t)(rb + m * 16) * ld + cb + n * 16;
                const f32x4 r = *(const f32x4*)(R + off); *(f32x4*)(O + off) = r + acc[m][n]; }
    } };

template <class MakeEpi>
DEVI void gemm_dense_units(const bf16_t* A, const bf16_t* Bt, int M, int N, int K, const MakeEpi& mk, char* lds, int u0, int ustride) {
    const int nN = N / G_BN, nU = (M / G_BM) * nN;
    for (int u = u0; u < nU; u += ustride) {
        const int pm = u / nN, pn = u % nN;
        AMapDense am{A + (size_t)pm * G_BM * K, K};
        gemm_tile(am, Bt + (size_t)pn * G_BN * K, K, mk(pm * G_BM, pn * G_BN), lds);
    }
}


DEVI const char* uni_ptr(const char* p) {
    const unsigned long long v = (unsigned long long)p;
    const unsigned lo = __builtin_amdgcn_readfirstlane((unsigned)v), hi = __builtin_amdgcn_readfirstlane((unsigned)(v >> 32));
    return (const char*)(gb_ptr)(((unsigned long long)hi << 32) | lo);
}
namespace g8 {
constexpr int BM = 256, BK = 64, HALF = 128, HTB = HALF * BK * 2, STAGE_BYTES = 8 * HTB;
DEVI int lds_byte(int r, int c) { const int st = (r >> 4) * 2 + (c >> 5), rr = r & 15, cc = c & 31, ob = rr * 64 + cc * 2; return st * 1024 + (ob ^ (((ob >> 9) & 1) << 5)); }
DEVI void stage_rc(int b, int& R, int& C) { const int st = b / 1024, sb = b % 1024, swz = sb ^ (((sb >> 9) & 1) << 5); R = (st >> 1) * 16 + swz / 64; C = (st & 1) * 32 + (swz % 64) / 2; }
DEVI int perm32(int rho) { const int n = rho >> 4, i = rho & 15; return 8 * (i >> 2) + 4 * n + (i & 3); }
struct UnitU { const char* A; const char* B; int i0, i1, i2, i3; int flags; };

template <class Epi, class Sched>
DEVI void gemm8(char* lds_generic, int K, int klen, Sched& S, const Epi& E) {
    LAS unsigned char* lds = (LAS unsigned char*)lds_generic;
    const int tid = TIDX(), wid = __builtin_amdgcn_readfirstlane(tid >> 6), lane = tid & 63, wr = wid >> 2, wc = wid & 3, fr = lane & 15, fq = lane >> 4;
    const int nt = klen / BK;
    int R0, C0, R1, C1; stage_rc(tid * 16, R0, C0); stage_rc(tid * 16 + 8192, R1, C1);
    unsigned voffB[2];
    { const int Rb0 = Epi::PERM ? ((R0 & ~31) + perm32(R0 & 31)) : R0, Rb1 = Epi::PERM ? ((R1 & ~31) + perm32(R1 & 31)) : R1;
      voffB[0] = (unsigned)(Rb0 * K + C0) * 2u; voffB[1] = (unsigned)(Rb1 * K + C1) * 2u; }
    const size_t kstep = (size_t)(BK * 2), hstepB = (size_t)HALF * K * 2;
    const unsigned ldsw = (unsigned)wid * 1024u;
    const int aoff = lds_byte(wr * 64 + fr, fq * 8), boff = lds_byte(wc * 32 + fr, fq * 8);
#define G8_SA(b, h) (((b) * 2 + (h)) * HTB)
#define G8_SB(b, h) ((4 + (b) * 2 + (h)) * HTB)
#define G8_STG(bufoff, gbase, v0, v1) do { const char* _gb = uni_ptr((const char*)(gbase));     \
        __builtin_amdgcn_global_load_lds((const unsigned*)(_gb + (v0)), (LAS unsigned*)(lds + (bufoff) + ldsw), 16, 0, 0); \
        __builtin_amdgcn_global_load_lds((const unsigned*)(_gb + (v1)), (LAS unsigned*)(lds + (bufoff) + ldsw + 8192), 16, 0, 0); } while (0)
#define G8_LDA(dst, b, h) do { _Pragma("unroll") for (int m = 0; m < 4; ++m) _Pragma("unroll") for (int k = 0; k < 2; ++k) dst[m][k] = *(const LAS bf16x8*)(lds + G8_SA(b, h) + aoff + m * 2048 + k * 1024); } while (0)
#define G8_LDB(dst, b, h) do { _Pragma("unroll") for (int n = 0; n < 2; ++n) _Pragma("unroll") for (int k = 0; k < 2; ++k) dst[n][k] = *(const LAS bf16x8*)(lds + G8_SB(b, h) + boff + n * 2048 + k * 1024); } while (0)
#define G8_MMA(ai, bj, At, Bt) do { __builtin_amdgcn_s_setprio(1); _Pragma("unroll") for (int m = 0; m < 4; ++m) _Pragma("unroll") for (int n = 0; n < 2; ++n) _Pragma("unroll") for (int k = 0; k < 2; ++k) \
        acc[ai][bj][m][n] = __builtin_amdgcn_mfma_f32_16x16x32_bf16(Bt[n][k], At[m][k], acc[ai][bj][m][n], 0, 0, 0); __builtin_amdgcn_s_setprio(0); } while (0)
#define G8_WAIT_V(n) asm volatile("s_waitcnt vmcnt(" #n ")" ::: "memory")
#define G8_WAIT_L(n) asm volatile("s_waitcnt lgkmcnt(" #n ")" ::: "memory")
#define G8_BAR __builtin_amdgcn_s_barrier()
#define G8_SCHED __builtin_amdgcn_sched_barrier(0)
    UnitU cur, nxt;
    if (!S.next(cur)) return;
    unsigned va00, va01, va10, va11;
    S.lane_va(cur, R0, C0, R1, C1, va00, va01, va10, va11);
    f32x4 acc[2][2][4][2];
#pragma unroll
    for (int a = 0; a < 2; ++a)
#pragma unroll
        for (int b = 0; b < 2; ++b)
#pragma unroll
            for (int m = 0; m < 4; ++m)
#pragma unroll
                for (int n = 0; n < 2; ++n) acc[a][b][m][n] = (f32x4){0.f, 0.f, 0.f, 0.f};
    bf16x8 At[4][2], B0[2][2], B1[2][2];
    const char* cA = cur.A; const char* cB = cur.B;
    G8_STG(G8_SB(0, 0), cB, voffB[0], voffB[1]); G8_STG(G8_SA(0, 0), cA, va00, va01); G8_STG(G8_SB(0, 1), cB + hstepB, voffB[0], voffB[1]); G8_STG(G8_SA(0, 1), cA, va10, va11);
    if (wr == 1) G8_BAR;
    G8_WAIT_V(4); G8_BAR;
    G8_STG(G8_SB(1, 0), cB + kstep, voffB[0], voffB[1]); G8_STG(G8_SA(1, 0), cA + kstep, va00, va01); G8_STG(G8_SB(1, 1), cB + hstepB + kstep, voffB[0], voffB[1]);
    G8_WAIT_V(6); G8_BAR;
    for (;;) {
        const bool has_next = S.next(nxt);
        const char* nA = has_next ? nxt.A : cA; const char* nB = has_next ? nxt.B : cB;
        unsigned x00 = va00, x01 = va01, x10 = va10, x11 = va11;
        for (int t = 0; t < nt; t += 2) {
            const bool last = (t == nt - 2);
            const char* a1 = cA + (size_t)(t + 1) * kstep;
            const char* a2 = last ? nA : cA + (size_t)(t + 2) * kstep; const char* b2 = last ? nB : cB + (size_t)(t + 2) * kstep;
            const char* a3 = a2 + kstep; const char* b3 = b2 + kstep;
            if (Sched::GATHER) { if (last && has_next) S.lane_va(nxt, R0, C0, R1, C1, x00, x01, x10, x11); }
            G8_LDB(B0, 0, 0); G8_SCHED; G8_LDA(At, 0, 0); G8_STG(G8_SA(1, 1), a1, va10, va11);
            G8_WAIT_L(8); G8_BAR; G8_WAIT_L(0); G8_MMA(0, 0, At, B0); G8_BAR; G8_SCHED;
            G8_LDB(B1, 0, 1); G8_STG(G8_SB(0, 0), b2, voffB[0], voffB[1]);
            G8_BAR; G8_WAIT_L(0); G8_MMA(0, 1, At, B1); G8_BAR;
            G8_LDA(At, 0, 1); G8_STG(G8_SA(0, 0), a2, x00, x01);
            G8_BAR; G8_WAIT_L(0); G8_MMA(1, 0, At, B0); G8_BAR; G8_SCHED;
            G8_STG(G8_SB(0, 1), b2 + hstepB, voffB[0], voffB[1]);
            G8_WAIT_V(6); G8_BAR; G8_MMA(1, 1, At, B1); G8_BAR;
            G8_LDB(B0, 1, 0); G8_SCHED; G8_LDA(At, 1, 0); G8_STG(G8_SA(0, 1), a2, x10, x11);
            G8_WAIT_L(8); G8_BAR; G8_WAIT_L(0); G8_MMA(0, 0, At, B0); G8_BAR; G8_SCHED;
            G8_LDB(B1, 1, 1); G8_STG(G8_SB(1, 0), b3, voffB[0], voffB[1]);
            G8_BAR; G8_WAIT_L(0); G8_MMA(0, 1, At, B1); G8_BAR;
            G8_LDA(At, 1, 1); G8_STG(G8_SA(1, 0), a3, x00, x01);
            G8_BAR; G8_WAIT_L(0); G8_MMA(1, 0, At, B0); G8_BAR; G8_SCHED;
            G8_STG(G8_SB(1, 1), b3 + hstepB, voffB[0], voffB[1]);
            G8_WAIT_V(6); G8_BAR; G8_MMA(1, 1, At, B1); G8_BAR;
        }
        if (cur.flags & 2) E(acc, cur, wr, wc, fr, fq); else E.mid(acc, cur, wr, wc, fr, fq);
        if (!has_next) break;
        if (nxt.flags & 1) {
#pragma unroll
        for (int a = 0; a < 2; ++a)
#pragma unroll
            for (int b = 0; b < 2; ++b)
#pragma unroll
                for (int m = 0; m < 4; ++m)
#pragma unroll
                    for (int n = 0; n < 2; ++n) acc[a][b][m][n] = (f32x4){0.f, 0.f, 0.f, 0.f};
        }
        cur = nxt; cA = nA; cB = nB; va00 = x00; va01 = x01; va10 = x10; va11 = x11;
    }
    G8_WAIT_V(0);
    if (wr == 0) G8_BAR;
    G8_BAR;
#undef G8_SA
#undef G8_SB
#undef G8_STG
#undef G8_LDA
#undef G8_LDB
#undef G8_MMA
#undef G8_WAIT_V
#undef G8_WAIT_L
#undef G8_BAR
#undef G8_SCHED
}

struct DenseSched {
    static constexpr bool GATHER = false;
    const char* A; const char* Bt; int K, nM, nN, nwg, G, c, i;
    DEVI void init(const bf16_t* A_, const bf16_t* Bt_, int M, int N, int K_, int G_, int c_) { A = (const char*)A_; Bt = (const char*)Bt_; K = K_; nM = M / BM; nN = N / BM; nwg = nM * nN; G = G_; c = c_; i = 0; }
    DEVI bool next(UnitU& u) {
        const long L = (long)i * G + c; if (L >= nwg) return false;
        ++i;
        int wgid = (int)L; { const int q = nwg / 8, r = nwg % 8, xcd = wgid % 8, off = wgid / 8; wgid = (xcd < r ? xcd * (q + 1) : r * (q + 1) + (xcd - r) * q) + off; }
        const int nig = 8 * nN, gid = wgid / nig, fm = gid * 8, gsz = (nM - fm) < 8 ? (nM - fm) : 8;
        const int pm = fm + ((wgid % nig) % gsz), pn = (wgid % nig) / gsz;
        u.A = A + (size_t)pm * BM * K * 2; u.B = Bt + (size_t)pn * BM * K * 2; u.i0 = pm; u.i1 = pn; u.i2 = 0; u.i3 = 0; u.flags = 3;
        return true;
    }
    DEVI void lane_va(const UnitU&, int R0, int C0, int R1, int C1, unsigned& v00, unsigned& v01, unsigned& v10, unsigned& v11) const {
        v00 = (unsigned)(R0 * K + C0) * 2u; v01 = (unsigned)(R1 * K + C1) * 2u; v10 = v00 + (unsigned)(HALF * K * 2); v11 = v01 + (unsigned)(HALF * K * 2);
    }
};
struct EpiBf16Scale { static constexpr bool PERM = true; bf16_t* O; int ldo; const float* rstd;
    DEVI void mid(f32x4 (&)[2][2][4][2], const UnitU&, int, int, int, int) const {}
    DEVI void operator()(const f32x4 (&acc)[2][2][4][2], const UnitU& u, int wr, int wc, int fr, int fq) const {
        const int row0 = u.i0 * BM + wr * 64 + fr;
        bf16_t* base = O + (size_t)row0 * ldo + u.i1 * BM + wc * 32 + 8 * fq;
        float rsv[2][4];
#pragma unroll
        for (int ai = 0; ai < 2; ++ai)
#pragma unroll
            for (int m = 0; m < 4; ++m) rsv[ai][m] = rstd[row0 + ai * HALF + m * 16];
#pragma unroll
        for (int ai = 0; ai < 2; ++ai)
#pragma unroll
            for (int m = 0; m < 4; ++m) { bf16_t* rowp = base + (size_t)(ai * HALF + m * 16) * ldo; const float rs = rsv[ai][m];
#pragma unroll
                for (int bj = 0; bj < 2; ++bj) { const f32x4 v0 = acc[ai][bj][m][0] * rs, v1 = acc[ai][bj][m][1] * rs;
                    u32x4 w; w.x = cvt_pk(v0[0], v0[1]); w.y = cvt_pk(v0[2], v0[3]); w.z = cvt_pk(v1[0], v1[1]); w.w = cvt_pk(v1[2], v1[3]);
                    *(u32x4*)(rowp + bj * HALF) = w; } }
    } };
struct EpiBf16 { static constexpr bool PERM = true; bf16_t* O; int ldo;
    DEVI void mid(f32x4 (&)[2][2][4][2], const UnitU&, int, int, int, int) const {}
    DEVI void operator()(const f32x4 (&acc)[2][2][4][2], const UnitU& u, int wr, int wc, int fr, int fq) const {
        bf16_t* base = O + (size_t)(u.i0 * BM + wr * 64 + fr) * ldo + u.i1 * BM + wc * 32 + 8 * fq;
#pragma unroll
        for (int ai = 0; ai < 2; ++ai)
#pragma unroll
            for (int m = 0; m < 4; ++m) { bf16_t* rowp = base + (size_t)(ai * HALF + m * 16) * ldo;
#pragma unroll
                for (int bj = 0; bj < 2; ++bj) { const f32x4 v0 = acc[ai][bj][m][0], v1 = acc[ai][bj][m][1];
                    u32x4 w; w.x = cvt_pk(v0[0], v0[1]); w.y = cvt_pk(v0[2], v0[3]); w.z = cvt_pk(v1[0], v1[1]); w.w = cvt_pk(v1[2], v1[3]);
                    *(u32x4*)(rowp + bj * HALF) = w; } }
    } };
struct EpiResBf { static constexpr bool PERM = true; const bf16_t* R; bf16_t* O; int ld;
    DEVI void mid(f32x4 (&)[2][2][4][2], const UnitU&, int, int, int, int) const {}
    DEVI void operator()(const f32x4 (&acc)[2][2][4][2], const UnitU& u, int wr, int wc, int fr, int fq) const {
        const size_t off0 = (size_t)(u.i0 * BM + wr * 64 + fr) * ld + u.i1 * BM + wc * 32 + 8 * fq;
#pragma unroll
        for (int ai = 0; ai < 2; ++ai) {
            u32x4 rr[4][2];
#pragma unroll
            for (int m = 0; m < 4; ++m)
#pragma unroll
                for (int bj = 0; bj < 2; ++bj) rr[m][bj] = *(const u32x4*)(R + off0 + (size_t)(ai * HALF + m * 16) * ld + bj * HALF);
#pragma unroll
            for (int m = 0; m < 4; ++m) { const size_t off = off0 + (size_t)(ai * HALF + m * 16) * ld;
#pragma unroll
                for (int bj = 0; bj < 2; ++bj) { const u32x4 r = rr[m][bj]; const f32x4 v0 = acc[ai][bj][m][0], v1 = acc[ai][bj][m][1];
                    u32x4 w; w.x = cvt_pk(bflo(r.x) + v0[0], bfhi(r.x) + v0[1]); w.y = cvt_pk(bflo(r.y) + v0[2], bfhi(r.y) + v0[3]);
                    w.z = cvt_pk(bflo(r.z) + v1[0], bfhi(r.z) + v1[1]); w.w = cvt_pk(bflo(r.w) + v1[2], bfhi(r.w) + v1[3]);
                    *(u32x4*)(O + off + bj * HALF) = w; } }
        }
    } };
struct EpiRes { static constexpr bool PERM = false; const float* R; float* O; int ld; bf16_t* H;
    DEVI void mid(f32x4 (&)[2][2][4][2], const UnitU&, int, int, int, int) const {}
    DEVI void operator()(const f32x4 (&acc)[2][2][4][2], const UnitU& u, int wr, int wc, int fr, int fq) const {
        const size_t off0 = (size_t)(u.i0 * BM + wr * 64 + fr) * ld + u.i1 * BM + wc * 32 + 4 * fq;
#pragma unroll
        for (int ai = 0; ai < 2; ++ai)
#pragma unroll
            for (int m = 0; m < 4; ++m) { const size_t off = off0 + (size_t)(ai * HALF + m * 16) * ld;
#pragma unroll
                for (int bj = 0; bj < 2; ++bj)
#pragma unroll
                    for (int n = 0; n < 2; ++n) { const f32x4 r = *(const f32x4*)(R + off + bj * HALF + n * 16); const f32x4 o = r + acc[ai][bj][m][n];
                        *(f32x4*)(O + off + bj * HALF + n * 16) = o;
                        u32x2 w; w.x = cvt_pk(o[0], o[1]); w.y = cvt_pk(o[2], o[3]); *(u32x2*)(H + off + bj * HALF + n * 16) = w; } }
    } };
struct DenseSched2 {
    static constexpr bool GATHER = false;
    DenseSched D; int sub;
    DEVI void init(const bf16_t* A_, const bf16_t* Bt_, int M, int N, int K_, int G_, int c_) { D.init(A_, Bt_, M, N, K_, G_, c_); sub = 0; }
    UnitU pend;
    DEVI bool next(UnitU& u) {
        if (sub == 0) { if (!D.next(pend)) return false; u = pend; u.A = pend.A + (size_t)(D.K / 2) * 2; u.B = pend.B + (size_t)(D.K / 2) * 2; u.flags = 1; sub = 1; return true; }
        u = pend; u.flags = 2; sub = 0; return true;
    }
    DEVI void lane_va(const UnitU& u, int R0, int C0, int R1, int C1, unsigned& v00, unsigned& v01, unsigned& v10, unsigned& v11) const { D.lane_va(u, R0, C0, R1, C1, v00, v01, v10, v11); }
};
struct EpiResScale : EpiResBf { const float* ssq;
    DEVI void mid(f32x4 (&acc)[2][2][4][2], const UnitU& u, int wr, int wc, int fr, int fq) const {
        float2 sqv[2][4];
#pragma unroll
        for (int ai = 0; ai < 2; ++ai)
#pragma unroll
            for (int m = 0; m < 4; ++m) sqv[ai][m] = *(const float2*)(ssq + (size_t)(u.i0 * BM + ai * HALF + wr * 64 + m * 16 + fr) * 2);
#pragma unroll
        for (int ai = 0; ai < 2; ++ai)
#pragma unroll
            for (int m = 0; m < 4; ++m) {
                const float2 sq = sqv[ai][m];
                const float rs = rsqrtf((sq.x + sq.y) * (1.0f / 512.0f) + EPS);
#pragma unroll
                for (int bj = 0; bj < 2; ++bj)
#pragma unroll
                    for (int n = 0; n < 2; ++n) acc[ai][bj][m][n] *= rs;
            }
    } };
}

constexpr float LOG2E_C = 1.4426950408889634f;
DEVI void cumsum_task(const DP& p, int bh, char* lds) {
    const int tid = TIDX(), wid = tid >> 6, lane = tid & 63;
    const int b = bh >> 2, h = bh & 3;
    const float* logf = (const float*)(p.ws() + WS_LOGF);
    float* cumf = (float*)(p.ws() + WS_CUMF);
    float* wtot = (float*)lds;
    float v[4];
#pragma unroll
    for (int j = 0; j < 4; ++j) v[j] = logf[((size_t)b * S + tid * 4 + j) * 4 + h];
    v[1] += v[0]; v[2] += v[1]; v[3] += v[2];
    float incl = v[3];
#pragma unroll
    for (int d = 1; d < 64; d <<= 1) { const float t = __shfl_up(incl, d); if (lane >= d) incl += t; }
    if (lane == 63) wtot[wid] = incl;
    __syncthreads();
    float woff = 0.f;
    for (int w = 0; w < wid; ++w) woff += wtot[w];
    const float base = woff + incl - v[3];
    *(float4*)(cumf + (size_t)bh * S + tid * 4) = make_float4((base + v[0]) * LOG2E_C, (base + v[1]) * LOG2E_C, (base + v[2]) * LOG2E_C, (base + v[3]) * LOG2E_C);
    __syncthreads();
}
DEVI void phase_inproj(const DP& p, int l, char* lds) {
    unsigned char* ws = p.ws();
    g8::DenseSched S; S.init((const bf16_t*)(ws + WS_HBUF), (const bf16_t*)(ws + WS_W_IN), T, NPROJ, DM, gridDim.x, BIDX());
    g8::EpiBf16Scale E{(bf16_t*)(ws + WS_PROJ), NPROJ, (const float*)(ws + WS_RSTD1)};
    g8::gemm8(lds, DM, DM, S, E);
}
DEVI void kv_gemm(const DP& p, char* lds) {
    unsigned char* ws = p.ws();
    const int c = BIDX() - ((int)gridDim.x - 64);
    if (c < 0) return;
    g8::DenseSched S; S.init((const bf16_t*)(ws + WS_MEMN), (const bf16_t*)(ws + WS_W_KV), MROWS, 2 * DM, DM, 64, c);
    g8::EpiBf16 E{(bf16_t*)(ws + WS_KV), 2 * DM};
    g8::gemm8(lds, DM, DM, S, E);
}

DEVI void conv8_pos(const DP& p, int l, const bf16_t* proj, int b, int sp, int chan0, float (&out)[8]) {
    float a[8];
    const float* cb = p.in(10) + l * 1024 + chan0;
#pragma unroll
    for (int i = 0; i < 8; ++i) a[i] = cb[i];
#pragma unroll
    for (int j = 0; j < 4; ++j) {
        const int s2 = sp - 3 + j;
        if (s2 >= 0) {
            const u32x4 w = *(const u32x4*)(proj + ((size_t)b * S + s2) * NPROJ + C_XBC + chan0);
            const float* cw = p.in(9) + ((size_t)l * 4 + j) * 1024 + chan0;
            a[0] += cw[0] * bflo(w.x); a[1] += cw[1] * bfhi(w.x); a[2] += cw[2] * bflo(w.y); a[3] += cw[3] * bfhi(w.y);
            a[4] += cw[4] * bflo(w.z); a[5] += cw[5] * bfhi(w.z); a[6] += cw[6] * bflo(w.w); a[7] += cw[7] * bfhi(w.w);
        }
    }
#pragma unroll
    for (int i = 0; i < 8; ++i) out[i] = silu_f(a[i]);
}
DEVI u32x4 pack8(const float (&v)[8]) { u32x4 w; w.x = cvt_pk(v[0], v[1]); w.y = cvt_pk(v[2], v[3]); w.z = cvt_pk(v[4], v[5]); w.w = cvt_pk(v[6], v[7]); return w; }


DEVI void phase_post(const DP& p, int l) {
    const int tid = TIDX(), wid = tid >> 6, lane = tid & 63;
    unsigned char* ws = p.ws();
    bf16_t* proj = (bf16_t*)(ws + WS_PROJ);
    const int sl = lane >> 2, qt = lane & 3, type = sl >> 2, head = sl & 3;
    const int col0 = (type < 2 ? type * 256 : 768 + (type - 2) * 256) + head * 64 + qt * 16;
    const float *gq0 = p.in(5), *gq1 = p.in(6), *gq2 = p.in(7), *gq3 = p.in(8);
    asm volatile("" : "+s"(gq0), "+s"(gq1), "+s"(gq2), "+s"(gq3));
    const float* gain = (type == 0 ? gq0 : type == 1 ? gq1 : type == 2 ? gq2 : gq3) + l * 64 + qt * 16;
    float gv[16];
#pragma unroll
    for (int i = 0; i < 16; ++i) gv[i] = gain[i];
    const float inv[8] = {1.000000000e+00f, 1.939227432e-01f, 3.760603070e-02f, 7.292664610e-03f, 1.414213562e-03f, 2.742481884e-04f, 5.318295734e-05f, 1.031338525e-05f};
    for (int row = BIDX() * 8 + wid; row < T; row += gridDim.x * 8) {
        bf16_t* ptr = proj + (size_t)row * NPROJ + col0;
        const u32x4 w0 = *(const u32x4*)ptr, w1 = *(const u32x4*)(ptr + 8);
        float v[16];
        v[0] = bflo(w0.x); v[1] = bfhi(w0.x); v[2] = bflo(w0.y); v[3] = bfhi(w0.y); v[4] = bflo(w0.z); v[5] = bfhi(w0.z); v[6] = bflo(w0.w); v[7] = bfhi(w0.w);
        v[8] = bflo(w1.x); v[9] = bfhi(w1.x); v[10] = bflo(w1.y); v[11] = bfhi(w1.y); v[12] = bflo(w1.z); v[13] = bfhi(w1.z); v[14] = bflo(w1.w); v[15] = bfhi(w1.w);
        float ss = 0.f;
#pragma unroll
        for (int i = 0; i < 16; ++i) ss += v[i] * v[i];
        ss += __shfl_xor(ss, 1); ss += __shfl_xor(ss, 2);
        const float rstd = rsqrtf(ss * (1.0f / 64.0f) + EPS);
        const float qs = (type == 0 || type == 2) ? rstd * (0.125f * 1.4426950408889634f) : rstd;
#pragma unroll
        for (int i = 0; i < 16; ++i) v[i] = v[i] * qs * gv[i];
        if (type >= 2 && qt == 0) {
            const float pos = (float)(row & (S - 1));
#pragma unroll
            for (int i = 0; i < 8; ++i) { const float rev = __builtin_amdgcn_fractf(pos * inv[i] * 0.15915494309189535f);
                const float sn = __builtin_amdgcn_sinf(rev), cs = __builtin_amdgcn_cosf(rev);
                const float a = v[i], b = v[i + 8]; v[i] = a * cs - b * sn; v[i + 8] = b * cs + a * sn; }
        }
        u32x4 o0, o1;
        o0.x = cvt_pk(v[0], v[1]); o0.y = cvt_pk(v[2], v[3]); o0.z = cvt_pk(v[4], v[5]); o0.w = cvt_pk(v[6], v[7]);
        o1.x = cvt_pk(v[8], v[9]); o1.y = cvt_pk(v[10], v[11]); o1.z = cvt_pk(v[12], v[13]); o1.w = cvt_pk(v[14], v[15]);
        *(u32x4*)ptr = o0; *(u32x4*)(ptr + 8) = o1;
    }
    bf16_t* xc = (bf16_t*)(ws + WS_XC);
    for (int item = BIDX() * NTHR + tid; item < T * 128; item += gridDim.x * NTHR) {
        const int t = item >> 7, c8 = (item & 127) * 8;
        float v[8]; conv8_pos(p, l, proj, t / S, t % S, c8, v);
        *(u32x4*)(xc + (size_t)t * 1024 + c8) = pack8(v);
    }
}
DEVI void phase_knorm(const DP& p, int l) {
    const int tid = TIDX(), wid = tid >> 6, lane = tid & 63;
    unsigned char* ws = p.ws();
    bf16_t* kv = (bf16_t*)(ws + WS_KV);
    const float* kg = p.in(21) + l * 256 + (lane & 15) * 16;
    float kgv[16];
#pragma unroll
    for (int i = 0; i < 16; ++i) kgv[i] = kg[i];
    for (int row = BIDX() * 8 + wid; row < MROWS; row += gridDim.x * 8) {
        bf16_t* ptr = kv + (size_t)row * 2 * DM + lane * 16;
        const u32x4 w0 = *(const u32x4*)ptr, w1 = *(const u32x4*)(ptr + 8);
        float v[16];
        v[0] = bflo(w0.x); v[1] = bfhi(w0.x); v[2] = bflo(w0.y); v[3] = bfhi(w0.y); v[4] = bflo(w0.z); v[5] = bfhi(w0.z); v[6] = bflo(w0.w); v[7] = bfhi(w0.w);
        v[8] = bflo(w1.x); v[9] = bfhi(w1.x); v[10] = bflo(w1.y); v[11] = bfhi(w1.y); v[12] = bflo(w1.z); v[13] = bfhi(w1.z); v[14] = bflo(w1.w); v[15] = bfhi(w1.w);
        float ss = 0.f;
#pragma unroll
        for (int i = 0; i < 16; ++i) ss += v[i] * v[i];
        ss += __shfl_xor(ss, 1); ss += __shfl_xor(ss, 2); ss += __shfl_xor(ss, 4); ss += __shfl_xor(ss, 8);
        const float rstd = rsqrtf(ss * (1.0f / 256.0f) + EPS);
#pragma unroll
        for (int i = 0; i < 16; ++i) v[i] = v[i] * rstd * kgv[i];
        u32x4 o0, o1;
        o0.x = cvt_pk(v[0], v[1]); o0.y = cvt_pk(v[2], v[3]); o0.z = cvt_pk(v[4], v[5]); o0.w = cvt_pk(v[6], v[7]);
        o1.x = cvt_pk(v[8], v[9]); o1.y = cvt_pk(v[10], v[11]); o1.z = cvt_pk(v[12], v[13]); o1.w = cvt_pk(v[14], v[15]);
        *(u32x4*)ptr = o0; *(u32x4*)(ptr + 8) = o1;
    }
}
constexpr float LOG2E = 1.4426950408889634f;
template <int DH> struct AttnLds { static constexpr int KST = DH + 8; static constexpr int TILE = 64 * KST; static constexpr int BYTES = 4 * TILE * 2; };
DEVI float xor16_max(float v) { auto r = __builtin_amdgcn_permlane16_swap(__float_as_uint(v), __float_as_uint(v), false, false); return fmaxf(__uint_as_float(r[0]), __uint_as_float(r[1])); }
DEVI float xor16_sum(float v) { auto r = __builtin_amdgcn_permlane16_swap(__float_as_uint(v), __float_as_uint(v), false, false); return __uint_as_float(r[0]) + __uint_as_float(r[1]); }
DEVI float xor32_max(float v) { auto r = __builtin_amdgcn_permlane32_swap(__float_as_uint(v), __float_as_uint(v), false, false); return fmaxf(__uint_as_float(r[0]), __uint_as_float(r[1])); }
DEVI float xor32_sum(float v) { auto r = __builtin_amdgcn_permlane32_swap(__float_as_uint(v), __float_as_uint(v), false, false); return __uint_as_float(r[0]) + __uint_as_float(r[1]); }
template <int DH, int MODE, int QR>
DEVI void attn_task(const bf16_t* __restrict__ Qb, int ldq, int qtok0, int qstep,
                    const bf16_t* __restrict__ Kb, const bf16_t* __restrict__ Vb, int ldk, int ktok0, int kstep,
                    int p0, int kt_lo, int kt_hi, float scale,
                    const float* __restrict__ cum, const float* __restrict__ qgain,
                    bf16_t* Ob, int ldo, float* Of, float* Om, float* Ol, char* lds) {
    constexpr int KST = AttnLds<DH>::KST, TILE = AttnLds<DH>::TILE, NKK = DH / 32, ND = DH / 16, NCH = (64 * DH / 8) / NTHR;
    constexpr int WR = 16 * QR;
    const int tid = TIDX(), wid = tid >> 6, lane = tid & 63, r16 = lane & 15, g4 = lane >> 4;
    bf16_t* Ks = (bf16_t*)lds;
    bf16_t* Vs = Ks + 2 * TILE;
    const float c2 = scale * LOG2E;
    bf16x8 qf[QR][NKK];
    int qpos[QR];
#pragma unroll
    for (int g = 0; g < QR; ++g) {
        qpos[g] = p0 + wid * WR + g * 16 + r16;
        const bf16_t* qp = Qb + (size_t)(qtok0 + qpos[g] * qstep) * ldq + g4 * 8;
#pragma unroll
        for (int kk = 0; kk < NKK; ++kk) qf[g][kk] = *(const bf16x8*)(qp + kk * 32);
    }
    if (MODE == 2) {
#pragma unroll
        for (int g = 0; g < QR; ++g) {
            float ss = 0.f;
#pragma unroll
            for (int kk = 0; kk < NKK; ++kk)
#pragma unroll
                for (int j = 0; j < 8; ++j) { const float v = bf2f((bf16_t)qf[g][kk][j]); ss += v * v; }
            ss += __shfl_xor(ss, 16); ss += __shfl_xor(ss, 32);
            const float rstd = rsqrtf(ss * (1.0f / DH) + EPS);
#pragma unroll
            for (int kk = 0; kk < NKK; ++kk)
#pragma unroll
                for (int j = 0; j < 8; ++j) { const float v = bf2f((bf16_t)qf[g][kk][j]) * (rstd * c2) * qgain[kk * 32 + g4 * 8 + j]; qf[g][kk][j] = (short)f2bf(v); }
        }
    }
    float m_[QR], cq[QR];
    f32x4 o[QR][ND], o1[QR];
#pragma unroll
    for (int g = 0; g < QR; ++g) {
        m_[g] = 0.f; cq[g] = (MODE == 0) ? cum[qpos[g]] : 0.f;
        o1[g] = (f32x4){0.f, 0.f, 0.f, 0.f};
#pragma unroll
        for (int n = 0; n < ND; ++n) o[g][n] = (f32x4){0.f, 0.f, 0.f, 0.f};
    }
    bf16x8 vones;
#pragma unroll
    for (int j = 0; j < 8; ++j) vones[j] = (short)(r16 == 0 ? 0x3f80 : 0);
    u32x4 rk[NCH], rv[NCH];
    auto gload = [&](int kt) {
#pragma unroll
        for (int i = 0; i < NCH; ++i) { const int c = tid + i * NTHR, key = c / (DH / 8), dc = c % (DH / 8);
            const size_t tok = (size_t)(ktok0 + (kt * 64 + key) * kstep);
            rk[i] = *(const u32x4*)(Kb + tok * ldk + dc * 8); rv[i] = *(const u32x4*)(Vb + tok * ldk + dc * 8); }
    };
    gload(kt_lo);
    __syncthreads();
    int buf = 0;
    for (int kt = kt_lo; kt < kt_hi; ++kt, buf ^= 1) {
        bf16_t* Kt = Ks + buf * TILE;
        bf16_t* Vt = Vs + buf * TILE;
#pragma unroll
        for (int i = 0; i < NCH; ++i) { const int c = tid + i * NTHR, key = c / (DH / 8), dc = c % (DH / 8);
            *(u32x4*)(Kt + key * KST + dc * 8) = rk[i]; *(u32x4*)(Vt + key * KST + dc * 8) = rv[i]; }
        __syncthreads();
        if (kt + 1 < kt_hi) gload(kt + 1);
        const int qmin = p0 + wid * WR, kmin = kt * 64;
        bool skip = false, interior = true;
        if (MODE == 0) { skip = kmin > qmin + WR - 1; interior = kmin + 63 <= qmin; }
        if (MODE == 1) { skip = (qmin + WR - 1 - kmin < 0) || (qmin - (kmin + 63) > 128); interior = (qmin - (kmin + 63) >= 0) && (qmin + WR - 1 - kmin <= 128); }
        if (skip) continue;
        f32x4 s[QR][4];
        float cm[QR];
#pragma unroll
        for (int g = 0; g < QR; ++g) cm[g] = cq[g] - m_[g];
#pragma unroll
        for (int n = 0; n < 4; ++n) {
            f32x4 ck = (f32x4){0.f, 0.f, 0.f, 0.f};
            if (MODE == 0) ck = *(const f32x4*)(cum + kt * 64 + n * 16 + g4 * 4);
#pragma unroll
            for (int g = 0; g < QR; ++g) s[g][n] = (f32x4){cm[g] - ck[0], cm[g] - ck[1], cm[g] - ck[2], cm[g] - ck[3]};
#pragma unroll
            for (int kk = 0; kk < NKK; ++kk) {
                const bf16x8 kf = *(const bf16x8*)(Kt + (n * 16 + r16) * KST + kk * 32 + g4 * 8);
#pragma unroll
                for (int g = 0; g < QR; ++g) s[g][n] = MFMA16(kf, qf[g][kk], s[g][n]);
            }
            if (DH > 64) __builtin_amdgcn_sched_barrier(0);
        }
        float mx[QR];
#pragma unroll
        for (int g = 0; g < QR; ++g) mx[g] = -INFINITY;
#pragma unroll
        for (int n = 0; n < 4; ++n)
#pragma unroll
            for (int g = 0; g < QR; ++g)
#pragma unroll
                for (int j = 0; j < 4; ++j) {
                    float t = s[g][n][j];
                    if (!interior) {
                        const int kpos = kt * 64 + n * 16 + g4 * 4 + j;
                        if (MODE == 0) { if (kpos > qpos[g]) t = -INFINITY; }
                        if (MODE == 1) { const int dd = qpos[g] - kpos; if (dd < 0 || dd > 128) t = -INFINITY; }
                        s[g][n][j] = t;
                    }
                    mx[g] = fmaxf(mx[g], t);
                }
        bool grow = false;
#pragma unroll
        for (int g = 0; g < QR; ++g) { mx[g] = xor32_max(xor16_max(mx[g])); grow = grow || (mx[g] > 8.0f); }
        if (__any(grow)) {
#pragma unroll
            for (int g = 0; g < QR; ++g) {
                const float delta = fmaxf(mx[g], 0.f);
                const float alpha = __builtin_amdgcn_exp2f(-delta);
                m_[g] += delta; o1[g] *= alpha;
#pragma unroll
                for (int n = 0; n < ND; ++n) o[g][n] *= alpha;
#pragma unroll
                for (int n = 0; n < 4; ++n) s[g][n] -= delta;
            }
        }
#pragma unroll
        for (int g = 0; g < QR; ++g)
#pragma unroll
            for (int n = 0; n < 4; ++n)
#pragma unroll
                for (int j = 0; j < 4; ++j) s[g][n][j] = __builtin_amdgcn_exp2f(s[g][n][j]);
#pragma unroll
        for (int kk = 0; kk < 2; ++kk) {
            bf16x8 pb[QR];
#pragma unroll
            for (int g = 0; g < QR; ++g) {
                u32x4 w; w.x = cvt_pk(s[g][2 * kk][0], s[g][2 * kk][1]); w.y = cvt_pk(s[g][2 * kk][2], s[g][2 * kk][3]); w.z = cvt_pk(s[g][2 * kk + 1][0], s[g][2 * kk + 1][1]); w.w = cvt_pk(s[g][2 * kk + 1][2], s[g][2 * kk + 1][3]);
                pb[g] = __builtin_bit_cast(bf16x8, w);
                o1[g] = MFMA16(vones, pb[g], o1[g]);
            }
            const bf16_t* vb = Vt + (kk * 32 + 4 * g4 + (r16 >> 2)) * KST + 4 * (r16 & 3);
#pragma unroll
            for (int n = 0; n < ND; ++n) {
                const s16x4 lo = tr_read(vb + n * 16), hi = tr_read(vb + 16 * KST + n * 16);
                bf16x8 vf; vf[0] = lo[0]; vf[1] = lo[1]; vf[2] = lo[2]; vf[3] = lo[3]; vf[4] = hi[0]; vf[5] = hi[1]; vf[6] = hi[2]; vf[7] = hi[3];
#pragma unroll
                for (int g = 0; g < QR; ++g) o[g][n] = MFMA16(vf, pb[g], o[g][n]);
                if (DH > 64 && (n & 3) == 3) __builtin_amdgcn_sched_barrier(0);
            }
        }
    }
#pragma unroll
    for (int g = 0; g < QR; ++g) {
        const size_t tok = (size_t)(qtok0 + qpos[g] * qstep);
        const float lsum = __shfl(o1[g][0], r16);
        if (MODE == 1) {
#pragma unroll
            for (int n = 0; n < ND; ++n) *(f32x4*)(Of + tok * 256 + n * 16 + g4 * 4) = o[g][n];
            if (g4 == 0) { Om[tok * 4] = m_[g]; Ol[tok * 4] = lsum; }
        } else {
            const float inv = 1.0f / lsum;
#pragma unroll
            for (int n = 0; n < ND; ++n) { u32x2 w; w.x = cvt_pk(o[g][n][0] * inv, o[g][n][1] * inv); w.y = cvt_pk(o[g][n][2] * inv, o[g][n][3] * inv);
                *(u32x2*)(Ob + tok * ldo + n * 16 + g4 * 4) = w; }
        }
    }
}

DEVI void ssd_acs(const DP& p, int l, int b, int c, int g, float* acs, float* dts) {
    const int tid = TIDX(), wid = tid >> 6, lane = tid & 63;
    if (wid < 4) {
        const int head = g * 4 + wid;
        const float* dtv = (const float*)(p.ws() + WS_DTV);
        const float A = -__expf(p.in(12)[l * 8 + head]);
        const size_t t0 = (size_t)b * S + c * 128 + 2 * lane;
        const float d0 = dtv[t0 * 8 + head], d1 = dtv[(t0 + 1) * 8 + head];
        const float a0 = d0 * A, a1 = d1 * A;
        float incl = a0 + a1;
#pragma unroll
        for (int d = 1; d < 64; d <<= 1) { const float t = __shfl_up(incl, d); if (lane >= d) incl += t; }
        const float ex = incl - (a0 + a1);
        acs[wid * 128 + 2 * lane] = ex + a0; acs[wid * 128 + 2 * lane + 1] = ex + a0 + a1;
        dts[wid * 128 + 2 * lane] = d0; dts[wid * 128 + 2 * lane + 1] = d1;
    }
}
DEVI void conv8_chan(const DP& p, int l, const bf16_t* proj, int b, int c, int chan, int l0, float (&out)[8]) {
    const float* cw = p.in(9) + (size_t)l * 4 * 1024 + chan;
    const float w0 = cw[0], w1 = cw[1024], w2 = cw[2048], w3 = cw[3072], cb = p.in(10)[l * 1024 + chan];
    float v[11];
    const int sbase = c * 128 + l0 - 3;
#pragma unroll
    for (int i = 0; i < 11; ++i) { const int sp = sbase + i; v[i] = sp >= 0 ? bf2f(proj[((size_t)b * S + sp) * NPROJ + C_XBC + chan]) : 0.f; }
#pragma unroll
    for (int i = 0; i < 8; ++i) out[i] = silu_f(cb + w0 * v[i] + w1 * v[i + 1] + w2 * v[i + 2] + w3 * v[i + 3]);
}
constexpr int SST = 136;
constexpr int XST4 = 264;
DEVI void ssd_states_task(const DP& p, int l, int b, int c, int g, char* lds) {
    const int tid = TIDX(), wid = tid >> 6, lane = tid & 63, r16 = lane & 15, g4 = lane >> 4;
    const bf16_t* xc = (const bf16_t*)(p.ws() + WS_XC);
    bf16_t* Bn = (bf16_t*)lds;
    bf16_t* Xn = Bn + 128 * SST;
    float* acs = (float*)(Xn + 128 * XST4);
    float* dts = acs + 512;
    __syncthreads();
    ssd_acs(p, l, b, c, g, acs, dts);
    __syncthreads();
    if (tid < 4) ((float*)(p.ws() + WS_DECAY))[((size_t)b * 16 + c) * 8 + g * 4 + tid] = __expf(acs[tid * 128 + 127]);
    const size_t tok0 = (size_t)b * S + c * 128;
    for (int it = tid; it < 2048; it += NTHR) {
        const int ll = it >> 4, nc = (it & 15) * 8;
        *(u32x4*)(Bn + ll * SST + nc) = *(const u32x4*)(xc + (tok0 + ll) * 1024 + 512 + g * 128 + nc);
    }
    for (int it = tid; it < 4096; it += NTHR) {
        const int ll = it >> 5, ch = (it & 31) * 8, hl = ch >> 6;
        const u32x4 w = *(const u32x4*)(xc + (tok0 + ll) * 1024 + g * 256 + ch);
        const float sc = dts[hl * 128 + ll] * __expf(acs[hl * 128 + 127] - acs[hl * 128 + ll]);
        u32x4 o; o.x = cvt_pk(bflo(w.x) * sc, bfhi(w.x) * sc); o.y = cvt_pk(bflo(w.y) * sc, bfhi(w.y) * sc); o.z = cvt_pk(bflo(w.z) * sc, bfhi(w.z) * sc); o.w = cvt_pk(bflo(w.w) * sc, bfhi(w.w) * sc);
        *(u32x4*)(Xn + ll * XST4 + ch) = o;
    }
    __syncthreads();
    const int hl = wid >> 1, nh = wid & 1;
    f32x4 acc[4][4];
#pragma unroll
    for (int m = 0; m < 4; ++m)
#pragma unroll
        for (int n = 0; n < 4; ++n) acc[m][n] = (f32x4){0.f, 0.f, 0.f, 0.f};
#pragma unroll
    for (int kk = 0; kk < 4; ++kk) {
        bf16x8 af[4], bfr[4];
        const int lrow = kk * 32 + 8 * g4 + (r16 >> 2), cq = 4 * (r16 & 3);
#pragma unroll
        for (int m = 0; m < 4; ++m) { const bf16_t* a = Xn + lrow * XST4 + hl * 64 + m * 16 + cq; const s16x4 lo = tr_read(a), hi = tr_read(a + 4 * XST4);
            af[m][0] = lo[0]; af[m][1] = lo[1]; af[m][2] = lo[2]; af[m][3] = lo[3]; af[m][4] = hi[0]; af[m][5] = hi[1]; af[m][6] = hi[2]; af[m][7] = hi[3]; }
#pragma unroll
        for (int n = 0; n < 4; ++n) { const bf16_t* a = Bn + lrow * SST + nh * 64 + n * 16 + cq; const s16x4 lo = tr_read(a), hi = tr_read(a + 4 * SST);
            bfr[n][0] = lo[0]; bfr[n][1] = lo[1]; bfr[n][2] = lo[2]; bfr[n][3] = lo[3]; bfr[n][4] = hi[0]; bfr[n][5] = hi[1]; bfr[n][6] = hi[2]; bfr[n][7] = hi[3]; }
#pragma unroll
        for (int m = 0; m < 4; ++m)
#pragma unroll
            for (int n = 0; n < 4; ++n) acc[m][n] = MFMA16(bfr[n], af[m], acc[m][n]);
    }
    float* st = (float*)(p.ws() + WS_SSTATE) + (((size_t)b * 16 + c) * 8 + g * 4 + hl) * 8192;
#pragma unroll
    for (int m = 0; m < 4; ++m)
#pragma unroll
        for (int n = 0; n < 4; ++n) *(f32x4*)(st + (m * 16 + r16) * 128 + nh * 64 + n * 16 + g4 * 4) = acc[m][n];
}
DEVI void phase_ssd_scan(const DP& p) {
    const float* st = (const float*)(p.ws() + WS_SSTATE);
    bf16_t* hin = (bf16_t*)(p.ws() + WS_HIN);
    const float* decay = (const float*)(p.ws() + WS_DECAY);
    const int total = NB * 8 * 2048;
    for (int i = BIDX() * NTHR + TIDX(); i < total; i += gridDim.x * NTHR) {
        const int e4 = i & 2047, head = (i >> 11) & 7, b = i >> 14;
        f32x4 h = (f32x4){0.f, 0.f, 0.f, 0.f};
        f32x4 sv[15]; float dv[15];
#pragma unroll
        for (int c = 0; c < 15; ++c) { sv[c] = *(const f32x4*)(st + (((size_t)b * 16 + c) * 8 + head) * 8192 + e4 * 4); dv[c] = decay[((size_t)b * 16 + c) * 8 + head]; }
#pragma unroll
        for (int c = 0; c < 16; ++c) {
            const size_t off = (((size_t)b * 16 + c) * 8 + head) * 8192 + e4 * 4;
            u32x2 w; w.x = cvt_pk(h[0], h[1]); w.y = cvt_pk(h[2], h[3]);
            *(u32x2*)(hin + off) = w;
            if (c < 15) h = h * dv[c] + sv[c];
        }
    }
}
constexpr int XST1 = 72;
DEVI void ssd_out_task(const DP& p, int l, int b, int c, int g, char* lds) {
    const int tid = TIDX(), wid = tid >> 6, lane = tid & 63, r16 = lane & 15, g4 = lane >> 4;
    const bf16_t* proj = (const bf16_t*)(p.ws() + WS_PROJ);
    const bf16_t* xc = (const bf16_t*)(p.ws() + WS_XC);
    bf16_t* Cs = (bf16_t*)lds;
    bf16_t* Bs = Cs + 128 * SST;
    bf16_t* Xn = Bs + 128 * SST;
    bf16_t* Hs = Xn + 128 * XST1;
    bf16_t* Mw = Hs + 64 * SST + wid * 16 * SST;
    float* acs = (float*)(Hs + 64 * SST + 8 * 16 * SST);
    float* dts = acs + 512;
    const int lrow = wid * 16 + r16;
    const size_t tok0 = (size_t)b * S + c * 128, tok = tok0 + lrow;
    bf16_t* mix = (bf16_t*)(p.ws() + WS_MIX);
    float ssq = 0.f;
    __syncthreads();
    ssd_acs(p, l, b, c, g, acs, dts);
    for (int it = tid; it < 2048; it += NTHR) {
        const int ll = it >> 4, nc = (it & 15) * 8;
        *(u32x4*)(Cs + ll * SST + nc) = *(const u32x4*)(xc + (tok0 + ll) * 1024 + 768 + g * 128 + nc);
        *(u32x4*)(Bs + ll * SST + nc) = *(const u32x4*)(xc + (tok0 + ll) * 1024 + 512 + g * 128 + nc);
    }
    __syncthreads();
    bf16x8 cfr[4];
#pragma unroll
    for (int kk = 0; kk < 4; ++kk) cfr[kk] = *(const bf16x8*)(Cs + lrow * SST + kk * 32 + g4 * 8);
    f32x4 cb[8];
#pragma unroll
    for (int st = 0; st < 8; ++st) {
        cb[st] = (f32x4){0.f, 0.f, 0.f, 0.f};
#pragma unroll
        for (int kk = 0; kk < 4; ++kk) {
            const bf16x8 bfr = *(const bf16x8*)(Bs + (st * 16 + r16) * SST + kk * 32 + g4 * 8);
            cb[st] = MFMA16(bfr, cfr[kk], cb[st]);
        }
    }
    u32x4 px[2], ph[2];
    auto hload = [&](int hl_) {
        const int head_ = g * 4 + hl_;
#pragma unroll
        for (int i = 0; i < 2; ++i) { const int it = tid + i * NTHR, ss = it >> 3, pc8 = (it & 7) * 8;
            px[i] = *(const u32x4*)(xc + (tok0 + ss) * 1024 + head_ * 64 + pc8);
            ph[i] = *(const u32x4*)((const bf16_t*)(p.ws() + WS_HIN) + (((size_t)b * 16 + c) * 8 + head_) * 8192 + (size_t)it * 8); }
    };
    hload(0);
    for (int hl = 0; hl < 4; ++hl) {
        const int head = g * 4 + hl;
        __syncthreads();
#pragma unroll
        for (int i = 0; i < 2; ++i) { const int it = tid + i * NTHR, ss = it >> 3, pc8 = (it & 7) * 8;
            *(u32x4*)(Xn + ss * XST1 + pc8) = px[i];
            *(u32x4*)(Hs + (it >> 4) * SST + (it & 15) * 8) = ph[i]; }
        __syncthreads();
        if (hl + 1 < 4) hload(hl + 1);
        u32x2 zpre[4];
#pragma unroll
        for (int pt = 0; pt < 4; ++pt) zpre[pt] = *(const u32x2*)(proj + tok * NPROJ + C_Z + head * 64 + pt * 16 + g4 * 4);
        const float al = acs[hl * 128 + lrow];
#pragma unroll
        for (int st = 0; st < 8; ++st) {
            float mv[4];
            const float4 a4 = *(const float4*)(acs + hl * 128 + st * 16 + g4 * 4), d4 = *(const float4*)(dts + hl * 128 + st * 16 + g4 * 4);
            const float av[4] = {a4.x, a4.y, a4.z, a4.w}, dv[4] = {d4.x, d4.y, d4.z, d4.w};
#pragma unroll
            for (int j = 0; j < 4; ++j) { const int sidx = st * 16 + g4 * 4 + j;
                mv[j] = (sidx <= lrow) ? cb[st][j] * __expf(al - av[j]) * dv[j] : 0.f; }
            u32x2 w; w.x = cvt_pk(mv[0], mv[1]); w.y = cvt_pk(mv[2], mv[3]);
            *(u32x2*)(Mw + r16 * SST + st * 16 + g4 * 4) = w;
        }
        __builtin_amdgcn_wave_barrier();
        asm volatile("s_waitcnt lgkmcnt(0)" ::: "memory");
        f32x4 yd[4], yo[4];
#pragma unroll
        for (int pt = 0; pt < 4; ++pt) { yd[pt] = (f32x4){0.f, 0.f, 0.f, 0.f}; yo[pt] = (f32x4){0.f, 0.f, 0.f, 0.f}; }
#pragma unroll
        for (int kk = 0; kk < 4; ++kk) {
            const bf16x8 mf = *(const bf16x8*)(Mw + r16 * SST + kk * 32 + g4 * 8);
            const bf16_t* xa = Xn + (kk * 32 + 8 * g4 + (r16 >> 2)) * XST1 + 4 * (r16 & 3);
#pragma unroll
            for (int pt = 0; pt < 4; ++pt) {
                const s16x4 lo = tr_read(xa + pt * 16), hi = tr_read(xa + 4 * XST1 + pt * 16);
                bf16x8 xf; xf[0] = lo[0]; xf[1] = lo[1]; xf[2] = lo[2]; xf[3] = lo[3]; xf[4] = hi[0]; xf[5] = hi[1]; xf[6] = hi[2]; xf[7] = hi[3];
                yd[pt] = MFMA16(xf, mf, yd[pt]);
                const bf16x8 hf = *(const bf16x8*)(Hs + (pt * 16 + r16) * SST + kk * 32 + g4 * 8);
                yo[pt] = MFMA16(hf, cfr[kk], yo[pt]);
            }
        }
        __builtin_amdgcn_wave_barrier();
        const float el = __expf(al), Dh = p.in(13)[l * 8 + head];
#pragma unroll
        for (int pt = 0; pt < 4; ++pt) {
            const int pc = pt * 16 + g4 * 4;
            const u32x2 zw = zpre[pt];
            const u32x2 xw = *(const u32x2*)(Xn + lrow * XST1 + pc);
            const float zz[4] = {bflo(zw.x), bfhi(zw.x), bflo(zw.y), bfhi(zw.y)};
            const float xx[4] = {bflo(xw.x), bfhi(xw.x), bflo(xw.y), bfhi(xw.y)};
            float gv[4];
#pragma unroll
            for (int j = 0; j < 4; ++j) { const float yv = yd[pt][j] + el * yo[pt][j] + Dh * xx[j]; gv[j] = yv * silu_f(zz[j]); ssq += gv[j] * gv[j]; }
            u32x2 w; w.x = cvt_pk(gv[0], gv[1]); w.y = cvt_pk(gv[2], gv[3]);
            *(u32x2*)(mix + tok * DM + 512 + head * 64 + pc) = w;
        }
    }
    ssq += __shfl_xor(ssq, 16); ssq += __shfl_xor(ssq, 32);
    if (g4 == 0) ((float*)(p.ws() + WS_SSQ))[tok * 2 + g] = ssq;
}
constexpr int N_FOX = 512, N_S1 = 256, N_DIL = 1536;
DEVI void phase_mix1(const DP& p, int l, char* lds) {
    unsigned char* ws = p.ws();
    kv_gemm(p, lds);
    const bf16_t* proj = (const bf16_t*)(ws + WS_PROJ);
    bf16_t* mix = (bf16_t*)(ws + WS_MIX);
    const int G = gridDim.x, bid = BIDX();
    for (int u = bid; u < N_S1; u += G) { const int g = u & 1, c = (u >> 1) & 15, b = u >> 5; ssd_states_task(p, l, b, c, g, lds); }
    const int nfw = G / 2;
    if (bid < nfw) {
        for (int t = bid; t < 128; t += nfw) {
            const int bh = t & 31, k = t >> 5, b = bh >> 2, h = bh & 3;
            const float* cum = (const float*)(ws + WS_CUMF) + (size_t)bh * S;
#pragma unroll 1
            for (int half = 0; half < 2; ++half) {
                const int qb = half == 0 ? 7 - k : k;
                attn_task<64, 0, 2>(proj + C_FQ + h * 64, NPROJ, b * S, 1, proj + C_FK + h * 64, proj + C_FV + h * 64, NPROJ, b * S, 1,
                                    qb * 256, 0, 4 * qb + 4, 0.125f, cum, nullptr, mix + h * 64, DM, nullptr, nullptr, nullptr, lds);
            }
        }
    } else {
        const int ndw = G - nfw;
        for (int u = bid - nfw; u < 1024; u += ndw) {
            const int bh = u & 31, v = u >> 5, b = bh >> 2, h = bh & 3;
            if (v < 16) {
                const int br = v >> 3, dil = br ? 4 : 1, r = br ? ((v - 8) & 3) : 0, pb = br ? ((v - 8) >> 2) : v;
                float* Of = (float*)(ws + WS_DILO) + (size_t)br * T * 256 + h * 64;
                float* Om = (float*)(ws + WS_DILM) + (size_t)br * T * 4 + h;
                float* Ol = (float*)(ws + WS_DILL) + (size_t)br * T * 4 + h;
                const int klo = pb > 0 ? 4 * pb - 2 : 0;
                attn_task<64, 1, 2>(proj + C_DQ + h * 64, NPROJ, b * S + r, dil, proj + C_DK + h * 64, proj + C_DV + h * 64, NPROJ, b * S + r, dil,
                                    pb * 256, klo, 4 * pb + 4, 0.125f, nullptr, nullptr, nullptr, 0, Of, Om, Ol, lds);
            } else {
                const int r = v - 16;
                float* Of = (float*)(ws + WS_DILO) + (size_t)2 * T * 256 + h * 64;
                float* Om = (float*)(ws + WS_DILM) + (size_t)2 * T * 4 + h;
                float* Ol = (float*)(ws + WS_DILL) + (size_t)2 * T * 4 + h;
                attn_task<64, 1, 1>(proj + C_DQ + h * 64, NPROJ, b * S + r, 16, proj + C_DK + h * 64, proj + C_DV + h * 64, NPROJ, b * S + r, 16,
                                    0, 0, 2, 0.125f, nullptr, nullptr, nullptr, 0, Of, Om, Ol, lds);
            }
        }
    }
}
DEVI void phase_mix3(const DP& p, int l, char* lds) {
    unsigned char* ws = p.ws();
    for (int t = BIDX(); t < NB * 16 * 2; t += gridDim.x) ssd_out_task(p, l, t >> 5, (t >> 1) & 15, t & 1, lds);
    const int tid = TIDX(), wid = tid >> 6, lane = tid & 63, head = lane >> 4, d4 = (lane & 15) * 4;
    const float* Of = (const float*)(ws + WS_DILO);
    const float* Om = (const float*)(ws + WS_DILM);
    const float* Ol = (const float*)(ws + WS_DILL);
    bf16_t* mix = (bf16_t*)(ws + WS_MIX);
    for (int row = BIDX() * 8 + wid; row < T; row += gridDim.x * 8) {
        float m[3], lsum[3];
#pragma unroll
        for (int br = 0; br < 3; ++br) { m[br] = Om[((size_t)br * T + row) * 4 + head]; lsum[br] = Ol[((size_t)br * T + row) * 4 + head]; }
        const float M = fmaxf(m[0], fmaxf(m[1], m[2]));
        f32x4 num = (f32x4){0.f, 0.f, 0.f, 0.f}; float den = 0.f;
#pragma unroll
        for (int br = 0; br < 3; ++br) {
            const float w = __builtin_amdgcn_exp2f(m[br] - M);
            const f32x4 o = *(const f32x4*)(Of + ((size_t)br * T + row) * 256 + head * 64 + d4);
            num += o * w; den += w * lsum[br];
        }
        const float inv = 1.0f / den;
        u32x2 w; w.x = cvt_pk(num[0] * inv, num[1] * inv); w.y = cvt_pk(num[2] * inv, num[3] * inv);
        *(u32x2*)(mix + (size_t)row * DM + 256 + head * 64 + d4) = w;
    }
}
DEVI void phase_xattn(const DP& p, int l, char* lds) {
    unsigned char* ws = p.ws();
    const bf16_t* qbuf = (const bf16_t*)(ws + WS_QBUF);
    const bf16_t* kv = (const bf16_t*)(ws + WS_KV);
    bf16_t* obuf = (bf16_t*)(ws + WS_OBUF);
    for (int t = BIDX(); t < NB * 4 * 16; t += gridDim.x) {
        const int qb = t & 15, h = (t >> 4) & 3, b = t >> 6;
        attn_task<256, 2, 1>(qbuf + h * 256, DM, b * S, 1, kv + h * 256, kv + DM + h * 256, 2 * DM, b * MEMLEN, 1,
                          qb * 128, 0, 4, 0.0625f, nullptr, p.in(20) + l * 256, obuf + h * 256, DM, nullptr, nullptr, nullptr, lds);
    }
}
namespace g8 {
template <bool GATHER_> struct MoeSched {
    static constexpr bool GATHER = GATHER_;
    const int* cnt; const int* list; const char* Abase; const char* Bbase; size_t bstride; int K, G;
    int ei, ubase, u, step, x, nxcd;
    DEVI void init(const int* cnt_, const int* list_, const void* A_, const void* B_, size_t bstride_, int K_, int G_, int c_) {
        cnt = cnt_; list = list_; Abase = (const char*)A_; Bbase = (const char*)B_; bstride = bstride_; K = K_; G = G_;
        nxcd = (G_ % 8 == 0) ? 8 : 1; x = c_ % nxcd; step = G_ / nxcd; u = c_ / nxcd; ei = 0; ubase = 0; }
    DEVI bool next(UnitU& o) {
        while (x + nxcd * ei < NEXP) {
            const int e = x + nxcd * ei;
            const int ce = cnt[e], nte = (ce + BM - 1) / BM, nun = nte * 4;
            if (u < ubase + nun) {
                const int lu = u - ubase, pm = lu >> 2, pn = lu & 3;
                int tbase = 0;
                for (int e2 = 0; e2 < e; ++e2) tbase += (cnt[e2] + BM - 1) / BM;
                o.i0 = tbase + pm; o.i1 = pn; o.i2 = e * (2 * T) + pm * BM; o.i3 = ce - pm * BM; o.flags = 3;
                o.A = GATHER ? Abase : Abase + (size_t)(tbase + pm) * BM * K * 2;
                o.B = Bbase + (size_t)e * bstride + (size_t)pn * BM * K * 2;
                u += step; return true;
            }
            ubase += nun; ++ei;
        }
        return false;
    }
    DEVI void lane_va(const UnitU& o, int R0, int C0, int R1, int C1, unsigned& v00, unsigned& v01, unsigned& v10, unsigned& v11) const {
        if (GATHER) {
            const int nv = o.i3; const int* ent = list + o.i2;
            const int t00 = (ent[R0 < nv ? R0 : 0] & 0xffff) >> 1, t01 = (ent[R1 < nv ? R1 : 0] & 0xffff) >> 1, t10 = (ent[R0 + HALF < nv ? R0 + HALF : 0] & 0xffff) >> 1, t11 = (ent[R1 + HALF < nv ? R1 + HALF : 0] & 0xffff) >> 1;
            v00 = (unsigned)(t00 * K + C0) * 2u; v01 = (unsigned)(t01 * K + C1) * 2u; v10 = (unsigned)(t10 * K + C0) * 2u; v11 = (unsigned)(t11 * K + C1) * 2u;
        } else {
            v00 = (unsigned)(R0 * K + C0) * 2u; v01 = (unsigned)(R1 * K + C1) * 2u; v10 = v00 + (unsigned)(HALF * K * 2); v11 = v01 + (unsigned)(HALF * K * 2);
        }
    }
};
struct EpiSwiglu { static constexpr bool PERM = false; bf16_t* act;
    DEVI void mid(f32x4 (&)[2][2][4][2], const UnitU&, int, int, int, int) const {}
    DEVI void operator()(const f32x4 (&acc)[2][2][4][2], const UnitU& u, int wr, int wc, int fr, int fq) const {
        const int nv = u.i3;
#pragma unroll
        for (int ai = 0; ai < 2; ++ai)
#pragma unroll
            for (int m = 0; m < 4; ++m) {
                const int r = ai * HALF + wr * 64 + m * 16 + fr;
                if (r < nv) {
                    bf16_t* rowp = act + (size_t)(u.i0 * BM + r) * EFF + u.i1 * 128 + wc * 16 + 4 * fq;
#pragma unroll
                    for (int bj = 0; bj < 2; ++bj) { const f32x4 x1 = acc[ai][bj][m][0], x3 = acc[ai][bj][m][1];
                        u32x2 w; w.x = cvt_pk(silu_f(x1[0]) * x3[0], silu_f(x1[1]) * x3[1]); w.y = cvt_pk(silu_f(x1[2]) * x3[2], silu_f(x1[3]) * x3[3]);
                        *(u32x2*)(rowp + bj * 64) = w; }
                }
            }
    } };
struct EpiMoeOut { static constexpr bool PERM = true; bf16_t* y; const int* list;
    DEVI void mid(f32x4 (&)[2][2][4][2], const UnitU&, int, int, int, int) const {}
    DEVI void operator()(const f32x4 (&acc)[2][2][4][2], const UnitU& u, int wr, int wc, int fr, int fq) const {
        const int nv = u.i3; const int* ent = list + u.i2;
        unsigned env[2][4];
#pragma unroll
        for (int ai = 0; ai < 2; ++ai)
#pragma unroll
            for (int m = 0; m < 4; ++m) { const int r = ai * HALF + wr * 64 + m * 16 + fr; env[ai][m] = (unsigned)ent[r < nv ? r : 0]; }
#pragma unroll
        for (int ai = 0; ai < 2; ++ai)
#pragma unroll
            for (int m = 0; m < 4; ++m) {
                const int r = ai * HALF + wr * 64 + m * 16 + fr;
                if (r < nv) {
                    const unsigned en = env[ai][m]; const int a = (int)(en & 0xffffu); const float gt = __uint_as_float(en & 0xffff0000u);
                    bf16_t* rowp = y + (size_t)a * DM + u.i1 * BM + wc * 32 + 8 * fq;
#pragma unroll
                    for (int bj = 0; bj < 2; ++bj) { const f32x4 v0 = acc[ai][bj][m][0] * gt, v1 = acc[ai][bj][m][1] * gt;
                        u32x4 w; w.x = cvt_pk(v0[0], v0[1]); w.y = cvt_pk(v0[2], v0[3]); w.z = cvt_pk(v1[0], v1[1]); w.w = cvt_pk(v1[2], v1[3]);
                        *(u32x4*)(rowp + bj * HALF) = w; }
                }
            }
    } };
}
template <int WHICH>
DEVI void phase_moe(const DP& p, int l, char* lds) {
    unsigned char* ws = p.ws();
    const int* cnt = (const int*)(ws + WS_CNT) + l * 64;
    const int* list = (const int*)(ws + WS_LIST);
    if (WHICH == 0) {
        g8::MoeSched<true> S;
        S.init(cnt, list, ws + WS_H3, ws + WS_W_13, (size_t)1024 * DM * 2, DM, gridDim.x, BIDX());
        g8::EpiSwiglu E{(bf16_t*)(ws + WS_ACT)};
        g8::gemm8(lds, DM, DM, S, E);
    } else {
        g8::MoeSched<false> S;
        S.init(cnt, list, ws + WS_ACT, ws + WS_W_2, (size_t)DM * EFF * 2, EFF, gridDim.x, BIDX());
        g8::EpiMoeOut E{(bf16_t*)(ws + WS_YBUF), list};
        g8::gemm8(lds, EFF, EFF, S, E);
    }
}
DEVI void phase_final(const DP& p) {
    const int tid = TIDX(), wid = tid >> 6, lane = tid & 63;
    const bf16_t* ybuf = (const bf16_t*)(p.ws() + WS_YBUF);
    const bf16_t* h0 = (const bf16_t*)(p.ws() + WS_HBUF);
    float* out = p.out();
    for (int row = BIDX() * 8 + wid; row < T; row += gridDim.x * 8) {
        float x[16];
        load_row_bf16(h0 + (size_t)row * DM, x, lane);
        add_row_bf16_b(ybuf + (size_t)(2 * row) * DM, x, lane);
        add_row_bf16_b(ybuf + (size_t)(2 * row + 1) * DM, x, lane);
#pragma unroll
        for (int j = 0; j < 2; ++j) {
            *(float4*)(out + (size_t)row * DM + j * 512 + lane * 8) = make_float4(x[8 * j], x[8 * j + 1], x[8 * j + 2], x[8 * j + 3]);
            *(float4*)(out + (size_t)row * DM + j * 512 + lane * 8 + 4) = make_float4(x[8 * j + 4], x[8 * j + 5], x[8 * j + 6], x[8 * j + 7]);
        }
    }
}

#define XB_TMO      128
#define XB_XCNT(j)  (256  + 64 * (j))
#define XB_XSUB(j)  (1280 + 64 * (j))
#define XB_XGEN(j)  (2304 + 64 * (j))
#define XB_TOP      3328
#define XB_TOPGEN   3392
#define XCD_BAR_WORDS 3456
#define XB_SPIN_CAP (1u << 22)
DEVI unsigned xb_ld(unsigned* p)              { return __hip_atomic_load(p, __ATOMIC_RELAXED, __HIP_MEMORY_SCOPE_AGENT); }
DEVI unsigned xb_add(unsigned* p, unsigned v) { return __hip_atomic_fetch_add(p, v, __ATOMIC_RELAXED, __HIP_MEMORY_SCOPE_AGENT); }
DEVI unsigned xb_xcc_id() { return (unsigned)__builtin_amdgcn_s_getreg((3 << 11) | 20) & 0xFu; }
#define XB_SPIN(cond, bar) do { unsigned _sp = 0; while (cond) { __builtin_amdgcn_s_sleep(1); \
    if ((++_sp & 255u) == 0u) { if (xb_ld(&(bar)[XB_TMO])) break; if (_sp > XB_SPIN_CAP) { atomicAdd(&(bar)[XB_TMO], 1u); break; } } } } while (0)
struct XcdBarrier { unsigned* bar; unsigned x; volatile LAS unsigned* st; };
DEVI XcdBarrier xcd_barrier_post(unsigned* bar, volatile LAS unsigned* st) {
    XcdBarrier b; b.bar = bar; b.x = xb_xcc_id(); b.st = st;
    if (threadIdx.x == 0) (void)xb_add(&bar[XB_XCNT(b.x)], 1u);
    return b;
}
DEVI void xcd_barrier_complete(unsigned* bar, unsigned x, unsigned& nloc, unsigned& nx) {
    const unsigned G = gridDim.x * gridDim.y * gridDim.z;
    unsigned sum, cnt, mine, sp = 0u;
    for (;;) {
        sum = 0u; cnt = 0u; mine = 0u;
#pragma unroll
        for (unsigned j = 0; j < 16; ++j) { const unsigned c = xb_ld(&bar[XB_XCNT(j)]); sum += c; cnt += (c > 0u) ? 1u : 0u; mine = (j == x) ? c : mine; }
        if (sum == G) break;
        __builtin_amdgcn_s_sleep(1);
        if ((++sp & 255u) == 0u) { if (xb_ld(&bar[XB_TMO])) break; if (sp > XB_SPIN_CAP) { atomicAdd(&bar[XB_TMO], 1u); break; } }
    }
    nloc = mine > 0u ? mine : 1u; nx = cnt > 0u ? cnt : 1u;
}
DEVI void xcd_barrier(const XcdBarrier& b) {
    asm volatile("s_waitcnt vmcnt(0)" ::: "memory");
    __syncthreads();
    if (threadIdx.x == 0) {
        unsigned* bar = b.bar;
        __builtin_amdgcn_s_waitcnt(0);
        unsigned nloc = b.st[0], nx = b.st[1];
        if (nloc == 0u) { xcd_barrier_complete(bar, b.x, nloc, nx); b.st[0] = nloc; b.st[1] = nx; }
        const unsigned old = xb_add(&bar[XB_XSUB(b.x)], 1u);
        const unsigned gen = old / nloc;
        if (old + 1u == (gen + 1u) * nloc) {
            __builtin_amdgcn_fence(__ATOMIC_RELEASE, "agent");
            asm volatile("s_waitcnt vmcnt(0)" ::: "memory");
            const unsigned og = xb_add(&bar[XB_TOP], 1u);
            const unsigned tg = og / nx;
            if (og + 1u == (tg + 1u) * nx) xb_add(&bar[XB_TOPGEN], 1u);
            else XB_SPIN(xb_ld(&bar[XB_TOPGEN]) == tg, bar);
            __builtin_amdgcn_fence(__ATOMIC_ACQUIRE, "agent");
            xb_add(&bar[XB_XGEN(b.x)], 1u);
            asm volatile("s_waitcnt vmcnt(0)" ::: "memory");
        } else {
            XB_SPIN(xb_ld(&bar[XB_XGEN(b.x)]) == gen, bar);
            __builtin_amdgcn_fence(__ATOMIC_ACQUIRE, "agent");
            asm volatile("s_waitcnt vmcnt(0)" ::: "memory");
        }
    }
    __syncthreads();
}

constexpr int N_PHASES = 27;
__global__ void __launch_bounds__(NTHR) hybrid_fwd(Params p_unused) {
    extern __shared__ __attribute__((aligned(16))) char lds_base[];
    karg_ptr kp = (karg_ptr)__builtin_amdgcn_kernarg_segment_ptr();
    int ph_lo, ph_hi, use_gs;
    { DP q{kp}; ph_lo = q.ph_lo(); ph_hi = q.ph_hi(); use_gs = q.use_gs(); }
    volatile LAS unsigned* xst = (volatile LAS unsigned*)(LAS char*)(lds_base + LDS_BYTES - 16);
    if (threadIdx.x == 0) { xst[0] = 0u; xst[1] = 0u; }
    __syncthreads();
    XcdBarrier xb; xb.bar = nullptr; xb.x = 0; xb.st = xst;
    if (use_gs == 1) { DP q{kp}; xb = xcd_barrier_post((unsigned*)(q.ws() + WS_BAR), xst); }
#define RUN_PHASE(PH, ...) \
    if (ph_lo <= (PH) && (PH) < ph_hi) { \
        if ((PH) > ph_lo) { if (use_gs == 1) xcd_barrier(xb); else if (use_gs == 2) cg::this_grid().sync(); } \
        asm volatile("" : "+s"(kp) :: "memory"); \
        const DP p{kp}; \
        unsigned lds_off = 0; asm volatile("" : "+s"(lds_off)); \
        char* lds = lds_base + lds_off; \
        unsigned char* ws = p.ws(); (void)ws; (void)lds; \
        __VA_ARGS__ \
    }
#define LAYER_PHASES(L, B0) \
    RUN_PHASE((B0) + 0, { if ((L) == 0) prep_small(p); prep_all(p, (L), lds); __syncthreads(); phase_norm1(p, (L), lds); }) \
    RUN_PHASE((B0) + 1, { phase_inproj(p, (L), lds); }) \
    RUN_PHASE((B0) + 2, { for (int t = (int)gridDim.x - 1 - BIDX(); t < 32; t += gridDim.x) cumsum_task(p, t, lds); phase_post(p, (L)); }) \
    RUN_PHASE((B0) + 3, { phase_mix1(p, (L), lds); }) \
    RUN_PHASE((B0) + 4, { phase_ssd_scan(p); phase_knorm(p, (L)); }) \
    RUN_PHASE((B0) + 5, { phase_mix3(p, (L), lds); }) \
    RUN_PHASE((B0) + 6, { g8::DenseSched2 S; S.init((const bf16_t*)(ws + WS_MIX), (const bf16_t*)(ws + WS_W_OUT), T, DM, DM, gridDim.x, BIDX()); \
                          g8::EpiResScale E{{(const bf16_t*)(ws + WS_HBUF), (bf16_t*)(ws + WS_H1), DM}, (const float*)(ws + WS_SSQ)}; g8::gemm8(lds, DM, DM / 2, S, E); }) \
    RUN_PHASE((B0) + 7, { g8::DenseSched S; S.init((const bf16_t*)(ws + WS_H1), (const bf16_t*)(ws + WS_W_Q), T, DM, DM, gridDim.x, BIDX()); \
                          g8::EpiBf16 E{(bf16_t*)(ws + WS_QBUF), DM}; g8::gemm8(lds, DM, DM, S, E); }) \
    RUN_PHASE((B0) + 8, { phase_xattn(p, (L), lds); }) \
    RUN_PHASE((B0) + 9, { g8::DenseSched S; S.init((const bf16_t*)(ws + WS_OBUF), (const bf16_t*)(ws + WS_W_O), T, DM, DM, gridDim.x, BIDX()); \
                          g8::EpiResBf E{(const bf16_t*)(ws + WS_H1), (bf16_t*)(ws + WS_HBUF), DM}; g8::gemm8(lds, DM, DM, S, E); }) \
    RUN_PHASE((B0) + 10, { phase_norm3(p, (L), lds); }) \
    RUN_PHASE((B0) + 11, { phase_moe<0>(p, (L), lds); }) \
    RUN_PHASE((B0) + 12, { phase_moe<1>(p, (L), lds); })

    LAYER_PHASES(0, 0)
    LAYER_PHASES(1, 13)
    RUN_PHASE(26, { phase_final(p); })
#undef LAYER_PHASES
#undef RUN_PHASE
}

extern "C" void kernel_launch(void* const* d_in, const int* in_sizes, int n_in, void* d_out, int out_size, void* d_ws, size_t ws_size, hipStream_t stream) {
    static int grid = 0;
    if (grid == 0) {
        if (n_in != 31 || out_size != T * DM || ws_size < WS_END) { fprintf(stderr, "kernel_launch: unexpected shapes (n_in %d out %d ws %zu need %zu)\n", n_in, out_size, ws_size, (size_t)WS_END); grid = -1; return; }
        int dev = 0, cus = 0, per_cu = 0;
        hipGetDevice(&dev);
        hipDeviceGetAttribute(&cus, hipDeviceAttributeMultiprocessorCount, dev);
        hipFuncSetAttribute((const void*)hybrid_fwd, hipFuncAttributeMaxDynamicSharedMemorySize, LDS_BYTES);
        hipOccupancyMaxActiveBlocksPerMultiprocessor(&per_cu, (const void*)hybrid_fwd, NTHR, LDS_BYTES);
        if (per_cu < 1) { fprintf(stderr, "kernel_launch: occupancy query says %d blocks per CU\n", per_cu); per_cu = 1; }
        (void)hipGetLastError();
        grid = cus;
    }
    if (grid < 0) return;
    Params p{};
    for (int i = 0; i < 31; ++i) p.in[i] = (const float*)d_in[i];
    p.out = (float*)d_out; p.ws = (unsigned char*)d_ws;
    p.use_grid_sync = 1; p.pad = 0;
    p.ph_lo = 0; p.ph_hi = N_PHASES;
    if (hipMemsetAsync((unsigned char*)d_ws + WS_BAR, 0, XCD_BAR_WORDS * 4, stream) != hipSuccess) { fprintf(stderr, "kernel_launch: memset failed\n"); return; }
    void* args[] = {&p};
    hipError_t e = hipLaunchCooperativeKernel((const void*)hybrid_fwd, dim3(grid), dim3(NTHR), args, LDS_BYTES, stream);
    if (e != hipSuccess) fprintf(stderr, "kernel_launch: cooperative launch failed: %s (grid %d)\n", hipGetErrorString(e), grid);
}
```

```cpp
#include <hip/hip_runtime.h>
#include <hip/hip_cooperative_groups.h>
#include <cstdio>
#include <cstdint>
namespace cg = cooperative_groups;

typedef unsigned short bf16_t;
typedef short bf16x8 __attribute__((ext_vector_type(8)));
typedef short s16x4 __attribute__((ext_vector_type(4)));
typedef float f32x4 __attribute__((ext_vector_type(4)));
typedef unsigned u32x4 __attribute__((ext_vector_type(4)));
typedef unsigned u32x2 __attribute__((ext_vector_type(2)));
#define DEVI __device__ __forceinline__
#define LAS __attribute__((address_space(3)))

constexpr int NB = 8, S = 2048, DM = 1024, T = NB * S, DEPTH = 2;
constexpr int INP = 3084, NPROJ = 3072;
constexpr int C_FQ = 0, C_FK = 256, C_FV = 512, C_DQ = 768, C_DK = 1024, C_DV = 1280, C_Z = 1536, C_XBC = 2048;
constexpr int MEMLEN = 256, MROWS = NB * MEMLEN;
constexpr int NEXP = 32, EFF = 512;
constexpr float EPS = 1e-6f;
constexpr int NTHR = 512;
constexpr int LDS_BYTES = 151552;

constexpr size_t al256(size_t x) { return (x + 255) & ~(size_t)255; }
constexpr size_t WS_W_IN = 0;
constexpr size_t WS_W_OUT = WS_W_IN + (size_t)NPROJ * DM * 2;
constexpr size_t WS_W_Q = WS_W_OUT + (size_t)DM * DM * 2;
constexpr size_t WS_W_KV = WS_W_Q + (size_t)DM * DM * 2;
constexpr size_t WS_W_O = WS_W_KV + (size_t)2 * DM * DM * 2;
constexpr size_t WS_W_13 = WS_W_O + (size_t)DM * DM * 2;
constexpr size_t WS_W_2 = WS_W_13 + (size_t)NEXP * 1024 * DM * 2;
constexpr size_t WS_WSMALL = WS_W_2 + (size_t)NEXP * DM * EFF * 2;
constexpr size_t WS_WROUT = WS_WSMALL + (size_t)DEPTH * 12 * DM * 4;
constexpr size_t WS_XB = WS_WROUT + (size_t)DEPTH * 36 * DM * 4;
constexpr size_t WS_H1 = WS_XB;
constexpr size_t WS_H3 = WS_XB + (size_t)T * DM * 2;
constexpr size_t WS_HBUF = WS_XB + (size_t)T * DM * 4;
constexpr size_t WS_PROJ = WS_HBUF + (size_t)T * DM * 2;
constexpr size_t WS_QBUF = WS_PROJ;
constexpr size_t WS_OBUF = WS_PROJ + (size_t)T * DM * 2;
constexpr size_t WS_ACT = WS_PROJ;
constexpr size_t WS_MIX = WS_PROJ + (size_t)T * NPROJ * 2;
constexpr size_t WS_U = WS_MIX + (size_t)T * DM * 2;
constexpr size_t WS_YBUF = WS_U;
constexpr size_t WS_DILO = WS_U;
constexpr size_t WS_DILM = WS_DILO + (size_t)3 * T * 256 * 4;
constexpr size_t WS_DILL = WS_DILM + (size_t)3 * T * 4 * 4;
constexpr size_t WS_SSTATE = WS_DILL + (size_t)3 * T * 4 * 4;
constexpr size_t WS_HIN = WS_SSTATE + (size_t)NB * 16 * 8 * 8192 * 4;
constexpr size_t WS_GBUF = WS_HIN + (size_t)NB * 16 * 8 * 8192 * 2;
constexpr size_t WS_U_END = WS_GBUF + (size_t)T * 512 * 4;
constexpr size_t WS_MEMN = WS_U_END;
constexpr size_t WS_KV = WS_MEMN + (size_t)MROWS * DM * 2;
constexpr size_t WS_LOGF = WS_KV + (size_t)MROWS * 2 * DM * 2;
constexpr size_t WS_CUMF = WS_LOGF + (size_t)T * 4 * 4;
constexpr size_t WS_DTV = WS_CUMF + (size_t)T * 4 * 4;
constexpr size_t WS_DECAY = WS_DTV + (size_t)T * 8 * 4;
constexpr size_t WS_CNT = WS_DECAY + (size_t)NB * 16 * 8 * 4;
constexpr size_t WS_LIST = WS_CNT + 1024;
constexpr size_t WS_GATE = WS_LIST + (size_t)NEXP * 2 * T * 4;
constexpr size_t WS_BAR = WS_GATE + (size_t)2 * T * 4;
constexpr size_t WS_XC = WS_BAR + 65536;
constexpr size_t WS_SSQ = WS_XC + (size_t)T * 1024 * 2;
constexpr size_t WS_RSTD1 = WS_SSQ + (size_t)T * 2 * 4;
constexpr size_t WS_RSTD3 = WS_RSTD1 + (size_t)T * 4;
constexpr size_t WS_END = WS_RSTD3 + (size_t)T * 4;
static_assert(WS_YBUF + (size_t)2 * T * DM * 2 <= WS_U_END, "ybuf alias");
static_assert(WS_OBUF + (size_t)T * DM * 2 <= WS_MIX, "obuf alias");

struct Params {
    const float* in[31];
    float* out;
    unsigned char* ws;
    int ph_lo, ph_hi;
    int use_grid_sync, pad;
};


typedef __attribute__((address_space(4))) const unsigned long long* karg_ptr;
typedef __attribute__((address_space(1))) const float* gcf_ptr;
typedef __attribute__((address_space(1))) float* gf_ptr;
typedef __attribute__((address_space(1))) unsigned char* gb_ptr;
struct DP {
    karg_ptr kp;
    DEVI const float* in(int i) const { return (const float*)(gcf_ptr)(kp[i]); }
    DEVI float* out() const { return (float*)(gf_ptr)(kp[31]); }
    DEVI unsigned char* ws() const { return (unsigned char*)(gb_ptr)(kp[32]); }
    DEVI int ph_lo() const { return (int)(unsigned)kp[33]; }
    DEVI int ph_hi() const { return (int)(unsigned)(kp[33] >> 32); }
    DEVI int use_gs() const { return (int)(unsigned)kp[34]; }
};

DEVI int TIDX() { int t = threadIdx.x; asm volatile("" : "+v"(t)); return t; }
DEVI int BIDX() { int b = blockIdx.x; asm volatile("" : "+s"(b)); return b; }
DEVI float bf2f(bf16_t v) { return __uint_as_float(((unsigned)v) << 16); }
typedef float f32x2 __attribute__((ext_vector_type(2)));
typedef __bf16 bf16x2_t __attribute__((ext_vector_type(2)));
DEVI unsigned cvt_pk(float lo, float hi) { f32x2 v = {lo, hi}; bf16x2_t b = __builtin_convertvector(v, bf16x2_t); return __builtin_bit_cast(unsigned, b); }
DEVI bf16_t f2bf(float f) { return (bf16_t)(cvt_pk(f, 0.f) & 0xffffu); }
DEVI float bflo(unsigned w) { return __uint_as_float(w << 16); }
DEVI float bfhi(unsigned w) { return __uint_as_float(w & 0xffff0000u); }
DEVI float wave_sum(float v) {
#pragma unroll
    for (int m = 32; m >= 1; m >>= 1) v += __shfl_xor(v, m);
    return v;
}
template <int CTRL> DEVI float dpp_mov(float v) { return __uint_as_float(__builtin_amdgcn_update_dpp(0u, __float_as_uint(v), CTRL, 0xf, 0xf, false)); }
DEVI float wave_sum_fast(float v) {
    v += dpp_mov<0xB1>(v);
    v += dpp_mov<0x4E>(v);
    v += dpp_mov<0x124>(v);
    v += dpp_mov<0x128>(v);
    const int iv = __float_as_int(v);
    return (__int_as_float(__builtin_amdgcn_readlane(iv, 0)) + __int_as_float(__builtin_amdgcn_readlane(iv, 16))) + (__int_as_float(__builtin_amdgcn_readlane(iv, 32)) + __int_as_float(__builtin_amdgcn_readlane(iv, 48)));
}
DEVI float silu_f(float x) { return x * __builtin_amdgcn_rcpf(1.f + __expf(-x)); }
DEVI float softplus_f(float x) { return x > 20.f ? x : log1pf(__expf(x)); }
DEVI float logsigmoid_f(float x) { return x >= 0.f ? -log1pf(__expf(-x)) : x - log1pf(__expf(x)); }
#define MFMA16(a, b, c) __builtin_amdgcn_mfma_f32_16x16x32_bf16(a, b, c, 0, 0, 0)
DEVI s16x4 tr_read(const bf16_t* p) {
    return __builtin_bit_cast(s16x4, __builtin_amdgcn_ds_read_tr16_b64_v4i16((LAS s16x4*)p));
}

DEVI int maprow(int mode, int n) { return mode == 0 ? n : ((n >> 4) * 32 + (n & 15) + (mode == 2 ? 16 : 0)); }
struct PrepD { const float* src; int ld, k0, c0; bf16_t* dst; int dstld, mode, n0; const float* ks; int ksf; };
DEVI void prep_ld(const PrepD& d, float4 (&v)[2], float (&sc)[2], int tid) {
#pragma unroll
    for (int i = 0; i < 2; ++i) {
        const int k = (tid >> 4) + 32 * i, n4 = (tid & 15) * 4;
        v[i] = *(const float4*)(d.src + (size_t)(d.k0 + k) * d.ld + d.c0 + n4);
        sc[i] = (d.ks != nullptr && (d.k0 + k) >= d.ksf) ? d.ks[d.k0 + k - d.ksf] : 1.f;
    }
}
DEVI void prep_tl(const float4 (&v)[2], const float (&sc)[2], float* tl, int tid) {
#pragma unroll
    for (int i = 0; i < 2; ++i) {
        const int k = (tid >> 4) + 32 * i, n4 = (tid & 15) * 4;
        tl[k * 65 + n4 + 0] = v[i].x * sc[i]; tl[k * 65 + n4 + 1] = v[i].y * sc[i]; tl[k * 65 + n4 + 2] = v[i].z * sc[i]; tl[k * 65 + n4 + 3] = v[i].w * sc[i];
    }
}
DEVI void prep_st(const PrepD& d, const float* tl, int tid) {
    const int n = tid >> 3, kc = (tid & 7) * 8;
    u32x4 w;
    w.x = cvt_pk(tl[(kc + 0) * 65 + n], tl[(kc + 1) * 65 + n]);
    w.y = cvt_pk(tl[(kc + 2) * 65 + n], tl[(kc + 3) * 65 + n]);
    w.z = cvt_pk(tl[(kc + 4) * 65 + n], tl[(kc + 5) * 65 + n]);
    w.w = cvt_pk(tl[(kc + 6) * 65 + n], tl[(kc + 7) * 65 + n]);
    const int drow = maprow(d.mode, d.n0 + n);
    *(u32x4*)(d.dst + (size_t)drow * d.dstld + d.k0 + kc) = w;
}

constexpr int PREP_UNITS = 2048 + 3 * 4096;
DEVI PrepD prep_decode(const DP& p, int l, int u) {
    unsigned char* ws = p.ws();
    PrepD d;
    if (u < 768) {
        const int kt = u / 48, nt = u % 48, n0 = nt * 64, c0 = n0 < 768 ? n0 : n0 + 4;
        d = PrepD{p.in(3) + (size_t)l * DM * INP, INP, kt * 64, c0, (bf16_t*)(ws + WS_W_IN), DM, 0, n0, p.in(2) + l * DM, 0};
    } else if (u < 1024) {
        const int v = u - 768, kt = v / 16, nt = v % 16;
        d = PrepD{p.in(15) + (size_t)l * DM * DM, DM, kt * 64, nt * 64, (bf16_t*)(ws + WS_W_OUT), DM, 0, nt * 64, p.in(14) + l * 512, 512};
    } else if (u < 1280) {
        const int v = u - 1024, kt = v / 16, nt = v % 16;
        d = PrepD{p.in(18) + (size_t)l * DM * DM, DM, kt * 64, nt * 64, (bf16_t*)(ws + WS_W_Q), DM, 0, nt * 64, p.in(16) + l * DM, 0};
    } else if (u < 1792) {
        const int v = u - 1280, kt = v / 32, nt = v % 32;
        d = PrepD{p.in(19) + (size_t)l * DM * 2 * DM, 2 * DM, kt * 64, nt * 64, (bf16_t*)(ws + WS_W_KV), DM, 0, nt * 64, nullptr, 0};
    } else if (u < 2048) {
        const int v = u - 1792, kt = v / 16, nt = v % 16;
        d = PrepD{p.in(22) + (size_t)l * DM * DM, DM, kt * 64, nt * 64, (bf16_t*)(ws + WS_W_O), DM, 0, nt * 64, nullptr, 0};
    } else if (u < 2048 + 8192) {
        const int v = u - 2048, which = v / 4096, w = v % 4096, e = w / 128, tI = w % 128, kt = tI / 8, nt = tI % 8;
        const float* src = (which == 0 ? p.in(28) : p.in(29)) + ((size_t)l * NEXP + e) * DM * EFF;
        d = PrepD{src, EFF, kt * 64, nt * 64, (bf16_t*)(ws + WS_W_13) + (size_t)e * 1024 * DM, DM, which == 0 ? 1 : 2, nt * 64, p.in(23) + l * DM, 0};
    } else {
        const int w = u - 2048 - 8192, e = w / 128, tI = w % 128, kt = tI / 16, nt = tI % 16;
        const float* src = p.in(30) + ((size_t)l * NEXP + e) * EFF * DM;
        d = PrepD{src, DM, kt * 64, nt * 64, (bf16_t*)(ws + WS_W_2) + (size_t)e * DM * EFF, EFF, 0, nt * 64, nullptr, 0};
    }
    return d;
}
DEVI void prep_all(const DP& p, int l, char* lds) {
    const int tid = TIDX(), G = gridDim.x;
    float* tl = (float*)lds;
    constexpr int NT = 4, TLS = 64 * 65;
    for (int u0 = BIDX(); u0 < PREP_UNITS; u0 += NT * G) {
        PrepD d[NT]; float4 v[NT][2]; float sc[NT][2];
#pragma unroll
        for (int i = 0; i < NT; ++i) { const int u = u0 + i * G; d[i] = prep_decode(p, l, u < PREP_UNITS ? u : u0); prep_ld(d[i], v[i], sc[i], tid); }
#pragma unroll
        for (int i = 0; i < NT; ++i) prep_tl(v[i], sc[i], tl + i * TLS, tid);
        __syncthreads();
#pragma unroll
        for (int i = 0; i < NT; ++i) if (u0 + i * G < PREP_UNITS) prep_st(d[i], tl + i * TLS, tid);
        __syncthreads();
    }
}
DEVI void prep_small(const DP& p) {
    float* wsm = (float*)(p.ws() + WS_WSMALL);
    float* wro = (float*)(p.ws() + WS_WROUT);
    const int gtid = BIDX() * NTHR + TIDX(), gn = gridDim.x * NTHR;
    for (int i = gtid; i < DEPTH * 12 * DM; i += gn) {
        const int l = i / (12 * DM), r = i % (12 * DM), c = r / DM, k = r % DM;
        const int col = c < 4 ? 768 + c : 3076 + (c - 4);
        wsm[i] = p.in(3)[((size_t)l * DM + k) * INP + col] * p.in(2)[l * DM + k];
    }
    for (int i = gtid; i < DEPTH * 36 * DM; i += gn) {
        const int l = i / (36 * DM), r = i % (36 * DM), c = r / DM, k = r % DM;
        wro[i] = (c < 4 ? p.in(24)[((size_t)l * DM + k) * 4 + c] : p.in(26)[((size_t)l * DM + k) * 32 + (c - 4)]) * p.in(23)[l * DM + k];
    }
    if (BIDX() == 0 && TIDX() < 128) ((int*)(p.ws() + WS_CNT))[TIDX()] = 0;
}

DEVI void store_h_bf16(bf16_t* hrow, const float (&h)[16], int lane) {
#pragma unroll
    for (int j = 0; j < 4; ++j) {
        u32x2 w; w.x = cvt_pk(h[4 * j], h[4 * j + 1]); w.y = cvt_pk(h[4 * j + 2], h[4 * j + 3]);
        *(u32x2*)(hrow + j * 256 + lane * 4) = w;
    }
}
DEVI void load_row_f32(const float* xr, float (&x)[16], int lane) {
#pragma unroll
    for (int j = 0; j < 4; ++j) { const float4 v = *(const float4*)(xr + j * 256 + lane * 4); x[4 * j] = v.x; x[4 * j + 1] = v.y; x[4 * j + 2] = v.z; x[4 * j + 3] = v.w; }
}
DEVI void add_row_bf16(const bf16_t* yr, float (&x)[16], int lane) {
#pragma unroll
    for (int j = 0; j < 4; ++j) { const u32x2 w = *(const u32x2*)(yr + j * 256 + lane * 4); x[4 * j] += bflo(w.x); x[4 * j + 1] += bfhi(w.x); x[4 * j + 2] += bflo(w.y); x[4 * j + 3] += bfhi(w.y); }
}
DEVI void store_row_f32(float* xr, const float (&x)[16], int lane) {
#pragma unroll
    for (int j = 0; j < 4; ++j) *(float4*)(xr + j * 256 + lane * 4) = make_float4(x[4 * j], x[4 * j + 1], x[4 * j + 2], x[4 * j + 3]);
}
DEVI void norm_row(const float (&x)[16], const float* g, float (&h)[16], int lane) {
    float ss = 0.f;
#pragma unroll
    for (int i = 0; i < 16; ++i) ss += x[i] * x[i];
    ss = wave_sum(ss);
    const float rstd = rsqrtf(ss * (1.0f / DM) + EPS);
#pragma unroll
    for (int j = 0; j < 4; ++j) { const float4 gv = *(const float4*)(g + j * 256 + lane * 4);
        h[4 * j] = x[4 * j] * rstd * gv.x; h[4 * j + 1] = x[4 * j + 1] * rstd * gv.y; h[4 * j + 2] = x[4 * j + 2] * rstd * gv.z; h[4 * j + 3] = x[4 * j + 3] * rstd * gv.w; }
}
DEVI float dot_lds(const float (&h)[16], const float* wrow, int lane) {
    f32x2 a0 = {0.f, 0.f}, a1 = {0.f, 0.f};
#pragma unroll
    for (int j = 0; j < 4; ++j) { const f32x4 w = *(const f32x4*)(wrow + j * 256 + lane * 4);
        a0 += (f32x2){h[4 * j], h[4 * j + 1]} * (f32x2){w[0], w[1]}; a1 += (f32x2){h[4 * j + 2], h[4 * j + 3]} * (f32x2){w[2], w[3]}; }
    a0 += a1;
    return a0[0] + a0[1];
}

DEVI void load_row_bf16(const bf16_t* xr, float (&x)[16], int lane) {
#pragma unroll
    for (int j = 0; j < 2; ++j) { const u32x4 w = *(const u32x4*)(xr + j * 512 + lane * 8);
        x[8 * j] = bflo(w.x); x[8 * j + 1] = bfhi(w.x); x[8 * j + 2] = bflo(w.y); x[8 * j + 3] = bfhi(w.y); x[8 * j + 4] = bflo(w.z); x[8 * j + 5] = bfhi(w.z); x[8 * j + 6] = bflo(w.w); x[8 * j + 7] = bfhi(w.w); }
}
DEVI void add_row_bf16_b(const bf16_t* yr, float (&x)[16], int lane) {
#pragma unroll
    for (int j = 0; j < 2; ++j) { const u32x4 w = *(const u32x4*)(yr + j * 512 + lane * 8);
        x[8 * j] += bflo(w.x); x[8 * j + 1] += bfhi(w.x); x[8 * j + 2] += bflo(w.y); x[8 * j + 3] += bfhi(w.y); x[8 * j + 4] += bflo(w.z); x[8 * j + 5] += bfhi(w.z); x[8 * j + 6] += bflo(w.w); x[8 * j + 7] += bfhi(w.w); }
}
DEVI void store_row_bf16_b(bf16_t* hr, const float (&h)[16], int lane) {
#pragma unroll
    for (int j = 0; j < 2; ++j) { u32x4 w; w.x = cvt_pk(h[8 * j], h[8 * j + 1]); w.y = cvt_pk(h[8 * j + 2], h[8 * j + 3]); w.z = cvt_pk(h[8 * j + 4], h[8 * j + 5]); w.w = cvt_pk(h[8 * j + 6], h[8 * j + 7]);
        *(u32x4*)(hr + j * 512 + lane * 8) = w; }
}
DEVI float dot_lds_b(const float (&h)[16], const float* wrow, int lane) {
    f32x2 a0 = {0.f, 0.f}, a1 = {0.f, 0.f};
#pragma unroll
    for (int j = 0; j < 2; ++j) { const f32x4 w0 = *(const f32x4*)(wrow + j * 512 + lane * 8), w1 = *(const f32x4*)(wrow + j * 512 + lane * 8 + 4);
        a0 += (f32x2){h[8 * j], h[8 * j + 1]} * (f32x2){w0[0], w0[1]}; a1 += (f32x2){h[8 * j + 2], h[8 * j + 3]} * (f32x2){w0[2], w0[3]};
        a0 += (f32x2){h[8 * j + 4], h[8 * j + 5]} * (f32x2){w1[0], w1[1]}; a1 += (f32x2){h[8 * j + 6], h[8 * j + 7]} * (f32x2){w1[2], w1[3]}; }
    a0 += a1;
    return a0[0] + a0[1];
}
#define MFMA_F32(a, b, c) __builtin_amdgcn_mfma_f32_16x16x4f32(a, b, c, 0, 0, 0)
template <int L>
DEVI void load_row_pre(const float* xin, const bf16_t* h0, const bf16_t* ybuf, int row, int lane, float (&x)[16]) {
    if (L == 0) load_row_f32(xin + (size_t)row * DM, x, lane);
    else { load_row_bf16(h0 + (size_t)row * DM, x, lane); add_row_bf16_b(ybuf + (size_t)(2 * row) * DM, x, lane); add_row_bf16_b(ybuf + (size_t)(2 * row + 1) * DM, x, lane); }
}
template <int L>
DEVI void norm1_rows(const DP& p, char* lds) {
    const int tid = TIDX(), wid = tid >> 6, lane = tid & 63;
    unsigned char* ws = p.ws();
    const float* wsl = (const float*)lds;
    const float* xin = p.in(0);
    const bf16_t* ybuf = (const bf16_t*)(ws + WS_YBUF);
    bf16_t* hbuf = (bf16_t*)(ws + WS_HBUF);
    float* logf = (float*)(ws + WS_LOGF);
    float* dtv = (float*)(ws + WS_DTV);
    float* rstd1 = (float*)(ws + WS_RSTD1);
    const int stride = gridDim.x * 8;
    int row = BIDX() * 8 + wid;
    float xn[16];
    if (row < T) load_row_pre<L>(xin, hbuf, ybuf, row, lane, xn);
    for (; row < T; row += stride) {
        float x[16];
#pragma unroll
        for (int i = 0; i < 16; ++i) x[i] = xn[i];
        if (row + stride < T) load_row_pre<L>(xin, hbuf, ybuf, row + stride, lane, xn);
        if (L == 0) store_h_bf16(hbuf + (size_t)row * DM, x, lane); else store_row_bf16_b(hbuf + (size_t)row * DM, x, lane);
        float ss = 0.f;
#pragma unroll
        for (int i = 0; i < 16; ++i) ss += x[i] * x[i];
        const float rstd = rsqrtf(wave_sum_fast(ss) * (1.0f / DM) + EPS);
        float keep = 0.f;
#pragma unroll
        for (int c = 0; c < 12; ++c) { const float v = wave_sum_fast(L == 0 ? dot_lds(x, wsl + c * DM, lane) : dot_lds_b(x, wsl + c * DM, lane)); keep = (lane == c) ? v : keep; if (c & 1) __builtin_amdgcn_sched_barrier(0); }
        keep *= rstd;
        if (lane == 0) rstd1[row] = rstd;
        {
            const float bias = lane < 4 ? p.in(4)[L * 4 + (lane & 3)] : p.in(11)[L * 8 + ((lane - 4) & 7)];
            const float xv = keep + bias;
            const float lt = __logf(1.0f + __expf(-fabsf(xv)));
            if (lane < 4) logf[(size_t)row * 4 + lane] = fminf(xv, 0.f) - lt;
            else if (lane < 12) dtv[(size_t)row * 8 + lane - 4] = fmaxf(xv, 0.f) + lt;
        }
    }
}
DEVI void phase_norm1(const DP& p, int l, char* lds) {
    const int tid = TIDX(), wid = tid >> 6, lane = tid & 63;
    unsigned char* ws = p.ws();
    float* wsl = (float*)lds;
    if (l == 0) {
        for (int i = tid; i < 12 * DM; i += NTHR) { const int c = i / DM, k = i % DM, col = c < 4 ? 768 + c : 3076 + (c - 4);
            wsl[i] = p.in(3)[(size_t)k * INP + col] * p.in(2)[k]; }
    } else {
        const float4* src = (const float4*)((const float*)(ws + WS_WSMALL) + (size_t)l * 12 * DM);
        for (int i = tid; i < 12 * DM / 4; i += NTHR) ((float4*)wsl)[i] = src[i];
    }
    __syncthreads();
    if (l == 0) norm1_rows<0>(p, lds); else norm1_rows<1>(p, lds);
    const float* gm = p.in(17) + l * DM;
    bf16_t* memn = (bf16_t*)(ws + WS_MEMN);
    for (int row = BIDX() * 8 + wid; row < MROWS; row += gridDim.x * 8) {
        float x[16], h[16];
        load_row_f32(p.in(1) + (size_t)row * DM, x, lane);
        norm_row(x, gm, h, lane);
        store_h_bf16(memn + (size_t)row * DM, h, lane);
    }
}
DEVI void phase_norm3(const DP& p, int l, char* lds) {
    const int tid = TIDX(), wid = tid >> 6, lane = tid & 63;
    unsigned char* ws = p.ws();
    float* wr = (float*)lds;
    int* lcnt = (int*)(lds + 36 * DM * 4);
    int* lbase = lcnt + 32;
    int* rinfo = lbase + 32;
    { const float4* src = (const float4*)((const float*)(ws + WS_WROUT) + (size_t)l * 36 * DM);
      for (int i = tid; i < 36 * DM / 4; i += NTHR) ((float4*)wr)[i] = src[i]; }
    if (tid < 32) lcnt[tid] = 0;
    __syncthreads();
    int* cnt = (int*)(ws + WS_CNT) + l * 64;
    int* list = (int*)(ws + WS_LIST);
    const bf16_t* xin = (const bf16_t*)(ws + WS_HBUF);
    bf16_t* h3 = (bf16_t*)(ws + WS_H3);
    const float* bg = p.in(25) + l * 4;
    const int be_i = __float_as_int(lane < 32 ? p.in(27)[l * 32 + lane] : 0.f);
    const int stride = gridDim.x * 8;
    int row = BIDX() * 8 + wid;
    float xn[16];
    if (row < T) load_row_bf16(xin + (size_t)row * DM, xn, lane);
    for (int it = 0; row < T; row += stride, ++it) {
        float x[16];
#pragma unroll
        for (int i = 0; i < 16; ++i) x[i] = xn[i];
        if (row + stride < T) load_row_bf16(xin + (size_t)(row + stride) * DM, xn, lane);
        float ss = 0.f;
#pragma unroll
        for (int i = 0; i < 16; ++i) ss += x[i] * x[i];
        const float rstd = rsqrtf(wave_sum_fast(ss) * (1.0f / DM) + EPS);
        { float hn[16];
#pragma unroll
          for (int i = 0; i < 16; ++i) hn[i] = x[i] * rstd;
          store_row_bf16_b(h3 + (size_t)row * DM, hn, lane); }
        float gl[4];
#pragma unroll
        for (int c = 0; c < 4; ++c) gl[c] = wave_sum_fast(dot_lds_b(x, wr + c * DM, lane)) * rstd + bg[c];
        int gsel = 0; float gmax = gl[0];
#pragma unroll
        for (int c = 1; c < 4; ++c) if (gl[c] > gmax) { gmax = gl[c]; gsel = c; }
        float gden = 0.f;
#pragma unroll
        for (int c = 0; c < 4; ++c) gden += __expf(gl[c] - gmax);
        const float ggate = 1.0f / gden;
        gsel = __builtin_amdgcn_readfirstlane(gsel);
        float v1 = -3.0e38f, v2 = -3.0e38f; int i1 = 0, i2 = 1;
#pragma unroll
        for (int c = 0; c < 8; ++c) {
            const float v = wave_sum_fast(dot_lds_b(x, wr + (4 + gsel * 8 + c) * DM, lane)) * rstd + __int_as_float(__builtin_amdgcn_readlane(be_i, gsel * 8 + c));
            if (v > v1) { v2 = v1; i2 = i1; v1 = v; i1 = c; } else if (v > v2) { v2 = v; i2 = c; }
            if (c & 1) __builtin_amdgcn_sched_barrier(0);
        }
        const float e2 = __expf(v2 - v1), inv = 1.0f / (1.0f + e2);
        if (lane == 0) {
            const int ea = gsel * 8 + i1, eb = gsel * 8 + i2;
            const int sa = atomicAdd(&lcnt[ea], 1), sb = atomicAdd(&lcnt[eb], 1);
            int* ri = rinfo + (it * 8 + wid) * 4;
            const unsigned gpk = cvt_pk(inv * ggate, e2 * inv * ggate);
            ri[0] = ea | (sa << 8); ri[1] = eb | (sb << 8); ri[2] = (int)(gpk << 16); ri[3] = (int)(gpk & 0xffff0000u);
        }
    }
    __syncthreads();
    if (tid < 32) lbase[tid] = atomicAdd(&cnt[tid], lcnt[tid]);
    __syncthreads();
    {
        const int nit = (T - (BIDX() * 8) + stride - 1) / stride;
        if (tid < nit * 8) {
            const int it = tid >> 3, w = tid & 7, r = BIDX() * 8 + w + it * stride;
            if (r < T) {
                const int* ri = rinfo + tid * 4;
                const int ea = ri[0] & 255, sa = ri[0] >> 8, eb = ri[1] & 255, sb = ri[1] >> 8;
                list[(size_t)ea * (2 * T) + lbase[ea] + sa] = ri[2] | (2 * r);
                list[(size_t)eb * (2 * T) + lbase[eb] + sb] = ri[3] | (2 * r + 1);
            }
        }
    }
    __syncthreads();
}

constexpr int G_BM = 256, G_BN = 128, G_BK = 64, G_ST = 72;
constexpr int G_ABUF = G_BM * G_ST, G_BBUF = G_BN * G_ST;
template <class AMap, class Epi>
DEVI void gemm_tile(const AMap& amap, const bf16_t* __restrict__ Bt, int K, const Epi& epi, char* lds) {
    const int tid = TIDX(), wid = tid >> 6, lane = tid & 63, r16 = lane & 15, g4 = lane >> 4;
    const int wr = wid >> 1, wc = wid & 1;
    bf16_t* As = (bf16_t*)lds;
    bf16_t* Bs = As + 2 * G_ABUF;
    const int srow = tid >> 3, skc = (tid & 7) * 8;
    const bf16_t* ap[4];
#pragma unroll
    for (int i = 0; i < 4; ++i) ap[i] = amap(srow + 64 * i) + skc;
    const bf16_t* bp[2];
#pragma unroll
    for (int i = 0; i < 2; ++i) bp[i] = Bt + (size_t)(srow + 64 * i) * K + skc;
    u32x4 ra[4], rb[2];
#pragma unroll
    for (int i = 0; i < 4; ++i) ra[i] = *(const u32x4*)(ap[i]);
#pragma unroll
    for (int i = 0; i < 2; ++i) rb[i] = *(const u32x4*)(bp[i]);
    f32x4 acc[4][4];
#pragma unroll
    for (int m = 0; m < 4; ++m)
#pragma unroll
        for (int n = 0; n < 4; ++n) acc[m][n] = (f32x4){0.f, 0.f, 0.f, 0.f};
    const int nt = K / G_BK;
    for (int t = 0; t < nt; ++t) {
        bf16_t* Ab = As + (t & 1) * G_ABUF;
        bf16_t* Bb = Bs + (t & 1) * G_BBUF;
#pragma unroll
        for (int i = 0; i < 4; ++i) *(u32x4*)(Ab + (srow + 64 * i) * G_ST + skc) = ra[i];
#pragma unroll
        for (int i = 0; i < 2; ++i) *(u32x4*)(Bb + (srow + 64 * i) * G_ST + skc) = rb[i];
        __syncthreads();
        if (t + 1 < nt) {
#pragma unroll
            for (int i = 0; i < 4; ++i) ra[i] = *(const u32x4*)(ap[i] + (size_t)(t + 1) * G_BK);
#pragma unroll
            for (int i = 0; i < 2; ++i) rb[i] = *(const u32x4*)(bp[i] + (size_t)(t + 1) * G_BK);
        }
#pragma unroll
        for (int kk = 0; kk < 2; ++kk) {
            bf16x8 af[4], bfr[4];
#pragma unroll
            for (int m = 0; m < 4; ++m) af[m] = *(const bf16x8*)(Ab + (wr * 64 + m * 16 + r16) * G_ST + kk * 32 + g4 * 8);
#pragma unroll
            for (int n = 0; n < 4; ++n) bfr[n] = *(const bf16x8*)(Bb + (wc * 64 + n * 16 + r16) * G_ST + kk * 32 + g4 * 8);
#pragma unroll
            for (int m = 0; m < 4; ++m)
#pragma unroll
                for (int n = 0; n < 4; ++n) acc[m][n] = MFMA16(bfr[n], af[m], acc[m][n]);
        }
    }
    epi(acc, wr * 64 + r16, wc * 64 + g4 * 4);
    __syncthreads();
}

struct AMapDense { const bf16_t* A; int K; DEVI const bf16_t* operator()(int r) const { return A + (size_t)r * K; } };
struct EpiBf16Out { bf16_t* O; int ldo;
    DEVI void operator()(const f32x4 (&acc)[4][4], int rb, int cb) const {
#pragma unroll
        for (int m = 0; m < 4; ++m)
#pragma unroll
            for (int n = 0; n < 4; ++n) { u32x2 w; w.x = cvt_pk(acc[m][n][0], acc[m][n][1]); w.y = cvt_pk(acc[m][n][2], acc[m][n][3]);
                *(u32x2*)(O + (size_t)(rb + m * 16) * ldo + cb + n * 16) = w; }
    } };
struct EpiResF32 { const float* R; float* O; int ld;
    DEVI void operator()(const f32x4 (&acc)[4][4], int rb, int cb) const {
#pragma unroll
        for (int m = 0; m < 4; ++m)
#pragma unroll
            for (int n = 0; n < 4; ++n) { const size_t off = (size_t)(rb + m * 16) * ld + cb + n * 16;
                const f32x4 r = *(const f32x4*)(R + off); *(f32x4*)(O + off) = r + acc[m][n]; }
    } };

template <class MakeEpi>
DEVI void gemm_dense_units(const bf16_t* A, const bf16_t* Bt, int M, int N, int K, const MakeEpi& mk, char* lds, int u0, int ustride) {
    const int nN = N / G_BN, nU = (M / G_BM) * nN;
    for (int u = u0; u < nU; u += ustride) {
        const int pm = u / nN, pn = u % nN;
        AMapDense am{A + (size_t)pm * G_BM * K, K};
        gemm_tile(am, Bt + (size_t)pn * G_BN * K, K, mk(pm * G_BM, pn * G_BN), lds);
    }
}


DEVI const char* uni_ptr(const char* p) {
    const unsigned long long v = (unsigned long long)p;
    const unsigned lo = __builtin_amdgcn_readfirstlane((unsigned)v), hi = __builtin_amdgcn_readfirstlane((unsigned)(v >> 32));
    return (const char*)(gb_ptr)(((unsigned long long)hi << 32) | lo);
}
namespace g8 {
constexpr int BM = 256, BK = 64, HALF = 128, HTB = HALF * BK * 2, STAGE_BYTES = 8 * HTB;
DEVI int lds_byte(int r, int c) { const int st = (r >> 4) * 2 + (c >> 5), rr = r & 15, cc = c & 31, ob = rr * 64 + cc * 2; return st * 1024 + (ob ^ (((ob >> 9) & 1) << 5)); }
DEVI void stage_rc(int b, int& R, int& C) { const int st = b / 1024, sb = b % 1024, swz = sb ^ (((sb >> 9) & 1) << 5); R = (st >> 1) * 16 + swz / 64; C = (st & 1) * 32 + (swz % 64) / 2; }
DEVI int perm32(int rho) { const int n = rho >> 4, i = rho & 15; return 8 * (i >> 2) + 4 * n + (i & 3); }
struct UnitU { const char* A; const char* B; int i0, i1, i2, i3; int flags; };

template <class Epi, class Sched>
DEVI void gemm8(char* lds_generic, int K, int klen, Sched& S, const Epi& E) {
    LAS unsigned char* lds = (LAS unsigned char*)lds_generic;
    const int tid = TIDX(), wid = __builtin_amdgcn_readfirstlane(tid >> 6), lane = tid & 63, wr = wid >> 2, wc = wid & 3, fr = lane & 15, fq = lane >> 4;
    const int nt = klen / BK;
    int R0, C0, R1, C1; stage_rc(tid * 16, R0, C0); stage_rc(tid * 16 + 8192, R1, C1);
    unsigned voffB[2];
    { const int Rb0 = Epi::PERM ? ((R0 & ~31) + perm32(R0 & 31)) : R0, Rb1 = Epi::PERM ? ((R1 & ~31) + perm32(R1 & 31)) : R1;
      voffB[0] = (unsigned)(Rb0 * K + C0) * 2u; voffB[1] = (unsigned)(Rb1 * K + C1) * 2u; }
    const size_t kstep = (size_t)(BK * 2), hstepB = (size_t)HALF * K * 2;
    const unsigned ldsw = (unsigned)wid * 1024u;
    const int aoff = lds_byte(wr * 64 + fr, fq * 8), boff = lds_byte(wc * 32 + fr, fq * 8);
#define G8_SA(b, h) (((b) * 2 + (h)) * HTB)
#define G8_SB(b, h) ((4 + (b) * 2 + (h)) * HTB)
#define G8_STG(bufoff, gbase, v0, v1) do { const char* _gb = uni_ptr((const char*)(gbase));     \
        __builtin_amdgcn_global_load_lds((const unsigned*)(_gb + (v0)), (LAS unsigned*)(lds + (bufoff) + ldsw), 16, 0, 0); \
        __builtin_amdgcn_global_load_lds((const unsigned*)(_gb + (v1)), (LAS unsigned*)(lds + (bufoff) + ldsw + 8192), 16, 0, 0); } while (0)
#define G8_LDA(dst, b, h) do { _Pragma("unroll") for (int m = 0; m < 4; ++m) _Pragma("unroll") for (int k = 0; k < 2; ++k) dst[m][k] = *(const LAS bf16x8*)(lds + G8_SA(b, h) + aoff + m * 2048 + k * 1024); } while (0)
#define G8_LDB(dst, b, h) do { _Pragma("unroll") for (int n = 0; n < 2; ++n) _Pragma("unroll") for (int k = 0; k < 2; ++k) dst[n][k] = *(const LAS bf16x8*)(lds + G8_SB(b, h) + boff + n * 2048 + k * 1024); } while (0)
#define G8_MMA(ai, bj, At, Bt) do { __builtin_amdgcn_s_setprio(1); _Pragma("unroll") for (int m = 0; m < 4; ++m) _Pragma("unroll") for (int n = 0; n < 2; ++n) _Pragma("unroll") for (int k = 0; k < 2; ++k) \
        acc[ai][bj][m][n] = __builtin_amdgcn_mfma_f32_16x16x32_bf16(Bt[n][k], At[m][k], acc[ai][bj][m][n], 0, 0, 0); __builtin_amdgcn_s_setprio(0); } while (0)
#define G8_WAIT_V(n) asm volatile("s_waitcnt vmcnt(" #n ")" ::: "memory")
#define G8_WAIT_L(n) asm volatile("s_waitcnt lgkmcnt(" #n ")" ::: "memory")
#define G8_BAR __builtin_amdgcn_s_barrier()
#define G8_SCHED __builtin_amdgcn_sched_barrier(0)
    UnitU cur, nxt;
    if (!S.next(cur)) return;
    unsigned va00, va01, va10, va11;
    S.lane_va(cur, R0, C0, R1, C1, va00, va01, va10, va11);
    f32x4 acc[2][2][4][2];
#pragma unroll
    for (int a = 0; a < 2; ++a)
#pragma unroll
        for (int b = 0; b < 2; ++b)
#pragma unroll
            for (int m = 0; m < 4; ++m)
#pragma unroll
                for (int n = 0; n < 2; ++n) acc[a][b][m][n] = (f32x4){0.f, 0.f, 0.f, 0.f};
    bf16x8 At[4][2], B0[2][2], B1[2][2];
    const char* cA = cur.A; const char* cB = cur.B;
    G8_STG(G8_SB(0, 0), cB, voffB[0], voffB[1]); G8_STG(G8_SA(0, 0), cA, va00, va01); G8_STG(G8_SB(0, 1), cB + hstepB, voffB[0], voffB[1]); G8_STG(G8_SA(0, 1), cA, va10, va11);
    if (wr == 1) G8_BAR;
    G8_WAIT_V(4); G8_BAR;
    G8_STG(G8_SB(1, 0), cB + kstep, voffB[0], voffB[1]); G8_STG(G8_SA(1, 0), cA + kstep, va00, va01); G8_STG(G8_SB(1, 1), cB + hstepB + kstep, voffB[0], voffB[1]);
    G8_WAIT_V(6); G8_BAR;
    for (;;) {
        const bool has_next = S.next(nxt);
        const char* nA = has_next ? nxt.A : cA; const char* nB = has_next ? nxt.B : cB;
        unsigned x00 = va00, x01 = va01, x10 = va10, x11 = va11;
        for (int t = 0; t < nt; t += 2) {
            const bool last = (t == nt - 2);
            const char* a1 = cA + (size_t)(t + 1) * kstep;
            const char* a2 = last ? nA : cA + (size_t)(t + 2) * kstep; const char* b2 = last ? nB : cB + (size_t)(t + 2) * kstep;
            const char* a3 = a2 + kstep; const char* b3 = b2 + kstep;
            if (Sched::GATHER) { if (last && has_next) S.lane_va(nxt, R0, C0, R1, C1, x00, x01, x10, x11); }
            G8_LDB(B0, 0, 0); G8_SCHED; G8_LDA(At, 0, 0); G8_STG(G8_SA(1, 1), a1, va10, va11);
            G8_WAIT_L(8); G8_BAR; G8_WAIT_L(0); G8_MMA(0, 0, At, B0); G8_BAR; G8_SCHED;
            G8_LDB(B1, 0, 1); G8_STG(G8_SB(0, 0), b2, voffB[0], voffB[1]);
            G8_BAR; G8_WAIT_L(0); G8_MMA(0, 1, At, B1); G8_BAR;
            G8_LDA(At, 0, 1); G8_STG(G8_SA(0, 0), a2, x00, x01);
            G8_BAR; G8_WAIT_L(0); G8_MMA(1, 0, At, B0); G8_BAR; G8_SCHED;
            G8_STG(G8_SB(0, 1), b2 + hstepB, voffB[0], voffB[1]);
            G8_WAIT_V(6); G8_BAR; G8_MMA(1, 1, At, B1); G8_BAR;
            G8_LDB(B0, 1, 0); G8_SCHED; G8_LDA(At, 1, 0); G8_STG(G8_SA(0, 1), a2, x10, x11);
            G8_WAIT_L(8); G8_BAR; G8_WAIT_L(0); G8_MMA(0, 0, At, B0); G8_BAR; G8_SCHED;
            G8_LDB(B1, 1, 1); G8_STG(G8_SB(1, 0), b3, voffB[0], voffB[1]);
            G8_BAR; G8_WAIT_L(0); G8_MMA(0, 1, At, B1); G8_BAR;
            G8_LDA(At, 1, 1); G8_STG(G8_SA(1, 0), a3, x00, x01);
            G8_BAR; G8_WAIT_L(0); G8_MMA(1, 0, At, B0); G8_BAR; G8_SCHED;
            G8_STG(G8_SB(1, 1), b3 + hstepB, voffB[0], voffB[1]);
            G8_WAIT_V(6); G8_BAR; G8_MMA(1, 1, At, B1); G8_BAR;
        }
        if (cur.flags & 2) E(acc, cur, wr, wc, fr, fq); else E.mid(acc, cur, wr, wc, fr, fq);
        if (!has_next) break;
        if (nxt.flags & 1) {
#pragma unroll
        for (int a = 0; a < 2; ++a)
#pragma unroll
            for (int b = 0; b < 2; ++b)
#pragma unroll
                for (int m = 0; m < 4; ++m)
#pragma unroll
                    for (int n = 0; n < 2; ++n) acc[a][b][m][n] = (f32x4){0.f, 0.f, 0.f, 0.f};
        }
        cur = nxt; cA = nA; cB = nB; va00 = x00; va01 = x01; va10 = x10; va11 = x11;
    }
    G8_WAIT_V(0);
    if (wr == 0) G8_BAR;
    G8_BAR;
#undef G8_SA
#undef G8_SB
#undef G8_STG
#undef G8_LDA
#undef G8_LDB
#undef G8_MMA
#undef G8_WAIT_V
#undef G8_WAIT_L
#undef G8_BAR
#undef G8_SCHED
}

struct DenseSched {
    static constexpr bool GATHER = false;
    const char* A; const char* Bt; int K, nM, nN, nwg, G, c, i;
    DEVI void init(const bf16_t* A_, const bf16_t* Bt_, int M, int N, int K_, int G_, int c_) { A = (const char*)A_; Bt = (const char*)Bt_; K = K_; nM = M / BM; nN = N / BM; nwg = nM * nN; G = G_; c = c_; i = 0; }
    DEVI bool next(UnitU& u) {
        const long L = (long)i * G + c; if (L >= nwg) return false;
        ++i;
        int wgid = (int)L; { const int q = nwg / 8, r = nwg % 8, xcd = wgid % 8, off = wgid / 8; wgid = (xcd < r ? xcd * (q + 1) : r * (q + 1) + (xcd - r) * q) + off; }
        const int nig = 8 * nN, gid = wgid / nig, fm = gid * 8, gsz = (nM - fm) < 8 ? (nM - fm) : 8;
        const int pm = fm + ((wgid % nig) % gsz), pn = (wgid % nig) / gsz;
        u.A = A + (size_t)pm * BM * K * 2; u.B = Bt + (size_t)pn * BM * K * 2; u.i0 = pm; u.i1 = pn; u.i2 = 0; u.i3 = 0; u.flags = 3;
        return true;
    }
    DEVI void lane_va(const UnitU&, int R0, int C0, int R1, int C1, unsigned& v00, unsigned& v01, unsigned& v10, unsigned& v11) const {
        v00 = (unsigned)(R0 * K + C0) * 2u; v01 = (unsigned)(R1 * K + C1) * 2u; v10 = v00 + (unsigned)(HALF * K * 2); v11 = v01 + (unsigned)(HALF * K * 2);
    }
};
struct EpiBf16Scale { static constexpr bool PERM = true; bf16_t* O; int ldo; const float* rstd;
    DEVI void mid(f32x4 (&)[2][2][4][2], const UnitU&, int, int, int, int) const {}
    DEVI void operator()(const f32x4 (&acc)[2][2][4][2], const UnitU& u, int wr, int wc, int fr, int fq) const {
        const int row0 = u.i0 * BM + wr * 64 + fr;
        bf16_t* base = O + (size_t)row0 * ldo + u.i1 * BM + wc * 32 + 8 * fq;
        float rsv[2][4];
#pragma unroll
        for (int ai = 0; ai < 2; ++ai)
#pragma unroll
            for (int m = 0; m < 4; ++m) rsv[ai][m] = rstd[row0 + ai * HALF + m * 16];
#pragma unroll
        for (int ai = 0; ai < 2; ++ai)
#pragma unroll
            for (int m = 0; m < 4; ++m) { bf16_t* rowp = base + (size_t)(ai * HALF + m * 16) * ldo; const float rs = rsv[ai][m];
#pragma unroll
                for (int bj = 0; bj < 2; ++bj) { const f32x4 v0 = acc[ai][bj][m][0] * rs, v1 = acc[ai][bj][m][1] * rs;
                    u32x4 w; w.x = cvt_pk(v0[0], v0[1]); w.y = cvt_pk(v0[2], v0[3]); w.z = cvt_pk(v1[0], v1[1]); w.w = cvt_pk(v1[2], v1[3]);
                    *(u32x4*)(rowp + bj * HALF) = w; } }
    } };
struct EpiBf16 { static constexpr bool PERM = true; bf16_t* O; int ldo;
    DEVI void mid(f32x4 (&)[2][2][4][2], const UnitU&, int, int, int, int) const {}
    DEVI void operator()(const f32x4 (&acc)[2][2][4][2], const UnitU& u, int wr, int wc, int fr, int fq) const {
        bf16_t* base = O + (size_t)(u.i0 * BM + wr * 64 + fr) * ldo + u.i1 * BM + wc * 32 + 8 * fq;
#pragma unroll
        for (int ai = 0; ai < 2; ++ai)
#pragma unroll
            for (int m = 0; m < 4; ++m) { bf16_t* rowp = base + (size_t)(ai * HALF + m * 16) * ldo;
#pragma unroll
                for (int bj = 0; bj < 2; ++bj) { const f32x4 v0 = acc[ai][bj][m][0], v1 = acc[ai][bj][m][1];
                    u32x4 w; w.x = cvt_pk(v0[0], v0[1]); w.y = cvt_pk(v0[2], v0[3]); w.z = cvt_pk(v1[0], v1[1]); w.w = cvt_pk(v1[2], v1[3]);
                    *(u32x4*)(rowp + bj * HALF) = w; } }
    } };
struct EpiResBf { static constexpr bool PERM = true; const bf16_t* R; bf16_t* O; int ld;
    DEVI void mid(f32x4 (&)[2][2][4][2], const UnitU&, int, int, int, int) const {}
    DEVI void operator()(const f32x4 (&acc)[2][2][4][2], const UnitU& u, int wr, int wc, int fr, int fq) const {
        const size_t off0 = (size_t)(u.i0 * BM + wr * 64 + fr) * ld + u.i1 * BM + wc * 32 + 8 * fq;
#pragma unroll
        for (int ai = 0; ai < 2; ++ai) {
            u32x4 rr[4][2];
#pragma unroll
            for (int m = 0; m < 4; ++m)
#pragma unroll
                for (int bj = 0; bj < 2; ++bj) rr[m][bj] = *(const u32x4*)(R + off0 + (size_t)(ai * HALF + m * 16) * ld + bj * HALF);
#pragma unroll
            for (int m = 0; m < 4; ++m) { const size_t off = off0 + (size_t)(ai * HALF + m * 16) * ld;
#pragma unroll
                for (int bj = 0; bj < 2; ++bj) { const u32x4 r = rr[m][bj]; const f32x4 v0 = acc[ai][bj][m][0], v1 = acc[ai][bj][m][1];
                    u32x4 w; w.x = cvt_pk(bflo(r.x) + v0[0], bfhi(r.x) + v0[1]); w.y = cvt_pk(bflo(r.y) + v0[2], bfhi(r.y) + v0[3]);
                    w.z = cvt_pk(bflo(r.z) + v1[0], bfhi(r.z) + v1[1]); w.w = cvt_pk(bflo(r.w) + v1[2], bfhi(r.w) + v1[3]);
                    *(u32x4*)(O + off + bj * HALF) = w; } }
        }
    } };
struct EpiRes { static constexpr bool PERM = false; const float* R; float* O; int ld; bf16_t* H;
    DEVI void mid(f32x4 (&)[2][2][4][2], const UnitU&, int, int, int, int) const {}
    DEVI void operator()(const f32x4 (&acc)[2][2][4][2], const UnitU& u, int wr, int wc, int fr, int fq) const {
        const size_t off0 = (size_t)(u.i0 * BM + wr * 64 + fr) * ld + u.i1 * BM + wc * 32 + 4 * fq;
#pragma unroll
        for (int ai = 0; ai < 2; ++ai)
#pragma unroll
            for (int m = 0; m < 4; ++m) { const size_t off = off0 + (size_t)(ai * HALF + m * 16) * ld;
#pragma unroll
                for (int bj = 0; bj < 2; ++bj)
#pragma unroll
                    for (int n = 0; n < 2; ++n) { const f32x4 r = *(const f32x4*)(R + off + bj * HALF + n * 16); const f32x4 o = r + acc[ai][bj][m][n];
                        *(f32x4*)(O + off + bj * HALF + n * 16) = o;
                        u32x2 w; w.x = cvt_pk(o[0], o[1]); w.y = cvt_pk(o[2], o[3]); *(u32x2*)(H + off + bj * HALF + n * 16) = w; } }
    } };
struct DenseSched2 {
    static constexpr bool GATHER = false;
    DenseSched D; int sub;
    DEVI void init(const bf16_t* A_, const bf16_t* Bt_, int M, int N, int K_, int G_, int c_) { D.init(A_, Bt_, M, N, K_, G_, c_); sub = 0; }
    UnitU pend;
    DEVI bool next(UnitU& u) {
        if (sub == 0) { if (!D.next(pend)) return false; u = pend; u.A = pend.A + (size_t)(D.K / 2) * 2; u.B = pend.B + (size_t)(D.K / 2) * 2; u.flags = 1; sub = 1; return true; }
        u = pend; u.flags = 2; sub = 0; return true;
    }
    DEVI void lane_va(const UnitU& u, int R0, int C0, int R1, int C1, unsigned& v00, unsigned& v01, unsigned& v10, unsigned& v11) const { D.lane_va(u, R0, C0, R1, C1, v00, v01, v10, v11); }
};
struct EpiResScale : EpiResBf { const float* ssq;
    DEVI void mid(f32x4 (&acc)[2][2][4][2], const UnitU& u, int wr, int wc, int fr, int fq) const {
        float2 sqv[2][4];
#pragma unroll
        for (int ai = 0; ai < 2; ++ai)
#pragma unroll
            for (int m = 0; m < 4; ++m) sqv[ai][m] = *(const float2*)(ssq + (size_t)(u.i0 * BM + ai * HALF + wr * 64 + m * 16 + fr) * 2);
#pragma unroll
        for (int ai = 0; ai < 2; ++ai)
#pragma unroll
            for (int m = 0; m < 4; ++m) {
                const float2 sq = sqv[ai][m];
                const float rs = rsqrtf((sq.x + sq.y) * (1.0f / 512.0f) + EPS);
#pragma unroll
                for (int bj = 0; bj < 2; ++bj)
#pragma unroll
                    for (int n = 0; n < 2; ++n) acc[ai][bj][m][n] *= rs;
            }
    } };
}

constexpr float LOG2E_C = 1.4426950408889634f;
DEVI void cumsum_task(const DP& p, int bh, char* lds) {
    const int tid = TIDX(), wid = tid >> 6, lane = tid & 63;
    const int b = bh >> 2, h = bh & 3;
    const float* logf = (const float*)(p.ws() + WS_LOGF);
    float* cumf = (float*)(p.ws() + WS_CUMF);
    float* wtot = (float*)lds;
    float v[4];
#pragma unroll
    for (int j = 0; j < 4; ++j) v[j] = logf[((size_t)b * S + tid * 4 + j) * 4 + h];
    v[1] += v[0]; v[2] += v[1]; v[3] += v[2];
    float incl = v[3];
#pragma unroll
    for (int d = 1; d < 64; d <<= 1) { const float t = __shfl_up(incl, d); if (lane >= d) incl += t; }
    if (lane == 63) wtot[wid] = incl;
    __syncthreads();
    float woff = 0.f;
    for (int w = 0; w < wid; ++w) woff += wtot[w];
    const float base = woff + incl - v[3];
    *(float4*)(cumf + (size_t)bh * S + tid * 4) = make_float4((base + v[0]) * LOG2E_C, (base + v[1]) * LOG2E_C, (base + v[2]) * LOG2E_C, (base + v[3]) * LOG2E_C);
    __syncthreads();
}
DEVI void phase_inproj(const DP& p, int l, char* lds) {
    unsigned char* ws = p.ws();
    g8::DenseSched S; S.init((const bf16_t*)(ws + WS_HBUF), (const bf16_t*)(ws + WS_W_IN), T, NPROJ, DM, gridDim.x, BIDX());
    g8::EpiBf16Scale E{(bf16_t*)(ws + WS_PROJ), NPROJ, (const float*)(ws + WS_RSTD1)};
    g8::gemm8(lds, DM, DM, S, E);
}
DEVI void kv_gemm(const DP& p, char* lds) {
    unsigned char* ws = p.ws();
    const int c = BIDX() - ((int)gridDim.x - 64);
    if (c < 0) return;
    g8::DenseSched S; S.init((const bf16_t*)(ws + WS_MEMN), (const bf16_t*)(ws + WS_W_KV), MROWS, 2 * DM, DM, 64, c);
    g8::EpiBf16 E{(bf16_t*)(ws + WS_KV), 2 * DM};
    g8::gemm8(lds, DM, DM, S, E);
}

DEVI void conv8_pos(const DP& p, int l, const bf16_t* proj, int b, int sp, int chan0, float (&out)[8]) {
    float a[8];
    const float* cb = p.in(10) + l * 1024 + chan0;
#pragma unroll
    for (int i = 0; i < 8; ++i) a[i] = cb[i];
#pragma unroll
    for (int j = 0; j < 4; ++j) {
        const int s2 = sp - 3 + j;
        if (s2 >= 0) {
            const u32x4 w = *(const u32x4*)(proj + ((size_t)b * S + s2) * NPROJ + C_XBC + chan0);
            const float* cw = p.in(9) + ((size_t)l * 4 + j) * 1024 + chan0;
            a[0] += cw[0] * bflo(w.x); a[1] += cw[1] * bfhi(w.x); a[2] += cw[2] * bflo(w.y); a[3] += cw[3] * bfhi(w.y);
            a[4] += cw[4] * bflo(w.z); a[5] += cw[5] * bfhi(w.z); a[6] += cw[6] * bflo(w.w); a[7] += cw[7] * bfhi(w.w);
        }
    }
#pragma unroll
    for (int i = 0; i < 8; ++i) out[i] = silu_f(a[i]);
}
DEVI u32x4 pack8(const float (&v)[8]) { u32x4 w; w.x = cvt_pk(v[0], v[1]); w.y = cvt_pk(v[2], v[3]); w.z = cvt_pk(v[4], v[5]); w.w = cvt_pk(v[6], v[7]); return w; }


DEVI void phase_post(const DP& p, int l) {
    const int tid = TIDX(), wid = tid >> 6, lane = tid & 63;
    unsigned char* ws = p.ws();
    bf16_t* proj = (bf16_t*)(ws + WS_PROJ);
    const int sl = lane >> 2, qt = lane & 3, type = sl >> 2, head = sl & 3;
    const int col0 = (type < 2 ? type * 256 : 768 + (type - 2) * 256) + head * 64 + qt * 16;
    const float *gq0 = p.in(5), *gq1 = p.in(6), *gq2 = p.in(7), *gq3 = p.in(8);
    asm volatile("" : "+s"(gq0), "+s"(gq1), "+s"(gq2), "+s"(gq3));
    const float* gain = (type == 0 ? gq0 : type == 1 ? gq1 : type == 2 ? gq2 : gq3) + l * 64 + qt * 16;
    float gv[16];
#pragma unroll
    for (int i = 0; i < 16; ++i) gv[i] = gain[i];
    const float inv[8] = {1.000000000e+00f, 1.939227432e-01f, 3.760603070e-02f, 7.292664610e-03f, 1.414213562e-03f, 2.742481884e-04f, 5.318295734e-05f, 1.031338525e-05f};
    for (int row = BIDX() * 8 + wid; row < T; row += gridDim.x * 8) {
        bf16_t* ptr = proj + (size_t)row * NPROJ + col0;
        const u32x4 w0 = *(const u32x4*)ptr, w1 = *(const u32x4*)(ptr + 8);
        float v[16];
        v[0] = bflo(w0.x); v[1] = bfhi(w0.x); v[2] = bflo(w0.y); v[3] = bfhi(w0.y); v[4] = bflo(w0.z); v[5] = bfhi(w0.z); v[6] = bflo(w0.w); v[7] = bfhi(w0.w);
        v[8] = bflo(w1.x); v[9] = bfhi(w1.x); v[10] = bflo(w1.y); v[11] = bfhi(w1.y); v[12] = bflo(w1.z); v[13] = bfhi(w1.z); v[14] = bflo(w1.w); v[15] = bfhi(w1.w);
        float ss = 0.f;
#pragma unroll
        for (int i = 0; i < 16; ++i) ss += v[i] * v[i];
        ss += __shfl_xor(ss, 1); ss += __shfl_xor(ss, 2);
        const float rstd = rsqrtf(ss * (1.0f / 64.0f) + EPS);
        const float qs = (type == 0 || type == 2) ? rstd * (0.125f * 1.4426950408889634f) : rstd;
#pragma unroll
        for (int i = 0; i < 16; ++i) v[i] = v[i] * qs * gv[i];
        if (type >= 2 && qt == 0) {
            const float pos = (float)(row & (S - 1));
#pragma unroll
            for (int i = 0; i < 8; ++i) { const float rev = __builtin_amdgcn_fractf(pos * inv[i] * 0.15915494309189535f);
                const float sn = __builtin_amdgcn_sinf(rev), cs = __builtin_amdgcn_cosf(rev);
                const float a = v[i], b = v[i + 8]; v[i] = a * cs - b * sn; v[i + 8] = b * cs + a * sn; }
        }
        u32x4 o0, o1;
        o0.x = cvt_pk(v[0], v[1]); o0.y = cvt_pk(v[2], v[3]); o0.z = cvt_pk(v[4], v[5]); o0.w = cvt_pk(v[6], v[7]);
        o1.x = cvt_pk(v[8], v[9]); o1.y = cvt_pk(v[10], v[11]); o1.z = cvt_pk(v[12], v[13]); o1.w = cvt_pk(v[14], v[15]);
        *(u32x4*)ptr = o0; *(u32x4*)(ptr + 8) = o1;
    }
    bf16_t* xc = (bf16_t*)(ws + WS_XC);
    {
        const int item0 = BIDX() * NTHR + tid, istride = gridDim.x * NTHR;
        if ((istride & 127) == 0) {
            const int c8 = (item0 & 127) * 8;
            float cwv[4][8], cbv[8];
#pragma unroll
            for (int i = 0; i < 8; ++i) cbv[i] = p.in(10)[l * 1024 + c8 + i];
#pragma unroll
            for (int j = 0; j < 4; ++j)
#pragma unroll
                for (int i = 0; i < 8; ++i) cwv[j][i] = p.in(9)[((size_t)l * 4 + j) * 1024 + c8 + i];
            for (int it0 = item0; it0 < T * 128; it0 += 4 * istride) {
                u32x4 w[4][4];
#pragma unroll
                for (int q = 0; q < 4; ++q) {
                    const int item = it0 + q * istride, t = (item < T * 128 ? item : it0) >> 7, sp = t % S;
#pragma unroll
                    for (int j = 0; j < 4; ++j) { const int s2 = sp - 3 + j; w[q][j] = *(const u32x4*)(proj + ((size_t)(t - sp) + (s2 >= 0 ? s2 : sp)) * NPROJ + C_XBC + c8); }
                }
#pragma unroll
                for (int q = 0; q < 4; ++q) {
                    const int item = it0 + q * istride;
                    if (item < T * 128) {
                        const int t = item >> 7, sp = t % S;
                        float a[8];
#pragma unroll
                        for (int i = 0; i < 8; ++i) a[i] = cbv[i];
#pragma unroll
                        for (int j = 0; j < 4; ++j) {
                            if (sp - 3 + j >= 0) { const u32x4 ww = w[q][j];
                                a[0] += cwv[j][0] * bflo(ww.x); a[1] += cwv[j][1] * bfhi(ww.x); a[2] += cwv[j][2] * bflo(ww.y); a[3] += cwv[j][3] * bfhi(ww.y);
                                a[4] += cwv[j][4] * bflo(ww.z); a[5] += cwv[j][5] * bfhi(ww.z); a[6] += cwv[j][6] * bflo(ww.w); a[7] += cwv[j][7] * bfhi(ww.w); }
                        }
                        float v[8];
#pragma unroll
                        for (int i = 0; i < 8; ++i) v[i] = silu_f(a[i]);
                        *(u32x4*)(xc + (size_t)t * 1024 + c8) = pack8(v);
                    }
                }
            }
        } else {
            for (int item = item0; item < T * 128; item += istride) {
                const int t = item >> 7, c8 = (item & 127) * 8;
                float v[8]; conv8_pos(p, l, proj, t / S, t % S, c8, v);
                *(u32x4*)(xc + (size_t)t * 1024 + c8) = pack8(v);
            }
        }
    }
}
DEVI void phase_knorm(const DP& p, int l) {
    const int tid = TIDX(), wid = tid >> 6, lane = tid & 63;
    unsigned char* ws = p.ws();
    bf16_t* kv = (bf16_t*)(ws + WS_KV);
    const float* kg = p.in(21) + l * 256 + (lane & 15) * 16;
    float kgv[16];
#pragma unroll
    for (int i = 0; i < 16; ++i) kgv[i] = kg[i];
    for (int row = BIDX() * 8 + wid; row < MROWS; row += gridDim.x * 8) {
        bf16_t* ptr = kv + (size_t)row * 2 * DM + lane * 16;
        const u32x4 w0 = *(const u32x4*)ptr, w1 = *(const u32x4*)(ptr + 8);
        float v[16];
        v[0] = bflo(w0.x); v[1] = bfhi(w0.x); v[2] = bflo(w0.y); v[3] = bfhi(w0.y); v[4] = bflo(w0.z); v[5] = bfhi(w0.z); v[6] = bflo(w0.w); v[7] = bfhi(w0.w);
        v[8] = bflo(w1.x); v[9] = bfhi(w1.x); v[10] = bflo(w1.y); v[11] = bfhi(w1.y); v[12] = bflo(w1.z); v[13] = bfhi(w1.z); v[14] = bflo(w1.w); v[15] = bfhi(w1.w);
        float ss = 0.f;
#pragma unroll
        for (int i = 0; i < 16; ++i) ss += v[i] * v[i];
        ss += __shfl_xor(ss, 1); ss += __shfl_xor(ss, 2); ss += __shfl_xor(ss, 4); ss += __shfl_xor(ss, 8);
        const float rstd = rsqrtf(ss * (1.0f / 256.0f) + EPS);
#pragma unroll
        for (int i = 0; i < 16; ++i) v[i] = v[i] * rstd * kgv[i];
        u32x4 o0, o1;
        o0.x = cvt_pk(v[0], v[1]); o0.y = cvt_pk(v[2], v[3]); o0.z = cvt_pk(v[4], v[5]); o0.w = cvt_pk(v[6], v[7]);
        o1.x = cvt_pk(v[8], v[9]); o1.y = cvt_pk(v[10], v[11]); o1.z = cvt_pk(v[12], v[13]); o1.w = cvt_pk(v[14], v[15]);
        *(u32x4*)ptr = o0; *(u32x4*)(ptr + 8) = o1;
    }
}
constexpr float LOG2E = 1.4426950408889634f;
template <int DH> struct AttnLds { static constexpr int KST = DH + 8; static constexpr int TILE = 64 * KST; static constexpr int BYTES = 4 * TILE * 2; };
DEVI float xor16_max(float v) { auto r = __builtin_amdgcn_permlane16_swap(__float_as_uint(v), __float_as_uint(v), false, false); return fmaxf(__uint_as_float(r[0]), __uint_as_float(r[1])); }
DEVI float xor16_sum(float v) { auto r = __builtin_amdgcn_permlane16_swap(__float_as_uint(v), __float_as_uint(v), false, false); return __uint_as_float(r[0]) + __uint_as_float(r[1]); }
DEVI float xor32_max(float v) { auto r = __builtin_amdgcn_permlane32_swap(__float_as_uint(v), __float_as_uint(v), false, false); return fmaxf(__uint_as_float(r[0]), __uint_as_float(r[1])); }
DEVI float xor32_sum(float v) { auto r = __builtin_amdgcn_permlane32_swap(__float_as_uint(v), __float_as_uint(v), false, false); return __uint_as_float(r[0]) + __uint_as_float(r[1]); }
template <int DH, int MODE, int QR>
DEVI void attn_task(const bf16_t* __restrict__ Qb, int ldq, int qtok0, int qstep,
                    const bf16_t* __restrict__ Kb, const bf16_t* __restrict__ Vb, int ldk, int ktok0, int kstep,
                    int p0, int kt_lo, int kt_hi, float scale,
                    const float* __restrict__ cum, const float* __restrict__ qgain,
                    bf16_t* Ob, int ldo, float* Of, float* Om, float* Ol, char* lds) {
    constexpr int KST = AttnLds<DH>::KST, TILE = AttnLds<DH>::TILE, NKK = DH / 32, ND = DH / 16, NCH = (64 * DH / 8) / NTHR;
    constexpr int WR = 16 * QR;
    const int tid = TIDX(), wid = tid >> 6, lane = tid & 63, r16 = lane & 15, g4 = lane >> 4;
    bf16_t* Ks = (bf16_t*)lds;
    bf16_t* Vs = Ks + 2 * TILE;
    const float c2 = scale * LOG2E;
    bf16x8 qf[QR][NKK];
    int qpos[QR];
#pragma unroll
    for (int g = 0; g < QR; ++g) {
        qpos[g] = p0 + wid * WR + g * 16 + r16;
        const bf16_t* qp = Qb + (size_t)(qtok0 + qpos[g] * qstep) * ldq + g4 * 8;
#pragma unroll
        for (int kk = 0; kk < NKK; ++kk) qf[g][kk] = *(const bf16x8*)(qp + kk * 32);
    }
    if (MODE == 2) {
#pragma unroll
        for (int g = 0; g < QR; ++g) {
            float ss = 0.f;
#pragma unroll
            for (int kk = 0; kk < NKK; ++kk)
#pragma unroll
                for (int j = 0; j < 8; ++j) { const float v = bf2f((bf16_t)qf[g][kk][j]); ss += v * v; }
            ss += __shfl_xor(ss, 16); ss += __shfl_xor(ss, 32);
            const float rstd = rsqrtf(ss * (1.0f / DH) + EPS);
#pragma unroll
            for (int kk = 0; kk < NKK; ++kk)
#pragma unroll
                for (int j = 0; j < 8; ++j) { const float v = bf2f((bf16_t)qf[g][kk][j]) * (rstd * c2) * qgain[kk * 32 + g4 * 8 + j]; qf[g][kk][j] = (short)f2bf(v); }
        }
    }
    float m_[QR], cq[QR];
    f32x4 o[QR][ND], o1[QR];
#pragma unroll
    for (int g = 0; g < QR; ++g) {
        m_[g] = 0.f; cq[g] = (MODE == 0) ? cum[qpos[g]] : 0.f;
        o1[g] = (f32x4){0.f, 0.f, 0.f, 0.f};
#pragma unroll
        for (int n = 0; n < ND; ++n) o[g][n] = (f32x4){0.f, 0.f, 0.f, 0.f};
    }
    bf16x8 vones;
#pragma unroll
    for (int j = 0; j < 8; ++j) vones[j] = (short)(r16 == 0 ? 0x3f80 : 0);
    u32x4 rk[NCH], rv[NCH];
    auto gload = [&](int kt) {
#pragma unroll
        for (int i = 0; i < NCH; ++i) { const int c = tid + i * NTHR, key = c / (DH / 8), dc = c % (DH / 8);
            const size_t tok = (size_t)(ktok0 + (kt * 64 + key) * kstep);
            rk[i] = *(const u32x4*)(Kb + tok * ldk + dc * 8); rv[i] = *(const u32x4*)(Vb + tok * ldk + dc * 8); }
    };
    gload(kt_lo);
    __syncthreads();
    int buf = 0;
    for (int kt = kt_lo; kt < kt_hi; ++kt, buf ^= 1) {
        bf16_t* Kt = Ks + buf * TILE;
        bf16_t* Vt = Vs + buf * TILE;
#pragma unroll
        for (int i = 0; i < NCH; ++i) { const int c = tid + i * NTHR, key = c / (DH / 8), dc = c % (DH / 8);
            *(u32x4*)(Kt + key * KST + dc * 8) = rk[i]; *(u32x4*)(Vt + key * KST + dc * 8) = rv[i]; }
        __syncthreads();
        if (kt + 1 < kt_hi) gload(kt + 1);
        const int qmin = p0 + wid * WR, kmin = kt * 64;
        bool skip = false, interior = true;
        if (MODE == 0) { skip = kmin > qmin + WR - 1; interior = kmin + 63 <= qmin; }
        if (MODE == 1) { skip = (qmin + WR - 1 - kmin < 0) || (qmin - (kmin + 63) > 128); interior = (qmin - (kmin + 63) >= 0) && (qmin + WR - 1 - kmin <= 128); }
        if (skip) continue;
        f32x4 s[QR][4];
        float cm[QR];
#pragma unroll
        for (int g = 0; g < QR; ++g) cm[g] = cq[g] - m_[g];
#pragma unroll
        for (int n = 0; n < 4; ++n) {
            f32x4 ck = (f32x4){0.f, 0.f, 0.f, 0.f};
            if (MODE == 0) ck = *(const f32x4*)(cum + kt * 64 + n * 16 + g4 * 4);
#pragma unroll
            for (int g = 0; g < QR; ++g) s[g][n] = (f32x4){cm[g] - ck[0], cm[g] - ck[1], cm[g] - ck[2], cm[g] - ck[3]};
#pragma unroll
            for (int kk = 0; kk < NKK; ++kk) {
                const bf16x8 kf = *(const bf16x8*)(Kt + (n * 16 + r16) * KST + kk * 32 + g4 * 8);
#pragma unroll
                for (int g = 0; g < QR; ++g) s[g][n] = MFMA16(kf, qf[g][kk], s[g][n]);
            }
            if (DH > 64) __builtin_amdgcn_sched_barrier(0);
        }
        float mx[QR];
#pragma unroll
        for (int g = 0; g < QR; ++g) mx[g] = -INFINITY;
#pragma unroll
        for (int n = 0; n < 4; ++n)
#pragma unroll
            for (int g = 0; g < QR; ++g)
#pragma unroll
                for (int j = 0; j < 4; ++j) {
                    float t = s[g][n][j];
                    if (!interior) {
                        const int kpos = kt * 64 + n * 16 + g4 * 4 + j;
                        if (MODE == 0) { if (kpos > qpos[g]) t = -INFINITY; }
                        if (MODE == 1) { const int dd = qpos[g] - kpos; if (dd < 0 || dd > 128) t = -INFINITY; }
                        s[g][n][j] = t;
                    }
                    mx[g] = fmaxf(mx[g], t);
                }
        bool grow = false;
#pragma unroll
        for (int g = 0; g < QR; ++g) { mx[g] = xor32_max(xor16_max(mx[g])); grow = grow || (mx[g] > 8.0f); }
        if (__any(grow)) {
#pragma unroll
            for (int g = 0; g < QR; ++g) {
                const float delta = fmaxf(mx[g], 0.f);
                const float alpha = __builtin_amdgcn_exp2f(-delta);
                m_[g] += delta; o1[g] *= alpha;
#pragma unroll
                for (int n = 0; n < ND; ++n) o[g][n] *= alpha;
#pragma unroll
                for (int n = 0; n < 4; ++n) s[g][n] -= delta;
            }
        }
#pragma unroll
        for (int g = 0; g < QR; ++g)
#pragma unroll
            for (int n = 0; n < 4; ++n)
#pragma unroll
                for (int j = 0; j < 4; ++j) s[g][n][j] = __builtin_amdgcn_exp2f(s[g][n][j]);
#pragma unroll
        for (int kk = 0; kk < 2; ++kk) {
            bf16x8 pb[QR];
#pragma unroll
            for (int g = 0; g < QR; ++g) {
                u32x4 w; w.x = cvt_pk(s[g][2 * kk][0], s[g][2 * kk][1]); w.y = cvt_pk(s[g][2 * kk][2], s[g][2 * kk][3]); w.z = cvt_pk(s[g][2 * kk + 1][0], s[g][2 * kk + 1][1]); w.w = cvt_pk(s[g][2 * kk + 1][2], s[g][2 * kk + 1][3]);
                pb[g] = __builtin_bit_cast(bf16x8, w);
                o1[g] = MFMA16(vones, pb[g], o1[g]);
            }
            const bf16_t* vb = Vt + (kk * 32 + 4 * g4 + (r16 >> 2)) * KST + 4 * (r16 & 3);
#pragma unroll
            for (int n = 0; n < ND; ++n) {
                const s16x4 lo = tr_read(vb + n * 16), hi = tr_read(vb + 16 * KST + n * 16);
                bf16x8 vf; vf[0] = lo[0]; vf[1] = lo[1]; vf[2] = lo[2]; vf[3] = lo[3]; vf[4] = hi[0]; vf[5] = hi[1]; vf[6] = hi[2]; vf[7] = hi[3];
#pragma unroll
                for (int g = 0; g < QR; ++g) o[g][n] = MFMA16(vf, pb[g], o[g][n]);
                if (DH > 64 && (n & 3) == 3) __builtin_amdgcn_sched_barrier(0);
            }
        }
    }
#pragma unroll
    for (int g = 0; g < QR; ++g) {
        const size_t tok = (size_t)(qtok0 + qpos[g] * qstep);
        const float lsum = __shfl(o1[g][0], r16);
        if (MODE == 1) {
#pragma unroll
            for (int n = 0; n < ND; ++n) *(f32x4*)(Of + tok * 256 + n * 16 + g4 * 4) = o[g][n];
            if (g4 == 0) { Om[tok * 4] = m_[g]; Ol[tok * 4] = lsum; }
        } else {
            const float inv = 1.0f / lsum;
#pragma unroll
            for (int n = 0; n < ND; ++n) { u32x2 w; w.x = cvt_pk(o[g][n][0] * inv, o[g][n][1] * inv); w.y = cvt_pk(o[g][n][2] * inv, o[g][n][3] * inv);
                *(u32x2*)(Ob + tok * ldo + n * 16 + g4 * 4) = w; }
        }
    }
}

DEVI void ssd_acs(const DP& p, int l, int b, int c, int g, float* acs, float* dts) {
    const int tid = TIDX(), wid = tid >> 6, lane = tid & 63;
    if (wid < 4) {
        const int head = g * 4 + wid;
        const float* dtv = (const float*)(p.ws() + WS_DTV);
        const float A = -__expf(p.in(12)[l * 8 + head]);
        const size_t t0 = (size_t)b * S + c * 128 + 2 * lane;
        const float d0 = dtv[t0 * 8 + head], d1 = dtv[(t0 + 1) * 8 + head];
        const float a0 = d0 * A, a1 = d1 * A;
        float incl = a0 + a1;
#pragma unroll
        for (int d = 1; d < 64; d <<= 1) { const float t = __shfl_up(incl, d); if (lane >= d) incl += t; }
        const float ex = incl - (a0 + a1);
        acs[wid * 128 + 2 * lane] = ex + a0; acs[wid * 128 + 2 * lane + 1] = ex + a0 + a1;
        dts[wid * 128 + 2 * lane] = d0; dts[wid * 128 + 2 * lane + 1] = d1;
    }
}
DEVI void conv8_chan(const DP& p, int l, const bf16_t* proj, int b, int c, int chan, int l0, float (&out)[8]) {
    const float* cw = p.in(9) + (size_t)l * 4 * 1024 + chan;
    const float w0 = cw[0], w1 = cw[1024], w2 = cw[2048], w3 = cw[3072], cb = p.in(10)[l * 1024 + chan];
    float v[11];
    const int sbase = c * 128 + l0 - 3;
#pragma unroll
    for (int i = 0; i < 11; ++i) { const int sp = sbase + i; v[i] = sp >= 0 ? bf2f(proj[((size_t)b * S + sp) * NPROJ + C_XBC + chan]) : 0.f; }
#pragma unroll
    for (int i = 0; i < 8; ++i) out[i] = silu_f(cb + w0 * v[i] + w1 * v[i + 1] + w2 * v[i + 2] + w3 * v[i + 3]);
}
constexpr int SST = 136;
constexpr int XST4 = 264;
DEVI void ssd_states_task(const DP& p, int l, int b, int c, int g, char* lds) {
    const int tid = TIDX(), wid = tid >> 6, lane = tid & 63, r16 = lane & 15, g4 = lane >> 4;
    const bf16_t* xc = (const bf16_t*)(p.ws() + WS_XC);
    bf16_t* Bn = (bf16_t*)lds;
    bf16_t* Xn = Bn + 128 * SST;
    float* acs = (float*)(Xn + 128 * XST4);
    float* dts = acs + 512;
    __syncthreads();
    ssd_acs(p, l, b, c, g, acs, dts);
    __syncthreads();
    if (tid < 4) ((float*)(p.ws() + WS_DECAY))[((size_t)b * 16 + c) * 8 + g * 4 + tid] = __expf(acs[tid * 128 + 127]);
    const size_t tok0 = (size_t)b * S + c * 128;
    for (int it = tid; it < 2048; it += NTHR) {
        const int ll = it >> 4, nc = (it & 15) * 8;
        *(u32x4*)(Bn + ll * SST + nc) = *(const u32x4*)(xc + (tok0 + ll) * 1024 + 512 + g * 128 + nc);
    }
    for (int it = tid; it < 4096; it += NTHR) {
        const int ll = it >> 5, ch = (it & 31) * 8, hl = ch >> 6;
        const u32x4 w = *(const u32x4*)(xc + (tok0 + ll) * 1024 + g * 256 + ch);
        const float sc = dts[hl * 128 + ll] * __expf(acs[hl * 128 + 127] - acs[hl * 128 + ll]);
        u32x4 o; o.x = cvt_pk(bflo(w.x) * sc, bfhi(w.x) * sc); o.y = cvt_pk(bflo(w.y) * sc, bfhi(w.y) * sc); o.z = cvt_pk(bflo(w.z) * sc, bfhi(w.z) * sc); o.w = cvt_pk(bflo(w.w) * sc, bfhi(w.w) * sc);
        *(u32x4*)(Xn + ll * XST4 + ch) = o;
    }
    __syncthreads();
    const int hl = wid >> 1, nh = wid & 1;
    f32x4 acc[4][4];
#pragma unroll
    for (int m = 0; m < 4; ++m)
#pragma unroll
        for (int n = 0; n < 4; ++n) acc[m][n] = (f32x4){0.f, 0.f, 0.f, 0.f};
#pragma unroll
    for (int kk = 0; kk < 4; ++kk) {
        bf16x8 af[4], bfr[4];
        const int lrow = kk * 32 + 8 * g4 + (r16 >> 2), cq = 4 * (r16 & 3);
#pragma unroll
        for (int m = 0; m < 4; ++m) { const bf16_t* a = Xn + lrow * XST4 + hl * 64 + m * 16 + cq; const s16x4 lo = tr_read(a), hi = tr_read(a + 4 * XST4);
            af[m][0] = lo[0]; af[m][1] = lo[1]; af[m][2] = lo[2]; af[m][3] = lo[3]; af[m][4] = hi[0]; af[m][5] = hi[1]; af[m][6] = hi[2]; af[m][7] = hi[3]; }
#pragma unroll
        for (int n = 0; n < 4; ++n) { const bf16_t* a = Bn + lrow * SST + nh * 64 + n * 16 + cq; const s16x4 lo = tr_read(a), hi = tr_read(a + 4 * SST);
            bfr[n][0] = lo[0]; bfr[n][1] = lo[1]; bfr[n][2] = lo[2]; bfr[n][3] = lo[3]; bfr[n][4] = hi[0]; bfr[n][5] = hi[1]; bfr[n][6] = hi[2]; bfr[n][7] = hi[3]; }
#pragma unroll
        for (int m = 0; m < 4; ++m)
#pragma unroll
            for (int n = 0; n < 4; ++n) acc[m][n] = MFMA16(bfr[n], af[m], acc[m][n]);
    }
    float* st = (float*)(p.ws() + WS_SSTATE) + (((size_t)b * 16 + c) * 8 + g * 4 + hl) * 8192;
#pragma unroll
    for (int m = 0; m < 4; ++m)
#pragma unroll
        for (int n = 0; n < 4; ++n) *(f32x4*)(st + (m * 16 + r16) * 128 + nh * 64 + n * 16 + g4 * 4) = acc[m][n];
}
DEVI void phase_ssd_scan(const DP& p) {
    const float* st = (const float*)(p.ws() + WS_SSTATE);
    bf16_t* hin = (bf16_t*)(p.ws() + WS_HIN);
    const float* decay = (const float*)(p.ws() + WS_DECAY);
    const int total = NB * 8 * 2048;
    for (int i = BIDX() * NTHR + TIDX(); i < total; i += gridDim.x * NTHR) {
        const int e4 = i & 2047, head = (i >> 11) & 7, b = i >> 14;
        f32x4 h = (f32x4){0.f, 0.f, 0.f, 0.f};
        f32x4 sv[15]; float dv[15];
#pragma unroll
        for (int c = 0; c < 15; ++c) { sv[c] = *(const f32x4*)(st + (((size_t)b * 16 + c) * 8 + head) * 8192 + e4 * 4); dv[c] = decay[((size_t)b * 16 + c) * 8 + head]; }
#pragma unroll
        for (int c = 0; c < 16; ++c) {
            const size_t off = (((size_t)b * 16 + c) * 8 + head) * 8192 + e4 * 4;
            u32x2 w; w.x = cvt_pk(h[0], h[1]); w.y = cvt_pk(h[2], h[3]);
            *(u32x2*)(hin + off) = w;
            if (c < 15) h = h * dv[c] + sv[c];
        }
    }
}
constexpr int XST1 = 72;
DEVI void ssd_out_task(const DP& p, int l, int b, int c, int g, char* lds) {
    const int tid = TIDX(), wid = tid >> 6, lane = tid & 63, r16 = lane & 15, g4 = lane >> 4;
    const bf16_t* proj = (const bf16_t*)(p.ws() + WS_PROJ);
    const bf16_t* xc = (const bf16_t*)(p.ws() + WS_XC);
    bf16_t* Cs = (bf16_t*)lds;
    bf16_t* Bs = Cs + 128 * SST;
    bf16_t* Xn = Bs + 128 * SST;
    bf16_t* Hs = Xn + 128 * XST1;
    bf16_t* Mw = Hs + 64 * SST + wid * 16 * SST;
    float* acs = (float*)(Hs + 64 * SST + 8 * 16 * SST);
    float* dts = acs + 512;
    const int lrow = wid * 16 + r16;
    const size_t tok0 = (size_t)b * S + c * 128, tok = tok0 + lrow;
    bf16_t* mix = (bf16_t*)(p.ws() + WS_MIX);
    float ssq = 0.f;
    __syncthreads();
    ssd_acs(p, l, b, c, g, acs, dts);
    for (int it = tid; it < 2048; it += NTHR) {
        const int ll = it >> 4, nc = (it & 15) * 8;
        *(u32x4*)(Cs + ll * SST + nc) = *(const u32x4*)(xc + (tok0 + ll) * 1024 + 768 + g * 128 + nc);
        *(u32x4*)(Bs + ll * SST + nc) = *(const u32x4*)(xc + (tok0 + ll) * 1024 + 512 + g * 128 + nc);
    }
    __syncthreads();
    bf16x8 cfr[4];
#pragma unroll
    for (int kk = 0; kk < 4; ++kk) cfr[kk] = *(const bf16x8*)(Cs + lrow * SST + kk * 32 + g4 * 8);
    f32x4 cb[8];
#pragma unroll
    for (int st = 0; st < 8; ++st) {
        cb[st] = (f32x4){0.f, 0.f, 0.f, 0.f};
#pragma unroll
        for (int kk = 0; kk < 4; ++kk) {
            const bf16x8 bfr = *(const bf16x8*)(Bs + (st * 16 + r16) * SST + kk * 32 + g4 * 8);
            cb[st] = MFMA16(bfr, cfr[kk], cb[st]);
        }
    }
    u32x4 px[2], ph[2];
    auto hload = [&](int hl_) {
        const int head_ = g * 4 + hl_;
#pragma unroll
        for (int i = 0; i < 2; ++i) { const int it = tid + i * NTHR, ss = it >> 3, pc8 = (it & 7) * 8;
            px[i] = *(const u32x4*)(xc + (tok0 + ss) * 1024 + head_ * 64 + pc8);
            ph[i] = *(const u32x4*)((const bf16_t*)(p.ws() + WS_HIN) + (((size_t)b * 16 + c) * 8 + head_) * 8192 + (size_t)it * 8); }
    };
    hload(0);
    for (int hl = 0; hl < 4; ++hl) {
        const int head = g * 4 + hl;
        __syncthreads();
#pragma unroll
        for (int i = 0; i < 2; ++i) { const int it = tid + i * NTHR, ss = it >> 3, pc8 = (it & 7) * 8;
            *(u32x4*)(Xn + ss * XST1 + pc8) = px[i];
            *(u32x4*)(Hs + (it >> 4) * SST + (it & 15) * 8) = ph[i]; }
        __syncthreads();
        if (hl + 1 < 4) hload(hl + 1);
        u32x2 zpre[4];
#pragma unroll
        for (int pt = 0; pt < 4; ++pt) zpre[pt] = *(const u32x2*)(proj + tok * NPROJ + C_Z + head * 64 + pt * 16 + g4 * 4);
        const float al = acs[hl * 128 + lrow];
#pragma unroll
        for (int st = 0; st < 8; ++st) {
            float mv[4];
            const float4 a4 = *(const float4*)(acs + hl * 128 + st * 16 + g4 * 4), d4 = *(const float4*)(dts + hl * 128 + st * 16 + g4 * 4);
            const float av[4] = {a4.x, a4.y, a4.z, a4.w}, dv[4] = {d4.x, d4.y, d4.z, d4.w};
#pragma unroll
            for (int j = 0; j < 4; ++j) { const int sidx = st * 16 + g4 * 4 + j;
                mv[j] = (sidx <= lrow) ? cb[st][j] * __expf(al - av[j]) * dv[j] : 0.f; }
            u32x2 w; w.x = cvt_pk(mv[0], mv[1]); w.y = cvt_pk(mv[2], mv[3]);
            *(u32x2*)(Mw + r16 * SST + st * 16 + g4 * 4) = w;
        }
        __builtin_amdgcn_wave_barrier();
        asm volatile("s_waitcnt lgkmcnt(0)" ::: "memory");
        f32x4 yd[4], yo[4];
#pragma unroll
        for (int pt = 0; pt < 4; ++pt) { yd[pt] = (f32x4){0.f, 0.f, 0.f, 0.f}; yo[pt] = (f32x4){0.f, 0.f, 0.f, 0.f}; }
#pragma unroll
        for (int kk = 0; kk < 4; ++kk) {
            const bf16x8 mf = *(const bf16x8*)(Mw + r16 * SST + kk * 32 + g4 * 8);
            const bf16_t* xa = Xn + (kk * 32 + 8 * g4 + (r16 >> 2)) * XST1 + 4 * (r16 & 3);
#pragma unroll
            for (int pt = 0; pt < 4; ++pt) {
                const s16x4 lo = tr_read(xa + pt * 16), hi = tr_read(xa + 4 * XST1 + pt * 16);
                bf16x8 xf; xf[0] = lo[0]; xf[1] = lo[1]; xf[2] = lo[2]; xf[3] = lo[3]; xf[4] = hi[0]; xf[5] = hi[1]; xf[6] = hi[2]; xf[7] = hi[3];
                yd[pt] = MFMA16(xf, mf, yd[pt]);
                const bf16x8 hf = *(const bf16x8*)(Hs + (pt * 16 + r16) * SST + kk * 32 + g4 * 8);
                yo[pt] = MFMA16(hf, cfr[kk], yo[pt]);
            }
        }
        __builtin_amdgcn_wave_barrier();
        const float el = __expf(al), Dh = p.in(13)[l * 8 + head];
#pragma unroll
        for (int pt = 0; pt < 4; ++pt) {
            const int pc = pt * 16 + g4 * 4;
            const u32x2 zw = zpre[pt];
            const u32x2 xw = *(const u32x2*)(Xn + lrow * XST1 + pc);
            const float zz[4] = {bflo(zw.x), bfhi(zw.x), bflo(zw.y), bfhi(zw.y)};
            const float xx[4] = {bflo(xw.x), bfhi(xw.x), bflo(xw.y), bfhi(xw.y)};
            float gv[4];
#pragma unroll
            for (int j = 0; j < 4; ++j) { const float yv = yd[pt][j] + el * yo[pt][j] + Dh * xx[j]; gv[j] = yv * silu_f(zz[j]); ssq += gv[j] * gv[j]; }
            u32x2 w; w.x = cvt_pk(gv[0], gv[1]); w.y = cvt_pk(gv[2], gv[3]);
            *(u32x2*)(mix + tok * DM + 512 + head * 64 + pc) = w;
        }
    }
    ssq += __shfl_xor(ssq, 16); ssq += __shfl_xor(ssq, 32);
    if (g4 == 0) ((float*)(p.ws() + WS_SSQ))[tok * 2 + g] = ssq;
}
constexpr int N_FOX = 512, N_S1 = 256, N_DIL = 1536;
DEVI void phase_mix1(const DP& p, int l, char* lds) {
    unsigned char* ws = p.ws();
    kv_gemm(p, lds);
    const bf16_t* proj = (const bf16_t*)(ws + WS_PROJ);
    bf16_t* mix = (bf16_t*)(ws + WS_MIX);
    const int G = gridDim.x, bid = BIDX();
    for (int u = bid; u < N_S1; u += G) { const int g = u & 1, c = (u >> 1) & 15, b = u >> 5; ssd_states_task(p, l, b, c, g, lds); }
    const int nfw = G / 2;
    if (bid < nfw) {
        for (int t = bid; t < 128; t += nfw) {
            const int bh = t & 31, k = t >> 5, b = bh >> 2, h = bh & 3;
            const float* cum = (const float*)(ws + WS_CUMF) + (size_t)bh * S;
#pragma unroll 1
            for (int half = 0; half < 2; ++half) {
                const int qb = half == 0 ? 7 - k : k;
                attn_task<64, 0, 2>(proj + C_FQ + h * 64, NPROJ, b * S, 1, proj + C_FK + h * 64, proj + C_FV + h * 64, NPROJ, b * S, 1,
                                    qb * 256, 0, 4 * qb + 4, 0.125f, cum, nullptr, mix + h * 64, DM, nullptr, nullptr, nullptr, lds);
            }
        }
    } else {
        const int ndw = G - nfw;
        for (int u = bid - nfw; u < 1024; u += ndw) {
            const int bh = u & 31, v = u >> 5, b = bh >> 2, h = bh & 3;
            if (v < 16) {
                const int br = v >> 3, dil = br ? 4 : 1, r = br ? ((v - 8) & 3) : 0, pb = br ? ((v - 8) >> 2) : v;
                float* Of = (float*)(ws + WS_DILO) + (size_t)br * T * 256 + h * 64;
                float* Om = (float*)(ws + WS_DILM) + (size_t)br * T * 4 + h;
                float* Ol = (float*)(ws + WS_DILL) + (size_t)br * T * 4 + h;
                const int klo = pb > 0 ? 4 * pb - 2 : 0;
                attn_task<64, 1, 2>(proj + C_DQ + h * 64, NPROJ, b * S + r, dil, proj + C_DK + h * 64, proj + C_DV + h * 64, NPROJ, b * S + r, dil,
                                    pb * 256, klo, 4 * pb + 4, 0.125f, nullptr, nullptr, nullptr, 0, Of, Om, Ol, lds);
            } else {
                const int r = v - 16;
                float* Of = (float*)(ws + WS_DILO) + (size_t)2 * T * 256 + h * 64;
                float* Om = (float*)(ws + WS_DILM) + (size_t)2 * T * 4 + h;
                float* Ol = (float*)(ws + WS_DILL) + (size_t)2 * T * 4 + h;
                attn_task<64, 1, 1>(proj + C_DQ + h * 64, NPROJ, b * S + r, 16, proj + C_DK + h * 64, proj + C_DV + h * 64, NPROJ, b * S + r, 16,
                                    0, 0, 2, 0.125f, nullptr, nullptr, nullptr, 0, Of, Om, Ol, lds);
            }
        }
    }
}
DEVI void phase_mix3(const DP& p, int l, char* lds) {
    unsigned char* ws = p.ws();
    for (int t = BIDX(); t < NB * 16 * 2; t += gridDim.x) ssd_out_task(p, l, t >> 5, (t >> 1) & 15, t & 1, lds);
    const int tid = TIDX(), wid = tid >> 6, lane = tid & 63, head = lane >> 4, d4 = (lane & 15) * 4;
    const float* Of = (const float*)(ws + WS_DILO);
    const float* Om = (const float*)(ws + WS_DILM);
    const float* Ol = (const float*)(ws + WS_DILL);
    bf16_t* mix = (bf16_t*)(ws + WS_MIX);
    for (int row = BIDX() * 8 + wid; row < T; row += gridDim.x * 8) {
        float m[3], lsum[3];
#pragma unroll
        for (int br = 0; br < 3; ++br) { m[br] = Om[((size_t)br * T + row) * 4 + head]; lsum[br] = Ol[((size_t)br * T + row) * 4 + head]; }
        const float M = fmaxf(m[0], fmaxf(m[1], m[2]));
        f32x4 num = (f32x4){0.f, 0.f, 0.f, 0.f}; float den = 0.f;
#pragma unroll
        for (int br = 0; br < 3; ++br) {
            const float w = __builtin_amdgcn_exp2f(m[br] - M);
            const f32x4 o = *(const f32x4*)(Of + ((size_t)br * T + row) * 256 + head * 64 + d4);
            num += o * w; den += w * lsum[br];
        }
        const float inv = 1.0f / den;
        u32x2 w; w.x = cvt_pk(num[0] * inv, num[1] * inv); w.y = cvt_pk(num[2] * inv, num[3] * inv);
        *(u32x2*)(mix + (size_t)row * DM + 256 + head * 64 + d4) = w;
    }
}
DEVI void phase_xattn(const DP& p, int l, char* lds) {
    unsigned char* ws = p.ws();
    const bf16_t* qbuf = (const bf16_t*)(ws + WS_QBUF);
    const bf16_t* kv = (const bf16_t*)(ws + WS_KV);
    bf16_t* obuf = (bf16_t*)(ws + WS_OBUF);
    for (int t = BIDX(); t < NB * 4 * 16; t += gridDim.x) {
        const int qb = t & 15, h = (t >> 4) & 3, b = t >> 6;
        attn_task<256, 2, 1>(qbuf + h * 256, DM, b * S, 1, kv + h * 256, kv + DM + h * 256, 2 * DM, b * MEMLEN, 1,
                          qb * 128, 0, 4, 0.0625f, nullptr, p.in(20) + l * 256, obuf + h * 256, DM, nullptr, nullptr, nullptr, lds);
    }
}
namespace g8 {
template <bool GATHER_> struct MoeSched {
    static constexpr bool GATHER = GATHER_;
    const int* cnt; const int* list; const char* Abase; const char* Bbase; size_t bstride; int K, G;
    int ei, ubase, u, step, x, nxcd;
    DEVI void init(const int* cnt_, const int* list_, const void* A_, const void* B_, size_t bstride_, int K_, int G_, int c_) {
        cnt = cnt_; list = list_; Abase = (const char*)A_; Bbase = (const char*)B_; bstride = bstride_; K = K_; G = G_;
        nxcd = (G_ % 8 == 0) ? 8 : 1; x = c_ % nxcd; step = G_ / nxcd; u = c_ / nxcd; ei = 0; ubase = 0; }
    DEVI bool next(UnitU& o) {
        while (x + nxcd * ei < NEXP) {
            const int e = x + nxcd * ei;
            const int ce = cnt[e], nte = (ce + BM - 1) / BM, nun = nte * 4;
            if (u < ubase + nun) {
                const int lu = u - ubase, pm = lu >> 2, pn = lu & 3;
                int tbase = 0;
                for (int e2 = 0; e2 < e; ++e2) tbase += (cnt[e2] + BM - 1) / BM;
                o.i0 = tbase + pm; o.i1 = pn; o.i2 = e * (2 * T) + pm * BM; o.i3 = ce - pm * BM; o.flags = 3;
                o.A = GATHER ? Abase : Abase + (size_t)(tbase + pm) * BM * K * 2;
                o.B = Bbase + (size_t)e * bstride + (size_t)pn * BM * K * 2;
                u += step; return true;
            }
            ubase += nun; ++ei;
        }
        return false;
    }
    DEVI void lane_va(const UnitU& o, int R0, int C0, int R1, int C1, unsigned& v00, unsigned& v01, unsigned& v10, unsigned& v11) const {
        if (GATHER) {
            const int nv = o.i3; const int* ent = list + o.i2;
            const int t00 = (ent[R0 < nv ? R0 : 0] & 0xffff) >> 1, t01 = (ent[R1 < nv ? R1 : 0] & 0xffff) >> 1, t10 = (ent[R0 + HALF < nv ? R0 + HALF : 0] & 0xffff) >> 1, t11 = (ent[R1 + HALF < nv ? R1 + HALF : 0] & 0xffff) >> 1;
            v00 = (unsigned)(t00 * K + C0) * 2u; v01 = (unsigned)(t01 * K + C1) * 2u; v10 = (unsigned)(t10 * K + C0) * 2u; v11 = (unsigned)(t11 * K + C1) * 2u;
        } else {
            v00 = (unsigned)(R0 * K + C0) * 2u; v01 = (unsigned)(R1 * K + C1) * 2u; v10 = v00 + (unsigned)(HALF * K * 2); v11 = v01 + (unsigned)(HALF * K * 2);
        }
    }
};
struct EpiSwiglu { static constexpr bool PERM = false; bf16_t* act;
    DEVI void mid(f32x4 (&)[2][2][4][2], const UnitU&, int, int, int, int) const {}
    DEVI void operator()(const f32x4 (&acc)[2][2][4][2], const UnitU& u, int wr, int wc, int fr, int fq) const {
        const int nv = u.i3;
#pragma unroll
        for (int ai = 0; ai < 2; ++ai)
#pragma unroll
            for (int m = 0; m < 4; ++m) {
                const int r = ai * HALF + wr * 64 + m * 16 + fr;
                if (r < nv) {
                    bf16_t* rowp = act + (size_t)(u.i0 * BM + r) * EFF + u.i1 * 128 + wc * 16 + 4 * fq;
#pragma unroll
                    for (int bj = 0; bj < 2; ++bj) { const f32x4 x1 = acc[ai][bj][m][0], x3 = acc[ai][bj][m][1];
                        u32x2 w; w.x = cvt_pk(silu_f(x1[0]) * x3[0], silu_f(x1[1]) * x3[1]); w.y = cvt_pk(silu_f(x1[2]) * x3[2], silu_f(x1[3]) * x3[3]);
                        *(u32x2*)(rowp + bj * 64) = w; }
                }
            }
    } };
struct EpiMoeOut { static constexpr bool PERM = true; bf16_t* y; const int* list;
    DEVI void mid(f32x4 (&)[2][2][4][2], const UnitU&, int, int, int, int) const {}
    DEVI void operator()(const f32x4 (&acc)[2][2][4][2], const UnitU& u, int wr, int wc, int fr, int fq) const {
        const int nv = u.i3; const int* ent = list + u.i2;
        unsigned env[2][4];
#pragma unroll
        for (int ai = 0; ai < 2; ++ai)
#pragma unroll
            for (int m = 0; m < 4; ++m) { const int r = ai * HALF + wr * 64 + m * 16 + fr; env[ai][m] = (unsigned)ent[r < nv ? r : 0]; }
#pragma unroll
        for (int ai = 0; ai < 2; ++ai)
#pragma unroll
            for (int m = 0; m < 4; ++m) {
                const int r = ai * HALF + wr * 64 + m * 16 + fr;
                if (r < nv) {
                    const unsigned en = env[ai][m]; const int a = (int)(en & 0xffffu); const float gt = __uint_as_float(en & 0xffff0000u);
                    bf16_t* rowp = y + (size_t)a * DM + u.i1 * BM + wc * 32 + 8 * fq;
#pragma unroll
                    for (int bj = 0; bj < 2; ++bj) { const f32x4 v0 = acc[ai][bj][m][0] * gt, v1 = acc[ai][bj][m][1] * gt;
                        u32x4 w; w.x = cvt_pk(v0[0], v0[1]); w.y = cvt_pk(v0[2], v0[3]); w.z = cvt_pk(v1[0], v1[1]); w.w = cvt_pk(v1[2], v1[3]);
                        *(u32x4*)(rowp + bj * HALF) = w; }
                }
            }
    } };
}
template <int WHICH>
DEVI void phase_moe(const DP& p, int l, char* lds) {
    unsigned char* ws = p.ws();
    const int* cnt = (const int*)(ws + WS_CNT) + l * 64;
    const int* list = (const int*)(ws + WS_LIST);
    if (WHICH == 0) {
        g8::MoeSched<true> S;
        S.init(cnt, list, ws + WS_H3, ws + WS_W_13, (size_t)1024 * DM * 2, DM, gridDim.x, BIDX());
        g8::EpiSwiglu E{(bf16_t*)(ws + WS_ACT)};
        g8::gemm8(lds, DM, DM, S, E);
    } else {
        g8::MoeSched<false> S;
        S.init(cnt, list, ws + WS_ACT, ws + WS_W_2, (size_t)DM * EFF * 2, EFF, gridDim.x, BIDX());
        g8::EpiMoeOut E{(bf16_t*)(ws + WS_YBUF), list};
        g8::gemm8(lds, EFF, EFF, S, E);
    }
}
DEVI void phase_final(const DP& p) {
    const int tid = TIDX(), wid = tid >> 6, lane = tid & 63;
    const bf16_t* ybuf = (const bf16_t*)(p.ws() + WS_YBUF);
    const bf16_t* h0 = (const bf16_t*)(p.ws() + WS_HBUF);
    float* out = p.out();
    for (int row = BIDX() * 8 + wid; row < T; row += gridDim.x * 8) {
        float x[16];
        load_row_bf16(h0 + (size_t)row * DM, x, lane);
        add_row_bf16_b(ybuf + (size_t)(2 * row) * DM, x, lane);
        add_row_bf16_b(ybuf + (size_t)(2 * row + 1) * DM, x, lane);
#pragma unroll
        for (int j = 0; j < 2; ++j) {
            *(float4*)(out + (size_t)row * DM + j * 512 + lane * 8) = make_float4(x[8 * j], x[8 * j + 1], x[8 * j + 2], x[8 * j + 3]);
            *(float4*)(out + (size_t)row * DM + j * 512 + lane * 8 + 4) = make_float4(x[8 * j + 4], x[8 * j + 5], x[8 * j + 6], x[8 * j + 7]);
        }
    }
}

#define XB_TMO      128
#define XB_XCNT(j)  (256  + 64 * (j))
#define XB_XSUB(j)  (1280 + 64 * (j))
#define XB_XGEN(j)  (2304 + 64 * (j))
#define XB_TOP      3328
#define XB_TOPGEN   3392
#define XCD_BAR_WORDS 3456
#define XB_SPIN_CAP (1u << 22)
DEVI unsigned xb_ld(unsigned* p)              { return __hip_atomic_load(p, __ATOMIC_RELAXED, __HIP_MEMORY_SCOPE_AGENT); }
DEVI unsigned xb_add(unsigned* p, unsigned v) { return __hip_atomic_fetch_add(p, v, __ATOMIC_RELAXED, __HIP_MEMORY_SCOPE_AGENT); }
DEVI unsigned xb_xcc_id() { return (unsigned)__builtin_amdgcn_s_getreg((3 << 11) | 20) & 0xFu; }
#define XB_SPIN(cond, bar) do { unsigned _sp = 0; while (cond) { __builtin_amdgcn_s_sleep(1); \
    if ((++_sp & 255u) == 0u) { if (xb_ld(&(bar)[XB_TMO])) break; if (_sp > XB_SPIN_CAP) { atomicAdd(&(bar)[XB_TMO], 1u); break; } } } } while (0)
struct XcdBarrier { unsigned* bar; unsigned x; volatile LAS unsigned* st; };
DEVI XcdBarrier xcd_barrier_post(unsigned* bar, volatile LAS unsigned* st) {
    XcdBarrier b; b.bar = bar; b.x = xb_xcc_id(); b.st = st;
    if (threadIdx.x == 0) (void)xb_add(&bar[XB_XCNT(b.x)], 1u);
    return b;
}
DEVI void xcd_barrier_complete(unsigned* bar, unsigned x, unsigned& nloc, unsigned& nx) {
    const unsigned G = gridDim.x * gridDim.y * gridDim.z;
    unsigned sum, cnt, mine, sp = 0u;
    for (;;) {
        sum = 0u; cnt = 0u; mine = 0u;
#pragma unroll
        for (unsigned j = 0; j < 16; ++j) { const unsigned c = xb_ld(&bar[XB_XCNT(j)]); sum += c; cnt += (c > 0u) ? 1u : 0u; mine = (j == x) ? c : mine; }
        if (sum == G) break;
        __builtin_amdgcn_s_sleep(1);
        if ((++sp & 255u) == 0u) { if (xb_ld(&bar[XB_TMO])) break; if (sp > XB_SPIN_CAP) { atomicAdd(&bar[XB_TMO], 1u); break; } }
    }
    nloc = mine > 0u ? mine : 1u; nx = cnt > 0u ? cnt : 1u;
}
DEVI void xcd_barrier(const XcdBarrier& b) {
    asm volatile("s_waitcnt vmcnt(0)" ::: "memory");
    __syncthreads();
    if (threadIdx.x == 0) {
        unsigned* bar = b.bar;
        __builtin_amdgcn_s_waitcnt(0);
        unsigned nloc = b.st[0], nx = b.st[1];
        if (nloc == 0u) { xcd_barrier_complete(bar, b.x, nloc, nx); b.st[0] = nloc; b.st[1] = nx; }
        const unsigned old = xb_add(&bar[XB_XSUB(b.x)], 1u);
        const unsigned gen = old / nloc;
        if (old + 1u == (gen + 1u) * nloc) {
            __builtin_amdgcn_fence(__ATOMIC_RELEASE, "agent");
            asm volatile("s_waitcnt vmcnt(0)" ::: "memory");
            const unsigned og = xb_add(&bar[XB_TOP], 1u);
            const unsigned tg = og / nx;
            if (og + 1u == (tg + 1u) * nx) xb_add(&bar[XB_TOPGEN], 1u);
            else XB_SPIN(xb_ld(&bar[XB_TOPGEN]) == tg, bar);
            __builtin_amdgcn_fence(__ATOMIC_ACQUIRE, "agent");
            xb_add(&bar[XB_XGEN(b.x)], 1u);
            asm volatile("s_waitcnt vmcnt(0)" ::: "memory");
        } else {
            XB_SPIN(xb_ld(&bar[XB_XGEN(b.x)]) == gen, bar);
            __builtin_amdgcn_fence(__ATOMIC_ACQUIRE, "agent");
            asm volatile("s_waitcnt vmcnt(0)" ::: "memory");
        }
    }
    __syncthreads();
}

constexpr int N_PHASES = 27;
__global__ void __launch_bounds__(NTHR) hybrid_fwd(Params p_unused) {
    extern __shared__ __attribute__((aligned(16))) char lds_base[];
    karg_ptr kp = (karg_ptr)__builtin_amdgcn_kernarg_segment_ptr();
    int ph_lo, ph_hi, use_gs;
    { DP q{kp}; ph_lo = q.ph_lo(); ph_hi = q.ph_hi(); use_gs = q.use_gs(); }
    volatile LAS unsigned* xst = (volatile LAS unsigned*)(LAS char*)(lds_base + LDS_BYTES - 16);
    if (threadIdx.x == 0) { xst[0] = 0u; xst[1] = 0u; }
    __syncthreads();
    XcdBarrier xb; xb.bar = nullptr; xb.x = 0; xb.st = xst;
    if (use_gs == 1) { DP q{kp}; xb = xcd_barrier_post((unsigned*)(q.ws() + WS_BAR), xst); }
#define RUN_PHASE(PH, ...) \
    if (ph_lo <= (PH) && (PH) < ph_hi) { \
        if ((PH) > ph_lo) { if (use_gs == 1) xcd_barrier(xb); else if (use_gs == 2) cg::this_grid().sync(); } \
        asm volatile("" : "+s"(kp) :: "memory"); \
        const DP p{kp}; \
        unsigned lds_off = 0; asm volatile("" : "+s"(lds_off)); \
        char* lds = lds_base + lds_off; \
        unsigned char* ws = p.ws(); (void)ws; (void)lds; \
        __VA_ARGS__ \
    }
#define LAYER_PHASES(L, B0) \
    RUN_PHASE((B0) + 0, { if ((L) == 0) prep_small(p); prep_all(p, (L), lds); __syncthreads(); phase_norm1(p, (L), lds); }) \
    RUN_PHASE((B0) + 1, { phase_inproj(p, (L), lds); }) \
    RUN_PHASE((B0) + 2, { for (int t = (int)gridDim.x - 1 - BIDX(); t < 32; t += gridDim.x) cumsum_task(p, t, lds); phase_post(p, (L)); }) \
    RUN_PHASE((B0) + 3, { phase_mix1(p, (L), lds); }) \
    RUN_PHASE((B0) + 4, { phase_ssd_scan(p); phase_knorm(p, (L)); }) \
    RUN_PHASE((B0) + 5, { phase_mix3(p, (L), lds); }) \
    RUN_PHASE((B0) + 6, { g8::DenseSched2 S; S.init((const bf16_t*)(ws + WS_MIX), (const bf16_t*)(ws + WS_W_OUT), T, DM, DM, gridDim.x, BIDX()); \
                          g8::EpiResScale E{{(const bf16_t*)(ws + WS_HBUF), (bf16_t*)(ws + WS_H1), DM}, (const float*)(ws + WS_SSQ)}; g8::gemm8(lds, DM, DM / 2, S, E); }) \
    RUN_PHASE((B0) + 7, { g8::DenseSched S; S.init((const bf16_t*)(ws + WS_H1), (const bf16_t*)(ws + WS_W_Q), T, DM, DM, gridDim.x, BIDX()); \
                          g8::EpiBf16 E{(bf16_t*)(ws + WS_QBUF), DM}; g8::gemm8(lds, DM, DM, S, E); }) \
    RUN_PHASE((B0) + 8, { phase_xattn(p, (L), lds); }) \
    RUN_PHASE((B0) + 9, { g8::DenseSched S; S.init((const bf16_t*)(ws + WS_OBUF), (const bf16_t*)(ws + WS_W_O), T, DM, DM, gridDim.x, BIDX()); \
                          g8::EpiResBf E{(const bf16_t*)(ws + WS_H1), (bf16_t*)(ws + WS_HBUF), DM}; g8::gemm8(lds, DM, DM, S, E); }) \
    RUN_PHASE((B0) + 10, { phase_norm3(p, (L), lds); }) \
    RUN_PHASE((B0) + 11, { phase_moe<0>(p, (L), lds); }) \
    RUN_PHASE((B0) + 12, { phase_moe<1>(p, (L), lds); })

    LAYER_PHASES(0, 0)
    LAYER_PHASES(1, 13)
    RUN_PHASE(26, { phase_final(p); })
#undef LAYER_PHASES
#undef RUN_PHASE
}

extern "C" void kernel_launch(void* const* d_in, const int* in_sizes, int n_in, void* d_out, int out_size, void* d_ws, size_t ws_size, hipStream_t stream) {
    static int grid = 0;
    if (grid == 0) {
        if (n_in != 31 || out_size != T * DM || ws_size < WS_END) { fprintf(stderr, "kernel_launch: unexpected shapes (n_in %d out %d ws %zu need %zu)\n", n_in, out_size, ws_size, (size_t)WS_END); grid = -1; return; }
        int dev = 0, cus = 0, per_cu = 0;
        hipGetDevice(&dev);
        hipDeviceGetAttribute(&cus, hipDeviceAttributeMultiprocessorCount, dev);
        hipFuncSetAttribute((const void*)hybrid_fwd, hipFuncAttributeMaxDynamicSharedMemorySize, LDS_BYTES);
        hipOccupancyMaxActiveBlocksPerMultiprocessor(&per_cu, (const void*)hybrid_fwd, NTHR, LDS_BYTES);
        if (per_cu < 1) { fprintf(stderr, "kernel_launch: occupancy query says %d blocks per CU\n", per_cu); per_cu = 1; }
        (void)hipGetLastError();
        grid = cus;
    }
    if (grid < 0) return;
    Params p{};
    for (int i = 0; i < 31; ++i) p.in[i] = (const float*)d_in[i];
    p.out = (float*)d_out; p.ws = (unsigned char*)d_ws;
    p.use_grid_sync = 1; p.pad = 0;
    p.ph_lo = 0; p.ph_hi = N_PHASES;
    if (hipMemsetAsync((unsigned char*)d_ws + WS_BAR, 0, XCD_BAR_WORDS * 4, stream) != hipSuccess) { fprintf(stderr, "kernel_launch: memset failed\n"); return; }
    void* args[] = {&p};
    hipError_t e = hipLaunchCooperativeKernel((const void*)hybrid_fwd, dim3(grid), dim3(NTHR), args, LDS_BYTES, stream);
    if (e != hipSuccess) fprintf(stderr, "kernel_launch: cooperative launch failed: %s (grid %d)\n", hipGetErrorString(e), grid);
}
```

```cpp
#include <hip/hip_runtime.h>
#include <hip/hip_cooperative_groups.h>
#include <cstdio>
#include <cstdint>
namespace cg = cooperative_groups;

typedef unsigned short bf16_t;
typedef short bf16x8 __attribute__((ext_vector_type(8)));
typedef short s16x4 __attribute__((ext_vector_type(4)));
typedef float f32x4 __attribute__((ext_vector_type(4)));
typedef unsigned u32x4 __attribute__((ext_vector_type(4)));
typedef unsigned u32x2 __attribute__((ext_vector_type(2)));
#define DEVI __device__ __forceinline__
#define LAS __attribute__((address_space(3)))

constexpr int NB = 8, S = 2048, DM = 1024, T = NB * S, DEPTH = 2;
constexpr int INP = 3084, NPROJ = 3072;
constexpr int C_FQ = 0, C_FK = 256, C_FV = 512, C_DQ = 768, C_DK = 1024, C_DV = 1280, C_Z = 1536, C_XBC = 2048;
constexpr int MEMLEN = 256, MROWS = NB * MEMLEN;
constexpr int NEXP = 32, EFF = 512;
constexpr float EPS = 1e-6f;
constexpr int NTHR = 512;
constexpr int LDS_BYTES = 151552;

constexpr size_t al256(size_t x) { return (x + 255) & ~(size_t)255; }
constexpr size_t WS_W_IN = 0;
constexpr size_t WS_W_OUT = WS_W_IN + (size_t)NPROJ * DM * 2;
constexpr size_t WS_W_Q = WS_W_OUT + (size_t)DM * DM * 2;
constexpr size_t WS_W_KV = WS_W_Q + (size_t)DM * DM * 2;
constexpr size_t WS_W_O = WS_W_KV + (size_t)2 * DM * DM * 2;
constexpr size_t WS_W_13 = WS_W_O + (size_t)DM * DM * 2;
constexpr size_t WS_W_2 = WS_W_13 + (size_t)NEXP * 1024 * DM * 2;
constexpr size_t WS_WSMALL = WS_W_2 + (size_t)NEXP * DM * EFF * 2;
constexpr size_t WS_WROUT = WS_WSMALL + (size_t)DEPTH * 12 * DM * 4;
constexpr size_t WS_XB = WS_WROUT + (size_t)DEPTH * 36 * DM * 4;
constexpr size_t WS_H1 = WS_XB;
constexpr size_t WS_H3 = WS_XB + (size_t)T * DM * 2;
constexpr size_t WS_HBUF = WS_XB + (size_t)T * DM * 4;
constexpr size_t WS_PROJ = WS_HBUF + (size_t)T * DM * 2;
constexpr size_t WS_QBUF = WS_PROJ;
constexpr size_t WS_OBUF = WS_PROJ + (size_t)T * DM * 2;
constexpr size_t WS_ACT = WS_PROJ;
constexpr size_t WS_MIX = WS_PROJ + (size_t)T * NPROJ * 2;
constexpr size_t WS_U = WS_MIX + (size_t)T * DM * 2;
constexpr size_t WS_YBUF = WS_U;
constexpr size_t WS_DILO = WS_U;
constexpr size_t WS_DILM = WS_DILO + (size_t)3 * T * 256 * 4;
constexpr size_t WS_DILL = WS_DILM + (size_t)3 * T * 4 * 4;
constexpr size_t WS_SSTATE = WS_DILL + (size_t)3 * T * 4 * 4;
constexpr size_t WS_HIN = WS_SSTATE + (size_t)NB * 16 * 8 * 8192 * 4;
constexpr size_t WS_GBUF = WS_HIN + (size_t)NB * 16 * 8 * 8192 * 2;
constexpr size_t WS_U_END = WS_GBUF + (size_t)T * 512 * 4;
constexpr size_t WS_MEMN = WS_U_END;
constexpr size_t WS_KV = WS_MEMN + (size_t)MROWS * DM * 2;
constexpr size_t WS_LOGF = WS_KV + (size_t)MROWS * 2 * DM * 2;
constexpr size_t WS_CUMF = WS_LOGF + (size_t)T * 4 * 4;
constexpr size_t WS_DTV = WS_CUMF + (size_t)T * 4 * 4;
constexpr size_t WS_DECAY = WS_DTV + (size_t)T * 8 * 4;
constexpr size_t WS_CNT = WS_DECAY + (size_t)NB * 16 * 8 * 4;
constexpr size_t WS_LIST = WS_CNT + 1024;
constexpr size_t WS_GATE = WS_LIST + (size_t)NEXP * 2 * T * 4;
constexpr size_t WS_BAR = WS_GATE + (size_t)2 * T * 4;
constexpr size_t WS_XC = WS_BAR + 65536;
constexpr size_t WS_SSQ = WS_XC + (size_t)T * 1024 * 2;
constexpr size_t WS_RSTD1 = WS_SSQ + (size_t)T * 2 * 4;
constexpr size_t WS_RSTD3 = WS_RSTD1 + (size_t)T * 4;
constexpr size_t WS_END = WS_RSTD3 + (size_t)T * 4;
static_assert(WS_YBUF + (size_t)2 * T * DM * 2 <= WS_U_END, "ybuf alias");
static_assert(WS_OBUF + (size_t)T * DM * 2 <= WS_MIX, "obuf alias");

struct Params {
    const float* in[31];
    float* out;
    unsigned char* ws;
    int ph_lo, ph_hi;
    int use_grid_sync, pad;
};


typedef __attribute__((address_space(4))) const unsigned long long* karg_ptr;
typedef __attribute__((address_space(1))) const float* gcf_ptr;
typedef __attribute__((address_space(1))) float* gf_ptr;
typedef __attribute__((address_space(1))) unsigned char* gb_ptr;
struct DP {
    karg_ptr kp;
    DEVI const float* in(int i) const { return (const float*)(gcf_ptr)(kp[i]); }
    DEVI float* out() const { return (float*)(gf_ptr)(kp[31]); }
    DEVI unsigned char* ws() const { return (unsigned char*)(gb_ptr)(kp[32]); }
    DEVI int ph_lo() const { return (int)(unsigned)kp[33]; }
    DEVI int ph_hi() const { return (int)(unsigned)(kp[33] >> 32); }
    DEVI int use_gs() const { return (int)(unsigned)kp[34]; }
};

DEVI int TIDX() { int t = threadIdx.x; asm volatile("" : "+v"(t)); return t; }
DEVI int BIDX() { int b = blockIdx.x; asm volatile("" : "+s"(b)); return b; }
DEVI float bf2f(bf16_t v) { return __uint_as_float(((unsigned)v) << 16); }
typedef float f32x2 __attribute__((ext_vector_type(2)));
typedef __bf16 bf16x2_t __attribute__((ext_vector_type(2)));
DEVI unsigned cvt_pk(float lo, float hi) { f32x2 v = {lo, hi}; bf16x2_t b = __builtin_convertvector(v, bf16x2_t); return __builtin_bit_cast(unsigned, b); }
DEVI bf16_t f2bf(float f) { return (bf16_t)(cvt_pk(f, 0.f) & 0xffffu); }
DEVI float bflo(unsigned w) { return __uint_as_float(w << 16); }
DEVI float bfhi(unsigned w) { return __uint_as_float(w & 0xffff0000u); }
DEVI float wave_sum(float v) {
#pragma unroll
    for (int m = 32; m >= 1; m >>= 1) v += __shfl_xor(v, m);
    return v;
}
template <int CTRL> DEVI float dpp_mov(float v) { return __uint_as_float(__builtin_amdgcn_update_dpp(0u, __float_as_uint(v), CTRL, 0xf, 0xf, false)); }
DEVI float wave_sum_fast(float v) {
    v += dpp_mov<0xB1>(v);
    v += dpp_mov<0x4E>(v);
    v += dpp_mov<0x124>(v);
    v += dpp_mov<0x128>(v);
    const int iv = __float_as_int(v);
    return (__int_as_float(__builtin_amdgcn_readlane(iv, 0)) + __int_as_float(__builtin_amdgcn_readlane(iv, 16))) + (__int_as_float(__builtin_amdgcn_readlane(iv, 32)) + __int_as_float(__builtin_amdgcn_readlane(iv, 48)));
}
DEVI float silu_f(float x) { return x * __builtin_amdgcn_rcpf(1.f + __expf(-x)); }
DEVI float softplus_f(float x) { return x > 20.f ? x : log1pf(__expf(x)); }
DEVI float logsigmoid_f(float x) { return x >= 0.f ? -log1pf(__expf(-x)) : x - log1pf(__expf(x)); }
#define MFMA16(a, b, c) __builtin_amdgcn_mfma_f32_16x16x32_bf16(a, b, c, 0, 0, 0)
DEVI s16x4 tr_read(const bf16_t* p) {
    return __builtin_bit_cast(s16x4, __builtin_amdgcn_ds_read_tr16_b64_v4i16((LAS s16x4*)p));
}

DEVI int maprow(int mode, int n) { return mode == 0 ? n : ((n >> 4) * 32 + (n & 15) + (mode == 2 ? 16 : 0)); }
struct PrepD { const float* src; int ld, k0, c0; bf16_t* dst; int dstld, mode, n0; const float* ks; int ksf; };
DEVI void prep_ld(const PrepD& d, float4 (&v)[2], float (&sc)[2], int tid) {
#pragma unroll
    for (int i = 0; i < 2; ++i) {
        const int k = (tid >> 4) + 32 * i, n4 = (tid & 15) * 4;
        v[i] = *(const float4*)(d.src + (size_t)(d.k0 + k) * d.ld + d.c0 + n4);
        sc[i] = (d.ks != nullptr && (d.k0 + k) >= d.ksf) ? d.ks[d.k0 + k - d.ksf] : 1.f;
    }
}
DEVI void prep_tl(const float4 (&v)[2], const float (&sc)[2], float* tl, int tid) {
#pragma unroll
    for (int i = 0; i < 2; ++i) {
        const int k = (tid >> 4) + 32 * i, n4 = (tid & 15) * 4;
        tl[k * 65 + n4 + 0] = v[i].x * sc[i]; tl[k * 65 + n4 + 1] = v[i].y * sc[i]; tl[k * 65 + n4 + 2] = v[i].z * sc[i]; tl[k * 65 + n4 + 3] = v[i].w * sc[i];
    }
}
DEVI void prep_st(const PrepD& d, const float* tl, int tid) {
    const int n = tid >> 3, kc = (tid & 7) * 8;
    u32x4 w;
    w.x = cvt_pk(tl[(kc + 0) * 65 + n], tl[(kc + 1) * 65 + n]);
    w.y = cvt_pk(tl[(kc + 2) * 65 + n], tl[(kc + 3) * 65 + n]);
    w.z = cvt_pk(tl[(kc + 4) * 65 + n], tl[(kc + 5) * 65 + n]);
    w.w = cvt_pk(tl[(kc + 6) * 65 + n], tl[(kc + 7) * 65 + n]);
    const int drow = maprow(d.mode, d.n0 + n);
    *(u32x4*)(d.dst + (size_t)drow * d.dstld + d.k0 + kc) = w;
}

constexpr int PREP_UNITS = 2048 + 3 * 4096;
DEVI PrepD prep_decode(const DP& p, int l, int u) {
    unsigned char* ws = p.ws();
    PrepD d;
    if (u < 768) {
        const int kt = u / 48, nt = u % 48, n0 = nt * 64, c0 = n0 < 768 ? n0 : n0 + 4;
        d = PrepD{p.in(3) + (size_t)l * DM * INP, INP, kt * 64, c0, (bf16_t*)(ws + WS_W_IN), DM, 0, n0, p.in(2) + l * DM, 0};
    } else if (u < 1024) {
        const int v = u - 768, kt = v / 16, nt = v % 16;
        d = PrepD{p.in(15) + (size_t)l * DM * DM, DM, kt * 64, nt * 64, (bf16_t*)(ws + WS_W_OUT), DM, 0, nt * 64, p.in(14) + l * 512, 512};
    } else if (u < 1280) {
        const int v = u - 1024, kt = v / 16, nt = v % 16;
        d = PrepD{p.in(18) + (size_t)l * DM * DM, DM, kt * 64, nt * 64, (bf16_t*)(ws + WS_W_Q), DM, 0, nt * 64, p.in(16) + l * DM, 0};
    } else if (u < 1792) {
        const int v = u - 1280, kt = v / 32, nt = v % 32;
        d = PrepD{p.in(19) + (size_t)l * DM * 2 * DM, 2 * DM, kt * 64, nt * 64, (bf16_t*)(ws + WS_W_KV), DM, 0, nt * 64, nullptr, 0};
    } else if (u < 2048) {
        const int v = u - 1792, kt = v / 16, nt = v % 16;
        d = PrepD{p.in(22) + (size_t)l * DM * DM, DM, kt * 64, nt * 64, (bf16_t*)(ws + WS_W_O), DM, 0, nt * 64, nullptr, 0};
    } else if (u < 2048 + 8192) {
        const int v = u - 2048, which = v / 4096, w = v % 4096, e = w / 128, tI = w % 128, kt = tI / 8, nt = tI % 8;
        const float* src = (which == 0 ? p.in(28) : p.in(29)) + ((size_t)l * NEXP + e) * DM * EFF;
        d = PrepD{src, EFF, kt * 64, nt * 64, (bf16_t*)(ws + WS_W_13) + (size_t)e * 1024 * DM, DM, which == 0 ? 1 : 2, nt * 64, p.in(23) + l * DM, 0};
    } else {
        const int w = u - 2048 - 8192, e = w / 128, tI = w % 128, kt = tI / 16, nt = tI % 16;
        const float* src = p.in(30) + ((size_t)l * NEXP + e) * EFF * DM;
        d = PrepD{src, DM, kt * 64, nt * 64, (bf16_t*)(ws + WS_W_2) + (size_t)e * DM * EFF, EFF, 0, nt * 64, nullptr, 0};
    }
    return d;
}
DEVI void prep_all(const DP& p, int l, char* lds) {
    const int tid = TIDX(), G = gridDim.x;
    float* tl = (float*)lds;
    constexpr int NT = 4, TLS = 64 * 65;
    for (int u0 = BIDX(); u0 < PREP_UNITS; u0 += NT * G) {
        PrepD d[NT]; float4 v[NT][2]; float sc[NT][2];
#pragma unroll
        for (int i = 0; i < NT; ++i) { const int u = u0 + i * G; d[i] = prep_decode(p, l, u < PREP_UNITS ? u : u0); prep_ld(d[i], v[i], sc[i], tid); }
#pragma unroll
        for (int i = 0; i < NT; ++i) prep_tl(v[i], sc[i], tl + i * TLS, tid);
        __syncthreads();
#pragma unroll
        for (int i = 0; i < NT; ++i) if (u0 + i * G < PREP_UNITS) prep_st(d[i], tl + i * TLS, tid);
        __syncthreads();
    }
}
DEVI void prep_small(const DP& p) {
    float* wsm = (float*)(p.ws() + WS_WSMALL);
    float* wro = (float*)(p.ws() + WS_WROUT);
    const int gtid = BIDX() * NTHR + TIDX(), gn = gridDim.x * NTHR;
    for (int i = gtid; i < DEPTH * 12 * DM; i += gn) {
        const int l = i / (12 * DM), r = i % (12 * DM), c = r / DM, k = r % DM;
        const int col = c < 4 ? 768 + c : 3076 + (c - 4);
        wsm[i] = p.in(3)[((size_t)l * DM + k) * INP + col] * p.in(2)[l * DM + k];
    }
    for (int i = gtid; i < DEPTH * 36 * DM; i += gn) {
        const int l = i / (36 * DM), r = i % (36 * DM), c = r / DM, k = r % DM;
        wro[i] = (c < 4 ? p.in(24)[((size_t)l * DM + k) * 4 + c] : p.in(26)[((size_t)l * DM + k) * 32 + (c - 4)]) * p.in(23)[l * DM + k];
    }
    if (BIDX() == 0 && TIDX() < 128) ((int*)(p.ws() + WS_CNT))[TIDX()] = 0;
}

DEVI void store_h_bf16(bf16_t* hrow, const float (&h)[16], int lane) {
#pragma unroll
    for (int j = 0; j < 4; ++j) {
        u32x2 w; w.x = cvt_pk(h[4 * j], h[4 * j + 1]); w.y = cvt_pk(h[4 * j + 2], h[4 * j + 3]);
        *(u32x2*)(hrow + j * 256 + lane * 4) = w;
    }
}
DEVI void load_row_f32(const float* xr, float (&x)[16], int lane) {
#pragma unroll
    for (int j = 0; j < 4; ++j) { const float4 v = *(const float4*)(xr + j * 256 + lane * 4); x[4 * j] = v.x; x[4 * j + 1] = v.y; x[4 * j + 2] = v.z; x[4 * j + 3] = v.w; }
}
DEVI void add_row_bf16(const bf16_t* yr, float (&x)[16], int lane) {
#pragma unroll
    for (int j = 0; j < 4; ++j) { const u32x2 w = *(const u32x2*)(yr + j * 256 + lane * 4); x[4 * j] += bflo(w.x); x[4 * j + 1] += bfhi(w.x); x[4 * j + 2] += bflo(w.y); x[4 * j + 3] += bfhi(w.y); }
}
DEVI void store_row_f32(float* xr, const float (&x)[16], int lane) {
#pragma unroll
    for (int j = 0; j < 4; ++j) *(float4*)(xr + j * 256 + lane * 4) = make_float4(x[4 * j], x[4 * j + 1], x[4 * j + 2], x[4 * j + 3]);
}
DEVI void norm_row(const float (&x)[16], const float* g, float (&h)[16], int lane) {
    float ss = 0.f;
#pragma unroll
    for (int i = 0; i < 16; ++i) ss += x[i] * x[i];
    ss = wave_sum(ss);
    const float rstd = rsqrtf(ss * (1.0f / DM) + EPS);
#pragma unroll
    for (int j = 0; j < 4; ++j) { const float4 gv = *(const float4*)(g + j * 256 + lane * 4);
        h[4 * j] = x[4 * j] * rstd * gv.x; h[4 * j + 1] = x[4 * j + 1] * rstd * gv.y; h[4 * j + 2] = x[4 * j + 2] * rstd * gv.z; h[4 * j + 3] = x[4 * j + 3] * rstd * gv.w; }
}
DEVI float dot_lds(const float (&h)[16], const float* wrow, int lane) {
    f32x2 a0 = {0.f, 0.f}, a1 = {0.f, 0.f};
#pragma unroll
    for (int j = 0; j < 4; ++j) { const f32x4 w = *(const f32x4*)(wrow + j * 256 + lane * 4);
        a0 += (f32x2){h[4 * j], h[4 * j + 1]} * (f32x2){w[0], w[1]}; a1 += (f32x2){h[4 * j + 2], h[4 * j + 3]} * (f32x2){w[2], w[3]}; }
    a0 += a1;
    return a0[0] + a0[1];
}

DEVI void load_row_bf16(const bf16_t* xr, float (&x)[16], int lane) {
#pragma unroll
    for (int j = 0; j < 2; ++j) { const u32x4 w = *(const u32x4*)(xr + j * 512 + lane * 8);
        x[8 * j] = bflo(w.x); x[8 * j + 1] = bfhi(w.x); x[8 * j + 2] = bflo(w.y); x[8 * j + 3] = bfhi(w.y); x[8 * j + 4] = bflo(w.z); x[8 * j + 5] = bfhi(w.z); x[8 * j + 6] = bflo(w.w); x[8 * j + 7] = bfhi(w.w); }
}
DEVI void add_row_bf16_b(const bf16_t* yr, float (&x)[16], int lane) {
#pragma unroll
    for (int j = 0; j < 2; ++j) { const u32x4 w = *(const u32x4*)(yr + j * 512 + lane * 8);
        x[8 * j] += bflo(w.x); x[8 * j + 1] += bfhi(w.x); x[8 * j + 2] += bflo(w.y); x[8 * j + 3] += bfhi(w.y); x[8 * j + 4] += bflo(w.z); x[8 * j + 5] += bfhi(w.z); x[8 * j + 6] += bflo(w.w); x[8 * j + 7] += bfhi(w.w); }
}
DEVI void store_row_bf16_b(bf16_t* hr, const float (&h)[16], int lane) {
#pragma unroll
    for (int j = 0; j < 2; ++j) { u32x4 w; w.x = cvt_pk(h[8 * j], h[8 * j + 1]); w.y = cvt_pk(h[8 * j + 2], h[8 * j + 3]); w.z = cvt_pk(h[8 * j + 4], h[8 * j + 5]); w.w = cvt_pk(h[8 * j + 6], h[8 * j + 7]);
        *(u32x4*)(hr + j * 512 + lane * 8) = w; }
}
DEVI float dot_lds_b(const float (&h)[16], const float* wrow, int lane) {
    f32x2 a0 = {0.f, 0.f}, a1 = {0.f, 0.f};
#pragma unroll
    for (int j = 0; j < 2; ++j) { const f32x4 w0 = *(const f32x4*)(wrow + j * 512 + lane * 8), w1 = *(const f32x4*)(wrow + j * 512 + lane * 8 + 4);
        a0 += (f32x2){h[8 * j], h[8 * j + 1]} * (f32x2){w0[0], w0[1]}; a1 += (f32x2){h[8 * j + 2], h[8 * j + 3]} * (f32x2){w0[2], w0[3]};
        a0 += (f32x2){h[8 * j + 4], h[8 * j + 5]} * (f32x2){w1[0], w1[1]}; a1 += (f32x2){h[8 * j + 6], h[8 * j + 7]} * (f32x2){w1[2], w1[3]}; }
    a0 += a1;
    return a0[0] + a0[1];
}
#define MFMA_F32(a, b, c) __builtin_amdgcn_mfma_f32_16x16x4f32(a, b, c, 0, 0, 0)
template <int L>
DEVI void load_row_pre(const float* xin, const bf16_t* h0, const bf16_t* ybuf, int row, int lane, float (&x)[16]) {
    if (L == 0) load_row_f32(xin + (size_t)row * DM, x, lane);
    else { load_row_bf16(h0 + (size_t)row * DM, x, lane); add_row_bf16_b(ybuf + (size_t)(2 * row) * DM, x, lane); add_row_bf16_b(ybuf + (size_t)(2 * row + 1) * DM, x, lane); }
}
template <int L>
DEVI void norm1_rows(const DP& p, char* lds) {
    const int tid = TIDX(), wid = tid >> 6, lane = tid & 63;
    unsigned char* ws = p.ws();
    const float* wsl = (const float*)lds;
    const float* xin = p.in(0);
    const bf16_t* ybuf = (const bf16_t*)(ws + WS_YBUF);
    bf16_t* hbuf = (bf16_t*)(ws + WS_HBUF);
    float* logf = (float*)(ws + WS_LOGF);
    float* dtv = (float*)(ws + WS_DTV);
    float* rstd1 = (float*)(ws + WS_RSTD1);
    const int stride = gridDim.x * 8;
    int row = BIDX() * 8 + wid;
    float xn[16];
    if (row < T) load_row_pre<L>(xin, hbuf, ybuf, row, lane, xn);
    for (; row < T; row += stride) {
        float x[16];
#pragma unroll
        for (int i = 0; i < 16; ++i) x[i] = xn[i];
        if (row + stride < T) load_row_pre<L>(xin, hbuf, ybuf, row + stride, lane, xn);
        if (L == 0) store_h_bf16(hbuf + (size_t)row * DM, x, lane); else store_row_bf16_b(hbuf + (size_t)row * DM, x, lane);
        float ss = 0.f;
#pragma unroll
        for (int i = 0; i < 16; ++i) ss += x[i] * x[i];
        const float rstd = rsqrtf(wave_sum_fast(ss) * (1.0f / DM) + EPS);
        float keep = 0.f;
#pragma unroll
        for (int c = 0; c < 12; ++c) { const float v = wave_sum_fast(L == 0 ? dot_lds(x, wsl + c * DM, lane) : dot_lds_b(x, wsl + c * DM, lane)); keep = (lane == c) ? v : keep; if (c & 1) __builtin_amdgcn_sched_barrier(0); }
        keep *= rstd;
        if (lane == 0) rstd1[row] = rstd;
        {
            const float bias = lane < 4 ? p.in(4)[L * 4 + (lane & 3)] : p.in(11)[L * 8 + ((lane - 4) & 7)];
            const float xv = keep + bias;
            const float lt = __logf(1.0f + __expf(-fabsf(xv)));
            if (lane < 4) logf[(size_t)row * 4 + lane] = fminf(xv, 0.f) - lt;
            else if (lane < 12) dtv[(size_t)row * 8 + lane - 4] = fmaxf(xv, 0.f) + lt;
        }
    }
}
DEVI void phase_norm1(const DP& p, int l, char* lds) {
    const int tid = TIDX(), wid = tid >> 6, lane = tid & 63;
    unsigned char* ws = p.ws();
    float* wsl = (float*)lds;
    if (l == 0) {
        float tv[24], tg[24];
#pragma unroll
        for (int q = 0; q < 24; ++q) { const int i = tid + q * NTHR, c = i / DM, k = i % DM, col = c < 4 ? 768 + c : 3076 + (c - 4);
            tv[q] = p.in(3)[(size_t)k * INP + col]; tg[q] = p.in(2)[k]; }
#pragma unroll
        for (int q = 0; q < 24; ++q) wsl[tid + q * NTHR] = tv[q] * tg[q];
    } else {
        const float4* src = (const float4*)((const float*)(ws + WS_WSMALL) + (size_t)l * 12 * DM);
        float4 tv[6];
#pragma unroll
        for (int k = 0; k < 6; ++k) tv[k] = src[tid + k * NTHR];
#pragma unroll
        for (int k = 0; k < 6; ++k) ((float4*)wsl)[tid + k * NTHR] = tv[k];
    }
    __syncthreads();
    if (l == 0) norm1_rows<0>(p, lds); else norm1_rows<1>(p, lds);
    const float* gm = p.in(17) + l * DM;
    bf16_t* memn = (bf16_t*)(ws + WS_MEMN);
    for (int row = BIDX() * 8 + wid; row < MROWS; row += gridDim.x * 8) {
        float x[16], h[16];
        load_row_f32(p.in(1) + (size_t)row * DM, x, lane);
        norm_row(x, gm, h, lane);
        store_h_bf16(memn + (size_t)row * DM, h, lane);
    }
}
DEVI void phase_norm3(const DP& p, int l, char* lds) {
    const int tid = TIDX(), wid = tid >> 6, lane = tid & 63;
    unsigned char* ws = p.ws();
    float* wr = (float*)lds;
    int* lcnt = (int*)(lds + 36 * DM * 4);
    int* lbase = lcnt + 32;
    int* rinfo = lbase + 32;
    { const float4* src = (const float4*)((const float*)(ws + WS_WROUT) + (size_t)l * 36 * DM);
      float4 tv[18];
#pragma unroll
      for (int k = 0; k < 18; ++k) tv[k] = src[tid + k * NTHR];
#pragma unroll
      for (int k = 0; k < 18; ++k) ((float4*)wr)[tid + k * NTHR] = tv[k]; }
    if (tid < 32) lcnt[tid] = 0;
    __syncthreads();
    int* cnt = (int*)(ws + WS_CNT) + l * 64;
    int* list = (int*)(ws + WS_LIST);
    const bf16_t* xin = (const bf16_t*)(ws + WS_HBUF);
    bf16_t* h3 = (bf16_t*)(ws + WS_H3);
    const float* bg = p.in(25) + l * 4;
    const int be_i = __float_as_int(lane < 32 ? p.in(27)[l * 32 + lane] : 0.f);
    const int stride = gridDim.x * 8;
    int row = BIDX() * 8 + wid;
    float xn[16];
    if (row < T) load_row_bf16(xin + (size_t)row * DM, xn, lane);
    for (int it = 0; row < T; row += stride, ++it) {
        float x[16];
#pragma unroll
        for (int i = 0; i < 16; ++i) x[i] = xn[i];
        if (row + stride < T) load_row_bf16(xin + (size_t)(row + stride) * DM, xn, lane);
        float ss = 0.f;
#pragma unroll
        for (int i = 0; i < 16; ++i) ss += x[i] * x[i];
        const float rstd = rsqrtf(wave_sum_fast(ss) * (1.0f / DM) + EPS);
        { float hn[16];
#pragma unroll
          for (int i = 0; i < 16; ++i) hn[i] = x[i] * rstd;
          store_row_bf16_b(h3 + (size_t)row * DM, hn, lane); }
        float gl[4];
#pragma unroll
        for (int c = 0; c < 4; ++c) gl[c] = wave_sum_fast(dot_lds_b(x, wr + c * DM, lane)) * rstd + bg[c];
        int gsel = 0; float gmax = gl[0];
#pragma unroll
        for (int c = 1; c < 4; ++c) if (gl[c] > gmax) { gmax = gl[c]; gsel = c; }
        float gden = 0.f;
#pragma unroll
        for (int c = 0; c < 4; ++c) gden += __expf(gl[c] - gmax);
        const float ggate = 1.0f / gden;
        gsel = __builtin_amdgcn_readfirstlane(gsel);
        float v1 = -3.0e38f, v2 = -3.0e38f; int i1 = 0, i2 = 1;
#pragma unroll
        for (int c = 0; c < 8; ++c) {
            const float v = wave_sum_fast(dot_lds_b(x, wr + (4 + gsel * 8 + c) * DM, lane)) * rstd + __int_as_float(__builtin_amdgcn_readlane(be_i, gsel * 8 + c));
            if (v > v1) { v2 = v1; i2 = i1; v1 = v; i1 = c; } else if (v > v2) { v2 = v; i2 = c; }
            if (c & 1) __builtin_amdgcn_sched_barrier(0);
        }
        const float e2 = __expf(v2 - v1), inv = 1.0f / (1.0f + e2);
        if (lane == 0) {
            const int ea = gsel * 8 + i1, eb = gsel * 8 + i2;
            const int sa = atomicAdd(&lcnt[ea], 1), sb = atomicAdd(&lcnt[eb], 1);
            int* ri = rinfo + (it * 8 + wid) * 4;
            const unsigned gpk = cvt_pk(inv * ggate, e2 * inv * ggate);
            ri[0] = ea | (sa << 8); ri[1] = eb | (sb << 8); ri[2] = (int)(gpk << 16); ri[3] = (int)(gpk & 0xffff0000u);
        }
    }
    __syncthreads();
    if (tid < 32) lbase[tid] = atomicAdd(&cnt[tid], lcnt[tid]);
    __syncthreads();
    {
        const int nit = (T - (BIDX() * 8) + stride - 1) / stride;
        if (tid < nit * 8) {
            const int it = tid >> 3, w = tid & 7, r = BIDX() * 8 + w + it * stride;
            if (r < T) {
                const int* ri = rinfo + tid * 4;
                const int ea = ri[0] & 255, sa = ri[0] >> 8, eb = ri[1] & 255, sb = ri[1] >> 8;
                list[(size_t)ea * (2 * T) + lbase[ea] + sa] = ri[2] | (2 * r);
                list[(size_t)eb * (2 * T) + lbase[eb] + sb] = ri[3] | (2 * r + 1);
            }
        }
    }
    __syncthreads();
}

constexpr int G_BM = 256, G_BN = 128, G_BK = 64, G_ST = 72;
constexpr int G_ABUF = G_BM * G_ST, G_BBUF = G_BN * G_ST;
template <class AMap, class Epi>
DEVI void gemm_tile(const AMap& amap, const bf16_t* __restrict__ Bt, int K, const Epi& epi, char* lds) {
    const int tid = TIDX(), wid = tid >> 6, lane = tid & 63, r16 = lane & 15, g4 = lane >> 4;
    const int wr = wid >> 1, wc = wid & 1;
    bf16_t* As = (bf16_t*)lds;
    bf16_t* Bs = As + 2 * G_ABUF;
    const int srow = tid >> 3, skc = (tid & 7) * 8;
    const bf16_t* ap[4];
#pragma unroll
    for (int i = 0; i < 4; ++i) ap[i] = amap(srow + 64 * i) + skc;
    const bf16_t* bp[2];
#pragma unroll
    for (int i = 0; i < 2; ++i) bp[i] = Bt + (size_t)(srow + 64 * i) * K + skc;
    u32x4 ra[4], rb[2];
#pragma unroll
    for (int i = 0; i < 4; ++i) ra[i] = *(const u32x4*)(ap[i]);
#pragma unroll
    for (int i = 0; i < 2; ++i) rb[i] = *(const u32x4*)(bp[i]);
    f32x4 acc[4][4];
#pragma unroll
    for (int m = 0; m < 4; ++m)
#pragma unroll
        for (int n = 0; n < 4; ++n) acc[m][n] = (f32x4){0.f, 0.f, 0.f, 0.f};
    const int nt = K / G_BK;
    for (int t = 0; t < nt; ++t) {
        bf16_t* Ab = As + (t & 1) * G_ABUF;
        bf16_t* Bb = Bs + (t & 1) * G_BBUF;
#pragma unroll
        for (int i = 0; i < 4; ++i) *(u32x4*)(Ab + (srow + 64 * i) * G_ST + skc) = ra[i];
#pragma unroll
        for (int i = 0; i < 2; ++i) *(u32x4*)(Bb + (srow + 64 * i) * G_ST + skc) = rb[i];
        __syncthreads();
        if (t + 1 < nt) {
#pragma unroll
            for (int i = 0; i < 4; ++i) ra[i] = *(const u32x4*)(ap[i] + (size_t)(t + 1) * G_BK);
#pragma unroll
            for (int i = 0; i < 2; ++i) rb[i] = *(const u32x4*)(bp[i] + (size_t)(t + 1) * G_BK);
        }
#pragma unroll
        for (int kk = 0; kk < 2; ++kk) {
            bf16x8 af[4], bfr[4];
#pragma unroll
            for (int m = 0; m < 4; ++m) af[m] = *(const bf16x8*)(Ab + (wr * 64 + m * 16 + r16) * G_ST + kk * 32 + g4 * 8);
#pragma unroll
            for (int n = 0; n < 4; ++n) bfr[n] = *(const bf16x8*)(Bb + (wc * 64 + n * 16 + r16) * G_ST + kk * 32 + g4 * 8);
#pragma unroll
            for (int m = 0; m < 4; ++m)
#pragma unroll
                for (int n = 0; n < 4; ++n) acc[m][n] = MFMA16(bfr[n], af[m], acc[m][n]);
        }
    }
    epi(acc, wr * 64 + r16, wc * 64 + g4 * 4);
    __syncthreads();
}

struct AMapDense { const bf16_t* A; int K; DEVI const bf16_t* operator()(int r) const { return A + (size_t)r * K; } };
struct EpiBf16Out { bf16_t* O; int ldo;
    DEVI void operator()(const f32x4 (&acc)[4][4], int rb, int cb) const {
#pragma unroll
        for (int m = 0; m < 4; ++m)
#pragma unroll
            for (int n = 0; n < 4; ++n) { u32x2 w; w.x = cvt_pk(acc[m][n][0], acc[m][n][1]); w.y = cvt_pk(acc[m][n][2], acc[m][n][3]);
                *(u32x2*)(O + (size_t)(rb + m * 16) * ldo + cb + n * 16) = w; }
    } };
struct EpiResF32 { const float* R; float* O; int ld;
    DEVI void operator()(const f32x4 (&acc)[4][4], int rb, int cb) const {
#pragma unroll
        for (int m = 0; m < 4; ++m)
#pragma unroll
            for (int n = 0; n < 4; ++n) { const size_t off = (size_t)(rb + m * 16) * ld + cb + n * 16;
                const f32x4 r = *(const f32x4*)(R + off); *(f32x4*)(O + off) = r + acc[m][n]; }
    } };

template <class MakeEpi>
DEVI void gemm_dense_units(const bf16_t* A, const bf16_t* Bt, int M, int N, int K, const MakeEpi& mk, char* lds, int u0, int ustride) {
    const int nN = N / G_BN, nU = (M / G_BM) * nN;
    for (int u = u0; u < nU; u += ustride) {
        const int pm = u / nN, pn = u % nN;
        AMapDense am{A + (size_t)pm * G_BM * K, K};
        gemm_tile(am, Bt + (size_t)pn * G_BN * K, K, mk(pm * G_BM, pn * G_BN), lds);
    }
}


DEVI const char* uni_ptr(const char* p) {
    const unsigned long long v = (unsigned long long)p;
    const unsigned lo = __builtin_amdgcn_readfirstlane((unsigned)v), hi = __builtin_amdgcn_readfirstlane((unsigned)(v >> 32));
    return (const char*)(gb_ptr)(((unsigned long long)hi << 32) | lo);
}
namespace g8 {
constexpr int BM = 256, BK = 64, HALF = 128, HTB = HALF * BK * 2, STAGE_BYTES = 8 * HTB;
DEVI int lds_byte(int r, int c) { const int st = (r >> 4) * 2 + (c >> 5), rr = r & 15, cc = c & 31, ob = rr * 64 + cc * 2; return st * 1024 + (ob ^ (((ob >> 9) & 1) << 5)); }
DEVI void stage_rc(int b, int& R, int& C) { const int st = b / 1024, sb = b % 1024, swz = sb ^ (((sb >> 9) & 1) << 5); R = (st >> 1) * 16 + swz / 64; C = (st & 1) * 32 + (swz % 64) / 2; }
DEVI int perm32(int rho) { const int n = rho >> 4, i = rho & 15; return 8 * (i >> 2) + 4 * n + (i & 3); }
struct UnitU { const char* A; const char* B; int i0, i1, i2, i3; int flags; };

template <class Epi, class Sched>
DEVI void gemm8(char* lds_generic, int K, int klen, Sched& S, const Epi& E) {
    LAS unsigned char* lds = (LAS unsigned char*)lds_generic;
    const int tid = TIDX(), wid = __builtin_amdgcn_readfirstlane(tid >> 6), lane = tid & 63, wr = wid >> 2, wc = wid & 3, fr = lane & 15, fq = lane >> 4;
    const int nt = klen / BK;
    int R0, C0, R1, C1; stage_rc(tid * 16, R0, C0); stage_rc(tid * 16 + 8192, R1, C1);
    unsigned voffB[2];
    { const int Rb0 = Epi::PERM ? ((R0 & ~31) + perm32(R0 & 31)) : R0, Rb1 = Epi::PERM ? ((R1 & ~31) + perm32(R1 & 31)) : R1;
      voffB[0] = (unsigned)(Rb0 * K + C0) * 2u; voffB[1] = (unsigned)(Rb1 * K + C1) * 2u; }
    const size_t kstep = (size_t)(BK * 2), hstepB = (size_t)HALF * K * 2;
    const unsigned ldsw = (unsigned)wid * 1024u;
    const int aoff = lds_byte(wr * 64 + fr, fq * 8), boff = lds_byte(wc * 32 + fr, fq * 8);
#define G8_SA(b, h) (((b) * 2 + (h)) * HTB)
#define G8_SB(b, h) ((4 + (b) * 2 + (h)) * HTB)
#define G8_STG(bufoff, gbase, v0, v1) do { const char* _gb = uni_ptr((const char*)(gbase));     \
        __builtin_amdgcn_global_load_lds((const unsigned*)(_gb + (v0)), (LAS unsigned*)(lds + (bufoff) + ldsw), 16, 0, 0); \
        __builtin_amdgcn_global_load_lds((const unsigned*)(_gb + (v1)), (LAS unsigned*)(lds + (bufoff) + ldsw + 8192), 16, 0, 0); } while (0)
#define G8_LDA(dst, b, h) do { _Pragma("unroll") for (int m = 0; m < 4; ++m) _Pragma("unroll") for (int k = 0; k < 2; ++k) dst[m][k] = *(const LAS bf16x8*)(lds + G8_SA(b, h) + aoff + m * 2048 + k * 1024); } while (0)
#define G8_LDB(dst, b, h) do { _Pragma("unroll") for (int n = 0; n < 2; ++n) _Pragma("unroll") for (int k = 0; k < 2; ++k) dst[n][k] = *(const LAS bf16x8*)(lds + G8_SB(b, h) + boff + n * 2048 + k * 1024); } while (0)
#define G8_MMA(ai, bj, At, Bt) do { __builtin_amdgcn_s_setprio(1); _Pragma("unroll") for (int m = 0; m < 4; ++m) _Pragma("unroll") for (int n = 0; n < 2; ++n) _Pragma("unroll") for (int k = 0; k < 2; ++k) \
        acc[ai][bj][m][n] = __builtin_amdgcn_mfma_f32_16x16x32_bf16(Bt[n][k], At[m][k], acc[ai][bj][m][n], 0, 0, 0); __builtin_amdgcn_s_setprio(0); } while (0)
#define G8_WAIT_V(n) asm volatile("s_waitcnt vmcnt(" #n ")" ::: "memory")
#define G8_WAIT_L(n) asm volatile("s_waitcnt lgkmcnt(" #n ")" ::: "memory")
#define G8_BAR __builtin_amdgcn_s_barrier()
#define G8_SCHED __builtin_amdgcn_sched_barrier(0)
    UnitU cur, nxt;
    if (!S.next(cur)) return;
    unsigned va00, va01, va10, va11;
    S.lane_va(cur, R0, C0, R1, C1, va00, va01, va10, va11);
    f32x4 acc[2][2][4][2];
#pragma unroll
    for (int a = 0; a < 2; ++a)
#pragma unroll
        for (int b = 0; b < 2; ++b)
#pragma unroll
            for (int m = 0; m < 4; ++m)
#pragma unroll
                for (int n = 0; n < 2; ++n) acc[a][b][m][n] = (f32x4){0.f, 0.f, 0.f, 0.f};
    bf16x8 At[4][2], B0[2][2], B1[2][2];
    const char* cA = cur.A; const char* cB = cur.B;
    G8_STG(G8_SB(0, 0), cB, voffB[0], voffB[1]); G8_STG(G8_SA(0, 0), cA, va00, va01); G8_STG(G8_SB(0, 1), cB + hstepB, voffB[0], voffB[1]); G8_STG(G8_SA(0, 1), cA, va10, va11);
    if (wr == 1) G8_BAR;
    G8_WAIT_V(4); G8_BAR;
    G8_STG(G8_SB(1, 0), cB + kstep, voffB[0], voffB[1]); G8_STG(G8_SA(1, 0), cA + kstep, va00, va01); G8_STG(G8_SB(1, 1), cB + hstepB + kstep, voffB[0], voffB[1]);
    G8_WAIT_V(6); G8_BAR;
    for (;;) {
        const bool has_next = S.next(nxt);
        const char* nA = has_next ? nxt.A : cA; const char* nB = has_next ? nxt.B : cB;
        unsigned x00 = va00, x01 = va01, x10 = va10, x11 = va11;
        for (int t = 0; t < nt; t += 2) {
            const bool last = (t == nt - 2);
            const char* a1 = cA + (size_t)(t + 1) * kstep;
            const char* a2 = last ? nA : cA + (size_t)(t + 2) * kstep; const char* b2 = last ? nB : cB + (size_t)(t + 2) * kstep;
            const char* a3 = a2 + kstep; const char* b3 = b2 + kstep;
            if (Sched::GATHER) { if (last && has_next) S.lane_va(nxt, R0, C0, R1, C1, x00, x01, x10, x11); }
            G8_LDB(B0, 0, 0); G8_SCHED; G8_LDA(At, 0, 0); G8_STG(G8_SA(1, 1), a1, va10, va11);
            G8_WAIT_L(8); G8_BAR; G8_WAIT_L(0); G8_MMA(0, 0, At, B0); G8_BAR; G8_SCHED;
            G8_LDB(B1, 0, 1); G8_STG(G8_SB(0, 0), b2, voffB[0], voffB[1]);
            G8_BAR; G8_WAIT_L(0); G8_MMA(0, 1, At, B1); G8_BAR;
            G8_LDA(At, 0, 1); G8_STG(G8_SA(0, 0), a2, x00, x01);
            G8_BAR; G8_WAIT_L(0); G8_MMA(1, 0, At, B0); G8_BAR; G8_SCHED;
            G8_STG(G8_SB(0, 1), b2 + hstepB, voffB[0], voffB[1]);
            G8_WAIT_V(6); G8_BAR; G8_MMA(1, 1, At, B1); G8_BAR;
            G8_LDB(B0, 1, 0); G8_SCHED; G8_LDA(At, 1, 0); G8_STG(G8_SA(0, 1), a2, x10, x11);
            G8_WAIT_L(8); G8_BAR; G8_WAIT_L(0); G8_MMA(0, 0, At, B0); G8_BAR; G8_SCHED;
            G8_LDB(B1, 1, 1); G8_STG(G8_SB(1, 0), b3, voffB[0], voffB[1]);
            G8_BAR; G8_WAIT_L(0); G8_MMA(0, 1, At, B1); G8_BAR;
            G8_LDA(At, 1, 1); G8_STG(G8_SA(1, 0), a3, x00, x01);
            G8_BAR; G8_WAIT_L(0); G8_MMA(1, 0, At, B0); G8_BAR; G8_SCHED;
            G8_STG(G8_SB(1, 1), b3 + hstepB, voffB[0], voffB[1]);
            G8_WAIT_V(6); G8_BAR; G8_MMA(1, 1, At, B1); G8_BAR;
        }
        if (cur.flags & 2) E(acc, cur, wr, wc, fr, fq); else E.mid(acc, cur, wr, wc, fr, fq);
        if (!has_next) break;
        if (nxt.flags & 1) {
#pragma unroll
        for (int a = 0; a < 2; ++a)
#pragma unroll
            for (int b = 0; b < 2; ++b)
#pragma unroll
                for (int m = 0; m < 4; ++m)
#pragma unroll
                    for (int n = 0; n < 2; ++n) acc[a][b][m][n] = (f32x4){0.f, 0.f, 0.f, 0.f};
        }
        cur = nxt; cA = nA; cB = nB; va00 = x00; va01 = x01; va10 = x10; va11 = x11;
    }
    G8_WAIT_V(0);
    if (wr == 0) G8_BAR;
    G8_BAR;
#undef G8_SA
#undef G8_SB
#undef G8_STG
#undef G8_LDA
#undef G8_LDB
#undef G8_MMA
#undef G8_WAIT_V
#undef G8_WAIT_L
#undef G8_BAR
#undef G8_SCHED
}

struct DenseSched {
    static constexpr bool GATHER = false;
    const char* A; const char* Bt; int K, nM, nN, nwg, G, c, i;
    DEVI void init(const bf16_t* A_, const bf16_t* Bt_, int M, int N, int K_, int G_, int c_) { A = (const char*)A_; Bt = (const char*)Bt_; K = K_; nM = M / BM; nN = N / BM; nwg = nM * nN; G = G_; c = c_; i = 0; }
    DEVI bool next(UnitU& u) {
        const long L = (long)i * G + c; if (L >= nwg) return false;
        ++i;
        int wgid = (int)L; { const int q = nwg / 8, r = nwg % 8, xcd = wgid % 8, off = wgid / 8; wgid = (xcd < r ? xcd * (q + 1) : r * (q + 1) + (xcd - r) * q) + off; }
        const int nig = 8 * nN, gid = wgid / nig, fm = gid * 8, gsz = (nM - fm) < 8 ? (nM - fm) : 8;
        const int pm = fm + ((wgid % nig) % gsz), pn = (wgid % nig) / gsz;
        u.A = A + (size_t)pm * BM * K * 2; u.B = Bt + (size_t)pn * BM * K * 2; u.i0 = pm; u.i1 = pn; u.i2 = 0; u.i3 = 0; u.flags = 3;
        return true;
    }
    DEVI void lane_va(const UnitU&, int R0, int C0, int R1, int C1, unsigned& v00, unsigned& v01, unsigned& v10, unsigned& v11) const {
        v00 = (unsigned)(R0 * K + C0) * 2u; v01 = (unsigned)(R1 * K + C1) * 2u; v10 = v00 + (unsigned)(HALF * K * 2); v11 = v01 + (unsigned)(HALF * K * 2);
    }
};
struct EpiBf16Scale { static constexpr bool PERM = true; bf16_t* O; int ldo; const float* rstd;
    DEVI void mid(f32x4 (&)[2][2][4][2], const UnitU&, int, int, int, int) const {}
    DEVI void operator()(const f32x4 (&acc)[2][2][4][2], const UnitU& u, int wr, int wc, int fr, int fq) const {
        const int row0 = u.i0 * BM + wr * 64 + fr;
        bf16_t* base = O + (size_t)row0 * ldo + u.i1 * BM + wc * 32 + 8 * fq;
        float rsv[2][4];
#pragma unroll
        for (int ai = 0; ai < 2; ++ai)
#pragma unroll
            for (int m = 0; m < 4; ++m) rsv[ai][m] = rstd[row0 + ai * HALF + m * 16];
#pragma unroll
        for (int ai = 0; ai < 2; ++ai)
#pragma unroll
            for (int m = 0; m < 4; ++m) { bf16_t* rowp = base + (size_t)(ai * HALF + m * 16) * ldo; const float rs = rsv[ai][m];
#pragma unroll
                for (int bj = 0; bj < 2; ++bj) { const f32x4 v0 = acc[ai][bj][m][0] * rs, v1 = acc[ai][bj][m][1] * rs;
                    u32x4 w; w.x = cvt_pk(v0[0], v0[1]); w.y = cvt_pk(v0[2], v0[3]); w.z = cvt_pk(v1[0], v1[1]); w.w = cvt_pk(v1[2], v1[3]);
                    *(u32x4*)(rowp + bj * HALF) = w; } }
    } };
struct EpiBf16 { static constexpr bool PERM = true; bf16_t* O; int ldo;
    DEVI void mid(f32x4 (&)[2][2][4][2], const UnitU&, int, int, int, int) const {}
    DEVI void operator()(const f32x4 (&acc)[2][2][4][2], const UnitU& u, int wr, int wc, int fr, int fq) const {
        bf16_t* base = O + (size_t)(u.i0 * BM + wr * 64 + fr) * ldo + u.i1 * BM + wc * 32 + 8 * fq;
#pragma unroll
        for (int ai = 0; ai < 2; ++ai)
#pragma unroll
            for (int m = 0; m < 4; ++m) { bf16_t* rowp = base + (size_t)(ai * HALF + m * 16) * ldo;
#pragma unroll
                for (int bj = 0; bj < 2; ++bj) { const f32x4 v0 = acc[ai][bj][m][0], v1 = acc[ai][bj][m][1];
                    u32x4 w; w.x = cvt_pk(v0[0], v0[1]); w.y = cvt_pk(v0[2], v0[3]); w.z = cvt_pk(v1[0], v1[1]); w.w = cvt_pk(v1[2], v1[3]);
                    *(u32x4*)(rowp + bj * HALF) = w; } }
    } };
struct EpiResBf { static constexpr bool PERM = true; const bf16_t* R; bf16_t* O; int ld;
    DEVI void mid(f32x4 (&)[2][2][4][2], const UnitU&, int, int, int, int) const {}
    DEVI void operator()(const f32x4 (&acc)[2][2][4][2], const UnitU& u, int wr, int wc, int fr, int fq) const {
        const size_t off0 = (size_t)(u.i0 * BM + wr * 64 + fr) * ld + u.i1 * BM + wc * 32 + 8 * fq;
#pragma unroll
        for (int ai = 0; ai < 2; ++ai) {
            u32x4 rr[4][2];
#pragma unroll
            for (int m = 0; m < 4; ++m)
#pragma unroll
                for (int bj = 0; bj < 2; ++bj) rr[m][bj] = *(const u32x4*)(R + off0 + (size_t)(ai * HALF + m * 16) * ld + bj * HALF);
#pragma unroll
            for (int m = 0; m < 4; ++m) { const size_t off = off0 + (size_t)(ai * HALF + m * 16) * ld;
#pragma unroll
                for (int bj = 0; bj < 2; ++bj) { const u32x4 r = rr[m][bj]; const f32x4 v0 = acc[ai][bj][m][0], v1 = acc[ai][bj][m][1];
                    u32x4 w; w.x = cvt_pk(bflo(r.x) + v0[0], bfhi(r.x) + v0[1]); w.y = cvt_pk(bflo(r.y) + v0[2], bfhi(r.y) + v0[3]);
                    w.z = cvt_pk(bflo(r.z) + v1[0], bfhi(r.z) + v1[1]); w.w = cvt_pk(bflo(r.w) + v1[2], bfhi(r.w) + v1[3]);
                    *(u32x4*)(O + off + bj * HALF) = w; } }
        }
    } };
struct EpiRes { static constexpr bool PERM = false; const float* R; float* O; int ld; bf16_t* H;
    DEVI void mid(f32x4 (&)[2][2][4][2], const UnitU&, int, int, int, int) const {}
    DEVI void operator()(const f32x4 (&acc)[2][2][4][2], const UnitU& u, int wr, int wc, int fr, int fq) const {
        const size_t off0 = (size_t)(u.i0 * BM + wr * 64 + fr) * ld + u.i1 * BM + wc * 32 + 4 * fq;
#pragma unroll
        for (int ai = 0; ai < 2; ++ai)
#pragma unroll
            for (int m = 0; m < 4; ++m) { const size_t off = off0 + (size_t)(ai * HALF + m * 16) * ld;
#pragma unroll
                for (int bj = 0; bj < 2; ++bj)
#pragma unroll
                    for (int n = 0; n < 2; ++n) { const f32x4 r = *(const f32x4*)(R + off + bj * HALF + n * 16); const f32x4 o = r + acc[ai][bj][m][n];
                        *(f32x4*)(O + off + bj * HALF + n * 16) = o;
                        u32x2 w; w.x = cvt_pk(o[0], o[1]); w.y = cvt_pk(o[2], o[3]); *(u32x2*)(H + off + bj * HALF + n * 16) = w; } }
    } };
struct DenseSched2 {
    static constexpr bool GATHER = false;
    DenseSched D; int sub;
    DEVI void init(const bf16_t* A_, const bf16_t* Bt_, int M, int N, int K_, int G_, int c_) { D.init(A_, Bt_, M, N, K_, G_, c_); sub = 0; }
    UnitU pend;
    DEVI bool next(UnitU& u) {
        if (sub == 0) { if (!D.next(pend)) return false; u = pend; u.A = pend.A + (size_t)(D.K / 2) * 2; u.B = pend.B + (size_t)(D.K / 2) * 2; u.flags = 1; sub = 1; return true; }
        u = pend; u.flags = 2; sub = 0; return true;
    }
    DEVI void lane_va(const UnitU& u, int R0, int C0, int R1, int C1, unsigned& v00, unsigned& v01, unsigned& v10, unsigned& v11) const { D.lane_va(u, R0, C0, R1, C1, v00, v01, v10, v11); }
};
struct EpiResScale : EpiResBf { const float* ssq;
    DEVI void mid(f32x4 (&acc)[2][2][4][2], const UnitU& u, int wr, int wc, int fr, int fq) const {
        float2 sqv[2][4];
#pragma unroll
        for (int ai = 0; ai < 2; ++ai)
#pragma unroll
            for (int m = 0; m < 4; ++m) sqv[ai][m] = *(const float2*)(ssq + (size_t)(u.i0 * BM + ai * HALF + wr * 64 + m * 16 + fr) * 2);
#pragma unroll
        for (int ai = 0; ai < 2; ++ai)
#pragma unroll
            for (int m = 0; m < 4; ++m) {
                const float2 sq = sqv[ai][m];
                const float rs = rsqrtf((sq.x + sq.y) * (1.0f / 512.0f) + EPS);
#pragma unroll
                for (int bj = 0; bj < 2; ++bj)
#pragma unroll
                    for (int n = 0; n < 2; ++n) acc[ai][bj][m][n] *= rs;
            }
    } };
}

constexpr float LOG2E_C = 1.4426950408889634f;
DEVI void cumsum_task(const DP& p, int bh, char* lds) {
    const int tid = TIDX(), wid = tid >> 6, lane = tid & 63;
    const int b = bh >> 2, h = bh & 3;
    const float* logf = (const float*)(p.ws() + WS_LOGF);
    float* cumf = (float*)(p.ws() + WS_CUMF);
    float* wtot = (float*)lds;
    float v[4];
#pragma unroll
    for (int j = 0; j < 4; ++j) v[j] = logf[((size_t)b * S + tid * 4 + j) * 4 + h];
    v[1] += v[0]; v[2] += v[1]; v[3] += v[2];
    float incl = v[3];
#pragma unroll
    for (int d = 1; d < 64; d <<= 1) { const float t = __shfl_up(incl, d); if (lane >= d) incl += t; }
    if (lane == 63) wtot[wid] = incl;
    __syncthreads();
    float woff = 0.f;
    for (int w = 0; w < wid; ++w) woff += wtot[w];
    const float base = woff + incl - v[3];
    *(float4*)(cumf + (size_t)bh * S + tid * 4) = make_float4((base + v[0]) * LOG2E_C, (base + v[1]) * LOG2E_C, (base + v[2]) * LOG2E_C, (base + v[3]) * LOG2E_C);
    __syncthreads();
}
DEVI void phase_inproj(const DP& p, int l, char* lds) {
    unsigned char* ws = p.ws();
    g8::DenseSched S; S.init((const bf16_t*)(ws + WS_HBUF), (const bf16_t*)(ws + WS_W_IN), T, NPROJ, DM, gridDim.x, BIDX());
    g8::EpiBf16Scale E{(bf16_t*)(ws + WS_PROJ), NPROJ, (const float*)(ws + WS_RSTD1)};
    g8::gemm8(lds, DM, DM, S, E);
}
DEVI void kv_gemm(const DP& p, char* lds) {
    unsigned char* ws = p.ws();
    const int c = BIDX() - ((int)gridDim.x - 64);
    if (c < 0) return;
    g8::DenseSched S; S.init((const bf16_t*)(ws + WS_MEMN), (const bf16_t*)(ws + WS_W_KV), MROWS, 2 * DM, DM, 64, c);
    g8::EpiBf16 E{(bf16_t*)(ws + WS_KV), 2 * DM};
    g8::gemm8(lds, DM, DM, S, E);
}

DEVI void conv8_pos(const DP& p, int l, const bf16_t* proj, int b, int sp, int chan0, float (&out)[8]) {
    float a[8];
    const float* cb = p.in(10) + l * 1024 + chan0;
#pragma unroll
    for (int i = 0; i < 8; ++i) a[i] = cb[i];
#pragma unroll
    for (int j = 0; j < 4; ++j) {
        const int s2 = sp - 3 + j;
        if (s2 >= 0) {
            const u32x4 w = *(const u32x4*)(proj + ((size_t)b * S + s2) * NPROJ + C_XBC + chan0);
            const float* cw = p.in(9) + ((size_t)l * 4 + j) * 1024 + chan0;
            a[0] += cw[0] * bflo(w.x); a[1] += cw[1] * bfhi(w.x); a[2] += cw[2] * bflo(w.y); a[3] += cw[3] * bfhi(w.y);
            a[4] += cw[4] * bflo(w.z); a[5] += cw[5] * bfhi(w.z); a[6] += cw[6] * bflo(w.w); a[7] += cw[7] * bfhi(w.w);
        }
    }
#pragma unroll
    for (int i = 0; i < 8; ++i) out[i] = silu_f(a[i]);
}
DEVI u32x4 pack8(const float (&v)[8]) { u32x4 w; w.x = cvt_pk(v[0], v[1]); w.y = cvt_pk(v[2], v[3]); w.z = cvt_pk(v[4], v[5]); w.w = cvt_pk(v[6], v[7]); return w; }


DEVI void phase_post(const DP& p, int l) {
    const int tid = TIDX(), wid = tid >> 6, lane = tid & 63;
    unsigned char* ws = p.ws();
    bf16_t* proj = (bf16_t*)(ws + WS_PROJ);
    const int sl = lane >> 2, qt = lane & 3, type = sl >> 2, head = sl & 3;
    const int col0 = (type < 2 ? type * 256 : 768 + (type - 2) * 256) + head * 64 + qt * 16;
    const float *gq0 = p.in(5), *gq1 = p.in(6), *gq2 = p.in(7), *gq3 = p.in(8);
    asm volatile("" : "+s"(gq0), "+s"(gq1), "+s"(gq2), "+s"(gq3));
    const float* gain = (type == 0 ? gq0 : type == 1 ? gq1 : type == 2 ? gq2 : gq3) + l * 64 + qt * 16;
    float gv[16];
#pragma unroll
    for (int i = 0; i < 16; ++i) gv[i] = gain[i];
    const float inv[8] = {1.000000000e+00f, 1.939227432e-01f, 3.760603070e-02f, 7.292664610e-03f, 1.414213562e-03f, 2.742481884e-04f, 5.318295734e-05f, 1.031338525e-05f};
    for (int row = BIDX() * 8 + wid; row < T; row += gridDim.x * 8) {
        bf16_t* ptr = proj + (size_t)row * NPROJ + col0;
        const u32x4 w0 = *(const u32x4*)ptr, w1 = *(const u32x4*)(ptr + 8);
        float v[16];
        v[0] = bflo(w0.x); v[1] = bfhi(w0.x); v[2] = bflo(w0.y); v[3] = bfhi(w0.y); v[4] = bflo(w0.z); v[5] = bfhi(w0.z); v[6] = bflo(w0.w); v[7] = bfhi(w0.w);
        v[8] = bflo(w1.x); v[9] = bfhi(w1.x); v[10] = bflo(w1.y); v[11] = bfhi(w1.y); v[12] = bflo(w1.z); v[13] = bfhi(w1.z); v[14] = bflo(w1.w); v[15] = bfhi(w1.w);
        float ss = 0.f;
#pragma unroll
        for (int i = 0; i < 16; ++i) ss += v[i] * v[i];
        ss += __shfl_xor(ss, 1); ss += __shfl_xor(ss, 2);
        const float rstd = rsqrtf(ss * (1.0f / 64.0f) + EPS);
        const float qs = (type == 0 || type == 2) ? rstd * (0.125f * 1.4426950408889634f) : rstd;
#pragma unroll
        for (int i = 0; i < 16; ++i) v[i] = v[i] * qs * gv[i];
        if (type >= 2 && qt == 0) {
            const float pos = (float)(row & (S - 1));
#pragma unroll
            for (int i = 0; i < 8; ++i) { const float rev = __builtin_amdgcn_fractf(pos * inv[i] * 0.15915494309189535f);
                const float sn = __builtin_amdgcn_sinf(rev), cs = __builtin_amdgcn_cosf(rev);
                const float a = v[i], b = v[i + 8]; v[i] = a * cs - b * sn; v[i + 8] = b * cs + a * sn; }
        }
        u32x4 o0, o1;
        o0.x = cvt_pk(v[0], v[1]); o0.y = cvt_pk(v[2], v[3]); o0.z = cvt_pk(v[4], v[5]); o0.w = cvt_pk(v[6], v[7]);
        o1.x = cvt_pk(v[8], v[9]); o1.y = cvt_pk(v[10], v[11]); o1.z = cvt_pk(v[12], v[13]); o1.w = cvt_pk(v[14], v[15]);
        *(u32x4*)ptr = o0; *(u32x4*)(ptr + 8) = o1;
    }
    bf16_t* xc = (bf16_t*)(ws + WS_XC);
    {
        const int item0 = BIDX() * NTHR + tid, istride = gridDim.x * NTHR;
        if ((istride & 127) == 0) {
            const int c8 = (item0 & 127) * 8;
            float cwv[4][8], cbv[8];
#pragma unroll
            for (int i = 0; i < 8; ++i) cbv[i] = p.in(10)[l * 1024 + c8 + i];
#pragma unroll
            for (int j = 0; j < 4; ++j)
#pragma unroll
                for (int i = 0; i < 8; ++i) cwv[j][i] = p.in(9)[((size_t)l * 4 + j) * 1024 + c8 + i];
            for (int it0 = item0; it0 < T * 128; it0 += 4 * istride) {
                u32x4 w[4][4];
#pragma unroll
                for (int q = 0; q < 4; ++q) {
                    const int item = it0 + q * istride, t = (item < T * 128 ? item : it0) >> 7, sp = t % S;
#pragma unroll
                    for (int j = 0; j < 4; ++j) { const int s2 = sp - 3 + j; w[q][j] = *(const u32x4*)(proj + ((size_t)(t - sp) + (s2 >= 0 ? s2 : sp)) * NPROJ + C_XBC + c8); }
                }
#pragma unroll
                for (int q = 0; q < 4; ++q) {
                    const int item = it0 + q * istride;
                    if (item < T * 128) {
                        const int t = item >> 7, sp = t % S;
                        float a[8];
#pragma unroll
                        for (int i = 0; i < 8; ++i) a[i] = cbv[i];
#pragma unroll
                        for (int j = 0; j < 4; ++j) {
                            if (sp - 3 + j >= 0) { const u32x4 ww = w[q][j];
                                a[0] += cwv[j][0] * bflo(ww.x); a[1] += cwv[j][1] * bfhi(ww.x); a[2] += cwv[j][2] * bflo(ww.y); a[3] += cwv[j][3] * bfhi(ww.y);
                                a[4] += cwv[j][4] * bflo(ww.z); a[5] += cwv[j][5] * bfhi(ww.z); a[6] += cwv[j][6] * bflo(ww.w); a[7] += cwv[j][7] * bfhi(ww.w); }
                        }
                        float v[8];
#pragma unroll
                        for (int i = 0; i < 8; ++i) v[i] = silu_f(a[i]);
                        *(u32x4*)(xc + (size_t)t * 1024 + c8) = pack8(v);
                    }
                }
            }
        } else {
            for (int item = item0; item < T * 128; item += istride) {
                const int t = item >> 7, c8 = (item & 127) * 8;
                float v[8]; conv8_pos(p, l, proj, t / S, t % S, c8, v);
                *(u32x4*)(xc + (size_t)t * 1024 + c8) = pack8(v);
            }
        }
    }
}
DEVI void phase_knorm(const DP& p, int l) {
    const int tid = TIDX(), wid = tid >> 6, lane = tid & 63;
    unsigned char* ws = p.ws();
    bf16_t* kv = (bf16_t*)(ws + WS_KV);
    const float* kg = p.in(21) + l * 256 + (lane & 15) * 16;
    float kgv[16];
#pragma unroll
    for (int i = 0; i < 16; ++i) kgv[i] = kg[i];
    for (int row = BIDX() * 8 + wid; row < MROWS; row += gridDim.x * 8) {
        bf16_t* ptr = kv + (size_t)row * 2 * DM + lane * 16;
        const u32x4 w0 = *(const u32x4*)ptr, w1 = *(const u32x4*)(ptr + 8);
        float v[16];
        v[0] = bflo(w0.x); v[1] = bfhi(w0.x); v[2] = bflo(w0.y); v[3] = bfhi(w0.y); v[4] = bflo(w0.z); v[5] = bfhi(w0.z); v[6] = bflo(w0.w); v[7] = bfhi(w0.w);
        v[8] = bflo(w1.x); v[9] = bfhi(w1.x); v[10] = bflo(w1.y); v[11] = bfhi(w1.y); v[12] = bflo(w1.z); v[13] = bfhi(w1.z); v[14] = bflo(w1.w); v[15] = bfhi(w1.w);
        float ss = 0.f;
#pragma unroll
        for (int i = 0; i < 16; ++i) ss += v[i] * v[i];
        ss += __shfl_xor(ss, 1); ss += __shfl_xor(ss, 2); ss += __shfl_xor(ss, 4); ss += __shfl_xor(ss, 8);
        const float rstd = rsqrtf(ss * (1.0f / 256.0f) + EPS);
#pragma unroll
        for (int i = 0; i < 16; ++i) v[i] = v[i] * rstd * kgv[i];
        u32x4 o0, o1;
        o0.x = cvt_pk(v[0], v[1]); o0.y = cvt_pk(v[2], v[3]); o0.z = cvt_pk(v[4], v[5]); o0.w = cvt_pk(v[6], v[7]);
        o1.x = cvt_pk(v[8], v[9]); o1.y = cvt_pk(v[10], v[11]); o1.z = cvt_pk(v[12], v[13]); o1.w = cvt_pk(v[14], v[15]);
        *(u32x4*)ptr = o0; *(u32x4*)(ptr + 8) = o1;
    }
}
constexpr float LOG2E = 1.4426950408889634f;
template <int DH> struct AttnLds { static constexpr int KST = DH + 8; static constexpr int TILE = 64 * KST; static constexpr int BYTES = 4 * TILE * 2; };
DEVI float xor16_max(float v) { auto r = __builtin_amdgcn_permlane16_swap(__float_as_uint(v), __float_as_uint(v), false, false); return fmaxf(__uint_as_float(r[0]), __uint_as_float(r[1])); }
DEVI float xor16_sum(float v) { auto r = __builtin_amdgcn_permlane16_swap(__float_as_uint(v), __float_as_uint(v), false, false); return __uint_as_float(r[0]) + __uint_as_float(r[1]); }
DEVI float xor32_max(float v) { auto r = __builtin_amdgcn_permlane32_swap(__float_as_uint(v), __float_as_uint(v), false, false); return fmaxf(__uint_as_float(r[0]), __uint_as_float(r[1])); }
DEVI float xor32_sum(float v) { auto r = __builtin_amdgcn_permlane32_swap(__float_as_uint(v), __float_as_uint(v), false, false); return __uint_as_float(r[0]) + __uint_as_float(r[1]); }
template <int DH, int MODE, int QR>
DEVI void attn_task(const bf16_t* __restrict__ Qb, int ldq, int qtok0, int qstep,
                    const bf16_t* __restrict__ Kb, const bf16_t* __restrict__ Vb, int ldk, int ktok0, int kstep,
                    int p0, int kt_lo, int kt_hi, float scale,
                    const float* __restrict__ cum, const float* __restrict__ qgain,
                    bf16_t* Ob, int ldo, float* Of, float* Om, float* Ol, char* lds) {
    constexpr int KST = AttnLds<DH>::KST, TILE = AttnLds<DH>::TILE, NKK = DH / 32, ND = DH / 16, NCH = (64 * DH / 8) / NTHR;
    constexpr int WR = 16 * QR;
    const int tid = TIDX(), wid = tid >> 6, lane = tid & 63, r16 = lane & 15, g4 = lane >> 4;
    bf16_t* Ks = (bf16_t*)lds;
    bf16_t* Vs = Ks + 2 * TILE;
    const float c2 = scale * LOG2E;
    bf16x8 qf[QR][NKK];
    int qpos[QR];
#pragma unroll
    for (int g = 0; g < QR; ++g) {
        qpos[g] = p0 + wid * WR + g * 16 + r16;
        const bf16_t* qp = Qb + (size_t)(qtok0 + qpos[g] * qstep) * ldq + g4 * 8;
#pragma unroll
        for (int kk = 0; kk < NKK; ++kk) qf[g][kk] = *(const bf16x8*)(qp + kk * 32);
    }
    if (MODE == 2) {
#pragma unroll
        for (int g = 0; g < QR; ++g) {
            float ss = 0.f;
#pragma unroll
            for (int kk = 0; kk < NKK; ++kk)
#pragma unroll
                for (int j = 0; j < 8; ++j) { const float v = bf2f((bf16_t)qf[g][kk][j]); ss += v * v; }
            ss += __shfl_xor(ss, 16); ss += __shfl_xor(ss, 32);
            const float rstd = rsqrtf(ss * (1.0f / DH) + EPS);
#pragma unroll
            for (int kk = 0; kk < NKK; ++kk)
#pragma unroll
                for (int j = 0; j < 8; ++j) { const float v = bf2f((bf16_t)qf[g][kk][j]) * (rstd * c2) * qgain[kk * 32 + g4 * 8 + j]; qf[g][kk][j] = (short)f2bf(v); }
        }
    }
    float m_[QR], cq[QR];
    f32x4 o[QR][ND], o1[QR];
#pragma unroll
    for (int g = 0; g < QR; ++g) {
        m_[g] = 0.f; cq[g] = (MODE == 0) ? cum[qpos[g]] : 0.f;
        o1[g] = (f32x4){0.f, 0.f, 0.f, 0.f};
#pragma unroll
        for (int n = 0; n < ND; ++n) o[g][n] = (f32x4){0.f, 0.f, 0.f, 0.f};
    }
    bf16x8 vones;
#pragma unroll
    for (int j = 0; j < 8; ++j) vones[j] = (short)(r16 == 0 ? 0x3f80 : 0);
    u32x4 rk[NCH], rv[NCH];
    f32x4 ckn[4];
#pragma unroll
    for (int n = 0; n < 4; ++n) ckn[n] = (f32x4){0.f, 0.f, 0.f, 0.f};
    auto gload = [&](int kt) {
#pragma unroll
        for (int i = 0; i < NCH; ++i) { const int c = tid + i * NTHR, key = c / (DH / 8), dc = c % (DH / 8);
            const size_t tok = (size_t)(ktok0 + (kt * 64 + key) * kstep);
            rk[i] = *(const u32x4*)(Kb + tok * ldk + dc * 8); rv[i] = *(const u32x4*)(Vb + tok * ldk + dc * 8); }
        if (MODE == 0) {
#pragma unroll
            for (int n = 0; n < 4; ++n) ckn[n] = *(const f32x4*)(cum + kt * 64 + n * 16 + g4 * 4);
        }
    };
    gload(kt_lo);
    __syncthreads();
    int buf = 0;
    for (int kt = kt_lo; kt < kt_hi; ++kt, buf ^= 1) {
        bf16_t* Kt = Ks + buf * TILE;
        bf16_t* Vt = Vs + buf * TILE;
#pragma unroll
        for (int i = 0; i < NCH; ++i) { const int c = tid + i * NTHR, key = c / (DH / 8), dc = c % (DH / 8);
            *(u32x4*)(Kt + key * KST + dc * 8) = rk[i]; *(u32x4*)(Vt + key * KST + dc * 8) = rv[i]; }
        __syncthreads();
        f32x4 ckc[4];
#pragma unroll
        for (int n = 0; n < 4; ++n) ckc[n] = ckn[n];
        if (kt + 1 < kt_hi) gload(kt + 1);
        const int qmin = p0 + wid * WR, kmin = kt * 64;
        bool skip = false, interior = true;
        if (MODE == 0) { skip = kmin > qmin + WR - 1; interior = kmin + 63 <= qmin; }
        if (MODE == 1) { skip = (qmin + WR - 1 - kmin < 0) || (qmin - (kmin + 63) > 128); interior = (qmin - (kmin + 63) >= 0) && (qmin + WR - 1 - kmin <= 128); }
        if (skip) continue;
        f32x4 s[QR][4];
        float cm[QR];
#pragma unroll
        for (int g = 0; g < QR; ++g) cm[g] = cq[g] - m_[g];
#pragma unroll
        for (int n = 0; n < 4; ++n) {
            const f32x4 ck = ckc[n];
#pragma unroll
            for (int g = 0; g < QR; ++g) s[g][n] = (f32x4){cm[g] - ck[0], cm[g] - ck[1], cm[g] - ck[2], cm[g] - ck[3]};
#pragma unroll
            for (int kk = 0; kk < NKK; ++kk) {
                const bf16x8 kf = *(const bf16x8*)(Kt + (n * 16 + r16) * KST + kk * 32 + g4 * 8);
#pragma unroll
                for (int g = 0; g < QR; ++g) s[g][n] = MFMA16(kf, qf[g][kk], s[g][n]);
            }
            if (DH > 64) __builtin_amdgcn_sched_barrier(0);
        }
        float mx[QR];
#pragma unroll
        for (int g = 0; g < QR; ++g) mx[g] = -INFINITY;
#pragma unroll
        for (int n = 0; n < 4; ++n)
#pragma unroll
            for (int g = 0; g < QR; ++g)
#pragma unroll
                for (int j = 0; j < 4; ++j) {
                    float t = s[g][n][j];
                    if (!interior) {
                        const int kpos = kt * 64 + n * 16 + g4 * 4 + j;
                        if (MODE == 0) { if (kpos > qpos[g]) t = -INFINITY; }
                        if (MODE == 1) { const int dd = qpos[g] - kpos; if (dd < 0 || dd > 128) t = -INFINITY; }
                        s[g][n][j] = t;
                    }
                    mx[g] = fmaxf(mx[g], t);
                }
        bool grow = false;
#pragma unroll
        for (int g = 0; g < QR; ++g) { mx[g] = xor32_max(xor16_max(mx[g])); grow = grow || (mx[g] > 8.0f); }
        if (__any(grow)) {
#pragma unroll
            for (int g = 0; g < QR; ++g) {
                const float delta = fmaxf(mx[g], 0.f);
                const float alpha = __builtin_amdgcn_exp2f(-delta);
                m_[g] += delta; o1[g] *= alpha;
#pragma unroll
                for (int n = 0; n < ND; ++n) o[g][n] *= alpha;
#pragma unroll
                for (int n = 0; n < 4; ++n) s[g][n] -= delta;
            }
        }
#pragma unroll
        for (int g = 0; g < QR; ++g)
#pragma unroll
            for (int n = 0; n < 4; ++n)
#pragma unroll
                for (int j = 0; j < 4; ++j) s[g][n][j] = __builtin_amdgcn_exp2f(s[g][n][j]);
#pragma unroll
        for (int kk = 0; kk < 2; ++kk) {
            bf16x8 pb[QR];
#pragma unroll
            for (int g = 0; g < QR; ++g) {
                u32x4 w; w.x = cvt_pk(s[g][2 * kk][0], s[g][2 * kk][1]); w.y = cvt_pk(s[g][2 * kk][2], s[g][2 * kk][3]); w.z = cvt_pk(s[g][2 * kk + 1][0], s[g][2 * kk + 1][1]); w.w = cvt_pk(s[g][2 * kk + 1][2], s[g][2 * kk + 1][3]);
                pb[g] = __builtin_bit_cast(bf16x8, w);
                o1[g] = MFMA16(vones, pb[g], o1[g]);
            }
            const bf16_t* vb = Vt + (kk * 32 + 4 * g4 + (r16 >> 2)) * KST + 4 * (r16 & 3);
#pragma unroll
            for (int n = 0; n < ND; ++n) {
                const s16x4 lo = tr_read(vb + n * 16), hi = tr_read(vb + 16 * KST + n * 16);
                bf16x8 vf; vf[0] = lo[0]; vf[1] = lo[1]; vf[2] = lo[2]; vf[3] = lo[3]; vf[4] = hi[0]; vf[5] = hi[1]; vf[6] = hi[2]; vf[7] = hi[3];
#pragma unroll
                for (int g = 0; g < QR; ++g) o[g][n] = MFMA16(vf, pb[g], o[g][n]);
                if (DH > 64 && (n & 3) == 3) __builtin_amdgcn_sched_barrier(0);
            }
        }
    }
#pragma unroll
    for (int g = 0; g < QR; ++g) {
        const size_t tok = (size_t)(qtok0 + qpos[g] * qstep);
        const float lsum = __shfl(o1[g][0], r16);
        if (MODE == 1) {
#pragma unroll
            for (int n = 0; n < ND; ++n) *(f32x4*)(Of + tok * 256 + n * 16 + g4 * 4) = o[g][n];
            if (g4 == 0) { Om[tok * 4] = m_[g]; Ol[tok * 4] = lsum; }
        } else {
            const float inv = 1.0f / lsum;
#pragma unroll
            for (int n = 0; n < ND; ++n) { u32x2 w; w.x = cvt_pk(o[g][n][0] * inv, o[g][n][1] * inv); w.y = cvt_pk(o[g][n][2] * inv, o[g][n][3] * inv);
                *(u32x2*)(Ob + tok * ldo + n * 16 + g4 * 4) = w; }
        }
    }
}

DEVI void ssd_acs(const DP& p, int l, int b, int c, int g, float* acs, float* dts) {
    const int tid = TIDX(), wid = tid >> 6, lane = tid & 63;
    if (wid < 4) {
        const int head = g * 4 + wid;
        const float* dtv = (const float*)(p.ws() + WS_DTV);
        const float A = -__expf(p.in(12)[l * 8 + head]);
        const size_t t0 = (size_t)b * S + c * 128 + 2 * lane;
        const float d0 = dtv[t0 * 8 + head], d1 = dtv[(t0 + 1) * 8 + head];
        const float a0 = d0 * A, a1 = d1 * A;
        float incl = a0 + a1;
#pragma unroll
        for (int d = 1; d < 64; d <<= 1) { const float t = __shfl_up(incl, d); if (lane >= d) incl += t; }
        const float ex = incl - (a0 + a1);
        acs[wid * 128 + 2 * lane] = ex + a0; acs[wid * 128 + 2 * lane + 1] = ex + a0 + a1;
        dts[wid * 128 + 2 * lane] = d0; dts[wid * 128 + 2 * lane + 1] = d1;
    }
}
DEVI void conv8_chan(const DP& p, int l, const bf16_t* proj, int b, int c, int chan, int l0, float (&out)[8]) {
    const float* cw = p.in(9) + (size_t)l * 4 * 1024 + chan;
    const float w0 = cw[0], w1 = cw[1024], w2 = cw[2048], w3 = cw[3072], cb = p.in(10)[l * 1024 + chan];
    float v[11];
    const int sbase = c * 128 + l0 - 3;
#pragma unroll
    for (int i = 0; i < 11; ++i) { const int sp = sbase + i; v[i] = sp >= 0 ? bf2f(proj[((size_t)b * S + sp) * NPROJ + C_XBC + chan]) : 0.f; }
#pragma unroll
    for (int i = 0; i < 8; ++i) out[i] = silu_f(cb + w0 * v[i] + w1 * v[i + 1] + w2 * v[i + 2] + w3 * v[i + 3]);
}
constexpr int SST = 136;
constexpr int XST4 = 264;
DEVI void ssd_states_task(const DP& p, int l, int b, int c, int g, char* lds) {
    const int tid = TIDX(), wid = tid >> 6, lane = tid & 63, r16 = lane & 15, g4 = lane >> 4;
    const bf16_t* xc = (const bf16_t*)(p.ws() + WS_XC);
    bf16_t* Bn = (bf16_t*)lds;
    bf16_t* Xn = Bn + 128 * SST;
    float* acs = (float*)(Xn + 128 * XST4);
    float* dts = acs + 512;
    __syncthreads();
    ssd_acs(p, l, b, c, g, acs, dts);
    __syncthreads();
    if (tid < 4) ((float*)(p.ws() + WS_DECAY))[((size_t)b * 16 + c) * 8 + g * 4 + tid] = __expf(acs[tid * 128 + 127]);
    const size_t tok0 = (size_t)b * S + c * 128;
    u32x4 sb_[4], sx_[8];
#pragma unroll
    for (int q = 0; q < 4; ++q) { const int it = tid + q * NTHR, ll = it >> 4, nc = (it & 15) * 8; sb_[q] = *(const u32x4*)(xc + (tok0 + ll) * 1024 + 512 + g * 128 + nc); }
#pragma unroll
    for (int q = 0; q < 8; ++q) { const int it = tid + q * NTHR, ll = it >> 5, ch = (it & 31) * 8; sx_[q] = *(const u32x4*)(xc + (tok0 + ll) * 1024 + g * 256 + ch); }
#pragma unroll
    for (int q = 0; q < 4; ++q) { const int it = tid + q * NTHR, ll = it >> 4, nc = (it & 15) * 8; *(u32x4*)(Bn + ll * SST + nc) = sb_[q]; }
#pragma unroll
    for (int q = 0; q < 8; ++q) {
        const int it = tid + q * NTHR;
        const int ll = it >> 5, ch = (it & 31) * 8, hl = ch >> 6;
        const u32x4 w = sx_[q];
        const float sc = dts[hl * 128 + ll] * __expf(acs[hl * 128 + 127] - acs[hl * 128 + ll]);
        u32x4 o; o.x = cvt_pk(bflo(w.x) * sc, bfhi(w.x) * sc); o.y = cvt_pk(bflo(w.y) * sc, bfhi(w.y) * sc); o.z = cvt_pk(bflo(w.z) * sc, bfhi(w.z) * sc); o.w = cvt_pk(bflo(w.w) * sc, bfhi(w.w) * sc);
        *(u32x4*)(Xn + ll * XST4 + ch) = o;
    }
    __syncthreads();
    const int hl = wid >> 1, nh = wid & 1;
    f32x4 acc[4][4];
#pragma unroll
    for (int m = 0; m < 4; ++m)
#pragma unroll
        for (int n = 0; n < 4; ++n) acc[m][n] = (f32x4){0.f, 0.f, 0.f, 0.f};
#pragma unroll
    for (int kk = 0; kk < 4; ++kk) {
        bf16x8 af[4], bfr[4];
        const int lrow = kk * 32 + 8 * g4 + (r16 >> 2), cq = 4 * (r16 & 3);
#pragma unroll
        for (int m = 0; m < 4; ++m) { const bf16_t* a = Xn + lrow * XST4 + hl * 64 + m * 16 + cq; const s16x4 lo = tr_read(a), hi = tr_read(a + 4 * XST4);
            af[m][0] = lo[0]; af[m][1] = lo[1]; af[m][2] = lo[2]; af[m][3] = lo[3]; af[m][4] = hi[0]; af[m][5] = hi[1]; af[m][6] = hi[2]; af[m][7] = hi[3]; }
#pragma unroll
        for (int n = 0; n < 4; ++n) { const bf16_t* a = Bn + lrow * SST + nh * 64 + n * 16 + cq; const s16x4 lo = tr_read(a), hi = tr_read(a + 4 * SST);
            bfr[n][0] = lo[0]; bfr[n][1] = lo[1]; bfr[n][2] = lo[2]; bfr[n][3] = lo[3]; bfr[n][4] = hi[0]; bfr[n][5] = hi[1]; bfr[n][6] = hi[2]; bfr[n][7] = hi[3]; }
#pragma unroll
        for (int m = 0; m < 4; ++m)
#pragma unroll
            for (int n = 0; n < 4; ++n) acc[m][n] = MFMA16(bfr[n], af[m], acc[m][n]);
    }
    float* st = (float*)(p.ws() + WS_SSTATE) + (((size_t)b * 16 + c) * 8 + g * 4 + hl) * 8192;
#pragma unroll
    for (int m = 0; m < 4; ++m)
#pragma unroll
        for (int n = 0; n < 4; ++n) *(f32x4*)(st + (m * 16 + r16) * 128 + nh * 64 + n * 16 + g4 * 4) = acc[m][n];
}
DEVI void phase_ssd_scan(const DP& p) {
    const float* st = (const float*)(p.ws() + WS_SSTATE);
    bf16_t* hin = (bf16_t*)(p.ws() + WS_HIN);
    const float* decay = (const float*)(p.ws() + WS_DECAY);
    const int total = NB * 8 * 2048;
    for (int i = BIDX() * NTHR + TIDX(); i < total; i += gridDim.x * NTHR) {
        const int e4 = i & 2047, head = (i >> 11) & 7, b = i >> 14;
        f32x4 h = (f32x4){0.f, 0.f, 0.f, 0.f};
        f32x4 sv[15]; float dv[15];
#pragma unroll
        for (int c = 0; c < 15; ++c) { sv[c] = *(const f32x4*)(st + (((size_t)b * 16 + c) * 8 + head) * 8192 + e4 * 4); dv[c] = decay[((size_t)b * 16 + c) * 8 + head]; }
#pragma unroll
        for (int c = 0; c < 16; ++c) {
            const size_t off = (((size_t)b * 16 + c) * 8 + head) * 8192 + e4 * 4;
            u32x2 w; w.x = cvt_pk(h[0], h[1]); w.y = cvt_pk(h[2], h[3]);
            *(u32x2*)(hin + off) = w;
            if (c < 15) h = h * dv[c] + sv[c];
        }
    }
}
constexpr int XST1 = 72;
DEVI void ssd_out_task(const DP& p, int l, int b, int c, int g, char* lds) {
    const int tid = TIDX(), wid = tid >> 6, lane = tid & 63, r16 = lane & 15, g4 = lane >> 4;
    const bf16_t* proj = (const bf16_t*)(p.ws() + WS_PROJ);
    const bf16_t* xc = (const bf16_t*)(p.ws() + WS_XC);
    bf16_t* Cs = (bf16_t*)lds;
    bf16_t* Bs = Cs + 128 * SST;
    bf16_t* Xn = Bs + 128 * SST;
    bf16_t* Hs = Xn + 128 * XST1;
    bf16_t* Mw = Hs + 64 * SST + wid * 16 * SST;
    float* acs = (float*)(Hs + 64 * SST + 8 * 16 * SST);
    float* dts = acs + 512;
    const int lrow = wid * 16 + r16;
    const size_t tok0 = (size_t)b * S + c * 128, tok = tok0 + lrow;
    bf16_t* mix = (bf16_t*)(p.ws() + WS_MIX);
    float ssq = 0.f;
    __syncthreads();
    ssd_acs(p, l, b, c, g, acs, dts);
    { u32x4 tc[4], tb[4];
#pragma unroll
      for (int q = 0; q < 4; ++q) { const int it = tid + q * NTHR, ll = it >> 4, nc = (it & 15) * 8;
          tc[q] = *(const u32x4*)(xc + (tok0 + ll) * 1024 + 768 + g * 128 + nc); tb[q] = *(const u32x4*)(xc + (tok0 + ll) * 1024 + 512 + g * 128 + nc); }
#pragma unroll
      for (int q = 0; q < 4; ++q) { const int it = tid + q * NTHR, ll = it >> 4, nc = (it & 15) * 8;
          *(u32x4*)(Cs + ll * SST + nc) = tc[q]; *(u32x4*)(Bs + ll * SST + nc) = tb[q]; } }
    __syncthreads();
    bf16x8 cfr[4];
#pragma unroll
    for (int kk = 0; kk < 4; ++kk) cfr[kk] = *(const bf16x8*)(Cs + lrow * SST + kk * 32 + g4 * 8);
    f32x4 cb[8];
#pragma unroll
    for (int st = 0; st < 8; ++st) {
        cb[st] = (f32x4){0.f, 0.f, 0.f, 0.f};
#pragma unroll
        for (int kk = 0; kk < 4; ++kk) {
            const bf16x8 bfr = *(const bf16x8*)(Bs + (st * 16 + r16) * SST + kk * 32 + g4 * 8);
            cb[st] = MFMA16(bfr, cfr[kk], cb[st]);
        }
    }
    u32x4 px[2], ph[2];
    auto hload = [&](int hl_) {
        const int head_ = g * 4 + hl_;
#pragma unroll
        for (int i = 0; i < 2; ++i) { const int it = tid + i * NTHR, ss = it >> 3, pc8 = (it & 7) * 8;
            px[i] = *(const u32x4*)(xc + (tok0 + ss) * 1024 + head_ * 64 + pc8);
            ph[i] = *(const u32x4*)((const bf16_t*)(p.ws() + WS_HIN) + (((size_t)b * 16 + c) * 8 + head_) * 8192 + (size_t)it * 8); }
    };
    hload(0);
    for (int hl = 0; hl < 4; ++hl) {
        const int head = g * 4 + hl;
        __syncthreads();
#pragma unroll
        for (int i = 0; i < 2; ++i) { const int it = tid + i * NTHR, ss = it >> 3, pc8 = (it & 7) * 8;
            *(u32x4*)(Xn + ss * XST1 + pc8) = px[i];
            *(u32x4*)(Hs + (it >> 4) * SST + (it & 15) * 8) = ph[i]; }
        __syncthreads();
        if (hl + 1 < 4) hload(hl + 1);
        u32x2 zpre[4];
#pragma unroll
        for (int pt = 0; pt < 4; ++pt) zpre[pt] = *(const u32x2*)(proj + tok * NPROJ + C_Z + head * 64 + pt * 16 + g4 * 4);
        const float al = acs[hl * 128 + lrow];
#pragma unroll
        for (int st = 0; st < 8; ++st) {
            float mv[4];
            const float4 a4 = *(const float4*)(acs + hl * 128 + st * 16 + g4 * 4), d4 = *(const float4*)(dts + hl * 128 + st * 16 + g4 * 4);
            const float av[4] = {a4.x, a4.y, a4.z, a4.w}, dv[4] = {d4.x, d4.y, d4.z, d4.w};
#pragma unroll
            for (int j = 0; j < 4; ++j) { const int sidx = st * 16 + g4 * 4 + j;
                mv[j] = (sidx <= lrow) ? cb[st][j] * __expf(al - av[j]) * dv[j] : 0.f; }
            u32x2 w; w.x = cvt_pk(mv[0], mv[1]); w.y = cvt_pk(mv[2], mv[3]);
            *(u32x2*)(Mw + r16 * SST + st * 16 + g4 * 4) = w;
        }
        __builtin_amdgcn_wave_barrier();
        asm volatile("s_waitcnt lgkmcnt(0)" ::: "memory");
        f32x4 yd[4], yo[4];
#pragma unroll
        for (int pt = 0; pt < 4; ++pt) { yd[pt] = (f32x4){0.f, 0.f, 0.f, 0.f}; yo[pt] = (f32x4){0.f, 0.f, 0.f, 0.f}; }
#pragma unroll
        for (int kk = 0; kk < 4; ++kk) {
            const bf16x8 mf = *(const bf16x8*)(Mw + r16 * SST + kk * 32 + g4 * 8);
            const bf16_t* xa = Xn + (kk * 32 + 8 * g4 + (r16 >> 2)) * XST1 + 4 * (r16 & 3);
#pragma unroll
            for (int pt = 0; pt < 4; ++pt) {
                const s16x4 lo = tr_read(xa + pt * 16), hi = tr_read(xa + 4 * XST1 + pt * 16);
                bf16x8 xf; xf[0] = lo[0]; xf[1] = lo[1]; xf[2] = lo[2]; xf[3] = lo[3]; xf[4] = hi[0]; xf[5] = hi[1]; xf[6] = hi[2]; xf[7] = hi[3];
                yd[pt] = MFMA16(xf, mf, yd[pt]);
                const bf16x8 hf = *(const bf16x8*)(Hs + (pt * 16 + r16) * SST + kk * 32 + g4 * 8);
                yo[pt] = MFMA16(hf, cfr[kk], yo[pt]);
            }
        }
        __builtin_amdgcn_wave_barrier();
        const float el = __expf(al), Dh = p.in(13)[l * 8 + head];
#pragma unroll
        for (int pt = 0; pt < 4; ++pt) {
            const int pc = pt * 16 + g4 * 4;
            const u32x2 zw = zpre[pt];
            const u32x2 xw = *(const u32x2*)(Xn + lrow * XST1 + pc);
            const float zz[4] = {bflo(zw.x), bfhi(zw.x), bflo(zw.y), bfhi(zw.y)};
            const float xx[4] = {bflo(xw.x), bfhi(xw.x), bflo(xw.y), bfhi(xw.y)};
            float gv[4];
#pragma unroll
            for (int j = 0; j < 4; ++j) { const float yv = yd[pt][j] + el * yo[pt][j] + Dh * xx[j]; gv[j] = yv * silu_f(zz[j]); ssq += gv[j] * gv[j]; }
            u32x2 w; w.x = cvt_pk(gv[0], gv[1]); w.y = cvt_pk(gv[2], gv[3]);
            *(u32x2*)(mix + tok * DM + 512 + head * 64 + pc) = w;
        }
    }
    ssq += __shfl_xor(ssq, 16); ssq += __shfl_xor(ssq, 32);
    if (g4 == 0) ((float*)(p.ws() + WS_SSQ))[tok * 2 + g] = ssq;
}
constexpr int N_FOX = 512, N_S1 = 256, N_DIL = 1536;
DEVI void phase_mix1(const DP& p, int l, char* lds) {
    unsigned char* ws = p.ws();
    kv_gemm(p, lds);
    const bf16_t* proj = (const bf16_t*)(ws + WS_PROJ);
    bf16_t* mix = (bf16_t*)(ws + WS_MIX);
    const int G = gridDim.x, bid = BIDX();
    for (int u = bid; u < N_S1; u += G) { const int g = u & 1, c = (u >> 1) & 15, b = u >> 5; ssd_states_task(p, l, b, c, g, lds); }
    const int nfw = G / 2;
    if (bid < nfw) {
        for (int t = bid; t < 128; t += nfw) {
            const int bh = t & 31, k = t >> 5, b = bh >> 2, h = bh & 3;
            const float* cum = (const float*)(ws + WS_CUMF) + (size_t)bh * S;
#pragma unroll 1
            for (int half = 0; half < 2; ++half) {
                const int qb = half == 0 ? 7 - k : k;
                attn_task<64, 0, 2>(proj + C_FQ + h * 64, NPROJ, b * S, 1, proj + C_FK + h * 64, proj + C_FV + h * 64, NPROJ, b * S, 1,
                                    qb * 256, 0, 4 * qb + 4, 0.125f, cum, nullptr, mix + h * 64, DM, nullptr, nullptr, nullptr, lds);
            }
        }
    } else {
        const int ndw = G - nfw;
        for (int u = bid - nfw; u < 1024; u += ndw) {
            const int bh = u & 31, v = u >> 5, b = bh >> 2, h = bh & 3;
            if (v < 16) {
                const int br = v >> 3, dil = br ? 4 : 1, r = br ? ((v - 8) & 3) : 0, pb = br ? ((v - 8) >> 2) : v;
                float* Of = (float*)(ws + WS_DILO) + (size_t)br * T * 256 + h * 64;
                float* Om = (float*)(ws + WS_DILM) + (size_t)br * T * 4 + h;
                float* Ol = (float*)(ws + WS_DILL) + (size_t)br * T * 4 + h;
                const int klo = pb > 0 ? 4 * pb - 2 : 0;
                attn_task<64, 1, 2>(proj + C_DQ + h * 64, NPROJ, b * S + r, dil, proj + C_DK + h * 64, proj + C_DV + h * 64, NPROJ, b * S + r, dil,
                                    pb * 256, klo, 4 * pb + 4, 0.125f, nullptr, nullptr, nullptr, 0, Of, Om, Ol, lds);
            } else {
                const int r = v - 16;
                float* Of = (float*)(ws + WS_DILO) + (size_t)2 * T * 256 + h * 64;
                float* Om = (float*)(ws + WS_DILM) + (size_t)2 * T * 4 + h;
                float* Ol = (float*)(ws + WS_DILL) + (size_t)2 * T * 4 + h;
                attn_task<64, 1, 1>(proj + C_DQ + h * 64, NPROJ, b * S + r, 16, proj + C_DK + h * 64, proj + C_DV + h * 64, NPROJ, b * S + r, 16,
                                    0, 0, 2, 0.125f, nullptr, nullptr, nullptr, 0, Of, Om, Ol, lds);
            }
        }
    }
}
DEVI void phase_mix3(const DP& p, int l, char* lds) {
    unsigned char* ws = p.ws();
    for (int t = BIDX(); t < NB * 16 * 2; t += gridDim.x) ssd_out_task(p, l, t >> 5, (t >> 1) & 15, t & 1, lds);
    const int tid = TIDX(), wid = tid >> 6, lane = tid & 63, head = lane >> 4, d4 = (lane & 15) * 4;
    const float* Of = (const float*)(ws + WS_DILO);
    const float* Om = (const float*)(ws + WS_DILM);
    const float* Ol = (const float*)(ws + WS_DILL);
    bf16_t* mix = (bf16_t*)(ws + WS_MIX);
    for (int row = BIDX() * 8 + wid; row < T; row += gridDim.x * 8) {
        float m[3], lsum[3];
#pragma unroll
        for (int br = 0; br < 3; ++br) { m[br] = Om[((size_t)br * T + row) * 4 + head]; lsum[br] = Ol[((size_t)br * T + row) * 4 + head]; }
        const float M = fmaxf(m[0], fmaxf(m[1], m[2]));
        f32x4 num = (f32x4){0.f, 0.f, 0.f, 0.f}; float den = 0.f;
#pragma unroll
        for (int br = 0; br < 3; ++br) {
            const float w = __builtin_amdgcn_exp2f(m[br] - M);
            const f32x4 o = *(const f32x4*)(Of + ((size_t)br * T + row) * 256 + head * 64 + d4);
            num += o * w; den += w * lsum[br];
        }
        const float inv = 1.0f / den;
        u32x2 w; w.x = cvt_pk(num[0] * inv, num[1] * inv); w.y = cvt_pk(num[2] * inv, num[3] * inv);
        *(u32x2*)(mix + (size_t)row * DM + 256 + head * 64 + d4) = w;
    }
}
DEVI void phase_xattn(const DP& p, int l, char* lds) {
    unsigned char* ws = p.ws();
    const bf16_t* qbuf = (const bf16_t*)(ws + WS_QBUF);
    const bf16_t* kv = (const bf16_t*)(ws + WS_KV);
    bf16_t* obuf = (bf16_t*)(ws + WS_OBUF);
    for (int t = BIDX(); t < NB * 4 * 16; t += gridDim.x) {
        const int qb = t & 15, h = (t >> 4) & 3, b = t >> 6;
        attn_task<256, 2, 1>(qbuf + h * 256, DM, b * S, 1, kv + h * 256, kv + DM + h * 256, 2 * DM, b * MEMLEN, 1,
                          qb * 128, 0, 4, 0.0625f, nullptr, p.in(20) + l * 256, obuf + h * 256, DM, nullptr, nullptr, nullptr, lds);
    }
}
namespace g8 {
template <bool GATHER_> struct MoeSched {
    static constexpr bool GATHER = GATHER_;
    const int* cnt; const int* list; const char* Abase; const char* Bbase; size_t bstride; int K, G;
    int ei, ubase, u, step, x, nxcd;
    int cv, pv;
    DEVI void init(const int* cnt_, const int* list_, const void* A_, const void* B_, size_t bstride_, int K_, int G_, int c_) {
        cnt = cnt_; list = list_; Abase = (const char*)A_; Bbase = (const char*)B_; bstride = bstride_; K = K_; G = G_;
        nxcd = (G_ % 8 == 0) ? 8 : 1; x = c_ % nxcd; step = G_ / nxcd; u = c_ / nxcd; ei = 0; ubase = 0;
        const int lane = TIDX() & 63;
        cv = cnt_[lane & 31];
        int incl = (cv + BM - 1) / BM;
        const int own = incl;
#pragma unroll
        for (int d = 1; d < 32; d <<= 1) { const int t = __shfl_up(incl, d); if ((lane & 31) >= d) incl += t; }
        pv = incl - own; }
    DEVI bool next(UnitU& o) {
        while (x + nxcd * ei < NEXP) {
            const int e = x + nxcd * ei;
            const int ce = __builtin_amdgcn_readlane(cv, e), nte = (ce + BM - 1) / BM, nun = nte * 4;
            if (u < ubase + nun) {
                const int lu = u - ubase, pm = lu >> 2, pn = lu & 3;
                const int tbase = __builtin_amdgcn_readlane(pv, e);
                o.i0 = tbase + pm; o.i1 = pn; o.i2 = e * (2 * T) + pm * BM; o.i3 = ce - pm * BM; o.flags = 3;
                o.A = GATHER ? Abase : Abase + (size_t)(tbase + pm) * BM * K * 2;
                o.B = Bbase + (size_t)e * bstride + (size_t)pn * BM * K * 2;
                u += step; return true;
            }
            ubase += nun; ++ei;
        }
        return false;
    }
    DEVI void lane_va(const UnitU& o, int R0, int C0, int R1, int C1, unsigned& v00, unsigned& v01, unsigned& v10, unsigned& v11) const {
        if (GATHER) {
            const int nv = o.i3; const int* ent = list + o.i2;
            const int t00 = (ent[R0 < nv ? R0 : 0] & 0xffff) >> 1, t01 = (ent[R1 < nv ? R1 : 0] & 0xffff) >> 1, t10 = (ent[R0 + HALF < nv ? R0 + HALF : 0] & 0xffff) >> 1, t11 = (ent[R1 + HALF < nv ? R1 + HALF : 0] & 0xffff) >> 1;
            v00 = (unsigned)(t00 * K + C0) * 2u; v01 = (unsigned)(t01 * K + C1) * 2u; v10 = (unsigned)(t10 * K + C0) * 2u; v11 = (unsigned)(t11 * K + C1) * 2u;
        } else {
            v00 = (unsigned)(R0 * K + C0) * 2u; v01 = (unsigned)(R1 * K + C1) * 2u; v10 = v00 + (unsigned)(HALF * K * 2); v11 = v01 + (unsigned)(HALF * K * 2);
        }
    }
};
struct EpiSwiglu { static constexpr bool PERM = false; bf16_t* act;
    DEVI void mid(f32x4 (&)[2][2][4][2], const UnitU&, int, int, int, int) const {}
    DEVI void operator()(const f32x4 (&acc)[2][2][4][2], const UnitU& u, int wr, int wc, int fr, int fq) const {
        const int nv = u.i3;
#pragma unroll
        for (int ai = 0; ai < 2; ++ai)
#pragma unroll
            for (int m = 0; m < 4; ++m) {
                const int r = ai * HALF + wr * 64 + m * 16 + fr;
                if (r < nv) {
                    bf16_t* rowp = act + (size_t)(u.i0 * BM + r) * EFF + u.i1 * 128 + wc * 16 + 4 * fq;
#pragma unroll
                    for (int bj = 0; bj < 2; ++bj) { const f32x4 x1 = acc[ai][bj][m][0], x3 = acc[ai][bj][m][1];
                        u32x2 w; w.x = cvt_pk(silu_f(x1[0]) * x3[0], silu_f(x1[1]) * x3[1]); w.y = cvt_pk(silu_f(x1[2]) * x3[2], silu_f(x1[3]) * x3[3]);
                        *(u32x2*)(rowp + bj * 64) = w; }
                }
            }
    } };
struct EpiMoeOut { static constexpr bool PERM = true; bf16_t* y; const int* list;
    DEVI void mid(f32x4 (&)[2][2][4][2], const UnitU&, int, int, int, int) const {}
    DEVI void operator()(const f32x4 (&acc)[2][2][4][2], const UnitU& u, int wr, int wc, int fr, int fq) const {
        const int nv = u.i3; const int* ent = list + u.i2;
        unsigned env[2][4];
#pragma unroll
        for (int ai = 0; ai < 2; ++ai)
#pragma unroll
            for (int m = 0; m < 4; ++m) { const int r = ai * HALF + wr * 64 + m * 16 + fr; env[ai][m] = (unsigned)ent[r < nv ? r : 0]; }
#pragma unroll
        for (int ai = 0; ai < 2; ++ai)
#pragma unroll
            for (int m = 0; m < 4; ++m) {
                const int r = ai * HALF + wr * 64 + m * 16 + fr;
                if (r < nv) {
                    const unsigned en = env[ai][m]; const int a = (int)(en & 0xffffu); const float gt = __uint_as_float(en & 0xffff0000u);
                    bf16_t* rowp = y + (size_t)a * DM + u.i1 * BM + wc * 32 + 8 * fq;
#pragma unroll
                    for (int bj = 0; bj < 2; ++bj) { const f32x4 v0 = acc[ai][bj][m][0] * gt, v1 = acc[ai][bj][m][1] * gt;
                        u32x4 w; w.x = cvt_pk(v0[0], v0[1]); w.y = cvt_pk(v0[2], v0[3]); w.z = cvt_pk(v1[0], v1[1]); w.w = cvt_pk(v1[2], v1[3]);
                        *(u32x4*)(rowp + bj * HALF) = w; }
                }
            }
    } };
}
template <int WHICH>
DEVI void phase_moe(const DP& p, int l, char* lds) {
    unsigned char* ws = p.ws();
    const int* cnt = (const int*)(ws + WS_CNT) + l * 64;
    const int* list = (const int*)(ws + WS_LIST);
    if (WHICH == 0) {
        g8::MoeSched<true> S;
        S.init(cnt, list, ws + WS_H3, ws + WS_W_13, (size_t)1024 * DM * 2, DM, gridDim.x, BIDX());
        g8::EpiSwiglu E{(bf16_t*)(ws + WS_ACT)};
        g8::gemm8(lds, DM, DM, S, E);
    } else {
        g8::MoeSched<false> S;
        S.init(cnt, list, ws + WS_ACT, ws + WS_W_2, (size_t)DM * EFF * 2, EFF, gridDim.x, BIDX());
        g8::EpiMoeOut E{(bf16_t*)(ws + WS_YBUF), list};
        g8::gemm8(lds, EFF, EFF, S, E);
    }
}
DEVI void phase_final(const DP& p) {
    const int tid = TIDX(), wid = tid >> 6, lane = tid & 63;
    const bf16_t* ybuf = (const bf16_t*)(p.ws() + WS_YBUF);
    const bf16_t* h0 = (const bf16_t*)(p.ws() + WS_HBUF);
    float* out = p.out();
    for (int row = BIDX() * 8 + wid; row < T; row += gridDim.x * 8) {
        float x[16];
        load_row_bf16(h0 + (size_t)row * DM, x, lane);
        add_row_bf16_b(ybuf + (size_t)(2 * row) * DM, x, lane);
        add_row_bf16_b(ybuf + (size_t)(2 * row + 1) * DM, x, lane);
#pragma unroll
        for (int j = 0; j < 2; ++j) {
            *(float4*)(out + (size_t)row * DM + j * 512 + lane * 8) = make_float4(x[8 * j], x[8 * j + 1], x[8 * j + 2], x[8 * j + 3]);
            *(float4*)(out + (size_t)row * DM + j * 512 + lane * 8 + 4) = make_float4(x[8 * j + 4], x[8 * j + 5], x[8 * j + 6], x[8 * j + 7]);
        }
    }
}

#define XB_TMO      128
#define XB_XCNT(j)  (256  + 64 * (j))
#define XB_XSUB(j)  (1280 + 64 * (j))
#define XB_XGEN(j)  (2304 + 64 * (j))
#define XB_TOP      3328
#define XB_TOPGEN   3392
#define XCD_BAR_WORDS 3456
#define XB_SPIN_CAP (1u << 22)
DEVI unsigned xb_ld(unsigned* p)              { return __hip_atomic_load(p, __ATOMIC_RELAXED, __HIP_MEMORY_SCOPE_AGENT); }
DEVI unsigned xb_add(unsigned* p, unsigned v) { return __hip_atomic_fetch_add(p, v, __ATOMIC_RELAXED, __HIP_MEMORY_SCOPE_AGENT); }
DEVI unsigned xb_xcc_id() { return (unsigned)__builtin_amdgcn_s_getreg((3 << 11) | 20) & 0xFu; }
#define XB_SPIN(cond, bar) do { unsigned _sp = 0; while (cond) { __builtin_amdgcn_s_sleep(1); \
    if ((++_sp & 255u) == 0u) { if (xb_ld(&(bar)[XB_TMO])) break; if (_sp > XB_SPIN_CAP) { atomicAdd(&(bar)[XB_TMO], 1u); break; } } } } while (0)
struct XcdBarrier { unsigned* bar; unsigned x; volatile LAS unsigned* st; };
DEVI XcdBarrier xcd_barrier_post(unsigned* bar, volatile LAS unsigned* st) {
    XcdBarrier b; b.bar = bar; b.x = xb_xcc_id(); b.st = st;
    if (threadIdx.x == 0) (void)xb_add(&bar[XB_XCNT(b.x)], 1u);
    return b;
}
DEVI void xcd_barrier_complete(unsigned* bar, unsigned x, unsigned& nloc, unsigned& nx) {
    const unsigned G = gridDim.x * gridDim.y * gridDim.z;
    unsigned sum, cnt, mine, sp = 0u;
    for (;;) {
        sum = 0u; cnt = 0u; mine = 0u;
#pragma unroll
        for (unsigned j = 0; j < 16; ++j) { const unsigned c = xb_ld(&bar[XB_XCNT(j)]); sum += c; cnt += (c > 0u) ? 1u : 0u; mine = (j == x) ? c : mine; }
        if (sum == G) break;
        __builtin_amdgcn_s_sleep(1);
        if ((++sp & 255u) == 0u) { if (xb_ld(&bar[XB_TMO])) break; if (sp > XB_SPIN_CAP) { atomicAdd(&bar[XB_TMO], 1u); break; } }
    }
    nloc = mine > 0u ? mine : 1u; nx = cnt > 0u ? cnt : 1u;
}
DEVI void xcd_barrier(const XcdBarrier& b) {
    asm volatile("s_waitcnt vmcnt(0)" ::: "memory");
    __syncthreads();
    if (threadIdx.x == 0) {
        unsigned* bar = b.bar;
        __builtin_amdgcn_s_waitcnt(0);
        unsigned nloc = b.st[0], nx = b.st[1];
        if (nloc == 0u) { xcd_barrier_complete(bar, b.x, nloc, nx); b.st[0] = nloc; b.st[1] = nx; }
        const unsigned old = xb_add(&bar[XB_XSUB(b.x)], 1u);
        const unsigned gen = old / nloc;
        if (old + 1u == (gen + 1u) * nloc) {
            __builtin_amdgcn_fence(__ATOMIC_RELEASE, "agent");
            asm volatile("s_waitcnt vmcnt(0)" ::: "memory");
            const unsigned og = xb_add(&bar[XB_TOP], 1u);
            const unsigned tg = og / nx;
            if (og + 1u == (tg + 1u) * nx) xb_add(&bar[XB_TOPGEN], 1u);
            else XB_SPIN(xb_ld(&bar[XB_TOPGEN]) == tg, bar);
            __builtin_amdgcn_fence(__ATOMIC_ACQUIRE, "agent");
            xb_add(&bar[XB_XGEN(b.x)], 1u);
            asm volatile("s_waitcnt vmcnt(0)" ::: "memory");
        } else {
            XB_SPIN(xb_ld(&bar[XB_XGEN(b.x)]) == gen, bar);
            __builtin_amdgcn_fence(__ATOMIC_ACQUIRE, "agent");
            asm volatile("s_waitcnt vmcnt(0)" ::: "memory");
        }
    }
    __syncthreads();
}

constexpr int N_PHASES = 27;
__global__ void __launch_bounds__(NTHR) hybrid_fwd(Params p_unused) {
    extern __shared__ __attribute__((aligned(16))) char lds_base[];
    karg_ptr kp = (karg_ptr)__builtin_amdgcn_kernarg_segment_ptr();
    int ph_lo, ph_hi, use_gs;
    { DP q{kp}; ph_lo = q.ph_lo(); ph_hi = q.ph_hi(); use_gs = q.use_gs(); }
    volatile LAS unsigned* xst = (volatile LAS unsigned*)(LAS char*)(lds_base + LDS_BYTES - 16);
    if (threadIdx.x == 0) { xst[0] = 0u; xst[1] = 0u; }
    __syncthreads();
    XcdBarrier xb; xb.bar = nullptr; xb.x = 0; xb.st = xst;
    if (use_gs == 1) { DP q{kp}; xb = xcd_barrier_post((unsigned*)(q.ws() + WS_BAR), xst); }
#define RUN_PHASE(PH, ...) \
    if (ph_lo <= (PH) && (PH) < ph_hi) { \
        if ((PH) > ph_lo) { if (use_gs == 1) xcd_barrier(xb); else if (use_gs == 2) cg::this_grid().sync(); } \
        asm volatile("" : "+s"(kp) :: "memory"); \
        const DP p{kp}; \
        unsigned lds_off = 0; asm volatile("" : "+s"(lds_off)); \
        char* lds = lds_base + lds_off; \
        unsigned char* ws = p.ws(); (void)ws; (void)lds; \
        __VA_ARGS__ \
    }
#define LAYER_PHASES(L, B0) \
    RUN_PHASE((B0) + 0, { if ((L) == 0) prep_small(p); prep_all(p, (L), lds); __syncthreads(); phase_norm1(p, (L), lds); }) \
    RUN_PHASE((B0) + 1, { phase_inproj(p, (L), lds); }) \
    RUN_PHASE((B0) + 2, { for (int t = (int)gridDim.x - 1 - BIDX(); t < 32; t += gridDim.x) cumsum_task(p, t, lds); phase_post(p, (L)); }) \
    RUN_PHASE((B0) + 3, { phase_mix1(p, (L), lds); }) \
    RUN_PHASE((B0) + 4, { phase_ssd_scan(p); phase_knorm(p, (L)); }) \
    RUN_PHASE((B0) + 5, { phase_mix3(p, (L), lds); }) \
    RUN_PHASE((B0) + 6, { g8::DenseSched2 S; S.init((const bf16_t*)(ws + WS_MIX), (const bf16_t*)(ws + WS_W_OUT), T, DM, DM, gridDim.x, BIDX()); \
                          g8::EpiResScale E{{(const bf16_t*)(ws + WS_HBUF), (bf16_t*)(ws + WS_H1), DM}, (const float*)(ws + WS_SSQ)}; g8::gemm8(lds, DM, DM / 2, S, E); }) \
    RUN_PHASE((B0) + 7, { g8::DenseSched S; S.init((const bf16_t*)(ws + WS_H1), (const bf16_t*)(ws + WS_W_Q), T, DM, DM, gridDim.x, BIDX()); \
                          g8::EpiBf16 E{(bf16_t*)(ws + WS_QBUF), DM}; g8::gemm8(lds, DM, DM, S, E); }) \
    RUN_PHASE((B0) + 8, { phase_xattn(p, (L), lds); }) \
    RUN_PHASE((B0) + 9, { g8::DenseSched S; S.init((const bf16_t*)(ws + WS_OBUF), (const bf16_t*)(ws + WS_W_O), T, DM, DM, gridDim.x, BIDX()); \
                          g8::EpiResBf E{(const bf16_t*)(ws + WS_H1), (bf16_t*)(ws + WS_HBUF), DM}; g8::gemm8(lds, DM, DM, S, E); }) \
    RUN_PHASE((B0) + 10, { phase_norm3(p, (L), lds); }) \
    RUN_PHASE((B0) + 11, { phase_moe<0>(p, (L), lds); }) \
    RUN_PHASE((B0) + 12, { phase_moe<1>(p, (L), lds); })

    LAYER_PHASES(0, 0)
    LAYER_PHASES(1, 13)
    RUN_PHASE(26, { phase_final(p); })
#undef LAYER_PHASES
#undef RUN_PHASE
}

extern "C" void kernel_launch(void* const* d_in, const int* in_sizes, int n_in, void* d_out, int out_size, void* d_ws, size_t ws_size, hipStream_t stream) {
    static int grid = 0;
    if (grid == 0) {
        if (n_in != 31 || out_size != T * DM || ws_size < WS_END) { fprintf(stderr, "kernel_launch: unexpected shapes (n_in %d out %d ws %zu need %zu)\n", n_in, out_size, ws_size, (size_t)WS_END); grid = -1; return; }
        int dev = 0, cus = 0, per_cu = 0;
        hipGetDevice(&dev);
        hipDeviceGetAttribute(&cus, hipDeviceAttributeMultiprocessorCount, dev);
        hipFuncSetAttribute((const void*)hybrid_fwd, hipFuncAttributeMaxDynamicSharedMemorySize, LDS_BYTES);
        hipOccupancyMaxActiveBlocksPerMultiprocessor(&per_cu, (const void*)hybrid_fwd, NTHR, LDS_BYTES);
        if (per_cu < 1) { fprintf(stderr, "kernel_launch: occupancy query says %d blocks per CU\n", per_cu); per_cu = 1; }
        (void)hipGetLastError();
        grid = cus;
    }
    if (grid < 0) return;
    Params p{};
    for (int i = 0; i < 31; ++i) p.in[i] = (const float*)d_in[i];
    p.out = (float*)d_out; p.ws = (unsigned char*)d_ws;
    p.use_grid_sync = 1; p.pad = 0;
    p.ph_lo = 0; p.ph_hi = N_PHASES;
    if (hipMemsetAsync((unsigned char*)d_ws + WS_BAR, 0, XCD_BAR_WORDS * 4, stream) != hipSuccess) { fprintf(stderr, "kernel_launch: memset failed\n"); return; }
    void* args[] = {&p};
    hipError_t e = hipLaunchCooperativeKernel((const void*)hybrid_fwd, dim3(grid), dim3(NTHR), args, LDS_BYTES, stream);
    if (e != hipSuccess) fprintf(stderr, "kernel_launch: cooperative launch failed: %s (grid %d)\n", hipGetErrorString(e), grid);
}
```
